# Optimizing an MI355X kernel written in HIP

```python
import math
import numpy as np
import jax
import jax.numpy as jnp
from jax import lax

D_MODEL = 1024
BATCH = 16
SEQ = 2048
DEPTH = 2

N_MIXERS = 4
GROUP_W = D_MODEL // N_MIXERS
EPS = 1e-6
ROPE_THETA = 500000.0
Q_BLOCK = 128
NEG = -1e30
MAX_START = 4096

MLA_HEADS = 4
MLA_ROPE = 32
MLA_NOPE = 64
MLA_V = GROUP_W // MLA_HEADS
MLA_QK = MLA_ROPE + MLA_NOPE
MLA_Q_RANK = 3 * GROUP_W // 4
MLA_KV_RANK = GROUP_W // 2

LRU_W = GROUP_W
LRU_BLOCKS = 4
LRU_BW = LRU_W // LRU_BLOCKS
CONV_W = 4
LRU_C = 8.0

S5_W = GROUP_W
S5_CH = 16
S5_GROUPS = S5_W // S5_CH
S5_P = 64

NSA_HEADS = 4
NSA_DK = GROUP_W // NSA_HEADS
ROT_DIM = NSA_DK // 4
CMP_LEN = 32
CMP_STRIDE = 16
CMP_HID = 128
SEL_LEN = 64
SEL_TOPK = 5
WIN = 512

N_GROUPS = 4
EXP_PER_GROUP = 4
N_EXPERTS = N_GROUPS * EXP_PER_GROUP
D_EXPERT = 256
TOPK_IN_GROUP = 2

IN_COLS = (MLA_Q_RANK, MLA_KV_RANK, MLA_ROPE, LRU_W, LRU_W, S5_W, NSA_HEADS * NSA_DK, 6 * NSA_DK, 3 * NSA_HEADS)
IN_SPLITS = tuple(sum(IN_COLS[:i + 1]) for i in range(len(IN_COLS) - 1))
D_IN = sum(IN_COLS)

kernel_name = 'hybrid_mla_rglru_s5_nsa_hmoe'


def rms_norm(x, g):
    xf = x.astype(jnp.float32)
    y = xf * lax.rsqrt(jnp.mean(xf * xf, axis=-1, keepdims=True) + EPS) * g.astype(jnp.float32)
    return y.astype(x.dtype)


def rope(x, pos, rot_dim):
    half = rot_dim // 2
    inv = ROPE_THETA ** (-jnp.arange(half, dtype=jnp.float32) * 2.0 / rot_dim)
    ang = pos.astype(jnp.float32)[..., None] * inv
    c = jnp.cos(ang)[:, :, None, :]
    s = jnp.sin(ang)[:, :, None, :]
    xf = x.astype(jnp.float32)
    x1 = xf[..., :half]
    x2 = xf[..., half:rot_dim]
    out = jnp.concatenate([x1 * c - x2 * s, x1 * s + x2 * c, xf[..., rot_dim:]], axis=-1)
    return out.astype(x.dtype)


def masked_softmax(s, mask):
    s = jnp.where(mask, s.astype(jnp.float32), NEG)
    p = jax.nn.softmax(s, axis=-1)
    return jnp.where(mask, p, 0.0)


def linear_scan(a, b):
    def comb(l, r):
        return (r[0] * l[0], r[0] * l[1] + r[1])
    return lax.associative_scan(comb, (a, b), axis=1)[1]


def causal_attention(q, k, v, scale):
    B, S, H, Dq = q.shape
    nq = S // Q_BLOCK
    qb = q.reshape(B, nq, Q_BLOCK, H, Dq).transpose(1, 0, 2, 3, 4)
    kpos = jnp.arange(S)

    def block(args):
        qc, c = args
        s = jnp.einsum('bqhd,bkhd->bhqk', qc, k) * scale
        qpos = c * Q_BLOCK + jnp.arange(Q_BLOCK)
        p = masked_softmax(s, kpos[None, :] <= qpos[:, None])
        return jnp.einsum('bhqk,bkhd->bqhd', p.astype(v.dtype), v)

    o = lax.map(block, (qb, jnp.arange(nq)))
    return o.transpose(1, 0, 2, 3, 4).reshape(B, S, H, v.shape[-1])


def mla(c_q, c_kv, k_pe, pos, g_cq, g_ckv, w_uq, w_ukv, g_q, g_k):
    B, S, _ = c_q.shape
    H = MLA_HEADS
    q = (rms_norm(c_q, g_cq) @ w_uq).reshape(B, S, H, MLA_QK)
    kv = (rms_norm(c_kv, g_ckv) @ w_ukv).reshape(B, S, H, MLA_NOPE + MLA_V)
    k_nope, v = kv[..., :MLA_NOPE], kv[..., MLA_NOPE:]
    k_rope = jnp.broadcast_to(k_pe[:, :, None, :], (B, S, H, MLA_ROPE))
    k = jnp.concatenate([k_rope, k_nope], axis=-1)
    q = rope(rms_norm(q, g_q), pos, MLA_ROPE)
    k = rope(rms_norm(k, g_k), pos, MLA_ROPE)
    o = causal_attention(q, k, v, MLA_QK ** -0.5)
    return o.reshape(B, S, H * MLA_V)


def rglru(xb, gb, w_conv, b_conv, w_a, b_a, w_i, b_i, lam):
    B, S, C = xb.shape
    xp = jnp.pad(xb, ((0, 0), (CONV_W - 1, 0), (0, 0)))
    u = b_conv
    for j in range(CONV_W):
        u = u + xp[:, j:j + S] * w_conv[j]
    ub = u.reshape(B, S, LRU_BLOCKS, LRU_BW)
    r = jax.nn.sigmoid(jnp.einsum('bshi,hij->bshj', ub, w_a) + b_a).reshape(B, S, C).astype(jnp.float32)
    gi = jax.nn.sigmoid(jnp.einsum('bshi,hij->bshj', ub, w_i) + b_i).reshape(B, S, C).astype(jnp.float32)
    log_a = -LRU_C * r * jax.nn.softplus(-lam.astype(jnp.float32))
    a = jnp.exp(log_a)
    mult = jnp.sqrt(jnp.maximum(-jnp.expm1(2.0 * log_a), 0.0))
    mult = jnp.where(jnp.arange(S)[None, :, None] == 0, 1.0, mult)
    h = linear_scan(a, mult * gi * u.astype(jnp.float32))
    y = h * jax.nn.gelu(gb.astype(jnp.float32))
    return y.astype(xb.dtype)


def s5(u, a_re, a_im, log_dt, b_re, b_im, c_re, c_im, d, w_glu, b_glu):
    B, S, _ = u.shape
    f32 = jnp.float32
    uf = u.astype(f32).reshape(B, S, S5_GROUPS, S5_CH)
    a_re = a_re.astype(f32)
    a_im = a_im.astype(f32)
    b_re = b_re.astype(f32)
    b_im = b_im.astype(f32)
    dt = jnp.exp(log_dt.astype(f32))[:, None]
    mag = jnp.exp(dt * a_re)
    ab_re = mag * jnp.cos(dt * a_im)
    ab_im = mag * jnp.sin(dt * a_im)
    den = a_re * a_re + a_im * a_im
    n_re = ab_re - 1.0
    g_re = (n_re * a_re + ab_im * a_im) / den
    g_im = (ab_im * a_re - n_re * a_im) / den
    bb_re = g_re[..., None] * b_re - g_im[..., None] * b_im
    bb_im = g_re[..., None] * b_im + g_im[..., None] * b_re
    bu_re = jnp.einsum('bsgh,gph->bsgp', uf, bb_re)
    bu_im = jnp.einsum('bsgh,gph->bsgp', uf, bb_im)
    ar = jnp.broadcast_to(ab_re, bu_re.shape)
    ai = jnp.broadcast_to(ab_im, bu_re.shape)

    def comb(l, r):
        ar1, ai1, br1, bi1 = l
        ar2, ai2, br2, bi2 = r
        return (ar2 * ar1 - ai2 * ai1, ar2 * ai1 + ai2 * ar1,
                ar2 * br1 - ai2 * bi1 + br2, ar2 * bi1 + ai2 * br1 + bi2)

    _, _, h_re, h_im = lax.associative_scan(comb, (ar, ai, bu_re, bu_im), axis=1)
    y = (jnp.einsum('bsgp,ghp->bsgh', h_re, c_re.astype(f32))
         - jnp.einsum('bsgp,ghp->bsgh', h_im, c_im.astype(f32)))
    y = y.reshape(B, S, S5_W) + d.astype(f32) * u.astype(f32)
    y = jax.nn.gelu(y)
    y = y * jax.nn.sigmoid(y @ w_glu.astype(f32) + b_glu.astype(f32))
    return y.astype(u.dtype)


def nsa(q, kv, gate_logits, pos, g_q, g_k, pe_k, w1_k, w2_k, pe_v, w1_v, w2_v):
    B, S, _ = q.shape
    H, Dh = NSA_HEADS, NSA_DK
    scale = Dh ** -0.5
    k_cmp, v_cmp, k_slc, v_slc, k_win, v_win = jnp.split(kv, 6, axis=-1)
    qh = rope(rms_norm(q.reshape(B, S, H, Dh), g_q), pos, ROT_DIM)
    qidx = jnp.arange(S)

    def key_prep(k, g, p):
        return rope(rms_norm(k, g)[:, :, None, :], p, ROT_DIM)[:, :, 0, :]

    nc = (S - CMP_LEN) // CMP_STRIDE + 1
    blk = np.arange(nc)[:, None] * CMP_STRIDE + np.arange(CMP_LEN)[None, :]
    blk_end = blk[:, -1]

    def compress(t, pe, w1, w2):
        tb = (t[:, blk] + pe).reshape(B, nc, CMP_LEN * Dh)
        return jax.nn.gelu(tb @ w1) @ w2

    kc = key_prep(compress(k_cmp, pe_k, w1_k, w2_k), g_k[0], pos[:, blk_end])
    vc = compress(v_cmp, pe_v, w1_v, w2_v)
    s_c = jnp.einsum('bshd,bcd->bhsc', qh, kc) * scale
    p_c = masked_softmax(s_c, blk_end[None, :] <= qidx[:, None])
    o_cmp = jnp.einsum('bhsc,bcd->bshd', p_c.astype(vc.dtype), vc)

    nsb = S // SEL_LEN
    cs = np.arange(nc) * CMP_STRIDE
    ss = np.arange(nsb) * SEL_LEN
    ov = np.clip(np.minimum(cs[:, None] + CMP_LEN, ss[None, :] + SEL_LEN)
                 - np.maximum(cs[:, None], ss[None, :]), 0, None) / CMP_STRIDE
    imp = jnp.einsum('bhsc,cj->bsj', p_c, jnp.asarray(ov, jnp.float32))
    cur = qidx // SEL_LEN
    sb = jnp.arange(nsb)
    forced = (sb[None, :] == 0) | (sb[None, :] == cur[:, None]) | (sb[None, :] == cur[:, None] - 1)
    future = sb[None, :] > cur[:, None]
    score = jnp.where(future, -jnp.inf, jnp.where(forced, jnp.inf, imp))
    ksel = min(SEL_TOPK, nsb)
    _, sel = lax.top_k(score, ksel)
    k_s = key_prep(k_slc, g_k[1], pos)
    nq = S // Q_BLOCK
    gather = jax.vmap(lambda kb, ib: kb[ib])

    def sel_block(args):
        qc, sc, qp = args
        tok = (sc[..., None] * SEL_LEN + jnp.arange(SEL_LEN)).reshape(B, Q_BLOCK, ksel * SEL_LEN)
        kg = gather(k_s, tok)
        vg = gather(v_slc, tok)
        s = jnp.einsum('bqhd,bqnd->bhqn', qc, kg) * scale
        p = masked_softmax(s, (tok <= qp[None, :, None])[:, None])
        return jnp.einsum('bhqn,bqnd->bqhd', p.astype(vg.dtype), vg)

    q_ch = qh.reshape(B, nq, Q_BLOCK, H, Dh).transpose(1, 0, 2, 3, 4)
    sel_ch = sel.reshape(B, nq, Q_BLOCK, ksel).transpose(1, 0, 2, 3)
    o_slc = lax.map(sel_block, (q_ch, sel_ch, qidx.reshape(nq, Q_BLOCK)))
    o_slc = o_slc.transpose(1, 0, 2, 3, 4).reshape(B, S, H, Dh)

    k_w = key_prep(k_win, g_k[2], pos)
    span = WIN + Q_BLOCK
    kidx = np.arange(nq)[:, None] * Q_BLOCK + np.arange(span)[None, :]
    kpos = kidx - WIN
    kw = jnp.pad(k_w, ((0, 0), (WIN, 0), (0, 0)))[:, kidx]
    vw = jnp.pad(v_win, ((0, 0), (WIN, 0), (0, 0)))[:, kidx]
    qb = qh.reshape(B, nq, Q_BLOCK, H, Dh)
    s_w = jnp.einsum('bcqhd,bckd->bhcqk', qb, kw) * scale
    qpos = np.arange(nq)[:, None] * Q_BLOCK + np.arange(Q_BLOCK)[None, :]
    mask_w = ((kpos[:, None, :] <= qpos[:, :, None]) & (qpos[:, :, None] - kpos[:, None, :] < WIN)
              & (kpos[:, None, :] >= 0))
    p_w = masked_softmax(s_w, mask_w)
    o_win = jnp.einsum('bhcqk,bckd->bcqhd', p_w.astype(vw.dtype), vw).reshape(B, S, H, Dh)

    g = jax.nn.sigmoid(gate_logits.astype(jnp.float32)).reshape(B, S, H, 3)
    o = g[..., 0:1] * o_cmp + g[..., 1:2] * o_slc + g[..., 2:3] * o_win
    return o.reshape(B, S, H * Dh).astype(q.dtype)


def hier_moe(h, w_rg, b_rg, w_re, b_re, w_gate, w_up, w_down):
    B, S, D = h.shape
    f32 = jnp.float32
    t = h.reshape(B * S, D)
    lg = (t @ w_rg).astype(f32) + b_rg.astype(f32)
    pg = jax.nn.softmax(lg, axis=-1)
    gi = jnp.argmax(lg, axis=-1)
    pg_top = jnp.take_along_axis(pg, gi[:, None], axis=1)
    le = ((t @ w_re).astype(f32) + b_re.astype(f32)).reshape(-1, N_GROUPS, EXP_PER_GROUP)
    le_g = jnp.take_along_axis(le, gi[:, None, None], axis=1)[:, 0]
    top_v, top_i = lax.top_k(jax.nn.softmax(le_g, axis=-1), TOPK_IN_GROUP)
    w = pg_top * top_v / jnp.sum(top_v, axis=-1, keepdims=True)
    eid = gi[:, None] * EXP_PER_GROUP + top_i
    comb = jnp.sum(jax.nn.one_hot(eid, N_EXPERTS, dtype=f32) * w[..., None], axis=1)
    y = jnp.zeros((B * S, D), f32)
    for e in range(N_EXPERTS):
        he = jax.nn.silu(t @ w_gate[e]) * (t @ w_up[e])
        y = y + comb[:, e:e + 1] * (he @ w_down[e]).astype(f32)
    return y.reshape(B, S, D).astype(h.dtype)


def setup_inputs(seed: int = 0) -> dict:
    key = jax.random.key(seed)
    ks = iter(jax.random.split(key, 64))
    f32 = jnp.float32
    L = DEPTH

    def rn(shape, scale):
        return scale * jax.random.normal(next(ks), shape, f32)

    def gain(shape):
        return 1.0 + rn(shape, 0.02)

    x = rn((BATCH, SEQ, D_MODEL), 1.0)
    start = jax.random.randint(next(ks), (BATCH, 1), 0, MAX_START, dtype=jnp.int32)
    positions = start + jnp.arange(SEQ, dtype=jnp.int32)[None, :]
    u_lam = jax.random.uniform(next(ks), (L, LRU_W), f32, 0.9, 0.999)
    s_lam = u_lam ** (1.0 / LRU_C)
    lru_lambda = jnp.log(s_lam) - jnp.log1p(-s_lam)
    s5_log_dt = jax.random.uniform(next(ks), (L, S5_GROUPS), f32, math.log(1e-3), math.log(1e-1))
    return {
        'x': x,
        'positions': positions,
        'mix_norm': gain((L, D_MODEL)),
        'w_in': rn((L, D_MODEL, D_IN), D_MODEL ** -0.5),
        'mla_g_cq': gain((L, MLA_Q_RANK)),
        'mla_g_ckv': gain((L, MLA_KV_RANK)),
        'mla_w_uq': rn((L, MLA_Q_RANK, MLA_HEADS * MLA_QK), MLA_Q_RANK ** -0.5),
        'mla_w_ukv': rn((L, MLA_KV_RANK, MLA_HEADS * (MLA_NOPE + MLA_V)), MLA_KV_RANK ** -0.5),
        'mla_g_q': gain((L, MLA_QK)),
        'mla_g_k': gain((L, MLA_QK)),
        'lru_conv_w': rn((L, CONV_W, LRU_W), CONV_W ** -0.5),
        'lru_conv_b': rn((L, LRU_W), 0.02),
        'lru_w_a': rn((L, LRU_BLOCKS, LRU_BW, LRU_BW), LRU_BW ** -0.5),
        'lru_b_a': rn((L, LRU_BLOCKS, LRU_BW), 0.1),
        'lru_w_i': rn((L, LRU_BLOCKS, LRU_BW, LRU_BW), LRU_BW ** -0.5),
        'lru_b_i': rn((L, LRU_BLOCKS, LRU_BW), 0.1),
        'lru_lambda': lru_lambda,
        's5_a_re': -0.5 + rn((L, S5_GROUPS, S5_P), 0.01),
        's5_a_im': math.pi * jnp.arange(S5_P, dtype=f32) + rn((L, S5_GROUPS, S5_P), 0.01),
        's5_log_dt': s5_log_dt,
        's5_b_re': rn((L, S5_GROUPS, S5_P, S5_CH), (2.0 * S5_CH) ** -0.5),
        's5_b_im': rn((L, S5_GROUPS, S5_P, S5_CH), (2.0 * S5_CH) ** -0.5),
        's5_c_re': rn((L, S5_GROUPS, S5_CH, S5_P), (2.0 * S5_P) ** -0.5),
        's5_c_im': rn((L, S5_GROUPS, S5_CH, S5_P), (2.0 * S5_P) ** -0.5),
        's5_d': rn((L, S5_W), 1.0),
        's5_w_glu': rn((L, S5_W, S5_W), S5_W ** -0.5),
        's5_b_glu': rn((L, S5_W), 0.02),
        'nsa_g_q': gain((L, NSA_DK)),
        'nsa_g_k': gain((L, 3, NSA_DK)),
        'nsa_pe_k': rn((L, CMP_LEN, NSA_DK), 0.02),
        'nsa_w1_k': rn((L, CMP_LEN * NSA_DK, CMP_HID), (CMP_LEN * NSA_DK) ** -0.5),
        'nsa_w2_k': rn((L, CMP_HID, NSA_DK), CMP_HID ** -0.5),
        'nsa_pe_v': rn((L, CMP_LEN, NSA_DK), 0.02),
        'nsa_w1_v': rn((L, CMP_LEN * NSA_DK, CMP_HID), (CMP_LEN * NSA_DK) ** -0.5),
        'nsa_w2_v': rn((L, CMP_HID, NSA_DK), CMP_HID ** -0.5),
        'out_norm': gain((L, N_MIXERS, GROUP_W)),
        'w_out': rn((L, D_MODEL, D_MODEL), D_MODEL ** -0.5),
        'ffn_norm': gain((L, D_MODEL)),
        'moe_w_rg': rn((L, D_MODEL, N_GROUPS), D_MODEL ** -0.5),
        'moe_b_rg': rn((L, N_GROUPS), 0.01),
        'moe_w_re': rn((L, D_MODEL, N_EXPERTS), D_MODEL ** -0.5),
        'moe_b_re': rn((L, N_EXPERTS), 0.01),
        'moe_w_gate': rn((L, N_EXPERTS, D_MODEL, D_EXPERT), D_MODEL ** -0.5),
        'moe_w_up': rn((L, N_EXPERTS, D_MODEL, D_EXPERT), D_MODEL ** -0.5),
        'moe_w_down': rn((L, N_EXPERTS, D_EXPERT, D_MODEL), D_EXPERT ** -0.5),
    }


def reference(x, positions, mix_norm, w_in, mla_g_cq, mla_g_ckv, mla_w_uq, mla_w_ukv, mla_g_q, mla_g_k,
              lru_conv_w, lru_conv_b, lru_w_a, lru_b_a, lru_w_i, lru_b_i, lru_lambda,
              s5_a_re, s5_a_im, s5_log_dt, s5_b_re, s5_b_im, s5_c_re, s5_c_im, s5_d, s5_w_glu, s5_b_glu,
              nsa_g_q, nsa_g_k, nsa_pe_k, nsa_w1_k, nsa_w2_k, nsa_pe_v, nsa_w1_v, nsa_w2_v,
              out_norm, w_out, ffn_norm, moe_w_rg, moe_b_rg, moe_w_re, moe_b_re,
              moe_w_gate, moe_w_up, moe_w_down):
    for l in range(DEPTH):
        h = rms_norm(x, mix_norm[l])
        c_q, c_kv, k_pe, lru_x, lru_gate, s5_u, nsa_q, nsa_kv, nsa_gate = jnp.split(
            h @ w_in[l], IN_SPLITS, axis=-1)
        y_a = mla(c_q, c_kv, k_pe, positions, mla_g_cq[l], mla_g_ckv[l], mla_w_uq[l], mla_w_ukv[l],
                  mla_g_q[l], mla_g_k[l])
        y_b = rglru(lru_x, lru_gate, lru_conv_w[l], lru_conv_b[l], lru_w_a[l], lru_b_a[l],
                    lru_w_i[l], lru_b_i[l], lru_lambda[l])
        y_c = s5(s5_u, s5_a_re[l], s5_a_im[l], s5_log_dt[l], s5_b_re[l], s5_b_im[l], s5_c_re[l],
                 s5_c_im[l], s5_d[l], s5_w_glu[l], s5_b_glu[l])
        y_d = nsa(nsa_q, nsa_kv, nsa_gate, positions, nsa_g_q[l], nsa_g_k[l], nsa_pe_k[l], nsa_w1_k[l],
                  nsa_w2_k[l], nsa_pe_v[l], nsa_w1_v[l], nsa_w2_v[l])
        y = jnp.stack([y_a, y_b, y_c, y_d], axis=2)
        y = rms_norm(y, out_norm[l]).reshape(x.shape)
        x = x + y @ w_out[l]
        x = x + hier_moe(rms_norm(x, ffn_norm[l]), moe_w_rg[l], moe_b_rg[l], moe_w_re[l], moe_b_re[l],
                         moe_w_gate[l], moe_w_up[l], moe_w_down[l])
    return x
```

```cpp
#include <hip/hip_runtime.h>
#include <hip/hip_cooperative_groups.h>
#include <cstdio>
#include <cstdint>
namespace cg = cooperative_groups;

#ifndef N_LAUNCH_MODE
#define N_LAUNCH_MODE 0
#endif

#define DEVI __device__ __forceinline__
typedef unsigned short bf16_t;
typedef short bf16x8 __attribute__((ext_vector_type(8)));
typedef float f32x4 __attribute__((ext_vector_type(4)));
typedef float f32x16 __attribute__((ext_vector_type(16)));
#define LAS __attribute__((address_space(3)))

constexpr int NB = 16, S = 2048, T = NB * S, D = 1024, DIN = 1772, DINP = 1792, NL = 2;
constexpr int C_CQ = 0, C_CKV = 192, C_KPE = 320, C_LX = 352, C_LG = 608, C_S5 = 864, C_NQ = 1120, C_NKV = 1376, C_NG = 1760;
constexpr float EPS = 1e-6f;
constexpr float LOG2E = 1.4426950408889634f;
constexpr int NTHREADS = 256;
constexpr int NPH = 1 + 13 * NL - 1;

constexpr size_t MiB = 1u << 20;
constexpr size_t WS_CTL = 0;
constexpr size_t WS_SMALL = 1 * MiB;
constexpr size_t WS_W = 16 * MiB;
constexpr size_t WS_WL = 32 * MiB;
constexpr size_t WS_A = 80 * MiB;
constexpr size_t WS_B = 144 * MiB;
constexpr size_t WS_C = 256 * MiB;
constexpr size_t WS_D = 292 * MiB;
constexpr size_t WS_E = 348 * MiB;
constexpr size_t WS_F = 380 * MiB;
constexpr size_t WS_G = 428 * MiB;
constexpr size_t WS_END = 452 * MiB;
constexpr size_t W_IN = 0;
constexpr size_t W_OUT = 4 * MiB;
constexpr size_t W_UQ = 6 * MiB;
constexpr size_t W_UKV = W_UQ + 384 * 192 * 2;
constexpr size_t W_LRU = W_UKV + 512 * 128 * 2;
constexpr size_t W_GLU = W_LRU + 4 * 128 * 64 * 2;
constexpr size_t W_1K = 6 * MiB + 512 * 1024;
constexpr size_t W_1V = W_1K + 128 * 2048 * 2;
constexpr size_t W_B1K = W_1V + 128 * 2048 * 2;
constexpr size_t W_B1V = W_B1K + 512;
constexpr size_t W_S5A = W_B1V + 512;
constexpr size_t W_S5A64 = W_S5A + 16 * 64 * 8;
constexpr size_t W_S5B = W_S5A64 + 16 * 64 * 8;
constexpr size_t W_GU = 8 * MiB;
constexpr size_t W_DN = 24 * MiB;
constexpr size_t SM_CNT = WS_SMALL;
constexpr size_t SM_LIST = WS_SMALL + 4096;
constexpr size_t SM_TOKW = SM_LIST + 24 * (size_t)T * 4;
constexpr size_t SM_LSUM = SM_TOKW + (size_t)T * 8;
constexpr size_t SM_SLOC = SM_LSUM + 16 * 32 * 256 * 8;
constexpr size_t SM_HK = SM_SLOC + 16 * 32 * 1024 * 8;
constexpr size_t SM_HV = SM_HK + 2048 * 128 * 2;
constexpr size_t SM_KC = SM_HV + 2048 * 128 * 2;
constexpr size_t SM_VC = SM_KC + 16 * 128 * 64 * 2;
constexpr size_t SM_END = SM_VC + 16 * 128 * 64 * 2;
static_assert(SM_END <= WS_W, "small region overflow");

constexpr int LDS_BYTES = 65536;

struct Params {
  const float* in[45];
  float* out;
  unsigned char* ws;
  int lo, hi;
};

DEVI float bf2f(bf16_t v) { return __uint_as_float(((unsigned)v) << 16); }
DEVI bf16_t f2bf(float f) { unsigned u = __float_as_uint(f); return (bf16_t)((u + 0x7fffu + ((u >> 16) & 1u)) >> 16); }
DEVI float wsum(float v) {
#pragma unroll
  for (int o = 32; o >= 1; o >>= 1) v += __shfl_xor(v, o);
  return v;
}
DEVI float sigmoidf_(float x) { return 1.f / (1.f + __expf(-x)); }
DEVI float gelu_tanh(float x) { return 0.5f * x * (1.f + tanhf(0.7978845608028654f * (x + 0.044715f * x * x * x))); }
DEVI f32x16 mfma32(bf16x8 a, bf16x8 b, f32x16 c) { return __builtin_amdgcn_mfma_f32_32x32x16_bf16(a, b, c, 0, 0, 0); }
DEVI f32x4 mfma16(bf16x8 a, bf16x8 b, f32x4 c) { return __builtin_amdgcn_mfma_f32_16x16x32_bf16(a, b, c, 0, 0, 0); }
DEVI int crow(int r, int h) { return (r & 3) + 8 * (r >> 2) + 4 * h; }

template <class AF, class BF>
DEVI void gemm128(unsigned char* lds, int K, AF aptr, BF bptr, f32x4 (&acc)[4][4]) {
  const int tid = threadIdx.x, wid = tid >> 6, lane = tid & 63, wr = wid >> 1, wc = wid & 1, fr = lane & 15, fq = lane >> 4;
  bf16_t* SA = (bf16_t*)lds;
  bf16_t* SB = SA + 128 * 32;
#pragma unroll
  for (int m = 0; m < 4; ++m)
#pragma unroll
    for (int n = 0; n < 4; ++n) acc[m][n] = (f32x4){0.f, 0.f, 0.f, 0.f};
  const int r0 = tid >> 2, c0 = (tid & 3) * 8;
  for (int kt = 0; kt < K / 32; ++kt) {
    const int k = kt * 32 + c0;
    const uint4 a0 = *(const uint4*)aptr(r0, k);
    const uint4 a1 = *(const uint4*)aptr(r0 + 64, k);
    const uint4 b0 = *(const uint4*)bptr(r0, k);
    const uint4 b1 = *(const uint4*)bptr(r0 + 64, k);
    __syncthreads();
    *(uint4*)(SA + r0 * 32 + c0) = a0;
    *(uint4*)(SA + (r0 + 64) * 32 + c0) = a1;
    *(uint4*)(SB + r0 * 32 + c0) = b0;
    *(uint4*)(SB + (r0 + 64) * 32 + c0) = b1;
    __syncthreads();
    bf16x8 At[4], Bt[4];
#pragma unroll
    for (int m = 0; m < 4; ++m) At[m] = *(const bf16x8*)(SA + (wr * 64 + m * 16 + fr) * 32 + fq * 8);
#pragma unroll
    for (int n = 0; n < 4; ++n) Bt[n] = *(const bf16x8*)(SB + (wc * 64 + n * 16 + fr) * 32 + fq * 8);
#pragma unroll
    for (int m = 0; m < 4; ++m)
#pragma unroll
      for (int n = 0; n < 4; ++n) acc[m][n] = mfma16(At[m], Bt[n], acc[m][n]);
  }
  __syncthreads();
}
#define GEMM_EPI_LOOP(body)                                                                 \
  {                                                                                         \
    const int _tid = threadIdx.x, _wid = _tid >> 6, _lane = _tid & 63, _wr = _wid >> 1, _wc = _wid & 1, _fr = _lane & 15, _fq = _lane >> 4; \
    _Pragma("unroll") for (int m = 0; m < 4; ++m) _Pragma("unroll") for (int n = 0; n < 4; ++n) _Pragma("unroll") for (int j = 0; j < 4; ++j) { \
      const int er = _wr * 64 + m * 16 + _fq * 4 + j, ec = _wc * 64 + n * 16 + _fr; const float ev = acc[m][n][j]; body }                      \
  }

DEVI void transpose_cvt(const float* src, int K, int N, bf16_t* dst, int Npad, size_t gtid, size_t gn) {
  const size_t tot = (size_t)Npad * K;
  for (size_t i = gtid; i < tot; i += gn) { const int n = (int)(i / K), k = (int)(i % K); dst[i] = (n < N) ? f2bf(src[(size_t)k * N + n]) : (bf16_t)0; }
}
DEVI void rmsnorm_rows(const float* x, const float* g, bf16_t* xn) {
  const int lane = threadIdx.x & 63, gw = blockIdx.x * 4 + (threadIdx.x >> 6), NGW = gridDim.x * 4;
  for (int t = gw; t < T; t += NGW) {
    const float4* xr = (const float4*)(x + (size_t)t * D);
    float4 v[4]; float s = 0.f;
#pragma unroll
    for (int j = 0; j < 4; ++j) { v[j] = xr[lane + 64 * j]; s += v[j].x * v[j].x + v[j].y * v[j].y + v[j].z * v[j].z + v[j].w * v[j].w; }
    const float rs = rsqrtf(wsum(s) * (1.f / D) + EPS);
#pragma unroll
    for (int j = 0; j < 4; ++j) {
      const float4 gg = ((const float4*)g)[lane + 64 * j];
      ushort4 o; o.x = f2bf(v[j].x * rs * gg.x); o.y = f2bf(v[j].y * rs * gg.y); o.z = f2bf(v[j].z * rs * gg.z); o.w = f2bf(v[j].w * rs * gg.w);
      ((ushort4*)(xn + (size_t)t * D))[lane + 64 * j] = o;
    }
  }
}
DEVI void phase_prep(const Params& p) {
  const size_t gtid = (size_t)blockIdx.x * NTHREADS + threadIdx.x, gn = (size_t)gridDim.x * NTHREADS;
  unsigned char* ws = p.ws;
  if (gtid < 64) ((int*)(ws + SM_CNT))[gtid] = 0;
  for (int l = 0; l < NL; ++l) {
    unsigned char* wl = ws + WS_W + l * WS_WL;
    transpose_cvt(p.in[3] + (size_t)l * D * DIN, D, DIN, (bf16_t*)(wl + W_IN), DINP, gtid, gn);
    transpose_cvt(p.in[36] + (size_t)l * D * D, D, D, (bf16_t*)(wl + W_OUT), D, gtid, gn);
    transpose_cvt(p.in[6] + (size_t)l * 192 * 384, 192, 384, (bf16_t*)(wl + W_UQ), 384, gtid, gn);
    transpose_cvt(p.in[7] + (size_t)l * 128 * 512, 128, 512, (bf16_t*)(wl + W_UKV), 512, gtid, gn);
    transpose_cvt(p.in[25] + (size_t)l * 256 * 256, 256, 256, (bf16_t*)(wl + W_GLU), 256, gtid, gn);
    transpose_cvt(p.in[30] + (size_t)l * 2048 * 128, 2048, 128, (bf16_t*)(wl + W_1K), 128, gtid, gn);
    transpose_cvt(p.in[33] + (size_t)l * 2048 * 128, 2048, 128, (bf16_t*)(wl + W_1V), 128, gtid, gn);
    for (size_t i = gtid; i < 4 * 128 * 64; i += gn) {
      const int h = (int)(i / (128 * 64)), rr = (int)((i / 64) % 128), k = (int)(i % 64);
      const float* src = (rr < 64) ? p.in[12] : p.in[14];
      ((bf16_t*)(wl + W_LRU))[i] = f2bf(src[(((size_t)l * 4 + h) * 64 + k) * 64 + (rr & 63)]);
    }
    for (size_t i = gtid; i < 256; i += gn) {
      const int kv = (int)(i >> 7), j = (int)(i & 127);
      const float* pe = (kv ? p.in[32] : p.in[29]) + (size_t)l * 2048;
      const float* w1 = (kv ? p.in[33] : p.in[30]) + (size_t)l * 2048 * 128;
      float a = 0.f;
      for (int k = 0; k < 2048; ++k) a += pe[k] * w1[(size_t)k * 128 + j];
      ((float*)(wl + (kv ? W_B1V : W_B1K)))[j] = a;
    }
    for (size_t i = gtid; i < 16 * 64; i += gn) {
      const int g = (int)(i >> 6);
      const float are = p.in[17][(size_t)l * 1024 + i], aim = p.in[18][(size_t)l * 1024 + i];
      const float dt = expf(p.in[19][l * 16 + g]);
      const float mag = expf(dt * are);
      float sn, cs; sincosf(dt * aim, &sn, &cs);
      const float abr = mag * cs, abi = mag * sn;
      const float den = are * are + aim * aim, nre = abr - 1.f;
      const float gre = (nre * are + abi * aim) / den, gim = (abi * are - nre * aim) / den;
      ((float2*)(wl + W_S5A))[i] = make_float2(abr, abi);
      float pr = abr, pi = abi;
#pragma unroll
      for (int q = 0; q < 6; ++q) { const float nr = pr * pr - pi * pi, ni = 2.f * pr * pi; pr = nr; pi = ni; }
      ((float2*)(wl + W_S5A64))[i] = make_float2(pr, pi);
      for (int ch = 0; ch < 16; ++ch) {
        const float br = p.in[20][((size_t)l * 1024 + i) * 16 + ch], bi = p.in[21][((size_t)l * 1024 + i) * 16 + ch];
        ((float2*)(wl + W_S5B))[i * 16 + ch] = make_float2(gre * br - gim * bi, gre * bi + gim * br);
      }
    }
    {
      const size_t tot = (size_t)16 * 512 * 1024;
      for (size_t i = gtid; i < tot; i += gn) {
        const int e = (int)(i / (512 * 1024)), row = (int)((i / 1024) % 512), k = (int)(i % 1024);
        const int nt = row >> 7, rr = row & 127, wc = rr >> 6, nf = (rr & 63) >> 4, fr = rr & 15;
        const int hh = nt * 64 + wc * 32 + (nf & 1) * 16 + fr;
        const float* src = (nf < 2) ? p.in[42] : p.in[43];
        ((bf16_t*)(wl + W_GU))[i] = f2bf(src[(((size_t)l * 16 + e) * 1024 + k) * 256 + hh]);
      }
    }
    {
      const size_t tot = (size_t)16 * 1024 * 256;
      for (size_t i = gtid; i < tot; i += gn) {
        const int e = (int)(i / (1024 * 256)), n = (int)((i / 256) % 1024), k = (int)(i % 256);
        ((bf16_t*)(wl + W_DN))[i] = f2bf(p.in[44][(((size_t)l * 16 + e) * 256 + k) * 1024 + n]);
      }
    }
  }
  rmsnorm_rows(p.in[0], p.in[2], (bf16_t*)(ws + WS_A));
}

DEVI void phase_g1(const Params& p, int l, unsigned char* lds) {
  const bf16_t* XN = (const bf16_t*)(p.ws + WS_A);
  const bf16_t* W = (const bf16_t*)(p.ws + WS_W + l * WS_WL + W_IN);
  bf16_t* PROJ = (bf16_t*)(p.ws + WS_B);
  constexpr int NT = DINP / 128;
  for (int it = blockIdx.x; it < (T / 128) * NT; it += gridDim.x) {
    const int mt = it / NT, nt = it % NT;
    f32x4 acc[4][4];
    gemm128(lds, D, [&](int r, int k) { return XN + (size_t)(mt * 128 + r) * D + k; }, [&](int r, int k) { return W + (size_t)(nt * 128 + r) * D + k; }, acc);
    GEMM_EPI_LOOP({ PROJ[(size_t)(mt * 128 + er) * DINP + nt * 128 + ec] = f2bf(ev); })
  }
}

DEVI void rope_cs(int pos, int i, int rot_dim, float& c, float& s) {
  const float inv = powf(500000.f, -(2.f * (float)i) / (float)rot_dim);
  sincosf((float)pos * inv, &s, &c);
}

DEVI void phase_r1(const Params& p, int l, unsigned char* lds) {
  const int lane = threadIdx.x & 63, wv = threadIdx.x >> 6, gw = blockIdx.x * 4 + wv, NGW = gridDim.x * 4;
  float* row = (float*)lds + wv * DINP;
  const bf16_t* PROJ = (const bf16_t*)(p.ws + WS_B);
  bf16_t* CQN = (bf16_t*)(p.ws + WS_C);
  bf16_t* CKVN = CQN + (size_t)T * 192;
  bf16_t* UB = CKVN + (size_t)T * 128;
  bf16_t* QN = (bf16_t*)(p.ws + WS_G);
  bf16_t* KS = QN + (size_t)T * 256;
  bf16_t* KW = KS + (size_t)T * 64;
  const float* g_cq = p.in[4] + l * 192; const float* g_ckv = p.in[5] + l * 128;
  const float* g_nq = p.in[27] + l * 64; const float* g_nk = p.in[28] + l * 192;
  const float* cw = p.in[10] + l * 4 * 256; const float* cb = p.in[11] + l * 256;
  const int* positions = (const int*)p.in[1];
  for (int t = gw; t < T; t += NGW) {
    const int s = t & (S - 1), pos = positions[t];
    const bf16_t* pr = PROJ + (size_t)t * DINP;
    for (int i = lane; i < DINP / 2; i += 64) { const unsigned u = ((const unsigned*)pr)[i]; row[2 * i] = __uint_as_float(u << 16); row[2 * i + 1] = __uint_as_float(u & 0xffff0000u); }
    __builtin_amdgcn_s_waitcnt(0);
    __builtin_amdgcn_wave_barrier();
    { float ss = 0.f; for (int i = lane; i < 192; i += 64) ss += row[C_CQ + i] * row[C_CQ + i];
      const float rs = rsqrtf(wsum(ss) * (1.f / 192) + EPS);
      for (int i = lane; i < 192; i += 64) CQN[(size_t)t * 192 + i] = f2bf(row[C_CQ + i] * rs * g_cq[i]); }
    { float ss = 0.f; for (int i = lane; i < 128; i += 64) ss += row[C_CKV + i] * row[C_CKV + i];
      const float rs = rsqrtf(wsum(ss) * (1.f / 128) + EPS);
      for (int i = lane; i < 128; i += 64) CKVN[(size_t)t * 128 + i] = f2bf(row[C_CKV + i] * rs * g_ckv[i]); }
    {
      const int hd = lane >> 4, li = lane & 15;
      const float* q = row + C_NQ + hd * 64;
      float ss = 0.f;
#pragma unroll
      for (int i = 0; i < 4; ++i) ss += q[li + 16 * i] * q[li + 16 * i];
      ss += __shfl_xor(ss, 1); ss += __shfl_xor(ss, 2); ss += __shfl_xor(ss, 4); ss += __shfl_xor(ss, 8);
      const float rs = rsqrtf(ss * (1.f / 64) + EPS);
      const float sc = 0.125f * LOG2E;
#pragma unroll
      for (int i = 0; i < 4; ++i) {
        const int d = li + 16 * i; float v;
        if (d < 16) { float c, sn; rope_cs(pos, d & 7, 16, c, sn);
          const float x1 = q[d & 7] * rs * g_nq[d & 7], x2 = q[(d & 7) + 8] * rs * g_nq[(d & 7) + 8];
          v = (d < 8) ? (x1 * c - x2 * sn) : (x1 * sn + x2 * c);
        } else v = q[d] * rs * g_nq[d];
        QN[(size_t)t * 256 + hd * 64 + d] = f2bf(v * sc);
      }
    }
    {
      const int which = lane >> 5, li = lane & 31;
      const float* kk = row + C_NKV + (which ? 256 : 128);
      const float* g = g_nk + (which ? 128 : 64);
      float ss = kk[li] * kk[li] + kk[li + 32] * kk[li + 32];
      ss += __shfl_xor(ss, 1); ss += __shfl_xor(ss, 2); ss += __shfl_xor(ss, 4); ss += __shfl_xor(ss, 8); ss += __shfl_xor(ss, 16);
      const float rs = rsqrtf(ss * (1.f / 64) + EPS);
      bf16_t* dst = (which ? KW : KS) + (size_t)t * 64;
#pragma unroll
      for (int i = 0; i < 2; ++i) {
        const int d = li + 32 * i; float v;
        if (d < 16) { float c, sn; rope_cs(pos, d & 7, 16, c, sn);
          const float x1 = kk[d & 7] * rs * g[d & 7], x2 = kk[(d & 7) + 8] * rs * g[(d & 7) + 8];
          v = (d < 8) ? (x1 * c - x2 * sn) : (x1 * sn + x2 * c);
        } else v = kk[d] * rs * g[d];
        dst[d] = f2bf(v);
      }
    }
    for (int c = lane; c < 256; c += 64) {
      float u = cb[c];
#pragma unroll
      for (int j = 0; j < 4; ++j) { const int ss2 = s - 3 + j; if (ss2 >= 0) u += bf2f(PROJ[(size_t)(t - 3 + j) * DINP + C_LX + c]) * cw[j * 256 + c]; }
      UB[(size_t)t * 256 + c] = f2bf(u);
    }
    __builtin_amdgcn_wave_barrier();
  }
}

DEVI void phase_g2(const Params& p, int l, unsigned char* lds) {
  unsigned char* wl = p.ws + WS_W + l * WS_WL;
  const bf16_t* PROJ = (const bf16_t*)(p.ws + WS_B);
  const bf16_t* CQN = (const bf16_t*)(p.ws + WS_C);
  const bf16_t* CKVN = CQN + (size_t)T * 192;
  const bf16_t* UB = CKVN + (size_t)T * 128;
  bf16_t* QR = (bf16_t*)(p.ws + WS_D);
  bf16_t* KVR = QR + (size_t)T * 384;
  bf16_t* GATES = (bf16_t*)(p.ws + WS_E);
  constexpr int N_CMP = 32, N_QR = 256 * 3, N_KVR = 256 * 4, N_GT = 256 * 4;
  for (int it = blockIdx.x; it < N_CMP + N_QR + N_KVR + N_GT; it += gridDim.x) {
    f32x4 acc[4][4];
    if (it < N_CMP) {
      const int kv = it & 1, mt = it >> 1;
      const bf16_t* W = (const bf16_t*)(wl + (kv ? W_1V : W_1K));
      const float* bias = (const float*)(wl + (kv ? W_B1V : W_B1K));
      bf16_t* H = (bf16_t*)(p.ws + (kv ? SM_HV : SM_HK));
      gemm128(lds, 2048,
              [&](int r, int k) { const int m = mt * 128 + r, b = m >> 7; int c = m & 127; if (c > 126) c = 126;
                                  return PROJ + (size_t)(b * S + 16 * c + (k >> 6)) * DINP + C_NKV + kv * 64 + (k & 63); },
              [&](int r, int k) { return W + (size_t)r * 2048 + k; }, acc);
      GEMM_EPI_LOOP({ H[(size_t)(mt * 128 + er) * 128 + ec] = f2bf(gelu_tanh(ev + bias[ec])); })
    } else if (it < N_CMP + N_QR) {
      const int i2 = it - N_CMP, mt = i2 / 3, nt = i2 % 3;
      const bf16_t* W = (const bf16_t*)(wl + W_UQ);
      gemm128(lds, 192, [&](int r, int k) { return CQN + (size_t)(mt * 128 + r) * 192 + k; }, [&](int r, int k) { return W + (size_t)(nt * 128 + r) * 192 + k; }, acc);
      GEMM_EPI_LOOP({ QR[(size_t)(mt * 128 + er) * 384 + nt * 128 + ec] = f2bf(ev); })
    } else if (it < N_CMP + N_QR + N_KVR) {
      const int i2 = it - N_CMP - N_QR, mt = i2 >> 2, nt = i2 & 3;
      const bf16_t* W = (const bf16_t*)(wl + W_UKV);
      gemm128(lds, 128, [&](int r, int k) { return CKVN + (size_t)(mt * 128 + r) * 128 + k; }, [&](int r, int k) { return W + (size_t)(nt * 128 + r) * 128 + k; }, acc);
      GEMM_EPI_LOOP({ KVR[(size_t)(mt * 128 + er) * 512 + nt * 128 + ec] = f2bf(ev); })
    } else {
      const int i2 = it - N_CMP - N_QR - N_KVR, mt = i2 >> 2, h = i2 & 3;
      const bf16_t* W = (const bf16_t*)(wl + W_LRU) + h * 128 * 64;
      gemm128(lds, 64, [&](int r, int k) { return UB + (size_t)(mt * 128 + r) * 256 + h * 64 + k; }, [&](int r, int k) { return W + (size_t)r * 64 + k; }, acc);
      GEMM_EPI_LOOP({ GATES[(size_t)(mt * 128 + er) * 512 + h * 128 + ec] = f2bf(ev); })
    }
  }
}

DEVI void lru_ab(float u, float rpre, float ipre, float sp, bool first, float& a, float& b) {
  const float r = sigmoidf_(rpre), gi = sigmoidf_(ipre);
  const float la = -8.f * r * sp;
  a = expf(la);
  const float mult = first ? 1.f : sqrtf(fmaxf(-expm1f(2.f * la), 0.f));
  b = mult * gi * u;
}
DEVI float lru_conv(const bf16_t* PROJ, int t, int s, int c, const float* cw, float cb) {
  float u = cb;
#pragma unroll
  for (int j = 0; j < 4; ++j) { const int ss2 = s - 3 + j; if (ss2 >= 0) u += bf2f(PROJ[(size_t)(t - 3 + j) * DINP + C_LX + c]) * cw[j * 256 + c]; }
  return u;
}

template <bool FULL>
DEVI void s5_chunk(const Params& p, int l, int b, int chunk, unsigned char* lds) {
  unsigned char* wl = p.ws + WS_W + l * WS_WL;
  const bf16_t* PROJ = (const bf16_t*)(p.ws + WS_B);
  const float2* Abar = (const float2*)(wl + W_S5A);
  const float2* A64 = (const float2*)(wl + W_S5A64);
  const float2* Bbar = (const float2*)(wl + W_S5B);
  float2* SLOC = (float2*)(p.ws + SM_SLOC);
  bf16_t* YCP = (bf16_t*)(p.ws + WS_F);
  const float* c_re = p.in[22] + (size_t)l * 16 * 16 * 64;
  const float* c_im = p.in[23] + (size_t)l * 16 * 16 * 64;
  const float* dd = p.in[24] + l * 256;
  const int tid = threadIdx.x, gs = tid >> 6, pp = tid & 63;
  bf16_t* U = (bf16_t*)lds;
  float2* H = (float2*)(lds + 32768);
  const int t0 = b * S + chunk * 64;
  __syncthreads();
  for (int i = tid; i < 64 * 32; i += NTHREADS) { const int r = i >> 5, c8 = i & 31; *(uint4*)(U + r * 256 + c8 * 8) = *(const uint4*)(PROJ + (size_t)(t0 + r) * DINP + C_S5 + c8 * 8); }
  __syncthreads();
  for (int set = 0; set < 4; ++set) {
    const int g = set * 4 + gs;
    const float2 A = Abar[g * 64 + pp];
    float2 Bb[16];
#pragma unroll
    for (int ch = 0; ch < 16; ++ch) Bb[ch] = Bbar[(g * 64 + pp) * 16 + ch];
    float hr = 0.f, hi = 0.f;
    if (FULL) {
      const float2 a64 = A64[g * 64 + pp];
      for (int cc = 0; cc < chunk; ++cc) { const float2 sl = SLOC[((size_t)(b * 32 + cc) * 16 + g) * 64 + pp]; const float nr = a64.x * hr - a64.y * hi + sl.x, ni = a64.x * hi + a64.y * hr + sl.y; hr = nr; hi = ni; }
    }
    for (int sub = 0; sub < 4; ++sub) {
      for (int tt = 0; tt < 16; ++tt) {
        const bf16_t* ur = U + (sub * 16 + tt) * 256 + g * 16;
        float br = 0.f, bi = 0.f;
#pragma unroll
        for (int ch = 0; ch < 16; ++ch) { const float uv = bf2f(ur[ch]); br += Bb[ch].x * uv; bi += Bb[ch].y * uv; }
        const float nr = A.x * hr - A.y * hi + br, ni = A.x * hi + A.y * hr + bi; hr = nr; hi = ni;
        if (FULL) H[(tt * 4 + gs) * 64 + pp] = make_float2(hr, hi);
      }
      if (FULL) {
        __syncthreads();
#pragma unroll
        for (int i = 0; i < 4; ++i) {
          const int idx = tid + 256 * i, tt = idx >> 6, gg = (idx >> 4) & 3, ch = idx & 15, g2 = set * 4 + gg;
          const float* cr = c_re + (g2 * 16 + ch) * 64; const float* ci = c_im + (g2 * 16 + ch) * 64;
          const float2* hh = H + (tt * 4 + gg) * 64;
          float y = 0.f;
          for (int q = 0; q < 64; ++q) { const float2 hv = hh[q]; y += hv.x * cr[q] - hv.y * ci[q]; }
          const int col = g2 * 16 + ch, tr = sub * 16 + tt;
          y += dd[col] * bf2f(U[tr * 256 + col]);
          YCP[(size_t)(t0 + tr) * 256 + col] = f2bf(gelu_tanh(y));
        }
        __syncthreads();
      }
    }
    if (!FULL) SLOC[((size_t)(b * 32 + chunk) * 16 + g) * 64 + pp] = make_float2(hr, hi);
  }
}

DEVI void phase_r2(const Params& p, int l, unsigned char* lds) {
  unsigned char* wl = p.ws + WS_W + l * WS_WL;
  const bf16_t* PROJ = (const bf16_t*)(p.ws + WS_B);
  const bf16_t* QR = (const bf16_t*)(p.ws + WS_D);
  const bf16_t* KVR = QR + (size_t)T * 384;
  const bf16_t* GATES = (const bf16_t*)(p.ws + WS_E);
  bf16_t* MQ = (bf16_t*)(p.ws + WS_F);
  bf16_t* MK = MQ + (size_t)T * 4 * 96;
  const int* positions = (const int*)p.in[1];
  const int tid = threadIdx.x, lane = tid & 63, wv = tid >> 6;
  {
    const float* g_q = p.in[8] + l * 96; const float* g_k = p.in[9] + l * 96;
    float* row = (float*)lds + wv * 768;
    const int gw = blockIdx.x * 4 + wv, NGW = gridDim.x * 4;
    for (int t = gw; t < T; t += NGW) {
      const int b = t >> 11, s = t & (S - 1), pos = positions[t];
      for (int i = lane; i < 384; i += 64) row[i] = bf2f(QR[(size_t)t * 384 + i]);
      for (int i = lane; i < 384; i += 64) { const int h = i / 96, d = i % 96; row[384 + i] = (d < 32) ? bf2f(PROJ[(size_t)t * DINP + C_KPE + d]) : bf2f(KVR[(size_t)t * 512 + h * 128 + (d - 32)]); }
      __builtin_amdgcn_s_waitcnt(0);
      __builtin_amdgcn_wave_barrier();
      const int vec = lane >> 3, li = lane & 7;
      const float* v = row + vec * 96;
      const float* g = (vec < 4) ? g_q : g_k;
      float ss = 0.f;
#pragma unroll
      for (int i = 0; i < 12; ++i) ss += v[li + 8 * i] * v[li + 8 * i];
      ss += __shfl_xor(ss, 1); ss += __shfl_xor(ss, 2); ss += __shfl_xor(ss, 4);
      const float rs = rsqrtf(ss * (1.f / 96) + EPS);
      const float sc = (vec < 4) ? (0.10206207261596575f * LOG2E) : 1.f;
      bf16_t* dst = ((vec < 4) ? MQ : MK) + ((size_t)(b * 4 + (vec & 3)) * S + s) * 96;
#pragma unroll
      for (int i = 0; i < 12; ++i) {
        const int d = li + 8 * i; float o;
        if (d < 32) { float c, sn; rope_cs(pos, d & 15, 32, c, sn);
          const float x1 = v[d & 15] * rs * g[d & 15], x2 = v[(d & 15) + 16] * rs * g[(d & 15) + 16];
          o = (d < 16) ? (x1 * c - x2 * sn) : (x1 * sn + x2 * c);
        } else o = v[d] * rs * g[d];
        dst[d] = f2bf(o * sc);
      }
      __builtin_amdgcn_wave_barrier();
    }
  }
  {
    const float* cw = p.in[10] + l * 4 * 256; const float* cbp = p.in[11] + l * 256;
    const float* b_a = p.in[13] + l * 256; const float* b_i = p.in[15] + l * 256; const float* lam = p.in[16] + l * 256;
    float2* LSUM = (float2*)(p.ws + SM_LSUM);
    const int c = tid, h = c >> 6, j = c & 63;
    const float sp = log1pf(expf(-lam[c])), ba = b_a[c], bi = b_i[c], cb = cbp[c];
    for (int it = blockIdx.x; it < NB * 32; it += gridDim.x) {
      const int b = it >> 5, chunk = it & 31;
      float ap = 1.f, hh = 0.f;
      for (int k = 0; k < 64; ++k) {
        const int s = chunk * 64 + k, t = b * S + s;
        const float u = lru_conv(PROJ, t, s, c, cw, cb);
        float a, bb; lru_ab(u, bf2f(GATES[(size_t)t * 512 + h * 128 + j]) + ba, bf2f(GATES[(size_t)t * 512 + h * 128 + 64 + j]) + bi, sp, s == 0, a, bb);
        hh = a * hh + bb; ap *= a;
      }
      LSUM[(size_t)it * 256 + c] = make_float2(ap, hh);
    }
  }
  for (int it = blockIdx.x; it < NB * 32; it += gridDim.x) s5_chunk<false>(p, l, it >> 5, it & 31, lds);
  {
    const float* w2k = p.in[31] + (size_t)l * 128 * 64; const float* w2v = p.in[34] + (size_t)l * 128 * 64;
    const float* g0 = p.in[28] + l * 192;
    const bf16_t* HK = (const bf16_t*)(p.ws + SM_HK); const bf16_t* HV = (const bf16_t*)(p.ws + SM_HV);
    bf16_t* KC = (bf16_t*)(p.ws + SM_KC); bf16_t* VC = (bf16_t*)(p.ws + SM_VC);
    float* sh = (float*)lds;
    for (int it = blockIdx.x; it < NB * 128; it += gridDim.x) {
      const int b = it >> 7, c = it & 127;
      __syncthreads();
      float val = 0.f;
      const int kv = tid >> 6, n = tid & 63;
      if (tid < 128 && c < 127) {
        const bf16_t* hrow = (kv ? HV : HK) + (size_t)it * 128;
        const float* w2 = kv ? w2v : w2k;
        for (int q = 0; q < 128; ++q) val += bf2f(hrow[q]) * w2[q * 64 + n];
      }
      if (tid < 64) sh[n] = val;
      __syncthreads();
      if (tid < 64) {
        float o = 0.f;
        if (c < 127) {
          float ss = val * val; ss = wsum(ss);
          const float rs = rsqrtf(ss * (1.f / 64) + EPS);
          const int pos = positions[b * S + 16 * c + 31];
          if (n < 16) { float cs, sn; rope_cs(pos, n & 7, 16, cs, sn);
            const float x1 = sh[n & 7] * rs * g0[n & 7], x2 = sh[(n & 7) + 8] * rs * g0[(n & 7) + 8];
            o = (n < 8) ? (x1 * cs - x2 * sn) : (x1 * sn + x2 * cs);
          } else o = val * rs * g0[n];
        }
        KC[(size_t)it * 64 + n] = f2bf(o);
      } else if (tid < 128) {
        VC[(size_t)it * 64 + n] = f2bf(c < 127 ? val : 0.f);
      }
    }
  }
}

template <int DK>
DEVI void load_k_tile(bf16_t* sK, const bf16_t* kbase, size_t kstride, int key0) {
  constexpr int CH = DK / 8;
  for (int c = threadIdx.x; c < 64 * CH; c += NTHREADS) { const int r = c / CH, cc = c % CH; *(uint4*)(sK + r * (DK + 8) + cc * 8) = *(const uint4*)(kbase + (size_t)(key0 + r) * kstride + cc * 8); }
}
DEVI void load_v_tile_t(bf16_t* sVt, const bf16_t* vbase, size_t vstride, int key0) {
  for (int c = threadIdx.x; c < 512; c += NTHREADS) {
    const int r = c >> 3, cc = c & 7;
    const uint4 v = *(const uint4*)(vbase + (size_t)(key0 + r) * vstride + cc * 8);
    const unsigned w[4] = {v.x, v.y, v.z, v.w};
#pragma unroll
    for (int i = 0; i < 4; ++i) { sVt[(cc * 8 + 2 * i) * 72 + r] = (bf16_t)(w[i] & 0xffffu); sVt[(cc * 8 + 2 * i + 1) * 72 + r] = (bf16_t)(w[i] >> 16); }
  }
}
template <int DK>
DEVI void qk_tile(const bf16_t* sK, const bf16x8* qf, f32x16& s0, f32x16& s1, int r, int h) {
#pragma unroll
  for (int i = 0; i < 16; ++i) { s0[i] = 0.f; s1[i] = 0.f; }
#pragma unroll
  for (int kk = 0; kk < DK / 16; ++kk) {
    const bf16x8 a0 = *(const bf16x8*)(sK + r * (DK + 8) + kk * 16 + h * 8);
    const bf16x8 a1 = *(const bf16x8*)(sK + (32 + r) * (DK + 8) + kk * 16 + h * 8);
    s0 = mfma32(a0, qf[kk], s0);
    s1 = mfma32(a1, qf[kk], s1);
  }
}
struct FState { f32x16 o0, o1; float m, l; };
DEVI void fstate_init(FState& f) {
#pragma unroll
  for (int i = 0; i < 16; ++i) { f.o0[i] = 0.f; f.o1[i] = 0.f; }
  f.m = -INFINITY; f.l = 0.f;
}
DEVI void softmax_pv(FState& f, f32x16& s0, f32x16& s1, const bf16_t* sVt, int r, int h) {
  float mx = -INFINITY;
#pragma unroll
  for (int i = 0; i < 16; ++i) mx = fmaxf(mx, fmaxf(s0[i], s1[i]));
  mx = fmaxf(mx, __shfl_xor(mx, 32));
  const float mnew = fmaxf(f.m, mx);
  const float muse = (mnew == -INFINITY) ? 0.f : mnew;
  const float alpha = exp2f(f.m - muse);
  float ps = 0.f;
#pragma unroll
  for (int i = 0; i < 16; ++i) { s0[i] = exp2f(s0[i] - muse); s1[i] = exp2f(s1[i] - muse); ps += s0[i] + s1[i]; }
  ps += __shfl_xor(ps, 32);
  f.l = f.l * alpha + ps; f.m = mnew;
#pragma unroll
  for (int i = 0; i < 16; ++i) { f.o0[i] *= alpha; f.o1[i] *= alpha; }
#pragma unroll
  for (int kb = 0; kb < 2; ++kb)
#pragma unroll
    for (int s = 0; s < 2; ++s) {
      bf16x8 pb;
#pragma unroll
      for (int j = 0; j < 8; ++j) pb[j] = (short)f2bf(kb ? s1[8 * s + j] : s0[8 * s + j]);
      const int base = kb * 32 + 16 * s + 4 * h;
#pragma unroll
      for (int db = 0; db < 2; ++db) {
        const uint2 lo = *(const uint2*)(sVt + (db * 32 + r) * 72 + base);
        const uint2 hi = *(const uint2*)(sVt + (db * 32 + r) * 72 + base + 8);
        bf16x8 a;
        a[0] = (short)(lo.x & 0xffffu); a[1] = (short)(lo.x >> 16); a[2] = (short)(lo.y & 0xffffu); a[3] = (short)(lo.y >> 16);
        a[4] = (short)(hi.x & 0xffffu); a[5] = (short)(hi.x >> 16); a[6] = (short)(hi.y & 0xffffu); a[7] = (short)(hi.y >> 16);
        if (db == 0) f.o0 = mfma32(a, pb, f.o0); else f.o1 = mfma32(a, pb, f.o1);
      }
    }
}

DEVI void mla_item(const Params& p, int b, int hd, int qt, unsigned char* lds) {
  const bf16_t* MQ = (const bf16_t*)(p.ws + WS_F);
  const bf16_t* MK = MQ + (size_t)T * 4 * 96;
  const bf16_t* KVR = (const bf16_t*)(p.ws + WS_D) + (size_t)T * 384;
  bf16_t* YA = (bf16_t*)(p.ws + WS_C);
  const int tid = threadIdx.x, wv = tid >> 6, lane = tid & 63, r = lane & 31, h = lane >> 5;
  bf16_t* sK = (bf16_t*)lds;
  bf16_t* sVt = sK + 64 * 104;
  const int q0 = qt * 128 + wv * 32, tq = q0 + r;
  const bf16_t* qrow = MQ + ((size_t)(b * 4 + hd) * S + tq) * 96;
  bf16x8 qf[6];
#pragma unroll
  for (int kk = 0; kk < 6; ++kk) qf[kk] = *(const bf16x8*)(qrow + kk * 16 + h * 8);
  FState f; fstate_init(f);
  const bf16_t* kbase = MK + (size_t)(b * 4 + hd) * S * 96;
  const bf16_t* vbase = KVR + (size_t)b * S * 512 + hd * 128 + 64;
  const int ntiles = 2 * qt + 2;
  for (int kt = 0; kt < ntiles; ++kt) {
    __syncthreads();
    load_k_tile<96>(sK, kbase, 96, kt * 64);
    load_v_tile_t(sVt, vbase, 512, kt * 64);
    __syncthreads();
    if (kt * 64 <= q0 + 31) {
      f32x16 s0, s1;
      qk_tile<96>(sK, qf, s0, s1, r, h);
      if (kt * 64 + 63 > q0) {
#pragma unroll
        for (int i = 0; i < 16; ++i) { const int key = kt * 64 + crow(i, h); if (key > tq) s0[i] = -INFINITY; if (key + 32 > tq) s1[i] = -INFINITY; }
      }
      softmax_pv(f, s0, s1, sVt, r, h);
    }
  }
  const float inv = 1.f / f.l;
  bf16_t* orow = YA + (size_t)(b * S + tq) * 256 + hd * 64;
#pragma unroll
  for (int g = 0; g < 4; ++g) {
    ushort4 v0, v1;
    v0.x = f2bf(f.o0[4 * g] * inv); v0.y = f2bf(f.o0[4 * g + 1] * inv); v0.z = f2bf(f.o0[4 * g + 2] * inv); v0.w = f2bf(f.o0[4 * g + 3] * inv);
    v1.x = f2bf(f.o1[4 * g] * inv); v1.y = f2bf(f.o1[4 * g + 1] * inv); v1.z = f2bf(f.o1[4 * g + 2] * inv); v1.w = f2bf(f.o1[4 * g + 3] * inv);
    *(ushort4*)(orow + 8 * g + 4 * h) = v0;
    *(ushort4*)(orow + 32 + 8 * g + 4 * h) = v1;
  }
}

DEVI void nsa_item(const Params& p, int b, int qt, unsigned char* lds) {
  const bf16_t* PROJ = (const bf16_t*)(p.ws + WS_B);
  const bf16_t* QN = (const bf16_t*)(p.ws + WS_G);
  const bf16_t* KS = QN + (size_t)T * 256;
  const bf16_t* KW = KS + (size_t)T * 64;
  const bf16_t* KC = (const bf16_t*)(p.ws + SM_KC) + (size_t)b * 128 * 64;
  const bf16_t* VC = (const bf16_t*)(p.ws + SM_VC) + (size_t)b * 128 * 64;
  bf16_t* YD = (bf16_t*)(p.ws + WS_C) + (size_t)T * 256;
  const int tid = threadIdx.x, wv = tid >> 6, lane = tid & 63, r = lane & 31, h = lane >> 5;
  bf16_t* sK = (bf16_t*)lds;
  bf16_t* sVt = sK + 64 * 104;
  float* psum = (float*)(lds + 24576);
  unsigned* selm = (unsigned*)(lds + 24576 + 16384);
  const int t0 = qt * 32, cur = t0 >> 6;
  const int ql = wv * 8 + (r >> 2), hd = r & 3, tq = t0 + ql;
  const size_t tg = (size_t)b * S + tq;
  bf16x8 qf[4];
#pragma unroll
  for (int kk = 0; kk < 4; ++kk) qf[kk] = *(const bf16x8*)(QN + tg * 256 + hd * 64 + kk * 16 + h * 8);
  f32x16 of0, of1;
#pragma unroll
  for (int i = 0; i < 16; ++i) { of0[i] = 0.f; of1[i] = 0.f; }
  const float g0 = sigmoidf_(bf2f(PROJ[tg * DINP + C_NG + hd * 3 + 0]));
  const float g1 = sigmoidf_(bf2f(PROJ[tg * DINP + C_NG + hd * 3 + 1]));
  const float g2 = sigmoidf_(bf2f(PROJ[tg * DINP + C_NG + hd * 3 + 2]));
  FState f; fstate_init(f);
  for (int kt = 0; kt < 2; ++kt) {
    __syncthreads();
    load_k_tile<64>(sK, KC, 64, kt * 64);
    load_v_tile_t(sVt, VC, 64, kt * 64);
    __syncthreads();
    f32x16 s0, s1;
    qk_tile<64>(sK, qf, s0, s1, r, h);
#pragma unroll
    for (int i = 0; i < 16; ++i) { const int c = kt * 64 + crow(i, h); if (16 * c + 31 > tq) s0[i] = -INFINITY; if (16 * (c + 32) + 31 > tq) s1[i] = -INFINITY; }
    softmax_pv(f, s0, s1, sVt, r, h);
  }
  {
    const float sc = (f.l > 0.f) ? g0 / f.l : 0.f;
#pragma unroll
    for (int i = 0; i < 16; ++i) { of0[i] += f.o0[i] * sc; of1[i] += f.o1[i] * sc; }
  }
  {
    const float muse = (f.m == -INFINITY) ? 0.f : f.m;
    const float il = (f.l > 0.f) ? 1.f / f.l : 0.f;
    for (int kt = 0; kt < 2; ++kt) {
      __syncthreads();
      load_k_tile<64>(sK, KC, 64, kt * 64);
      __syncthreads();
      f32x16 s0, s1;
      qk_tile<64>(sK, qf, s0, s1, r, h);
#pragma unroll
      for (int i = 0; i < 16; ++i) {
        const int c = kt * 64 + crow(i, h);
        float p0 = (16 * c + 31 > tq) ? 0.f : exp2f(s0[i] - muse) * il;
        float p1 = (16 * (c + 32) + 31 > tq) ? 0.f : exp2f(s1[i] - muse) * il;
        p0 += __shfl_xor(p0, 1); p0 += __shfl_xor(p0, 2);
        p1 += __shfl_xor(p1, 1); p1 += __shfl_xor(p1, 2);
        if (hd == 0) { psum[ql * 128 + c] = p0; psum[ql * 128 + c + 32] = p1; }
      }
    }
  }
  __syncthreads();
#pragma unroll 1
  for (int itq = 0; itq < 4; ++itq) {
    const int q2 = wv * 8 + itq * 2 + (lane >> 5), j = lane & 31;
    const float* ps = psum + q2 * 128;
    float imp = 2.f * (ps[4 * j] + ps[4 * j + 1] + ps[4 * j + 2]) + ps[4 * j + 3];
    if (j > 0) imp += ps[4 * j - 1];
    const bool cand = (j >= 1) && (j <= cur - 2);
    int rank = 0;
    for (int jj = 0; jj < 32; ++jj) {
      const float v = __shfl(imp, (lane & 32) | jj);
      const bool cj = (jj >= 1) && (jj <= cur - 2);
      if (cj && (v > imp || (v == imp && jj < j))) ++rank;
    }
    const bool sel = cand && rank < 2;
    const unsigned long long bal = __ballot(sel);
    unsigned mk = (unsigned)(bal >> (32 * (lane >> 5)));
    mk |= 1u | (1u << cur); if (cur >= 1) mk |= (1u << (cur - 1));
    if (j == 0) selm[q2] = mk;
  }
  __syncthreads();
  unsigned blk_or = 0, wave_or = 0;
  for (int i = 0; i < 32; ++i) blk_or |= selm[i];
  for (int i = 0; i < 8; ++i) wave_or |= selm[wv * 8 + i];
  const unsigned mymask = selm[ql];
  fstate_init(f);
  {
    const bf16_t* kb = KS + (size_t)b * S * 64;
    const bf16_t* vb = PROJ + (size_t)b * S * DINP + C_NKV + 192;
    for (int j = 0; j <= cur; ++j) {
      if (!((blk_or >> j) & 1u)) continue;
      __syncthreads();
      load_k_tile<64>(sK, kb, 64, j * 64);
      load_v_tile_t(sVt, vb, DINP, j * 64);
      __syncthreads();
      if ((wave_or >> j) & 1u) {
        f32x16 s0, s1;
        qk_tile<64>(sK, qf, s0, s1, r, h);
        const bool on = (mymask >> j) & 1u;
#pragma unroll
        for (int i = 0; i < 16; ++i) { const int key = j * 64 + crow(i, h); if (!on || key > tq) s0[i] = -INFINITY; if (!on || key + 32 > tq) s1[i] = -INFINITY; }
        softmax_pv(f, s0, s1, sVt, r, h);
      }
    }
    const float sc = (f.l > 0.f) ? g1 / f.l : 0.f;
#pragma unroll
    for (int i = 0; i < 16; ++i) { of0[i] += f.o0[i] * sc; of1[i] += f.o1[i] * sc; }
  }
  fstate_init(f);
  {
    const bf16_t* kb = KW + (size_t)b * S * 64;
    const bf16_t* vb = PROJ + (size_t)b * S * DINP + C_NKV + 320;
    int jlo = (t0 - 511) >> 6; if (jlo < 0) jlo = 0;
    for (int j = jlo; j <= cur; ++j) {
      __syncthreads();
      load_k_tile<64>(sK, kb, 64, j * 64);
      load_v_tile_t(sVt, vb, DINP, j * 64);
      __syncthreads();
      f32x16 s0, s1;
      qk_tile<64>(sK, qf, s0, s1, r, h);
#pragma unroll
      for (int i = 0; i < 16; ++i) {
        const int key = j * 64 + crow(i, h);
        if (key > tq || tq - key >= 512) s0[i] = -INFINITY;
        if (key + 32 > tq || tq - key - 32 >= 512) s1[i] = -INFINITY;
      }
      softmax_pv(f, s0, s1, sVt, r, h);
    }
    const float sc = (f.l > 0.f) ? g2 / f.l : 0.f;
#pragma unroll
    for (int i = 0; i < 16; ++i) { of0[i] += f.o0[i] * sc; of1[i] += f.o1[i] * sc; }
  }
  bf16_t* orow = YD + tg * 256 + hd * 64;
#pragma unroll
  for (int g = 0; g < 4; ++g) {
    ushort4 v0, v1;
    v0.x = f2bf(of0[4 * g]); v0.y = f2bf(of0[4 * g + 1]); v0.z = f2bf(of0[4 * g + 2]); v0.w = f2bf(of0[4 * g + 3]);
    v1.x = f2bf(of1[4 * g]); v1.y = f2bf(of1[4 * g + 1]); v1.z = f2bf(of1[4 * g + 2]); v1.w = f2bf(of1[4 * g + 3]);
    *(ushort4*)(orow + 8 * g + 4 * h) = v0;
    *(ushort4*)(orow + 32 + 8 * g + 4 * h) = v1;
  }
}
DEVI void phase_a1(const Params& p, int l, unsigned char* lds) {
  for (int it = blockIdx.x; it < 2048; it += gridDim.x) {
    const int j = it >> 1;
    if (it & 1) { const int qt = 63 - (j >> 4), b = j & 15; nsa_item(p, b, qt, lds); }
    else { const int qt = 15 - (j >> 6), bh = j & 63; mla_item(p, bh >> 2, bh & 3, qt, lds); }
  }
}

DEVI void phase_r3(const Params& p, int l, unsigned char* lds) {
  const bf16_t* PROJ = (const bf16_t*)(p.ws + WS_B);
  const bf16_t* GATES = (const bf16_t*)(p.ws + WS_E);
  bf16_t* Y = (bf16_t*)(p.ws + WS_A);
  const int tid = threadIdx.x, lane = tid & 63, wv = tid >> 6;
  {
    const float* cw = p.in[10] + l * 4 * 256; const float* cbp = p.in[11] + l * 256;
    const float* b_a = p.in[13] + l * 256; const float* b_i = p.in[15] + l * 256; const float* lam = p.in[16] + l * 256;
    const float* onorm = p.in[35] + l * 1024 + 256;
    const float2* LSUM = (const float2*)(p.ws + SM_LSUM);
    float* tile = (float*)lds;
    const int c = tid, h = c >> 6, j = c & 63;
    const float sp = log1pf(expf(-lam[c])), ba = b_a[c], bi = b_i[c], cb = cbp[c];
    for (int it = blockIdx.x; it < NB * 32; it += gridDim.x) {
      const int b = it >> 5, chunk = it & 31;
      float hh = 0.f;
      for (int cc = 0; cc < chunk; ++cc) { const float2 sv = LSUM[(size_t)(b * 32 + cc) * 256 + c]; hh = sv.x * hh + sv.y; }
      __syncthreads();
      for (int k = 0; k < 64; ++k) {
        const int s = chunk * 64 + k, t = b * S + s;
        const float u = lru_conv(PROJ, t, s, c, cw, cb);
        float a, bb; lru_ab(u, bf2f(GATES[(size_t)t * 512 + h * 128 + j]) + ba, bf2f(GATES[(size_t)t * 512 + h * 128 + 64 + j]) + bi, sp, s == 0, a, bb);
        hh = a * hh + bb;
        tile[k * 256 + c] = hh * gelu_tanh(bf2f(PROJ[(size_t)t * DINP + C_LG + c]));
      }
      __syncthreads();
      for (int k = wv; k < 64; k += 4) {
        float v[4], ss = 0.f;
#pragma unroll
        for (int i = 0; i < 4; ++i) { v[i] = tile[k * 256 + lane + 64 * i]; ss += v[i] * v[i]; }
        const float rs = rsqrtf(wsum(ss) * (1.f / 256) + EPS);
        const size_t t = (size_t)b * S + chunk * 64 + k;
#pragma unroll
        for (int i = 0; i < 4; ++i) Y[t * 1024 + 256 + lane + 64 * i] = f2bf(v[i] * rs * onorm[lane + 64 * i]);
      }
    }
  }
  for (int it = blockIdx.x; it < NB * 32; it += gridDim.x) s5_chunk<true>(p, l, it >> 5, it & 31, lds);
}

DEVI void phase_g3(const Params& p, int l, unsigned char* lds) {
  const bf16_t* YCP = (const bf16_t*)(p.ws + WS_F);
  bf16_t* YC = (bf16_t*)(p.ws + WS_F) + (size_t)T * 256;
  const bf16_t* W = (const bf16_t*)(p.ws + WS_W + l * WS_WL + W_GLU);
  const float* bg = p.in[26] + l * 256;
  for (int it = blockIdx.x; it < 256 * 2; it += gridDim.x) {
    const int mt = it >> 1, nt = it & 1;
    f32x4 acc[4][4];
    gemm128(lds, 256, [&](int r, int k) { return YCP + (size_t)(mt * 128 + r) * 256 + k; }, [&](int r, int k) { return W + (size_t)(nt * 128 + r) * 256 + k; }, acc);
    GEMM_EPI_LOOP({ const size_t o = (size_t)(mt * 128 + er) * 256 + nt * 128 + ec; YC[o] = f2bf(bf2f(YCP[o]) * sigmoidf_(ev + bg[nt * 128 + ec])); })
  }
}

DEVI void phase_r4(const Params& p, int l) {
  const bf16_t* YA = (const bf16_t*)(p.ws + WS_C);
  const bf16_t* YD = YA + (size_t)T * 256;
  const bf16_t* YC = (const bf16_t*)(p.ws + WS_F) + (size_t)T * 256;
  bf16_t* Y = (bf16_t*)(p.ws + WS_A);
  const float* onorm = p.in[35] + l * 1024;
  const int lane = threadIdx.x & 63, gw = blockIdx.x * 4 + (threadIdx.x >> 6), NGW = gridDim.x * 4;
  for (int t = gw; t < T; t += NGW) {
#pragma unroll
    for (int grp = 0; grp < 3; ++grp) {
      const bf16_t* src = (grp == 0 ? YA : (grp == 1 ? YC : YD)) + (size_t)t * 256;
      const int gcol = (grp == 0 ? 0 : (grp == 1 ? 512 : 768));
      const ushort4 u = ((const ushort4*)src)[lane];
      const float v0 = bf2f(u.x), v1 = bf2f(u.y), v2 = bf2f(u.z), v3 = bf2f(u.w);
      const float rs = rsqrtf(wsum(v0 * v0 + v1 * v1 + v2 * v2 + v3 * v3) * (1.f / 256) + EPS);
      const float4 g = ((const float4*)(onorm + gcol))[lane];
      ushort4 o; o.x = f2bf(v0 * rs * g.x); o.y = f2bf(v1 * rs * g.y); o.z = f2bf(v2 * rs * g.z); o.w = f2bf(v3 * rs * g.w);
      ((ushort4*)(Y + (size_t)t * 1024 + gcol))[lane] = o;
    }
  }
}

DEVI void phase_g4(const Params& p, int l, unsigned char* lds) {
  const bf16_t* Y = (const bf16_t*)(p.ws + WS_A);
  const bf16_t* W = (const bf16_t*)(p.ws + WS_W + l * WS_WL + W_OUT);
  const float* xin = (l == 0) ? p.in[0] : p.out;
  float* out = p.out;
  for (int it = blockIdx.x; it < 256 * 8; it += gridDim.x) {
    const int mt = it >> 3, nt = it & 7;
    f32x4 acc[4][4];
    gemm128(lds, D, [&](int r, int k) { return Y + (size_t)(mt * 128 + r) * D + k; }, [&](int r, int k) { return W + (size_t)(nt * 128 + r) * D + k; }, acc);
    GEMM_EPI_LOOP({ const size_t o = (size_t)(mt * 128 + er) * D + nt * 128 + ec; out[o] = xin[o] + ev; })
  }
}

DEVI void phase_r5(const Params& p, int l) {
  const float* x1 = p.out;
  bf16_t* XN = (bf16_t*)(p.ws + WS_A);
  const float* g = p.in[37] + l * D;
  const float* wrg = p.in[38] + (size_t)l * D * 4; const float* brg = p.in[39] + l * 4;
  const float* wre = p.in[40] + (size_t)l * D * 16; const float* bre = p.in[41] + l * 16;
  int* CNT = (int*)(p.ws + SM_CNT) + l * 32;
  int* LIST = (int*)(p.ws + SM_LIST);
  float2* TOKW = (float2*)(p.ws + SM_TOKW);
  const int lane = threadIdx.x & 63, gw = blockIdx.x * 4 + (threadIdx.x >> 6), NGW = gridDim.x * 4;
  for (int t = gw; t < T; t += NGW) {
    const float4* xr = (const float4*)(x1 + (size_t)t * D);
    float s = 0.f;
#pragma unroll
    for (int j = 0; j < 4; ++j) { const float4 v = xr[lane + 64 * j]; s += v.x * v.x + v.y * v.y + v.z * v.z + v.w * v.w; }
    const float rs = rsqrtf(wsum(s) * (1.f / D) + EPS);
    float lg[20];
#pragma unroll
    for (int o = 0; o < 20; ++o) lg[o] = 0.f;
#pragma unroll 1
    for (int j = 0; j < 4; ++j) {
      const float4 v = xr[lane + 64 * j];
      const float4 gg = ((const float4*)g)[lane + 64 * j];
      const float tv[4] = {v.x * rs * gg.x, v.y * rs * gg.y, v.z * rs * gg.z, v.w * rs * gg.w};
      ushort4 o; o.x = f2bf(tv[0]); o.y = f2bf(tv[1]); o.z = f2bf(tv[2]); o.w = f2bf(tv[3]);
      ((ushort4*)(XN + (size_t)t * D))[lane + 64 * j] = o;
#pragma unroll
      for (int e = 0; e < 4; ++e) {
        const int k = (lane + 64 * j) * 4 + e;
        const float4 a = *(const float4*)(wrg + (size_t)k * 4);
        lg[0] += tv[e] * a.x; lg[1] += tv[e] * a.y; lg[2] += tv[e] * a.z; lg[3] += tv[e] * a.w;
#pragma unroll
        for (int q = 0; q < 4; ++q) { const float4 w4 = *(const float4*)(wre + (size_t)k * 16 + q * 4); lg[4 + q * 4] += tv[e] * w4.x; lg[5 + q * 4] += tv[e] * w4.y; lg[6 + q * 4] += tv[e] * w4.z; lg[7 + q * 4] += tv[e] * w4.w; }
      }
    }
#pragma unroll
    for (int o = 0; o < 20; ++o) lg[o] = wsum(lg[o]);
    if (lane == 0) {
      float gl[4];
#pragma unroll
      for (int q = 0; q < 4; ++q) gl[q] = lg[q] + brg[q];
      int gi = 0; float gbest = gl[0];
#pragma unroll
      for (int q = 1; q < 4; ++q) if (gl[q] > gbest) { gbest = gl[q]; gi = q; }
      float den = 0.f;
#pragma unroll
      for (int q = 0; q < 4; ++q) den += expf(gl[q] - gbest);
      const float pg = 1.f / den;
      float le[4];
#pragma unroll
      for (int q = 0; q < 4; ++q) { float sel = 0.f;
#pragma unroll
        for (int gg2 = 0; gg2 < 4; ++gg2) sel = (gi == gg2) ? (lg[4 + gg2 * 4 + q] + bre[gg2 * 4 + q]) : sel;
        le[q] = sel; }
      int i0 = 0; float l0 = le[0];
#pragma unroll
      for (int q = 1; q < 4; ++q) if (le[q] > l0) { l0 = le[q]; i0 = q; }
      int i1 = -1; float l1 = -INFINITY;
#pragma unroll
      for (int q = 0; q < 4; ++q) if (q != i0 && le[q] > l1) { l1 = le[q]; i1 = q; }
      const float e1 = expf(l1 - l0);
      const float w0 = pg / (1.f + e1), w1 = pg * e1 / (1.f + e1);
      const int elo = (i0 < i1) ? i0 : i1, ehi = (i0 < i1) ? i1 : i0;
      const float wlo = (i0 < i1) ? w0 : w1, whi = (i0 < i1) ? w1 : w0;
      const int pidx = (elo == 0) ? (ehi - 1) : ((elo == 1) ? (ehi + 1) : 5);
      const int cls = gi * 6 + pidx;
      const int slot = atomicAdd(&CNT[cls], 1);
      LIST[(size_t)cls * T + slot] = t;
      TOKW[t] = make_float2(wlo, whi);
    }
  }
}

struct MoeItem { int cls, mtile, nt, cnt; };
DEVI bool moe_item(const int* CNT, int it, MoeItem& m) {
  int mt = it >> 3; m.nt = it & 7;
  for (int c = 0; c < 24; ++c) { const int n = CNT[c], tc = (n + 127) >> 7; if (mt < tc) { m.cls = c; m.mtile = mt; m.cnt = n; return true; } mt -= tc; }
  return false;
}
DEVI void cls_experts(int cls, int& e0, int& e1) {
  const int g = cls / 6, pi = cls % 6;
  const int lo = (pi < 3) ? 0 : ((pi < 5) ? 1 : 2);
  const int hi = (pi < 3) ? (pi + 1) : ((pi < 5) ? (pi - 1) : 3);
  e0 = g * 4 + lo; e1 = g * 4 + hi;
}
DEVI void phase_g5(const Params& p, int l, unsigned char* lds) {
  const bf16_t* XN = (const bf16_t*)(p.ws + WS_A);
  bf16_t* HID = (bf16_t*)(p.ws + WS_B);
  const bf16_t* WGU = (const bf16_t*)(p.ws + WS_W + l * WS_WL + W_GU);
  const int* CNT = (const int*)(p.ws + SM_CNT) + l * 32;
  const int* LIST = (const int*)(p.ws + SM_LIST);
  const float2* TOKW = (const float2*)(p.ws + SM_TOKW);
  for (int it = blockIdx.x;; it += gridDim.x) {
    MoeItem mi; if (!moe_item(CNT, it, mi)) break;
    int e0, e1; cls_experts(mi.cls, e0, e1);
    const int ex = (mi.nt < 4) ? e0 : e1, ntl = mi.nt & 3;
    const bf16_t* W = WGU + ((size_t)ex * 512 + ntl * 128) * 1024;
    const int* list = LIST + (size_t)mi.cls * T + mi.mtile * 128;
    const int nvalid = mi.cnt - mi.mtile * 128;
    f32x4 acc[4][4];
    gemm128(lds, D, [&](int r, int k) { const int tok = (r < nvalid) ? list[r] : list[0]; return XN + (size_t)tok * D + k; }, [&](int r, int k) { return W + (size_t)r * D + k; }, acc);
    {
      const int tid = threadIdx.x, wid = tid >> 6, lane = tid & 63, wr = wid >> 1, wc = wid & 1, fr = lane & 15, fq = lane >> 4;
#pragma unroll
      for (int m = 0; m < 4; ++m)
#pragma unroll
        for (int j = 0; j < 4; ++j) {
          const int er = wr * 64 + m * 16 + fq * 4 + j;
          if (er < nvalid) {
            const int tok = list[er];
            const float2 tw = TOKW[tok];
            const float w = (mi.nt < 4) ? tw.x : tw.y;
#pragma unroll
            for (int n = 0; n < 2; ++n) {
              const float gt = acc[m][n][j], up = acc[m][n + 2][j];
              const int hh = (mi.nt < 4 ? 0 : 256) + ntl * 64 + wc * 32 + n * 16 + fr;
              HID[(size_t)tok * 512 + hh] = f2bf(gt * sigmoidf_(gt) * up * w);
            }
          }
        }
    }
  }
}
DEVI void phase_g6(const Params& p, int l, unsigned char* lds) {
  const bf16_t* HID = (const bf16_t*)(p.ws + WS_B);
  const bf16_t* WDN = (const bf16_t*)(p.ws + WS_W + l * WS_WL + W_DN);
  const int* CNT = (const int*)(p.ws + SM_CNT) + l * 32;
  const int* LIST = (const int*)(p.ws + SM_LIST);
  float* out = p.out;
  for (int it = blockIdx.x;; it += gridDim.x) {
    MoeItem mi; if (!moe_item(CNT, it, mi)) break;
    int e0, e1; cls_experts(mi.cls, e0, e1);
    const int* list = LIST + (size_t)mi.cls * T + mi.mtile * 128;
    const int nvalid = mi.cnt - mi.mtile * 128;
    const bf16_t* W0 = WDN + ((size_t)e0 * 1024 + mi.nt * 128) * 256;
    const bf16_t* W1 = WDN + ((size_t)e1 * 1024 + mi.nt * 128) * 256;
    f32x4 acc[4][4];
    gemm128(lds, 512, [&](int r, int k) { const int tok = (r < nvalid) ? list[r] : list[0]; return HID + (size_t)tok * 512 + k; },
            [&](int r, int k) { return ((k < 256) ? W0 : W1) + (size_t)r * 256 + (k & 255); }, acc);
    GEMM_EPI_LOOP({ if (er < nvalid) { const size_t o = (size_t)list[er] * D + mi.nt * 128 + ec; out[o] += ev; } })
  }
}

#define PH(k, call) { const int _k = (k); if (p.lo <= _k && _k < p.hi) { call; if (_k + 1 < p.hi) grid.sync(); } }
__global__ void __launch_bounds__(NTHREADS, 2) hybrid_fwd(Params p) {
  extern __shared__ __attribute__((aligned(16))) unsigned char lds[];
  cg::grid_group grid = cg::this_grid();
  PH(0, phase_prep(p))
#define LAYER(l) { \
    PH(1 + 13 * l + 0, phase_g1(p, l, lds)) \
    PH(1 + 13 * l + 1, phase_r1(p, l, lds)) \
    PH(1 + 13 * l + 2, phase_g2(p, l, lds)) \
    PH(1 + 13 * l + 3, phase_r2(p, l, lds)) \
    PH(1 + 13 * l + 4, phase_a1(p, l, lds)) \
    PH(1 + 13 * l + 5, phase_r3(p, l, lds)) \
    PH(1 + 13 * l + 6, phase_g3(p, l, lds)) \
    PH(1 + 13 * l + 7, phase_r4(p, l)) \
    PH(1 + 13 * l + 8, phase_g4(p, l, lds)) \
    PH(1 + 13 * l + 9, phase_r5(p, l)) \
    PH(1 + 13 * l + 10, phase_g5(p, l, lds)) \
    PH(1 + 13 * l + 11, phase_g6(p, l, lds)) }
  LAYER(0)
  PH(13, rmsnorm_rows(p.out, p.in[2] + D, (bf16_t*)(p.ws + WS_A)))
  LAYER(1)
}

extern "C" void kernel_launch(void* const* d_in, const int* in_sizes, int n_in, void* d_out, int out_size, void* d_ws, size_t ws_size, hipStream_t stream) {
  static int grid_blocks = 0;
  if (!grid_blocks) {
    if (n_in != 45 || ws_size < WS_END) { fprintf(stderr, "kernel_launch: unexpected n_in %d or ws_size %zu (< %zu)\n", n_in, ws_size, (size_t)WS_END); grid_blocks = -1; return; }
    int dev = 0, cus = 0, per_cu = 0;
    hipGetDevice(&dev);
    hipDeviceGetAttribute(&cus, hipDeviceAttributeMultiprocessorCount, dev);
    hipFuncSetAttribute((const void*)hybrid_fwd, hipFuncAttributeMaxDynamicSharedMemorySize, LDS_BYTES);
    hipOccupancyMaxActiveBlocksPerMultiprocessor(&per_cu, (const void*)hybrid_fwd, NTHREADS, LDS_BYTES);
    if (per_cu < 1) per_cu = 1;
    if (per_cu > 2) per_cu = 2;
    grid_blocks = cus * per_cu;
    fprintf(stderr, "kernel_launch: cus %d per_cu %d grid %d\n", cus, per_cu, grid_blocks);
  }
  if (grid_blocks < 0) return;
  Params p{};
  for (int i = 0; i < 45; ++i) p.in[i] = (const float*)d_in[i];
  p.out = (float*)d_out; p.ws = (unsigned char*)d_ws;
#if N_LAUNCH_MODE == 1
  p.lo = 0; p.hi = NPH;
  { void* args[] = {&p}; hipError_t e = hipLaunchCooperativeKernel((void*)hybrid_fwd, dim3(grid_blocks), dim3(NTHREADS), args, LDS_BYTES, stream);
    if (e != hipSuccess) fprintf(stderr, "cooperative launch failed: %s\n", hipGetErrorString(e)); }
#else
  for (int ph = 0; ph < NPH; ++ph) {
    p.lo = ph; p.hi = ph + 1;
    void* args[] = {&p}; hipError_t e = hipLaunchCooperativeKernel((void*)hybrid_fwd, dim3(grid_blocks), dim3(NTHREADS), args, LDS_BYTES, stream);
    if (e != hipSuccess) { fprintf(stderr, "launch %d failed: %s\n", ph, hipGetErrorString(e)); break; }
  }
#endif
}
```

```cpp
#include <hip/hip_runtime.h>
#include <hip/hip_cooperative_groups.h>
#include <cstdio>
#include <cstdint>
namespace cg = cooperative_groups;

#ifndef N_LAUNCH_MODE
#define N_LAUNCH_MODE 1
#endif

#define DEVI __device__ __forceinline__
typedef unsigned short bf16_t;
typedef short bf16x8 __attribute__((ext_vector_type(8)));
typedef float f32x4 __attribute__((ext_vector_type(4)));
typedef float f32x16 __attribute__((ext_vector_type(16)));
#define LAS __attribute__((address_space(3)))

constexpr int NB = 16, S = 2048, T = NB * S, D = 1024, DIN = 1772, DINP = 1792, NL = 2;
constexpr int C_CQ = 0, C_CKV = 192, C_KPE = 320, C_LX = 352, C_LG = 608, C_S5 = 864, C_NQ = 1120, C_NKV = 1376, C_NG = 1760;
constexpr float EPS = 1e-6f;
constexpr float LOG2E = 1.4426950408889634f;
constexpr int NTHREADS = 256;
constexpr int NPH = 1 + 13 * NL - 1;

constexpr size_t MiB = 1u << 20;
constexpr size_t WS_CTL = 0;
constexpr size_t WS_SMALL = 1 * MiB;
constexpr size_t WS_W = 16 * MiB;
constexpr size_t WS_WL = 32 * MiB;
constexpr size_t WS_A = 80 * MiB;
constexpr size_t WS_B = 144 * MiB;
constexpr size_t WS_C = 256 * MiB;
constexpr size_t WS_D = 292 * MiB;
constexpr size_t WS_E = 348 * MiB;
constexpr size_t WS_F = 380 * MiB;
constexpr size_t WS_G = 428 * MiB;
constexpr size_t WS_END = 452 * MiB;
constexpr size_t W_IN = 0;
constexpr size_t W_OUT = 4 * MiB;
constexpr size_t W_UQ = 6 * MiB;
constexpr size_t W_UKV = W_UQ + 384 * 192 * 2;
constexpr size_t W_LRU = W_UKV + 512 * 128 * 2;
constexpr size_t W_GLU = W_LRU + 4 * 128 * 64 * 2;
constexpr size_t W_1K = 6 * MiB + 512 * 1024;
constexpr size_t W_1V = W_1K + 128 * 2048 * 2;
constexpr size_t W_B1K = W_1V + 128 * 2048 * 2;
constexpr size_t W_B1V = W_B1K + 512;
constexpr size_t W_S5A = W_B1V + 512;
constexpr size_t W_S5A64 = W_S5A + 16 * 64 * 8;
constexpr size_t W_S5B = W_S5A64 + 16 * 64 * 8;
constexpr size_t W_GU = 8 * MiB;
constexpr size_t W_DN = 24 * MiB;
constexpr size_t SM_CNT = WS_SMALL;
constexpr size_t SM_LIST = WS_SMALL + 4096;
constexpr size_t SM_TOKW = SM_LIST + 24 * (size_t)T * 4;
constexpr size_t SM_LSUM = SM_TOKW + (size_t)T * 8;
constexpr size_t SM_SLOC = SM_LSUM + 16 * 32 * 256 * 8;
constexpr size_t SM_HK = SM_SLOC + 16 * 32 * 1024 * 8;
constexpr size_t SM_HV = SM_HK + 2048 * 128 * 2;
constexpr size_t SM_KC = SM_HV + 2048 * 128 * 2;
constexpr size_t SM_VC = SM_KC + 16 * 128 * 64 * 2;
constexpr size_t SM_END = SM_VC + 16 * 128 * 64 * 2;
static_assert(SM_END <= WS_W, "small region overflow");

constexpr int LDS_BYTES = 65536;
constexpr int LDS_ALLOC = LDS_BYTES + 64;

struct Params {
  const float* in[45];
  float* out;
  unsigned char* ws;
  int lo, hi;
};

DEVI float bf2f(bf16_t v) { return __uint_as_float(((unsigned)v) << 16); }
DEVI bf16_t f2bf(float f) { unsigned u = __float_as_uint(f); return (bf16_t)((u + 0x7fffu + ((u >> 16) & 1u)) >> 16); }
DEVI float wsum(float v) {
#pragma unroll
  for (int o = 32; o >= 1; o >>= 1) v += __shfl_xor(v, o);
  return v;
}
DEVI float sigmoidf_(float x) { return 1.f / (1.f + __expf(-x)); }
DEVI float gelu_tanh(float x) { return 0.5f * x * (1.f + tanhf(0.7978845608028654f * (x + 0.044715f * x * x * x))); }
DEVI f32x16 mfma32(bf16x8 a, bf16x8 b, f32x16 c) { return __builtin_amdgcn_mfma_f32_32x32x16_bf16(a, b, c, 0, 0, 0); }
DEVI f32x4 mfma16(bf16x8 a, bf16x8 b, f32x4 c) { return __builtin_amdgcn_mfma_f32_16x16x32_bf16(a, b, c, 0, 0, 0); }
DEVI int crow(int r, int h) { return (r & 3) + 8 * (r >> 2) + 4 * h; }

template <class AF, class BF>
DEVI void gemm128(unsigned char* lds, int K, AF aptr, BF bptr, f32x4 (&acc)[4][4]) {
  const int tid = threadIdx.x, wid = tid >> 6, lane = tid & 63, wr = wid >> 1, wc = wid & 1, fr = lane & 15, fq = lane >> 4;
  bf16_t* SA = (bf16_t*)lds;
  bf16_t* SB = SA + 128 * 32;
#pragma unroll
  for (int m = 0; m < 4; ++m)
#pragma unroll
    for (int n = 0; n < 4; ++n) acc[m][n] = (f32x4){0.f, 0.f, 0.f, 0.f};
  const int r0 = tid >> 2, c0 = (tid & 3) * 8;
  for (int kt = 0; kt < K / 32; ++kt) {
    const int k = kt * 32 + c0;
    const uint4 a0 = *(const uint4*)aptr(r0, k);
    const uint4 a1 = *(const uint4*)aptr(r0 + 64, k);
    const uint4 b0 = *(const uint4*)bptr(r0, k);
    const uint4 b1 = *(const uint4*)bptr(r0 + 64, k);
    __syncthreads();
    *(uint4*)(SA + r0 * 32 + c0) = a0;
    *(uint4*)(SA + (r0 + 64) * 32 + c0) = a1;
    *(uint4*)(SB + r0 * 32 + c0) = b0;
    *(uint4*)(SB + (r0 + 64) * 32 + c0) = b1;
    __syncthreads();
    bf16x8 At[4], Bt[4];
#pragma unroll
    for (int m = 0; m < 4; ++m) At[m] = *(const bf16x8*)(SA + (wr * 64 + m * 16 + fr) * 32 + fq * 8);
#pragma unroll
    for (int n = 0; n < 4; ++n) Bt[n] = *(const bf16x8*)(SB + (wc * 64 + n * 16 + fr) * 32 + fq * 8);
#pragma unroll
    for (int m = 0; m < 4; ++m)
#pragma unroll
      for (int n = 0; n < 4; ++n) acc[m][n] = mfma16(At[m], Bt[n], acc[m][n]);
  }
  __syncthreads();
}
#define GEMM_EPI_LOOP(body)                                                                 \
  {                                                                                         \
    const int _tid = threadIdx.x, _wid = _tid >> 6, _lane = _tid & 63, _wr = _wid >> 1, _wc = _wid & 1, _fr = _lane & 15, _fq = _lane >> 4; \
    _Pragma("unroll") for (int m = 0; m < 4; ++m) _Pragma("unroll") for (int n = 0; n < 4; ++n) _Pragma("unroll") for (int j = 0; j < 4; ++j) { \
      const int er = _wr * 64 + m * 16 + _fq * 4 + j, ec = _wc * 64 + n * 16 + _fr; const float ev = acc[m][n][j]; body }                      \
  }

DEVI void transpose_cvt(const float* src, int K, int N, bf16_t* dst, int Npad, size_t gtid, size_t gn) {
  const size_t tot = (size_t)Npad * K;
  for (size_t i = gtid; i < tot; i += gn) { const int n = (int)(i / K), k = (int)(i % K); dst[i] = (n < N) ? f2bf(src[(size_t)k * N + n]) : (bf16_t)0; }
}
DEVI void rmsnorm_rows(const float* x, const float* g, bf16_t* xn) {
  const int lane = threadIdx.x & 63, gw = blockIdx.x * 4 + (threadIdx.x >> 6), NGW = gridDim.x * 4;
  for (int t = gw; t < T; t += NGW) {
    const float4* xr = (const float4*)(x + (size_t)t * D);
    float4 v[4]; float s = 0.f;
#pragma unroll
    for (int j = 0; j < 4; ++j) { v[j] = xr[lane + 64 * j]; s += v[j].x * v[j].x + v[j].y * v[j].y + v[j].z * v[j].z + v[j].w * v[j].w; }
    const float rs = rsqrtf(wsum(s) * (1.f / D) + EPS);
#pragma unroll
    for (int j = 0; j < 4; ++j) {
      const float4 gg = ((const float4*)g)[lane + 64 * j];
      ushort4 o; o.x = f2bf(v[j].x * rs * gg.x); o.y = f2bf(v[j].y * rs * gg.y); o.z = f2bf(v[j].z * rs * gg.z); o.w = f2bf(v[j].w * rs * gg.w);
      ((ushort4*)(xn + (size_t)t * D))[lane + 64 * j] = o;
    }
  }
}
DEVI void phase_prep(const Params& p) {
  const size_t gtid = (size_t)blockIdx.x * NTHREADS + threadIdx.x, gn = (size_t)gridDim.x * NTHREADS;
  unsigned char* ws = p.ws;
  if (gtid < 64) ((int*)(ws + SM_CNT))[gtid] = 0;
  for (int l = 0; l < NL; ++l) {
    unsigned char* wl = ws + WS_W + l * WS_WL;
    transpose_cvt(p.in[3] + (size_t)l * D * DIN, D, DIN, (bf16_t*)(wl + W_IN), DINP, gtid, gn);
    transpose_cvt(p.in[36] + (size_t)l * D * D, D, D, (bf16_t*)(wl + W_OUT), D, gtid, gn);
    transpose_cvt(p.in[6] + (size_t)l * 192 * 384, 192, 384, (bf16_t*)(wl + W_UQ), 384, gtid, gn);
    transpose_cvt(p.in[7] + (size_t)l * 128 * 512, 128, 512, (bf16_t*)(wl + W_UKV), 512, gtid, gn);
    transpose_cvt(p.in[25] + (size_t)l * 256 * 256, 256, 256, (bf16_t*)(wl + W_GLU), 256, gtid, gn);
    transpose_cvt(p.in[30] + (size_t)l * 2048 * 128, 2048, 128, (bf16_t*)(wl + W_1K), 128, gtid, gn);
    transpose_cvt(p.in[33] + (size_t)l * 2048 * 128, 2048, 128, (bf16_t*)(wl + W_1V), 128, gtid, gn);
    for (size_t i = gtid; i < 4 * 128 * 64; i += gn) {
      const int h = (int)(i / (128 * 64)), rr = (int)((i / 64) % 128), k = (int)(i % 64);
      const float* src = (rr < 64) ? p.in[12] : p.in[14];
      ((bf16_t*)(wl + W_LRU))[i] = f2bf(src[(((size_t)l * 4 + h) * 64 + k) * 64 + (rr & 63)]);
    }
    for (size_t i = gtid; i < 256; i += gn) {
      const int kv = (int)(i >> 7), j = (int)(i & 127);
      const float* pe = (kv ? p.in[32] : p.in[29]) + (size_t)l * 2048;
      const float* w1 = (kv ? p.in[33] : p.in[30]) + (size_t)l * 2048 * 128;
      float a = 0.f;
      for (int k = 0; k < 2048; ++k) a += pe[k] * w1[(size_t)k * 128 + j];
      ((float*)(wl + (kv ? W_B1V : W_B1K)))[j] = a;
    }
    for (size_t i = gtid; i < 16 * 64; i += gn) {
      const int g = (int)(i >> 6);
      const float are = p.in[17][(size_t)l * 1024 + i], aim = p.in[18][(size_t)l * 1024 + i];
      const float dt = expf(p.in[19][l * 16 + g]);
      const float mag = expf(dt * are);
      float sn, cs; sincosf(dt * aim, &sn, &cs);
      const float abr = mag * cs, abi = mag * sn;
      const float den = are * are + aim * aim, nre = abr - 1.f;
      const float gre = (nre * are + abi * aim) / den, gim = (abi * are - nre * aim) / den;
      ((float2*)(wl + W_S5A))[i] = make_float2(abr, abi);
      float pr = abr, pi = abi;
#pragma unroll
      for (int q = 0; q < 6; ++q) { const float nr = pr * pr - pi * pi, ni = 2.f * pr * pi; pr = nr; pi = ni; }
      ((float2*)(wl + W_S5A64))[i] = make_float2(pr, pi);
      for (int ch = 0; ch < 16; ++ch) {
        const float br = p.in[20][((size_t)l * 1024 + i) * 16 + ch], bi = p.in[21][((size_t)l * 1024 + i) * 16 + ch];
        ((float2*)(wl + W_S5B))[i * 16 + ch] = make_float2(gre * br - gim * bi, gre * bi + gim * br);
      }
    }
    {
      const size_t tot = (size_t)16 * 512 * 1024;
      for (size_t i = gtid; i < tot; i += gn) {
        const int e = (int)(i / (512 * 1024)), row = (int)((i / 1024) % 512), k = (int)(i % 1024);
        const int nt = row >> 7, rr = row & 127, wc = rr >> 6, nf = (rr & 63) >> 4, fr = rr & 15;
        const int hh = nt * 64 + wc * 32 + (nf & 1) * 16 + fr;
        const float* src = (nf < 2) ? p.in[42] : p.in[43];
        ((bf16_t*)(wl + W_GU))[i] = f2bf(src[(((size_t)l * 16 + e) * 1024 + k) * 256 + hh]);
      }
    }
    {
      const size_t tot = (size_t)16 * 1024 * 256;
      for (size_t i = gtid; i < tot; i += gn) {
        const int e = (int)(i / (1024 * 256)), n = (int)((i / 256) % 1024), k = (int)(i % 256);
        ((bf16_t*)(wl + W_DN))[i] = f2bf(p.in[44][(((size_t)l * 16 + e) * 256 + k) * 1024 + n]);
      }
    }
  }
  rmsnorm_rows(p.in[0], p.in[2], (bf16_t*)(ws + WS_A));
}

DEVI void phase_g1(const Params& p, int l, unsigned char* lds) {
  const bf16_t* XN = (const bf16_t*)(p.ws + WS_A);
  const bf16_t* W = (const bf16_t*)(p.ws + WS_W + l * WS_WL + W_IN);
  bf16_t* PROJ = (bf16_t*)(p.ws + WS_B);
  constexpr int NT = DINP / 128;
  for (int it = blockIdx.x; it < (T / 128) * NT; it += gridDim.x) {
    const int mt = it / NT, nt = it % NT;
    f32x4 acc[4][4];
    gemm128(lds, D, [&](int r, int k) { return XN + (size_t)(mt * 128 + r) * D + k; }, [&](int r, int k) { return W + (size_t)(nt * 128 + r) * D + k; }, acc);
    GEMM_EPI_LOOP({ PROJ[(size_t)(mt * 128 + er) * DINP + nt * 128 + ec] = f2bf(ev); })
  }
}

DEVI void rope_cs(int pos, int i, int rot_dim, float& c, float& s) {
  const float inv = powf(500000.f, -(2.f * (float)i) / (float)rot_dim);
  sincosf((float)pos * inv, &s, &c);
}

DEVI void phase_r1(const Params& p, int l, unsigned char* lds) {
  const int lane = threadIdx.x & 63, wv = threadIdx.x >> 6, gw = blockIdx.x * 4 + wv, NGW = gridDim.x * 4;
  float* row = (float*)lds + wv * DINP;
  const bf16_t* PROJ = (const bf16_t*)(p.ws + WS_B);
  bf16_t* CQN = (bf16_t*)(p.ws + WS_C);
  bf16_t* CKVN = CQN + (size_t)T * 192;
  bf16_t* UB = CKVN + (size_t)T * 128;
  bf16_t* QN = (bf16_t*)(p.ws + WS_G);
  bf16_t* KS = QN + (size_t)T * 256;
  bf16_t* KW = KS + (size_t)T * 64;
  const float* g_cq = p.in[4] + l * 192; const float* g_ckv = p.in[5] + l * 128;
  const float* g_nq = p.in[27] + l * 64; const float* g_nk = p.in[28] + l * 192;
  const float* cw = p.in[10] + l * 4 * 256; const float* cb = p.in[11] + l * 256;
  const int* positions = (const int*)p.in[1];
  for (int t = gw; t < T; t += NGW) {
    const int s = t & (S - 1), pos = positions[t];
    const bf16_t* pr = PROJ + (size_t)t * DINP;
    for (int i = lane; i < DINP / 2; i += 64) { const unsigned u = ((const unsigned*)pr)[i]; row[2 * i] = __uint_as_float(u << 16); row[2 * i + 1] = __uint_as_float(u & 0xffff0000u); }
    __builtin_amdgcn_s_waitcnt(0);
    __builtin_amdgcn_wave_barrier();
    { float ss = 0.f; for (int i = lane; i < 192; i += 64) ss += row[C_CQ + i] * row[C_CQ + i];
      const float rs = rsqrtf(wsum(ss) * (1.f / 192) + EPS);
      for (int i = lane; i < 192; i += 64) CQN[(size_t)t * 192 + i] = f2bf(row[C_CQ + i] * rs * g_cq[i]); }
    { float ss = 0.f; for (int i = lane; i < 128; i += 64) ss += row[C_CKV + i] * row[C_CKV + i];
      const float rs = rsqrtf(wsum(ss) * (1.f / 128) + EPS);
      for (int i = lane; i < 128; i += 64) CKVN[(size_t)t * 128 + i] = f2bf(row[C_CKV + i] * rs * g_ckv[i]); }
    {
      const int hd = lane >> 4, li = lane & 15;
      const float* q = row + C_NQ + hd * 64;
      float ss = 0.f;
#pragma unroll
      for (int i = 0; i < 4; ++i) ss += q[li + 16 * i] * q[li + 16 * i];
      ss += __shfl_xor(ss, 1); ss += __shfl_xor(ss, 2); ss += __shfl_xor(ss, 4); ss += __shfl_xor(ss, 8);
      const float rs = rsqrtf(ss * (1.f / 64) + EPS);
      const float sc = 0.125f * LOG2E;
#pragma unroll
      for (int i = 0; i < 4; ++i) {
        const int d = li + 16 * i; float v;
        if (d < 16) { float c, sn; rope_cs(pos, d & 7, 16, c, sn);
          const float x1 = q[d & 7] * rs * g_nq[d & 7], x2 = q[(d & 7) + 8] * rs * g_nq[(d & 7) + 8];
          v = (d < 8) ? (x1 * c - x2 * sn) : (x1 * sn + x2 * c);
        } else v = q[d] * rs * g_nq[d];
        QN[(size_t)t * 256 + hd * 64 + d] = f2bf(v * sc);
      }
    }
    {
      const int which = lane >> 5, li = lane & 31;
      const float* kk = row + C_NKV + (which ? 256 : 128);
      const float* g = g_nk + (which ? 128 : 64);
      float ss = kk[li] * kk[li] + kk[li + 32] * kk[li + 32];
      ss += __shfl_xor(ss, 1); ss += __shfl_xor(ss, 2); ss += __shfl_xor(ss, 4); ss += __shfl_xor(ss, 8); ss += __shfl_xor(ss, 16);
      const float rs = rsqrtf(ss * (1.f / 64) + EPS);
      bf16_t* dst = (which ? KW : KS) + (size_t)t * 64;
#pragma unroll
      for (int i = 0; i < 2; ++i) {
        const int d = li + 32 * i; float v;
        if (d < 16) { float c, sn; rope_cs(pos, d & 7, 16, c, sn);
          const float x1 = kk[d & 7] * rs * g[d & 7], x2 = kk[(d & 7) + 8] * rs * g[(d & 7) + 8];
          v = (d < 8) ? (x1 * c - x2 * sn) : (x1 * sn + x2 * c);
        } else v = kk[d] * rs * g[d];
        dst[d] = f2bf(v);
      }
    }
    for (int c = lane; c < 256; c += 64) {
      float u = cb[c];
#pragma unroll
      for (int j = 0; j < 4; ++j) { const int ss2 = s - 3 + j; if (ss2 >= 0) u += bf2f(PROJ[(size_t)(t - 3 + j) * DINP + C_LX + c]) * cw[j * 256 + c]; }
      UB[(size_t)t * 256 + c] = f2bf(u);
    }
    __builtin_amdgcn_wave_barrier();
  }
}

DEVI void phase_g2(const Params& p, int l, unsigned char* lds) {
  unsigned char* wl = p.ws + WS_W + l * WS_WL;
  const bf16_t* PROJ = (const bf16_t*)(p.ws + WS_B);
  const bf16_t* CQN = (const bf16_t*)(p.ws + WS_C);
  const bf16_t* CKVN = CQN + (size_t)T * 192;
  const bf16_t* UB = CKVN + (size_t)T * 128;
  bf16_t* QR = (bf16_t*)(p.ws + WS_D);
  bf16_t* KVR = QR + (size_t)T * 384;
  bf16_t* GATES = (bf16_t*)(p.ws + WS_E);
  constexpr int N_CMP = 32, N_QR = 256 * 3, N_KVR = 256 * 4, N_GT = 256 * 4;
  for (int it = blockIdx.x; it < N_CMP + N_QR + N_KVR + N_GT; it += gridDim.x) {
    f32x4 acc[4][4];
    if (it < N_CMP) {
      const int kv = it & 1, mt = it >> 1;
      const bf16_t* W = (const bf16_t*)(wl + (kv ? W_1V : W_1K));
      const float* bias = (const float*)(wl + (kv ? W_B1V : W_B1K));
      bf16_t* H = (bf16_t*)(p.ws + (kv ? SM_HV : SM_HK));
      gemm128(lds, 2048,
              [&](int r, int k) { const int m = mt * 128 + r, b = m >> 7; int c = m & 127; if (c > 126) c = 126;
                                  return PROJ + (size_t)(b * S + 16 * c + (k >> 6)) * DINP + C_NKV + kv * 64 + (k & 63); },
              [&](int r, int k) { return W + (size_t)r * 2048 + k; }, acc);
      GEMM_EPI_LOOP({ H[(size_t)(mt * 128 + er) * 128 + ec] = f2bf(gelu_tanh(ev + bias[ec])); })
    } else if (it < N_CMP + N_QR) {
      const int i2 = it - N_CMP, mt = i2 / 3, nt = i2 % 3;
      const bf16_t* W = (const bf16_t*)(wl + W_UQ);
      gemm128(lds, 192, [&](int r, int k) { return CQN + (size_t)(mt * 128 + r) * 192 + k; }, [&](int r, int k) { return W + (size_t)(nt * 128 + r) * 192 + k; }, acc);
      GEMM_EPI_LOOP({ QR[(size_t)(mt * 128 + er) * 384 + nt * 128 + ec] = f2bf(ev); })
    } else if (it < N_CMP + N_QR + N_KVR) {
      const int i2 = it - N_CMP - N_QR, mt = i2 >> 2, nt = i2 & 3;
      const bf16_t* W = (const bf16_t*)(wl + W_UKV);
      gemm128(lds, 128, [&](int r, int k) { return CKVN + (size_t)(mt * 128 + r) * 128 + k; }, [&](int r, int k) { return W + (size_t)(nt * 128 + r) * 128 + k; }, acc);
      GEMM_EPI_LOOP({ KVR[(size_t)(mt * 128 + er) * 512 + nt * 128 + ec] = f2bf(ev); })
    } else {
      const int i2 = it - N_CMP - N_QR - N_KVR, mt = i2 >> 2, h = i2 & 3;
      const bf16_t* W = (const bf16_t*)(wl + W_LRU) + h * 128 * 64;
      gemm128(lds, 64, [&](int r, int k) { return UB + (size_t)(mt * 128 + r) * 256 + h * 64 + k; }, [&](int r, int k) { return W + (size_t)r * 64 + k; }, acc);
      GEMM_EPI_LOOP({ GATES[(size_t)(mt * 128 + er) * 512 + h * 128 + ec] = f2bf(ev); })
    }
  }
}

DEVI void lru_ab(float u, float rpre, float ipre, float sp, bool first, float& a, float& b) {
  const float r = sigmoidf_(rpre), gi = sigmoidf_(ipre);
  const float la = -8.f * r * sp;
  a = expf(la);
  const float mult = first ? 1.f : sqrtf(fmaxf(-expm1f(2.f * la), 0.f));
  b = mult * gi * u;
}
DEVI float lru_conv(const bf16_t* PROJ, int t, int s, int c, const float* cw, float cb) {
  float u = cb;
#pragma unroll
  for (int j = 0; j < 4; ++j) { const int ss2 = s - 3 + j; if (ss2 >= 0) u += bf2f(PROJ[(size_t)(t - 3 + j) * DINP + C_LX + c]) * cw[j * 256 + c]; }
  return u;
}

template <bool FULL>
DEVI void s5_chunk(const Params& p, int l, int b, int chunk, unsigned char* lds) {
  unsigned char* wl = p.ws + WS_W + l * WS_WL;
  const bf16_t* PROJ = (const bf16_t*)(p.ws + WS_B);
  const float2* Abar = (const float2*)(wl + W_S5A);
  const float2* A64 = (const float2*)(wl + W_S5A64);
  const float2* Bbar = (const float2*)(wl + W_S5B);
  float2* SLOC = (float2*)(p.ws + SM_SLOC);
  bf16_t* YCP = (bf16_t*)(p.ws + WS_F);
  const float* c_re = p.in[22] + (size_t)l * 16 * 16 * 64;
  const float* c_im = p.in[23] + (size_t)l * 16 * 16 * 64;
  const float* dd = p.in[24] + l * 256;
  const int tid = threadIdx.x, gs = tid >> 6, pp = tid & 63;
  bf16_t* U = (bf16_t*)lds;
  float2* H = (float2*)(lds + 32768);
  const int t0 = b * S + chunk * 64;
  __syncthreads();
  for (int i = tid; i < 64 * 32; i += NTHREADS) { const int r = i >> 5, c8 = i & 31; *(uint4*)(U + r * 256 + c8 * 8) = *(const uint4*)(PROJ + (size_t)(t0 + r) * DINP + C_S5 + c8 * 8); }
  __syncthreads();
  for (int set = 0; set < 4; ++set) {
    const int g = set * 4 + gs;
    const float2 A = Abar[g * 64 + pp];
    float2 Bb[16];
#pragma unroll
    for (int ch = 0; ch < 16; ++ch) Bb[ch] = Bbar[(g * 64 + pp) * 16 + ch];
    float hr = 0.f, hi = 0.f;
    if (FULL) {
      const float2 a64 = A64[g * 64 + pp];
      for (int cc = 0; cc < chunk; ++cc) { const float2 sl = SLOC[((size_t)(b * 32 + cc) * 16 + g) * 64 + pp]; const float nr = a64.x * hr - a64.y * hi + sl.x, ni = a64.x * hi + a64.y * hr + sl.y; hr = nr; hi = ni; }
    }
    for (int sub = 0; sub < 4; ++sub) {
      for (int tt = 0; tt < 16; ++tt) {
        const bf16_t* ur = U + (sub * 16 + tt) * 256 + g * 16;
        float br = 0.f, bi = 0.f;
#pragma unroll
        for (int ch = 0; ch < 16; ++ch) { const float uv = bf2f(ur[ch]); br += Bb[ch].x * uv; bi += Bb[ch].y * uv; }
        const float nr = A.x * hr - A.y * hi + br, ni = A.x * hi + A.y * hr + bi; hr = nr; hi = ni;
        if (FULL) H[(tt * 4 + gs) * 64 + pp] = make_float2(hr, hi);
      }
      if (FULL) {
        __syncthreads();
#pragma unroll
        for (int i = 0; i < 4; ++i) {
          const int idx = tid + 256 * i, tt = idx >> 6, gg = (idx >> 4) & 3, ch = idx & 15, g2 = set * 4 + gg;
          const float* cr = c_re + (g2 * 16 + ch) * 64; const float* ci = c_im + (g2 * 16 + ch) * 64;
          const float2* hh = H + (tt * 4 + gg) * 64;
          float y = 0.f;
          for (int q = 0; q < 64; ++q) { const float2 hv = hh[q]; y += hv.x * cr[q] - hv.y * ci[q]; }
          const int col = g2 * 16 + ch, tr = sub * 16 + tt;
          y += dd[col] * bf2f(U[tr * 256 + col]);
          YCP[(size_t)(t0 + tr) * 256 + col] = f2bf(gelu_tanh(y));
        }
        __syncthreads();
      }
    }
    if (!FULL) SLOC[((size_t)(b * 32 + chunk) * 16 + g) * 64 + pp] = make_float2(hr, hi);
  }
}

DEVI void phase_r2(const Params& p, int l, unsigned char* lds) {
  unsigned char* wl = p.ws + WS_W + l * WS_WL;
  const bf16_t* PROJ = (const bf16_t*)(p.ws + WS_B);
  const bf16_t* QR = (const bf16_t*)(p.ws + WS_D);
  const bf16_t* KVR = QR + (size_t)T * 384;
  const bf16_t* GATES = (const bf16_t*)(p.ws + WS_E);
  bf16_t* MQ = (bf16_t*)(p.ws + WS_F);
  bf16_t* MK = MQ + (size_t)T * 4 * 96;
  const int* positions = (const int*)p.in[1];
  const int tid = threadIdx.x, lane = tid & 63, wv = tid >> 6;
  {
    const float* g_q = p.in[8] + l * 96; const float* g_k = p.in[9] + l * 96;
    float* row = (float*)lds + wv * 768;
    const int gw = blockIdx.x * 4 + wv, NGW = gridDim.x * 4;
    for (int t = gw; t < T; t += NGW) {
      const int b = t >> 11, s = t & (S - 1), pos = positions[t];
      for (int i = lane; i < 384; i += 64) row[i] = bf2f(QR[(size_t)t * 384 + i]);
      for (int i = lane; i < 384; i += 64) { const int h = i / 96, d = i % 96; row[384 + i] = (d < 32) ? bf2f(PROJ[(size_t)t * DINP + C_KPE + d]) : bf2f(KVR[(size_t)t * 512 + h * 128 + (d - 32)]); }
      __builtin_amdgcn_s_waitcnt(0);
      __builtin_amdgcn_wave_barrier();
      const int vec = lane >> 3, li = lane & 7;
      const float* v = row + vec * 96;
      const float* g = (vec < 4) ? g_q : g_k;
      float ss = 0.f;
#pragma unroll
      for (int i = 0; i < 12; ++i) ss += v[li + 8 * i] * v[li + 8 * i];
      ss += __shfl_xor(ss, 1); ss += __shfl_xor(ss, 2); ss += __shfl_xor(ss, 4);
      const float rs = rsqrtf(ss * (1.f / 96) + EPS);
      const float sc = (vec < 4) ? (0.10206207261596575f * LOG2E) : 1.f;
      bf16_t* dst = ((vec < 4) ? MQ : MK) + ((size_t)(b * 4 + (vec & 3)) * S + s) * 96;
#pragma unroll
      for (int i = 0; i < 12; ++i) {
        const int d = li + 8 * i; float o;
        if (d < 32) { float c, sn; rope_cs(pos, d & 15, 32, c, sn);
          const float x1 = v[d & 15] * rs * g[d & 15], x2 = v[(d & 15) + 16] * rs * g[(d & 15) + 16];
          o = (d < 16) ? (x1 * c - x2 * sn) : (x1 * sn + x2 * c);
        } else o = v[d] * rs * g[d];
        dst[d] = f2bf(o * sc);
      }
      __builtin_amdgcn_wave_barrier();
    }
  }
  {
    const float* cw = p.in[10] + l * 4 * 256; const float* cbp = p.in[11] + l * 256;
    const float* b_a = p.in[13] + l * 256; const float* b_i = p.in[15] + l * 256; const float* lam = p.in[16] + l * 256;
    float2* LSUM = (float2*)(p.ws + SM_LSUM);
    const int c = tid, h = c >> 6, j = c & 63;
    const float sp = log1pf(expf(-lam[c])), ba = b_a[c], bi = b_i[c], cb = cbp[c];
    for (int it = blockIdx.x; it < NB * 32; it += gridDim.x) {
      const int b = it >> 5, chunk = it & 31;
      float ap = 1.f, hh = 0.f;
      for (int k = 0; k < 64; ++k) {
        const int s = chunk * 64 + k, t = b * S + s;
        const float u = lru_conv(PROJ, t, s, c, cw, cb);
        float a, bb; lru_ab(u, bf2f(GATES[(size_t)t * 512 + h * 128 + j]) + ba, bf2f(GATES[(size_t)t * 512 + h * 128 + 64 + j]) + bi, sp, s == 0, a, bb);
        hh = a * hh + bb; ap *= a;
      }
      LSUM[(size_t)it * 256 + c] = make_float2(ap, hh);
    }
  }
  for (int it = blockIdx.x; it < NB * 32; it += gridDim.x) s5_chunk<false>(p, l, it >> 5, it & 31, lds);
  {
    const float* w2k = p.in[31] + (size_t)l * 128 * 64; const float* w2v = p.in[34] + (size_t)l * 128 * 64;
    const float* g0 = p.in[28] + l * 192;
    const bf16_t* HK = (const bf16_t*)(p.ws + SM_HK); const bf16_t* HV = (const bf16_t*)(p.ws + SM_HV);
    bf16_t* KC = (bf16_t*)(p.ws + SM_KC); bf16_t* VC = (bf16_t*)(p.ws + SM_VC);
    float* sh = (float*)lds;
    for (int it = blockIdx.x; it < NB * 128; it += gridDim.x) {
      const int b = it >> 7, c = it & 127;
      __syncthreads();
      float val = 0.f;
      const int kv = tid >> 6, n = tid & 63;
      if (tid < 128 && c < 127) {
        const bf16_t* hrow = (kv ? HV : HK) + (size_t)it * 128;
        const float* w2 = kv ? w2v : w2k;
        for (int q = 0; q < 128; ++q) val += bf2f(hrow[q]) * w2[q * 64 + n];
      }
      if (tid < 64) sh[n] = val;
      __syncthreads();
      if (tid < 64) {
        float o = 0.f;
        if (c < 127) {
          float ss = val * val; ss = wsum(ss);
          const float rs = rsqrtf(ss * (1.f / 64) + EPS);
          const int pos = positions[b * S + 16 * c + 31];
          if (n < 16) { float cs, sn; rope_cs(pos, n & 7, 16, cs, sn);
            const float x1 = sh[n & 7] * rs * g0[n & 7], x2 = sh[(n & 7) + 8] * rs * g0[(n & 7) + 8];
            o = (n < 8) ? (x1 * cs - x2 * sn) : (x1 * sn + x2 * cs);
          } else o = val * rs * g0[n];
        }
        KC[(size_t)it * 64 + n] = f2bf(o);
      } else if (tid < 128) {
        VC[(size_t)it * 64 + n] = f2bf(c < 127 ? val : 0.f);
      }
    }
  }
}

template <int DK>
DEVI void load_k_tile(bf16_t* sK, const bf16_t* kbase, size_t kstride, int key0) {
  constexpr int CH = DK / 8;
  for (int c = threadIdx.x; c < 64 * CH; c += NTHREADS) { const int r = c / CH, cc = c % CH; *(uint4*)(sK + r * (DK + 8) + cc * 8) = *(const uint4*)(kbase + (size_t)(key0 + r) * kstride + cc * 8); }
}
DEVI void load_v_tile_t(bf16_t* sVt, const bf16_t* vbase, size_t vstride, int key0) {
  for (int c = threadIdx.x; c < 512; c += NTHREADS) {
    const int r = c >> 3, cc = c & 7;
    const uint4 v = *(const uint4*)(vbase + (size_t)(key0 + r) * vstride + cc * 8);
    const unsigned w[4] = {v.x, v.y, v.z, v.w};
#pragma unroll
    for (int i = 0; i < 4; ++i) { sVt[(cc * 8 + 2 * i) * 72 + r] = (bf16_t)(w[i] & 0xffffu); sVt[(cc * 8 + 2 * i + 1) * 72 + r] = (bf16_t)(w[i] >> 16); }
  }
}
template <int DK>
DEVI void qk_tile(const bf16_t* sK, const bf16x8* qf, f32x16& s0, f32x16& s1, int r, int h) {
#pragma unroll
  for (int i = 0; i < 16; ++i) { s0[i] = 0.f; s1[i] = 0.f; }
#pragma unroll
  for (int kk = 0; kk < DK / 16; ++kk) {
    const bf16x8 a0 = *(const bf16x8*)(sK + r * (DK + 8) + kk * 16 + h * 8);
    const bf16x8 a1 = *(const bf16x8*)(sK + (32 + r) * (DK + 8) + kk * 16 + h * 8);
    s0 = mfma32(a0, qf[kk], s0);
    s1 = mfma32(a1, qf[kk], s1);
  }
}
struct FState { f32x16 o0, o1; float m, l; };
DEVI void fstate_init(FState& f) {
#pragma unroll
  for (int i = 0; i < 16; ++i) { f.o0[i] = 0.f; f.o1[i] = 0.f; }
  f.m = -INFINITY; f.l = 0.f;
}
DEVI void softmax_pv(FState& f, f32x16& s0, f32x16& s1, const bf16_t* sVt, int r, int h) {
  float mx = -INFINITY;
#pragma unroll
  for (int i = 0; i < 16; ++i) mx = fmaxf(mx, fmaxf(s0[i], s1[i]));
  mx = fmaxf(mx, __shfl_xor(mx, 32));
  const float mnew = fmaxf(f.m, mx);
  const float muse = (mnew == -INFINITY) ? 0.f : mnew;
  const float alpha = exp2f(f.m - muse);
  float ps = 0.f;
#pragma unroll
  for (int i = 0; i < 16; ++i) { s0[i] = exp2f(s0[i] - muse); s1[i] = exp2f(s1[i] - muse); ps += s0[i] + s1[i]; }
  ps += __shfl_xor(ps, 32);
  f.l = f.l * alpha + ps; f.m = mnew;
#pragma unroll
  for (int i = 0; i < 16; ++i) { f.o0[i] *= alpha; f.o1[i] *= alpha; }
#pragma unroll
  for (int kb = 0; kb < 2; ++kb)
#pragma unroll
    for (int s = 0; s < 2; ++s) {
      bf16x8 pb;
#pragma unroll
      for (int j = 0; j < 8; ++j) pb[j] = (short)f2bf(kb ? s1[8 * s + j] : s0[8 * s + j]);
      const int base = kb * 32 + 16 * s + 4 * h;
#pragma unroll
      for (int db = 0; db < 2; ++db) {
        const uint2 lo = *(const uint2*)(sVt + (db * 32 + r) * 72 + base);
        const uint2 hi = *(const uint2*)(sVt + (db * 32 + r) * 72 + base + 8);
        bf16x8 a;
        a[0] = (short)(lo.x & 0xffffu); a[1] = (short)(lo.x >> 16); a[2] = (short)(lo.y & 0xffffu); a[3] = (short)(lo.y >> 16);
        a[4] = (short)(hi.x & 0xffffu); a[5] = (short)(hi.x >> 16); a[6] = (short)(hi.y & 0xffffu); a[7] = (short)(hi.y >> 16);
        if (db == 0) f.o0 = mfma32(a, pb, f.o0); else f.o1 = mfma32(a, pb, f.o1);
      }
    }
}

DEVI void mla_item(const Params& p, int b, int hd, int qt, unsigned char* lds) {
  const bf16_t* MQ = (const bf16_t*)(p.ws + WS_F);
  const bf16_t* MK = MQ + (size_t)T * 4 * 96;
  const bf16_t* KVR = (const bf16_t*)(p.ws + WS_D) + (size_t)T * 384;
  bf16_t* YA = (bf16_t*)(p.ws + WS_C);
  const int tid = threadIdx.x, wv = tid >> 6, lane = tid & 63, r = lane & 31, h = lane >> 5;
  bf16_t* sK = (bf16_t*)lds;
  bf16_t* sVt = sK + 64 * 104;
  const int q0 = qt * 128 + wv * 32, tq = q0 + r;
  const bf16_t* qrow = MQ + ((size_t)(b * 4 + hd) * S + tq) * 96;
  bf16x8 qf[6];
#pragma unroll
  for (int kk = 0; kk < 6; ++kk) qf[kk] = *(const bf16x8*)(qrow + kk * 16 + h * 8);
  FState f; fstate_init(f);
  const bf16_t* kbase = MK + (size_t)(b * 4 + hd) * S * 96;
  const bf16_t* vbase = KVR + (size_t)b * S * 512 + hd * 128 + 64;
  const int ntiles = 2 * qt + 2;
  for (int kt = 0; kt < ntiles; ++kt) {
    __syncthreads();
    load_k_tile<96>(sK, kbase, 96, kt * 64);
    load_v_tile_t(sVt, vbase, 512, kt * 64);
    __syncthreads();
    if (kt * 64 <= q0 + 31) {
      f32x16 s0, s1;
      qk_tile<96>(sK, qf, s0, s1, r, h);
      if (kt * 64 + 63 > q0) {
#pragma unroll
        for (int i = 0; i < 16; ++i) { const int key = kt * 64 + crow(i, h); if (key > tq) s0[i] = -INFINITY; if (key + 32 > tq) s1[i] = -INFINITY; }
      }
      softmax_pv(f, s0, s1, sVt, r, h);
    }
  }
  const float inv = 1.f / f.l;
  bf16_t* orow = YA + (size_t)(b * S + tq) * 256 + hd * 64;
#pragma unroll
  for (int g = 0; g < 4; ++g) {
    ushort4 v0, v1;
    v0.x = f2bf(f.o0[4 * g] * inv); v0.y = f2bf(f.o0[4 * g + 1] * inv); v0.z = f2bf(f.o0[4 * g + 2] * inv); v0.w = f2bf(f.o0[4 * g + 3] * inv);
    v1.x = f2bf(f.o1[4 * g] * inv); v1.y = f2bf(f.o1[4 * g + 1] * inv); v1.z = f2bf(f.o1[4 * g + 2] * inv); v1.w = f2bf(f.o1[4 * g + 3] * inv);
    *(ushort4*)(orow + 8 * g + 4 * h) = v0;
    *(ushort4*)(orow + 32 + 8 * g + 4 * h) = v1;
  }
}

DEVI void nsa_item(const Params& p, int b, int qt, unsigned char* lds) {
  const bf16_t* PROJ = (const bf16_t*)(p.ws + WS_B);
  const bf16_t* QN = (const bf16_t*)(p.ws + WS_G);
  const bf16_t* KS = QN + (size_t)T * 256;
  const bf16_t* KW = KS + (size_t)T * 64;
  const bf16_t* KC = (const bf16_t*)(p.ws + SM_KC) + (size_t)b * 128 * 64;
  const bf16_t* VC = (const bf16_t*)(p.ws + SM_VC) + (size_t)b * 128 * 64;
  bf16_t* YD = (bf16_t*)(p.ws + WS_C) + (size_t)T * 256;
  const int tid = threadIdx.x, wv = tid >> 6, lane = tid & 63, r = lane & 31, h = lane >> 5;
  bf16_t* sK = (bf16_t*)lds;
  bf16_t* sVt = sK + 64 * 104;
  float* psum = (float*)(lds + 24576);
  unsigned* selm = (unsigned*)(lds + 24576 + 16384);
  const int t0 = qt * 32, cur = t0 >> 6;
  const int ql = wv * 8 + (r >> 2), hd = r & 3, tq = t0 + ql;
  const size_t tg = (size_t)b * S + tq;
  bf16x8 qf[4];
#pragma unroll
  for (int kk = 0; kk < 4; ++kk) qf[kk] = *(const bf16x8*)(QN + tg * 256 + hd * 64 + kk * 16 + h * 8);
  f32x16 of0, of1;
#pragma unroll
  for (int i = 0; i < 16; ++i) { of0[i] = 0.f; of1[i] = 0.f; }
  const float g0 = sigmoidf_(bf2f(PROJ[tg * DINP + C_NG + hd * 3 + 0]));
  const float g1 = sigmoidf_(bf2f(PROJ[tg * DINP + C_NG + hd * 3 + 1]));
  const float g2 = sigmoidf_(bf2f(PROJ[tg * DINP + C_NG + hd * 3 + 2]));
  FState f; fstate_init(f);
  for (int kt = 0; kt < 2; ++kt) {
    __syncthreads();
    load_k_tile<64>(sK, KC, 64, kt * 64);
    load_v_tile_t(sVt, VC, 64, kt * 64);
    __syncthreads();
    f32x16 s0, s1;
    qk_tile<64>(sK, qf, s0, s1, r, h);
#pragma unroll
    for (int i = 0; i < 16; ++i) { const int c = kt * 64 + crow(i, h); if (16 * c + 31 > tq) s0[i] = -INFINITY; if (16 * (c + 32) + 31 > tq) s1[i] = -INFINITY; }
    softmax_pv(f, s0, s1, sVt, r, h);
  }
  {
    const float sc = (f.l > 0.f) ? g0 / f.l : 0.f;
#pragma unroll
    for (int i = 0; i < 16; ++i) { of0[i] += f.o0[i] * sc; of1[i] += f.o1[i] * sc; }
  }
  {
    const float muse = (f.m == -INFINITY) ? 0.f : f.m;
    const float il = (f.l > 0.f) ? 1.f / f.l : 0.f;
    for (int kt = 0; kt < 2; ++kt) {
      __syncthreads();
      load_k_tile<64>(sK, KC, 64, kt * 64);
      __syncthreads();
      f32x16 s0, s1;
      qk_tile<64>(sK, qf, s0, s1, r, h);
#pragma unroll
      for (int i = 0; i < 16; ++i) {
        const int c = kt * 64 + crow(i, h);
        float p0 = (16 * c + 31 > tq) ? 0.f : exp2f(s0[i] - muse) * il;
        float p1 = (16 * (c + 32) + 31 > tq) ? 0.f : exp2f(s1[i] - muse) * il;
        p0 += __shfl_xor(p0, 1); p0 += __shfl_xor(p0, 2);
        p1 += __shfl_xor(p1, 1); p1 += __shfl_xor(p1, 2);
        if (hd == 0) { psum[ql * 128 + c] = p0; psum[ql * 128 + c + 32] = p1; }
      }
    }
  }
  __syncthreads();
#pragma unroll 1
  for (int itq = 0; itq < 4; ++itq) {
    const int q2 = wv * 8 + itq * 2 + (lane >> 5), j = lane & 31;
    const float* ps = psum + q2 * 128;
    float imp = 2.f * (ps[4 * j] + ps[4 * j + 1] + ps[4 * j + 2]) + ps[4 * j + 3];
    if (j > 0) imp += ps[4 * j - 1];
    const bool cand = (j >= 1) && (j <= cur - 2);
    int rank = 0;
    for (int jj = 0; jj < 32; ++jj) {
      const float v = __shfl(imp, (lane & 32) | jj);
      const bool cj = (jj >= 1) && (jj <= cur - 2);
      if (cj && (v > imp || (v == imp && jj < j))) ++rank;
    }
    const bool sel = cand && rank < 2;
    const unsigned long long bal = __ballot(sel);
    unsigned mk = (unsigned)(bal >> (32 * (lane >> 5)));
    mk |= 1u | (1u << cur); if (cur >= 1) mk |= (1u << (cur - 1));
    if (j == 0) selm[q2] = mk;
  }
  __syncthreads();
  unsigned blk_or = 0, wave_or = 0;
  for (int i = 0; i < 32; ++i) blk_or |= selm[i];
  for (int i = 0; i < 8; ++i) wave_or |= selm[wv * 8 + i];
  const unsigned mymask = selm[ql];
  fstate_init(f);
  {
    const bf16_t* kb = KS + (size_t)b * S * 64;
    const bf16_t* vb = PROJ + (size_t)b * S * DINP + C_NKV + 192;
    for (int j = 0; j <= cur; ++j) {
      if (!((blk_or >> j) & 1u)) continue;
      __syncthreads();
      load_k_tile<64>(sK, kb, 64, j * 64);
      load_v_tile_t(sVt, vb, DINP, j * 64);
      __syncthreads();
      if ((wave_or >> j) & 1u) {
        f32x16 s0, s1;
        qk_tile<64>(sK, qf, s0, s1, r, h);
        const bool on = (mymask >> j) & 1u;
#pragma unroll
        for (int i = 0; i < 16; ++i) { const int key = j * 64 + crow(i, h); if (!on || key > tq) s0[i] = -INFINITY; if (!on || key + 32 > tq) s1[i] = -INFINITY; }
        softmax_pv(f, s0, s1, sVt, r, h);
      }
    }
    const float sc = (f.l > 0.f) ? g1 / f.l : 0.f;
#pragma unroll
    for (int i = 0; i < 16; ++i) { of0[i] += f.o0[i] * sc; of1[i] += f.o1[i] * sc; }
  }
  fstate_init(f);
  {
    const bf16_t* kb = KW + (size_t)b * S * 64;
    const bf16_t* vb = PROJ + (size_t)b * S * DINP + C_NKV + 320;
    int jlo = (t0 - 511) >> 6; if (jlo < 0) jlo = 0;
    for (int j = jlo; j <= cur; ++j) {
      __syncthreads();
      load_k_tile<64>(sK, kb, 64, j * 64);
      load_v_tile_t(sVt, vb, DINP, j * 64);
      __syncthreads();
      f32x16 s0, s1;
      qk_tile<64>(sK, qf, s0, s1, r, h);
#pragma unroll
      for (int i = 0; i < 16; ++i) {
        const int key = j * 64 + crow(i, h);
        if (key > tq || tq - key >= 512) s0[i] = -INFINITY;
        if (key + 32 > tq || tq - key - 32 >= 512) s1[i] = -INFINITY;
      }
      softmax_pv(f, s0, s1, sVt, r, h);
    }
    const float sc = (f.l > 0.f) ? g2 / f.l : 0.f;
#pragma unroll
    for (int i = 0; i < 16; ++i) { of0[i] += f.o0[i] * sc; of1[i] += f.o1[i] * sc; }
  }
  bf16_t* orow = YD + tg * 256 + hd * 64;
#pragma unroll
  for (int g = 0; g < 4; ++g) {
    ushort4 v0, v1;
    v0.x = f2bf(of0[4 * g]); v0.y = f2bf(of0[4 * g + 1]); v0.z = f2bf(of0[4 * g + 2]); v0.w = f2bf(of0[4 * g + 3]);
    v1.x = f2bf(of1[4 * g]); v1.y = f2bf(of1[4 * g + 1]); v1.z = f2bf(of1[4 * g + 2]); v1.w = f2bf(of1[4 * g + 3]);
    *(ushort4*)(orow + 8 * g + 4 * h) = v0;
    *(ushort4*)(orow + 32 + 8 * g + 4 * h) = v1;
  }
}
DEVI void phase_a1(const Params& p, int l, unsigned char* lds) {
  for (int it = blockIdx.x; it < 2048; it += gridDim.x) {
    const int j = it >> 1;
    if (it & 1) { const int qt = 63 - (j >> 4), b = j & 15; nsa_item(p, b, qt, lds); }
    else { const int qt = 15 - (j >> 6), bh = j & 63; mla_item(p, bh >> 2, bh & 3, qt, lds); }
  }
}

DEVI void phase_r3(const Params& p, int l, unsigned char* lds) {
  const bf16_t* PROJ = (const bf16_t*)(p.ws + WS_B);
  const bf16_t* GATES = (const bf16_t*)(p.ws + WS_E);
  bf16_t* Y = (bf16_t*)(p.ws + WS_A);
  const int tid = threadIdx.x, lane = tid & 63, wv = tid >> 6;
  {
    const float* cw = p.in[10] + l * 4 * 256; const float* cbp = p.in[11] + l * 256;
    const float* b_a = p.in[13] + l * 256; const float* b_i = p.in[15] + l * 256; const float* lam = p.in[16] + l * 256;
    const float* onorm = p.in[35] + l * 1024 + 256;
    const float2* LSUM = (const float2*)(p.ws + SM_LSUM);
    float* tile = (float*)lds;
    const int c = tid, h = c >> 6, j = c & 63;
    const float sp = log1pf(expf(-lam[c])), ba = b_a[c], bi = b_i[c], cb = cbp[c];
    for (int it = blockIdx.x; it < NB * 32; it += gridDim.x) {
      const int b = it >> 5, chunk = it & 31;
      float hh = 0.f;
      for (int cc = 0; cc < chunk; ++cc) { const float2 sv = LSUM[(size_t)(b * 32 + cc) * 256 + c]; hh = sv.x * hh + sv.y; }
      __syncthreads();
      for (int k = 0; k < 64; ++k) {
        const int s = chunk * 64 + k, t = b * S + s;
        const float u = lru_conv(PROJ, t, s, c, cw, cb);
        float a, bb; lru_ab(u, bf2f(GATES[(size_t)t * 512 + h * 128 + j]) + ba, bf2f(GATES[(size_t)t * 512 + h * 128 + 64 + j]) + bi, sp, s == 0, a, bb);
        hh = a * hh + bb;
        tile[k * 256 + c] = hh * gelu_tanh(bf2f(PROJ[(size_t)t * DINP + C_LG + c]));
      }
      __syncthreads();
      for (int k = wv; k < 64; k += 4) {
        float v[4], ss = 0.f;
#pragma unroll
        for (int i = 0; i < 4; ++i) { v[i] = tile[k * 256 + lane + 64 * i]; ss += v[i] * v[i]; }
        const float rs = rsqrtf(wsum(ss) * (1.f / 256) + EPS);
        const size_t t = (size_t)b * S + chunk * 64 + k;
#pragma unroll
        for (int i = 0; i < 4; ++i) Y[t * 1024 + 256 + lane + 64 * i] = f2bf(v[i] * rs * onorm[lane + 64 * i]);
      }
    }
  }
  for (int it = blockIdx.x; it < NB * 32; it += gridDim.x) s5_chunk<true>(p, l, it >> 5, it & 31, lds);
}

DEVI void phase_g3(const Params& p, int l, unsigned char* lds) {
  const bf16_t* YCP = (const bf16_t*)(p.ws + WS_F);
  bf16_t* YC = (bf16_t*)(p.ws + WS_F) + (size_t)T * 256;
  const bf16_t* W = (const bf16_t*)(p.ws + WS_W + l * WS_WL + W_GLU);
  const float* bg = p.in[26] + l * 256;
  for (int it = blockIdx.x; it < 256 * 2; it += gridDim.x) {
    const int mt = it >> 1, nt = it & 1;
    f32x4 acc[4][4];
    gemm128(lds, 256, [&](int r, int k) { return YCP + (size_t)(mt * 128 + r) * 256 + k; }, [&](int r, int k) { return W + (size_t)(nt * 128 + r) * 256 + k; }, acc);
    GEMM_EPI_LOOP({ const size_t o = (size_t)(mt * 128 + er) * 256 + nt * 128 + ec; YC[o] = f2bf(bf2f(YCP[o]) * sigmoidf_(ev + bg[nt * 128 + ec])); })
  }
}

DEVI void phase_r4(const Params& p, int l) {
  const bf16_t* YA = (const bf16_t*)(p.ws + WS_C);
  const bf16_t* YD = YA + (size_t)T * 256;
  const bf16_t* YC = (const bf16_t*)(p.ws + WS_F) + (size_t)T * 256;
  bf16_t* Y = (bf16_t*)(p.ws + WS_A);
  const float* onorm = p.in[35] + l * 1024;
  const int lane = threadIdx.x & 63, gw = blockIdx.x * 4 + (threadIdx.x >> 6), NGW = gridDim.x * 4;
  for (int t = gw; t < T; t += NGW) {
#pragma unroll
    for (int grp = 0; grp < 3; ++grp) {
      const bf16_t* src = (grp == 0 ? YA : (grp == 1 ? YC : YD)) + (size_t)t * 256;
      const int gcol = (grp == 0 ? 0 : (grp == 1 ? 512 : 768));
      const ushort4 u = ((const ushort4*)src)[lane];
      const float v0 = bf2f(u.x), v1 = bf2f(u.y), v2 = bf2f(u.z), v3 = bf2f(u.w);
      const float rs = rsqrtf(wsum(v0 * v0 + v1 * v1 + v2 * v2 + v3 * v3) * (1.f / 256) + EPS);
      const float4 g = ((const float4*)(onorm + gcol))[lane];
      ushort4 o; o.x = f2bf(v0 * rs * g.x); o.y = f2bf(v1 * rs * g.y); o.z = f2bf(v2 * rs * g.z); o.w = f2bf(v3 * rs * g.w);
      ((ushort4*)(Y + (size_t)t * 1024 + gcol))[lane] = o;
    }
  }
}

DEVI void phase_g4(const Params& p, int l, unsigned char* lds) {
  const bf16_t* Y = (const bf16_t*)(p.ws + WS_A);
  const bf16_t* W = (const bf16_t*)(p.ws + WS_W + l * WS_WL + W_OUT);
  const float* xin = (l == 0) ? p.in[0] : p.out;
  float* out = p.out;
  for (int it = blockIdx.x; it < 256 * 8; it += gridDim.x) {
    const int mt = it >> 3, nt = it & 7;
    f32x4 acc[4][4];
    gemm128(lds, D, [&](int r, int k) { return Y + (size_t)(mt * 128 + r) * D + k; }, [&](int r, int k) { return W + (size_t)(nt * 128 + r) * D + k; }, acc);
    GEMM_EPI_LOOP({ const size_t o = (size_t)(mt * 128 + er) * D + nt * 128 + ec; out[o] = xin[o] + ev; })
  }
}

DEVI void phase_r5(const Params& p, int l) {
  const float* x1 = p.out;
  bf16_t* XN = (bf16_t*)(p.ws + WS_A);
  const float* g = p.in[37] + l * D;
  const float* wrg = p.in[38] + (size_t)l * D * 4; const float* brg = p.in[39] + l * 4;
  const float* wre = p.in[40] + (size_t)l * D * 16; const float* bre = p.in[41] + l * 16;
  int* CNT = (int*)(p.ws + SM_CNT) + l * 32;
  int* LIST = (int*)(p.ws + SM_LIST);
  float2* TOKW = (float2*)(p.ws + SM_TOKW);
  const int lane = threadIdx.x & 63, gw = blockIdx.x * 4 + (threadIdx.x >> 6), NGW = gridDim.x * 4;
  for (int t = gw; t < T; t += NGW) {
    const float4* xr = (const float4*)(x1 + (size_t)t * D);
    float s = 0.f;
#pragma unroll
    for (int j = 0; j < 4; ++j) { const float4 v = xr[lane + 64 * j]; s += v.x * v.x + v.y * v.y + v.z * v.z + v.w * v.w; }
    const float rs = rsqrtf(wsum(s) * (1.f / D) + EPS);
    float lg[20];
#pragma unroll
    for (int o = 0; o < 20; ++o) lg[o] = 0.f;
#pragma unroll 1
    for (int j = 0; j < 4; ++j) {
      const float4 v = xr[lane + 64 * j];
      const float4 gg = ((const float4*)g)[lane + 64 * j];
      const float tv[4] = {v.x * rs * gg.x, v.y * rs * gg.y, v.z * rs * gg.z, v.w * rs * gg.w};
      ushort4 o; o.x = f2bf(tv[0]); o.y = f2bf(tv[1]); o.z = f2bf(tv[2]); o.w = f2bf(tv[3]);
      ((ushort4*)(XN + (size_t)t * D))[lane + 64 * j] = o;
#pragma unroll
      for (int e = 0; e < 4; ++e) {
        const int k = (lane + 64 * j) * 4 + e;
        const float4 a = *(const float4*)(wrg + (size_t)k * 4);
        lg[0] += tv[e] * a.x; lg[1] += tv[e] * a.y; lg[2] += tv[e] * a.z; lg[3] += tv[e] * a.w;
#pragma unroll
        for (int q = 0; q < 4; ++q) { const float4 w4 = *(const float4*)(wre + (size_t)k * 16 + q * 4); lg[4 + q * 4] += tv[e] * w4.x; lg[5 + q * 4] += tv[e] * w4.y; lg[6 + q * 4] += tv[e] * w4.z; lg[7 + q * 4] += tv[e] * w4.w; }
      }
    }
#pragma unroll
    for (int o = 0; o < 20; ++o) lg[o] = wsum(lg[o]);
    if (lane == 0) {
      float gl[4];
#pragma unroll
      for (int q = 0; q < 4; ++q) gl[q] = lg[q] + brg[q];
      int gi = 0; float gbest = gl[0];
#pragma unroll
      for (int q = 1; q < 4; ++q) if (gl[q] > gbest) { gbest = gl[q]; gi = q; }
      float den = 0.f;
#pragma unroll
      for (int q = 0; q < 4; ++q) den += expf(gl[q] - gbest);
      const float pg = 1.f / den;
      float le[4];
#pragma unroll
      for (int q = 0; q < 4; ++q) { float sel = 0.f;
#pragma unroll
        for (int gg2 = 0; gg2 < 4; ++gg2) sel = (gi == gg2) ? (lg[4 + gg2 * 4 + q] + bre[gg2 * 4 + q]) : sel;
        le[q] = sel; }
      int i0 = 0; float l0 = le[0];
#pragma unroll
      for (int q = 1; q < 4; ++q) if (le[q] > l0) { l0 = le[q]; i0 = q; }
      int i1 = -1; float l1 = -INFINITY;
#pragma unroll
      for (int q = 0; q < 4; ++q) if (q != i0 && le[q] > l1) { l1 = le[q]; i1 = q; }
      const float e1 = expf(l1 - l0);
      const float w0 = pg / (1.f + e1), w1 = pg * e1 / (1.f + e1);
      const int elo = (i0 < i1) ? i0 : i1, ehi = (i0 < i1) ? i1 : i0;
      const float wlo = (i0 < i1) ? w0 : w1, whi = (i0 < i1) ? w1 : w0;
      const int pidx = (elo == 0) ? (ehi - 1) : ((elo == 1) ? (ehi + 1) : 5);
      const int cls = gi * 6 + pidx;
      const int slot = atomicAdd(&CNT[cls], 1);
      LIST[(size_t)cls * T + slot] = t;
      TOKW[t] = make_float2(wlo, whi);
    }
  }
}

struct MoeItem { int cls, mtile, nt, cnt; };
DEVI bool moe_item(const int* CNT, int it, MoeItem& m) {
  int mt = it >> 3; m.nt = it & 7;
  for (int c = 0; c < 24; ++c) { const int n = CNT[c], tc = (n + 127) >> 7; if (mt < tc) { m.cls = c; m.mtile = mt; m.cnt = n; return true; } mt -= tc; }
  return false;
}
DEVI void cls_experts(int cls, int& e0, int& e1) {
  const int g = cls / 6, pi = cls % 6;
  const int lo = (pi < 3) ? 0 : ((pi < 5) ? 1 : 2);
  const int hi = (pi < 3) ? (pi + 1) : ((pi < 5) ? (pi - 1) : 3);
  e0 = g * 4 + lo; e1 = g * 4 + hi;
}
DEVI void phase_g5(const Params& p, int l, unsigned char* lds) {
  const bf16_t* XN = (const bf16_t*)(p.ws + WS_A);
  bf16_t* HID = (bf16_t*)(p.ws + WS_B);
  const bf16_t* WGU = (const bf16_t*)(p.ws + WS_W + l * WS_WL + W_GU);
  const int* CNT = (const int*)(p.ws + SM_CNT) + l * 32;
  const int* LIST = (const int*)(p.ws + SM_LIST);
  const float2* TOKW = (const float2*)(p.ws + SM_TOKW);
  for (int it = blockIdx.x;; it += gridDim.x) {
    MoeItem mi; if (!moe_item(CNT, it, mi)) break;
    int e0, e1; cls_experts(mi.cls, e0, e1);
    const int ex = (mi.nt < 4) ? e0 : e1, ntl = mi.nt & 3;
    const bf16_t* W = WGU + ((size_t)ex * 512 + ntl * 128) * 1024;
    const int* list = LIST + (size_t)mi.cls * T + mi.mtile * 128;
    const int nvalid = mi.cnt - mi.mtile * 128;
    f32x4 acc[4][4];
    gemm128(lds, D, [&](int r, int k) { const int tok = (r < nvalid) ? list[r] : list[0]; return XN + (size_t)tok * D + k; }, [&](int r, int k) { return W + (size_t)r * D + k; }, acc);
    {
      const int tid = threadIdx.x, wid = tid >> 6, lane = tid & 63, wr = wid >> 1, wc = wid & 1, fr = lane & 15, fq = lane >> 4;
#pragma unroll
      for (int m = 0; m < 4; ++m)
#pragma unroll
        for (int j = 0; j < 4; ++j) {
          const int er = wr * 64 + m * 16 + fq * 4 + j;
          if (er < nvalid) {
            const int tok = list[er];
            const float2 tw = TOKW[tok];
            const float w = (mi.nt < 4) ? tw.x : tw.y;
#pragma unroll
            for (int n = 0; n < 2; ++n) {
              const float gt = acc[m][n][j], up = acc[m][n + 2][j];
              const int hh = (mi.nt < 4 ? 0 : 256) + ntl * 64 + wc * 32 + n * 16 + fr;
              HID[(size_t)tok * 512 + hh] = f2bf(gt * sigmoidf_(gt) * up * w);
            }
          }
        }
    }
  }
}
DEVI void phase_g6(const Params& p, int l, unsigned char* lds) {
  const bf16_t* HID = (const bf16_t*)(p.ws + WS_B);
  const bf16_t* WDN = (const bf16_t*)(p.ws + WS_W + l * WS_WL + W_DN);
  const int* CNT = (const int*)(p.ws + SM_CNT) + l * 32;
  const int* LIST = (const int*)(p.ws + SM_LIST);
  float* out = p.out;
  for (int it = blockIdx.x;; it += gridDim.x) {
    MoeItem mi; if (!moe_item(CNT, it, mi)) break;
    int e0, e1; cls_experts(mi.cls, e0, e1);
    const int* list = LIST + (size_t)mi.cls * T + mi.mtile * 128;
    const int nvalid = mi.cnt - mi.mtile * 128;
    const bf16_t* W0 = WDN + ((size_t)e0 * 1024 + mi.nt * 128) * 256;
    const bf16_t* W1 = WDN + ((size_t)e1 * 1024 + mi.nt * 128) * 256;
    f32x4 acc[4][4];
    gemm128(lds, 512, [&](int r, int k) { const int tok = (r < nvalid) ? list[r] : list[0]; return HID + (size_t)tok * 512 + k; },
            [&](int r, int k) { return ((k < 256) ? W0 : W1) + (size_t)r * 256 + (k & 255); }, acc);
    GEMM_EPI_LOOP({ if (er < nvalid) { const size_t o = (size_t)list[er] * D + mi.nt * 128 + ec; out[o] += ev; } })
  }
}


#define XB_TMO      128
#define XB_XCNT(j)  (256  + 64 * (j))
#define XB_XSUB(j)  (1280 + 64 * (j))
#define XB_XGEN(j)  (2304 + 64 * (j))
#define XB_TOP      3328
#define XB_TOPGEN   3392
#define XCD_BAR_WORDS 3456
#define XB_SPIN_CAP (1u << 18)
DEVI unsigned xb_ld(unsigned* p)              { return __hip_atomic_load(p, __ATOMIC_RELAXED, __HIP_MEMORY_SCOPE_AGENT); }
DEVI unsigned xb_add(unsigned* p, unsigned v) { return __hip_atomic_fetch_add(p, v, __ATOMIC_RELAXED, __HIP_MEMORY_SCOPE_AGENT); }
DEVI unsigned xb_xcc_id() { return (unsigned)__builtin_amdgcn_s_getreg((3 << 11) | 20) & 0xFu; }
#define XB_SPIN(cond, bar) do { unsigned _sp = 0; while (cond) { __builtin_amdgcn_s_sleep(1); \
    if ((++_sp & 255u) == 0u) { if (xb_ld(&(bar)[XB_TMO])) break; if (_sp > XB_SPIN_CAP) { atomicAdd(&(bar)[XB_TMO], 1u); break; } } } } while (0)
struct XcdBarrier { unsigned* bar; unsigned x; volatile LAS unsigned* st; };
DEVI XcdBarrier xcd_barrier_post(unsigned* bar, volatile LAS unsigned* st) {
    XcdBarrier b; b.bar = bar; b.x = xb_xcc_id(); b.st = st;
    if (threadIdx.x == 0) (void)xb_add(&bar[XB_XCNT(b.x)], 1u);
    return b;
}
DEVI void xcd_barrier_complete(unsigned* bar, unsigned x, unsigned& nloc, unsigned& nx) {
    const unsigned G = gridDim.x * gridDim.y * gridDim.z;
    unsigned sum, cnt, mine, sp = 0u;
    for (;;) {
        sum = 0u; cnt = 0u; mine = 0u;
#pragma unroll
        for (unsigned j = 0; j < 16; ++j) { const unsigned c = xb_ld(&bar[XB_XCNT(j)]); sum += c; cnt += (c > 0u) ? 1u : 0u; mine = (j == x) ? c : mine; }
        if (sum == G) break;
        __builtin_amdgcn_s_sleep(1);
        if ((++sp & 255u) == 0u) { if (xb_ld(&bar[XB_TMO])) break; if (sp > XB_SPIN_CAP) { atomicAdd(&bar[XB_TMO], 1u); break; } }
    }
    nloc = mine > 0u ? mine : 1u; nx = cnt > 0u ? cnt : 1u;
}
DEVI void xcd_barrier(const XcdBarrier& b) {
    asm volatile("s_waitcnt vmcnt(0)" ::: "memory");
    __syncthreads();
    if (threadIdx.x == 0) {
        unsigned* bar = b.bar;
        __builtin_amdgcn_s_waitcnt(0);
        unsigned nloc = b.st[0], nx = b.st[1];
        if (nloc == 0u) { xcd_barrier_complete(bar, b.x, nloc, nx); b.st[0] = nloc; b.st[1] = nx; }
        const unsigned old = xb_add(&bar[XB_XSUB(b.x)], 1u);
        const unsigned gen = old / nloc;
        if (old + 1u == (gen + 1u) * nloc) {
            __builtin_amdgcn_fence(__ATOMIC_RELEASE, "agent");
            asm volatile("s_waitcnt vmcnt(0)" ::: "memory");
            const unsigned og = xb_add(&bar[XB_TOP], 1u);
            const unsigned tg = og / nx;
            if (og + 1u == (tg + 1u) * nx) xb_add(&bar[XB_TOPGEN], 1u);
            else XB_SPIN(xb_ld(&bar[XB_TOPGEN]) == tg, bar);
            __builtin_amdgcn_fence(__ATOMIC_ACQUIRE, "agent");
            xb_add(&bar[XB_XGEN(b.x)], 1u);
            asm volatile("s_waitcnt vmcnt(0)" ::: "memory");
        } else {
            XB_SPIN(xb_ld(&bar[XB_XGEN(b.x)]) == gen, bar);
            __builtin_amdgcn_fence(__ATOMIC_ACQUIRE, "agent");
            asm volatile("s_waitcnt vmcnt(0)" ::: "memory");
        }
    }
    __syncthreads();
}

#define PH(k, call) { const int _k = (k); if (p.lo <= _k && _k < p.hi) { call; if (_k + 1 < p.hi) { if (_k == 0) grid.sync(); else xcd_barrier(xbar); } } }
__global__ void __launch_bounds__(NTHREADS, 2) hybrid_fwd(Params p) {
  extern __shared__ __attribute__((aligned(16))) unsigned char lds[];
  cg::grid_group grid = cg::this_grid();
  volatile LAS unsigned* xst = (volatile LAS unsigned*)(LAS unsigned char*)(lds + LDS_BYTES);
  if (threadIdx.x < 4) xst[threadIdx.x] = 0u;
  __syncthreads();
  XcdBarrier xbar = xcd_barrier_post((unsigned*)(p.ws + WS_CTL), xst);
  PH(0, phase_prep(p))
#define LAYER(l) { \
    PH(1 + 13 * l + 0, phase_g1(p, l, lds)) \
    PH(1 + 13 * l + 1, phase_r1(p, l, lds)) \
    PH(1 + 13 * l + 2, phase_g2(p, l, lds)) \
    PH(1 + 13 * l + 3, phase_r2(p, l, lds)) \
    PH(1 + 13 * l + 4, phase_a1(p, l, lds)) \
    PH(1 + 13 * l + 5, phase_r3(p, l, lds)) \
    PH(1 + 13 * l + 6, phase_g3(p, l, lds)) \
    PH(1 + 13 * l + 7, phase_r4(p, l)) \
    PH(1 + 13 * l + 8, phase_g4(p, l, lds)) \
    PH(1 + 13 * l + 9, phase_r5(p, l)) \
    PH(1 + 13 * l + 10, phase_g5(p, l, lds)) \
    PH(1 + 13 * l + 11, phase_g6(p, l, lds)) }
  LAYER(0)
  PH(13, rmsnorm_rows(p.out, p.in[2] + D, (bf16_t*)(p.ws + WS_A)))
  LAYER(1)
}

extern "C" void kernel_launch(void* const* d_in, const int* in_sizes, int n_in, void* d_out, int out_size, void* d_ws, size_t ws_size, hipStream_t stream) {
  static int grid_blocks = 0;
  if (!grid_blocks) {
    if (n_in != 45 || ws_size < WS_END) { fprintf(stderr, "kernel_launch: unexpected n_in %d or ws_size %zu (< %zu)\n", n_in, ws_size, (size_t)WS_END); grid_blocks = -1; return; }
    int dev = 0, cus = 0, per_cu = 0;
    hipGetDevice(&dev);
    hipDeviceGetAttribute(&cus, hipDeviceAttributeMultiprocessorCount, dev);
    hipFuncSetAttribute((const void*)hybrid_fwd, hipFuncAttributeMaxDynamicSharedMemorySize, LDS_ALLOC);
    hipOccupancyMaxActiveBlocksPerMultiprocessor(&per_cu, (const void*)hybrid_fwd, NTHREADS, LDS_ALLOC);
    if (per_cu < 1) per_cu = 1;
    if (per_cu > 2) per_cu = 2;
    grid_blocks = cus * per_cu;
    fprintf(stderr, "kernel_launch: cus %d per_cu %d grid %d\n", cus, per_cu, grid_blocks);
  }
  if (grid_blocks < 0) return;
  (void)hipMemsetAsync((unsigned char*)d_ws + WS_CTL, 0, XCD_BAR_WORDS * 4, stream);
  Params p{};
  for (int i = 0; i < 45; ++i) p.in[i] = (const float*)d_in[i];
  p.out = (float*)d_out; p.ws = (unsigned char*)d_ws;
#if N_LAUNCH_MODE == 1
  p.lo = 0; p.hi = NPH;
  { void* args[] = {&p}; hipError_t e = hipLaunchCooperativeKernel((void*)hybrid_fwd, dim3(grid_blocks), dim3(NTHREADS), args, LDS_ALLOC, stream);
    if (e != hipSuccess) fprintf(stderr, "cooperative launch failed: %s\n", hipGetErrorString(e)); }
#else
  for (int ph = 0; ph < NPH; ++ph) {
    p.lo = ph; p.hi = ph + 1;
    void* args[] = {&p}; hipError_t e = hipLaunchCooperativeKernel((void*)hybrid_fwd, dim3(grid_blocks), dim3(NTHREADS), args, LDS_ALLOC, stream);
    if (e != hipSuccess) { fprintf(stderr, "launch %d failed: %s\n", ph, hipGetErrorString(e)); break; }
  }
#endif
}
```

```cpp
#include <hip/hip_runtime.h>
#include <hip/hip_cooperative_groups.h>
#include <cstdio>
#include <cstdint>
namespace cg = cooperative_groups;

#ifndef N_LAUNCH_MODE
#define N_LAUNCH_MODE 1
#endif

#define DEVI __device__ __forceinline__
typedef unsigned short bf16_t;
typedef short bf16x8 __attribute__((ext_vector_type(8)));
typedef float f32x4 __attribute__((ext_vector_type(4)));
typedef float f32x16 __attribute__((ext_vector_type(16)));
typedef unsigned u32x4 __attribute__((ext_vector_type(4)));
#define LAS __attribute__((address_space(3)))

constexpr int NB = 16, S = 2048, T = NB * S, D = 1024, DIN = 1772, DINP = 1792, NL = 2;
constexpr int C_CQ = 0, C_CKV = 192, C_KPE = 320, C_LX = 352, C_LG = 608, C_S5 = 864, C_NQ = 1120, C_NKV = 1376, C_NG = 1760;
constexpr float EPS = 1e-6f;
constexpr float LOG2E = 1.4426950408889634f;
constexpr int NTHREADS = 256;
constexpr int NPH = 1 + 13 * NL - 1;

constexpr size_t MiB = 1u << 20;
constexpr size_t WS_CTL = 0;
constexpr size_t WS_SMALL = 1 * MiB;
constexpr size_t WS_W = 16 * MiB;
constexpr size_t WS_WL = 32 * MiB;
constexpr size_t WS_A = 80 * MiB;
constexpr size_t WS_B = 144 * MiB;
constexpr size_t WS_C = 256 * MiB;
constexpr size_t WS_D = 292 * MiB;
constexpr size_t WS_E = 348 * MiB;
constexpr size_t WS_F = 380 * MiB;
constexpr size_t WS_G = 428 * MiB;
constexpr size_t WS_ROPE = 452 * MiB;
constexpr size_t WS_END = 460 * MiB;
constexpr size_t W_IN = 0;
constexpr size_t W_OUT = 4 * MiB;
constexpr size_t W_UQ = 6 * MiB;
constexpr size_t W_UKV = W_UQ + 384 * 192 * 2;
constexpr size_t W_LRU = W_UKV + 512 * 128 * 2;
constexpr size_t W_GLU = W_LRU + 4 * 128 * 64 * 2;
constexpr size_t W_1K = 6 * MiB + 512 * 1024;
constexpr size_t W_1V = W_1K + 128 * 2048 * 2;
constexpr size_t W_B1K = W_1V + 128 * 2048 * 2;
constexpr size_t W_B1V = W_B1K + 512;
constexpr size_t W_S5A = W_B1V + 512;
constexpr size_t W_S5A64 = W_S5A + 16 * 64 * 8;
constexpr size_t W_S5B = W_S5A64 + 16 * 64 * 8;
constexpr size_t W_S5BB = W_S5B + 16 * 64 * 16 * 8;
constexpr size_t W_S5CM = W_S5BB + 16 * 4 * 32 * 16 * 2;
constexpr size_t W_2K = W_S5CM + 16 * 16 * 128 * 2;
constexpr size_t W_2V = W_2K + 64 * 128 * 2;
static_assert(W_2V + 64 * 128 * 2 <= 8 * MiB, "weights overflow");
constexpr size_t W_RT = W_2V + 64 * 128 * 2;
static_assert(W_RT + 1024 * 20 * 4 <= 8 * MiB, "weights overflow 2");
constexpr size_t W_GU = 8 * MiB;
constexpr size_t W_DN = 24 * MiB;
constexpr size_t SM_CNT = WS_SMALL;
constexpr size_t SM_LIST = WS_SMALL + 4096;
constexpr size_t SM_TOKW = SM_LIST + 24 * (size_t)T * 4;
constexpr size_t SM_LSUM = SM_TOKW + (size_t)T * 8;
constexpr size_t SM_SLOC = SM_LSUM + 16 * 32 * 256 * 8;
constexpr size_t SM_HK = SM_SLOC + 16 * 32 * 1024 * 8;
constexpr size_t SM_HV = SM_HK + 2048 * 128 * 2;
constexpr size_t SM_KC = SM_HV + 2048 * 128 * 2;
constexpr size_t SM_VC = SM_KC + 16 * 128 * 64 * 2;
constexpr size_t SM_SCAR = SM_VC + 16 * 128 * 64 * 2;
constexpr size_t SM_LCAR = SM_SCAR + 16 * 32 * 1024 * 8;
constexpr size_t SM_END = SM_LCAR + 16 * 32 * 256 * 4;
static_assert(SM_END <= WS_W, "small region overflow");

constexpr int LDS_BYTES = 65536;
constexpr int LDS_ALLOC = LDS_BYTES + 512;

struct Params {
  const float* in[45];
  float* out;
  unsigned char* ws;
  int lo, hi;
};

DEVI float bf2f(bf16_t v) { return __uint_as_float(((unsigned)v) << 16); }
DEVI bf16_t f2bf(float f) { unsigned u = __float_as_uint(f); return (bf16_t)((u + 0x7fffu + ((u >> 16) & 1u)) >> 16); }
DEVI float wsum(float v) {
#pragma unroll
  for (int o = 32; o >= 1; o >>= 1) v += __shfl_xor(v, o);
  return v;
}
DEVI float sigmoidf_(float x) { return 1.f / (1.f + __expf(-x)); }
DEVI float gelu_tanh(float x) { return 0.5f * x * (1.f + tanhf(0.7978845608028654f * (x + 0.044715f * x * x * x))); }
DEVI f32x16 mfma32(bf16x8 a, bf16x8 b, f32x16 c) { return __builtin_amdgcn_mfma_f32_32x32x16_bf16(a, b, c, 0, 0, 0); }
DEVI f32x4 mfma16(bf16x8 a, bf16x8 b, f32x4 c) { return __builtin_amdgcn_mfma_f32_16x16x32_bf16(a, b, c, 0, 0, 0); }
DEVI int crow(int r, int h) { return (r & 3) + 8 * (r >> 2) + 4 * h; }

template <class AF, class BF>
DEVI void gemm128(unsigned char* lds, int K, AF aptr, BF bptr, f32x4 (&acc)[4][4]) {
  const int tid = threadIdx.x, wid = tid >> 6, lane = tid & 63, wr = wid >> 1, wc = wid & 1, fr = lane & 15, fq = lane >> 4;
#pragma unroll
  for (int m = 0; m < 4; ++m)
#pragma unroll
    for (int n = 0; n < 4; ++n) acc[m][n] = (f32x4){0.f, 0.f, 0.f, 0.f};
  const int lr = tid >> 3, ch = tid & 7;
  const int wofs = lr * 128 + ((ch ^ ((lr >> 1) & 7)) * 16);
  const int sw = (fr >> 1) & 7;
  const int aro = (wr * 64 + fr) * 128, bro = (wc * 64 + fr) * 128;
  const int nk = K >> 6;
  u32x4 ra[4], rb[4];
#pragma unroll
  for (int i = 0; i < 4; ++i) { ra[i] = *(const u32x4*)aptr(lr + 32 * i, ch * 8); rb[i] = *(const u32x4*)bptr(lr + 32 * i, ch * 8); }
  __syncthreads();
#pragma unroll
  for (int i = 0; i < 4; ++i) { *(u32x4*)(lds + wofs + i * 4096) = ra[i]; *(u32x4*)(lds + 16384 + wofs + i * 4096) = rb[i]; }
  __syncthreads();
  for (int kt = 0; kt < nk; ++kt) {
    const bool more = (kt + 1 < nk);
    if (more) {
      const int k = (kt + 1) * 64 + ch * 8;
#pragma unroll
      for (int i = 0; i < 4; ++i) { ra[i] = *(const u32x4*)aptr(lr + 32 * i, k); rb[i] = *(const u32x4*)bptr(lr + 32 * i, k); }
    }
    const unsigned char* bufA = lds + (kt & 1) * 32768;
    const unsigned char* bufB = bufA + 16384;
#pragma unroll
    for (int kk = 0; kk < 2; ++kk) {
      bf16x8 At[4], Bt[4];
      const int co = ((kk * 4 + fq) ^ sw) * 16;
#pragma unroll
      for (int m = 0; m < 4; ++m) At[m] = *(const bf16x8*)(bufA + aro + m * 2048 + co);
#pragma unroll
      for (int n = 0; n < 4; ++n) Bt[n] = *(const bf16x8*)(bufB + bro + n * 2048 + co);
#pragma unroll
      for (int m = 0; m < 4; ++m)
#pragma unroll
        for (int n = 0; n < 4; ++n) acc[m][n] = mfma16(Bt[n], At[m], acc[m][n]);
    }
    if (more) {
      unsigned char* nb = lds + ((kt + 1) & 1) * 32768;
#pragma unroll
      for (int i = 0; i < 4; ++i) { *(u32x4*)(nb + wofs + i * 4096) = ra[i]; *(u32x4*)(nb + 16384 + wofs + i * 4096) = rb[i]; }
    }
    __syncthreads();
  }
}
#define GEMM_EPI_LOOP(body)                                                                 \
  {                                                                                         \
    const int _tid = threadIdx.x, _wid = _tid >> 6, _lane = _tid & 63, _wr = _wid >> 1, _wc = _wid & 1, _fr = _lane & 15, _fq = _lane >> 4; \
    _Pragma("unroll") for (int m = 0; m < 4; ++m) _Pragma("unroll") for (int n = 0; n < 4; ++n) _Pragma("unroll") for (int j = 0; j < 4; ++j) { \
      const int er = _wr * 64 + m * 16 + _fr, ec = _wc * 64 + n * 16 + _fq * 4 + j; const float ev = acc[m][n][j]; body }                      \
  }
#define GEMM_EPI4(body)                                                                     \
  {                                                                                         \
    const int _tid = threadIdx.x, _wid = _tid >> 6, _lane = _tid & 63, _wr = _wid >> 1, _wc = _wid & 1, _fr = _lane & 15, _fq = _lane >> 4; \
    _Pragma("unroll") for (int m = 0; m < 4; ++m) _Pragma("unroll") for (int n = 0; n < 4; ++n) {                                             \
      const int er = _wr * 64 + m * 16 + _fr, ec0 = _wc * 64 + n * 16 + _fq * 4; const f32x4 ev4 = acc[m][n]; body }                          \
  }
DEVI void st_bf16x4(bf16_t* p, f32x4 v) { ushort4 o; o.x = f2bf(v[0]); o.y = f2bf(v[1]); o.z = f2bf(v[2]); o.w = f2bf(v[3]); *(ushort4*)p = o; }

template <class RM>
DEVI void transpose_tiles(const float* src, int K, int N, bf16_t* dst, int ldk, RM rowmap, unsigned char* lds, int& cursor) {
  float* tl = (float*)lds;
  const int tk = K / 64, tn = (N + 63) / 64, nt = tk * tn;
  const int tid = threadIdx.x;
  const int G_ = (int)gridDim.x;
  for (int it = ((int)blockIdx.x - cursor % G_ + G_) % G_; it < nt; it += G_) {
    const int kt = it / tn, ntile = it % tn, k0 = kt * 64, n0 = ntile * 64;
    __syncthreads();
#pragma unroll
    for (int q = 0; q < 4; ++q) {
      const int r = (tid >> 4) + 16 * q, c4 = (tid & 15) * 4;
      const float* sp = src + (size_t)(k0 + r) * N + n0 + c4;
      float4 v;
      if (n0 + c4 + 3 < N) v = *(const float4*)sp;
      else { v.x = (n0 + c4 < N) ? sp[0] : 0.f; v.y = (n0 + c4 + 1 < N) ? sp[1] : 0.f; v.z = (n0 + c4 + 2 < N) ? sp[2] : 0.f; v.w = 0.f; }
      tl[r * 65 + c4] = v.x; tl[r * 65 + c4 + 1] = v.y; tl[r * 65 + c4 + 2] = v.z; tl[r * 65 + c4 + 3] = v.w;
    }
    __syncthreads();
    const int n = tid >> 2, kc = (tid & 3) * 16;
    if (n0 + n < N) {
      unsigned w[8];
#pragma unroll
      for (int i = 0; i < 8; ++i) w[i] = (unsigned)f2bf(tl[(kc + 2 * i) * 65 + n]) | ((unsigned)f2bf(tl[(kc + 2 * i + 1) * 65 + n]) << 16);
      uint4* o = (uint4*)(dst + (size_t)rowmap(n0 + n) * ldk + k0 + kc);
      o[0] = make_uint4(w[0], w[1], w[2], w[3]); o[1] = make_uint4(w[4], w[5], w[6], w[7]);
    }
  }
  cursor += nt;
}
DEVI void rmsnorm_rows(const float* x, const float* g, bf16_t* xn) {
  const int lane = threadIdx.x & 63, gw = blockIdx.x * 4 + (threadIdx.x >> 6), NGW = gridDim.x * 4;
  for (int t = gw; t < T; t += NGW) {
    const float4* xr = (const float4*)(x + (size_t)t * D);
    float4 v[4]; float s = 0.f;
#pragma unroll
    for (int j = 0; j < 4; ++j) { v[j] = xr[lane + 64 * j]; s += v[j].x * v[j].x + v[j].y * v[j].y + v[j].z * v[j].z + v[j].w * v[j].w; }
    const float rs = rsqrtf(wsum(s) * (1.f / D) + EPS);
#pragma unroll
    for (int j = 0; j < 4; ++j) {
      const float4 gg = ((const float4*)g)[lane + 64 * j];
      ushort4 o; o.x = f2bf(v[j].x * rs * gg.x); o.y = f2bf(v[j].y * rs * gg.y); o.z = f2bf(v[j].z * rs * gg.z); o.w = f2bf(v[j].w * rs * gg.w);
      ((ushort4*)(xn + (size_t)t * D))[lane + 64 * j] = o;
    }
  }
}
DEVI void phase_prep(const Params& p, unsigned char* lds) {
  const size_t gtid = (size_t)blockIdx.x * NTHREADS + threadIdx.x, gn = (size_t)gridDim.x * NTHREADS;
  unsigned char* ws = p.ws;
  if (gtid < 64) ((int*)(ws + SM_CNT))[gtid] = 0;
  auto ident = [](int n) { return n; };
  int cursor = 0;
  for (int l = 0; l < NL; ++l) {
    unsigned char* wl = ws + WS_W + l * WS_WL;
    transpose_tiles(p.in[3] + (size_t)l * D * DIN, D, DIN, (bf16_t*)(wl + W_IN), D, ident, lds, cursor);
    for (size_t i = gtid; i < (size_t)(DINP - DIN) * D; i += gn) ((bf16_t*)(wl + W_IN))[(size_t)DIN * D + i] = 0;
    transpose_tiles(p.in[36] + (size_t)l * D * D, D, D, (bf16_t*)(wl + W_OUT), D, ident, lds, cursor);
    transpose_tiles(p.in[6] + (size_t)l * 192 * 384, 192, 384, (bf16_t*)(wl + W_UQ), 192, ident, lds, cursor);
    transpose_tiles(p.in[7] + (size_t)l * 128 * 512, 128, 512, (bf16_t*)(wl + W_UKV), 128, ident, lds, cursor);
    transpose_tiles(p.in[25] + (size_t)l * 256 * 256, 256, 256, (bf16_t*)(wl + W_GLU), 256, ident, lds, cursor);
    transpose_tiles(p.in[30] + (size_t)l * 2048 * 128, 2048, 128, (bf16_t*)(wl + W_1K), 2048, ident, lds, cursor);
    transpose_tiles(p.in[33] + (size_t)l * 2048 * 128, 2048, 128, (bf16_t*)(wl + W_1V), 2048, ident, lds, cursor);
    transpose_tiles(p.in[31] + (size_t)l * 128 * 64, 128, 64, (bf16_t*)(wl + W_2K), 128, ident, lds, cursor);
    transpose_tiles(p.in[34] + (size_t)l * 128 * 64, 128, 64, (bf16_t*)(wl + W_2V), 128, ident, lds, cursor);
    for (int h = 0; h < 4; ++h) {
      transpose_tiles(p.in[12] + ((size_t)l * 4 + h) * 64 * 64, 64, 64, (bf16_t*)(wl + W_LRU) + h * 128 * 64, 64, ident, lds, cursor);
      transpose_tiles(p.in[14] + ((size_t)l * 4 + h) * 64 * 64, 64, 64, (bf16_t*)(wl + W_LRU) + h * 128 * 64 + 64 * 64, 64, ident, lds, cursor);
    }
    for (int e = 0; e < 16; ++e) {
      bf16_t* dg = (bf16_t*)(wl + W_GU) + (size_t)e * 512 * 1024;
      transpose_tiles(p.in[42] + ((size_t)l * 16 + e) * 1024 * 256, 1024, 256, dg, 1024, [](int hh) { return (hh >> 6) * 128 + ((hh >> 5) & 1) * 64 + ((hh >> 4) & 1) * 16 + (hh & 15); }, lds, cursor);
      transpose_tiles(p.in[43] + ((size_t)l * 16 + e) * 1024 * 256, 1024, 256, dg, 1024, [](int hh) { return (hh >> 6) * 128 + ((hh >> 5) & 1) * 64 + (((hh >> 4) & 1) + 2) * 16 + (hh & 15); }, lds, cursor);
      transpose_tiles(p.in[44] + ((size_t)l * 16 + e) * 256 * 1024, 256, 1024, (bf16_t*)(wl + W_DN) + (size_t)e * 1024 * 256, 256, ident, lds, cursor);
    }
    {
      const int lane = threadIdx.x & 63, gw = blockIdx.x * 4 + (threadIdx.x >> 6), NGW = gridDim.x * 4;
      for (int o = gw; o < 256; o += NGW) {
        const int kv = o >> 7, j = o & 127;
        const float* pe = (kv ? p.in[32] : p.in[29]) + (size_t)l * 2048;
        const float* w1 = (kv ? p.in[33] : p.in[30]) + (size_t)l * 2048 * 128;
        float a = 0.f;
#pragma unroll 8
        for (int k = lane; k < 2048; k += 64) a += pe[k] * w1[(size_t)k * 128 + j];
        a = wsum(a);
        if (lane == 0) ((float*)(wl + (kv ? W_B1V : W_B1K)))[j] = a;
      }
    }
    for (size_t i = gtid; i < 16 * 64; i += gn) {
      const int g = (int)(i >> 6), sidx = (int)(i & 63);
      const float are = p.in[17][(size_t)l * 1024 + i], aim = p.in[18][(size_t)l * 1024 + i];
      const float dt = expf(p.in[19][l * 16 + g]);
      const float mag = expf(dt * are);
      float sn, cs; sincosf(dt * aim, &sn, &cs);
      const float abr = mag * cs, abi = mag * sn;
      const float den = are * are + aim * aim, nre = abr - 1.f;
      const float gre = (nre * are + abi * aim) / den, gim = (abi * are - nre * aim) / den;
      ((float2*)(wl + W_S5A))[i] = make_float2(abr, abi);
      float pr = abr, pi = abi;
#pragma unroll
      for (int q = 0; q < 6; ++q) { const float nr = pr * pr - pi * pi, ni = 2.f * pr * pi; pr = nr; pi = ni; }
      ((float2*)(wl + W_S5A64))[i] = make_float2(pr, pi);
      bf16_t* bb = (bf16_t*)(wl + W_S5BB);
      for (int ch = 0; ch < 16; ++ch) {
        const float br = p.in[20][((size_t)l * 1024 + i) * 16 + ch], bi = p.in[21][((size_t)l * 1024 + i) * 16 + ch];
        const float vr = gre * br - gim * bi, vi = gre * bi + gim * br;
        const int sb = sidx >> 5, r = sidx & 31;
        bb[((g * 4 + sb * 2 + 0) * 32 + r) * 16 + ch] = f2bf(vr);
        bb[((g * 4 + sb * 2 + 1) * 32 + r) * 16 + ch] = f2bf(vi);
      }
    }
    for (size_t i = gtid; i < 1024 * 20; i += gn) {
      const int k = (int)(i / 20), n = (int)(i % 20);
      const float gk = p.in[37][l * D + k];
      ((float*)(wl + W_RT))[i] = gk * ((n < 4) ? p.in[38][((size_t)l * D + k) * 4 + n] : p.in[40][((size_t)l * D + k) * 16 + (n - 4)]);
    }
    for (size_t i = gtid; i < 16 * 16 * 64; i += gn) {
      const int g = (int)(i >> 10), ch = (int)((i >> 6) & 15), pp = (int)(i & 63);
      const float cr = p.in[22][(size_t)l * 16384 + i], ci = p.in[23][(size_t)l * 16384 + i];
      bf16_t* cm = (bf16_t*)(wl + W_S5CM) + ((size_t)(g * 16 + ch) * 128 + 2 * pp);
      cm[0] = f2bf(cr); cm[1] = f2bf(-ci);
    }
  }
  {
    const int* positions = (const int*)p.in[1];
    float2* RM = (float2*)(ws + WS_ROPE);
    float2* RN = RM + (size_t)T * 16;
    for (size_t i = gtid; i < (size_t)T * 24; i += gn) {
      const int t = (int)(i / 24), j = (int)(i % 24);
      const int rot = (j < 16) ? 32 : 16, fi = (j < 16) ? j : (j - 16);
      const float inv = powf(500000.f, -(2.f * (float)fi) / (float)rot);
      float sn, cs; sincosf((float)positions[t] * inv, &sn, &cs);
      if (j < 16) RM[(size_t)t * 16 + fi] = make_float2(cs, sn); else RN[(size_t)t * 8 + fi] = make_float2(cs, sn);
    }
  }
  rmsnorm_rows(p.in[0], p.in[2], (bf16_t*)(ws + WS_A));
}

DEVI void phase_g1(const Params& p, int l, unsigned char* lds) {
  const bf16_t* XN = (const bf16_t*)(p.ws + WS_A);
  const bf16_t* W = (const bf16_t*)(p.ws + WS_W + l * WS_WL + W_IN);
  bf16_t* PROJ = (bf16_t*)(p.ws + WS_B);
  constexpr int NT = DINP / 128;
  for (int it = blockIdx.x; it < (T / 128) * NT; it += gridDim.x) {
    const int mt = it / NT, nt = it % NT;
    f32x4 acc[4][4];
    gemm128(lds, D, [&](int r, int k) { return XN + (size_t)(mt * 128 + r) * D + k; }, [&](int r, int k) { return W + (size_t)(nt * 128 + r) * D + k; }, acc);
    GEMM_EPI4({ st_bf16x4(PROJ + (size_t)(mt * 128 + er) * DINP + nt * 128 + ec0, ev4); })
  }
}

DEVI void phase_r1(const Params& p, int l, unsigned char* lds) {
  const int lane = threadIdx.x & 63, wv = threadIdx.x >> 6, gw = blockIdx.x * 4 + wv, NGW = gridDim.x * 4;
  float* row = (float*)lds + wv * DINP;
  const bf16_t* PROJ = (const bf16_t*)(p.ws + WS_B);
  bf16_t* CQN = (bf16_t*)(p.ws + WS_C);
  bf16_t* CKVN = CQN + (size_t)T * 192;
  bf16_t* UB = CKVN + (size_t)T * 128;
  bf16_t* QN = (bf16_t*)(p.ws + WS_G);
  bf16_t* KS = QN + (size_t)T * 256;
  bf16_t* KW = KS + (size_t)T * 64;
  const float* g_cq = p.in[4] + l * 192; const float* g_ckv = p.in[5] + l * 128;
  const float* g_nq = p.in[27] + l * 64; const float* g_nk = p.in[28] + l * 192;
  const float* cw = p.in[10] + l * 4 * 256; const float* cb = p.in[11] + l * 256;
  const float2* RN = (const float2*)(p.ws + WS_ROPE) + (size_t)T * 16;
  for (int t = gw; t < T; t += NGW) {
    const int s = t & (S - 1);
    const bf16_t* pr = PROJ + (size_t)t * DINP;
    for (int i = lane; i < DINP / 2; i += 64) { const unsigned u = ((const unsigned*)pr)[i]; row[2 * i] = __uint_as_float(u << 16); row[2 * i + 1] = __uint_as_float(u & 0xffff0000u); }
    __builtin_amdgcn_s_waitcnt(0);
    __builtin_amdgcn_wave_barrier();
    { float ss = 0.f; for (int i = lane; i < 192; i += 64) ss += row[C_CQ + i] * row[C_CQ + i];
      const float rs = rsqrtf(wsum(ss) * (1.f / 192) + EPS);
      for (int i = lane; i < 192; i += 64) CQN[(size_t)t * 192 + i] = f2bf(row[C_CQ + i] * rs * g_cq[i]); }
    { float ss = 0.f; for (int i = lane; i < 128; i += 64) ss += row[C_CKV + i] * row[C_CKV + i];
      const float rs = rsqrtf(wsum(ss) * (1.f / 128) + EPS);
      for (int i = lane; i < 128; i += 64) CKVN[(size_t)t * 128 + i] = f2bf(row[C_CKV + i] * rs * g_ckv[i]); }
    {
      const int hd = lane >> 4, li = lane & 15;
      const float* q = row + C_NQ + hd * 64;
      float ss = 0.f;
#pragma unroll
      for (int i = 0; i < 4; ++i) ss += q[li + 16 * i] * q[li + 16 * i];
      ss += __shfl_xor(ss, 1); ss += __shfl_xor(ss, 2); ss += __shfl_xor(ss, 4); ss += __shfl_xor(ss, 8);
      const float rs = rsqrtf(ss * (1.f / 64) + EPS);
      const float sc = 0.125f * LOG2E;
#pragma unroll
      for (int i = 0; i < 4; ++i) {
        const int d = li + 16 * i; float v;
        if (d < 16) { const float2 cs2 = RN[(size_t)t * 8 + (d & 7)]; const float c = cs2.x, sn = cs2.y;
          const float x1 = q[d & 7] * rs * g_nq[d & 7], x2 = q[(d & 7) + 8] * rs * g_nq[(d & 7) + 8];
          v = (d < 8) ? (x1 * c - x2 * sn) : (x1 * sn + x2 * c);
        } else v = q[d] * rs * g_nq[d];
        QN[(size_t)t * 256 + hd * 64 + d] = f2bf(v * sc);
      }
    }
    {
      const int which = lane >> 5, li = lane & 31;
      const float* kk = row + C_NKV + (which ? 256 : 128);
      const float* g = g_nk + (which ? 128 : 64);
      float ss = kk[li] * kk[li] + kk[li + 32] * kk[li + 32];
      ss += __shfl_xor(ss, 1); ss += __shfl_xor(ss, 2); ss += __shfl_xor(ss, 4); ss += __shfl_xor(ss, 8); ss += __shfl_xor(ss, 16);
      const float rs = rsqrtf(ss * (1.f / 64) + EPS);
      bf16_t* dst = (which ? KW : KS) + (size_t)t * 64;
#pragma unroll
      for (int i = 0; i < 2; ++i) {
        const int d = li + 32 * i; float v;
        if (d < 16) { const float2 cs2 = RN[(size_t)t * 8 + (d & 7)]; const float c = cs2.x, sn = cs2.y;
          const float x1 = kk[d & 7] * rs * g[d & 7], x2 = kk[(d & 7) + 8] * rs * g[(d & 7) + 8];
          v = (d < 8) ? (x1 * c - x2 * sn) : (x1 * sn + x2 * c);
        } else v = kk[d] * rs * g[d];
        dst[d] = f2bf(v);
      }
    }
    for (int c = lane; c < 256; c += 64) {
      float u = cb[c];
#pragma unroll
      for (int j = 0; j < 4; ++j) { const int ss2 = s - 3 + j; if (ss2 >= 0) u += bf2f(PROJ[(size_t)(t - 3 + j) * DINP + C_LX + c]) * cw[j * 256 + c]; }
      UB[(size_t)t * 256 + c] = f2bf(u);
    }
    __builtin_amdgcn_wave_barrier();
  }
}

DEVI void phase_g2(const Params& p, int l, unsigned char* lds) {
  unsigned char* wl = p.ws + WS_W + l * WS_WL;
  const bf16_t* PROJ = (const bf16_t*)(p.ws + WS_B);
  const bf16_t* CQN = (const bf16_t*)(p.ws + WS_C);
  const bf16_t* CKVN = CQN + (size_t)T * 192;
  const bf16_t* UB = CKVN + (size_t)T * 128;
  bf16_t* QR = (bf16_t*)(p.ws + WS_D);
  bf16_t* KVR = QR + (size_t)T * 384;
  bf16_t* GATES = (bf16_t*)(p.ws + WS_E);
  constexpr int N_CMP = 32, N_QR = 256 * 3, N_KVR = 256 * 4, N_GT = 256 * 4;
  for (int it = blockIdx.x; it < N_CMP + N_QR + N_KVR + N_GT; it += gridDim.x) {
    f32x4 acc[4][4];
    if (it < N_CMP) {
      const int kv = it & 1, mt = it >> 1;
      const bf16_t* W = (const bf16_t*)(wl + (kv ? W_1V : W_1K));
      const float* bias = (const float*)(wl + (kv ? W_B1V : W_B1K));
      bf16_t* H = (bf16_t*)(p.ws + (kv ? SM_HV : SM_HK));
      gemm128(lds, 2048,
              [&](int r, int k) { const int m = mt * 128 + r, b = m >> 7; int c = m & 127; if (c > 126) c = 126;
                                  return PROJ + (size_t)(b * S + 16 * c + (k >> 6)) * DINP + C_NKV + kv * 64 + (k & 63); },
              [&](int r, int k) { return W + (size_t)r * 2048 + k; }, acc);
      GEMM_EPI4({ f32x4 o; _Pragma("unroll") for (int j = 0; j < 4; ++j) o[j] = gelu_tanh(ev4[j] + bias[ec0 + j]); st_bf16x4(H + (size_t)(mt * 128 + er) * 128 + ec0, o); })
    } else if (it < N_CMP + N_QR) {
      const int i2 = it - N_CMP, mt = i2 / 3, nt = i2 % 3;
      const bf16_t* W = (const bf16_t*)(wl + W_UQ);
      gemm128(lds, 192, [&](int r, int k) { return CQN + (size_t)(mt * 128 + r) * 192 + k; }, [&](int r, int k) { return W + (size_t)(nt * 128 + r) * 192 + k; }, acc);
      GEMM_EPI4({ st_bf16x4(QR + (size_t)(mt * 128 + er) * 384 + nt * 128 + ec0, ev4); })
    } else if (it < N_CMP + N_QR + N_KVR) {
      const int i2 = it - N_CMP - N_QR, mt = i2 >> 2, nt = i2 & 3;
      const bf16_t* W = (const bf16_t*)(wl + W_UKV);
      gemm128(lds, 128, [&](int r, int k) { return CKVN + (size_t)(mt * 128 + r) * 128 + k; }, [&](int r, int k) { return W + (size_t)(nt * 128 + r) * 128 + k; }, acc);
      GEMM_EPI4({ st_bf16x4(KVR + (size_t)(mt * 128 + er) * 512 + nt * 128 + ec0, ev4); })
    } else {
      const int i2 = it - N_CMP - N_QR - N_KVR, mt = i2 >> 2, h = i2 & 3;
      const bf16_t* W = (const bf16_t*)(wl + W_LRU) + h * 128 * 64;
      gemm128(lds, 64, [&](int r, int k) { return UB + (size_t)(mt * 128 + r) * 256 + h * 64 + k; }, [&](int r, int k) { return W + (size_t)r * 64 + k; }, acc);
      GEMM_EPI4({ st_bf16x4(GATES + (size_t)(mt * 128 + er) * 512 + h * 128 + ec0, ev4); })
    }
  }
}

DEVI void lru_ab(float u, float rpre, float ipre, float sp, bool first, float& a, float& b) {
  const float r = sigmoidf_(rpre), gi = sigmoidf_(ipre);
  const float la = -8.f * r * sp;
  a = expf(la);
  const float mult = first ? 1.f : sqrtf(fmaxf(-expm1f(2.f * la), 0.f));
  b = mult * gi * u;
}
DEVI float lru_conv(const bf16_t* PROJ, int t, int s, int c, const float* cw, float cb) {
  float u = cb;
#pragma unroll
  for (int j = 0; j < 4; ++j) { const int ss2 = s - 3 + j; if (ss2 >= 0) u += bf2f(PROJ[(size_t)(t - 3 + j) * DINP + C_LX + c]) * cw[j * 256 + c]; }
  return u;
}

template <bool FULL>
DEVI void s5_chunk(const Params& p, int l, int b, int chunk, unsigned char* lds) {
  unsigned char* wl = p.ws + WS_W + l * WS_WL;
  const bf16_t* PROJ = (const bf16_t*)(p.ws + WS_B);
  const float2* Abar = (const float2*)(wl + W_S5A);
  const bf16_t* BB = (const bf16_t*)(wl + W_S5BB);
  const bf16_t* CM = (const bf16_t*)(wl + W_S5CM);
  float2* SLOC = (float2*)(p.ws + SM_SLOC);
  bf16_t* YCP = (bf16_t*)(p.ws + WS_F);
  const float* dd = p.in[24] + l * 256;
  const int tid = threadIdx.x, wv = tid >> 6, lane = tid & 63, r = lane & 31, h = lane >> 5, fr = lane & 15, fq = lane >> 4;
  unsigned* Hs = (unsigned*)(lds + wv * 8704);
  const int t0 = b * S + chunk * 64;
#pragma unroll 1
  for (int gi = 0; gi < 4; ++gi) {
    const int g = wv * 4 + gi;
    bf16x8 bbf[4];
#pragma unroll
    for (int nb = 0; nb < 4; ++nb) bbf[nb] = *(const bf16x8*)(BB + ((g * 4 + nb) * 32 + r) * 16 + 8 * h);
    float2 Ac[2]; float hr[2], hi[2];
#pragma unroll
    for (int sb = 0; sb < 2; ++sb) {
      Ac[sb] = Abar[g * 64 + sb * 32 + r];
      hr[sb] = 0.f; hi[sb] = 0.f;
      if (FULL) { const float2 cin = ((const float2*)(p.ws + SM_SCAR))[((size_t)(b * 32 + chunk) * 16 + g) * 64 + sb * 32 + r]; hr[sb] = cin.x; hi[sb] = cin.y; }
    }
    bf16x8 cm[4];
    float dcol = 0.f;
    if (FULL) {
#pragma unroll
      for (int kk = 0; kk < 4; ++kk) cm[kk] = *(const bf16x8*)(CM + (size_t)(g * 16 + fr) * 128 + kk * 32 + 8 * fq);
      dcol = dd[g * 16 + fr];
    }
#pragma unroll 1
    for (int tb = 0; tb < 2; ++tb) {
      const bf16x8 ua = *(const bf16x8*)(PROJ + (size_t)(t0 + tb * 32 + r) * DINP + C_S5 + g * 16 + 8 * h);
      f32x16 acc[4];
#pragma unroll
      for (int nb = 0; nb < 4; ++nb) {
        f32x16 z;
#pragma unroll
        for (int i = 0; i < 16; ++i) z[i] = 0.f;
        acc[nb] = mfma32(ua, bbf[nb], z);
      }
#pragma unroll
      for (int sb = 0; sb < 2; ++sb) {
        float sr = hr[sb], si = hi[sb];
        const float ax = Ac[sb].x, ay = Ac[sb].y;
#pragma unroll
        for (int q = 0; q < 4; ++q)
#pragma unroll
          for (int owner = 0; owner < 2; ++owner) {
#pragma unroll
            for (int i = 0; i < 4; ++i) {
              const int reg = 4 * q + i;
              const float br = acc[2 * sb][reg], bi = acc[2 * sb + 1][reg];
              const float nr = ax * sr - ay * si + br, ni = ax * si + ay * sr + bi; sr = nr; si = ni;
              if (FULL) { acc[2 * sb][reg] = (h == owner) ? sr : br; acc[2 * sb + 1][reg] = (h == owner) ? si : bi; }
            }
            const float orr = __shfl_xor(sr, 32), oi = __shfl_xor(si, 32);
            if (h != owner) { sr = orr; si = oi; }
          }
        hr[sb] = sr; hi[sb] = si;
      }
      if (FULL) {
#pragma unroll
        for (int sb = 0; sb < 2; ++sb)
#pragma unroll
          for (int reg = 0; reg < 16; ++reg)
            Hs[crow(reg, h) * 68 + sb * 32 + r] = (unsigned)f2bf(acc[2 * sb][reg]) | ((unsigned)f2bf(acc[2 * sb + 1][reg]) << 16);
#pragma unroll
        for (int tb16 = 0; tb16 < 2; ++tb16) {
          f32x4 y = (f32x4){0.f, 0.f, 0.f, 0.f};
#pragma unroll
          for (int kk = 0; kk < 4; ++kk) { const bf16x8 a = *(const bf16x8*)((const bf16_t*)Hs + (tb16 * 16 + fr) * 136 + kk * 32 + 8 * fq); y = mfma16(a, cm[kk], y); }
#pragma unroll
          for (int j = 0; j < 4; ++j) {
            const size_t t = (size_t)t0 + tb * 32 + tb16 * 16 + fq * 4 + j; const int col = g * 16 + fr;
            const float val = y[j] + dcol * bf2f(PROJ[t * DINP + C_S5 + col]);
            YCP[t * 256 + col] = f2bf(gelu_tanh(val));
          }
        }
      }
    }
    if (!FULL) {
#pragma unroll
      for (int sb = 0; sb < 2; ++sb) if (h == 0) SLOC[((size_t)(b * 32 + chunk) * 16 + g) * 64 + sb * 32 + r] = make_float2(hr[sb], hi[sb]);
    }
  }
}

template <bool FULL>
DEVI void lru_chunk(const Params& p, int l, int b, int chunk, float* tile) {
  const bf16_t* PROJ = (const bf16_t*)(p.ws + WS_B);
  const bf16_t* GATES = (const bf16_t*)(p.ws + WS_E);
  float2* LSUM = (float2*)(p.ws + SM_LSUM);
  const int c = threadIdx.x, h = c >> 6, j = c & 63;
  const float* cw = p.in[10] + l * 4 * 256;
  const float w0 = cw[c], w1 = cw[256 + c], w2 = cw[512 + c], w3 = cw[768 + c], cb = p.in[11][l * 256 + c];
  const float ba = p.in[13][l * 256 + c], bi = p.in[15][l * 256 + c];
  const float sp = log1pf(expf(-p.in[16][l * 256 + c]));
  const int s0 = chunk * 64; const size_t t0 = (size_t)b * S + s0;
  float xm3 = 0.f, xm2 = 0.f, xm1 = 0.f;
  if (s0 > 0) { xm3 = bf2f(PROJ[(t0 - 3) * DINP + C_LX + c]); xm2 = bf2f(PROJ[(t0 - 2) * DINP + C_LX + c]); xm1 = bf2f(PROJ[(t0 - 1) * DINP + C_LX + c]); }
  float hh = 0.f, ap = 1.f;
  if (FULL) hh = ((const float*)(p.ws + SM_LCAR))[(size_t)(b * 32 + chunk) * 256 + c];
#pragma unroll 1
  for (int k0 = 0; k0 < 64; k0 += 8) {
    float xv[8], rp[8], ip[8], gt[8];
#pragma unroll
    for (int i = 0; i < 8; ++i) {
      const size_t t = t0 + k0 + i;
      xv[i] = bf2f(PROJ[t * DINP + C_LX + c]);
      rp[i] = bf2f(GATES[t * 512 + h * 128 + j]); ip[i] = bf2f(GATES[t * 512 + h * 128 + 64 + j]);
      gt[i] = FULL ? bf2f(PROJ[t * DINP + C_LG + c]) : 0.f;
    }
#pragma unroll
    for (int i = 0; i < 8; ++i) {
      const float u = cb + xm3 * w0 + xm2 * w1 + xm1 * w2 + xv[i] * w3;
      xm3 = xm2; xm2 = xm1; xm1 = xv[i];
      float a, bb; lru_ab(u, rp[i] + ba, ip[i] + bi, sp, (s0 + k0 + i) == 0, a, bb);
      hh = a * hh + bb; ap *= a;
      if (FULL) tile[(k0 + i) * 256 + c] = hh * gelu_tanh(gt[i]);
    }
  }
  if (!FULL) LSUM[(size_t)(b * 32 + chunk) * 256 + c] = make_float2(ap, hh);
}

DEVI void phase_r2(const Params& p, int l, unsigned char* lds) {
  unsigned char* wl = p.ws + WS_W + l * WS_WL;
  const bf16_t* PROJ = (const bf16_t*)(p.ws + WS_B);
  const bf16_t* QR = (const bf16_t*)(p.ws + WS_D);
  const bf16_t* KVR = QR + (size_t)T * 384;
  const bf16_t* GATES = (const bf16_t*)(p.ws + WS_E);
  bf16_t* MQ = (bf16_t*)(p.ws + WS_F);
  bf16_t* MK = MQ + (size_t)T * 4 * 96;
  const float2* RM = (const float2*)(p.ws + WS_ROPE);
  const float2* RN = RM + (size_t)T * 16;
  const int tid = threadIdx.x, lane = tid & 63, wv = tid >> 6;
  {
    const float* g_q = p.in[8] + l * 96; const float* g_k = p.in[9] + l * 96;
    float* row = (float*)lds + wv * 768;
    const int gw = blockIdx.x * 4 + wv, NGW = gridDim.x * 4;
    for (int t = gw; t < T; t += NGW) {
      const int b = t >> 11, s = t & (S - 1);
      for (int i = lane; i < 384; i += 64) row[i] = bf2f(QR[(size_t)t * 384 + i]);
      for (int i = lane; i < 384; i += 64) { const int h = i / 96, d = i % 96; row[384 + i] = (d < 32) ? bf2f(PROJ[(size_t)t * DINP + C_KPE + d]) : bf2f(KVR[(size_t)t * 512 + h * 128 + (d - 32)]); }
      __builtin_amdgcn_s_waitcnt(0);
      __builtin_amdgcn_wave_barrier();
      const int vec = lane >> 3, li = lane & 7;
      const float* v = row + vec * 96;
      const float* g = (vec < 4) ? g_q : g_k;
      float ss = 0.f;
#pragma unroll
      for (int i = 0; i < 12; ++i) ss += v[li + 8 * i] * v[li + 8 * i];
      ss += __shfl_xor(ss, 1); ss += __shfl_xor(ss, 2); ss += __shfl_xor(ss, 4);
      const float rs = rsqrtf(ss * (1.f / 96) + EPS);
      const float sc = (vec < 4) ? (0.10206207261596575f * LOG2E) : 1.f;
      bf16_t* dst = ((vec < 4) ? MQ : MK) + ((size_t)(b * 4 + (vec & 3)) * S + s) * 96;
#pragma unroll
      for (int i = 0; i < 12; ++i) {
        const int d = li + 8 * i; float o;
        if (d < 32) { const float2 cs2 = RM[(size_t)t * 16 + (d & 15)]; const float c = cs2.x, sn = cs2.y;
          const float x1 = v[d & 15] * rs * g[d & 15], x2 = v[(d & 15) + 16] * rs * g[(d & 15) + 16];
          o = (d < 16) ? (x1 * c - x2 * sn) : (x1 * sn + x2 * c);
        } else o = v[d] * rs * g[d];
        dst[d] = f2bf(o * sc);
      }
      __builtin_amdgcn_wave_barrier();
    }
  }
  for (int it = blockIdx.x; it < NB * 32; it += gridDim.x) lru_chunk<false>(p, l, it >> 5, it & 31, nullptr);
  __syncthreads();
  for (int it = blockIdx.x; it < NB * 32; it += gridDim.x) s5_chunk<false>(p, l, it >> 5, it & 31, lds);
  {
    const bf16_t* HK = (const bf16_t*)(p.ws + SM_HK); const bf16_t* HV = (const bf16_t*)(p.ws + SM_HV);
    bf16_t* KC = (bf16_t*)(p.ws + SM_KC); bf16_t* VC = (bf16_t*)(p.ws + SM_VC);
    const bf16_t* W2K = (const bf16_t*)(wl + W_2K); const bf16_t* W2V = (const bf16_t*)(wl + W_2V);
    const float* g0 = p.in[28] + l * 192;
    for (int it = blockIdx.x; it < 32; it += gridDim.x) {
      const int kv = it & 1, mt = it >> 1;
      const bf16_t* H = kv ? HV : HK; const bf16_t* W2 = kv ? W2V : W2K;
      f32x4 acc[4][4];
      __syncthreads();
      gemm128(lds, 128, [&](int r, int k) { return H + (size_t)(mt * 128 + r) * 128 + k; }, [&](int r, int k) { return W2 + (size_t)(r & 63) * 128 + k; }, acc);
      const int wid = tid >> 6, wr = wid >> 1, wc = wid & 1, fr = lane & 15, fq = lane >> 4;
      if (wc == 0) {
#pragma unroll
        for (int m = 0; m < 4; ++m) {
          const int row = mt * 128 + wr * 64 + m * 16 + fr, b = row >> 7, c = row & 127;
          f32x4 v[4];
#pragma unroll
          for (int n = 0; n < 4; ++n) v[n] = acc[m][n];
          if (kv == 0) {
            float ss = 0.f;
#pragma unroll
            for (int n = 0; n < 4; ++n) ss += v[n][0] * v[n][0] + v[n][1] * v[n][1] + v[n][2] * v[n][2] + v[n][3] * v[n][3];
            ss += __shfl_xor(ss, 16); ss += __shfl_xor(ss, 32);
            const float rs = rsqrtf(ss * (1.f / 64) + EPS);
#pragma unroll
            for (int n = 0; n < 4; ++n) { const float4 gg = *(const float4*)(g0 + n * 16 + fq * 4); v[n][0] *= rs * gg.x; v[n][1] *= rs * gg.y; v[n][2] *= rs * gg.z; v[n][3] *= rs * gg.w; }
            const int cc = (c < 127) ? c : 126;
            const float2* cs = RN + (size_t)(b * S + 16 * cc + 31) * 8;
#pragma unroll
            for (int j = 0; j < 4; ++j) {
              const float x = v[0][j], partner = __shfl_xor(x, 32);
              const int d = fq * 4 + j; const float2 cs2 = cs[d & 7];
              v[0][j] = (d < 8) ? (x * cs2.x - partner * cs2.y) : (partner * cs2.y + x * cs2.x);
            }
          }
          bf16_t* dst = (kv ? VC : KC) + (size_t)row * 64;
#pragma unroll
          for (int n = 0; n < 4; ++n) { f32x4 o = v[n]; if (c >= 127) o = (f32x4){0.f, 0.f, 0.f, 0.f}; st_bf16x4(dst + n * 16 + fq * 4, o); }
        }
      }
    }
  }
}

template <int DK>
DEVI void load_k_tile(bf16_t* sK, const bf16_t* kbase, size_t kstride, int key0) {
  constexpr int CH = DK / 8;
  for (int c = threadIdx.x; c < 64 * CH; c += NTHREADS) { const int r = c / CH, cc = c % CH; *(uint4*)(sK + r * (DK + 8) + cc * 8) = *(const uint4*)(kbase + (size_t)(key0 + r) * kstride + cc * 8); }
}
DEVI void load_v_tile_t(bf16_t* sVt, const bf16_t* vbase, size_t vstride, int key0) {
  for (int c = threadIdx.x; c < 512; c += NTHREADS) {
    const int r = c >> 3, cc = c & 7;
    const uint4 v = *(const uint4*)(vbase + (size_t)(key0 + r) * vstride + cc * 8);
    const unsigned w[4] = {v.x, v.y, v.z, v.w};
#pragma unroll
    for (int i = 0; i < 4; ++i) { sVt[(cc * 8 + 2 * i) * 72 + r] = (bf16_t)(w[i] & 0xffffu); sVt[(cc * 8 + 2 * i + 1) * 72 + r] = (bf16_t)(w[i] >> 16); }
  }
}
template <int DK>
DEVI void qk_tile(const bf16_t* sK, const bf16x8* qf, f32x16& s0, f32x16& s1, int r, int h) {
#pragma unroll
  for (int i = 0; i < 16; ++i) { s0[i] = 0.f; s1[i] = 0.f; }
#pragma unroll
  for (int kk = 0; kk < DK / 16; ++kk) {
    const bf16x8 a0 = *(const bf16x8*)(sK + r * (DK + 8) + kk * 16 + h * 8);
    const bf16x8 a1 = *(const bf16x8*)(sK + (32 + r) * (DK + 8) + kk * 16 + h * 8);
    s0 = mfma32(a0, qf[kk], s0);
    s1 = mfma32(a1, qf[kk], s1);
  }
}
struct FState { f32x16 o0, o1; float m, l; };
DEVI void fstate_init(FState& f) {
#pragma unroll
  for (int i = 0; i < 16; ++i) { f.o0[i] = 0.f; f.o1[i] = 0.f; }
  f.m = -INFINITY; f.l = 0.f;
}
DEVI void softmax_pv(FState& f, f32x16& s0, f32x16& s1, const bf16_t* sVt, int r, int h) {
  float mx = -INFINITY;
#pragma unroll
  for (int i = 0; i < 16; ++i) mx = fmaxf(mx, fmaxf(s0[i], s1[i]));
  mx = fmaxf(mx, __shfl_xor(mx, 32));
  const float mnew = fmaxf(f.m, mx);
  const float muse = (mnew == -INFINITY) ? 0.f : mnew;
  const float alpha = exp2f(f.m - muse);
  float ps = 0.f;
#pragma unroll
  for (int i = 0; i < 16; ++i) { s0[i] = exp2f(s0[i] - muse); s1[i] = exp2f(s1[i] - muse); ps += s0[i] + s1[i]; }
  ps += __shfl_xor(ps, 32);
  f.l = f.l * alpha + ps; f.m = mnew;
#pragma unroll
  for (int i = 0; i < 16; ++i) { f.o0[i] *= alpha; f.o1[i] *= alpha; }
#pragma unroll
  for (int kb = 0; kb < 2; ++kb)
#pragma unroll
    for (int s = 0; s < 2; ++s) {
      bf16x8 pb;
#pragma unroll
      for (int j = 0; j < 8; ++j) pb[j] = (short)f2bf(kb ? s1[8 * s + j] : s0[8 * s + j]);
      const int base = kb * 32 + 16 * s + 4 * h;
#pragma unroll
      for (int db = 0; db < 2; ++db) {
        const uint2 lo = *(const uint2*)(sVt + (db * 32 + r) * 72 + base);
        const uint2 hi = *(const uint2*)(sVt + (db * 32 + r) * 72 + base + 8);
        bf16x8 a;
        a[0] = (short)(lo.x & 0xffffu); a[1] = (short)(lo.x >> 16); a[2] = (short)(lo.y & 0xffffu); a[3] = (short)(lo.y >> 16);
        a[4] = (short)(hi.x & 0xffffu); a[5] = (short)(hi.x >> 16); a[6] = (short)(hi.y & 0xffffu); a[7] = (short)(hi.y >> 16);
        if (db == 0) f.o0 = mfma32(a, pb, f.o0); else f.o1 = mfma32(a, pb, f.o1);
      }
    }
}

DEVI void mla_item(const Params& p, int b, int hd, int qt, unsigned char* lds) {
  const bf16_t* MQ = (const bf16_t*)(p.ws + WS_F);
  const bf16_t* MK = MQ + (size_t)T * 4 * 96;
  const bf16_t* KVR = (const bf16_t*)(p.ws + WS_D) + (size_t)T * 384;
  bf16_t* YA = (bf16_t*)(p.ws + WS_C);
  const int tid = threadIdx.x, wv = tid >> 6, lane = tid & 63, r = lane & 31, h = lane >> 5;
  bf16_t* sK = (bf16_t*)lds;
  bf16_t* sVt = sK + 64 * 104;
  const int q0 = qt * 128 + wv * 32, tq = q0 + r;
  const bf16_t* qrow = MQ + ((size_t)(b * 4 + hd) * S + tq) * 96;
  bf16x8 qf[6];
#pragma unroll
  for (int kk = 0; kk < 6; ++kk) qf[kk] = *(const bf16x8*)(qrow + kk * 16 + h * 8);
  FState f; fstate_init(f);
  const bf16_t* kbase = MK + (size_t)(b * 4 + hd) * S * 96;
  const bf16_t* vbase = KVR + (size_t)b * S * 512 + hd * 128 + 64;
  const int ntiles = 2 * qt + 2;
  for (int kt = 0; kt < ntiles; ++kt) {
    __syncthreads();
    load_k_tile<96>(sK, kbase, 96, kt * 64);
    load_v_tile_t(sVt, vbase, 512, kt * 64);
    __syncthreads();
    if (kt * 64 <= q0 + 31) {
      f32x16 s0, s1;
      qk_tile<96>(sK, qf, s0, s1, r, h);
      if (kt * 64 + 63 > q0) {
#pragma unroll
        for (int i = 0; i < 16; ++i) { const int key = kt * 64 + crow(i, h); if (key > tq) s0[i] = -INFINITY; if (key + 32 > tq) s1[i] = -INFINITY; }
      }
      softmax_pv(f, s0, s1, sVt, r, h);
    }
  }
  const float inv = 1.f / f.l;
  bf16_t* orow = YA + (size_t)(b * S + tq) * 256 + hd * 64;
#pragma unroll
  for (int g = 0; g < 4; ++g) {
    ushort4 v0, v1;
    v0.x = f2bf(f.o0[4 * g] * inv); v0.y = f2bf(f.o0[4 * g + 1] * inv); v0.z = f2bf(f.o0[4 * g + 2] * inv); v0.w = f2bf(f.o0[4 * g + 3] * inv);
    v1.x = f2bf(f.o1[4 * g] * inv); v1.y = f2bf(f.o1[4 * g + 1] * inv); v1.z = f2bf(f.o1[4 * g + 2] * inv); v1.w = f2bf(f.o1[4 * g + 3] * inv);
    *(ushort4*)(orow + 8 * g + 4 * h) = v0;
    *(ushort4*)(orow + 32 + 8 * g + 4 * h) = v1;
  }
}

DEVI void nsa_item(const Params& p, int b, int qt, unsigned char* lds) {
  const bf16_t* PROJ = (const bf16_t*)(p.ws + WS_B);
  const bf16_t* QN = (const bf16_t*)(p.ws + WS_G);
  const bf16_t* KS = QN + (size_t)T * 256;
  const bf16_t* KW = KS + (size_t)T * 64;
  const bf16_t* KC = (const bf16_t*)(p.ws + SM_KC) + (size_t)b * 128 * 64;
  const bf16_t* VC = (const bf16_t*)(p.ws + SM_VC) + (size_t)b * 128 * 64;
  bf16_t* YD = (bf16_t*)(p.ws + WS_C) + (size_t)T * 256;
  const int tid = threadIdx.x, wv = tid >> 6, lane = tid & 63, r = lane & 31, h = lane >> 5;
  bf16_t* sK = (bf16_t*)lds;
  bf16_t* sVt = sK + 64 * 104;
  float* psum = (float*)(lds + 24576);
  unsigned* selm = (unsigned*)(lds + 24576 + 16384);
  const int t0 = qt * 32, cur = t0 >> 6;
  const int ql = wv * 8 + (r >> 2), hd = r & 3, tq = t0 + ql;
  const size_t tg = (size_t)b * S + tq;
  bf16x8 qf[4];
#pragma unroll
  for (int kk = 0; kk < 4; ++kk) qf[kk] = *(const bf16x8*)(QN + tg * 256 + hd * 64 + kk * 16 + h * 8);
  f32x16 of0, of1;
#pragma unroll
  for (int i = 0; i < 16; ++i) { of0[i] = 0.f; of1[i] = 0.f; }
  const float g0 = sigmoidf_(bf2f(PROJ[tg * DINP + C_NG + hd * 3 + 0]));
  const float g1 = sigmoidf_(bf2f(PROJ[tg * DINP + C_NG + hd * 3 + 1]));
  const float g2 = sigmoidf_(bf2f(PROJ[tg * DINP + C_NG + hd * 3 + 2]));
  FState f; fstate_init(f);
  for (int kt = 0; kt < 2; ++kt) {
    __syncthreads();
    load_k_tile<64>(sK, KC, 64, kt * 64);
    load_v_tile_t(sVt, VC, 64, kt * 64);
    __syncthreads();
    f32x16 s0, s1;
    qk_tile<64>(sK, qf, s0, s1, r, h);
#pragma unroll
    for (int i = 0; i < 16; ++i) { const int c = kt * 64 + crow(i, h); if (16 * c + 31 > tq) s0[i] = -INFINITY; if (16 * (c + 32) + 31 > tq) s1[i] = -INFINITY; }
    softmax_pv(f, s0, s1, sVt, r, h);
  }
  {
    const float sc = (f.l > 0.f) ? g0 / f.l : 0.f;
#pragma unroll
    for (int i = 0; i < 16; ++i) { of0[i] += f.o0[i] * sc; of1[i] += f.o1[i] * sc; }
  }
  {
    const float muse = (f.m == -INFINITY) ? 0.f : f.m;
    const float il = (f.l > 0.f) ? 1.f / f.l : 0.f;
    for (int kt = 0; kt < 2; ++kt) {
      __syncthreads();
      load_k_tile<64>(sK, KC, 64, kt * 64);
      __syncthreads();
      f32x16 s0, s1;
      qk_tile<64>(sK, qf, s0, s1, r, h);
#pragma unroll
      for (int i = 0; i < 16; ++i) {
        const int c = kt * 64 + crow(i, h);
        float p0 = (16 * c + 31 > tq) ? 0.f : exp2f(s0[i] - muse) * il;
        float p1 = (16 * (c + 32) + 31 > tq) ? 0.f : exp2f(s1[i] - muse) * il;
        p0 += __shfl_xor(p0, 1); p0 += __shfl_xor(p0, 2);
        p1 += __shfl_xor(p1, 1); p1 += __shfl_xor(p1, 2);
        if (hd == 0) { psum[ql * 128 + c] = p0; psum[ql * 128 + c + 32] = p1; }
      }
    }
  }
  __syncthreads();
#pragma unroll 1
  for (int itq = 0; itq < 4; ++itq) {
    const int q2 = wv * 8 + itq * 2 + (lane >> 5), j = lane & 31;
    const float* ps = psum + q2 * 128;
    float imp = 2.f * (ps[4 * j] + ps[4 * j + 1] + ps[4 * j + 2]) + ps[4 * j + 3];
    if (j > 0) imp += ps[4 * j - 1];
    const bool cand = (j >= 1) && (j <= cur - 2);
    int rank = 0;
    for (int jj = 0; jj < 32; ++jj) {
      const float v = __shfl(imp, (lane & 32) | jj);
      const bool cj = (jj >= 1) && (jj <= cur - 2);
      if (cj && (v > imp || (v == imp && jj < j))) ++rank;
    }
    const bool sel = cand && rank < 2;
    const unsigned long long bal = __ballot(sel);
    unsigned mk = (unsigned)(bal >> (32 * (lane >> 5)));
    mk |= 1u | (1u << cur); if (cur >= 1) mk |= (1u << (cur - 1));
    if (j == 0) selm[q2] = mk;
  }
  __syncthreads();
  unsigned blk_or = 0, wave_or = 0;
  for (int i = 0; i < 32; ++i) blk_or |= selm[i];
  for (int i = 0; i < 8; ++i) wave_or |= selm[wv * 8 + i];
  const unsigned mymask = selm[ql];
  fstate_init(f);
  {
    const bf16_t* kb = KS + (size_t)b * S * 64;
    const bf16_t* vb = PROJ + (size_t)b * S * DINP + C_NKV + 192;
    for (int j = 0; j <= cur; ++j) {
      if (!((blk_or >> j) & 1u)) continue;
      __syncthreads();
      load_k_tile<64>(sK, kb, 64, j * 64);
      load_v_tile_t(sVt, vb, DINP, j * 64);
      __syncthreads();
      if ((wave_or >> j) & 1u) {
        f32x16 s0, s1;
        qk_tile<64>(sK, qf, s0, s1, r, h);
        const bool on = (mymask >> j) & 1u;
#pragma unroll
        for (int i = 0; i < 16; ++i) { const int key = j * 64 + crow(i, h); if (!on || key > tq) s0[i] = -INFINITY; if (!on || key + 32 > tq) s1[i] = -INFINITY; }
        softmax_pv(f, s0, s1, sVt, r, h);
      }
    }
    const float sc = (f.l > 0.f) ? g1 / f.l : 0.f;
#pragma unroll
    for (int i = 0; i < 16; ++i) { of0[i] += f.o0[i] * sc; of1[i] += f.o1[i] * sc; }
  }
  fstate_init(f);
  {
    const bf16_t* kb = KW + (size_t)b * S * 64;
    const bf16_t* vb = PROJ + (size_t)b * S * DINP + C_NKV + 320;
    int jlo = (t0 - 511) >> 6; if (jlo < 0) jlo = 0;
    for (int j = jlo; j <= cur; ++j) {
      __syncthreads();
      load_k_tile<64>(sK, kb, 64, j * 64);
      load_v_tile_t(sVt, vb, DINP, j * 64);
      __syncthreads();
      f32x16 s0, s1;
      qk_tile<64>(sK, qf, s0, s1, r, h);
#pragma unroll
      for (int i = 0; i < 16; ++i) {
        const int key = j * 64 + crow(i, h);
        if (key > tq || tq - key >= 512) s0[i] = -INFINITY;
        if (key + 32 > tq || tq - key - 32 >= 512) s1[i] = -INFINITY;
      }
      softmax_pv(f, s0, s1, sVt, r, h);
    }
    const float sc = (f.l > 0.f) ? g2 / f.l : 0.f;
#pragma unroll
    for (int i = 0; i < 16; ++i) { of0[i] += f.o0[i] * sc; of1[i] += f.o1[i] * sc; }
  }
  bf16_t* orow = YD + tg * 256 + hd * 64;
#pragma unroll
  for (int g = 0; g < 4; ++g) {
    ushort4 v0, v1;
    v0.x = f2bf(of0[4 * g]); v0.y = f2bf(of0[4 * g + 1]); v0.z = f2bf(of0[4 * g + 2]); v0.w = f2bf(of0[4 * g + 3]);
    v1.x = f2bf(of1[4 * g]); v1.y = f2bf(of1[4 * g + 1]); v1.z = f2bf(of1[4 * g + 2]); v1.w = f2bf(of1[4 * g + 3]);
    *(ushort4*)(orow + 8 * g + 4 * h) = v0;
    *(ushort4*)(orow + 32 + 8 * g + 4 * h) = v1;
  }
}
DEVI void carry_item(const Params& p, int l, int it) {
  const int tid = threadIdx.x;
  if (it < 64) {
    const int idx = it * 256 + tid, b = idx >> 10, gs = idx & 1023;
    const float2 a64 = ((const float2*)(p.ws + WS_W + l * WS_WL + W_S5A64))[gs];
    const float2* SLOC = (const float2*)(p.ws + SM_SLOC) + (size_t)b * 32 * 1024 + gs;
    float2* SCAR = (float2*)(p.ws + SM_SCAR) + (size_t)b * 32 * 1024 + gs;
    float hr = 0.f, hi = 0.f;
#pragma unroll 1
    for (int c0 = 0; c0 < 32; c0 += 8) {
      float2 sl[8];
#pragma unroll
      for (int i = 0; i < 8; ++i) sl[i] = SLOC[(size_t)(c0 + i) * 1024];
#pragma unroll
      for (int i = 0; i < 8; ++i) { SCAR[(size_t)(c0 + i) * 1024] = make_float2(hr, hi); const float nr = a64.x * hr - a64.y * hi + sl[i].x, ni = a64.x * hi + a64.y * hr + sl[i].y; hr = nr; hi = ni; }
    }
  } else {
    const int idx = (it - 64) * 256 + tid, b = idx >> 8, c = idx & 255;
    const float2* LSUM = (const float2*)(p.ws + SM_LSUM) + (size_t)b * 32 * 256 + c;
    float* LCAR = (float*)(p.ws + SM_LCAR) + (size_t)b * 32 * 256 + c;
    float hh = 0.f;
#pragma unroll 1
    for (int c0 = 0; c0 < 32; c0 += 8) {
      float2 sv[8];
#pragma unroll
      for (int i = 0; i < 8; ++i) sv[i] = LSUM[(size_t)(c0 + i) * 256];
#pragma unroll
      for (int i = 0; i < 8; ++i) { LCAR[(size_t)(c0 + i) * 256] = hh; hh = sv[i].x * hh + sv[i].y; }
    }
  }
}
DEVI void phase_a1(const Params& p, int l, unsigned char* lds) {
  for (int it = blockIdx.x; it < 80; it += gridDim.x) carry_item(p, l, it);
  for (int it = blockIdx.x; it < 2048; it += gridDim.x) {
    const int j = it >> 1;
    if (it & 1) { const int qt = 63 - (j >> 4), b = j & 15; nsa_item(p, b, qt, lds); }
    else { const int qt = 15 - (j >> 6), bh = j & 63; mla_item(p, bh >> 2, bh & 3, qt, lds); }
  }
}

DEVI void phase_r3(const Params& p, int l, unsigned char* lds) {
  bf16_t* Y = (bf16_t*)(p.ws + WS_A);
  const int tid = threadIdx.x, lane = tid & 63, wv = tid >> 6;
  {
    const float* onorm = p.in[35] + l * 1024 + 256;
    float* tile = (float*)lds;
    for (int it = blockIdx.x; it < NB * 32; it += gridDim.x) {
      const int b = it >> 5, chunk = it & 31;
      __syncthreads();
      lru_chunk<true>(p, l, b, chunk, tile);
      __syncthreads();
      for (int k = wv; k < 64; k += 4) {
        float v[4], ss = 0.f;
#pragma unroll
        for (int i = 0; i < 4; ++i) { v[i] = tile[k * 256 + lane + 64 * i]; ss += v[i] * v[i]; }
        const float rs = rsqrtf(wsum(ss) * (1.f / 256) + EPS);
        const size_t t = (size_t)b * S + chunk * 64 + k;
#pragma unroll
        for (int i = 0; i < 4; ++i) Y[t * 1024 + 256 + lane + 64 * i] = f2bf(v[i] * rs * onorm[lane + 64 * i]);
      }
    }
  }
  __syncthreads();
  for (int it = blockIdx.x; it < NB * 32; it += gridDim.x) s5_chunk<true>(p, l, it >> 5, it & 31, lds);
}

DEVI void phase_g3(const Params& p, int l, unsigned char* lds) {
  const bf16_t* YCP = (const bf16_t*)(p.ws + WS_F);
  bf16_t* YC = (bf16_t*)(p.ws + WS_F) + (size_t)T * 256;
  const bf16_t* W = (const bf16_t*)(p.ws + WS_W + l * WS_WL + W_GLU);
  const float* bg = p.in[26] + l * 256;
  for (int it = blockIdx.x; it < 256 * 2; it += gridDim.x) {
    const int mt = it >> 1, nt = it & 1;
    f32x4 acc[4][4];
    gemm128(lds, 256, [&](int r, int k) { return YCP + (size_t)(mt * 128 + r) * 256 + k; }, [&](int r, int k) { return W + (size_t)(nt * 128 + r) * 256 + k; }, acc);
    GEMM_EPI4({ const size_t o = (size_t)(mt * 128 + er) * 256 + nt * 128 + ec0; const ushort4 yp = *(const ushort4*)(YCP + o); f32x4 r4; r4[0] = bf2f(yp.x) * sigmoidf_(ev4[0] + bg[nt * 128 + ec0]); r4[1] = bf2f(yp.y) * sigmoidf_(ev4[1] + bg[nt * 128 + ec0 + 1]); r4[2] = bf2f(yp.z) * sigmoidf_(ev4[2] + bg[nt * 128 + ec0 + 2]); r4[3] = bf2f(yp.w) * sigmoidf_(ev4[3] + bg[nt * 128 + ec0 + 3]); st_bf16x4(YC + o, r4); })
  }
}

DEVI void phase_r4(const Params& p, int l) {
  const bf16_t* YA = (const bf16_t*)(p.ws + WS_C);
  const bf16_t* YD = YA + (size_t)T * 256;
  const bf16_t* YC = (const bf16_t*)(p.ws + WS_F) + (size_t)T * 256;
  bf16_t* Y = (bf16_t*)(p.ws + WS_A);
  const float* onorm = p.in[35] + l * 1024;
  const int lane = threadIdx.x & 63, gw = blockIdx.x * 4 + (threadIdx.x >> 6), NGW = gridDim.x * 4;
  for (int t = gw; t < T; t += NGW) {
#pragma unroll
    for (int grp = 0; grp < 3; ++grp) {
      const bf16_t* src = (grp == 0 ? YA : (grp == 1 ? YC : YD)) + (size_t)t * 256;
      const int gcol = (grp == 0 ? 0 : (grp == 1 ? 512 : 768));
      const ushort4 u = ((const ushort4*)src)[lane];
      const float v0 = bf2f(u.x), v1 = bf2f(u.y), v2 = bf2f(u.z), v3 = bf2f(u.w);
      const float rs = rsqrtf(wsum(v0 * v0 + v1 * v1 + v2 * v2 + v3 * v3) * (1.f / 256) + EPS);
      const float4 g = ((const float4*)(onorm + gcol))[lane];
      ushort4 o; o.x = f2bf(v0 * rs * g.x); o.y = f2bf(v1 * rs * g.y); o.z = f2bf(v2 * rs * g.z); o.w = f2bf(v3 * rs * g.w);
      ((ushort4*)(Y + (size_t)t * 1024 + gcol))[lane] = o;
    }
  }
}

DEVI void phase_g4(const Params& p, int l, unsigned char* lds) {
  const bf16_t* Y = (const bf16_t*)(p.ws + WS_A);
  const bf16_t* W = (const bf16_t*)(p.ws + WS_W + l * WS_WL + W_OUT);
  const float* xin = (l == 0) ? p.in[0] : p.out;
  float* out = p.out;
  for (int it = blockIdx.x; it < 256 * 8; it += gridDim.x) {
    const int mt = it >> 3, nt = it & 7;
    f32x4 acc[4][4];
    gemm128(lds, D, [&](int r, int k) { return Y + (size_t)(mt * 128 + r) * D + k; }, [&](int r, int k) { return W + (size_t)(nt * 128 + r) * D + k; }, acc);
    GEMM_EPI4({ const size_t o = (size_t)(mt * 128 + er) * D + nt * 128 + ec0; const f32x4 xi = *(const f32x4*)(xin + o); *(f32x4*)(out + o) = xi + ev4; })
  }
}

DEVI void phase_r5(const Params& p, int l, unsigned char* lds) {
  const float* x1 = p.out;
  bf16_t* XN = (bf16_t*)(p.ws + WS_A);
  const float* g = p.in[37] + l * D;
  const float* WR = (const float*)(p.ws + WS_W + l * WS_WL + W_RT);
  const float* brg = p.in[39] + l * 4; const float* bre = p.in[41] + l * 16;
  int* CNT = (int*)(p.ws + SM_CNT) + l * 32;
  int* LIST = (int*)(p.ws + SM_LIST);
  float2* TOKW = (float2*)(p.ws + SM_TOKW);
  const int tid = threadIdx.x, lane = tid & 63, wv = __builtin_amdgcn_readfirstlane(tid >> 6);
  float* xt = (float*)lds + wv * (64 * 33);
  float* red = (float*)(lds + 4 * 64 * 33 * 4);
  float* rsv = red + 4 * 64 * 21;
  for (int it = blockIdx.x; it < T / 64; it += gridDim.x) {
    const size_t tb = (size_t)it * 64;
    float acc[20]; float ss = 0.f;
#pragma unroll
    for (int n = 0; n < 20; ++n) acc[n] = 0.f;
    __syncthreads();
#pragma unroll 1
    for (int kc = 0; kc < 8; ++kc) {
      const int k0 = wv * 256 + kc * 32;
      float4 v[8];
#pragma unroll
      for (int i = 0; i < 8; ++i) { const int idx = lane + 64 * i, r = idx >> 3, c4 = idx & 7; v[i] = *(const float4*)(x1 + (tb + r) * D + k0 + c4 * 4); }
#pragma unroll
      for (int i = 0; i < 8; ++i) { const int idx = lane + 64 * i, r = idx >> 3, c4 = idx & 7; float* d = xt + r * 33 + c4 * 4; d[0] = v[i].x; d[1] = v[i].y; d[2] = v[i].z; d[3] = v[i].w; }
      __builtin_amdgcn_wave_barrier();
#pragma unroll 4
      for (int kk = 0; kk < 32; ++kk) {
        const float xv = xt[lane * 33 + kk];
        ss += xv * xv;
        const float* wr = WR + (size_t)(k0 + kk) * 20;
#pragma unroll
        for (int n = 0; n < 20; ++n) acc[n] += xv * wr[n];
      }
      __builtin_amdgcn_wave_barrier();
    }
#pragma unroll
    for (int n = 0; n < 20; ++n) red[(wv * 64 + lane) * 21 + n] = acc[n];
    red[(wv * 64 + lane) * 21 + 20] = ss;
    __syncthreads();
    if (wv == 0) {
      float lg[20]; float s2 = 0.f;
#pragma unroll
      for (int n = 0; n < 20; ++n) lg[n] = red[lane * 21 + n] + red[(64 + lane) * 21 + n] + red[(128 + lane) * 21 + n] + red[(192 + lane) * 21 + n];
      s2 = red[lane * 21 + 20] + red[(64 + lane) * 21 + 20] + red[(128 + lane) * 21 + 20] + red[(192 + lane) * 21 + 20];
      const float rs = rsqrtf(s2 * (1.f / D) + EPS);
      rsv[lane] = rs;
      const int t = (int)tb + lane;
      float gl[4];
#pragma unroll
      for (int q = 0; q < 4; ++q) gl[q] = lg[q] * rs + brg[q];
      int gi = 0; float gbest = gl[0];
#pragma unroll
      for (int q = 1; q < 4; ++q) if (gl[q] > gbest) { gbest = gl[q]; gi = q; }
      float den = 0.f;
#pragma unroll
      for (int q = 0; q < 4; ++q) den += expf(gl[q] - gbest);
      const float pg = 1.f / den;
      float le[4];
#pragma unroll
      for (int q = 0; q < 4; ++q) { float sel = 0.f;
#pragma unroll
        for (int gg2 = 0; gg2 < 4; ++gg2) sel = (gi == gg2) ? (lg[4 + gg2 * 4 + q] * rs + bre[gg2 * 4 + q]) : sel;
        le[q] = sel; }
      int i0 = 0; float l0 = le[0];
#pragma unroll
      for (int q = 1; q < 4; ++q) if (le[q] > l0) { l0 = le[q]; i0 = q; }
      int i1 = -1; float l1 = -INFINITY;
#pragma unroll
      for (int q = 0; q < 4; ++q) if (q != i0 && le[q] > l1) { l1 = le[q]; i1 = q; }
      const float e1 = expf(l1 - l0);
      const float w0 = pg / (1.f + e1), w1 = pg * e1 / (1.f + e1);
      const int elo = (i0 < i1) ? i0 : i1, ehi = (i0 < i1) ? i1 : i0;
      const float wlo = (i0 < i1) ? w0 : w1, whi = (i0 < i1) ? w1 : w0;
      const int pidx = (elo == 0) ? (ehi - 1) : ((elo == 1) ? (ehi + 1) : 5);
      const int cls = gi * 6 + pidx;
      const int slot = atomicAdd(&CNT[cls], 1);
      LIST[(size_t)cls * T + slot] = t;
      TOKW[t] = make_float2(wlo, whi);
    }
    __syncthreads();
#pragma unroll 1
    for (int r = wv * 16; r < wv * 16 + 16; ++r) {
      const float rs = rsv[r];
      const float4* xr = (const float4*)(x1 + (tb + r) * D);
#pragma unroll
      for (int j = 0; j < 4; ++j) {
        const float4 v = xr[lane + 64 * j]; const float4 gg = ((const float4*)g)[lane + 64 * j];
        ushort4 o; o.x = f2bf(v.x * rs * gg.x); o.y = f2bf(v.y * rs * gg.y); o.z = f2bf(v.z * rs * gg.z); o.w = f2bf(v.w * rs * gg.w);
        ((ushort4*)(XN + (tb + r) * D))[lane + 64 * j] = o;
      }
    }
  }
}

struct MoeItem { int cls, mtile, nt, cnt; };
DEVI void moe_prefix(const int* CNT, unsigned char* lds) {
  int* pre = (int*)(lds + LDS_BYTES + 64);
  __syncthreads();
  if (threadIdx.x < 24) pre[32 + threadIdx.x] = CNT[threadIdx.x];
  __syncthreads();
  if (threadIdx.x == 0) { int a = 0; for (int c = 0; c < 24; ++c) { pre[c] = a; a += (pre[32 + c] + 127) >> 7; } pre[24] = a; }
  __syncthreads();
}
DEVI bool moe_item(unsigned char* lds, int it, MoeItem& m) {
  const int* pre = (const int*)(lds + LDS_BYTES + 64);
  const int mt = it >> 3; m.nt = it & 7;
  if (mt >= pre[24]) return false;
  int c = 0;
#pragma unroll
  for (int q = 1; q < 24; ++q) c += (mt >= pre[q]) ? 1 : 0;
  m.cls = c; m.mtile = mt - pre[c]; m.cnt = pre[32 + c];
  return true;
}
DEVI void cls_experts(int cls, int& e0, int& e1) {
  const int g = cls / 6, pi = cls % 6;
  const int lo = (pi < 3) ? 0 : ((pi < 5) ? 1 : 2);
  const int hi = (pi < 3) ? (pi + 1) : ((pi < 5) ? (pi - 1) : 3);
  e0 = g * 4 + lo; e1 = g * 4 + hi;
}
DEVI void phase_g5(const Params& p, int l, unsigned char* lds) {
  const bf16_t* XN = (const bf16_t*)(p.ws + WS_A);
  bf16_t* HID = (bf16_t*)(p.ws + WS_B);
  const bf16_t* WGU = (const bf16_t*)(p.ws + WS_W + l * WS_WL + W_GU);
  const int* CNT = (const int*)(p.ws + SM_CNT) + l * 32;
  const int* LIST = (const int*)(p.ws + SM_LIST);
  const float2* TOKW = (const float2*)(p.ws + SM_TOKW);
  moe_prefix(CNT, lds);
  for (int it = blockIdx.x;; it += gridDim.x) {
    MoeItem mi; if (!moe_item(lds, it, mi)) break;
    int e0, e1; cls_experts(mi.cls, e0, e1);
    const int ex = (mi.nt < 4) ? e0 : e1, ntl = mi.nt & 3;
    const bf16_t* W = WGU + ((size_t)ex * 512 + ntl * 128) * 1024;
    const int* list = LIST + (size_t)mi.cls * T + mi.mtile * 128;
    const int nvalid = mi.cnt - mi.mtile * 128;
    f32x4 acc[4][4];
    gemm128(lds, D, [&](int r, int k) { const int tok = (r < nvalid) ? list[r] : list[0]; return XN + (size_t)tok * D + k; }, [&](int r, int k) { return W + (size_t)r * D + k; }, acc);
    {
      const int tid = threadIdx.x, wid = tid >> 6, lane = tid & 63, wr = wid >> 1, wc = wid & 1, fr = lane & 15, fq = lane >> 4;
#pragma unroll
      for (int m = 0; m < 4; ++m) {
        const int er = wr * 64 + m * 16 + fr;
        if (er < nvalid) {
          const int tok = list[er];
          const float2 tw = TOKW[tok];
          const float w = (mi.nt < 4) ? tw.x : tw.y;
#pragma unroll
          for (int n = 0; n < 2; ++n) {
            f32x4 hv;
#pragma unroll
            for (int j = 0; j < 4; ++j) { const float gt = acc[m][n][j], up = acc[m][n + 2][j]; hv[j] = gt * sigmoidf_(gt) * up * w; }
            const int hh = (mi.nt < 4 ? 0 : 256) + ntl * 64 + wc * 32 + n * 16 + fq * 4;
            st_bf16x4(HID + (size_t)tok * 512 + hh, hv);
          }
        }
      }
    }
  }
}
DEVI void phase_g6(const Params& p, int l, unsigned char* lds) {
  const bf16_t* HID = (const bf16_t*)(p.ws + WS_B);
  const bf16_t* WDN = (const bf16_t*)(p.ws + WS_W + l * WS_WL + W_DN);
  const int* CNT = (const int*)(p.ws + SM_CNT) + l * 32;
  const int* LIST = (const int*)(p.ws + SM_LIST);
  float* out = p.out;
  moe_prefix(CNT, lds);
  for (int it = blockIdx.x;; it += gridDim.x) {
    MoeItem mi; if (!moe_item(lds, it, mi)) break;
    int e0, e1; cls_experts(mi.cls, e0, e1);
    const int* list = LIST + (size_t)mi.cls * T + mi.mtile * 128;
    const int nvalid = mi.cnt - mi.mtile * 128;
    const bf16_t* W0 = WDN + ((size_t)e0 * 1024 + mi.nt * 128) * 256;
    const bf16_t* W1 = WDN + ((size_t)e1 * 1024 + mi.nt * 128) * 256;
    f32x4 acc[4][4];
    gemm128(lds, 512, [&](int r, int k) { const int tok = (r < nvalid) ? list[r] : list[0]; return HID + (size_t)tok * 512 + k; },
            [&](int r, int k) { return ((k < 256) ? W0 : W1) + (size_t)r * 256 + (k & 255); }, acc);
    GEMM_EPI4({ if (er < nvalid) { const size_t o = (size_t)list[er] * D + mi.nt * 128 + ec0; const f32x4 xi = *(const f32x4*)(out + o); *(f32x4*)(out + o) = xi + ev4; } })
  }
}


#define XB_TMO      128
#define XB_XCNT(j)  (256  + 64 * (j))
#define XB_XSUB(j)  (1280 + 64 * (j))
#define XB_XGEN(j)  (2304 + 64 * (j))
#define XB_TOP      3328
#define XB_TOPGEN   3392
#define XCD_BAR_WORDS 3456
#define XB_SPIN_CAP (1u << 18)
DEVI unsigned xb_ld(unsigned* p)              { return __hip_atomic_load(p, __ATOMIC_RELAXED, __HIP_MEMORY_SCOPE_AGENT); }
DEVI unsigned xb_add(unsigned* p, unsigned v) { return __hip_atomic_fetch_add(p, v, __ATOMIC_RELAXED, __HIP_MEMORY_SCOPE_AGENT); }
DEVI unsigned xb_xcc_id() { return (unsigned)__builtin_amdgcn_s_getreg((3 << 11) | 20) & 0xFu; }
#define XB_SPIN(cond, bar) do { unsigned _sp = 0; while (cond) { __builtin_amdgcn_s_sleep(1); \
    if ((++_sp & 255u) == 0u) { if (xb_ld(&(bar)[XB_TMO])) break; if (_sp > XB_SPIN_CAP) { atomicAdd(&(bar)[XB_TMO], 1u); break; } } } } while (0)
struct XcdBarrier { unsigned* bar; unsigned x; volatile LAS unsigned* st; };
DEVI XcdBarrier xcd_barrier_post(unsigned* bar, volatile LAS unsigned* st) {
    XcdBarrier b; b.bar = bar; b.x = xb_xcc_id(); b.st = st;
    if (threadIdx.x == 0) (void)xb_add(&bar[XB_XCNT(b.x)], 1u);
    return b;
}
DEVI void xcd_barrier_complete(unsigned* bar, unsigned x, unsigned& nloc, unsigned& nx) {
    const unsigned G = gridDim.x * gridDim.y * gridDim.z;
    unsigned sum, cnt, mine, sp = 0u;
    for (;;) {
        sum = 0u; cnt = 0u; mine = 0u;
#pragma unroll
        for (unsigned j = 0; j < 16; ++j) { const unsigned c = xb_ld(&bar[XB_XCNT(j)]); sum += c; cnt += (c > 0u) ? 1u : 0u; mine = (j == x) ? c : mine; }
        if (sum == G) break;
        __builtin_amdgcn_s_sleep(1);
        if ((++sp & 255u) == 0u) { if (xb_ld(&bar[XB_TMO])) break; if (sp > XB_SPIN_CAP) { atomicAdd(&bar[XB_TMO], 1u); break; } }
    }
    nloc = mine > 0u ? mine : 1u; nx = cnt > 0u ? cnt : 1u;
}
DEVI void xcd_barrier(const XcdBarrier& b) {
    asm volatile("s_waitcnt vmcnt(0)" ::: "memory");
    __syncthreads();
    if (threadIdx.x == 0) {
        unsigned* bar = b.bar;
        __builtin_amdgcn_s_waitcnt(0);
        unsigned nloc = b.st[0], nx = b.st[1];
        if (nloc == 0u) { xcd_barrier_complete(bar, b.x, nloc, nx); b.st[0] = nloc; b.st[1] = nx; }
        const unsigned old = xb_add(&bar[XB_XSUB(b.x)], 1u);
        const unsigned gen = old / nloc;
        if (old + 1u == (gen + 1u) * nloc) {
            __builtin_amdgcn_fence(__ATOMIC_RELEASE, "agent");
            asm volatile("s_waitcnt vmcnt(0)" ::: "memory");
            const unsigned og = xb_add(&bar[XB_TOP], 1u);
            const unsigned tg = og / nx;
            if (og + 1u == (tg + 1u) * nx) xb_add(&bar[XB_TOPGEN], 1u);
            else XB_SPIN(xb_ld(&bar[XB_TOPGEN]) == tg, bar);
            __builtin_amdgcn_fence(__ATOMIC_ACQUIRE, "agent");
            xb_add(&bar[XB_XGEN(b.x)], 1u);
            asm volatile("s_waitcnt vmcnt(0)" ::: "memory");
        } else {
            XB_SPIN(xb_ld(&bar[XB_XGEN(b.x)]) == gen, bar);
            __builtin_amdgcn_fence(__ATOMIC_ACQUIRE, "agent");
            asm volatile("s_waitcnt vmcnt(0)" ::: "memory");
        }
    }
    __syncthreads();
}

#define PH(k, call) { const int _k = (k); if (p.lo <= _k && _k < p.hi) { call; if (_k + 1 < p.hi) { if (_k == 0) grid.sync(); else xcd_barrier(xbar); } } }
__global__ void __launch_bounds__(NTHREADS, 2) hybrid_fwd(Params p) {
  extern __shared__ __attribute__((aligned(16))) unsigned char lds[];
  cg::grid_group grid = cg::this_grid();
  volatile LAS unsigned* xst = (volatile LAS unsigned*)(LAS unsigned char*)(lds + LDS_BYTES);
  if (threadIdx.x < 4) xst[threadIdx.x] = 0u;
  __syncthreads();
  XcdBarrier xbar = xcd_barrier_post((unsigned*)(p.ws + WS_CTL), xst);
  PH(0, phase_prep(p, lds))
#define LAYER(l) { \
    PH(1 + 13 * l + 0, phase_g1(p, l, lds)) \
    PH(1 + 13 * l + 1, phase_r1(p, l, lds)) \
    PH(1 + 13 * l + 2, phase_g2(p, l, lds)) \
    PH(1 + 13 * l + 3, phase_r2(p, l, lds)) \
    PH(1 + 13 * l + 4, phase_a1(p, l, lds)) \
    PH(1 + 13 * l + 5, phase_r3(p, l, lds)) \
    PH(1 + 13 * l + 6, phase_g3(p, l, lds)) \
    PH(1 + 13 * l + 7, phase_r4(p, l)) \
    PH(1 + 13 * l + 8, phase_g4(p, l, lds)) \
    PH(1 + 13 * l + 9, phase_r5(p, l, lds)) \
    PH(1 + 13 * l + 10, phase_g5(p, l, lds)) \
    PH(1 + 13 * l + 11, phase_g6(p, l, lds)) }
  LAYER(0)
  PH(13, rmsnorm_rows(p.out, p.in[2] + D, (bf16_t*)(p.ws + WS_A)))
  LAYER(1)
}

extern "C" void kernel_launch(void* const* d_in, const int* in_sizes, int n_in, void* d_out, int out_size, void* d_ws, size_t ws_size, hipStream_t stream) {
  static int grid_blocks = 0;
  if (!grid_blocks) {
    if (n_in != 45 || ws_size < WS_END) { fprintf(stderr, "kernel_launch: unexpected n_in %d or ws_size %zu (< %zu)\n", n_in, ws_size, (size_t)WS_END); grid_blocks = -1; return; }
    int dev = 0, cus = 0, per_cu = 0;
    hipGetDevice(&dev);
    hipDeviceGetAttribute(&cus, hipDeviceAttributeMultiprocessorCount, dev);
    hipFuncSetAttribute((const void*)hybrid_fwd, hipFuncAttributeMaxDynamicSharedMemorySize, LDS_ALLOC);
    hipOccupancyMaxActiveBlocksPerMultiprocessor(&per_cu, (const void*)hybrid_fwd, NTHREADS, LDS_ALLOC);
    if (per_cu < 1) per_cu = 1;
    if (per_cu > 2) per_cu = 2;
    grid_blocks = cus * per_cu;
    fprintf(stderr, "kernel_launch: cus %d per_cu %d grid %d\n", cus, per_cu, grid_blocks);
  }
  if (grid_blocks < 0) return;
  (void)hipMemsetAsync((unsigned char*)d_ws + WS_CTL, 0, XCD_BAR_WORDS * 4, stream);
  Params p{};
  for (int i = 0; i < 45; ++i) p.in[i] = (const float*)d_in[i];
  p.out = (float*)d_out; p.ws = (unsigned char*)d_ws;
#if N_LAUNCH_MODE == 1
  p.lo = 0; p.hi = NPH;
  { void* args[] = {&p}; hipError_t e = hipLaunchCooperativeKernel((void*)hybrid_fwd, dim3(grid_blocks), dim3(NTHREADS), args, LDS_ALLOC, stream);
    if (e != hipSuccess) fprintf(stderr, "cooperative launch failed: %s\n", hipGetErrorString(e)); }
#else
  for (int ph = 0; ph < NPH; ++ph) {
    p.lo = ph; p.hi = ph + 1;
    void* args[] = {&p}; hipError_t e = hipLaunchCooperativeKernel((void*)hybrid_fwd, dim3(grid_blocks), dim3(NTHREADS), args, LDS_ALLOC, stream);
    if (e != hipSuccess) { fprintf(stderr, "launch %d failed: %s\n", ph, hipGetErrorString(e)); break; }
  }
#endif
}
```

```cpp
#include <hip/hip_runtime.h>
#include <hip/hip_cooperative_groups.h>
#include <cstdio>
#include <cstdint>
namespace cg = cooperative_groups;

#ifndef N_LAUNCH_MODE
#define N_LAUNCH_MODE 1
#endif

#define DEVI __device__ __forceinline__
typedef unsigned short bf16_t;
typedef short bf16x8 __attribute__((ext_vector_type(8)));
typedef float f32x4 __attribute__((ext_vector_type(4)));
typedef float f32x16 __attribute__((ext_vector_type(16)));
typedef unsigned u32x4 __attribute__((ext_vector_type(4)));
#define LAS __attribute__((address_space(3)))

constexpr int NB = 16, S = 2048, T = NB * S, D = 1024, DIN = 1772, DINP = 1792, NL = 2;
constexpr int C_CQ = 0, C_KPE = 192, C_NG = 224, C_CKV = 256, C_LX = 384, C_LG = 640, C_S5 = 896, C_NQ = 1152, C_KS = 1408, C_KW = 1472, C_KC = 1536, C_VC = 1600, C_VS = 1664, C_VW = 1728;
__host__ __device__ constexpr int colmap(int n) {
  if (n < 192) return n;
  if (n < 320) return C_CKV + (n - 192);
  if (n < 352) return C_KPE + (n - 320);
  if (n < 608) return C_LX + (n - 352);
  if (n < 864) return C_LG + (n - 608);
  if (n < 1120) return C_S5 + (n - 864);
  if (n < 1376) return C_NQ + (n - 1120);
  if (n < 1760) { const int j = n - 1376, part = j >> 6, d = j & 63; return (part == 0 ? C_KC : part == 1 ? C_VC : part == 2 ? C_KS : part == 3 ? C_VS : part == 4 ? C_KW : C_VW) + d; }
  return C_NG + (n - 1760);
}
constexpr float EPS = 1e-6f;
constexpr float LOG2E = 1.4426950408889634f;
constexpr int NTHREADS = 256;
constexpr int NPH = 1 + 13 * NL - 1;

constexpr size_t MiB = 1u << 20;
constexpr size_t WS_CTL = 0;
constexpr size_t WS_SMALL = 1 * MiB;
constexpr size_t WS_W = 16 * MiB;
constexpr size_t WS_WL = 32 * MiB;
constexpr size_t WS_A = 80 * MiB;
constexpr size_t WS_B = 144 * MiB;
constexpr size_t WS_C = 256 * MiB;
constexpr size_t WS_D = 292 * MiB;
constexpr size_t WS_E = 348 * MiB;
constexpr size_t WS_F = 380 * MiB;
constexpr size_t WS_G = 428 * MiB;
constexpr size_t WS_ROPE = 452 * MiB;
constexpr size_t WS_END = 460 * MiB;
constexpr size_t W_IN = 0;
constexpr size_t W_OUT = 4 * MiB;
constexpr size_t W_UQ = 6 * MiB;
constexpr size_t W_UKV = W_UQ + 384 * 192 * 2;
constexpr size_t W_LRU = W_UKV + 512 * 128 * 2;
constexpr size_t W_GLU = W_LRU + 4 * 128 * 64 * 2;
constexpr size_t W_1K = 6 * MiB + 512 * 1024;
constexpr size_t W_1V = W_1K + 128 * 2048 * 2;
constexpr size_t W_B1K = W_1V + 128 * 2048 * 2;
constexpr size_t W_B1V = W_B1K + 512;
constexpr size_t W_S5A = W_B1V + 512;
constexpr size_t W_S5A64 = W_S5A + 16 * 64 * 8;
constexpr size_t W_S5B = W_S5A64 + 16 * 64 * 8;
constexpr size_t W_S5BB = W_S5B + 16 * 64 * 16 * 8;
constexpr size_t W_S5CM = W_S5BB + 16 * 4 * 32 * 16 * 2;
constexpr size_t W_2K = W_S5CM + 16 * 16 * 128 * 2;
constexpr size_t W_2V = W_2K + 64 * 128 * 2;
static_assert(W_2V + 64 * 128 * 2 <= 8 * MiB, "weights overflow");
constexpr size_t W_RTH = W_2V + 64 * 128 * 2;
constexpr size_t W_RTL = W_RTH + 32 * 1024 * 2;
static_assert(W_RTL + 32 * 1024 * 2 <= 8 * MiB, "weights overflow 2");
constexpr size_t W_GU = 8 * MiB;
constexpr size_t W_DN = 24 * MiB;
constexpr size_t SM_CNT = WS_SMALL;
constexpr size_t SM_LIST = WS_SMALL + 4096;
constexpr size_t SM_TOKW = SM_LIST + 24 * (size_t)T * 4;
constexpr size_t SM_LSUM = SM_TOKW + (size_t)T * 8;
constexpr size_t SM_SLOC = SM_LSUM + 16 * 32 * 256 * 8;
constexpr size_t SM_HK = SM_SLOC + 16 * 32 * 1024 * 8;
constexpr size_t SM_HV = SM_HK + 2048 * 128 * 2;
constexpr size_t SM_KC = SM_HV + 2048 * 128 * 2;
constexpr size_t SM_VC = SM_KC + 16 * 128 * 64 * 2;
constexpr size_t SM_SCAR = SM_VC + 16 * 128 * 64 * 2;
constexpr size_t SM_LCAR = SM_SCAR + 16 * 32 * 1024 * 8;
constexpr size_t SM_END = SM_LCAR + 16 * 32 * 256 * 4;
static_assert(SM_END <= WS_W, "small region overflow");

constexpr int LDS_BYTES = 65536;
constexpr int LDS_ALLOC = LDS_BYTES + 512;

struct Params {
  const float* in[45];
  float* out;
  unsigned char* ws;
  int lo, hi;
};

DEVI float bf2f(bf16_t v) { return __uint_as_float(((unsigned)v) << 16); }
DEVI bf16_t f2bf(float f) { unsigned u = __float_as_uint(f); return (bf16_t)((u + 0x7fffu + ((u >> 16) & 1u)) >> 16); }
DEVI float wsum(float v) {
#pragma unroll
  for (int o = 32; o >= 1; o >>= 1) v += __shfl_xor(v, o);
  return v;
}
DEVI float sigmoidf_(float x) { return 1.f / (1.f + __expf(-x)); }
DEVI float gelu_tanh(float x) { return 0.5f * x * (1.f + tanhf(0.7978845608028654f * (x + 0.044715f * x * x * x))); }
DEVI f32x16 mfma32(bf16x8 a, bf16x8 b, f32x16 c) { return __builtin_amdgcn_mfma_f32_32x32x16_bf16(a, b, c, 0, 0, 0); }
DEVI f32x4 mfma16(bf16x8 a, bf16x8 b, f32x4 c) { return __builtin_amdgcn_mfma_f32_16x16x32_bf16(a, b, c, 0, 0, 0); }
DEVI int crow(int r, int h) { return (r & 3) + 8 * (r >> 2) + 4 * h; }
typedef __bf16 bf16x2_t __attribute__((ext_vector_type(2)));
typedef float f32x2_t __attribute__((ext_vector_type(2)));
DEVI unsigned pk2bf(float lo, float hi) { f32x2_t v = {lo, hi}; bf16x2_t b = __builtin_convertvector(v, bf16x2_t); return __builtin_bit_cast(unsigned, b); }

template <class AF, class BF>
DEVI void gemm128(unsigned char* lds, int K, AF aload, BF bptr, f32x4 (&acc)[4][4]) {
  const int tid = threadIdx.x, wid = tid >> 6, lane = tid & 63, wr = wid >> 1, wc = wid & 1, fr = lane & 15, fq = lane >> 4;
#pragma unroll
  for (int m = 0; m < 4; ++m)
#pragma unroll
    for (int n = 0; n < 4; ++n) acc[m][n] = (f32x4){0.f, 0.f, 0.f, 0.f};
  const int lr = tid >> 3, ch = tid & 7;
  const int wofs = lr * 128 + ((ch ^ ((lr >> 1) & 7)) * 16);
  const int sw = (fr >> 1) & 7;
  const int aro = (wr * 64 + fr) * 128, bro = (wc * 64 + fr) * 128;
  const int nk = K >> 6;
  u32x4 ra[4], rb[4];
#pragma unroll
  for (int i = 0; i < 4; ++i) { ra[i] = aload(lr + 32 * i, ch * 8); rb[i] = *(const u32x4*)bptr(lr + 32 * i, ch * 8); }
  __syncthreads();
#pragma unroll
  for (int i = 0; i < 4; ++i) { *(u32x4*)(lds + wofs + i * 4096) = ra[i]; *(u32x4*)(lds + 16384 + wofs + i * 4096) = rb[i]; }
  __syncthreads();
  for (int kt = 0; kt < nk; ++kt) {
    const bool more = (kt + 1 < nk);
    if (more) {
      const int k = (kt + 1) * 64 + ch * 8;
#pragma unroll
      for (int i = 0; i < 4; ++i) { ra[i] = aload(lr + 32 * i, k); rb[i] = *(const u32x4*)bptr(lr + 32 * i, k); }
    }
    const unsigned char* bufA = lds + (kt & 1) * 32768;
    const unsigned char* bufB = bufA + 16384;
#pragma unroll
    for (int kk = 0; kk < 2; ++kk) {
      bf16x8 At[4], Bt[4];
      const int co = ((kk * 4 + fq) ^ sw) * 16;
#pragma unroll
      for (int m = 0; m < 4; ++m) At[m] = *(const bf16x8*)(bufA + aro + m * 2048 + co);
#pragma unroll
      for (int n = 0; n < 4; ++n) Bt[n] = *(const bf16x8*)(bufB + bro + n * 2048 + co);
#pragma unroll
      for (int m = 0; m < 4; ++m)
#pragma unroll
        for (int n = 0; n < 4; ++n) acc[m][n] = mfma16(Bt[n], At[m], acc[m][n]);
    }
    if (more) {
      unsigned char* nb = lds + ((kt + 1) & 1) * 32768;
#pragma unroll
      for (int i = 0; i < 4; ++i) { *(u32x4*)(nb + wofs + i * 4096) = ra[i]; *(u32x4*)(nb + 16384 + wofs + i * 4096) = rb[i]; }
    }
    __syncthreads();
  }
}
#define GEMM_EPI_LOOP(body)                                                                 \
  {                                                                                         \
    const int _tid = threadIdx.x, _wid = _tid >> 6, _lane = _tid & 63, _wr = _wid >> 1, _wc = _wid & 1, _fr = _lane & 15, _fq = _lane >> 4; \
    _Pragma("unroll") for (int m = 0; m < 4; ++m) _Pragma("unroll") for (int n = 0; n < 4; ++n) _Pragma("unroll") for (int j = 0; j < 4; ++j) { \
      const int er = _wr * 64 + m * 16 + _fr, ec = _wc * 64 + n * 16 + _fq * 4 + j; const float ev = acc[m][n][j]; body }                      \
  }
#define GEMM_EPI4(body)                                                                     \
  {                                                                                         \
    const int _tid = threadIdx.x, _wid = _tid >> 6, _lane = _tid & 63, _wr = _wid >> 1, _wc = _wid & 1, _fr = _lane & 15, _fq = _lane >> 4; \
    _Pragma("unroll") for (int m = 0; m < 4; ++m) _Pragma("unroll") for (int n = 0; n < 4; ++n) {                                             \
      const int er = _wr * 64 + m * 16 + _fr, ec0 = _wc * 64 + n * 16 + _fq * 4; const f32x4 ev4 = acc[m][n]; body }                          \
  }
DEVI void st_bf16x4(bf16_t* p, f32x4 v) { ushort4 o; o.x = f2bf(v[0]); o.y = f2bf(v[1]); o.z = f2bf(v[2]); o.w = f2bf(v[3]); *(ushort4*)p = o; }

template <class RM>
DEVI void transpose_tiles(const float* src, int K, int N, bf16_t* dst, int ldk, RM rowmap, unsigned char* lds, int& cursor, const float* kscale = nullptr) {
  float* tl = (float*)lds;
  const int tk = K / 64, tn = (N + 63) / 64, nt = tk * tn;
  const int tid = threadIdx.x;
  const int G_ = (int)gridDim.x;
  for (int it = ((int)blockIdx.x - cursor % G_ + G_) % G_; it < nt; it += G_) {
    const int kt = it / tn, ntile = it % tn, k0 = kt * 64, n0 = ntile * 64;
    __syncthreads();
#pragma unroll
    for (int q = 0; q < 4; ++q) {
      const int r = (tid >> 4) + 16 * q, c4 = (tid & 15) * 4;
      const float* sp = src + (size_t)(k0 + r) * N + n0 + c4;
      float4 v;
      if (n0 + c4 + 3 < N) v = *(const float4*)sp;
      else { v.x = (n0 + c4 < N) ? sp[0] : 0.f; v.y = (n0 + c4 + 1 < N) ? sp[1] : 0.f; v.z = (n0 + c4 + 2 < N) ? sp[2] : 0.f; v.w = 0.f; }
      if (kscale) { const float ks = kscale[k0 + r]; v.x *= ks; v.y *= ks; v.z *= ks; v.w *= ks; }
      tl[r * 65 + c4] = v.x; tl[r * 65 + c4 + 1] = v.y; tl[r * 65 + c4 + 2] = v.z; tl[r * 65 + c4 + 3] = v.w;
    }
    __syncthreads();
    const int n = tid >> 2, kc = (tid & 3) * 16;
    if (n0 + n < N) {
      unsigned w[8];
#pragma unroll
      for (int i = 0; i < 8; ++i) w[i] = (unsigned)f2bf(tl[(kc + 2 * i) * 65 + n]) | ((unsigned)f2bf(tl[(kc + 2 * i + 1) * 65 + n]) << 16);
      uint4* o = (uint4*)(dst + (size_t)rowmap(n0 + n) * ldk + k0 + kc);
      o[0] = make_uint4(w[0], w[1], w[2], w[3]); o[1] = make_uint4(w[4], w[5], w[6], w[7]);
    }
  }
  cursor += nt;
}
DEVI void rmsnorm_rows(const float* x, const float* g, bf16_t* xn) {
  const int lane = threadIdx.x & 63, gw = blockIdx.x * 4 + (threadIdx.x >> 6), NGW = gridDim.x * 4;
  for (int t = gw; t < T; t += NGW) {
    const float4* xr = (const float4*)(x + (size_t)t * D);
    float4 v[4]; float s = 0.f;
#pragma unroll
    for (int j = 0; j < 4; ++j) { v[j] = xr[lane + 64 * j]; s += v[j].x * v[j].x + v[j].y * v[j].y + v[j].z * v[j].z + v[j].w * v[j].w; }
    const float rs = rsqrtf(wsum(s) * (1.f / D) + EPS);
#pragma unroll
    for (int j = 0; j < 4; ++j) {
      const float4 gg = ((const float4*)g)[lane + 64 * j];
      ushort4 o; o.x = f2bf(v[j].x * rs * gg.x); o.y = f2bf(v[j].y * rs * gg.y); o.z = f2bf(v[j].z * rs * gg.z); o.w = f2bf(v[j].w * rs * gg.w);
      ((ushort4*)(xn + (size_t)t * D))[lane + 64 * j] = o;
    }
  }
}
DEVI void phase_prep(const Params& p, unsigned char* lds) {
  const size_t gtid = (size_t)blockIdx.x * NTHREADS + threadIdx.x, gn = (size_t)gridDim.x * NTHREADS;
  unsigned char* ws = p.ws;
  if (gtid < 64) ((int*)(ws + SM_CNT))[gtid] = 0;
  auto ident = [](int n) { return n; };
  int cursor = 0;
  for (int l = 0; l < NL; ++l) {
    unsigned char* wl = ws + WS_W + l * WS_WL;
    transpose_tiles(p.in[3] + (size_t)l * D * DIN, D, DIN, (bf16_t*)(wl + W_IN), D, [](int n) { return colmap(n); }, lds, cursor);
    for (size_t i = gtid; i < (size_t)20 * D; i += gn) ((bf16_t*)(wl + W_IN))[(size_t)236 * D + i] = 0;
    transpose_tiles(p.in[36] + (size_t)l * D * D, D, D, (bf16_t*)(wl + W_OUT), D, ident, lds, cursor);
    transpose_tiles(p.in[6] + (size_t)l * 192 * 384, 192, 384, (bf16_t*)(wl + W_UQ), 192, ident, lds, cursor, p.in[4] + l * 192);
    transpose_tiles(p.in[7] + (size_t)l * 128 * 512, 128, 512, (bf16_t*)(wl + W_UKV), 128, ident, lds, cursor, p.in[5] + l * 128);
    transpose_tiles(p.in[25] + (size_t)l * 256 * 256, 256, 256, (bf16_t*)(wl + W_GLU), 256, ident, lds, cursor);
    transpose_tiles(p.in[30] + (size_t)l * 2048 * 128, 2048, 128, (bf16_t*)(wl + W_1K), 2048, ident, lds, cursor);
    transpose_tiles(p.in[33] + (size_t)l * 2048 * 128, 2048, 128, (bf16_t*)(wl + W_1V), 2048, ident, lds, cursor);
    transpose_tiles(p.in[31] + (size_t)l * 128 * 64, 128, 64, (bf16_t*)(wl + W_2K), 128, ident, lds, cursor);
    transpose_tiles(p.in[34] + (size_t)l * 128 * 64, 128, 64, (bf16_t*)(wl + W_2V), 128, ident, lds, cursor);
    for (int h = 0; h < 4; ++h) {
      transpose_tiles(p.in[12] + ((size_t)l * 4 + h) * 64 * 64, 64, 64, (bf16_t*)(wl + W_LRU) + h * 128 * 64, 64, ident, lds, cursor);
      transpose_tiles(p.in[14] + ((size_t)l * 4 + h) * 64 * 64, 64, 64, (bf16_t*)(wl + W_LRU) + h * 128 * 64 + 64 * 64, 64, ident, lds, cursor);
    }
    for (int e = 0; e < 16; ++e) {
      bf16_t* dg = (bf16_t*)(wl + W_GU) + (size_t)e * 512 * 1024;
      transpose_tiles(p.in[42] + ((size_t)l * 16 + e) * 1024 * 256, 1024, 256, dg, 1024, [](int hh) { return (hh >> 6) * 128 + ((hh >> 5) & 1) * 64 + ((hh >> 4) & 1) * 16 + (hh & 15); }, lds, cursor);
      transpose_tiles(p.in[43] + ((size_t)l * 16 + e) * 1024 * 256, 1024, 256, dg, 1024, [](int hh) { return (hh >> 6) * 128 + ((hh >> 5) & 1) * 64 + (((hh >> 4) & 1) + 2) * 16 + (hh & 15); }, lds, cursor);
      transpose_tiles(p.in[44] + ((size_t)l * 16 + e) * 256 * 1024, 256, 1024, (bf16_t*)(wl + W_DN) + (size_t)e * 1024 * 256, 256, ident, lds, cursor);
    }
    {
      const int lane = threadIdx.x & 63, gw = blockIdx.x * 4 + (threadIdx.x >> 6), NGW = gridDim.x * 4;
      for (int o = gw; o < 256; o += NGW) {
        const int kv = o >> 7, j = o & 127;
        const float* pe = (kv ? p.in[32] : p.in[29]) + (size_t)l * 2048;
        const float* w1 = (kv ? p.in[33] : p.in[30]) + (size_t)l * 2048 * 128;
        float a = 0.f;
#pragma unroll 8
        for (int k = lane; k < 2048; k += 64) a += pe[k] * w1[(size_t)k * 128 + j];
        a = wsum(a);
        if (lane == 0) ((float*)(wl + (kv ? W_B1V : W_B1K)))[j] = a;
      }
    }
    for (size_t i = gtid; i < 16 * 64; i += gn) {
      const int g = (int)(i >> 6), sidx = (int)(i & 63);
      const float are = p.in[17][(size_t)l * 1024 + i], aim = p.in[18][(size_t)l * 1024 + i];
      const float dt = expf(p.in[19][l * 16 + g]);
      const float mag = expf(dt * are);
      float sn, cs; sincosf(dt * aim, &sn, &cs);
      const float abr = mag * cs, abi = mag * sn;
      const float den = are * are + aim * aim, nre = abr - 1.f;
      const float gre = (nre * are + abi * aim) / den, gim = (abi * are - nre * aim) / den;
      ((float2*)(wl + W_S5A))[i] = make_float2(abr, abi);
      float pr = abr, pi = abi;
#pragma unroll
      for (int q = 0; q < 6; ++q) { const float nr = pr * pr - pi * pi, ni = 2.f * pr * pi; pr = nr; pi = ni; }
      ((float2*)(wl + W_S5A64))[i] = make_float2(pr, pi);
      bf16_t* bb = (bf16_t*)(wl + W_S5BB);
      for (int ch = 0; ch < 16; ++ch) {
        const float br = p.in[20][((size_t)l * 1024 + i) * 16 + ch], bi = p.in[21][((size_t)l * 1024 + i) * 16 + ch];
        const float vr = gre * br - gim * bi, vi = gre * bi + gim * br;
        const int sb = sidx >> 5, r = sidx & 31;
        bb[((g * 4 + sb * 2 + 0) * 32 + r) * 16 + ch] = f2bf(vr);
        bb[((g * 4 + sb * 2 + 1) * 32 + r) * 16 + ch] = f2bf(vi);
      }
    }
    for (size_t i = gtid; i < 32 * 1024; i += gn) {
      const int n = (int)(i >> 10), k = (int)(i & 1023);
      float w = 0.f;
      if (n < 20) w = p.in[37][l * D + k] * ((n < 4) ? p.in[38][((size_t)l * D + k) * 4 + n] : p.in[40][((size_t)l * D + k) * 16 + (n - 4)]);
      const bf16_t hi = f2bf(w);
      ((bf16_t*)(wl + W_RTH))[i] = hi; ((bf16_t*)(wl + W_RTL))[i] = f2bf(w - bf2f(hi));
    }
    for (size_t i = gtid; i < 16 * 16 * 64; i += gn) {
      const int g = (int)(i >> 10), ch = (int)((i >> 6) & 15), pp = (int)(i & 63);
      const float cr = p.in[22][(size_t)l * 16384 + i], ci = p.in[23][(size_t)l * 16384 + i];
      bf16_t* cm = (bf16_t*)(wl + W_S5CM) + ((size_t)(g * 16 + ch) * 128 + 2 * pp);
      cm[0] = f2bf(cr); cm[1] = f2bf(-ci);
    }
  }
  {
    const int* positions = (const int*)p.in[1];
    float2* RM = (float2*)(ws + WS_ROPE);
    float2* RN = RM + (size_t)T * 16;
    for (size_t i = gtid; i < (size_t)T * 24; i += gn) {
      const int t = (int)(i / 24), j = (int)(i % 24);
      const int rot = (j < 16) ? 32 : 16, fi = (j < 16) ? j : (j - 16);
      const float inv = powf(500000.f, -(2.f * (float)fi) / (float)rot);
      float sn, cs; sincosf((float)positions[t] * inv, &sn, &cs);
      if (j < 16) RM[(size_t)t * 16 + fi] = make_float2(cs, sn); else RN[(size_t)t * 8 + fi] = make_float2(cs, sn);
    }
  }
  rmsnorm_rows(p.in[0], p.in[2], (bf16_t*)(ws + WS_A));
}

DEVI void phase_g1(const Params& p, int l, unsigned char* lds) {
  const bf16_t* XN = (const bf16_t*)(p.ws + WS_A);
  const bf16_t* W = (const bf16_t*)(p.ws + WS_W + l * WS_WL + W_IN);
  bf16_t* PROJ = (bf16_t*)(p.ws + WS_B);
  constexpr int NT = DINP / 128;
  for (int it = blockIdx.x; it < (T / 128) * NT; it += gridDim.x) {
    const int mt = it / NT, nt = it % NT;
    f32x4 acc[4][4];
    gemm128(lds, D, [&](int r, int k) { return *(const u32x4*)(XN + (size_t)(mt * 128 + r) * D + k); }, [&](int r, int k) { return W + (size_t)(nt * 128 + r) * D + k; }, acc);
    if (nt >= 9 && nt <= 11) {
      const int tid = threadIdx.x, wid = tid >> 6, lane = tid & 63, wr = wid >> 1, wc = wid & 1, fr = lane & 15, fq = lane >> 4;
      const float* gg = (nt < 11) ? (p.in[27] + l * 64) : (p.in[28] + l * 192 + (wc ? 128 : 64));
      const float sc = (nt < 11) ? (0.125f * LOG2E) : 1.f;
      const float2* RN = (const float2*)(p.ws + WS_ROPE) + (size_t)T * 16;
#pragma unroll
      for (int m = 0; m < 4; ++m) {
        const size_t t = (size_t)mt * 128 + wr * 64 + m * 16 + fr;
        float ss = 0.f;
#pragma unroll
        for (int n = 0; n < 4; ++n) ss += acc[m][n][0] * acc[m][n][0] + acc[m][n][1] * acc[m][n][1] + acc[m][n][2] * acc[m][n][2] + acc[m][n][3] * acc[m][n][3];
        ss += __shfl_xor(ss, 16); ss += __shfl_xor(ss, 32);
        const float rs = rsqrtf(ss * (1.f / 64) + EPS);
#pragma unroll
        for (int n = 0; n < 4; ++n) {
          const float4 g4 = *(const float4*)(gg + n * 16 + fq * 4);
          f32x4 v = acc[m][n];
          v[0] *= rs * g4.x; v[1] *= rs * g4.y; v[2] *= rs * g4.z; v[3] *= rs * g4.w;
          if (n == 0) {
#pragma unroll
            for (int j = 0; j < 4; ++j) {
              const float x = v[j], partner = __shfl_xor(x, 32);
              const int d = fq * 4 + j; const float2 cs2 = RN[t * 8 + (d & 7)];
              v[j] = (d < 8) ? (x * cs2.x - partner * cs2.y) : (partner * cs2.y + x * cs2.x);
            }
          }
          st_bf16x4(PROJ + t * DINP + nt * 128 + wc * 64 + n * 16 + fq * 4, v * sc);
        }
      }
    } else {
      GEMM_EPI4({ st_bf16x4(PROJ + (size_t)(mt * 128 + er) * DINP + nt * 128 + ec0, ev4); })
    }
  }
}

DEVI void phase_g2(const Params& p, int l, unsigned char* lds) {
  unsigned char* wl = p.ws + WS_W + l * WS_WL;
  const bf16_t* PROJ = (const bf16_t*)(p.ws + WS_B);
  bf16_t* QR = (bf16_t*)(p.ws + WS_D);
  bf16_t* KVR = QR + (size_t)T * 384;
  bf16_t* GATES = (bf16_t*)(p.ws + WS_E);
  bf16_t* MK = (bf16_t*)(p.ws + WS_F) + (size_t)T * 4 * 96;
  const float2* RM = (const float2*)(p.ws + WS_ROPE);
  constexpr int N_CMP = 32, N_QR = 256 * 3, N_KVR = 256 * 4, N_GT = 256 * 4;
  const int tid = threadIdx.x, wid = tid >> 6, lane = tid & 63, wr = wid >> 1, wc = wid & 1, fr = lane & 15, fq = lane >> 4;
  for (int it = blockIdx.x; it < N_CMP + N_QR + N_KVR + N_GT; it += gridDim.x) {
    f32x4 acc[4][4];
    if (it < N_CMP) {
      const int kv = it & 1, mt = it >> 1;
      const bf16_t* W = (const bf16_t*)(wl + (kv ? W_1V : W_1K));
      const float* bias = (const float*)(wl + (kv ? W_B1V : W_B1K));
      bf16_t* H = (bf16_t*)(p.ws + (kv ? SM_HV : SM_HK));
      gemm128(lds, 2048,
              [&](int r, int k) { const int m = mt * 128 + r, b = m >> 7; int c = m & 127; if (c > 126) c = 126;
                                  return *(const u32x4*)(PROJ + (size_t)(b * S + 16 * c + (k >> 6)) * DINP + C_KC + kv * 64 + (k & 63)); },
              [&](int r, int k) { return W + (size_t)r * 2048 + k; }, acc);
      GEMM_EPI4({ f32x4 o; _Pragma("unroll") for (int j = 0; j < 4; ++j) o[j] = gelu_tanh(ev4[j] + bias[ec0 + j]); st_bf16x4(H + (size_t)(mt * 128 + er) * 128 + ec0, o); })
    } else if (it < N_CMP + N_QR) {
      const int i2 = it - N_CMP, mt = i2 / 3, nt = i2 % 3;
      const bf16_t* W = (const bf16_t*)(wl + W_UQ);
      gemm128(lds, 192, [&](int r, int k) { return *(const u32x4*)(PROJ + (size_t)(mt * 128 + r) * DINP + C_CQ + k); }, [&](int r, int k) { return W + (size_t)(nt * 128 + r) * 192 + k; }, acc);
      GEMM_EPI4({ st_bf16x4(QR + (size_t)(mt * 128 + er) * 384 + nt * 128 + ec0, ev4); })
    } else if (it < N_CMP + N_QR + N_KVR) {
      const int i2 = it - N_CMP - N_QR, mt = i2 >> 2, hd = i2 & 3;
      const bf16_t* W = (const bf16_t*)(wl + W_UKV);
      gemm128(lds, 128, [&](int r, int k) { return *(const u32x4*)(PROJ + (size_t)(mt * 128 + r) * DINP + C_CKV + k); }, [&](int r, int k) { return W + (size_t)(hd * 128 + r) * 128 + k; }, acc);
      const float* g_k = p.in[9] + l * 96;
#pragma unroll
      for (int m = 0; m < 4; ++m) {
        const size_t t = (size_t)mt * 128 + wr * 64 + m * 16 + fr;
        const int b = (int)(t >> 11), sq = (int)(t & (S - 1));
        float ss = 0.f;
        {
          const bf16_t* cr = PROJ + t * DINP + C_CKV + fq * 32;
#pragma unroll
          for (int q = 0; q < 4; ++q) { const u32x4 w = *(const u32x4*)(cr + q * 8);
#pragma unroll
            for (int e = 0; e < 4; ++e) { const float lo = __uint_as_float(w[e] << 16), hi = __uint_as_float(w[e] & 0xffff0000u); ss += lo * lo + hi * hi; } }
        }
        ss += __shfl_xor(ss, 16); ss += __shfl_xor(ss, 32);
        const float rskv = rsqrtf(ss * (1.f / 128) + EPS);
        if (wc == 1) {
#pragma unroll
          for (int n = 0; n < 4; ++n) st_bf16x4(KVR + t * 512 + hd * 128 + 64 + n * 16 + fq * 4, acc[m][n] * rskv);
        } else {
          const uint2 plo = *(const uint2*)(PROJ + t * DINP + C_KPE + 4 * fq), phi = *(const uint2*)(PROJ + t * DINP + C_KPE + 16 + 4 * fq);
          float pl[4] = {__uint_as_float(plo.x << 16), __uint_as_float(plo.x & 0xffff0000u), __uint_as_float(plo.y << 16), __uint_as_float(plo.y & 0xffff0000u)};
          float ph[4] = {__uint_as_float(phi.x << 16), __uint_as_float(phi.x & 0xffff0000u), __uint_as_float(phi.y << 16), __uint_as_float(phi.y & 0xffff0000u)};
          float sk = 0.f;
#pragma unroll
          for (int j = 0; j < 4; ++j) sk += pl[j] * pl[j] + ph[j] * ph[j];
          f32x4 kn[4];
#pragma unroll
          for (int n = 0; n < 4; ++n) { kn[n] = acc[m][n] * rskv; sk += kn[n][0] * kn[n][0] + kn[n][1] * kn[n][1] + kn[n][2] * kn[n][2] + kn[n][3] * kn[n][3]; }
          sk += __shfl_xor(sk, 16); sk += __shfl_xor(sk, 32);
          const float rsk = rsqrtf(sk * (1.f / 96) + EPS);
          bf16_t* dst = MK + ((size_t)(b * 4 + hd) * S + sq) * 96;
          f32x4 olo, ohi;
#pragma unroll
          for (int j = 0; j < 4; ++j) {
            const int d = 4 * fq + j; const float2 cs2 = RM[t * 16 + d];
            const float x1 = pl[j] * rsk * g_k[d], x2 = ph[j] * rsk * g_k[16 + d];
            olo[j] = x1 * cs2.x - x2 * cs2.y; ohi[j] = x1 * cs2.y + x2 * cs2.x;
          }
          st_bf16x4(dst + 4 * fq, olo); st_bf16x4(dst + 16 + 4 * fq, ohi);
#pragma unroll
          for (int n = 0; n < 4; ++n) { const float4 g4 = *(const float4*)(g_k + 32 + n * 16 + fq * 4); f32x4 o = kn[n] * rsk; o[0] *= g4.x; o[1] *= g4.y; o[2] *= g4.z; o[3] *= g4.w; st_bf16x4(dst + 32 + n * 16 + fq * 4, o); }
        }
      }
    } else {
      const int i2 = it - N_CMP - N_QR - N_KVR, mt = i2 >> 2, h = i2 & 3;
      const bf16_t* W = (const bf16_t*)(wl + W_LRU) + h * 128 * 64;
      const int c0 = h * 64 + (tid & 7) * 8;
      const float* cw = p.in[10] + l * 4 * 256 + c0; const float* cbp = p.in[11] + l * 256 + c0;
      gemm128(lds, 64,
              [&](int r, int k) {
                const size_t t = (size_t)mt * 128 + r; const int sq = (int)(t & (S - 1));
                float u[8];
#pragma unroll
                for (int e = 0; e < 8; ++e) u[e] = cbp[e];
#pragma unroll
                for (int j = 0; j < 4; ++j) {
                  if (sq - 3 + j >= 0) {
                    const u32x4 w = *(const u32x4*)(PROJ + (t - 3 + j) * DINP + C_LX + h * 64 + k);
#pragma unroll
                    for (int e = 0; e < 4; ++e) { u[2 * e] += __uint_as_float(w[e] << 16) * cw[j * 256 + 2 * e]; u[2 * e + 1] += __uint_as_float(w[e] & 0xffff0000u) * cw[j * 256 + 2 * e + 1]; }
                  }
                }
                u32x4 o; o[0] = pk2bf(u[0], u[1]); o[1] = pk2bf(u[2], u[3]); o[2] = pk2bf(u[4], u[5]); o[3] = pk2bf(u[6], u[7]);
                return o; },
              [&](int r, int k) { return W + (size_t)r * 64 + k; }, acc);
      GEMM_EPI4({ st_bf16x4(GATES + (size_t)(mt * 128 + er) * 512 + h * 128 + ec0, ev4); })
    }
  }
}

DEVI void lru_ab(float u, float rpre, float ipre, float sp, bool first, float& a, float& b) {
  const float r = sigmoidf_(rpre), gi = sigmoidf_(ipre);
  const float la = -8.f * r * sp;
  a = expf(la);
  const float mult = first ? 1.f : sqrtf(fmaxf(-expm1f(2.f * la), 0.f));
  b = mult * gi * u;
}
DEVI float lru_conv(const bf16_t* PROJ, int t, int s, int c, const float* cw, float cb) {
  float u = cb;
#pragma unroll
  for (int j = 0; j < 4; ++j) { const int ss2 = s - 3 + j; if (ss2 >= 0) u += bf2f(PROJ[(size_t)(t - 3 + j) * DINP + C_LX + c]) * cw[j * 256 + c]; }
  return u;
}

template <bool FULL>
DEVI void s5_chunk(const Params& p, int l, int b, int chunk, unsigned char* lds) {
  unsigned char* wl = p.ws + WS_W + l * WS_WL;
  const bf16_t* PROJ = (const bf16_t*)(p.ws + WS_B);
  const float2* Abar = (const float2*)(wl + W_S5A);
  const bf16_t* BB = (const bf16_t*)(wl + W_S5BB);
  const bf16_t* CM = (const bf16_t*)(wl + W_S5CM);
  float2* SLOC = (float2*)(p.ws + SM_SLOC);
  bf16_t* YCP = (bf16_t*)(p.ws + WS_F);
  const float* dd = p.in[24] + l * 256;
  const int tid = threadIdx.x, wv = tid >> 6, lane = tid & 63, r = lane & 31, h = lane >> 5, fr = lane & 15, fq = lane >> 4;
  unsigned* Hs = (unsigned*)(lds + wv * 8704);
  const int t0 = b * S + chunk * 64;
#pragma unroll 1
  for (int gi = 0; gi < 4; ++gi) {
    const int g = wv * 4 + gi;
    bf16x8 bbf[4];
#pragma unroll
    for (int nb = 0; nb < 4; ++nb) bbf[nb] = *(const bf16x8*)(BB + ((g * 4 + nb) * 32 + r) * 16 + 8 * h);
    float2 Ac[2]; float hr[2], hi[2];
#pragma unroll
    for (int sb = 0; sb < 2; ++sb) {
      Ac[sb] = Abar[g * 64 + sb * 32 + r];
      hr[sb] = 0.f; hi[sb] = 0.f;
      if (FULL) { const float2 cin = ((const float2*)(p.ws + SM_SCAR))[((size_t)(b * 32 + chunk) * 16 + g) * 64 + sb * 32 + r]; hr[sb] = cin.x; hi[sb] = cin.y; }
    }
    bf16x8 cm[4];
    float dcol = 0.f;
    if (FULL) {
#pragma unroll
      for (int kk = 0; kk < 4; ++kk) cm[kk] = *(const bf16x8*)(CM + (size_t)(g * 16 + fr) * 128 + kk * 32 + 8 * fq);
      dcol = dd[g * 16 + fr];
    }
#pragma unroll 1
    for (int tb = 0; tb < 2; ++tb) {
      const bf16x8 ua = *(const bf16x8*)(PROJ + (size_t)(t0 + tb * 32 + r) * DINP + C_S5 + g * 16 + 8 * h);
      f32x16 acc[4];
#pragma unroll
      for (int nb = 0; nb < 4; ++nb) {
        f32x16 z;
#pragma unroll
        for (int i = 0; i < 16; ++i) z[i] = 0.f;
        acc[nb] = mfma32(ua, bbf[nb], z);
      }
#pragma unroll
      for (int sb = 0; sb < 2; ++sb) {
        float sr = hr[sb], si = hi[sb];
        const float ax = Ac[sb].x, ay = Ac[sb].y;
#pragma unroll
        for (int q = 0; q < 4; ++q)
#pragma unroll
          for (int owner = 0; owner < 2; ++owner) {
#pragma unroll
            for (int i = 0; i < 4; ++i) {
              const int reg = 4 * q + i;
              const float br = acc[2 * sb][reg], bi = acc[2 * sb + 1][reg];
              const float nr = ax * sr - ay * si + br, ni = ax * si + ay * sr + bi; sr = nr; si = ni;
              if (FULL) { acc[2 * sb][reg] = (h == owner) ? sr : br; acc[2 * sb + 1][reg] = (h == owner) ? si : bi; }
            }
            const float orr = __shfl_xor(sr, 32), oi = __shfl_xor(si, 32);
            if (h != owner) { sr = orr; si = oi; }
          }
        hr[sb] = sr; hi[sb] = si;
      }
      if (FULL) {
#pragma unroll
        for (int sb = 0; sb < 2; ++sb)
#pragma unroll
          for (int reg = 0; reg < 16; ++reg)
            Hs[crow(reg, h) * 68 + sb * 32 + r] = (unsigned)f2bf(acc[2 * sb][reg]) | ((unsigned)f2bf(acc[2 * sb + 1][reg]) << 16);
#pragma unroll
        for (int tb16 = 0; tb16 < 2; ++tb16) {
          f32x4 y = (f32x4){0.f, 0.f, 0.f, 0.f};
#pragma unroll
          for (int kk = 0; kk < 4; ++kk) { const bf16x8 a = *(const bf16x8*)((const bf16_t*)Hs + (tb16 * 16 + fr) * 136 + kk * 32 + 8 * fq); y = mfma16(a, cm[kk], y); }
#pragma unroll
          for (int j = 0; j < 4; ++j) {
            const size_t t = (size_t)t0 + tb * 32 + tb16 * 16 + fq * 4 + j; const int col = g * 16 + fr;
            const float val = y[j] + dcol * bf2f(PROJ[t * DINP + C_S5 + col]);
            YCP[t * 256 + col] = f2bf(gelu_tanh(val));
          }
        }
      }
    }
    if (!FULL) {
#pragma unroll
      for (int sb = 0; sb < 2; ++sb) if (h == 0) SLOC[((size_t)(b * 32 + chunk) * 16 + g) * 64 + sb * 32 + r] = make_float2(hr[sb], hi[sb]);
    }
  }
}

template <bool FULL>
DEVI void lru_chunk(const Params& p, int l, int b, int chunk, float* tile) {
  const bf16_t* PROJ = (const bf16_t*)(p.ws + WS_B);
  const bf16_t* GATES = (const bf16_t*)(p.ws + WS_E);
  float2* LSUM = (float2*)(p.ws + SM_LSUM);
  const int c = threadIdx.x, h = c >> 6, j = c & 63;
  const float* cw = p.in[10] + l * 4 * 256;
  const float w0 = cw[c], w1 = cw[256 + c], w2 = cw[512 + c], w3 = cw[768 + c], cb = p.in[11][l * 256 + c];
  const float ba = p.in[13][l * 256 + c], bi = p.in[15][l * 256 + c];
  const float sp = log1pf(expf(-p.in[16][l * 256 + c]));
  const int s0 = chunk * 64; const size_t t0 = (size_t)b * S + s0;
  float xm3 = 0.f, xm2 = 0.f, xm1 = 0.f;
  if (s0 > 0) { xm3 = bf2f(PROJ[(t0 - 3) * DINP + C_LX + c]); xm2 = bf2f(PROJ[(t0 - 2) * DINP + C_LX + c]); xm1 = bf2f(PROJ[(t0 - 1) * DINP + C_LX + c]); }
  float hh = 0.f, ap = 1.f;
  if (FULL) hh = ((const float*)(p.ws + SM_LCAR))[(size_t)(b * 32 + chunk) * 256 + c];
#pragma unroll 1
  for (int k0 = 0; k0 < 64; k0 += 8) {
    float xv[8], rp[8], ip[8], gt[8];
#pragma unroll
    for (int i = 0; i < 8; ++i) {
      const size_t t = t0 + k0 + i;
      xv[i] = bf2f(PROJ[t * DINP + C_LX + c]);
      rp[i] = bf2f(GATES[t * 512 + h * 128 + j]); ip[i] = bf2f(GATES[t * 512 + h * 128 + 64 + j]);
      gt[i] = FULL ? bf2f(PROJ[t * DINP + C_LG + c]) : 0.f;
    }
#pragma unroll
    for (int i = 0; i < 8; ++i) {
      const float u = cb + xm3 * w0 + xm2 * w1 + xm1 * w2 + xv[i] * w3;
      xm3 = xm2; xm2 = xm1; xm1 = xv[i];
      float a, bb; lru_ab(u, rp[i] + ba, ip[i] + bi, sp, (s0 + k0 + i) == 0, a, bb);
      hh = a * hh + bb; ap *= a;
      if (FULL) tile[(k0 + i) * 256 + c] = hh * gelu_tanh(gt[i]);
    }
  }
  if (!FULL) LSUM[(size_t)(b * 32 + chunk) * 256 + c] = make_float2(ap, hh);
}

DEVI void phase_r2(const Params& p, int l, unsigned char* lds) {
  unsigned char* wl = p.ws + WS_W + l * WS_WL;
  const bf16_t* PROJ = (const bf16_t*)(p.ws + WS_B);
  const bf16_t* QR = (const bf16_t*)(p.ws + WS_D);
  const bf16_t* KVR = QR + (size_t)T * 384;
  const bf16_t* GATES = (const bf16_t*)(p.ws + WS_E);
  bf16_t* MQ = (bf16_t*)(p.ws + WS_F);
  bf16_t* MK = MQ + (size_t)T * 4 * 96;
  const float2* RM = (const float2*)(p.ws + WS_ROPE);
  const float2* RN = RM + (size_t)T * 16;
  const int tid = threadIdx.x, lane = tid & 63, wv = tid >> 6;
  for (int it = blockIdx.x; it < NB * 32; it += gridDim.x) lru_chunk<false>(p, l, it >> 5, it & 31, nullptr);
  __syncthreads();
  for (int it = blockIdx.x; it < NB * 32; it += gridDim.x) s5_chunk<false>(p, l, it >> 5, it & 31, lds);
  {
    const bf16_t* HK = (const bf16_t*)(p.ws + SM_HK); const bf16_t* HV = (const bf16_t*)(p.ws + SM_HV);
    bf16_t* KC = (bf16_t*)(p.ws + SM_KC); bf16_t* VC = (bf16_t*)(p.ws + SM_VC);
    const bf16_t* W2K = (const bf16_t*)(wl + W_2K); const bf16_t* W2V = (const bf16_t*)(wl + W_2V);
    const float* g0 = p.in[28] + l * 192;
    for (int it = blockIdx.x; it < 32; it += gridDim.x) {
      const int kv = it & 1, mt = it >> 1;
      const bf16_t* H = kv ? HV : HK; const bf16_t* W2 = kv ? W2V : W2K;
      f32x4 acc[4][4];
      __syncthreads();
      gemm128(lds, 128, [&](int r, int k) { return *(const u32x4*)(H + (size_t)(mt * 128 + r) * 128 + k); }, [&](int r, int k) { return W2 + (size_t)(r & 63) * 128 + k; }, acc);
      const int wid = tid >> 6, wr = wid >> 1, wc = wid & 1, fr = lane & 15, fq = lane >> 4;
      if (wc == 0) {
#pragma unroll
        for (int m = 0; m < 4; ++m) {
          const int row = mt * 128 + wr * 64 + m * 16 + fr, b = row >> 7, c = row & 127;
          f32x4 v[4];
#pragma unroll
          for (int n = 0; n < 4; ++n) v[n] = acc[m][n];
          if (kv == 0) {
            float ss = 0.f;
#pragma unroll
            for (int n = 0; n < 4; ++n) ss += v[n][0] * v[n][0] + v[n][1] * v[n][1] + v[n][2] * v[n][2] + v[n][3] * v[n][3];
            ss += __shfl_xor(ss, 16); ss += __shfl_xor(ss, 32);
            const float rs = rsqrtf(ss * (1.f / 64) + EPS);
#pragma unroll
            for (int n = 0; n < 4; ++n) { const float4 gg = *(const float4*)(g0 + n * 16 + fq * 4); v[n][0] *= rs * gg.x; v[n][1] *= rs * gg.y; v[n][2] *= rs * gg.z; v[n][3] *= rs * gg.w; }
            const int cc = (c < 127) ? c : 126;
            const float2* cs = RN + (size_t)(b * S + 16 * cc + 31) * 8;
#pragma unroll
            for (int j = 0; j < 4; ++j) {
              const float x = v[0][j], partner = __shfl_xor(x, 32);
              const int d = fq * 4 + j; const float2 cs2 = cs[d & 7];
              v[0][j] = (d < 8) ? (x * cs2.x - partner * cs2.y) : (partner * cs2.y + x * cs2.x);
            }
          }
          bf16_t* dst = (kv ? VC : KC) + (size_t)row * 64;
#pragma unroll
          for (int n = 0; n < 4; ++n) { f32x4 o = v[n]; if (c >= 127) o = (f32x4){0.f, 0.f, 0.f, 0.f}; st_bf16x4(dst + n * 16 + fq * 4, o); }
        }
      }
    }
  }
}

typedef short v4i16_t __attribute__((ext_vector_type(4)));
DEVI float fexp2(float x) { return __builtin_amdgcn_exp2f(x); }
constexpr int ATT_KBYTES = 64 * 104 * 2;
constexpr int ATT_VBYTES = 64 * 72 * 2;
constexpr int ATT_BUF = ATT_KBYTES + ATT_VBYTES;
template <int DK> struct TileRegs { u32x4 k[DK / 32]; u32x4 v[2]; };
template <int DK>
DEVI void tile_load(TileRegs<DK>& tr, const bf16_t* kbase, size_t kstride, const bf16_t* vbase, size_t vstride, int key0, bool withv = true) {
  constexpr int CH = DK / 8;
#pragma unroll
  for (int i = 0; i < DK / 32; ++i) { const int c = threadIdx.x + 256 * i, r = c / CH, cc = c % CH; tr.k[i] = *(const u32x4*)(kbase + (size_t)(key0 + r) * kstride + cc * 8); }
  if (withv) {
#pragma unroll
    for (int i = 0; i < 2; ++i) { const int c = threadIdx.x + 256 * i, r = c >> 3, cc = c & 7; tr.v[i] = *(const u32x4*)(vbase + (size_t)(key0 + r) * vstride + cc * 8); }
  }
}
template <int DK>
DEVI void tile_store(const TileRegs<DK>& tr, unsigned char* buf, bool withv = true) {
  constexpr int CH = DK / 8;
  bf16_t* sK = (bf16_t*)buf; bf16_t* sV = (bf16_t*)(buf + ATT_KBYTES);
#pragma unroll
  for (int i = 0; i < DK / 32; ++i) { const int c = threadIdx.x + 256 * i, r = c / CH, cc = c % CH; *(u32x4*)(sK + r * (DK + 8) + cc * 8) = tr.k[i]; }
  if (withv) {
#pragma unroll
    for (int i = 0; i < 2; ++i) { const int c = threadIdx.x + 256 * i, r = c >> 3, cc = c & 7; *(u32x4*)(sV + r * 72 + cc * 8) = tr.v[i]; }
  }
}
template <int DK>
DEVI void qk_tile(const bf16_t* sK, const bf16x8* qf, f32x16& s0, f32x16& s1, int r, int h) {
#pragma unroll
  for (int i = 0; i < 16; ++i) { s0[i] = 0.f; s1[i] = 0.f; }
#pragma unroll
  for (int kk = 0; kk < DK / 16; ++kk) {
    const bf16x8 a0 = *(const bf16x8*)(sK + r * (DK + 8) + kk * 16 + h * 8);
    const bf16x8 a1 = *(const bf16x8*)(sK + (32 + r) * (DK + 8) + kk * 16 + h * 8);
    s0 = mfma32(a0, qf[kk], s0);
    s1 = mfma32(a1, qf[kk], s1);
  }
}
struct FState { f32x16 o0, o1; float m, l; };
DEVI void fstate_init(FState& f) {
#pragma unroll
  for (int i = 0; i < 16; ++i) { f.o0[i] = 0.f; f.o1[i] = 0.f; }
  f.m = -INFINITY; f.l = 0.f;
}
DEVI v4i16_t vtr(const bf16_t* p) { return __builtin_amdgcn_ds_read_tr16_b64_v4i16((LAS v4i16_t*)p); }
DEVI void softmax_pv(FState& f, f32x16& s0, f32x16& s1, const bf16_t* sV, int lane) {
  const int h = lane >> 5;
  float mx = -INFINITY;
#pragma unroll
  for (int i = 0; i < 16; ++i) mx = fmaxf(mx, fmaxf(s0[i], s1[i]));
  mx = fmaxf(mx, __shfl_xor(mx, 32));
  const float mnew = fmaxf(f.m, mx);
  const float muse = (mnew == -INFINITY) ? 0.f : mnew;
  const float alpha = fexp2(f.m - muse);
  float ps = 0.f;
#pragma unroll
  for (int i = 0; i < 16; ++i) { s0[i] = fexp2(s0[i] - muse); s1[i] = fexp2(s1[i] - muse); ps += s0[i] + s1[i]; }
  ps += __shfl_xor(ps, 32);
  f.l = f.l * alpha + ps; f.m = mnew;
#pragma unroll
  for (int i = 0; i < 16; ++i) { f.o0[i] *= alpha; f.o1[i] *= alpha; }
  const int g = lane >> 4, li = lane & 15, q = li >> 2, pp = li & 3;
  const bf16_t* vb = sV + (4 * h + q) * 72 + (g & 1) * 16 + 4 * pp;
#pragma unroll
  for (int kb = 0; kb < 2; ++kb)
#pragma unroll
    for (int s = 0; s < 2; ++s) {
      unsigned pw[4];
#pragma unroll
      for (int j = 0; j < 4; ++j) pw[j] = kb ? pk2bf(s1[8 * s + 2 * j], s1[8 * s + 2 * j + 1]) : pk2bf(s0[8 * s + 2 * j], s0[8 * s + 2 * j + 1]);
      const bf16x8 pb = __builtin_bit_cast(bf16x8, (u32x4){pw[0], pw[1], pw[2], pw[3]});
#pragma unroll
      for (int db = 0; db < 2; ++db) {
        const v4i16_t lo = vtr(vb + (kb * 32 + 16 * s) * 72 + db * 32);
        const v4i16_t hi = vtr(vb + (kb * 32 + 16 * s + 8) * 72 + db * 32);
        const bf16x8 a = {lo[0], lo[1], lo[2], lo[3], hi[0], hi[1], hi[2], hi[3]};
        if (db == 0) f.o0 = mfma32(a, pb, f.o0); else f.o1 = mfma32(a, pb, f.o1);
      }
    }
}
DEVI void store_o(bf16_t* orow, const f32x16& o0, const f32x16& o1, float sc, int h) {
#pragma unroll
  for (int g = 0; g < 4; ++g) {
    uint2 v0, v1;
    v0.x = pk2bf(o0[4 * g] * sc, o0[4 * g + 1] * sc); v0.y = pk2bf(o0[4 * g + 2] * sc, o0[4 * g + 3] * sc);
    v1.x = pk2bf(o1[4 * g] * sc, o1[4 * g + 1] * sc); v1.y = pk2bf(o1[4 * g + 2] * sc, o1[4 * g + 3] * sc);
    *(uint2*)(orow + 8 * g + 4 * h) = v0;
    *(uint2*)(orow + 32 + 8 * g + 4 * h) = v1;
  }
}

DEVI void mla_item(const Params& p, int l, int b, int hd, int qt, unsigned char* lds) {
  const bf16_t* MQ = (const bf16_t*)(p.ws + WS_F);
  const bf16_t* MK = MQ + (size_t)T * 4 * 96;
  const bf16_t* KVR = (const bf16_t*)(p.ws + WS_D) + (size_t)T * 384;
  bf16_t* YA = (bf16_t*)(p.ws + WS_C);
  const int tid = threadIdx.x, wv = tid >> 6, lane = tid & 63, r = lane & 31, h = lane >> 5;
  const int q0 = qt * 128 + wv * 32, tq = q0 + r;
  bf16x8 qf[6];
  {
    const bf16_t* qrow = (const bf16_t*)(p.ws + WS_D) + ((size_t)b * S + tq) * 384 + hd * 96;
    const float* g_q = p.in[8] + l * 96;
    float qv[6][8]; float ss = 0.f;
#pragma unroll
    for (int kk = 0; kk < 6; ++kk) {
      const u32x4 w = *(const u32x4*)(qrow + kk * 16 + h * 8);
#pragma unroll
      for (int e = 0; e < 4; ++e) { qv[kk][2 * e] = __uint_as_float(w[e] << 16); qv[kk][2 * e + 1] = __uint_as_float(w[e] & 0xffff0000u); ss += qv[kk][2 * e] * qv[kk][2 * e] + qv[kk][2 * e + 1] * qv[kk][2 * e + 1]; }
    }
    ss += __shfl_xor(ss, 32);
    const float rs = rsqrtf(ss * (1.f / 96) + EPS) * (0.10206207261596575f * LOG2E);
#pragma unroll
    for (int kk = 0; kk < 6; ++kk)
#pragma unroll
      for (int j = 0; j < 8; ++j) qv[kk][j] *= rs * g_q[kk * 16 + h * 8 + j];
    const float2* cs = (const float2*)(p.ws + WS_ROPE) + ((size_t)b * S + tq) * 16 + 8 * h;
#pragma unroll
    for (int j = 0; j < 8; ++j) { const float2 c2 = cs[j]; const float x1 = qv[0][j], x2 = qv[1][j]; qv[0][j] = x1 * c2.x - x2 * c2.y; qv[1][j] = x1 * c2.y + x2 * c2.x; }
#pragma unroll
    for (int kk = 0; kk < 6; ++kk) { const u32x4 w = {pk2bf(qv[kk][0], qv[kk][1]), pk2bf(qv[kk][2], qv[kk][3]), pk2bf(qv[kk][4], qv[kk][5]), pk2bf(qv[kk][6], qv[kk][7])}; qf[kk] = __builtin_bit_cast(bf16x8, w); }
  }
  FState f; fstate_init(f);
  const bf16_t* kbase = MK + (size_t)(b * 4 + hd) * S * 96;
  const bf16_t* vbase = KVR + (size_t)b * S * 512 + hd * 128 + 64;
  const int ntiles = 2 * qt + 2;
  TileRegs<96> tr;
  tile_load<96>(tr, kbase, 96, vbase, 512, 0);
  __syncthreads();
  tile_store<96>(tr, lds);
  __syncthreads();
#pragma unroll 1
  for (int kt = 0; kt < ntiles; ++kt) {
    unsigned char* cur = lds + (kt & 1) * ATT_BUF;
    const bool more = kt + 1 < ntiles;
    if (more) tile_load<96>(tr, kbase, 96, vbase, 512, (kt + 1) * 64);
    if (kt * 64 <= q0 + 31) {
      f32x16 s0, s1;
      qk_tile<96>((const bf16_t*)cur, qf, s0, s1, r, h);
      if (kt * 64 + 63 > q0) {
        int rel = tq - kt * 64 - 4 * h; asm volatile("" : "+v"(rel));
#pragma unroll
        for (int i = 0; i < 16; ++i) { const int kk2 = (i & 3) + 8 * (i >> 2); if (kk2 > rel) s0[i] = -INFINITY; if (kk2 + 32 > rel) s1[i] = -INFINITY; }
      }
      softmax_pv(f, s0, s1, (const bf16_t*)(cur + ATT_KBYTES), lane);
    }
    if (more) tile_store<96>(tr, lds + ((kt + 1) & 1) * ATT_BUF);
    __syncthreads();
  }
  store_o(YA + (size_t)(b * S + tq) * 256 + hd * 64, f.o0, f.o1, 1.f / f.l, h);
}

template <class KF, class BODY>
DEVI void nsa_stream(unsigned char* lds, const bf16_t* kbase, size_t kstride, const bf16_t* vbase, size_t vstride, bool withv, int nt, KF key0f, BODY body) {
  if (nt <= 0) return;
  TileRegs<64> tr;
  tile_load<64>(tr, kbase, kstride, vbase, vstride, key0f(0), withv);
  __syncthreads();
  tile_store<64>(tr, lds, withv);
  __syncthreads();
#pragma unroll 1
  for (int i = 0; i < nt; ++i) {
    unsigned char* cur = lds + (i & 1) * ATT_BUF;
    const bool more = i + 1 < nt;
    if (more) tile_load<64>(tr, kbase, kstride, vbase, vstride, key0f(i + 1), withv);
    body(i, cur);
    if (more) tile_store<64>(tr, lds + ((i + 1) & 1) * ATT_BUF, withv);
    __syncthreads();
  }
}
DEVI void nsa_item(const Params& p, int b, int qt, unsigned char* lds) {
  const bf16_t* PROJ = (const bf16_t*)(p.ws + WS_B);
  const bf16_t* KC = (const bf16_t*)(p.ws + SM_KC) + (size_t)b * 128 * 64;
  const bf16_t* VC = (const bf16_t*)(p.ws + SM_VC) + (size_t)b * 128 * 64;
  bf16_t* YD = (bf16_t*)(p.ws + WS_C) + (size_t)T * 256;
  const int tid = threadIdx.x, wv = tid >> 6, lane = tid & 63, r = lane & 31, h = lane >> 5;
  float* psum = (float*)(lds + 2 * ATT_BUF);
  unsigned* selm = (unsigned*)(lds + 2 * ATT_BUF + 16384);
  const int t0 = qt * 32, cur = t0 >> 6;
  const int ql = wv * 8 + (r >> 2), hd = r & 3, tq = t0 + ql;
  const size_t tg = (size_t)b * S + tq;
  bf16x8 qf[4];
#pragma unroll
  for (int kk = 0; kk < 4; ++kk) qf[kk] = *(const bf16x8*)(PROJ + tg * DINP + C_NQ + hd * 64 + kk * 16 + h * 8);
  f32x16 of0, of1;
#pragma unroll
  for (int i = 0; i < 16; ++i) { of0[i] = 0.f; of1[i] = 0.f; }
  const float g0 = sigmoidf_(bf2f(PROJ[tg * DINP + C_NG + hd * 3 + 0]));
  const float g1 = sigmoidf_(bf2f(PROJ[tg * DINP + C_NG + hd * 3 + 1]));
  const float g2 = sigmoidf_(bf2f(PROJ[tg * DINP + C_NG + hd * 3 + 2]));
  FState f; fstate_init(f);
  const int ncmp = (t0 + 31 < 31) ? 0 : (((t0 >> 4) >> 6) + 1);
  nsa_stream(lds, KC, 64, VC, 64, true, ncmp, [&](int i) { return i * 64; }, [&](int kt, unsigned char* buf) {
    f32x16 s0, s1;
    qk_tile<64>((const bf16_t*)buf, qf, s0, s1, r, h);
    int rel = ((tq - 31) >> 4) - kt * 64 - 4 * h; asm volatile("" : "+v"(rel));
#pragma unroll
    for (int i = 0; i < 16; ++i) { const int kk2 = (i & 3) + 8 * (i >> 2); if (kk2 > rel) s0[i] = -INFINITY; if (kk2 + 32 > rel) s1[i] = -INFINITY; }
    softmax_pv(f, s0, s1, (const bf16_t*)(buf + ATT_KBYTES), lane);
  });
  {
    const float sc = (f.l > 0.f) ? g0 / f.l : 0.f;
#pragma unroll
    for (int i = 0; i < 16; ++i) { of0[i] += f.o0[i] * sc; of1[i] += f.o1[i] * sc; }
  }
  {
    const float muse = (f.m == -INFINITY) ? 0.f : f.m;
    const float il = (f.l > 0.f) ? 1.f / f.l : 0.f;
    if (ncmp < 2) {
#pragma unroll 1
      for (int i = tid; i < 32 * 128; i += NTHREADS) psum[i] = 0.f;
      __syncthreads();
    }
    nsa_stream(lds, KC, 64, VC, 64, false, ncmp, [&](int i) { return i * 64; }, [&](int kt, unsigned char* buf) {
      f32x16 s0, s1;
      qk_tile<64>((const bf16_t*)buf, qf, s0, s1, r, h);
      int rel = ((tq - 31) >> 4) - kt * 64 - 4 * h; asm volatile("" : "+v"(rel));
      int cb0 = kt * 64 + 4 * h; asm volatile("" : "+v"(cb0));
#pragma unroll
      for (int i = 0; i < 16; ++i) {
        const int kk2 = (i & 3) + 8 * (i >> 2); const int c = cb0 + kk2;
        float p0 = (kk2 > rel) ? 0.f : fexp2(s0[i] - muse) * il;
        float p1 = (kk2 + 32 > rel) ? 0.f : fexp2(s1[i] - muse) * il;
        p0 += __shfl_xor(p0, 1); p0 += __shfl_xor(p0, 2);
        p1 += __shfl_xor(p1, 1); p1 += __shfl_xor(p1, 2);
        if (hd == 0) { psum[ql * 128 + c] = p0; psum[ql * 128 + c + 32] = p1; }
      }
    });
  }
  __syncthreads();
#pragma unroll 1
  for (int itq = 0; itq < 4; ++itq) {
    const int q2 = wv * 8 + itq * 2 + (lane >> 5), j = lane & 31;
    const float* ps = psum + q2 * 128;
    float imp = 2.f * (ps[4 * j] + ps[4 * j + 1] + ps[4 * j + 2]) + ps[4 * j + 3];
    if (j > 0) imp += ps[4 * j - 1];
    const bool cand = (j >= 1) && (j <= cur - 2);
    int rank = 0;
    for (int jj = 0; jj < 32; ++jj) {
      const float v = __shfl(imp, (lane & 32) | jj);
      const bool cj = (jj >= 1) && (jj <= cur - 2);
      if (cj && (v > imp || (v == imp && jj < j))) ++rank;
    }
    const bool sel = cand && rank < 2;
    const unsigned long long bal = __ballot(sel);
    unsigned mk = (unsigned)(bal >> (32 * (lane >> 5)));
    mk |= 1u | (1u << cur); if (cur >= 1) mk |= (1u << (cur - 1));
    if (j == 0) selm[q2] = mk;
  }
  __syncthreads();
  unsigned blk_or = 0, wave_or = 0;
  for (int i = 0; i < 32; ++i) blk_or |= selm[i];
  for (int i = 0; i < 8; ++i) wave_or |= selm[wv * 8 + i];
  const unsigned mymask = selm[ql];
  fstate_init(f);
  {
    unsigned* tl = selm + 32;
    if (tid < 32 && ((blk_or >> tid) & 1u)) tl[__popc(blk_or & ((1u << tid) - 1u))] = tid;
    __syncthreads();
    const int nsel = __popc(blk_or);
    nsa_stream(lds, PROJ + (size_t)b * S * DINP + C_KS, DINP, PROJ + (size_t)b * S * DINP + C_VS, DINP, true, nsel,
      [&](int i) { return (int)tl[i] * 64; },
      [&](int i, unsigned char* buf) {
        const int jj = (int)tl[i];
        if ((wave_or >> jj) & 1u) {
          f32x16 s0, s1;
          qk_tile<64>((const bf16_t*)buf, qf, s0, s1, r, h);
          const bool on = (mymask >> jj) & 1u;
          int rel = on ? (tq - jj * 64 - 4 * h) : -1; asm volatile("" : "+v"(rel));
#pragma unroll
          for (int i2 = 0; i2 < 16; ++i2) { const int kk2 = (i2 & 3) + 8 * (i2 >> 2); if (kk2 > rel) s0[i2] = -INFINITY; if (kk2 + 32 > rel) s1[i2] = -INFINITY; }
          softmax_pv(f, s0, s1, (const bf16_t*)(buf + ATT_KBYTES), lane);
        }
      });
    const float sc = (f.l > 0.f) ? g1 / f.l : 0.f;
#pragma unroll
    for (int i = 0; i < 16; ++i) { of0[i] += f.o0[i] * sc; of1[i] += f.o1[i] * sc; }
  }
  fstate_init(f);
  {
    int jlo = (t0 - 511) >> 6; if (jlo < 0) jlo = 0;
    nsa_stream(lds, PROJ + (size_t)b * S * DINP + C_KW, DINP, PROJ + (size_t)b * S * DINP + C_VW, DINP, true, cur - jlo + 1,
      [&](int i) { return (jlo + i) * 64; },
      [&](int i, unsigned char* buf) {
        const int j = jlo + i;
        f32x16 s0, s1;
        qk_tile<64>((const bf16_t*)buf, qf, s0, s1, r, h);
        if (j == cur || j * 64 < t0 + 31 - 511 + 64) {
          int rel = tq - j * 64 - 4 * h; asm volatile("" : "+v"(rel));
#pragma unroll
          for (int i2 = 0; i2 < 16; ++i2) {
            const int kk2 = (i2 & 3) + 8 * (i2 >> 2);
            if (kk2 > rel || kk2 < rel - 511) s0[i2] = -INFINITY;
            if (kk2 + 32 > rel || kk2 + 32 < rel - 511) s1[i2] = -INFINITY;
          }
        }
        softmax_pv(f, s0, s1, (const bf16_t*)(buf + ATT_KBYTES), lane);
      });
    const float sc = (f.l > 0.f) ? g2 / f.l : 0.f;
#pragma unroll
    for (int i = 0; i < 16; ++i) { of0[i] += f.o0[i] * sc; of1[i] += f.o1[i] * sc; }
  }
  store_o(YD + tg * 256 + hd * 64, of0, of1, 1.f, h);
}

DEVI void carry_item(const Params& p, int l, int it) {
  const int tid = threadIdx.x;
  if (it < 64) {
    const int idx = it * 256 + tid, b = idx >> 10, gs = idx & 1023;
    const float2 a64 = ((const float2*)(p.ws + WS_W + l * WS_WL + W_S5A64))[gs];
    const float2* SLOC = (const float2*)(p.ws + SM_SLOC) + (size_t)b * 32 * 1024 + gs;
    float2* SCAR = (float2*)(p.ws + SM_SCAR) + (size_t)b * 32 * 1024 + gs;
    float hr = 0.f, hi = 0.f;
#pragma unroll 1
    for (int c0 = 0; c0 < 32; c0 += 8) {
      float2 sl[8];
#pragma unroll
      for (int i = 0; i < 8; ++i) sl[i] = SLOC[(size_t)(c0 + i) * 1024];
#pragma unroll
      for (int i = 0; i < 8; ++i) { SCAR[(size_t)(c0 + i) * 1024] = make_float2(hr, hi); const float nr = a64.x * hr - a64.y * hi + sl[i].x, ni = a64.x * hi + a64.y * hr + sl[i].y; hr = nr; hi = ni; }
    }
  } else {
    const int idx = (it - 64) * 256 + tid, b = idx >> 8, c = idx & 255;
    const float2* LSUM = (const float2*)(p.ws + SM_LSUM) + (size_t)b * 32 * 256 + c;
    float* LCAR = (float*)(p.ws + SM_LCAR) + (size_t)b * 32 * 256 + c;
    float hh = 0.f;
#pragma unroll 1
    for (int c0 = 0; c0 < 32; c0 += 8) {
      float2 sv[8];
#pragma unroll
      for (int i = 0; i < 8; ++i) sv[i] = LSUM[(size_t)(c0 + i) * 256];
#pragma unroll
      for (int i = 0; i < 8; ++i) { LCAR[(size_t)(c0 + i) * 256] = hh; hh = sv[i].x * hh + sv[i].y; }
    }
  }
}
DEVI void phase_a1(const Params& p, int l, unsigned char* lds) {
  for (int it = blockIdx.x; it < 80; it += gridDim.x) carry_item(p, l, it);
  for (int j = blockIdx.x; j < 1024; j += gridDim.x) { const int qt = 63 - (j >> 4), b = j & 15; nsa_item(p, b, qt, lds); }
  __syncthreads();
  for (int j = blockIdx.x; j < 1024; j += gridDim.x) { const int qt = 15 - (j >> 6), bh = j & 63; mla_item(p, l, bh >> 2, bh & 3, qt, lds); }
}

DEVI void phase_r3(const Params& p, int l, unsigned char* lds) {
  bf16_t* Y = (bf16_t*)(p.ws + WS_A);
  const int tid = threadIdx.x, lane = tid & 63, wv = tid >> 6;
  {
    const float* onorm = p.in[35] + l * 1024 + 256;
    float* tile = (float*)lds;
    for (int it = blockIdx.x; it < NB * 32; it += gridDim.x) {
      const int b = it >> 5, chunk = it & 31;
      __syncthreads();
      lru_chunk<true>(p, l, b, chunk, tile);
      __syncthreads();
      for (int k = wv; k < 64; k += 4) {
        float v[4], ss = 0.f;
#pragma unroll
        for (int i = 0; i < 4; ++i) { v[i] = tile[k * 256 + lane + 64 * i]; ss += v[i] * v[i]; }
        const float rs = rsqrtf(wsum(ss) * (1.f / 256) + EPS);
        const size_t t = (size_t)b * S + chunk * 64 + k;
#pragma unroll
        for (int i = 0; i < 4; ++i) Y[t * 1024 + 256 + lane + 64 * i] = f2bf(v[i] * rs * onorm[lane + 64 * i]);
      }
    }
  }
  __syncthreads();
  for (int it = blockIdx.x; it < NB * 32; it += gridDim.x) s5_chunk<true>(p, l, it >> 5, it & 31, lds);
}

DEVI void phase_g3(const Params& p, int l, unsigned char* lds) {
  const bf16_t* YCP = (const bf16_t*)(p.ws + WS_F);
  bf16_t* YC = (bf16_t*)(p.ws + WS_F) + (size_t)T * 256;
  const bf16_t* W = (const bf16_t*)(p.ws + WS_W + l * WS_WL + W_GLU);
  const float* bg = p.in[26] + l * 256;
  for (int it = blockIdx.x; it < 256 * 2; it += gridDim.x) {
    const int mt = it >> 1, nt = it & 1;
    f32x4 acc[4][4];
    gemm128(lds, 256, [&](int r, int k) { return *(const u32x4*)(YCP + (size_t)(mt * 128 + r) * 256 + k); }, [&](int r, int k) { return W + (size_t)(nt * 128 + r) * 256 + k; }, acc);
    GEMM_EPI4({ const size_t o = (size_t)(mt * 128 + er) * 256 + nt * 128 + ec0; const ushort4 yp = *(const ushort4*)(YCP + o); f32x4 r4; r4[0] = bf2f(yp.x) * sigmoidf_(ev4[0] + bg[nt * 128 + ec0]); r4[1] = bf2f(yp.y) * sigmoidf_(ev4[1] + bg[nt * 128 + ec0 + 1]); r4[2] = bf2f(yp.z) * sigmoidf_(ev4[2] + bg[nt * 128 + ec0 + 2]); r4[3] = bf2f(yp.w) * sigmoidf_(ev4[3] + bg[nt * 128 + ec0 + 3]); st_bf16x4(YC + o, r4); })
  }
}

DEVI void phase_r4(const Params& p, int l) {
  const bf16_t* YA = (const bf16_t*)(p.ws + WS_C);
  const bf16_t* YD = YA + (size_t)T * 256;
  const bf16_t* YC = (const bf16_t*)(p.ws + WS_F) + (size_t)T * 256;
  bf16_t* Y = (bf16_t*)(p.ws + WS_A);
  const float* onorm = p.in[35] + l * 1024;
  const int lane = threadIdx.x & 63, gw = blockIdx.x * 4 + (threadIdx.x >> 6), NGW = gridDim.x * 4;
  for (int t = gw; t < T; t += NGW) {
#pragma unroll
    for (int grp = 0; grp < 3; ++grp) {
      const bf16_t* src = (grp == 0 ? YA : (grp == 1 ? YC : YD)) + (size_t)t * 256;
      const int gcol = (grp == 0 ? 0 : (grp == 1 ? 512 : 768));
      const ushort4 u = ((const ushort4*)src)[lane];
      const float v0 = bf2f(u.x), v1 = bf2f(u.y), v2 = bf2f(u.z), v3 = bf2f(u.w);
      const float rs = rsqrtf(wsum(v0 * v0 + v1 * v1 + v2 * v2 + v3 * v3) * (1.f / 256) + EPS);
      const float4 g = ((const float4*)(onorm + gcol))[lane];
      ushort4 o; o.x = f2bf(v0 * rs * g.x); o.y = f2bf(v1 * rs * g.y); o.z = f2bf(v2 * rs * g.z); o.w = f2bf(v3 * rs * g.w);
      ((ushort4*)(Y + (size_t)t * 1024 + gcol))[lane] = o;
    }
  }
}

DEVI void phase_g4(const Params& p, int l, unsigned char* lds) {
  const bf16_t* Y = (const bf16_t*)(p.ws + WS_A);
  const bf16_t* W = (const bf16_t*)(p.ws + WS_W + l * WS_WL + W_OUT);
  const float* xin = (l == 0) ? p.in[0] : p.out;
  float* out = p.out;
  for (int it = blockIdx.x; it < 256 * 8; it += gridDim.x) {
    const int mt = it >> 3, nt = it & 7;
    f32x4 acc[4][4];
    gemm128(lds, D, [&](int r, int k) { return *(const u32x4*)(Y + (size_t)(mt * 128 + r) * D + k); }, [&](int r, int k) { return W + (size_t)(nt * 128 + r) * D + k; }, acc);
    GEMM_EPI4({ const size_t o = (size_t)(mt * 128 + er) * D + nt * 128 + ec0; const f32x4 xi = *(const f32x4*)(xin + o); *(f32x4*)(out + o) = xi + ev4; })
  }
}

DEVI void phase_r5(const Params& p, int l, unsigned char* lds) {
  const float* x1 = p.out;
  bf16_t* XN = (bf16_t*)(p.ws + WS_A);
  const float* g = p.in[37] + l * D;
  const bf16_t* WH = (const bf16_t*)(p.ws + WS_W + l * WS_WL + W_RTH);
  const bf16_t* WL = (const bf16_t*)(p.ws + WS_W + l * WS_WL + W_RTL);
  const float* brg = p.in[39] + l * 4; const float* bre = p.in[41] + l * 16;
  int* CNT = (int*)(p.ws + SM_CNT) + l * 32;
  int* LIST = (int*)(p.ws + SM_LIST);
  float2* TOKW = (float2*)(p.ws + SM_TOKW);
  const int tid = threadIdx.x, lane = tid & 63, wv = tid >> 6, r = lane & 31, h = lane >> 5;
  float* red = (float*)lds;
  float* rsv = red + 4 * 17 * 64;
  for (int it = blockIdx.x; it < T / 32; it += gridDim.x) {
    const size_t tb = (size_t)it * 32;
    f32x16 acc;
#pragma unroll
    for (int i = 0; i < 16; ++i) acc[i] = 0.f;
    float ss = 0.f;
    const float* xrow = x1 + (tb + r) * D + wv * 256 + 8 * h;
    const bf16_t* whr = WH + (size_t)r * 1024 + wv * 256 + 8 * h;
    const bf16_t* wlr = WL + (size_t)r * 1024 + wv * 256 + 8 * h;
#pragma unroll 4
    for (int ks = 0; ks < 16; ++ks) {
      const float4 xa = *(const float4*)(xrow + ks * 16), xb = *(const float4*)(xrow + ks * 16 + 4);
      const bf16x8 wh = *(const bf16x8*)(whr + ks * 16), wl = *(const bf16x8*)(wlr + ks * 16);
      const float xv[8] = {xa.x, xa.y, xa.z, xa.w, xb.x, xb.y, xb.z, xb.w};
      bf16x8 xh, xl;
#pragma unroll
      for (int j = 0; j < 8; ++j) { ss += xv[j] * xv[j]; const bf16_t hb = f2bf(xv[j]); xh[j] = (short)hb; xl[j] = (short)f2bf(xv[j] - bf2f(hb)); }
      acc = mfma32(wh, xh, acc); acc = mfma32(wh, xl, acc); acc = mfma32(wl, xh, acc);
    }
    ss += __shfl_xor(ss, 32);
    __syncthreads();
#pragma unroll
    for (int i = 0; i < 16; ++i) red[(wv * 17 + i) * 64 + lane] = acc[i];
    red[(wv * 17 + 16) * 64 + lane] = ss;
    __syncthreads();
    if (wv == 0) {
      float c[16];
#pragma unroll
      for (int i = 0; i < 16; ++i) c[i] = red[i * 64 + lane] + red[(17 + i) * 64 + lane] + red[(34 + i) * 64 + lane] + red[(51 + i) * 64 + lane];
      const float s2 = red[16 * 64 + lane] + red[(17 + 16) * 64 + lane] + red[(34 + 16) * 64 + lane] + red[(51 + 16) * 64 + lane];
      const float rs = rsqrtf(s2 * (1.f / D) + EPS);
      if (h == 0) rsv[r] = rs;
      float lg[20];
#pragma unroll
      for (int n = 0; n < 20; ++n) {
        const int reg = (n & 3) + 4 * (n >> 3), half = (n >> 2) & 1;
        const float mine = c[reg], oth = __shfl_xor(mine, 32);
        lg[n] = (h == half) ? mine : oth;
      }
      const int t = (int)tb + r;
      float gl[4];
#pragma unroll
      for (int q = 0; q < 4; ++q) gl[q] = lg[q] * rs + brg[q];
      int gi = 0; float gbest = gl[0];
#pragma unroll
      for (int q = 1; q < 4; ++q) if (gl[q] > gbest) { gbest = gl[q]; gi = q; }
      float den = 0.f;
#pragma unroll
      for (int q = 0; q < 4; ++q) den += expf(gl[q] - gbest);
      const float pg = 1.f / den;
      float le[4];
#pragma unroll
      for (int q = 0; q < 4; ++q) { float sel = 0.f;
#pragma unroll
        for (int gg2 = 0; gg2 < 4; ++gg2) sel = (gi == gg2) ? (lg[4 + gg2 * 4 + q] * rs + bre[gg2 * 4 + q]) : sel;
        le[q] = sel; }
      int i0 = 0; float l0 = le[0];
#pragma unroll
      for (int q = 1; q < 4; ++q) if (le[q] > l0) { l0 = le[q]; i0 = q; }
      int i1 = -1; float l1 = -INFINITY;
#pragma unroll
      for (int q = 0; q < 4; ++q) if (q != i0 && le[q] > l1) { l1 = le[q]; i1 = q; }
      const float e1 = expf(l1 - l0);
      const float w0 = pg / (1.f + e1), w1 = pg * e1 / (1.f + e1);
      const int elo = (i0 < i1) ? i0 : i1, ehi = (i0 < i1) ? i1 : i0;
      const float wlo = (i0 < i1) ? w0 : w1, whi = (i0 < i1) ? w1 : w0;
      const int pidx = (elo == 0) ? (ehi - 1) : ((elo == 1) ? (ehi + 1) : 5);
      const int cls = gi * 6 + pidx;
      if (h == 0) {
        const int slot = atomicAdd(&CNT[cls], 1);
        LIST[(size_t)cls * T + slot] = t;
        TOKW[t] = make_float2(wlo, whi);
      }
    }
    __syncthreads();
#pragma unroll 1
    for (int rr = wv * 8; rr < wv * 8 + 8; rr += 2) {
      const float rs0 = rsv[rr], rs1 = rsv[rr + 1];
      const float4* xr0 = (const float4*)(x1 + (tb + rr) * D); const float4* xr1 = (const float4*)(x1 + (tb + rr + 1) * D);
      float4 v0[4], v1[4];
#pragma unroll
      for (int j = 0; j < 4; ++j) { v0[j] = xr0[lane + 64 * j]; v1[j] = xr1[lane + 64 * j]; }
#pragma unroll
      for (int j = 0; j < 4; ++j) {
        const float4 gg = ((const float4*)g)[lane + 64 * j];
        ushort4 o; o.x = f2bf(v0[j].x * rs0 * gg.x); o.y = f2bf(v0[j].y * rs0 * gg.y); o.z = f2bf(v0[j].z * rs0 * gg.z); o.w = f2bf(v0[j].w * rs0 * gg.w);
        ((ushort4*)(XN + (tb + rr) * D))[lane + 64 * j] = o;
        ushort4 o1; o1.x = f2bf(v1[j].x * rs1 * gg.x); o1.y = f2bf(v1[j].y * rs1 * gg.y); o1.z = f2bf(v1[j].z * rs1 * gg.z); o1.w = f2bf(v1[j].w * rs1 * gg.w);
        ((ushort4*)(XN + (tb + rr + 1) * D))[lane + 64 * j] = o1;
      }
    }
  }
}

struct MoeItem { int cls, mtile, nt, cnt; };
DEVI void moe_prefix(const int* CNT, unsigned char* lds) {
  int* pre = (int*)(lds + LDS_BYTES + 64);
  __syncthreads();
  if (threadIdx.x < 24) pre[32 + threadIdx.x] = CNT[threadIdx.x];
  __syncthreads();
  if (threadIdx.x == 0) { int a = 0; for (int c = 0; c < 24; ++c) { pre[c] = a; a += (pre[32 + c] + 127) >> 7; } pre[24] = a; }
  __syncthreads();
}
DEVI bool moe_item(unsigned char* lds, int it, MoeItem& m) {
  const int* pre = (const int*)(lds + LDS_BYTES + 64);
  const int mt = it >> 3; m.nt = it & 7;
  if (mt >= pre[24]) return false;
  int c = 0;
#pragma unroll
  for (int q = 1; q < 24; ++q) c += (mt >= pre[q]) ? 1 : 0;
  m.cls = c; m.mtile = mt - pre[c]; m.cnt = pre[32 + c];
  return true;
}
DEVI void cls_experts(int cls, int& e0, int& e1) {
  const int g = cls / 6, pi = cls % 6;
  const int lo = (pi < 3) ? 0 : ((pi < 5) ? 1 : 2);
  const int hi = (pi < 3) ? (pi + 1) : ((pi < 5) ? (pi - 1) : 3);
  e0 = g * 4 + lo; e1 = g * 4 + hi;
}
DEVI void phase_g5(const Params& p, int l, unsigned char* lds) {
  const bf16_t* XN = (const bf16_t*)(p.ws + WS_A);
  bf16_t* HID = (bf16_t*)(p.ws + WS_B);
  const bf16_t* WGU = (const bf16_t*)(p.ws + WS_W + l * WS_WL + W_GU);
  const int* CNT = (const int*)(p.ws + SM_CNT) + l * 32;
  const int* LIST = (const int*)(p.ws + SM_LIST);
  const float2* TOKW = (const float2*)(p.ws + SM_TOKW);
  moe_prefix(CNT, lds);
  for (int it = blockIdx.x;; it += gridDim.x) {
    MoeItem mi; if (!moe_item(lds, it, mi)) break;
    int e0, e1; cls_experts(mi.cls, e0, e1);
    const int ex = (mi.nt < 4) ? e0 : e1, ntl = mi.nt & 3;
    const bf16_t* W = WGU + ((size_t)ex * 512 + ntl * 128) * 1024;
    const int* list = LIST + (size_t)mi.cls * T + mi.mtile * 128;
    const int nvalid = mi.cnt - mi.mtile * 128;
    f32x4 acc[4][4];
    gemm128(lds, D, [&](int r, int k) { const int tok = (r < nvalid) ? list[r] : list[0]; return *(const u32x4*)(XN + (size_t)tok * D + k); }, [&](int r, int k) { return W + (size_t)r * D + k; }, acc);
    {
      const int tid = threadIdx.x, wid = tid >> 6, lane = tid & 63, wr = wid >> 1, wc = wid & 1, fr = lane & 15, fq = lane >> 4;
#pragma unroll
      for (int m = 0; m < 4; ++m) {
        const int er = wr * 64 + m * 16 + fr;
        if (er < nvalid) {
          const int tok = list[er];
          const float2 tw = TOKW[tok];
          const float w = (mi.nt < 4) ? tw.x : tw.y;
#pragma unroll
          for (int n = 0; n < 2; ++n) {
            f32x4 hv;
#pragma unroll
            for (int j = 0; j < 4; ++j) { const float gt = acc[m][n][j], up = acc[m][n + 2][j]; hv[j] = gt * sigmoidf_(gt) * up * w; }
            const int hh = (mi.nt < 4 ? 0 : 256) + ntl * 64 + wc * 32 + n * 16 + fq * 4;
            st_bf16x4(HID + (size_t)tok * 512 + hh, hv);
          }
        }
      }
    }
  }
}
DEVI void phase_g6(const Params& p, int l, unsigned char* lds) {
  const bf16_t* HID = (const bf16_t*)(p.ws + WS_B);
  const bf16_t* WDN = (const bf16_t*)(p.ws + WS_W + l * WS_WL + W_DN);
  const int* CNT = (const int*)(p.ws + SM_CNT) + l * 32;
  const int* LIST = (const int*)(p.ws + SM_LIST);
  float* out = p.out;
  moe_prefix(CNT, lds);
  for (int it = blockIdx.x;; it += gridDim.x) {
    MoeItem mi; if (!moe_item(lds, it, mi)) break;
    int e0, e1; cls_experts(mi.cls, e0, e1);
    const int* list = LIST + (size_t)mi.cls * T + mi.mtile * 128;
    const int nvalid = mi.cnt - mi.mtile * 128;
    const bf16_t* W0 = WDN + ((size_t)e0 * 1024 + mi.nt * 128) * 256;
    const bf16_t* W1 = WDN + ((size_t)e1 * 1024 + mi.nt * 128) * 256;
    f32x4 acc[4][4];
    gemm128(lds, 512, [&](int r, int k) { const int tok = (r < nvalid) ? list[r] : list[0]; return *(const u32x4*)(HID + (size_t)tok * 512 + k); },
            [&](int r, int k) { return ((k < 256) ? W0 : W1) + (size_t)r * 256 + (k & 255); }, acc);
    GEMM_EPI4({ if (er < nvalid) { const size_t o = (size_t)list[er] * D + mi.nt * 128 + ec0; const f32x4 xi = *(const f32x4*)(out + o); *(f32x4*)(out + o) = xi + ev4; } })
  }
}


#define XB_TMO      128
#define XB_XCNT(j)  (256  + 64 * (j))
#define XB_XSUB(j)  (1280 + 64 * (j))
#define XB_XGEN(j)  (2304 + 64 * (j))
#define XB_TOP      3328
#define XB_TOPGEN   3392
#define XCD_BAR_WORDS 3456
#define XB_SPIN_CAP (1u << 18)
DEVI unsigned xb_ld(unsigned* p)              { return __hip_atomic_load(p, __ATOMIC_RELAXED, __HIP_MEMORY_SCOPE_AGENT); }
DEVI unsigned xb_add(unsigned* p, unsigned v) { return __hip_atomic_fetch_add(p, v, __ATOMIC_RELAXED, __HIP_MEMORY_SCOPE_AGENT); }
DEVI unsigned xb_xcc_id() { return (unsigned)__builtin_amdgcn_s_getreg((3 << 11) | 20) & 0xFu; }
#define XB_SPIN(cond, bar) do { unsigned _sp = 0; while (cond) { __builtin_amdgcn_s_sleep(1); \
    if ((++_sp & 255u) == 0u) { if (xb_ld(&(bar)[XB_TMO])) break; if (_sp > XB_SPIN_CAP) { atomicAdd(&(bar)[XB_TMO], 1u); break; } } } } while (0)
struct XcdBarrier { unsigned* bar; unsigned x; volatile LAS unsigned* st; };
DEVI XcdBarrier xcd_barrier_post(unsigned* bar, volatile LAS unsigned* st) {
    XcdBarrier b; b.bar = bar; b.x = xb_xcc_id(); b.st = st;
    if (threadIdx.x == 0) (void)xb_add(&bar[XB_XCNT(b.x)], 1u);
    return b;
}
DEVI void xcd_barrier_complete(unsigned* bar, unsigned x, unsigned& nloc, unsigned& nx) {
    const unsigned G = gridDim.x * gridDim.y * gridDim.z;
    unsigned sum, cnt, mine, sp = 0u;
    for (;;) {
        sum = 0u; cnt = 0u; mine = 0u;
#pragma unroll
        for (unsigned j = 0; j < 16; ++j) { const unsigned c = xb_ld(&bar[XB_XCNT(j)]); sum += c; cnt += (c > 0u) ? 1u : 0u; mine = (j == x) ? c : mine; }
        if (sum == G) break;
        __builtin_amdgcn_s_sleep(1);
        if ((++sp & 255u) == 0u) { if (xb_ld(&bar[XB_TMO])) break; if (sp > XB_SPIN_CAP) { atomicAdd(&bar[XB_TMO], 1u); break; } }
    }
    nloc = mine > 0u ? mine : 1u; nx = cnt > 0u ? cnt : 1u;
}
DEVI void xcd_barrier(const XcdBarrier& b) {
    asm volatile("s_waitcnt vmcnt(0)" ::: "memory");
    __syncthreads();
    if (threadIdx.x == 0) {
        unsigned* bar = b.bar;
        __builtin_amdgcn_s_waitcnt(0);
        unsigned nloc = b.st[0], nx = b.st[1];
        if (nloc == 0u) { xcd_barrier_complete(bar, b.x, nloc, nx); b.st[0] = nloc; b.st[1] = nx; }
        const unsigned old = xb_add(&bar[XB_XSUB(b.x)], 1u);
        const unsigned gen = old / nloc;
        if (old + 1u == (gen + 1u) * nloc) {
            __builtin_amdgcn_fence(__ATOMIC_RELEASE, "agent");
            asm volatile("s_waitcnt vmcnt(0)" ::: "memory");
            const unsigned og = xb_add(&bar[XB_TOP], 1u);
            const unsigned tg = og / nx;
            if (og + 1u == (tg + 1u) * nx) xb_add(&bar[XB_TOPGEN], 1u);
            else XB_SPIN(xb_ld(&bar[XB_TOPGEN]) == tg, bar);
            __builtin_amdgcn_fence(__ATOMIC_ACQUIRE, "agent");
            xb_add(&bar[XB_XGEN(b.x)], 1u);
            asm volatile("s_waitcnt vmcnt(0)" ::: "memory");
        } else {
            XB_SPIN(xb_ld(&bar[XB_XGEN(b.x)]) == gen, bar);
            __builtin_amdgcn_fence(__ATOMIC_ACQUIRE, "agent");
            asm volatile("s_waitcnt vmcnt(0)" ::: "memory");
        }
    }
    __syncthreads();
}

#define PH(k, call) { const int _k = (k); if (p.lo <= _k && _k < p.hi) { call; if (_k + 1 < p.hi) { if (_k == 0) grid.sync(); else xcd_barrier(xbar); } } }
__global__ void __launch_bounds__(NTHREADS, 2) hybrid_fwd(Params p) {
  extern __shared__ __attribute__((aligned(16))) unsigned char lds[];
  cg::grid_group grid = cg::this_grid();
  volatile LAS unsigned* xst = (volatile LAS unsigned*)(LAS unsigned char*)(lds + LDS_BYTES);
  if (threadIdx.x < 4) xst[threadIdx.x] = 0u;
  __syncthreads();
  XcdBarrier xbar = xcd_barrier_post((unsigned*)(p.ws + WS_CTL), xst);
  PH(0, phase_prep(p, lds))
#define LAYER(l) { \
    PH(1 + 13 * l + 0, phase_g1(p, l, lds)) \
    PH(1 + 13 * l + 2, phase_g2(p, l, lds)) \
    PH(1 + 13 * l + 3, phase_r2(p, l, lds)) \
    PH(1 + 13 * l + 4, phase_a1(p, l, lds)) \
    PH(1 + 13 * l + 5, phase_r3(p, l, lds)) \
    PH(1 + 13 * l + 6, phase_g3(p, l, lds)) \
    PH(1 + 13 * l + 7, phase_r4(p, l)) \
    PH(1 + 13 * l + 8, phase_g4(p, l, lds)) \
    PH(1 + 13 * l + 9, phase_r5(p, l, lds)) \
    PH(1 + 13 * l + 10, phase_g5(p, l, lds)) \
    PH(1 + 13 * l + 11, phase_g6(p, l, lds)) }
  LAYER(0)
  PH(13, rmsnorm_rows(p.out, p.in[2] + D, (bf16_t*)(p.ws + WS_A)))
  LAYER(1)
}

extern "C" void kernel_launch(void* const* d_in, const int* in_sizes, int n_in, void* d_out, int out_size, void* d_ws, size_t ws_size, hipStream_t stream) {
  static int grid_blocks = 0;
  if (!grid_blocks) {
    if (n_in != 45 || ws_size < WS_END) { fprintf(stderr, "kernel_launch: unexpected n_in %d or ws_size %zu (< %zu)\n", n_in, ws_size, (size_t)WS_END); grid_blocks = -1; return; }
    int dev = 0, cus = 0, per_cu = 0;
    hipGetDevice(&dev);
    hipDeviceGetAttribute(&cus, hipDeviceAttributeMultiprocessorCount, dev);
    hipFuncSetAttribute((const void*)hybrid_fwd, hipFuncAttributeMaxDynamicSharedMemorySize, LDS_ALLOC);
    hipOccupancyMaxActiveBlocksPerMultiprocessor(&per_cu, (const void*)hybrid_fwd, NTHREADS, LDS_ALLOC);
    if (per_cu < 1) per_cu = 1;
    if (per_cu > 2) per_cu = 2;
    grid_blocks = cus * per_cu;
    fprintf(stderr, "kernel_launch: cus %d per_cu %d grid %d\n", cus, per_cu, grid_blocks);
  }
  if (grid_blocks < 0) return;
  (void)hipMemsetAsync((unsigned char*)d_ws + WS_CTL, 0, XCD_BAR_WORDS * 4, stream);
  Params p{};
  for (int i = 0; i < 45; ++i) p.in[i] = (const float*)d_in[i];
  p.out = (float*)d_out; p.ws = (unsigned char*)d_ws;
#if N_LAUNCH_MODE == 1
  p.lo = 0; p.hi = NPH;
  { void* args[] = {&p}; hipError_t e = hipLaunchCooperativeKernel((void*)hybrid_fwd, dim3(grid_blocks), dim3(NTHREADS), args, LDS_ALLOC, stream);
    if (e != hipSuccess) fprintf(stderr, "cooperative launch failed: %s\n", hipGetErrorString(e)); }
#else
  for (int ph = 0; ph < NPH; ++ph) {
    p.lo = ph; p.hi = ph + 1;
    void* args[] = {&p}; hipError_t e = hipLaunchCooperativeKernel((void*)hybrid_fwd, dim3(grid_blocks), dim3(NTHREADS), args, LDS_ALLOC, stream);
    if (e != hipSuccess) { fprintf(stderr, "launch %d failed: %s\n", ph, hipGetErrorString(e)); break; }
  }
#endif
}
```

```cpp
#include <hip/hip_runtime.h>
#include <hip/hip_cooperative_groups.h>
#include <cstdio>
#include <cstdint>
namespace cg = cooperative_groups;

#ifndef N_LAUNCH_MODE
#define N_LAUNCH_MODE 1
#endif

#define DEVI __device__ __forceinline__
typedef unsigned short bf16_t;
typedef short bf16x8 __attribute__((ext_vector_type(8)));
typedef float f32x4 __attribute__((ext_vector_type(4)));
typedef float f32x16 __attribute__((ext_vector_type(16)));
typedef unsigned u32x4 __attribute__((ext_vector_type(4)));
#define LAS __attribute__((address_space(3)))

constexpr int NB = 16, S = 2048, T = NB * S, D = 1024, DIN = 1772, DINP = 1792, NL = 2;
constexpr int C_CQ = 0, C_KPE = 192, C_NG = 224, C_CKV = 256, C_LX = 384, C_LG = 640, C_S5 = 896, C_NQ = 1152, C_KS = 1408, C_KW = 1472, C_KC = 1536, C_VC = 1600, C_VS = 1664, C_VW = 1728;
__host__ __device__ constexpr int colmap(int n) {
  if (n < 192) return n;
  if (n < 320) return C_CKV + (n - 192);
  if (n < 352) return C_KPE + (n - 320);
  if (n < 608) return C_LX + (n - 352);
  if (n < 864) return C_LG + (n - 608);
  if (n < 1120) return C_S5 + (n - 864);
  if (n < 1376) return C_NQ + (n - 1120);
  if (n < 1760) { const int j = n - 1376, part = j >> 6, d = j & 63; return (part == 0 ? C_KC : part == 1 ? C_VC : part == 2 ? C_KS : part == 3 ? C_VS : part == 4 ? C_KW : C_VW) + d; }
  return C_NG + (n - 1760);
}
constexpr float EPS = 1e-6f;
constexpr float LOG2E = 1.4426950408889634f;
constexpr int NTHREADS = 256;
constexpr int NPH = 1 + 13 * NL - 1;

constexpr size_t MiB = 1u << 20;
constexpr size_t WS_CTL = 0;
constexpr size_t WS_SMALL = 1 * MiB;
constexpr size_t WS_W = 16 * MiB;
constexpr size_t WS_WL = 32 * MiB;
constexpr size_t WS_A = 80 * MiB;
constexpr size_t WS_B = 144 * MiB;
constexpr size_t WS_C = 256 * MiB;
constexpr size_t WS_D = 292 * MiB;
constexpr size_t WS_E = 348 * MiB;
constexpr size_t WS_F = 380 * MiB;
constexpr size_t WS_G = 428 * MiB;
constexpr size_t WS_ROPE = 452 * MiB;
constexpr size_t WS_END = 460 * MiB;
constexpr size_t W_IN = 0;
constexpr size_t W_OUT = 4 * MiB;
constexpr size_t W_UQ = 6 * MiB;
constexpr size_t W_UKV = W_UQ + 384 * 192 * 2;
constexpr size_t W_LRU = W_UKV + 512 * 128 * 2;
constexpr size_t W_GLU = W_LRU + 4 * 128 * 64 * 2;
constexpr size_t W_1K = 6 * MiB + 512 * 1024;
constexpr size_t W_1V = W_1K + 128 * 2048 * 2;
constexpr size_t W_B1K = W_1V + 128 * 2048 * 2;
constexpr size_t W_B1V = W_B1K + 512;
constexpr size_t W_S5A = W_B1V + 512;
constexpr size_t W_S5A64 = W_S5A + 16 * 64 * 8;
constexpr size_t W_S5B = W_S5A64 + 16 * 64 * 8;
constexpr size_t W_S5BB = W_S5B + 16 * 64 * 16 * 8;
constexpr size_t W_S5CM = W_S5BB + 16 * 4 * 32 * 16 * 2;
constexpr size_t W_2K = W_S5CM + 16 * 16 * 128 * 2;
constexpr size_t W_2V = W_2K + 64 * 128 * 2;
static_assert(W_2V + 64 * 128 * 2 <= 8 * MiB, "weights overflow");
constexpr size_t W_RTH = W_2V + 64 * 128 * 2;
constexpr size_t W_RTL = W_RTH + 32 * 1024 * 2;
static_assert(W_RTL + 32 * 1024 * 2 <= 8 * MiB, "weights overflow 2");
constexpr size_t W_GU = 8 * MiB;
constexpr size_t W_DN = 24 * MiB;
constexpr size_t SM_CNT = WS_SMALL;
constexpr size_t SM_LIST = WS_SMALL + 4096;
constexpr size_t SM_TOKW = SM_LIST + 24 * (size_t)T * 4;
constexpr size_t SM_LSUM = SM_TOKW + (size_t)T * 8;
constexpr size_t SM_SLOC = SM_LSUM + 16 * 32 * 256 * 8;
constexpr size_t SM_HK = SM_SLOC + 16 * 32 * 1024 * 8;
constexpr size_t SM_HV = SM_HK + 2048 * 128 * 2;
constexpr size_t SM_KC = SM_HV + 2048 * 128 * 2;
constexpr size_t SM_VC = SM_KC + 16 * 128 * 64 * 2;
constexpr size_t SM_SCAR = SM_VC + 16 * 128 * 64 * 2;
constexpr size_t SM_LCAR = SM_SCAR + 16 * 32 * 1024 * 8;
constexpr size_t SM_END = SM_LCAR + 16 * 32 * 256 * 4;
static_assert(SM_END <= WS_W, "small region overflow");

constexpr int LDS_BYTES = 65536;
constexpr int LDS_ALLOC = LDS_BYTES + 512;

struct Params {
  const float* in[45];
  float* out;
  unsigned char* ws;
  int lo, hi;
};

DEVI float bf2f(bf16_t v) { return __uint_as_float(((unsigned)v) << 16); }
DEVI bf16_t f2bf(float f) { unsigned u = __float_as_uint(f); return (bf16_t)((u + 0x7fffu + ((u >> 16) & 1u)) >> 16); }
DEVI float wsum(float v) {
#pragma unroll
  for (int o = 32; o >= 1; o >>= 1) v += __shfl_xor(v, o);
  return v;
}
DEVI float sigmoidf_(float x) { return 1.f / (1.f + __expf(-x)); }
DEVI float gelu_tanh(float x) { return 0.5f * x * (1.f + tanhf(0.7978845608028654f * (x + 0.044715f * x * x * x))); }
DEVI f32x16 mfma32(bf16x8 a, bf16x8 b, f32x16 c) { return __builtin_amdgcn_mfma_f32_32x32x16_bf16(a, b, c, 0, 0, 0); }
DEVI f32x4 mfma16(bf16x8 a, bf16x8 b, f32x4 c) { return __builtin_amdgcn_mfma_f32_16x16x32_bf16(a, b, c, 0, 0, 0); }
DEVI int vblock() { const int G = (int)gridDim.x, bx = (int)blockIdx.x; return (G % 8 == 0) ? (bx % 8) * (G / 8) + bx / 8 : bx; }
DEVI int crow(int r, int h) { return (r & 3) + 8 * (r >> 2) + 4 * h; }
typedef __bf16 bf16x2_t __attribute__((ext_vector_type(2)));
typedef float f32x2_t __attribute__((ext_vector_type(2)));
DEVI unsigned pk2bf(float lo, float hi) { f32x2_t v = {lo, hi}; bf16x2_t b = __builtin_convertvector(v, bf16x2_t); return __builtin_bit_cast(unsigned, b); }

template <class AF, class BF>
DEVI void gemm128(unsigned char* lds, int K, AF aload, BF bptr, f32x4 (&acc)[4][4]) {
  const int tid = threadIdx.x, wid = tid >> 6, lane = tid & 63, wr = wid >> 1, wc = wid & 1, fr = lane & 15, fq = lane >> 4;
#pragma unroll
  for (int m = 0; m < 4; ++m)
#pragma unroll
    for (int n = 0; n < 4; ++n) acc[m][n] = (f32x4){0.f, 0.f, 0.f, 0.f};
  const int lr = tid >> 3, ch = tid & 7;
  const int wofs = lr * 128 + ((ch ^ ((lr >> 1) & 7)) * 16);
  const int sw = (fr >> 1) & 7;
  const int aro = (wr * 64 + fr) * 128, bro = (wc * 64 + fr) * 128;
  const int nk = K >> 6;
  u32x4 ra[4], rb[4];
#pragma unroll
  for (int i = 0; i < 4; ++i) { ra[i] = aload(lr + 32 * i, ch * 8); rb[i] = *(const u32x4*)bptr(lr + 32 * i, ch * 8); }
  __syncthreads();
#pragma unroll
  for (int i = 0; i < 4; ++i) { *(u32x4*)(lds + wofs + i * 4096) = ra[i]; *(u32x4*)(lds + 16384 + wofs + i * 4096) = rb[i]; }
  __syncthreads();
  for (int kt = 0; kt < nk; ++kt) {
    const bool more = (kt + 1 < nk);
    if (more) {
      const int k = (kt + 1) * 64 + ch * 8;
#pragma unroll
      for (int i = 0; i < 4; ++i) { ra[i] = aload(lr + 32 * i, k); rb[i] = *(const u32x4*)bptr(lr + 32 * i, k); }
    }
    const unsigned char* bufA = lds + (kt & 1) * 32768;
    const unsigned char* bufB = bufA + 16384;
#pragma unroll
    for (int kk = 0; kk < 2; ++kk) {
      bf16x8 At[4], Bt[4];
      const int co = ((kk * 4 + fq) ^ sw) * 16;
#pragma unroll
      for (int m = 0; m < 4; ++m) At[m] = *(const bf16x8*)(bufA + aro + m * 2048 + co);
#pragma unroll
      for (int n = 0; n < 4; ++n) Bt[n] = *(const bf16x8*)(bufB + bro + n * 2048 + co);
#pragma unroll
      for (int m = 0; m < 4; ++m)
#pragma unroll
        for (int n = 0; n < 4; ++n) acc[m][n] = mfma16(Bt[n], At[m], acc[m][n]);
    }
    if (more) {
      unsigned char* nb = lds + ((kt + 1) & 1) * 32768;
#pragma unroll
      for (int i = 0; i < 4; ++i) { *(u32x4*)(nb + wofs + i * 4096) = ra[i]; *(u32x4*)(nb + 16384 + wofs + i * 4096) = rb[i]; }
    }
    __syncthreads();
  }
}
template <class AF, class BF>
DEVI void gemm128g(unsigned char* lds, int K, AF aptr, BF bptr, f32x4 (&acc)[4][4]) {
  const int tid = threadIdx.x, wid = tid >> 6, lane = tid & 63, wr = wid >> 1, wc = wid & 1, fr = lane & 15, fq = lane >> 4;
#pragma unroll
  for (int m = 0; m < 4; ++m)
#pragma unroll
    for (int n = 0; n < 4; ++n) acc[m][n] = (f32x4){0.f, 0.f, 0.f, 0.f};
  const int lr = tid >> 3;
  const int chs = ((tid & 7) ^ ((lr >> 1) & 7)) * 8;
  const int sw = (fr >> 1) & 7;
  const int aro = (wr * 64 + fr) * 128, bro = (wc * 64 + fr) * 128;
  const int nk = K >> 6;
  LAS unsigned char* l3 = (LAS unsigned char*)lds;
#define G128_STAGE(buf, kbase)                                                                                                   \
  _Pragma("unroll") for (int i = 0; i < 4; ++i) {                                                                                 \
    __builtin_amdgcn_global_load_lds((const __attribute__((address_space(1))) unsigned*)aptr(lr + 32 * i, (kbase) + chs),          \
                                     (LAS unsigned*)(l3 + (buf) * 32768 + tid * 16 + i * 4096), 16, 0, 0);                           \
    __builtin_amdgcn_global_load_lds((const __attribute__((address_space(1))) unsigned*)bptr(lr + 32 * i, (kbase) + chs),          \
                                     (LAS unsigned*)(l3 + (buf) * 32768 + 16384 + tid * 16 + i * 4096), 16, 0, 0);                   \
  }
  __syncthreads();
  G128_STAGE(0, 0)
  asm volatile("s_waitcnt vmcnt(0)" ::: "memory");
  __syncthreads();
  for (int kt = 0; kt < nk; ++kt) {
    if (kt + 1 < nk) { G128_STAGE((kt + 1) & 1, (kt + 1) * 64) }
    const unsigned char* bufA = lds + (kt & 1) * 32768;
    const unsigned char* bufB = bufA + 16384;
#pragma unroll
    for (int kk = 0; kk < 2; ++kk) {
      bf16x8 At[4], Bt[4];
      const int co = ((kk * 4 + fq) ^ sw) * 16;
#pragma unroll
      for (int m = 0; m < 4; ++m) At[m] = *(const bf16x8*)(bufA + aro + m * 2048 + co);
#pragma unroll
      for (int n = 0; n < 4; ++n) Bt[n] = *(const bf16x8*)(bufB + bro + n * 2048 + co);
#pragma unroll
      for (int m = 0; m < 4; ++m)
#pragma unroll
        for (int n = 0; n < 4; ++n) acc[m][n] = mfma16(Bt[n], At[m], acc[m][n]);
    }
    asm volatile("s_waitcnt vmcnt(0)" ::: "memory");
    __syncthreads();
  }
#undef G128_STAGE
}
#define GEMM_EPI_LOOP(body)                                                                 \
  {                                                                                         \
    const int _tid = threadIdx.x, _wid = _tid >> 6, _lane = _tid & 63, _wr = _wid >> 1, _wc = _wid & 1, _fr = _lane & 15, _fq = _lane >> 4; \
    _Pragma("unroll") for (int m = 0; m < 4; ++m) _Pragma("unroll") for (int n = 0; n < 4; ++n) _Pragma("unroll") for (int j = 0; j < 4; ++j) { \
      const int er = _wr * 64 + m * 16 + _fr, ec = _wc * 64 + n * 16 + _fq * 4 + j; const float ev = acc[m][n][j]; body }                      \
  }
#define GEMM_EPI4(body)                                                                     \
  {                                                                                         \
    const int _tid = threadIdx.x, _wid = _tid >> 6, _lane = _tid & 63, _wr = _wid >> 1, _wc = _wid & 1, _fr = _lane & 15, _fq = _lane >> 4; \
    _Pragma("unroll") for (int m = 0; m < 4; ++m) _Pragma("unroll") for (int n = 0; n < 4; ++n) {                                             \
      const int er = _wr * 64 + m * 16 + _fr, ec0 = _wc * 64 + n * 16 + _fq * 4; const f32x4 ev4 = acc[m][n]; body }                          \
  }
DEVI void st_bf16x4(bf16_t* p, f32x4 v) { ushort4 o; o.x = f2bf(v[0]); o.y = f2bf(v[1]); o.z = f2bf(v[2]); o.w = f2bf(v[3]); *(ushort4*)p = o; }

template <class RM>
DEVI void transpose_tiles(const float* src, int K, int N, bf16_t* dst, int ldk, RM rowmap, unsigned char* lds, int& cursor, const float* kscale = nullptr) {
  float* tl = (float*)lds;
  const int tk = K / 64, tn = (N + 63) / 64, nt = tk * tn;
  const int tid = threadIdx.x;
  const int G_ = (int)gridDim.x;
  for (int it = ((int)blockIdx.x - cursor % G_ + G_) % G_; it < nt; it += G_) {
    const int kt = it / tn, ntile = it % tn, k0 = kt * 64, n0 = ntile * 64;
    __syncthreads();
#pragma unroll
    for (int q = 0; q < 4; ++q) {
      const int r = (tid >> 4) + 16 * q, c4 = (tid & 15) * 4;
      const float* sp = src + (size_t)(k0 + r) * N + n0 + c4;
      float4 v;
      if (n0 + c4 + 3 < N) v = *(const float4*)sp;
      else { v.x = (n0 + c4 < N) ? sp[0] : 0.f; v.y = (n0 + c4 + 1 < N) ? sp[1] : 0.f; v.z = (n0 + c4 + 2 < N) ? sp[2] : 0.f; v.w = 0.f; }
      if (kscale) { const float ks = kscale[k0 + r]; v.x *= ks; v.y *= ks; v.z *= ks; v.w *= ks; }
      tl[r * 65 + c4] = v.x; tl[r * 65 + c4 + 1] = v.y; tl[r * 65 + c4 + 2] = v.z; tl[r * 65 + c4 + 3] = v.w;
    }
    __syncthreads();
    const int n = tid >> 2, kc = (tid & 3) * 16;
    if (n0 + n < N) {
      unsigned w[8];
#pragma unroll
      for (int i = 0; i < 8; ++i) w[i] = (unsigned)f2bf(tl[(kc + 2 * i) * 65 + n]) | ((unsigned)f2bf(tl[(kc + 2 * i + 1) * 65 + n]) << 16);
      uint4* o = (uint4*)(dst + (size_t)rowmap(n0 + n) * ldk + k0 + kc);
      o[0] = make_uint4(w[0], w[1], w[2], w[3]); o[1] = make_uint4(w[4], w[5], w[6], w[7]);
    }
  }
  cursor += nt;
}
DEVI void rmsnorm_rows(const float* x, const float* g, bf16_t* xn) {
  const int lane = threadIdx.x & 63, gw = blockIdx.x * 4 + (threadIdx.x >> 6), NGW = gridDim.x * 4;
  for (int t = gw; t < T; t += NGW) {
    const float4* xr = (const float4*)(x + (size_t)t * D);
    float4 v[4]; float s = 0.f;
#pragma unroll
    for (int j = 0; j < 4; ++j) { v[j] = xr[lane + 64 * j]; s += v[j].x * v[j].x + v[j].y * v[j].y + v[j].z * v[j].z + v[j].w * v[j].w; }
    const float rs = rsqrtf(wsum(s) * (1.f / D) + EPS);
#pragma unroll
    for (int j = 0; j < 4; ++j) {
      const float4 gg = ((const float4*)g)[lane + 64 * j];
      ushort4 o; o.x = f2bf(v[j].x * rs * gg.x); o.y = f2bf(v[j].y * rs * gg.y); o.z = f2bf(v[j].z * rs * gg.z); o.w = f2bf(v[j].w * rs * gg.w);
      ((ushort4*)(xn + (size_t)t * D))[lane + 64 * j] = o;
    }
  }
}
DEVI void phase_prep(const Params& p, unsigned char* lds) {
  const size_t gtid = (size_t)blockIdx.x * NTHREADS + threadIdx.x, gn = (size_t)gridDim.x * NTHREADS;
  unsigned char* ws = p.ws;
  if (gtid < 64) ((int*)(ws + SM_CNT))[gtid] = 0;
  auto ident = [](int n) { return n; };
  int cursor = 0;
  for (int l = 0; l < NL; ++l) {
    unsigned char* wl = ws + WS_W + l * WS_WL;
    transpose_tiles(p.in[3] + (size_t)l * D * DIN, D, DIN, (bf16_t*)(wl + W_IN), D, [](int n) { return colmap(n); }, lds, cursor);
    for (size_t i = gtid; i < (size_t)20 * D; i += gn) ((bf16_t*)(wl + W_IN))[(size_t)236 * D + i] = 0;
    transpose_tiles(p.in[36] + (size_t)l * D * D, D, D, (bf16_t*)(wl + W_OUT), D, ident, lds, cursor);
    transpose_tiles(p.in[6] + (size_t)l * 192 * 384, 192, 384, (bf16_t*)(wl + W_UQ), 192, ident, lds, cursor, p.in[4] + l * 192);
    transpose_tiles(p.in[7] + (size_t)l * 128 * 512, 128, 512, (bf16_t*)(wl + W_UKV), 128, ident, lds, cursor, p.in[5] + l * 128);
    transpose_tiles(p.in[25] + (size_t)l * 256 * 256, 256, 256, (bf16_t*)(wl + W_GLU), 256, ident, lds, cursor);
    transpose_tiles(p.in[30] + (size_t)l * 2048 * 128, 2048, 128, (bf16_t*)(wl + W_1K), 2048, ident, lds, cursor);
    transpose_tiles(p.in[33] + (size_t)l * 2048 * 128, 2048, 128, (bf16_t*)(wl + W_1V), 2048, ident, lds, cursor);
    transpose_tiles(p.in[31] + (size_t)l * 128 * 64, 128, 64, (bf16_t*)(wl + W_2K), 128, ident, lds, cursor);
    transpose_tiles(p.in[34] + (size_t)l * 128 * 64, 128, 64, (bf16_t*)(wl + W_2V), 128, ident, lds, cursor);
    for (int h = 0; h < 4; ++h) {
      transpose_tiles(p.in[12] + ((size_t)l * 4 + h) * 64 * 64, 64, 64, (bf16_t*)(wl + W_LRU) + h * 128 * 64, 64, ident, lds, cursor);
      transpose_tiles(p.in[14] + ((size_t)l * 4 + h) * 64 * 64, 64, 64, (bf16_t*)(wl + W_LRU) + h * 128 * 64 + 64 * 64, 64, ident, lds, cursor);
    }
    for (int e = 0; e < 16; ++e) {
      bf16_t* dg = (bf16_t*)(wl + W_GU) + (size_t)e * 512 * 1024;
      transpose_tiles(p.in[42] + ((size_t)l * 16 + e) * 1024 * 256, 1024, 256, dg, 1024, [](int hh) { return (hh >> 6) * 128 + ((hh >> 5) & 1) * 64 + ((hh >> 4) & 1) * 16 + (hh & 15); }, lds, cursor);
      transpose_tiles(p.in[43] + ((size_t)l * 16 + e) * 1024 * 256, 1024, 256, dg, 1024, [](int hh) { return (hh >> 6) * 128 + ((hh >> 5) & 1) * 64 + (((hh >> 4) & 1) + 2) * 16 + (hh & 15); }, lds, cursor);
      transpose_tiles(p.in[44] + ((size_t)l * 16 + e) * 256 * 1024, 256, 1024, (bf16_t*)(wl + W_DN) + (size_t)e * 1024 * 256, 256, ident, lds, cursor);
    }
    {
      const int lane = threadIdx.x & 63, gw = blockIdx.x * 4 + (threadIdx.x >> 6), NGW = gridDim.x * 4;
      for (int o = gw; o < 256; o += NGW) {
        const int kv = o >> 7, j = o & 127;
        const float* pe = (kv ? p.in[32] : p.in[29]) + (size_t)l * 2048;
        const float* w1 = (kv ? p.in[33] : p.in[30]) + (size_t)l * 2048 * 128;
        float a = 0.f;
#pragma unroll 8
        for (int k = lane; k < 2048; k += 64) a += pe[k] * w1[(size_t)k * 128 + j];
        a = wsum(a);
        if (lane == 0) ((float*)(wl + (kv ? W_B1V : W_B1K)))[j] = a;
      }
    }
    for (size_t i = gtid; i < 16 * 64; i += gn) {
      const int g = (int)(i >> 6), sidx = (int)(i & 63);
      const float are = p.in[17][(size_t)l * 1024 + i], aim = p.in[18][(size_t)l * 1024 + i];
      const float dt = expf(p.in[19][l * 16 + g]);
      const float mag = expf(dt * are);
      float sn, cs; sincosf(dt * aim, &sn, &cs);
      const float abr = mag * cs, abi = mag * sn;
      const float den = are * are + aim * aim, nre = abr - 1.f;
      const float gre = (nre * are + abi * aim) / den, gim = (abi * are - nre * aim) / den;
      ((float2*)(wl + W_S5A))[i] = make_float2(abr, abi);
      float pr = abr, pi = abi;
#pragma unroll
      for (int q = 0; q < 6; ++q) { const float nr = pr * pr - pi * pi, ni = 2.f * pr * pi; pr = nr; pi = ni; }
      ((float2*)(wl + W_S5A64))[i] = make_float2(pr, pi);
      bf16_t* bb = (bf16_t*)(wl + W_S5BB);
      for (int ch = 0; ch < 16; ++ch) {
        const float br = p.in[20][((size_t)l * 1024 + i) * 16 + ch], bi = p.in[21][((size_t)l * 1024 + i) * 16 + ch];
        const float vr = gre * br - gim * bi, vi = gre * bi + gim * br;
        const int sb = sidx >> 5, r = sidx & 31;
        bb[((g * 4 + sb * 2 + 0) * 32 + r) * 16 + ch] = f2bf(vr);
        bb[((g * 4 + sb * 2 + 1) * 32 + r) * 16 + ch] = f2bf(vi);
      }
    }
    for (size_t i = gtid; i < 32 * 1024; i += gn) {
      const int n = (int)(i >> 10), k = (int)(i & 1023);
      float w = 0.f;
      if (n < 20) w = p.in[37][l * D + k] * ((n < 4) ? p.in[38][((size_t)l * D + k) * 4 + n] : p.in[40][((size_t)l * D + k) * 16 + (n - 4)]);
      const bf16_t hi = f2bf(w);
      ((bf16_t*)(wl + W_RTH))[i] = hi; ((bf16_t*)(wl + W_RTL))[i] = f2bf(w - bf2f(hi));
    }
    for (size_t i = gtid; i < 16 * 16 * 64; i += gn) {
      const int g = (int)(i >> 10), ch = (int)((i >> 6) & 15), pp = (int)(i & 63);
      const float cr = p.in[22][(size_t)l * 16384 + i], ci = p.in[23][(size_t)l * 16384 + i];
      bf16_t* cm = (bf16_t*)(wl + W_S5CM) + ((size_t)(g * 16 + ch) * 128 + 2 * pp);
      cm[0] = f2bf(cr); cm[1] = f2bf(-ci);
    }
  }
  {
    const int* positions = (const int*)p.in[1];
    float2* RM = (float2*)(ws + WS_ROPE);
    float2* RN = RM + (size_t)T * 16;
    for (size_t i = gtid; i < (size_t)T * 24; i += gn) {
      const int t = (int)(i / 24), j = (int)(i % 24);
      const int rot = (j < 16) ? 32 : 16, fi = (j < 16) ? j : (j - 16);
      const float inv = powf(500000.f, -(2.f * (float)fi) / (float)rot);
      float sn, cs; sincosf((float)positions[t] * inv, &sn, &cs);
      if (j < 16) RM[(size_t)t * 16 + fi] = make_float2(cs, sn); else RN[(size_t)t * 8 + fi] = make_float2(cs, sn);
    }
  }
  rmsnorm_rows(p.in[0], p.in[2], (bf16_t*)(ws + WS_A));
}

DEVI void phase_g1(const Params& p, int l, unsigned char* lds) {
  const bf16_t* XN = (const bf16_t*)(p.ws + WS_A);
  const bf16_t* W = (const bf16_t*)(p.ws + WS_W + l * WS_WL + W_IN);
  bf16_t* PROJ = (bf16_t*)(p.ws + WS_B);
  constexpr int NT = DINP / 128;
  for (int it = vblock(); it < (T / 128) * NT; it += gridDim.x) {
    const int mt = it / NT, nt = it % NT;
    f32x4 acc[4][4];
    gemm128g(lds, D, [&](int r, int k) { return XN + (size_t)(mt * 128 + r) * D + k; }, [&](int r, int k) { return W + (size_t)(nt * 128 + r) * D + k; }, acc);
    if (nt >= 9 && nt <= 11) {
      const int tid = threadIdx.x, wid = tid >> 6, lane = tid & 63, wr = wid >> 1, wc = wid & 1, fr = lane & 15, fq = lane >> 4;
      const float* gg = (nt < 11) ? (p.in[27] + l * 64) : (p.in[28] + l * 192 + (wc ? 128 : 64));
      const float sc = (nt < 11) ? (0.125f * LOG2E) : 1.f;
      const float2* RN = (const float2*)(p.ws + WS_ROPE) + (size_t)T * 16;
#pragma unroll
      for (int m = 0; m < 4; ++m) {
        const size_t t = (size_t)mt * 128 + wr * 64 + m * 16 + fr;
        float ss = 0.f;
#pragma unroll
        for (int n = 0; n < 4; ++n) ss += acc[m][n][0] * acc[m][n][0] + acc[m][n][1] * acc[m][n][1] + acc[m][n][2] * acc[m][n][2] + acc[m][n][3] * acc[m][n][3];
        ss += __shfl_xor(ss, 16); ss += __shfl_xor(ss, 32);
        const float rs = rsqrtf(ss * (1.f / 64) + EPS);
#pragma unroll
        for (int n = 0; n < 4; ++n) {
          const float4 g4 = *(const float4*)(gg + n * 16 + fq * 4);
          f32x4 v = acc[m][n];
          v[0] *= rs * g4.x; v[1] *= rs * g4.y; v[2] *= rs * g4.z; v[3] *= rs * g4.w;
          if (n == 0) {
#pragma unroll
            for (int j = 0; j < 4; ++j) {
              const float x = v[j], partner = __shfl_xor(x, 32);
              const int d = fq * 4 + j; const float2 cs2 = RN[t * 8 + (d & 7)];
              v[j] = (d < 8) ? (x * cs2.x - partner * cs2.y) : (partner * cs2.y + x * cs2.x);
            }
          }
          st_bf16x4(PROJ + t * DINP + nt * 128 + wc * 64 + n * 16 + fq * 4, v * sc);
        }
      }
    } else {
      GEMM_EPI4({ st_bf16x4(PROJ + (size_t)(mt * 128 + er) * DINP + nt * 128 + ec0, ev4); })
    }
  }
}

DEVI void phase_g2(const Params& p, int l, unsigned char* lds) {
  unsigned char* wl = p.ws + WS_W + l * WS_WL;
  const bf16_t* PROJ = (const bf16_t*)(p.ws + WS_B);
  bf16_t* QR = (bf16_t*)(p.ws + WS_D);
  bf16_t* KVR = QR + (size_t)T * 384;
  bf16_t* GATES = (bf16_t*)(p.ws + WS_E);
  bf16_t* MK = (bf16_t*)(p.ws + WS_F) + (size_t)T * 4 * 96;
  const float2* RM = (const float2*)(p.ws + WS_ROPE);
  constexpr int N_CMP = 32, N_QR = 256 * 3, N_KVR = 256 * 4, N_GT = 256 * 4;
  const int tid = threadIdx.x, wid = tid >> 6, lane = tid & 63, wr = wid >> 1, wc = wid & 1, fr = lane & 15, fq = lane >> 4;
  for (int it = vblock(); it < N_CMP + N_QR + N_KVR + N_GT; it += gridDim.x) {
    f32x4 acc[4][4];
    if (it < N_CMP) {
      const int kv = it & 1, mt = it >> 1;
      const bf16_t* W = (const bf16_t*)(wl + (kv ? W_1V : W_1K));
      const float* bias = (const float*)(wl + (kv ? W_B1V : W_B1K));
      bf16_t* H = (bf16_t*)(p.ws + (kv ? SM_HV : SM_HK));
      gemm128g(lds, 2048,
              [&](int r, int k) { const int m = mt * 128 + r, b = m >> 7; int c = m & 127; if (c > 126) c = 126;
                                  return PROJ + (size_t)(b * S + 16 * c + (k >> 6)) * DINP + C_KC + kv * 64 + (k & 63); },
              [&](int r, int k) { return W + (size_t)r * 2048 + k; }, acc);
      GEMM_EPI4({ f32x4 o; _Pragma("unroll") for (int j = 0; j < 4; ++j) o[j] = gelu_tanh(ev4[j] + bias[ec0 + j]); st_bf16x4(H + (size_t)(mt * 128 + er) * 128 + ec0, o); })
    } else if (it < N_CMP + N_QR) {
      const int i2 = it - N_CMP, mt = i2 / 3, nt = i2 % 3;
      const bf16_t* W = (const bf16_t*)(wl + W_UQ);
      gemm128g(lds, 192, [&](int r, int k) { return PROJ + (size_t)(mt * 128 + r) * DINP + C_CQ + k; }, [&](int r, int k) { return W + (size_t)(nt * 128 + r) * 192 + k; }, acc);
      GEMM_EPI4({ st_bf16x4(QR + (size_t)(mt * 128 + er) * 384 + nt * 128 + ec0, ev4); })
    } else if (it < N_CMP + N_QR + N_KVR) {
      const int i2 = it - N_CMP - N_QR, mt = i2 >> 2, hd = i2 & 3;
      const bf16_t* W = (const bf16_t*)(wl + W_UKV);
      gemm128g(lds, 128, [&](int r, int k) { return PROJ + (size_t)(mt * 128 + r) * DINP + C_CKV + k; }, [&](int r, int k) { return W + (size_t)(hd * 128 + r) * 128 + k; }, acc);
      const float* g_k = p.in[9] + l * 96;
#pragma unroll
      for (int m = 0; m < 4; ++m) {
        const size_t t = (size_t)mt * 128 + wr * 64 + m * 16 + fr;
        const int b = (int)(t >> 11), sq = (int)(t & (S - 1));
        float ss = 0.f;
        {
          const bf16_t* cr = PROJ + t * DINP + C_CKV + fq * 32;
#pragma unroll
          for (int q = 0; q < 4; ++q) { const u32x4 w = *(const u32x4*)(cr + q * 8);
#pragma unroll
            for (int e = 0; e < 4; ++e) { const float lo = __uint_as_float(w[e] << 16), hi = __uint_as_float(w[e] & 0xffff0000u); ss += lo * lo + hi * hi; } }
        }
        ss += __shfl_xor(ss, 16); ss += __shfl_xor(ss, 32);
        const float rskv = rsqrtf(ss * (1.f / 128) + EPS);
        if (wc == 1) {
#pragma unroll
          for (int n = 0; n < 4; ++n) st_bf16x4(KVR + t * 512 + hd * 128 + 64 + n * 16 + fq * 4, acc[m][n] * rskv);
        } else {
          const uint2 plo = *(const uint2*)(PROJ + t * DINP + C_KPE + 4 * fq), phi = *(const uint2*)(PROJ + t * DINP + C_KPE + 16 + 4 * fq);
          float pl[4] = {__uint_as_float(plo.x << 16), __uint_as_float(plo.x & 0xffff0000u), __uint_as_float(plo.y << 16), __uint_as_float(plo.y & 0xffff0000u)};
          float ph[4] = {__uint_as_float(phi.x << 16), __uint_as_float(phi.x & 0xffff0000u), __uint_as_float(phi.y << 16), __uint_as_float(phi.y & 0xffff0000u)};
          float sk = 0.f;
#pragma unroll
          for (int j = 0; j < 4; ++j) sk += pl[j] * pl[j] + ph[j] * ph[j];
          f32x4 kn[4];
#pragma unroll
          for (int n = 0; n < 4; ++n) { kn[n] = acc[m][n] * rskv; sk += kn[n][0] * kn[n][0] + kn[n][1] * kn[n][1] + kn[n][2] * kn[n][2] + kn[n][3] * kn[n][3]; }
          sk += __shfl_xor(sk, 16); sk += __shfl_xor(sk, 32);
          const float rsk = rsqrtf(sk * (1.f / 96) + EPS);
          bf16_t* dst = MK + ((size_t)(b * 4 + hd) * S + sq) * 96;
          f32x4 olo, ohi;
#pragma unroll
          for (int j = 0; j < 4; ++j) {
            const int d = 4 * fq + j; const float2 cs2 = RM[t * 16 + d];
            const float x1 = pl[j] * rsk * g_k[d], x2 = ph[j] * rsk * g_k[16 + d];
            olo[j] = x1 * cs2.x - x2 * cs2.y; ohi[j] = x1 * cs2.y + x2 * cs2.x;
          }
          st_bf16x4(dst + 4 * fq, olo); st_bf16x4(dst + 16 + 4 * fq, ohi);
#pragma unroll
          for (int n = 0; n < 4; ++n) { const float4 g4 = *(const float4*)(g_k + 32 + n * 16 + fq * 4); f32x4 o = kn[n] * rsk; o[0] *= g4.x; o[1] *= g4.y; o[2] *= g4.z; o[3] *= g4.w; st_bf16x4(dst + 32 + n * 16 + fq * 4, o); }
        }
      }
    } else {
      const int i2 = it - N_CMP - N_QR - N_KVR, mt = i2 >> 2, h = i2 & 3;
      const bf16_t* W = (const bf16_t*)(wl + W_LRU) + h * 128 * 64;
      const int c0 = h * 64 + (tid & 7) * 8;
      const float* cw = p.in[10] + l * 4 * 256 + c0; const float* cbp = p.in[11] + l * 256 + c0;
      gemm128(lds, 64,
              [&](int r, int k) {
                const size_t t = (size_t)mt * 128 + r; const int sq = (int)(t & (S - 1));
                float u[8];
#pragma unroll
                for (int e = 0; e < 8; ++e) u[e] = cbp[e];
#pragma unroll
                for (int j = 0; j < 4; ++j) {
                  if (sq - 3 + j >= 0) {
                    const u32x4 w = *(const u32x4*)(PROJ + (t - 3 + j) * DINP + C_LX + h * 64 + k);
#pragma unroll
                    for (int e = 0; e < 4; ++e) { u[2 * e] += __uint_as_float(w[e] << 16) * cw[j * 256 + 2 * e]; u[2 * e + 1] += __uint_as_float(w[e] & 0xffff0000u) * cw[j * 256 + 2 * e + 1]; }
                  }
                }
                u32x4 o; o[0] = pk2bf(u[0], u[1]); o[1] = pk2bf(u[2], u[3]); o[2] = pk2bf(u[4], u[5]); o[3] = pk2bf(u[6], u[7]);
                return o; },
              [&](int r, int k) { return W + (size_t)r * 64 + k; }, acc);
      GEMM_EPI4({ st_bf16x4(GATES + (size_t)(mt * 128 + er) * 512 + h * 128 + ec0, ev4); })
    }
  }
}

DEVI void lru_ab(float u, float rpre, float ipre, float sp, bool first, float& a, float& b) {
  const float r = sigmoidf_(rpre), gi = sigmoidf_(ipre);
  const float la = -8.f * r * sp;
  a = expf(la);
  const float mult = first ? 1.f : sqrtf(fmaxf(-expm1f(2.f * la), 0.f));
  b = mult * gi * u;
}
DEVI float lru_conv(const bf16_t* PROJ, int t, int s, int c, const float* cw, float cb) {
  float u = cb;
#pragma unroll
  for (int j = 0; j < 4; ++j) { const int ss2 = s - 3 + j; if (ss2 >= 0) u += bf2f(PROJ[(size_t)(t - 3 + j) * DINP + C_LX + c]) * cw[j * 256 + c]; }
  return u;
}

template <bool FULL>
DEVI void s5_chunk(const Params& p, int l, int b, int chunk, unsigned char* lds) {
  unsigned char* wl = p.ws + WS_W + l * WS_WL;
  const bf16_t* PROJ = (const bf16_t*)(p.ws + WS_B);
  const float2* Abar = (const float2*)(wl + W_S5A);
  const bf16_t* BB = (const bf16_t*)(wl + W_S5BB);
  const bf16_t* CM = (const bf16_t*)(wl + W_S5CM);
  float2* SLOC = (float2*)(p.ws + SM_SLOC);
  bf16_t* YCP = (bf16_t*)(p.ws + WS_F);
  const float* dd = p.in[24] + l * 256;
  const int tid = threadIdx.x, wv = tid >> 6, lane = tid & 63, r = lane & 31, h = lane >> 5, fr = lane & 15, fq = lane >> 4;
  unsigned* Hs = (unsigned*)(lds + wv * 8704);
  const int t0 = b * S + chunk * 64;
#pragma unroll 1
  for (int gi = 0; gi < 4; ++gi) {
    const int g = wv * 4 + gi;
    bf16x8 bbf[4];
#pragma unroll
    for (int nb = 0; nb < 4; ++nb) bbf[nb] = *(const bf16x8*)(BB + ((g * 4 + nb) * 32 + r) * 16 + 8 * h);
    float2 Ac[2]; float hr[2], hi[2];
#pragma unroll
    for (int sb = 0; sb < 2; ++sb) {
      Ac[sb] = Abar[g * 64 + sb * 32 + r];
      hr[sb] = 0.f; hi[sb] = 0.f;
      if (FULL) { const float2 cin = ((const float2*)(p.ws + SM_SCAR))[((size_t)(b * 32 + chunk) * 16 + g) * 64 + sb * 32 + r]; hr[sb] = cin.x; hi[sb] = cin.y; }
    }
    bf16x8 cm[4];
    float dcol = 0.f;
    if (FULL) {
#pragma unroll
      for (int kk = 0; kk < 4; ++kk) cm[kk] = *(const bf16x8*)(CM + (size_t)(g * 16 + fr) * 128 + kk * 32 + 8 * fq);
      dcol = dd[g * 16 + fr];
    }
#pragma unroll 1
    for (int tb = 0; tb < 2; ++tb) {
      const bf16x8 ua = *(const bf16x8*)(PROJ + (size_t)(t0 + tb * 32 + r) * DINP + C_S5 + g * 16 + 8 * h);
      f32x16 acc[4];
#pragma unroll
      for (int nb = 0; nb < 4; ++nb) {
        f32x16 z;
#pragma unroll
        for (int i = 0; i < 16; ++i) z[i] = 0.f;
        acc[nb] = mfma32(ua, bbf[nb], z);
      }
#pragma unroll
      for (int sb = 0; sb < 2; ++sb) {
        float sr = hr[sb], si = hi[sb];
        const float ax = Ac[sb].x, ay = Ac[sb].y;
#pragma unroll
        for (int q = 0; q < 4; ++q)
#pragma unroll
          for (int owner = 0; owner < 2; ++owner) {
#pragma unroll
            for (int i = 0; i < 4; ++i) {
              const int reg = 4 * q + i;
              const float br = acc[2 * sb][reg], bi = acc[2 * sb + 1][reg];
              const float nr = ax * sr - ay * si + br, ni = ax * si + ay * sr + bi; sr = nr; si = ni;
              if (FULL) { acc[2 * sb][reg] = (h == owner) ? sr : br; acc[2 * sb + 1][reg] = (h == owner) ? si : bi; }
            }
            const float orr = __shfl_xor(sr, 32), oi = __shfl_xor(si, 32);
            if (h != owner) { sr = orr; si = oi; }
          }
        hr[sb] = sr; hi[sb] = si;
      }
      if (FULL) {
#pragma unroll
        for (int sb = 0; sb < 2; ++sb)
#pragma unroll
          for (int reg = 0; reg < 16; ++reg)
            Hs[crow(reg, h) * 68 + sb * 32 + r] = (unsigned)f2bf(acc[2 * sb][reg]) | ((unsigned)f2bf(acc[2 * sb + 1][reg]) << 16);
#pragma unroll
        for (int tb16 = 0; tb16 < 2; ++tb16) {
          f32x4 y = (f32x4){0.f, 0.f, 0.f, 0.f};
#pragma unroll
          for (int kk = 0; kk < 4; ++kk) { const bf16x8 a = *(const bf16x8*)((const bf16_t*)Hs + (tb16 * 16 + fr) * 136 + kk * 32 + 8 * fq); y = mfma16(a, cm[kk], y); }
#pragma unroll
          for (int j = 0; j < 4; ++j) {
            const size_t t = (size_t)t0 + tb * 32 + tb16 * 16 + fq * 4 + j; const int col = g * 16 + fr;
            const float val = y[j] + dcol * bf2f(PROJ[t * DINP + C_S5 + col]);
            YCP[t * 256 + col] = f2bf(gelu_tanh(val));
          }
        }
      }
    }
    if (!FULL) {
#pragma unroll
      for (int sb = 0; sb < 2; ++sb) if (h == 0) SLOC[((size_t)(b * 32 + chunk) * 16 + g) * 64 + sb * 32 + r] = make_float2(hr[sb], hi[sb]);
    }
  }
}

template <bool FULL>
DEVI void lru_chunk(const Params& p, int l, int b, int chunk, float* tile) {
  const bf16_t* PROJ = (const bf16_t*)(p.ws + WS_B);
  const bf16_t* GATES = (const bf16_t*)(p.ws + WS_E);
  float2* LSUM = (float2*)(p.ws + SM_LSUM);
  const int c = threadIdx.x, h = c >> 6, j = c & 63;
  const float* cw = p.in[10] + l * 4 * 256;
  const float w0 = cw[c], w1 = cw[256 + c], w2 = cw[512 + c], w3 = cw[768 + c], cb = p.in[11][l * 256 + c];
  const float ba = p.in[13][l * 256 + c], bi = p.in[15][l * 256 + c];
  const float sp = log1pf(expf(-p.in[16][l * 256 + c]));
  const int s0 = chunk * 64; const size_t t0 = (size_t)b * S + s0;
  float xm3 = 0.f, xm2 = 0.f, xm1 = 0.f;
  if (s0 > 0) { xm3 = bf2f(PROJ[(t0 - 3) * DINP + C_LX + c]); xm2 = bf2f(PROJ[(t0 - 2) * DINP + C_LX + c]); xm1 = bf2f(PROJ[(t0 - 1) * DINP + C_LX + c]); }
  float hh = 0.f, ap = 1.f;
  if (FULL) hh = ((const float*)(p.ws + SM_LCAR))[(size_t)(b * 32 + chunk) * 256 + c];
#pragma unroll 1
  for (int k0 = 0; k0 < 64; k0 += 8) {
    float xv[8], rp[8], ip[8], gt[8];
#pragma unroll
    for (int i = 0; i < 8; ++i) {
      const size_t t = t0 + k0 + i;
      xv[i] = bf2f(PROJ[t * DINP + C_LX + c]);
      rp[i] = bf2f(GATES[t * 512 + h * 128 + j]); ip[i] = bf2f(GATES[t * 512 + h * 128 + 64 + j]);
      gt[i] = FULL ? bf2f(PROJ[t * DINP + C_LG + c]) : 0.f;
    }
#pragma unroll
    for (int i = 0; i < 8; ++i) {
      const float u = cb + xm3 * w0 + xm2 * w1 + xm1 * w2 + xv[i] * w3;
      xm3 = xm2; xm2 = xm1; xm1 = xv[i];
      float a, bb; lru_ab(u, rp[i] + ba, ip[i] + bi, sp, (s0 + k0 + i) == 0, a, bb);
      hh = a * hh + bb; ap *= a;
      if (FULL) tile[(k0 + i) * 256 + c] = hh * gelu_tanh(gt[i]);
    }
  }
  if (!FULL) LSUM[(size_t)(b * 32 + chunk) * 256 + c] = make_float2(ap, hh);
}

DEVI void phase_r2(const Params& p, int l, unsigned char* lds) {
  unsigned char* wl = p.ws + WS_W + l * WS_WL;
  const bf16_t* PROJ = (const bf16_t*)(p.ws + WS_B);
  const bf16_t* QR = (const bf16_t*)(p.ws + WS_D);
  const bf16_t* KVR = QR + (size_t)T * 384;
  const bf16_t* GATES = (const bf16_t*)(p.ws + WS_E);
  bf16_t* MQ = (bf16_t*)(p.ws + WS_F);
  bf16_t* MK = MQ + (size_t)T * 4 * 96;
  const float2* RM = (const float2*)(p.ws + WS_ROPE);
  const float2* RN = RM + (size_t)T * 16;
  const int tid = threadIdx.x, lane = tid & 63, wv = tid >> 6;
  for (int it = blockIdx.x; it < NB * 32; it += gridDim.x) lru_chunk<false>(p, l, it >> 5, it & 31, nullptr);
  __syncthreads();
  for (int it = blockIdx.x; it < NB * 32; it += gridDim.x) s5_chunk<false>(p, l, it >> 5, it & 31, lds);
  {
    const bf16_t* HK = (const bf16_t*)(p.ws + SM_HK); const bf16_t* HV = (const bf16_t*)(p.ws + SM_HV);
    bf16_t* KC = (bf16_t*)(p.ws + SM_KC); bf16_t* VC = (bf16_t*)(p.ws + SM_VC);
    const bf16_t* W2K = (const bf16_t*)(wl + W_2K); const bf16_t* W2V = (const bf16_t*)(wl + W_2V);
    const float* g0 = p.in[28] + l * 192;
    for (int it = blockIdx.x; it < 32; it += gridDim.x) {
      const int kv = it & 1, mt = it >> 1;
      const bf16_t* H = kv ? HV : HK; const bf16_t* W2 = kv ? W2V : W2K;
      f32x4 acc[4][4];
      __syncthreads();
      gemm128g(lds, 128, [&](int r, int k) { return H + (size_t)(mt * 128 + r) * 128 + k; }, [&](int r, int k) { return W2 + (size_t)(r & 63) * 128 + k; }, acc);
      const int wid = tid >> 6, wr = wid >> 1, wc = wid & 1, fr = lane & 15, fq = lane >> 4;
      if (wc == 0) {
#pragma unroll
        for (int m = 0; m < 4; ++m) {
          const int row = mt * 128 + wr * 64 + m * 16 + fr, b = row >> 7, c = row & 127;
          f32x4 v[4];
#pragma unroll
          for (int n = 0; n < 4; ++n) v[n] = acc[m][n];
          if (kv == 0) {
            float ss = 0.f;
#pragma unroll
            for (int n = 0; n < 4; ++n) ss += v[n][0] * v[n][0] + v[n][1] * v[n][1] + v[n][2] * v[n][2] + v[n][3] * v[n][3];
            ss += __shfl_xor(ss, 16); ss += __shfl_xor(ss, 32);
            const float rs = rsqrtf(ss * (1.f / 64) + EPS);
#pragma unroll
            for (int n = 0; n < 4; ++n) { const float4 gg = *(const float4*)(g0 + n * 16 + fq * 4); v[n][0] *= rs * gg.x; v[n][1] *= rs * gg.y; v[n][2] *= rs * gg.z; v[n][3] *= rs * gg.w; }
            const int cc = (c < 127) ? c : 126;
            const float2* cs = RN + (size_t)(b * S + 16 * cc + 31) * 8;
#pragma unroll
            for (int j = 0; j < 4; ++j) {
              const float x = v[0][j], partner = __shfl_xor(x, 32);
              const int d = fq * 4 + j; const float2 cs2 = cs[d & 7];
              v[0][j] = (d < 8) ? (x * cs2.x - partner * cs2.y) : (partner * cs2.y + x * cs2.x);
            }
          }
          bf16_t* dst = (kv ? VC : KC) + (size_t)row * 64;
#pragma unroll
          for (int n = 0; n < 4; ++n) { f32x4 o = v[n]; if (c >= 127) o = (f32x4){0.f, 0.f, 0.f, 0.f}; st_bf16x4(dst + n * 16 + fq * 4, o); }
        }
      }
    }
  }
}

typedef short v4i16_t __attribute__((ext_vector_type(4)));
DEVI float fexp2(float x) { return __builtin_amdgcn_exp2f(x); }
constexpr int VST = 96;
constexpr int ATT_VBYTES = 64 * VST * 2;
template <int DK> constexpr int att_kbytes() { return 64 * (DK + 8) * 2; }
template <int DK> constexpr int att_buf() { return att_kbytes<DK>() + ATT_VBYTES; }
template <int DK> struct TileRegs { u32x4 k[DK / 32]; u32x4 v[2]; };
template <int DK>
DEVI void tile_load(TileRegs<DK>& tr, const bf16_t* kbase, size_t kstride, const bf16_t* vbase, size_t vstride, int key0, bool withv = true) {
  constexpr int CH = DK / 8;
#pragma unroll
  for (int i = 0; i < DK / 32; ++i) { const int c = threadIdx.x + 256 * i, r = c / CH, cc = c % CH; tr.k[i] = *(const u32x4*)(kbase + (size_t)(key0 + r) * kstride + cc * 8); }
  if (withv) {
#pragma unroll
    for (int i = 0; i < 2; ++i) { const int c = threadIdx.x + 256 * i, r = c >> 3, cc = c & 7; tr.v[i] = *(const u32x4*)(vbase + (size_t)(key0 + r) * vstride + cc * 8); }
  }
}
template <int DK>
DEVI void tile_store(const TileRegs<DK>& tr, unsigned char* buf, bool withv = true) {
  constexpr int CH = DK / 8;
  bf16_t* sK = (bf16_t*)buf; bf16_t* sV = (bf16_t*)(buf + att_kbytes<DK>());
#pragma unroll
  for (int i = 0; i < DK / 32; ++i) { const int c = threadIdx.x + 256 * i, r = c / CH, cc = c % CH; *(u32x4*)(sK + r * (DK + 8) + cc * 8) = tr.k[i]; }
  if (withv) {
#pragma unroll
    for (int i = 0; i < 2; ++i) { const int c = threadIdx.x + 256 * i, r = c >> 3, cc = c & 7; *(u32x4*)(sV + r * VST + cc * 8) = tr.v[i]; }
  }
}
template <int DK>
DEVI void qk_tile(const bf16_t* sK, const bf16x8* qf, f32x16& s0, f32x16& s1, int r, int h) {
#pragma unroll
  for (int i = 0; i < 16; ++i) { s0[i] = 0.f; s1[i] = 0.f; }
#pragma unroll
  for (int kk = 0; kk < DK / 16; ++kk) {
    const bf16x8 a0 = *(const bf16x8*)(sK + r * (DK + 8) + kk * 16 + h * 8);
    const bf16x8 a1 = *(const bf16x8*)(sK + (32 + r) * (DK + 8) + kk * 16 + h * 8);
    s0 = mfma32(a0, qf[kk], s0);
    s1 = mfma32(a1, qf[kk], s1);
  }
}
struct FState { f32x16 o0, o1; float m, l; };
DEVI void fstate_init(FState& f) {
#pragma unroll
  for (int i = 0; i < 16; ++i) { f.o0[i] = 0.f; f.o1[i] = 0.f; }
  f.m = -INFINITY; f.l = 0.f;
}
DEVI v4i16_t vtr(const bf16_t* p) { return __builtin_amdgcn_ds_read_tr16_b64_v4i16((LAS v4i16_t*)p); }
DEVI void softmax_pv(FState& f, f32x16& s0, f32x16& s1, const bf16_t* sV, int lane) {
  const int h = lane >> 5;
  float mx = -INFINITY;
#pragma unroll
  for (int i = 0; i < 16; ++i) mx = fmaxf(mx, fmaxf(s0[i], s1[i]));
  mx = fmaxf(mx, __shfl_xor(mx, 32));
  const float mnew = fmaxf(f.m, mx);
  const float muse = (mnew == -INFINITY) ? 0.f : mnew;
  const float alpha = fexp2(f.m - muse);
  float ps = 0.f;
#pragma unroll
  for (int i = 0; i < 16; ++i) { s0[i] = fexp2(s0[i] - muse); s1[i] = fexp2(s1[i] - muse); ps += s0[i] + s1[i]; }
  ps += __shfl_xor(ps, 32);
  f.l = f.l * alpha + ps; f.m = mnew;
#pragma unroll
  for (int i = 0; i < 16; ++i) { f.o0[i] *= alpha; f.o1[i] *= alpha; }
  const int g = lane >> 4, li = lane & 15, q = li >> 2, pp = li & 3;
  const bf16_t* vb = sV + (4 * h + q) * VST + (g & 1) * 16 + 4 * pp;
#pragma unroll
  for (int kb = 0; kb < 2; ++kb)
#pragma unroll
    for (int s = 0; s < 2; ++s) {
      unsigned pw[4];
#pragma unroll
      for (int j = 0; j < 4; ++j) pw[j] = kb ? pk2bf(s1[8 * s + 2 * j], s1[8 * s + 2 * j + 1]) : pk2bf(s0[8 * s + 2 * j], s0[8 * s + 2 * j + 1]);
      const bf16x8 pb = __builtin_bit_cast(bf16x8, (u32x4){pw[0], pw[1], pw[2], pw[3]});
#pragma unroll
      for (int db = 0; db < 2; ++db) {
        const v4i16_t lo = vtr(vb + (kb * 32 + 16 * s) * VST + db * 32);
        const v4i16_t hi = vtr(vb + (kb * 32 + 16 * s + 8) * VST + db * 32);
        const bf16x8 a = {lo[0], lo[1], lo[2], lo[3], hi[0], hi[1], hi[2], hi[3]};
        if (db == 0) f.o0 = mfma32(a, pb, f.o0); else f.o1 = mfma32(a, pb, f.o1);
      }
    }
}
DEVI void store_o(bf16_t* orow, const f32x16& o0, const f32x16& o1, float sc, int h) {
#pragma unroll
  for (int g = 0; g < 4; ++g) {
    uint2 v0, v1;
    v0.x = pk2bf(o0[4 * g] * sc, o0[4 * g + 1] * sc); v0.y = pk2bf(o0[4 * g + 2] * sc, o0[4 * g + 3] * sc);
    v1.x = pk2bf(o1[4 * g] * sc, o1[4 * g + 1] * sc); v1.y = pk2bf(o1[4 * g + 2] * sc, o1[4 * g + 3] * sc);
    *(uint2*)(orow + 8 * g + 4 * h) = v0;
    *(uint2*)(orow + 32 + 8 * g + 4 * h) = v1;
  }
}

DEVI void mla_item(const Params& p, int l, int b, int hd, int qt, unsigned char* lds) {
  const bf16_t* MQ = (const bf16_t*)(p.ws + WS_F);
  const bf16_t* MK = MQ + (size_t)T * 4 * 96;
  const bf16_t* KVR = (const bf16_t*)(p.ws + WS_D) + (size_t)T * 384;
  bf16_t* YA = (bf16_t*)(p.ws + WS_C);
  const int tid = threadIdx.x, wv = tid >> 6, lane = tid & 63, r = lane & 31, h = lane >> 5;
  const int q0 = qt * 128 + wv * 32, tq = q0 + r;
  bf16x8 qf[6];
  {
    const bf16_t* qrow = (const bf16_t*)(p.ws + WS_D) + ((size_t)b * S + tq) * 384 + hd * 96;
    const float* g_q = p.in[8] + l * 96;
    float qv[6][8]; float ss = 0.f;
#pragma unroll
    for (int kk = 0; kk < 6; ++kk) {
      const u32x4 w = *(const u32x4*)(qrow + kk * 16 + h * 8);
#pragma unroll
      for (int e = 0; e < 4; ++e) { qv[kk][2 * e] = __uint_as_float(w[e] << 16); qv[kk][2 * e + 1] = __uint_as_float(w[e] & 0xffff0000u); ss += qv[kk][2 * e] * qv[kk][2 * e] + qv[kk][2 * e + 1] * qv[kk][2 * e + 1]; }
    }
    ss += __shfl_xor(ss, 32);
    const float rs = rsqrtf(ss * (1.f / 96) + EPS) * (0.10206207261596575f * LOG2E);
#pragma unroll
    for (int kk = 0; kk < 6; ++kk)
#pragma unroll
      for (int j = 0; j < 8; ++j) qv[kk][j] *= rs * g_q[kk * 16 + h * 8 + j];
    const float2* cs = (const float2*)(p.ws + WS_ROPE) + ((size_t)b * S + tq) * 16 + 8 * h;
#pragma unroll
    for (int j = 0; j < 8; ++j) { const float2 c2 = cs[j]; const float x1 = qv[0][j], x2 = qv[1][j]; qv[0][j] = x1 * c2.x - x2 * c2.y; qv[1][j] = x1 * c2.y + x2 * c2.x; }
#pragma unroll
    for (int kk = 0; kk < 6; ++kk) { const u32x4 w = {pk2bf(qv[kk][0], qv[kk][1]), pk2bf(qv[kk][2], qv[kk][3]), pk2bf(qv[kk][4], qv[kk][5]), pk2bf(qv[kk][6], qv[kk][7])}; qf[kk] = __builtin_bit_cast(bf16x8, w); }
  }
  FState f; fstate_init(f);
  const bf16_t* kbase = MK + (size_t)(b * 4 + hd) * S * 96;
  const bf16_t* vbase = KVR + (size_t)b * S * 512 + hd * 128 + 64;
  const int ntiles = 2 * qt + 2;
  TileRegs<96> tr;
  tile_load<96>(tr, kbase, 96, vbase, 512, 0);
  __syncthreads();
  tile_store<96>(tr, lds);
  __syncthreads();
#pragma unroll 1
  for (int kt = 0; kt < ntiles; ++kt) {
    unsigned char* cur = lds + (kt & 1) * att_buf<96>();
    const bool more = kt + 1 < ntiles;
    if (more) tile_load<96>(tr, kbase, 96, vbase, 512, (kt + 1) * 64);
    if (kt * 64 <= q0 + 31) {
      f32x16 s0, s1;
      qk_tile<96>((const bf16_t*)cur, qf, s0, s1, r, h);
      if (kt * 64 + 63 > q0) {
        int rel = tq - kt * 64 - 4 * h; asm volatile("" : "+v"(rel));
#pragma unroll
        for (int i = 0; i < 16; ++i) { const int kk2 = (i & 3) + 8 * (i >> 2); if (kk2 > rel) s0[i] = -INFINITY; if (kk2 + 32 > rel) s1[i] = -INFINITY; }
      }
      softmax_pv(f, s0, s1, (const bf16_t*)(cur + att_kbytes<96>()), lane);
    }
    if (more) tile_store<96>(tr, lds + ((kt + 1) & 1) * att_buf<96>());
    __syncthreads();
  }
  store_o(YA + (size_t)(b * S + tq) * 256 + hd * 64, f.o0, f.o1, 1.f / f.l, h);
}

template <class KF, class BODY>
DEVI void nsa_stream(unsigned char* lds, const bf16_t* kbase, size_t kstride, const bf16_t* vbase, size_t vstride, bool withv, int nt, KF key0f, BODY body) {
  if (nt <= 0) return;
  TileRegs<64> tr;
  tile_load<64>(tr, kbase, kstride, vbase, vstride, key0f(0), withv);
  __syncthreads();
  tile_store<64>(tr, lds, withv);
  __syncthreads();
#pragma unroll 1
  for (int i = 0; i < nt; ++i) {
    unsigned char* cur = lds + (i & 1) * att_buf<64>();
    const bool more = i + 1 < nt;
    if (more) tile_load<64>(tr, kbase, kstride, vbase, vstride, key0f(i + 1), withv);
    body(i, cur);
    if (more) tile_store<64>(tr, lds + ((i + 1) & 1) * att_buf<64>(), withv);
    __syncthreads();
  }
}
DEVI void nsa_item(const Params& p, int l, int b, int qt, unsigned char* lds) {
  const bf16_t* PROJ = (const bf16_t*)(p.ws + WS_B);
  const bf16_t* KC = (const bf16_t*)(p.ws + SM_KC) + (size_t)b * 128 * 64;
  const bf16_t* VC = (const bf16_t*)(p.ws + SM_VC) + (size_t)b * 128 * 64;
  const int tid = threadIdx.x, wv = tid >> 6, lane = tid & 63, r = lane & 31, h = lane >> 5;
  float* psum = (float*)(lds + 2 * att_buf<64>());
  unsigned* selm = (unsigned*)(lds + 2 * att_buf<64>() + 16384);
  const int t0 = qt * 32, cur = t0 >> 6;
  const int ql = wv * 8 + (r >> 2), hd = r & 3, tq = t0 + ql;
  const size_t tg = (size_t)b * S + tq;
  bf16x8 qf[4];
#pragma unroll
  for (int kk = 0; kk < 4; ++kk) qf[kk] = *(const bf16x8*)(PROJ + tg * DINP + C_NQ + hd * 64 + kk * 16 + h * 8);
  f32x16 of0, of1;
#pragma unroll
  for (int i = 0; i < 16; ++i) { of0[i] = 0.f; of1[i] = 0.f; }
  const float g0 = sigmoidf_(bf2f(PROJ[tg * DINP + C_NG + hd * 3 + 0]));
  const float g1 = sigmoidf_(bf2f(PROJ[tg * DINP + C_NG + hd * 3 + 1]));
  const float g2 = sigmoidf_(bf2f(PROJ[tg * DINP + C_NG + hd * 3 + 2]));
  FState f; fstate_init(f);
  const int ncmp = (t0 + 31 < 31) ? 0 : (((t0 >> 4) >> 6) + 1);
  nsa_stream(lds, KC, 64, VC, 64, true, ncmp, [&](int i) { return i * 64; }, [&](int kt, unsigned char* buf) {
    f32x16 s0, s1;
    qk_tile<64>((const bf16_t*)buf, qf, s0, s1, r, h);
    int rel = ((tq - 31) >> 4) - kt * 64 - 4 * h; asm volatile("" : "+v"(rel));
#pragma unroll
    for (int i = 0; i < 16; ++i) { const int kk2 = (i & 3) + 8 * (i >> 2); if (kk2 > rel) s0[i] = -INFINITY; if (kk2 + 32 > rel) s1[i] = -INFINITY; }
    softmax_pv(f, s0, s1, (const bf16_t*)(buf + att_kbytes<64>()), lane);
  });
  {
    const float sc = (f.l > 0.f) ? g0 / f.l : 0.f;
#pragma unroll
    for (int i = 0; i < 16; ++i) { of0[i] += f.o0[i] * sc; of1[i] += f.o1[i] * sc; }
  }
  {
    const float muse = (f.m == -INFINITY) ? 0.f : f.m;
    const float il = (f.l > 0.f) ? 1.f / f.l : 0.f;
    if (ncmp < 2) {
#pragma unroll 1
      for (int i = tid; i < 32 * 128; i += NTHREADS) psum[i] = 0.f;
      __syncthreads();
    }
    nsa_stream(lds, KC, 64, VC, 64, false, ncmp, [&](int i) { return i * 64; }, [&](int kt, unsigned char* buf) {
      f32x16 s0, s1;
      qk_tile<64>((const bf16_t*)buf, qf, s0, s1, r, h);
      int rel = ((tq - 31) >> 4) - kt * 64 - 4 * h; asm volatile("" : "+v"(rel));
      int cb0 = kt * 64 + 4 * h; asm volatile("" : "+v"(cb0));
#pragma unroll
      for (int i = 0; i < 16; ++i) {
        const int kk2 = (i & 3) + 8 * (i >> 2); const int c = cb0 + kk2;
        float p0 = (kk2 > rel) ? 0.f : fexp2(s0[i] - muse) * il;
        float p1 = (kk2 + 32 > rel) ? 0.f : fexp2(s1[i] - muse) * il;
        p0 += __shfl_xor(p0, 1); p0 += __shfl_xor(p0, 2);
        p1 += __shfl_xor(p1, 1); p1 += __shfl_xor(p1, 2);
        if (hd == 0) { psum[ql * 128 + c] = p0; psum[ql * 128 + c + 32] = p1; }
      }
    });
  }
  __syncthreads();
#pragma unroll 1
  for (int itq = 0; itq < 4; ++itq) {
    const int q2 = wv * 8 + itq * 2 + (lane >> 5), j = lane & 31;
    const float* ps = psum + q2 * 128;
    float imp = 2.f * (ps[4 * j] + ps[4 * j + 1] + ps[4 * j + 2]) + ps[4 * j + 3];
    if (j > 0) imp += ps[4 * j - 1];
    const bool cand = (j >= 1) && (j <= cur - 2);
    int rank = 0;
    for (int jj = 0; jj < 32; ++jj) {
      const float v = __shfl(imp, (lane & 32) | jj);
      const bool cj = (jj >= 1) && (jj <= cur - 2);
      if (cj && (v > imp || (v == imp && jj < j))) ++rank;
    }
    const bool sel = cand && rank < 2;
    const unsigned long long bal = __ballot(sel);
    unsigned mk = (unsigned)(bal >> (32 * (lane >> 5)));
    mk |= 1u | (1u << cur); if (cur >= 1) mk |= (1u << (cur - 1));
    if (j == 0) selm[q2] = mk;
  }
  __syncthreads();
  unsigned blk_or = 0, wave_or = 0;
  for (int i = 0; i < 32; ++i) blk_or |= selm[i];
  for (int i = 0; i < 8; ++i) wave_or |= selm[wv * 8 + i];
  const unsigned mymask = selm[ql];
  fstate_init(f);
  {
    unsigned* tl = selm + 32;
    if (tid < 32 && ((blk_or >> tid) & 1u)) tl[__popc(blk_or & ((1u << tid) - 1u))] = tid;
    __syncthreads();
    const int nsel = __popc(blk_or);
    nsa_stream(lds, PROJ + (size_t)b * S * DINP + C_KS, DINP, PROJ + (size_t)b * S * DINP + C_VS, DINP, true, nsel,
      [&](int i) { return (int)tl[i] * 64; },
      [&](int i, unsigned char* buf) {
        const int jj = (int)tl[i];
        if ((wave_or >> jj) & 1u) {
          f32x16 s0, s1;
          qk_tile<64>((const bf16_t*)buf, qf, s0, s1, r, h);
          const bool on = (mymask >> jj) & 1u;
          int rel = on ? (tq - jj * 64 - 4 * h) : -1; asm volatile("" : "+v"(rel));
#pragma unroll
          for (int i2 = 0; i2 < 16; ++i2) { const int kk2 = (i2 & 3) + 8 * (i2 >> 2); if (kk2 > rel) s0[i2] = -INFINITY; if (kk2 + 32 > rel) s1[i2] = -INFINITY; }
          softmax_pv(f, s0, s1, (const bf16_t*)(buf + att_kbytes<64>()), lane);
        }
      });
    const float sc = (f.l > 0.f) ? g1 / f.l : 0.f;
#pragma unroll
    for (int i = 0; i < 16; ++i) { of0[i] += f.o0[i] * sc; of1[i] += f.o1[i] * sc; }
  }
  fstate_init(f);
  {
    int jlo = (t0 - 511) >> 6; if (jlo < 0) jlo = 0;
    nsa_stream(lds, PROJ + (size_t)b * S * DINP + C_KW, DINP, PROJ + (size_t)b * S * DINP + C_VW, DINP, true, cur - jlo + 1,
      [&](int i) { return (jlo + i) * 64; },
      [&](int i, unsigned char* buf) {
        const int j = jlo + i;
        f32x16 s0, s1;
        qk_tile<64>((const bf16_t*)buf, qf, s0, s1, r, h);
        if (j == cur || j * 64 < t0 + 31 - 511 + 64) {
          int rel = tq - j * 64 - 4 * h; asm volatile("" : "+v"(rel));
#pragma unroll
          for (int i2 = 0; i2 < 16; ++i2) {
            const int kk2 = (i2 & 3) + 8 * (i2 >> 2);
            if (kk2 > rel || kk2 < rel - 511) s0[i2] = -INFINITY;
            if (kk2 + 32 > rel || kk2 + 32 < rel - 511) s1[i2] = -INFINITY;
          }
        }
        softmax_pv(f, s0, s1, (const bf16_t*)(buf + att_kbytes<64>()), lane);
      });
    const float sc = (f.l > 0.f) ? g2 / f.l : 0.f;
#pragma unroll
    for (int i = 0; i < 16; ++i) { of0[i] += f.o0[i] * sc; of1[i] += f.o1[i] * sc; }
  }
  {
    float ss = 0.f;
#pragma unroll
    for (int i = 0; i < 16; ++i) ss += of0[i] * of0[i] + of1[i] * of1[i];
    ss += __shfl_xor(ss, 1); ss += __shfl_xor(ss, 2); ss += __shfl_xor(ss, 32);
    const float rs = rsqrtf(ss * (1.f / 256) + EPS);
    const float* on = p.in[35] + l * 1024 + 768 + hd * 64;
#pragma unroll
    for (int g4 = 0; g4 < 4; ++g4) {
      const float4 a = *(const float4*)(on + 8 * g4 + 4 * h), b4 = *(const float4*)(on + 32 + 8 * g4 + 4 * h);
      of0[4 * g4] *= a.x; of0[4 * g4 + 1] *= a.y; of0[4 * g4 + 2] *= a.z; of0[4 * g4 + 3] *= a.w;
      of1[4 * g4] *= b4.x; of1[4 * g4 + 1] *= b4.y; of1[4 * g4 + 2] *= b4.z; of1[4 * g4 + 3] *= b4.w;
    }
    store_o((bf16_t*)(p.ws + WS_A) + tg * 1024 + 768 + hd * 64, of0, of1, rs, h);
  }
}

DEVI void carry_item(const Params& p, int l, int it) {
  const int tid = threadIdx.x;
  if (it < 64) {
    const int idx = it * 256 + tid, b = idx >> 10, gs = idx & 1023;
    const float2 a64 = ((const float2*)(p.ws + WS_W + l * WS_WL + W_S5A64))[gs];
    const float2* SLOC = (const float2*)(p.ws + SM_SLOC) + (size_t)b * 32 * 1024 + gs;
    float2* SCAR = (float2*)(p.ws + SM_SCAR) + (size_t)b * 32 * 1024 + gs;
    float hr = 0.f, hi = 0.f;
#pragma unroll 1
    for (int c0 = 0; c0 < 32; c0 += 8) {
      float2 sl[8];
#pragma unroll
      for (int i = 0; i < 8; ++i) sl[i] = SLOC[(size_t)(c0 + i) * 1024];
#pragma unroll
      for (int i = 0; i < 8; ++i) { SCAR[(size_t)(c0 + i) * 1024] = make_float2(hr, hi); const float nr = a64.x * hr - a64.y * hi + sl[i].x, ni = a64.x * hi + a64.y * hr + sl[i].y; hr = nr; hi = ni; }
    }
  } else {
    const int idx = (it - 64) * 256 + tid, b = idx >> 8, c = idx & 255;
    const float2* LSUM = (const float2*)(p.ws + SM_LSUM) + (size_t)b * 32 * 256 + c;
    float* LCAR = (float*)(p.ws + SM_LCAR) + (size_t)b * 32 * 256 + c;
    float hh = 0.f;
#pragma unroll 1
    for (int c0 = 0; c0 < 32; c0 += 8) {
      float2 sv[8];
#pragma unroll
      for (int i = 0; i < 8; ++i) sv[i] = LSUM[(size_t)(c0 + i) * 256];
#pragma unroll
      for (int i = 0; i < 8; ++i) { LCAR[(size_t)(c0 + i) * 256] = hh; hh = sv[i].x * hh + sv[i].y; }
    }
  }
}
DEVI void phase_a1(const Params& p, int l, unsigned char* lds) {
  for (int it = blockIdx.x; it < 80; it += gridDim.x) carry_item(p, l, it);
  const int G_ = (int)gridDim.x;
  const int vb_ = vblock();
  for (int rr = 0;; ++rr) { const int j = rr * G_ + ((rr & 1) ? (G_ - 1 - vb_) : vb_); if (rr * G_ >= 1024) break; if (j < 1024) { const int b = j >> 6, qt = 63 - (j & 63); nsa_item(p, l, b, qt, lds); } }
  __syncthreads();
  for (int rr = 0;; ++rr) { const int j = rr * G_ + ((rr & 1) ? (G_ - 1 - vb_) : vb_); if (rr * G_ >= 1024) break; if (j < 1024) { const int bh = j >> 4, qt = 15 - (j & 15); mla_item(p, l, bh >> 2, bh & 3, qt, lds); } }
}

DEVI void phase_r3(const Params& p, int l, unsigned char* lds) {
  bf16_t* Y = (bf16_t*)(p.ws + WS_A);
  const int tid = threadIdx.x, lane = tid & 63, wv = tid >> 6;
  {
    const float* onorm = p.in[35] + l * 1024 + 256;
    float* tile = (float*)lds;
    for (int it = blockIdx.x; it < NB * 32; it += gridDim.x) {
      const int b = it >> 5, chunk = it & 31;
      __syncthreads();
      lru_chunk<true>(p, l, b, chunk, tile);
      __syncthreads();
      for (int k = wv; k < 64; k += 4) {
        float v[4], ss = 0.f;
#pragma unroll
        for (int i = 0; i < 4; ++i) { v[i] = tile[k * 256 + lane + 64 * i]; ss += v[i] * v[i]; }
        const float rs = rsqrtf(wsum(ss) * (1.f / 256) + EPS);
        const size_t t = (size_t)b * S + chunk * 64 + k;
#pragma unroll
        for (int i = 0; i < 4; ++i) Y[t * 1024 + 256 + lane + 64 * i] = f2bf(v[i] * rs * onorm[lane + 64 * i]);
      }
    }
  }
  __syncthreads();
  for (int it = blockIdx.x; it < NB * 32; it += gridDim.x) s5_chunk<true>(p, l, it >> 5, it & 31, lds);
}

DEVI void phase_g3(const Params& p, int l, unsigned char* lds) {
  const bf16_t* YCP = (const bf16_t*)(p.ws + WS_F);
  bf16_t* YC = (bf16_t*)(p.ws + WS_F) + (size_t)T * 256;
  const bf16_t* W = (const bf16_t*)(p.ws + WS_W + l * WS_WL + W_GLU);
  const float* bg = p.in[26] + l * 256;
  for (int it = vblock(); it < 256 * 2; it += gridDim.x) {
    const int mt = it >> 1, nt = it & 1;
    f32x4 acc[4][4];
    gemm128g(lds, 256, [&](int r, int k) { return YCP + (size_t)(mt * 128 + r) * 256 + k; }, [&](int r, int k) { return W + (size_t)(nt * 128 + r) * 256 + k; }, acc);
    GEMM_EPI4({ const size_t o = (size_t)(mt * 128 + er) * 256 + nt * 128 + ec0; const ushort4 yp = *(const ushort4*)(YCP + o); f32x4 r4; r4[0] = bf2f(yp.x) * sigmoidf_(ev4[0] + bg[nt * 128 + ec0]); r4[1] = bf2f(yp.y) * sigmoidf_(ev4[1] + bg[nt * 128 + ec0 + 1]); r4[2] = bf2f(yp.z) * sigmoidf_(ev4[2] + bg[nt * 128 + ec0 + 2]); r4[3] = bf2f(yp.w) * sigmoidf_(ev4[3] + bg[nt * 128 + ec0 + 3]); st_bf16x4(YC + o, r4); })
  }
}

DEVI void phase_r4(const Params& p, int l) {
  const bf16_t* YA = (const bf16_t*)(p.ws + WS_C);
  const bf16_t* YC = (const bf16_t*)(p.ws + WS_F) + (size_t)T * 256;
  bf16_t* Y = (bf16_t*)(p.ws + WS_A);
  const float* onorm = p.in[35] + l * 1024;
  const int lane = threadIdx.x & 63, gw = blockIdx.x * 4 + (threadIdx.x >> 6), NGW = gridDim.x * 4;
  for (int t = gw; t < T; t += NGW) {
#pragma unroll
    for (int grp = 0; grp < 2; ++grp) {
      const bf16_t* src = (grp == 0 ? YA : YC) + (size_t)t * 256;
      const int gcol = (grp == 0 ? 0 : 512);
      const ushort4 u = ((const ushort4*)src)[lane];
      const float v0 = bf2f(u.x), v1 = bf2f(u.y), v2 = bf2f(u.z), v3 = bf2f(u.w);
      const float rs = rsqrtf(wsum(v0 * v0 + v1 * v1 + v2 * v2 + v3 * v3) * (1.f / 256) + EPS);
      const float4 g = ((const float4*)(onorm + gcol))[lane];
      ushort4 o; o.x = f2bf(v0 * rs * g.x); o.y = f2bf(v1 * rs * g.y); o.z = f2bf(v2 * rs * g.z); o.w = f2bf(v3 * rs * g.w);
      ((ushort4*)(Y + (size_t)t * 1024 + gcol))[lane] = o;
    }
  }
}

DEVI void phase_g4(const Params& p, int l, unsigned char* lds) {
  const bf16_t* Y = (const bf16_t*)(p.ws + WS_A);
  const bf16_t* W = (const bf16_t*)(p.ws + WS_W + l * WS_WL + W_OUT);
  const float* xin = (l == 0) ? p.in[0] : p.out;
  float* out = p.out;
  for (int it = vblock(); it < 256 * 8; it += gridDim.x) {
    const int mt = it >> 3, nt = it & 7;
    f32x4 acc[4][4];
    gemm128g(lds, D, [&](int r, int k) { return Y + (size_t)(mt * 128 + r) * D + k; }, [&](int r, int k) { return W + (size_t)(nt * 128 + r) * D + k; }, acc);
    GEMM_EPI4({ const size_t o = (size_t)(mt * 128 + er) * D + nt * 128 + ec0; const f32x4 xi = *(const f32x4*)(xin + o); *(f32x4*)(out + o) = xi + ev4; })
  }
}

DEVI void phase_r5(const Params& p, int l, unsigned char* lds) {
  const float* x1 = p.out;
  bf16_t* XN = (bf16_t*)(p.ws + WS_A);
  const float* g = p.in[37] + l * D;
  const bf16_t* WH = (const bf16_t*)(p.ws + WS_W + l * WS_WL + W_RTH);
  const bf16_t* WL = (const bf16_t*)(p.ws + WS_W + l * WS_WL + W_RTL);
  const float* brg = p.in[39] + l * 4; const float* bre = p.in[41] + l * 16;
  int* CNT = (int*)(p.ws + SM_CNT) + l * 32;
  int* LIST = (int*)(p.ws + SM_LIST);
  float2* TOKW = (float2*)(p.ws + SM_TOKW);
  const int tid = threadIdx.x, lane = tid & 63, wv = tid >> 6, r = lane & 31, h = lane >> 5;
  float* red = (float*)lds;
  float* rsv = red + 4 * 17 * 64;
  for (int it = blockIdx.x; it < T / 32; it += gridDim.x) {
    const size_t tb = (size_t)it * 32;
    f32x16 acc;
#pragma unroll
    for (int i = 0; i < 16; ++i) acc[i] = 0.f;
    float ss = 0.f;
    const float* xrow = x1 + (tb + r) * D + wv * 256 + 8 * h;
    const bf16_t* whr = WH + (size_t)r * 1024 + wv * 256 + 8 * h;
    const bf16_t* wlr = WL + (size_t)r * 1024 + wv * 256 + 8 * h;
#pragma unroll 4
    for (int ks = 0; ks < 16; ++ks) {
      const float4 xa = *(const float4*)(xrow + ks * 16), xb = *(const float4*)(xrow + ks * 16 + 4);
      const bf16x8 wh = *(const bf16x8*)(whr + ks * 16), wl = *(const bf16x8*)(wlr + ks * 16);
      const float xv[8] = {xa.x, xa.y, xa.z, xa.w, xb.x, xb.y, xb.z, xb.w};
      bf16x8 xh, xl;
#pragma unroll
      for (int j = 0; j < 8; ++j) { ss += xv[j] * xv[j]; const bf16_t hb = f2bf(xv[j]); xh[j] = (short)hb; xl[j] = (short)f2bf(xv[j] - bf2f(hb)); }
      acc = mfma32(wh, xh, acc); acc = mfma32(wh, xl, acc); acc = mfma32(wl, xh, acc);
    }
    ss += __shfl_xor(ss, 32);
    __syncthreads();
#pragma unroll
    for (int i = 0; i < 16; ++i) red[(wv * 17 + i) * 64 + lane] = acc[i];
    red[(wv * 17 + 16) * 64 + lane] = ss;
    __syncthreads();
    if (wv == 0) {
      float c[16];
#pragma unroll
      for (int i = 0; i < 16; ++i) c[i] = red[i * 64 + lane] + red[(17 + i) * 64 + lane] + red[(34 + i) * 64 + lane] + red[(51 + i) * 64 + lane];
      const float s2 = red[16 * 64 + lane] + red[(17 + 16) * 64 + lane] + red[(34 + 16) * 64 + lane] + red[(51 + 16) * 64 + lane];
      const float rs = rsqrtf(s2 * (1.f / D) + EPS);
      if (h == 0) rsv[r] = rs;
      float lg[20];
#pragma unroll
      for (int n = 0; n < 20; ++n) {
        const int reg = (n & 3) + 4 * (n >> 3), half = (n >> 2) & 1;
        const float mine = c[reg], oth = __shfl_xor(mine, 32);
        lg[n] = (h == half) ? mine : oth;
      }
      const int t = (int)tb + r;
      float gl[4];
#pragma unroll
      for (int q = 0; q < 4; ++q) gl[q] = lg[q] * rs + brg[q];
      int gi = 0; float gbest = gl[0];
#pragma unroll
      for (int q = 1; q < 4; ++q) if (gl[q] > gbest) { gbest = gl[q]; gi = q; }
      float den = 0.f;
#pragma unroll
      for (int q = 0; q < 4; ++q) den += expf(gl[q] - gbest);
      const float pg = 1.f / den;
      float le[4];
#pragma unroll
      for (int q = 0; q < 4; ++q) { float sel = 0.f;
#pragma unroll
        for (int gg2 = 0; gg2 < 4; ++gg2) sel = (gi == gg2) ? (lg[4 + gg2 * 4 + q] * rs + bre[gg2 * 4 + q]) : sel;
        le[q] = sel; }
      int i0 = 0; float l0 = le[0];
#pragma unroll
      for (int q = 1; q < 4; ++q) if (le[q] > l0) { l0 = le[q]; i0 = q; }
      int i1 = -1; float l1 = -INFINITY;
#pragma unroll
      for (int q = 0; q < 4; ++q) if (q != i0 && le[q] > l1) { l1 = le[q]; i1 = q; }
      const float e1 = expf(l1 - l0);
      const float w0 = pg / (1.f + e1), w1 = pg * e1 / (1.f + e1);
      const int elo = (i0 < i1) ? i0 : i1, ehi = (i0 < i1) ? i1 : i0;
      const float wlo = (i0 < i1) ? w0 : w1, whi = (i0 < i1) ? w1 : w0;
      const int pidx = (elo == 0) ? (ehi - 1) : ((elo == 1) ? (ehi + 1) : 5);
      const int cls = gi * 6 + pidx;
      if (h == 0) {
        const int slot = atomicAdd(&CNT[cls], 1);
        LIST[(size_t)cls * T + slot] = t;
        TOKW[t] = make_float2(wlo, whi);
      }
    }
    __syncthreads();
#pragma unroll 1
    for (int rr = wv * 8; rr < wv * 8 + 8; rr += 2) {
      const float rs0 = rsv[rr], rs1 = rsv[rr + 1];
      const float4* xr0 = (const float4*)(x1 + (tb + rr) * D); const float4* xr1 = (const float4*)(x1 + (tb + rr + 1) * D);
      float4 v0[4], v1[4];
#pragma unroll
      for (int j = 0; j < 4; ++j) { v0[j] = xr0[lane + 64 * j]; v1[j] = xr1[lane + 64 * j]; }
#pragma unroll
      for (int j = 0; j < 4; ++j) {
        const float4 gg = ((const float4*)g)[lane + 64 * j];
        ushort4 o; o.x = f2bf(v0[j].x * rs0 * gg.x); o.y = f2bf(v0[j].y * rs0 * gg.y); o.z = f2bf(v0[j].z * rs0 * gg.z); o.w = f2bf(v0[j].w * rs0 * gg.w);
        ((ushort4*)(XN + (tb + rr) * D))[lane + 64 * j] = o;
        ushort4 o1; o1.x = f2bf(v1[j].x * rs1 * gg.x); o1.y = f2bf(v1[j].y * rs1 * gg.y); o1.z = f2bf(v1[j].z * rs1 * gg.z); o1.w = f2bf(v1[j].w * rs1 * gg.w);
        ((ushort4*)(XN + (tb + rr + 1) * D))[lane + 64 * j] = o1;
      }
    }
  }
}

struct MoeItem { int cls, mtile, nt, cnt; };
DEVI void moe_prefix(const int* CNT, unsigned char* lds) {
  int* pre = (int*)(lds + LDS_BYTES + 64);
  __syncthreads();
  if (threadIdx.x < 24) pre[32 + threadIdx.x] = CNT[threadIdx.x];
  __syncthreads();
  if (threadIdx.x == 0) { int a = 0; for (int c = 0; c < 24; ++c) { pre[c] = a; a += (pre[32 + c] + 127) >> 7; } pre[24] = a; }
  __syncthreads();
}
DEVI bool moe_item(unsigned char* lds, int it, MoeItem& m) {
  const int* pre = (const int*)(lds + LDS_BYTES + 64);
  const int mt = it >> 3; m.nt = it & 7;
  if (mt >= pre[24]) return false;
  int c = 0;
#pragma unroll
  for (int q = 1; q < 24; ++q) c += (mt >= pre[q]) ? 1 : 0;
  m.cls = c; m.mtile = mt - pre[c]; m.cnt = pre[32 + c];
  return true;
}
DEVI void cls_experts(int cls, int& e0, int& e1) {
  const int g = cls / 6, pi = cls % 6;
  const int lo = (pi < 3) ? 0 : ((pi < 5) ? 1 : 2);
  const int hi = (pi < 3) ? (pi + 1) : ((pi < 5) ? (pi - 1) : 3);
  e0 = g * 4 + lo; e1 = g * 4 + hi;
}
DEVI void phase_g5(const Params& p, int l, unsigned char* lds) {
  const bf16_t* XN = (const bf16_t*)(p.ws + WS_A);
  bf16_t* HID = (bf16_t*)(p.ws + WS_B);
  const bf16_t* WGU = (const bf16_t*)(p.ws + WS_W + l * WS_WL + W_GU);
  const int* CNT = (const int*)(p.ws + SM_CNT) + l * 32;
  const int* LIST = (const int*)(p.ws + SM_LIST);
  const float2* TOKW = (const float2*)(p.ws + SM_TOKW);
  moe_prefix(CNT, lds);
  for (int it = vblock();; it += gridDim.x) {
    MoeItem mi; if (!moe_item(lds, it, mi)) break;
    int e0, e1; cls_experts(mi.cls, e0, e1);
    const int ex = (mi.nt < 4) ? e0 : e1, ntl = mi.nt & 3;
    const bf16_t* W = WGU + ((size_t)ex * 512 + ntl * 128) * 1024;
    const int* list = LIST + (size_t)mi.cls * T + mi.mtile * 128;
    const int nvalid = mi.cnt - mi.mtile * 128;
    f32x4 acc[4][4];
    gemm128g(lds, D, [&](int r, int k) { const int tok = (r < nvalid) ? list[r] : list[0]; return XN + (size_t)tok * D + k; }, [&](int r, int k) { return W + (size_t)r * D + k; }, acc);
    {
      const int tid = threadIdx.x, wid = tid >> 6, lane = tid & 63, wr = wid >> 1, wc = wid & 1, fr = lane & 15, fq = lane >> 4;
#pragma unroll
      for (int m = 0; m < 4; ++m) {
        const int er = wr * 64 + m * 16 + fr;
        if (er < nvalid) {
          const int tok = list[er];
          const float2 tw = TOKW[tok];
          const float w = (mi.nt < 4) ? tw.x : tw.y;
#pragma unroll
          for (int n = 0; n < 2; ++n) {
            f32x4 hv;
#pragma unroll
            for (int j = 0; j < 4; ++j) { const float gt = acc[m][n][j], up = acc[m][n + 2][j]; hv[j] = gt * sigmoidf_(gt) * up * w; }
            const int hh = (mi.nt < 4 ? 0 : 256) + ntl * 64 + wc * 32 + n * 16 + fq * 4;
            st_bf16x4(HID + (size_t)tok * 512 + hh, hv);
          }
        }
      }
    }
  }
}
DEVI void phase_g6(const Params& p, int l, unsigned char* lds) {
  const bf16_t* HID = (const bf16_t*)(p.ws + WS_B);
  const bf16_t* WDN = (const bf16_t*)(p.ws + WS_W + l * WS_WL + W_DN);
  const int* CNT = (const int*)(p.ws + SM_CNT) + l * 32;
  const int* LIST = (const int*)(p.ws + SM_LIST);
  float* out = p.out;
  moe_prefix(CNT, lds);
  for (int it = vblock();; it += gridDim.x) {
    MoeItem mi; if (!moe_item(lds, it, mi)) break;
    int e0, e1; cls_experts(mi.cls, e0, e1);
    const int* list = LIST + (size_t)mi.cls * T + mi.mtile * 128;
    const int nvalid = mi.cnt - mi.mtile * 128;
    const bf16_t* W0 = WDN + ((size_t)e0 * 1024 + mi.nt * 128) * 256;
    const bf16_t* W1 = WDN + ((size_t)e1 * 1024 + mi.nt * 128) * 256;
    f32x4 acc[4][4];
    gemm128g(lds, 512, [&](int r, int k) { const int tok = (r < nvalid) ? list[r] : list[0]; return HID + (size_t)tok * 512 + k; },
            [&](int r, int k) { return ((k < 256) ? W0 : W1) + (size_t)r * 256 + (k & 255); }, acc);
    GEMM_EPI4({ if (er < nvalid) { const size_t o = (size_t)list[er] * D + mi.nt * 128 + ec0; const f32x4 xi = *(const f32x4*)(out + o); *(f32x4*)(out + o) = xi + ev4; } })
  }
}


#define XB_TMO      128
#define XB_XCNT(j)  (256  + 64 * (j))
#define XB_XSUB(j)  (1280 + 64 * (j))
#define XB_XGEN(j)  (2304 + 64 * (j))
#define XB_TOP      3328
#define XB_TOPGEN   3392
#define XCD_BAR_WORDS 3456
#define XB_SPIN_CAP (1u << 18)
DEVI unsigned xb_ld(unsigned* p)              { return __hip_atomic_load(p, __ATOMIC_RELAXED, __HIP_MEMORY_SCOPE_AGENT); }
DEVI unsigned xb_add(unsigned* p, unsigned v) { return __hip_atomic_fetch_add(p, v, __ATOMIC_RELAXED, __HIP_MEMORY_SCOPE_AGENT); }
DEVI unsigned xb_xcc_id() { return (unsigned)__builtin_amdgcn_s_getreg((3 << 11) | 20) & 0xFu; }
#define XB_SPIN(cond, bar) do { unsigned _sp = 0; while (cond) { __builtin_amdgcn_s_sleep(1); \
    if ((++_sp & 255u) == 0u) { if (xb_ld(&(bar)[XB_TMO])) break; if (_sp > XB_SPIN_CAP) { atomicAdd(&(bar)[XB_TMO], 1u); break; } } } } while (0)
struct XcdBarrier { unsigned* bar; unsigned x; volatile LAS unsigned* st; };
DEVI XcdBarrier xcd_barrier_post(unsigned* bar, volatile LAS unsigned* st) {
    XcdBarrier b; b.bar = bar; b.x = xb_xcc_id(); b.st = st;
    if (threadIdx.x == 0) (void)xb_add(&bar[XB_XCNT(b.x)], 1u);
    return b;
}
DEVI void xcd_barrier_complete(unsigned* bar, unsigned x, unsigned& nloc, unsigned& nx) {
    const unsigned G = gridDim.x * gridDim.y * gridDim.z;
    unsigned sum, cnt, mine, sp = 0u;
    for (;;) {
        sum = 0u; cnt = 0u; mine = 0u;
#pragma unroll
        for (unsigned j = 0; j < 16; ++j) { const unsigned c = xb_ld(&bar[XB_XCNT(j)]); sum += c; cnt += (c > 0u) ? 1u : 0u; mine = (j == x) ? c : mine; }
        if (sum == G) break;
        __builtin_amdgcn_s_sleep(1);
        if ((++sp & 255u) == 0u) { if (xb_ld(&bar[XB_TMO])) break; if (sp > XB_SPIN_CAP) { atomicAdd(&bar[XB_TMO], 1u); break; } }
    }
    nloc = mine > 0u ? mine : 1u; nx = cnt > 0u ? cnt : 1u;
}
DEVI void xcd_barrier(const XcdBarrier& b) {
    asm volatile("s_waitcnt vmcnt(0)" ::: "memory");
    __syncthreads();
    if (threadIdx.x == 0) {
        unsigned* bar = b.bar;
        __builtin_amdgcn_s_waitcnt(0);
        unsigned nloc = b.st[0], nx = b.st[1];
        if (nloc == 0u) { xcd_barrier_complete(bar, b.x, nloc, nx); b.st[0] = nloc; b.st[1] = nx; }
        const unsigned old = xb_add(&bar[XB_XSUB(b.x)], 1u);
        const unsigned gen = old / nloc;
        if (old + 1u == (gen + 1u) * nloc) {
            __builtin_amdgcn_fence(__ATOMIC_RELEASE, "agent");
            asm volatile("s_waitcnt vmcnt(0)" ::: "memory");
            const unsigned og = xb_add(&bar[XB_TOP], 1u);
            const unsigned tg = og / nx;
            if (og + 1u == (tg + 1u) * nx) xb_add(&bar[XB_TOPGEN], 1u);
            else XB_SPIN(xb_ld(&bar[XB_TOPGEN]) == tg, bar);
            __builtin_amdgcn_fence(__ATOMIC_ACQUIRE, "agent");
            xb_add(&bar[XB_XGEN(b.x)], 1u);
            asm volatile("s_waitcnt vmcnt(0)" ::: "memory");
        } else {
            XB_SPIN(xb_ld(&bar[XB_XGEN(b.x)]) == gen, bar);
            __builtin_amdgcn_fence(__ATOMIC_ACQUIRE, "agent");
            asm volatile("s_waitcnt vmcnt(0)" ::: "memory");
        }
    }
    __syncthreads();
}

#define PH(k, call) { const int _k = (k); if (p.lo <= _k && _k < p.hi) { call; if (_k + 1 < p.hi) { if (_k == 0) grid.sync(); else xcd_barrier(xbar); } } }
__global__ void __launch_bounds__(NTHREADS, 2) hybrid_fwd(Params p) {
  extern __shared__ __attribute__((aligned(16))) unsigned char lds[];
  cg::grid_group grid = cg::this_grid();
  volatile LAS unsigned* xst = (volatile LAS unsigned*)(LAS unsigned char*)(lds + LDS_BYTES);
  if (threadIdx.x < 4) xst[threadIdx.x] = 0u;
  __syncthreads();
  XcdBarrier xbar = xcd_barrier_post((unsigned*)(p.ws + WS_CTL), xst);
  PH(0, phase_prep(p, lds))
#define LAYER(l) { \
    PH(1 + 13 * l + 0, phase_g1(p, l, lds)) \
    PH(1 + 13 * l + 2, phase_g2(p, l, lds)) \
    PH(1 + 13 * l + 3, phase_r2(p, l, lds)) \
    PH(1 + 13 * l + 4, phase_a1(p, l, lds)) \
    PH(1 + 13 * l + 5, phase_r3(p, l, lds)) \
    PH(1 + 13 * l + 6, phase_g3(p, l, lds)) \
    PH(1 + 13 * l + 7, phase_r4(p, l)) \
    PH(1 + 13 * l + 8, phase_g4(p, l, lds)) \
    PH(1 + 13 * l + 9, phase_r5(p, l, lds)) \
    PH(1 + 13 * l + 10, phase_g5(p, l, lds)) \
    PH(1 + 13 * l + 11, phase_g6(p, l, lds)) }
  LAYER(0)
  PH(13, rmsnorm_rows(p.out, p.in[2] + D, (bf16_t*)(p.ws + WS_A)))
  LAYER(1)
}

extern "C" void kernel_launch(void* const* d_in, const int* in_sizes, int n_in, void* d_out, int out_size, void* d_ws, size_t ws_size, hipStream_t stream) {
  static int grid_blocks = 0;
  if (!grid_blocks) {
    if (n_in != 45 || ws_size < WS_END) { fprintf(stderr, "kernel_launch: unexpected n_in %d or ws_size %zu (< %zu)\n", n_in, ws_size, (size_t)WS_END); grid_blocks = -1; return; }
    int dev = 0, cus = 0, per_cu = 0;
    hipGetDevice(&dev);
    hipDeviceGetAttribute(&cus, hipDeviceAttributeMultiprocessorCount, dev);
    hipFuncSetAttribute((const void*)hybrid_fwd, hipFuncAttributeMaxDynamicSharedMemorySize, LDS_ALLOC);
    hipOccupancyMaxActiveBlocksPerMultiprocessor(&per_cu, (const void*)hybrid_fwd, NTHREADS, LDS_ALLOC);
    if (per_cu < 1) per_cu = 1;
    if (per_cu > 2) per_cu = 2;
    grid_blocks = cus * per_cu;
    fprintf(stderr, "kernel_launch: cus %d per_cu %d grid %d\n", cus, per_cu, grid_blocks);
  }
  if (grid_blocks < 0) return;
  (void)hipMemsetAsync((unsigned char*)d_ws + WS_CTL, 0, XCD_BAR_WORDS * 4, stream);
  Params p{};
  for (int i = 0; i < 45; ++i) p.in[i] = (const float*)d_in[i];
  p.out = (float*)d_out; p.ws = (unsigned char*)d_ws;
#if N_LAUNCH_MODE == 1
  p.lo = 0; p.hi = NPH;
  { void* args[] = {&p}; hipError_t e = hipLaunchCooperativeKernel((void*)hybrid_fwd, dim3(grid_blocks), dim3(NTHREADS), args, LDS_ALLOC, stream);
    if (e != hipSuccess) fprintf(stderr, "cooperative launch failed: %s\n", hipGetErrorString(e)); }
#else
  for (int ph = 0; ph < NPH; ++ph) {
    p.lo = ph; p.hi = ph + 1;
    void* args[] = {&p}; hipError_t e = hipLaunchCooperativeKernel((void*)hybrid_fwd, dim3(grid_blocks), dim3(NTHREADS), args, LDS_ALLOC, stream);
    if (e != hipSuccess) { fprintf(stderr, "launch %d failed: %s\n", ph, hipGetErrorString(e)); break; }
  }
#endif
}
```

```cpp
#include <hip/hip_runtime.h>
#include <hip/hip_cooperative_groups.h>
#include <cstdio>
#include <cstdint>
namespace cg = cooperative_groups;

#ifndef N_LAUNCH_MODE
#define N_LAUNCH_MODE 1
#endif

#define DEVI __device__ __forceinline__
typedef unsigned short bf16_t;
typedef short bf16x8 __attribute__((ext_vector_type(8)));
typedef float f32x4 __attribute__((ext_vector_type(4)));
typedef float f32x16 __attribute__((ext_vector_type(16)));
typedef unsigned u32x4 __attribute__((ext_vector_type(4)));
#define LAS __attribute__((address_space(3)))

constexpr int NB = 16, S = 2048, T = NB * S, D = 1024, DIN = 1772, DINP = 1792, NL = 2;
constexpr int C_CQ = 0, C_KPE = 192, C_NG = 224, C_CKV = 256, C_LX = 384, C_LG = 640, C_S5 = 896, C_NQ = 1152, C_KS = 1408, C_KW = 1472, C_KC = 1536, C_VC = 1600, C_VS = 1664, C_VW = 1728;
__host__ __device__ constexpr int colmap(int n) {
  if (n < 192) return n;
  if (n < 320) return C_CKV + (n - 192);
  if (n < 352) return C_KPE + (n - 320);
  if (n < 608) return C_LX + (n - 352);
  if (n < 864) return C_LG + (n - 608);
  if (n < 1120) return C_S5 + (n - 864);
  if (n < 1376) return C_NQ + (n - 1120);
  if (n < 1760) { const int j = n - 1376, part = j >> 6, d = j & 63; return (part == 0 ? C_KC : part == 1 ? C_VC : part == 2 ? C_KS : part == 3 ? C_VS : part == 4 ? C_KW : C_VW) + d; }
  return C_NG + (n - 1760);
}
constexpr float EPS = 1e-6f;
constexpr float LOG2E = 1.4426950408889634f;
constexpr int NTHREADS = 256;
constexpr int NPH = 1 + 13 * NL - 1;

constexpr size_t MiB = 1u << 20;
constexpr size_t WS_CTL = 0;
constexpr size_t WS_SMALL = 1 * MiB;
constexpr size_t WS_W = 16 * MiB;
constexpr size_t WS_WL = 32 * MiB;
constexpr size_t WS_A = 80 * MiB;
constexpr size_t WS_B = 144 * MiB;
constexpr size_t WS_C = 256 * MiB;
constexpr size_t WS_D = 292 * MiB;
constexpr size_t WS_E = 348 * MiB;
constexpr size_t WS_F = 380 * MiB;
constexpr size_t WS_G = 428 * MiB;
constexpr size_t WS_ROPE = 452 * MiB;
constexpr size_t WS_END = 460 * MiB;
constexpr size_t W_IN = 0;
constexpr size_t W_OUT = 4 * MiB;
constexpr size_t W_UQ = 6 * MiB;
constexpr size_t W_UKV = W_UQ + 384 * 192 * 2;
constexpr size_t W_LRU = W_UKV + 512 * 128 * 2;
constexpr size_t W_GLU = W_LRU + 4 * 128 * 64 * 2;
constexpr size_t W_1K = 6 * MiB + 512 * 1024;
constexpr size_t W_1V = W_1K + 128 * 2048 * 2;
constexpr size_t W_B1K = W_1V + 128 * 2048 * 2;
constexpr size_t W_B1V = W_B1K + 512;
constexpr size_t W_S5A = W_B1V + 512;
constexpr size_t W_S5A64 = W_S5A + 16 * 64 * 8;
constexpr size_t W_S5B = W_S5A64 + 16 * 64 * 8;
constexpr size_t W_S5BB = W_S5B + 16 * 64 * 16 * 8;
constexpr size_t W_S5CM = W_S5BB + 16 * 4 * 32 * 16 * 2;
constexpr size_t W_2K = W_S5CM + 16 * 16 * 128 * 2;
constexpr size_t W_2V = W_2K + 64 * 128 * 2;
static_assert(W_2V + 64 * 128 * 2 <= 8 * MiB, "weights overflow");
constexpr size_t W_RTH = W_2V + 64 * 128 * 2;
constexpr size_t W_RTL = W_RTH + 32 * 1024 * 2;
static_assert(W_RTL + 32 * 1024 * 2 <= 8 * MiB, "weights overflow 2");
constexpr size_t W_GU = 8 * MiB;
constexpr size_t W_DN = 24 * MiB;
constexpr size_t SM_CNT = WS_SMALL;
constexpr size_t SM_LIST = WS_SMALL + 4096;
constexpr size_t SM_TOKW = SM_LIST + 24 * (size_t)T * 4;
constexpr size_t SM_LSUM = SM_TOKW + (size_t)T * 8;
constexpr size_t SM_SLOC = SM_LSUM + 16 * 32 * 256 * 8;
constexpr size_t SM_HK = SM_SLOC + 16 * 32 * 1024 * 8;
constexpr size_t SM_HV = SM_HK + 2048 * 128 * 2;
constexpr size_t SM_KC = SM_HV + 2048 * 128 * 2;
constexpr size_t SM_VC = SM_KC + 16 * 128 * 64 * 2;
constexpr size_t SM_SCAR = SM_VC + 16 * 128 * 64 * 2;
constexpr size_t SM_LCAR = SM_SCAR + 16 * 32 * 1024 * 8;
constexpr size_t SM_END = SM_LCAR + 16 * 32 * 256 * 4;
static_assert(SM_END <= WS_W, "small region overflow");

constexpr int LDS_BYTES = 65536;
constexpr int LDS_ALLOC = LDS_BYTES + 512;

struct Params {
  const float* in[45];
  float* out;
  unsigned char* ws;
  int lo, hi;
};

DEVI float bf2f(bf16_t v) { return __uint_as_float(((unsigned)v) << 16); }
DEVI bf16_t f2bf(float f) { unsigned u = __float_as_uint(f); return (bf16_t)((u + 0x7fffu + ((u >> 16) & 1u)) >> 16); }
DEVI float wsum(float v) {
#pragma unroll
  for (int o = 32; o >= 1; o >>= 1) v += __shfl_xor(v, o);
  return v;
}
DEVI float sigmoidf_(float x) { return __builtin_amdgcn_rcpf(1.f + __expf(-x)); }
DEVI float gelu_tanh(float x) { const float u2 = 1.5957691216057308f * (x + 0.044715f * x * x * x); return x * __builtin_amdgcn_rcpf(1.f + __expf(-u2)); }
DEVI f32x16 mfma32(bf16x8 a, bf16x8 b, f32x16 c) { return __builtin_amdgcn_mfma_f32_32x32x16_bf16(a, b, c, 0, 0, 0); }
DEVI f32x4 mfma16(bf16x8 a, bf16x8 b, f32x4 c) { return __builtin_amdgcn_mfma_f32_16x16x32_bf16(a, b, c, 0, 0, 0); }
DEVI int vblock() { const int G = (int)gridDim.x, bx = (int)blockIdx.x; return (G % 8 == 0) ? (bx % 8) * (G / 8) + bx / 8 : bx; }
DEVI int crow(int r, int h) { return (r & 3) + 8 * (r >> 2) + 4 * h; }
typedef __bf16 bf16x2_t __attribute__((ext_vector_type(2)));
typedef float f32x2_t __attribute__((ext_vector_type(2)));
DEVI unsigned pk2bf(float lo, float hi) { f32x2_t v = {lo, hi}; bf16x2_t b = __builtin_convertvector(v, bf16x2_t); return __builtin_bit_cast(unsigned, b); }

template <class AF, class BF>
DEVI void gemm128(unsigned char* lds, int K, AF aload, BF bptr, f32x4 (&acc)[4][4]) {
  const int tid = threadIdx.x, wid = tid >> 6, lane = tid & 63, wr = wid >> 1, wc = wid & 1, fr = lane & 15, fq = lane >> 4;
#pragma unroll
  for (int m = 0; m < 4; ++m)
#pragma unroll
    for (int n = 0; n < 4; ++n) acc[m][n] = (f32x4){0.f, 0.f, 0.f, 0.f};
  const int lr = tid >> 3, ch = tid & 7;
  const int wofs = lr * 128 + ((ch ^ ((lr >> 1) & 7)) * 16);
  const int sw = (fr >> 1) & 7;
  const int aro = (wr * 64 + fr) * 128, bro = (wc * 64 + fr) * 128;
  const int nk = K >> 6;
  u32x4 ra[4], rb[4];
#pragma unroll
  for (int i = 0; i < 4; ++i) { ra[i] = aload(lr + 32 * i, ch * 8); rb[i] = *(const u32x4*)bptr(lr + 32 * i, ch * 8); }
  __syncthreads();
#pragma unroll
  for (int i = 0; i < 4; ++i) { *(u32x4*)(lds + wofs + i * 4096) = ra[i]; *(u32x4*)(lds + 16384 + wofs + i * 4096) = rb[i]; }
  __syncthreads();
  for (int kt = 0; kt < nk; ++kt) {
    const bool more = (kt + 1 < nk);
    if (more) {
      const int k = (kt + 1) * 64 + ch * 8;
#pragma unroll
      for (int i = 0; i < 4; ++i) { ra[i] = aload(lr + 32 * i, k); rb[i] = *(const u32x4*)bptr(lr + 32 * i, k); }
    }
    const unsigned char* bufA = lds + (kt & 1) * 32768;
    const unsigned char* bufB = bufA + 16384;
#pragma unroll
    for (int kk = 0; kk < 2; ++kk) {
      bf16x8 At[4], Bt[4];
      const int co = ((kk * 4 + fq) ^ sw) * 16;
#pragma unroll
      for (int m = 0; m < 4; ++m) At[m] = *(const bf16x8*)(bufA + aro + m * 2048 + co);
#pragma unroll
      for (int n = 0; n < 4; ++n) Bt[n] = *(const bf16x8*)(bufB + bro + n * 2048 + co);
#pragma unroll
      for (int m = 0; m < 4; ++m)
#pragma unroll
        for (int n = 0; n < 4; ++n) acc[m][n] = mfma16(Bt[n], At[m], acc[m][n]);
    }
    if (more) {
      unsigned char* nb = lds + ((kt + 1) & 1) * 32768;
#pragma unroll
      for (int i = 0; i < 4; ++i) { *(u32x4*)(nb + wofs + i * 4096) = ra[i]; *(u32x4*)(nb + 16384 + wofs + i * 4096) = rb[i]; }
    }
    __syncthreads();
  }
}
template <class AF, class BF>
DEVI void gemm128g(unsigned char* lds, int K, AF aptr, BF bptr, f32x4 (&acc)[4][4]) {
  const int tid = threadIdx.x, wid = tid >> 6, lane = tid & 63, wr = wid >> 1, wc = wid & 1, fr = lane & 15, fq = lane >> 4;
#pragma unroll
  for (int m = 0; m < 4; ++m)
#pragma unroll
    for (int n = 0; n < 4; ++n) acc[m][n] = (f32x4){0.f, 0.f, 0.f, 0.f};
  const int lr = tid >> 3;
  const int chs = ((tid & 7) ^ ((lr >> 1) & 7)) * 8;
  const int sw = (fr >> 1) & 7;
  const int aro = (wr * 64 + fr) * 128, bro = (wc * 64 + fr) * 128;
  const int nk = K >> 6;
  LAS unsigned char* l3 = (LAS unsigned char*)lds;
#define G128_STAGE(buf, kbase)                                                                                                   \
  _Pragma("unroll") for (int i = 0; i < 4; ++i) {                                                                                 \
    __builtin_amdgcn_global_load_lds((const __attribute__((address_space(1))) unsigned*)aptr(lr + 32 * i, (kbase) + chs),          \
                                     (LAS unsigned*)(l3 + (buf) * 32768 + tid * 16 + i * 4096), 16, 0, 0);                           \
    __builtin_amdgcn_global_load_lds((const __attribute__((address_space(1))) unsigned*)bptr(lr + 32 * i, (kbase) + chs),          \
                                     (LAS unsigned*)(l3 + (buf) * 32768 + 16384 + tid * 16 + i * 4096), 16, 0, 0);                   \
  }
  __syncthreads();
  G128_STAGE(0, 0)
  asm volatile("s_waitcnt vmcnt(0)" ::: "memory");
  __syncthreads();
  for (int kt = 0; kt < nk; ++kt) {
    if (kt + 1 < nk) { G128_STAGE((kt + 1) & 1, (kt + 1) * 64) }
    const unsigned char* bufA = lds + (kt & 1) * 32768;
    const unsigned char* bufB = bufA + 16384;
#pragma unroll
    for (int kk = 0; kk < 2; ++kk) {
      bf16x8 At[4], Bt[4];
      const int co = ((kk * 4 + fq) ^ sw) * 16;
#pragma unroll
      for (int m = 0; m < 4; ++m) At[m] = *(const bf16x8*)(bufA + aro + m * 2048 + co);
#pragma unroll
      for (int n = 0; n < 4; ++n) Bt[n] = *(const bf16x8*)(bufB + bro + n * 2048 + co);
#pragma unroll
      for (int m = 0; m < 4; ++m)
#pragma unroll
        for (int n = 0; n < 4; ++n) acc[m][n] = mfma16(Bt[n], At[m], acc[m][n]);
    }
    asm volatile("s_waitcnt vmcnt(0)" ::: "memory");
    __syncthreads();
  }
#undef G128_STAGE
}
#define GEMM_EPI_LOOP(body)                                                                 \
  {                                                                                         \
    const int _tid = threadIdx.x, _wid = _tid >> 6, _lane = _tid & 63, _wr = _wid >> 1, _wc = _wid & 1, _fr = _lane & 15, _fq = _lane >> 4; \
    _Pragma("unroll") for (int m = 0; m < 4; ++m) _Pragma("unroll") for (int n = 0; n < 4; ++n) _Pragma("unroll") for (int j = 0; j < 4; ++j) { \
      const int er = _wr * 64 + m * 16 + _fr, ec = _wc * 64 + n * 16 + _fq * 4 + j; const float ev = acc[m][n][j]; body }                      \
  }
#define GEMM_EPI4(body)                                                                     \
  {                                                                                         \
    const int _tid = threadIdx.x, _wid = _tid >> 6, _lane = _tid & 63, _wr = _wid >> 1, _wc = _wid & 1, _fr = _lane & 15, _fq = _lane >> 4; \
    _Pragma("unroll") for (int m = 0; m < 4; ++m) _Pragma("unroll") for (int n = 0; n < 4; ++n) {                                             \
      const int er = _wr * 64 + m * 16 + _fr, ec0 = _wc * 64 + n * 16 + _fq * 4; const f32x4 ev4 = acc[m][n]; body }                          \
  }
DEVI void st_bf16x4(bf16_t* p, f32x4 v) { uint2 o; o.x = pk2bf(v[0], v[1]); o.y = pk2bf(v[2], v[3]); *(uint2*)p = o; }

template <class RM>
DEVI void transpose_tiles(const float* src, int K, int N, bf16_t* dst, int ldk, RM rowmap, unsigned char* lds, int& cursor, const float* kscale = nullptr) {
  float* tl = (float*)lds;
  const int tk = K / 64, tn = (N + 63) / 64, nt = tk * tn;
  const int tid = threadIdx.x;
  const int G_ = (int)gridDim.x;
  for (int it = ((int)blockIdx.x - cursor % G_ + G_) % G_; it < nt; it += G_) {
    const int kt = it / tn, ntile = it % tn, k0 = kt * 64, n0 = ntile * 64;
    __syncthreads();
#pragma unroll
    for (int q = 0; q < 4; ++q) {
      const int r = (tid >> 4) + 16 * q, c4 = (tid & 15) * 4;
      const float* sp = src + (size_t)(k0 + r) * N + n0 + c4;
      float4 v;
      if (n0 + c4 + 3 < N) v = *(const float4*)sp;
      else { v.x = (n0 + c4 < N) ? sp[0] : 0.f; v.y = (n0 + c4 + 1 < N) ? sp[1] : 0.f; v.z = (n0 + c4 + 2 < N) ? sp[2] : 0.f; v.w = 0.f; }
      if (kscale) { const float ks = kscale[k0 + r]; v.x *= ks; v.y *= ks; v.z *= ks; v.w *= ks; }
      tl[r * 65 + c4] = v.x; tl[r * 65 + c4 + 1] = v.y; tl[r * 65 + c4 + 2] = v.z; tl[r * 65 + c4 + 3] = v.w;
    }
    __syncthreads();
    const int n = tid >> 2, kc = (tid & 3) * 16;
    if (n0 + n < N) {
      unsigned w[8];
#pragma unroll
      for (int i = 0; i < 8; ++i) w[i] = pk2bf(tl[(kc + 2 * i) * 65 + n], tl[(kc + 2 * i + 1) * 65 + n]);
      uint4* o = (uint4*)(dst + (size_t)rowmap(n0 + n) * ldk + k0 + kc);
      o[0] = make_uint4(w[0], w[1], w[2], w[3]); o[1] = make_uint4(w[4], w[5], w[6], w[7]);
    }
  }
  cursor += nt;
}
DEVI void rmsnorm_rows(const float* x, const float* g, bf16_t* xn) {
  const int lane = threadIdx.x & 63, gw = blockIdx.x * 4 + (threadIdx.x >> 6), NGW = gridDim.x * 4;
  for (int t = gw; t < T; t += NGW) {
    const float4* xr = (const float4*)(x + (size_t)t * D);
    float4 v[4]; float s = 0.f;
#pragma unroll
    for (int j = 0; j < 4; ++j) { v[j] = xr[lane + 64 * j]; s += v[j].x * v[j].x + v[j].y * v[j].y + v[j].z * v[j].z + v[j].w * v[j].w; }
    const float rs = rsqrtf(wsum(s) * (1.f / D) + EPS);
#pragma unroll
    for (int j = 0; j < 4; ++j) {
      const float4 gg = ((const float4*)g)[lane + 64 * j];
      uint2 o; o.x = pk2bf(v[j].x * rs * gg.x, v[j].y * rs * gg.y); o.y = pk2bf(v[j].z * rs * gg.z, v[j].w * rs * gg.w);
      ((uint2*)(xn + (size_t)t * D))[lane + 64 * j] = o;
    }
  }
}
DEVI void phase_prep(const Params& p, unsigned char* lds) {
  const size_t gtid = (size_t)blockIdx.x * NTHREADS + threadIdx.x, gn = (size_t)gridDim.x * NTHREADS;
  unsigned char* ws = p.ws;
  if (gtid < 64) ((int*)(ws + SM_CNT))[gtid] = 0;
  auto ident = [](int n) { return n; };
  int cursor = 0;
  for (int l = 0; l < NL; ++l) {
    unsigned char* wl = ws + WS_W + l * WS_WL;
    transpose_tiles(p.in[3] + (size_t)l * D * DIN, D, DIN, (bf16_t*)(wl + W_IN), D, [](int n) { return colmap(n); }, lds, cursor);
    for (size_t i = gtid; i < (size_t)20 * D; i += gn) ((bf16_t*)(wl + W_IN))[(size_t)236 * D + i] = 0;
    transpose_tiles(p.in[36] + (size_t)l * D * D, D, D, (bf16_t*)(wl + W_OUT), D, ident, lds, cursor);
    transpose_tiles(p.in[6] + (size_t)l * 192 * 384, 192, 384, (bf16_t*)(wl + W_UQ), 192, ident, lds, cursor, p.in[4] + l * 192);
    transpose_tiles(p.in[7] + (size_t)l * 128 * 512, 128, 512, (bf16_t*)(wl + W_UKV), 128, ident, lds, cursor, p.in[5] + l * 128);
    transpose_tiles(p.in[25] + (size_t)l * 256 * 256, 256, 256, (bf16_t*)(wl + W_GLU), 256, ident, lds, cursor);
    transpose_tiles(p.in[30] + (size_t)l * 2048 * 128, 2048, 128, (bf16_t*)(wl + W_1K), 2048, ident, lds, cursor);
    transpose_tiles(p.in[33] + (size_t)l * 2048 * 128, 2048, 128, (bf16_t*)(wl + W_1V), 2048, ident, lds, cursor);
    transpose_tiles(p.in[31] + (size_t)l * 128 * 64, 128, 64, (bf16_t*)(wl + W_2K), 128, ident, lds, cursor);
    transpose_tiles(p.in[34] + (size_t)l * 128 * 64, 128, 64, (bf16_t*)(wl + W_2V), 128, ident, lds, cursor);
    for (int h = 0; h < 4; ++h) {
      transpose_tiles(p.in[12] + ((size_t)l * 4 + h) * 64 * 64, 64, 64, (bf16_t*)(wl + W_LRU) + h * 128 * 64, 64, ident, lds, cursor);
      transpose_tiles(p.in[14] + ((size_t)l * 4 + h) * 64 * 64, 64, 64, (bf16_t*)(wl + W_LRU) + h * 128 * 64 + 64 * 64, 64, ident, lds, cursor);
    }
    for (int e = 0; e < 16; ++e) {
      bf16_t* dg = (bf16_t*)(wl + W_GU) + (size_t)e * 512 * 1024;
      transpose_tiles(p.in[42] + ((size_t)l * 16 + e) * 1024 * 256, 1024, 256, dg, 1024, [](int hh) { return (hh >> 6) * 128 + ((hh >> 5) & 1) * 64 + ((hh >> 4) & 1) * 16 + (hh & 15); }, lds, cursor);
      transpose_tiles(p.in[43] + ((size_t)l * 16 + e) * 1024 * 256, 1024, 256, dg, 1024, [](int hh) { return (hh >> 6) * 128 + ((hh >> 5) & 1) * 64 + (((hh >> 4) & 1) + 2) * 16 + (hh & 15); }, lds, cursor);
      transpose_tiles(p.in[44] + ((size_t)l * 16 + e) * 256 * 1024, 256, 1024, (bf16_t*)(wl + W_DN) + (size_t)e * 1024 * 256, 256, ident, lds, cursor);
    }
    {
      const int lane = threadIdx.x & 63, gw = blockIdx.x * 4 + (threadIdx.x >> 6), NGW = gridDim.x * 4;
      for (int o = gw; o < 256; o += NGW) {
        const int kv = o >> 7, j = o & 127;
        const float* pe = (kv ? p.in[32] : p.in[29]) + (size_t)l * 2048;
        const float* w1 = (kv ? p.in[33] : p.in[30]) + (size_t)l * 2048 * 128;
        float a = 0.f;
#pragma unroll 8
        for (int k = lane; k < 2048; k += 64) a += pe[k] * w1[(size_t)k * 128 + j];
        a = wsum(a);
        if (lane == 0) ((float*)(wl + (kv ? W_B1V : W_B1K)))[j] = a;
      }
    }
    for (size_t i = gtid; i < 16 * 64; i += gn) {
      const int g = (int)(i >> 6), sidx = (int)(i & 63);
      const float are = p.in[17][(size_t)l * 1024 + i], aim = p.in[18][(size_t)l * 1024 + i];
      const float dt = expf(p.in[19][l * 16 + g]);
      const float mag = expf(dt * are);
      float sn, cs; sincosf(dt * aim, &sn, &cs);
      const float abr = mag * cs, abi = mag * sn;
      const float den = are * are + aim * aim, nre = abr - 1.f;
      const float gre = (nre * are + abi * aim) / den, gim = (abi * are - nre * aim) / den;
      ((float2*)(wl + W_S5A))[i] = make_float2(abr, abi);
      float pr = abr, pi = abi;
#pragma unroll
      for (int q = 0; q < 6; ++q) { const float nr = pr * pr - pi * pi, ni = 2.f * pr * pi; pr = nr; pi = ni; }
      ((float2*)(wl + W_S5A64))[i] = make_float2(pr, pi);
      bf16_t* bb = (bf16_t*)(wl + W_S5BB);
      for (int ch = 0; ch < 16; ++ch) {
        const float br = p.in[20][((size_t)l * 1024 + i) * 16 + ch], bi = p.in[21][((size_t)l * 1024 + i) * 16 + ch];
        const float vr = gre * br - gim * bi, vi = gre * bi + gim * br;
        const int sb = sidx >> 5, r = sidx & 31;
        bb[((g * 4 + sb * 2 + 0) * 32 + r) * 16 + ch] = f2bf(vr);
        bb[((g * 4 + sb * 2 + 1) * 32 + r) * 16 + ch] = f2bf(vi);
      }
    }
    for (size_t i = gtid; i < 32 * 1024; i += gn) {
      const int n = (int)(i >> 10), k = (int)(i & 1023);
      float w = 0.f;
      if (n < 20) w = p.in[37][l * D + k] * ((n < 4) ? p.in[38][((size_t)l * D + k) * 4 + n] : p.in[40][((size_t)l * D + k) * 16 + (n - 4)]);
      const bf16_t hi = f2bf(w);
      ((bf16_t*)(wl + W_RTH))[i] = hi; ((bf16_t*)(wl + W_RTL))[i] = f2bf(w - bf2f(hi));
    }
    for (size_t i = gtid; i < 16 * 16 * 64; i += gn) {
      const int g = (int)(i >> 10), ch = (int)((i >> 6) & 15), pp = (int)(i & 63);
      const float cr = p.in[22][(size_t)l * 16384 + i], ci = p.in[23][(size_t)l * 16384 + i];
      bf16_t* cm = (bf16_t*)(wl + W_S5CM) + ((size_t)(g * 16 + ch) * 128 + 2 * pp);
      cm[0] = f2bf(cr); cm[1] = f2bf(-ci);
    }
  }
  {
    const int* positions = (const int*)p.in[1];
    float2* RM = (float2*)(ws + WS_ROPE);
    float2* RN = RM + (size_t)T * 16;
    for (size_t i = gtid; i < (size_t)T * 24; i += gn) {
      const int t = (int)(i / 24), j = (int)(i % 24);
      const int rot = (j < 16) ? 32 : 16, fi = (j < 16) ? j : (j - 16);
      const float inv = powf(500000.f, -(2.f * (float)fi) / (float)rot);
      float sn, cs; sincosf((float)positions[t] * inv, &sn, &cs);
      if (j < 16) RM[(size_t)t * 16 + fi] = make_float2(cs, sn); else RN[(size_t)t * 8 + fi] = make_float2(cs, sn);
    }
  }
  rmsnorm_rows(p.in[0], p.in[2], (bf16_t*)(ws + WS_A));
}

DEVI void phase_g1(const Params& p, int l, unsigned char* lds) {
  const bf16_t* XN = (const bf16_t*)(p.ws + WS_A);
  const bf16_t* W = (const bf16_t*)(p.ws + WS_W + l * WS_WL + W_IN);
  bf16_t* PROJ = (bf16_t*)(p.ws + WS_B);
  constexpr int NT = DINP / 128;
  for (int it = vblock(); it < (T / 128) * NT; it += gridDim.x) {
    const int mt = it / NT, nt = it % NT;
    f32x4 acc[4][4];
    gemm128g(lds, D, [&](int r, int k) { return XN + (size_t)(mt * 128 + r) * D + k; }, [&](int r, int k) { return W + (size_t)(nt * 128 + r) * D + k; }, acc);
    if (nt >= 9 && nt <= 11) {
      const int tid = threadIdx.x, wid = tid >> 6, lane = tid & 63, wr = wid >> 1, wc = wid & 1, fr = lane & 15, fq = lane >> 4;
      const float* gg = (nt < 11) ? (p.in[27] + l * 64) : (p.in[28] + l * 192 + (wc ? 128 : 64));
      const float sc = (nt < 11) ? (0.125f * LOG2E) : 1.f;
      const float2* RN = (const float2*)(p.ws + WS_ROPE) + (size_t)T * 16;
#pragma unroll
      for (int m = 0; m < 4; ++m) {
        const size_t t = (size_t)mt * 128 + wr * 64 + m * 16 + fr;
        float ss = 0.f;
#pragma unroll
        for (int n = 0; n < 4; ++n) ss += acc[m][n][0] * acc[m][n][0] + acc[m][n][1] * acc[m][n][1] + acc[m][n][2] * acc[m][n][2] + acc[m][n][3] * acc[m][n][3];
        ss += __shfl_xor(ss, 16); ss += __shfl_xor(ss, 32);
        const float rs = rsqrtf(ss * (1.f / 64) + EPS);
#pragma unroll
        for (int n = 0; n < 4; ++n) {
          const float4 g4 = *(const float4*)(gg + n * 16 + fq * 4);
          f32x4 v = acc[m][n];
          v[0] *= rs * g4.x; v[1] *= rs * g4.y; v[2] *= rs * g4.z; v[3] *= rs * g4.w;
          if (n == 0) {
#pragma unroll
            for (int j = 0; j < 4; ++j) {
              const float x = v[j], partner = __shfl_xor(x, 32);
              const int d = fq * 4 + j; const float2 cs2 = RN[t * 8 + (d & 7)];
              v[j] = (d < 8) ? (x * cs2.x - partner * cs2.y) : (partner * cs2.y + x * cs2.x);
            }
          }
          st_bf16x4(PROJ + t * DINP + nt * 128 + wc * 64 + n * 16 + fq * 4, v * sc);
        }
      }
    } else {
      GEMM_EPI4({ st_bf16x4(PROJ + (size_t)(mt * 128 + er) * DINP + nt * 128 + ec0, ev4); })
    }
  }
}

DEVI void phase_g2(const Params& p, int l, unsigned char* lds) {
  unsigned char* wl = p.ws + WS_W + l * WS_WL;
  const bf16_t* PROJ = (const bf16_t*)(p.ws + WS_B);
  bf16_t* QR = (bf16_t*)(p.ws + WS_D);
  bf16_t* KVR = QR + (size_t)T * 384;
  bf16_t* GATES = (bf16_t*)(p.ws + WS_E);
  bf16_t* MK = (bf16_t*)(p.ws + WS_F) + (size_t)T * 4 * 96;
  const float2* RM = (const float2*)(p.ws + WS_ROPE);
  constexpr int N_CMP = 32, N_QR = 256 * 3, N_KVR = 256 * 4, N_GT = 256 * 4;
  const int tid = threadIdx.x, wid = tid >> 6, lane = tid & 63, wr = wid >> 1, wc = wid & 1, fr = lane & 15, fq = lane >> 4;
  for (int it = vblock(); it < N_CMP + N_QR + N_KVR + N_GT; it += gridDim.x) {
    f32x4 acc[4][4];
    if (it < N_CMP) {
      const int kv = it & 1, mt = it >> 1;
      const bf16_t* W = (const bf16_t*)(wl + (kv ? W_1V : W_1K));
      const float* bias = (const float*)(wl + (kv ? W_B1V : W_B1K));
      bf16_t* H = (bf16_t*)(p.ws + (kv ? SM_HV : SM_HK));
      gemm128g(lds, 2048,
              [&](int r, int k) { const int m = mt * 128 + r, b = m >> 7; int c = m & 127; if (c > 126) c = 126;
                                  return PROJ + (size_t)(b * S + 16 * c + (k >> 6)) * DINP + C_KC + kv * 64 + (k & 63); },
              [&](int r, int k) { return W + (size_t)r * 2048 + k; }, acc);
      GEMM_EPI4({ f32x4 o; _Pragma("unroll") for (int j = 0; j < 4; ++j) o[j] = gelu_tanh(ev4[j] + bias[ec0 + j]); st_bf16x4(H + (size_t)(mt * 128 + er) * 128 + ec0, o); })
    } else if (it < N_CMP + N_QR) {
      const int i2 = it - N_CMP, mt = i2 / 3, nt = i2 % 3;
      const bf16_t* W = (const bf16_t*)(wl + W_UQ);
      gemm128g(lds, 192, [&](int r, int k) { return PROJ + (size_t)(mt * 128 + r) * DINP + C_CQ + k; }, [&](int r, int k) { return W + (size_t)(nt * 128 + r) * 192 + k; }, acc);
      GEMM_EPI4({ st_bf16x4(QR + (size_t)(mt * 128 + er) * 384 + nt * 128 + ec0, ev4); })
    } else if (it < N_CMP + N_QR + N_KVR) {
      const int i2 = it - N_CMP - N_QR, mt = i2 >> 2, hd = i2 & 3;
      const bf16_t* W = (const bf16_t*)(wl + W_UKV);
      gemm128g(lds, 128, [&](int r, int k) { return PROJ + (size_t)(mt * 128 + r) * DINP + C_CKV + k; }, [&](int r, int k) { return W + (size_t)(hd * 128 + r) * 128 + k; }, acc);
      const float* g_k = p.in[9] + l * 96;
#pragma unroll
      for (int m = 0; m < 4; ++m) {
        const size_t t = (size_t)mt * 128 + wr * 64 + m * 16 + fr;
        const int b = (int)(t >> 11), sq = (int)(t & (S - 1));
        float ss = 0.f;
        {
          const bf16_t* cr = PROJ + t * DINP + C_CKV + fq * 32;
#pragma unroll
          for (int q = 0; q < 4; ++q) { const u32x4 w = *(const u32x4*)(cr + q * 8);
#pragma unroll
            for (int e = 0; e < 4; ++e) { const float lo = __uint_as_float(w[e] << 16), hi = __uint_as_float(w[e] & 0xffff0000u); ss += lo * lo + hi * hi; } }
        }
        ss += __shfl_xor(ss, 16); ss += __shfl_xor(ss, 32);
        const float rskv = rsqrtf(ss * (1.f / 128) + EPS);
        if (wc == 1) {
#pragma unroll
          for (int n = 0; n < 4; ++n) st_bf16x4(KVR + t * 512 + hd * 128 + 64 + n * 16 + fq * 4, acc[m][n] * rskv);
        } else {
          const uint2 plo = *(const uint2*)(PROJ + t * DINP + C_KPE + 4 * fq), phi = *(const uint2*)(PROJ + t * DINP + C_KPE + 16 + 4 * fq);
          float pl[4] = {__uint_as_float(plo.x << 16), __uint_as_float(plo.x & 0xffff0000u), __uint_as_float(plo.y << 16), __uint_as_float(plo.y & 0xffff0000u)};
          float ph[4] = {__uint_as_float(phi.x << 16), __uint_as_float(phi.x & 0xffff0000u), __uint_as_float(phi.y << 16), __uint_as_float(phi.y & 0xffff0000u)};
          float sk = 0.f;
#pragma unroll
          for (int j = 0; j < 4; ++j) sk += pl[j] * pl[j] + ph[j] * ph[j];
          f32x4 kn[4];
#pragma unroll
          for (int n = 0; n < 4; ++n) { kn[n] = acc[m][n] * rskv; sk += kn[n][0] * kn[n][0] + kn[n][1] * kn[n][1] + kn[n][2] * kn[n][2] + kn[n][3] * kn[n][3]; }
          sk += __shfl_xor(sk, 16); sk += __shfl_xor(sk, 32);
          const float rsk = rsqrtf(sk * (1.f / 96) + EPS);
          bf16_t* dst = MK + ((size_t)(b * 4 + hd) * S + sq) * 96;
          f32x4 olo, ohi;
#pragma unroll
          for (int j = 0; j < 4; ++j) {
            const int d = 4 * fq + j; const float2 cs2 = RM[t * 16 + d];
            const float x1 = pl[j] * rsk * g_k[d], x2 = ph[j] * rsk * g_k[16 + d];
            olo[j] = x1 * cs2.x - x2 * cs2.y; ohi[j] = x1 * cs2.y + x2 * cs2.x;
          }
          st_bf16x4(dst + 4 * fq, olo); st_bf16x4(dst + 16 + 4 * fq, ohi);
#pragma unroll
          for (int n = 0; n < 4; ++n) { const float4 g4 = *(const float4*)(g_k + 32 + n * 16 + fq * 4); f32x4 o = kn[n] * rsk; o[0] *= g4.x; o[1] *= g4.y; o[2] *= g4.z; o[3] *= g4.w; st_bf16x4(dst + 32 + n * 16 + fq * 4, o); }
        }
      }
    } else {
      const int i2 = it - N_CMP - N_QR - N_KVR, mt = i2 >> 2, h = i2 & 3;
      const bf16_t* W = (const bf16_t*)(wl + W_LRU) + h * 128 * 64;
      const int c0 = h * 64 + (tid & 7) * 8;
      const float* cw = p.in[10] + l * 4 * 256 + c0; const float* cbp = p.in[11] + l * 256 + c0;
      gemm128(lds, 64,
              [&](int r, int k) {
                const size_t t = (size_t)mt * 128 + r; const int sq = (int)(t & (S - 1));
                float u[8];
#pragma unroll
                for (int e = 0; e < 8; ++e) u[e] = cbp[e];
#pragma unroll
                for (int j = 0; j < 4; ++j) {
                  if (sq - 3 + j >= 0) {
                    const u32x4 w = *(const u32x4*)(PROJ + (t - 3 + j) * DINP + C_LX + h * 64 + k);
#pragma unroll
                    for (int e = 0; e < 4; ++e) { u[2 * e] += __uint_as_float(w[e] << 16) * cw[j * 256 + 2 * e]; u[2 * e + 1] += __uint_as_float(w[e] & 0xffff0000u) * cw[j * 256 + 2 * e + 1]; }
                  }
                }
                u32x4 o; o[0] = pk2bf(u[0], u[1]); o[1] = pk2bf(u[2], u[3]); o[2] = pk2bf(u[4], u[5]); o[3] = pk2bf(u[6], u[7]);
                return o; },
              [&](int r, int k) { return W + (size_t)r * 64 + k; }, acc);
      GEMM_EPI4({ st_bf16x4(GATES + (size_t)(mt * 128 + er) * 512 + h * 128 + ec0, ev4); })
    }
  }
}

DEVI void lru_ab(float u, float rpre, float ipre, float sp, bool first, float& a, float& b) {
  const float r = sigmoidf_(rpre), gi = sigmoidf_(ipre);
  const float la = -8.f * r * sp;
  a = __expf(la);
  const float x = 2.f * la;
  const float om = (x > -0.1f) ? (-x * (1.f + 0.5f * x * (1.f + (1.f / 3.f) * x * (1.f + 0.25f * x * (1.f + 0.2f * x))))) : (1.f - a * a);
  const float mult = first ? 1.f : sqrtf(fmaxf(om, 0.f));
  b = mult * gi * u;
}
DEVI float lru_conv(const bf16_t* PROJ, int t, int s, int c, const float* cw, float cb) {
  float u = cb;
#pragma unroll
  for (int j = 0; j < 4; ++j) { const int ss2 = s - 3 + j; if (ss2 >= 0) u += bf2f(PROJ[(size_t)(t - 3 + j) * DINP + C_LX + c]) * cw[j * 256 + c]; }
  return u;
}

template <bool FULL>
DEVI void s5_chunk(const Params& p, int l, int b, int chunk, unsigned char* lds) {
  unsigned char* wl = p.ws + WS_W + l * WS_WL;
  const bf16_t* PROJ = (const bf16_t*)(p.ws + WS_B);
  const float2* Abar = (const float2*)(wl + W_S5A);
  const bf16_t* BB = (const bf16_t*)(wl + W_S5BB);
  const bf16_t* CM = (const bf16_t*)(wl + W_S5CM);
  float2* SLOC = (float2*)(p.ws + SM_SLOC);
  bf16_t* YCP = (bf16_t*)(p.ws + WS_F);
  const float* dd = p.in[24] + l * 256;
  const int tid = threadIdx.x, wv = tid >> 6, lane = tid & 63, r = lane & 31, h = lane >> 5, fr = lane & 15, fq = lane >> 4;
  unsigned* Hs = (unsigned*)(lds + wv * 8704);
  const int t0 = b * S + chunk * 64;
#pragma unroll 1
  for (int gi = 0; gi < 4; ++gi) {
    const int g = wv * 4 + gi;
    bf16x8 bbf[4];
#pragma unroll
    for (int nb = 0; nb < 4; ++nb) bbf[nb] = *(const bf16x8*)(BB + ((g * 4 + nb) * 32 + r) * 16 + 8 * h);
    float2 Ac[2]; float hr[2], hi[2];
#pragma unroll
    for (int sb = 0; sb < 2; ++sb) {
      Ac[sb] = Abar[g * 64 + sb * 32 + r];
      hr[sb] = 0.f; hi[sb] = 0.f;
      if (FULL) { const float2 cin = ((const float2*)(p.ws + SM_SCAR))[((size_t)(b * 32 + chunk) * 16 + g) * 64 + sb * 32 + r]; hr[sb] = cin.x; hi[sb] = cin.y; }
    }
    bf16x8 cm[4];
    float4 dcol4 = make_float4(0.f, 0.f, 0.f, 0.f);
    if (FULL) {
#pragma unroll
      for (int kk = 0; kk < 4; ++kk) cm[kk] = *(const bf16x8*)(CM + (size_t)(g * 16 + fr) * 128 + kk * 32 + 8 * fq);
      dcol4 = *(const float4*)(dd + g * 16 + 4 * fq);
    }
#pragma unroll 1
    for (int tb = 0; tb < 2; ++tb) {
      const bf16x8 ua = *(const bf16x8*)(PROJ + (size_t)(t0 + tb * 32 + r) * DINP + C_S5 + g * 16 + 8 * h);
      f32x16 acc[4];
#pragma unroll
      for (int nb = 0; nb < 4; ++nb) {
        f32x16 z;
#pragma unroll
        for (int i = 0; i < 16; ++i) z[i] = 0.f;
        acc[nb] = mfma32(ua, bbf[nb], z);
      }
#pragma unroll
      for (int sb = 0; sb < 2; ++sb) {
        float sr = hr[sb], si = hi[sb];
        const float ax = Ac[sb].x, ay = Ac[sb].y;
#pragma unroll
        for (int q = 0; q < 4; ++q)
#pragma unroll
          for (int owner = 0; owner < 2; ++owner) {
#pragma unroll
            for (int i = 0; i < 4; ++i) {
              const int reg = 4 * q + i;
              const float br = acc[2 * sb][reg], bi = acc[2 * sb + 1][reg];
              const float nr = ax * sr - ay * si + br, ni = ax * si + ay * sr + bi; sr = nr; si = ni;
              if (FULL) { acc[2 * sb][reg] = (h == owner) ? sr : br; acc[2 * sb + 1][reg] = (h == owner) ? si : bi; }
            }
            const float orr = __shfl_xor(sr, 32), oi = __shfl_xor(si, 32);
            if (h != owner) { sr = orr; si = oi; }
          }
        hr[sb] = sr; hi[sb] = si;
      }
      if (FULL) {
#pragma unroll
        for (int sb = 0; sb < 2; ++sb)
#pragma unroll
          for (int reg = 0; reg < 16; ++reg)
            Hs[crow(reg, h) * 68 + sb * 32 + r] = pk2bf(acc[2 * sb][reg], acc[2 * sb + 1][reg]);
#pragma unroll
        for (int tb16 = 0; tb16 < 2; ++tb16) {
          f32x4 y = (f32x4){0.f, 0.f, 0.f, 0.f};
#pragma unroll
          for (int kk = 0; kk < 4; ++kk) { const bf16x8 a = *(const bf16x8*)((const bf16_t*)Hs + (tb16 * 16 + fr) * 136 + kk * 32 + 8 * fq); y = mfma16(cm[kk], a, y); }
          const size_t t = (size_t)t0 + tb * 32 + tb16 * 16 + fr; const int col = g * 16 + 4 * fq;
          const uint2 uw = *(const uint2*)(PROJ + t * DINP + C_S5 + col);
          f32x4 o;
          o[0] = gelu_tanh(y[0] + dcol4.x * __uint_as_float(uw.x << 16)); o[1] = gelu_tanh(y[1] + dcol4.y * __uint_as_float(uw.x & 0xffff0000u));
          o[2] = gelu_tanh(y[2] + dcol4.z * __uint_as_float(uw.y << 16)); o[3] = gelu_tanh(y[3] + dcol4.w * __uint_as_float(uw.y & 0xffff0000u));
          st_bf16x4(YCP + t * 256 + col, o);
        }
      }
    }
    if (!FULL) {
#pragma unroll
      for (int sb = 0; sb < 2; ++sb) if (h == 0) SLOC[((size_t)(b * 32 + chunk) * 16 + g) * 64 + sb * 32 + r] = make_float2(hr[sb], hi[sb]);
    }
  }
}

template <bool FULL>
DEVI void lru_chunk(const Params& p, int l, int b, int chunk, float* tile) {
  const bf16_t* PROJ = (const bf16_t*)(p.ws + WS_B);
  const bf16_t* GATES = (const bf16_t*)(p.ws + WS_E);
  float2* LSUM = (float2*)(p.ws + SM_LSUM);
  const int c = threadIdx.x, h = c >> 6, j = c & 63;
  const float* cw = p.in[10] + l * 4 * 256;
  const float w0 = cw[c], w1 = cw[256 + c], w2 = cw[512 + c], w3 = cw[768 + c], cb = p.in[11][l * 256 + c];
  const float ba = p.in[13][l * 256 + c], bi = p.in[15][l * 256 + c];
  const float sp = log1pf(expf(-p.in[16][l * 256 + c]));
  const int s0 = chunk * 64; const size_t t0 = (size_t)b * S + s0;
  float xm3 = 0.f, xm2 = 0.f, xm1 = 0.f;
  if (s0 > 0) { xm3 = bf2f(PROJ[(t0 - 3) * DINP + C_LX + c]); xm2 = bf2f(PROJ[(t0 - 2) * DINP + C_LX + c]); xm1 = bf2f(PROJ[(t0 - 1) * DINP + C_LX + c]); }
  float hh = 0.f, ap = 1.f;
  if (FULL) hh = ((const float*)(p.ws + SM_LCAR))[(size_t)(b * 32 + chunk) * 256 + c];
#pragma unroll 1
  for (int k0 = 0; k0 < 64; k0 += 8) {
    float xv[8], rp[8], ip[8], gt[8];
#pragma unroll
    for (int i = 0; i < 8; ++i) {
      const size_t t = t0 + k0 + i;
      xv[i] = bf2f(PROJ[t * DINP + C_LX + c]);
      rp[i] = bf2f(GATES[t * 512 + h * 128 + j]); ip[i] = bf2f(GATES[t * 512 + h * 128 + 64 + j]);
      gt[i] = FULL ? bf2f(PROJ[t * DINP + C_LG + c]) : 0.f;
    }
#pragma unroll
    for (int i = 0; i < 8; ++i) {
      const float u = cb + xm3 * w0 + xm2 * w1 + xm1 * w2 + xv[i] * w3;
      xm3 = xm2; xm2 = xm1; xm1 = xv[i];
      float a, bb; lru_ab(u, rp[i] + ba, ip[i] + bi, sp, (s0 + k0 + i) == 0, a, bb);
      hh = a * hh + bb; ap *= a;
      if (FULL) tile[(k0 + i) * 256 + c] = hh * gelu_tanh(gt[i]);
    }
  }
  if (!FULL) LSUM[(size_t)(b * 32 + chunk) * 256 + c] = make_float2(ap, hh);
}

DEVI void phase_r2(const Params& p, int l, unsigned char* lds) {
  unsigned char* wl = p.ws + WS_W + l * WS_WL;
  const bf16_t* PROJ = (const bf16_t*)(p.ws + WS_B);
  const bf16_t* QR = (const bf16_t*)(p.ws + WS_D);
  const bf16_t* KVR = QR + (size_t)T * 384;
  const bf16_t* GATES = (const bf16_t*)(p.ws + WS_E);
  bf16_t* MQ = (bf16_t*)(p.ws + WS_F);
  bf16_t* MK = MQ + (size_t)T * 4 * 96;
  const float2* RM = (const float2*)(p.ws + WS_ROPE);
  const float2* RN = RM + (size_t)T * 16;
  const int tid = threadIdx.x, lane = tid & 63, wv = tid >> 6;
  for (int it = blockIdx.x; it < NB * 32; it += gridDim.x) lru_chunk<false>(p, l, it >> 5, it & 31, nullptr);
  __syncthreads();
  for (int it = blockIdx.x; it < NB * 32; it += gridDim.x) s5_chunk<false>(p, l, it >> 5, it & 31, lds);
  {
    const bf16_t* HK = (const bf16_t*)(p.ws + SM_HK); const bf16_t* HV = (const bf16_t*)(p.ws + SM_HV);
    bf16_t* KC = (bf16_t*)(p.ws + SM_KC); bf16_t* VC = (bf16_t*)(p.ws + SM_VC);
    const bf16_t* W2K = (const bf16_t*)(wl + W_2K); const bf16_t* W2V = (const bf16_t*)(wl + W_2V);
    const float* g0 = p.in[28] + l * 192;
    for (int it = blockIdx.x; it < 32; it += gridDim.x) {
      const int kv = it & 1, mt = it >> 1;
      const bf16_t* H = kv ? HV : HK; const bf16_t* W2 = kv ? W2V : W2K;
      f32x4 acc[4][4];
      __syncthreads();
      gemm128g(lds, 128, [&](int r, int k) { return H + (size_t)(mt * 128 + r) * 128 + k; }, [&](int r, int k) { return W2 + (size_t)(r & 63) * 128 + k; }, acc);
      const int wid = tid >> 6, wr = wid >> 1, wc = wid & 1, fr = lane & 15, fq = lane >> 4;
      if (wc == 0) {
#pragma unroll
        for (int m = 0; m < 4; ++m) {
          const int row = mt * 128 + wr * 64 + m * 16 + fr, b = row >> 7, c = row & 127;
          f32x4 v[4];
#pragma unroll
          for (int n = 0; n < 4; ++n) v[n] = acc[m][n];
          if (kv == 0) {
            float ss = 0.f;
#pragma unroll
            for (int n = 0; n < 4; ++n) ss += v[n][0] * v[n][0] + v[n][1] * v[n][1] + v[n][2] * v[n][2] + v[n][3] * v[n][3];
            ss += __shfl_xor(ss, 16); ss += __shfl_xor(ss, 32);
            const float rs = rsqrtf(ss * (1.f / 64) + EPS);
#pragma unroll
            for (int n = 0; n < 4; ++n) { const float4 gg = *(const float4*)(g0 + n * 16 + fq * 4); v[n][0] *= rs * gg.x; v[n][1] *= rs * gg.y; v[n][2] *= rs * gg.z; v[n][3] *= rs * gg.w; }
            const int cc = (c < 127) ? c : 126;
            const float2* cs = RN + (size_t)(b * S + 16 * cc + 31) * 8;
#pragma unroll
            for (int j = 0; j < 4; ++j) {
              const float x = v[0][j], partner = __shfl_xor(x, 32);
              const int d = fq * 4 + j; const float2 cs2 = cs[d & 7];
              v[0][j] = (d < 8) ? (x * cs2.x - partner * cs2.y) : (partner * cs2.y + x * cs2.x);
            }
          }
          bf16_t* dst = (kv ? VC : KC) + (size_t)row * 64;
#pragma unroll
          for (int n = 0; n < 4; ++n) { f32x4 o = v[n]; if (c >= 127) o = (f32x4){0.f, 0.f, 0.f, 0.f}; st_bf16x4(dst + n * 16 + fq * 4, o); }
        }
      }
    }
  }
}

typedef short v4i16_t __attribute__((ext_vector_type(4)));
DEVI float fexp2(float x) { return __builtin_amdgcn_exp2f(x); }
constexpr int VST = 96;
constexpr int ATT_VBYTES = 64 * VST * 2;
template <int DK> constexpr int att_kbytes() { return 64 * (DK + 8) * 2; }
template <int DK> constexpr int att_buf() { return att_kbytes<DK>() + ATT_VBYTES; }
template <int DK> struct TileRegs { u32x4 k[DK / 32]; u32x4 v[2]; };
template <int DK>
DEVI void tile_load(TileRegs<DK>& tr, const bf16_t* kbase, size_t kstride, const bf16_t* vbase, size_t vstride, int key0, bool withv = true) {
  constexpr int CH = DK / 8;
#pragma unroll
  for (int i = 0; i < DK / 32; ++i) { const int c = threadIdx.x + 256 * i, r = c / CH, cc = c % CH; tr.k[i] = *(const u32x4*)(kbase + (size_t)(key0 + r) * kstride + cc * 8); }
  if (withv) {
#pragma unroll
    for (int i = 0; i < 2; ++i) { const int c = threadIdx.x + 256 * i, r = c >> 3, cc = c & 7; tr.v[i] = *(const u32x4*)(vbase + (size_t)(key0 + r) * vstride + cc * 8); }
  }
}
template <int DK>
DEVI void tile_store(const TileRegs<DK>& tr, unsigned char* buf, bool withv = true) {
  constexpr int CH = DK / 8;
  bf16_t* sK = (bf16_t*)buf; bf16_t* sV = (bf16_t*)(buf + att_kbytes<DK>());
#pragma unroll
  for (int i = 0; i < DK / 32; ++i) { const int c = threadIdx.x + 256 * i, r = c / CH, cc = c % CH; *(u32x4*)(sK + r * (DK + 8) + cc * 8) = tr.k[i]; }
  if (withv) {
#pragma unroll
    for (int i = 0; i < 2; ++i) { const int c = threadIdx.x + 256 * i, r = c >> 3, cc = c & 7; *(u32x4*)(sV + r * VST + cc * 8) = tr.v[i]; }
  }
}
template <int DK>
DEVI void qk_tile(const bf16_t* sK, const bf16x8* qf, f32x16& s0, f32x16& s1, int r, int h) {
#pragma unroll
  for (int i = 0; i < 16; ++i) { s0[i] = 0.f; s1[i] = 0.f; }
#pragma unroll
  for (int kk = 0; kk < DK / 16; ++kk) {
    const bf16x8 a0 = *(const bf16x8*)(sK + r * (DK + 8) + kk * 16 + h * 8);
    const bf16x8 a1 = *(const bf16x8*)(sK + (32 + r) * (DK + 8) + kk * 16 + h * 8);
    s0 = mfma32(a0, qf[kk], s0);
    s1 = mfma32(a1, qf[kk], s1);
  }
}
struct FState { f32x16 o0, o1; float m, l; };
DEVI void fstate_init(FState& f) {
#pragma unroll
  for (int i = 0; i < 16; ++i) { f.o0[i] = 0.f; f.o1[i] = 0.f; }
  f.m = -INFINITY; f.l = 0.f;
}
DEVI v4i16_t vtr(const bf16_t* p) { return __builtin_amdgcn_ds_read_tr16_b64_v4i16((LAS v4i16_t*)p); }
DEVI void softmax_pv(FState& f, f32x16& s0, f32x16& s1, const bf16_t* sV, int lane) {
  const int h = lane >> 5;
  float mx = -INFINITY;
#pragma unroll
  for (int i = 0; i < 16; ++i) mx = fmaxf(mx, fmaxf(s0[i], s1[i]));
  mx = fmaxf(mx, __shfl_xor(mx, 32));
  const float mnew = fmaxf(f.m, mx);
  const float muse = (mnew == -INFINITY) ? 0.f : mnew;
  const float alpha = fexp2(f.m - muse);
  float ps = 0.f;
#pragma unroll
  for (int i = 0; i < 16; ++i) { s0[i] = fexp2(s0[i] - muse); s1[i] = fexp2(s1[i] - muse); ps += s0[i] + s1[i]; }
  ps += __shfl_xor(ps, 32);
  f.l = f.l * alpha + ps; f.m = mnew;
#pragma unroll
  for (int i = 0; i < 16; ++i) { f.o0[i] *= alpha; f.o1[i] *= alpha; }
  const int g = lane >> 4, li = lane & 15, q = li >> 2, pp = li & 3;
  const bf16_t* vb = sV + (4 * h + q) * VST + (g & 1) * 16 + 4 * pp;
#pragma unroll
  for (int kb = 0; kb < 2; ++kb)
#pragma unroll
    for (int s = 0; s < 2; ++s) {
      unsigned pw[4];
#pragma unroll
      for (int j = 0; j < 4; ++j) pw[j] = kb ? pk2bf(s1[8 * s + 2 * j], s1[8 * s + 2 * j + 1]) : pk2bf(s0[8 * s + 2 * j], s0[8 * s + 2 * j + 1]);
      const bf16x8 pb = __builtin_bit_cast(bf16x8, (u32x4){pw[0], pw[1], pw[2], pw[3]});
#pragma unroll
      for (int db = 0; db < 2; ++db) {
        const v4i16_t lo = vtr(vb + (kb * 32 + 16 * s) * VST + db * 32);
        const v4i16_t hi = vtr(vb + (kb * 32 + 16 * s + 8) * VST + db * 32);
        const bf16x8 a = {lo[0], lo[1], lo[2], lo[3], hi[0], hi[1], hi[2], hi[3]};
        if (db == 0) f.o0 = mfma32(a, pb, f.o0); else f.o1 = mfma32(a, pb, f.o1);
      }
    }
}
DEVI void store_o(bf16_t* orow, const f32x16& o0, const f32x16& o1, float sc, int h) {
#pragma unroll
  for (int g = 0; g < 4; ++g) {
    uint2 v0, v1;
    v0.x = pk2bf(o0[4 * g] * sc, o0[4 * g + 1] * sc); v0.y = pk2bf(o0[4 * g + 2] * sc, o0[4 * g + 3] * sc);
    v1.x = pk2bf(o1[4 * g] * sc, o1[4 * g + 1] * sc); v1.y = pk2bf(o1[4 * g + 2] * sc, o1[4 * g + 3] * sc);
    *(uint2*)(orow + 8 * g + 4 * h) = v0;
    *(uint2*)(orow + 32 + 8 * g + 4 * h) = v1;
  }
}

DEVI void mla_item(const Params& p, int l, int b, int hd, int qt, unsigned char* lds) {
  const bf16_t* MQ = (const bf16_t*)(p.ws + WS_F);
  const bf16_t* MK = MQ + (size_t)T * 4 * 96;
  const bf16_t* KVR = (const bf16_t*)(p.ws + WS_D) + (size_t)T * 384;
  bf16_t* YA = (bf16_t*)(p.ws + WS_C);
  const int tid = threadIdx.x, wv = tid >> 6, lane = tid & 63, r = lane & 31, h = lane >> 5;
  const int q0 = qt * 128 + wv * 32, tq = q0 + r;
  bf16x8 qf[6];
  {
    const bf16_t* qrow = (const bf16_t*)(p.ws + WS_D) + ((size_t)b * S + tq) * 384 + hd * 96;
    const float* g_q = p.in[8] + l * 96;
    float qv[6][8]; float ss = 0.f;
#pragma unroll
    for (int kk = 0; kk < 6; ++kk) {
      const u32x4 w = *(const u32x4*)(qrow + kk * 16 + h * 8);
#pragma unroll
      for (int e = 0; e < 4; ++e) { qv[kk][2 * e] = __uint_as_float(w[e] << 16); qv[kk][2 * e + 1] = __uint_as_float(w[e] & 0xffff0000u); ss += qv[kk][2 * e] * qv[kk][2 * e] + qv[kk][2 * e + 1] * qv[kk][2 * e + 1]; }
    }
    ss += __shfl_xor(ss, 32);
    const float rs = rsqrtf(ss * (1.f / 96) + EPS) * (0.10206207261596575f * LOG2E);
#pragma unroll
    for (int kk = 0; kk < 6; ++kk)
#pragma unroll
      for (int j = 0; j < 8; ++j) qv[kk][j] *= rs * g_q[kk * 16 + h * 8 + j];
    const float2* cs = (const float2*)(p.ws + WS_ROPE) + ((size_t)b * S + tq) * 16 + 8 * h;
#pragma unroll
    for (int j = 0; j < 8; ++j) { const float2 c2 = cs[j]; const float x1 = qv[0][j], x2 = qv[1][j]; qv[0][j] = x1 * c2.x - x2 * c2.y; qv[1][j] = x1 * c2.y + x2 * c2.x; }
#pragma unroll
    for (int kk = 0; kk < 6; ++kk) { const u32x4 w = {pk2bf(qv[kk][0], qv[kk][1]), pk2bf(qv[kk][2], qv[kk][3]), pk2bf(qv[kk][4], qv[kk][5]), pk2bf(qv[kk][6], qv[kk][7])}; qf[kk] = __builtin_bit_cast(bf16x8, w); }
  }
  FState f; fstate_init(f);
  const bf16_t* kbase = MK + (size_t)(b * 4 + hd) * S * 96;
  const bf16_t* vbase = KVR + (size_t)b * S * 512 + hd * 128 + 64;
  const int ntiles = 2 * qt + 2;
  TileRegs<96> tr;
  tile_load<96>(tr, kbase, 96, vbase, 512, 0);
  __syncthreads();
  tile_store<96>(tr, lds);
  __syncthreads();
#pragma unroll 1
  for (int kt = 0; kt < ntiles; ++kt) {
    unsigned char* cur = lds + (kt & 1) * att_buf<96>();
    const bool more = kt + 1 < ntiles;
    if (more) tile_load<96>(tr, kbase, 96, vbase, 512, (kt + 1) * 64);
    if (kt * 64 <= q0 + 31) {
      f32x16 s0, s1;
      qk_tile<96>((const bf16_t*)cur, qf, s0, s1, r, h);
      if (kt * 64 + 63 > q0) {
        int rel = tq - kt * 64 - 4 * h; asm volatile("" : "+v"(rel));
#pragma unroll
        for (int i = 0; i < 16; ++i) { const int kk2 = (i & 3) + 8 * (i >> 2); if (kk2 > rel) s0[i] = -INFINITY; if (kk2 + 32 > rel) s1[i] = -INFINITY; }
      }
      softmax_pv(f, s0, s1, (const bf16_t*)(cur + att_kbytes<96>()), lane);
    }
    if (more) tile_store<96>(tr, lds + ((kt + 1) & 1) * att_buf<96>());
    __syncthreads();
  }
  store_o(YA + (size_t)(b * S + tq) * 256 + hd * 64, f.o0, f.o1, 1.f / f.l, h);
}

template <class KF, class BODY>
DEVI void nsa_stream(unsigned char* lds, const bf16_t* kbase, size_t kstride, const bf16_t* vbase, size_t vstride, bool withv, int nt, KF key0f, BODY body) {
  if (nt <= 0) return;
  TileRegs<64> tr;
  tile_load<64>(tr, kbase, kstride, vbase, vstride, key0f(0), withv);
  __syncthreads();
  tile_store<64>(tr, lds, withv);
  __syncthreads();
#pragma unroll 1
  for (int i = 0; i < nt; ++i) {
    unsigned char* cur = lds + (i & 1) * att_buf<64>();
    const bool more = i + 1 < nt;
    if (more) tile_load<64>(tr, kbase, kstride, vbase, vstride, key0f(i + 1), withv);
    body(i, cur);
    if (more) tile_store<64>(tr, lds + ((i + 1) & 1) * att_buf<64>(), withv);
    __syncthreads();
  }
}
DEVI void nsa_item(const Params& p, int l, int b, int qt, unsigned char* lds) {
  const bf16_t* PROJ = (const bf16_t*)(p.ws + WS_B);
  const bf16_t* KC = (const bf16_t*)(p.ws + SM_KC) + (size_t)b * 128 * 64;
  const bf16_t* VC = (const bf16_t*)(p.ws + SM_VC) + (size_t)b * 128 * 64;
  const int tid = threadIdx.x, wv = tid >> 6, lane = tid & 63, r = lane & 31, h = lane >> 5;
  float* psum = (float*)(lds + 2 * att_buf<64>());
  unsigned* selm = (unsigned*)(lds + 2 * att_buf<64>() + 16384);
  const int t0 = qt * 32, cur = t0 >> 6;
  const int ql = wv * 8 + (r >> 2), hd = r & 3, tq = t0 + ql;
  const size_t tg = (size_t)b * S + tq;
  bf16x8 qf[4];
#pragma unroll
  for (int kk = 0; kk < 4; ++kk) qf[kk] = *(const bf16x8*)(PROJ + tg * DINP + C_NQ + hd * 64 + kk * 16 + h * 8);
  f32x16 of0, of1;
#pragma unroll
  for (int i = 0; i < 16; ++i) { of0[i] = 0.f; of1[i] = 0.f; }
  const float g0 = sigmoidf_(bf2f(PROJ[tg * DINP + C_NG + hd * 3 + 0]));
  const float g1 = sigmoidf_(bf2f(PROJ[tg * DINP + C_NG + hd * 3 + 1]));
  const float g2 = sigmoidf_(bf2f(PROJ[tg * DINP + C_NG + hd * 3 + 2]));
  FState f; fstate_init(f);
  const int ncmp = (t0 + 31 < 31) ? 0 : (((t0 >> 4) >> 6) + 1);
  nsa_stream(lds, KC, 64, VC, 64, true, ncmp, [&](int i) { return i * 64; }, [&](int kt, unsigned char* buf) {
    f32x16 s0, s1;
    qk_tile<64>((const bf16_t*)buf, qf, s0, s1, r, h);
    int rel = ((tq - 31) >> 4) - kt * 64 - 4 * h; asm volatile("" : "+v"(rel));
#pragma unroll
    for (int i = 0; i < 16; ++i) { const int kk2 = (i & 3) + 8 * (i >> 2); if (kk2 > rel) s0[i] = -INFINITY; if (kk2 + 32 > rel) s1[i] = -INFINITY; }
    softmax_pv(f, s0, s1, (const bf16_t*)(buf + att_kbytes<64>()), lane);
  });
  {
    const float sc = (f.l > 0.f) ? g0 / f.l : 0.f;
#pragma unroll
    for (int i = 0; i < 16; ++i) { of0[i] += f.o0[i] * sc; of1[i] += f.o1[i] * sc; }
  }
  {
    const float muse = (f.m == -INFINITY) ? 0.f : f.m;
    const float il = (f.l > 0.f) ? 1.f / f.l : 0.f;
    if (ncmp < 2) {
#pragma unroll 1
      for (int i = tid; i < 32 * 128; i += NTHREADS) psum[i] = 0.f;
      __syncthreads();
    }
    nsa_stream(lds, KC, 64, VC, 64, false, ncmp, [&](int i) { return i * 64; }, [&](int kt, unsigned char* buf) {
      f32x16 s0, s1;
      qk_tile<64>((const bf16_t*)buf, qf, s0, s1, r, h);
      int rel = ((tq - 31) >> 4) - kt * 64 - 4 * h; asm volatile("" : "+v"(rel));
      int cb0 = kt * 64 + 4 * h; asm volatile("" : "+v"(cb0));
#pragma unroll
      for (int i = 0; i < 16; ++i) {
        const int kk2 = (i & 3) + 8 * (i >> 2); const int c = cb0 + kk2;
        float p0 = (kk2 > rel) ? 0.f : fexp2(s0[i] - muse) * il;
        float p1 = (kk2 + 32 > rel) ? 0.f : fexp2(s1[i] - muse) * il;
        p0 += __shfl_xor(p0, 1); p0 += __shfl_xor(p0, 2);
        p1 += __shfl_xor(p1, 1); p1 += __shfl_xor(p1, 2);
        if (hd == 0) { psum[ql * 128 + c] = p0; psum[ql * 128 + c + 32] = p1; }
      }
    });
  }
  __syncthreads();
#pragma unroll 1
  for (int itq = 0; itq < 4; ++itq) {
    const int q2 = wv * 8 + itq * 2 + (lane >> 5), j = lane & 31;
    const float* ps = psum + q2 * 128;
    float imp = 2.f * (ps[4 * j] + ps[4 * j + 1] + ps[4 * j + 2]) + ps[4 * j + 3];
    if (j > 0) imp += ps[4 * j - 1];
    const bool cand = (j >= 1) && (j <= cur - 2);
    int rank = 0;
    for (int jj = 0; jj < 32; ++jj) {
      const float v = __shfl(imp, (lane & 32) | jj);
      const bool cj = (jj >= 1) && (jj <= cur - 2);
      if (cj && (v > imp || (v == imp && jj < j))) ++rank;
    }
    const bool sel = cand && rank < 2;
    const unsigned long long bal = __ballot(sel);
    unsigned mk = (unsigned)(bal >> (32 * (lane >> 5)));
    mk |= 1u | (1u << cur); if (cur >= 1) mk |= (1u << (cur - 1));
    if (j == 0) selm[q2] = mk;
  }
  __syncthreads();
  unsigned blk_or = 0, wave_or = 0;
  for (int i = 0; i < 32; ++i) blk_or |= selm[i];
  for (int i = 0; i < 8; ++i) wave_or |= selm[wv * 8 + i];
  const unsigned mymask = selm[ql];
  fstate_init(f);
  {
    unsigned* tl = selm + 32;
    if (tid < 32 && ((blk_or >> tid) & 1u)) tl[__popc(blk_or & ((1u << tid) - 1u))] = tid;
    __syncthreads();
    const int nsel = __popc(blk_or);
    nsa_stream(lds, PROJ + (size_t)b * S * DINP + C_KS, DINP, PROJ + (size_t)b * S * DINP + C_VS, DINP, true, nsel,
      [&](int i) { return (int)tl[i] * 64; },
      [&](int i, unsigned char* buf) {
        const int jj = (int)tl[i];
        if ((wave_or >> jj) & 1u) {
          f32x16 s0, s1;
          qk_tile<64>((const bf16_t*)buf, qf, s0, s1, r, h);
          const bool on = (mymask >> jj) & 1u;
          int rel = on ? (tq - jj * 64 - 4 * h) : -1; asm volatile("" : "+v"(rel));
#pragma unroll
          for (int i2 = 0; i2 < 16; ++i2) { const int kk2 = (i2 & 3) + 8 * (i2 >> 2); if (kk2 > rel) s0[i2] = -INFINITY; if (kk2 + 32 > rel) s1[i2] = -INFINITY; }
          softmax_pv(f, s0, s1, (const bf16_t*)(buf + att_kbytes<64>()), lane);
        }
      });
    const float sc = (f.l > 0.f) ? g1 / f.l : 0.f;
#pragma unroll
    for (int i = 0; i < 16; ++i) { of0[i] += f.o0[i] * sc; of1[i] += f.o1[i] * sc; }
  }
  fstate_init(f);
  {
    int jlo = (t0 - 511) >> 6; if (jlo < 0) jlo = 0;
    nsa_stream(lds, PROJ + (size_t)b * S * DINP + C_KW, DINP, PROJ + (size_t)b * S * DINP + C_VW, DINP, true, cur - jlo + 1,
      [&](int i) { return (jlo + i) * 64; },
      [&](int i, unsigned char* buf) {
        const int j = jlo + i;
        f32x16 s0, s1;
        qk_tile<64>((const bf16_t*)buf, qf, s0, s1, r, h);
        if (j == cur || j * 64 < t0 + 31 - 511 + 64) {
          int rel = tq - j * 64 - 4 * h; asm volatile("" : "+v"(rel));
#pragma unroll
          for (int i2 = 0; i2 < 16; ++i2) {
            const int kk2 = (i2 & 3) + 8 * (i2 >> 2);
            if (kk2 > rel || kk2 < rel - 511) s0[i2] = -INFINITY;
            if (kk2 + 32 > rel || kk2 + 32 < rel - 511) s1[i2] = -INFINITY;
          }
        }
        softmax_pv(f, s0, s1, (const bf16_t*)(buf + att_kbytes<64>()), lane);
      });
    const float sc = (f.l > 0.f) ? g2 / f.l : 0.f;
#pragma unroll
    for (int i = 0; i < 16; ++i) { of0[i] += f.o0[i] * sc; of1[i] += f.o1[i] * sc; }
  }
  {
    float ss = 0.f;
#pragma unroll
    for (int i = 0; i < 16; ++i) ss += of0[i] * of0[i] + of1[i] * of1[i];
    ss += __shfl_xor(ss, 1); ss += __shfl_xor(ss, 2); ss += __shfl_xor(ss, 32);
    const float rs = rsqrtf(ss * (1.f / 256) + EPS);
    const float* on = p.in[35] + l * 1024 + 768 + hd * 64;
#pragma unroll
    for (int g4 = 0; g4 < 4; ++g4) {
      const float4 a = *(const float4*)(on + 8 * g4 + 4 * h), b4 = *(const float4*)(on + 32 + 8 * g4 + 4 * h);
      of0[4 * g4] *= a.x; of0[4 * g4 + 1] *= a.y; of0[4 * g4 + 2] *= a.z; of0[4 * g4 + 3] *= a.w;
      of1[4 * g4] *= b4.x; of1[4 * g4 + 1] *= b4.y; of1[4 * g4 + 2] *= b4.z; of1[4 * g4 + 3] *= b4.w;
    }
    store_o((bf16_t*)(p.ws + WS_A) + tg * 1024 + 768 + hd * 64, of0, of1, rs, h);
  }
}

DEVI void carry_item(const Params& p, int l, int it) {
  const int tid = threadIdx.x;
  if (it < 64) {
    const int idx = it * 256 + tid, b = idx >> 10, gs = idx & 1023;
    const float2 a64 = ((const float2*)(p.ws + WS_W + l * WS_WL + W_S5A64))[gs];
    const float2* SLOC = (const float2*)(p.ws + SM_SLOC) + (size_t)b * 32 * 1024 + gs;
    float2* SCAR = (float2*)(p.ws + SM_SCAR) + (size_t)b * 32 * 1024 + gs;
    float hr = 0.f, hi = 0.f;
#pragma unroll 1
    for (int c0 = 0; c0 < 32; c0 += 8) {
      float2 sl[8];
#pragma unroll
      for (int i = 0; i < 8; ++i) sl[i] = SLOC[(size_t)(c0 + i) * 1024];
#pragma unroll
      for (int i = 0; i < 8; ++i) { SCAR[(size_t)(c0 + i) * 1024] = make_float2(hr, hi); const float nr = a64.x * hr - a64.y * hi + sl[i].x, ni = a64.x * hi + a64.y * hr + sl[i].y; hr = nr; hi = ni; }
    }
  } else {
    const int idx = (it - 64) * 256 + tid, b = idx >> 8, c = idx & 255;
    const float2* LSUM = (const float2*)(p.ws + SM_LSUM) + (size_t)b * 32 * 256 + c;
    float* LCAR = (float*)(p.ws + SM_LCAR) + (size_t)b * 32 * 256 + c;
    float hh = 0.f;
#pragma unroll 1
    for (int c0 = 0; c0 < 32; c0 += 8) {
      float2 sv[8];
#pragma unroll
      for (int i = 0; i < 8; ++i) sv[i] = LSUM[(size_t)(c0 + i) * 256];
#pragma unroll
      for (int i = 0; i < 8; ++i) { LCAR[(size_t)(c0 + i) * 256] = hh; hh = sv[i].x * hh + sv[i].y; }
    }
  }
}
DEVI void phase_a1(const Params& p, int l, unsigned char* lds) {
  for (int it = blockIdx.x; it < 80; it += gridDim.x) carry_item(p, l, it);
  const int G_ = (int)gridDim.x;
  const int vb_ = vblock();
  for (int rr = 0;; ++rr) { const int j = rr * G_ + ((rr & 1) ? (G_ - 1 - vb_) : vb_); if (rr * G_ >= 1024) break; if (j < 1024) { const int b = j >> 6, qt = 63 - (j & 63); nsa_item(p, l, b, qt, lds); } }
  __syncthreads();
  for (int rr = 0;; ++rr) { const int j = rr * G_ + ((rr & 1) ? (G_ - 1 - vb_) : vb_); if (rr * G_ >= 1024) break; if (j < 1024) { const int bh = j >> 4, qt = 15 - (j & 15); mla_item(p, l, bh >> 2, bh & 3, qt, lds); } }
}

DEVI void phase_r3(const Params& p, int l, unsigned char* lds) {
  bf16_t* Y = (bf16_t*)(p.ws + WS_A);
  const int tid = threadIdx.x, lane = tid & 63, wv = tid >> 6;
  {
    const float* onorm = p.in[35] + l * 1024 + 256;
    float* tile = (float*)lds;
    for (int it = blockIdx.x; it < NB * 32; it += gridDim.x) {
      const int b = it >> 5, chunk = it & 31;
      __syncthreads();
      lru_chunk<true>(p, l, b, chunk, tile);
      __syncthreads();
      for (int k = wv; k < 64; k += 4) {
        const float4 v = *(const float4*)(tile + k * 256 + lane * 4);
        const float rs = rsqrtf(wsum(v.x * v.x + v.y * v.y + v.z * v.z + v.w * v.w) * (1.f / 256) + EPS);
        const size_t t = (size_t)b * S + chunk * 64 + k;
        const float4 gg = *(const float4*)(onorm + lane * 4);
        st_bf16x4(Y + t * 1024 + 256 + lane * 4, (f32x4){v.x * rs * gg.x, v.y * rs * gg.y, v.z * rs * gg.z, v.w * rs * gg.w});
      }
    }
  }
  __syncthreads();
  for (int it = blockIdx.x; it < NB * 32; it += gridDim.x) s5_chunk<true>(p, l, it >> 5, it & 31, lds);
}

DEVI void phase_g3(const Params& p, int l, unsigned char* lds) {
  const bf16_t* YCP = (const bf16_t*)(p.ws + WS_F);
  bf16_t* YC = (bf16_t*)(p.ws + WS_F) + (size_t)T * 256;
  const bf16_t* W = (const bf16_t*)(p.ws + WS_W + l * WS_WL + W_GLU);
  const float* bg = p.in[26] + l * 256;
  for (int it = vblock(); it < 256 * 2; it += gridDim.x) {
    const int mt = it >> 1, nt = it & 1;
    f32x4 acc[4][4];
    gemm128g(lds, 256, [&](int r, int k) { return YCP + (size_t)(mt * 128 + r) * 256 + k; }, [&](int r, int k) { return W + (size_t)(nt * 128 + r) * 256 + k; }, acc);
    GEMM_EPI4({ const size_t o = (size_t)(mt * 128 + er) * 256 + nt * 128 + ec0; const ushort4 yp = *(const ushort4*)(YCP + o); f32x4 r4; r4[0] = bf2f(yp.x) * sigmoidf_(ev4[0] + bg[nt * 128 + ec0]); r4[1] = bf2f(yp.y) * sigmoidf_(ev4[1] + bg[nt * 128 + ec0 + 1]); r4[2] = bf2f(yp.z) * sigmoidf_(ev4[2] + bg[nt * 128 + ec0 + 2]); r4[3] = bf2f(yp.w) * sigmoidf_(ev4[3] + bg[nt * 128 + ec0 + 3]); st_bf16x4(YC + o, r4); })
  }
}

DEVI void phase_r4(const Params& p, int l) {
  const bf16_t* YA = (const bf16_t*)(p.ws + WS_C);
  const bf16_t* YC = (const bf16_t*)(p.ws + WS_F) + (size_t)T * 256;
  bf16_t* Y = (bf16_t*)(p.ws + WS_A);
  const float* onorm = p.in[35] + l * 1024;
  const int lane = threadIdx.x & 63, gw = blockIdx.x * 4 + (threadIdx.x >> 6), NGW = gridDim.x * 4;
  for (int t = gw; t < T; t += NGW) {
#pragma unroll
    for (int grp = 0; grp < 2; ++grp) {
      const bf16_t* src = (grp == 0 ? YA : YC) + (size_t)t * 256;
      const int gcol = (grp == 0 ? 0 : 512);
      const ushort4 u = ((const ushort4*)src)[lane];
      const float v0 = bf2f(u.x), v1 = bf2f(u.y), v2 = bf2f(u.z), v3 = bf2f(u.w);
      const float rs = rsqrtf(wsum(v0 * v0 + v1 * v1 + v2 * v2 + v3 * v3) * (1.f / 256) + EPS);
      const float4 g = ((const float4*)(onorm + gcol))[lane];
      uint2 o; o.x = pk2bf(v0 * rs * g.x, v1 * rs * g.y); o.y = pk2bf(v2 * rs * g.z, v3 * rs * g.w);
      ((uint2*)(Y + (size_t)t * 1024 + gcol))[lane] = o;
    }
  }
}

DEVI void phase_g4(const Params& p, int l, unsigned char* lds) {
  const bf16_t* Y = (const bf16_t*)(p.ws + WS_A);
  const bf16_t* W = (const bf16_t*)(p.ws + WS_W + l * WS_WL + W_OUT);
  const float* xin = (l == 0) ? p.in[0] : p.out;
  float* out = p.out;
  for (int it = vblock(); it < 256 * 8; it += gridDim.x) {
    const int mt = it >> 3, nt = it & 7;
    f32x4 acc[4][4];
    gemm128g(lds, D, [&](int r, int k) { return Y + (size_t)(mt * 128 + r) * D + k; }, [&](int r, int k) { return W + (size_t)(nt * 128 + r) * D + k; }, acc);
    GEMM_EPI4({ const size_t o = (size_t)(mt * 128 + er) * D + nt * 128 + ec0; const f32x4 xi = *(const f32x4*)(xin + o); *(f32x4*)(out + o) = xi + ev4; })
  }
}

DEVI void phase_r5(const Params& p, int l, unsigned char* lds) {
  const float* x1 = p.out;
  bf16_t* XN = (bf16_t*)(p.ws + WS_A);
  const float* g = p.in[37] + l * D;
  const bf16_t* WH = (const bf16_t*)(p.ws + WS_W + l * WS_WL + W_RTH);
  const bf16_t* WL = (const bf16_t*)(p.ws + WS_W + l * WS_WL + W_RTL);
  const float* brg = p.in[39] + l * 4; const float* bre = p.in[41] + l * 16;
  int* CNT = (int*)(p.ws + SM_CNT) + l * 32;
  int* LIST = (int*)(p.ws + SM_LIST);
  float2* TOKW = (float2*)(p.ws + SM_TOKW);
  const int tid = threadIdx.x, lane = tid & 63, wv = tid >> 6, c = lane & 15, q = lane >> 4;
  float* red = (float*)lds;
  for (int it = blockIdx.x; it < T / 16; it += gridDim.x) {
    const size_t tb = (size_t)it * 16;
    f32x4 a0 = (f32x4){0.f, 0.f, 0.f, 0.f}, a1 = (f32x4){0.f, 0.f, 0.f, 0.f};
    float ss = 0.f;
    const float* xrow = x1 + (tb + c) * D + wv * 256 + 8 * q;
    const bf16_t* wh0 = WH + (size_t)c * 1024 + wv * 256 + 8 * q;
    const bf16_t* wl0 = WL + (size_t)c * 1024 + wv * 256 + 8 * q;
    float4 xk[8][2];
#pragma unroll
    for (int ks = 0; ks < 8; ++ks) { xk[ks][0] = *(const float4*)(xrow + ks * 32); xk[ks][1] = *(const float4*)(xrow + ks * 32 + 4); }
#pragma unroll
    for (int ks = 0; ks < 8; ++ks) {
      const bf16x8 wh_a = *(const bf16x8*)(wh0 + ks * 32), wl_a = *(const bf16x8*)(wl0 + ks * 32);
      const bf16x8 wh_b = *(const bf16x8*)(wh0 + 16 * 1024 + ks * 32), wl_b = *(const bf16x8*)(wl0 + 16 * 1024 + ks * 32);
      const float xv[8] = {xk[ks][0].x, xk[ks][0].y, xk[ks][0].z, xk[ks][0].w, xk[ks][1].x, xk[ks][1].y, xk[ks][1].z, xk[ks][1].w};
      u32x4 hw, lw;
#pragma unroll
      for (int j = 0; j < 4; ++j) {
        const float x0 = xv[2 * j], x1v = xv[2 * j + 1];
        ss += x0 * x0 + x1v * x1v;
        const unsigned hp = pk2bf(x0, x1v);
        hw[j] = hp; lw[j] = pk2bf(x0 - __uint_as_float(hp << 16), x1v - __uint_as_float(hp & 0xffff0000u));
      }
      const bf16x8 xh = __builtin_bit_cast(bf16x8, hw), xl = __builtin_bit_cast(bf16x8, lw);
      a0 = mfma16(wh_a, xh, a0); a0 = mfma16(wh_a, xl, a0); a0 = mfma16(wl_a, xh, a0);
      a1 = mfma16(wh_b, xh, a1); a1 = mfma16(wh_b, xl, a1); a1 = mfma16(wl_b, xh, a1);
    }
    ss += __shfl_xor(ss, 16); ss += __shfl_xor(ss, 32);
    __syncthreads();
#pragma unroll
    for (int j = 0; j < 4; ++j) { red[(wv * 9 + j) * 64 + lane] = a0[j]; red[(wv * 9 + 4 + j) * 64 + lane] = a1[j]; }
    red[(wv * 9 + 8) * 64 + lane] = ss;
    __syncthreads();
    const float s2 = red[8 * 64 + lane] + red[(9 + 8) * 64 + lane] + red[(18 + 8) * 64 + lane] + red[(27 + 8) * 64 + lane];
    const float rs = rsqrtf(s2 * (1.f / D) + EPS);
    {
      bf16_t* xo = XN + (tb + c) * D + wv * 256 + 8 * q;
      const float* gp = g + wv * 256 + 8 * q;
#pragma unroll
      for (int ks = 0; ks < 8; ++ks) {
        const float4 g0 = *(const float4*)(gp + ks * 32), g1 = *(const float4*)(gp + ks * 32 + 4);
        u32x4 o;
        o[0] = pk2bf(xk[ks][0].x * rs * g0.x, xk[ks][0].y * rs * g0.y); o[1] = pk2bf(xk[ks][0].z * rs * g0.z, xk[ks][0].w * rs * g0.w);
        o[2] = pk2bf(xk[ks][1].x * rs * g1.x, xk[ks][1].y * rs * g1.y); o[3] = pk2bf(xk[ks][1].z * rs * g1.z, xk[ks][1].w * rs * g1.w);
        *(u32x4*)(xo + ks * 32) = o;
      }
    }
    if (wv == 0) {
      float c0[4], c1[4];
#pragma unroll
      for (int j = 0; j < 4; ++j) {
        c0[j] = red[j * 64 + lane] + red[(9 + j) * 64 + lane] + red[(18 + j) * 64 + lane] + red[(27 + j) * 64 + lane];
        c1[j] = red[(4 + j) * 64 + lane] + red[(13 + j) * 64 + lane] + red[(22 + j) * 64 + lane] + red[(31 + j) * 64 + lane];
      }
      float lg[20];
#pragma unroll
      for (int qq = 0; qq < 4; ++qq)
#pragma unroll
        for (int j = 0; j < 4; ++j) lg[4 * qq + j] = __shfl(c0[j], c + 16 * qq);
#pragma unroll
      for (int j = 0; j < 4; ++j) lg[16 + j] = __shfl(c1[j], c);
      const int t = (int)tb + c;
      float gl[4];
#pragma unroll
      for (int k2 = 0; k2 < 4; ++k2) gl[k2] = lg[k2] * rs + brg[k2];
      int gi = 0; float gbest = gl[0];
#pragma unroll
      for (int k2 = 1; k2 < 4; ++k2) if (gl[k2] > gbest) { gbest = gl[k2]; gi = k2; }
      float den = 0.f;
#pragma unroll
      for (int k2 = 0; k2 < 4; ++k2) den += expf(gl[k2] - gbest);
      const float pg = 1.f / den;
      float le[4];
#pragma unroll
      for (int k2 = 0; k2 < 4; ++k2) { float sel = 0.f;
#pragma unroll
        for (int gg2 = 0; gg2 < 4; ++gg2) sel = (gi == gg2) ? (lg[4 + gg2 * 4 + k2] * rs + bre[gg2 * 4 + k2]) : sel;
        le[k2] = sel; }
      int i0 = 0; float l0 = le[0];
#pragma unroll
      for (int k2 = 1; k2 < 4; ++k2) if (le[k2] > l0) { l0 = le[k2]; i0 = k2; }
      int i1 = -1; float l1 = -INFINITY;
#pragma unroll
      for (int k2 = 0; k2 < 4; ++k2) if (k2 != i0 && le[k2] > l1) { l1 = le[k2]; i1 = k2; }
      const float e1 = expf(l1 - l0);
      const float w0 = pg / (1.f + e1), w1 = pg * e1 / (1.f + e1);
      const int elo = (i0 < i1) ? i0 : i1, ehi = (i0 < i1) ? i1 : i0;
      const float wlo = (i0 < i1) ? w0 : w1, whi = (i0 < i1) ? w1 : w0;
      const int pidx = (elo == 0) ? (ehi - 1) : ((elo == 1) ? (ehi + 1) : 5);
      const int cls = gi * 6 + pidx;
      if (q == 0) {
        const int slot = atomicAdd(&CNT[cls], 1);
        LIST[(size_t)cls * T + slot] = t;
        TOKW[t] = make_float2(wlo, whi);
      }
    }
  }
}

struct MoeItem { int cls, mtile, nt, cnt; };
DEVI void moe_prefix(const int* CNT, unsigned char* lds) {
  int* pre = (int*)(lds + LDS_BYTES + 64);
  __syncthreads();
  if (threadIdx.x < 24) pre[32 + threadIdx.x] = CNT[threadIdx.x];
  __syncthreads();
  if (threadIdx.x == 0) { int a = 0; for (int c = 0; c < 24; ++c) { pre[c] = a; a += (pre[32 + c] + 127) >> 7; } pre[24] = a; }
  __syncthreads();
}
DEVI bool moe_item(unsigned char* lds, int it, MoeItem& m) {
  const int* pre = (const int*)(lds + LDS_BYTES + 64);
  const int mt = it >> 3; m.nt = it & 7;
  if (mt >= pre[24]) return false;
  int c = 0;
#pragma unroll
  for (int q = 1; q < 24; ++q) c += (mt >= pre[q]) ? 1 : 0;
  m.cls = c; m.mtile = mt - pre[c]; m.cnt = pre[32 + c];
  return true;
}
DEVI void cls_experts(int cls, int& e0, int& e1) {
  const int g = cls / 6, pi = cls % 6;
  const int lo = (pi < 3) ? 0 : ((pi < 5) ? 1 : 2);
  const int hi = (pi < 3) ? (pi + 1) : ((pi < 5) ? (pi - 1) : 3);
  e0 = g * 4 + lo; e1 = g * 4 + hi;
}
DEVI void phase_g5(const Params& p, int l, unsigned char* lds) {
  const bf16_t* XN = (const bf16_t*)(p.ws + WS_A);
  bf16_t* HID = (bf16_t*)(p.ws + WS_B);
  const bf16_t* WGU = (const bf16_t*)(p.ws + WS_W + l * WS_WL + W_GU);
  const int* CNT = (const int*)(p.ws + SM_CNT) + l * 32;
  const int* LIST = (const int*)(p.ws + SM_LIST);
  const float2* TOKW = (const float2*)(p.ws + SM_TOKW);
  moe_prefix(CNT, lds);
  for (int it = vblock();; it += gridDim.x) {
    MoeItem mi; if (!moe_item(lds, it, mi)) break;
    int e0, e1; cls_experts(mi.cls, e0, e1);
    const int ex = (mi.nt < 4) ? e0 : e1, ntl = mi.nt & 3;
    const bf16_t* W = WGU + ((size_t)ex * 512 + ntl * 128) * 1024;
    const int* list = LIST + (size_t)mi.cls * T + mi.mtile * 128;
    const int nvalid = mi.cnt - mi.mtile * 128;
    f32x4 acc[4][4];
    gemm128g(lds, D, [&](int r, int k) { const int tok = (r < nvalid) ? list[r] : list[0]; return XN + (size_t)tok * D + k; }, [&](int r, int k) { return W + (size_t)r * D + k; }, acc);
    {
      const int tid = threadIdx.x, wid = tid >> 6, lane = tid & 63, wr = wid >> 1, wc = wid & 1, fr = lane & 15, fq = lane >> 4;
#pragma unroll
      for (int m = 0; m < 4; ++m) {
        const int er = wr * 64 + m * 16 + fr;
        if (er < nvalid) {
          const int tok = list[er];
          const float2 tw = TOKW[tok];
          const float w = (mi.nt < 4) ? tw.x : tw.y;
#pragma unroll
          for (int n = 0; n < 2; ++n) {
            f32x4 hv;
#pragma unroll
            for (int j = 0; j < 4; ++j) { const float gt = acc[m][n][j], up = acc[m][n + 2][j]; hv[j] = gt * sigmoidf_(gt) * up * w; }
            const int hh = (mi.nt < 4 ? 0 : 256) + ntl * 64 + wc * 32 + n * 16 + fq * 4;
            st_bf16x4(HID + (size_t)tok * 512 + hh, hv);
          }
        }
      }
    }
  }
}
DEVI void phase_g6(const Params& p, int l, unsigned char* lds) {
  const bf16_t* HID = (const bf16_t*)(p.ws + WS_B);
  const bf16_t* WDN = (const bf16_t*)(p.ws + WS_W + l * WS_WL + W_DN);
  const int* CNT = (const int*)(p.ws + SM_CNT) + l * 32;
  const int* LIST = (const int*)(p.ws + SM_LIST);
  float* out = p.out;
  moe_prefix(CNT, lds);
  for (int it = vblock();; it += gridDim.x) {
    MoeItem mi; if (!moe_item(lds, it, mi)) break;
    int e0, e1; cls_experts(mi.cls, e0, e1);
    const int* list = LIST + (size_t)mi.cls * T + mi.mtile * 128;
    const int nvalid = mi.cnt - mi.mtile * 128;
    const bf16_t* W0 = WDN + ((size_t)e0 * 1024 + mi.nt * 128) * 256;
    const bf16_t* W1 = WDN + ((size_t)e1 * 1024 + mi.nt * 128) * 256;
    f32x4 acc[4][4];
    gemm128g(lds, 512, [&](int r, int k) { const int tok = (r < nvalid) ? list[r] : list[0]; return HID + (size_t)tok * 512 + k; },
            [&](int r, int k) { return ((k < 256) ? W0 : W1) + (size_t)r * 256 + (k & 255); }, acc);
    GEMM_EPI4({ if (er < nvalid) { const size_t o = (size_t)list[er] * D + mi.nt * 128 + ec0; const f32x4 xi = *(const f32x4*)(out + o); *(f32x4*)(out + o) = xi + ev4; } })
  }
}


#define XB_TMO      128
#define XB_XCNT(j)  (256  + 64 * (j))
#define XB_XSUB(j)  (1280 + 64 * (j))
#define XB_XGEN(j)  (2304 + 64 * (j))
#define XB_TOP      3328
#define XB_TOPGEN   3392
#define XCD_BAR_WORDS 3456
#define XB_SPIN_CAP (1u << 18)
DEVI unsigned xb_ld(unsigned* p)              { return __hip_atomic_load(p, __ATOMIC_RELAXED, __HIP_MEMORY_SCOPE_AGENT); }
DEVI unsigned xb_add(unsigned* p, unsigned v) { return __hip_atomic_fetch_add(p, v, __ATOMIC_RELAXED, __HIP_MEMORY_SCOPE_AGENT); }
DEVI unsigned xb_xcc_id() { return (unsigned)__builtin_amdgcn_s_getreg((3 << 11) | 20) & 0xFu; }
#define XB_SPIN(cond, bar) do { unsigned _sp = 0; while (cond) { __builtin_amdgcn_s_sleep(1); \
    if ((++_sp & 255u) == 0u) { if (xb_ld(&(bar)[XB_TMO])) break; if (_sp > XB_SPIN_CAP) { atomicAdd(&(bar)[XB_TMO], 1u); break; } } } } while (0)
struct XcdBarrier { unsigned* bar; unsigned x; volatile LAS unsigned* st; };
DEVI XcdBarrier xcd_barrier_post(unsigned* bar, volatile LAS unsigned* st) {
    XcdBarrier b; b.bar = bar; b.x = xb_xcc_id(); b.st = st;
    if (threadIdx.x == 0) (void)xb_add(&bar[XB_XCNT(b.x)], 1u);
    return b;
}
DEVI void xcd_barrier_complete(unsigned* bar, unsigned x, unsigned& nloc, unsigned& nx) {
    const unsigned G = gridDim.x * gridDim.y * gridDim.z;
    unsigned sum, cnt, mine, sp = 0u;
    for (;;) {
        sum = 0u; cnt = 0u; mine = 0u;
#pragma unroll
        for (unsigned j = 0; j < 16; ++j) { const unsigned c = xb_ld(&bar[XB_XCNT(j)]); sum += c; cnt += (c > 0u) ? 1u : 0u; mine = (j == x) ? c : mine; }
        if (sum == G) break;
        __builtin_amdgcn_s_sleep(1);
        if ((++sp & 255u) == 0u) { if (xb_ld(&bar[XB_TMO])) break; if (sp > XB_SPIN_CAP) { atomicAdd(&bar[XB_TMO], 1u); break; } }
    }
    nloc = mine > 0u ? mine : 1u; nx = cnt > 0u ? cnt : 1u;
}
DEVI void xcd_barrier(const XcdBarrier& b) {
    asm volatile("s_waitcnt vmcnt(0)" ::: "memory");
    __syncthreads();
    if (threadIdx.x == 0) {
        unsigned* bar = b.bar;
        __builtin_amdgcn_s_waitcnt(0);
        unsigned nloc = b.st[0], nx = b.st[1];
        if (nloc == 0u) { xcd_barrier_complete(bar, b.x, nloc, nx); b.st[0] = nloc; b.st[1] = nx; }
        const unsigned old = xb_add(&bar[XB_XSUB(b.x)], 1u);
        const unsigned gen = old / nloc;
        if (old + 1u == (gen + 1u) * nloc) {
            __builtin_amdgcn_fence(__ATOMIC_RELEASE, "agent");
            asm volatile("s_waitcnt vmcnt(0)" ::: "memory");
            const unsigned og = xb_add(&bar[XB_TOP], 1u);
            const unsigned tg = og / nx;
            if (og + 1u == (tg + 1u) * nx) xb_add(&bar[XB_TOPGEN], 1u);
            else XB_SPIN(xb_ld(&bar[XB_TOPGEN]) == tg, bar);
            __builtin_amdgcn_fence(__ATOMIC_ACQUIRE, "agent");
            xb_add(&bar[XB_XGEN(b.x)], 1u);
            asm volatile("s_waitcnt vmcnt(0)" ::: "memory");
        } else {
            XB_SPIN(xb_ld(&bar[XB_XGEN(b.x)]) == gen, bar);
            __builtin_amdgcn_fence(__ATOMIC_ACQUIRE, "agent");
            asm volatile("s_waitcnt vmcnt(0)" ::: "memory");
        }
    }
    __syncthreads();
}

#define PH(k, call) { const int _k = (k); if (p.lo <= _k && _k < p.hi) { call; if (_k + 1 < p.hi) { if (_k == 0) grid.sync(); else xcd_barrier(xbar); } } }
__global__ void __launch_bounds__(NTHREADS, 2) hybrid_fwd(Params p) {
  extern __shared__ __attribute__((aligned(16))) unsigned char lds[];
  cg::grid_group grid = cg::this_grid();
  volatile LAS unsigned* xst = (volatile LAS unsigned*)(LAS unsigned char*)(lds + LDS_BYTES);
  if (threadIdx.x < 4) xst[threadIdx.x] = 0u;
  __syncthreads();
  XcdBarrier xbar = xcd_barrier_post((unsigned*)(p.ws + WS_CTL), xst);
  PH(0, phase_prep(p, lds))
#define LAYER(l) { \
    PH(1 + 13 * l + 0, phase_g1(p, l, lds)) \
    PH(1 + 13 * l + 2, phase_g2(p, l, lds)) \
    PH(1 + 13 * l + 3, phase_r2(p, l, lds)) \
    PH(1 + 13 * l + 4, phase_a1(p, l, lds)) \
    PH(1 + 13 * l + 5, phase_r3(p, l, lds)) \
    PH(1 + 13 * l + 6, phase_g3(p, l, lds)) \
    PH(1 + 13 * l + 7, phase_r4(p, l)) \
    PH(1 + 13 * l + 8, phase_g4(p, l, lds)) \
    PH(1 + 13 * l + 9, phase_r5(p, l, lds)) \
    PH(1 + 13 * l + 10, phase_g5(p, l, lds)) \
    PH(1 + 13 * l + 11, phase_g6(p, l, lds)) }
  LAYER(0)
  PH(13, rmsnorm_rows(p.out, p.in[2] + D, (bf16_t*)(p.ws + WS_A)))
  LAYER(1)
}

extern "C" void kernel_launch(void* const* d_in, const int* in_sizes, int n_in, void* d_out, int out_size, void* d_ws, size_t ws_size, hipStream_t stream) {
  static int grid_blocks = 0;
  if (!grid_blocks) {
    if (n_in != 45 || ws_size < WS_END) { fprintf(stderr, "kernel_launch: unexpected n_in %d or ws_size %zu (< %zu)\n", n_in, ws_size, (size_t)WS_END); grid_blocks = -1; return; }
    int dev = 0, cus = 0, per_cu = 0;
    hipGetDevice(&dev);
    hipDeviceGetAttribute(&cus, hipDeviceAttributeMultiprocessorCount, dev);
    hipFuncSetAttribute((const void*)hybrid_fwd, hipFuncAttributeMaxDynamicSharedMemorySize, LDS_ALLOC);
    hipOccupancyMaxActiveBlocksPerMultiprocessor(&per_cu, (const void*)hybrid_fwd, NTHREADS, LDS_ALLOC);
    if (per_cu < 1) per_cu = 1;
    if (per_cu > 2) per_cu = 2;
    grid_blocks = cus * per_cu;
    fprintf(stderr, "kernel_launch: cus %d per_cu %d grid %d\n", cus, per_cu, grid_blocks);
  }
  if (grid_blocks < 0) return;
  (void)hipMemsetAsync((unsigned char*)d_ws + WS_CTL, 0, XCD_BAR_WORDS * 4, stream);
  Params p{};
  for (int i = 0; i < 45; ++i) p.in[i] = (const float*)d_in[i];
  p.out = (float*)d_out; p.ws = (unsigned char*)d_ws;
#if N_LAUNCH_MODE == 1
  p.lo = 0; p.hi = NPH;
  { void* args[] = {&p}; hipError_t e = hipLaunchCooperativeKernel((void*)hybrid_fwd, dim3(grid_blocks), dim3(NTHREADS), args, LDS_ALLOC, stream);
    if (e != hipSuccess) fprintf(stderr, "cooperative launch failed: %s\n", hipGetErrorString(e)); }
#else
  for (int ph = 0; ph < NPH; ++ph) {
    p.lo = ph; p.hi = ph + 1;
    void* args[] = {&p}; hipError_t e = hipLaunchCooperativeKernel((void*)hybrid_fwd, dim3(grid_blocks), dim3(NTHREADS), args, LDS_ALLOC, stream);
    if (e != hipSuccess) { fprintf(stderr, "launch %d failed: %s\n", ph, hipGetErrorString(e)); break; }
  }
#endif
}
```

```cpp
#include <hip/hip_runtime.h>
#include <hip/hip_cooperative_groups.h>
#include <cstdio>
#include <cstdint>
namespace cg = cooperative_groups;

#ifndef N_LAUNCH_MODE
#define N_LAUNCH_MODE 1
#endif

#define DEVI __device__ __forceinline__
typedef unsigned short bf16_t;
typedef short bf16x8 __attribute__((ext_vector_type(8)));
typedef float f32x4 __attribute__((ext_vector_type(4)));
typedef float f32x16 __attribute__((ext_vector_type(16)));
typedef unsigned u32x4 __attribute__((ext_vector_type(4)));
#define LAS __attribute__((address_space(3)))

constexpr int NB = 16, S = 2048, T = NB * S, D = 1024, DIN = 1772, DINP = 1792, NL = 2;
constexpr int C_CQ = 0, C_KPE = 192, C_NG = 224, C_CKV = 256, C_LX = 384, C_LG = 640, C_S5 = 896, C_NQ = 1152, C_KS = 1408, C_KW = 1472, C_KC = 1536, C_VC = 1600, C_VS = 1664, C_VW = 1728;
__host__ __device__ constexpr int colmap(int n) {
  if (n < 192) return n;
  if (n < 320) return C_CKV + (n - 192);
  if (n < 352) return C_KPE + (n - 320);
  if (n < 608) return C_LX + (n - 352);
  if (n < 864) return C_LG + (n - 608);
  if (n < 1120) return C_S5 + (n - 864);
  if (n < 1376) return C_NQ + (n - 1120);
  if (n < 1760) { const int j = n - 1376, part = j >> 6, d = j & 63; return (part == 0 ? C_KC : part == 1 ? C_VC : part == 2 ? C_KS : part == 3 ? C_VS : part == 4 ? C_KW : C_VW) + d; }
  return C_NG + (n - 1760);
}
constexpr float EPS = 1e-6f;
constexpr float LOG2E = 1.4426950408889634f;
constexpr int NTHREADS = 256;
constexpr int NPH = 1 + 13 * NL - 1;

constexpr size_t MiB = 1u << 20;
constexpr size_t WS_CTL = 0;
constexpr size_t WS_SMALL = 1 * MiB;
constexpr size_t WS_W = 16 * MiB;
constexpr size_t WS_WL = 32 * MiB;
constexpr size_t WS_A = 80 * MiB;
constexpr size_t WS_B = 144 * MiB;
constexpr size_t WS_C = 256 * MiB;
constexpr size_t WS_D = 292 * MiB;
constexpr size_t WS_E = 348 * MiB;
constexpr size_t WS_F = 380 * MiB;
constexpr size_t WS_G = 428 * MiB;
constexpr size_t WS_ROPE = 452 * MiB;
constexpr size_t WS_END = 460 * MiB;
constexpr size_t W_IN = 0;
constexpr size_t W_OUT = 4 * MiB;
constexpr size_t W_UQ = 6 * MiB;
constexpr size_t W_UKV = W_UQ + 384 * 192 * 2;
constexpr size_t W_LRU = W_UKV + 512 * 128 * 2;
constexpr size_t W_GLU = W_LRU + 4 * 128 * 64 * 2;
constexpr size_t W_1K = 6 * MiB + 512 * 1024;
constexpr size_t W_1V = W_1K + 128 * 2048 * 2;
constexpr size_t W_B1K = W_1V + 128 * 2048 * 2;
constexpr size_t W_B1V = W_B1K + 512;
constexpr size_t W_S5A = W_B1V + 512;
constexpr size_t W_S5A64 = W_S5A + 16 * 64 * 8;
constexpr size_t W_S5B = W_S5A64 + 16 * 64 * 8;
constexpr size_t W_S5BB = W_S5B + 16 * 64 * 16 * 8;
constexpr size_t W_S5CM = W_S5BB + 16 * 4 * 32 * 16 * 2;
constexpr size_t W_2K = W_S5CM + 16 * 16 * 128 * 2;
constexpr size_t W_2V = W_2K + 64 * 128 * 2;
static_assert(W_2V + 64 * 128 * 2 <= 8 * MiB, "weights overflow");
constexpr size_t W_RTH = W_2V + 64 * 128 * 2;
constexpr size_t W_RTL = W_RTH + 32 * 1024 * 2;
static_assert(W_RTL + 32 * 1024 * 2 <= 8 * MiB, "weights overflow 2");
constexpr size_t W_GU = 8 * MiB;
constexpr size_t W_DN = 24 * MiB;
constexpr size_t SM_CNT = WS_SMALL;
constexpr size_t SM_LIST = WS_SMALL + 4096;
constexpr size_t SM_TOKW = SM_LIST + 24 * (size_t)T * 4;
constexpr size_t SM_LSUM = SM_TOKW + (size_t)T * 8;
constexpr size_t SM_SLOC = SM_LSUM + 16 * 32 * 256 * 8;
constexpr size_t SM_HK = SM_SLOC + 16 * 32 * 1024 * 8;
constexpr size_t SM_HV = SM_HK + 2048 * 128 * 2;
constexpr size_t SM_KC = SM_HV + 2048 * 128 * 2;
constexpr size_t SM_VC = SM_KC + 16 * 128 * 64 * 2;
constexpr size_t SM_SCAR = SM_VC + 16 * 128 * 64 * 2;
constexpr size_t SM_LCAR = SM_SCAR + 16 * 32 * 1024 * 8;
constexpr size_t SM_END = SM_LCAR + 16 * 32 * 256 * 4;
static_assert(SM_END <= WS_W, "small region overflow");

constexpr int LDS_BYTES = 65536;
constexpr int LDS_ALLOC = LDS_BYTES + 512;

struct Params {
  const float* in[45];
  float* out;
  unsigned char* ws;
  int lo, hi;
};

DEVI float bf2f(bf16_t v) { return __uint_as_float(((unsigned)v) << 16); }
DEVI bf16_t f2bf(float f) { unsigned u = __float_as_uint(f); return (bf16_t)((u + 0x7fffu + ((u >> 16) & 1u)) >> 16); }
DEVI float wsum(float v) {
#pragma unroll
  for (int o = 32; o >= 1; o >>= 1) v += __shfl_xor(v, o);
  return v;
}
DEVI float sigmoidf_(float x) { return __builtin_amdgcn_rcpf(1.f + __expf(-x)); }
DEVI float gelu_tanh(float x) { const float u2 = 1.5957691216057308f * (x + 0.044715f * x * x * x); return x * __builtin_amdgcn_rcpf(1.f + __expf(-u2)); }
DEVI f32x16 mfma32(bf16x8 a, bf16x8 b, f32x16 c) { return __builtin_amdgcn_mfma_f32_32x32x16_bf16(a, b, c, 0, 0, 0); }
DEVI f32x4 mfma16(bf16x8 a, bf16x8 b, f32x4 c) { return __builtin_amdgcn_mfma_f32_16x16x32_bf16(a, b, c, 0, 0, 0); }
DEVI int vblock() { const int G = (int)gridDim.x, bx = (int)blockIdx.x; return (G % 8 == 0) ? (bx % 8) * (G / 8) + bx / 8 : bx; }
DEVI int crow(int r, int h) { return (r & 3) + 8 * (r >> 2) + 4 * h; }
typedef __bf16 bf16x2_t __attribute__((ext_vector_type(2)));
typedef float f32x2_t __attribute__((ext_vector_type(2)));
DEVI unsigned pk2bf(float lo, float hi) { f32x2_t v = {lo, hi}; bf16x2_t b = __builtin_convertvector(v, bf16x2_t); return __builtin_bit_cast(unsigned, b); }

template <class AF, class BF>
DEVI void gemm128(unsigned char* lds, int K, AF aload, BF bptr, f32x4 (&acc)[4][4]) {
  const int tid = threadIdx.x, wid = tid >> 6, lane = tid & 63, wr = wid >> 1, wc = wid & 1, fr = lane & 15, fq = lane >> 4;
#pragma unroll
  for (int m = 0; m < 4; ++m)
#pragma unroll
    for (int n = 0; n < 4; ++n) acc[m][n] = (f32x4){0.f, 0.f, 0.f, 0.f};
  const int lr = tid >> 3, ch = tid & 7;
  const int wofs = lr * 128 + ((ch ^ ((lr >> 1) & 7)) * 16);
  const int sw = (fr >> 1) & 7;
  const int aro = (wr * 64 + fr) * 128, bro = (wc * 64 + fr) * 128;
  const int nk = K >> 6;
  u32x4 ra[4], rb[4];
#pragma unroll
  for (int i = 0; i < 4; ++i) { ra[i] = aload(lr + 32 * i, ch * 8); rb[i] = *(const u32x4*)bptr(lr + 32 * i, ch * 8); }
  __syncthreads();
#pragma unroll
  for (int i = 0; i < 4; ++i) { *(u32x4*)(lds + wofs + i * 4096) = ra[i]; *(u32x4*)(lds + 16384 + wofs + i * 4096) = rb[i]; }
  __syncthreads();
  for (int kt = 0; kt < nk; ++kt) {
    const bool more = (kt + 1 < nk);
    if (more) {
      const int k = (kt + 1) * 64 + ch * 8;
#pragma unroll
      for (int i = 0; i < 4; ++i) { ra[i] = aload(lr + 32 * i, k); rb[i] = *(const u32x4*)bptr(lr + 32 * i, k); }
    }
    const unsigned char* bufA = lds + (kt & 1) * 32768;
    const unsigned char* bufB = bufA + 16384;
#pragma unroll
    for (int kk = 0; kk < 2; ++kk) {
      bf16x8 At[4], Bt[4];
      const int co = ((kk * 4 + fq) ^ sw) * 16;
#pragma unroll
      for (int m = 0; m < 4; ++m) At[m] = *(const bf16x8*)(bufA + aro + m * 2048 + co);
#pragma unroll
      for (int n = 0; n < 4; ++n) Bt[n] = *(const bf16x8*)(bufB + bro + n * 2048 + co);
#pragma unroll
      for (int m = 0; m < 4; ++m)
#pragma unroll
        for (int n = 0; n < 4; ++n) acc[m][n] = mfma16(Bt[n], At[m], acc[m][n]);
    }
    if (more) {
      unsigned char* nb = lds + ((kt + 1) & 1) * 32768;
#pragma unroll
      for (int i = 0; i < 4; ++i) { *(u32x4*)(nb + wofs + i * 4096) = ra[i]; *(u32x4*)(nb + 16384 + wofs + i * 4096) = rb[i]; }
    }
    __syncthreads();
  }
}
template <class AF, class BF>
DEVI void gemm128g(unsigned char* lds, int K, AF aptr, BF bptr, f32x4 (&acc)[4][4]) {
  const int tid = threadIdx.x, wid = tid >> 6, lane = tid & 63, wr = wid >> 1, wc = wid & 1, fr = lane & 15, fq = lane >> 4;
#pragma unroll
  for (int m = 0; m < 4; ++m)
#pragma unroll
    for (int n = 0; n < 4; ++n) acc[m][n] = (f32x4){0.f, 0.f, 0.f, 0.f};
  const int lr = tid >> 3;
  const int chs = ((tid & 7) ^ ((lr >> 1) & 7)) * 8;
  const int sw = (fr >> 1) & 7;
  const int aro = (wr * 64 + fr) * 128, bro = (wc * 64 + fr) * 128;
  const int nk = K >> 6;
  LAS unsigned char* l3 = (LAS unsigned char*)lds;
#define G128_STAGE(buf, kbase)                                                                                                   \
  _Pragma("unroll") for (int i = 0; i < 4; ++i) {                                                                                 \
    __builtin_amdgcn_global_load_lds((const __attribute__((address_space(1))) unsigned*)aptr(lr + 32 * i, (kbase) + chs),          \
                                     (LAS unsigned*)(l3 + (buf) * 32768 + tid * 16 + i * 4096), 16, 0, 0);                           \
    __builtin_amdgcn_global_load_lds((const __attribute__((address_space(1))) unsigned*)bptr(lr + 32 * i, (kbase) + chs),          \
                                     (LAS unsigned*)(l3 + (buf) * 32768 + 16384 + tid * 16 + i * 4096), 16, 0, 0);                   \
  }
  __syncthreads();
  G128_STAGE(0, 0)
  asm volatile("s_waitcnt vmcnt(0)" ::: "memory");
  __syncthreads();
  for (int kt = 0; kt < nk; ++kt) {
    if (kt + 1 < nk) { G128_STAGE((kt + 1) & 1, (kt + 1) * 64) }
    const unsigned char* bufA = lds + (kt & 1) * 32768;
    const unsigned char* bufB = bufA + 16384;
#pragma unroll
    for (int kk = 0; kk < 2; ++kk) {
      bf16x8 At[4], Bt[4];
      const int co = ((kk * 4 + fq) ^ sw) * 16;
#pragma unroll
      for (int m = 0; m < 4; ++m) At[m] = *(const bf16x8*)(bufA + aro + m * 2048 + co);
#pragma unroll
      for (int n = 0; n < 4; ++n) Bt[n] = *(const bf16x8*)(bufB + bro + n * 2048 + co);
#pragma unroll
      for (int m = 0; m < 4; ++m)
#pragma unroll
        for (int n = 0; n < 4; ++n) acc[m][n] = mfma16(Bt[n], At[m], acc[m][n]);
    }
    asm volatile("s_waitcnt vmcnt(0)" ::: "memory");
    __syncthreads();
  }
#undef G128_STAGE
}
template <class AF, class BF, class AF2, class BF2>
DEVI void gemm128p(unsigned char* lds, int K, AF aptr, BF bptr, f32x4 (&acc)[4][4], int& par, bool staged, bool has_next, AF2 naptr, BF2 nbptr) {
  const int tid = threadIdx.x, wid = tid >> 6, lane = tid & 63, wr = wid >> 1, wc = wid & 1, fr = lane & 15, fq = lane >> 4;
#pragma unroll
  for (int m = 0; m < 4; ++m)
#pragma unroll
    for (int n = 0; n < 4; ++n) acc[m][n] = (f32x4){0.f, 0.f, 0.f, 0.f};
  const int lr = tid >> 3;
  const int chs = ((tid & 7) ^ ((lr >> 1) & 7)) * 8;
  const int sw = (fr >> 1) & 7;
  const int aro = (wr * 64 + fr) * 128, bro = (wc * 64 + fr) * 128;
  const int nk = K >> 6;
  LAS unsigned char* l3 = (LAS unsigned char*)lds;
#define GP_STAGE(buf, kbase, AP, BP)                                                                                             \
  _Pragma("unroll") for (int i = 0; i < 4; ++i) {                                                                                 \
    __builtin_amdgcn_global_load_lds((const __attribute__((address_space(1))) unsigned*)AP(lr + 32 * i, (kbase) + chs),            \
                                     (LAS unsigned*)(l3 + (buf) * 32768 + tid * 16 + i * 4096), 16, 0, 0);                           \
    __builtin_amdgcn_global_load_lds((const __attribute__((address_space(1))) unsigned*)BP(lr + 32 * i, (kbase) + chs),            \
                                     (LAS unsigned*)(l3 + (buf) * 32768 + 16384 + tid * 16 + i * 4096), 16, 0, 0);                   \
  }
  if (!staged) {
    __syncthreads();
    GP_STAGE(par, 0, aptr, bptr)
    asm volatile("s_waitcnt vmcnt(0)" ::: "memory");
    __syncthreads();
  }
  for (int kt = 0; kt < nk; ++kt) {
    const int cur = (par + kt) & 1;
    if (kt + 1 < nk) { GP_STAGE(cur ^ 1, (kt + 1) * 64, aptr, bptr) }
    else if (has_next) { GP_STAGE(cur ^ 1, 0, naptr, nbptr) }
    const unsigned char* bufA = lds + cur * 32768;
    const unsigned char* bufB = bufA + 16384;
#pragma unroll
    for (int kk = 0; kk < 2; ++kk) {
      bf16x8 At[4], Bt[4];
      const int co = ((kk * 4 + fq) ^ sw) * 16;
#pragma unroll
      for (int m = 0; m < 4; ++m) At[m] = *(const bf16x8*)(bufA + aro + m * 2048 + co);
#pragma unroll
      for (int n = 0; n < 4; ++n) Bt[n] = *(const bf16x8*)(bufB + bro + n * 2048 + co);
#pragma unroll
      for (int m = 0; m < 4; ++m)
#pragma unroll
        for (int n = 0; n < 4; ++n) acc[m][n] = mfma16(Bt[n], At[m], acc[m][n]);
    }
    asm volatile("s_waitcnt vmcnt(0)" ::: "memory");
    __syncthreads();
  }
  par = (par + nk) & 1;
#undef GP_STAGE
}
#define GEMM_EPI_LOOP(body)                                                                 \
  {                                                                                         \
    const int _tid = threadIdx.x, _wid = _tid >> 6, _lane = _tid & 63, _wr = _wid >> 1, _wc = _wid & 1, _fr = _lane & 15, _fq = _lane >> 4; \
    _Pragma("unroll") for (int m = 0; m < 4; ++m) _Pragma("unroll") for (int n = 0; n < 4; ++n) _Pragma("unroll") for (int j = 0; j < 4; ++j) { \
      const int er = _wr * 64 + m * 16 + _fr, ec = _wc * 64 + n * 16 + _fq * 4 + j; const float ev = acc[m][n][j]; body }                      \
  }
#define GEMM_EPI4(body)                                                                     \
  {                                                                                         \
    const int _tid = threadIdx.x, _wid = _tid >> 6, _lane = _tid & 63, _wr = _wid >> 1, _wc = _wid & 1, _fr = _lane & 15, _fq = _lane >> 4; \
    _Pragma("unroll") for (int m = 0; m < 4; ++m) _Pragma("unroll") for (int n = 0; n < 4; ++n) {                                             \
      const int er = _wr * 64 + m * 16 + _fr, ec0 = _wc * 64 + n * 16 + _fq * 4; const f32x4 ev4 = acc[m][n]; body }                          \
  }
DEVI void st_bf16x4(bf16_t* p, f32x4 v) { uint2 o; o.x = pk2bf(v[0], v[1]); o.y = pk2bf(v[2], v[3]); *(uint2*)p = o; }

template <class RM>
DEVI void transpose_tiles(const float* src, int K, int N, bf16_t* dst, int ldk, RM rowmap, unsigned char* lds, int& cursor, const float* kscale = nullptr) {
  float* tl = (float*)lds;
  const int tk = K / 64, tn = (N + 63) / 64, nt = tk * tn;
  const int tid = threadIdx.x;
  const int G_ = (int)gridDim.x;
  for (int it = ((int)blockIdx.x - cursor % G_ + G_) % G_; it < nt; it += G_) {
    const int kt = it / tn, ntile = it % tn, k0 = kt * 64, n0 = ntile * 64;
    __syncthreads();
#pragma unroll
    for (int q = 0; q < 4; ++q) {
      const int r = (tid >> 4) + 16 * q, c4 = (tid & 15) * 4;
      const float* sp = src + (size_t)(k0 + r) * N + n0 + c4;
      float4 v;
      if (n0 + c4 + 3 < N) v = *(const float4*)sp;
      else { v.x = (n0 + c4 < N) ? sp[0] : 0.f; v.y = (n0 + c4 + 1 < N) ? sp[1] : 0.f; v.z = (n0 + c4 + 2 < N) ? sp[2] : 0.f; v.w = 0.f; }
      if (kscale) { const float ks = kscale[k0 + r]; v.x *= ks; v.y *= ks; v.z *= ks; v.w *= ks; }
      tl[r * 65 + c4] = v.x; tl[r * 65 + c4 + 1] = v.y; tl[r * 65 + c4 + 2] = v.z; tl[r * 65 + c4 + 3] = v.w;
    }
    __syncthreads();
    const int n = tid >> 2, kc = (tid & 3) * 16;
    if (n0 + n < N) {
      unsigned w[8];
#pragma unroll
      for (int i = 0; i < 8; ++i) w[i] = pk2bf(tl[(kc + 2 * i) * 65 + n], tl[(kc + 2 * i + 1) * 65 + n]);
      uint4* o = (uint4*)(dst + (size_t)rowmap(n0 + n) * ldk + k0 + kc);
      o[0] = make_uint4(w[0], w[1], w[2], w[3]); o[1] = make_uint4(w[4], w[5], w[6], w[7]);
    }
  }
  cursor += nt;
}
DEVI void rmsnorm_rows(const float* x, const float* g, bf16_t* xn) {
  const int lane = threadIdx.x & 63, gw = blockIdx.x * 4 + (threadIdx.x >> 6), NGW = gridDim.x * 4;
  for (int t = gw; t < T; t += NGW) {
    const float4* xr = (const float4*)(x + (size_t)t * D);
    float4 v[4]; float s = 0.f;
#pragma unroll
    for (int j = 0; j < 4; ++j) { v[j] = xr[lane + 64 * j]; s += v[j].x * v[j].x + v[j].y * v[j].y + v[j].z * v[j].z + v[j].w * v[j].w; }
    const float rs = rsqrtf(wsum(s) * (1.f / D) + EPS);
#pragma unroll
    for (int j = 0; j < 4; ++j) {
      const float4 gg = ((const float4*)g)[lane + 64 * j];
      uint2 o; o.x = pk2bf(v[j].x * rs * gg.x, v[j].y * rs * gg.y); o.y = pk2bf(v[j].z * rs * gg.z, v[j].w * rs * gg.w);
      ((uint2*)(xn + (size_t)t * D))[lane + 64 * j] = o;
    }
  }
}
DEVI void phase_prep(const Params& p, unsigned char* lds) {
  const size_t gtid = (size_t)blockIdx.x * NTHREADS + threadIdx.x, gn = (size_t)gridDim.x * NTHREADS;
  unsigned char* ws = p.ws;
  if (gtid < 64) ((int*)(ws + SM_CNT))[gtid] = 0;
  auto ident = [](int n) { return n; };
  int cursor = 0;
  for (int l = 0; l < NL; ++l) {
    unsigned char* wl = ws + WS_W + l * WS_WL;
    transpose_tiles(p.in[3] + (size_t)l * D * DIN, D, DIN, (bf16_t*)(wl + W_IN), D, [](int n) { return colmap(n); }, lds, cursor);
    for (size_t i = gtid; i < (size_t)20 * D; i += gn) ((bf16_t*)(wl + W_IN))[(size_t)236 * D + i] = 0;
    transpose_tiles(p.in[36] + (size_t)l * D * D, D, D, (bf16_t*)(wl + W_OUT), D, ident, lds, cursor);
    transpose_tiles(p.in[6] + (size_t)l * 192 * 384, 192, 384, (bf16_t*)(wl + W_UQ), 192, ident, lds, cursor, p.in[4] + l * 192);
    transpose_tiles(p.in[7] + (size_t)l * 128 * 512, 128, 512, (bf16_t*)(wl + W_UKV), 128, ident, lds, cursor, p.in[5] + l * 128);
    transpose_tiles(p.in[25] + (size_t)l * 256 * 256, 256, 256, (bf16_t*)(wl + W_GLU), 256, ident, lds, cursor);
    transpose_tiles(p.in[30] + (size_t)l * 2048 * 128, 2048, 128, (bf16_t*)(wl + W_1K), 2048, ident, lds, cursor);
    transpose_tiles(p.in[33] + (size_t)l * 2048 * 128, 2048, 128, (bf16_t*)(wl + W_1V), 2048, ident, lds, cursor);
    transpose_tiles(p.in[31] + (size_t)l * 128 * 64, 128, 64, (bf16_t*)(wl + W_2K), 128, ident, lds, cursor);
    transpose_tiles(p.in[34] + (size_t)l * 128 * 64, 128, 64, (bf16_t*)(wl + W_2V), 128, ident, lds, cursor);
    for (int h = 0; h < 4; ++h) {
      transpose_tiles(p.in[12] + ((size_t)l * 4 + h) * 64 * 64, 64, 64, (bf16_t*)(wl + W_LRU) + h * 128 * 64, 64, ident, lds, cursor);
      transpose_tiles(p.in[14] + ((size_t)l * 4 + h) * 64 * 64, 64, 64, (bf16_t*)(wl + W_LRU) + h * 128 * 64 + 64 * 64, 64, ident, lds, cursor);
    }
    for (int e = 0; e < 16; ++e) {
      bf16_t* dg = (bf16_t*)(wl + W_GU) + (size_t)e * 512 * 1024;
      transpose_tiles(p.in[42] + ((size_t)l * 16 + e) * 1024 * 256, 1024, 256, dg, 1024, [](int hh) { return (hh >> 6) * 128 + ((hh >> 5) & 1) * 64 + ((hh >> 4) & 1) * 16 + (hh & 15); }, lds, cursor);
      transpose_tiles(p.in[43] + ((size_t)l * 16 + e) * 1024 * 256, 1024, 256, dg, 1024, [](int hh) { return (hh >> 6) * 128 + ((hh >> 5) & 1) * 64 + (((hh >> 4) & 1) + 2) * 16 + (hh & 15); }, lds, cursor);
      transpose_tiles(p.in[44] + ((size_t)l * 16 + e) * 256 * 1024, 256, 1024, (bf16_t*)(wl + W_DN) + (size_t)e * 1024 * 256, 256, ident, lds, cursor);
    }
    {
      const int lane = threadIdx.x & 63, gw = blockIdx.x * 4 + (threadIdx.x >> 6), NGW = gridDim.x * 4;
      for (int o = gw; o < 256; o += NGW) {
        const int kv = o >> 7, j = o & 127;
        const float* pe = (kv ? p.in[32] : p.in[29]) + (size_t)l * 2048;
        const float* w1 = (kv ? p.in[33] : p.in[30]) + (size_t)l * 2048 * 128;
        float a = 0.f;
#pragma unroll 8
        for (int k = lane; k < 2048; k += 64) a += pe[k] * w1[(size_t)k * 128 + j];
        a = wsum(a);
        if (lane == 0) ((float*)(wl + (kv ? W_B1V : W_B1K)))[j] = a;
      }
    }
    for (size_t i = gtid; i < 16 * 64; i += gn) {
      const int g = (int)(i >> 6), sidx = (int)(i & 63);
      const float are = p.in[17][(size_t)l * 1024 + i], aim = p.in[18][(size_t)l * 1024 + i];
      const float dt = expf(p.in[19][l * 16 + g]);
      const float mag = expf(dt * are);
      float sn, cs; sincosf(dt * aim, &sn, &cs);
      const float abr = mag * cs, abi = mag * sn;
      const float den = are * are + aim * aim, nre = abr - 1.f;
      const float gre = (nre * are + abi * aim) / den, gim = (abi * are - nre * aim) / den;
      ((float2*)(wl + W_S5A))[i] = make_float2(abr, abi);
      float pr = abr, pi = abi;
#pragma unroll
      for (int q = 0; q < 6; ++q) { const float nr = pr * pr - pi * pi, ni = 2.f * pr * pi; pr = nr; pi = ni; }
      ((float2*)(wl + W_S5A64))[i] = make_float2(pr, pi);
      bf16_t* bb = (bf16_t*)(wl + W_S5BB);
      for (int ch = 0; ch < 16; ++ch) {
        const float br = p.in[20][((size_t)l * 1024 + i) * 16 + ch], bi = p.in[21][((size_t)l * 1024 + i) * 16 + ch];
        const float vr = gre * br - gim * bi, vi = gre * bi + gim * br;
        const int sb = sidx >> 5, r = sidx & 31;
        bb[((g * 4 + sb * 2 + 0) * 32 + r) * 16 + ch] = f2bf(vr);
        bb[((g * 4 + sb * 2 + 1) * 32 + r) * 16 + ch] = f2bf(vi);
      }
    }
    for (size_t i = gtid; i < 32 * 1024; i += gn) {
      const int n = (int)(i >> 10), k = (int)(i & 1023);
      float w = 0.f;
      if (n < 20) w = p.in[37][l * D + k] * ((n < 4) ? p.in[38][((size_t)l * D + k) * 4 + n] : p.in[40][((size_t)l * D + k) * 16 + (n - 4)]);
      const bf16_t hi = f2bf(w);
      ((bf16_t*)(wl + W_RTH))[i] = hi; ((bf16_t*)(wl + W_RTL))[i] = f2bf(w - bf2f(hi));
    }
    for (size_t i = gtid; i < 16 * 16 * 64; i += gn) {
      const int g = (int)(i >> 10), ch = (int)((i >> 6) & 15), pp = (int)(i & 63);
      const float cr = p.in[22][(size_t)l * 16384 + i], ci = p.in[23][(size_t)l * 16384 + i];
      bf16_t* cm = (bf16_t*)(wl + W_S5CM) + ((size_t)(g * 16 + ch) * 128 + 2 * pp);
      cm[0] = f2bf(cr); cm[1] = f2bf(-ci);
    }
  }
  {
    const int* positions = (const int*)p.in[1];
    float2* RM = (float2*)(ws + WS_ROPE);
    float2* RN = RM + (size_t)T * 16;
    for (size_t i = gtid; i < (size_t)T * 24; i += gn) {
      const int t = (int)(i / 24), j = (int)(i % 24);
      const int rot = (j < 16) ? 32 : 16, fi = (j < 16) ? j : (j - 16);
      const float inv = powf(500000.f, -(2.f * (float)fi) / (float)rot);
      float sn, cs; sincosf((float)positions[t] * inv, &sn, &cs);
      if (j < 16) RM[(size_t)t * 16 + fi] = make_float2(cs, sn); else RN[(size_t)t * 8 + fi] = make_float2(cs, sn);
    }
  }
  rmsnorm_rows(p.in[0], p.in[2], (bf16_t*)(ws + WS_A));
}

DEVI void phase_g1(const Params& p, int l, unsigned char* lds) {
  const bf16_t* XN = (const bf16_t*)(p.ws + WS_A);
  const bf16_t* W = (const bf16_t*)(p.ws + WS_W + l * WS_WL + W_IN);
  bf16_t* PROJ = (bf16_t*)(p.ws + WS_B);
  constexpr int NT = DINP / 128;
  int par = 0; bool staged = false;
  for (int it = vblock(); it < (T / 128) * NT; it += gridDim.x) {
    const int mt = it / NT, nt = it % NT;
    const int itn = it + (int)gridDim.x; const bool hn = itn < (T / 128) * NT; const int mtn = itn / NT, ntn = itn % NT;
    f32x4 acc[4][4];
    gemm128p(lds, D, [&](int r, int k) { return XN + (size_t)(mt * 128 + r) * D + k; }, [&](int r, int k) { return W + (size_t)(nt * 128 + r) * D + k; }, acc, par, staged, hn,
             [&](int r, int k) { return XN + (size_t)(mtn * 128 + r) * D + k; }, [&](int r, int k) { return W + (size_t)(ntn * 128 + r) * D + k; });
    staged = hn;
    if (nt >= 9 && nt <= 11) {
      const int tid = threadIdx.x, wid = tid >> 6, lane = tid & 63, wr = wid >> 1, wc = wid & 1, fr = lane & 15, fq = lane >> 4;
      const float* gg = (nt < 11) ? (p.in[27] + l * 64) : (p.in[28] + l * 192 + (wc ? 128 : 64));
      const float sc = (nt < 11) ? (0.125f * LOG2E) : 1.f;
      const float2* RN = (const float2*)(p.ws + WS_ROPE) + (size_t)T * 16;
#pragma unroll
      for (int m = 0; m < 4; ++m) {
        const size_t t = (size_t)mt * 128 + wr * 64 + m * 16 + fr;
        float ss = 0.f;
#pragma unroll
        for (int n = 0; n < 4; ++n) ss += acc[m][n][0] * acc[m][n][0] + acc[m][n][1] * acc[m][n][1] + acc[m][n][2] * acc[m][n][2] + acc[m][n][3] * acc[m][n][3];
        ss += __shfl_xor(ss, 16); ss += __shfl_xor(ss, 32);
        const float rs = rsqrtf(ss * (1.f / 64) + EPS);
#pragma unroll
        for (int n = 0; n < 4; ++n) {
          const float4 g4 = *(const float4*)(gg + n * 16 + fq * 4);
          f32x4 v = acc[m][n];
          v[0] *= rs * g4.x; v[1] *= rs * g4.y; v[2] *= rs * g4.z; v[3] *= rs * g4.w;
          if (n == 0) {
#pragma unroll
            for (int j = 0; j < 4; ++j) {
              const float x = v[j], partner = __shfl_xor(x, 32);
              const int d = fq * 4 + j; const float2 cs2 = RN[t * 8 + (d & 7)];
              v[j] = (d < 8) ? (x * cs2.x - partner * cs2.y) : (partner * cs2.y + x * cs2.x);
            }
          }
          st_bf16x4(PROJ + t * DINP + nt * 128 + wc * 64 + n * 16 + fq * 4, v * sc);
        }
      }
    } else {
      GEMM_EPI4({ st_bf16x4(PROJ + (size_t)(mt * 128 + er) * DINP + nt * 128 + ec0, ev4); })
    }
  }
}

DEVI void phase_g2(const Params& p, int l, unsigned char* lds) {
  unsigned char* wl = p.ws + WS_W + l * WS_WL;
  const bf16_t* PROJ = (const bf16_t*)(p.ws + WS_B);
  bf16_t* QR = (bf16_t*)(p.ws + WS_D);
  bf16_t* KVR = QR + (size_t)T * 384;
  bf16_t* GATES = (bf16_t*)(p.ws + WS_E);
  bf16_t* MK = (bf16_t*)(p.ws + WS_F) + (size_t)T * 4 * 96;
  const float2* RM = (const float2*)(p.ws + WS_ROPE);
  constexpr int N_CMP = 32, N_QR = 256 * 3, N_KVR = 256 * 4, N_GT = 256 * 4;
  const int tid = threadIdx.x, wid = tid >> 6, lane = tid & 63, wr = wid >> 1, wc = wid & 1, fr = lane & 15, fq = lane >> 4;
  for (int it = vblock(); it < N_CMP + N_QR + N_KVR + N_GT; it += gridDim.x) {
    f32x4 acc[4][4];
    if (it < N_CMP) {
      const int kv = it & 1, mt = it >> 1;
      const bf16_t* W = (const bf16_t*)(wl + (kv ? W_1V : W_1K));
      const float* bias = (const float*)(wl + (kv ? W_B1V : W_B1K));
      bf16_t* H = (bf16_t*)(p.ws + (kv ? SM_HV : SM_HK));
      gemm128g(lds, 2048,
              [&](int r, int k) { const int m = mt * 128 + r, b = m >> 7; int c = m & 127; if (c > 126) c = 126;
                                  return PROJ + (size_t)(b * S + 16 * c + (k >> 6)) * DINP + C_KC + kv * 64 + (k & 63); },
              [&](int r, int k) { return W + (size_t)r * 2048 + k; }, acc);
      GEMM_EPI4({ f32x4 o; _Pragma("unroll") for (int j = 0; j < 4; ++j) o[j] = gelu_tanh(ev4[j] + bias[ec0 + j]); st_bf16x4(H + (size_t)(mt * 128 + er) * 128 + ec0, o); })
    } else if (it < N_CMP + N_QR) {
      const int i2 = it - N_CMP, mt = i2 / 3, nt = i2 % 3;
      const bf16_t* W = (const bf16_t*)(wl + W_UQ);
      gemm128g(lds, 192, [&](int r, int k) { return PROJ + (size_t)(mt * 128 + r) * DINP + C_CQ + k; }, [&](int r, int k) { return W + (size_t)(nt * 128 + r) * 192 + k; }, acc);
      GEMM_EPI4({ st_bf16x4(QR + (size_t)(mt * 128 + er) * 384 + nt * 128 + ec0, ev4); })
    } else if (it < N_CMP + N_QR + N_KVR) {
      const int i2 = it - N_CMP - N_QR, mt = i2 >> 2, hd = i2 & 3;
      const bf16_t* W = (const bf16_t*)(wl + W_UKV);
      gemm128g(lds, 128, [&](int r, int k) { return PROJ + (size_t)(mt * 128 + r) * DINP + C_CKV + k; }, [&](int r, int k) { return W + (size_t)(hd * 128 + r) * 128 + k; }, acc);
      const float* g_k = p.in[9] + l * 96;
#pragma unroll
      for (int m = 0; m < 4; ++m) {
        const size_t t = (size_t)mt * 128 + wr * 64 + m * 16 + fr;
        const int b = (int)(t >> 11), sq = (int)(t & (S - 1));
        float ss = 0.f;
        {
          const bf16_t* cr = PROJ + t * DINP + C_CKV + fq * 32;
#pragma unroll
          for (int q = 0; q < 4; ++q) { const u32x4 w = *(const u32x4*)(cr + q * 8);
#pragma unroll
            for (int e = 0; e < 4; ++e) { const float lo = __uint_as_float(w[e] << 16), hi = __uint_as_float(w[e] & 0xffff0000u); ss += lo * lo + hi * hi; } }
        }
        ss += __shfl_xor(ss, 16); ss += __shfl_xor(ss, 32);
        const float rskv = rsqrtf(ss * (1.f / 128) + EPS);
        if (wc == 1) {
#pragma unroll
          for (int n = 0; n < 4; ++n) st_bf16x4(KVR + t * 512 + hd * 128 + 64 + n * 16 + fq * 4, acc[m][n] * rskv);
        } else {
          const uint2 plo = *(const uint2*)(PROJ + t * DINP + C_KPE + 4 * fq), phi = *(const uint2*)(PROJ + t * DINP + C_KPE + 16 + 4 * fq);
          float pl[4] = {__uint_as_float(plo.x << 16), __uint_as_float(plo.x & 0xffff0000u), __uint_as_float(plo.y << 16), __uint_as_float(plo.y & 0xffff0000u)};
          float ph[4] = {__uint_as_float(phi.x << 16), __uint_as_float(phi.x & 0xffff0000u), __uint_as_float(phi.y << 16), __uint_as_float(phi.y & 0xffff0000u)};
          float sk = 0.f;
#pragma unroll
          for (int j = 0; j < 4; ++j) sk += pl[j] * pl[j] + ph[j] * ph[j];
          f32x4 kn[4];
#pragma unroll
          for (int n = 0; n < 4; ++n) { kn[n] = acc[m][n] * rskv; sk += kn[n][0] * kn[n][0] + kn[n][1] * kn[n][1] + kn[n][2] * kn[n][2] + kn[n][3] * kn[n][3]; }
          sk += __shfl_xor(sk, 16); sk += __shfl_xor(sk, 32);
          const float rsk = rsqrtf(sk * (1.f / 96) + EPS);
          bf16_t* dst = MK + ((size_t)(b * 4 + hd) * S + sq) * 96;
          f32x4 olo, ohi;
#pragma unroll
          for (int j = 0; j < 4; ++j) {
            const int d = 4 * fq + j; const float2 cs2 = RM[t * 16 + d];
            const float x1 = pl[j] * rsk * g_k[d], x2 = ph[j] * rsk * g_k[16 + d];
            olo[j] = x1 * cs2.x - x2 * cs2.y; ohi[j] = x1 * cs2.y + x2 * cs2.x;
          }
          st_bf16x4(dst + 4 * fq, olo); st_bf16x4(dst + 16 + 4 * fq, ohi);
#pragma unroll
          for (int n = 0; n < 4; ++n) { const float4 g4 = *(const float4*)(g_k + 32 + n * 16 + fq * 4); f32x4 o = kn[n] * rsk; o[0] *= g4.x; o[1] *= g4.y; o[2] *= g4.z; o[3] *= g4.w; st_bf16x4(dst + 32 + n * 16 + fq * 4, o); }
        }
      }
    } else {
      const int i2 = it - N_CMP - N_QR - N_KVR, mt = i2 >> 2, h = i2 & 3;
      const bf16_t* W = (const bf16_t*)(wl + W_LRU) + h * 128 * 64;
      const int c0 = h * 64 + (tid & 7) * 8;
      const float* cw = p.in[10] + l * 4 * 256 + c0; const float* cbp = p.in[11] + l * 256 + c0;
      gemm128(lds, 64,
              [&](int r, int k) {
                const size_t t = (size_t)mt * 128 + r; const int sq = (int)(t & (S - 1));
                float u[8];
#pragma unroll
                for (int e = 0; e < 8; ++e) u[e] = cbp[e];
#pragma unroll
                for (int j = 0; j < 4; ++j) {
                  if (sq - 3 + j >= 0) {
                    const u32x4 w = *(const u32x4*)(PROJ + (t - 3 + j) * DINP + C_LX + h * 64 + k);
#pragma unroll
                    for (int e = 0; e < 4; ++e) { u[2 * e] += __uint_as_float(w[e] << 16) * cw[j * 256 + 2 * e]; u[2 * e + 1] += __uint_as_float(w[e] & 0xffff0000u) * cw[j * 256 + 2 * e + 1]; }
                  }
                }
                u32x4 o; o[0] = pk2bf(u[0], u[1]); o[1] = pk2bf(u[2], u[3]); o[2] = pk2bf(u[4], u[5]); o[3] = pk2bf(u[6], u[7]);
                return o; },
              [&](int r, int k) { return W + (size_t)r * 64 + k; }, acc);
      GEMM_EPI4({ st_bf16x4(GATES + (size_t)(mt * 128 + er) * 512 + h * 128 + ec0, ev4); })
    }
  }
}

DEVI void lru_ab(float u, float rpre, float ipre, float sp, bool first, float& a, float& b) {
  const float r = sigmoidf_(rpre), gi = sigmoidf_(ipre);
  const float la = -8.f * r * sp;
  a = __expf(la);
  const float x = 2.f * la;
  const float om = (x > -0.1f) ? (-x * (1.f + 0.5f * x * (1.f + (1.f / 3.f) * x * (1.f + 0.25f * x * (1.f + 0.2f * x))))) : (1.f - a * a);
  const float mult = first ? 1.f : sqrtf(fmaxf(om, 0.f));
  b = mult * gi * u;
}
DEVI float lru_conv(const bf16_t* PROJ, int t, int s, int c, const float* cw, float cb) {
  float u = cb;
#pragma unroll
  for (int j = 0; j < 4; ++j) { const int ss2 = s - 3 + j; if (ss2 >= 0) u += bf2f(PROJ[(size_t)(t - 3 + j) * DINP + C_LX + c]) * cw[j * 256 + c]; }
  return u;
}

template <bool FULL>
DEVI void s5_chunk(const Params& p, int l, int b, int chunk, unsigned char* lds) {
  unsigned char* wl = p.ws + WS_W + l * WS_WL;
  const bf16_t* PROJ = (const bf16_t*)(p.ws + WS_B);
  const float2* Abar = (const float2*)(wl + W_S5A);
  const bf16_t* BB = (const bf16_t*)(wl + W_S5BB);
  const bf16_t* CM = (const bf16_t*)(wl + W_S5CM);
  float2* SLOC = (float2*)(p.ws + SM_SLOC);
  bf16_t* YCP = (bf16_t*)(p.ws + WS_F);
  const float* dd = p.in[24] + l * 256;
  const int tid = threadIdx.x, wv = tid >> 6, lane = tid & 63, r = lane & 31, h = lane >> 5, fr = lane & 15, fq = lane >> 4;
  unsigned* Hs = (unsigned*)(lds + wv * 8704);
  const int t0 = b * S + chunk * 64;
#pragma unroll 1
  for (int gi = 0; gi < 4; ++gi) {
    const int g = wv * 4 + gi;
    bf16x8 bbf[4];
#pragma unroll
    for (int nb = 0; nb < 4; ++nb) bbf[nb] = *(const bf16x8*)(BB + ((g * 4 + nb) * 32 + r) * 16 + 8 * h);
    float2 Ac[2]; float hr[2], hi[2];
#pragma unroll
    for (int sb = 0; sb < 2; ++sb) {
      Ac[sb] = Abar[g * 64 + sb * 32 + r];
      hr[sb] = 0.f; hi[sb] = 0.f;
      if (FULL) { const float2 cin = ((const float2*)(p.ws + SM_SCAR))[((size_t)(b * 32 + chunk) * 16 + g) * 64 + sb * 32 + r]; hr[sb] = cin.x; hi[sb] = cin.y; }
    }
    bf16x8 cm[4];
    float4 dcol4 = make_float4(0.f, 0.f, 0.f, 0.f);
    if (FULL) {
#pragma unroll
      for (int kk = 0; kk < 4; ++kk) cm[kk] = *(const bf16x8*)(CM + (size_t)(g * 16 + fr) * 128 + kk * 32 + 8 * fq);
      dcol4 = *(const float4*)(dd + g * 16 + 4 * fq);
    }
#pragma unroll 1
    for (int tb = 0; tb < 2; ++tb) {
      const bf16x8 ua = *(const bf16x8*)(PROJ + (size_t)(t0 + tb * 32 + r) * DINP + C_S5 + g * 16 + 8 * h);
      f32x16 acc[4];
#pragma unroll
      for (int nb = 0; nb < 4; ++nb) {
        f32x16 z;
#pragma unroll
        for (int i = 0; i < 16; ++i) z[i] = 0.f;
        acc[nb] = mfma32(ua, bbf[nb], z);
      }
#pragma unroll
      for (int sb = 0; sb < 2; ++sb) {
        float sr = hr[sb], si = hi[sb];
        const float ax = Ac[sb].x, ay = Ac[sb].y;
#pragma unroll
        for (int q = 0; q < 4; ++q)
#pragma unroll
          for (int owner = 0; owner < 2; ++owner) {
#pragma unroll
            for (int i = 0; i < 4; ++i) {
              const int reg = 4 * q + i;
              const float br = acc[2 * sb][reg], bi = acc[2 * sb + 1][reg];
              const float nr = ax * sr - ay * si + br, ni = ax * si + ay * sr + bi; sr = nr; si = ni;
              if (FULL) { acc[2 * sb][reg] = (h == owner) ? sr : br; acc[2 * sb + 1][reg] = (h == owner) ? si : bi; }
            }
            const float orr = __shfl_xor(sr, 32), oi = __shfl_xor(si, 32);
            if (h != owner) { sr = orr; si = oi; }
          }
        hr[sb] = sr; hi[sb] = si;
      }
      if (FULL) {
#pragma unroll
        for (int sb = 0; sb < 2; ++sb)
#pragma unroll
          for (int reg = 0; reg < 16; ++reg)
            Hs[crow(reg, h) * 68 + sb * 32 + r] = pk2bf(acc[2 * sb][reg], acc[2 * sb + 1][reg]);
#pragma unroll
        for (int tb16 = 0; tb16 < 2; ++tb16) {
          f32x4 y = (f32x4){0.f, 0.f, 0.f, 0.f};
#pragma unroll
          for (int kk = 0; kk < 4; ++kk) { const bf16x8 a = *(const bf16x8*)((const bf16_t*)Hs + (tb16 * 16 + fr) * 136 + kk * 32 + 8 * fq); y = mfma16(cm[kk], a, y); }
          const size_t t = (size_t)t0 + tb * 32 + tb16 * 16 + fr; const int col = g * 16 + 4 * fq;
          const uint2 uw = *(const uint2*)(PROJ + t * DINP + C_S5 + col);
          f32x4 o;
          o[0] = gelu_tanh(y[0] + dcol4.x * __uint_as_float(uw.x << 16)); o[1] = gelu_tanh(y[1] + dcol4.y * __uint_as_float(uw.x & 0xffff0000u));
          o[2] = gelu_tanh(y[2] + dcol4.z * __uint_as_float(uw.y << 16)); o[3] = gelu_tanh(y[3] + dcol4.w * __uint_as_float(uw.y & 0xffff0000u));
          st_bf16x4(YCP + t * 256 + col, o);
        }
      }
    }
    if (!FULL) {
#pragma unroll
      for (int sb = 0; sb < 2; ++sb) if (h == 0) SLOC[((size_t)(b * 32 + chunk) * 16 + g) * 64 + sb * 32 + r] = make_float2(hr[sb], hi[sb]);
    }
  }
}

template <bool FULL>
DEVI void lru_chunk(const Params& p, int l, int b, int chunk, float* tile) {
  const bf16_t* PROJ = (const bf16_t*)(p.ws + WS_B);
  const bf16_t* GATES = (const bf16_t*)(p.ws + WS_E);
  float2* LSUM = (float2*)(p.ws + SM_LSUM);
  const int c = threadIdx.x, h = c >> 6, j = c & 63;
  const float* cw = p.in[10] + l * 4 * 256;
  const float w0 = cw[c], w1 = cw[256 + c], w2 = cw[512 + c], w3 = cw[768 + c], cb = p.in[11][l * 256 + c];
  const float ba = p.in[13][l * 256 + c], bi = p.in[15][l * 256 + c];
  const float sp = log1pf(expf(-p.in[16][l * 256 + c]));
  const int s0 = chunk * 64; const size_t t0 = (size_t)b * S + s0;
  float xm3 = 0.f, xm2 = 0.f, xm1 = 0.f;
  if (s0 > 0) { xm3 = bf2f(PROJ[(t0 - 3) * DINP + C_LX + c]); xm2 = bf2f(PROJ[(t0 - 2) * DINP + C_LX + c]); xm1 = bf2f(PROJ[(t0 - 1) * DINP + C_LX + c]); }
  float hh = 0.f, ap = 1.f;
  if (FULL) hh = ((const float*)(p.ws + SM_LCAR))[(size_t)(b * 32 + chunk) * 256 + c];
#pragma unroll 1
  for (int k0 = 0; k0 < 64; k0 += 8) {
    float xv[8], rp[8], ip[8], gt[8];
#pragma unroll
    for (int i = 0; i < 8; ++i) {
      const size_t t = t0 + k0 + i;
      xv[i] = bf2f(PROJ[t * DINP + C_LX + c]);
      rp[i] = bf2f(GATES[t * 512 + h * 128 + j]); ip[i] = bf2f(GATES[t * 512 + h * 128 + 64 + j]);
      gt[i] = FULL ? bf2f(PROJ[t * DINP + C_LG + c]) : 0.f;
    }
#pragma unroll
    for (int i = 0; i < 8; ++i) {
      const float u = cb + xm3 * w0 + xm2 * w1 + xm1 * w2 + xv[i] * w3;
      xm3 = xm2; xm2 = xm1; xm1 = xv[i];
      float a, bb; lru_ab(u, rp[i] + ba, ip[i] + bi, sp, (s0 + k0 + i) == 0, a, bb);
      hh = a * hh + bb; ap *= a;
      if (FULL) tile[(k0 + i) * 256 + c] = hh * gelu_tanh(gt[i]);
    }
  }
  if (!FULL) LSUM[(size_t)(b * 32 + chunk) * 256 + c] = make_float2(ap, hh);
}

DEVI void phase_r2(const Params& p, int l, unsigned char* lds) {
  unsigned char* wl = p.ws + WS_W + l * WS_WL;
  const bf16_t* PROJ = (const bf16_t*)(p.ws + WS_B);
  const bf16_t* QR = (const bf16_t*)(p.ws + WS_D);
  const bf16_t* KVR = QR + (size_t)T * 384;
  const bf16_t* GATES = (const bf16_t*)(p.ws + WS_E);
  bf16_t* MQ = (bf16_t*)(p.ws + WS_F);
  bf16_t* MK = MQ + (size_t)T * 4 * 96;
  const float2* RM = (const float2*)(p.ws + WS_ROPE);
  const float2* RN = RM + (size_t)T * 16;
  const int tid = threadIdx.x, lane = tid & 63, wv = tid >> 6;
  for (int it = blockIdx.x; it < NB * 32; it += gridDim.x) lru_chunk<false>(p, l, it >> 5, it & 31, nullptr);
  __syncthreads();
  for (int it = blockIdx.x; it < NB * 32; it += gridDim.x) s5_chunk<false>(p, l, it >> 5, it & 31, lds);
  {
    const bf16_t* HK = (const bf16_t*)(p.ws + SM_HK); const bf16_t* HV = (const bf16_t*)(p.ws + SM_HV);
    bf16_t* KC = (bf16_t*)(p.ws + SM_KC); bf16_t* VC = (bf16_t*)(p.ws + SM_VC);
    const bf16_t* W2K = (const bf16_t*)(wl + W_2K); const bf16_t* W2V = (const bf16_t*)(wl + W_2V);
    const float* g0 = p.in[28] + l * 192;
    for (int it = blockIdx.x; it < 32; it += gridDim.x) {
      const int kv = it & 1, mt = it >> 1;
      const bf16_t* H = kv ? HV : HK; const bf16_t* W2 = kv ? W2V : W2K;
      f32x4 acc[4][4];
      __syncthreads();
      gemm128g(lds, 128, [&](int r, int k) { return H + (size_t)(mt * 128 + r) * 128 + k; }, [&](int r, int k) { return W2 + (size_t)(r & 63) * 128 + k; }, acc);
      const int wid = tid >> 6, wr = wid >> 1, wc = wid & 1, fr = lane & 15, fq = lane >> 4;
      if (wc == 0) {
#pragma unroll
        for (int m = 0; m < 4; ++m) {
          const int row = mt * 128 + wr * 64 + m * 16 + fr, b = row >> 7, c = row & 127;
          f32x4 v[4];
#pragma unroll
          for (int n = 0; n < 4; ++n) v[n] = acc[m][n];
          if (kv == 0) {
            float ss = 0.f;
#pragma unroll
            for (int n = 0; n < 4; ++n) ss += v[n][0] * v[n][0] + v[n][1] * v[n][1] + v[n][2] * v[n][2] + v[n][3] * v[n][3];
            ss += __shfl_xor(ss, 16); ss += __shfl_xor(ss, 32);
            const float rs = rsqrtf(ss * (1.f / 64) + EPS);
#pragma unroll
            for (int n = 0; n < 4; ++n) { const float4 gg = *(const float4*)(g0 + n * 16 + fq * 4); v[n][0] *= rs * gg.x; v[n][1] *= rs * gg.y; v[n][2] *= rs * gg.z; v[n][3] *= rs * gg.w; }
            const int cc = (c < 127) ? c : 126;
            const float2* cs = RN + (size_t)(b * S + 16 * cc + 31) * 8;
#pragma unroll
            for (int j = 0; j < 4; ++j) {
              const float x = v[0][j], partner = __shfl_xor(x, 32);
              const int d = fq * 4 + j; const float2 cs2 = cs[d & 7];
              v[0][j] = (d < 8) ? (x * cs2.x - partner * cs2.y) : (partner * cs2.y + x * cs2.x);
            }
          }
          bf16_t* dst = (kv ? VC : KC) + (size_t)row * 64;
#pragma unroll
          for (int n = 0; n < 4; ++n) { f32x4 o = v[n]; if (c >= 127) o = (f32x4){0.f, 0.f, 0.f, 0.f}; st_bf16x4(dst + n * 16 + fq * 4, o); }
        }
      }
    }
  }
}

typedef short v4i16_t __attribute__((ext_vector_type(4)));
DEVI float fexp2(float x) { return __builtin_amdgcn_exp2f(x); }
constexpr int VST = 96;
constexpr int ATT_VBYTES = 64 * VST * 2;
template <int DK> constexpr int att_kbytes() { return 64 * (DK + 8) * 2; }
template <int DK> constexpr int att_buf() { return att_kbytes<DK>() + ATT_VBYTES; }
template <int DK> struct TileRegs { u32x4 k[DK / 32]; u32x4 v[2]; };
template <int DK>
DEVI void tile_load(TileRegs<DK>& tr, const bf16_t* kbase, size_t kstride, const bf16_t* vbase, size_t vstride, int key0, bool withv = true) {
  constexpr int CH = DK / 8;
#pragma unroll
  for (int i = 0; i < DK / 32; ++i) { const int c = threadIdx.x + 256 * i, r = c / CH, cc = c % CH; tr.k[i] = *(const u32x4*)(kbase + (size_t)(key0 + r) * kstride + cc * 8); }
  if (withv) {
#pragma unroll
    for (int i = 0; i < 2; ++i) { const int c = threadIdx.x + 256 * i, r = c >> 3, cc = c & 7; tr.v[i] = *(const u32x4*)(vbase + (size_t)(key0 + r) * vstride + cc * 8); }
  }
}
template <int DK>
DEVI void tile_store(const TileRegs<DK>& tr, unsigned char* buf, bool withv = true) {
  constexpr int CH = DK / 8;
  bf16_t* sK = (bf16_t*)buf; bf16_t* sV = (bf16_t*)(buf + att_kbytes<DK>());
#pragma unroll
  for (int i = 0; i < DK / 32; ++i) { const int c = threadIdx.x + 256 * i, r = c / CH, cc = c % CH; *(u32x4*)(sK + r * (DK + 8) + cc * 8) = tr.k[i]; }
  if (withv) {
#pragma unroll
    for (int i = 0; i < 2; ++i) { const int c = threadIdx.x + 256 * i, r = c >> 3, cc = c & 7; *(u32x4*)(sV + r * VST + cc * 8) = tr.v[i]; }
  }
}
template <int DK>
DEVI void qk_tile(const bf16_t* sK, const bf16x8* qf, f32x16& s0, f32x16& s1, int r, int h) {
#pragma unroll
  for (int i = 0; i < 16; ++i) { s0[i] = 0.f; s1[i] = 0.f; }
#pragma unroll
  for (int kk = 0; kk < DK / 16; ++kk) {
    const bf16x8 a0 = *(const bf16x8*)(sK + r * (DK + 8) + kk * 16 + h * 8);
    const bf16x8 a1 = *(const bf16x8*)(sK + (32 + r) * (DK + 8) + kk * 16 + h * 8);
    s0 = mfma32(a0, qf[kk], s0);
    s1 = mfma32(a1, qf[kk], s1);
  }
}
struct FState { f32x16 o0, o1; float m, l; };
DEVI void fstate_init(FState& f) {
#pragma unroll
  for (int i = 0; i < 16; ++i) { f.o0[i] = 0.f; f.o1[i] = 0.f; }
  f.m = -INFINITY; f.l = 0.f;
}
DEVI v4i16_t vtr(const bf16_t* p) { return __builtin_amdgcn_ds_read_tr16_b64_v4i16((LAS v4i16_t*)p); }
DEVI void softmax_pv(FState& f, f32x16& s0, f32x16& s1, const bf16_t* sV, int lane) {
  const int h = lane >> 5;
  float mx = -INFINITY;
#pragma unroll
  for (int i = 0; i < 16; ++i) mx = fmaxf(mx, fmaxf(s0[i], s1[i]));
  mx = fmaxf(mx, __shfl_xor(mx, 32));
  const float mnew = fmaxf(f.m, mx);
  const float muse = (mnew == -INFINITY) ? 0.f : mnew;
  float ps = 0.f;
#pragma unroll
  for (int i = 0; i < 16; ++i) { s0[i] = fexp2(s0[i] - muse); s1[i] = fexp2(s1[i] - muse); ps += s0[i] + s1[i]; }
  ps += __shfl_xor(ps, 32);
  if (__any(mnew != f.m)) {
    const float alpha = fexp2(f.m - muse);
    f.l = f.l * alpha + ps; f.m = mnew;
#pragma unroll
    for (int i = 0; i < 16; ++i) { f.o0[i] *= alpha; f.o1[i] *= alpha; }
  } else {
    f.l += ps;
  }
  const int g = lane >> 4, li = lane & 15, q = li >> 2, pp = li & 3;
  const bf16_t* vb = sV + (4 * h + q) * VST + (g & 1) * 16 + 4 * pp;
#pragma unroll
  for (int kb = 0; kb < 2; ++kb)
#pragma unroll
    for (int s = 0; s < 2; ++s) {
      unsigned pw[4];
#pragma unroll
      for (int j = 0; j < 4; ++j) pw[j] = kb ? pk2bf(s1[8 * s + 2 * j], s1[8 * s + 2 * j + 1]) : pk2bf(s0[8 * s + 2 * j], s0[8 * s + 2 * j + 1]);
      const bf16x8 pb = __builtin_bit_cast(bf16x8, (u32x4){pw[0], pw[1], pw[2], pw[3]});
#pragma unroll
      for (int db = 0; db < 2; ++db) {
        const v4i16_t lo = vtr(vb + (kb * 32 + 16 * s) * VST + db * 32);
        const v4i16_t hi = vtr(vb + (kb * 32 + 16 * s + 8) * VST + db * 32);
        const bf16x8 a = {lo[0], lo[1], lo[2], lo[3], hi[0], hi[1], hi[2], hi[3]};
        if (db == 0) f.o0 = mfma32(a, pb, f.o0); else f.o1 = mfma32(a, pb, f.o1);
      }
    }
}
DEVI void store_o(bf16_t* orow, const f32x16& o0, const f32x16& o1, float sc, int h) {
#pragma unroll
  for (int g = 0; g < 4; ++g) {
    uint2 v0, v1;
    v0.x = pk2bf(o0[4 * g] * sc, o0[4 * g + 1] * sc); v0.y = pk2bf(o0[4 * g + 2] * sc, o0[4 * g + 3] * sc);
    v1.x = pk2bf(o1[4 * g] * sc, o1[4 * g + 1] * sc); v1.y = pk2bf(o1[4 * g + 2] * sc, o1[4 * g + 3] * sc);
    *(uint2*)(orow + 8 * g + 4 * h) = v0;
    *(uint2*)(orow + 32 + 8 * g + 4 * h) = v1;
  }
}

DEVI void mla_item(const Params& p, int l, int b, int hd, int qt, unsigned char* lds) {
  const bf16_t* MQ = (const bf16_t*)(p.ws + WS_F);
  const bf16_t* MK = MQ + (size_t)T * 4 * 96;
  const bf16_t* KVR = (const bf16_t*)(p.ws + WS_D) + (size_t)T * 384;
  bf16_t* YA = (bf16_t*)(p.ws + WS_C);
  const int tid = threadIdx.x, wv = tid >> 6, lane = tid & 63, r = lane & 31, h = lane >> 5;
  const int q0 = qt * 128 + wv * 32, tq = q0 + r;
  bf16x8 qf[6];
  {
    const bf16_t* qrow = (const bf16_t*)(p.ws + WS_D) + ((size_t)b * S + tq) * 384 + hd * 96;
    const float* g_q = p.in[8] + l * 96;
    float qv[6][8]; float ss = 0.f;
#pragma unroll
    for (int kk = 0; kk < 6; ++kk) {
      const u32x4 w = *(const u32x4*)(qrow + kk * 16 + h * 8);
#pragma unroll
      for (int e = 0; e < 4; ++e) { qv[kk][2 * e] = __uint_as_float(w[e] << 16); qv[kk][2 * e + 1] = __uint_as_float(w[e] & 0xffff0000u); ss += qv[kk][2 * e] * qv[kk][2 * e] + qv[kk][2 * e + 1] * qv[kk][2 * e + 1]; }
    }
    ss += __shfl_xor(ss, 32);
    const float rs = rsqrtf(ss * (1.f / 96) + EPS) * (0.10206207261596575f * LOG2E);
#pragma unroll
    for (int kk = 0; kk < 6; ++kk)
#pragma unroll
      for (int j = 0; j < 8; ++j) qv[kk][j] *= rs * g_q[kk * 16 + h * 8 + j];
    const float2* cs = (const float2*)(p.ws + WS_ROPE) + ((size_t)b * S + tq) * 16 + 8 * h;
#pragma unroll
    for (int j = 0; j < 8; ++j) { const float2 c2 = cs[j]; const float x1 = qv[0][j], x2 = qv[1][j]; qv[0][j] = x1 * c2.x - x2 * c2.y; qv[1][j] = x1 * c2.y + x2 * c2.x; }
#pragma unroll
    for (int kk = 0; kk < 6; ++kk) { const u32x4 w = {pk2bf(qv[kk][0], qv[kk][1]), pk2bf(qv[kk][2], qv[kk][3]), pk2bf(qv[kk][4], qv[kk][5]), pk2bf(qv[kk][6], qv[kk][7])}; qf[kk] = __builtin_bit_cast(bf16x8, w); }
  }
  FState f; fstate_init(f);
  const bf16_t* kbase = MK + (size_t)(b * 4 + hd) * S * 96;
  const bf16_t* vbase = KVR + (size_t)b * S * 512 + hd * 128 + 64;
  const int ntiles = 2 * qt + 2;
  TileRegs<96> tr;
  TileRegs<96> tr2;
  tile_load<96>(tr, kbase, 96, vbase, 512, 0);
  tile_load<96>(tr2, kbase, 96, vbase, 512, 64);
  __syncthreads();
  tile_store<96>(tr, lds);
  __syncthreads();
  auto compute = [&](int kt, unsigned char* cur) {
    if (kt * 64 <= q0 + 31) {
      f32x16 s0, s1;
      qk_tile<96>((const bf16_t*)cur, qf, s0, s1, r, h);
      if (kt * 64 + 63 > q0) {
        int rel = tq - kt * 64 - 4 * h; asm volatile("" : "+v"(rel));
#pragma unroll
        for (int i = 0; i < 16; ++i) { const int kk2 = (i & 3) + 8 * (i >> 2); if (kk2 > rel) s0[i] = -INFINITY; if (kk2 + 32 > rel) s1[i] = -INFINITY; }
      }
      softmax_pv(f, s0, s1, (const bf16_t*)(cur + att_kbytes<96>()), lane);
    }
  };
#pragma unroll 1
  for (int kt = 0; kt < ntiles; kt += 2) {
    if (kt + 2 < ntiles) tile_load<96>(tr, kbase, 96, vbase, 512, (kt + 2) * 64);
    compute(kt, lds);
    tile_store<96>(tr2, lds + att_buf<96>());
    __syncthreads();
    if (kt + 3 < ntiles) tile_load<96>(tr2, kbase, 96, vbase, 512, (kt + 3) * 64);
    compute(kt + 1, lds + att_buf<96>());
    if (kt + 2 < ntiles) tile_store<96>(tr, lds);
    __syncthreads();
  }
  store_o(YA + (size_t)(b * S + tq) * 256 + hd * 64, f.o0, f.o1, 1.f / f.l, h);
}

template <class KF, class BODY>
DEVI void nsa_stream(unsigned char* lds, const bf16_t* kbase, size_t kstride, const bf16_t* vbase, size_t vstride, bool withv, int nt, KF key0f, BODY body) {
  if (nt <= 0) return;
  TileRegs<64> tr;
  tile_load<64>(tr, kbase, kstride, vbase, vstride, key0f(0), withv);
  __syncthreads();
  tile_store<64>(tr, lds, withv);
  __syncthreads();
#pragma unroll 1
  for (int i = 0; i < nt; ++i) {
    unsigned char* cur = lds + (i & 1) * att_buf<64>();
    const bool more = i + 1 < nt;
    if (more) tile_load<64>(tr, kbase, kstride, vbase, vstride, key0f(i + 1), withv);
    body(i, cur);
    if (more) tile_store<64>(tr, lds + ((i + 1) & 1) * att_buf<64>(), withv);
    __syncthreads();
  }
}
DEVI void nsa_item(const Params& p, int l, int b, int qt, unsigned char* lds) {
  const bf16_t* PROJ = (const bf16_t*)(p.ws + WS_B);
  const bf16_t* KC = (const bf16_t*)(p.ws + SM_KC) + (size_t)b * 128 * 64;
  const bf16_t* VC = (const bf16_t*)(p.ws + SM_VC) + (size_t)b * 128 * 64;
  const int tid = threadIdx.x, wv = tid >> 6, lane = tid & 63, r = lane & 31, h = lane >> 5;
  float* psum = (float*)(lds + 2 * att_buf<64>());
  unsigned* selm = (unsigned*)(lds + 2 * att_buf<64>() + 16384);
  const int t0 = qt * 32, cur = t0 >> 6;
  const int ql = wv * 8 + (r >> 2), hd = r & 3, tq = t0 + ql;
  const size_t tg = (size_t)b * S + tq;
  bf16x8 qf[4];
#pragma unroll
  for (int kk = 0; kk < 4; ++kk) qf[kk] = *(const bf16x8*)(PROJ + tg * DINP + C_NQ + hd * 64 + kk * 16 + h * 8);
  f32x16 of0, of1;
#pragma unroll
  for (int i = 0; i < 16; ++i) { of0[i] = 0.f; of1[i] = 0.f; }
  const float g0 = sigmoidf_(bf2f(PROJ[tg * DINP + C_NG + hd * 3 + 0]));
  const float g1 = sigmoidf_(bf2f(PROJ[tg * DINP + C_NG + hd * 3 + 1]));
  const float g2 = sigmoidf_(bf2f(PROJ[tg * DINP + C_NG + hd * 3 + 2]));
  FState f; fstate_init(f);
  const int ncmp = (t0 + 31 < 31) ? 0 : (((t0 >> 4) >> 6) + 1);
  nsa_stream(lds, KC, 64, VC, 64, true, ncmp, [&](int i) { return i * 64; }, [&](int kt, unsigned char* buf) {
    f32x16 s0, s1;
    qk_tile<64>((const bf16_t*)buf, qf, s0, s1, r, h);
    int rel = ((tq - 31) >> 4) - kt * 64 - 4 * h; asm volatile("" : "+v"(rel));
#pragma unroll
    for (int i = 0; i < 16; ++i) { const int kk2 = (i & 3) + 8 * (i >> 2); if (kk2 > rel) s0[i] = -INFINITY; if (kk2 + 32 > rel) s1[i] = -INFINITY; }
    softmax_pv(f, s0, s1, (const bf16_t*)(buf + att_kbytes<64>()), lane);
  });
  {
    const float sc = (f.l > 0.f) ? g0 / f.l : 0.f;
#pragma unroll
    for (int i = 0; i < 16; ++i) { of0[i] += f.o0[i] * sc; of1[i] += f.o1[i] * sc; }
  }
  {
    const float muse = (f.m == -INFINITY) ? 0.f : f.m;
    const float il = (f.l > 0.f) ? 1.f / f.l : 0.f;
    if (ncmp < 2) {
#pragma unroll 1
      for (int i = tid; i < 32 * 128; i += NTHREADS) psum[i] = 0.f;
      __syncthreads();
    }
    nsa_stream(lds, KC, 64, VC, 64, false, ncmp, [&](int i) { return i * 64; }, [&](int kt, unsigned char* buf) {
      f32x16 s0, s1;
      qk_tile<64>((const bf16_t*)buf, qf, s0, s1, r, h);
      int rel = ((tq - 31) >> 4) - kt * 64 - 4 * h; asm volatile("" : "+v"(rel));
      int cb0 = kt * 64 + 4 * h; asm volatile("" : "+v"(cb0));
#pragma unroll
      for (int i = 0; i < 16; ++i) {
        const int kk2 = (i & 3) + 8 * (i >> 2); const int c = cb0 + kk2;
        float p0 = (kk2 > rel) ? 0.f : fexp2(s0[i] - muse) * il;
        float p1 = (kk2 + 32 > rel) ? 0.f : fexp2(s1[i] - muse) * il;
        p0 += __shfl_xor(p0, 1); p0 += __shfl_xor(p0, 2);
        p1 += __shfl_xor(p1, 1); p1 += __shfl_xor(p1, 2);
        if (hd == 0) { psum[ql * 128 + c] = p0; psum[ql * 128 + c + 32] = p1; }
      }
    });
  }
  __syncthreads();
#pragma unroll 1
  for (int itq = 0; itq < 4; ++itq) {
    const int q2 = wv * 8 + itq * 2 + (lane >> 5), j = lane & 31;
    const float* ps = psum + q2 * 128;
    float imp = 2.f * (ps[4 * j] + ps[4 * j + 1] + ps[4 * j + 2]) + ps[4 * j + 3];
    if (j > 0) imp += ps[4 * j - 1];
    const bool cand = (j >= 1) && (j <= cur - 2);
    int rank = 0;
    for (int jj = 0; jj < 32; ++jj) {
      const float v = __shfl(imp, (lane & 32) | jj);
      const bool cj = (jj >= 1) && (jj <= cur - 2);
      if (cj && (v > imp || (v == imp && jj < j))) ++rank;
    }
    const bool sel = cand && rank < 2;
    const unsigned long long bal = __ballot(sel);
    unsigned mk = (unsigned)(bal >> (32 * (lane >> 5)));
    mk |= 1u | (1u << cur); if (cur >= 1) mk |= (1u << (cur - 1));
    if (j == 0) selm[q2] = mk;
  }
  __syncthreads();
  unsigned blk_or = 0, wave_or = 0;
  for (int i = 0; i < 32; ++i) blk_or |= selm[i];
  for (int i = 0; i < 8; ++i) wave_or |= selm[wv * 8 + i];
  const unsigned mymask = selm[ql];
  fstate_init(f);
  {
    unsigned* tl = selm + 32;
    if (tid < 32 && ((blk_or >> tid) & 1u)) tl[__popc(blk_or & ((1u << tid) - 1u))] = tid;
    __syncthreads();
    const int nsel = __popc(blk_or);
    nsa_stream(lds, PROJ + (size_t)b * S * DINP + C_KS, DINP, PROJ + (size_t)b * S * DINP + C_VS, DINP, true, nsel,
      [&](int i) { return (int)tl[i] * 64; },
      [&](int i, unsigned char* buf) {
        const int jj = (int)tl[i];
        if ((wave_or >> jj) & 1u) {
          f32x16 s0, s1;
          qk_tile<64>((const bf16_t*)buf, qf, s0, s1, r, h);
          const bool on = (mymask >> jj) & 1u;
          int rel = on ? (tq - jj * 64 - 4 * h) : -1; asm volatile("" : "+v"(rel));
#pragma unroll
          for (int i2 = 0; i2 < 16; ++i2) { const int kk2 = (i2 & 3) + 8 * (i2 >> 2); if (kk2 > rel) s0[i2] = -INFINITY; if (kk2 + 32 > rel) s1[i2] = -INFINITY; }
          softmax_pv(f, s0, s1, (const bf16_t*)(buf + att_kbytes<64>()), lane);
        }
      });
    const float sc = (f.l > 0.f) ? g1 / f.l : 0.f;
#pragma unroll
    for (int i = 0; i < 16; ++i) { of0[i] += f.o0[i] * sc; of1[i] += f.o1[i] * sc; }
  }
  fstate_init(f);
  {
    int jlo = (t0 - 511) >> 6; if (jlo < 0) jlo = 0;
    nsa_stream(lds, PROJ + (size_t)b * S * DINP + C_KW, DINP, PROJ + (size_t)b * S * DINP + C_VW, DINP, true, cur - jlo + 1,
      [&](int i) { return (jlo + i) * 64; },
      [&](int i, unsigned char* buf) {
        const int j = jlo + i;
        f32x16 s0, s1;
        qk_tile<64>((const bf16_t*)buf, qf, s0, s1, r, h);
        if (j == cur || j * 64 < t0 + 31 - 511 + 64) {
          int rel = tq - j * 64 - 4 * h; asm volatile("" : "+v"(rel));
#pragma unroll
          for (int i2 = 0; i2 < 16; ++i2) {
            const int kk2 = (i2 & 3) + 8 * (i2 >> 2);
            if (kk2 > rel || kk2 < rel - 511) s0[i2] = -INFINITY;
            if (kk2 + 32 > rel || kk2 + 32 < rel - 511) s1[i2] = -INFINITY;
          }
        }
        softmax_pv(f, s0, s1, (const bf16_t*)(buf + att_kbytes<64>()), lane);
      });
    const float sc = (f.l > 0.f) ? g2 / f.l : 0.f;
#pragma unroll
    for (int i = 0; i < 16; ++i) { of0[i] += f.o0[i] * sc; of1[i] += f.o1[i] * sc; }
  }
  {
    float ss = 0.f;
#pragma unroll
    for (int i = 0; i < 16; ++i) ss += of0[i] * of0[i] + of1[i] * of1[i];
    ss += __shfl_xor(ss, 1); ss += __shfl_xor(ss, 2); ss += __shfl_xor(ss, 32);
    const float rs = rsqrtf(ss * (1.f / 256) + EPS);
    const float* on = p.in[35] + l * 1024 + 768 + hd * 64;
#pragma unroll
    for (int g4 = 0; g4 < 4; ++g4) {
      const float4 a = *(const float4*)(on + 8 * g4 + 4 * h), b4 = *(const float4*)(on + 32 + 8 * g4 + 4 * h);
      of0[4 * g4] *= a.x; of0[4 * g4 + 1] *= a.y; of0[4 * g4 + 2] *= a.z; of0[4 * g4 + 3] *= a.w;
      of1[4 * g4] *= b4.x; of1[4 * g4 + 1] *= b4.y; of1[4 * g4 + 2] *= b4.z; of1[4 * g4 + 3] *= b4.w;
    }
    store_o((bf16_t*)(p.ws + WS_A) + tg * 1024 + 768 + hd * 64, of0, of1, rs, h);
  }
}

DEVI void carry_item(const Params& p, int l, int it) {
  const int tid = threadIdx.x;
  if (it < 64) {
    const int idx = it * 256 + tid, b = idx >> 10, gs = idx & 1023;
    const float2 a64 = ((const float2*)(p.ws + WS_W + l * WS_WL + W_S5A64))[gs];
    const float2* SLOC = (const float2*)(p.ws + SM_SLOC) + (size_t)b * 32 * 1024 + gs;
    float2* SCAR = (float2*)(p.ws + SM_SCAR) + (size_t)b * 32 * 1024 + gs;
    float hr = 0.f, hi = 0.f;
#pragma unroll 1
    for (int c0 = 0; c0 < 32; c0 += 8) {
      float2 sl[8];
#pragma unroll
      for (int i = 0; i < 8; ++i) sl[i] = SLOC[(size_t)(c0 + i) * 1024];
#pragma unroll
      for (int i = 0; i < 8; ++i) { SCAR[(size_t)(c0 + i) * 1024] = make_float2(hr, hi); const float nr = a64.x * hr - a64.y * hi + sl[i].x, ni = a64.x * hi + a64.y * hr + sl[i].y; hr = nr; hi = ni; }
    }
  } else {
    const int idx = (it - 64) * 256 + tid, b = idx >> 8, c = idx & 255;
    const float2* LSUM = (const float2*)(p.ws + SM_LSUM) + (size_t)b * 32 * 256 + c;
    float* LCAR = (float*)(p.ws + SM_LCAR) + (size_t)b * 32 * 256 + c;
    float hh = 0.f;
#pragma unroll 1
    for (int c0 = 0; c0 < 32; c0 += 8) {
      float2 sv[8];
#pragma unroll
      for (int i = 0; i < 8; ++i) sv[i] = LSUM[(size_t)(c0 + i) * 256];
#pragma unroll
      for (int i = 0; i < 8; ++i) { LCAR[(size_t)(c0 + i) * 256] = hh; hh = sv[i].x * hh + sv[i].y; }
    }
  }
}
DEVI void phase_a1(const Params& p, int l, unsigned char* lds) {
  for (int it = blockIdx.x; it < 80; it += gridDim.x) carry_item(p, l, it);
  const int G_ = (int)gridDim.x;
  const int vb_ = vblock();
  for (int rr = 0;; ++rr) { const int j = rr * G_ + ((rr & 1) ? (G_ - 1 - vb_) : vb_); if (rr * G_ >= 1024) break; if (j < 1024) { const int b = j >> 6, qt = 63 - (j & 63); nsa_item(p, l, b, qt, lds); } }
  __syncthreads();
  for (int rr = 0;; ++rr) { const int j = rr * G_ + ((rr & 1) ? (G_ - 1 - vb_) : vb_); if (rr * G_ >= 1024) break; if (j < 1024) { const int bh = j >> 4, qt = 15 - (j & 15); mla_item(p, l, bh >> 2, bh & 3, qt, lds); } }
}

DEVI void phase_r3(const Params& p, int l, unsigned char* lds) {
  bf16_t* Y = (bf16_t*)(p.ws + WS_A);
  const int tid = threadIdx.x, lane = tid & 63, wv = tid >> 6;
  {
    const float* onorm = p.in[35] + l * 1024 + 256;
    float* tile = (float*)lds;
    for (int it = blockIdx.x; it < NB * 32; it += gridDim.x) {
      const int b = it >> 5, chunk = it & 31;
      __syncthreads();
      lru_chunk<true>(p, l, b, chunk, tile);
      __syncthreads();
      for (int k = wv; k < 64; k += 4) {
        const float4 v = *(const float4*)(tile + k * 256 + lane * 4);
        const float rs = rsqrtf(wsum(v.x * v.x + v.y * v.y + v.z * v.z + v.w * v.w) * (1.f / 256) + EPS);
        const size_t t = (size_t)b * S + chunk * 64 + k;
        const float4 gg = *(const float4*)(onorm + lane * 4);
        st_bf16x4(Y + t * 1024 + 256 + lane * 4, (f32x4){v.x * rs * gg.x, v.y * rs * gg.y, v.z * rs * gg.z, v.w * rs * gg.w});
      }
    }
  }
  __syncthreads();
  for (int it = blockIdx.x; it < NB * 32; it += gridDim.x) s5_chunk<true>(p, l, it >> 5, it & 31, lds);
}

DEVI void phase_g3(const Params& p, int l, unsigned char* lds) {
  const bf16_t* YCP = (const bf16_t*)(p.ws + WS_F);
  bf16_t* YC = (bf16_t*)(p.ws + WS_F) + (size_t)T * 256;
  const bf16_t* W = (const bf16_t*)(p.ws + WS_W + l * WS_WL + W_GLU);
  const float* bg = p.in[26] + l * 256;
  for (int it = vblock(); it < 256 * 2; it += gridDim.x) {
    const int mt = it >> 1, nt = it & 1;
    f32x4 acc[4][4];
    gemm128g(lds, 256, [&](int r, int k) { return YCP + (size_t)(mt * 128 + r) * 256 + k; }, [&](int r, int k) { return W + (size_t)(nt * 128 + r) * 256 + k; }, acc);
    GEMM_EPI4({ const size_t o = (size_t)(mt * 128 + er) * 256 + nt * 128 + ec0; const ushort4 yp = *(const ushort4*)(YCP + o); f32x4 r4; r4[0] = bf2f(yp.x) * sigmoidf_(ev4[0] + bg[nt * 128 + ec0]); r4[1] = bf2f(yp.y) * sigmoidf_(ev4[1] + bg[nt * 128 + ec0 + 1]); r4[2] = bf2f(yp.z) * sigmoidf_(ev4[2] + bg[nt * 128 + ec0 + 2]); r4[3] = bf2f(yp.w) * sigmoidf_(ev4[3] + bg[nt * 128 + ec0 + 3]); st_bf16x4(YC + o, r4); })
  }
}

DEVI void phase_r4(const Params& p, int l) {
  const bf16_t* YA = (const bf16_t*)(p.ws + WS_C);
  const bf16_t* YC = (const bf16_t*)(p.ws + WS_F) + (size_t)T * 256;
  bf16_t* Y = (bf16_t*)(p.ws + WS_A);
  const float* onorm = p.in[35] + l * 1024;
  const int lane = threadIdx.x & 63, gw = blockIdx.x * 4 + (threadIdx.x >> 6), NGW = gridDim.x * 4;
  for (int t = gw; t < T; t += NGW) {
#pragma unroll
    for (int grp = 0; grp < 2; ++grp) {
      const bf16_t* src = (grp == 0 ? YA : YC) + (size_t)t * 256;
      const int gcol = (grp == 0 ? 0 : 512);
      const ushort4 u = ((const ushort4*)src)[lane];
      const float v0 = bf2f(u.x), v1 = bf2f(u.y), v2 = bf2f(u.z), v3 = bf2f(u.w);
      const float rs = rsqrtf(wsum(v0 * v0 + v1 * v1 + v2 * v2 + v3 * v3) * (1.f / 256) + EPS);
      const float4 g = ((const float4*)(onorm + gcol))[lane];
      uint2 o; o.x = pk2bf(v0 * rs * g.x, v1 * rs * g.y); o.y = pk2bf(v2 * rs * g.z, v3 * rs * g.w);
      ((uint2*)(Y + (size_t)t * 1024 + gcol))[lane] = o;
    }
  }
}

DEVI void phase_g4(const Params& p, int l, unsigned char* lds) {
  const bf16_t* Y = (const bf16_t*)(p.ws + WS_A);
  const bf16_t* W = (const bf16_t*)(p.ws + WS_W + l * WS_WL + W_OUT);
  const float* xin = (l == 0) ? p.in[0] : p.out;
  float* out = p.out;
  int par = 0; bool staged = false;
  for (int it = vblock(); it < 256 * 8; it += gridDim.x) {
    const int mt = it >> 3, nt = it & 7;
    f32x4 acc[4][4], xr[4][4];
    {
      const int tid = threadIdx.x, wid = tid >> 6, lane = tid & 63, wr = wid >> 1, wc = wid & 1, fr = lane & 15, fq = lane >> 4;
#pragma unroll
      for (int m = 0; m < 4; ++m)
#pragma unroll
        for (int n = 0; n < 4; ++n) xr[m][n] = *(const f32x4*)(xin + (size_t)(mt * 128 + wr * 64 + m * 16 + fr) * D + nt * 128 + wc * 64 + n * 16 + fq * 4);
    }
    const int itn = it + (int)gridDim.x; const bool hn = itn < 256 * 8; const int mtn = itn >> 3, ntn = itn & 7;
    gemm128p(lds, D, [&](int r, int k) { return Y + (size_t)(mt * 128 + r) * D + k; }, [&](int r, int k) { return W + (size_t)(nt * 128 + r) * D + k; }, acc, par, staged, hn,
             [&](int r, int k) { return Y + (size_t)(mtn * 128 + r) * D + k; }, [&](int r, int k) { return W + (size_t)(ntn * 128 + r) * D + k; });
    staged = hn;
    GEMM_EPI4({ const size_t o = (size_t)(mt * 128 + er) * D + nt * 128 + ec0; *(f32x4*)(out + o) = xr[m][n] + ev4; })
  }
}

DEVI void phase_r5(const Params& p, int l, unsigned char* lds) {
  const float* x1 = p.out;
  bf16_t* XN = (bf16_t*)(p.ws + WS_A);
  const float* g = p.in[37] + l * D;
  const bf16_t* WH = (const bf16_t*)(p.ws + WS_W + l * WS_WL + W_RTH);
  const bf16_t* WL = (const bf16_t*)(p.ws + WS_W + l * WS_WL + W_RTL);
  const float* brg = p.in[39] + l * 4; const float* bre = p.in[41] + l * 16;
  int* CNT = (int*)(p.ws + SM_CNT) + l * 32;
  int* LIST = (int*)(p.ws + SM_LIST);
  float2* TOKW = (float2*)(p.ws + SM_TOKW);
  const int tid = threadIdx.x, lane = tid & 63, wv = tid >> 6, c = lane & 15, q = lane >> 4;
  float* red = (float*)lds;
  int* hist = (int*)(lds + 16384);
  int* tokl = (int*)(lds + 16384 + 256);
  if (tid < 64) hist[tid] = 0;
  int ntok = 0;
  __syncthreads();
  for (int it = blockIdx.x; it < T / 16; it += gridDim.x) {
    const size_t tb = (size_t)it * 16;
    f32x4 a0 = (f32x4){0.f, 0.f, 0.f, 0.f}, a1 = (f32x4){0.f, 0.f, 0.f, 0.f};
    float ss = 0.f;
    const float* xrow = x1 + (tb + c) * D + wv * 256 + 8 * q;
    const bf16_t* wh0 = WH + (size_t)c * 1024 + wv * 256 + 8 * q;
    const bf16_t* wl0 = WL + (size_t)c * 1024 + wv * 256 + 8 * q;
    float4 xk[8][2];
#pragma unroll
    for (int ks = 0; ks < 8; ++ks) { xk[ks][0] = *(const float4*)(xrow + ks * 32); xk[ks][1] = *(const float4*)(xrow + ks * 32 + 4); }
#pragma unroll
    for (int ks = 0; ks < 8; ++ks) {
      const bf16x8 wh_a = *(const bf16x8*)(wh0 + ks * 32), wl_a = *(const bf16x8*)(wl0 + ks * 32);
      const bf16x8 wh_b = *(const bf16x8*)(wh0 + 16 * 1024 + ks * 32), wl_b = *(const bf16x8*)(wl0 + 16 * 1024 + ks * 32);
      const float xv[8] = {xk[ks][0].x, xk[ks][0].y, xk[ks][0].z, xk[ks][0].w, xk[ks][1].x, xk[ks][1].y, xk[ks][1].z, xk[ks][1].w};
      u32x4 hw, lw;
#pragma unroll
      for (int j = 0; j < 4; ++j) {
        const float x0 = xv[2 * j], x1v = xv[2 * j + 1];
        ss += x0 * x0 + x1v * x1v;
        const unsigned hp = pk2bf(x0, x1v);
        hw[j] = hp; lw[j] = pk2bf(x0 - __uint_as_float(hp << 16), x1v - __uint_as_float(hp & 0xffff0000u));
      }
      const bf16x8 xh = __builtin_bit_cast(bf16x8, hw), xl = __builtin_bit_cast(bf16x8, lw);
      a0 = mfma16(wh_a, xh, a0); a0 = mfma16(wh_a, xl, a0); a0 = mfma16(wl_a, xh, a0);
      a1 = mfma16(wh_b, xh, a1); a1 = mfma16(wh_b, xl, a1); a1 = mfma16(wl_b, xh, a1);
    }
    ss += __shfl_xor(ss, 16); ss += __shfl_xor(ss, 32);
    __syncthreads();
#pragma unroll
    for (int j = 0; j < 4; ++j) { red[(wv * 9 + j) * 64 + lane] = a0[j]; red[(wv * 9 + 4 + j) * 64 + lane] = a1[j]; }
    red[(wv * 9 + 8) * 64 + lane] = ss;
    __syncthreads();
    const float s2 = red[8 * 64 + lane] + red[(9 + 8) * 64 + lane] + red[(18 + 8) * 64 + lane] + red[(27 + 8) * 64 + lane];
    const float rs = rsqrtf(s2 * (1.f / D) + EPS);
    {
      bf16_t* xo = XN + (tb + c) * D + wv * 256 + 8 * q;
      const float* gp = g + wv * 256 + 8 * q;
#pragma unroll
      for (int ks = 0; ks < 8; ++ks) {
        const float4 g0 = *(const float4*)(gp + ks * 32), g1 = *(const float4*)(gp + ks * 32 + 4);
        u32x4 o;
        o[0] = pk2bf(xk[ks][0].x * rs * g0.x, xk[ks][0].y * rs * g0.y); o[1] = pk2bf(xk[ks][0].z * rs * g0.z, xk[ks][0].w * rs * g0.w);
        o[2] = pk2bf(xk[ks][1].x * rs * g1.x, xk[ks][1].y * rs * g1.y); o[3] = pk2bf(xk[ks][1].z * rs * g1.z, xk[ks][1].w * rs * g1.w);
        *(u32x4*)(xo + ks * 32) = o;
      }
    }
    if (wv == 0) {
      float c0[4], c1[4];
#pragma unroll
      for (int j = 0; j < 4; ++j) {
        c0[j] = red[j * 64 + lane] + red[(9 + j) * 64 + lane] + red[(18 + j) * 64 + lane] + red[(27 + j) * 64 + lane];
        c1[j] = red[(4 + j) * 64 + lane] + red[(13 + j) * 64 + lane] + red[(22 + j) * 64 + lane] + red[(31 + j) * 64 + lane];
      }
      float lg[20];
#pragma unroll
      for (int qq = 0; qq < 4; ++qq)
#pragma unroll
        for (int j = 0; j < 4; ++j) lg[4 * qq + j] = __shfl(c0[j], c + 16 * qq);
#pragma unroll
      for (int j = 0; j < 4; ++j) lg[16 + j] = __shfl(c1[j], c);
      const int t = (int)tb + c;
      float gl[4];
#pragma unroll
      for (int k2 = 0; k2 < 4; ++k2) gl[k2] = lg[k2] * rs + brg[k2];
      int gi = 0; float gbest = gl[0];
#pragma unroll
      for (int k2 = 1; k2 < 4; ++k2) if (gl[k2] > gbest) { gbest = gl[k2]; gi = k2; }
      float den = 0.f;
#pragma unroll
      for (int k2 = 0; k2 < 4; ++k2) den += expf(gl[k2] - gbest);
      const float pg = 1.f / den;
      float le[4];
#pragma unroll
      for (int k2 = 0; k2 < 4; ++k2) { float sel = 0.f;
#pragma unroll
        for (int gg2 = 0; gg2 < 4; ++gg2) sel = (gi == gg2) ? (lg[4 + gg2 * 4 + k2] * rs + bre[gg2 * 4 + k2]) : sel;
        le[k2] = sel; }
      int i0 = 0; float l0 = le[0];
#pragma unroll
      for (int k2 = 1; k2 < 4; ++k2) if (le[k2] > l0) { l0 = le[k2]; i0 = k2; }
      int i1 = -1; float l1 = -INFINITY;
#pragma unroll
      for (int k2 = 0; k2 < 4; ++k2) if (k2 != i0 && le[k2] > l1) { l1 = le[k2]; i1 = k2; }
      const float e1 = expf(l1 - l0);
      const float w0 = pg / (1.f + e1), w1 = pg * e1 / (1.f + e1);
      const int elo = (i0 < i1) ? i0 : i1, ehi = (i0 < i1) ? i1 : i0;
      const float wlo = (i0 < i1) ? w0 : w1, whi = (i0 < i1) ? w1 : w0;
      const int pidx = (elo == 0) ? (ehi - 1) : ((elo == 1) ? (ehi + 1) : 5);
      const int cls = gi * 6 + pidx;
      if (q == 0) {
        const int rank = atomicAdd(&hist[cls], 1);
        tokl[2 * (ntok + c)] = t; tokl[2 * (ntok + c) + 1] = (cls << 16) | rank;
        TOKW[t] = make_float2(wlo, whi);
      }
    }
    ntok += 16;
  }
  __syncthreads();
  if (tid < 24) { const int n = hist[tid]; hist[32 + tid] = n ? atomicAdd(&CNT[tid], n) : 0; }
  __syncthreads();
  for (int i = tid; i < ntok; i += NTHREADS) { const int t = tokl[2 * i], cr = tokl[2 * i + 1], cls = cr >> 16; LIST[(size_t)cls * T + hist[32 + cls] + (cr & 0xffff)] = t; }
}

struct MoeItem { int cls, mtile, nt, cnt; };
DEVI void moe_prefix(const int* CNT, unsigned char* lds) {
  int* pre = (int*)(lds + LDS_BYTES + 64);
  __syncthreads();
  if (threadIdx.x < 24) pre[32 + threadIdx.x] = CNT[threadIdx.x];
  __syncthreads();
  if (threadIdx.x == 0) { int a = 0; for (int c = 0; c < 24; ++c) { pre[c] = a; a += (pre[32 + c] + 127) >> 7; } pre[24] = a; }
  __syncthreads();
}
DEVI bool moe_item(unsigned char* lds, int it, MoeItem& m) {
  const int* pre = (const int*)(lds + LDS_BYTES + 64);
  const int mt = it >> 3; m.nt = it & 7;
  if (mt >= pre[24]) return false;
  int c = 0;
#pragma unroll
  for (int q = 1; q < 24; ++q) c += (mt >= pre[q]) ? 1 : 0;
  m.cls = c; m.mtile = mt - pre[c]; m.cnt = pre[32 + c];
  return true;
}
DEVI void cls_experts(int cls, int& e0, int& e1) {
  const int g = cls / 6, pi = cls % 6;
  const int lo = (pi < 3) ? 0 : ((pi < 5) ? 1 : 2);
  const int hi = (pi < 3) ? (pi + 1) : ((pi < 5) ? (pi - 1) : 3);
  e0 = g * 4 + lo; e1 = g * 4 + hi;
}
DEVI void phase_g5(const Params& p, int l, unsigned char* lds) {
  const bf16_t* XN = (const bf16_t*)(p.ws + WS_A);
  bf16_t* HID = (bf16_t*)(p.ws + WS_B);
  const bf16_t* WGU = (const bf16_t*)(p.ws + WS_W + l * WS_WL + W_GU);
  const int* CNT = (const int*)(p.ws + SM_CNT) + l * 32;
  const int* LIST = (const int*)(p.ws + SM_LIST);
  const float2* TOKW = (const float2*)(p.ws + SM_TOKW);
  moe_prefix(CNT, lds);
  for (int it = vblock();; it += gridDim.x) {
    MoeItem mi; if (!moe_item(lds, it, mi)) break;
    int e0, e1; cls_experts(mi.cls, e0, e1);
    const int ex = (mi.nt < 4) ? e0 : e1, ntl = mi.nt & 3;
    const bf16_t* W = WGU + ((size_t)ex * 512 + ntl * 128) * 1024;
    const int* list = LIST + (size_t)mi.cls * T + mi.mtile * 128;
    const int nvalid = mi.cnt - mi.mtile * 128;
    f32x4 acc[4][4];
    int tokA[4], tokE[4]; float twE[4];
#pragma unroll
    for (int i = 0; i < 4; ++i) { const int r = (threadIdx.x >> 3) + 32 * i; tokA[i] = list[(r < nvalid) ? r : 0]; }
    {
      const int tid_ = threadIdx.x, er0 = ((tid_ >> 6) >> 1) * 64 + (tid_ & 15);
#pragma unroll
      for (int m = 0; m < 4; ++m) { const int er = er0 + m * 16; tokE[m] = list[(er < nvalid) ? er : 0]; }
#pragma unroll
      for (int m = 0; m < 4; ++m) { const float2 tw = TOKW[tokE[m]]; twE[m] = (mi.nt < 4) ? tw.x : tw.y; }
    }
    gemm128g(lds, D, [&](int r, int k) { const int i = r >> 5; const int tok = (i == 0) ? tokA[0] : (i == 1) ? tokA[1] : (i == 2) ? tokA[2] : tokA[3]; return XN + (size_t)tok * D + k; }, [&](int r, int k) { return W + (size_t)r * D + k; }, acc);
    {
      const int tid = threadIdx.x, wid = tid >> 6, lane = tid & 63, wr = wid >> 1, wc = wid & 1, fr = lane & 15, fq = lane >> 4;
#pragma unroll
      for (int m = 0; m < 4; ++m) {
        const int er = wr * 64 + m * 16 + fr;
        if (er < nvalid) {
          const int tok = tokE[m];
          const float w = twE[m];
#pragma unroll
          for (int n = 0; n < 2; ++n) {
            f32x4 hv;
#pragma unroll
            for (int j = 0; j < 4; ++j) { const float gt = acc[m][n][j], up = acc[m][n + 2][j]; hv[j] = gt * sigmoidf_(gt) * up * w; }
            const int hh = (mi.nt < 4 ? 0 : 256) + ntl * 64 + wc * 32 + n * 16 + fq * 4;
            st_bf16x4(HID + (size_t)tok * 512 + hh, hv);
          }
        }
      }
    }
  }
}
DEVI void phase_g6(const Params& p, int l, unsigned char* lds) {
  const bf16_t* HID = (const bf16_t*)(p.ws + WS_B);
  const bf16_t* WDN = (const bf16_t*)(p.ws + WS_W + l * WS_WL + W_DN);
  const int* CNT = (const int*)(p.ws + SM_CNT) + l * 32;
  const int* LIST = (const int*)(p.ws + SM_LIST);
  float* out = p.out;
  moe_prefix(CNT, lds);
  for (int it = vblock();; it += gridDim.x) {
    MoeItem mi; if (!moe_item(lds, it, mi)) break;
    int e0, e1; cls_experts(mi.cls, e0, e1);
    const int* list = LIST + (size_t)mi.cls * T + mi.mtile * 128;
    const int nvalid = mi.cnt - mi.mtile * 128;
    const bf16_t* W0 = WDN + ((size_t)e0 * 1024 + mi.nt * 128) * 256;
    const bf16_t* W1 = WDN + ((size_t)e1 * 1024 + mi.nt * 128) * 256;
    f32x4 acc[4][4];
    int trow[4], tokA[4];
    {
      const int tid = threadIdx.x, wid = tid >> 6, lane = tid & 63, wr = wid >> 1, fr = lane & 15;
#pragma unroll
      for (int i = 0; i < 4; ++i) { const int r = (tid >> 3) + 32 * i; tokA[i] = list[(r < nvalid) ? r : 0]; }
#pragma unroll
      for (int m = 0; m < 4; ++m) { const int er = wr * 64 + m * 16 + fr; trow[m] = list[(er < nvalid) ? er : 0]; }
    }
    gemm128g(lds, 512, [&](int r, int k) { const int i = r >> 5; const int tok = (i == 0) ? tokA[0] : (i == 1) ? tokA[1] : (i == 2) ? tokA[2] : tokA[3]; return HID + (size_t)tok * 512 + k; },
            [&](int r, int k) { return ((k < 256) ? W0 : W1) + (size_t)r * 256 + (k & 255); }, acc);
    GEMM_EPI4({ if (er < nvalid) { const size_t o = (size_t)trow[m] * D + mi.nt * 128 + ec0; const f32x4 xi = *(const f32x4*)(out + o); *(f32x4*)(out + o) = xi + ev4; } })
  }
}


#define XB_TMO      128
#define XB_XCNT(j)  (256  + 64 * (j))
#define XB_XSUB(j)  (1280 + 64 * (j))
#define XB_XGEN(j)  (2304 + 64 * (j))
#define XB_TOP      3328
#define XB_TOPGEN   3392
#define XCD_BAR_WORDS 3456
#define XB_SPIN_CAP (1u << 18)
DEVI unsigned xb_ld(unsigned* p)              { return __hip_atomic_load(p, __ATOMIC_RELAXED, __HIP_MEMORY_SCOPE_AGENT); }
DEVI unsigned xb_add(unsigned* p, unsigned v) { return __hip_atomic_fetch_add(p, v, __ATOMIC_RELAXED, __HIP_MEMORY_SCOPE_AGENT); }
DEVI unsigned xb_xcc_id() { return (unsigned)__builtin_amdgcn_s_getreg((3 << 11) | 20) & 0xFu; }
#define XB_SPIN(cond, bar) do { unsigned _sp = 0; while (cond) { __builtin_amdgcn_s_sleep(1); \
    if ((++_sp & 255u) == 0u) { if (xb_ld(&(bar)[XB_TMO])) break; if (_sp > XB_SPIN_CAP) { atomicAdd(&(bar)[XB_TMO], 1u); break; } } } } while (0)
struct XcdBarrier { unsigned* bar; unsigned x; volatile LAS unsigned* st; };
DEVI XcdBarrier xcd_barrier_post(unsigned* bar, volatile LAS unsigned* st) {
    XcdBarrier b; b.bar = bar; b.x = xb_xcc_id(); b.st = st;
    if (threadIdx.x == 0) (void)xb_add(&bar[XB_XCNT(b.x)], 1u);
    return b;
}
DEVI void xcd_barrier_complete(unsigned* bar, unsigned x, unsigned& nloc, unsigned& nx) {
    const unsigned G = gridDim.x * gridDim.y * gridDim.z;
    unsigned sum, cnt, mine, sp = 0u;
    for (;;) {
        sum = 0u; cnt = 0u; mine = 0u;
#pragma unroll
        for (unsigned j = 0; j < 16; ++j) { const unsigned c = xb_ld(&bar[XB_XCNT(j)]); sum += c; cnt += (c > 0u) ? 1u : 0u; mine = (j == x) ? c : mine; }
        if (sum == G) break;
        __builtin_amdgcn_s_sleep(1);
        if ((++sp & 255u) == 0u) { if (xb_ld(&bar[XB_TMO])) break; if (sp > XB_SPIN_CAP) { atomicAdd(&bar[XB_TMO], 1u); break; } }
    }
    nloc = mine > 0u ? mine : 1u; nx = cnt > 0u ? cnt : 1u;
}
DEVI void xcd_barrier(const XcdBarrier& b) {
    asm volatile("s_waitcnt vmcnt(0)" ::: "memory");
    __syncthreads();
    if (threadIdx.x == 0) {
        unsigned* bar = b.bar;
        __builtin_amdgcn_s_waitcnt(0);
        unsigned nloc = b.st[0], nx = b.st[1];
        if (nloc == 0u) { xcd_barrier_complete(bar, b.x, nloc, nx); b.st[0] = nloc; b.st[1] = nx; }
        const unsigned old = xb_add(&bar[XB_XSUB(b.x)], 1u);
        const unsigned gen = old / nloc;
        if (old + 1u == (gen + 1u) * nloc) {
            __builtin_amdgcn_fence(__ATOMIC_RELEASE, "agent");
            asm volatile("s_waitcnt vmcnt(0)" ::: "memory");
            const unsigned og = xb_add(&bar[XB_TOP], 1u);
            const unsigned tg = og / nx;
            if (og + 1u == (tg + 1u) * nx) xb_add(&bar[XB_TOPGEN], 1u);
            else XB_SPIN(xb_ld(&bar[XB_TOPGEN]) == tg, bar);
            __builtin_amdgcn_fence(__ATOMIC_ACQUIRE, "agent");
            xb_add(&bar[XB_XGEN(b.x)], 1u);
            asm volatile("s_waitcnt vmcnt(0)" ::: "memory");
        } else {
            XB_SPIN(xb_ld(&bar[XB_XGEN(b.x)]) == gen, bar);
            __builtin_amdgcn_fence(__ATOMIC_ACQUIRE, "agent");
            asm volatile("s_waitcnt vmcnt(0)" ::: "memory");
        }
    }
    __syncthreads();
}

#define PH(k, call) { const int _k = (k); if (p.lo <= _k && _k < p.hi) { call; if (_k + 1 < p.hi) { if (_k == 0) grid.sync(); else xcd_barrier(xbar); } } }
__global__ void __launch_bounds__(NTHREADS, 2) hybrid_fwd(Params p) {
  extern __shared__ __attribute__((aligned(16))) unsigned char lds[];
  cg::grid_group grid = cg::this_grid();
  volatile LAS unsigned* xst = (volatile LAS unsigned*)(LAS unsigned char*)(lds + LDS_BYTES);
  if (threadIdx.x < 4) xst[threadIdx.x] = 0u;
  __syncthreads();
  XcdBarrier xbar = xcd_barrier_post((unsigned*)(p.ws + WS_CTL), xst);
  PH(0, phase_prep(p, lds))
#define LAYER(l) { \
    PH(1 + 13 * l + 0, phase_g1(p, l, lds)) \
    PH(1 + 13 * l + 2, phase_g2(p, l, lds)) \
    PH(1 + 13 * l + 3, phase_r2(p, l, lds)) \
    PH(1 + 13 * l + 4, phase_a1(p, l, lds)) \
    PH(1 + 13 * l + 5, phase_r3(p, l, lds)) \
    PH(1 + 13 * l + 6, phase_g3(p, l, lds)) \
    PH(1 + 13 * l + 7, phase_r4(p, l)) \
    PH(1 + 13 * l + 8, phase_g4(p, l, lds)) \
    PH(1 + 13 * l + 9, phase_r5(p, l, lds)) \
    PH(1 + 13 * l + 10, phase_g5(p, l, lds)) \
    PH(1 + 13 * l + 11, phase_g6(p, l, lds)) }
  LAYER(0)
  PH(13, rmsnorm_rows(p.out, p.in[2] + D, (bf16_t*)(p.ws + WS_A)))
  LAYER(1)
}

extern "C" void kernel_launch(void* const* d_in, const int* in_sizes, int n_in, void* d_out, int out_size, void* d_ws, size_t ws_size, hipStream_t stream) {
  static int grid_blocks = 0;
  if (!grid_blocks) {
    if (n_in != 45 || ws_size < WS_END) { fprintf(stderr, "kernel_launch: unexpected n_in %d or ws_size %zu (< %zu)\n", n_in, ws_size, (size_t)WS_END); grid_blocks = -1; return; }
    int dev = 0, cus = 0, per_cu = 0;
    hipGetDevice(&dev);
    hipDeviceGetAttribute(&cus, hipDeviceAttributeMultiprocessorCount, dev);
    hipFuncSetAttribute((const void*)hybrid_fwd, hipFuncAttributeMaxDynamicSharedMemorySize, LDS_ALLOC);
    hipOccupancyMaxActiveBlocksPerMultiprocessor(&per_cu, (const void*)hybrid_fwd, NTHREADS, LDS_ALLOC);
    if (per_cu < 1) per_cu = 1;
    if (per_cu > 2) per_cu = 2;
    grid_blocks = cus * per_cu;
    fprintf(stderr, "kernel_launch: cus %d per_cu %d grid %d\n", cus, per_cu, grid_blocks);
  }
  if (grid_blocks < 0) return;
  (void)hipMemsetAsync((unsigned char*)d_ws + WS_CTL, 0, XCD_BAR_WORDS * 4, stream);
  Params p{};
  for (int i = 0; i < 45; ++i) p.in[i] = (const float*)d_in[i];
  p.out = (float*)d_out; p.ws = (unsigned char*)d_ws;
#if N_LAUNCH_MODE == 1
  p.lo = 0; p.hi = NPH;
  { void* args[] = {&p}; hipError_t e = hipLaunchCooperativeKernel((void*)hybrid_fwd, dim3(grid_blocks), dim3(NTHREADS), args, LDS_ALLOC, stream);
    if (e != hipSuccess) fprintf(stderr, "cooperative launch failed: %s\n", hipGetErrorString(e)); }
#else
  for (int ph = 0; ph < NPH; ++ph) {
    p.lo = ph; p.hi = ph + 1;
    void* args[] = {&p}; hipError_t e = hipLaunchCooperativeKernel((void*)hybrid_fwd, dim3(grid_blocks), dim3(NTHREADS), args, LDS_ALLOC, stream);
    if (e != hipSuccess) { fprintf(stderr, "launch %d failed: %s\n", ph, hipGetErrorString(e)); break; }
  }
#endif
}
```

```cpp
#include <hip/hip_runtime.h>
#include <hip/hip_cooperative_groups.h>
#include <cstdio>
#include <cstdint>
namespace cg = cooperative_groups;

#ifndef N_LAUNCH_MODE
#define N_LAUNCH_MODE 1
#endif

#define DEVI __device__ __forceinline__
typedef unsigned short bf16_t;
typedef short bf16x8 __attribute__((ext_vector_type(8)));
typedef float f32x4 __attribute__((ext_vector_type(4)));
typedef float f32x16 __attribute__((ext_vector_type(16)));
typedef unsigned u32x4 __attribute__((ext_vector_type(4)));
#define LAS __attribute__((address_space(3)))

constexpr int NB = 16, S = 2048, T = NB * S, D = 1024, DIN = 1772, DINP = 1792, NL = 2;
constexpr int C_CQ = 0, C_KPE = 192, C_NG = 224, C_CKV = 256, C_LX = 384, C_LG = 640, C_S5 = 896, C_NQ = 1152, C_KS = 1408, C_KW = 1472, C_KC = 1536, C_VC = 1600, C_VS = 1664, C_VW = 1728;
__host__ __device__ constexpr int colmap(int n) {
  if (n < 192) return n;
  if (n < 320) return C_CKV + (n - 192);
  if (n < 352) return C_KPE + (n - 320);
  if (n < 608) return C_LX + (n - 352);
  if (n < 864) return C_LG + (n - 608);
  if (n < 1120) return C_S5 + (n - 864);
  if (n < 1376) return C_NQ + (n - 1120);
  if (n < 1760) { const int j = n - 1376, part = j >> 6, d = j & 63; return (part == 0 ? C_KC : part == 1 ? C_VC : part == 2 ? C_KS : part == 3 ? C_VS : part == 4 ? C_KW : C_VW) + d; }
  return C_NG + (n - 1760);
}
constexpr float EPS = 1e-6f;
constexpr float LOG2E = 1.4426950408889634f;
constexpr int NTHREADS = 256;
constexpr int NPH = 1 + 13 * NL - 1;

constexpr size_t MiB = 1u << 20;
constexpr size_t WS_CTL = 0;
constexpr size_t WS_SMALL = 1 * MiB;
constexpr size_t WS_W = 16 * MiB;
constexpr size_t WS_WL = 32 * MiB;
constexpr size_t WS_A = 80 * MiB;
constexpr size_t WS_B = 144 * MiB;
constexpr size_t WS_C = 256 * MiB;
constexpr size_t WS_D = 292 * MiB;
constexpr size_t WS_E = 348 * MiB;
constexpr size_t WS_F = 380 * MiB;
constexpr size_t WS_G = 428 * MiB;
constexpr size_t WS_ROPE = 452 * MiB;
constexpr size_t WS_END = 460 * MiB;
constexpr size_t W_IN = 0;
constexpr size_t W_OUT = 4 * MiB;
constexpr size_t W_UQ = 6 * MiB;
constexpr size_t W_UKV = W_UQ + 384 * 192 * 2;
constexpr size_t W_LRU = W_UKV + 512 * 128 * 2;
constexpr size_t W_GLU = W_LRU + 4 * 128 * 64 * 2;
constexpr size_t W_1K = 6 * MiB + 512 * 1024;
constexpr size_t W_1V = W_1K + 128 * 2048 * 2;
constexpr size_t W_B1K = W_1V + 128 * 2048 * 2;
constexpr size_t W_B1V = W_B1K + 512;
constexpr size_t W_S5A = W_B1V + 512;
constexpr size_t W_S5A64 = W_S5A + 16 * 64 * 8;
constexpr size_t W_S5B = W_S5A64 + 16 * 64 * 8;
constexpr size_t W_S5BB = W_S5B + 16 * 64 * 16 * 8;
constexpr size_t W_S5CM = W_S5BB + 16 * 4 * 32 * 16 * 2;
constexpr size_t W_2K = W_S5CM + 16 * 16 * 128 * 2;
constexpr size_t W_2V = W_2K + 64 * 128 * 2;
static_assert(W_2V + 64 * 128 * 2 <= 8 * MiB, "weights overflow");
constexpr size_t W_RTH = W_2V + 64 * 128 * 2;
constexpr size_t W_RTL = W_RTH + 32 * 1024 * 2;
static_assert(W_RTL + 32 * 1024 * 2 <= 8 * MiB, "weights overflow 2");
constexpr size_t W_GU = 8 * MiB;
constexpr size_t W_DN = 24 * MiB;
constexpr size_t SM_CNT = WS_SMALL;
constexpr size_t SM_LIST = WS_SMALL + 4096;
constexpr size_t SM_TOKW = SM_LIST + 24 * (size_t)T * 4;
constexpr size_t SM_LSUM = SM_TOKW + (size_t)T * 8;
constexpr size_t SM_SLOC = SM_LSUM + 16 * 32 * 256 * 8;
constexpr size_t SM_HK = SM_SLOC + 16 * 32 * 1024 * 8;
constexpr size_t SM_HV = SM_HK + 2048 * 128 * 2;
constexpr size_t SM_KC = SM_HV + 2048 * 128 * 2;
constexpr size_t SM_VC = SM_KC + 16 * 128 * 64 * 2;
constexpr size_t SM_SCAR = SM_VC + 16 * 128 * 64 * 2;
constexpr size_t SM_LCAR = SM_SCAR + 16 * 32 * 1024 * 8;
constexpr size_t SM_END = SM_LCAR + 16 * 32 * 256 * 4;
static_assert(SM_END <= WS_W, "small region overflow");

constexpr int LDS_BYTES = 65536;
constexpr int LDS_ALLOC = LDS_BYTES + 512;

struct Params {
  const float* in[45];
  float* out;
  unsigned char* ws;
  int lo, hi;
};

DEVI float bf2f(bf16_t v) { return __uint_as_float(((unsigned)v) << 16); }
DEVI bf16_t f2bf(float f) { unsigned u = __float_as_uint(f); return (bf16_t)((u + 0x7fffu + ((u >> 16) & 1u)) >> 16); }
DEVI float wsum(float v) {
#pragma unroll
  for (int o = 32; o >= 1; o >>= 1) v += __shfl_xor(v, o);
  return v;
}
DEVI float sigmoidf_(float x) { return __builtin_amdgcn_rcpf(1.f + __expf(-x)); }
DEVI float gelu_tanh(float x) { const float u2 = 1.5957691216057308f * (x + 0.044715f * x * x * x); return x * __builtin_amdgcn_rcpf(1.f + __expf(-u2)); }
DEVI f32x16 mfma32(bf16x8 a, bf16x8 b, f32x16 c) { return __builtin_amdgcn_mfma_f32_32x32x16_bf16(a, b, c, 0, 0, 0); }
DEVI f32x4 mfma16(bf16x8 a, bf16x8 b, f32x4 c) { return __builtin_amdgcn_mfma_f32_16x16x32_bf16(a, b, c, 0, 0, 0); }
DEVI int vblock() { const int G = (int)gridDim.x, bx = (int)blockIdx.x; return (G % 8 == 0) ? (bx % 8) * (G / 8) + bx / 8 : bx; }
DEVI int crow(int r, int h) { return (r & 3) + 8 * (r >> 2) + 4 * h; }
typedef __bf16 bf16x2_t __attribute__((ext_vector_type(2)));
typedef float f32x2_t __attribute__((ext_vector_type(2)));
DEVI unsigned pk2bf(float lo, float hi) { f32x2_t v = {lo, hi}; bf16x2_t b = __builtin_convertvector(v, bf16x2_t); return __builtin_bit_cast(unsigned, b); }

template <class AF, class BF>
DEVI void gemm128(unsigned char* lds, int K, AF aload, BF bptr, f32x4 (&acc)[4][4]) {
  const int tid = threadIdx.x, wid = tid >> 6, lane = tid & 63, wr = wid >> 1, wc = wid & 1, fr = lane & 15, fq = lane >> 4;
#pragma unroll
  for (int m = 0; m < 4; ++m)
#pragma unroll
    for (int n = 0; n < 4; ++n) acc[m][n] = (f32x4){0.f, 0.f, 0.f, 0.f};
  const int lr = tid >> 3, ch = tid & 7;
  const int wofs = lr * 128 + ((ch ^ ((lr >> 1) & 7)) * 16);
  const int sw = (fr >> 1) & 7;
  const int aro = (wr * 64 + fr) * 128, bro = (wc * 64 + fr) * 128;
  const int nk = K >> 6;
  u32x4 ra[4], rb[4];
#pragma unroll
  for (int i = 0; i < 4; ++i) { ra[i] = aload(lr + 32 * i, ch * 8); rb[i] = *(const u32x4*)bptr(lr + 32 * i, ch * 8); }
  __syncthreads();
#pragma unroll
  for (int i = 0; i < 4; ++i) { *(u32x4*)(lds + wofs + i * 4096) = ra[i]; *(u32x4*)(lds + 16384 + wofs + i * 4096) = rb[i]; }
  __syncthreads();
  for (int kt = 0; kt < nk; ++kt) {
    const bool more = (kt + 1 < nk);
    if (more) {
      const int k = (kt + 1) * 64 + ch * 8;
#pragma unroll
      for (int i = 0; i < 4; ++i) { ra[i] = aload(lr + 32 * i, k); rb[i] = *(const u32x4*)bptr(lr + 32 * i, k); }
    }
    const unsigned char* bufA = lds + (kt & 1) * 32768;
    const unsigned char* bufB = bufA + 16384;
#pragma unroll
    for (int kk = 0; kk < 2; ++kk) {
      bf16x8 At[4], Bt[4];
      const int co = ((kk * 4 + fq) ^ sw) * 16;
#pragma unroll
      for (int m = 0; m < 4; ++m) At[m] = *(const bf16x8*)(bufA + aro + m * 2048 + co);
#pragma unroll
      for (int n = 0; n < 4; ++n) Bt[n] = *(const bf16x8*)(bufB + bro + n * 2048 + co);
#pragma unroll
      for (int m = 0; m < 4; ++m)
#pragma unroll
        for (int n = 0; n < 4; ++n) acc[m][n] = mfma16(Bt[n], At[m], acc[m][n]);
    }
    if (more) {
      unsigned char* nb = lds + ((kt + 1) & 1) * 32768;
#pragma unroll
      for (int i = 0; i < 4; ++i) { *(u32x4*)(nb + wofs + i * 4096) = ra[i]; *(u32x4*)(nb + 16384 + wofs + i * 4096) = rb[i]; }
    }
    __syncthreads();
  }
}
template <class AF, class BF>
DEVI void gemm128g(unsigned char* lds, int K, AF aptr, BF bptr, f32x4 (&acc)[4][4]) {
  const int tid = threadIdx.x, wid = tid >> 6, lane = tid & 63, wr = wid >> 1, wc = wid & 1, fr = lane & 15, fq = lane >> 4;
#pragma unroll
  for (int m = 0; m < 4; ++m)
#pragma unroll
    for (int n = 0; n < 4; ++n) acc[m][n] = (f32x4){0.f, 0.f, 0.f, 0.f};
  const int lr = tid >> 3;
  const int chs = ((tid & 7) ^ ((lr >> 1) & 7)) * 8;
  const int sw = (fr >> 1) & 7;
  const int aro = (wr * 64 + fr) * 128, bro = (wc * 64 + fr) * 128;
  const int nk = K >> 6;
  LAS unsigned char* l3 = (LAS unsigned char*)lds;
#define G128_STAGE(buf, kbase)                                                                                                   \
  _Pragma("unroll") for (int i = 0; i < 4; ++i) {                                                                                 \
    __builtin_amdgcn_global_load_lds((const __attribute__((address_space(1))) unsigned*)aptr(lr + 32 * i, (kbase) + chs),          \
                                     (LAS unsigned*)(l3 + (buf) * 32768 + tid * 16 + i * 4096), 16, 0, 0);                           \
    __builtin_amdgcn_global_load_lds((const __attribute__((address_space(1))) unsigned*)bptr(lr + 32 * i, (kbase) + chs),          \
                                     (LAS unsigned*)(l3 + (buf) * 32768 + 16384 + tid * 16 + i * 4096), 16, 0, 0);                   \
  }
  __syncthreads();
  G128_STAGE(0, 0)
  asm volatile("s_waitcnt vmcnt(0)" ::: "memory");
  __syncthreads();
  for (int kt = 0; kt < nk; ++kt) {
    if (kt + 1 < nk) { G128_STAGE((kt + 1) & 1, (kt + 1) * 64) }
    const unsigned char* bufA = lds + (kt & 1) * 32768;
    const unsigned char* bufB = bufA + 16384;
#pragma unroll
    for (int kk = 0; kk < 2; ++kk) {
      bf16x8 At[4], Bt[4];
      const int co = ((kk * 4 + fq) ^ sw) * 16;
#pragma unroll
      for (int m = 0; m < 4; ++m) At[m] = *(const bf16x8*)(bufA + aro + m * 2048 + co);
#pragma unroll
      for (int n = 0; n < 4; ++n) Bt[n] = *(const bf16x8*)(bufB + bro + n * 2048 + co);
#pragma unroll
      for (int m = 0; m < 4; ++m)
#pragma unroll
        for (int n = 0; n < 4; ++n) acc[m][n] = mfma16(Bt[n], At[m], acc[m][n]);
    }
    asm volatile("s_waitcnt vmcnt(0)" ::: "memory");
    __syncthreads();
  }
#undef G128_STAGE
}
template <class AF, class BF, class AF2, class BF2>
DEVI void gemm128p(unsigned char* lds, int K, AF aptr, BF bptr, f32x4 (&acc)[4][4], int& par, bool staged, bool has_next, AF2 naptr, BF2 nbptr) {
  const int tid = threadIdx.x, wid = tid >> 6, lane = tid & 63, wr = wid >> 1, wc = wid & 1, fr = lane & 15, fq = lane >> 4;
#pragma unroll
  for (int m = 0; m < 4; ++m)
#pragma unroll
    for (int n = 0; n < 4; ++n) acc[m][n] = (f32x4){0.f, 0.f, 0.f, 0.f};
  const int lr = tid >> 3;
  const int chs = ((tid & 7) ^ ((lr >> 1) & 7)) * 8;
  const int sw = (fr >> 1) & 7;
  const int aro = (wr * 64 + fr) * 128, bro = (wc * 64 + fr) * 128;
  const int nk = K >> 6;
  LAS unsigned char* l3 = (LAS unsigned char*)lds;
#define GP_STAGE(buf, kbase, AP, BP)                                                                                             \
  _Pragma("unroll") for (int i = 0; i < 4; ++i) {                                                                                 \
    __builtin_amdgcn_global_load_lds((const __attribute__((address_space(1))) unsigned*)AP(lr + 32 * i, (kbase) + chs),            \
                                     (LAS unsigned*)(l3 + (buf) * 32768 + tid * 16 + i * 4096), 16, 0, 0);                           \
    __builtin_amdgcn_global_load_lds((const __attribute__((address_space(1))) unsigned*)BP(lr + 32 * i, (kbase) + chs),            \
                                     (LAS unsigned*)(l3 + (buf) * 32768 + 16384 + tid * 16 + i * 4096), 16, 0, 0);                   \
  }
  if (!staged) {
    __syncthreads();
    GP_STAGE(par, 0, aptr, bptr)
    asm volatile("s_waitcnt vmcnt(0)" ::: "memory");
    __syncthreads();
  }
  for (int kt = 0; kt < nk; ++kt) {
    const int cur = (par + kt) & 1;
    if (kt + 1 < nk) { GP_STAGE(cur ^ 1, (kt + 1) * 64, aptr, bptr) }
    else if (has_next) { GP_STAGE(cur ^ 1, 0, naptr, nbptr) }
    const unsigned char* bufA = lds + cur * 32768;
    const unsigned char* bufB = bufA + 16384;
#pragma unroll
    for (int kk = 0; kk < 2; ++kk) {
      bf16x8 At[4], Bt[4];
      const int co = ((kk * 4 + fq) ^ sw) * 16;
#pragma unroll
      for (int m = 0; m < 4; ++m) At[m] = *(const bf16x8*)(bufA + aro + m * 2048 + co);
#pragma unroll
      for (int n = 0; n < 4; ++n) Bt[n] = *(const bf16x8*)(bufB + bro + n * 2048 + co);
#pragma unroll
      for (int m = 0; m < 4; ++m)
#pragma unroll
        for (int n = 0; n < 4; ++n) acc[m][n] = mfma16(Bt[n], At[m], acc[m][n]);
    }
    asm volatile("s_waitcnt vmcnt(0)" ::: "memory");
    __syncthreads();
  }
  par = (par + nk) & 1;
#undef GP_STAGE
}
#define GEMM_EPI_LOOP(body)                                                                 \
  {                                                                                         \
    const int _tid = threadIdx.x, _wid = _tid >> 6, _lane = _tid & 63, _wr = _wid >> 1, _wc = _wid & 1, _fr = _lane & 15, _fq = _lane >> 4; \
    _Pragma("unroll") for (int m = 0; m < 4; ++m) _Pragma("unroll") for (int n = 0; n < 4; ++n) _Pragma("unroll") for (int j = 0; j < 4; ++j) { \
      const int er = _wr * 64 + m * 16 + _fr, ec = _wc * 64 + n * 16 + _fq * 4 + j; const float ev = acc[m][n][j]; body }                      \
  }
#define GEMM_EPI4(body)                                                                     \
  {                                                                                         \
    const int _tid = threadIdx.x, _wid = _tid >> 6, _lane = _tid & 63, _wr = _wid >> 1, _wc = _wid & 1, _fr = _lane & 15, _fq = _lane >> 4; \
    _Pragma("unroll") for (int m = 0; m < 4; ++m) _Pragma("unroll") for (int n = 0; n < 4; ++n) {                                             \
      const int er = _wr * 64 + m * 16 + _fr, ec0 = _wc * 64 + n * 16 + _fq * 4; const f32x4 ev4 = acc[m][n]; body }                          \
  }
DEVI void st_bf16x4(bf16_t* p, f32x4 v) { uint2 o; o.x = pk2bf(v[0], v[1]); o.y = pk2bf(v[2], v[3]); *(uint2*)p = o; }

template <class RM>
DEVI void transpose_tiles(const float* src, int K, int N, bf16_t* dst, int ldk, RM rowmap, unsigned char* lds, int& cursor, const float* kscale = nullptr) {
  float* tl = (float*)lds;
  const int tk = K / 64, tn = (N + 63) / 64, nt = tk * tn;
  const int tid = threadIdx.x;
  const int G_ = (int)gridDim.x;
  for (int it = ((int)blockIdx.x - cursor % G_ + G_) % G_; it < nt; it += G_) {
    const int kt = it / tn, ntile = it % tn, k0 = kt * 64, n0 = ntile * 64;
    __syncthreads();
#pragma unroll
    for (int q = 0; q < 4; ++q) {
      const int r = (tid >> 4) + 16 * q, c4 = (tid & 15) * 4;
      const float* sp = src + (size_t)(k0 + r) * N + n0 + c4;
      float4 v;
      if (n0 + c4 + 3 < N) v = *(const float4*)sp;
      else { v.x = (n0 + c4 < N) ? sp[0] : 0.f; v.y = (n0 + c4 + 1 < N) ? sp[1] : 0.f; v.z = (n0 + c4 + 2 < N) ? sp[2] : 0.f; v.w = 0.f; }
      if (kscale) { const float ks = kscale[k0 + r]; v.x *= ks; v.y *= ks; v.z *= ks; v.w *= ks; }
      tl[r * 65 + c4] = v.x; tl[r * 65 + c4 + 1] = v.y; tl[r * 65 + c4 + 2] = v.z; tl[r * 65 + c4 + 3] = v.w;
    }
    __syncthreads();
    const int n = tid >> 2, kc = (tid & 3) * 16;
    if (n0 + n < N) {
      unsigned w[8];
#pragma unroll
      for (int i = 0; i < 8; ++i) w[i] = pk2bf(tl[(kc + 2 * i) * 65 + n], tl[(kc + 2 * i + 1) * 65 + n]);
      uint4* o = (uint4*)(dst + (size_t)rowmap(n0 + n) * ldk + k0 + kc);
      o[0] = make_uint4(w[0], w[1], w[2], w[3]); o[1] = make_uint4(w[4], w[5], w[6], w[7]);
    }
  }
  cursor += nt;
}
DEVI void rmsnorm_rows(const float* x, const float* g, bf16_t* xn) {
  const int lane = threadIdx.x & 63, gw = blockIdx.x * 4 + (threadIdx.x >> 6), NGW = gridDim.x * 4;
  float4 gg[4];
#pragma unroll
  for (int j = 0; j < 4; ++j) gg[j] = ((const float4*)g)[lane + 64 * j];
  for (int t0 = gw * 4; t0 < T; t0 += NGW * 4) {
    float4 v[4][4];
#pragma unroll
    for (int q = 0; q < 4; ++q)
#pragma unroll
      for (int j = 0; j < 4; ++j) v[q][j] = ((const float4*)(x + (size_t)(t0 + q) * D))[lane + 64 * j];
#pragma unroll
    for (int q = 0; q < 4; ++q) {
      float s = 0.f;
#pragma unroll
      for (int j = 0; j < 4; ++j) s += v[q][j].x * v[q][j].x + v[q][j].y * v[q][j].y + v[q][j].z * v[q][j].z + v[q][j].w * v[q][j].w;
      const float rs = rsqrtf(wsum(s) * (1.f / D) + EPS);
#pragma unroll
      for (int j = 0; j < 4; ++j) {
        uint2 o; o.x = pk2bf(v[q][j].x * rs * gg[j].x, v[q][j].y * rs * gg[j].y); o.y = pk2bf(v[q][j].z * rs * gg[j].z, v[q][j].w * rs * gg[j].w);
        ((uint2*)(xn + (size_t)(t0 + q) * D))[lane + 64 * j] = o;
      }
    }
  }
}
DEVI void phase_prep(const Params& p, unsigned char* lds) {
  const size_t gtid = (size_t)blockIdx.x * NTHREADS + threadIdx.x, gn = (size_t)gridDim.x * NTHREADS;
  unsigned char* ws = p.ws;
  if (gtid < 64) ((int*)(ws + SM_CNT))[gtid] = 0;
  auto ident = [](int n) { return n; };
  int cursor = 0;
  for (int l = 0; l < NL; ++l) {
    unsigned char* wl = ws + WS_W + l * WS_WL;
    transpose_tiles(p.in[3] + (size_t)l * D * DIN, D, DIN, (bf16_t*)(wl + W_IN), D, [](int n) { return colmap(n); }, lds, cursor);
    for (size_t i = gtid; i < (size_t)20 * D; i += gn) ((bf16_t*)(wl + W_IN))[(size_t)236 * D + i] = 0;
    transpose_tiles(p.in[36] + (size_t)l * D * D, D, D, (bf16_t*)(wl + W_OUT), D, ident, lds, cursor);
    transpose_tiles(p.in[6] + (size_t)l * 192 * 384, 192, 384, (bf16_t*)(wl + W_UQ), 192, ident, lds, cursor, p.in[4] + l * 192);
    transpose_tiles(p.in[7] + (size_t)l * 128 * 512, 128, 512, (bf16_t*)(wl + W_UKV), 128, ident, lds, cursor, p.in[5] + l * 128);
    transpose_tiles(p.in[25] + (size_t)l * 256 * 256, 256, 256, (bf16_t*)(wl + W_GLU), 256, ident, lds, cursor);
    transpose_tiles(p.in[30] + (size_t)l * 2048 * 128, 2048, 128, (bf16_t*)(wl + W_1K), 2048, ident, lds, cursor);
    transpose_tiles(p.in[33] + (size_t)l * 2048 * 128, 2048, 128, (bf16_t*)(wl + W_1V), 2048, ident, lds, cursor);
    transpose_tiles(p.in[31] + (size_t)l * 128 * 64, 128, 64, (bf16_t*)(wl + W_2K), 128, ident, lds, cursor);
    transpose_tiles(p.in[34] + (size_t)l * 128 * 64, 128, 64, (bf16_t*)(wl + W_2V), 128, ident, lds, cursor);
    for (int h = 0; h < 4; ++h) {
      transpose_tiles(p.in[12] + ((size_t)l * 4 + h) * 64 * 64, 64, 64, (bf16_t*)(wl + W_LRU) + h * 128 * 64, 64, ident, lds, cursor);
      transpose_tiles(p.in[14] + ((size_t)l * 4 + h) * 64 * 64, 64, 64, (bf16_t*)(wl + W_LRU) + h * 128 * 64 + 64 * 64, 64, ident, lds, cursor);
    }
    for (int e = 0; e < 16; ++e) {
      bf16_t* dg = (bf16_t*)(wl + W_GU) + (size_t)e * 512 * 1024;
      transpose_tiles(p.in[42] + ((size_t)l * 16 + e) * 1024 * 256, 1024, 256, dg, 1024, [](int hh) { return (hh >> 6) * 128 + ((hh >> 5) & 1) * 64 + ((hh >> 4) & 1) * 16 + (hh & 15); }, lds, cursor);
      transpose_tiles(p.in[43] + ((size_t)l * 16 + e) * 1024 * 256, 1024, 256, dg, 1024, [](int hh) { return (hh >> 6) * 128 + ((hh >> 5) & 1) * 64 + (((hh >> 4) & 1) + 2) * 16 + (hh & 15); }, lds, cursor);
      transpose_tiles(p.in[44] + ((size_t)l * 16 + e) * 256 * 1024, 256, 1024, (bf16_t*)(wl + W_DN) + (size_t)e * 1024 * 256, 256, ident, lds, cursor);
    }
    {
      const int lane = threadIdx.x & 63, gw = blockIdx.x * 4 + (threadIdx.x >> 6), NGW = gridDim.x * 4;
      for (int o = gw; o < 256; o += NGW) {
        const int kv = o >> 7, j = o & 127;
        const float* pe = (kv ? p.in[32] : p.in[29]) + (size_t)l * 2048;
        const float* w1 = (kv ? p.in[33] : p.in[30]) + (size_t)l * 2048 * 128;
        float a = 0.f;
#pragma unroll 8
        for (int k = lane; k < 2048; k += 64) a += pe[k] * w1[(size_t)k * 128 + j];
        a = wsum(a);
        if (lane == 0) ((float*)(wl + (kv ? W_B1V : W_B1K)))[j] = a;
      }
    }
    for (size_t i = gtid; i < 16 * 64; i += gn) {
      const int g = (int)(i >> 6), sidx = (int)(i & 63);
      const float are = p.in[17][(size_t)l * 1024 + i], aim = p.in[18][(size_t)l * 1024 + i];
      const float dt = expf(p.in[19][l * 16 + g]);
      const float mag = expf(dt * are);
      float sn, cs; sincosf(dt * aim, &sn, &cs);
      const float abr = mag * cs, abi = mag * sn;
      const float den = are * are + aim * aim, nre = abr - 1.f;
      const float gre = (nre * are + abi * aim) / den, gim = (abi * are - nre * aim) / den;
      ((float2*)(wl + W_S5A))[i] = make_float2(abr, abi);
      float pr = abr, pi = abi;
#pragma unroll
      for (int q = 0; q < 6; ++q) { const float nr = pr * pr - pi * pi, ni = 2.f * pr * pi; pr = nr; pi = ni; }
      ((float2*)(wl + W_S5A64))[i] = make_float2(pr, pi);
      bf16_t* bb = (bf16_t*)(wl + W_S5BB);
      for (int ch = 0; ch < 16; ++ch) {
        const float br = p.in[20][((size_t)l * 1024 + i) * 16 + ch], bi = p.in[21][((size_t)l * 1024 + i) * 16 + ch];
        const float vr = gre * br - gim * bi, vi = gre * bi + gim * br;
        const int sb = sidx >> 5, r = sidx & 31;
        bb[((g * 4 + sb * 2 + 0) * 32 + r) * 16 + ch] = f2bf(vr);
        bb[((g * 4 + sb * 2 + 1) * 32 + r) * 16 + ch] = f2bf(vi);
      }
    }
    for (size_t i = gtid; i < 32 * 1024; i += gn) {
      const int n = (int)(i >> 10), k = (int)(i & 1023);
      float w = 0.f;
      if (n < 20) w = p.in[37][l * D + k] * ((n < 4) ? p.in[38][((size_t)l * D + k) * 4 + n] : p.in[40][((size_t)l * D + k) * 16 + (n - 4)]);
      const bf16_t hi = f2bf(w);
      ((bf16_t*)(wl + W_RTH))[i] = hi; ((bf16_t*)(wl + W_RTL))[i] = f2bf(w - bf2f(hi));
    }
    for (size_t i = gtid; i < 16 * 16 * 64; i += gn) {
      const int g = (int)(i >> 10), ch = (int)((i >> 6) & 15), pp = (int)(i & 63);
      const float cr = p.in[22][(size_t)l * 16384 + i], ci = p.in[23][(size_t)l * 16384 + i];
      bf16_t* cm = (bf16_t*)(wl + W_S5CM) + ((size_t)(g * 16 + ch) * 128 + 2 * pp);
      cm[0] = f2bf(cr); cm[1] = f2bf(-ci);
    }
  }
  {
    const int* positions = (const int*)p.in[1];
    float2* RM = (float2*)(ws + WS_ROPE);
    float2* RN = RM + (size_t)T * 16;
    for (size_t i = gtid; i < (size_t)T * 24; i += gn) {
      const int t = (int)(i / 24), j = (int)(i % 24);
      const int rot = (j < 16) ? 32 : 16, fi = (j < 16) ? j : (j - 16);
      const float inv = powf(500000.f, -(2.f * (float)fi) / (float)rot);
      float sn, cs; sincosf((float)positions[t] * inv, &sn, &cs);
      if (j < 16) RM[(size_t)t * 16 + fi] = make_float2(cs, sn); else RN[(size_t)t * 8 + fi] = make_float2(cs, sn);
    }
  }
  rmsnorm_rows(p.in[0], p.in[2], (bf16_t*)(ws + WS_A));
}

DEVI void phase_g1(const Params& p, int l, unsigned char* lds) {
  const bf16_t* XN = (const bf16_t*)(p.ws + WS_A);
  const bf16_t* W = (const bf16_t*)(p.ws + WS_W + l * WS_WL + W_IN);
  bf16_t* PROJ = (bf16_t*)(p.ws + WS_B);
  constexpr int NT = DINP / 128;
  int par = 0; bool staged = false;
  for (int it = vblock(); it < (T / 128) * NT; it += gridDim.x) {
    const int mt = it / NT, nt = it % NT;
    const int itn = it + (int)gridDim.x; const bool hn = itn < (T / 128) * NT; const int mtn = itn / NT, ntn = itn % NT;
    f32x4 acc[4][4];
    gemm128p(lds, D, [&](int r, int k) { return XN + (size_t)(mt * 128 + r) * D + k; }, [&](int r, int k) { return W + (size_t)(nt * 128 + r) * D + k; }, acc, par, staged, hn,
             [&](int r, int k) { return XN + (size_t)(mtn * 128 + r) * D + k; }, [&](int r, int k) { return W + (size_t)(ntn * 128 + r) * D + k; });
    staged = hn;
    if (nt >= 9 && nt <= 11) {
      const int tid = threadIdx.x, wid = tid >> 6, lane = tid & 63, wr = wid >> 1, wc = wid & 1, fr = lane & 15, fq = lane >> 4;
      const float* gg = (nt < 11) ? (p.in[27] + l * 64) : (p.in[28] + l * 192 + (wc ? 128 : 64));
      const float sc = (nt < 11) ? (0.125f * LOG2E) : 1.f;
      const float2* RN = (const float2*)(p.ws + WS_ROPE) + (size_t)T * 16;
#pragma unroll
      for (int m = 0; m < 4; ++m) {
        const size_t t = (size_t)mt * 128 + wr * 64 + m * 16 + fr;
        float ss = 0.f;
#pragma unroll
        for (int n = 0; n < 4; ++n) ss += acc[m][n][0] * acc[m][n][0] + acc[m][n][1] * acc[m][n][1] + acc[m][n][2] * acc[m][n][2] + acc[m][n][3] * acc[m][n][3];
        ss += __shfl_xor(ss, 16); ss += __shfl_xor(ss, 32);
        const float rs = rsqrtf(ss * (1.f / 64) + EPS);
#pragma unroll
        for (int n = 0; n < 4; ++n) {
          const float4 g4 = *(const float4*)(gg + n * 16 + fq * 4);
          f32x4 v = acc[m][n];
          v[0] *= rs * g4.x; v[1] *= rs * g4.y; v[2] *= rs * g4.z; v[3] *= rs * g4.w;
          if (n == 0) {
#pragma unroll
            for (int j = 0; j < 4; ++j) {
              const float x = v[j], partner = __shfl_xor(x, 32);
              const int d = fq * 4 + j; const float2 cs2 = RN[t * 8 + (d & 7)];
              v[j] = (d < 8) ? (x * cs2.x - partner * cs2.y) : (partner * cs2.y + x * cs2.x);
            }
          }
          st_bf16x4(PROJ + t * DINP + nt * 128 + wc * 64 + n * 16 + fq * 4, v * sc);
        }
      }
    } else {
      GEMM_EPI4({ st_bf16x4(PROJ + (size_t)(mt * 128 + er) * DINP + nt * 128 + ec0, ev4); })
    }
  }
}

DEVI void phase_g2(const Params& p, int l, unsigned char* lds) {
  unsigned char* wl = p.ws + WS_W + l * WS_WL;
  const bf16_t* PROJ = (const bf16_t*)(p.ws + WS_B);
  bf16_t* QR = (bf16_t*)(p.ws + WS_D);
  bf16_t* KVR = QR + (size_t)T * 384;
  bf16_t* GATES = (bf16_t*)(p.ws + WS_E);
  bf16_t* MK = (bf16_t*)(p.ws + WS_F) + (size_t)T * 4 * 96;
  const float2* RM = (const float2*)(p.ws + WS_ROPE);
  constexpr int N_CMP = 32, N_QR = 256 * 3, N_KVR = 256 * 4, N_GT = 256 * 4;
  const int tid = threadIdx.x, wid = tid >> 6, lane = tid & 63, wr = wid >> 1, wc = wid & 1, fr = lane & 15, fq = lane >> 4;
  for (int it = vblock(); it < N_CMP + N_QR + N_KVR + N_GT; it += gridDim.x) {
    f32x4 acc[4][4];
    if (it < N_CMP) {
      const int kv = it & 1, mt = it >> 1;
      const bf16_t* W = (const bf16_t*)(wl + (kv ? W_1V : W_1K));
      const float* bias = (const float*)(wl + (kv ? W_B1V : W_B1K));
      bf16_t* H = (bf16_t*)(p.ws + (kv ? SM_HV : SM_HK));
      gemm128g(lds, 2048,
              [&](int r, int k) { const int m = mt * 128 + r, b = m >> 7; int c = m & 127; if (c > 126) c = 126;
                                  return PROJ + (size_t)(b * S + 16 * c + (k >> 6)) * DINP + C_KC + kv * 64 + (k & 63); },
              [&](int r, int k) { return W + (size_t)r * 2048 + k; }, acc);
      GEMM_EPI4({ f32x4 o; _Pragma("unroll") for (int j = 0; j < 4; ++j) o[j] = gelu_tanh(ev4[j] + bias[ec0 + j]); st_bf16x4(H + (size_t)(mt * 128 + er) * 128 + ec0, o); })
    } else if (it < N_CMP + N_QR) {
      const int i2 = it - N_CMP, mt = i2 / 3, nt = i2 % 3;
      const bf16_t* W = (const bf16_t*)(wl + W_UQ);
      gemm128g(lds, 192, [&](int r, int k) { return PROJ + (size_t)(mt * 128 + r) * DINP + C_CQ + k; }, [&](int r, int k) { return W + (size_t)(nt * 128 + r) * 192 + k; }, acc);
      GEMM_EPI4({ st_bf16x4(QR + (size_t)(mt * 128 + er) * 384 + nt * 128 + ec0, ev4); })
    } else if (it < N_CMP + N_QR + N_KVR) {
      const int i2 = it - N_CMP - N_QR, mt = i2 >> 2, hd = i2 & 3;
      const bf16_t* W = (const bf16_t*)(wl + W_UKV);
      gemm128g(lds, 128, [&](int r, int k) { return PROJ + (size_t)(mt * 128 + r) * DINP + C_CKV + k; }, [&](int r, int k) { return W + (size_t)(hd * 128 + r) * 128 + k; }, acc);
      const float* g_k = p.in[9] + l * 96;
#pragma unroll
      for (int m = 0; m < 4; ++m) {
        const size_t t = (size_t)mt * 128 + wr * 64 + m * 16 + fr;
        const int b = (int)(t >> 11), sq = (int)(t & (S - 1));
        float ss = 0.f;
        {
          const bf16_t* cr = PROJ + t * DINP + C_CKV + fq * 32;
#pragma unroll
          for (int q = 0; q < 4; ++q) { const u32x4 w = *(const u32x4*)(cr + q * 8);
#pragma unroll
            for (int e = 0; e < 4; ++e) { const float lo = __uint_as_float(w[e] << 16), hi = __uint_as_float(w[e] & 0xffff0000u); ss += lo * lo + hi * hi; } }
        }
        ss += __shfl_xor(ss, 16); ss += __shfl_xor(ss, 32);
        const float rskv = rsqrtf(ss * (1.f / 128) + EPS);
        if (wc == 1) {
#pragma unroll
          for (int n = 0; n < 4; ++n) st_bf16x4(KVR + t * 512 + hd * 128 + 64 + n * 16 + fq * 4, acc[m][n] * rskv);
        } else {
          const uint2 plo = *(const uint2*)(PROJ + t * DINP + C_KPE + 4 * fq), phi = *(const uint2*)(PROJ + t * DINP + C_KPE + 16 + 4 * fq);
          float pl[4] = {__uint_as_float(plo.x << 16), __uint_as_float(plo.x & 0xffff0000u), __uint_as_float(plo.y << 16), __uint_as_float(plo.y & 0xffff0000u)};
          float ph[4] = {__uint_as_float(phi.x << 16), __uint_as_float(phi.x & 0xffff0000u), __uint_as_float(phi.y << 16), __uint_as_float(phi.y & 0xffff0000u)};
          float sk = 0.f;
#pragma unroll
          for (int j = 0; j < 4; ++j) sk += pl[j] * pl[j] + ph[j] * ph[j];
          f32x4 kn[4];
#pragma unroll
          for (int n = 0; n < 4; ++n) { kn[n] = acc[m][n] * rskv; sk += kn[n][0] * kn[n][0] + kn[n][1] * kn[n][1] + kn[n][2] * kn[n][2] + kn[n][3] * kn[n][3]; }
          sk += __shfl_xor(sk, 16); sk += __shfl_xor(sk, 32);
          const float rsk = rsqrtf(sk * (1.f / 96) + EPS);
          bf16_t* dst = MK + ((size_t)(b * 4 + hd) * S + sq) * 96;
          f32x4 olo, ohi;
#pragma unroll
          for (int j = 0; j < 4; ++j) {
            const int d = 4 * fq + j; const float2 cs2 = RM[t * 16 + d];
            const float x1 = pl[j] * rsk * g_k[d], x2 = ph[j] * rsk * g_k[16 + d];
            olo[j] = x1 * cs2.x - x2 * cs2.y; ohi[j] = x1 * cs2.y + x2 * cs2.x;
          }
          st_bf16x4(dst + 4 * fq, olo); st_bf16x4(dst + 16 + 4 * fq, ohi);
#pragma unroll
          for (int n = 0; n < 4; ++n) { const float4 g4 = *(const float4*)(g_k + 32 + n * 16 + fq * 4); f32x4 o = kn[n] * rsk; o[0] *= g4.x; o[1] *= g4.y; o[2] *= g4.z; o[3] *= g4.w; st_bf16x4(dst + 32 + n * 16 + fq * 4, o); }
        }
      }
    } else {
      const int i2 = it - N_CMP - N_QR - N_KVR, mt = i2 >> 2, h = i2 & 3;
      const bf16_t* W = (const bf16_t*)(wl + W_LRU) + h * 128 * 64;
      const int c0 = h * 64 + (tid & 7) * 8;
      const float* cw = p.in[10] + l * 4 * 256 + c0; const float* cbp = p.in[11] + l * 256 + c0;
      gemm128(lds, 64,
              [&](int r, int k) {
                const size_t t = (size_t)mt * 128 + r; const int sq = (int)(t & (S - 1));
                float u[8];
#pragma unroll
                for (int e = 0; e < 8; ++e) u[e] = cbp[e];
#pragma unroll
                for (int j = 0; j < 4; ++j) {
                  if (sq - 3 + j >= 0) {
                    const u32x4 w = *(const u32x4*)(PROJ + (t - 3 + j) * DINP + C_LX + h * 64 + k);
#pragma unroll
                    for (int e = 0; e < 4; ++e) { u[2 * e] += __uint_as_float(w[e] << 16) * cw[j * 256 + 2 * e]; u[2 * e + 1] += __uint_as_float(w[e] & 0xffff0000u) * cw[j * 256 + 2 * e + 1]; }
                  }
                }
                u32x4 o; o[0] = pk2bf(u[0], u[1]); o[1] = pk2bf(u[2], u[3]); o[2] = pk2bf(u[4], u[5]); o[3] = pk2bf(u[6], u[7]);
                return o; },
              [&](int r, int k) { return W + (size_t)r * 64 + k; }, acc);
      GEMM_EPI4({ st_bf16x4(GATES + (size_t)(mt * 128 + er) * 512 + h * 128 + ec0, ev4); })
    }
  }
}

DEVI void lru_ab(float u, float rpre, float ipre, float sp, bool first, float& a, float& b) {
  const float r = sigmoidf_(rpre), gi = sigmoidf_(ipre);
  const float la = -8.f * r * sp;
  a = __expf(la);
  const float x = 2.f * la;
  const float om = (x > -0.1f) ? (-x * (1.f + 0.5f * x * (1.f + (1.f / 3.f) * x * (1.f + 0.25f * x * (1.f + 0.2f * x))))) : (1.f - a * a);
  const float mult = first ? 1.f : sqrtf(fmaxf(om, 0.f));
  b = mult * gi * u;
}
DEVI float lru_conv(const bf16_t* PROJ, int t, int s, int c, const float* cw, float cb) {
  float u = cb;
#pragma unroll
  for (int j = 0; j < 4; ++j) { const int ss2 = s - 3 + j; if (ss2 >= 0) u += bf2f(PROJ[(size_t)(t - 3 + j) * DINP + C_LX + c]) * cw[j * 256 + c]; }
  return u;
}

template <bool FULL>
DEVI void s5_chunk(const Params& p, int l, int b, int chunk, unsigned char* lds) {
  unsigned char* wl = p.ws + WS_W + l * WS_WL;
  const bf16_t* PROJ = (const bf16_t*)(p.ws + WS_B);
  const float2* Abar = (const float2*)(wl + W_S5A);
  const bf16_t* BB = (const bf16_t*)(wl + W_S5BB);
  const bf16_t* CM = (const bf16_t*)(wl + W_S5CM);
  float2* SLOC = (float2*)(p.ws + SM_SLOC);
  bf16_t* YCP = (bf16_t*)(p.ws + WS_F);
  const float* dd = p.in[24] + l * 256;
  const int tid = threadIdx.x, wv = tid >> 6, lane = tid & 63, r = lane & 31, h = lane >> 5, fr = lane & 15, fq = lane >> 4;
  unsigned* Hs = (unsigned*)(lds + wv * 8704);
  const int t0 = b * S + chunk * 64;
#pragma unroll 1
  for (int gi = 0; gi < 4; ++gi) {
    const int g = wv * 4 + gi;
    bf16x8 bbf[4];
#pragma unroll
    for (int nb = 0; nb < 4; ++nb) bbf[nb] = *(const bf16x8*)(BB + ((g * 4 + nb) * 32 + r) * 16 + 8 * h);
    float2 Ac[2]; float hr[2], hi[2];
#pragma unroll
    for (int sb = 0; sb < 2; ++sb) {
      Ac[sb] = Abar[g * 64 + sb * 32 + r];
      hr[sb] = 0.f; hi[sb] = 0.f;
      if (FULL) { const float2 cin = ((const float2*)(p.ws + SM_SCAR))[((size_t)(b * 32 + chunk) * 16 + g) * 64 + sb * 32 + r]; hr[sb] = cin.x; hi[sb] = cin.y; }
    }
    bf16x8 cm[4];
    float4 dcol4 = make_float4(0.f, 0.f, 0.f, 0.f);
    if (FULL) {
#pragma unroll
      for (int kk = 0; kk < 4; ++kk) cm[kk] = *(const bf16x8*)(CM + (size_t)(g * 16 + fr) * 128 + kk * 32 + 8 * fq);
      dcol4 = *(const float4*)(dd + g * 16 + 4 * fq);
    }
#pragma unroll 1
    for (int tb = 0; tb < 2; ++tb) {
      const bf16x8 ua = *(const bf16x8*)(PROJ + (size_t)(t0 + tb * 32 + r) * DINP + C_S5 + g * 16 + 8 * h);
      f32x16 acc[4];
#pragma unroll
      for (int nb = 0; nb < 4; ++nb) {
        f32x16 z;
#pragma unroll
        for (int i = 0; i < 16; ++i) z[i] = 0.f;
        acc[nb] = mfma32(ua, bbf[nb], z);
      }
#pragma unroll
      for (int sb = 0; sb < 2; ++sb) {
        float sr = hr[sb], si = hi[sb];
        const float ax = Ac[sb].x, ay = Ac[sb].y;
#pragma unroll
        for (int q = 0; q < 4; ++q)
#pragma unroll
          for (int owner = 0; owner < 2; ++owner) {
#pragma unroll
            for (int i = 0; i < 4; ++i) {
              const int reg = 4 * q + i;
              const float br = acc[2 * sb][reg], bi = acc[2 * sb + 1][reg];
              const float nr = ax * sr - ay * si + br, ni = ax * si + ay * sr + bi; sr = nr; si = ni;
              if (FULL) { acc[2 * sb][reg] = (h == owner) ? sr : br; acc[2 * sb + 1][reg] = (h == owner) ? si : bi; }
            }
            const float orr = __shfl_xor(sr, 32), oi = __shfl_xor(si, 32);
            if (h != owner) { sr = orr; si = oi; }
          }
        hr[sb] = sr; hi[sb] = si;
      }
      if (FULL) {
#pragma unroll
        for (int sb = 0; sb < 2; ++sb)
#pragma unroll
          for (int reg = 0; reg < 16; ++reg)
            Hs[crow(reg, h) * 68 + sb * 32 + r] = pk2bf(acc[2 * sb][reg], acc[2 * sb + 1][reg]);
#pragma unroll
        for (int tb16 = 0; tb16 < 2; ++tb16) {
          f32x4 y = (f32x4){0.f, 0.f, 0.f, 0.f};
#pragma unroll
          for (int kk = 0; kk < 4; ++kk) { const bf16x8 a = *(const bf16x8*)((const bf16_t*)Hs + (tb16 * 16 + fr) * 136 + kk * 32 + 8 * fq); y = mfma16(cm[kk], a, y); }
          const size_t t = (size_t)t0 + tb * 32 + tb16 * 16 + fr; const int col = g * 16 + 4 * fq;
          const uint2 uw = *(const uint2*)(PROJ + t * DINP + C_S5 + col);
          f32x4 o;
          o[0] = gelu_tanh(y[0] + dcol4.x * __uint_as_float(uw.x << 16)); o[1] = gelu_tanh(y[1] + dcol4.y * __uint_as_float(uw.x & 0xffff0000u));
          o[2] = gelu_tanh(y[2] + dcol4.z * __uint_as_float(uw.y << 16)); o[3] = gelu_tanh(y[3] + dcol4.w * __uint_as_float(uw.y & 0xffff0000u));
          st_bf16x4(YCP + t * 256 + col, o);
        }
      }
    }
    if (!FULL) {
#pragma unroll
      for (int sb = 0; sb < 2; ++sb) if (h == 0) SLOC[((size_t)(b * 32 + chunk) * 16 + g) * 64 + sb * 32 + r] = make_float2(hr[sb], hi[sb]);
    }
  }
}

template <bool FULL>
DEVI void lru_chunk(const Params& p, int l, int b, int chunk, float* tile) {
  const bf16_t* PROJ = (const bf16_t*)(p.ws + WS_B);
  const bf16_t* GATES = (const bf16_t*)(p.ws + WS_E);
  float2* LSUM = (float2*)(p.ws + SM_LSUM);
  const int c = threadIdx.x, h = c >> 6, j = c & 63;
  const float* cw = p.in[10] + l * 4 * 256;
  const float w0 = cw[c], w1 = cw[256 + c], w2 = cw[512 + c], w3 = cw[768 + c], cb = p.in[11][l * 256 + c];
  const float ba = p.in[13][l * 256 + c], bi = p.in[15][l * 256 + c];
  const float sp = log1pf(expf(-p.in[16][l * 256 + c]));
  const int s0 = chunk * 64; const size_t t0 = (size_t)b * S + s0;
  float xm3 = 0.f, xm2 = 0.f, xm1 = 0.f;
  if (s0 > 0) { xm3 = bf2f(PROJ[(t0 - 3) * DINP + C_LX + c]); xm2 = bf2f(PROJ[(t0 - 2) * DINP + C_LX + c]); xm1 = bf2f(PROJ[(t0 - 1) * DINP + C_LX + c]); }
  float hh = 0.f, ap = 1.f;
  if (FULL) hh = ((const float*)(p.ws + SM_LCAR))[(size_t)(b * 32 + chunk) * 256 + c];
#pragma unroll 1
  for (int k0 = 0; k0 < 64; k0 += 8) {
    float xv[8], rp[8], ip[8], gt[8];
#pragma unroll
    for (int i = 0; i < 8; ++i) {
      const size_t t = t0 + k0 + i;
      xv[i] = bf2f(PROJ[t * DINP + C_LX + c]);
      rp[i] = bf2f(GATES[t * 512 + h * 128 + j]); ip[i] = bf2f(GATES[t * 512 + h * 128 + 64 + j]);
      gt[i] = FULL ? bf2f(PROJ[t * DINP + C_LG + c]) : 0.f;
    }
#pragma unroll
    for (int i = 0; i < 8; ++i) {
      const float u = cb + xm3 * w0 + xm2 * w1 + xm1 * w2 + xv[i] * w3;
      xm3 = xm2; xm2 = xm1; xm1 = xv[i];
      float a, bb; lru_ab(u, rp[i] + ba, ip[i] + bi, sp, (s0 + k0 + i) == 0, a, bb);
      hh = a * hh + bb; ap *= a;
      if (FULL) tile[(k0 + i) * 256 + c] = hh * gelu_tanh(gt[i]);
    }
  }
  if (!FULL) LSUM[(size_t)(b * 32 + chunk) * 256 + c] = make_float2(ap, hh);
}

DEVI void phase_r2(const Params& p, int l, unsigned char* lds) {
  unsigned char* wl = p.ws + WS_W + l * WS_WL;
  const bf16_t* PROJ = (const bf16_t*)(p.ws + WS_B);
  const bf16_t* QR = (const bf16_t*)(p.ws + WS_D);
  const bf16_t* KVR = QR + (size_t)T * 384;
  const bf16_t* GATES = (const bf16_t*)(p.ws + WS_E);
  bf16_t* MQ = (bf16_t*)(p.ws + WS_F);
  bf16_t* MK = MQ + (size_t)T * 4 * 96;
  const float2* RM = (const float2*)(p.ws + WS_ROPE);
  const float2* RN = RM + (size_t)T * 16;
  const int tid = threadIdx.x, lane = tid & 63, wv = tid >> 6;
  for (int it = blockIdx.x; it < NB * 32; it += gridDim.x) lru_chunk<false>(p, l, it >> 5, it & 31, nullptr);
  __syncthreads();
  for (int it = blockIdx.x; it < NB * 32; it += gridDim.x) s5_chunk<false>(p, l, it >> 5, it & 31, lds);
  {
    const bf16_t* HK = (const bf16_t*)(p.ws + SM_HK); const bf16_t* HV = (const bf16_t*)(p.ws + SM_HV);
    bf16_t* KC = (bf16_t*)(p.ws + SM_KC); bf16_t* VC = (bf16_t*)(p.ws + SM_VC);
    const bf16_t* W2K = (const bf16_t*)(wl + W_2K); const bf16_t* W2V = (const bf16_t*)(wl + W_2V);
    const float* g0 = p.in[28] + l * 192;
    for (int it = blockIdx.x; it < 32; it += gridDim.x) {
      const int kv = it & 1, mt = it >> 1;
      const bf16_t* H = kv ? HV : HK; const bf16_t* W2 = kv ? W2V : W2K;
      f32x4 acc[4][4];
      __syncthreads();
      gemm128g(lds, 128, [&](int r, int k) { return H + (size_t)(mt * 128 + r) * 128 + k; }, [&](int r, int k) { return W2 + (size_t)(r & 63) * 128 + k; }, acc);
      const int wid = tid >> 6, wr = wid >> 1, wc = wid & 1, fr = lane & 15, fq = lane >> 4;
      if (wc == 0) {
#pragma unroll
        for (int m = 0; m < 4; ++m) {
          const int row = mt * 128 + wr * 64 + m * 16 + fr, b = row >> 7, c = row & 127;
          f32x4 v[4];
#pragma unroll
          for (int n = 0; n < 4; ++n) v[n] = acc[m][n];
          if (kv == 0) {
            float ss = 0.f;
#pragma unroll
            for (int n = 0; n < 4; ++n) ss += v[n][0] * v[n][0] + v[n][1] * v[n][1] + v[n][2] * v[n][2] + v[n][3] * v[n][3];
            ss += __shfl_xor(ss, 16); ss += __shfl_xor(ss, 32);
            const float rs = rsqrtf(ss * (1.f / 64) + EPS);
#pragma unroll
            for (int n = 0; n < 4; ++n) { const float4 gg = *(const float4*)(g0 + n * 16 + fq * 4); v[n][0] *= rs * gg.x; v[n][1] *= rs * gg.y; v[n][2] *= rs * gg.z; v[n][3] *= rs * gg.w; }
            const int cc = (c < 127) ? c : 126;
            const float2* cs = RN + (size_t)(b * S + 16 * cc + 31) * 8;
#pragma unroll
            for (int j = 0; j < 4; ++j) {
              const float x = v[0][j], partner = __shfl_xor(x, 32);
              const int d = fq * 4 + j; const float2 cs2 = cs[d & 7];
              v[0][j] = (d < 8) ? (x * cs2.x - partner * cs2.y) : (partner * cs2.y + x * cs2.x);
            }
          }
          bf16_t* dst = (kv ? VC : KC) + (size_t)row * 64;
#pragma unroll
          for (int n = 0; n < 4; ++n) { f32x4 o = v[n]; if (c >= 127) o = (f32x4){0.f, 0.f, 0.f, 0.f}; st_bf16x4(dst + n * 16 + fq * 4, o); }
        }
      }
    }
  }
}

typedef short v4i16_t __attribute__((ext_vector_type(4)));
DEVI float fexp2(float x) { return __builtin_amdgcn_exp2f(x); }
constexpr int VST = 96;
constexpr int ATT_VBYTES = 64 * VST * 2;
template <int DK> constexpr int att_kbytes() { return 64 * (DK + 8) * 2; }
template <int DK> constexpr int att_buf() { return att_kbytes<DK>() + ATT_VBYTES; }
template <int DK> struct TileRegs { u32x4 k[DK / 32]; u32x4 v[2]; };
template <int DK>
DEVI void tile_load(TileRegs<DK>& tr, const bf16_t* kbase, size_t kstride, const bf16_t* vbase, size_t vstride, int key0, bool withv = true) {
  constexpr int CH = DK / 8;
#pragma unroll
  for (int i = 0; i < DK / 32; ++i) { const int c = threadIdx.x + 256 * i, r = c / CH, cc = c % CH; tr.k[i] = *(const u32x4*)(kbase + (size_t)(key0 + r) * kstride + cc * 8); }
  if (withv) {
#pragma unroll
    for (int i = 0; i < 2; ++i) { const int c = threadIdx.x + 256 * i, r = c >> 3, cc = c & 7; tr.v[i] = *(const u32x4*)(vbase + (size_t)(key0 + r) * vstride + cc * 8); }
  }
}
template <int DK>
DEVI void tile_store(const TileRegs<DK>& tr, unsigned char* buf, bool withv = true) {
  constexpr int CH = DK / 8;
  bf16_t* sK = (bf16_t*)buf; bf16_t* sV = (bf16_t*)(buf + att_kbytes<DK>());
#pragma unroll
  for (int i = 0; i < DK / 32; ++i) { const int c = threadIdx.x + 256 * i, r = c / CH, cc = c % CH; *(u32x4*)(sK + r * (DK + 8) + cc * 8) = tr.k[i]; }
  if (withv) {
#pragma unroll
    for (int i = 0; i < 2; ++i) { const int c = threadIdx.x + 256 * i, r = c >> 3, cc = c & 7; *(u32x4*)(sV + r * VST + cc * 8) = tr.v[i]; }
  }
}
template <int DK>
DEVI void qk_tile(const bf16_t* sK, const bf16x8* qf, f32x16& s0, f32x16& s1, int r, int h) {
#pragma unroll
  for (int i = 0; i < 16; ++i) { s0[i] = 0.f; s1[i] = 0.f; }
#pragma unroll
  for (int kk = 0; kk < DK / 16; ++kk) {
    const bf16x8 a0 = *(const bf16x8*)(sK + r * (DK + 8) + kk * 16 + h * 8);
    const bf16x8 a1 = *(const bf16x8*)(sK + (32 + r) * (DK + 8) + kk * 16 + h * 8);
    s0 = mfma32(a0, qf[kk], s0);
    s1 = mfma32(a1, qf[kk], s1);
  }
}
struct FState { f32x16 o0, o1; float m, l; };
DEVI void fstate_init(FState& f) {
#pragma unroll
  for (int i = 0; i < 16; ++i) { f.o0[i] = 0.f; f.o1[i] = 0.f; }
  f.m = -INFINITY; f.l = 0.f;
}
DEVI v4i16_t vtr(const bf16_t* p) { return __builtin_amdgcn_ds_read_tr16_b64_v4i16((LAS v4i16_t*)p); }
DEVI void softmax_pv(FState& f, f32x16& s0, f32x16& s1, const bf16_t* sV, int lane) {
  const int h = lane >> 5;
  float mx = -INFINITY;
#pragma unroll
  for (int i = 0; i < 16; ++i) mx = fmaxf(mx, fmaxf(s0[i], s1[i]));
  mx = fmaxf(mx, __shfl_xor(mx, 32));
  const float mnew = fmaxf(f.m, mx);
  const float muse = (mnew == -INFINITY) ? 0.f : mnew;
  float ps = 0.f;
#pragma unroll
  for (int i = 0; i < 16; ++i) { s0[i] = fexp2(s0[i] - muse); s1[i] = fexp2(s1[i] - muse); ps += s0[i] + s1[i]; }
  ps += __shfl_xor(ps, 32);
  if (__any(mnew != f.m)) {
    const float alpha = fexp2(f.m - muse);
    f.l = f.l * alpha + ps; f.m = mnew;
#pragma unroll
    for (int i = 0; i < 16; ++i) { f.o0[i] *= alpha; f.o1[i] *= alpha; }
  } else {
    f.l += ps;
  }
  const int g = lane >> 4, li = lane & 15, q = li >> 2, pp = li & 3;
  const bf16_t* vb = sV + (4 * h + q) * VST + (g & 1) * 16 + 4 * pp;
#pragma unroll
  for (int kb = 0; kb < 2; ++kb)
#pragma unroll
    for (int s = 0; s < 2; ++s) {
      unsigned pw[4];
#pragma unroll
      for (int j = 0; j < 4; ++j) pw[j] = kb ? pk2bf(s1[8 * s + 2 * j], s1[8 * s + 2 * j + 1]) : pk2bf(s0[8 * s + 2 * j], s0[8 * s + 2 * j + 1]);
      const bf16x8 pb = __builtin_bit_cast(bf16x8, (u32x4){pw[0], pw[1], pw[2], pw[3]});
#pragma unroll
      for (int db = 0; db < 2; ++db) {
        const v4i16_t lo = vtr(vb + (kb * 32 + 16 * s) * VST + db * 32);
        const v4i16_t hi = vtr(vb + (kb * 32 + 16 * s + 8) * VST + db * 32);
        const bf16x8 a = {lo[0], lo[1], lo[2], lo[3], hi[0], hi[1], hi[2], hi[3]};
        if (db == 0) f.o0 = mfma32(a, pb, f.o0); else f.o1 = mfma32(a, pb, f.o1);
      }
    }
}
DEVI void store_o(bf16_t* orow, const f32x16& o0, const f32x16& o1, float sc, int h) {
#pragma unroll
  for (int g = 0; g < 4; ++g) {
    uint2 v0, v1;
    v0.x = pk2bf(o0[4 * g] * sc, o0[4 * g + 1] * sc); v0.y = pk2bf(o0[4 * g + 2] * sc, o0[4 * g + 3] * sc);
    v1.x = pk2bf(o1[4 * g] * sc, o1[4 * g + 1] * sc); v1.y = pk2bf(o1[4 * g + 2] * sc, o1[4 * g + 3] * sc);
    *(uint2*)(orow + 8 * g + 4 * h) = v0;
    *(uint2*)(orow + 32 + 8 * g + 4 * h) = v1;
  }
}

DEVI void mla_item(const Params& p, int l, int b, int hd, int qt, unsigned char* lds) {
  const bf16_t* MQ = (const bf16_t*)(p.ws + WS_F);
  const bf16_t* MK = MQ + (size_t)T * 4 * 96;
  const bf16_t* KVR = (const bf16_t*)(p.ws + WS_D) + (size_t)T * 384;
  bf16_t* YA = (bf16_t*)(p.ws + WS_C);
  const int tid = threadIdx.x, wv = tid >> 6, lane = tid & 63, r = lane & 31, h = lane >> 5;
  const int q0 = qt * 128 + wv * 32, tq = q0 + r;
  bf16x8 qf[6];
  {
    const bf16_t* qrow = (const bf16_t*)(p.ws + WS_D) + ((size_t)b * S + tq) * 384 + hd * 96;
    const float* g_q = p.in[8] + l * 96;
    float qv[6][8]; float ss = 0.f;
#pragma unroll
    for (int kk = 0; kk < 6; ++kk) {
      const u32x4 w = *(const u32x4*)(qrow + kk * 16 + h * 8);
#pragma unroll
      for (int e = 0; e < 4; ++e) { qv[kk][2 * e] = __uint_as_float(w[e] << 16); qv[kk][2 * e + 1] = __uint_as_float(w[e] & 0xffff0000u); ss += qv[kk][2 * e] * qv[kk][2 * e] + qv[kk][2 * e + 1] * qv[kk][2 * e + 1]; }
    }
    ss += __shfl_xor(ss, 32);
    const float rs = rsqrtf(ss * (1.f / 96) + EPS) * (0.10206207261596575f * LOG2E);
#pragma unroll
    for (int kk = 0; kk < 6; ++kk)
#pragma unroll
      for (int j = 0; j < 8; ++j) qv[kk][j] *= rs * g_q[kk * 16 + h * 8 + j];
    const float2* cs = (const float2*)(p.ws + WS_ROPE) + ((size_t)b * S + tq) * 16 + 8 * h;
#pragma unroll
    for (int j = 0; j < 8; ++j) { const float2 c2 = cs[j]; const float x1 = qv[0][j], x2 = qv[1][j]; qv[0][j] = x1 * c2.x - x2 * c2.y; qv[1][j] = x1 * c2.y + x2 * c2.x; }
#pragma unroll
    for (int kk = 0; kk < 6; ++kk) { const u32x4 w = {pk2bf(qv[kk][0], qv[kk][1]), pk2bf(qv[kk][2], qv[kk][3]), pk2bf(qv[kk][4], qv[kk][5]), pk2bf(qv[kk][6], qv[kk][7])}; qf[kk] = __builtin_bit_cast(bf16x8, w); }
  }
  FState f; fstate_init(f);
  const bf16_t* kbase = MK + (size_t)(b * 4 + hd) * S * 96;
  const bf16_t* vbase = KVR + (size_t)b * S * 512 + hd * 128 + 64;
  const int ntiles = 2 * qt + 2;
  TileRegs<96> tr;
  TileRegs<96> tr2;
  tile_load<96>(tr, kbase, 96, vbase, 512, 0);
  tile_load<96>(tr2, kbase, 96, vbase, 512, 64);
  __syncthreads();
  tile_store<96>(tr, lds);
  __syncthreads();
  auto compute = [&](int kt, unsigned char* cur) {
    if (kt * 64 <= q0 + 31) {
      f32x16 s0, s1;
      qk_tile<96>((const bf16_t*)cur, qf, s0, s1, r, h);
      if (kt * 64 + 63 > q0) {
        int rel = tq - kt * 64 - 4 * h; asm volatile("" : "+v"(rel));
#pragma unroll
        for (int i = 0; i < 16; ++i) { const int kk2 = (i & 3) + 8 * (i >> 2); if (kk2 > rel) s0[i] = -INFINITY; if (kk2 + 32 > rel) s1[i] = -INFINITY; }
      }
      softmax_pv(f, s0, s1, (const bf16_t*)(cur + att_kbytes<96>()), lane);
    }
  };
#pragma unroll 1
  for (int kt = 0; kt < ntiles; kt += 2) {
    if (kt + 2 < ntiles) tile_load<96>(tr, kbase, 96, vbase, 512, (kt + 2) * 64);
    compute(kt, lds);
    tile_store<96>(tr2, lds + att_buf<96>());
    __syncthreads();
    if (kt + 3 < ntiles) tile_load<96>(tr2, kbase, 96, vbase, 512, (kt + 3) * 64);
    compute(kt + 1, lds + att_buf<96>());
    if (kt + 2 < ntiles) tile_store<96>(tr, lds);
    __syncthreads();
  }
  store_o(YA + (size_t)(b * S + tq) * 256 + hd * 64, f.o0, f.o1, 1.f / f.l, h);
}

template <class KF, class BODY>
DEVI void nsa_stream(unsigned char* lds, const bf16_t* kbase, size_t kstride, const bf16_t* vbase, size_t vstride, bool withv, int nt, KF key0f, BODY body) {
  if (nt <= 0) return;
  TileRegs<64> tr;
  tile_load<64>(tr, kbase, kstride, vbase, vstride, key0f(0), withv);
  __syncthreads();
  tile_store<64>(tr, lds, withv);
  __syncthreads();
#pragma unroll 1
  for (int i = 0; i < nt; ++i) {
    unsigned char* cur = lds + (i & 1) * att_buf<64>();
    const bool more = i + 1 < nt;
    if (more) tile_load<64>(tr, kbase, kstride, vbase, vstride, key0f(i + 1), withv);
    body(i, cur);
    if (more) tile_store<64>(tr, lds + ((i + 1) & 1) * att_buf<64>(), withv);
    __syncthreads();
  }
}
DEVI void nsa_item(const Params& p, int l, int b, int qt, unsigned char* lds) {
  const bf16_t* PROJ = (const bf16_t*)(p.ws + WS_B);
  const bf16_t* KC = (const bf16_t*)(p.ws + SM_KC) + (size_t)b * 128 * 64;
  const bf16_t* VC = (const bf16_t*)(p.ws + SM_VC) + (size_t)b * 128 * 64;
  const int tid = threadIdx.x, wv = tid >> 6, lane = tid & 63, r = lane & 31, h = lane >> 5;
  float* psum = (float*)(lds + 2 * att_buf<64>());
  unsigned* selm = (unsigned*)(lds + 2 * att_buf<64>() + 16384);
  const int t0 = qt * 32, cur = t0 >> 6;
  const int ql = wv * 8 + (r >> 2), hd = r & 3, tq = t0 + ql;
  const size_t tg = (size_t)b * S + tq;
  bf16x8 qf[4];
#pragma unroll
  for (int kk = 0; kk < 4; ++kk) qf[kk] = *(const bf16x8*)(PROJ + tg * DINP + C_NQ + hd * 64 + kk * 16 + h * 8);
  unsigned* ofs = (unsigned*)psum + wv * 1024 + lane;
  const float g0 = sigmoidf_(bf2f(PROJ[tg * DINP + C_NG + hd * 3 + 0]));
  const float g1 = sigmoidf_(bf2f(PROJ[tg * DINP + C_NG + hd * 3 + 1]));
  const float g2 = sigmoidf_(bf2f(PROJ[tg * DINP + C_NG + hd * 3 + 2]));
  FState f; fstate_init(f);
  const int ncmp = (t0 + 31 < 31) ? 0 : (((t0 >> 4) >> 6) + 1);
  nsa_stream(lds, KC, 64, VC, 64, true, ncmp, [&](int i) { return i * 64; }, [&](int kt, unsigned char* buf) {
    f32x16 s0, s1;
    qk_tile<64>((const bf16_t*)buf, qf, s0, s1, r, h);
    int rel = ((tq - 31) >> 4) - kt * 64 - 4 * h; asm volatile("" : "+v"(rel));
#pragma unroll
    for (int i = 0; i < 16; ++i) { const int kk2 = (i & 3) + 8 * (i >> 2); if (kk2 > rel) s0[i] = -INFINITY; if (kk2 + 32 > rel) s1[i] = -INFINITY; }
    softmax_pv(f, s0, s1, (const bf16_t*)(buf + att_kbytes<64>()), lane);
  });
  {
    const float muse = (f.m == -INFINITY) ? 0.f : f.m;
    const float il = (f.l > 0.f) ? 1.f / f.l : 0.f;
    if (ncmp < 2) {
#pragma unroll 1
      for (int i = tid; i < 32 * 128; i += NTHREADS) psum[i] = 0.f;
      __syncthreads();
    }
    nsa_stream(lds, KC, 64, VC, 64, false, ncmp, [&](int i) { return i * 64; }, [&](int kt, unsigned char* buf) {
      f32x16 s0, s1;
      qk_tile<64>((const bf16_t*)buf, qf, s0, s1, r, h);
      int rel = ((tq - 31) >> 4) - kt * 64 - 4 * h; asm volatile("" : "+v"(rel));
      int cb0 = kt * 64 + 4 * h; asm volatile("" : "+v"(cb0));
#pragma unroll
      for (int i = 0; i < 16; ++i) {
        const int kk2 = (i & 3) + 8 * (i >> 2); const int c = cb0 + kk2;
        float p0 = (kk2 > rel) ? 0.f : fexp2(s0[i] - muse) * il;
        float p1 = (kk2 + 32 > rel) ? 0.f : fexp2(s1[i] - muse) * il;
        p0 += __shfl_xor(p0, 1); p0 += __shfl_xor(p0, 2);
        p1 += __shfl_xor(p1, 1); p1 += __shfl_xor(p1, 2);
        if (hd == 0) { psum[ql * 128 + c] = p0; psum[ql * 128 + c + 32] = p1; }
      }
    });
  }
  __syncthreads();
#pragma unroll 1
  for (int itq = 0; itq < 4; ++itq) {
    const int q2 = wv * 8 + itq * 2 + (lane >> 5), j = lane & 31;
    const float* ps = psum + q2 * 128;
    float imp = 2.f * (ps[4 * j] + ps[4 * j + 1] + ps[4 * j + 2]) + ps[4 * j + 3];
    if (j > 0) imp += ps[4 * j - 1];
    const bool cand = (j >= 1) && (j <= cur - 2);
    int rank = 0;
    for (int jj = 0; jj < 32; ++jj) {
      const float v = __shfl(imp, (lane & 32) | jj);
      const bool cj = (jj >= 1) && (jj <= cur - 2);
      if (cj && (v > imp || (v == imp && jj < j))) ++rank;
    }
    const bool sel = cand && rank < 2;
    const unsigned long long bal = __ballot(sel);
    unsigned mk = (unsigned)(bal >> (32 * (lane >> 5)));
    mk |= 1u | (1u << cur); if (cur >= 1) mk |= (1u << (cur - 1));
    if (j == 0) selm[q2] = mk;
  }
  __syncthreads();
  unsigned blk_or = 0, wave_or = 0;
  for (int i = 0; i < 32; ++i) blk_or |= selm[i];
  for (int i = 0; i < 8; ++i) wave_or |= selm[wv * 8 + i];
  const unsigned mymask = selm[ql];
  {
    const float sc = (f.l > 0.f) ? g0 / f.l : 0.f;
#pragma unroll
    for (int i = 0; i < 8; ++i) { ofs[i * 64] = pk2bf(f.o0[2 * i] * sc, f.o0[2 * i + 1] * sc); ofs[(8 + i) * 64] = pk2bf(f.o1[2 * i] * sc, f.o1[2 * i + 1] * sc); }
  }
  fstate_init(f);
  {
    unsigned* tl = selm + 32;
    if (tid < 32 && ((blk_or >> tid) & 1u)) tl[__popc(blk_or & ((1u << tid) - 1u))] = tid;
    __syncthreads();
    const int nsel = __popc(blk_or);
    nsa_stream(lds, PROJ + (size_t)b * S * DINP + C_KS, DINP, PROJ + (size_t)b * S * DINP + C_VS, DINP, true, nsel,
      [&](int i) { return (int)tl[i] * 64; },
      [&](int i, unsigned char* buf) {
        const int jj = (int)tl[i];
        if ((wave_or >> jj) & 1u) {
          f32x16 s0, s1;
          qk_tile<64>((const bf16_t*)buf, qf, s0, s1, r, h);
          const bool on = (mymask >> jj) & 1u;
          int rel = on ? (tq - jj * 64 - 4 * h) : -1; asm volatile("" : "+v"(rel));
#pragma unroll
          for (int i2 = 0; i2 < 16; ++i2) { const int kk2 = (i2 & 3) + 8 * (i2 >> 2); if (kk2 > rel) s0[i2] = -INFINITY; if (kk2 + 32 > rel) s1[i2] = -INFINITY; }
          softmax_pv(f, s0, s1, (const bf16_t*)(buf + att_kbytes<64>()), lane);
        }
      });
    const float sc = (f.l > 0.f) ? g1 / f.l : 0.f;
#pragma unroll
    for (int i = 0; i < 8; ++i) {
      const unsigned w0 = ofs[i * 64], w1 = ofs[(8 + i) * 64];
      ofs[i * 64] = pk2bf(__uint_as_float(w0 << 16) + f.o0[2 * i] * sc, __uint_as_float(w0 & 0xffff0000u) + f.o0[2 * i + 1] * sc);
      ofs[(8 + i) * 64] = pk2bf(__uint_as_float(w1 << 16) + f.o1[2 * i] * sc, __uint_as_float(w1 & 0xffff0000u) + f.o1[2 * i + 1] * sc);
    }
  }
  fstate_init(f);
  {
    int jlo = (t0 - 511) >> 6; if (jlo < 0) jlo = 0;
    nsa_stream(lds, PROJ + (size_t)b * S * DINP + C_KW, DINP, PROJ + (size_t)b * S * DINP + C_VW, DINP, true, cur - jlo + 1,
      [&](int i) { return (jlo + i) * 64; },
      [&](int i, unsigned char* buf) {
        const int j = jlo + i;
        f32x16 s0, s1;
        qk_tile<64>((const bf16_t*)buf, qf, s0, s1, r, h);
        if (j == cur || j * 64 < t0 + 31 - 511 + 64) {
          int rel = tq - j * 64 - 4 * h; asm volatile("" : "+v"(rel));
#pragma unroll
          for (int i2 = 0; i2 < 16; ++i2) {
            const int kk2 = (i2 & 3) + 8 * (i2 >> 2);
            if (kk2 > rel || kk2 < rel - 511) s0[i2] = -INFINITY;
            if (kk2 + 32 > rel || kk2 + 32 < rel - 511) s1[i2] = -INFINITY;
          }
        }
        softmax_pv(f, s0, s1, (const bf16_t*)(buf + att_kbytes<64>()), lane);
      });
    const float sc = (f.l > 0.f) ? g2 / f.l : 0.f;
#pragma unroll
    for (int i = 0; i < 8; ++i) {
      const unsigned w0 = ofs[i * 64], w1 = ofs[(8 + i) * 64];
      f.o0[2 * i] = __uint_as_float(w0 << 16) + f.o0[2 * i] * sc; f.o0[2 * i + 1] = __uint_as_float(w0 & 0xffff0000u) + f.o0[2 * i + 1] * sc;
      f.o1[2 * i] = __uint_as_float(w1 << 16) + f.o1[2 * i] * sc; f.o1[2 * i + 1] = __uint_as_float(w1 & 0xffff0000u) + f.o1[2 * i + 1] * sc;
    }
  }
  f32x16& of0 = f.o0; f32x16& of1 = f.o1;
  {
    float ss = 0.f;
#pragma unroll
    for (int i = 0; i < 16; ++i) ss += of0[i] * of0[i] + of1[i] * of1[i];
    ss += __shfl_xor(ss, 1); ss += __shfl_xor(ss, 2); ss += __shfl_xor(ss, 32);
    const float rs = rsqrtf(ss * (1.f / 256) + EPS);
    const float* on = p.in[35] + l * 1024 + 768 + hd * 64;
#pragma unroll
    for (int g4 = 0; g4 < 4; ++g4) {
      const float4 a = *(const float4*)(on + 8 * g4 + 4 * h), b4 = *(const float4*)(on + 32 + 8 * g4 + 4 * h);
      of0[4 * g4] *= a.x; of0[4 * g4 + 1] *= a.y; of0[4 * g4 + 2] *= a.z; of0[4 * g4 + 3] *= a.w;
      of1[4 * g4] *= b4.x; of1[4 * g4 + 1] *= b4.y; of1[4 * g4 + 2] *= b4.z; of1[4 * g4 + 3] *= b4.w;
    }
    store_o((bf16_t*)(p.ws + WS_A) + tg * 1024 + 768 + hd * 64, of0, of1, rs, h);
  }
}

DEVI void carry_item(const Params& p, int l, int it) {
  const int tid = threadIdx.x;
  if (it < 64) {
    const int idx = it * 256 + tid, b = idx >> 10, gs = idx & 1023;
    const float2 a64 = ((const float2*)(p.ws + WS_W + l * WS_WL + W_S5A64))[gs];
    const float2* SLOC = (const float2*)(p.ws + SM_SLOC) + (size_t)b * 32 * 1024 + gs;
    float2* SCAR = (float2*)(p.ws + SM_SCAR) + (size_t)b * 32 * 1024 + gs;
    float hr = 0.f, hi = 0.f;
#pragma unroll 1
    for (int c0 = 0; c0 < 32; c0 += 8) {
      float2 sl[8];
#pragma unroll
      for (int i = 0; i < 8; ++i) sl[i] = SLOC[(size_t)(c0 + i) * 1024];
#pragma unroll
      for (int i = 0; i < 8; ++i) { SCAR[(size_t)(c0 + i) * 1024] = make_float2(hr, hi); const float nr = a64.x * hr - a64.y * hi + sl[i].x, ni = a64.x * hi + a64.y * hr + sl[i].y; hr = nr; hi = ni; }
    }
  } else {
    const int idx = (it - 64) * 256 + tid, b = idx >> 8, c = idx & 255;
    const float2* LSUM = (const float2*)(p.ws + SM_LSUM) + (size_t)b * 32 * 256 + c;
    float* LCAR = (float*)(p.ws + SM_LCAR) + (size_t)b * 32 * 256 + c;
    float hh = 0.f;
#pragma unroll 1
    for (int c0 = 0; c0 < 32; c0 += 8) {
      float2 sv[8];
#pragma unroll
      for (int i = 0; i < 8; ++i) sv[i] = LSUM[(size_t)(c0 + i) * 256];
#pragma unroll
      for (int i = 0; i < 8; ++i) { LCAR[(size_t)(c0 + i) * 256] = hh; hh = sv[i].x * hh + sv[i].y; }
    }
  }
}
DEVI void phase_a1(const Params& p, int l, unsigned char* lds) {
  for (int it = blockIdx.x; it < 80; it += gridDim.x) carry_item(p, l, it);
  const int G_ = (int)gridDim.x;
  const int vb_ = vblock();
  for (int rr = 0;; ++rr) { const int j = rr * G_ + ((rr & 1) ? (G_ - 1 - vb_) : vb_); if (rr * G_ >= 1024) break; if (j < 1024) { const int b = j >> 6, qt = 63 - (j & 63); nsa_item(p, l, b, qt, lds); } }
  __syncthreads();
  for (int rr = 0;; ++rr) { const int j = rr * G_ + ((rr & 1) ? (G_ - 1 - vb_) : vb_); if (rr * G_ >= 1024) break; if (j < 1024) { const int bh = j >> 4, qt = 15 - (j & 15); mla_item(p, l, bh >> 2, bh & 3, qt, lds); } }
}

DEVI void phase_r3(const Params& p, int l, unsigned char* lds) {
  bf16_t* Y = (bf16_t*)(p.ws + WS_A);
  const int tid = threadIdx.x, lane = tid & 63, wv = tid >> 6;
  {
    const float* onorm = p.in[35] + l * 1024 + 256;
    float* tile = (float*)lds;
    for (int it = blockIdx.x; it < NB * 32; it += gridDim.x) {
      const int b = it >> 5, chunk = it & 31;
      __syncthreads();
      lru_chunk<true>(p, l, b, chunk, tile);
      __syncthreads();
      for (int k = wv; k < 64; k += 4) {
        const float4 v = *(const float4*)(tile + k * 256 + lane * 4);
        const float rs = rsqrtf(wsum(v.x * v.x + v.y * v.y + v.z * v.z + v.w * v.w) * (1.f / 256) + EPS);
        const size_t t = (size_t)b * S + chunk * 64 + k;
        const float4 gg = *(const float4*)(onorm + lane * 4);
        st_bf16x4(Y + t * 1024 + 256 + lane * 4, (f32x4){v.x * rs * gg.x, v.y * rs * gg.y, v.z * rs * gg.z, v.w * rs * gg.w});
      }
    }
  }
  __syncthreads();
  for (int it = blockIdx.x; it < NB * 32; it += gridDim.x) s5_chunk<true>(p, l, it >> 5, it & 31, lds);
}

DEVI void phase_g3(const Params& p, int l, unsigned char* lds) {
  const bf16_t* YCP = (const bf16_t*)(p.ws + WS_F);
  bf16_t* YC = (bf16_t*)(p.ws + WS_F) + (size_t)T * 256;
  const bf16_t* W = (const bf16_t*)(p.ws + WS_W + l * WS_WL + W_GLU);
  const float* bg = p.in[26] + l * 256;
  for (int it = vblock(); it < 256 * 2; it += gridDim.x) {
    const int mt = it >> 1, nt = it & 1;
    f32x4 acc[4][4];
    gemm128g(lds, 256, [&](int r, int k) { return YCP + (size_t)(mt * 128 + r) * 256 + k; }, [&](int r, int k) { return W + (size_t)(nt * 128 + r) * 256 + k; }, acc);
    GEMM_EPI4({ const size_t o = (size_t)(mt * 128 + er) * 256 + nt * 128 + ec0; const ushort4 yp = *(const ushort4*)(YCP + o); f32x4 r4; r4[0] = bf2f(yp.x) * sigmoidf_(ev4[0] + bg[nt * 128 + ec0]); r4[1] = bf2f(yp.y) * sigmoidf_(ev4[1] + bg[nt * 128 + ec0 + 1]); r4[2] = bf2f(yp.z) * sigmoidf_(ev4[2] + bg[nt * 128 + ec0 + 2]); r4[3] = bf2f(yp.w) * sigmoidf_(ev4[3] + bg[nt * 128 + ec0 + 3]); st_bf16x4(YC + o, r4); })
  }
}

DEVI void phase_r4(const Params& p, int l) {
  const bf16_t* YA = (const bf16_t*)(p.ws + WS_C);
  const bf16_t* YC = (const bf16_t*)(p.ws + WS_F) + (size_t)T * 256;
  bf16_t* Y = (bf16_t*)(p.ws + WS_A);
  const float* onorm = p.in[35] + l * 1024;
  const int lane = threadIdx.x & 63, gw = blockIdx.x * 4 + (threadIdx.x >> 6), NGW = gridDim.x * 4;
  for (int t = gw; t < T; t += NGW) {
#pragma unroll
    for (int grp = 0; grp < 2; ++grp) {
      const bf16_t* src = (grp == 0 ? YA : YC) + (size_t)t * 256;
      const int gcol = (grp == 0 ? 0 : 512);
      const ushort4 u = ((const ushort4*)src)[lane];
      const float v0 = bf2f(u.x), v1 = bf2f(u.y), v2 = bf2f(u.z), v3 = bf2f(u.w);
      const float rs = rsqrtf(wsum(v0 * v0 + v1 * v1 + v2 * v2 + v3 * v3) * (1.f / 256) + EPS);
      const float4 g = ((const float4*)(onorm + gcol))[lane];
      uint2 o; o.x = pk2bf(v0 * rs * g.x, v1 * rs * g.y); o.y = pk2bf(v2 * rs * g.z, v3 * rs * g.w);
      ((uint2*)(Y + (size_t)t * 1024 + gcol))[lane] = o;
    }
  }
}

DEVI void phase_g4(const Params& p, int l, unsigned char* lds) {
  const bf16_t* Y = (const bf16_t*)(p.ws + WS_A);
  const bf16_t* W = (const bf16_t*)(p.ws + WS_W + l * WS_WL + W_OUT);
  const float* xin = (l == 0) ? p.in[0] : p.out;
  float* out = p.out;
  int par = 0; bool staged = false;
  for (int it = vblock(); it < 256 * 8; it += gridDim.x) {
    const int mt = it >> 3, nt = it & 7;
    f32x4 acc[4][4], xr[4][4];
    {
      const int tid = threadIdx.x, wid = tid >> 6, lane = tid & 63, wr = wid >> 1, wc = wid & 1, fr = lane & 15, fq = lane >> 4;
#pragma unroll
      for (int m = 0; m < 4; ++m)
#pragma unroll
        for (int n = 0; n < 4; ++n) xr[m][n] = *(const f32x4*)(xin + (size_t)(mt * 128 + wr * 64 + m * 16 + fr) * D + nt * 128 + wc * 64 + n * 16 + fq * 4);
    }
    const int itn = it + (int)gridDim.x; const bool hn = itn < 256 * 8; const int mtn = itn >> 3, ntn = itn & 7;
    gemm128p(lds, D, [&](int r, int k) { return Y + (size_t)(mt * 128 + r) * D + k; }, [&](int r, int k) { return W + (size_t)(nt * 128 + r) * D + k; }, acc, par, staged, hn,
             [&](int r, int k) { return Y + (size_t)(mtn * 128 + r) * D + k; }, [&](int r, int k) { return W + (size_t)(ntn * 128 + r) * D + k; });
    staged = hn;
    GEMM_EPI4({ const size_t o = (size_t)(mt * 128 + er) * D + nt * 128 + ec0; *(f32x4*)(out + o) = xr[m][n] + ev4; })
  }
}

DEVI void phase_r5(const Params& p, int l, unsigned char* lds) {
  const float* x1 = p.out;
  bf16_t* XN = (bf16_t*)(p.ws + WS_A);
  const float* g = p.in[37] + l * D;
  const bf16_t* WH = (const bf16_t*)(p.ws + WS_W + l * WS_WL + W_RTH);
  const bf16_t* WL = (const bf16_t*)(p.ws + WS_W + l * WS_WL + W_RTL);
  const float* brg = p.in[39] + l * 4; const float* bre = p.in[41] + l * 16;
  int* CNT = (int*)(p.ws + SM_CNT) + l * 32;
  int* LIST = (int*)(p.ws + SM_LIST);
  float2* TOKW = (float2*)(p.ws + SM_TOKW);
  const int tid = threadIdx.x, lane = tid & 63, wv = tid >> 6, c = lane & 15, q = lane >> 4;
  float* red = (float*)lds;
  int* hist = (int*)(lds + 16384);
  int* tokl = (int*)(lds + 16384 + 256);
  if (tid < 64) hist[tid] = 0;
  int ntok = 0;
  __syncthreads();
  for (int it = blockIdx.x; it < T / 16; it += gridDim.x) {
    const size_t tb = (size_t)it * 16;
    f32x4 a0 = (f32x4){0.f, 0.f, 0.f, 0.f}, a1 = (f32x4){0.f, 0.f, 0.f, 0.f};
    float ss = 0.f;
    const float* xrow = x1 + (tb + c) * D + wv * 256 + 8 * q;
    const bf16_t* wh0 = WH + (size_t)c * 1024 + wv * 256 + 8 * q;
    const bf16_t* wl0 = WL + (size_t)c * 1024 + wv * 256 + 8 * q;
    float4 xk[8][2];
#pragma unroll
    for (int ks = 0; ks < 8; ++ks) { xk[ks][0] = *(const float4*)(xrow + ks * 32); xk[ks][1] = *(const float4*)(xrow + ks * 32 + 4); }
#pragma unroll
    for (int ks = 0; ks < 8; ++ks) {
      const bf16x8 wh_a = *(const bf16x8*)(wh0 + ks * 32), wl_a = *(const bf16x8*)(wl0 + ks * 32);
      const bf16x8 wh_b = *(const bf16x8*)(wh0 + 16 * 1024 + ks * 32), wl_b = *(const bf16x8*)(wl0 + 16 * 1024 + ks * 32);
      const float xv[8] = {xk[ks][0].x, xk[ks][0].y, xk[ks][0].z, xk[ks][0].w, xk[ks][1].x, xk[ks][1].y, xk[ks][1].z, xk[ks][1].w};
      u32x4 hw, lw;
#pragma unroll
      for (int j = 0; j < 4; ++j) {
        const float x0 = xv[2 * j], x1v = xv[2 * j + 1];
        ss += x0 * x0 + x1v * x1v;
        const unsigned hp = pk2bf(x0, x1v);
        hw[j] = hp; lw[j] = pk2bf(x0 - __uint_as_float(hp << 16), x1v - __uint_as_float(hp & 0xffff0000u));
      }
      const bf16x8 xh = __builtin_bit_cast(bf16x8, hw), xl = __builtin_bit_cast(bf16x8, lw);
      a0 = mfma16(wh_a, xh, a0); a0 = mfma16(wh_a, xl, a0); a0 = mfma16(wl_a, xh, a0);
      a1 = mfma16(wh_b, xh, a1); a1 = mfma16(wh_b, xl, a1); a1 = mfma16(wl_b, xh, a1);
    }
    ss += __shfl_xor(ss, 16); ss += __shfl_xor(ss, 32);
    __syncthreads();
#pragma unroll
    for (int j = 0; j < 4; ++j) { red[(wv * 9 + j) * 64 + lane] = a0[j]; red[(wv * 9 + 4 + j) * 64 + lane] = a1[j]; }
    red[(wv * 9 + 8) * 64 + lane] = ss;
    __syncthreads();
    const float s2 = red[8 * 64 + lane] + red[(9 + 8) * 64 + lane] + red[(18 + 8) * 64 + lane] + red[(27 + 8) * 64 + lane];
    const float rs = rsqrtf(s2 * (1.f / D) + EPS);
    {
      bf16_t* xo = XN + (tb + c) * D + wv * 256 + 8 * q;
      const float* gp = g + wv * 256 + 8 * q;
#pragma unroll
      for (int ks = 0; ks < 8; ++ks) {
        const float4 g0 = *(const float4*)(gp + ks * 32), g1 = *(const float4*)(gp + ks * 32 + 4);
        u32x4 o;
        o[0] = pk2bf(xk[ks][0].x * rs * g0.x, xk[ks][0].y * rs * g0.y); o[1] = pk2bf(xk[ks][0].z * rs * g0.z, xk[ks][0].w * rs * g0.w);
        o[2] = pk2bf(xk[ks][1].x * rs * g1.x, xk[ks][1].y * rs * g1.y); o[3] = pk2bf(xk[ks][1].z * rs * g1.z, xk[ks][1].w * rs * g1.w);
        *(u32x4*)(xo + ks * 32) = o;
      }
    }
    if (wv == 0) {
      float c0[4], c1[4];
#pragma unroll
      for (int j = 0; j < 4; ++j) {
        c0[j] = red[j * 64 + lane] + red[(9 + j) * 64 + lane] + red[(18 + j) * 64 + lane] + red[(27 + j) * 64 + lane];
        c1[j] = red[(4 + j) * 64 + lane] + red[(13 + j) * 64 + lane] + red[(22 + j) * 64 + lane] + red[(31 + j) * 64 + lane];
      }
      float lg[20];
#pragma unroll
      for (int qq = 0; qq < 4; ++qq)
#pragma unroll
        for (int j = 0; j < 4; ++j) lg[4 * qq + j] = __shfl(c0[j], c + 16 * qq);
#pragma unroll
      for (int j = 0; j < 4; ++j) lg[16 + j] = __shfl(c1[j], c);
      const int t = (int)tb + c;
      float gl[4];
#pragma unroll
      for (int k2 = 0; k2 < 4; ++k2) gl[k2] = lg[k2] * rs + brg[k2];
      int gi = 0; float gbest = gl[0];
#pragma unroll
      for (int k2 = 1; k2 < 4; ++k2) if (gl[k2] > gbest) { gbest = gl[k2]; gi = k2; }
      float den = 0.f;
#pragma unroll
      for (int k2 = 0; k2 < 4; ++k2) den += expf(gl[k2] - gbest);
      const float pg = 1.f / den;
      float le[4];
#pragma unroll
      for (int k2 = 0; k2 < 4; ++k2) { float sel = 0.f;
#pragma unroll
        for (int gg2 = 0; gg2 < 4; ++gg2) sel = (gi == gg2) ? (lg[4 + gg2 * 4 + k2] * rs + bre[gg2 * 4 + k2]) : sel;
        le[k2] = sel; }
      int i0 = 0; float l0 = le[0];
#pragma unroll
      for (int k2 = 1; k2 < 4; ++k2) if (le[k2] > l0) { l0 = le[k2]; i0 = k2; }
      int i1 = -1; float l1 = -INFINITY;
#pragma unroll
      for (int k2 = 0; k2 < 4; ++k2) if (k2 != i0 && le[k2] > l1) { l1 = le[k2]; i1 = k2; }
      const float e1 = expf(l1 - l0);
      const float w0 = pg / (1.f + e1), w1 = pg * e1 / (1.f + e1);
      const int elo = (i0 < i1) ? i0 : i1, ehi = (i0 < i1) ? i1 : i0;
      const float wlo = (i0 < i1) ? w0 : w1, whi = (i0 < i1) ? w1 : w0;
      const int pidx = (elo == 0) ? (ehi - 1) : ((elo == 1) ? (ehi + 1) : 5);
      const int cls = gi * 6 + pidx;
      if (q == 0) {
        const int rank = atomicAdd(&hist[cls], 1);
        tokl[2 * (ntok + c)] = t; tokl[2 * (ntok + c) + 1] = (cls << 16) | rank;
        TOKW[t] = make_float2(wlo, whi);
      }
    }
    ntok += 16;
  }
  __syncthreads();
  if (tid < 24) { const int n = hist[tid]; hist[32 + tid] = n ? atomicAdd(&CNT[tid], n) : 0; }
  __syncthreads();
  for (int i = tid; i < ntok; i += NTHREADS) { const int t = tokl[2 * i], cr = tokl[2 * i + 1], cls = cr >> 16; LIST[(size_t)cls * T + hist[32 + cls] + (cr & 0xffff)] = t; }
}

struct MoeItem { int cls, mtile, nt, cnt; };
DEVI void moe_prefix(const int* CNT, unsigned char* lds) {
  int* pre = (int*)(lds + LDS_BYTES + 64);
  __syncthreads();
  if (threadIdx.x < 24) pre[32 + threadIdx.x] = CNT[threadIdx.x];
  __syncthreads();
  if (threadIdx.x == 0) { int a = 0; for (int c = 0; c < 24; ++c) { pre[c] = a; a += (pre[32 + c] + 127) >> 7; } pre[24] = a; }
  __syncthreads();
}
DEVI bool moe_item(unsigned char* lds, int it, MoeItem& m) {
  const int* pre = (const int*)(lds + LDS_BYTES + 64);
  const int mt = it >> 3; m.nt = it & 7;
  if (mt >= pre[24]) return false;
  int c = 0;
#pragma unroll
  for (int q = 1; q < 24; ++q) c += (mt >= pre[q]) ? 1 : 0;
  m.cls = c; m.mtile = mt - pre[c]; m.cnt = pre[32 + c];
  return true;
}
DEVI void cls_experts(int cls, int& e0, int& e1) {
  const int g = cls / 6, pi = cls % 6;
  const int lo = (pi < 3) ? 0 : ((pi < 5) ? 1 : 2);
  const int hi = (pi < 3) ? (pi + 1) : ((pi < 5) ? (pi - 1) : 3);
  e0 = g * 4 + lo; e1 = g * 4 + hi;
}
DEVI void phase_g5(const Params& p, int l, unsigned char* lds) {
  const bf16_t* XN = (const bf16_t*)(p.ws + WS_A);
  bf16_t* HID = (bf16_t*)(p.ws + WS_B);
  const bf16_t* WGU = (const bf16_t*)(p.ws + WS_W + l * WS_WL + W_GU);
  const int* CNT = (const int*)(p.ws + SM_CNT) + l * 32;
  const int* LIST = (const int*)(p.ws + SM_LIST);
  const float2* TOKW = (const float2*)(p.ws + SM_TOKW);
  moe_prefix(CNT, lds);
  for (int it = vblock();; it += gridDim.x) {
    MoeItem mi; if (!moe_item(lds, it, mi)) break;
    int e0, e1; cls_experts(mi.cls, e0, e1);
    const int ex = (mi.nt < 4) ? e0 : e1, ntl = mi.nt & 3;
    const bf16_t* W = WGU + ((size_t)ex * 512 + ntl * 128) * 1024;
    const int* list = LIST + (size_t)mi.cls * T + mi.mtile * 128;
    const int nvalid = mi.cnt - mi.mtile * 128;
    f32x4 acc[4][4];
    int tokA[4], tokE[4]; float twE[4];
#pragma unroll
    for (int i = 0; i < 4; ++i) { const int r = (threadIdx.x >> 3) + 32 * i; tokA[i] = list[(r < nvalid) ? r : 0]; }
    {
      const int tid_ = threadIdx.x, er0 = ((tid_ >> 6) >> 1) * 64 + (tid_ & 15);
#pragma unroll
      for (int m = 0; m < 4; ++m) { const int er = er0 + m * 16; tokE[m] = list[(er < nvalid) ? er : 0]; }
#pragma unroll
      for (int m = 0; m < 4; ++m) { const float2 tw = TOKW[tokE[m]]; twE[m] = (mi.nt < 4) ? tw.x : tw.y; }
    }
    gemm128g(lds, D, [&](int r, int k) { const int i = r >> 5; const int tok = (i == 0) ? tokA[0] : (i == 1) ? tokA[1] : (i == 2) ? tokA[2] : tokA[3]; return XN + (size_t)tok * D + k; }, [&](int r, int k) { return W + (size_t)r * D + k; }, acc);
    {
      const int tid = threadIdx.x, wid = tid >> 6, lane = tid & 63, wr = wid >> 1, wc = wid & 1, fr = lane & 15, fq = lane >> 4;
#pragma unroll
      for (int m = 0; m < 4; ++m) {
        const int er = wr * 64 + m * 16 + fr;
        if (er < nvalid) {
          const int tok = tokE[m];
          const float w = twE[m];
#pragma unroll
          for (int n = 0; n < 2; ++n) {
            f32x4 hv;
#pragma unroll
            for (int j = 0; j < 4; ++j) { const float gt = acc[m][n][j], up = acc[m][n + 2][j]; hv[j] = gt * sigmoidf_(gt) * up * w; }
            const int hh = (mi.nt < 4 ? 0 : 256) + ntl * 64 + wc * 32 + n * 16 + fq * 4;
            st_bf16x4(HID + (size_t)tok * 512 + hh, hv);
          }
        }
      }
    }
  }
}
DEVI void phase_g6(const Params& p, int l, unsigned char* lds) {
  const bf16_t* HID = (const bf16_t*)(p.ws + WS_B);
  const bf16_t* WDN = (const bf16_t*)(p.ws + WS_W + l * WS_WL + W_DN);
  const int* CNT = (const int*)(p.ws + SM_CNT) + l * 32;
  const int* LIST = (const int*)(p.ws + SM_LIST);
  float* out = p.out;
  moe_prefix(CNT, lds);
  for (int it = vblock();; it += gridDim.x) {
    MoeItem mi; if (!moe_item(lds, it, mi)) break;
    int e0, e1; cls_experts(mi.cls, e0, e1);
    const int* list = LIST + (size_t)mi.cls * T + mi.mtile * 128;
    const int nvalid = mi.cnt - mi.mtile * 128;
    const bf16_t* W0 = WDN + ((size_t)e0 * 1024 + mi.nt * 128) * 256;
    const bf16_t* W1 = WDN + ((size_t)e1 * 1024 + mi.nt * 128) * 256;
    f32x4 acc[4][4];
    int trow[4], tokA[4];
    {
      const int tid = threadIdx.x, wid = tid >> 6, lane = tid & 63, wr = wid >> 1, fr = lane & 15;
#pragma unroll
      for (int i = 0; i < 4; ++i) { const int r = (tid >> 3) + 32 * i; tokA[i] = list[(r < nvalid) ? r : 0]; }
#pragma unroll
      for (int m = 0; m < 4; ++m) { const int er = wr * 64 + m * 16 + fr; trow[m] = list[(er < nvalid) ? er : 0]; }
    }
    gemm128g(lds, 512, [&](int r, int k) { const int i = r >> 5; const int tok = (i == 0) ? tokA[0] : (i == 1) ? tokA[1] : (i == 2) ? tokA[2] : tokA[3]; return HID + (size_t)tok * 512 + k; },
            [&](int r, int k) { return ((k < 256) ? W0 : W1) + (size_t)r * 256 + (k & 255); }, acc);
    GEMM_EPI4({ if (er < nvalid) { const size_t o = (size_t)trow[m] * D + mi.nt * 128 + ec0; const f32x4 xi = *(const f32x4*)(out + o); *(f32x4*)(out + o) = xi + ev4; } })
  }
}


#define XB_TMO      128
#define XB_XCNT(j)  (256  + 64 * (j))
#define XB_XSUB(j)  (1280 + 64 * (j))
#define XB_XGEN(j)  (2304 + 64 * (j))
#define XB_TOP      3328
#define XB_TOPGEN   3392
#define XCD_BAR_WORDS 3456
#define XB_SPIN_CAP (1u << 18)
DEVI unsigned xb_ld(unsigned* p)              { return __hip_atomic_load(p, __ATOMIC_RELAXED, __HIP_MEMORY_SCOPE_AGENT); }
DEVI unsigned xb_add(unsigned* p, unsigned v) { return __hip_atomic_fetch_add(p, v, __ATOMIC_RELAXED, __HIP_MEMORY_SCOPE_AGENT); }
DEVI unsigned xb_xcc_id() { return (unsigned)__builtin_amdgcn_s_getreg((3 << 11) | 20) & 0xFu; }
#define XB_SPIN(cond, bar) do { unsigned _sp = 0; while (cond) { __builtin_amdgcn_s_sleep(1); \
    if ((++_sp & 255u) == 0u) { if (xb_ld(&(bar)[XB_TMO])) break; if (_sp > XB_SPIN_CAP) { atomicAdd(&(bar)[XB_TMO], 1u); break; } } } } while (0)
struct XcdBarrier { unsigned* bar; unsigned x; volatile LAS unsigned* st; };
DEVI XcdBarrier xcd_barrier_post(unsigned* bar, volatile LAS unsigned* st) {
    XcdBarrier b; b.bar = bar; b.x = xb_xcc_id(); b.st = st;
    if (threadIdx.x == 0) (void)xb_add(&bar[XB_XCNT(b.x)], 1u);
    return b;
}
DEVI void xcd_barrier_complete(unsigned* bar, unsigned x, unsigned& nloc, unsigned& nx) {
    const unsigned G = gridDim.x * gridDim.y * gridDim.z;
    unsigned sum, cnt, mine, sp = 0u;
    for (;;) {
        sum = 0u; cnt = 0u; mine = 0u;
#pragma unroll
        for (unsigned j = 0; j < 16; ++j) { const unsigned c = xb_ld(&bar[XB_XCNT(j)]); sum += c; cnt += (c > 0u) ? 1u : 0u; mine = (j == x) ? c : mine; }
        if (sum == G) break;
        __builtin_amdgcn_s_sleep(1);
        if ((++sp & 255u) == 0u) { if (xb_ld(&bar[XB_TMO])) break; if (sp > XB_SPIN_CAP) { atomicAdd(&bar[XB_TMO], 1u); break; } }
    }
    nloc = mine > 0u ? mine : 1u; nx = cnt > 0u ? cnt : 1u;
}
DEVI void xcd_barrier(const XcdBarrier& b) {
    asm volatile("s_waitcnt vmcnt(0)" ::: "memory");
    __syncthreads();
    if (threadIdx.x == 0) {
        unsigned* bar = b.bar;
        __builtin_amdgcn_s_waitcnt(0);
        unsigned nloc = b.st[0], nx = b.st[1];
        if (nloc == 0u) { xcd_barrier_complete(bar, b.x, nloc, nx); b.st[0] = nloc; b.st[1] = nx; }
        const unsigned old = xb_add(&bar[XB_XSUB(b.x)], 1u);
        const unsigned gen = old / nloc;
        if (old + 1u == (gen + 1u) * nloc) {
            __builtin_amdgcn_fence(__ATOMIC_RELEASE, "agent");
            asm volatile("s_waitcnt vmcnt(0)" ::: "memory");
            const unsigned og = xb_add(&bar[XB_TOP], 1u);
            const unsigned tg = og / nx;
            if (og + 1u == (tg + 1u) * nx) xb_add(&bar[XB_TOPGEN], 1u);
            else XB_SPIN(xb_ld(&bar[XB_TOPGEN]) == tg, bar);
            __builtin_amdgcn_fence(__ATOMIC_ACQUIRE, "agent");
            xb_add(&bar[XB_XGEN(b.x)], 1u);
            asm volatile("s_waitcnt vmcnt(0)" ::: "memory");
        } else {
            XB_SPIN(xb_ld(&bar[XB_XGEN(b.x)]) == gen, bar);
            __builtin_amdgcn_fence(__ATOMIC_ACQUIRE, "agent");
            asm volatile("s_waitcnt vmcnt(0)" ::: "memory");
        }
    }
    __syncthreads();
}

#define PH(k, call) { const int _k = (k); if (p.lo <= _k && _k < p.hi) { call; if (_k + 1 < p.hi) { if (_k == 0) grid.sync(); else xcd_barrier(xbar); } } }
__global__ void __launch_bounds__(NTHREADS, 2) hybrid_fwd(Params p) {
  extern __shared__ __attribute__((aligned(16))) unsigned char lds[];
  cg::grid_group grid = cg::this_grid();
  volatile LAS unsigned* xst = (volatile LAS unsigned*)(LAS unsigned char*)(lds + LDS_BYTES);
  if (threadIdx.x < 4) xst[threadIdx.x] = 0u;
  __syncthreads();
  XcdBarrier xbar = xcd_barrier_post((unsigned*)(p.ws + WS_CTL), xst);
  PH(0, phase_prep(p, lds))
#define LAYER(l) { \
    PH(1 + 13 * l + 0, phase_g1(p, l, lds)) \
    PH(1 + 13 * l + 2, phase_g2(p, l, lds)) \
    PH(1 + 13 * l + 3, phase_r2(p, l, lds)) \
    PH(1 + 13 * l + 4, phase_a1(p, l, lds)) \
    PH(1 + 13 * l + 5, phase_r3(p, l, lds)) \
    PH(1 + 13 * l + 6, phase_g3(p, l, lds)) \
    PH(1 + 13 * l + 7, phase_r4(p, l)) \
    PH(1 + 13 * l + 8, phase_g4(p, l, lds)) \
    PH(1 + 13 * l + 9, phase_r5(p, l, lds)) \
    PH(1 + 13 * l + 10, phase_g5(p, l, lds)) \
    PH(1 + 13 * l + 11, phase_g6(p, l, lds)) }
  LAYER(0)
  PH(13, rmsnorm_rows(p.out, p.in[2] + D, (bf16_t*)(p.ws + WS_A)))
  LAYER(1)
}

extern "C" void kernel_launch(void* const* d_in, const int* in_sizes, int n_in, void* d_out, int out_size, void* d_ws, size_t ws_size, hipStream_t stream) {
  static int grid_blocks = 0;
  if (!grid_blocks) {
    if (n_in != 45 || ws_size < WS_END) { fprintf(stderr, "kernel_launch: unexpected n_in %d or ws_size %zu (< %zu)\n", n_in, ws_size, (size_t)WS_END); grid_blocks = -1; return; }
    int dev = 0, cus = 0, per_cu = 0;
    hipGetDevice(&dev);
    hipDeviceGetAttribute(&cus, hipDeviceAttributeMultiprocessorCount, dev);
    hipFuncSetAttribute((const void*)hybrid_fwd, hipFuncAttributeMaxDynamicSharedMemorySize, LDS_ALLOC);
    hipOccupancyMaxActiveBlocksPerMultiprocessor(&per_cu, (const void*)hybrid_fwd, NTHREADS, LDS_ALLOC);
    if (per_cu < 1) per_cu = 1;
    if (per_cu > 2) per_cu = 2;
    grid_blocks = cus * per_cu;
    fprintf(stderr, "kernel_launch: cus %d per_cu %d grid %d\n", cus, per_cu, grid_blocks);
  }
  if (grid_blocks < 0) return;
  (void)hipMemsetAsync((unsigned char*)d_ws + WS_CTL, 0, XCD_BAR_WORDS * 4, stream);
  Params p{};
  for (int i = 0; i < 45; ++i) p.in[i] = (const float*)d_in[i];
  p.out = (float*)d_out; p.ws = (unsigned char*)d_ws;
#if N_LAUNCH_MODE == 1
  p.lo = 0; p.hi = NPH;
  { void* args[] = {&p}; hipError_t e = hipLaunchCooperativeKernel((void*)hybrid_fwd, dim3(grid_blocks), dim3(NTHREADS), args, LDS_ALLOC, stream);
    if (e != hipSuccess) fprintf(stderr, "cooperative launch failed: %s\n", hipGetErrorString(e)); }
#else
  for (int ph = 0; ph < NPH; ++ph) {
    p.lo = ph; p.hi = ph + 1;
    void* args[] = {&p}; hipError_t e = hipLaunchCooperativeKernel((void*)hybrid_fwd, dim3(grid_blocks), dim3(NTHREADS), args, LDS_ALLOC, stream);
    if (e != hipSuccess) { fprintf(stderr, "launch %d failed: %s\n", ph, hipGetErrorString(e)); break; }
  }
#endif
}
```

```cpp
#include <hip/hip_runtime.h>
#include <hip/hip_cooperative_groups.h>
#include <cstdio>
#include <cstdint>
namespace cg = cooperative_groups;

#ifndef N_LAUNCH_MODE
#define N_LAUNCH_MODE 1
#endif

#define DEVI __device__ __forceinline__
typedef unsigned short bf16_t;
typedef short bf16x8 __attribute__((ext_vector_type(8)));
typedef float f32x4 __attribute__((ext_vector_type(4)));
typedef float f32x16 __attribute__((ext_vector_type(16)));
typedef unsigned u32x4 __attribute__((ext_vector_type(4)));
#define LAS __attribute__((address_space(3)))

constexpr int NB = 16, S = 2048, T = NB * S, D = 1024, DIN = 1772, DINP = 1792, NL = 2;
constexpr int C_CQ = 0, C_KPE = 192, C_NG = 224, C_CKV = 256, C_LX = 384, C_LG = 640, C_S5 = 896, C_NQ = 1152, C_KS = 1408, C_KW = 1472, C_KC = 1536, C_VC = 1600, C_VS = 1664, C_VW = 1728;
__host__ __device__ constexpr int colmap(int n) {
  if (n < 192) return n;
  if (n < 320) return C_CKV + (n - 192);
  if (n < 352) return C_KPE + (n - 320);
  if (n < 608) return C_LX + (n - 352);
  if (n < 864) return C_LG + (n - 608);
  if (n < 1120) return C_S5 + (n - 864);
  if (n < 1376) return C_NQ + (n - 1120);
  if (n < 1760) { const int j = n - 1376, part = j >> 6, d = j & 63; return (part == 0 ? C_KC : part == 1 ? C_VC : part == 2 ? C_KS : part == 3 ? C_VS : part == 4 ? C_KW : C_VW) + d; }
  return C_NG + (n - 1760);
}
constexpr float EPS = 1e-6f;
constexpr float LOG2E = 1.4426950408889634f;
constexpr int NTHREADS = 256;
constexpr int NPH = 1 + 13 * NL - 1;

constexpr size_t MiB = 1u << 20;
constexpr size_t WS_CTL = 0;
constexpr size_t WS_SMALL = 1 * MiB;
constexpr size_t WS_W = 16 * MiB;
constexpr size_t WS_WL = 32 * MiB;
constexpr size_t WS_A = 80 * MiB;
constexpr size_t WS_B = 144 * MiB;
constexpr size_t WS_C = 256 * MiB;
constexpr size_t WS_D = 292 * MiB;
constexpr size_t WS_E = 348 * MiB;
constexpr size_t WS_F = 380 * MiB;
constexpr size_t WS_G = 428 * MiB;
constexpr size_t WS_ROPE = 452 * MiB;
constexpr size_t WS_END = 460 * MiB;
constexpr size_t W_IN = 0;
constexpr size_t W_OUT = 4 * MiB;
constexpr size_t W_UQ = 6 * MiB;
constexpr size_t W_UKV = W_UQ + 384 * 192 * 2;
constexpr size_t W_LRU = W_UKV + 512 * 128 * 2;
constexpr size_t W_GLU = W_LRU + 4 * 128 * 64 * 2;
constexpr size_t W_1K = 6 * MiB + 512 * 1024;
constexpr size_t W_1V = W_1K + 128 * 2048 * 2;
constexpr size_t W_B1K = W_1V + 128 * 2048 * 2;
constexpr size_t W_B1V = W_B1K + 512;
constexpr size_t W_S5A = W_B1V + 512;
constexpr size_t W_S5A64 = W_S5A + 16 * 64 * 8;
constexpr size_t W_S5B = W_S5A64 + 16 * 64 * 8;
constexpr size_t W_S5BB = W_S5B + 16 * 64 * 16 * 8;
constexpr size_t W_S5CM = W_S5BB + 16 * 4 * 32 * 16 * 2;
constexpr size_t W_2K = W_S5CM + 16 * 16 * 128 * 2;
constexpr size_t W_2V = W_2K + 64 * 128 * 2;
static_assert(W_2V + 64 * 128 * 2 <= 8 * MiB, "weights overflow");
constexpr size_t W_RTH = W_2V + 64 * 128 * 2;
constexpr size_t W_RTL = W_RTH + 32 * 1024 * 2;
static_assert(W_RTL + 32 * 1024 * 2 <= 8 * MiB, "weights overflow 2");
constexpr size_t W_GU = 8 * MiB;
constexpr size_t W_DN = 24 * MiB;
constexpr size_t SM_CNT = WS_SMALL;
constexpr size_t SM_LIST = WS_SMALL + 4096;
constexpr size_t SM_TOKW = SM_LIST + 24 * (size_t)T * 4;
constexpr size_t SM_LSUM = SM_TOKW + (size_t)T * 8;
constexpr size_t SM_SLOC = SM_LSUM + 16 * 32 * 256 * 8;
constexpr size_t SM_HK = SM_SLOC + 16 * 32 * 1024 * 8;
constexpr size_t SM_HV = SM_HK + 2048 * 128 * 2;
constexpr size_t SM_KC = SM_HV + 2048 * 128 * 2;
constexpr size_t SM_VC = SM_KC + 16 * 128 * 64 * 2;
constexpr size_t SM_SCAR = SM_VC + 16 * 128 * 64 * 2;
constexpr size_t SM_LCAR = SM_SCAR + 16 * 32 * 1024 * 8;
constexpr size_t SM_END = SM_LCAR + 16 * 32 * 256 * 4;
static_assert(SM_END <= WS_W, "small region overflow");

constexpr int LDS_BYTES = 65536;
constexpr int LDS_ALLOC = LDS_BYTES + 512;

struct Params {
  const float* in[45];
  float* out;
  unsigned char* ws;
  int lo, hi;
};

DEVI float bf2f(bf16_t v) { return __uint_as_float(((unsigned)v) << 16); }
DEVI bf16_t f2bf(float f) { unsigned u = __float_as_uint(f); return (bf16_t)((u + 0x7fffu + ((u >> 16) & 1u)) >> 16); }
DEVI float wsum(float v) {
#pragma unroll
  for (int o = 32; o >= 1; o >>= 1) v += __shfl_xor(v, o);
  return v;
}
DEVI float sigmoidf_(float x) { return __builtin_amdgcn_rcpf(1.f + __expf(-x)); }
DEVI float gelu_tanh(float x) { const float u2 = 1.5957691216057308f * (x + 0.044715f * x * x * x); return x * __builtin_amdgcn_rcpf(1.f + __expf(-u2)); }
DEVI f32x16 mfma32(bf16x8 a, bf16x8 b, f32x16 c) { return __builtin_amdgcn_mfma_f32_32x32x16_bf16(a, b, c, 0, 0, 0); }
DEVI f32x4 mfma16(bf16x8 a, bf16x8 b, f32x4 c) { return __builtin_amdgcn_mfma_f32_16x16x32_bf16(a, b, c, 0, 0, 0); }
DEVI int vblock() { const int G = (int)gridDim.x, bx = (int)blockIdx.x; return (G % 8 == 0) ? (bx % 8) * (G / 8) + bx / 8 : bx; }
DEVI int crow(int r, int h) { return (r & 3) + 8 * (r >> 2) + 4 * h; }
typedef __bf16 bf16x2_t __attribute__((ext_vector_type(2)));
typedef float f32x2_t __attribute__((ext_vector_type(2)));
DEVI unsigned pk2bf(float lo, float hi) { f32x2_t v = {lo, hi}; bf16x2_t b = __builtin_convertvector(v, bf16x2_t); return __builtin_bit_cast(unsigned, b); }

template <class AF, class BF>
DEVI void gemm128(unsigned char* lds, int K, AF aload, BF bptr, f32x4 (&acc)[4][4]) {
  const int tid = threadIdx.x, wid = tid >> 6, lane = tid & 63, wr = wid >> 1, wc = wid & 1, fr = lane & 15, fq = lane >> 4;
#pragma unroll
  for (int m = 0; m < 4; ++m)
#pragma unroll
    for (int n = 0; n < 4; ++n) acc[m][n] = (f32x4){0.f, 0.f, 0.f, 0.f};
  const int lr = tid >> 3, ch = tid & 7;
  const int wofs = lr * 128 + ((ch ^ ((lr >> 1) & 7)) * 16);
  const int sw = (fr >> 1) & 7;
  const int aro = (wr * 64 + fr) * 128, bro = (wc * 64 + fr) * 128;
  const int nk = K >> 6;
  u32x4 ra[4], rb[4];
#pragma unroll
  for (int i = 0; i < 4; ++i) { ra[i] = aload(lr + 32 * i, ch * 8); rb[i] = *(const u32x4*)bptr(lr + 32 * i, ch * 8); }
  __syncthreads();
#pragma unroll
  for (int i = 0; i < 4; ++i) { *(u32x4*)(lds + wofs + i * 4096) = ra[i]; *(u32x4*)(lds + 16384 + wofs + i * 4096) = rb[i]; }
  __syncthreads();
  for (int kt = 0; kt < nk; ++kt) {
    const bool more = (kt + 1 < nk);
    if (more) {
      const int k = (kt + 1) * 64 + ch * 8;
#pragma unroll
      for (int i = 0; i < 4; ++i) { ra[i] = aload(lr + 32 * i, k); rb[i] = *(const u32x4*)bptr(lr + 32 * i, k); }
    }
    const unsigned char* bufA = lds + (kt & 1) * 32768;
    const unsigned char* bufB = bufA + 16384;
#pragma unroll
    for (int kk = 0; kk < 2; ++kk) {
      bf16x8 At[4], Bt[4];
      const int co = ((kk * 4 + fq) ^ sw) * 16;
#pragma unroll
      for (int m = 0; m < 4; ++m) At[m] = *(const bf16x8*)(bufA + aro + m * 2048 + co);
#pragma unroll
      for (int n = 0; n < 4; ++n) Bt[n] = *(const bf16x8*)(bufB + bro + n * 2048 + co);
#pragma unroll
      for (int m = 0; m < 4; ++m)
#pragma unroll
        for (int n = 0; n < 4; ++n) acc[m][n] = mfma16(Bt[n], At[m], acc[m][n]);
    }
    if (more) {
      unsigned char* nb = lds + ((kt + 1) & 1) * 32768;
#pragma unroll
      for (int i = 0; i < 4; ++i) { *(u32x4*)(nb + wofs + i * 4096) = ra[i]; *(u32x4*)(nb + 16384 + wofs + i * 4096) = rb[i]; }
    }
    __syncthreads();
  }
}
template <class AF, class BF>
DEVI void gemm128g(unsigned char* lds, int K, AF aptr, BF bptr, f32x4 (&acc)[4][4]) {
  const int tid = threadIdx.x, wid = tid >> 6, lane = tid & 63, wr = wid >> 1, wc = wid & 1, fr = lane & 15, fq = lane >> 4;
#pragma unroll
  for (int m = 0; m < 4; ++m)
#pragma unroll
    for (int n = 0; n < 4; ++n) acc[m][n] = (f32x4){0.f, 0.f, 0.f, 0.f};
  const int lr = tid >> 3;
  const int chs = ((tid & 7) ^ ((lr >> 1) & 7)) * 8;
  const int sw = (fr >> 1) & 7;
  const int aro = (wr * 64 + fr) * 128, bro = (wc * 64 + fr) * 128;
  const int nk = K >> 6;
  LAS unsigned char* l3 = (LAS unsigned char*)lds;
#define G128_STAGE(buf, kbase)                                                                                                   \
  _Pragma("unroll") for (int i = 0; i < 4; ++i) {                                                                                 \
    __builtin_amdgcn_global_load_lds((const __attribute__((address_space(1))) unsigned*)aptr(lr + 32 * i, (kbase) + chs),          \
                                     (LAS unsigned*)(l3 + (buf) * 32768 + tid * 16 + i * 4096), 16, 0, 0);                           \
    __builtin_amdgcn_global_load_lds((const __attribute__((address_space(1))) unsigned*)bptr(lr + 32 * i, (kbase) + chs),          \
                                     (LAS unsigned*)(l3 + (buf) * 32768 + 16384 + tid * 16 + i * 4096), 16, 0, 0);                   \
  }
  __syncthreads();
  G128_STAGE(0, 0)
  asm volatile("s_waitcnt vmcnt(0)" ::: "memory");
  __syncthreads();
  for (int kt = 0; kt < nk; ++kt) {
    if (kt + 1 < nk) { G128_STAGE((kt + 1) & 1, (kt + 1) * 64) }
    const unsigned char* bufA = lds + (kt & 1) * 32768;
    const unsigned char* bufB = bufA + 16384;
#pragma unroll
    for (int kk = 0; kk < 2; ++kk) {
      bf16x8 At[4], Bt[4];
      const int co = ((kk * 4 + fq) ^ sw) * 16;
#pragma unroll
      for (int m = 0; m < 4; ++m) At[m] = *(const bf16x8*)(bufA + aro + m * 2048 + co);
#pragma unroll
      for (int n = 0; n < 4; ++n) Bt[n] = *(const bf16x8*)(bufB + bro + n * 2048 + co);
#pragma unroll
      for (int m = 0; m < 4; ++m)
#pragma unroll
        for (int n = 0; n < 4; ++n) acc[m][n] = mfma16(Bt[n], At[m], acc[m][n]);
    }
    asm volatile("s_waitcnt vmcnt(0)" ::: "memory");
    __syncthreads();
  }
#undef G128_STAGE
}
template <class AF, class BF, class AF2, class BF2>
DEVI void gemm128p(unsigned char* lds, int K, AF aptr, BF bptr, f32x4 (&acc)[4][4], int& par, bool staged, bool has_next, AF2 naptr, BF2 nbptr) {
  const int tid = threadIdx.x, wid = tid >> 6, lane = tid & 63, wr = wid >> 1, wc = wid & 1, fr = lane & 15, fq = lane >> 4;
#pragma unroll
  for (int m = 0; m < 4; ++m)
#pragma unroll
    for (int n = 0; n < 4; ++n) acc[m][n] = (f32x4){0.f, 0.f, 0.f, 0.f};
  const int lr = tid >> 3;
  const int chs = ((tid & 7) ^ ((lr >> 1) & 7)) * 8;
  const int sw = (fr >> 1) & 7;
  const int aro = (wr * 64 + fr) * 128, bro = (wc * 64 + fr) * 128;
  const int nk = K >> 6;
  LAS unsigned char* l3 = (LAS unsigned char*)lds;
#define GP_STAGE(buf, kbase, AP, BP)                                                                                             \
  _Pragma("unroll") for (int i = 0; i < 4; ++i) {                                                                                 \
    __builtin_amdgcn_global_load_lds((const __attribute__((address_space(1))) unsigned*)AP(lr + 32 * i, (kbase) + chs),            \
                                     (LAS unsigned*)(l3 + (buf) * 32768 + tid * 16 + i * 4096), 16, 0, 0);                           \
    __builtin_amdgcn_global_load_lds((const __attribute__((address_space(1))) unsigned*)BP(lr + 32 * i, (kbase) + chs),            \
                                     (LAS unsigned*)(l3 + (buf) * 32768 + 16384 + tid * 16 + i * 4096), 16, 0, 0);                   \
  }
  if (!staged) {
    __syncthreads();
    GP_STAGE(par, 0, aptr, bptr)
    asm volatile("s_waitcnt vmcnt(0)" ::: "memory");
    __syncthreads();
  }
  for (int kt = 0; kt < nk; ++kt) {
    const int cur = (par + kt) & 1;
    if (kt + 1 < nk) { GP_STAGE(cur ^ 1, (kt + 1) * 64, aptr, bptr) }
    else if (has_next) { GP_STAGE(cur ^ 1, 0, naptr, nbptr) }
    const unsigned char* bufA = lds + cur * 32768;
    const unsigned char* bufB = bufA + 16384;
#pragma unroll
    for (int kk = 0; kk < 2; ++kk) {
      bf16x8 At[4], Bt[4];
      const int co = ((kk * 4 + fq) ^ sw) * 16;
#pragma unroll
      for (int m = 0; m < 4; ++m) At[m] = *(const bf16x8*)(bufA + aro + m * 2048 + co);
#pragma unroll
      for (int n = 0; n < 4; ++n) Bt[n] = *(const bf16x8*)(bufB + bro + n * 2048 + co);
#pragma unroll
      for (int m = 0; m < 4; ++m)
#pragma unroll
        for (int n = 0; n < 4; ++n) acc[m][n] = mfma16(Bt[n], At[m], acc[m][n]);
    }
    asm volatile("s_waitcnt vmcnt(0)" ::: "memory");
    __syncthreads();
  }
  par = (par + nk) & 1;
#undef GP_STAGE
}
template <class AF, class BF>
DEVI void gemm128h(unsigned char* lds, int K, AF aptr, BF bptr, f32x4 (&acc)[2][4]) {
  const int tid = threadIdx.x, wid = tid >> 6, lane = tid & 63, fr = lane & 15, fq = lane >> 4;
#pragma unroll
  for (int m = 0; m < 2; ++m)
#pragma unroll
    for (int n = 0; n < 4; ++n) acc[m][n] = (f32x4){0.f, 0.f, 0.f, 0.f};
  const int lr = tid >> 3;
  const int chs = ((tid & 7) ^ ((lr >> 1) & 7)) * 8;
  const int sw = (fr >> 1) & 7;
  const int aro = (wid * 32 + fr) * 128, bro = fr * 128;
  const int nk = K >> 6;
  LAS unsigned char* l3 = (LAS unsigned char*)lds;
#define GH_STAGE(buf, kbase)                                                                                                     \
  { _Pragma("unroll") for (int i = 0; i < 4; ++i)                                                                                 \
      __builtin_amdgcn_global_load_lds((const __attribute__((address_space(1))) unsigned*)aptr(lr + 32 * i, (kbase) + chs),        \
                                       (LAS unsigned*)(l3 + (buf) * 32768 + tid * 16 + i * 4096), 16, 0, 0);                         \
    _Pragma("unroll") for (int i = 0; i < 2; ++i)                                                                                 \
      __builtin_amdgcn_global_load_lds((const __attribute__((address_space(1))) unsigned*)bptr(lr + 32 * i, (kbase) + chs),        \
                                       (LAS unsigned*)(l3 + (buf) * 32768 + 16384 + tid * 16 + i * 4096), 16, 0, 0); }
  __syncthreads();
  GH_STAGE(0, 0)
  asm volatile("s_waitcnt vmcnt(0)" ::: "memory");
  __syncthreads();
  for (int kt = 0; kt < nk; ++kt) {
    if (kt + 1 < nk) { GH_STAGE((kt + 1) & 1, (kt + 1) * 64) }
    const unsigned char* bufA = lds + (kt & 1) * 32768;
    const unsigned char* bufB = bufA + 16384;
#pragma unroll
    for (int kk = 0; kk < 2; ++kk) {
      bf16x8 At[2], Bt[4];
      const int co = ((kk * 4 + fq) ^ sw) * 16;
#pragma unroll
      for (int m = 0; m < 2; ++m) At[m] = *(const bf16x8*)(bufA + aro + m * 2048 + co);
#pragma unroll
      for (int n = 0; n < 4; ++n) Bt[n] = *(const bf16x8*)(bufB + bro + n * 2048 + co);
#pragma unroll
      for (int m = 0; m < 2; ++m)
#pragma unroll
        for (int n = 0; n < 4; ++n) acc[m][n] = mfma16(Bt[n], At[m], acc[m][n]);
    }
    asm volatile("s_waitcnt vmcnt(0)" ::: "memory");
    __syncthreads();
  }
#undef GH_STAGE
}
#define GEMM_EPI_LOOP(body)                                                                 \
  {                                                                                         \
    const int _tid = threadIdx.x, _wid = _tid >> 6, _lane = _tid & 63, _wr = _wid >> 1, _wc = _wid & 1, _fr = _lane & 15, _fq = _lane >> 4; \
    _Pragma("unroll") for (int m = 0; m < 4; ++m) _Pragma("unroll") for (int n = 0; n < 4; ++n) _Pragma("unroll") for (int j = 0; j < 4; ++j) { \
      const int er = _wr * 64 + m * 16 + _fr, ec = _wc * 64 + n * 16 + _fq * 4 + j; const float ev = acc[m][n][j]; body }                      \
  }
#define GEMM_EPI4(body)                                                                     \
  {                                                                                         \
    const int _tid = threadIdx.x, _wid = _tid >> 6, _lane = _tid & 63, _wr = _wid >> 1, _wc = _wid & 1, _fr = _lane & 15, _fq = _lane >> 4; \
    _Pragma("unroll") for (int m = 0; m < 4; ++m) _Pragma("unroll") for (int n = 0; n < 4; ++n) {                                             \
      const int er = _wr * 64 + m * 16 + _fr, ec0 = _wc * 64 + n * 16 + _fq * 4; const f32x4 ev4 = acc[m][n]; body }                          \
  }
DEVI void st_bf16x4(bf16_t* p, f32x4 v) { uint2 o; o.x = pk2bf(v[0], v[1]); o.y = pk2bf(v[2], v[3]); *(uint2*)p = o; }

template <class RM>
DEVI void transpose_tiles(const float* src, int K, int N, bf16_t* dst, int ldk, RM rowmap, unsigned char* lds, int& cursor, const float* kscale = nullptr) {
  float* tl = (float*)lds;
  const int tk = K / 64, tn = (N + 63) / 64, nt = tk * tn;
  const int tid = threadIdx.x;
  const int G_ = (int)gridDim.x;
  for (int it = ((int)blockIdx.x - cursor % G_ + G_) % G_; it < nt; it += G_) {
    const int kt = it / tn, ntile = it % tn, k0 = kt * 64, n0 = ntile * 64;
    __syncthreads();
#pragma unroll
    for (int q = 0; q < 4; ++q) {
      const int r = (tid >> 4) + 16 * q, c4 = (tid & 15) * 4;
      const float* sp = src + (size_t)(k0 + r) * N + n0 + c4;
      float4 v;
      if (n0 + c4 + 3 < N) v = *(const float4*)sp;
      else { v.x = (n0 + c4 < N) ? sp[0] : 0.f; v.y = (n0 + c4 + 1 < N) ? sp[1] : 0.f; v.z = (n0 + c4 + 2 < N) ? sp[2] : 0.f; v.w = 0.f; }
      if (kscale) { const float ks = kscale[k0 + r]; v.x *= ks; v.y *= ks; v.z *= ks; v.w *= ks; }
      tl[r * 65 + c4] = v.x; tl[r * 65 + c4 + 1] = v.y; tl[r * 65 + c4 + 2] = v.z; tl[r * 65 + c4 + 3] = v.w;
    }
    __syncthreads();
    const int n = tid >> 2, kc = (tid & 3) * 16;
    if (n0 + n < N) {
      unsigned w[8];
#pragma unroll
      for (int i = 0; i < 8; ++i) w[i] = pk2bf(tl[(kc + 2 * i) * 65 + n], tl[(kc + 2 * i + 1) * 65 + n]);
      uint4* o = (uint4*)(dst + (size_t)rowmap(n0 + n) * ldk + k0 + kc);
      o[0] = make_uint4(w[0], w[1], w[2], w[3]); o[1] = make_uint4(w[4], w[5], w[6], w[7]);
    }
  }
  cursor += nt;
}
DEVI void rmsnorm_rows(const float* x, const float* g, bf16_t* xn) {
  const int lane = threadIdx.x & 63, gw = blockIdx.x * 4 + (threadIdx.x >> 6), NGW = gridDim.x * 4;
  float4 gg[4];
#pragma unroll
  for (int j = 0; j < 4; ++j) gg[j] = ((const float4*)g)[lane + 64 * j];
  for (int t0 = gw * 4; t0 < T; t0 += NGW * 4) {
    float4 v[4][4];
#pragma unroll
    for (int q = 0; q < 4; ++q)
#pragma unroll
      for (int j = 0; j < 4; ++j) v[q][j] = ((const float4*)(x + (size_t)(t0 + q) * D))[lane + 64 * j];
#pragma unroll
    for (int q = 0; q < 4; ++q) {
      float s = 0.f;
#pragma unroll
      for (int j = 0; j < 4; ++j) s += v[q][j].x * v[q][j].x + v[q][j].y * v[q][j].y + v[q][j].z * v[q][j].z + v[q][j].w * v[q][j].w;
      const float rs = rsqrtf(wsum(s) * (1.f / D) + EPS);
#pragma unroll
      for (int j = 0; j < 4; ++j) {
        uint2 o; o.x = pk2bf(v[q][j].x * rs * gg[j].x, v[q][j].y * rs * gg[j].y); o.y = pk2bf(v[q][j].z * rs * gg[j].z, v[q][j].w * rs * gg[j].w);
        ((uint2*)(xn + (size_t)(t0 + q) * D))[lane + 64 * j] = o;
      }
    }
  }
}
DEVI void phase_prep(const Params& p, unsigned char* lds) {
  const size_t gtid = (size_t)blockIdx.x * NTHREADS + threadIdx.x, gn = (size_t)gridDim.x * NTHREADS;
  unsigned char* ws = p.ws;
  if (gtid < 64) ((int*)(ws + SM_CNT))[gtid] = 0;
  auto ident = [](int n) { return n; };
  int cursor = 0;
  for (int l = 0; l < NL; ++l) {
    unsigned char* wl = ws + WS_W + l * WS_WL;
    transpose_tiles(p.in[3] + (size_t)l * D * DIN, D, DIN, (bf16_t*)(wl + W_IN), D, [](int n) { return colmap(n); }, lds, cursor);
    for (size_t i = gtid; i < (size_t)20 * D; i += gn) ((bf16_t*)(wl + W_IN))[(size_t)236 * D + i] = 0;
    transpose_tiles(p.in[36] + (size_t)l * D * D, D, D, (bf16_t*)(wl + W_OUT), D, ident, lds, cursor);
    transpose_tiles(p.in[6] + (size_t)l * 192 * 384, 192, 384, (bf16_t*)(wl + W_UQ), 192, ident, lds, cursor, p.in[4] + l * 192);
    transpose_tiles(p.in[7] + (size_t)l * 128 * 512, 128, 512, (bf16_t*)(wl + W_UKV), 128, ident, lds, cursor, p.in[5] + l * 128);
    transpose_tiles(p.in[25] + (size_t)l * 256 * 256, 256, 256, (bf16_t*)(wl + W_GLU), 256, ident, lds, cursor);
    transpose_tiles(p.in[30] + (size_t)l * 2048 * 128, 2048, 128, (bf16_t*)(wl + W_1K), 2048, ident, lds, cursor);
    transpose_tiles(p.in[33] + (size_t)l * 2048 * 128, 2048, 128, (bf16_t*)(wl + W_1V), 2048, ident, lds, cursor);
    transpose_tiles(p.in[31] + (size_t)l * 128 * 64, 128, 64, (bf16_t*)(wl + W_2K), 128, ident, lds, cursor);
    transpose_tiles(p.in[34] + (size_t)l * 128 * 64, 128, 64, (bf16_t*)(wl + W_2V), 128, ident, lds, cursor);
    for (int h = 0; h < 4; ++h) {
      transpose_tiles(p.in[12] + ((size_t)l * 4 + h) * 64 * 64, 64, 64, (bf16_t*)(wl + W_LRU) + h * 128 * 64, 64, ident, lds, cursor);
      transpose_tiles(p.in[14] + ((size_t)l * 4 + h) * 64 * 64, 64, 64, (bf16_t*)(wl + W_LRU) + h * 128 * 64 + 64 * 64, 64, ident, lds, cursor);
    }
    for (int e = 0; e < 16; ++e) {
      bf16_t* dg = (bf16_t*)(wl + W_GU) + (size_t)e * 512 * 1024;
      transpose_tiles(p.in[42] + ((size_t)l * 16 + e) * 1024 * 256, 1024, 256, dg, 1024, [](int hh) { return (hh >> 6) * 128 + ((hh >> 5) & 1) * 64 + ((hh >> 4) & 1) * 16 + (hh & 15); }, lds, cursor);
      transpose_tiles(p.in[43] + ((size_t)l * 16 + e) * 1024 * 256, 1024, 256, dg, 1024, [](int hh) { return (hh >> 6) * 128 + ((hh >> 5) & 1) * 64 + (((hh >> 4) & 1) + 2) * 16 + (hh & 15); }, lds, cursor);
      transpose_tiles(p.in[44] + ((size_t)l * 16 + e) * 256 * 1024, 256, 1024, (bf16_t*)(wl + W_DN) + (size_t)e * 1024 * 256, 256, ident, lds, cursor);
    }
    {
      const int lane = threadIdx.x & 63, gw = blockIdx.x * 4 + (threadIdx.x >> 6), NGW = gridDim.x * 4;
      for (int o = gw; o < 256; o += NGW) {
        const int kv = o >> 7, j = o & 127;
        const float* pe = (kv ? p.in[32] : p.in[29]) + (size_t)l * 2048;
        const float* w1 = (kv ? p.in[33] : p.in[30]) + (size_t)l * 2048 * 128;
        float a = 0.f;
#pragma unroll 8
        for (int k = lane; k < 2048; k += 64) a += pe[k] * w1[(size_t)k * 128 + j];
        a = wsum(a);
        if (lane == 0) ((float*)(wl + (kv ? W_B1V : W_B1K)))[j] = a;
      }
    }
    for (size_t i = gtid; i < 16 * 64; i += gn) {
      const int g = (int)(i >> 6), sidx = (int)(i & 63);
      const float are = p.in[17][(size_t)l * 1024 + i], aim = p.in[18][(size_t)l * 1024 + i];
      const float dt = expf(p.in[19][l * 16 + g]);
      const float mag = expf(dt * are);
      float sn, cs; sincosf(dt * aim, &sn, &cs);
      const float abr = mag * cs, abi = mag * sn;
      const float den = are * are + aim * aim, nre = abr - 1.f;
      const float gre = (nre * are + abi * aim) / den, gim = (abi * are - nre * aim) / den;
      ((float2*)(wl + W_S5A))[i] = make_float2(abr, abi);
      float pr = abr, pi = abi;
#pragma unroll
      for (int q = 0; q < 6; ++q) { const float nr = pr * pr - pi * pi, ni = 2.f * pr * pi; pr = nr; pi = ni; }
      ((float2*)(wl + W_S5A64))[i] = make_float2(pr, pi);
      bf16_t* bb = (bf16_t*)(wl + W_S5BB);
      for (int ch = 0; ch < 16; ++ch) {
        const float br = p.in[20][((size_t)l * 1024 + i) * 16 + ch], bi = p.in[21][((size_t)l * 1024 + i) * 16 + ch];
        const float vr = gre * br - gim * bi, vi = gre * bi + gim * br;
        const int sb = sidx >> 5, r = sidx & 31;
        bb[((g * 4 + sb * 2 + 0) * 32 + r) * 16 + ch] = f2bf(vr);
        bb[((g * 4 + sb * 2 + 1) * 32 + r) * 16 + ch] = f2bf(vi);
      }
    }
    for (size_t i = gtid; i < 32 * 1024; i += gn) {
      const int n = (int)(i >> 10), k = (int)(i & 1023);
      float w = 0.f;
      if (n < 20) w = p.in[37][l * D + k] * ((n < 4) ? p.in[38][((size_t)l * D + k) * 4 + n] : p.in[40][((size_t)l * D + k) * 16 + (n - 4)]);
      const bf16_t hi = f2bf(w);
      ((bf16_t*)(wl + W_RTH))[i] = hi; ((bf16_t*)(wl + W_RTL))[i] = f2bf(w - bf2f(hi));
    }
    for (size_t i = gtid; i < 16 * 16 * 64; i += gn) {
      const int g = (int)(i >> 10), ch = (int)((i >> 6) & 15), pp = (int)(i & 63);
      const float cr = p.in[22][(size_t)l * 16384 + i], ci = p.in[23][(size_t)l * 16384 + i];
      bf16_t* cm = (bf16_t*)(wl + W_S5CM) + ((size_t)(g * 16 + ch) * 128 + 2 * pp);
      cm[0] = f2bf(cr); cm[1] = f2bf(-ci);
    }
  }
  {
    const int* positions = (const int*)p.in[1];
    float2* RM = (float2*)(ws + WS_ROPE);
    float2* RN = RM + (size_t)T * 16;
    for (size_t i = gtid; i < (size_t)T * 24; i += gn) {
      const int t = (int)(i / 24), j = (int)(i % 24);
      const int rot = (j < 16) ? 32 : 16, fi = (j < 16) ? j : (j - 16);
      const float inv = powf(500000.f, -(2.f * (float)fi) / (float)rot);
      float sn, cs; sincosf((float)positions[t] * inv, &sn, &cs);
      if (j < 16) RM[(size_t)t * 16 + fi] = make_float2(cs, sn); else RN[(size_t)t * 8 + fi] = make_float2(cs, sn);
    }
  }
  rmsnorm_rows(p.in[0], p.in[2], (bf16_t*)(ws + WS_A));
}

DEVI void phase_g1(const Params& p, int l, unsigned char* lds) {
  const bf16_t* XN = (const bf16_t*)(p.ws + WS_A);
  const bf16_t* W = (const bf16_t*)(p.ws + WS_W + l * WS_WL + W_IN);
  bf16_t* PROJ = (bf16_t*)(p.ws + WS_B);
  constexpr int NT = DINP / 128;
  int par = 0; bool staged = false;
  for (int it = vblock(); it < (T / 128) * NT; it += gridDim.x) {
    const int mt = it / NT, nt = it % NT;
    const int itn = it + (int)gridDim.x; const bool hn = itn < (T / 128) * NT; const int mtn = itn / NT, ntn = itn % NT;
    f32x4 acc[4][4];
    gemm128p(lds, D, [&](int r, int k) { return XN + (size_t)(mt * 128 + r) * D + k; }, [&](int r, int k) { return W + (size_t)(nt * 128 + r) * D + k; }, acc, par, staged, hn,
             [&](int r, int k) { return XN + (size_t)(mtn * 128 + r) * D + k; }, [&](int r, int k) { return W + (size_t)(ntn * 128 + r) * D + k; });
    staged = hn;
    if (nt >= 9 && nt <= 11) {
      const int tid = threadIdx.x, wid = tid >> 6, lane = tid & 63, wr = wid >> 1, wc = wid & 1, fr = lane & 15, fq = lane >> 4;
      const float* gg = (nt < 11) ? (p.in[27] + l * 64) : (p.in[28] + l * 192 + (wc ? 128 : 64));
      const float sc = (nt < 11) ? (0.125f * LOG2E) : 1.f;
      const float2* RN = (const float2*)(p.ws + WS_ROPE) + (size_t)T * 16;
#pragma unroll
      for (int m = 0; m < 4; ++m) {
        const size_t t = (size_t)mt * 128 + wr * 64 + m * 16 + fr;
        float ss = 0.f;
#pragma unroll
        for (int n = 0; n < 4; ++n) ss += acc[m][n][0] * acc[m][n][0] + acc[m][n][1] * acc[m][n][1] + acc[m][n][2] * acc[m][n][2] + acc[m][n][3] * acc[m][n][3];
        ss += __shfl_xor(ss, 16); ss += __shfl_xor(ss, 32);
        const float rs = rsqrtf(ss * (1.f / 64) + EPS);
#pragma unroll
        for (int n = 0; n < 4; ++n) {
          const float4 g4 = *(const float4*)(gg + n * 16 + fq * 4);
          f32x4 v = acc[m][n];
          v[0] *= rs * g4.x; v[1] *= rs * g4.y; v[2] *= rs * g4.z; v[3] *= rs * g4.w;
          if (n == 0) {
#pragma unroll
            for (int j = 0; j < 4; ++j) {
              const float x = v[j], partner = __shfl_xor(x, 32);
              const int d = fq * 4 + j; const float2 cs2 = RN[t * 8 + (d & 7)];
              v[j] = (d < 8) ? (x * cs2.x - partner * cs2.y) : (partner * cs2.y + x * cs2.x);
            }
          }
          st_bf16x4(PROJ + t * DINP + nt * 128 + wc * 64 + n * 16 + fq * 4, v * sc);
        }
      }
    } else {
      GEMM_EPI4({ st_bf16x4(PROJ + (size_t)(mt * 128 + er) * DINP + nt * 128 + ec0, ev4); })
    }
  }
}

DEVI void phase_g2(const Params& p, int l, unsigned char* lds) {
  unsigned char* wl = p.ws + WS_W + l * WS_WL;
  const bf16_t* PROJ = (const bf16_t*)(p.ws + WS_B);
  bf16_t* QR = (bf16_t*)(p.ws + WS_D);
  bf16_t* KVR = QR + (size_t)T * 384;
  bf16_t* GATES = (bf16_t*)(p.ws + WS_E);
  bf16_t* MK = (bf16_t*)(p.ws + WS_F) + (size_t)T * 4 * 96;
  const float2* RM = (const float2*)(p.ws + WS_ROPE);
  constexpr int N_CMP = 32, N_QR = 256 * 3, N_KVR = 256 * 4, N_GT = 256 * 4;
  const int tid = threadIdx.x, wid = tid >> 6, lane = tid & 63, wr = wid >> 1, wc = wid & 1, fr = lane & 15, fq = lane >> 4;
  for (int it = vblock(); it < N_CMP + N_QR + N_KVR + N_GT; it += gridDim.x) {
    f32x4 acc[4][4];
    if (it < N_CMP) {
      const int kv = it & 1, mt = it >> 1;
      const bf16_t* W = (const bf16_t*)(wl + (kv ? W_1V : W_1K));
      const float* bias = (const float*)(wl + (kv ? W_B1V : W_B1K));
      bf16_t* H = (bf16_t*)(p.ws + (kv ? SM_HV : SM_HK));
      gemm128g(lds, 2048,
              [&](int r, int k) { const int m = mt * 128 + r, b = m >> 7; int c = m & 127; if (c > 126) c = 126;
                                  return PROJ + (size_t)(b * S + 16 * c + (k >> 6)) * DINP + C_KC + kv * 64 + (k & 63); },
              [&](int r, int k) { return W + (size_t)r * 2048 + k; }, acc);
      GEMM_EPI4({ f32x4 o; _Pragma("unroll") for (int j = 0; j < 4; ++j) o[j] = gelu_tanh(ev4[j] + bias[ec0 + j]); st_bf16x4(H + (size_t)(mt * 128 + er) * 128 + ec0, o); })
    } else if (it < N_CMP + N_QR) {
      const int i2 = it - N_CMP, mt = i2 / 3, nt = i2 % 3;
      const bf16_t* W = (const bf16_t*)(wl + W_UQ);
      gemm128g(lds, 192, [&](int r, int k) { return PROJ + (size_t)(mt * 128 + r) * DINP + C_CQ + k; }, [&](int r, int k) { return W + (size_t)(nt * 128 + r) * 192 + k; }, acc);
      GEMM_EPI4({ st_bf16x4(QR + (size_t)(mt * 128 + er) * 384 + nt * 128 + ec0, ev4); })
    } else if (it < N_CMP + N_QR + N_KVR) {
      const int i2 = it - N_CMP - N_QR, mt = i2 >> 2, hd = i2 & 3;
      const bf16_t* W = (const bf16_t*)(wl + W_UKV);
      gemm128g(lds, 128, [&](int r, int k) { return PROJ + (size_t)(mt * 128 + r) * DINP + C_CKV + k; }, [&](int r, int k) { return W + (size_t)(hd * 128 + r) * 128 + k; }, acc);
      const float* g_k = p.in[9] + l * 96;
#pragma unroll
      for (int m = 0; m < 4; ++m) {
        const size_t t = (size_t)mt * 128 + wr * 64 + m * 16 + fr;
        const int b = (int)(t >> 11), sq = (int)(t & (S - 1));
        float ss = 0.f;
        {
          const bf16_t* cr = PROJ + t * DINP + C_CKV + fq * 32;
#pragma unroll
          for (int q = 0; q < 4; ++q) { const u32x4 w = *(const u32x4*)(cr + q * 8);
#pragma unroll
            for (int e = 0; e < 4; ++e) { const float lo = __uint_as_float(w[e] << 16), hi = __uint_as_float(w[e] & 0xffff0000u); ss += lo * lo + hi * hi; } }
        }
        ss += __shfl_xor(ss, 16); ss += __shfl_xor(ss, 32);
        const float rskv = rsqrtf(ss * (1.f / 128) + EPS);
        if (wc == 1) {
#pragma unroll
          for (int n = 0; n < 4; ++n) st_bf16x4(KVR + t * 512 + hd * 128 + 64 + n * 16 + fq * 4, acc[m][n] * rskv);
        } else {
          const uint2 plo = *(const uint2*)(PROJ + t * DINP + C_KPE + 4 * fq), phi = *(const uint2*)(PROJ + t * DINP + C_KPE + 16 + 4 * fq);
          float pl[4] = {__uint_as_float(plo.x << 16), __uint_as_float(plo.x & 0xffff0000u), __uint_as_float(plo.y << 16), __uint_as_float(plo.y & 0xffff0000u)};
          float ph[4] = {__uint_as_float(phi.x << 16), __uint_as_float(phi.x & 0xffff0000u), __uint_as_float(phi.y << 16), __uint_as_float(phi.y & 0xffff0000u)};
          float sk = 0.f;
#pragma unroll
          for (int j = 0; j < 4; ++j) sk += pl[j] * pl[j] + ph[j] * ph[j];
          f32x4 kn[4];
#pragma unroll
          for (int n = 0; n < 4; ++n) { kn[n] = acc[m][n] * rskv; sk += kn[n][0] * kn[n][0] + kn[n][1] * kn[n][1] + kn[n][2] * kn[n][2] + kn[n][3] * kn[n][3]; }
          sk += __shfl_xor(sk, 16); sk += __shfl_xor(sk, 32);
          const float rsk = rsqrtf(sk * (1.f / 96) + EPS);
          bf16_t* dst = MK + ((size_t)(b * 4 + hd) * S + sq) * 96;
          f32x4 olo, ohi;
#pragma unroll
          for (int j = 0; j < 4; ++j) {
            const int d = 4 * fq + j; const float2 cs2 = RM[t * 16 + d];
            const float x1 = pl[j] * rsk * g_k[d], x2 = ph[j] * rsk * g_k[16 + d];
            olo[j] = x1 * cs2.x - x2 * cs2.y; ohi[j] = x1 * cs2.y + x2 * cs2.x;
          }
          st_bf16x4(dst + 4 * fq, olo); st_bf16x4(dst + 16 + 4 * fq, ohi);
#pragma unroll
          for (int n = 0; n < 4; ++n) { const float4 g4 = *(const float4*)(g_k + 32 + n * 16 + fq * 4); f32x4 o = kn[n] * rsk; o[0] *= g4.x; o[1] *= g4.y; o[2] *= g4.z; o[3] *= g4.w; st_bf16x4(dst + 32 + n * 16 + fq * 4, o); }
        }
      }
    } else {
      const int i2 = it - N_CMP - N_QR - N_KVR, mt = i2 >> 2, h = i2 & 3;
      const bf16_t* W = (const bf16_t*)(wl + W_LRU) + h * 128 * 64;
      const int c0 = h * 64 + (tid & 7) * 8;
      const float* cw = p.in[10] + l * 4 * 256 + c0; const float* cbp = p.in[11] + l * 256 + c0;
      gemm128(lds, 64,
              [&](int r, int k) {
                const size_t t = (size_t)mt * 128 + r; const int sq = (int)(t & (S - 1));
                float u[8];
#pragma unroll
                for (int e = 0; e < 8; ++e) u[e] = cbp[e];
#pragma unroll
                for (int j = 0; j < 4; ++j) {
                  if (sq - 3 + j >= 0) {
                    const u32x4 w = *(const u32x4*)(PROJ + (t - 3 + j) * DINP + C_LX + h * 64 + k);
#pragma unroll
                    for (int e = 0; e < 4; ++e) { u[2 * e] += __uint_as_float(w[e] << 16) * cw[j * 256 + 2 * e]; u[2 * e + 1] += __uint_as_float(w[e] & 0xffff0000u) * cw[j * 256 + 2 * e + 1]; }
                  }
                }
                u32x4 o; o[0] = pk2bf(u[0], u[1]); o[1] = pk2bf(u[2], u[3]); o[2] = pk2bf(u[4], u[5]); o[3] = pk2bf(u[6], u[7]);
                return o; },
              [&](int r, int k) { return W + (size_t)r * 64 + k; }, acc);
      GEMM_EPI4({ st_bf16x4(GATES + (size_t)(mt * 128 + er) * 512 + h * 128 + ec0, ev4); })
    }
  }
}

DEVI void lru_ab(float u, float rpre, float ipre, float sp, bool first, float& a, float& b) {
  const float r = sigmoidf_(rpre), gi = sigmoidf_(ipre);
  const float la = -8.f * r * sp;
  a = __expf(la);
  const float x = 2.f * la;
  const float om = (x > -0.1f) ? (-x * (1.f + 0.5f * x * (1.f + (1.f / 3.f) * x * (1.f + 0.25f * x * (1.f + 0.2f * x))))) : (1.f - a * a);
  const float mult = first ? 1.f : sqrtf(fmaxf(om, 0.f));
  b = mult * gi * u;
}
DEVI float lru_conv(const bf16_t* PROJ, int t, int s, int c, const float* cw, float cb) {
  float u = cb;
#pragma unroll
  for (int j = 0; j < 4; ++j) { const int ss2 = s - 3 + j; if (ss2 >= 0) u += bf2f(PROJ[(size_t)(t - 3 + j) * DINP + C_LX + c]) * cw[j * 256 + c]; }
  return u;
}

template <bool FULL>
DEVI void s5_chunk(const Params& p, int l, int b, int chunk, unsigned char* lds) {
  unsigned char* wl = p.ws + WS_W + l * WS_WL;
  const bf16_t* PROJ = (const bf16_t*)(p.ws + WS_B);
  const float2* Abar = (const float2*)(wl + W_S5A);
  const bf16_t* BB = (const bf16_t*)(wl + W_S5BB);
  const bf16_t* CM = (const bf16_t*)(wl + W_S5CM);
  float2* SLOC = (float2*)(p.ws + SM_SLOC);
  bf16_t* YCP = (bf16_t*)(p.ws + WS_F);
  const float* dd = p.in[24] + l * 256;
  const int tid = threadIdx.x, wv = tid >> 6, lane = tid & 63, r = lane & 31, h = lane >> 5, fr = lane & 15, fq = lane >> 4;
  unsigned* Hs = (unsigned*)(lds + wv * 8704);
  const int t0 = b * S + chunk * 64;
#pragma unroll 1
  for (int gi = 0; gi < 4; ++gi) {
    const int g = wv * 4 + gi;
    bf16x8 bbf[4];
#pragma unroll
    for (int nb = 0; nb < 4; ++nb) bbf[nb] = *(const bf16x8*)(BB + ((g * 4 + nb) * 32 + r) * 16 + 8 * h);
    float2 Ac[2]; float hr[2], hi[2];
#pragma unroll
    for (int sb = 0; sb < 2; ++sb) {
      Ac[sb] = Abar[g * 64 + sb * 32 + r];
      hr[sb] = 0.f; hi[sb] = 0.f;
      if (FULL) { const float2 cin = ((const float2*)(p.ws + SM_SCAR))[((size_t)(b * 32 + chunk) * 16 + g) * 64 + sb * 32 + r]; hr[sb] = cin.x; hi[sb] = cin.y; }
    }
    bf16x8 cm[4];
    float4 dcol4 = make_float4(0.f, 0.f, 0.f, 0.f);
    if (FULL) {
#pragma unroll
      for (int kk = 0; kk < 4; ++kk) cm[kk] = *(const bf16x8*)(CM + (size_t)(g * 16 + fr) * 128 + kk * 32 + 8 * fq);
      dcol4 = *(const float4*)(dd + g * 16 + 4 * fq);
    }
#pragma unroll 1
    for (int tb = 0; tb < 2; ++tb) {
      const bf16x8 ua = *(const bf16x8*)(PROJ + (size_t)(t0 + tb * 32 + r) * DINP + C_S5 + g * 16 + 8 * h);
      f32x16 acc[4];
#pragma unroll
      for (int nb = 0; nb < 4; ++nb) {
        f32x16 z;
#pragma unroll
        for (int i = 0; i < 16; ++i) z[i] = 0.f;
        acc[nb] = mfma32(ua, bbf[nb], z);
      }
#pragma unroll
      for (int sb = 0; sb < 2; ++sb) {
        float sr = hr[sb], si = hi[sb];
        const float ax = Ac[sb].x, ay = Ac[sb].y;
#pragma unroll
        for (int q = 0; q < 4; ++q)
#pragma unroll
          for (int owner = 0; owner < 2; ++owner) {
#pragma unroll
            for (int i = 0; i < 4; ++i) {
              const int reg = 4 * q + i;
              const float br = acc[2 * sb][reg], bi = acc[2 * sb + 1][reg];
              const float nr = ax * sr - ay * si + br, ni = ax * si + ay * sr + bi; sr = nr; si = ni;
              if (FULL) { acc[2 * sb][reg] = (h == owner) ? sr : br; acc[2 * sb + 1][reg] = (h == owner) ? si : bi; }
            }
            const float orr = __shfl_xor(sr, 32), oi = __shfl_xor(si, 32);
            if (h != owner) { sr = orr; si = oi; }
          }
        hr[sb] = sr; hi[sb] = si;
      }
      if (FULL) {
#pragma unroll
        for (int sb = 0; sb < 2; ++sb)
#pragma unroll
          for (int reg = 0; reg < 16; ++reg)
            Hs[crow(reg, h) * 68 + sb * 32 + r] = pk2bf(acc[2 * sb][reg], acc[2 * sb + 1][reg]);
#pragma unroll
        for (int tb16 = 0; tb16 < 2; ++tb16) {
          f32x4 y = (f32x4){0.f, 0.f, 0.f, 0.f};
#pragma unroll
          for (int kk = 0; kk < 4; ++kk) { const bf16x8 a = *(const bf16x8*)((const bf16_t*)Hs + (tb16 * 16 + fr) * 136 + kk * 32 + 8 * fq); y = mfma16(cm[kk], a, y); }
          const size_t t = (size_t)t0 + tb * 32 + tb16 * 16 + fr; const int col = g * 16 + 4 * fq;
          const uint2 uw = *(const uint2*)(PROJ + t * DINP + C_S5 + col);
          f32x4 o;
          o[0] = gelu_tanh(y[0] + dcol4.x * __uint_as_float(uw.x << 16)); o[1] = gelu_tanh(y[1] + dcol4.y * __uint_as_float(uw.x & 0xffff0000u));
          o[2] = gelu_tanh(y[2] + dcol4.z * __uint_as_float(uw.y << 16)); o[3] = gelu_tanh(y[3] + dcol4.w * __uint_as_float(uw.y & 0xffff0000u));
          st_bf16x4(YCP + t * 256 + col, o);
        }
      }
    }
    if (!FULL) {
#pragma unroll
      for (int sb = 0; sb < 2; ++sb) if (h == 0) SLOC[((size_t)(b * 32 + chunk) * 16 + g) * 64 + sb * 32 + r] = make_float2(hr[sb], hi[sb]);
    }
  }
}

template <bool FULL>
DEVI void lru_chunk(const Params& p, int l, int b, int chunk, float* tile) {
  const bf16_t* PROJ = (const bf16_t*)(p.ws + WS_B);
  const bf16_t* GATES = (const bf16_t*)(p.ws + WS_E);
  float2* LSUM = (float2*)(p.ws + SM_LSUM);
  const int c = threadIdx.x, h = c >> 6, j = c & 63;
  const float* cw = p.in[10] + l * 4 * 256;
  const float w0 = cw[c], w1 = cw[256 + c], w2 = cw[512 + c], w3 = cw[768 + c], cb = p.in[11][l * 256 + c];
  const float ba = p.in[13][l * 256 + c], bi = p.in[15][l * 256 + c];
  const float sp = log1pf(expf(-p.in[16][l * 256 + c]));
  const int s0 = chunk * 64; const size_t t0 = (size_t)b * S + s0;
  float xm3 = 0.f, xm2 = 0.f, xm1 = 0.f;
  if (s0 > 0) { xm3 = bf2f(PROJ[(t0 - 3) * DINP + C_LX + c]); xm2 = bf2f(PROJ[(t0 - 2) * DINP + C_LX + c]); xm1 = bf2f(PROJ[(t0 - 1) * DINP + C_LX + c]); }
  float hh = 0.f, ap = 1.f;
  if (FULL) hh = ((const float*)(p.ws + SM_LCAR))[(size_t)(b * 32 + chunk) * 256 + c];
#pragma unroll 1
  for (int k0 = 0; k0 < 64; k0 += 8) {
    float xv[8], rp[8], ip[8], gt[8];
#pragma unroll
    for (int i = 0; i < 8; ++i) {
      const size_t t = t0 + k0 + i;
      xv[i] = bf2f(PROJ[t * DINP + C_LX + c]);
      rp[i] = bf2f(GATES[t * 512 + h * 128 + j]); ip[i] = bf2f(GATES[t * 512 + h * 128 + 64 + j]);
      gt[i] = FULL ? bf2f(PROJ[t * DINP + C_LG + c]) : 0.f;
    }
#pragma unroll
    for (int i = 0; i < 8; ++i) {
      const float u = cb + xm3 * w0 + xm2 * w1 + xm1 * w2 + xv[i] * w3;
      xm3 = xm2; xm2 = xm1; xm1 = xv[i];
      float a, bb; lru_ab(u, rp[i] + ba, ip[i] + bi, sp, (s0 + k0 + i) == 0, a, bb);
      hh = a * hh + bb; ap *= a;
      if (FULL) tile[(k0 + i) * 256 + c] = hh * gelu_tanh(gt[i]);
    }
  }
  if (!FULL) LSUM[(size_t)(b * 32 + chunk) * 256 + c] = make_float2(ap, hh);
}

DEVI void phase_r2(const Params& p, int l, unsigned char* lds) {
  unsigned char* wl = p.ws + WS_W + l * WS_WL;
  const bf16_t* PROJ = (const bf16_t*)(p.ws + WS_B);
  const bf16_t* QR = (const bf16_t*)(p.ws + WS_D);
  const bf16_t* KVR = QR + (size_t)T * 384;
  const bf16_t* GATES = (const bf16_t*)(p.ws + WS_E);
  bf16_t* MQ = (bf16_t*)(p.ws + WS_F);
  bf16_t* MK = MQ + (size_t)T * 4 * 96;
  const float2* RM = (const float2*)(p.ws + WS_ROPE);
  const float2* RN = RM + (size_t)T * 16;
  const int tid = threadIdx.x, lane = tid & 63, wv = tid >> 6;
  for (int it = blockIdx.x; it < NB * 32; it += gridDim.x) lru_chunk<false>(p, l, it >> 5, it & 31, nullptr);
  __syncthreads();
  for (int it = blockIdx.x; it < NB * 32; it += gridDim.x) s5_chunk<false>(p, l, it >> 5, it & 31, lds);
  {
    const bf16_t* HK = (const bf16_t*)(p.ws + SM_HK); const bf16_t* HV = (const bf16_t*)(p.ws + SM_HV);
    bf16_t* KC = (bf16_t*)(p.ws + SM_KC); bf16_t* VC = (bf16_t*)(p.ws + SM_VC);
    const bf16_t* W2K = (const bf16_t*)(wl + W_2K); const bf16_t* W2V = (const bf16_t*)(wl + W_2V);
    const float* g0 = p.in[28] + l * 192;
    for (int it = blockIdx.x; it < 32; it += gridDim.x) {
      const int kv = it & 1, mt = it >> 1;
      const bf16_t* H = kv ? HV : HK; const bf16_t* W2 = kv ? W2V : W2K;
      f32x4 acc[4][4];
      __syncthreads();
      gemm128g(lds, 128, [&](int r, int k) { return H + (size_t)(mt * 128 + r) * 128 + k; }, [&](int r, int k) { return W2 + (size_t)(r & 63) * 128 + k; }, acc);
      const int wid = tid >> 6, wr = wid >> 1, wc = wid & 1, fr = lane & 15, fq = lane >> 4;
      if (wc == 0) {
#pragma unroll
        for (int m = 0; m < 4; ++m) {
          const int row = mt * 128 + wr * 64 + m * 16 + fr, b = row >> 7, c = row & 127;
          f32x4 v[4];
#pragma unroll
          for (int n = 0; n < 4; ++n) v[n] = acc[m][n];
          if (kv == 0) {
            float ss = 0.f;
#pragma unroll
            for (int n = 0; n < 4; ++n) ss += v[n][0] * v[n][0] + v[n][1] * v[n][1] + v[n][2] * v[n][2] + v[n][3] * v[n][3];
            ss += __shfl_xor(ss, 16); ss += __shfl_xor(ss, 32);
            const float rs = rsqrtf(ss * (1.f / 64) + EPS);
#pragma unroll
            for (int n = 0; n < 4; ++n) { const float4 gg = *(const float4*)(g0 + n * 16 + fq * 4); v[n][0] *= rs * gg.x; v[n][1] *= rs * gg.y; v[n][2] *= rs * gg.z; v[n][3] *= rs * gg.w; }
            const int cc = (c < 127) ? c : 126;
            const float2* cs = RN + (size_t)(b * S + 16 * cc + 31) * 8;
#pragma unroll
            for (int j = 0; j < 4; ++j) {
              const float x = v[0][j], partner = __shfl_xor(x, 32);
              const int d = fq * 4 + j; const float2 cs2 = cs[d & 7];
              v[0][j] = (d < 8) ? (x * cs2.x - partner * cs2.y) : (partner * cs2.y + x * cs2.x);
            }
          }
          bf16_t* dst = (kv ? VC : KC) + (size_t)row * 64;
#pragma unroll
          for (int n = 0; n < 4; ++n) { f32x4 o = v[n]; if (c >= 127) o = (f32x4){0.f, 0.f, 0.f, 0.f}; st_bf16x4(dst + n * 16 + fq * 4, o); }
        }
      }
    }
  }
}

typedef short v4i16_t __attribute__((ext_vector_type(4)));
DEVI float fexp2(float x) { return __builtin_amdgcn_exp2f(x); }
constexpr int VST = 96;
constexpr int ATT_VBYTES = 64 * VST * 2;
template <int DK> constexpr int att_kbytes() { return 64 * (DK + 8) * 2; }
template <int DK> constexpr int att_buf() { return att_kbytes<DK>() + ATT_VBYTES; }
template <int DK> struct TileRegs { u32x4 k[DK / 32]; u32x4 v[2]; };
template <int DK>
DEVI void tile_load(TileRegs<DK>& tr, const bf16_t* kbase, size_t kstride, const bf16_t* vbase, size_t vstride, int key0, bool withv = true) {
  constexpr int CH = DK / 8;
#pragma unroll
  for (int i = 0; i < DK / 32; ++i) { const int c = threadIdx.x + 256 * i, r = c / CH, cc = c % CH; tr.k[i] = *(const u32x4*)(kbase + (size_t)(key0 + r) * kstride + cc * 8); }
  if (withv) {
#pragma unroll
    for (int i = 0; i < 2; ++i) { const int c = threadIdx.x + 256 * i, r = c >> 3, cc = c & 7; tr.v[i] = *(const u32x4*)(vbase + (size_t)(key0 + r) * vstride + cc * 8); }
  }
}
template <int DK>
DEVI void tile_store(const TileRegs<DK>& tr, unsigned char* buf, bool withv = true) {
  constexpr int CH = DK / 8;
  bf16_t* sK = (bf16_t*)buf; bf16_t* sV = (bf16_t*)(buf + att_kbytes<DK>());
#pragma unroll
  for (int i = 0; i < DK / 32; ++i) { const int c = threadIdx.x + 256 * i, r = c / CH, cc = c % CH; *(u32x4*)(sK + r * (DK + 8) + cc * 8) = tr.k[i]; }
  if (withv) {
#pragma unroll
    for (int i = 0; i < 2; ++i) { const int c = threadIdx.x + 256 * i, r = c >> 3, cc = c & 7; *(u32x4*)(sV + r * VST + cc * 8) = tr.v[i]; }
  }
}
template <int DK>
DEVI void qk_tile(const bf16_t* sK, const bf16x8* qf, f32x16& s0, f32x16& s1, int r, int h) {
#pragma unroll
  for (int i = 0; i < 16; ++i) { s0[i] = 0.f; s1[i] = 0.f; }
#pragma unroll
  for (int kk = 0; kk < DK / 16; ++kk) {
    const bf16x8 a0 = *(const bf16x8*)(sK + r * (DK + 8) + kk * 16 + h * 8);
    const bf16x8 a1 = *(const bf16x8*)(sK + (32 + r) * (DK + 8) + kk * 16 + h * 8);
    s0 = mfma32(a0, qf[kk], s0);
    s1 = mfma32(a1, qf[kk], s1);
  }
}
struct FState { f32x16 o0, o1; float m, l; };
DEVI void fstate_init(FState& f) {
#pragma unroll
  for (int i = 0; i < 16; ++i) { f.o0[i] = 0.f; f.o1[i] = 0.f; }
  f.m = -INFINITY; f.l = 0.f;
}
DEVI v4i16_t vtr(const bf16_t* p) { return __builtin_amdgcn_ds_read_tr16_b64_v4i16((LAS v4i16_t*)p); }
DEVI void softmax_pv(FState& f, f32x16& s0, f32x16& s1, const bf16_t* sV, int lane) {
  const int h = lane >> 5;
  float mx = -INFINITY;
#pragma unroll
  for (int i = 0; i < 16; ++i) mx = fmaxf(mx, fmaxf(s0[i], s1[i]));
  mx = fmaxf(mx, __shfl_xor(mx, 32));
  const float mnew = fmaxf(f.m, mx);
  const float muse = (mnew == -INFINITY) ? 0.f : mnew;
  float ps = 0.f;
#pragma unroll
  for (int i = 0; i < 16; ++i) { s0[i] = fexp2(s0[i] - muse); s1[i] = fexp2(s1[i] - muse); ps += s0[i] + s1[i]; }
  ps += __shfl_xor(ps, 32);
  if (__any(mnew != f.m)) {
    const float alpha = fexp2(f.m - muse);
    f.l = f.l * alpha + ps; f.m = mnew;
#pragma unroll
    for (int i = 0; i < 16; ++i) { f.o0[i] *= alpha; f.o1[i] *= alpha; }
  } else {
    f.l += ps;
  }
  const int g = lane >> 4, li = lane & 15, q = li >> 2, pp = li & 3;
  const bf16_t* vb = sV + (4 * h + q) * VST + (g & 1) * 16 + 4 * pp;
#pragma unroll
  for (int kb = 0; kb < 2; ++kb)
#pragma unroll
    for (int s = 0; s < 2; ++s) {
      unsigned pw[4];
#pragma unroll
      for (int j = 0; j < 4; ++j) pw[j] = kb ? pk2bf(s1[8 * s + 2 * j], s1[8 * s + 2 * j + 1]) : pk2bf(s0[8 * s + 2 * j], s0[8 * s + 2 * j + 1]);
      const bf16x8 pb = __builtin_bit_cast(bf16x8, (u32x4){pw[0], pw[1], pw[2], pw[3]});
#pragma unroll
      for (int db = 0; db < 2; ++db) {
        const v4i16_t lo = vtr(vb + (kb * 32 + 16 * s) * VST + db * 32);
        const v4i16_t hi = vtr(vb + (kb * 32 + 16 * s + 8) * VST + db * 32);
        const bf16x8 a = {lo[0], lo[1], lo[2], lo[3], hi[0], hi[1], hi[2], hi[3]};
        if (db == 0) f.o0 = mfma32(a, pb, f.o0); else f.o1 = mfma32(a, pb, f.o1);
      }
    }
}
DEVI void store_o(bf16_t* orow, const f32x16& o0, const f32x16& o1, float sc, int h) {
#pragma unroll
  for (int g = 0; g < 4; ++g) {
    uint2 v0, v1;
    v0.x = pk2bf(o0[4 * g] * sc, o0[4 * g + 1] * sc); v0.y = pk2bf(o0[4 * g + 2] * sc, o0[4 * g + 3] * sc);
    v1.x = pk2bf(o1[4 * g] * sc, o1[4 * g + 1] * sc); v1.y = pk2bf(o1[4 * g + 2] * sc, o1[4 * g + 3] * sc);
    *(uint2*)(orow + 8 * g + 4 * h) = v0;
    *(uint2*)(orow + 32 + 8 * g + 4 * h) = v1;
  }
}

DEVI void mla_item(const Params& p, int l, int b, int hd, int qt, unsigned char* lds) {
  const bf16_t* MQ = (const bf16_t*)(p.ws + WS_F);
  const bf16_t* MK = MQ + (size_t)T * 4 * 96;
  const bf16_t* KVR = (const bf16_t*)(p.ws + WS_D) + (size_t)T * 384;
  bf16_t* YA = (bf16_t*)(p.ws + WS_C);
  const int tid = threadIdx.x, wv = tid >> 6, lane = tid & 63, r = lane & 31, h = lane >> 5;
  const int q0 = qt * 128 + wv * 32, tq = q0 + r;
  bf16x8 qf[6];
  {
    const bf16_t* qrow = (const bf16_t*)(p.ws + WS_D) + ((size_t)b * S + tq) * 384 + hd * 96;
    const float* g_q = p.in[8] + l * 96;
    float qv[6][8]; float ss = 0.f;
#pragma unroll
    for (int kk = 0; kk < 6; ++kk) {
      const u32x4 w = *(const u32x4*)(qrow + kk * 16 + h * 8);
#pragma unroll
      for (int e = 0; e < 4; ++e) { qv[kk][2 * e] = __uint_as_float(w[e] << 16); qv[kk][2 * e + 1] = __uint_as_float(w[e] & 0xffff0000u); ss += qv[kk][2 * e] * qv[kk][2 * e] + qv[kk][2 * e + 1] * qv[kk][2 * e + 1]; }
    }
    ss += __shfl_xor(ss, 32);
    const float rs = rsqrtf(ss * (1.f / 96) + EPS) * (0.10206207261596575f * LOG2E);
#pragma unroll
    for (int kk = 0; kk < 6; ++kk)
#pragma unroll
      for (int j = 0; j < 8; ++j) qv[kk][j] *= rs * g_q[kk * 16 + h * 8 + j];
    const float2* cs = (const float2*)(p.ws + WS_ROPE) + ((size_t)b * S + tq) * 16 + 8 * h;
#pragma unroll
    for (int j = 0; j < 8; ++j) { const float2 c2 = cs[j]; const float x1 = qv[0][j], x2 = qv[1][j]; qv[0][j] = x1 * c2.x - x2 * c2.y; qv[1][j] = x1 * c2.y + x2 * c2.x; }
#pragma unroll
    for (int kk = 0; kk < 6; ++kk) { const u32x4 w = {pk2bf(qv[kk][0], qv[kk][1]), pk2bf(qv[kk][2], qv[kk][3]), pk2bf(qv[kk][4], qv[kk][5]), pk2bf(qv[kk][6], qv[kk][7])}; qf[kk] = __builtin_bit_cast(bf16x8, w); }
  }
  FState f; fstate_init(f);
  const bf16_t* kbase = MK + (size_t)(b * 4 + hd) * S * 96;
  const bf16_t* vbase = KVR + (size_t)b * S * 512 + hd * 128 + 64;
  const int ntiles = 2 * qt + 2;
  TileRegs<96> tr;
  TileRegs<96> tr2;
  tile_load<96>(tr, kbase, 96, vbase, 512, 0);
  tile_load<96>(tr2, kbase, 96, vbase, 512, 64);
  __syncthreads();
  tile_store<96>(tr, lds);
  __syncthreads();
  auto compute = [&](int kt, unsigned char* cur) {
    if (kt * 64 <= q0 + 31) {
      f32x16 s0, s1;
      qk_tile<96>((const bf16_t*)cur, qf, s0, s1, r, h);
      if (kt * 64 + 63 > q0) {
        int rel = tq - kt * 64 - 4 * h; asm volatile("" : "+v"(rel));
#pragma unroll
        for (int i = 0; i < 16; ++i) { const int kk2 = (i & 3) + 8 * (i >> 2); if (kk2 > rel) s0[i] = -INFINITY; if (kk2 + 32 > rel) s1[i] = -INFINITY; }
      }
      softmax_pv(f, s0, s1, (const bf16_t*)(cur + att_kbytes<96>()), lane);
    }
  };
#pragma unroll 1
  for (int kt = 0; kt < ntiles; kt += 2) {
    if (kt + 2 < ntiles) tile_load<96>(tr, kbase, 96, vbase, 512, (kt + 2) * 64);
    compute(kt, lds);
    tile_store<96>(tr2, lds + att_buf<96>());
    __syncthreads();
    if (kt + 3 < ntiles) tile_load<96>(tr2, kbase, 96, vbase, 512, (kt + 3) * 64);
    compute(kt + 1, lds + att_buf<96>());
    if (kt + 2 < ntiles) tile_store<96>(tr, lds);
    __syncthreads();
  }
  store_o(YA + (size_t)(b * S + tq) * 256 + hd * 64, f.o0, f.o1, 1.f / f.l, h);
}

template <class KF, class BODY>
DEVI void nsa_stream(unsigned char* lds, const bf16_t* kbase, size_t kstride, const bf16_t* vbase, size_t vstride, bool withv, int nt, KF key0f, BODY body) {
  if (nt <= 0) return;
  TileRegs<64> tr;
  tile_load<64>(tr, kbase, kstride, vbase, vstride, key0f(0), withv);
  __syncthreads();
  tile_store<64>(tr, lds, withv);
  __syncthreads();
#pragma unroll 1
  for (int i = 0; i < nt; ++i) {
    unsigned char* cur = lds + (i & 1) * att_buf<64>();
    const bool more = i + 1 < nt;
    if (more) tile_load<64>(tr, kbase, kstride, vbase, vstride, key0f(i + 1), withv);
    body(i, cur);
    if (more) tile_store<64>(tr, lds + ((i + 1) & 1) * att_buf<64>(), withv);
    __syncthreads();
  }
}
DEVI void nsa_item(const Params& p, int l, int b, int qt, unsigned char* lds) {
  const bf16_t* PROJ = (const bf16_t*)(p.ws + WS_B);
  const bf16_t* KC = (const bf16_t*)(p.ws + SM_KC) + (size_t)b * 128 * 64;
  const bf16_t* VC = (const bf16_t*)(p.ws + SM_VC) + (size_t)b * 128 * 64;
  const int tid = threadIdx.x, wv = tid >> 6, lane = tid & 63, r = lane & 31, h = lane >> 5;
  float* psum = (float*)(lds + 2 * att_buf<64>());
  unsigned* selm = (unsigned*)(lds + 2 * att_buf<64>() + 16384);
  const int t0 = qt * 32, cur = t0 >> 6;
  const int ql = wv * 8 + (r >> 2), hd = r & 3, tq = t0 + ql;
  const size_t tg = (size_t)b * S + tq;
  bf16x8 qf[4];
#pragma unroll
  for (int kk = 0; kk < 4; ++kk) qf[kk] = *(const bf16x8*)(PROJ + tg * DINP + C_NQ + hd * 64 + kk * 16 + h * 8);
  unsigned* ofs = (unsigned*)psum + wv * 1024 + lane;
  const float g0 = sigmoidf_(bf2f(PROJ[tg * DINP + C_NG + hd * 3 + 0]));
  const float g1 = sigmoidf_(bf2f(PROJ[tg * DINP + C_NG + hd * 3 + 1]));
  const float g2 = sigmoidf_(bf2f(PROJ[tg * DINP + C_NG + hd * 3 + 2]));
  FState f; fstate_init(f);
  const int ncmp = (t0 + 31 < 31) ? 0 : (((t0 >> 4) >> 6) + 1);
  nsa_stream(lds, KC, 64, VC, 64, true, ncmp, [&](int i) { return i * 64; }, [&](int kt, unsigned char* buf) {
    f32x16 s0, s1;
    qk_tile<64>((const bf16_t*)buf, qf, s0, s1, r, h);
    int rel = ((tq - 31) >> 4) - kt * 64 - 4 * h; asm volatile("" : "+v"(rel));
#pragma unroll
    for (int i = 0; i < 16; ++i) { const int kk2 = (i & 3) + 8 * (i >> 2); if (kk2 > rel) s0[i] = -INFINITY; if (kk2 + 32 > rel) s1[i] = -INFINITY; }
    softmax_pv(f, s0, s1, (const bf16_t*)(buf + att_kbytes<64>()), lane);
  });
  {
    const float muse = (f.m == -INFINITY) ? 0.f : f.m;
    const float il = (f.l > 0.f) ? 1.f / f.l : 0.f;
    if (ncmp < 2) {
#pragma unroll 1
      for (int i = tid; i < 32 * 128; i += NTHREADS) psum[i] = 0.f;
      __syncthreads();
    }
    nsa_stream(lds, KC, 64, VC, 64, false, ncmp, [&](int i) { return i * 64; }, [&](int kt, unsigned char* buf) {
      f32x16 s0, s1;
      qk_tile<64>((const bf16_t*)buf, qf, s0, s1, r, h);
      int rel = ((tq - 31) >> 4) - kt * 64 - 4 * h; asm volatile("" : "+v"(rel));
      int cb0 = kt * 64 + 4 * h; asm volatile("" : "+v"(cb0));
#pragma unroll
      for (int i = 0; i < 16; ++i) {
        const int kk2 = (i & 3) + 8 * (i >> 2); const int c = cb0 + kk2;
        float p0 = (kk2 > rel) ? 0.f : fexp2(s0[i] - muse) * il;
        float p1 = (kk2 + 32 > rel) ? 0.f : fexp2(s1[i] - muse) * il;
        p0 += __shfl_xor(p0, 1); p0 += __shfl_xor(p0, 2);
        p1 += __shfl_xor(p1, 1); p1 += __shfl_xor(p1, 2);
        if (hd == 0) { psum[ql * 128 + c] = p0; psum[ql * 128 + c + 32] = p1; }
      }
    });
  }
  __syncthreads();
#pragma unroll 1
  for (int itq = 0; itq < 4; ++itq) {
    const int q2 = wv * 8 + itq * 2 + (lane >> 5), j = lane & 31;
    const float* ps = psum + q2 * 128;
    float imp = 2.f * (ps[4 * j] + ps[4 * j + 1] + ps[4 * j + 2]) + ps[4 * j + 3];
    if (j > 0) imp += ps[4 * j - 1];
    const bool cand = (j >= 1) && (j <= cur - 2);
    int rank = 0;
    for (int jj = 0; jj < 32; ++jj) {
      const float v = __shfl(imp, (lane & 32) | jj);
      const bool cj = (jj >= 1) && (jj <= cur - 2);
      if (cj && (v > imp || (v == imp && jj < j))) ++rank;
    }
    const bool sel = cand && rank < 2;
    const unsigned long long bal = __ballot(sel);
    unsigned mk = (unsigned)(bal >> (32 * (lane >> 5)));
    mk |= 1u | (1u << cur); if (cur >= 1) mk |= (1u << (cur - 1));
    if (j == 0) selm[q2] = mk;
  }
  __syncthreads();
  unsigned blk_or = 0, wave_or = 0;
  for (int i = 0; i < 32; ++i) blk_or |= selm[i];
  for (int i = 0; i < 8; ++i) wave_or |= selm[wv * 8 + i];
  const unsigned mymask = selm[ql];
  {
    const float sc = (f.l > 0.f) ? g0 / f.l : 0.f;
#pragma unroll
    for (int i = 0; i < 8; ++i) { ofs[i * 64] = pk2bf(f.o0[2 * i] * sc, f.o0[2 * i + 1] * sc); ofs[(8 + i) * 64] = pk2bf(f.o1[2 * i] * sc, f.o1[2 * i + 1] * sc); }
  }
  fstate_init(f);
  {
    unsigned* tl = selm + 32;
    if (tid < 32 && ((blk_or >> tid) & 1u)) tl[__popc(blk_or & ((1u << tid) - 1u))] = tid;
    __syncthreads();
    const int nsel = __popc(blk_or);
    nsa_stream(lds, PROJ + (size_t)b * S * DINP + C_KS, DINP, PROJ + (size_t)b * S * DINP + C_VS, DINP, true, nsel,
      [&](int i) { return (int)tl[i] * 64; },
      [&](int i, unsigned char* buf) {
        const int jj = (int)tl[i];
        if ((wave_or >> jj) & 1u) {
          f32x16 s0, s1;
          qk_tile<64>((const bf16_t*)buf, qf, s0, s1, r, h);
          const bool on = (mymask >> jj) & 1u;
          int rel = on ? (tq - jj * 64 - 4 * h) : -1; asm volatile("" : "+v"(rel));
#pragma unroll
          for (int i2 = 0; i2 < 16; ++i2) { const int kk2 = (i2 & 3) + 8 * (i2 >> 2); if (kk2 > rel) s0[i2] = -INFINITY; if (kk2 + 32 > rel) s1[i2] = -INFINITY; }
          softmax_pv(f, s0, s1, (const bf16_t*)(buf + att_kbytes<64>()), lane);
        }
      });
    const float sc = (f.l > 0.f) ? g1 / f.l : 0.f;
#pragma unroll
    for (int i = 0; i < 8; ++i) {
      const unsigned w0 = ofs[i * 64], w1 = ofs[(8 + i) * 64];
      ofs[i * 64] = pk2bf(__uint_as_float(w0 << 16) + f.o0[2 * i] * sc, __uint_as_float(w0 & 0xffff0000u) + f.o0[2 * i + 1] * sc);
      ofs[(8 + i) * 64] = pk2bf(__uint_as_float(w1 << 16) + f.o1[2 * i] * sc, __uint_as_float(w1 & 0xffff0000u) + f.o1[2 * i + 1] * sc);
    }
  }
  fstate_init(f);
  {
    int jlo = (t0 - 511) >> 6; if (jlo < 0) jlo = 0;
    nsa_stream(lds, PROJ + (size_t)b * S * DINP + C_KW, DINP, PROJ + (size_t)b * S * DINP + C_VW, DINP, true, cur - jlo + 1,
      [&](int i) { return (jlo + i) * 64; },
      [&](int i, unsigned char* buf) {
        const int j = jlo + i;
        f32x16 s0, s1;
        qk_tile<64>((const bf16_t*)buf, qf, s0, s1, r, h);
        if (j == cur || j * 64 < t0 + 31 - 511 + 64) {
          int rel = tq - j * 64 - 4 * h; asm volatile("" : "+v"(rel));
#pragma unroll
          for (int i2 = 0; i2 < 16; ++i2) {
            const int kk2 = (i2 & 3) + 8 * (i2 >> 2);
            if (kk2 > rel || kk2 < rel - 511) s0[i2] = -INFINITY;
            if (kk2 + 32 > rel || kk2 + 32 < rel - 511) s1[i2] = -INFINITY;
          }
        }
        softmax_pv(f, s0, s1, (const bf16_t*)(buf + att_kbytes<64>()), lane);
      });
    const float sc = (f.l > 0.f) ? g2 / f.l : 0.f;
#pragma unroll
    for (int i = 0; i < 8; ++i) {
      const unsigned w0 = ofs[i * 64], w1 = ofs[(8 + i) * 64];
      f.o0[2 * i] = __uint_as_float(w0 << 16) + f.o0[2 * i] * sc; f.o0[2 * i + 1] = __uint_as_float(w0 & 0xffff0000u) + f.o0[2 * i + 1] * sc;
      f.o1[2 * i] = __uint_as_float(w1 << 16) + f.o1[2 * i] * sc; f.o1[2 * i + 1] = __uint_as_float(w1 & 0xffff0000u) + f.o1[2 * i + 1] * sc;
    }
  }
  f32x16& of0 = f.o0; f32x16& of1 = f.o1;
  {
    float ss = 0.f;
#pragma unroll
    for (int i = 0; i < 16; ++i) ss += of0[i] * of0[i] + of1[i] * of1[i];
    ss += __shfl_xor(ss, 1); ss += __shfl_xor(ss, 2); ss += __shfl_xor(ss, 32);
    const float rs = rsqrtf(ss * (1.f / 256) + EPS);
    const float* on = p.in[35] + l * 1024 + 768 + hd * 64;
#pragma unroll
    for (int g4 = 0; g4 < 4; ++g4) {
      const float4 a = *(const float4*)(on + 8 * g4 + 4 * h), b4 = *(const float4*)(on + 32 + 8 * g4 + 4 * h);
      of0[4 * g4] *= a.x; of0[4 * g4 + 1] *= a.y; of0[4 * g4 + 2] *= a.z; of0[4 * g4 + 3] *= a.w;
      of1[4 * g4] *= b4.x; of1[4 * g4 + 1] *= b4.y; of1[4 * g4 + 2] *= b4.z; of1[4 * g4 + 3] *= b4.w;
    }
    store_o((bf16_t*)(p.ws + WS_A) + tg * 1024 + 768 + hd * 64, of0, of1, rs, h);
  }
}

DEVI void carry_item(const Params& p, int l, int it) {
  const int tid = threadIdx.x;
  if (it < 64) {
    const int idx = it * 256 + tid, b = idx >> 10, gs = idx & 1023;
    const float2 a64 = ((const float2*)(p.ws + WS_W + l * WS_WL + W_S5A64))[gs];
    const float2* SLOC = (const float2*)(p.ws + SM_SLOC) + (size_t)b * 32 * 1024 + gs;
    float2* SCAR = (float2*)(p.ws + SM_SCAR) + (size_t)b * 32 * 1024 + gs;
    float hr = 0.f, hi = 0.f;
#pragma unroll 1
    for (int c0 = 0; c0 < 32; c0 += 8) {
      float2 sl[8];
#pragma unroll
      for (int i = 0; i < 8; ++i) sl[i] = SLOC[(size_t)(c0 + i) * 1024];
#pragma unroll
      for (int i = 0; i < 8; ++i) { SCAR[(size_t)(c0 + i) * 1024] = make_float2(hr, hi); const float nr = a64.x * hr - a64.y * hi + sl[i].x, ni = a64.x * hi + a64.y * hr + sl[i].y; hr = nr; hi = ni; }
    }
  } else {
    const int idx = (it - 64) * 256 + tid, b = idx >> 8, c = idx & 255;
    const float2* LSUM = (const float2*)(p.ws + SM_LSUM) + (size_t)b * 32 * 256 + c;
    float* LCAR = (float*)(p.ws + SM_LCAR) + (size_t)b * 32 * 256 + c;
    float hh = 0.f;
#pragma unroll 1
    for (int c0 = 0; c0 < 32; c0 += 8) {
      float2 sv[8];
#pragma unroll
      for (int i = 0; i < 8; ++i) sv[i] = LSUM[(size_t)(c0 + i) * 256];
#pragma unroll
      for (int i = 0; i < 8; ++i) { LCAR[(size_t)(c0 + i) * 256] = hh; hh = sv[i].x * hh + sv[i].y; }
    }
  }
}
DEVI void phase_a1(const Params& p, int l, unsigned char* lds) {
  for (int it = blockIdx.x; it < 80; it += gridDim.x) carry_item(p, l, it);
  const int G_ = (int)gridDim.x;
  const int vb_ = vblock();
  for (int rr = 0;; ++rr) { const int j = rr * G_ + ((rr & 1) ? (G_ - 1 - vb_) : vb_); if (rr * G_ >= 1024) break; if (j < 1024) { const int b = j >> 6, qt = 63 - (j & 63); nsa_item(p, l, b, qt, lds); } }
  __syncthreads();
  for (int rr = 0;; ++rr) { const int j = rr * G_ + ((rr & 1) ? (G_ - 1 - vb_) : vb_); if (rr * G_ >= 1024) break; if (j < 1024) { const int bh = j >> 4, qt = 15 - (j & 15); mla_item(p, l, bh >> 2, bh & 3, qt, lds); } }
}

DEVI void phase_r3(const Params& p, int l, unsigned char* lds) {
  bf16_t* Y = (bf16_t*)(p.ws + WS_A);
  const int tid = threadIdx.x, lane = tid & 63, wv = tid >> 6;
  {
    const float* onorm = p.in[35] + l * 1024 + 256;
    float* tile = (float*)lds;
    for (int it = blockIdx.x; it < NB * 32; it += gridDim.x) {
      const int b = it >> 5, chunk = it & 31;
      __syncthreads();
      lru_chunk<true>(p, l, b, chunk, tile);
      __syncthreads();
      for (int k = wv; k < 64; k += 4) {
        const float4 v = *(const float4*)(tile + k * 256 + lane * 4);
        const float rs = rsqrtf(wsum(v.x * v.x + v.y * v.y + v.z * v.z + v.w * v.w) * (1.f / 256) + EPS);
        const size_t t = (size_t)b * S + chunk * 64 + k;
        const float4 gg = *(const float4*)(onorm + lane * 4);
        st_bf16x4(Y + t * 1024 + 256 + lane * 4, (f32x4){v.x * rs * gg.x, v.y * rs * gg.y, v.z * rs * gg.z, v.w * rs * gg.w});
      }
    }
  }
  __syncthreads();
  for (int it = blockIdx.x; it < NB * 32; it += gridDim.x) s5_chunk<true>(p, l, it >> 5, it & 31, lds);
}

DEVI void phase_g3(const Params& p, int l, unsigned char* lds) {
  const bf16_t* YCP = (const bf16_t*)(p.ws + WS_F);
  bf16_t* YC = (bf16_t*)(p.ws + WS_F) + (size_t)T * 256;
  const bf16_t* W = (const bf16_t*)(p.ws + WS_W + l * WS_WL + W_GLU);
  const float* bg = p.in[26] + l * 256;
  for (int it = vblock(); it < 256 * 2; it += gridDim.x) {
    const int mt = it >> 1, nt = it & 1;
    f32x4 acc[4][4];
    gemm128g(lds, 256, [&](int r, int k) { return YCP + (size_t)(mt * 128 + r) * 256 + k; }, [&](int r, int k) { return W + (size_t)(nt * 128 + r) * 256 + k; }, acc);
    GEMM_EPI4({ const size_t o = (size_t)(mt * 128 + er) * 256 + nt * 128 + ec0; const ushort4 yp = *(const ushort4*)(YCP + o); f32x4 r4; r4[0] = bf2f(yp.x) * sigmoidf_(ev4[0] + bg[nt * 128 + ec0]); r4[1] = bf2f(yp.y) * sigmoidf_(ev4[1] + bg[nt * 128 + ec0 + 1]); r4[2] = bf2f(yp.z) * sigmoidf_(ev4[2] + bg[nt * 128 + ec0 + 2]); r4[3] = bf2f(yp.w) * sigmoidf_(ev4[3] + bg[nt * 128 + ec0 + 3]); st_bf16x4(YC + o, r4); })
  }
}

DEVI void phase_r4(const Params& p, int l) {
  const bf16_t* YA = (const bf16_t*)(p.ws + WS_C);
  const bf16_t* YC = (const bf16_t*)(p.ws + WS_F) + (size_t)T * 256;
  bf16_t* Y = (bf16_t*)(p.ws + WS_A);
  const float* onorm = p.in[35] + l * 1024;
  const int lane = threadIdx.x & 63, gw = blockIdx.x * 4 + (threadIdx.x >> 6), NGW = gridDim.x * 4;
  for (int t = gw; t < T; t += NGW) {
#pragma unroll
    for (int grp = 0; grp < 2; ++grp) {
      const bf16_t* src = (grp == 0 ? YA : YC) + (size_t)t * 256;
      const int gcol = (grp == 0 ? 0 : 512);
      const ushort4 u = ((const ushort4*)src)[lane];
      const float v0 = bf2f(u.x), v1 = bf2f(u.y), v2 = bf2f(u.z), v3 = bf2f(u.w);
      const float rs = rsqrtf(wsum(v0 * v0 + v1 * v1 + v2 * v2 + v3 * v3) * (1.f / 256) + EPS);
      const float4 g = ((const float4*)(onorm + gcol))[lane];
      uint2 o; o.x = pk2bf(v0 * rs * g.x, v1 * rs * g.y); o.y = pk2bf(v2 * rs * g.z, v3 * rs * g.w);
      ((uint2*)(Y + (size_t)t * 1024 + gcol))[lane] = o;
    }
  }
}

DEVI void phase_g4(const Params& p, int l, unsigned char* lds) {
  const bf16_t* Y = (const bf16_t*)(p.ws + WS_A);
  const bf16_t* W = (const bf16_t*)(p.ws + WS_W + l * WS_WL + W_OUT);
  const float* xin = (l == 0) ? p.in[0] : p.out;
  float* out = p.out;
  int par = 0; bool staged = false;
  for (int it = vblock(); it < 256 * 8; it += gridDim.x) {
    const int mt = it >> 3, nt = it & 7;
    f32x4 acc[4][4], xr[4][4];
    {
      const int tid = threadIdx.x, wid = tid >> 6, lane = tid & 63, wr = wid >> 1, wc = wid & 1, fr = lane & 15, fq = lane >> 4;
#pragma unroll
      for (int m = 0; m < 4; ++m)
#pragma unroll
        for (int n = 0; n < 4; ++n) xr[m][n] = *(const f32x4*)(xin + (size_t)(mt * 128 + wr * 64 + m * 16 + fr) * D + nt * 128 + wc * 64 + n * 16 + fq * 4);
    }
    const int itn = it + (int)gridDim.x; const bool hn = itn < 256 * 8; const int mtn = itn >> 3, ntn = itn & 7;
    gemm128p(lds, D, [&](int r, int k) { return Y + (size_t)(mt * 128 + r) * D + k; }, [&](int r, int k) { return W + (size_t)(nt * 128 + r) * D + k; }, acc, par, staged, hn,
             [&](int r, int k) { return Y + (size_t)(mtn * 128 + r) * D + k; }, [&](int r, int k) { return W + (size_t)(ntn * 128 + r) * D + k; });
    staged = hn;
    GEMM_EPI4({ const size_t o = (size_t)(mt * 128 + er) * D + nt * 128 + ec0; *(f32x4*)(out + o) = xr[m][n] + ev4; })
  }
}

DEVI void phase_r5(const Params& p, int l, unsigned char* lds) {
  const float* x1 = p.out;
  bf16_t* XN = (bf16_t*)(p.ws + WS_A);
  const float* g = p.in[37] + l * D;
  const bf16_t* WH = (const bf16_t*)(p.ws + WS_W + l * WS_WL + W_RTH);
  const bf16_t* WL = (const bf16_t*)(p.ws + WS_W + l * WS_WL + W_RTL);
  const float* brg = p.in[39] + l * 4; const float* bre = p.in[41] + l * 16;
  int* CNT = (int*)(p.ws + SM_CNT) + l * 32;
  int* LIST = (int*)(p.ws + SM_LIST);
  float2* TOKW = (float2*)(p.ws + SM_TOKW);
  const int tid = threadIdx.x, lane = tid & 63, wv = tid >> 6, c = lane & 15, q = lane >> 4;
  float* red = (float*)lds;
  int* hist = (int*)(lds + 16384);
  int* tokl = (int*)(lds + 16384 + 256);
  if (tid < 64) hist[tid] = 0;
  int ntok = 0;
  __syncthreads();
  for (int it = blockIdx.x; it < T / 16; it += gridDim.x) {
    const size_t tb = (size_t)it * 16;
    f32x4 a0 = (f32x4){0.f, 0.f, 0.f, 0.f}, a1 = (f32x4){0.f, 0.f, 0.f, 0.f};
    float ss = 0.f;
    const float* xrow = x1 + (tb + c) * D + wv * 256 + 8 * q;
    const bf16_t* wh0 = WH + (size_t)c * 1024 + wv * 256 + 8 * q;
    const bf16_t* wl0 = WL + (size_t)c * 1024 + wv * 256 + 8 * q;
    float4 xk[8][2];
#pragma unroll
    for (int ks = 0; ks < 8; ++ks) { xk[ks][0] = *(const float4*)(xrow + ks * 32); xk[ks][1] = *(const float4*)(xrow + ks * 32 + 4); }
#pragma unroll
    for (int ks = 0; ks < 8; ++ks) {
      const bf16x8 wh_a = *(const bf16x8*)(wh0 + ks * 32), wl_a = *(const bf16x8*)(wl0 + ks * 32);
      const bf16x8 wh_b = *(const bf16x8*)(wh0 + 16 * 1024 + ks * 32), wl_b = *(const bf16x8*)(wl0 + 16 * 1024 + ks * 32);
      const float xv[8] = {xk[ks][0].x, xk[ks][0].y, xk[ks][0].z, xk[ks][0].w, xk[ks][1].x, xk[ks][1].y, xk[ks][1].z, xk[ks][1].w};
      u32x4 hw, lw;
#pragma unroll
      for (int j = 0; j < 4; ++j) {
        const float x0 = xv[2 * j], x1v = xv[2 * j + 1];
        ss += x0 * x0 + x1v * x1v;
        const unsigned hp = pk2bf(x0, x1v);
        hw[j] = hp; lw[j] = pk2bf(x0 - __uint_as_float(hp << 16), x1v - __uint_as_float(hp & 0xffff0000u));
      }
      const bf16x8 xh = __builtin_bit_cast(bf16x8, hw), xl = __builtin_bit_cast(bf16x8, lw);
      a0 = mfma16(wh_a, xh, a0); a0 = mfma16(wh_a, xl, a0); a0 = mfma16(wl_a, xh, a0);
      a1 = mfma16(wh_b, xh, a1); a1 = mfma16(wh_b, xl, a1); a1 = mfma16(wl_b, xh, a1);
    }
    ss += __shfl_xor(ss, 16); ss += __shfl_xor(ss, 32);
    __syncthreads();
#pragma unroll
    for (int j = 0; j < 4; ++j) { red[(wv * 9 + j) * 64 + lane] = a0[j]; red[(wv * 9 + 4 + j) * 64 + lane] = a1[j]; }
    red[(wv * 9 + 8) * 64 + lane] = ss;
    __syncthreads();
    const float s2 = red[8 * 64 + lane] + red[(9 + 8) * 64 + lane] + red[(18 + 8) * 64 + lane] + red[(27 + 8) * 64 + lane];
    const float rs = rsqrtf(s2 * (1.f / D) + EPS);
    {
      bf16_t* xo = XN + (tb + c) * D + wv * 256 + 8 * q;
      const float* gp = g + wv * 256 + 8 * q;
#pragma unroll
      for (int ks = 0; ks < 8; ++ks) {
        const float4 g0 = *(const float4*)(gp + ks * 32), g1 = *(const float4*)(gp + ks * 32 + 4);
        u32x4 o;
        o[0] = pk2bf(xk[ks][0].x * rs * g0.x, xk[ks][0].y * rs * g0.y); o[1] = pk2bf(xk[ks][0].z * rs * g0.z, xk[ks][0].w * rs * g0.w);
        o[2] = pk2bf(xk[ks][1].x * rs * g1.x, xk[ks][1].y * rs * g1.y); o[3] = pk2bf(xk[ks][1].z * rs * g1.z, xk[ks][1].w * rs * g1.w);
        *(u32x4*)(xo + ks * 32) = o;
      }
    }
    if (wv == 0) {
      float c0[4], c1[4];
#pragma unroll
      for (int j = 0; j < 4; ++j) {
        c0[j] = red[j * 64 + lane] + red[(9 + j) * 64 + lane] + red[(18 + j) * 64 + lane] + red[(27 + j) * 64 + lane];
        c1[j] = red[(4 + j) * 64 + lane] + red[(13 + j) * 64 + lane] + red[(22 + j) * 64 + lane] + red[(31 + j) * 64 + lane];
      }
      float lg[20];
#pragma unroll
      for (int qq = 0; qq < 4; ++qq)
#pragma unroll
        for (int j = 0; j < 4; ++j) lg[4 * qq + j] = __shfl(c0[j], c + 16 * qq);
#pragma unroll
      for (int j = 0; j < 4; ++j) lg[16 + j] = __shfl(c1[j], c);
      const int t = (int)tb + c;
      float gl[4];
#pragma unroll
      for (int k2 = 0; k2 < 4; ++k2) gl[k2] = lg[k2] * rs + brg[k2];
      int gi = 0; float gbest = gl[0];
#pragma unroll
      for (int k2 = 1; k2 < 4; ++k2) if (gl[k2] > gbest) { gbest = gl[k2]; gi = k2; }
      float den = 0.f;
#pragma unroll
      for (int k2 = 0; k2 < 4; ++k2) den += expf(gl[k2] - gbest);
      const float pg = 1.f / den;
      float le[4];
#pragma unroll
      for (int k2 = 0; k2 < 4; ++k2) { float sel = 0.f;
#pragma unroll
        for (int gg2 = 0; gg2 < 4; ++gg2) sel = (gi == gg2) ? (lg[4 + gg2 * 4 + k2] * rs + bre[gg2 * 4 + k2]) : sel;
        le[k2] = sel; }
      int i0 = 0; float l0 = le[0];
#pragma unroll
      for (int k2 = 1; k2 < 4; ++k2) if (le[k2] > l0) { l0 = le[k2]; i0 = k2; }
      int i1 = -1; float l1 = -INFINITY;
#pragma unroll
      for (int k2 = 0; k2 < 4; ++k2) if (k2 != i0 && le[k2] > l1) { l1 = le[k2]; i1 = k2; }
      const float e1 = expf(l1 - l0);
      const float w0 = pg / (1.f + e1), w1 = pg * e1 / (1.f + e1);
      const int elo = (i0 < i1) ? i0 : i1, ehi = (i0 < i1) ? i1 : i0;
      const float wlo = (i0 < i1) ? w0 : w1, whi = (i0 < i1) ? w1 : w0;
      const int pidx = (elo == 0) ? (ehi - 1) : ((elo == 1) ? (ehi + 1) : 5);
      const int cls = gi * 6 + pidx;
      if (q == 0) {
        const int rank = atomicAdd(&hist[cls], 1);
        tokl[2 * (ntok + c)] = t; tokl[2 * (ntok + c) + 1] = (cls << 16) | rank;
        TOKW[t] = make_float2(wlo, whi);
      }
    }
    ntok += 16;
  }
  __syncthreads();
  if (tid < 24) { const int n = hist[tid]; hist[32 + tid] = n ? atomicAdd(&CNT[tid], n) : 0; }
  __syncthreads();
  for (int i = tid; i < ntok; i += NTHREADS) { const int t = tokl[2 * i], cr = tokl[2 * i + 1], cls = cr >> 16; LIST[(size_t)cls * T + hist[32 + cls] + (cr & 0xffff)] = t; }
}

struct MoeItem { int cls, mtile, nt, cnt; };
DEVI void moe_prefix(const int* CNT, unsigned char* lds) {
  int* pre = (int*)(lds + LDS_BYTES + 64);
  __syncthreads();
  if (threadIdx.x < 24) pre[32 + threadIdx.x] = CNT[threadIdx.x];
  __syncthreads();
  if (threadIdx.x == 0) { int a = 0; for (int c = 0; c < 24; ++c) { pre[c] = a; a += (pre[32 + c] + 127) >> 7; } pre[24] = a; }
  __syncthreads();
}
DEVI bool moe_item(unsigned char* lds, int it, MoeItem& m) {
  const int* pre = (const int*)(lds + LDS_BYTES + 64);
  const int mt = it >> 3; m.nt = it & 7;
  if (mt >= pre[24]) return false;
  int c = 0;
#pragma unroll
  for (int q = 1; q < 24; ++q) c += (mt >= pre[q]) ? 1 : 0;
  m.cls = c; m.mtile = mt - pre[c]; m.cnt = pre[32 + c];
  return true;
}
DEVI void cls_experts(int cls, int& e0, int& e1) {
  const int g = cls / 6, pi = cls % 6;
  const int lo = (pi < 3) ? 0 : ((pi < 5) ? 1 : 2);
  const int hi = (pi < 3) ? (pi + 1) : ((pi < 5) ? (pi - 1) : 3);
  e0 = g * 4 + lo; e1 = g * 4 + hi;
}
DEVI void phase_g5(const Params& p, int l, unsigned char* lds) {
  const bf16_t* XN = (const bf16_t*)(p.ws + WS_A);
  bf16_t* HID = (bf16_t*)(p.ws + WS_B);
  const bf16_t* WGU = (const bf16_t*)(p.ws + WS_W + l * WS_WL + W_GU);
  const int* CNT = (const int*)(p.ws + SM_CNT) + l * 32;
  const int* LIST = (const int*)(p.ws + SM_LIST);
  const float2* TOKW = (const float2*)(p.ws + SM_TOKW);
  moe_prefix(CNT, lds);
  const int G_ = (int)gridDim.x, total_ = ((const int*)(lds + LDS_BYTES + 64))[24] * 8, full_ = (total_ / G_) * G_, rem_ = total_ - full_;
  for (int it = vblock(); it < full_ + 2 * rem_; it += G_) {
    const bool halfmode = it >= full_; const int half = (it - full_) & 1;
    MoeItem mi; if (!moe_item(lds, halfmode ? full_ + ((it - full_) >> 1) : it, mi)) break;
    int e0, e1; cls_experts(mi.cls, e0, e1);
    const int ex = (mi.nt < 4) ? e0 : e1, ntl = mi.nt & 3;
    const bf16_t* W = WGU + ((size_t)ex * 512 + ntl * 128) * 1024;
    const int* list = LIST + (size_t)mi.cls * T + mi.mtile * 128;
    const int nvalid = mi.cnt - mi.mtile * 128;
    if (halfmode) {
      f32x4 acc2[2][4];
      int tokA[4];
#pragma unroll
      for (int i = 0; i < 4; ++i) { const int r = (threadIdx.x >> 3) + 32 * i; tokA[i] = list[(r < nvalid) ? r : 0]; }
      const int tid = threadIdx.x, wid = tid >> 6, lane = tid & 63, fr = lane & 15, fq = lane >> 4;
      int tokE2[2]; float twE2[2];
#pragma unroll
      for (int m = 0; m < 2; ++m) { const int er = wid * 32 + m * 16 + fr; tokE2[m] = list[(er < nvalid) ? er : 0]; }
#pragma unroll
      for (int m = 0; m < 2; ++m) { const float2 tw = TOKW[tokE2[m]]; twE2[m] = (mi.nt < 4) ? tw.x : tw.y; }
      const bf16_t* Wh = W + (size_t)half * 64 * 1024;
      gemm128h(lds, D, [&](int r, int k) { const int i = r >> 5; const int tok = (i == 0) ? tokA[0] : (i == 1) ? tokA[1] : (i == 2) ? tokA[2] : tokA[3]; return XN + (size_t)tok * D + k; },
               [&](int r, int k) { return Wh + (size_t)r * D + k; }, acc2);
#pragma unroll
      for (int m = 0; m < 2; ++m) {
        const int er = wid * 32 + m * 16 + fr;
        if (er < nvalid) {
#pragma unroll
          for (int n = 0; n < 2; ++n) {
            f32x4 hv;
#pragma unroll
            for (int j = 0; j < 4; ++j) { const float gt = acc2[m][n][j], up = acc2[m][n + 2][j]; hv[j] = gt * sigmoidf_(gt) * up * twE2[m]; }
            st_bf16x4(HID + (size_t)tokE2[m] * 512 + (mi.nt < 4 ? 0 : 256) + ntl * 64 + half * 32 + n * 16 + fq * 4, hv);
          }
        }
      }
      continue;
    }
    f32x4 acc[4][4];
    int tokA[4], tokE[4]; float twE[4];
#pragma unroll
    for (int i = 0; i < 4; ++i) { const int r = (threadIdx.x >> 3) + 32 * i; tokA[i] = list[(r < nvalid) ? r : 0]; }
    {
      const int tid_ = threadIdx.x, er0 = ((tid_ >> 6) >> 1) * 64 + (tid_ & 15);
#pragma unroll
      for (int m = 0; m < 4; ++m) { const int er = er0 + m * 16; tokE[m] = list[(er < nvalid) ? er : 0]; }
#pragma unroll
      for (int m = 0; m < 4; ++m) { const float2 tw = TOKW[tokE[m]]; twE[m] = (mi.nt < 4) ? tw.x : tw.y; }
    }
    gemm128g(lds, D, [&](int r, int k) { const int i = r >> 5; const int tok = (i == 0) ? tokA[0] : (i == 1) ? tokA[1] : (i == 2) ? tokA[2] : tokA[3]; return XN + (size_t)tok * D + k; }, [&](int r, int k) { return W + (size_t)r * D + k; }, acc);
    {
      const int tid = threadIdx.x, wid = tid >> 6, lane = tid & 63, wr = wid >> 1, wc = wid & 1, fr = lane & 15, fq = lane >> 4;
#pragma unroll
      for (int m = 0; m < 4; ++m) {
        const int er = wr * 64 + m * 16 + fr;
        if (er < nvalid) {
          const int tok = tokE[m];
          const float w = twE[m];
#pragma unroll
          for (int n = 0; n < 2; ++n) {
            f32x4 hv;
#pragma unroll
            for (int j = 0; j < 4; ++j) { const float gt = acc[m][n][j], up = acc[m][n + 2][j]; hv[j] = gt * sigmoidf_(gt) * up * w; }
            const int hh = (mi.nt < 4 ? 0 : 256) + ntl * 64 + wc * 32 + n * 16 + fq * 4;
            st_bf16x4(HID + (size_t)tok * 512 + hh, hv);
          }
        }
      }
    }
  }
}
DEVI void phase_g6(const Params& p, int l, unsigned char* lds) {
  const bf16_t* HID = (const bf16_t*)(p.ws + WS_B);
  const bf16_t* WDN = (const bf16_t*)(p.ws + WS_W + l * WS_WL + W_DN);
  const int* CNT = (const int*)(p.ws + SM_CNT) + l * 32;
  const int* LIST = (const int*)(p.ws + SM_LIST);
  float* out = p.out;
  moe_prefix(CNT, lds);
  const int G_ = (int)gridDim.x, total_ = ((const int*)(lds + LDS_BYTES + 64))[24] * 8, full_ = (total_ / G_) * G_, rem_ = total_ - full_;
  for (int it = vblock(); it < full_ + 2 * rem_; it += G_) {
    const bool halfmode = it >= full_; const int half = (it - full_) & 1;
    MoeItem mi; if (!moe_item(lds, halfmode ? full_ + ((it - full_) >> 1) : it, mi)) break;
    int e0, e1; cls_experts(mi.cls, e0, e1);
    const int* list = LIST + (size_t)mi.cls * T + mi.mtile * 128;
    const int nvalid = mi.cnt - mi.mtile * 128;
    const bf16_t* W0 = WDN + ((size_t)e0 * 1024 + mi.nt * 128) * 256;
    const bf16_t* W1 = WDN + ((size_t)e1 * 1024 + mi.nt * 128) * 256;
    if (halfmode) {
      f32x4 acc2[2][4];
      int tokA[4];
#pragma unroll
      for (int i = 0; i < 4; ++i) { const int r = (threadIdx.x >> 3) + 32 * i; tokA[i] = list[(r < nvalid) ? r : 0]; }
      const int tid = threadIdx.x, wid = tid >> 6, lane = tid & 63, fr = lane & 15, fq = lane >> 4;
      int trow2[2];
#pragma unroll
      for (int m = 0; m < 2; ++m) { const int er = wid * 32 + m * 16 + fr; trow2[m] = list[(er < nvalid) ? er : 0]; }
      const bf16_t* W0h = W0 + (size_t)half * 64 * 256; const bf16_t* W1h = W1 + (size_t)half * 64 * 256;
      gemm128h(lds, 512, [&](int r, int k) { const int i = r >> 5; const int tok = (i == 0) ? tokA[0] : (i == 1) ? tokA[1] : (i == 2) ? tokA[2] : tokA[3]; return HID + (size_t)tok * 512 + k; },
               [&](int r, int k) { return ((k < 256) ? W0h : W1h) + (size_t)r * 256 + (k & 255); }, acc2);
#pragma unroll
      for (int m = 0; m < 2; ++m) {
        const int er = wid * 32 + m * 16 + fr;
        if (er < nvalid) {
#pragma unroll
          for (int n = 0; n < 4; ++n) { float* o = out + (size_t)trow2[m] * D + mi.nt * 128 + half * 64 + n * 16 + fq * 4; const f32x4 xi = *(const f32x4*)o; *(f32x4*)o = xi + acc2[m][n]; }
        }
      }
      continue;
    }
    f32x4 acc[4][4];
    int trow[4], tokA[4];
    {
      const int tid = threadIdx.x, wid = tid >> 6, lane = tid & 63, wr = wid >> 1, fr = lane & 15;
#pragma unroll
      for (int i = 0; i < 4; ++i) { const int r = (tid >> 3) + 32 * i; tokA[i] = list[(r < nvalid) ? r : 0]; }
#pragma unroll
      for (int m = 0; m < 4; ++m) { const int er = wr * 64 + m * 16 + fr; trow[m] = list[(er < nvalid) ? er : 0]; }
    }
    gemm128g(lds, 512, [&](int r, int k) { const int i = r >> 5; const int tok = (i == 0) ? tokA[0] : (i == 1) ? tokA[1] : (i == 2) ? tokA[2] : tokA[3]; return HID + (size_t)tok * 512 + k; },
            [&](int r, int k) { return ((k < 256) ? W0 : W1) + (size_t)r * 256 + (k & 255); }, acc);
    GEMM_EPI4({ if (er < nvalid) { const size_t o = (size_t)trow[m] * D + mi.nt * 128 + ec0; const f32x4 xi = *(const f32x4*)(out + o); *(f32x4*)(out + o) = xi + ev4; } })
  }
}


#define XB_TMO      128
#define XB_XCNT(j)  (256  + 64 * (j))
#define XB_XSUB(j)  (1280 + 64 * (j))
#define XB_XGEN(j)  (2304 + 64 * (j))
#define XB_TOP      3328
#define XB_TOPGEN   3392
#define XCD_BAR_WORDS 3456
#define XB_SPIN_CAP (1u << 18)
DEVI unsigned xb_ld(unsigned* p)              { return __hip_atomic_load(p, __ATOMIC_RELAXED, __HIP_MEMORY_SCOPE_AGENT); }
DEVI unsigned xb_add(unsigned* p, unsigned v) { return __hip_atomic_fetch_add(p, v, __ATOMIC_RELAXED, __HIP_MEMORY_SCOPE_AGENT); }
DEVI unsigned xb_xcc_id() { return (unsigned)__builtin_amdgcn_s_getreg((3 << 11) | 20) & 0xFu; }
#define XB_SPIN(cond, bar) do { unsigned _sp = 0; while (cond) { __builtin_amdgcn_s_sleep(1); \
    if ((++_sp & 255u) == 0u) { if (xb_ld(&(bar)[XB_TMO])) break; if (_sp > XB_SPIN_CAP) { atomicAdd(&(bar)[XB_TMO], 1u); break; } } } } while (0)
struct XcdBarrier { unsigned* bar; unsigned x; volatile LAS unsigned* st; };
DEVI XcdBarrier xcd_barrier_post(unsigned* bar, volatile LAS unsigned* st) {
    XcdBarrier b; b.bar = bar; b.x = xb_xcc_id(); b.st = st;
    if (threadIdx.x == 0) (void)xb_add(&bar[XB_XCNT(b.x)], 1u);
    return b;
}
DEVI void xcd_barrier_complete(unsigned* bar, unsigned x, unsigned& nloc, unsigned& nx) {
    const unsigned G = gridDim.x * gridDim.y * gridDim.z;
    unsigned sum, cnt, mine, sp = 0u;
    for (;;) {
        sum = 0u; cnt = 0u; mine = 0u;
#pragma unroll
        for (unsigned j = 0; j < 16; ++j) { const unsigned c = xb_ld(&bar[XB_XCNT(j)]); sum += c; cnt += (c > 0u) ? 1u : 0u; mine = (j == x) ? c : mine; }
        if (sum == G) break;
        __builtin_amdgcn_s_sleep(1);
        if ((++sp & 255u) == 0u) { if (xb_ld(&bar[XB_TMO])) break; if (sp > XB_SPIN_CAP) { atomicAdd(&bar[XB_TMO], 1u); break; } }
    }
    nloc = mine > 0u ? mine : 1u; nx = cnt > 0u ? cnt : 1u;
}
DEVI void xcd_barrier(const XcdBarrier& b) {
    asm volatile("s_waitcnt vmcnt(0)" ::: "memory");
    __syncthreads();
    if (threadIdx.x == 0) {
        unsigned* bar = b.bar;
        __builtin_amdgcn_s_waitcnt(0);
        unsigned nloc = b.st[0], nx = b.st[1];
        if (nloc == 0u) { xcd_barrier_complete(bar, b.x, nloc, nx); b.st[0] = nloc; b.st[1] = nx; }
        const unsigned old = xb_add(&bar[XB_XSUB(b.x)], 1u);
        const unsigned gen = old / nloc;
        if (old + 1u == (gen + 1u) * nloc) {
            __builtin_amdgcn_fence(__ATOMIC_RELEASE, "agent");
            asm volatile("s_waitcnt vmcnt(0)" ::: "memory");
            const unsigned og = xb_add(&bar[XB_TOP], 1u);
            const unsigned tg = og / nx;
            if (og + 1u == (tg + 1u) * nx) xb_add(&bar[XB_TOPGEN], 1u);
            else XB_SPIN(xb_ld(&bar[XB_TOPGEN]) == tg, bar);
            __builtin_amdgcn_fence(__ATOMIC_ACQUIRE, "agent");
            xb_add(&bar[XB_XGEN(b.x)], 1u);
            asm volatile("s_waitcnt vmcnt(0)" ::: "memory");
        } else {
            XB_SPIN(xb_ld(&bar[XB_XGEN(b.x)]) == gen, bar);
            __builtin_amdgcn_fence(__ATOMIC_ACQUIRE, "agent");
            asm volatile("s_waitcnt vmcnt(0)" ::: "memory");
        }
    }
    __syncthreads();
}

#define PH(k, call) { const int _k = (k); if (p.lo <= _k && _k < p.hi) { call; if (_k + 1 < p.hi) { if (_k == 0) grid.sync(); else xcd_barrier(xbar); } } }
__global__ void __launch_bounds__(NTHREADS, 2) hybrid_fwd(Params p) {
  extern __shared__ __attribute__((aligned(16))) unsigned char lds[];
  cg::grid_group grid = cg::this_grid();
  volatile LAS unsigned* xst = (volatile LAS unsigned*)(LAS unsigned char*)(lds + LDS_BYTES);
  if (threadIdx.x < 4) xst[threadIdx.x] = 0u;
  __syncthreads();
  XcdBarrier xbar = xcd_barrier_post((unsigned*)(p.ws + WS_CTL), xst);
  PH(0, phase_prep(p, lds))
#define LAYER(l) { \
    PH(1 + 13 * l + 0, phase_g1(p, l, lds)) \
    PH(1 + 13 * l + 2, phase_g2(p, l, lds)) \
    PH(1 + 13 * l + 3, phase_r2(p, l, lds)) \
    PH(1 + 13 * l + 4, phase_a1(p, l, lds)) \
    PH(1 + 13 * l + 5, phase_r3(p, l, lds)) \
    PH(1 + 13 * l + 6, phase_g3(p, l, lds)) \
    PH(1 + 13 * l + 7, phase_r4(p, l)) \
    PH(1 + 13 * l + 8, phase_g4(p, l, lds)) \
    PH(1 + 13 * l + 9, phase_r5(p, l, lds)) \
    PH(1 + 13 * l + 10, phase_g5(p, l, lds)) \
    PH(1 + 13 * l + 11, phase_g6(p, l, lds)) }
  LAYER(0)
  PH(13, rmsnorm_rows(p.out, p.in[2] + D, (bf16_t*)(p.ws + WS_A)))
  LAYER(1)
}

extern "C" void kernel_launch(void* const* d_in, const int* in_sizes, int n_in, void* d_out, int out_size, void* d_ws, size_t ws_size, hipStream_t stream) {
  static int grid_blocks = 0;
  if (!grid_blocks) {
    if (n_in != 45 || ws_size < WS_END) { fprintf(stderr, "kernel_launch: unexpected n_in %d or ws_size %zu (< %zu)\n", n_in, ws_size, (size_t)WS_END); grid_blocks = -1; return; }
    int dev = 0, cus = 0, per_cu = 0;
    hipGetDevice(&dev);
    hipDeviceGetAttribute(&cus, hipDeviceAttributeMultiprocessorCount, dev);
    hipFuncSetAttribute((const void*)hybrid_fwd, hipFuncAttributeMaxDynamicSharedMemorySize, LDS_ALLOC);
    hipOccupancyMaxActiveBlocksPerMultiprocessor(&per_cu, (const void*)hybrid_fwd, NTHREADS, LDS_ALLOC);
    if (per_cu < 1) per_cu = 1;
    if (per_cu > 2) per_cu = 2;
    grid_blocks = cus * per_cu;
    fprintf(stderr, "kernel_launch: cus %d per_cu %d grid %d\n", cus, per_cu, grid_blocks);
  }
  if (grid_blocks < 0) return;
  (void)hipMemsetAsync((unsigned char*)d_ws + WS_CTL, 0, XCD_BAR_WORDS * 4, stream);
  Params p{};
  for (int i = 0; i < 45; ++i) p.in[i] = (const float*)d_in[i];
  p.out = (float*)d_out; p.ws = (unsigned char*)d_ws;
#if N_LAUNCH_MODE == 1
  p.lo = 0; p.hi = NPH;
  { void* args[] = {&p}; hipError_t e = hipLaunchCooperativeKernel((void*)hybrid_fwd, dim3(grid_blocks), dim3(NTHREADS), args, LDS_ALLOC, stream);
    if (e != hipSuccess) fprintf(stderr, "cooperative launch failed: %s\n", hipGetErrorString(e)); }
#else
  for (int ph = 0; ph < NPH; ++ph) {
    p.lo = ph; p.hi = ph + 1;
    void* args[] = {&p}; hipError_t e = hipLaunchCooperativeKernel((void*)hybrid_fwd, dim3(grid_blocks), dim3(NTHREADS), args, LDS_ALLOC, stream);
    if (e != hipSuccess) { fprintf(stderr, "launch %d failed: %s\n", ph, hipGetErrorString(e)); break; }
  }
#endif
}
```

```cpp
#include <hip/hip_runtime.h>
#include <hip/hip_cooperative_groups.h>
#include <cstdio>
#include <cstdint>
namespace cg = cooperative_groups;

#ifndef N_LAUNCH_MODE
#define N_LAUNCH_MODE 1
#endif

#define DEVI __device__ __forceinline__
typedef unsigned short bf16_t;
typedef short bf16x8 __attribute__((ext_vector_type(8)));
typedef float f32x4 __attribute__((ext_vector_type(4)));
typedef float f32x16 __attribute__((ext_vector_type(16)));
typedef unsigned u32x4 __attribute__((ext_vector_type(4)));
#define LAS __attribute__((address_space(3)))

constexpr int NB = 16, S = 2048, T = NB * S, D = 1024, DIN = 1772, DINP = 1792, NL = 2;
constexpr int C_CQ = 0, C_KPE = 192, C_NG = 224, C_CKV = 256, C_LX = 384, C_LG = 640, C_S5 = 896, C_NQ = 1152, C_KS = 1408, C_KW = 1472, C_KC = 1536, C_VC = 1600, C_VS = 1664, C_VW = 1728;
__host__ __device__ constexpr int colmap(int n) {
  if (n < 192) return n;
  if (n < 320) return C_CKV + (n - 192);
  if (n < 352) return C_KPE + (n - 320);
  if (n < 608) return C_LX + (n - 352);
  if (n < 864) return C_LG + (n - 608);
  if (n < 1120) return C_S5 + (n - 864);
  if (n < 1376) return C_NQ + (n - 1120);
  if (n < 1760) { const int j = n - 1376, part = j >> 6, d = j & 63; return (part == 0 ? C_KC : part == 1 ? C_VC : part == 2 ? C_KS : part == 3 ? C_VS : part == 4 ? C_KW : C_VW) + d; }
  return C_NG + (n - 1760);
}
constexpr float EPS = 1e-6f;
constexpr float LOG2E = 1.4426950408889634f;
constexpr int NTHREADS = 256;
constexpr int NPH = 1 + 13 * NL - 1;

constexpr size_t MiB = 1u << 20;
constexpr size_t WS_CTL = 0;
constexpr size_t WS_SMALL = 1 * MiB;
constexpr size_t WS_W = 16 * MiB;
constexpr size_t WS_WL = 32 * MiB;
constexpr size_t WS_A = 80 * MiB;
constexpr size_t WS_B = 144 * MiB;
constexpr size_t WS_C = 256 * MiB;
constexpr size_t WS_D = 292 * MiB;
constexpr size_t WS_E = 348 * MiB;
constexpr size_t WS_F = 380 * MiB;
constexpr size_t WS_G = 428 * MiB;
constexpr size_t WS_ROPE = 452 * MiB;
constexpr size_t WS_END = 460 * MiB;
constexpr size_t W_IN = 0;
constexpr size_t W_OUT = 4 * MiB;
constexpr size_t W_UQ = 6 * MiB;
constexpr size_t W_UKV = W_UQ + 384 * 192 * 2;
constexpr size_t W_LRU = W_UKV + 512 * 128 * 2;
constexpr size_t W_GLU = W_LRU + 4 * 128 * 64 * 2;
constexpr size_t W_1K = 6 * MiB + 512 * 1024;
constexpr size_t W_1V = W_1K + 128 * 2048 * 2;
constexpr size_t W_B1K = W_1V + 128 * 2048 * 2;
constexpr size_t W_B1V = W_B1K + 512;
constexpr size_t W_S5A = W_B1V + 512;
constexpr size_t W_S5A64 = W_S5A + 16 * 64 * 8;
constexpr size_t W_S5B = W_S5A64 + 16 * 64 * 8;
constexpr size_t W_S5BB = W_S5B + 16 * 64 * 16 * 8;
constexpr size_t W_S5CM = W_S5BB + 16 * 4 * 32 * 16 * 2;
constexpr size_t W_2K = W_S5CM + 16 * 16 * 128 * 2;
constexpr size_t W_2V = W_2K + 64 * 128 * 2;
static_assert(W_2V + 64 * 128 * 2 <= 8 * MiB, "weights overflow");
constexpr size_t W_RTH = W_2V + 64 * 128 * 2;
constexpr size_t W_RTL = W_RTH + 32 * 1024 * 2;
static_assert(W_RTL + 32 * 1024 * 2 <= 8 * MiB, "weights overflow 2");
constexpr size_t W_GU = 8 * MiB;
constexpr size_t W_DN = 24 * MiB;
constexpr size_t SM_CNT = WS_SMALL;
constexpr size_t SM_LIST = WS_SMALL + 4096;
constexpr size_t SM_TOKW = SM_LIST + 24 * (size_t)T * 4;
constexpr size_t SM_LSUM = SM_TOKW + (size_t)T * 8;
constexpr size_t SM_SLOC = SM_LSUM + 16 * 32 * 256 * 8;
constexpr size_t SM_HK = SM_SLOC + 16 * 32 * 1024 * 8;
constexpr size_t SM_HV = SM_HK + 2048 * 128 * 2;
constexpr size_t SM_KC = SM_HV + 2048 * 128 * 2;
constexpr size_t SM_VC = SM_KC + 16 * 128 * 64 * 2;
constexpr size_t SM_SCAR = SM_VC + 16 * 128 * 64 * 2;
constexpr size_t SM_LCAR = SM_SCAR + 16 * 32 * 1024 * 8;
constexpr size_t SM_END = SM_LCAR + 16 * 32 * 256 * 4;
static_assert(SM_END <= WS_W, "small region overflow");

constexpr int LDS_BYTES = 65536;
constexpr int LDS_ALLOC = LDS_BYTES + 512;

struct Params {
  const float* in[45];
  float* out;
  unsigned char* ws;
  int lo, hi;
};

DEVI float bf2f(bf16_t v) { return __uint_as_float(((unsigned)v) << 16); }
DEVI bf16_t f2bf(float f) { unsigned u = __float_as_uint(f); return (bf16_t)((u + 0x7fffu + ((u >> 16) & 1u)) >> 16); }
DEVI float wsum(float v) {
#pragma unroll
  for (int o = 32; o >= 1; o >>= 1) v += __shfl_xor(v, o);
  return v;
}
DEVI float sigmoidf_(float x) { return __builtin_amdgcn_rcpf(1.f + __expf(-x)); }
DEVI float gelu_tanh(float x) { const float u2 = 1.5957691216057308f * (x + 0.044715f * x * x * x); return x * __builtin_amdgcn_rcpf(1.f + __expf(-u2)); }
DEVI f32x16 mfma32(bf16x8 a, bf16x8 b, f32x16 c) { return __builtin_amdgcn_mfma_f32_32x32x16_bf16(a, b, c, 0, 0, 0); }
DEVI f32x4 mfma16(bf16x8 a, bf16x8 b, f32x4 c) { return __builtin_amdgcn_mfma_f32_16x16x32_bf16(a, b, c, 0, 0, 0); }
DEVI int vblock() { const int G = (int)gridDim.x, bx = (int)blockIdx.x; return (G % 8 == 0) ? (bx % 8) * (G / 8) + bx / 8 : bx; }
DEVI int crow(int r, int h) { return (r & 3) + 8 * (r >> 2) + 4 * h; }
typedef __bf16 bf16x2_t __attribute__((ext_vector_type(2)));
typedef float f32x2_t __attribute__((ext_vector_type(2)));
DEVI unsigned pk2bf(float lo, float hi) { f32x2_t v = {lo, hi}; bf16x2_t b = __builtin_convertvector(v, bf16x2_t); return __builtin_bit_cast(unsigned, b); }

template <class AF, class BF>
DEVI void gemm128(unsigned char* lds, int K, AF aload, BF bptr, f32x4 (&acc)[4][4]) {
  const int tid = threadIdx.x, wid = tid >> 6, lane = tid & 63, wr = wid >> 1, wc = wid & 1, fr = lane & 15, fq = lane >> 4;
#pragma unroll
  for (int m = 0; m < 4; ++m)
#pragma unroll
    for (int n = 0; n < 4; ++n) acc[m][n] = (f32x4){0.f, 0.f, 0.f, 0.f};
  const int lr = tid >> 3, ch = tid & 7;
  const int wofs = lr * 128 + ((ch ^ ((lr >> 1) & 7)) * 16);
  const int sw = (fr >> 1) & 7;
  const int aro = (wr * 64 + fr) * 128, bro = (wc * 64 + fr) * 128;
  const int nk = K >> 6;
  u32x4 ra[4], rb[4];
#pragma unroll
  for (int i = 0; i < 4; ++i) { ra[i] = aload(lr + 32 * i, ch * 8); rb[i] = *(const u32x4*)bptr(lr + 32 * i, ch * 8); }
  __syncthreads();
#pragma unroll
  for (int i = 0; i < 4; ++i) { *(u32x4*)(lds + wofs + i * 4096) = ra[i]; *(u32x4*)(lds + 16384 + wofs + i * 4096) = rb[i]; }
  __syncthreads();
  for (int kt = 0; kt < nk; ++kt) {
    const bool more = (kt + 1 < nk);
    if (more) {
      const int k = (kt + 1) * 64 + ch * 8;
#pragma unroll
      for (int i = 0; i < 4; ++i) { ra[i] = aload(lr + 32 * i, k); rb[i] = *(const u32x4*)bptr(lr + 32 * i, k); }
    }
    const unsigned char* bufA = lds + (kt & 1) * 32768;
    const unsigned char* bufB = bufA + 16384;
#pragma unroll
    for (int kk = 0; kk < 2; ++kk) {
      bf16x8 At[4], Bt[4];
      const int co = ((kk * 4 + fq) ^ sw) * 16;
#pragma unroll
      for (int m = 0; m < 4; ++m) At[m] = *(const bf16x8*)(bufA + aro + m * 2048 + co);
#pragma unroll
      for (int n = 0; n < 4; ++n) Bt[n] = *(const bf16x8*)(bufB + bro + n * 2048 + co);
#pragma unroll
      for (int m = 0; m < 4; ++m)
#pragma unroll
        for (int n = 0; n < 4; ++n) acc[m][n] = mfma16(Bt[n], At[m], acc[m][n]);
    }
    if (more) {
      unsigned char* nb = lds + ((kt + 1) & 1) * 32768;
#pragma unroll
      for (int i = 0; i < 4; ++i) { *(u32x4*)(nb + wofs + i * 4096) = ra[i]; *(u32x4*)(nb + 16384 + wofs + i * 4096) = rb[i]; }
    }
    __syncthreads();
  }
}
template <class AF, class BF>
DEVI void gemm128g(unsigned char* lds, int K, AF aptr, BF bptr, f32x4 (&acc)[4][4]) {
  const int tid = threadIdx.x, wid = tid >> 6, lane = tid & 63, wr = wid >> 1, wc = wid & 1, fr = lane & 15, fq = lane >> 4;
#pragma unroll
  for (int m = 0; m < 4; ++m)
#pragma unroll
    for (int n = 0; n < 4; ++n) acc[m][n] = (f32x4){0.f, 0.f, 0.f, 0.f};
  const int lr = tid >> 3;
  const int chs = ((tid & 7) ^ ((lr >> 1) & 7)) * 8;
  const int sw = (fr >> 1) & 7;
  const int aro = (wr * 64 + fr) * 128, bro = (wc * 64 + fr) * 128;
  const int nk = K >> 6;
  LAS unsigned char* l3 = (LAS unsigned char*)lds;
#define G128_STAGE(buf, kbase)                                                                                                   \
  _Pragma("unroll") for (int i = 0; i < 4; ++i) {                                                                                 \
    __builtin_amdgcn_global_load_lds((const __attribute__((address_space(1))) unsigned*)aptr(lr + 32 * i, (kbase) + chs),          \
                                     (LAS unsigned*)(l3 + (buf) * 32768 + tid * 16 + i * 4096), 16, 0, 0);                           \
    __builtin_amdgcn_global_load_lds((const __attribute__((address_space(1))) unsigned*)bptr(lr + 32 * i, (kbase) + chs),          \
                                     (LAS unsigned*)(l3 + (buf) * 32768 + 16384 + tid * 16 + i * 4096), 16, 0, 0);                   \
  }
  __syncthreads();
  G128_STAGE(0, 0)
  asm volatile("s_waitcnt vmcnt(0)" ::: "memory");
  __syncthreads();
  for (int kt = 0; kt < nk; ++kt) {
    if (kt + 1 < nk) { G128_STAGE((kt + 1) & 1, (kt + 1) * 64) }
    const unsigned char* bufA = lds + (kt & 1) * 32768;
    const unsigned char* bufB = bufA + 16384;
#pragma unroll
    for (int kk = 0; kk < 2; ++kk) {
      bf16x8 At[4], Bt[4];
      const int co = ((kk * 4 + fq) ^ sw) * 16;
#pragma unroll
      for (int m = 0; m < 4; ++m) At[m] = *(const bf16x8*)(bufA + aro + m * 2048 + co);
#pragma unroll
      for (int n = 0; n < 4; ++n) Bt[n] = *(const bf16x8*)(bufB + bro + n * 2048 + co);
#pragma unroll
      for (int m = 0; m < 4; ++m)
#pragma unroll
        for (int n = 0; n < 4; ++n) acc[m][n] = mfma16(Bt[n], At[m], acc[m][n]);
    }
    asm volatile("s_waitcnt vmcnt(0)" ::: "memory");
    __syncthreads();
  }
#undef G128_STAGE
}
template <class AF, class BF, class AF2, class BF2>
DEVI void gemm128p(unsigned char* lds, int K, AF aptr, BF bptr, f32x4 (&acc)[4][4], int& par, bool staged, bool has_next, AF2 naptr, BF2 nbptr) {
  const int tid = threadIdx.x, wid = tid >> 6, lane = tid & 63, wr = wid >> 1, wc = wid & 1, fr = lane & 15, fq = lane >> 4;
#pragma unroll
  for (int m = 0; m < 4; ++m)
#pragma unroll
    for (int n = 0; n < 4; ++n) acc[m][n] = (f32x4){0.f, 0.f, 0.f, 0.f};
  const int lr = tid >> 3;
  const int chs = ((tid & 7) ^ ((lr >> 1) & 7)) * 8;
  const int sw = (fr >> 1) & 7;
  const int aro = (wr * 64 + fr) * 128, bro = (wc * 64 + fr) * 128;
  const int nk = K >> 6;
  LAS unsigned char* l3 = (LAS unsigned char*)lds;
#define GP_STAGE(buf, kbase, AP, BP)                                                                                             \
  _Pragma("unroll") for (int i = 0; i < 4; ++i) {                                                                                 \
    __builtin_amdgcn_global_load_lds((const __attribute__((address_space(1))) unsigned*)AP(lr + 32 * i, (kbase) + chs),            \
                                     (LAS unsigned*)(l3 + (buf) * 32768 + tid * 16 + i * 4096), 16, 0, 0);                           \
    __builtin_amdgcn_global_load_lds((const __attribute__((address_space(1))) unsigned*)BP(lr + 32 * i, (kbase) + chs),            \
                                     (LAS unsigned*)(l3 + (buf) * 32768 + 16384 + tid * 16 + i * 4096), 16, 0, 0);                   \
  }
  if (!staged) {
    __syncthreads();
    GP_STAGE(par, 0, aptr, bptr)
    asm volatile("s_waitcnt vmcnt(0)" ::: "memory");
    __syncthreads();
  }
  for (int kt = 0; kt < nk; ++kt) {
    const int cur = (par + kt) & 1;
    if (kt + 1 < nk) { GP_STAGE(cur ^ 1, (kt + 1) * 64, aptr, bptr) }
    else if (has_next) { GP_STAGE(cur ^ 1, 0, naptr, nbptr) }
    const unsigned char* bufA = lds + cur * 32768;
    const unsigned char* bufB = bufA + 16384;
#pragma unroll
    for (int kk = 0; kk < 2; ++kk) {
      bf16x8 At[4], Bt[4];
      const int co = ((kk * 4 + fq) ^ sw) * 16;
#pragma unroll
      for (int m = 0; m < 4; ++m) At[m] = *(const bf16x8*)(bufA + aro + m * 2048 + co);
#pragma unroll
      for (int n = 0; n < 4; ++n) Bt[n] = *(const bf16x8*)(bufB + bro + n * 2048 + co);
#pragma unroll
      for (int m = 0; m < 4; ++m)
#pragma unroll
        for (int n = 0; n < 4; ++n) acc[m][n] = mfma16(Bt[n], At[m], acc[m][n]);
    }
    asm volatile("s_waitcnt vmcnt(0)" ::: "memory");
    __syncthreads();
  }
  par = (par + nk) & 1;
#undef GP_STAGE
}
template <class AF, class BF>
DEVI void gemm128h(unsigned char* lds, int K, AF aptr, BF bptr, f32x4 (&acc)[2][4]) {
  const int tid = threadIdx.x, wid = tid >> 6, lane = tid & 63, fr = lane & 15, fq = lane >> 4;
#pragma unroll
  for (int m = 0; m < 2; ++m)
#pragma unroll
    for (int n = 0; n < 4; ++n) acc[m][n] = (f32x4){0.f, 0.f, 0.f, 0.f};
  const int lr = tid >> 3;
  const int chs = ((tid & 7) ^ ((lr >> 1) & 7)) * 8;
  const int sw = (fr >> 1) & 7;
  const int aro = (wid * 32 + fr) * 128, bro = fr * 128;
  const int nk = K >> 6;
  LAS unsigned char* l3 = (LAS unsigned char*)lds;
#define GH_STAGE(buf, kbase)                                                                                                     \
  { _Pragma("unroll") for (int i = 0; i < 4; ++i)                                                                                 \
      __builtin_amdgcn_global_load_lds((const __attribute__((address_space(1))) unsigned*)aptr(lr + 32 * i, (kbase) + chs),        \
                                       (LAS unsigned*)(l3 + (buf) * 32768 + tid * 16 + i * 4096), 16, 0, 0);                         \
    _Pragma("unroll") for (int i = 0; i < 2; ++i)                                                                                 \
      __builtin_amdgcn_global_load_lds((const __attribute__((address_space(1))) unsigned*)bptr(lr + 32 * i, (kbase) + chs),        \
                                       (LAS unsigned*)(l3 + (buf) * 32768 + 16384 + tid * 16 + i * 4096), 16, 0, 0); }
  __syncthreads();
  GH_STAGE(0, 0)
  asm volatile("s_waitcnt vmcnt(0)" ::: "memory");
  __syncthreads();
  for (int kt = 0; kt < nk; ++kt) {
    if (kt + 1 < nk) { GH_STAGE((kt + 1) & 1, (kt + 1) * 64) }
    const unsigned char* bufA = lds + (kt & 1) * 32768;
    const unsigned char* bufB = bufA + 16384;
#pragma unroll
    for (int kk = 0; kk < 2; ++kk) {
      bf16x8 At[2], Bt[4];
      const int co = ((kk * 4 + fq) ^ sw) * 16;
#pragma unroll
      for (int m = 0; m < 2; ++m) At[m] = *(const bf16x8*)(bufA + aro + m * 2048 + co);
#pragma unroll
      for (int n = 0; n < 4; ++n) Bt[n] = *(const bf16x8*)(bufB + bro + n * 2048 + co);
#pragma unroll
      for (int m = 0; m < 2; ++m)
#pragma unroll
        for (int n = 0; n < 4; ++n) acc[m][n] = mfma16(Bt[n], At[m], acc[m][n]);
    }
    asm volatile("s_waitcnt vmcnt(0)" ::: "memory");
    __syncthreads();
  }
#undef GH_STAGE
}
#define GEMM_EPI_LOOP(body)                                                                 \
  {                                                                                         \
    const int _tid = threadIdx.x, _wid = _tid >> 6, _lane = _tid & 63, _wr = _wid >> 1, _wc = _wid & 1, _fr = _lane & 15, _fq = _lane >> 4; \
    _Pragma("unroll") for (int m = 0; m < 4; ++m) _Pragma("unroll") for (int n = 0; n < 4; ++n) _Pragma("unroll") for (int j = 0; j < 4; ++j) { \
      const int er = _wr * 64 + m * 16 + _fr, ec = _wc * 64 + n * 16 + _fq * 4 + j; const float ev = acc[m][n][j]; body }                      \
  }
#define GEMM_EPI4(body)                                                                     \
  {                                                                                         \
    const int _tid = threadIdx.x, _wid = _tid >> 6, _lane = _tid & 63, _wr = _wid >> 1, _wc = _wid & 1, _fr = _lane & 15, _fq = _lane >> 4; \
    _Pragma("unroll") for (int m = 0; m < 4; ++m) _Pragma("unroll") for (int n = 0; n < 4; ++n) {                                             \
      const int er = _wr * 64 + m * 16 + _fr, ec0 = _wc * 64 + n * 16 + _fq * 4; const f32x4 ev4 = acc[m][n]; body }                          \
  }
DEVI void st_bf16x4(bf16_t* p, f32x4 v) { uint2 o; o.x = pk2bf(v[0], v[1]); o.y = pk2bf(v[2], v[3]); *(uint2*)p = o; }

template <class RM>
DEVI void transpose_tiles(const float* src, int K, int N, bf16_t* dst, int ldk, RM rowmap, unsigned char* lds, int& cursor, const float* kscale = nullptr) {
  float* tl = (float*)lds;
  const int tk = K / 64, tn = (N + 63) / 64, nt = tk * tn;
  const int tid = threadIdx.x;
  const int G_ = (int)gridDim.x;
  for (int it = ((int)blockIdx.x - cursor % G_ + G_) % G_; it < nt; it += G_) {
    const int kt = it / tn, ntile = it % tn, k0 = kt * 64, n0 = ntile * 64;
    __syncthreads();
#pragma unroll
    for (int q = 0; q < 4; ++q) {
      const int r = (tid >> 4) + 16 * q, c4 = (tid & 15) * 4;
      const float* sp = src + (size_t)(k0 + r) * N + n0 + c4;
      float4 v;
      if (n0 + c4 + 3 < N) v = *(const float4*)sp;
      else { v.x = (n0 + c4 < N) ? sp[0] : 0.f; v.y = (n0 + c4 + 1 < N) ? sp[1] : 0.f; v.z = (n0 + c4 + 2 < N) ? sp[2] : 0.f; v.w = 0.f; }
      if (kscale) { const float ks = kscale[k0 + r]; v.x *= ks; v.y *= ks; v.z *= ks; v.w *= ks; }
      tl[r * 65 + c4] = v.x; tl[r * 65 + c4 + 1] = v.y; tl[r * 65 + c4 + 2] = v.z; tl[r * 65 + c4 + 3] = v.w;
    }
    __syncthreads();
    const int n = tid >> 2, kc = (tid & 3) * 16;
    if (n0 + n < N) {
      unsigned w[8];
#pragma unroll
      for (int i = 0; i < 8; ++i) w[i] = pk2bf(tl[(kc + 2 * i) * 65 + n], tl[(kc + 2 * i + 1) * 65 + n]);
      uint4* o = (uint4*)(dst + (size_t)rowmap(n0 + n) * ldk + k0 + kc);
      o[0] = make_uint4(w[0], w[1], w[2], w[3]); o[1] = make_uint4(w[4], w[5], w[6], w[7]);
    }
  }
  cursor += nt;
}
DEVI void rmsnorm_rows(const float* x, const float* g, bf16_t* xn) {
  const int lane = threadIdx.x & 63, gw = blockIdx.x * 4 + (threadIdx.x >> 6), NGW = gridDim.x * 4;
  float4 gg[4];
#pragma unroll
  for (int j = 0; j < 4; ++j) gg[j] = ((const float4*)g)[lane + 64 * j];
  for (int t0 = gw * 4; t0 < T; t0 += NGW * 4) {
    float4 v[4][4];
#pragma unroll
    for (int q = 0; q < 4; ++q)
#pragma unroll
      for (int j = 0; j < 4; ++j) v[q][j] = ((const float4*)(x + (size_t)(t0 + q) * D))[lane + 64 * j];
#pragma unroll
    for (int q = 0; q < 4; ++q) {
      float s = 0.f;
#pragma unroll
      for (int j = 0; j < 4; ++j) s += v[q][j].x * v[q][j].x + v[q][j].y * v[q][j].y + v[q][j].z * v[q][j].z + v[q][j].w * v[q][j].w;
      const float rs = rsqrtf(wsum(s) * (1.f / D) + EPS);
#pragma unroll
      for (int j = 0; j < 4; ++j) {
        uint2 o; o.x = pk2bf(v[q][j].x * rs * gg[j].x, v[q][j].y * rs * gg[j].y); o.y = pk2bf(v[q][j].z * rs * gg[j].z, v[q][j].w * rs * gg[j].w);
        ((uint2*)(xn + (size_t)(t0 + q) * D))[lane + 64 * j] = o;
      }
    }
  }
}
DEVI void phase_prep(const Params& p, unsigned char* lds) {
  const size_t gtid = (size_t)blockIdx.x * NTHREADS + threadIdx.x, gn = (size_t)gridDim.x * NTHREADS;
  unsigned char* ws = p.ws;
  if (gtid < 64) ((int*)(ws + SM_CNT))[gtid] = 0;
  auto ident = [](int n) { return n; };
  int cursor = 0;
  for (int l = 0; l < NL; ++l) {
    unsigned char* wl = ws + WS_W + l * WS_WL;
    transpose_tiles(p.in[3] + (size_t)l * D * DIN, D, DIN, (bf16_t*)(wl + W_IN), D, [](int n) { return colmap(n); }, lds, cursor);
    for (size_t i = gtid; i < (size_t)20 * D; i += gn) ((bf16_t*)(wl + W_IN))[(size_t)236 * D + i] = 0;
    transpose_tiles(p.in[36] + (size_t)l * D * D, D, D, (bf16_t*)(wl + W_OUT), D, ident, lds, cursor);
    transpose_tiles(p.in[6] + (size_t)l * 192 * 384, 192, 384, (bf16_t*)(wl + W_UQ), 192, ident, lds, cursor, p.in[4] + l * 192);
    transpose_tiles(p.in[7] + (size_t)l * 128 * 512, 128, 512, (bf16_t*)(wl + W_UKV), 128, ident, lds, cursor, p.in[5] + l * 128);
    transpose_tiles(p.in[25] + (size_t)l * 256 * 256, 256, 256, (bf16_t*)(wl + W_GLU), 256, ident, lds, cursor);
    transpose_tiles(p.in[30] + (size_t)l * 2048 * 128, 2048, 128, (bf16_t*)(wl + W_1K), 2048, ident, lds, cursor);
    transpose_tiles(p.in[33] + (size_t)l * 2048 * 128, 2048, 128, (bf16_t*)(wl + W_1V), 2048, ident, lds, cursor);
    transpose_tiles(p.in[31] + (size_t)l * 128 * 64, 128, 64, (bf16_t*)(wl + W_2K), 128, ident, lds, cursor);
    transpose_tiles(p.in[34] + (size_t)l * 128 * 64, 128, 64, (bf16_t*)(wl + W_2V), 128, ident, lds, cursor);
    for (int h = 0; h < 4; ++h) {
      transpose_tiles(p.in[12] + ((size_t)l * 4 + h) * 64 * 64, 64, 64, (bf16_t*)(wl + W_LRU) + h * 128 * 64, 64, ident, lds, cursor);
      transpose_tiles(p.in[14] + ((size_t)l * 4 + h) * 64 * 64, 64, 64, (bf16_t*)(wl + W_LRU) + h * 128 * 64 + 64 * 64, 64, ident, lds, cursor);
    }
    for (int e = 0; e < 16; ++e) {
      bf16_t* dg = (bf16_t*)(wl + W_GU) + (size_t)e * 512 * 1024;
      transpose_tiles(p.in[42] + ((size_t)l * 16 + e) * 1024 * 256, 1024, 256, dg, 1024, [](int hh) { return (hh >> 6) * 128 + ((hh >> 5) & 1) * 64 + ((hh >> 4) & 1) * 16 + (hh & 15); }, lds, cursor);
      transpose_tiles(p.in[43] + ((size_t)l * 16 + e) * 1024 * 256, 1024, 256, dg, 1024, [](int hh) { return (hh >> 6) * 128 + ((hh >> 5) & 1) * 64 + (((hh >> 4) & 1) + 2) * 16 + (hh & 15); }, lds, cursor);
      transpose_tiles(p.in[44] + ((size_t)l * 16 + e) * 256 * 1024, 256, 1024, (bf16_t*)(wl + W_DN) + (size_t)e * 1024 * 256, 256, ident, lds, cursor);
    }
    {
      const int lane = threadIdx.x & 63, gw = blockIdx.x * 4 + (threadIdx.x >> 6), NGW = gridDim.x * 4;
      for (int o = gw; o < 256; o += NGW) {
        const int kv = o >> 7, j = o & 127;
        const float* pe = (kv ? p.in[32] : p.in[29]) + (size_t)l * 2048;
        const float* w1 = (kv ? p.in[33] : p.in[30]) + (size_t)l * 2048 * 128;
        float a = 0.f;
#pragma unroll 8
        for (int k = lane; k < 2048; k += 64) a += pe[k] * w1[(size_t)k * 128 + j];
        a = wsum(a);
        if (lane == 0) ((float*)(wl + (kv ? W_B1V : W_B1K)))[j] = a;
      }
    }
    for (size_t i = gtid; i < 16 * 64; i += gn) {
      const int g = (int)(i >> 6), sidx = (int)(i & 63);
      const float are = p.in[17][(size_t)l * 1024 + i], aim = p.in[18][(size_t)l * 1024 + i];
      const float dt = expf(p.in[19][l * 16 + g]);
      const float mag = expf(dt * are);
      float sn, cs; sincosf(dt * aim, &sn, &cs);
      const float abr = mag * cs, abi = mag * sn;
      const float den = are * are + aim * aim, nre = abr - 1.f;
      const float gre = (nre * are + abi * aim) / den, gim = (abi * are - nre * aim) / den;
      ((float2*)(wl + W_S5A))[i] = make_float2(abr, abi);
      float pr = abr, pi = abi;
#pragma unroll
      for (int q = 0; q < 6; ++q) { const float nr = pr * pr - pi * pi, ni = 2.f * pr * pi; pr = nr; pi = ni; }
      ((float2*)(wl + W_S5A64))[i] = make_float2(pr, pi);
      bf16_t* bb = (bf16_t*)(wl + W_S5BB);
      for (int ch = 0; ch < 16; ++ch) {
        const float br = p.in[20][((size_t)l * 1024 + i) * 16 + ch], bi = p.in[21][((size_t)l * 1024 + i) * 16 + ch];
        const float vr = gre * br - gim * bi, vi = gre * bi + gim * br;
        const int sb = sidx >> 5, r = sidx & 31;
        bb[((g * 4 + sb * 2 + 0) * 32 + r) * 16 + ch] = f2bf(vr);
        bb[((g * 4 + sb * 2 + 1) * 32 + r) * 16 + ch] = f2bf(vi);
      }
    }
    for (size_t i = gtid; i < 32 * 1024; i += gn) {
      const int n = (int)(i >> 10), k = (int)(i & 1023);
      float w = 0.f;
      if (n < 20) w = p.in[37][l * D + k] * ((n < 4) ? p.in[38][((size_t)l * D + k) * 4 + n] : p.in[40][((size_t)l * D + k) * 16 + (n - 4)]);
      const bf16_t hi = f2bf(w);
      ((bf16_t*)(wl + W_RTH))[i] = hi; ((bf16_t*)(wl + W_RTL))[i] = f2bf(w - bf2f(hi));
    }
    for (size_t i = gtid; i < 16 * 16 * 64; i += gn) {
      const int g = (int)(i >> 10), ch = (int)((i >> 6) & 15), pp = (int)(i & 63);
      const float cr = p.in[22][(size_t)l * 16384 + i], ci = p.in[23][(size_t)l * 16384 + i];
      bf16_t* cm = (bf16_t*)(wl + W_S5CM) + ((size_t)(g * 16 + ch) * 128 + 2 * pp);
      cm[0] = f2bf(cr); cm[1] = f2bf(-ci);
    }
  }
  {
    const int* positions = (const int*)p.in[1];
    float2* RM = (float2*)(ws + WS_ROPE);
    float2* RN = RM + (size_t)T * 16;
    for (size_t i = gtid; i < (size_t)T * 24; i += gn) {
      const int t = (int)(i / 24), j = (int)(i % 24);
      const int rot = (j < 16) ? 32 : 16, fi = (j < 16) ? j : (j - 16);
      const float inv = powf(500000.f, -(2.f * (float)fi) / (float)rot);
      float sn, cs; sincosf((float)positions[t] * inv, &sn, &cs);
      if (j < 16) RM[(size_t)t * 16 + fi] = make_float2(cs, sn); else RN[(size_t)t * 8 + fi] = make_float2(cs, sn);
    }
  }
  rmsnorm_rows(p.in[0], p.in[2], (bf16_t*)(ws + WS_A));
}

DEVI void phase_g1(const Params& p, int l, unsigned char* lds) {
  const bf16_t* XN = (const bf16_t*)(p.ws + WS_A);
  const bf16_t* W = (const bf16_t*)(p.ws + WS_W + l * WS_WL + W_IN);
  bf16_t* PROJ = (bf16_t*)(p.ws + WS_B);
  constexpr int NT = DINP / 128;
  int par = 0; bool staged = false;
  for (int it = vblock(); it < (T / 128) * NT; it += gridDim.x) {
    const int mt = it / NT, nt = it % NT;
    const int itn = it + (int)gridDim.x; const bool hn = itn < (T / 128) * NT; const int mtn = itn / NT, ntn = itn % NT;
    f32x4 acc[4][4];
    gemm128p(lds, D, [&](int r, int k) { return XN + (size_t)(mt * 128 + r) * D + k; }, [&](int r, int k) { return W + (size_t)(nt * 128 + r) * D + k; }, acc, par, staged, hn,
             [&](int r, int k) { return XN + (size_t)(mtn * 128 + r) * D + k; }, [&](int r, int k) { return W + (size_t)(ntn * 128 + r) * D + k; });
    staged = hn;
    if (nt >= 9 && nt <= 11) {
      const int tid = threadIdx.x, wid = tid >> 6, lane = tid & 63, wr = wid >> 1, wc = wid & 1, fr = lane & 15, fq = lane >> 4;
      const float* gg = (nt < 11) ? (p.in[27] + l * 64) : (p.in[28] + l * 192 + (wc ? 128 : 64));
      const float sc = (nt < 11) ? (0.125f * LOG2E) : 1.f;
      const float2* RN = (const float2*)(p.ws + WS_ROPE) + (size_t)T * 16;
#pragma unroll
      for (int m = 0; m < 4; ++m) {
        const size_t t = (size_t)mt * 128 + wr * 64 + m * 16 + fr;
        float ss = 0.f;
#pragma unroll
        for (int n = 0; n < 4; ++n) ss += acc[m][n][0] * acc[m][n][0] + acc[m][n][1] * acc[m][n][1] + acc[m][n][2] * acc[m][n][2] + acc[m][n][3] * acc[m][n][3];
        ss += __shfl_xor(ss, 16); ss += __shfl_xor(ss, 32);
        const float rs = rsqrtf(ss * (1.f / 64) + EPS);
#pragma unroll
        for (int n = 0; n < 4; ++n) {
          const float4 g4 = *(const float4*)(gg + n * 16 + fq * 4);
          f32x4 v = acc[m][n];
          v[0] *= rs * g4.x; v[1] *= rs * g4.y; v[2] *= rs * g4.z; v[3] *= rs * g4.w;
          if (n == 0) {
#pragma unroll
            for (int j = 0; j < 4; ++j) {
              const float x = v[j], partner = __shfl_xor(x, 32);
              const int d = fq * 4 + j; const float2 cs2 = RN[t * 8 + (d & 7)];
              v[j] = (d < 8) ? (x * cs2.x - partner * cs2.y) : (partner * cs2.y + x * cs2.x);
            }
          }
          st_bf16x4(PROJ + t * DINP + nt * 128 + wc * 64 + n * 16 + fq * 4, v * sc);
        }
      }
    } else {
      GEMM_EPI4({ st_bf16x4(PROJ + (size_t)(mt * 128 + er) * DINP + nt * 128 + ec0, ev4); })
    }
  }
}

DEVI void phase_g2(const Params& p, int l, unsigned char* lds) {
  unsigned char* wl = p.ws + WS_W + l * WS_WL;
  const bf16_t* PROJ = (const bf16_t*)(p.ws + WS_B);
  bf16_t* QR = (bf16_t*)(p.ws + WS_D);
  bf16_t* KVR = QR + (size_t)T * 384;
  bf16_t* GATES = (bf16_t*)(p.ws + WS_E);
  bf16_t* MK = (bf16_t*)(p.ws + WS_F) + (size_t)T * 4 * 96;
  const float2* RM = (const float2*)(p.ws + WS_ROPE);
  constexpr int N_CMP = 64, N_QR = 256 * 3, N_KVR = 256 * 4, N_GT = 256 * 4;
  const int tid = threadIdx.x, wid = tid >> 6, lane = tid & 63, wr = wid >> 1, wc = wid & 1, fr = lane & 15, fq = lane >> 4;
  for (int it = vblock(); it < N_CMP + N_QR + N_KVR + N_GT; it += gridDim.x) {
    f32x4 acc[4][4];
    if (it < N_CMP) {
      const int kv = it & 1, half = (it >> 1) & 1, mt = it >> 2;
      const bf16_t* W = (const bf16_t*)(wl + (kv ? W_1V : W_1K)) + (size_t)half * 64 * 2048;
      const float* bias = (const float*)(wl + (kv ? W_B1V : W_B1K)) + half * 64;
      bf16_t* H = (bf16_t*)(p.ws + (kv ? SM_HV : SM_HK)) + half * 64;
      f32x4 acc2[2][4];
      gemm128h(lds, 2048,
              [&](int r, int k) { const int m = mt * 128 + r, b = m >> 7; int c = m & 127; if (c > 126) c = 126;
                                  return PROJ + (size_t)(b * S + 16 * c + (k >> 6)) * DINP + C_KC + kv * 64 + (k & 63); },
              [&](int r, int k) { return W + (size_t)r * 2048 + k; }, acc2);
#pragma unroll
      for (int m = 0; m < 2; ++m)
#pragma unroll
        for (int n = 0; n < 4; ++n) {
          const float4 b4 = *(const float4*)(bias + n * 16 + fq * 4);
          f32x4 o; o[0] = gelu_tanh(acc2[m][n][0] + b4.x); o[1] = gelu_tanh(acc2[m][n][1] + b4.y); o[2] = gelu_tanh(acc2[m][n][2] + b4.z); o[3] = gelu_tanh(acc2[m][n][3] + b4.w);
          st_bf16x4(H + (size_t)(mt * 128 + wid * 32 + m * 16 + fr) * 128 + n * 16 + fq * 4, o);
        }
    } else if (it < N_CMP + N_QR) {
      const int i2 = it - N_CMP, mt = i2 / 3, nt = i2 % 3;
      const bf16_t* W = (const bf16_t*)(wl + W_UQ);
      gemm128g(lds, 192, [&](int r, int k) { return PROJ + (size_t)(mt * 128 + r) * DINP + C_CQ + k; }, [&](int r, int k) { return W + (size_t)(nt * 128 + r) * 192 + k; }, acc);
      GEMM_EPI4({ st_bf16x4(QR + (size_t)(mt * 128 + er) * 384 + nt * 128 + ec0, ev4); })
    } else if (it < N_CMP + N_QR + N_KVR) {
      const int i2 = it - N_CMP - N_QR, mt = i2 >> 2, hd = i2 & 3;
      const bf16_t* W = (const bf16_t*)(wl + W_UKV);
      gemm128g(lds, 128, [&](int r, int k) { return PROJ + (size_t)(mt * 128 + r) * DINP + C_CKV + k; }, [&](int r, int k) { return W + (size_t)(hd * 128 + r) * 128 + k; }, acc);
      const float* g_k = p.in[9] + l * 96;
#pragma unroll
      for (int m = 0; m < 4; ++m) {
        const size_t t = (size_t)mt * 128 + wr * 64 + m * 16 + fr;
        const int b = (int)(t >> 11), sq = (int)(t & (S - 1));
        float ss = 0.f;
        {
          const bf16_t* cr = PROJ + t * DINP + C_CKV + fq * 32;
#pragma unroll
          for (int q = 0; q < 4; ++q) { const u32x4 w = *(const u32x4*)(cr + q * 8);
#pragma unroll
            for (int e = 0; e < 4; ++e) { const float lo = __uint_as_float(w[e] << 16), hi = __uint_as_float(w[e] & 0xffff0000u); ss += lo * lo + hi * hi; } }
        }
        ss += __shfl_xor(ss, 16); ss += __shfl_xor(ss, 32);
        const float rskv = rsqrtf(ss * (1.f / 128) + EPS);
        if (wc == 1) {
#pragma unroll
          for (int n = 0; n < 4; ++n) st_bf16x4(KVR + t * 512 + hd * 128 + 64 + n * 16 + fq * 4, acc[m][n] * rskv);
        } else {
          const uint2 plo = *(const uint2*)(PROJ + t * DINP + C_KPE + 4 * fq), phi = *(const uint2*)(PROJ + t * DINP + C_KPE + 16 + 4 * fq);
          float pl[4] = {__uint_as_float(plo.x << 16), __uint_as_float(plo.x & 0xffff0000u), __uint_as_float(plo.y << 16), __uint_as_float(plo.y & 0xffff0000u)};
          float ph[4] = {__uint_as_float(phi.x << 16), __uint_as_float(phi.x & 0xffff0000u), __uint_as_float(phi.y << 16), __uint_as_float(phi.y & 0xffff0000u)};
          float sk = 0.f;
#pragma unroll
          for (int j = 0; j < 4; ++j) sk += pl[j] * pl[j] + ph[j] * ph[j];
          f32x4 kn[4];
#pragma unroll
          for (int n = 0; n < 4; ++n) { kn[n] = acc[m][n] * rskv; sk += kn[n][0] * kn[n][0] + kn[n][1] * kn[n][1] + kn[n][2] * kn[n][2] + kn[n][3] * kn[n][3]; }
          sk += __shfl_xor(sk, 16); sk += __shfl_xor(sk, 32);
          const float rsk = rsqrtf(sk * (1.f / 96) + EPS);
          bf16_t* dst = MK + ((size_t)(b * 4 + hd) * S + sq) * 96;
          f32x4 olo, ohi;
#pragma unroll
          for (int j = 0; j < 4; ++j) {
            const int d = 4 * fq + j; const float2 cs2 = RM[t * 16 + d];
            const float x1 = pl[j] * rsk * g_k[d], x2 = ph[j] * rsk * g_k[16 + d];
            olo[j] = x1 * cs2.x - x2 * cs2.y; ohi[j] = x1 * cs2.y + x2 * cs2.x;
          }
          st_bf16x4(dst + 4 * fq, olo); st_bf16x4(dst + 16 + 4 * fq, ohi);
#pragma unroll
          for (int n = 0; n < 4; ++n) { const float4 g4 = *(const float4*)(g_k + 32 + n * 16 + fq * 4); f32x4 o = kn[n] * rsk; o[0] *= g4.x; o[1] *= g4.y; o[2] *= g4.z; o[3] *= g4.w; st_bf16x4(dst + 32 + n * 16 + fq * 4, o); }
        }
      }
    } else {
      const int i2 = it - N_CMP - N_QR - N_KVR, mt = i2 >> 2, h = i2 & 3;
      const bf16_t* W = (const bf16_t*)(wl + W_LRU) + h * 128 * 64;
      const int c0 = h * 64 + (tid & 7) * 8;
      const float* cw = p.in[10] + l * 4 * 256 + c0; const float* cbp = p.in[11] + l * 256 + c0;
      gemm128(lds, 64,
              [&](int r, int k) {
                const size_t t = (size_t)mt * 128 + r; const int sq = (int)(t & (S - 1));
                float u[8];
#pragma unroll
                for (int e = 0; e < 8; ++e) u[e] = cbp[e];
#pragma unroll
                for (int j = 0; j < 4; ++j) {
                  if (sq - 3 + j >= 0) {
                    const u32x4 w = *(const u32x4*)(PROJ + (t - 3 + j) * DINP + C_LX + h * 64 + k);
#pragma unroll
                    for (int e = 0; e < 4; ++e) { u[2 * e] += __uint_as_float(w[e] << 16) * cw[j * 256 + 2 * e]; u[2 * e + 1] += __uint_as_float(w[e] & 0xffff0000u) * cw[j * 256 + 2 * e + 1]; }
                  }
                }
                u32x4 o; o[0] = pk2bf(u[0], u[1]); o[1] = pk2bf(u[2], u[3]); o[2] = pk2bf(u[4], u[5]); o[3] = pk2bf(u[6], u[7]);
                return o; },
              [&](int r, int k) { return W + (size_t)r * 64 + k; }, acc);
      GEMM_EPI4({ st_bf16x4(GATES + (size_t)(mt * 128 + er) * 512 + h * 128 + ec0, ev4); })
    }
  }
}

DEVI void lru_ab(float u, float rpre, float ipre, float sp, bool first, float& a, float& b) {
  const float r = sigmoidf_(rpre), gi = sigmoidf_(ipre);
  const float la = -8.f * r * sp;
  a = __expf(la);
  const float x = 2.f * la;
  const float om = (x > -0.1f) ? (-x * (1.f + 0.5f * x * (1.f + (1.f / 3.f) * x * (1.f + 0.25f * x * (1.f + 0.2f * x))))) : (1.f - a * a);
  const float mult = first ? 1.f : sqrtf(fmaxf(om, 0.f));
  b = mult * gi * u;
}
DEVI float lru_conv(const bf16_t* PROJ, int t, int s, int c, const float* cw, float cb) {
  float u = cb;
#pragma unroll
  for (int j = 0; j < 4; ++j) { const int ss2 = s - 3 + j; if (ss2 >= 0) u += bf2f(PROJ[(size_t)(t - 3 + j) * DINP + C_LX + c]) * cw[j * 256 + c]; }
  return u;
}

template <bool FULL>
DEVI void s5_chunk(const Params& p, int l, int b, int chunk, unsigned char* lds) {
  unsigned char* wl = p.ws + WS_W + l * WS_WL;
  const bf16_t* PROJ = (const bf16_t*)(p.ws + WS_B);
  const float2* Abar = (const float2*)(wl + W_S5A);
  const bf16_t* BB = (const bf16_t*)(wl + W_S5BB);
  const bf16_t* CM = (const bf16_t*)(wl + W_S5CM);
  float2* SLOC = (float2*)(p.ws + SM_SLOC);
  bf16_t* YCP = (bf16_t*)(p.ws + WS_F);
  const float* dd = p.in[24] + l * 256;
  const int tid = threadIdx.x, wv = tid >> 6, lane = tid & 63, r = lane & 31, h = lane >> 5, fr = lane & 15, fq = lane >> 4;
  unsigned* Hs = (unsigned*)(lds + wv * 8704);
  const int t0 = b * S + chunk * 64;
#pragma unroll 1
  for (int gi = 0; gi < 4; ++gi) {
    const int g = wv * 4 + gi;
    bf16x8 bbf[4];
#pragma unroll
    for (int nb = 0; nb < 4; ++nb) bbf[nb] = *(const bf16x8*)(BB + ((g * 4 + nb) * 32 + r) * 16 + 8 * h);
    float2 Ac[2]; float hr[2], hi[2];
#pragma unroll
    for (int sb = 0; sb < 2; ++sb) {
      Ac[sb] = Abar[g * 64 + sb * 32 + r];
      hr[sb] = 0.f; hi[sb] = 0.f;
      if (FULL) { const float2 cin = ((const float2*)(p.ws + SM_SCAR))[((size_t)(b * 32 + chunk) * 16 + g) * 64 + sb * 32 + r]; hr[sb] = cin.x; hi[sb] = cin.y; }
    }
    bf16x8 cm[4];
    float4 dcol4 = make_float4(0.f, 0.f, 0.f, 0.f);
    if (FULL) {
#pragma unroll
      for (int kk = 0; kk < 4; ++kk) cm[kk] = *(const bf16x8*)(CM + (size_t)(g * 16 + fr) * 128 + kk * 32 + 8 * fq);
      dcol4 = *(const float4*)(dd + g * 16 + 4 * fq);
    }
#pragma unroll 1
    for (int tb = 0; tb < 2; ++tb) {
      const bf16x8 ua = *(const bf16x8*)(PROJ + (size_t)(t0 + tb * 32 + r) * DINP + C_S5 + g * 16 + 8 * h);
      f32x16 acc[4];
#pragma unroll
      for (int nb = 0; nb < 4; ++nb) {
        f32x16 z;
#pragma unroll
        for (int i = 0; i < 16; ++i) z[i] = 0.f;
        acc[nb] = mfma32(ua, bbf[nb], z);
      }
#pragma unroll
      for (int sb = 0; sb < 2; ++sb) {
        float sr = hr[sb], si = hi[sb];
        const float ax = Ac[sb].x, ay = Ac[sb].y;
#pragma unroll
        for (int q = 0; q < 4; ++q)
#pragma unroll
          for (int owner = 0; owner < 2; ++owner) {
#pragma unroll
            for (int i = 0; i < 4; ++i) {
              const int reg = 4 * q + i;
              const float br = acc[2 * sb][reg], bi = acc[2 * sb + 1][reg];
              const float nr = ax * sr - ay * si + br, ni = ax * si + ay * sr + bi; sr = nr; si = ni;
              if (FULL) { acc[2 * sb][reg] = (h == owner) ? sr : br; acc[2 * sb + 1][reg] = (h == owner) ? si : bi; }
            }
            const float orr = __shfl_xor(sr, 32), oi = __shfl_xor(si, 32);
            if (h != owner) { sr = orr; si = oi; }
          }
        hr[sb] = sr; hi[sb] = si;
      }
      if (FULL) {
#pragma unroll
        for (int sb = 0; sb < 2; ++sb)
#pragma unroll
          for (int reg = 0; reg < 16; ++reg)
            Hs[crow(reg, h) * 68 + sb * 32 + r] = pk2bf(acc[2 * sb][reg], acc[2 * sb + 1][reg]);
#pragma unroll
        for (int tb16 = 0; tb16 < 2; ++tb16) {
          f32x4 y = (f32x4){0.f, 0.f, 0.f, 0.f};
#pragma unroll
          for (int kk = 0; kk < 4; ++kk) { const bf16x8 a = *(const bf16x8*)((const bf16_t*)Hs + (tb16 * 16 + fr) * 136 + kk * 32 + 8 * fq); y = mfma16(cm[kk], a, y); }
          const size_t t = (size_t)t0 + tb * 32 + tb16 * 16 + fr; const int col = g * 16 + 4 * fq;
          const uint2 uw = *(const uint2*)(PROJ + t * DINP + C_S5 + col);
          f32x4 o;
          o[0] = gelu_tanh(y[0] + dcol4.x * __uint_as_float(uw.x << 16)); o[1] = gelu_tanh(y[1] + dcol4.y * __uint_as_float(uw.x & 0xffff0000u));
          o[2] = gelu_tanh(y[2] + dcol4.z * __uint_as_float(uw.y << 16)); o[3] = gelu_tanh(y[3] + dcol4.w * __uint_as_float(uw.y & 0xffff0000u));
          st_bf16x4(YCP + t * 256 + col, o);
        }
      }
    }
    if (!FULL) {
#pragma unroll
      for (int sb = 0; sb < 2; ++sb) if (h == 0) SLOC[((size_t)(b * 32 + chunk) * 16 + g) * 64 + sb * 32 + r] = make_float2(hr[sb], hi[sb]);
    }
  }
}

template <bool FULL>
DEVI void lru_chunk(const Params& p, int l, int b, int chunk, float* tile) {
  const bf16_t* PROJ = (const bf16_t*)(p.ws + WS_B);
  const bf16_t* GATES = (const bf16_t*)(p.ws + WS_E);
  float2* LSUM = (float2*)(p.ws + SM_LSUM);
  const int c = threadIdx.x, h = c >> 6, j = c & 63;
  const float* cw = p.in[10] + l * 4 * 256;
  const float w0 = cw[c], w1 = cw[256 + c], w2 = cw[512 + c], w3 = cw[768 + c], cb = p.in[11][l * 256 + c];
  const float ba = p.in[13][l * 256 + c], bi = p.in[15][l * 256 + c];
  const float sp = log1pf(expf(-p.in[16][l * 256 + c]));
  const int s0 = chunk * 64; const size_t t0 = (size_t)b * S + s0;
  float xm3 = 0.f, xm2 = 0.f, xm1 = 0.f;
  if (s0 > 0) { xm3 = bf2f(PROJ[(t0 - 3) * DINP + C_LX + c]); xm2 = bf2f(PROJ[(t0 - 2) * DINP + C_LX + c]); xm1 = bf2f(PROJ[(t0 - 1) * DINP + C_LX + c]); }
  float hh = 0.f, ap = 1.f;
  if (FULL) hh = ((const float*)(p.ws + SM_LCAR))[(size_t)(b * 32 + chunk) * 256 + c];
#pragma unroll 1
  for (int k0 = 0; k0 < 64; k0 += 8) {
    float xv[8], rp[8], ip[8], gt[8];
#pragma unroll
    for (int i = 0; i < 8; ++i) {
      const size_t t = t0 + k0 + i;
      xv[i] = bf2f(PROJ[t * DINP + C_LX + c]);
      rp[i] = bf2f(GATES[t * 512 + h * 128 + j]); ip[i] = bf2f(GATES[t * 512 + h * 128 + 64 + j]);
      gt[i] = FULL ? bf2f(PROJ[t * DINP + C_LG + c]) : 0.f;
    }
#pragma unroll
    for (int i = 0; i < 8; ++i) {
      const float u = cb + xm3 * w0 + xm2 * w1 + xm1 * w2 + xv[i] * w3;
      xm3 = xm2; xm2 = xm1; xm1 = xv[i];
      float a, bb; lru_ab(u, rp[i] + ba, ip[i] + bi, sp, (s0 + k0 + i) == 0, a, bb);
      hh = a * hh + bb; ap *= a;
      if (FULL) tile[(k0 + i) * 256 + c] = hh * gelu_tanh(gt[i]);
    }
  }
  if (!FULL) LSUM[(size_t)(b * 32 + chunk) * 256 + c] = make_float2(ap, hh);
}

DEVI void phase_r2(const Params& p, int l, unsigned char* lds) {
  unsigned char* wl = p.ws + WS_W + l * WS_WL;
  const bf16_t* PROJ = (const bf16_t*)(p.ws + WS_B);
  const bf16_t* QR = (const bf16_t*)(p.ws + WS_D);
  const bf16_t* KVR = QR + (size_t)T * 384;
  const bf16_t* GATES = (const bf16_t*)(p.ws + WS_E);
  bf16_t* MQ = (bf16_t*)(p.ws + WS_F);
  bf16_t* MK = MQ + (size_t)T * 4 * 96;
  const float2* RM = (const float2*)(p.ws + WS_ROPE);
  const float2* RN = RM + (size_t)T * 16;
  const int tid = threadIdx.x, lane = tid & 63, wv = tid >> 6;
  for (int it = blockIdx.x; it < NB * 32; it += gridDim.x) lru_chunk<false>(p, l, it >> 5, it & 31, nullptr);
  __syncthreads();
  for (int it = blockIdx.x; it < NB * 32; it += gridDim.x) s5_chunk<false>(p, l, it >> 5, it & 31, lds);
  {
    const bf16_t* HK = (const bf16_t*)(p.ws + SM_HK); const bf16_t* HV = (const bf16_t*)(p.ws + SM_HV);
    bf16_t* KC = (bf16_t*)(p.ws + SM_KC); bf16_t* VC = (bf16_t*)(p.ws + SM_VC);
    const bf16_t* W2K = (const bf16_t*)(wl + W_2K); const bf16_t* W2V = (const bf16_t*)(wl + W_2V);
    const float* g0 = p.in[28] + l * 192;
    for (int it = blockIdx.x; it < 32; it += gridDim.x) {
      const int kv = it & 1, mt = it >> 1;
      const bf16_t* H = kv ? HV : HK; const bf16_t* W2 = kv ? W2V : W2K;
      f32x4 acc[4][4];
      __syncthreads();
      gemm128g(lds, 128, [&](int r, int k) { return H + (size_t)(mt * 128 + r) * 128 + k; }, [&](int r, int k) { return W2 + (size_t)(r & 63) * 128 + k; }, acc);
      const int wid = tid >> 6, wr = wid >> 1, wc = wid & 1, fr = lane & 15, fq = lane >> 4;
      if (wc == 0) {
#pragma unroll
        for (int m = 0; m < 4; ++m) {
          const int row = mt * 128 + wr * 64 + m * 16 + fr, b = row >> 7, c = row & 127;
          f32x4 v[4];
#pragma unroll
          for (int n = 0; n < 4; ++n) v[n] = acc[m][n];
          if (kv == 0) {
            float ss = 0.f;
#pragma unroll
            for (int n = 0; n < 4; ++n) ss += v[n][0] * v[n][0] + v[n][1] * v[n][1] + v[n][2] * v[n][2] + v[n][3] * v[n][3];
            ss += __shfl_xor(ss, 16); ss += __shfl_xor(ss, 32);
            const float rs = rsqrtf(ss * (1.f / 64) + EPS);
#pragma unroll
            for (int n = 0; n < 4; ++n) { const float4 gg = *(const float4*)(g0 + n * 16 + fq * 4); v[n][0] *= rs * gg.x; v[n][1] *= rs * gg.y; v[n][2] *= rs * gg.z; v[n][3] *= rs * gg.w; }
            const int cc = (c < 127) ? c : 126;
            const float2* cs = RN + (size_t)(b * S + 16 * cc + 31) * 8;
#pragma unroll
            for (int j = 0; j < 4; ++j) {
              const float x = v[0][j], partner = __shfl_xor(x, 32);
              const int d = fq * 4 + j; const float2 cs2 = cs[d & 7];
              v[0][j] = (d < 8) ? (x * cs2.x - partner * cs2.y) : (partner * cs2.y + x * cs2.x);
            }
          }
          bf16_t* dst = (kv ? VC : KC) + (size_t)row * 64;
#pragma unroll
          for (int n = 0; n < 4; ++n) { f32x4 o = v[n]; if (c >= 127) o = (f32x4){0.f, 0.f, 0.f, 0.f}; st_bf16x4(dst + n * 16 + fq * 4, o); }
        }
      }
    }
  }
}

typedef short v4i16_t __attribute__((ext_vector_type(4)));
DEVI float fexp2(float x) { return __builtin_amdgcn_exp2f(x); }
constexpr int VST = 96;
constexpr int ATT_VBYTES = 64 * VST * 2;
template <int DK> constexpr int att_kbytes() { return 64 * (DK + 8) * 2; }
template <int DK> constexpr int att_buf() { return att_kbytes<DK>() + ATT_VBYTES; }
template <int DK> struct TileRegs { u32x4 k[DK / 32]; u32x4 v[2]; };
template <int DK>
DEVI void tile_load(TileRegs<DK>& tr, const bf16_t* kbase, size_t kstride, const bf16_t* vbase, size_t vstride, int key0, bool withv = true) {
  constexpr int CH = DK / 8;
#pragma unroll
  for (int i = 0; i < DK / 32; ++i) { const int c = threadIdx.x + 256 * i, r = c / CH, cc = c % CH; tr.k[i] = *(const u32x4*)(kbase + (size_t)(key0 + r) * kstride + cc * 8); }
  if (withv) {
#pragma unroll
    for (int i = 0; i < 2; ++i) { const int c = threadIdx.x + 256 * i, r = c >> 3, cc = c & 7; tr.v[i] = *(const u32x4*)(vbase + (size_t)(key0 + r) * vstride + cc * 8); }
  }
}
template <int DK>
DEVI void tile_store(const TileRegs<DK>& tr, unsigned char* buf, bool withv = true) {
  constexpr int CH = DK / 8;
  bf16_t* sK = (bf16_t*)buf; bf16_t* sV = (bf16_t*)(buf + att_kbytes<DK>());
#pragma unroll
  for (int i = 0; i < DK / 32; ++i) { const int c = threadIdx.x + 256 * i, r = c / CH, cc = c % CH; *(u32x4*)(sK + r * (DK + 8) + cc * 8) = tr.k[i]; }
  if (withv) {
#pragma unroll
    for (int i = 0; i < 2; ++i) { const int c = threadIdx.x + 256 * i, r = c >> 3, cc = c & 7; *(u32x4*)(sV + r * VST + cc * 8) = tr.v[i]; }
  }
}
template <int DK>
DEVI void qk_tile(const bf16_t* sK, const bf16x8* qf, f32x16& s0, f32x16& s1, int r, int h) {
#pragma unroll
  for (int i = 0; i < 16; ++i) { s0[i] = 0.f; s1[i] = 0.f; }
#pragma unroll
  for (int kk = 0; kk < DK / 16; ++kk) {
    const bf16x8 a0 = *(const bf16x8*)(sK + r * (DK + 8) + kk * 16 + h * 8);
    const bf16x8 a1 = *(const bf16x8*)(sK + (32 + r) * (DK + 8) + kk * 16 + h * 8);
    s0 = mfma32(a0, qf[kk], s0);
    s1 = mfma32(a1, qf[kk], s1);
  }
}
struct FState { f32x16 o0, o1; float m, l; };
DEVI void fstate_init(FState& f) {
#pragma unroll
  for (int i = 0; i < 16; ++i) { f.o0[i] = 0.f; f.o1[i] = 0.f; }
  f.m = -INFINITY; f.l = 0.f;
}
DEVI v4i16_t vtr(const bf16_t* p) { return __builtin_amdgcn_ds_read_tr16_b64_v4i16((LAS v4i16_t*)p); }
DEVI void softmax_pv(FState& f, f32x16& s0, f32x16& s1, const bf16_t* sV, int lane) {
  const int h = lane >> 5;
  float mx = -INFINITY;
#pragma unroll
  for (int i = 0; i < 16; ++i) mx = fmaxf(mx, fmaxf(s0[i], s1[i]));
  mx = fmaxf(mx, __shfl_xor(mx, 32));
  const float mnew = fmaxf(f.m, mx);
  const float muse = (mnew == -INFINITY) ? 0.f : mnew;
  float ps = 0.f;
#pragma unroll
  for (int i = 0; i < 16; ++i) { s0[i] = fexp2(s0[i] - muse); s1[i] = fexp2(s1[i] - muse); ps += s0[i] + s1[i]; }
  ps += __shfl_xor(ps, 32);
  if (__any(mnew != f.m)) {
    const float alpha = fexp2(f.m - muse);
    f.l = f.l * alpha + ps; f.m = mnew;
#pragma unroll
    for (int i = 0; i < 16; ++i) { f.o0[i] *= alpha; f.o1[i] *= alpha; }
  } else {
    f.l += ps;
  }
  const int g = lane >> 4, li = lane & 15, q = li >> 2, pp = li & 3;
  const bf16_t* vb = sV + (4 * h + q) * VST + (g & 1) * 16 + 4 * pp;
#pragma unroll
  for (int kb = 0; kb < 2; ++kb)
#pragma unroll
    for (int s = 0; s < 2; ++s) {
      unsigned pw[4];
#pragma unroll
      for (int j = 0; j < 4; ++j) pw[j] = kb ? pk2bf(s1[8 * s + 2 * j], s1[8 * s + 2 * j + 1]) : pk2bf(s0[8 * s + 2 * j], s0[8 * s + 2 * j + 1]);
      const bf16x8 pb = __builtin_bit_cast(bf16x8, (u32x4){pw[0], pw[1], pw[2], pw[3]});
#pragma unroll
      for (int db = 0; db < 2; ++db) {
        const v4i16_t lo = vtr(vb + (kb * 32 + 16 * s) * VST + db * 32);
        const v4i16_t hi = vtr(vb + (kb * 32 + 16 * s + 8) * VST + db * 32);
        const bf16x8 a = {lo[0], lo[1], lo[2], lo[3], hi[0], hi[1], hi[2], hi[3]};
        if (db == 0) f.o0 = mfma32(a, pb, f.o0); else f.o1 = mfma32(a, pb, f.o1);
      }
    }
}
DEVI void store_o(bf16_t* orow, const f32x16& o0, const f32x16& o1, float sc, int h) {
#pragma unroll
  for (int g = 0; g < 4; ++g) {
    uint2 v0, v1;
    v0.x = pk2bf(o0[4 * g] * sc, o0[4 * g + 1] * sc); v0.y = pk2bf(o0[4 * g + 2] * sc, o0[4 * g + 3] * sc);
    v1.x = pk2bf(o1[4 * g] * sc, o1[4 * g + 1] * sc); v1.y = pk2bf(o1[4 * g + 2] * sc, o1[4 * g + 3] * sc);
    *(uint2*)(orow + 8 * g + 4 * h) = v0;
    *(uint2*)(orow + 32 + 8 * g + 4 * h) = v1;
  }
}

DEVI void mla_item(const Params& p, int l, int b, int hd, int qt, unsigned char* lds) {
  const bf16_t* MQ = (const bf16_t*)(p.ws + WS_F);
  const bf16_t* MK = MQ + (size_t)T * 4 * 96;
  const bf16_t* KVR = (const bf16_t*)(p.ws + WS_D) + (size_t)T * 384;
  bf16_t* YA = (bf16_t*)(p.ws + WS_C);
  const int tid = threadIdx.x, wv = tid >> 6, lane = tid & 63, r = lane & 31, h = lane >> 5;
  const int q0 = qt * 128 + wv * 32, tq = q0 + r;
  bf16x8 qf[6];
  {
    const bf16_t* qrow = (const bf16_t*)(p.ws + WS_D) + ((size_t)b * S + tq) * 384 + hd * 96;
    const float* g_q = p.in[8] + l * 96;
    float qv[6][8]; float ss = 0.f;
#pragma unroll
    for (int kk = 0; kk < 6; ++kk) {
      const u32x4 w = *(const u32x4*)(qrow + kk * 16 + h * 8);
#pragma unroll
      for (int e = 0; e < 4; ++e) { qv[kk][2 * e] = __uint_as_float(w[e] << 16); qv[kk][2 * e + 1] = __uint_as_float(w[e] & 0xffff0000u); ss += qv[kk][2 * e] * qv[kk][2 * e] + qv[kk][2 * e + 1] * qv[kk][2 * e + 1]; }
    }
    ss += __shfl_xor(ss, 32);
    const float rs = rsqrtf(ss * (1.f / 96) + EPS) * (0.10206207261596575f * LOG2E);
#pragma unroll
    for (int kk = 0; kk < 6; ++kk)
#pragma unroll
      for (int j = 0; j < 8; ++j) qv[kk][j] *= rs * g_q[kk * 16 + h * 8 + j];
    const float2* cs = (const float2*)(p.ws + WS_ROPE) + ((size_t)b * S + tq) * 16 + 8 * h;
#pragma unroll
    for (int j = 0; j < 8; ++j) { const float2 c2 = cs[j]; const float x1 = qv[0][j], x2 = qv[1][j]; qv[0][j] = x1 * c2.x - x2 * c2.y; qv[1][j] = x1 * c2.y + x2 * c2.x; }
#pragma unroll
    for (int kk = 0; kk < 6; ++kk) { const u32x4 w = {pk2bf(qv[kk][0], qv[kk][1]), pk2bf(qv[kk][2], qv[kk][3]), pk2bf(qv[kk][4], qv[kk][5]), pk2bf(qv[kk][6], qv[kk][7])}; qf[kk] = __builtin_bit_cast(bf16x8, w); }
  }
  FState f; fstate_init(f);
  const bf16_t* kbase = MK + (size_t)(b * 4 + hd) * S * 96;
  const bf16_t* vbase = KVR + (size_t)b * S * 512 + hd * 128 + 64;
  const int ntiles = 2 * qt + 2;
  TileRegs<96> tr;
  TileRegs<96> tr2;
  tile_load<96>(tr, kbase, 96, vbase, 512, 0);
  tile_load<96>(tr2, kbase, 96, vbase, 512, 64);
  __syncthreads();
  tile_store<96>(tr, lds);
  __syncthreads();
  auto compute = [&](int kt, unsigned char* cur) {
    if (kt * 64 <= q0 + 31) {
      f32x16 s0, s1;
      qk_tile<96>((const bf16_t*)cur, qf, s0, s1, r, h);
      if (kt * 64 + 63 > q0) {
        int rel = tq - kt * 64 - 4 * h; asm volatile("" : "+v"(rel));
#pragma unroll
        for (int i = 0; i < 16; ++i) { const int kk2 = (i & 3) + 8 * (i >> 2); if (kk2 > rel) s0[i] = -INFINITY; if (kk2 + 32 > rel) s1[i] = -INFINITY; }
      }
      softmax_pv(f, s0, s1, (const bf16_t*)(cur + att_kbytes<96>()), lane);
    }
  };
#pragma unroll 1
  for (int kt = 0; kt < ntiles; kt += 2) {
    if (kt + 2 < ntiles) tile_load<96>(tr, kbase, 96, vbase, 512, (kt + 2) * 64);
    compute(kt, lds);
    tile_store<96>(tr2, lds + att_buf<96>());
    __syncthreads();
    if (kt + 3 < ntiles) tile_load<96>(tr2, kbase, 96, vbase, 512, (kt + 3) * 64);
    compute(kt + 1, lds + att_buf<96>());
    if (kt + 2 < ntiles) tile_store<96>(tr, lds);
    __syncthreads();
  }
  store_o(YA + (size_t)(b * S + tq) * 256 + hd * 64, f.o0, f.o1, 1.f / f.l, h);
}

template <class KF, class BODY>
DEVI void nsa_stream(unsigned char* lds, const bf16_t* kbase, size_t kstride, const bf16_t* vbase, size_t vstride, bool withv, int nt, KF key0f, BODY body) {
  if (nt <= 0) return;
  TileRegs<64> tr;
  tile_load<64>(tr, kbase, kstride, vbase, vstride, key0f(0), withv);
  __syncthreads();
  tile_store<64>(tr, lds, withv);
  __syncthreads();
#pragma unroll 1
  for (int i = 0; i < nt; ++i) {
    unsigned char* cur = lds + (i & 1) * att_buf<64>();
    const bool more = i + 1 < nt;
    if (more) tile_load<64>(tr, kbase, kstride, vbase, vstride, key0f(i + 1), withv);
    body(i, cur);
    if (more) tile_store<64>(tr, lds + ((i + 1) & 1) * att_buf<64>(), withv);
    __syncthreads();
  }
}
DEVI void nsa_item(const Params& p, int l, int b, int qt, unsigned char* lds) {
  const bf16_t* PROJ = (const bf16_t*)(p.ws + WS_B);
  const bf16_t* KC = (const bf16_t*)(p.ws + SM_KC) + (size_t)b * 128 * 64;
  const bf16_t* VC = (const bf16_t*)(p.ws + SM_VC) + (size_t)b * 128 * 64;
  const int tid = threadIdx.x, wv = tid >> 6, lane = tid & 63, r = lane & 31, h = lane >> 5;
  float* psum = (float*)(lds + 2 * att_buf<64>());
  unsigned* selm = (unsigned*)(lds + 2 * att_buf<64>() + 16384);
  const int t0 = qt * 32, cur = t0 >> 6;
  const int ql = wv * 8 + (r >> 2), hd = r & 3, tq = t0 + ql;
  const size_t tg = (size_t)b * S + tq;
  bf16x8 qf[4];
#pragma unroll
  for (int kk = 0; kk < 4; ++kk) qf[kk] = *(const bf16x8*)(PROJ + tg * DINP + C_NQ + hd * 64 + kk * 16 + h * 8);
  unsigned* ofs = (unsigned*)psum + wv * 1024 + lane;
  const float g0 = sigmoidf_(bf2f(PROJ[tg * DINP + C_NG + hd * 3 + 0]));
  const float g1 = sigmoidf_(bf2f(PROJ[tg * DINP + C_NG + hd * 3 + 1]));
  const float g2 = sigmoidf_(bf2f(PROJ[tg * DINP + C_NG + hd * 3 + 2]));
  FState f; fstate_init(f);
  const int ncmp = (t0 + 31 < 31) ? 0 : (((t0 >> 4) >> 6) + 1);
  nsa_stream(lds, KC, 64, VC, 64, true, ncmp, [&](int i) { return i * 64; }, [&](int kt, unsigned char* buf) {
    f32x16 s0, s1;
    qk_tile<64>((const bf16_t*)buf, qf, s0, s1, r, h);
    int rel = ((tq - 31) >> 4) - kt * 64 - 4 * h; asm volatile("" : "+v"(rel));
#pragma unroll
    for (int i = 0; i < 16; ++i) { const int kk2 = (i & 3) + 8 * (i >> 2); if (kk2 > rel) s0[i] = -INFINITY; if (kk2 + 32 > rel) s1[i] = -INFINITY; }
    softmax_pv(f, s0, s1, (const bf16_t*)(buf + att_kbytes<64>()), lane);
  });
  {
    const float muse = (f.m == -INFINITY) ? 0.f : f.m;
    const float il = (f.l > 0.f) ? 1.f / f.l : 0.f;
    if (ncmp < 2) {
#pragma unroll 1
      for (int i = tid; i < 32 * 128; i += NTHREADS) psum[i] = 0.f;
      __syncthreads();
    }
    nsa_stream(lds, KC, 64, VC, 64, false, ncmp, [&](int i) { return i * 64; }, [&](int kt, unsigned char* buf) {
      f32x16 s0, s1;
      qk_tile<64>((const bf16_t*)buf, qf, s0, s1, r, h);
      int rel = ((tq - 31) >> 4) - kt * 64 - 4 * h; asm volatile("" : "+v"(rel));
      int cb0 = kt * 64 + 4 * h; asm volatile("" : "+v"(cb0));
#pragma unroll
      for (int i = 0; i < 16; ++i) {
        const int kk2 = (i & 3) + 8 * (i >> 2); const int c = cb0 + kk2;
        float p0 = (kk2 > rel) ? 0.f : fexp2(s0[i] - muse) * il;
        float p1 = (kk2 + 32 > rel) ? 0.f : fexp2(s1[i] - muse) * il;
        p0 += __shfl_xor(p0, 1); p0 += __shfl_xor(p0, 2);
        p1 += __shfl_xor(p1, 1); p1 += __shfl_xor(p1, 2);
        if (hd == 0) { psum[ql * 128 + c] = p0; psum[ql * 128 + c + 32] = p1; }
      }
    });
  }
  __syncthreads();
#pragma unroll 1
  for (int itq = 0; itq < 4; ++itq) {
    const int q2 = wv * 8 + itq * 2 + (lane >> 5), j = lane & 31;
    const float* ps = psum + q2 * 128;
    float imp = 2.f * (ps[4 * j] + ps[4 * j + 1] + ps[4 * j + 2]) + ps[4 * j + 3];
    if (j > 0) imp += ps[4 * j - 1];
    const bool cand = (j >= 1) && (j <= cur - 2);
    int rank = 0;
    for (int jj = 0; jj < 32; ++jj) {
      const float v = __shfl(imp, (lane & 32) | jj);
      const bool cj = (jj >= 1) && (jj <= cur - 2);
      if (cj && (v > imp || (v == imp && jj < j))) ++rank;
    }
    const bool sel = cand && rank < 2;
    const unsigned long long bal = __ballot(sel);
    unsigned mk = (unsigned)(bal >> (32 * (lane >> 5)));
    mk |= 1u | (1u << cur); if (cur >= 1) mk |= (1u << (cur - 1));
    if (j == 0) selm[q2] = mk;
  }
  __syncthreads();
  unsigned blk_or = 0, wave_or = 0;
  for (int i = 0; i < 32; ++i) blk_or |= selm[i];
  for (int i = 0; i < 8; ++i) wave_or |= selm[wv * 8 + i];
  const unsigned mymask = selm[ql];
  {
    const float sc = (f.l > 0.f) ? g0 / f.l : 0.f;
#pragma unroll
    for (int i = 0; i < 8; ++i) { ofs[i * 64] = pk2bf(f.o0[2 * i] * sc, f.o0[2 * i + 1] * sc); ofs[(8 + i) * 64] = pk2bf(f.o1[2 * i] * sc, f.o1[2 * i + 1] * sc); }
  }
  fstate_init(f);
  {
    unsigned* tl = selm + 32;
    if (tid < 32 && ((blk_or >> tid) & 1u)) tl[__popc(blk_or & ((1u << tid) - 1u))] = tid;
    __syncthreads();
    const int nsel = __popc(blk_or);
    nsa_stream(lds, PROJ + (size_t)b * S * DINP + C_KS, DINP, PROJ + (size_t)b * S * DINP + C_VS, DINP, true, nsel,
      [&](int i) { return (int)tl[i] * 64; },
      [&](int i, unsigned char* buf) {
        const int jj = (int)tl[i];
        if ((wave_or >> jj) & 1u) {
          f32x16 s0, s1;
          qk_tile<64>((const bf16_t*)buf, qf, s0, s1, r, h);
          const bool on = (mymask >> jj) & 1u;
          int rel = on ? (tq - jj * 64 - 4 * h) : -1; asm volatile("" : "+v"(rel));
#pragma unroll
          for (int i2 = 0; i2 < 16; ++i2) { const int kk2 = (i2 & 3) + 8 * (i2 >> 2); if (kk2 > rel) s0[i2] = -INFINITY; if (kk2 + 32 > rel) s1[i2] = -INFINITY; }
          softmax_pv(f, s0, s1, (const bf16_t*)(buf + att_kbytes<64>()), lane);
        }
      });
    const float sc = (f.l > 0.f) ? g1 / f.l : 0.f;
#pragma unroll
    for (int i = 0; i < 8; ++i) {
      const unsigned w0 = ofs[i * 64], w1 = ofs[(8 + i) * 64];
      ofs[i * 64] = pk2bf(__uint_as_float(w0 << 16) + f.o0[2 * i] * sc, __uint_as_float(w0 & 0xffff0000u) + f.o0[2 * i + 1] * sc);
      ofs[(8 + i) * 64] = pk2bf(__uint_as_float(w1 << 16) + f.o1[2 * i] * sc, __uint_as_float(w1 & 0xffff0000u) + f.o1[2 * i + 1] * sc);
    }
  }
  fstate_init(f);
  {
    int jlo = (t0 - 511) >> 6; if (jlo < 0) jlo = 0;
    nsa_stream(lds, PROJ + (size_t)b * S * DINP + C_KW, DINP, PROJ + (size_t)b * S * DINP + C_VW, DINP, true, cur - jlo + 1,
      [&](int i) { return (jlo + i) * 64; },
      [&](int i, unsigned char* buf) {
        const int j = jlo + i;
        f32x16 s0, s1;
        qk_tile<64>((const bf16_t*)buf, qf, s0, s1, r, h);
        if (j == cur || j * 64 < t0 + 31 - 511 + 64) {
          int rel = tq - j * 64 - 4 * h; asm volatile("" : "+v"(rel));
#pragma unroll
          for (int i2 = 0; i2 < 16; ++i2) {
            const int kk2 = (i2 & 3) + 8 * (i2 >> 2);
            if (kk2 > rel || kk2 < rel - 511) s0[i2] = -INFINITY;
            if (kk2 + 32 > rel || kk2 + 32 < rel - 511) s1[i2] = -INFINITY;
          }
        }
        softmax_pv(f, s0, s1, (const bf16_t*)(buf + att_kbytes<64>()), lane);
      });
    const float sc = (f.l > 0.f) ? g2 / f.l : 0.f;
#pragma unroll
    for (int i = 0; i < 8; ++i) {
      const unsigned w0 = ofs[i * 64], w1 = ofs[(8 + i) * 64];
      f.o0[2 * i] = __uint_as_float(w0 << 16) + f.o0[2 * i] * sc; f.o0[2 * i + 1] = __uint_as_float(w0 & 0xffff0000u) + f.o0[2 * i + 1] * sc;
      f.o1[2 * i] = __uint_as_float(w1 << 16) + f.o1[2 * i] * sc; f.o1[2 * i + 1] = __uint_as_float(w1 & 0xffff0000u) + f.o1[2 * i + 1] * sc;
    }
  }
  f32x16& of0 = f.o0; f32x16& of1 = f.o1;
  {
    float ss = 0.f;
#pragma unroll
    for (int i = 0; i < 16; ++i) ss += of0[i] * of0[i] + of1[i] * of1[i];
    ss += __shfl_xor(ss, 1); ss += __shfl_xor(ss, 2); ss += __shfl_xor(ss, 32);
    const float rs = rsqrtf(ss * (1.f / 256) + EPS);
    const float* on = p.in[35] + l * 1024 + 768 + hd * 64;
#pragma unroll
    for (int g4 = 0; g4 < 4; ++g4) {
      const float4 a = *(const float4*)(on + 8 * g4 + 4 * h), b4 = *(const float4*)(on + 32 + 8 * g4 + 4 * h);
      of0[4 * g4] *= a.x; of0[4 * g4 + 1] *= a.y; of0[4 * g4 + 2] *= a.z; of0[4 * g4 + 3] *= a.w;
      of1[4 * g4] *= b4.x; of1[4 * g4 + 1] *= b4.y; of1[4 * g4 + 2] *= b4.z; of1[4 * g4 + 3] *= b4.w;
    }
    store_o((bf16_t*)(p.ws + WS_A) + tg * 1024 + 768 + hd * 64, of0, of1, rs, h);
  }
}

DEVI void carry_item(const Params& p, int l, int it) {
  const int tid = threadIdx.x;
  if (it < 64) {
    const int idx = it * 256 + tid, b = idx >> 10, gs = idx & 1023;
    const float2 a64 = ((const float2*)(p.ws + WS_W + l * WS_WL + W_S5A64))[gs];
    const float2* SLOC = (const float2*)(p.ws + SM_SLOC) + (size_t)b * 32 * 1024 + gs;
    float2* SCAR = (float2*)(p.ws + SM_SCAR) + (size_t)b * 32 * 1024 + gs;
    float hr = 0.f, hi = 0.f;
#pragma unroll 1
    for (int c0 = 0; c0 < 32; c0 += 8) {
      float2 sl[8];
#pragma unroll
      for (int i = 0; i < 8; ++i) sl[i] = SLOC[(size_t)(c0 + i) * 1024];
#pragma unroll
      for (int i = 0; i < 8; ++i) { SCAR[(size_t)(c0 + i) * 1024] = make_float2(hr, hi); const float nr = a64.x * hr - a64.y * hi + sl[i].x, ni = a64.x * hi + a64.y * hr + sl[i].y; hr = nr; hi = ni; }
    }
  } else {
    const int idx = (it - 64) * 256 + tid, b = idx >> 8, c = idx & 255;
    const float2* LSUM = (const float2*)(p.ws + SM_LSUM) + (size_t)b * 32 * 256 + c;
    float* LCAR = (float*)(p.ws + SM_LCAR) + (size_t)b * 32 * 256 + c;
    float hh = 0.f;
#pragma unroll 1
    for (int c0 = 0; c0 < 32; c0 += 8) {
      float2 sv[8];
#pragma unroll
      for (int i = 0; i < 8; ++i) sv[i] = LSUM[(size_t)(c0 + i) * 256];
#pragma unroll
      for (int i = 0; i < 8; ++i) { LCAR[(size_t)(c0 + i) * 256] = hh; hh = sv[i].x * hh + sv[i].y; }
    }
  }
}
DEVI void phase_a1(const Params& p, int l, unsigned char* lds) {
  for (int it = blockIdx.x; it < 80; it += gridDim.x) carry_item(p, l, it);
  const int G_ = (int)gridDim.x;
  const int vb_ = vblock();
  for (int rr = 0;; ++rr) { const int j = rr * G_ + ((rr & 1) ? (G_ - 1 - vb_) : vb_); if (rr * G_ >= 1024) break; if (j < 1024) { const int b = j >> 6, qt = 63 - (j & 63); nsa_item(p, l, b, qt, lds); } }
  __syncthreads();
  for (int rr = 0;; ++rr) { const int j = rr * G_ + ((rr & 1) ? (G_ - 1 - vb_) : vb_); if (rr * G_ >= 1024) break; if (j < 1024) { const int bh = j >> 4, qt = 15 - (j & 15); mla_item(p, l, bh >> 2, bh & 3, qt, lds); } }
}

DEVI void phase_r3(const Params& p, int l, unsigned char* lds) {
  bf16_t* Y = (bf16_t*)(p.ws + WS_A);
  const int tid = threadIdx.x, lane = tid & 63, wv = tid >> 6;
  {
    const float* onorm = p.in[35] + l * 1024 + 256;
    float* tile = (float*)lds;
    for (int it = blockIdx.x; it < NB * 32; it += gridDim.x) {
      const int b = it >> 5, chunk = it & 31;
      __syncthreads();
      lru_chunk<true>(p, l, b, chunk, tile);
      __syncthreads();
      for (int k = wv; k < 64; k += 4) {
        const float4 v = *(const float4*)(tile + k * 256 + lane * 4);
        const float rs = rsqrtf(wsum(v.x * v.x + v.y * v.y + v.z * v.z + v.w * v.w) * (1.f / 256) + EPS);
        const size_t t = (size_t)b * S + chunk * 64 + k;
        const float4 gg = *(const float4*)(onorm + lane * 4);
        st_bf16x4(Y + t * 1024 + 256 + lane * 4, (f32x4){v.x * rs * gg.x, v.y * rs * gg.y, v.z * rs * gg.z, v.w * rs * gg.w});
      }
    }
  }
  __syncthreads();
  for (int it = blockIdx.x; it < NB * 32; it += gridDim.x) s5_chunk<true>(p, l, it >> 5, it & 31, lds);
}

DEVI void phase_g3(const Params& p, int l, unsigned char* lds) {
  const bf16_t* YCP = (const bf16_t*)(p.ws + WS_F);
  bf16_t* YC = (bf16_t*)(p.ws + WS_F) + (size_t)T * 256;
  const bf16_t* W = (const bf16_t*)(p.ws + WS_W + l * WS_WL + W_GLU);
  const float* bg = p.in[26] + l * 256;
  for (int it = vblock(); it < 256 * 2; it += gridDim.x) {
    const int mt = it >> 1, nt = it & 1;
    f32x4 acc[4][4];
    gemm128g(lds, 256, [&](int r, int k) { return YCP + (size_t)(mt * 128 + r) * 256 + k; }, [&](int r, int k) { return W + (size_t)(nt * 128 + r) * 256 + k; }, acc);
    GEMM_EPI4({ const size_t o = (size_t)(mt * 128 + er) * 256 + nt * 128 + ec0; const ushort4 yp = *(const ushort4*)(YCP + o); f32x4 r4; r4[0] = bf2f(yp.x) * sigmoidf_(ev4[0] + bg[nt * 128 + ec0]); r4[1] = bf2f(yp.y) * sigmoidf_(ev4[1] + bg[nt * 128 + ec0 + 1]); r4[2] = bf2f(yp.z) * sigmoidf_(ev4[2] + bg[nt * 128 + ec0 + 2]); r4[3] = bf2f(yp.w) * sigmoidf_(ev4[3] + bg[nt * 128 + ec0 + 3]); st_bf16x4(YC + o, r4); })
  }
}

DEVI void phase_r4(const Params& p, int l) {
  const bf16_t* YA = (const bf16_t*)(p.ws + WS_C);
  const bf16_t* YC = (const bf16_t*)(p.ws + WS_F) + (size_t)T * 256;
  bf16_t* Y = (bf16_t*)(p.ws + WS_A);
  const float* onorm = p.in[35] + l * 1024;
  const int lane = threadIdx.x & 63, gw = blockIdx.x * 4 + (threadIdx.x >> 6), NGW = gridDim.x * 4;
  for (int t = gw; t < T; t += NGW) {
#pragma unroll
    for (int grp = 0; grp < 2; ++grp) {
      const bf16_t* src = (grp == 0 ? YA : YC) + (size_t)t * 256;
      const int gcol = (grp == 0 ? 0 : 512);
      const ushort4 u = ((const ushort4*)src)[lane];
      const float v0 = bf2f(u.x), v1 = bf2f(u.y), v2 = bf2f(u.z), v3 = bf2f(u.w);
      const float rs = rsqrtf(wsum(v0 * v0 + v1 * v1 + v2 * v2 + v3 * v3) * (1.f / 256) + EPS);
      const float4 g = ((const float4*)(onorm + gcol))[lane];
      uint2 o; o.x = pk2bf(v0 * rs * g.x, v1 * rs * g.y); o.y = pk2bf(v2 * rs * g.z, v3 * rs * g.w);
      ((uint2*)(Y + (size_t)t * 1024 + gcol))[lane] = o;
    }
  }
}

DEVI void phase_g4(const Params& p, int l, unsigned char* lds) {
  const bf16_t* Y = (const bf16_t*)(p.ws + WS_A);
  const bf16_t* W = (const bf16_t*)(p.ws + WS_W + l * WS_WL + W_OUT);
  const float* xin = (l == 0) ? p.in[0] : p.out;
  float* out = p.out;
  int par = 0; bool staged = false;
  for (int it = vblock(); it < 256 * 8; it += gridDim.x) {
    const int mt = it >> 3, nt = it & 7;
    f32x4 acc[4][4], xr[4][4];
    {
      const int tid = threadIdx.x, wid = tid >> 6, lane = tid & 63, wr = wid >> 1, wc = wid & 1, fr = lane & 15, fq = lane >> 4;
#pragma unroll
      for (int m = 0; m < 4; ++m)
#pragma unroll
        for (int n = 0; n < 4; ++n) xr[m][n] = *(const f32x4*)(xin + (size_t)(mt * 128 + wr * 64 + m * 16 + fr) * D + nt * 128 + wc * 64 + n * 16 + fq * 4);
    }
    const int itn = it + (int)gridDim.x; const bool hn = itn < 256 * 8; const int mtn = itn >> 3, ntn = itn & 7;
    gemm128p(lds, D, [&](int r, int k) { return Y + (size_t)(mt * 128 + r) * D + k; }, [&](int r, int k) { return W + (size_t)(nt * 128 + r) * D + k; }, acc, par, staged, hn,
             [&](int r, int k) { return Y + (size_t)(mtn * 128 + r) * D + k; }, [&](int r, int k) { return W + (size_t)(ntn * 128 + r) * D + k; });
    staged = hn;
    GEMM_EPI4({ const size_t o = (size_t)(mt * 128 + er) * D + nt * 128 + ec0; *(f32x4*)(out + o) = xr[m][n] + ev4; })
  }
}

DEVI void phase_r5(const Params& p, int l, unsigned char* lds) {
  const float* x1 = p.out;
  bf16_t* XN = (bf16_t*)(p.ws + WS_A);
  const float* g = p.in[37] + l * D;
  const bf16_t* WH = (const bf16_t*)(p.ws + WS_W + l * WS_WL + W_RTH);
  const bf16_t* WL = (const bf16_t*)(p.ws + WS_W + l * WS_WL + W_RTL);
  const float* brg = p.in[39] + l * 4; const float* bre = p.in[41] + l * 16;
  int* CNT = (int*)(p.ws + SM_CNT) + l * 32;
  int* LIST = (int*)(p.ws + SM_LIST);
  float2* TOKW = (float2*)(p.ws + SM_TOKW);
  const int tid = threadIdx.x, lane = tid & 63, wv = tid >> 6, c = lane & 15, q = lane >> 4;
  float* red = (float*)lds;
  int* hist = (int*)(lds + 16384);
  int* tokl = (int*)(lds + 16384 + 256);
  if (tid < 64) hist[tid] = 0;
  int ntok = 0;
  __syncthreads();
  for (int it = blockIdx.x; it < T / 16; it += gridDim.x) {
    const size_t tb = (size_t)it * 16;
    f32x4 a0 = (f32x4){0.f, 0.f, 0.f, 0.f}, a1 = (f32x4){0.f, 0.f, 0.f, 0.f};
    float ss = 0.f;
    const float* xrow = x1 + (tb + c) * D + wv * 256 + 8 * q;
    const bf16_t* wh0 = WH + (size_t)c * 1024 + wv * 256 + 8 * q;
    const bf16_t* wl0 = WL + (size_t)c * 1024 + wv * 256 + 8 * q;
    float4 xk[8][2];
#pragma unroll
    for (int ks = 0; ks < 8; ++ks) { xk[ks][0] = *(const float4*)(xrow + ks * 32); xk[ks][1] = *(const float4*)(xrow + ks * 32 + 4); }
#pragma unroll
    for (int ks = 0; ks < 8; ++ks) {
      const bf16x8 wh_a = *(const bf16x8*)(wh0 + ks * 32), wl_a = *(const bf16x8*)(wl0 + ks * 32);
      const bf16x8 wh_b = *(const bf16x8*)(wh0 + 16 * 1024 + ks * 32), wl_b = *(const bf16x8*)(wl0 + 16 * 1024 + ks * 32);
      const float xv[8] = {xk[ks][0].x, xk[ks][0].y, xk[ks][0].z, xk[ks][0].w, xk[ks][1].x, xk[ks][1].y, xk[ks][1].z, xk[ks][1].w};
      u32x4 hw, lw;
#pragma unroll
      for (int j = 0; j < 4; ++j) {
        const float x0 = xv[2 * j], x1v = xv[2 * j + 1];
        ss += x0 * x0 + x1v * x1v;
        const unsigned hp = pk2bf(x0, x1v);
        hw[j] = hp; lw[j] = pk2bf(x0 - __uint_as_float(hp << 16), x1v - __uint_as_float(hp & 0xffff0000u));
      }
      const bf16x8 xh = __builtin_bit_cast(bf16x8, hw), xl = __builtin_bit_cast(bf16x8, lw);
      a0 = mfma16(wh_a, xh, a0); a0 = mfma16(wh_a, xl, a0); a0 = mfma16(wl_a, xh, a0);
      a1 = mfma16(wh_b, xh, a1); a1 = mfma16(wh_b, xl, a1); a1 = mfma16(wl_b, xh, a1);
    }
    ss += __shfl_xor(ss, 16); ss += __shfl_xor(ss, 32);
    __syncthreads();
#pragma unroll
    for (int j = 0; j < 4; ++j) { red[(wv * 9 + j) * 64 + lane] = a0[j]; red[(wv * 9 + 4 + j) * 64 + lane] = a1[j]; }
    red[(wv * 9 + 8) * 64 + lane] = ss;
    __syncthreads();
    const float s2 = red[8 * 64 + lane] + red[(9 + 8) * 64 + lane] + red[(18 + 8) * 64 + lane] + red[(27 + 8) * 64 + lane];
    const float rs = rsqrtf(s2 * (1.f / D) + EPS);
    {
      bf16_t* xo = XN + (tb + c) * D + wv * 256 + 8 * q;
      const float* gp = g + wv * 256 + 8 * q;
#pragma unroll
      for (int ks = 0; ks < 8; ++ks) {
        const float4 g0 = *(const float4*)(gp + ks * 32), g1 = *(const float4*)(gp + ks * 32 + 4);
        u32x4 o;
        o[0] = pk2bf(xk[ks][0].x * rs * g0.x, xk[ks][0].y * rs * g0.y); o[1] = pk2bf(xk[ks][0].z * rs * g0.z, xk[ks][0].w * rs * g0.w);
        o[2] = pk2bf(xk[ks][1].x * rs * g1.x, xk[ks][1].y * rs * g1.y); o[3] = pk2bf(xk[ks][1].z * rs * g1.z, xk[ks][1].w * rs * g1.w);
        *(u32x4*)(xo + ks * 32) = o;
      }
    }
    if (wv == 0) {
      float c0[4], c1[4];
#pragma unroll
      for (int j = 0; j < 4; ++j) {
        c0[j] = red[j * 64 + lane] + red[(9 + j) * 64 + lane] + red[(18 + j) * 64 + lane] + red[(27 + j) * 64 + lane];
        c1[j] = red[(4 + j) * 64 + lane] + red[(13 + j) * 64 + lane] + red[(22 + j) * 64 + lane] + red[(31 + j) * 64 + lane];
      }
      float lg[20];
#pragma unroll
      for (int qq = 0; qq < 4; ++qq)
#pragma unroll
        for (int j = 0; j < 4; ++j) lg[4 * qq + j] = __shfl(c0[j], c + 16 * qq);
#pragma unroll
      for (int j = 0; j < 4; ++j) lg[16 + j] = __shfl(c1[j], c);
      const int t = (int)tb + c;
      float gl[4];
#pragma unroll
      for (int k2 = 0; k2 < 4; ++k2) gl[k2] = lg[k2] * rs + brg[k2];
      int gi = 0; float gbest = gl[0];
#pragma unroll
      for (int k2 = 1; k2 < 4; ++k2) if (gl[k2] > gbest) { gbest = gl[k2]; gi = k2; }
      float den = 0.f;
#pragma unroll
      for (int k2 = 0; k2 < 4; ++k2) den += expf(gl[k2] - gbest);
      const float pg = 1.f / den;
      float le[4];
#pragma unroll
      for (int k2 = 0; k2 < 4; ++k2) { float sel = 0.f;
#pragma unroll
        for (int gg2 = 0; gg2 < 4; ++gg2) sel = (gi == gg2) ? (lg[4 + gg2 * 4 + k2] * rs + bre[gg2 * 4 + k2]) : sel;
        le[k2] = sel; }
      int i0 = 0; float l0 = le[0];
#pragma unroll
      for (int k2 = 1; k2 < 4; ++k2) if (le[k2] > l0) { l0 = le[k2]; i0 = k2; }
      int i1 = -1; float l1 = -INFINITY;
#pragma unroll
      for (int k2 = 0; k2 < 4; ++k2) if (k2 != i0 && le[k2] > l1) { l1 = le[k2]; i1 = k2; }
      const float e1 = expf(l1 - l0);
      const float w0 = pg / (1.f + e1), w1 = pg * e1 / (1.f + e1);
      const int elo = (i0 < i1) ? i0 : i1, ehi = (i0 < i1) ? i1 : i0;
      const float wlo = (i0 < i1) ? w0 : w1, whi = (i0 < i1) ? w1 : w0;
      const int pidx = (elo == 0) ? (ehi - 1) : ((elo == 1) ? (ehi + 1) : 5);
      const int cls = gi * 6 + pidx;
      if (q == 0) {
        const int rank = atomicAdd(&hist[cls], 1);
        tokl[2 * (ntok + c)] = t; tokl[2 * (ntok + c) + 1] = (cls << 16) | rank;
        TOKW[t] = make_float2(wlo, whi);
      }
    }
    ntok += 16;
  }
  __syncthreads();
  if (tid < 24) { const int n = hist[tid]; hist[32 + tid] = n ? atomicAdd(&CNT[tid], n) : 0; }
  __syncthreads();
  for (int i = tid; i < ntok; i += NTHREADS) { const int t = tokl[2 * i], cr = tokl[2 * i + 1], cls = cr >> 16; LIST[(size_t)cls * T + hist[32 + cls] + (cr & 0xffff)] = t; }
}

struct MoeItem { int cls, mtile, nt, cnt; };
DEVI void moe_prefix(const int* CNT, unsigned char* lds) {
  int* pre = (int*)(lds + LDS_BYTES + 64);
  __syncthreads();
  if (threadIdx.x < 24) pre[32 + threadIdx.x] = CNT[threadIdx.x];
  __syncthreads();
  if (threadIdx.x == 0) { int a = 0; for (int c = 0; c < 24; ++c) { pre[c] = a; a += (pre[32 + c] + 127) >> 7; } pre[24] = a; }
  __syncthreads();
}
DEVI bool moe_item(unsigned char* lds, int it, MoeItem& m) {
  const int* pre = (const int*)(lds + LDS_BYTES + 64);
  const int mt = it >> 3; m.nt = it & 7;
  if (mt >= pre[24]) return false;
  int c = 0;
#pragma unroll
  for (int q = 1; q < 24; ++q) c += (mt >= pre[q]) ? 1 : 0;
  m.cls = c; m.mtile = mt - pre[c]; m.cnt = pre[32 + c];
  return true;
}
DEVI void cls_experts(int cls, int& e0, int& e1) {
  const int g = cls / 6, pi = cls % 6;
  const int lo = (pi < 3) ? 0 : ((pi < 5) ? 1 : 2);
  const int hi = (pi < 3) ? (pi + 1) : ((pi < 5) ? (pi - 1) : 3);
  e0 = g * 4 + lo; e1 = g * 4 + hi;
}
DEVI void phase_g5(const Params& p, int l, unsigned char* lds) {
  const bf16_t* XN = (const bf16_t*)(p.ws + WS_A);
  bf16_t* HID = (bf16_t*)(p.ws + WS_B);
  const bf16_t* WGU = (const bf16_t*)(p.ws + WS_W + l * WS_WL + W_GU);
  const int* CNT = (const int*)(p.ws + SM_CNT) + l * 32;
  const int* LIST = (const int*)(p.ws + SM_LIST);
  const float2* TOKW = (const float2*)(p.ws + SM_TOKW);
  moe_prefix(CNT, lds);
  const int G_ = (int)gridDim.x, total_ = ((const int*)(lds + LDS_BYTES + 64))[24] * 8, full_ = (total_ / G_) * G_, rem_ = total_ - full_;
  for (int it = vblock(); it < full_ + 2 * rem_; it += G_) {
    const bool halfmode = it >= full_; const int half = (it - full_) & 1;
    MoeItem mi; if (!moe_item(lds, halfmode ? full_ + ((it - full_) >> 1) : it, mi)) break;
    int e0, e1; cls_experts(mi.cls, e0, e1);
    const int ex = (mi.nt < 4) ? e0 : e1, ntl = mi.nt & 3;
    const bf16_t* W = WGU + ((size_t)ex * 512 + ntl * 128) * 1024;
    const int* list = LIST + (size_t)mi.cls * T + mi.mtile * 128;
    const int nvalid = mi.cnt - mi.mtile * 128;
    if (halfmode) {
      f32x4 acc2[2][4];
      int tokA[4];
#pragma unroll
      for (int i = 0; i < 4; ++i) { const int r = (threadIdx.x >> 3) + 32 * i; tokA[i] = list[(r < nvalid) ? r : 0]; }
      const int tid = threadIdx.x, wid = tid >> 6, lane = tid & 63, fr = lane & 15, fq = lane >> 4;
      int tokE2[2]; float twE2[2];
#pragma unroll
      for (int m = 0; m < 2; ++m) { const int er = wid * 32 + m * 16 + fr; tokE2[m] = list[(er < nvalid) ? er : 0]; }
#pragma unroll
      for (int m = 0; m < 2; ++m) { const float2 tw = TOKW[tokE2[m]]; twE2[m] = (mi.nt < 4) ? tw.x : tw.y; }
      const bf16_t* Wh = W + (size_t)half * 64 * 1024;
      gemm128h(lds, D, [&](int r, int k) { const int i = r >> 5; const int tok = (i == 0) ? tokA[0] : (i == 1) ? tokA[1] : (i == 2) ? tokA[2] : tokA[3]; return XN + (size_t)tok * D + k; },
               [&](int r, int k) { return Wh + (size_t)r * D + k; }, acc2);
#pragma unroll
      for (int m = 0; m < 2; ++m) {
        const int er = wid * 32 + m * 16 + fr;
        if (er < nvalid) {
#pragma unroll
          for (int n = 0; n < 2; ++n) {
            f32x4 hv;
#pragma unroll
            for (int j = 0; j < 4; ++j) { const float gt = acc2[m][n][j], up = acc2[m][n + 2][j]; hv[j] = gt * sigmoidf_(gt) * up * twE2[m]; }
            st_bf16x4(HID + (size_t)tokE2[m] * 512 + (mi.nt < 4 ? 0 : 256) + ntl * 64 + half * 32 + n * 16 + fq * 4, hv);
          }
        }
      }
      continue;
    }
    f32x4 acc[4][4];
    int tokA[4], tokE[4]; float twE[4];
#pragma unroll
    for (int i = 0; i < 4; ++i) { const int r = (threadIdx.x >> 3) + 32 * i; tokA[i] = list[(r < nvalid) ? r : 0]; }
    {
      const int tid_ = threadIdx.x, er0 = ((tid_ >> 6) >> 1) * 64 + (tid_ & 15);
#pragma unroll
      for (int m = 0; m < 4; ++m) { const int er = er0 + m * 16; tokE[m] = list[(er < nvalid) ? er : 0]; }
#pragma unroll
      for (int m = 0; m < 4; ++m) { const float2 tw = TOKW[tokE[m]]; twE[m] = (mi.nt < 4) ? tw.x : tw.y; }
    }
    gemm128g(lds, D, [&](int r, int k) { const int i = r >> 5; const int tok = (i == 0) ? tokA[0] : (i == 1) ? tokA[1] : (i == 2) ? tokA[2] : tokA[3]; return XN + (size_t)tok * D + k; }, [&](int r, int k) { return W + (size_t)r * D + k; }, acc);
    {
      const int tid = threadIdx.x, wid = tid >> 6, lane = tid & 63, wr = wid >> 1, wc = wid & 1, fr = lane & 15, fq = lane >> 4;
#pragma unroll
      for (int m = 0; m < 4; ++m) {
        const int er = wr * 64 + m * 16 + fr;
        if (er < nvalid) {
          const int tok = tokE[m];
          const float w = twE[m];
#pragma unroll
          for (int n = 0; n < 2; ++n) {
            f32x4 hv;
#pragma unroll
            for (int j = 0; j < 4; ++j) { const float gt = acc[m][n][j], up = acc[m][n + 2][j]; hv[j] = gt * sigmoidf_(gt) * up * w; }
            const int hh = (mi.nt < 4 ? 0 : 256) + ntl * 64 + wc * 32 + n * 16 + fq * 4;
            st_bf16x4(HID + (size_t)tok * 512 + hh, hv);
          }
        }
      }
    }
  }
}
DEVI void phase_g6(const Params& p, int l, unsigned char* lds) {
  const bf16_t* HID = (const bf16_t*)(p.ws + WS_B);
  const bf16_t* WDN = (const bf16_t*)(p.ws + WS_W + l * WS_WL + W_DN);
  const int* CNT = (const int*)(p.ws + SM_CNT) + l * 32;
  const int* LIST = (const int*)(p.ws + SM_LIST);
  float* out = p.out;
  moe_prefix(CNT, lds);
  const int G_ = (int)gridDim.x, total_ = ((const int*)(lds + LDS_BYTES + 64))[24] * 8, full_ = (total_ / G_) * G_, rem_ = total_ - full_;
  for (int it = vblock(); it < full_ + 2 * rem_; it += G_) {
    const bool halfmode = it >= full_; const int half = (it - full_) & 1;
    MoeItem mi; if (!moe_item(lds, halfmode ? full_ + ((it - full_) >> 1) : it, mi)) break;
    int e0, e1; cls_experts(mi.cls, e0, e1);
    const int* list = LIST + (size_t)mi.cls * T + mi.mtile * 128;
    const int nvalid = mi.cnt - mi.mtile * 128;
    const bf16_t* W0 = WDN + ((size_t)e0 * 1024 + mi.nt * 128) * 256;
    const bf16_t* W1 = WDN + ((size_t)e1 * 1024 + mi.nt * 128) * 256;
    if (halfmode) {
      f32x4 acc2[2][4];
      int tokA[4];
#pragma unroll
      for (int i = 0; i < 4; ++i) { const int r = (threadIdx.x >> 3) + 32 * i; tokA[i] = list[(r < nvalid) ? r : 0]; }
      const int tid = threadIdx.x, wid = tid >> 6, lane = tid & 63, fr = lane & 15, fq = lane >> 4;
      int trow2[2];
#pragma unroll
      for (int m = 0; m < 2; ++m) { const int er = wid * 32 + m * 16 + fr; trow2[m] = list[(er < nvalid) ? er : 0]; }
      const bf16_t* W0h = W0 + (size_t)half * 64 * 256; const bf16_t* W1h = W1 + (size_t)half * 64 * 256;
      gemm128h(lds, 512, [&](int r, int k) { const int i = r >> 5; const int tok = (i == 0) ? tokA[0] : (i == 1) ? tokA[1] : (i == 2) ? tokA[2] : tokA[3]; return HID + (size_t)tok * 512 + k; },
               [&](int r, int k) { return ((k < 256) ? W0h : W1h) + (size_t)r * 256 + (k & 255); }, acc2);
#pragma unroll
      for (int m = 0; m < 2; ++m) {
        const int er = wid * 32 + m * 16 + fr;
        if (er < nvalid) {
#pragma unroll
          for (int n = 0; n < 4; ++n) { float* o = out + (size_t)trow2[m] * D + mi.nt * 128 + half * 64 + n * 16 + fq * 4; const f32x4 xi = *(const f32x4*)o; *(f32x4*)o = xi + acc2[m][n]; }
        }
      }
      continue;
    }
    f32x4 acc[4][4];
    int trow[4], tokA[4];
    {
      const int tid = threadIdx.x, wid = tid >> 6, lane = tid & 63, wr = wid >> 1, fr = lane & 15;
#pragma unroll
      for (int i = 0; i < 4; ++i) { const int r = (tid >> 3) + 32 * i; tokA[i] = list[(r < nvalid) ? r : 0]; }
#pragma unroll
      for (int m = 0; m < 4; ++m) { const int er = wr * 64 + m * 16 + fr; trow[m] = list[(er < nvalid) ? er : 0]; }
    }
    gemm128g(lds, 512, [&](int r, int k) { const int i = r >> 5; const int tok = (i == 0) ? tokA[0] : (i == 1) ? tokA[1] : (i == 2) ? tokA[2] : tokA[3]; return HID + (size_t)tok * 512 + k; },
            [&](int r, int k) { return ((k < 256) ? W0 : W1) + (size_t)r * 256 + (k & 255); }, acc);
    GEMM_EPI4({ if (er < nvalid) { const size_t o = (size_t)trow[m] * D + mi.nt * 128 + ec0; const f32x4 xi = *(const f32x4*)(out + o); *(f32x4*)(out + o) = xi + ev4; } })
  }
}


#define XB_TMO      128
#define XB_XCNT(j)  (256  + 64 * (j))
#define XB_XSUB(j)  (1280 + 64 * (j))
#define XB_XGEN(j)  (2304 + 64 * (j))
#define XB_TOP      3328
#define XB_TOPGEN   3392
#define XCD_BAR_WORDS 3456
#define XB_SPIN_CAP (1u << 18)
DEVI unsigned xb_ld(unsigned* p)              { return __hip_atomic_load(p, __ATOMIC_RELAXED, __HIP_MEMORY_SCOPE_AGENT); }
DEVI unsigned xb_add(unsigned* p, unsigned v) { return __hip_atomic_fetch_add(p, v, __ATOMIC_RELAXED, __HIP_MEMORY_SCOPE_AGENT); }
DEVI unsigned xb_xcc_id() { return (unsigned)__builtin_amdgcn_s_getreg((3 << 11) | 20) & 0xFu; }
#define XB_SPIN(cond, bar) do { unsigned _sp = 0; while (cond) { __builtin_amdgcn_s_sleep(1); \
    if ((++_sp & 255u) == 0u) { if (xb_ld(&(bar)[XB_TMO])) break; if (_sp > XB_SPIN_CAP) { atomicAdd(&(bar)[XB_TMO], 1u); break; } } } } while (0)
struct XcdBarrier { unsigned* bar; unsigned x; volatile LAS unsigned* st; };
DEVI XcdBarrier xcd_barrier_post(unsigned* bar, volatile LAS unsigned* st) {
    XcdBarrier b; b.bar = bar; b.x = xb_xcc_id(); b.st = st;
    if (threadIdx.x == 0) (void)xb_add(&bar[XB_XCNT(b.x)], 1u);
    return b;
}
DEVI void xcd_barrier_complete(unsigned* bar, unsigned x, unsigned& nloc, unsigned& nx) {
    const unsigned G = gridDim.x * gridDim.y * gridDim.z;
    unsigned sum, cnt, mine, sp = 0u;
    for (;;) {
        sum = 0u; cnt = 0u; mine = 0u;
#pragma unroll
        for (unsigned j = 0; j < 16; ++j) { const unsigned c = xb_ld(&bar[XB_XCNT(j)]); sum += c; cnt += (c > 0u) ? 1u : 0u; mine = (j == x) ? c : mine; }
        if (sum == G) break;
        __builtin_amdgcn_s_sleep(1);
        if ((++sp & 255u) == 0u) { if (xb_ld(&bar[XB_TMO])) break; if (sp > XB_SPIN_CAP) { atomicAdd(&bar[XB_TMO], 1u); break; } }
    }
    nloc = mine > 0u ? mine : 1u; nx = cnt > 0u ? cnt : 1u;
}
DEVI void xcd_barrier(const XcdBarrier& b) {
    asm volatile("s_waitcnt vmcnt(0)" ::: "memory");
    __syncthreads();
    if (threadIdx.x == 0) {
        unsigned* bar = b.bar;
        __builtin_amdgcn_s_waitcnt(0);
        unsigned nloc = b.st[0], nx = b.st[1];
        if (nloc == 0u) { xcd_barrier_complete(bar, b.x, nloc, nx); b.st[0] = nloc; b.st[1] = nx; }
        const unsigned old = xb_add(&bar[XB_XSUB(b.x)], 1u);
        const unsigned gen = old / nloc;
        if (old + 1u == (gen + 1u) * nloc) {
            __builtin_amdgcn_fence(__ATOMIC_RELEASE, "agent");
            asm volatile("s_waitcnt vmcnt(0)" ::: "memory");
            const unsigned og = xb_add(&bar[XB_TOP], 1u);
            const unsigned tg = og / nx;
            if (og + 1u == (tg + 1u) * nx) xb_add(&bar[XB_TOPGEN], 1u);
            else XB_SPIN(xb_ld(&bar[XB_TOPGEN]) == tg, bar);
            __builtin_amdgcn_fence(__ATOMIC_ACQUIRE, "agent");
            xb_add(&bar[XB_XGEN(b.x)], 1u);
            asm volatile("s_waitcnt vmcnt(0)" ::: "memory");
        } else {
            XB_SPIN(xb_ld(&bar[XB_XGEN(b.x)]) == gen, bar);
            __builtin_amdgcn_fence(__ATOMIC_ACQUIRE, "agent");
            asm volatile("s_waitcnt vmcnt(0)" ::: "memory");
        }
    }
    __syncthreads();
}

#define PH(k, call) { const int _k = (k); if (p.lo <= _k && _k < p.hi) { call; if (_k + 1 < p.hi) { if (_k == 0) grid.sync(); else xcd_barrier(xbar); } } }
__global__ void __launch_bounds__(NTHREADS, 2) hybrid_fwd(Params p) {
  extern __shared__ __attribute__((aligned(16))) unsigned char lds[];
  cg::grid_group grid = cg::this_grid();
  volatile LAS unsigned* xst = (volatile LAS unsigned*)(LAS unsigned char*)(lds + LDS_BYTES);
  if (threadIdx.x < 4) xst[threadIdx.x] = 0u;
  __syncthreads();
  XcdBarrier xbar = xcd_barrier_post((unsigned*)(p.ws + WS_CTL), xst);
  PH(0, phase_prep(p, lds))
#define LAYER(l) { \
    PH(1 + 13 * l + 0, phase_g1(p, l, lds)) \
    PH(1 + 13 * l + 2, phase_g2(p, l, lds)) \
    PH(1 + 13 * l + 3, phase_r2(p, l, lds)) \
    PH(1 + 13 * l + 4, phase_a1(p, l, lds)) \
    PH(1 + 13 * l + 5, phase_r3(p, l, lds)) \
    PH(1 + 13 * l + 6, phase_g3(p, l, lds)) \
    PH(1 + 13 * l + 7, phase_r4(p, l)) \
    PH(1 + 13 * l + 8, phase_g4(p, l, lds)) \
    PH(1 + 13 * l + 9, phase_r5(p, l, lds)) \
    PH(1 + 13 * l + 10, phase_g5(p, l, lds)) \
    PH(1 + 13 * l + 11, phase_g6(p, l, lds)) }
  LAYER(0)
  PH(13, rmsnorm_rows(p.out, p.in[2] + D, (bf16_t*)(p.ws + WS_A)))
  LAYER(1)
}

extern "C" void kernel_launch(void* const* d_in, const int* in_sizes, int n_in, void* d_out, int out_size, void* d_ws, size_t ws_size, hipStream_t stream) {
  static int grid_blocks = 0;
  if (!grid_blocks) {
    if (n_in != 45 || ws_size < WS_END) { fprintf(stderr, "kernel_launch: unexpected n_in %d or ws_size %zu (< %zu)\n", n_in, ws_size, (size_t)WS_END); grid_blocks = -1; return; }
    int dev = 0, cus = 0, per_cu = 0;
    hipGetDevice(&dev);
    hipDeviceGetAttribute(&cus, hipDeviceAttributeMultiprocessorCount, dev);
    hipFuncSetAttribute((const void*)hybrid_fwd, hipFuncAttributeMaxDynamicSharedMemorySize, LDS_ALLOC);
    hipOccupancyMaxActiveBlocksPerMultiprocessor(&per_cu, (const void*)hybrid_fwd, NTHREADS, LDS_ALLOC);
    if (per_cu < 1) per_cu = 1;
    if (per_cu > 2) per_cu = 2;
    grid_blocks = cus * per_cu;
    fprintf(stderr, "kernel_launch: cus %d per_cu %d grid %d\n", cus, per_cu, grid_blocks);
  }
  if (grid_blocks < 0) return;
  (void)hipMemsetAsync((unsigned char*)d_ws + WS_CTL, 0, XCD_BAR_WORDS * 4, stream);
  Params p{};
  for (int i = 0; i < 45; ++i) p.in[i] = (const float*)d_in[i];
  p.out = (float*)d_out; p.ws = (unsigned char*)d_ws;
#if N_LAUNCH_MODE == 1
  p.lo = 0; p.hi = NPH;
  { void* args[] = {&p}; hipError_t e = hipLaunchCooperativeKernel((void*)hybrid_fwd, dim3(grid_blocks), dim3(NTHREADS), args, LDS_ALLOC, stream);
    if (e != hipSuccess) fprintf(stderr, "cooperative launch failed: %s\n", hipGetErrorString(e)); }
#else
  for (int ph = 0; ph < NPH; ++ph) {
    p.lo = ph; p.hi = ph + 1;
    void* args[] = {&p}; hipError_t e = hipLaunchCooperativeKernel((void*)hybrid_fwd, dim3(grid_blocks), dim3(NTHREADS), args, LDS_ALLOC, stream);
    if (e != hipSuccess) { fprintf(stderr, "launch %d failed: %s\n", ph, hipGetErrorString(e)); break; }
  }
#endif
}
```

```cpp
#include <hip/hip_runtime.h>
#include <hip/hip_cooperative_groups.h>
#include <cstdio>
#include <cstdint>
namespace cg = cooperative_groups;

#ifndef N_LAUNCH_MODE
#define N_LAUNCH_MODE 1
#endif

#define DEVI __device__ __forceinline__
typedef unsigned short bf16_t;
typedef short bf16x8 __attribute__((ext_vector_type(8)));
typedef float f32x4 __attribute__((ext_vector_type(4)));
typedef float f32x16 __attribute__((ext_vector_type(16)));
typedef unsigned u32x4 __attribute__((ext_vector_type(4)));
#define LAS __attribute__((address_space(3)))

constexpr int NB = 16, S = 2048, T = NB * S, D = 1024, DIN = 1772, DINP = 1792, NL = 2;
constexpr int C_CQ = 0, C_KPE = 192, C_NG = 224, C_CKV = 256, C_LX = 384, C_LG = 640, C_S5 = 896, C_NQ = 1152, C_KS = 1408, C_KW = 1472, C_KC = 1536, C_VC = 1600, C_VS = 1664, C_VW = 1728;
__host__ __device__ constexpr int colmap(int n) {
  if (n < 192) return n;
  if (n < 320) return C_CKV + (n - 192);
  if (n < 352) return C_KPE + (n - 320);
  if (n < 608) return C_LX + (n - 352);
  if (n < 864) return C_LG + (n - 608);
  if (n < 1120) return C_S5 + (n - 864);
  if (n < 1376) return C_NQ + (n - 1120);
  if (n < 1760) { const int j = n - 1376, part = j >> 6, d = j & 63; return (part == 0 ? C_KC : part == 1 ? C_VC : part == 2 ? C_KS : part == 3 ? C_VS : part == 4 ? C_KW : C_VW) + d; }
  return C_NG + (n - 1760);
}
constexpr float EPS = 1e-6f;
constexpr float LOG2E = 1.4426950408889634f;
constexpr int NTHREADS = 256;
constexpr int NPH = 1 + 13 * NL - 1;

constexpr size_t MiB = 1u << 20;
constexpr size_t WS_CTL = 0;
constexpr size_t WS_SMALL = 1 * MiB;
constexpr size_t WS_W = 16 * MiB;
constexpr size_t WS_WL = 32 * MiB;
constexpr size_t WS_A = 80 * MiB;
constexpr size_t WS_B = 144 * MiB;
constexpr size_t WS_C = 256 * MiB;
constexpr size_t WS_D = 292 * MiB;
constexpr size_t WS_E = 348 * MiB;
constexpr size_t WS_F = 380 * MiB;
constexpr size_t WS_G = 428 * MiB;
constexpr size_t WS_ROPE = 452 * MiB;
constexpr size_t WS_END = 460 * MiB;
constexpr size_t W_IN = 0;
constexpr size_t W_OUT = 4 * MiB;
constexpr size_t W_UQ = 6 * MiB;
constexpr size_t W_UKV = W_UQ + 384 * 192 * 2;
constexpr size_t W_LRU = W_UKV + 512 * 128 * 2;
constexpr size_t W_GLU = W_LRU + 4 * 128 * 64 * 2;
constexpr size_t W_1K = 6 * MiB + 512 * 1024;
constexpr size_t W_1V = W_1K + 128 * 2048 * 2;
constexpr size_t W_B1K = W_1V + 128 * 2048 * 2;
constexpr size_t W_B1V = W_B1K + 512;
constexpr size_t W_S5A = W_B1V + 512;
constexpr size_t W_S5A64 = W_S5A + 16 * 64 * 8;
constexpr size_t W_S5B = W_S5A64 + 16 * 64 * 8;
constexpr size_t W_S5BB = W_S5B + 16 * 64 * 16 * 8;
constexpr size_t W_S5CM = W_S5BB + 16 * 4 * 32 * 16 * 2;
constexpr size_t W_2K = W_S5CM + 16 * 16 * 128 * 2;
constexpr size_t W_2V = W_2K + 64 * 128 * 2;
static_assert(W_2V + 64 * 128 * 2 <= 8 * MiB, "weights overflow");
constexpr size_t W_RTH = W_2V + 64 * 128 * 2;
constexpr size_t W_RTL = W_RTH + 32 * 1024 * 2;
static_assert(W_RTL + 32 * 1024 * 2 <= 8 * MiB, "weights overflow 2");
constexpr size_t W_GU = 8 * MiB;
constexpr size_t W_DN = 24 * MiB;
constexpr size_t SM_CNT = WS_SMALL;
constexpr size_t SM_LIST = WS_SMALL + 4096;
constexpr size_t SM_TOKW = SM_LIST + 24 * (size_t)T * 4;
constexpr size_t SM_LSUM = SM_TOKW + (size_t)T * 8;
constexpr size_t SM_SLOC = SM_LSUM + 16 * 32 * 256 * 8;
constexpr size_t SM_HK = SM_SLOC + 16 * 32 * 1024 * 8;
constexpr size_t SM_HV = SM_HK + 2048 * 128 * 2;
constexpr size_t SM_KC = SM_HV + 2048 * 128 * 2;
constexpr size_t SM_VC = SM_KC + 16 * 128 * 64 * 2;
constexpr size_t SM_SCAR = SM_VC + 16 * 128 * 64 * 2;
constexpr size_t SM_LCAR = SM_SCAR + 16 * 32 * 1024 * 8;
constexpr size_t SM_SSKV = SM_LCAR + 16 * 32 * 256 * 4;
constexpr size_t SM_END = SM_SSKV + (size_t)T * 2 * 4;
static_assert(SM_END <= WS_W, "small region overflow");

constexpr int LDS_BYTES = 65536;
constexpr int LDS_ALLOC = LDS_BYTES + 512;

struct Params {
  const float* in[45];
  float* out;
  unsigned char* ws;
  int lo, hi;
};

DEVI float bf2f(bf16_t v) { return __uint_as_float(((unsigned)v) << 16); }
DEVI bf16_t f2bf(float f) { unsigned u = __float_as_uint(f); return (bf16_t)((u + 0x7fffu + ((u >> 16) & 1u)) >> 16); }
DEVI float wsum(float v) {
#pragma unroll
  for (int o = 32; o >= 1; o >>= 1) v += __shfl_xor(v, o);
  return v;
}
DEVI float sigmoidf_(float x) { return __builtin_amdgcn_rcpf(1.f + __expf(-x)); }
DEVI float gelu_tanh(float x) { const float u2 = 1.5957691216057308f * (x + 0.044715f * x * x * x); return x * __builtin_amdgcn_rcpf(1.f + __expf(-u2)); }
DEVI f32x16 mfma32(bf16x8 a, bf16x8 b, f32x16 c) { return __builtin_amdgcn_mfma_f32_32x32x16_bf16(a, b, c, 0, 0, 0); }
DEVI f32x4 mfma16(bf16x8 a, bf16x8 b, f32x4 c) { return __builtin_amdgcn_mfma_f32_16x16x32_bf16(a, b, c, 0, 0, 0); }
DEVI int vblock() { const int G = (int)gridDim.x, bx = (int)blockIdx.x; return (G % 8 == 0) ? (bx % 8) * (G / 8) + bx / 8 : bx; }
DEVI int crow(int r, int h) { return (r & 3) + 8 * (r >> 2) + 4 * h; }
typedef __bf16 bf16x2_t __attribute__((ext_vector_type(2)));
typedef float f32x2_t __attribute__((ext_vector_type(2)));
DEVI unsigned pk2bf(float lo, float hi) { f32x2_t v = {lo, hi}; bf16x2_t b = __builtin_convertvector(v, bf16x2_t); return __builtin_bit_cast(unsigned, b); }

template <class AF, class BF>
DEVI void gemm128(unsigned char* lds, int K, AF aload, BF bptr, f32x4 (&acc)[4][4]) {
  const int tid = threadIdx.x, wid = tid >> 6, lane = tid & 63, wr = wid >> 1, wc = wid & 1, fr = lane & 15, fq = lane >> 4;
#pragma unroll
  for (int m = 0; m < 4; ++m)
#pragma unroll
    for (int n = 0; n < 4; ++n) acc[m][n] = (f32x4){0.f, 0.f, 0.f, 0.f};
  const int lr = tid >> 3, ch = tid & 7;
  const int wofs = lr * 128 + ((ch ^ ((lr >> 1) & 7)) * 16);
  const int sw = (fr >> 1) & 7;
  const int aro = (wr * 64 + fr) * 128, bro = (wc * 64 + fr) * 128;
  const int nk = K >> 6;
  u32x4 ra[4], rb[4];
#pragma unroll
  for (int i = 0; i < 4; ++i) { ra[i] = aload(lr + 32 * i, ch * 8); rb[i] = *(const u32x4*)bptr(lr + 32 * i, ch * 8); }
  __syncthreads();
#pragma unroll
  for (int i = 0; i < 4; ++i) { *(u32x4*)(lds + wofs + i * 4096) = ra[i]; *(u32x4*)(lds + 16384 + wofs + i * 4096) = rb[i]; }
  __syncthreads();
  for (int kt = 0; kt < nk; ++kt) {
    const bool more = (kt + 1 < nk);
    if (more) {
      const int k = (kt + 1) * 64 + ch * 8;
#pragma unroll
      for (int i = 0; i < 4; ++i) { ra[i] = aload(lr + 32 * i, k); rb[i] = *(const u32x4*)bptr(lr + 32 * i, k); }
    }
    const unsigned char* bufA = lds + (kt & 1) * 32768;
    const unsigned char* bufB = bufA + 16384;
#pragma unroll
    for (int kk = 0; kk < 2; ++kk) {
      bf16x8 At[4], Bt[4];
      const int co = ((kk * 4 + fq) ^ sw) * 16;
#pragma unroll
      for (int m = 0; m < 4; ++m) At[m] = *(const bf16x8*)(bufA + aro + m * 2048 + co);
#pragma unroll
      for (int n = 0; n < 4; ++n) Bt[n] = *(const bf16x8*)(bufB + bro + n * 2048 + co);
#pragma unroll
      for (int m = 0; m < 4; ++m)
#pragma unroll
        for (int n = 0; n < 4; ++n) acc[m][n] = mfma16(Bt[n], At[m], acc[m][n]);
    }
    if (more) {
      unsigned char* nb = lds + ((kt + 1) & 1) * 32768;
#pragma unroll
      for (int i = 0; i < 4; ++i) { *(u32x4*)(nb + wofs + i * 4096) = ra[i]; *(u32x4*)(nb + 16384 + wofs + i * 4096) = rb[i]; }
    }
    __syncthreads();
  }
}
template <class AF, class BF>
DEVI void gemm128g(unsigned char* lds, int K, AF aptr, BF bptr, f32x4 (&acc)[4][4]) {
  const int tid = threadIdx.x, wid = tid >> 6, lane = tid & 63, wr = wid >> 1, wc = wid & 1, fr = lane & 15, fq = lane >> 4;
#pragma unroll
  for (int m = 0; m < 4; ++m)
#pragma unroll
    for (int n = 0; n < 4; ++n) acc[m][n] = (f32x4){0.f, 0.f, 0.f, 0.f};
  const int lr = tid >> 3;
  const int chs = ((tid & 7) ^ ((lr >> 1) & 7)) * 8;
  const int sw = (fr >> 1) & 7;
  const int aro = (wr * 64 + fr) * 128, bro = (wc * 64 + fr) * 128;
  const int nk = K >> 6;
  LAS unsigned char* l3 = (LAS unsigned char*)lds;
#define G128_STAGE(buf, kbase)                                                                                                   \
  _Pragma("unroll") for (int i = 0; i < 4; ++i) {                                                                                 \
    __builtin_amdgcn_global_load_lds((const __attribute__((address_space(1))) unsigned*)aptr(lr + 32 * i, (kbase) + chs),          \
                                     (LAS unsigned*)(l3 + (buf) * 32768 + tid * 16 + i * 4096), 16, 0, 0);                           \
    __builtin_amdgcn_global_load_lds((const __attribute__((address_space(1))) unsigned*)bptr(lr + 32 * i, (kbase) + chs),          \
                                     (LAS unsigned*)(l3 + (buf) * 32768 + 16384 + tid * 16 + i * 4096), 16, 0, 0);                   \
  }
  __syncthreads();
  G128_STAGE(0, 0)
  asm volatile("s_waitcnt vmcnt(0)" ::: "memory");
  __syncthreads();
  for (int kt = 0; kt < nk; ++kt) {
    if (kt + 1 < nk) { G128_STAGE((kt + 1) & 1, (kt + 1) * 64) }
    const unsigned char* bufA = lds + (kt & 1) * 32768;
    const unsigned char* bufB = bufA + 16384;
#pragma unroll
    for (int kk = 0; kk < 2; ++kk) {
      bf16x8 At[4], Bt[4];
      const int co = ((kk * 4 + fq) ^ sw) * 16;
#pragma unroll
      for (int m = 0; m < 4; ++m) At[m] = *(const bf16x8*)(bufA + aro + m * 2048 + co);
#pragma unroll
      for (int n = 0; n < 4; ++n) Bt[n] = *(const bf16x8*)(bufB + bro + n * 2048 + co);
#pragma unroll
      for (int m = 0; m < 4; ++m)
#pragma unroll
        for (int n = 0; n < 4; ++n) acc[m][n] = mfma16(Bt[n], At[m], acc[m][n]);
    }
    asm volatile("s_waitcnt vmcnt(0)" ::: "memory");
    __syncthreads();
  }
#undef G128_STAGE
}
template <class AF, class BF, class AF2, class BF2>
DEVI void gemm128p(unsigned char* lds, int K, AF aptr, BF bptr, f32x4 (&acc)[4][4], int& par, bool staged, bool has_next, AF2 naptr, BF2 nbptr) {
  const int tid = threadIdx.x, wid = tid >> 6, lane = tid & 63, wr = wid >> 1, wc = wid & 1, fr = lane & 15, fq = lane >> 4;
#pragma unroll
  for (int m = 0; m < 4; ++m)
#pragma unroll
    for (int n = 0; n < 4; ++n) acc[m][n] = (f32x4){0.f, 0.f, 0.f, 0.f};
  const int lr = tid >> 3;
  const int chs = ((tid & 7) ^ ((lr >> 1) & 7)) * 8;
  const int sw = (fr >> 1) & 7;
  const int aro = (wr * 64 + fr) * 128, bro = (wc * 64 + fr) * 128;
  const int nk = K >> 6;
  LAS unsigned char* l3 = (LAS unsigned char*)lds;
#define GP_STAGE(buf, kbase, AP, BP)                                                                                             \
  _Pragma("unroll") for (int i = 0; i < 4; ++i) {                                                                                 \
    __builtin_amdgcn_global_load_lds((const __attribute__((address_space(1))) unsigned*)AP(lr + 32 * i, (kbase) + chs),            \
                                     (LAS unsigned*)(l3 + (buf) * 32768 + tid * 16 + i * 4096), 16, 0, 0);                           \
    __builtin_amdgcn_global_load_lds((const __attribute__((address_space(1))) unsigned*)BP(lr + 32 * i, (kbase) + chs),            \
                                     (LAS unsigned*)(l3 + (buf) * 32768 + 16384 + tid * 16 + i * 4096), 16, 0, 0);                   \
  }
  if (!staged) {
    __syncthreads();
    GP_STAGE(par, 0, aptr, bptr)
    asm volatile("s_waitcnt vmcnt(0)" ::: "memory");
    __syncthreads();
  }
  for (int kt = 0; kt < nk; ++kt) {
    const int cur = (par + kt) & 1;
    if (kt + 1 < nk) { GP_STAGE(cur ^ 1, (kt + 1) * 64, aptr, bptr) }
    else if (has_next) { GP_STAGE(cur ^ 1, 0, naptr, nbptr) }
    const unsigned char* bufA = lds + cur * 32768;
    const unsigned char* bufB = bufA + 16384;
#pragma unroll
    for (int kk = 0; kk < 2; ++kk) {
      bf16x8 At[4], Bt[4];
      const int co = ((kk * 4 + fq) ^ sw) * 16;
#pragma unroll
      for (int m = 0; m < 4; ++m) At[m] = *(const bf16x8*)(bufA + aro + m * 2048 + co);
#pragma unroll
      for (int n = 0; n < 4; ++n) Bt[n] = *(const bf16x8*)(bufB + bro + n * 2048 + co);
#pragma unroll
      for (int m = 0; m < 4; ++m)
#pragma unroll
        for (int n = 0; n < 4; ++n) acc[m][n] = mfma16(Bt[n], At[m], acc[m][n]);
    }
    asm volatile("s_waitcnt vmcnt(0)" ::: "memory");
    __syncthreads();
  }
  par = (par + nk) & 1;
#undef GP_STAGE
}
template <class AF, class BF>
DEVI void gemm128h(unsigned char* lds, int K, AF aptr, BF bptr, f32x4 (&acc)[2][4]) {
  const int tid = threadIdx.x, wid = tid >> 6, lane = tid & 63, fr = lane & 15, fq = lane >> 4;
#pragma unroll
  for (int m = 0; m < 2; ++m)
#pragma unroll
    for (int n = 0; n < 4; ++n) acc[m][n] = (f32x4){0.f, 0.f, 0.f, 0.f};
  const int lr = tid >> 3;
  const int chs = ((tid & 7) ^ ((lr >> 1) & 7)) * 8;
  const int sw = (fr >> 1) & 7;
  const int aro = (wid * 32 + fr) * 128, bro = fr * 128;
  const int nk = K >> 6;
  LAS unsigned char* l3 = (LAS unsigned char*)lds;
#define GH_STAGE(buf, kbase)                                                                                                     \
  { _Pragma("unroll") for (int i = 0; i < 4; ++i)                                                                                 \
      __builtin_amdgcn_global_load_lds((const __attribute__((address_space(1))) unsigned*)aptr(lr + 32 * i, (kbase) + chs),        \
                                       (LAS unsigned*)(l3 + (buf) * 32768 + tid * 16 + i * 4096), 16, 0, 0);                         \
    _Pragma("unroll") for (int i = 0; i < 2; ++i)                                                                                 \
      __builtin_amdgcn_global_load_lds((const __attribute__((address_space(1))) unsigned*)bptr(lr + 32 * i, (kbase) + chs),        \
                                       (LAS unsigned*)(l3 + (buf) * 32768 + 16384 + tid * 16 + i * 4096), 16, 0, 0); }
  __syncthreads();
  GH_STAGE(0, 0)
  asm volatile("s_waitcnt vmcnt(0)" ::: "memory");
  __syncthreads();
  for (int kt = 0; kt < nk; ++kt) {
    if (kt + 1 < nk) { GH_STAGE((kt + 1) & 1, (kt + 1) * 64) }
    const unsigned char* bufA = lds + (kt & 1) * 32768;
    const unsigned char* bufB = bufA + 16384;
#pragma unroll
    for (int kk = 0; kk < 2; ++kk) {
      bf16x8 At[2], Bt[4];
      const int co = ((kk * 4 + fq) ^ sw) * 16;
#pragma unroll
      for (int m = 0; m < 2; ++m) At[m] = *(const bf16x8*)(bufA + aro + m * 2048 + co);
#pragma unroll
      for (int n = 0; n < 4; ++n) Bt[n] = *(const bf16x8*)(bufB + bro + n * 2048 + co);
#pragma unroll
      for (int m = 0; m < 2; ++m)
#pragma unroll
        for (int n = 0; n < 4; ++n) acc[m][n] = mfma16(Bt[n], At[m], acc[m][n]);
    }
    asm volatile("s_waitcnt vmcnt(0)" ::: "memory");
    __syncthreads();
  }
#undef GH_STAGE
}
#define GEMM_EPI_LOOP(body)                                                                 \
  {                                                                                         \
    const int _tid = threadIdx.x, _wid = _tid >> 6, _lane = _tid & 63, _wr = _wid >> 1, _wc = _wid & 1, _fr = _lane & 15, _fq = _lane >> 4; \
    _Pragma("unroll") for (int m = 0; m < 4; ++m) _Pragma("unroll") for (int n = 0; n < 4; ++n) _Pragma("unroll") for (int j = 0; j < 4; ++j) { \
      const int er = _wr * 64 + m * 16 + _fr, ec = _wc * 64 + n * 16 + _fq * 4 + j; const float ev = acc[m][n][j]; body }                      \
  }
#define GEMM_EPI4(body)                                                                     \
  {                                                                                         \
    const int _tid = threadIdx.x, _wid = _tid >> 6, _lane = _tid & 63, _wr = _wid >> 1, _wc = _wid & 1, _fr = _lane & 15, _fq = _lane >> 4; \
    _Pragma("unroll") for (int m = 0; m < 4; ++m) _Pragma("unroll") for (int n = 0; n < 4; ++n) {                                             \
      const int er = _wr * 64 + m * 16 + _fr, ec0 = _wc * 64 + n * 16 + _fq * 4; const f32x4 ev4 = acc[m][n]; body }                          \
  }
DEVI void st_bf16x4(bf16_t* p, f32x4 v) { uint2 o; o.x = pk2bf(v[0], v[1]); o.y = pk2bf(v[2], v[3]); *(uint2*)p = o; }

template <class RM>
DEVI void transpose_tiles(const float* src, int K, int N, bf16_t* dst, int ldk, RM rowmap, unsigned char* lds, int& cursor, const float* kscale = nullptr) {
  float* tl = (float*)lds;
  const int tk = K / 64, tn = (N + 63) / 64, nt = tk * tn;
  const int tid = threadIdx.x;
  const int G_ = (int)gridDim.x;
  for (int it = ((int)blockIdx.x - cursor % G_ + G_) % G_; it < nt; it += G_) {
    const int kt = it / tn, ntile = it % tn, k0 = kt * 64, n0 = ntile * 64;
    __syncthreads();
#pragma unroll
    for (int q = 0; q < 4; ++q) {
      const int r = (tid >> 4) + 16 * q, c4 = (tid & 15) * 4;
      const float* sp = src + (size_t)(k0 + r) * N + n0 + c4;
      float4 v;
      if (n0 + c4 + 3 < N) v = *(const float4*)sp;
      else { v.x = (n0 + c4 < N) ? sp[0] : 0.f; v.y = (n0 + c4 + 1 < N) ? sp[1] : 0.f; v.z = (n0 + c4 + 2 < N) ? sp[2] : 0.f; v.w = 0.f; }
      if (kscale) { const float ks = kscale[k0 + r]; v.x *= ks; v.y *= ks; v.z *= ks; v.w *= ks; }
      tl[r * 65 + c4] = v.x; tl[r * 65 + c4 + 1] = v.y; tl[r * 65 + c4 + 2] = v.z; tl[r * 65 + c4 + 3] = v.w;
    }
    __syncthreads();
    const int n = tid >> 2, kc = (tid & 3) * 16;
    if (n0 + n < N) {
      unsigned w[8];
#pragma unroll
      for (int i = 0; i < 8; ++i) w[i] = pk2bf(tl[(kc + 2 * i) * 65 + n], tl[(kc + 2 * i + 1) * 65 + n]);
      uint4* o = (uint4*)(dst + (size_t)rowmap(n0 + n) * ldk + k0 + kc);
      o[0] = make_uint4(w[0], w[1], w[2], w[3]); o[1] = make_uint4(w[4], w[5], w[6], w[7]);
    }
  }
  cursor += nt;
}
DEVI void rmsnorm_rows(const float* x, const float* g, bf16_t* xn) {
  const int lane = threadIdx.x & 63, gw = blockIdx.x * 4 + (threadIdx.x >> 6), NGW = gridDim.x * 4;
  float4 gg[4];
#pragma unroll
  for (int j = 0; j < 4; ++j) gg[j] = ((const float4*)g)[lane + 64 * j];
  for (int t0 = gw * 4; t0 < T; t0 += NGW * 4) {
    float4 v[4][4];
#pragma unroll
    for (int q = 0; q < 4; ++q)
#pragma unroll
      for (int j = 0; j < 4; ++j) v[q][j] = ((const float4*)(x + (size_t)(t0 + q) * D))[lane + 64 * j];
#pragma unroll
    for (int q = 0; q < 4; ++q) {
      float s = 0.f;
#pragma unroll
      for (int j = 0; j < 4; ++j) s += v[q][j].x * v[q][j].x + v[q][j].y * v[q][j].y + v[q][j].z * v[q][j].z + v[q][j].w * v[q][j].w;
      const float rs = rsqrtf(wsum(s) * (1.f / D) + EPS);
#pragma unroll
      for (int j = 0; j < 4; ++j) {
        uint2 o; o.x = pk2bf(v[q][j].x * rs * gg[j].x, v[q][j].y * rs * gg[j].y); o.y = pk2bf(v[q][j].z * rs * gg[j].z, v[q][j].w * rs * gg[j].w);
        ((uint2*)(xn + (size_t)(t0 + q) * D))[lane + 64 * j] = o;
      }
    }
  }
}
DEVI void phase_prep(const Params& p, unsigned char* lds) {
  const size_t gtid = (size_t)blockIdx.x * NTHREADS + threadIdx.x, gn = (size_t)gridDim.x * NTHREADS;
  unsigned char* ws = p.ws;
  if (gtid < 64) ((int*)(ws + SM_CNT))[gtid] = 0;
  auto ident = [](int n) { return n; };
  int cursor = 0;
  for (int l = 0; l < NL; ++l) {
    unsigned char* wl = ws + WS_W + l * WS_WL;
    transpose_tiles(p.in[3] + (size_t)l * D * DIN, D, DIN, (bf16_t*)(wl + W_IN), D, [](int n) { return colmap(n); }, lds, cursor);
    for (size_t i = gtid; i < (size_t)20 * D; i += gn) ((bf16_t*)(wl + W_IN))[(size_t)236 * D + i] = 0;
    transpose_tiles(p.in[36] + (size_t)l * D * D, D, D, (bf16_t*)(wl + W_OUT), D, ident, lds, cursor);
    transpose_tiles(p.in[6] + (size_t)l * 192 * 384, 192, 384, (bf16_t*)(wl + W_UQ), 192, ident, lds, cursor, p.in[4] + l * 192);
    transpose_tiles(p.in[7] + (size_t)l * 128 * 512, 128, 512, (bf16_t*)(wl + W_UKV), 128, ident, lds, cursor, p.in[5] + l * 128);
    transpose_tiles(p.in[25] + (size_t)l * 256 * 256, 256, 256, (bf16_t*)(wl + W_GLU), 256, ident, lds, cursor);
    transpose_tiles(p.in[30] + (size_t)l * 2048 * 128, 2048, 128, (bf16_t*)(wl + W_1K), 2048, ident, lds, cursor);
    transpose_tiles(p.in[33] + (size_t)l * 2048 * 128, 2048, 128, (bf16_t*)(wl + W_1V), 2048, ident, lds, cursor);
    transpose_tiles(p.in[31] + (size_t)l * 128 * 64, 128, 64, (bf16_t*)(wl + W_2K), 128, ident, lds, cursor);
    transpose_tiles(p.in[34] + (size_t)l * 128 * 64, 128, 64, (bf16_t*)(wl + W_2V), 128, ident, lds, cursor);
    for (int h = 0; h < 4; ++h) {
      transpose_tiles(p.in[12] + ((size_t)l * 4 + h) * 64 * 64, 64, 64, (bf16_t*)(wl + W_LRU) + h * 128 * 64, 64, ident, lds, cursor);
      transpose_tiles(p.in[14] + ((size_t)l * 4 + h) * 64 * 64, 64, 64, (bf16_t*)(wl + W_LRU) + h * 128 * 64 + 64 * 64, 64, ident, lds, cursor);
    }
    for (int e = 0; e < 16; ++e) {
      bf16_t* dg = (bf16_t*)(wl + W_GU) + (size_t)e * 512 * 1024;
      transpose_tiles(p.in[42] + ((size_t)l * 16 + e) * 1024 * 256, 1024, 256, dg, 1024, [](int hh) { return (hh >> 6) * 128 + ((hh >> 5) & 1) * 64 + ((hh >> 4) & 1) * 16 + (hh & 15); }, lds, cursor);
      transpose_tiles(p.in[43] + ((size_t)l * 16 + e) * 1024 * 256, 1024, 256, dg, 1024, [](int hh) { return (hh >> 6) * 128 + ((hh >> 5) & 1) * 64 + (((hh >> 4) & 1) + 2) * 16 + (hh & 15); }, lds, cursor);
      transpose_tiles(p.in[44] + ((size_t)l * 16 + e) * 256 * 1024, 256, 1024, (bf16_t*)(wl + W_DN) + (size_t)e * 1024 * 256, 256, ident, lds, cursor);
    }
    {
      const int lane = threadIdx.x & 63, gw = blockIdx.x * 4 + (threadIdx.x >> 6), NGW = gridDim.x * 4;
      for (int o = gw; o < 256; o += NGW) {
        const int kv = o >> 7, j = o & 127;
        const float* pe = (kv ? p.in[32] : p.in[29]) + (size_t)l * 2048;
        const float* w1 = (kv ? p.in[33] : p.in[30]) + (size_t)l * 2048 * 128;
        float a = 0.f;
#pragma unroll 8
        for (int k = lane; k < 2048; k += 64) a += pe[k] * w1[(size_t)k * 128 + j];
        a = wsum(a);
        if (lane == 0) ((float*)(wl + (kv ? W_B1V : W_B1K)))[j] = a;
      }
    }
    for (size_t i = gtid; i < 16 * 64; i += gn) {
      const int g = (int)(i >> 6), sidx = (int)(i & 63);
      const float are = p.in[17][(size_t)l * 1024 + i], aim = p.in[18][(size_t)l * 1024 + i];
      const float dt = expf(p.in[19][l * 16 + g]);
      const float mag = expf(dt * are);
      float sn, cs; sincosf(dt * aim, &sn, &cs);
      const float abr = mag * cs, abi = mag * sn;
      const float den = are * are + aim * aim, nre = abr - 1.f;
      const float gre = (nre * are + abi * aim) / den, gim = (abi * are - nre * aim) / den;
      ((float2*)(wl + W_S5A))[i] = make_float2(abr, abi);
      float pr = abr, pi = abi;
#pragma unroll
      for (int q = 0; q < 6; ++q) { const float nr = pr * pr - pi * pi, ni = 2.f * pr * pi; pr = nr; pi = ni; }
      ((float2*)(wl + W_S5A64))[i] = make_float2(pr, pi);
      bf16_t* bb = (bf16_t*)(wl + W_S5BB);
      for (int ch = 0; ch < 16; ++ch) {
        const float br = p.in[20][((size_t)l * 1024 + i) * 16 + ch], bi = p.in[21][((size_t)l * 1024 + i) * 16 + ch];
        const float vr = gre * br - gim * bi, vi = gre * bi + gim * br;
        const int sb = sidx >> 5, r = sidx & 31;
        bb[((g * 4 + sb * 2 + 0) * 32 + r) * 16 + ch] = f2bf(vr);
        bb[((g * 4 + sb * 2 + 1) * 32 + r) * 16 + ch] = f2bf(vi);
      }
    }
    for (size_t i = gtid; i < 32 * 1024; i += gn) {
      const int n = (int)(i >> 10), k = (int)(i & 1023);
      float w = 0.f;
      if (n < 20) w = p.in[37][l * D + k] * ((n < 4) ? p.in[38][((size_t)l * D + k) * 4 + n] : p.in[40][((size_t)l * D + k) * 16 + (n - 4)]);
      const bf16_t hi = f2bf(w);
      ((bf16_t*)(wl + W_RTH))[i] = hi; ((bf16_t*)(wl + W_RTL))[i] = f2bf(w - bf2f(hi));
    }
    for (size_t i = gtid; i < 16 * 16 * 64; i += gn) {
      const int g = (int)(i >> 10), ch = (int)((i >> 6) & 15), pp = (int)(i & 63);
      const float cr = p.in[22][(size_t)l * 16384 + i], ci = p.in[23][(size_t)l * 16384 + i];
      bf16_t* cm = (bf16_t*)(wl + W_S5CM) + ((size_t)(g * 16 + ch) * 128 + 2 * pp);
      cm[0] = f2bf(cr); cm[1] = f2bf(-ci);
    }
  }
  {
    const int* positions = (const int*)p.in[1];
    float2* RM = (float2*)(ws + WS_ROPE);
    float2* RN = RM + (size_t)T * 16;
    for (size_t i = gtid; i < (size_t)T * 24; i += gn) {
      const int t = (int)(i / 24), j = (int)(i % 24);
      const int rot = (j < 16) ? 32 : 16, fi = (j < 16) ? j : (j - 16);
      const float inv = powf(500000.f, -(2.f * (float)fi) / (float)rot);
      float sn, cs; sincosf((float)positions[t] * inv, &sn, &cs);
      if (j < 16) RM[(size_t)t * 16 + fi] = make_float2(cs, sn); else RN[(size_t)t * 8 + fi] = make_float2(cs, sn);
    }
  }
  rmsnorm_rows(p.in[0], p.in[2], (bf16_t*)(ws + WS_A));
}

DEVI void phase_g1(const Params& p, int l, unsigned char* lds) {
  const bf16_t* XN = (const bf16_t*)(p.ws + WS_A);
  const bf16_t* W = (const bf16_t*)(p.ws + WS_W + l * WS_WL + W_IN);
  bf16_t* PROJ = (bf16_t*)(p.ws + WS_B);
  constexpr int NT = DINP / 128;
  int par = 0; bool staged = false;
  for (int it = vblock(); it < (T / 128) * NT; it += gridDim.x) {
    const int mt = it / NT, nt = it % NT;
    const int itn = it + (int)gridDim.x; const bool hn = itn < (T / 128) * NT; const int mtn = itn / NT, ntn = itn % NT;
    f32x4 acc[4][4];
    gemm128p(lds, D, [&](int r, int k) { return XN + (size_t)(mt * 128 + r) * D + k; }, [&](int r, int k) { return W + (size_t)(nt * 128 + r) * D + k; }, acc, par, staged, hn,
             [&](int r, int k) { return XN + (size_t)(mtn * 128 + r) * D + k; }, [&](int r, int k) { return W + (size_t)(ntn * 128 + r) * D + k; });
    staged = hn;
    if (nt >= 9 && nt <= 11) {
      const int tid = threadIdx.x, wid = tid >> 6, lane = tid & 63, wr = wid >> 1, wc = wid & 1, fr = lane & 15, fq = lane >> 4;
      const float* gg = (nt < 11) ? (p.in[27] + l * 64) : (p.in[28] + l * 192 + (wc ? 128 : 64));
      const float sc = (nt < 11) ? (0.125f * LOG2E) : 1.f;
      const float2* RN = (const float2*)(p.ws + WS_ROPE) + (size_t)T * 16;
#pragma unroll
      for (int m = 0; m < 4; ++m) {
        const size_t t = (size_t)mt * 128 + wr * 64 + m * 16 + fr;
        float ss = 0.f;
#pragma unroll
        for (int n = 0; n < 4; ++n) ss += acc[m][n][0] * acc[m][n][0] + acc[m][n][1] * acc[m][n][1] + acc[m][n][2] * acc[m][n][2] + acc[m][n][3] * acc[m][n][3];
        ss += __shfl_xor(ss, 16); ss += __shfl_xor(ss, 32);
        const float rs = rsqrtf(ss * (1.f / 64) + EPS);
#pragma unroll
        for (int n = 0; n < 4; ++n) {
          const float4 g4 = *(const float4*)(gg + n * 16 + fq * 4);
          f32x4 v = acc[m][n];
          v[0] *= rs * g4.x; v[1] *= rs * g4.y; v[2] *= rs * g4.z; v[3] *= rs * g4.w;
          if (n == 0) {
#pragma unroll
            for (int j = 0; j < 4; ++j) {
              const float x = v[j], partner = __shfl_xor(x, 32);
              const int d = fq * 4 + j; const float2 cs2 = RN[t * 8 + (d & 7)];
              v[j] = (d < 8) ? (x * cs2.x - partner * cs2.y) : (partner * cs2.y + x * cs2.x);
            }
          }
          st_bf16x4(PROJ + t * DINP + nt * 128 + wc * 64 + n * 16 + fq * 4, v * sc);
        }
      }
    } else {
      GEMM_EPI4({ st_bf16x4(PROJ + (size_t)(mt * 128 + er) * DINP + nt * 128 + ec0, ev4); })
      if (nt == 2) {
        const int tid = threadIdx.x, wid = tid >> 6, lane = tid & 63, wr = wid >> 1, wc = wid & 1, fr = lane & 15, fq = lane >> 4;
        float* SSKV = (float*)(p.ws + SM_SSKV);
#pragma unroll
        for (int m = 0; m < 4; ++m) {
          float ss = 0.f;
#pragma unroll
          for (int n = 0; n < 4; ++n) ss += acc[m][n][0] * acc[m][n][0] + acc[m][n][1] * acc[m][n][1] + acc[m][n][2] * acc[m][n][2] + acc[m][n][3] * acc[m][n][3];
          ss += __shfl_xor(ss, 16); ss += __shfl_xor(ss, 32);
          if (fq == 0) SSKV[(size_t)(mt * 128 + wr * 64 + m * 16 + fr) * 2 + wc] = ss;
        }
      }
    }
  }
}

DEVI void phase_g2(const Params& p, int l, unsigned char* lds) {
  unsigned char* wl = p.ws + WS_W + l * WS_WL;
  const bf16_t* PROJ = (const bf16_t*)(p.ws + WS_B);
  bf16_t* QR = (bf16_t*)(p.ws + WS_D);
  bf16_t* KVR = QR + (size_t)T * 384;
  bf16_t* GATES = (bf16_t*)(p.ws + WS_E);
  bf16_t* MK = (bf16_t*)(p.ws + WS_F) + (size_t)T * 4 * 96;
  const float2* RM = (const float2*)(p.ws + WS_ROPE);
  constexpr int N_CMP = 64, N_QR = 256 * 3, N_KVR = 256 * 4, N_GT = 256 * 4;
  const int tid = threadIdx.x, wid = tid >> 6, lane = tid & 63, wr = wid >> 1, wc = wid & 1, fr = lane & 15, fq = lane >> 4;
  for (int it = vblock(); it < N_CMP + N_QR + N_KVR + N_GT; it += gridDim.x) {
    f32x4 acc[4][4];
    if (it < N_CMP) {
      const int kv = it & 1, half = (it >> 1) & 1, mt = it >> 2;
      const bf16_t* W = (const bf16_t*)(wl + (kv ? W_1V : W_1K)) + (size_t)half * 64 * 2048;
      const float* bias = (const float*)(wl + (kv ? W_B1V : W_B1K)) + half * 64;
      bf16_t* H = (bf16_t*)(p.ws + (kv ? SM_HV : SM_HK)) + half * 64;
      f32x4 acc2[2][4];
      gemm128h(lds, 2048,
              [&](int r, int k) { const int m = mt * 128 + r, b = m >> 7; int c = m & 127; if (c > 126) c = 126;
                                  return PROJ + (size_t)(b * S + 16 * c + (k >> 6)) * DINP + C_KC + kv * 64 + (k & 63); },
              [&](int r, int k) { return W + (size_t)r * 2048 + k; }, acc2);
#pragma unroll
      for (int m = 0; m < 2; ++m)
#pragma unroll
        for (int n = 0; n < 4; ++n) {
          const float4 b4 = *(const float4*)(bias + n * 16 + fq * 4);
          f32x4 o; o[0] = gelu_tanh(acc2[m][n][0] + b4.x); o[1] = gelu_tanh(acc2[m][n][1] + b4.y); o[2] = gelu_tanh(acc2[m][n][2] + b4.z); o[3] = gelu_tanh(acc2[m][n][3] + b4.w);
          st_bf16x4(H + (size_t)(mt * 128 + wid * 32 + m * 16 + fr) * 128 + n * 16 + fq * 4, o);
        }
    } else if (it < N_CMP + N_QR) {
      const int i2 = it - N_CMP, mt = i2 / 3, nt = i2 % 3;
      const bf16_t* W = (const bf16_t*)(wl + W_UQ);
      gemm128g(lds, 192, [&](int r, int k) { return PROJ + (size_t)(mt * 128 + r) * DINP + C_CQ + k; }, [&](int r, int k) { return W + (size_t)(nt * 128 + r) * 192 + k; }, acc);
      GEMM_EPI4({ st_bf16x4(QR + (size_t)(mt * 128 + er) * 384 + nt * 128 + ec0, ev4); })
    } else if (it < N_CMP + N_QR + N_KVR) {
      const int i2 = it - N_CMP - N_QR, mt = i2 >> 2, hd = i2 & 3;
      const bf16_t* W = (const bf16_t*)(wl + W_UKV);
      gemm128g(lds, 128, [&](int r, int k) { return PROJ + (size_t)(mt * 128 + r) * DINP + C_CKV + k; }, [&](int r, int k) { return W + (size_t)(hd * 128 + r) * 128 + k; }, acc);
      const float* g_k = p.in[9] + l * 96;
#pragma unroll
      for (int m = 0; m < 4; ++m) {
        const size_t t = (size_t)mt * 128 + wr * 64 + m * 16 + fr;
        const int b = (int)(t >> 11), sq = (int)(t & (S - 1));
        const float2 ssp = *(const float2*)((const float*)(p.ws + SM_SSKV) + t * 2);
        const float ss = ssp.x + ssp.y;
        const float rskv = rsqrtf(ss * (1.f / 128) + EPS);
        if (wc == 1) {
#pragma unroll
          for (int n = 0; n < 4; ++n) st_bf16x4(KVR + t * 512 + hd * 128 + 64 + n * 16 + fq * 4, acc[m][n] * rskv);
        } else {
          const uint2 plo = *(const uint2*)(PROJ + t * DINP + C_KPE + 4 * fq), phi = *(const uint2*)(PROJ + t * DINP + C_KPE + 16 + 4 * fq);
          float pl[4] = {__uint_as_float(plo.x << 16), __uint_as_float(plo.x & 0xffff0000u), __uint_as_float(plo.y << 16), __uint_as_float(plo.y & 0xffff0000u)};
          float ph[4] = {__uint_as_float(phi.x << 16), __uint_as_float(phi.x & 0xffff0000u), __uint_as_float(phi.y << 16), __uint_as_float(phi.y & 0xffff0000u)};
          float sk = 0.f;
#pragma unroll
          for (int j = 0; j < 4; ++j) sk += pl[j] * pl[j] + ph[j] * ph[j];
          f32x4 kn[4];
#pragma unroll
          for (int n = 0; n < 4; ++n) { kn[n] = acc[m][n] * rskv; sk += kn[n][0] * kn[n][0] + kn[n][1] * kn[n][1] + kn[n][2] * kn[n][2] + kn[n][3] * kn[n][3]; }
          sk += __shfl_xor(sk, 16); sk += __shfl_xor(sk, 32);
          const float rsk = rsqrtf(sk * (1.f / 96) + EPS);
          bf16_t* dst = MK + ((size_t)(b * 4 + hd) * S + sq) * 96;
          f32x4 olo, ohi;
#pragma unroll
          for (int j = 0; j < 4; ++j) {
            const int d = 4 * fq + j; const float2 cs2 = RM[t * 16 + d];
            const float x1 = pl[j] * rsk * g_k[d], x2 = ph[j] * rsk * g_k[16 + d];
            olo[j] = x1 * cs2.x - x2 * cs2.y; ohi[j] = x1 * cs2.y + x2 * cs2.x;
          }
          st_bf16x4(dst + 4 * fq, olo); st_bf16x4(dst + 16 + 4 * fq, ohi);
#pragma unroll
          for (int n = 0; n < 4; ++n) { const float4 g4 = *(const float4*)(g_k + 32 + n * 16 + fq * 4); f32x4 o = kn[n] * rsk; o[0] *= g4.x; o[1] *= g4.y; o[2] *= g4.z; o[3] *= g4.w; st_bf16x4(dst + 32 + n * 16 + fq * 4, o); }
        }
      }
    } else {
      const int i2 = it - N_CMP - N_QR - N_KVR, mt = i2 >> 2, h = i2 & 3;
      const bf16_t* W = (const bf16_t*)(wl + W_LRU) + h * 128 * 64;
      const int c0 = h * 64 + (tid & 7) * 8;
      const float* cw = p.in[10] + l * 4 * 256 + c0; const float* cbp = p.in[11] + l * 256 + c0;
      gemm128(lds, 64,
              [&](int r, int k) {
                const size_t t = (size_t)mt * 128 + r; const int sq = (int)(t & (S - 1));
                float u[8];
#pragma unroll
                for (int e = 0; e < 8; ++e) u[e] = cbp[e];
#pragma unroll
                for (int j = 0; j < 4; ++j) {
                  if (sq - 3 + j >= 0) {
                    const u32x4 w = *(const u32x4*)(PROJ + (t - 3 + j) * DINP + C_LX + h * 64 + k);
#pragma unroll
                    for (int e = 0; e < 4; ++e) { u[2 * e] += __uint_as_float(w[e] << 16) * cw[j * 256 + 2 * e]; u[2 * e + 1] += __uint_as_float(w[e] & 0xffff0000u) * cw[j * 256 + 2 * e + 1]; }
                  }
                }
                u32x4 o; o[0] = pk2bf(u[0], u[1]); o[1] = pk2bf(u[2], u[3]); o[2] = pk2bf(u[4], u[5]); o[3] = pk2bf(u[6], u[7]);
                return o; },
              [&](int r, int k) { return W + (size_t)r * 64 + k; }, acc);
      GEMM_EPI4({ st_bf16x4(GATES + (size_t)(mt * 128 + er) * 512 + h * 128 + ec0, ev4); })
    }
  }
}

DEVI void lru_ab(float u, float rpre, float ipre, float sp, bool first, float& a, float& b) {
  const float r = sigmoidf_(rpre), gi = sigmoidf_(ipre);
  const float la = -8.f * r * sp;
  a = __expf(la);
  const float x = 2.f * la;
  const float om = (x > -0.1f) ? (-x * (1.f + 0.5f * x * (1.f + (1.f / 3.f) * x * (1.f + 0.25f * x * (1.f + 0.2f * x))))) : (1.f - a * a);
  const float mult = first ? 1.f : sqrtf(fmaxf(om, 0.f));
  b = mult * gi * u;
}
DEVI float lru_conv(const bf16_t* PROJ, int t, int s, int c, const float* cw, float cb) {
  float u = cb;
#pragma unroll
  for (int j = 0; j < 4; ++j) { const int ss2 = s - 3 + j; if (ss2 >= 0) u += bf2f(PROJ[(size_t)(t - 3 + j) * DINP + C_LX + c]) * cw[j * 256 + c]; }
  return u;
}

template <bool FULL>
DEVI void s5_chunk(const Params& p, int l, int b, int chunk, unsigned char* lds) {
  unsigned char* wl = p.ws + WS_W + l * WS_WL;
  const bf16_t* PROJ = (const bf16_t*)(p.ws + WS_B);
  const float2* Abar = (const float2*)(wl + W_S5A);
  const bf16_t* BB = (const bf16_t*)(wl + W_S5BB);
  const bf16_t* CM = (const bf16_t*)(wl + W_S5CM);
  float2* SLOC = (float2*)(p.ws + SM_SLOC);
  bf16_t* YCP = (bf16_t*)(p.ws + WS_F);
  const float* dd = p.in[24] + l * 256;
  const int tid = threadIdx.x, wv = tid >> 6, lane = tid & 63, r = lane & 31, h = lane >> 5, fr = lane & 15, fq = lane >> 4;
  unsigned* Hs = (unsigned*)(lds + wv * 8704);
  const int t0 = b * S + chunk * 64;
#pragma unroll 1
  for (int gi = 0; gi < 4; ++gi) {
    const int g = wv * 4 + gi;
    bf16x8 bbf[4];
#pragma unroll
    for (int nb = 0; nb < 4; ++nb) bbf[nb] = *(const bf16x8*)(BB + ((g * 4 + nb) * 32 + r) * 16 + 8 * h);
    float2 Ac[2]; float hr[2], hi[2];
#pragma unroll
    for (int sb = 0; sb < 2; ++sb) {
      Ac[sb] = Abar[g * 64 + sb * 32 + r];
      hr[sb] = 0.f; hi[sb] = 0.f;
      if (FULL) { const float2 cin = ((const float2*)(p.ws + SM_SCAR))[((size_t)(b * 32 + chunk) * 16 + g) * 64 + sb * 32 + r]; hr[sb] = cin.x; hi[sb] = cin.y; }
    }
    bf16x8 cm[4];
    float4 dcol4 = make_float4(0.f, 0.f, 0.f, 0.f);
    if (FULL) {
#pragma unroll
      for (int kk = 0; kk < 4; ++kk) cm[kk] = *(const bf16x8*)(CM + (size_t)(g * 16 + fr) * 128 + kk * 32 + 8 * fq);
      dcol4 = *(const float4*)(dd + g * 16 + 4 * fq);
    }
#pragma unroll 1
    for (int tb = 0; tb < 2; ++tb) {
      const bf16x8 ua = *(const bf16x8*)(PROJ + (size_t)(t0 + tb * 32 + r) * DINP + C_S5 + g * 16 + 8 * h);
      f32x16 acc[4];
#pragma unroll
      for (int nb = 0; nb < 4; ++nb) {
        f32x16 z;
#pragma unroll
        for (int i = 0; i < 16; ++i) z[i] = 0.f;
        acc[nb] = mfma32(ua, bbf[nb], z);
      }
#pragma unroll
      for (int sb = 0; sb < 2; ++sb) {
        float sr = hr[sb], si = hi[sb];
        const float ax = Ac[sb].x, ay = Ac[sb].y;
#pragma unroll
        for (int q = 0; q < 4; ++q)
#pragma unroll
          for (int owner = 0; owner < 2; ++owner) {
#pragma unroll
            for (int i = 0; i < 4; ++i) {
              const int reg = 4 * q + i;
              const float br = acc[2 * sb][reg], bi = acc[2 * sb + 1][reg];
              const float nr = ax * sr - ay * si + br, ni = ax * si + ay * sr + bi; sr = nr; si = ni;
              if (FULL) { acc[2 * sb][reg] = (h == owner) ? sr : br; acc[2 * sb + 1][reg] = (h == owner) ? si : bi; }
            }
            const float orr = __shfl_xor(sr, 32), oi = __shfl_xor(si, 32);
            if (h != owner) { sr = orr; si = oi; }
          }
        hr[sb] = sr; hi[sb] = si;
      }
      if (FULL) {
#pragma unroll
        for (int sb = 0; sb < 2; ++sb)
#pragma unroll
          for (int reg = 0; reg < 16; ++reg)
            Hs[crow(reg, h) * 68 + sb * 32 + r] = pk2bf(acc[2 * sb][reg], acc[2 * sb + 1][reg]);
#pragma unroll
        for (int tb16 = 0; tb16 < 2; ++tb16) {
          f32x4 y = (f32x4){0.f, 0.f, 0.f, 0.f};
#pragma unroll
          for (int kk = 0; kk < 4; ++kk) { const bf16x8 a = *(const bf16x8*)((const bf16_t*)Hs + (tb16 * 16 + fr) * 136 + kk * 32 + 8 * fq); y = mfma16(cm[kk], a, y); }
          const size_t t = (size_t)t0 + tb * 32 + tb16 * 16 + fr; const int col = g * 16 + 4 * fq;
          const uint2 uw = *(const uint2*)(PROJ + t * DINP + C_S5 + col);
          f32x4 o;
          o[0] = gelu_tanh(y[0] + dcol4.x * __uint_as_float(uw.x << 16)); o[1] = gelu_tanh(y[1] + dcol4.y * __uint_as_float(uw.x & 0xffff0000u));
          o[2] = gelu_tanh(y[2] + dcol4.z * __uint_as_float(uw.y << 16)); o[3] = gelu_tanh(y[3] + dcol4.w * __uint_as_float(uw.y & 0xffff0000u));
          st_bf16x4(YCP + t * 256 + col, o);
        }
      }
    }
    if (!FULL) {
#pragma unroll
      for (int sb = 0; sb < 2; ++sb) if (h == 0) SLOC[((size_t)(b * 32 + chunk) * 16 + g) * 64 + sb * 32 + r] = make_float2(hr[sb], hi[sb]);
    }
  }
}

template <bool FULL>
DEVI void lru_chunk(const Params& p, int l, int b, int chunk, float* tile) {
  const bf16_t* PROJ = (const bf16_t*)(p.ws + WS_B);
  const bf16_t* GATES = (const bf16_t*)(p.ws + WS_E);
  float2* LSUM = (float2*)(p.ws + SM_LSUM);
  const int c = threadIdx.x, h = c >> 6, j = c & 63;
  const float* cw = p.in[10] + l * 4 * 256;
  const float w0 = cw[c], w1 = cw[256 + c], w2 = cw[512 + c], w3 = cw[768 + c], cb = p.in[11][l * 256 + c];
  const float ba = p.in[13][l * 256 + c], bi = p.in[15][l * 256 + c];
  const float sp = log1pf(expf(-p.in[16][l * 256 + c]));
  const int s0 = chunk * 64; const size_t t0 = (size_t)b * S + s0;
  float xm3 = 0.f, xm2 = 0.f, xm1 = 0.f;
  if (s0 > 0) { xm3 = bf2f(PROJ[(t0 - 3) * DINP + C_LX + c]); xm2 = bf2f(PROJ[(t0 - 2) * DINP + C_LX + c]); xm1 = bf2f(PROJ[(t0 - 1) * DINP + C_LX + c]); }
  float hh = 0.f, ap = 1.f;
  if (FULL) hh = ((const float*)(p.ws + SM_LCAR))[(size_t)(b * 32 + chunk) * 256 + c];
#pragma unroll 1
  for (int k0 = 0; k0 < 64; k0 += 8) {
    float xv[8], rp[8], ip[8], gt[8];
#pragma unroll
    for (int i = 0; i < 8; ++i) {
      const size_t t = t0 + k0 + i;
      xv[i] = bf2f(PROJ[t * DINP + C_LX + c]);
      rp[i] = bf2f(GATES[t * 512 + h * 128 + j]); ip[i] = bf2f(GATES[t * 512 + h * 128 + 64 + j]);
      gt[i] = FULL ? bf2f(PROJ[t * DINP + C_LG + c]) : 0.f;
    }
#pragma unroll
    for (int i = 0; i < 8; ++i) {
      const float u = cb + xm3 * w0 + xm2 * w1 + xm1 * w2 + xv[i] * w3;
      xm3 = xm2; xm2 = xm1; xm1 = xv[i];
      float a, bb; lru_ab(u, rp[i] + ba, ip[i] + bi, sp, (s0 + k0 + i) == 0, a, bb);
      hh = a * hh + bb; ap *= a;
      if (FULL) tile[(k0 + i) * 256 + c] = hh * gelu_tanh(gt[i]);
    }
  }
  if (!FULL) LSUM[(size_t)(b * 32 + chunk) * 256 + c] = make_float2(ap, hh);
}

DEVI void phase_r2(const Params& p, int l, unsigned char* lds) {
  unsigned char* wl = p.ws + WS_W + l * WS_WL;
  const bf16_t* PROJ = (const bf16_t*)(p.ws + WS_B);
  const bf16_t* QR = (const bf16_t*)(p.ws + WS_D);
  const bf16_t* KVR = QR + (size_t)T * 384;
  const bf16_t* GATES = (const bf16_t*)(p.ws + WS_E);
  bf16_t* MQ = (bf16_t*)(p.ws + WS_F);
  bf16_t* MK = MQ + (size_t)T * 4 * 96;
  const float2* RM = (const float2*)(p.ws + WS_ROPE);
  const float2* RN = RM + (size_t)T * 16;
  const int tid = threadIdx.x, lane = tid & 63, wv = tid >> 6;
  for (int it = blockIdx.x; it < NB * 32; it += gridDim.x) lru_chunk<false>(p, l, it >> 5, it & 31, nullptr);
  __syncthreads();
  for (int it = blockIdx.x; it < NB * 32; it += gridDim.x) s5_chunk<false>(p, l, it >> 5, it & 31, lds);
  {
    const bf16_t* HK = (const bf16_t*)(p.ws + SM_HK); const bf16_t* HV = (const bf16_t*)(p.ws + SM_HV);
    bf16_t* KC = (bf16_t*)(p.ws + SM_KC); bf16_t* VC = (bf16_t*)(p.ws + SM_VC);
    const bf16_t* W2K = (const bf16_t*)(wl + W_2K); const bf16_t* W2V = (const bf16_t*)(wl + W_2V);
    const float* g0 = p.in[28] + l * 192;
    for (int it = blockIdx.x; it < 32; it += gridDim.x) {
      const int kv = it & 1, mt = it >> 1;
      const bf16_t* H = kv ? HV : HK; const bf16_t* W2 = kv ? W2V : W2K;
      f32x4 acc[4][4];
      __syncthreads();
      gemm128g(lds, 128, [&](int r, int k) { return H + (size_t)(mt * 128 + r) * 128 + k; }, [&](int r, int k) { return W2 + (size_t)(r & 63) * 128 + k; }, acc);
      const int wid = tid >> 6, wr = wid >> 1, wc = wid & 1, fr = lane & 15, fq = lane >> 4;
      if (wc == 0) {
#pragma unroll
        for (int m = 0; m < 4; ++m) {
          const int row = mt * 128 + wr * 64 + m * 16 + fr, b = row >> 7, c = row & 127;
          f32x4 v[4];
#pragma unroll
          for (int n = 0; n < 4; ++n) v[n] = acc[m][n];
          if (kv == 0) {
            float ss = 0.f;
#pragma unroll
            for (int n = 0; n < 4; ++n) ss += v[n][0] * v[n][0] + v[n][1] * v[n][1] + v[n][2] * v[n][2] + v[n][3] * v[n][3];
            ss += __shfl_xor(ss, 16); ss += __shfl_xor(ss, 32);
            const float rs = rsqrtf(ss * (1.f / 64) + EPS);
#pragma unroll
            for (int n = 0; n < 4; ++n) { const float4 gg = *(const float4*)(g0 + n * 16 + fq * 4); v[n][0] *= rs * gg.x; v[n][1] *= rs * gg.y; v[n][2] *= rs * gg.z; v[n][3] *= rs * gg.w; }
            const int cc = (c < 127) ? c : 126;
            const float2* cs = RN + (size_t)(b * S + 16 * cc + 31) * 8;
#pragma unroll
            for (int j = 0; j < 4; ++j) {
              const float x = v[0][j], partner = __shfl_xor(x, 32);
              const int d = fq * 4 + j; const float2 cs2 = cs[d & 7];
              v[0][j] = (d < 8) ? (x * cs2.x - partner * cs2.y) : (partner * cs2.y + x * cs2.x);
            }
          }
          bf16_t* dst = (kv ? VC : KC) + (size_t)row * 64;
#pragma unroll
          for (int n = 0; n < 4; ++n) { f32x4 o = v[n]; if (c >= 127) o = (f32x4){0.f, 0.f, 0.f, 0.f}; st_bf16x4(dst + n * 16 + fq * 4, o); }
        }
      }
    }
  }
}

typedef short v4i16_t __attribute__((ext_vector_type(4)));
DEVI float fexp2(float x) { return __builtin_amdgcn_exp2f(x); }
constexpr int VST = 96;
constexpr int ATT_VBYTES = 64 * VST * 2;
template <int DK> constexpr int att_kbytes() { return 64 * (DK + 8) * 2; }
template <int DK> constexpr int att_buf() { return att_kbytes<DK>() + ATT_VBYTES; }
template <int DK> struct TileRegs { u32x4 k[DK / 32]; u32x4 v[2]; };
template <int DK>
DEVI void tile_load(TileRegs<DK>& tr, const bf16_t* kbase, size_t kstride, const bf16_t* vbase, size_t vstride, int key0, bool withv = true) {
  constexpr int CH = DK / 8;
#pragma unroll
  for (int i = 0; i < DK / 32; ++i) { const int c = threadIdx.x + 256 * i, r = c / CH, cc = c % CH; tr.k[i] = *(const u32x4*)(kbase + (size_t)(key0 + r) * kstride + cc * 8); }
  if (withv) {
#pragma unroll
    for (int i = 0; i < 2; ++i) { const int c = threadIdx.x + 256 * i, r = c >> 3, cc = c & 7; tr.v[i] = *(const u32x4*)(vbase + (size_t)(key0 + r) * vstride + cc * 8); }
  }
}
template <int DK>
DEVI void tile_store(const TileRegs<DK>& tr, unsigned char* buf, bool withv = true) {
  constexpr int CH = DK / 8;
  bf16_t* sK = (bf16_t*)buf; bf16_t* sV = (bf16_t*)(buf + att_kbytes<DK>());
#pragma unroll
  for (int i = 0; i < DK / 32; ++i) { const int c = threadIdx.x + 256 * i, r = c / CH, cc = c % CH; *(u32x4*)(sK + r * (DK + 8) + cc * 8) = tr.k[i]; }
  if (withv) {
#pragma unroll
    for (int i = 0; i < 2; ++i) { const int c = threadIdx.x + 256 * i, r = c >> 3, cc = c & 7; *(u32x4*)(sV + r * VST + cc * 8) = tr.v[i]; }
  }
}
template <int DK>
DEVI void qk_tile(const bf16_t* sK, const bf16x8* qf, f32x16& s0, f32x16& s1, int r, int h) {
#pragma unroll
  for (int i = 0; i < 16; ++i) { s0[i] = 0.f; s1[i] = 0.f; }
#pragma unroll
  for (int kk = 0; kk < DK / 16; ++kk) {
    const bf16x8 a0 = *(const bf16x8*)(sK + r * (DK + 8) + kk * 16 + h * 8);
    const bf16x8 a1 = *(const bf16x8*)(sK + (32 + r) * (DK + 8) + kk * 16 + h * 8);
    s0 = mfma32(a0, qf[kk], s0);
    s1 = mfma32(a1, qf[kk], s1);
  }
}
struct FState { f32x16 o0, o1; float m, l; };
DEVI void fstate_init(FState& f) {
#pragma unroll
  for (int i = 0; i < 16; ++i) { f.o0[i] = 0.f; f.o1[i] = 0.f; }
  f.m = -INFINITY; f.l = 0.f;
}
DEVI v4i16_t vtr(const bf16_t* p) { return __builtin_amdgcn_ds_read_tr16_b64_v4i16((LAS v4i16_t*)p); }
DEVI void softmax_pv(FState& f, f32x16& s0, f32x16& s1, const bf16_t* sV, int lane) {
  const int h = lane >> 5;
  float mx = -INFINITY;
#pragma unroll
  for (int i = 0; i < 16; ++i) mx = fmaxf(mx, fmaxf(s0[i], s1[i]));
  mx = fmaxf(mx, __shfl_xor(mx, 32));
  const float mnew = fmaxf(f.m, mx);
  const float muse = (mnew == -INFINITY) ? 0.f : mnew;
  float ps = 0.f;
#pragma unroll
  for (int i = 0; i < 16; ++i) { s0[i] = fexp2(s0[i] - muse); s1[i] = fexp2(s1[i] - muse); ps += s0[i] + s1[i]; }
  ps += __shfl_xor(ps, 32);
  if (__any(mnew != f.m)) {
    const float alpha = fexp2(f.m - muse);
    f.l = f.l * alpha + ps; f.m = mnew;
#pragma unroll
    for (int i = 0; i < 16; ++i) { f.o0[i] *= alpha; f.o1[i] *= alpha; }
  } else {
    f.l += ps;
  }
  const int g = lane >> 4, li = lane & 15, q = li >> 2, pp = li & 3;
  const bf16_t* vb = sV + (4 * h + q) * VST + (g & 1) * 16 + 4 * pp;
#pragma unroll
  for (int kb = 0; kb < 2; ++kb)
#pragma unroll
    for (int s = 0; s < 2; ++s) {
      unsigned pw[4];
#pragma unroll
      for (int j = 0; j < 4; ++j) pw[j] = kb ? pk2bf(s1[8 * s + 2 * j], s1[8 * s + 2 * j + 1]) : pk2bf(s0[8 * s + 2 * j], s0[8 * s + 2 * j + 1]);
      const bf16x8 pb = __builtin_bit_cast(bf16x8, (u32x4){pw[0], pw[1], pw[2], pw[3]});
#pragma unroll
      for (int db = 0; db < 2; ++db) {
        const v4i16_t lo = vtr(vb + (kb * 32 + 16 * s) * VST + db * 32);
        const v4i16_t hi = vtr(vb + (kb * 32 + 16 * s + 8) * VST + db * 32);
        const bf16x8 a = {lo[0], lo[1], lo[2], lo[3], hi[0], hi[1], hi[2], hi[3]};
        if (db == 0) f.o0 = mfma32(a, pb, f.o0); else f.o1 = mfma32(a, pb, f.o1);
      }
    }
}
DEVI void store_o(bf16_t* orow, const f32x16& o0, const f32x16& o1, float sc, int h) {
#pragma unroll
  for (int g = 0; g < 4; ++g) {
    uint2 v0, v1;
    v0.x = pk2bf(o0[4 * g] * sc, o0[4 * g + 1] * sc); v0.y = pk2bf(o0[4 * g + 2] * sc, o0[4 * g + 3] * sc);
    v1.x = pk2bf(o1[4 * g] * sc, o1[4 * g + 1] * sc); v1.y = pk2bf(o1[4 * g + 2] * sc, o1[4 * g + 3] * sc);
    *(uint2*)(orow + 8 * g + 4 * h) = v0;
    *(uint2*)(orow + 32 + 8 * g + 4 * h) = v1;
  }
}

DEVI void mla_item(const Params& p, int l, int b, int hd, int qt, unsigned char* lds) {
  const bf16_t* MQ = (const bf16_t*)(p.ws + WS_F);
  const bf16_t* MK = MQ + (size_t)T * 4 * 96;
  const bf16_t* KVR = (const bf16_t*)(p.ws + WS_D) + (size_t)T * 384;
  bf16_t* YA = (bf16_t*)(p.ws + WS_C);
  const int tid = threadIdx.x, wv = tid >> 6, lane = tid & 63, r = lane & 31, h = lane >> 5;
  const int q0 = qt * 128 + wv * 32, tq = q0 + r;
  bf16x8 qf[6];
  {
    const bf16_t* qrow = (const bf16_t*)(p.ws + WS_D) + ((size_t)b * S + tq) * 384 + hd * 96;
    const float* g_q = p.in[8] + l * 96;
    float qv[6][8]; float ss = 0.f;
#pragma unroll
    for (int kk = 0; kk < 6; ++kk) {
      const u32x4 w = *(const u32x4*)(qrow + kk * 16 + h * 8);
#pragma unroll
      for (int e = 0; e < 4; ++e) { qv[kk][2 * e] = __uint_as_float(w[e] << 16); qv[kk][2 * e + 1] = __uint_as_float(w[e] & 0xffff0000u); ss += qv[kk][2 * e] * qv[kk][2 * e] + qv[kk][2 * e + 1] * qv[kk][2 * e + 1]; }
    }
    ss += __shfl_xor(ss, 32);
    const float rs = rsqrtf(ss * (1.f / 96) + EPS) * (0.10206207261596575f * LOG2E);
#pragma unroll
    for (int kk = 0; kk < 6; ++kk)
#pragma unroll
      for (int j = 0; j < 8; ++j) qv[kk][j] *= rs * g_q[kk * 16 + h * 8 + j];
    const float2* cs = (const float2*)(p.ws + WS_ROPE) + ((size_t)b * S + tq) * 16 + 8 * h;
#pragma unroll
    for (int j = 0; j < 8; ++j) { const float2 c2 = cs[j]; const float x1 = qv[0][j], x2 = qv[1][j]; qv[0][j] = x1 * c2.x - x2 * c2.y; qv[1][j] = x1 * c2.y + x2 * c2.x; }
#pragma unroll
    for (int kk = 0; kk < 6; ++kk) { const u32x4 w = {pk2bf(qv[kk][0], qv[kk][1]), pk2bf(qv[kk][2], qv[kk][3]), pk2bf(qv[kk][4], qv[kk][5]), pk2bf(qv[kk][6], qv[kk][7])}; qf[kk] = __builtin_bit_cast(bf16x8, w); }
  }
  FState f; fstate_init(f);
  const bf16_t* kbase = MK + (size_t)(b * 4 + hd) * S * 96;
  const bf16_t* vbase = KVR + (size_t)b * S * 512 + hd * 128 + 64;
  const int ntiles = 2 * qt + 2;
  TileRegs<96> tr;
  TileRegs<96> tr2;
  tile_load<96>(tr, kbase, 96, vbase, 512, 0);
  tile_load<96>(tr2, kbase, 96, vbase, 512, 64);
  __syncthreads();
  tile_store<96>(tr, lds);
  __syncthreads();
  auto compute = [&](int kt, unsigned char* cur) {
    if (kt * 64 <= q0 + 31) {
      f32x16 s0, s1;
      qk_tile<96>((const bf16_t*)cur, qf, s0, s1, r, h);
      if (kt * 64 + 63 > q0) {
        int rel = tq - kt * 64 - 4 * h; asm volatile("" : "+v"(rel));
#pragma unroll
        for (int i = 0; i < 16; ++i) { const int kk2 = (i & 3) + 8 * (i >> 2); if (kk2 > rel) s0[i] = -INFINITY; if (kk2 + 32 > rel) s1[i] = -INFINITY; }
      }
      softmax_pv(f, s0, s1, (const bf16_t*)(cur + att_kbytes<96>()), lane);
    }
  };
#pragma unroll 1
  for (int kt = 0; kt < ntiles; kt += 2) {
    if (kt + 2 < ntiles) tile_load<96>(tr, kbase, 96, vbase, 512, (kt + 2) * 64);
    compute(kt, lds);
    tile_store<96>(tr2, lds + att_buf<96>());
    __syncthreads();
    if (kt + 3 < ntiles) tile_load<96>(tr2, kbase, 96, vbase, 512, (kt + 3) * 64);
    compute(kt + 1, lds + att_buf<96>());
    if (kt + 2 < ntiles) tile_store<96>(tr, lds);
    __syncthreads();
  }
  store_o(YA + (size_t)(b * S + tq) * 256 + hd * 64, f.o0, f.o1, 1.f / f.l, h);
}

template <class KF, class BODY>
DEVI void nsa_stream(unsigned char* lds, const bf16_t* kbase, size_t kstride, const bf16_t* vbase, size_t vstride, bool withv, int nt, KF key0f, BODY body) {
  if (nt <= 0) return;
  TileRegs<64> trA, trB;
  tile_load<64>(trA, kbase, kstride, vbase, vstride, key0f(0), withv);
  if (nt > 1) tile_load<64>(trB, kbase, kstride, vbase, vstride, key0f(1), withv);
  __syncthreads();
  tile_store<64>(trA, lds, withv);
  __syncthreads();
  unsigned char* buf0 = lds; unsigned char* buf1 = lds + att_buf<64>();
#pragma unroll 1
  for (int i = 0; i < nt; i += 2) {
    if (i + 2 < nt) tile_load<64>(trA, kbase, kstride, vbase, vstride, key0f(i + 2), withv);
    body(i, buf0);
    if (i + 1 < nt) tile_store<64>(trB, buf1, withv);
    __syncthreads();
    if (i + 1 >= nt) break;
    if (i + 3 < nt) tile_load<64>(trB, kbase, kstride, vbase, vstride, key0f(i + 3), withv);
    body(i + 1, buf1);
    if (i + 2 < nt) tile_store<64>(trA, buf0, withv);
    __syncthreads();
  }
}
DEVI void nsa_item(const Params& p, int l, int b, int qt, unsigned char* lds) {
  const bf16_t* PROJ = (const bf16_t*)(p.ws + WS_B);
  const bf16_t* KC = (const bf16_t*)(p.ws + SM_KC) + (size_t)b * 128 * 64;
  const bf16_t* VC = (const bf16_t*)(p.ws + SM_VC) + (size_t)b * 128 * 64;
  const int tid = threadIdx.x, wv = tid >> 6, lane = tid & 63, r = lane & 31, h = lane >> 5;
  float* psum = (float*)(lds + 2 * att_buf<64>());
  unsigned* selm = (unsigned*)(lds + 2 * att_buf<64>() + 16384);
  const int t0 = qt * 32, cur = t0 >> 6;
  const int ql = wv * 8 + (r >> 2), hd = r & 3, tq = t0 + ql;
  const size_t tg = (size_t)b * S + tq;
  bf16x8 qf[4];
#pragma unroll
  for (int kk = 0; kk < 4; ++kk) qf[kk] = *(const bf16x8*)(PROJ + tg * DINP + C_NQ + hd * 64 + kk * 16 + h * 8);
  unsigned* ofs = (unsigned*)psum + wv * 1024 + lane;
  const float g0 = sigmoidf_(bf2f(PROJ[tg * DINP + C_NG + hd * 3 + 0]));
  const float g1 = sigmoidf_(bf2f(PROJ[tg * DINP + C_NG + hd * 3 + 1]));
  const float g2 = sigmoidf_(bf2f(PROJ[tg * DINP + C_NG + hd * 3 + 2]));
  FState f; fstate_init(f);
  const int ncmp = (t0 + 31 < 31) ? 0 : (((t0 >> 4) >> 6) + 1);
  nsa_stream(lds, KC, 64, VC, 64, true, ncmp, [&](int i) { return i * 64; }, [&](int kt, unsigned char* buf) {
    f32x16 s0, s1;
    qk_tile<64>((const bf16_t*)buf, qf, s0, s1, r, h);
    int rel = ((tq - 31) >> 4) - kt * 64 - 4 * h; asm volatile("" : "+v"(rel));
#pragma unroll
    for (int i = 0; i < 16; ++i) { const int kk2 = (i & 3) + 8 * (i >> 2); if (kk2 > rel) s0[i] = -INFINITY; if (kk2 + 32 > rel) s1[i] = -INFINITY; }
    softmax_pv(f, s0, s1, (const bf16_t*)(buf + att_kbytes<64>()), lane);
  });
  {
    const float muse = (f.m == -INFINITY) ? 0.f : f.m;
    const float il = (f.l > 0.f) ? 1.f / f.l : 0.f;
    if (ncmp < 2) {
#pragma unroll 1
      for (int i = tid; i < 32 * 128; i += NTHREADS) psum[i] = 0.f;
      __syncthreads();
    }
    nsa_stream(lds, KC, 64, VC, 64, false, ncmp, [&](int i) { return i * 64; }, [&](int kt, unsigned char* buf) {
      f32x16 s0, s1;
      qk_tile<64>((const bf16_t*)buf, qf, s0, s1, r, h);
      int rel = ((tq - 31) >> 4) - kt * 64 - 4 * h; asm volatile("" : "+v"(rel));
      int cb0 = kt * 64 + 4 * h; asm volatile("" : "+v"(cb0));
#pragma unroll
      for (int i = 0; i < 16; ++i) {
        const int kk2 = (i & 3) + 8 * (i >> 2); const int c = cb0 + kk2;
        float p0 = (kk2 > rel) ? 0.f : fexp2(s0[i] - muse) * il;
        float p1 = (kk2 + 32 > rel) ? 0.f : fexp2(s1[i] - muse) * il;
        p0 += __shfl_xor(p0, 1); p0 += __shfl_xor(p0, 2);
        p1 += __shfl_xor(p1, 1); p1 += __shfl_xor(p1, 2);
        if (hd == 0) { psum[ql * 128 + c] = p0; psum[ql * 128 + c + 32] = p1; }
      }
    });
  }
  __syncthreads();
#pragma unroll 1
  for (int itq = 0; itq < 4; ++itq) {
    const int q2 = wv * 8 + itq * 2 + (lane >> 5), j = lane & 31;
    const float* ps = psum + q2 * 128;
    float imp = 2.f * (ps[4 * j] + ps[4 * j + 1] + ps[4 * j + 2]) + ps[4 * j + 3];
    if (j > 0) imp += ps[4 * j - 1];
    const bool cand = (j >= 1) && (j <= cur - 2);
    int rank = 0;
    for (int jj = 0; jj < 32; ++jj) {
      const float v = __shfl(imp, (lane & 32) | jj);
      const bool cj = (jj >= 1) && (jj <= cur - 2);
      if (cj && (v > imp || (v == imp && jj < j))) ++rank;
    }
    const bool sel = cand && rank < 2;
    const unsigned long long bal = __ballot(sel);
    unsigned mk = (unsigned)(bal >> (32 * (lane >> 5)));
    mk |= 1u | (1u << cur); if (cur >= 1) mk |= (1u << (cur - 1));
    if (j == 0) selm[q2] = mk;
  }
  __syncthreads();
  unsigned blk_or = 0, wave_or = 0;
  for (int i = 0; i < 32; ++i) blk_or |= selm[i];
  for (int i = 0; i < 8; ++i) wave_or |= selm[wv * 8 + i];
  const unsigned mymask = selm[ql];
  {
    const float sc = (f.l > 0.f) ? g0 / f.l : 0.f;
#pragma unroll
    for (int i = 0; i < 8; ++i) { ofs[i * 64] = pk2bf(f.o0[2 * i] * sc, f.o0[2 * i + 1] * sc); ofs[(8 + i) * 64] = pk2bf(f.o1[2 * i] * sc, f.o1[2 * i + 1] * sc); }
  }
  fstate_init(f);
  {
    unsigned* tl = selm + 32;
    if (tid < 32 && ((blk_or >> tid) & 1u)) tl[__popc(blk_or & ((1u << tid) - 1u))] = tid;
    __syncthreads();
    const int nsel = __popc(blk_or);
    nsa_stream(lds, PROJ + (size_t)b * S * DINP + C_KS, DINP, PROJ + (size_t)b * S * DINP + C_VS, DINP, true, nsel,
      [&](int i) { return (int)tl[i] * 64; },
      [&](int i, unsigned char* buf) {
        const int jj = (int)tl[i];
        if ((wave_or >> jj) & 1u) {
          f32x16 s0, s1;
          qk_tile<64>((const bf16_t*)buf, qf, s0, s1, r, h);
          const bool on = (mymask >> jj) & 1u;
          int rel = on ? (tq - jj * 64 - 4 * h) : -1; asm volatile("" : "+v"(rel));
#pragma unroll
          for (int i2 = 0; i2 < 16; ++i2) { const int kk2 = (i2 & 3) + 8 * (i2 >> 2); if (kk2 > rel) s0[i2] = -INFINITY; if (kk2 + 32 > rel) s1[i2] = -INFINITY; }
          softmax_pv(f, s0, s1, (const bf16_t*)(buf + att_kbytes<64>()), lane);
        }
      });
    const float sc = (f.l > 0.f) ? g1 / f.l : 0.f;
#pragma unroll
    for (int i = 0; i < 8; ++i) {
      const unsigned w0 = ofs[i * 64], w1 = ofs[(8 + i) * 64];
      ofs[i * 64] = pk2bf(__uint_as_float(w0 << 16) + f.o0[2 * i] * sc, __uint_as_float(w0 & 0xffff0000u) + f.o0[2 * i + 1] * sc);
      ofs[(8 + i) * 64] = pk2bf(__uint_as_float(w1 << 16) + f.o1[2 * i] * sc, __uint_as_float(w1 & 0xffff0000u) + f.o1[2 * i + 1] * sc);
    }
  }
  fstate_init(f);
  {
    int jlo = (t0 - 511) >> 6; if (jlo < 0) jlo = 0;
    nsa_stream(lds, PROJ + (size_t)b * S * DINP + C_KW, DINP, PROJ + (size_t)b * S * DINP + C_VW, DINP, true, cur - jlo + 1,
      [&](int i) { return (jlo + i) * 64; },
      [&](int i, unsigned char* buf) {
        const int j = jlo + i;
        f32x16 s0, s1;
        qk_tile<64>((const bf16_t*)buf, qf, s0, s1, r, h);
        if (j == cur || j * 64 < t0 + 31 - 511 + 64) {
          int rel = tq - j * 64 - 4 * h; asm volatile("" : "+v"(rel));
#pragma unroll
          for (int i2 = 0; i2 < 16; ++i2) {
            const int kk2 = (i2 & 3) + 8 * (i2 >> 2);
            if (kk2 > rel || kk2 < rel - 511) s0[i2] = -INFINITY;
            if (kk2 + 32 > rel || kk2 + 32 < rel - 511) s1[i2] = -INFINITY;
          }
        }
        softmax_pv(f, s0, s1, (const bf16_t*)(buf + att_kbytes<64>()), lane);
      });
    const float sc = (f.l > 0.f) ? g2 / f.l : 0.f;
#pragma unroll
    for (int i = 0; i < 8; ++i) {
      const unsigned w0 = ofs[i * 64], w1 = ofs[(8 + i) * 64];
      f.o0[2 * i] = __uint_as_float(w0 << 16) + f.o0[2 * i] * sc; f.o0[2 * i + 1] = __uint_as_float(w0 & 0xffff0000u) + f.o0[2 * i + 1] * sc;
      f.o1[2 * i] = __uint_as_float(w1 << 16) + f.o1[2 * i] * sc; f.o1[2 * i + 1] = __uint_as_float(w1 & 0xffff0000u) + f.o1[2 * i + 1] * sc;
    }
  }
  f32x16& of0 = f.o0; f32x16& of1 = f.o1;
  {
    float ss = 0.f;
#pragma unroll
    for (int i = 0; i < 16; ++i) ss += of0[i] * of0[i] + of1[i] * of1[i];
    ss += __shfl_xor(ss, 1); ss += __shfl_xor(ss, 2); ss += __shfl_xor(ss, 32);
    const float rs = rsqrtf(ss * (1.f / 256) + EPS);
    const float* on = p.in[35] + l * 1024 + 768 + hd * 64;
#pragma unroll
    for (int g4 = 0; g4 < 4; ++g4) {
      const float4 a = *(const float4*)(on + 8 * g4 + 4 * h), b4 = *(const float4*)(on + 32 + 8 * g4 + 4 * h);
      of0[4 * g4] *= a.x; of0[4 * g4 + 1] *= a.y; of0[4 * g4 + 2] *= a.z; of0[4 * g4 + 3] *= a.w;
      of1[4 * g4] *= b4.x; of1[4 * g4 + 1] *= b4.y; of1[4 * g4 + 2] *= b4.z; of1[4 * g4 + 3] *= b4.w;
    }
    store_o((bf16_t*)(p.ws + WS_A) + tg * 1024 + 768 + hd * 64, of0, of1, rs, h);
  }
}

DEVI void carry_item(const Params& p, int l, int it) {
  const int tid = threadIdx.x;
  if (it < 64) {
    const int idx = it * 256 + tid, b = idx >> 10, gs = idx & 1023;
    const float2 a64 = ((const float2*)(p.ws + WS_W + l * WS_WL + W_S5A64))[gs];
    const float2* SLOC = (const float2*)(p.ws + SM_SLOC) + (size_t)b * 32 * 1024 + gs;
    float2* SCAR = (float2*)(p.ws + SM_SCAR) + (size_t)b * 32 * 1024 + gs;
    float hr = 0.f, hi = 0.f;
#pragma unroll 1
    for (int c0 = 0; c0 < 32; c0 += 8) {
      float2 sl[8];
#pragma unroll
      for (int i = 0; i < 8; ++i) sl[i] = SLOC[(size_t)(c0 + i) * 1024];
#pragma unroll
      for (int i = 0; i < 8; ++i) { SCAR[(size_t)(c0 + i) * 1024] = make_float2(hr, hi); const float nr = a64.x * hr - a64.y * hi + sl[i].x, ni = a64.x * hi + a64.y * hr + sl[i].y; hr = nr; hi = ni; }
    }
  } else {
    const int idx = (it - 64) * 256 + tid, b = idx >> 8, c = idx & 255;
    const float2* LSUM = (const float2*)(p.ws + SM_LSUM) + (size_t)b * 32 * 256 + c;
    float* LCAR = (float*)(p.ws + SM_LCAR) + (size_t)b * 32 * 256 + c;
    float hh = 0.f;
#pragma unroll 1
    for (int c0 = 0; c0 < 32; c0 += 8) {
      float2 sv[8];
#pragma unroll
      for (int i = 0; i < 8; ++i) sv[i] = LSUM[(size_t)(c0 + i) * 256];
#pragma unroll
      for (int i = 0; i < 8; ++i) { LCAR[(size_t)(c0 + i) * 256] = hh; hh = sv[i].x * hh + sv[i].y; }
    }
  }
}
DEVI void phase_a1(const Params& p, int l, unsigned char* lds) {
  for (int it = blockIdx.x; it < 80; it += gridDim.x) carry_item(p, l, it);
  const int G_ = (int)gridDim.x;
  const int vb_ = vblock();
  for (int rr = 0;; ++rr) { const int j = rr * G_ + ((rr & 1) ? (G_ - 1 - vb_) : vb_); if (rr * G_ >= 1024) break; if (j < 1024) { const int b = j >> 6, qt = 63 - (j & 63); nsa_item(p, l, b, qt, lds); } }
  __syncthreads();
  for (int rr = 0;; ++rr) { const int j = rr * G_ + ((rr & 1) ? (G_ - 1 - vb_) : vb_); if (rr * G_ >= 1024) break; if (j < 1024) { const int bh = j >> 4, qt = 15 - (j & 15); mla_item(p, l, bh >> 2, bh & 3, qt, lds); } }
}

DEVI void phase_r3(const Params& p, int l, unsigned char* lds) {
  bf16_t* Y = (bf16_t*)(p.ws + WS_A);
  const int tid = threadIdx.x, lane = tid & 63, wv = tid >> 6;
  {
    const float* onorm = p.in[35] + l * 1024 + 256;
    float* tile = (float*)lds;
    for (int it = blockIdx.x; it < NB * 32; it += gridDim.x) {
      const int b = it >> 5, chunk = it & 31;
      __syncthreads();
      lru_chunk<true>(p, l, b, chunk, tile);
      __syncthreads();
      for (int k = wv; k < 64; k += 4) {
        const float4 v = *(const float4*)(tile + k * 256 + lane * 4);
        const float rs = rsqrtf(wsum(v.x * v.x + v.y * v.y + v.z * v.z + v.w * v.w) * (1.f / 256) + EPS);
        const size_t t = (size_t)b * S + chunk * 64 + k;
        const float4 gg = *(const float4*)(onorm + lane * 4);
        st_bf16x4(Y + t * 1024 + 256 + lane * 4, (f32x4){v.x * rs * gg.x, v.y * rs * gg.y, v.z * rs * gg.z, v.w * rs * gg.w});
      }
    }
  }
  __syncthreads();
  for (int it = blockIdx.x; it < NB * 32; it += gridDim.x) s5_chunk<true>(p, l, it >> 5, it & 31, lds);
}

DEVI void phase_g3(const Params& p, int l, unsigned char* lds) {
  const bf16_t* YCP = (const bf16_t*)(p.ws + WS_F);
  bf16_t* YC = (bf16_t*)(p.ws + WS_F) + (size_t)T * 256;
  const bf16_t* W = (const bf16_t*)(p.ws + WS_W + l * WS_WL + W_GLU);
  const float* bg = p.in[26] + l * 256;
  for (int it = vblock(); it < 256 * 2; it += gridDim.x) {
    const int mt = it >> 1, nt = it & 1;
    f32x4 acc[4][4];
    gemm128g(lds, 256, [&](int r, int k) { return YCP + (size_t)(mt * 128 + r) * 256 + k; }, [&](int r, int k) { return W + (size_t)(nt * 128 + r) * 256 + k; }, acc);
    GEMM_EPI4({ const size_t o = (size_t)(mt * 128 + er) * 256 + nt * 128 + ec0; const ushort4 yp = *(const ushort4*)(YCP + o); f32x4 r4; r4[0] = bf2f(yp.x) * sigmoidf_(ev4[0] + bg[nt * 128 + ec0]); r4[1] = bf2f(yp.y) * sigmoidf_(ev4[1] + bg[nt * 128 + ec0 + 1]); r4[2] = bf2f(yp.z) * sigmoidf_(ev4[2] + bg[nt * 128 + ec0 + 2]); r4[3] = bf2f(yp.w) * sigmoidf_(ev4[3] + bg[nt * 128 + ec0 + 3]); st_bf16x4(YC + o, r4); })
  }
}

DEVI void phase_r4(const Params& p, int l) {
  const bf16_t* YA = (const bf16_t*)(p.ws + WS_C);
  const bf16_t* YC = (const bf16_t*)(p.ws + WS_F) + (size_t)T * 256;
  bf16_t* Y = (bf16_t*)(p.ws + WS_A);
  const float* onorm = p.in[35] + l * 1024;
  const int lane = threadIdx.x & 63, gw = blockIdx.x * 4 + (threadIdx.x >> 6), NGW = gridDim.x * 4;
  for (int t = gw; t < T; t += NGW) {
#pragma unroll
    for (int grp = 0; grp < 2; ++grp) {
      const bf16_t* src = (grp == 0 ? YA : YC) + (size_t)t * 256;
      const int gcol = (grp == 0 ? 0 : 512);
      const ushort4 u = ((const ushort4*)src)[lane];
      const float v0 = bf2f(u.x), v1 = bf2f(u.y), v2 = bf2f(u.z), v3 = bf2f(u.w);
      const float rs = rsqrtf(wsum(v0 * v0 + v1 * v1 + v2 * v2 + v3 * v3) * (1.f / 256) + EPS);
      const float4 g = ((const float4*)(onorm + gcol))[lane];
      uint2 o; o.x = pk2bf(v0 * rs * g.x, v1 * rs * g.y); o.y = pk2bf(v2 * rs * g.z, v3 * rs * g.w);
      ((uint2*)(Y + (size_t)t * 1024 + gcol))[lane] = o;
    }
  }
}

DEVI void phase_g4(const Params& p, int l, unsigned char* lds) {
  const bf16_t* Y = (const bf16_t*)(p.ws + WS_A);
  const bf16_t* W = (const bf16_t*)(p.ws + WS_W + l * WS_WL + W_OUT);
  const float* xin = (l == 0) ? p.in[0] : p.out;
  float* out = p.out;
  int par = 0; bool staged = false;
  for (int it = vblock(); it < 256 * 8; it += gridDim.x) {
    const int mt = it >> 3, nt = it & 7;
    f32x4 acc[4][4], xr[4][4];
    {
      const int tid = threadIdx.x, wid = tid >> 6, lane = tid & 63, wr = wid >> 1, wc = wid & 1, fr = lane & 15, fq = lane >> 4;
#pragma unroll
      for (int m = 0; m < 4; ++m)
#pragma unroll
        for (int n = 0; n < 4; ++n) xr[m][n] = *(const f32x4*)(xin + (size_t)(mt * 128 + wr * 64 + m * 16 + fr) * D + nt * 128 + wc * 64 + n * 16 + fq * 4);
    }
    const int itn = it + (int)gridDim.x; const bool hn = itn < 256 * 8; const int mtn = itn >> 3, ntn = itn & 7;
    gemm128p(lds, D, [&](int r, int k) { return Y + (size_t)(mt * 128 + r) * D + k; }, [&](int r, int k) { return W + (size_t)(nt * 128 + r) * D + k; }, acc, par, staged, hn,
             [&](int r, int k) { return Y + (size_t)(mtn * 128 + r) * D + k; }, [&](int r, int k) { return W + (size_t)(ntn * 128 + r) * D + k; });
    staged = hn;
    GEMM_EPI4({ const size_t o = (size_t)(mt * 128 + er) * D + nt * 128 + ec0; *(f32x4*)(out + o) = xr[m][n] + ev4; })
  }
}

DEVI void phase_r5(const Params& p, int l, unsigned char* lds) {
  const float* x1 = p.out;
  bf16_t* XN = (bf16_t*)(p.ws + WS_A);
  const float* g = p.in[37] + l * D;
  const bf16_t* WH = (const bf16_t*)(p.ws + WS_W + l * WS_WL + W_RTH);
  const bf16_t* WL = (const bf16_t*)(p.ws + WS_W + l * WS_WL + W_RTL);
  const float* brg = p.in[39] + l * 4; const float* bre = p.in[41] + l * 16;
  int* CNT = (int*)(p.ws + SM_CNT) + l * 32;
  int* LIST = (int*)(p.ws + SM_LIST);
  float2* TOKW = (float2*)(p.ws + SM_TOKW);
  const int tid = threadIdx.x, lane = tid & 63, wv = tid >> 6, c = lane & 15, q = lane >> 4;
  float* red = (float*)lds;
  int* hist = (int*)(lds + 16384);
  int* tokl = (int*)(lds + 16384 + 256);
  if (tid < 64) hist[tid] = 0;
  int ntok = 0;
  __syncthreads();
  for (int it = blockIdx.x; it < T / 16; it += gridDim.x) {
    const size_t tb = (size_t)it * 16;
    f32x4 a0 = (f32x4){0.f, 0.f, 0.f, 0.f}, a1 = (f32x4){0.f, 0.f, 0.f, 0.f};
    float ss = 0.f;
    const float* xrow = x1 + (tb + c) * D + wv * 256 + 8 * q;
    const bf16_t* wh0 = WH + (size_t)c * 1024 + wv * 256 + 8 * q;
    const bf16_t* wl0 = WL + (size_t)c * 1024 + wv * 256 + 8 * q;
    float4 xk[8][2];
#pragma unroll
    for (int ks = 0; ks < 8; ++ks) { xk[ks][0] = *(const float4*)(xrow + ks * 32); xk[ks][1] = *(const float4*)(xrow + ks * 32 + 4); }
#pragma unroll
    for (int ks = 0; ks < 8; ++ks) {
      const bf16x8 wh_a = *(const bf16x8*)(wh0 + ks * 32), wl_a = *(const bf16x8*)(wl0 + ks * 32);
      const bf16x8 wh_b = *(const bf16x8*)(wh0 + 16 * 1024 + ks * 32), wl_b = *(const bf16x8*)(wl0 + 16 * 1024 + ks * 32);
      const float xv[8] = {xk[ks][0].x, xk[ks][0].y, xk[ks][0].z, xk[ks][0].w, xk[ks][1].x, xk[ks][1].y, xk[ks][1].z, xk[ks][1].w};
      u32x4 hw, lw;
#pragma unroll
      for (int j = 0; j < 4; ++j) {
        const float x0 = xv[2 * j], x1v = xv[2 * j + 1];
        ss += x0 * x0 + x1v * x1v;
        const unsigned hp = pk2bf(x0, x1v);
        hw[j] = hp; lw[j] = pk2bf(x0 - __uint_as_float(hp << 16), x1v - __uint_as_float(hp & 0xffff0000u));
      }
      const bf16x8 xh = __builtin_bit_cast(bf16x8, hw), xl = __builtin_bit_cast(bf16x8, lw);
      a0 = mfma16(wh_a, xh, a0); a0 = mfma16(wh_a, xl, a0); a0 = mfma16(wl_a, xh, a0);
      a1 = mfma16(wh_b, xh, a1); a1 = mfma16(wh_b, xl, a1); a1 = mfma16(wl_b, xh, a1);
    }
    ss += __shfl_xor(ss, 16); ss += __shfl_xor(ss, 32);
    __syncthreads();
#pragma unroll
    for (int j = 0; j < 4; ++j) { red[(wv * 9 + j) * 64 + lane] = a0[j]; red[(wv * 9 + 4 + j) * 64 + lane] = a1[j]; }
    red[(wv * 9 + 8) * 64 + lane] = ss;
    __syncthreads();
    const float s2 = red[8 * 64 + lane] + red[(9 + 8) * 64 + lane] + red[(18 + 8) * 64 + lane] + red[(27 + 8) * 64 + lane];
    const float rs = rsqrtf(s2 * (1.f / D) + EPS);
    {
      bf16_t* xo = XN + (tb + c) * D + wv * 256 + 8 * q;
      const float* gp = g + wv * 256 + 8 * q;
#pragma unroll
      for (int ks = 0; ks < 8; ++ks) {
        const float4 g0 = *(const float4*)(gp + ks * 32), g1 = *(const float4*)(gp + ks * 32 + 4);
        u32x4 o;
        o[0] = pk2bf(xk[ks][0].x * rs * g0.x, xk[ks][0].y * rs * g0.y); o[1] = pk2bf(xk[ks][0].z * rs * g0.z, xk[ks][0].w * rs * g0.w);
        o[2] = pk2bf(xk[ks][1].x * rs * g1.x, xk[ks][1].y * rs * g1.y); o[3] = pk2bf(xk[ks][1].z * rs * g1.z, xk[ks][1].w * rs * g1.w);
        *(u32x4*)(xo + ks * 32) = o;
      }
    }
    if (wv == 0) {
      float c0[4], c1[4];
#pragma unroll
      for (int j = 0; j < 4; ++j) {
        c0[j] = red[j * 64 + lane] + red[(9 + j) * 64 + lane] + red[(18 + j) * 64 + lane] + red[(27 + j) * 64 + lane];
        c1[j] = red[(4 + j) * 64 + lane] + red[(13 + j) * 64 + lane] + red[(22 + j) * 64 + lane] + red[(31 + j) * 64 + lane];
      }
      float lg[20];
#pragma unroll
      for (int qq = 0; qq < 4; ++qq)
#pragma unroll
        for (int j = 0; j < 4; ++j) lg[4 * qq + j] = __shfl(c0[j], c + 16 * qq);
#pragma unroll
      for (int j = 0; j < 4; ++j) lg[16 + j] = __shfl(c1[j], c);
      const int t = (int)tb + c;
      float gl[4];
#pragma unroll
      for (int k2 = 0; k2 < 4; ++k2) gl[k2] = lg[k2] * rs + brg[k2];
      int gi = 0; float gbest = gl[0];
#pragma unroll
      for (int k2 = 1; k2 < 4; ++k2) if (gl[k2] > gbest) { gbest = gl[k2]; gi = k2; }
      float den = 0.f;
#pragma unroll
      for (int k2 = 0; k2 < 4; ++k2) den += expf(gl[k2] - gbest);
      const float pg = 1.f / den;
      float le[4];
#pragma unroll
      for (int k2 = 0; k2 < 4; ++k2) { float sel = 0.f;
#pragma unroll
        for (int gg2 = 0; gg2 < 4; ++gg2) sel = (gi == gg2) ? (lg[4 + gg2 * 4 + k2] * rs + bre[gg2 * 4 + k2]) : sel;
        le[k2] = sel; }
      int i0 = 0; float l0 = le[0];
#pragma unroll
      for (int k2 = 1; k2 < 4; ++k2) if (le[k2] > l0) { l0 = le[k2]; i0 = k2; }
      int i1 = -1; float l1 = -INFINITY;
#pragma unroll
      for (int k2 = 0; k2 < 4; ++k2) if (k2 != i0 && le[k2] > l1) { l1 = le[k2]; i1 = k2; }
      const float e1 = expf(l1 - l0);
      const float w0 = pg / (1.f + e1), w1 = pg * e1 / (1.f + e1);
      const int elo = (i0 < i1) ? i0 : i1, ehi = (i0 < i1) ? i1 : i0;
      const float wlo = (i0 < i1) ? w0 : w1, whi = (i0 < i1) ? w1 : w0;
      const int pidx = (elo == 0) ? (ehi - 1) : ((elo == 1) ? (ehi + 1) : 5);
      const int cls = gi * 6 + pidx;
      if (q == 0) {
        const int rank = atomicAdd(&hist[cls], 1);
        tokl[2 * (ntok + c)] = t; tokl[2 * (ntok + c) + 1] = (cls << 16) | rank;
        TOKW[t] = make_float2(wlo, whi);
      }
    }
    ntok += 16;
  }
  __syncthreads();
  if (tid < 24) { const int n = hist[tid]; hist[32 + tid] = n ? atomicAdd(&CNT[tid], n) : 0; }
  __syncthreads();
  for (int i = tid; i < ntok; i += NTHREADS) { const int t = tokl[2 * i], cr = tokl[2 * i + 1], cls = cr >> 16; LIST[(size_t)cls * T + hist[32 + cls] + (cr & 0xffff)] = t; }
}

struct MoeItem { int cls, mtile, nt, cnt; };
DEVI void moe_prefix(const int* CNT, unsigned char* lds) {
  int* pre = (int*)(lds + LDS_BYTES + 64);
  __syncthreads();
  if (threadIdx.x < 24) pre[32 + threadIdx.x] = CNT[threadIdx.x];
  __syncthreads();
  if (threadIdx.x == 0) { int a = 0; for (int c = 0; c < 24; ++c) { pre[c] = a; a += (pre[32 + c] + 127) >> 7; } pre[24] = a; }
  __syncthreads();
}
DEVI bool moe_item(unsigned char* lds, int it, MoeItem& m) {
  const int* pre = (const int*)(lds + LDS_BYTES + 64);
  const int mt = it >> 3; m.nt = it & 7;
  if (mt >= pre[24]) return false;
  int c = 0;
#pragma unroll
  for (int q = 1; q < 24; ++q) c += (mt >= pre[q]) ? 1 : 0;
  m.cls = c; m.mtile = mt - pre[c]; m.cnt = pre[32 + c];
  return true;
}
DEVI void cls_experts(int cls, int& e0, int& e1) {
  const int g = cls / 6, pi = cls % 6;
  const int lo = (pi < 3) ? 0 : ((pi < 5) ? 1 : 2);
  const int hi = (pi < 3) ? (pi + 1) : ((pi < 5) ? (pi - 1) : 3);
  e0 = g * 4 + lo; e1 = g * 4 + hi;
}
DEVI void phase_g5(const Params& p, int l, unsigned char* lds) {
  const bf16_t* XN = (const bf16_t*)(p.ws + WS_A);
  bf16_t* HID = (bf16_t*)(p.ws + WS_B);
  const bf16_t* WGU = (const bf16_t*)(p.ws + WS_W + l * WS_WL + W_GU);
  const int* CNT = (const int*)(p.ws + SM_CNT) + l * 32;
  const int* LIST = (const int*)(p.ws + SM_LIST);
  const float2* TOKW = (const float2*)(p.ws + SM_TOKW);
  moe_prefix(CNT, lds);
  const int G_ = (int)gridDim.x, total_ = ((const int*)(lds + LDS_BYTES + 64))[24] * 8, full_ = (total_ / G_) * G_, rem_ = total_ - full_;
  for (int it = vblock(); it < full_ + 2 * rem_; it += G_) {
    const bool halfmode = it >= full_; const int half = (it - full_) & 1;
    MoeItem mi; if (!moe_item(lds, halfmode ? full_ + ((it - full_) >> 1) : it, mi)) break;
    int e0, e1; cls_experts(mi.cls, e0, e1);
    const int ex = (mi.nt < 4) ? e0 : e1, ntl = mi.nt & 3;
    const bf16_t* W = WGU + ((size_t)ex * 512 + ntl * 128) * 1024;
    const int* list = LIST + (size_t)mi.cls * T + mi.mtile * 128;
    const int nvalid = mi.cnt - mi.mtile * 128;
    if (halfmode) {
      f32x4 acc2[2][4];
      int tokA[4];
#pragma unroll
      for (int i = 0; i < 4; ++i) { const int r = (threadIdx.x >> 3) + 32 * i; tokA[i] = list[(r < nvalid) ? r : 0]; }
      const int tid = threadIdx.x, wid = tid >> 6, lane = tid & 63, fr = lane & 15, fq = lane >> 4;
      int tokE2[2]; float twE2[2];
#pragma unroll
      for (int m = 0; m < 2; ++m) { const int er = wid * 32 + m * 16 + fr; tokE2[m] = list[(er < nvalid) ? er : 0]; }
#pragma unroll
      for (int m = 0; m < 2; ++m) { const float2 tw = TOKW[tokE2[m]]; twE2[m] = (mi.nt < 4) ? tw.x : tw.y; }
      const bf16_t* Wh = W + (size_t)half * 64 * 1024;
      gemm128h(lds, D, [&](int r, int k) { const int i = r >> 5; const int tok = (i == 0) ? tokA[0] : (i == 1) ? tokA[1] : (i == 2) ? tokA[2] : tokA[3]; return XN + (size_t)tok * D + k; },
               [&](int r, int k) { return Wh + (size_t)r * D + k; }, acc2);
#pragma unroll
      for (int m = 0; m < 2; ++m) {
        const int er = wid * 32 + m * 16 + fr;
        if (er < nvalid) {
#pragma unroll
          for (int n = 0; n < 2; ++n) {
            f32x4 hv;
#pragma unroll
            for (int j = 0; j < 4; ++j) { const float gt = acc2[m][n][j], up = acc2[m][n + 2][j]; hv[j] = gt * sigmoidf_(gt) * up * twE2[m]; }
            st_bf16x4(HID + (size_t)tokE2[m] * 512 + (mi.nt < 4 ? 0 : 256) + ntl * 64 + half * 32 + n * 16 + fq * 4, hv);
          }
        }
      }
      continue;
    }
    f32x4 acc[4][4];
    int tokA[4], tokE[4]; float twE[4];
#pragma unroll
    for (int i = 0; i < 4; ++i) { const int r = (threadIdx.x >> 3) + 32 * i; tokA[i] = list[(r < nvalid) ? r : 0]; }
    {
      const int tid_ = threadIdx.x, er0 = ((tid_ >> 6) >> 1) * 64 + (tid_ & 15);
#pragma unroll
      for (int m = 0; m < 4; ++m) { const int er = er0 + m * 16; tokE[m] = list[(er < nvalid) ? er : 0]; }
#pragma unroll
      for (int m = 0; m < 4; ++m) { const float2 tw = TOKW[tokE[m]]; twE[m] = (mi.nt < 4) ? tw.x : tw.y; }
    }
    gemm128g(lds, D, [&](int r, int k) { const int i = r >> 5; const int tok = (i == 0) ? tokA[0] : (i == 1) ? tokA[1] : (i == 2) ? tokA[2] : tokA[3]; return XN + (size_t)tok * D + k; }, [&](int r, int k) { return W + (size_t)r * D + k; }, acc);
    {
      const int tid = threadIdx.x, wid = tid >> 6, lane = tid & 63, wr = wid >> 1, wc = wid & 1, fr = lane & 15, fq = lane >> 4;
#pragma unroll
      for (int m = 0; m < 4; ++m) {
        const int er = wr * 64 + m * 16 + fr;
        if (er < nvalid) {
          const int tok = tokE[m];
          const float w = twE[m];
#pragma unroll
          for (int n = 0; n < 2; ++n) {
            f32x4 hv;
#pragma unroll
            for (int j = 0; j < 4; ++j) { const float gt = acc[m][n][j], up = acc[m][n + 2][j]; hv[j] = gt * sigmoidf_(gt) * up * w; }
            const int hh = (mi.nt < 4 ? 0 : 256) + ntl * 64 + wc * 32 + n * 16 + fq * 4;
            st_bf16x4(HID + (size_t)tok * 512 + hh, hv);
          }
        }
      }
    }
  }
}
DEVI void phase_g6(const Params& p, int l, unsigned char* lds) {
  const bf16_t* HID = (const bf16_t*)(p.ws + WS_B);
  const bf16_t* WDN = (const bf16_t*)(p.ws + WS_W + l * WS_WL + W_DN);
  const int* CNT = (const int*)(p.ws + SM_CNT) + l * 32;
  const int* LIST = (const int*)(p.ws + SM_LIST);
  float* out = p.out;
  moe_prefix(CNT, lds);
  const int G_ = (int)gridDim.x, total_ = ((const int*)(lds + LDS_BYTES + 64))[24] * 8, full_ = (total_ / G_) * G_, rem_ = total_ - full_;
  for (int it = vblock(); it < full_ + 2 * rem_; it += G_) {
    const bool halfmode = it >= full_; const int half = (it - full_) & 1;
    MoeItem mi; if (!moe_item(lds, halfmode ? full_ + ((it - full_) >> 1) : it, mi)) break;
    int e0, e1; cls_experts(mi.cls, e0, e1);
    const int* list = LIST + (size_t)mi.cls * T + mi.mtile * 128;
    const int nvalid = mi.cnt - mi.mtile * 128;
    const bf16_t* W0 = WDN + ((size_t)e0 * 1024 + mi.nt * 128) * 256;
    const bf16_t* W1 = WDN + ((size_t)e1 * 1024 + mi.nt * 128) * 256;
    if (halfmode) {
      f32x4 acc2[2][4];
      int tokA[4];
#pragma unroll
      for (int i = 0; i < 4; ++i) { const int r = (threadIdx.x >> 3) + 32 * i; tokA[i] = list[(r < nvalid) ? r : 0]; }
      const int tid = threadIdx.x, wid = tid >> 6, lane = tid & 63, fr = lane & 15, fq = lane >> 4;
      int trow2[2];
#pragma unroll
      for (int m = 0; m < 2; ++m) { const int er = wid * 32 + m * 16 + fr; trow2[m] = list[(er < nvalid) ? er : 0]; }
      const bf16_t* W0h = W0 + (size_t)half * 64 * 256; const bf16_t* W1h = W1 + (size_t)half * 64 * 256;
      gemm128h(lds, 512, [&](int r, int k) { const int i = r >> 5; const int tok = (i == 0) ? tokA[0] : (i == 1) ? tokA[1] : (i == 2) ? tokA[2] : tokA[3]; return HID + (size_t)tok * 512 + k; },
               [&](int r, int k) { return ((k < 256) ? W0h : W1h) + (size_t)r * 256 + (k & 255); }, acc2);
#pragma unroll
      for (int m = 0; m < 2; ++m) {
        const int er = wid * 32 + m * 16 + fr;
        if (er < nvalid) {
#pragma unroll
          for (int n = 0; n < 4; ++n) { float* o = out + (size_t)trow2[m] * D + mi.nt * 128 + half * 64 + n * 16 + fq * 4; const f32x4 xi = *(const f32x4*)o; *(f32x4*)o = xi + acc2[m][n]; }
        }
      }
      continue;
    }
    f32x4 acc[4][4];
    int trow[4], tokA[4];
    {
      const int tid = threadIdx.x, wid = tid >> 6, lane = tid & 63, wr = wid >> 1, fr = lane & 15;
#pragma unroll
      for (int i = 0; i < 4; ++i) { const int r = (tid >> 3) + 32 * i; tokA[i] = list[(r < nvalid) ? r : 0]; }
#pragma unroll
      for (int m = 0; m < 4; ++m) { const int er = wr * 64 + m * 16 + fr; trow[m] = list[(er < nvalid) ? er : 0]; }
    }
    gemm128g(lds, 512, [&](int r, int k) { const int i = r >> 5; const int tok = (i == 0) ? tokA[0] : (i == 1) ? tokA[1] : (i == 2) ? tokA[2] : tokA[3]; return HID + (size_t)tok * 512 + k; },
            [&](int r, int k) { return ((k < 256) ? W0 : W1) + (size_t)r * 256 + (k & 255); }, acc);
    GEMM_EPI4({ if (er < nvalid) { const size_t o = (size_t)trow[m] * D + mi.nt * 128 + ec0; const f32x4 xi = *(const f32x4*)(out + o); *(f32x4*)(out + o) = xi + ev4; } })
  }
}


#define XB_TMO      128
#define XB_XCNT(j)  (256  + 64 * (j))
#define XB_XSUB(j)  (1280 + 64 * (j))
#define XB_XGEN(j)  (2304 + 64 * (j))
#define XB_TOP      3328
#define XB_TOPGEN   3392
#define XCD_BAR_WORDS 3456
#define XB_SPIN_CAP (1u << 18)
DEVI unsigned xb_ld(unsigned* p)              { return __hip_atomic_load(p, __ATOMIC_RELAXED, __HIP_MEMORY_SCOPE_AGENT); }
DEVI unsigned xb_add(unsigned* p, unsigned v) { return __hip_atomic_fetch_add(p, v, __ATOMIC_RELAXED, __HIP_MEMORY_SCOPE_AGENT); }
DEVI unsigned xb_xcc_id() { return (unsigned)__builtin_amdgcn_s_getreg((3 << 11) | 20) & 0xFu; }
#define XB_SPIN(cond, bar) do { unsigned _sp = 0; while (cond) { __builtin_amdgcn_s_sleep(1); \
    if ((++_sp & 255u) == 0u) { if (xb_ld(&(bar)[XB_TMO])) break; if (_sp > XB_SPIN_CAP) { atomicAdd(&(bar)[XB_TMO], 1u); break; } } } } while (0)
struct XcdBarrier { unsigned* bar; unsigned x; volatile LAS unsigned* st; };
DEVI XcdBarrier xcd_barrier_post(unsigned* bar, volatile LAS unsigned* st) {
    XcdBarrier b; b.bar = bar; b.x = xb_xcc_id(); b.st = st;
    if (threadIdx.x == 0) (void)xb_add(&bar[XB_XCNT(b.x)], 1u);
    return b;
}
DEVI void xcd_barrier_complete(unsigned* bar, unsigned x, unsigned& nloc, unsigned& nx) {
    const unsigned G = gridDim.x * gridDim.y * gridDim.z;
    unsigned sum, cnt, mine, sp = 0u;
    for (;;) {
        sum = 0u; cnt = 0u; mine = 0u;
#pragma unroll
        for (unsigned j = 0; j < 16; ++j) { const unsigned c = xb_ld(&bar[XB_XCNT(j)]); sum += c; cnt += (c > 0u) ? 1u : 0u; mine = (j == x) ? c : mine; }
        if (sum == G) break;
        __builtin_amdgcn_s_sleep(1);
        if ((++sp & 255u) == 0u) { if (xb_ld(&bar[XB_TMO])) break; if (sp > XB_SPIN_CAP) { atomicAdd(&bar[XB_TMO], 1u); break; } }
    }
    nloc = mine > 0u ? mine : 1u; nx = cnt > 0u ? cnt : 1u;
}
DEVI void xcd_barrier(const XcdBarrier& b) {
    asm volatile("s_waitcnt vmcnt(0)" ::: "memory");
    __syncthreads();
    if (threadIdx.x == 0) {
        unsigned* bar = b.bar;
        __builtin_amdgcn_s_waitcnt(0);
        unsigned nloc = b.st[0], nx = b.st[1];
        if (nloc == 0u) { xcd_barrier_complete(bar, b.x, nloc, nx); b.st[0] = nloc; b.st[1] = nx; }
        const unsigned old = xb_add(&bar[XB_XSUB(b.x)], 1u);
        const unsigned gen = old / nloc;
        if (old + 1u == (gen + 1u) * nloc) {
            __builtin_amdgcn_fence(__ATOMIC_RELEASE, "agent");
            asm volatile("s_waitcnt vmcnt(0)" ::: "memory");
            const unsigned og = xb_add(&bar[XB_TOP], 1u);
            const unsigned tg = og / nx;
            if (og + 1u == (tg + 1u) * nx) xb_add(&bar[XB_TOPGEN], 1u);
            else XB_SPIN(xb_ld(&bar[XB_TOPGEN]) == tg, bar);
            __builtin_amdgcn_fence(__ATOMIC_ACQUIRE, "agent");
            xb_add(&bar[XB_XGEN(b.x)], 1u);
            asm volatile("s_waitcnt vmcnt(0)" ::: "memory");
        } else {
            XB_SPIN(xb_ld(&bar[XB_XGEN(b.x)]) == gen, bar);
            __builtin_amdgcn_fence(__ATOMIC_ACQUIRE, "agent");
            asm volatile("s_waitcnt vmcnt(0)" ::: "memory");
        }
    }
    __syncthreads();
}

#define PH(k, call) { const int _k = (k); if (p.lo <= _k && _k < p.hi) { call; if (_k + 1 < p.hi) { if (_k == 0) grid.sync(); else xcd_barrier(xbar); } } }
__global__ void __launch_bounds__(NTHREADS, 2) hybrid_fwd(Params p) {
  extern __shared__ __attribute__((aligned(16))) unsigned char lds[];
  cg::grid_group grid = cg::this_grid();
  volatile LAS unsigned* xst = (volatile LAS unsigned*)(LAS unsigned char*)(lds + LDS_BYTES);
  if (threadIdx.x < 4) xst[threadIdx.x] = 0u;
  __syncthreads();
  XcdBarrier xbar = xcd_barrier_post((unsigned*)(p.ws + WS_CTL), xst);
  PH(0, phase_prep(p, lds))
#define LAYER(l) { \
    PH(1 + 13 * l + 0, phase_g1(p, l, lds)) \
    PH(1 + 13 * l + 2, phase_g2(p, l, lds)) \
    PH(1 + 13 * l + 3, phase_r2(p, l, lds)) \
    PH(1 + 13 * l + 4, phase_a1(p, l, lds)) \
    PH(1 + 13 * l + 5, phase_r3(p, l, lds)) \
    PH(1 + 13 * l + 6, phase_g3(p, l, lds)) \
    PH(1 + 13 * l + 7, phase_r4(p, l)) \
    PH(1 + 13 * l + 8, phase_g4(p, l, lds)) \
    PH(1 + 13 * l + 9, phase_r5(p, l, lds)) \
    PH(1 + 13 * l + 10, phase_g5(p, l, lds)) \
    PH(1 + 13 * l + 11, phase_g6(p, l, lds)) }
  LAYER(0)
  PH(13, rmsnorm_rows(p.out, p.in[2] + D, (bf16_t*)(p.ws + WS_A)))
  LAYER(1)
}

extern "C" void kernel_launch(void* const* d_in, const int* in_sizes, int n_in, void* d_out, int out_size, void* d_ws, size_t ws_size, hipStream_t stream) {
  static int grid_blocks = 0;
  if (!grid_blocks) {
    if (n_in != 45 || ws_size < WS_END) { fprintf(stderr, "kernel_launch: unexpected n_in %d or ws_size %zu (< %zu)\n", n_in, ws_size, (size_t)WS_END); grid_blocks = -1; return; }
    int dev = 0, cus = 0, per_cu = 0;
    hipGetDevice(&dev);
    hipDeviceGetAttribute(&cus, hipDeviceAttributeMultiprocessorCount, dev);
    hipFuncSetAttribute((const void*)hybrid_fwd, hipFuncAttributeMaxDynamicSharedMemorySize, LDS_ALLOC);
    hipOccupancyMaxActiveBlocksPerMultiprocessor(&per_cu, (const void*)hybrid_fwd, NTHREADS, LDS_ALLOC);
    if (per_cu < 1) per_cu = 1;
    if (per_cu > 2) per_cu = 2;
    grid_blocks = cus * per_cu;
    fprintf(stderr, "kernel_launch: cus %d per_cu %d grid %d\n", cus, per_cu, grid_blocks);
  }
  if (grid_blocks < 0) return;
  (void)hipMemsetAsync((unsigned char*)d_ws + WS_CTL, 0, XCD_BAR_WORDS * 4, stream);
  Params p{};
  for (int i = 0; i < 45; ++i) p.in[i] = (const float*)d_in[i];
  p.out = (float*)d_out; p.ws = (unsigned char*)d_ws;
#if N_LAUNCH_MODE == 1
  p.lo = 0; p.hi = NPH;
  { void* args[] = {&p}; hipError_t e = hipLaunchCooperativeKernel((void*)hybrid_fwd, dim3(grid_blocks), dim3(NTHREADS), args, LDS_ALLOC, stream);
    if (e != hipSuccess) fprintf(stderr, "cooperative launch failed: %s\n", hipGetErrorString(e)); }
#else
  for (int ph = 0; ph < NPH; ++ph) {
    p.lo = ph; p.hi = ph + 1;
    void* args[] = {&p}; hipError_t e = hipLaunchCooperativeKernel((void*)hybrid_fwd, dim3(grid_blocks), dim3(NTHREADS), args, LDS_ALLOC, stream);
    if (e != hipSuccess) { fprintf(stderr, "launch %d failed: %s\n", ph, hipGetErrorString(e)); break; }
  }
#endif
}
```

```cpp
#include <hip/hip_runtime.h>
#include <hip/hip_cooperative_groups.h>
#include <cstdio>
#include <cstdint>
namespace cg = cooperative_groups;

#ifndef N_LAUNCH_MODE
#define N_LAUNCH_MODE 1
#endif

#define DEVI __device__ __forceinline__

constexpr int KTHREADS = 512;
__shared__ unsigned g_hs[4];
#define HTID ((int)(threadIdx.x & 255))
__device__ __forceinline__ int hb_() { return __builtin_amdgcn_readfirstlane((int)(threadIdx.x >> 8)); }
#define VBID ((int)blockIdx.x * 2 + hb_())
#define VGRID ((int)gridDim.x * 2)
__device__ __forceinline__ void hsync() {
  asm volatile("s_waitcnt lgkmcnt(0)" ::: "memory");
  if ((threadIdx.x & 63) == 0) {
    unsigned* c = &g_hs[hb_()];
    const unsigned old = __hip_atomic_fetch_add(c, 1u, __ATOMIC_RELAXED, __HIP_MEMORY_SCOPE_WORKGROUP);
    const unsigned target = (old & ~3u) + 4u;
    while ((int)(__hip_atomic_load(c, __ATOMIC_RELAXED, __HIP_MEMORY_SCOPE_WORKGROUP) - target) < 0) __builtin_amdgcn_s_sleep(1);
  }
  asm volatile("" ::: "memory");
}
typedef unsigned short bf16_t;
typedef short bf16x8 __attribute__((ext_vector_type(8)));
typedef float f32x4 __attribute__((ext_vector_type(4)));
typedef float f32x16 __attribute__((ext_vector_type(16)));
typedef unsigned u32x4 __attribute__((ext_vector_type(4)));
#define LAS __attribute__((address_space(3)))

constexpr int NB = 16, S = 2048, T = NB * S, D = 1024, DIN = 1772, DINP = 1792, NL = 2;
constexpr int C_CQ = 0, C_KPE = 192, C_NG = 224, C_T1 = 256, C_LX = 512, C_LG = 768, C_S5 = 1024, C_T5 = 1280, C_KC = 1536, C_VC = 1600, C_VS = 1664, C_VW = 1728;
__host__ __device__ constexpr int wgcol(int tile0, int wc, int e) { return tile0 + 128 * (e >> 5) + 32 * wc + (e & 31); }
__host__ __device__ constexpr int colmap(int n) {
  if (n < 192) return n;
  if (n < 320) { const int k = n - 192; return wgcol(C_T1, k >> 6, k & 63); }
  if (n < 352) return C_KPE + (n - 320);
  if (n < 608) return C_LX + (n - 352);
  if (n < 864) return C_LG + (n - 608);
  if (n < 1120) return C_S5 + (n - 864);
  if (n < 1376) { const int q = n - 1120; return wgcol(C_T5, q >> 6, q & 63); }
  if (n < 1760) { const int j = n - 1376, part = j >> 6, d = j & 63;
    return part == 0 ? C_KC + d : part == 1 ? C_VC + d : part == 2 ? wgcol(C_T1, 2, d) : part == 3 ? C_VS + d : part == 4 ? wgcol(C_T1, 3, d) : C_VW + d; }
  return C_NG + (n - 1760);
}
constexpr float EPS = 1e-6f;
constexpr float LOG2E = 1.4426950408889634f;
constexpr int NTHREADS = 256;
constexpr int NPH = 1 + 13 * NL - 1;

constexpr size_t MiB = 1u << 20;
constexpr size_t WS_CTL = 0;
constexpr size_t WS_SMALL = 1 * MiB;
constexpr size_t WS_W = 16 * MiB;
constexpr size_t WS_WL = 32 * MiB;
constexpr size_t WS_A = 80 * MiB;
constexpr size_t WS_B = 144 * MiB;
constexpr size_t WS_C = 256 * MiB;
constexpr size_t WS_D = 292 * MiB;
constexpr size_t WS_E = 348 * MiB;
constexpr size_t WS_F = 380 * MiB;
constexpr size_t WS_G = 428 * MiB;
constexpr size_t WS_ROPE = 452 * MiB;
constexpr size_t WS_END = 460 * MiB;
constexpr size_t W_IN = 0;
constexpr size_t W_OUT = 4 * MiB;
constexpr size_t W_UQ = 6 * MiB;
constexpr size_t W_UKV = W_UQ + 384 * 192 * 2;
constexpr size_t W_LRU = W_UKV + 512 * 128 * 2;
constexpr size_t W_GLU = W_LRU + 4 * 128 * 64 * 2;
constexpr size_t W_1K = 6 * MiB + 512 * 1024;
constexpr size_t W_1V = W_1K + 128 * 2048 * 2;
constexpr size_t W_B1K = W_1V + 128 * 2048 * 2;
constexpr size_t W_B1V = W_B1K + 512;
constexpr size_t W_S5A = W_B1V + 512;
constexpr size_t W_S5A64 = W_S5A + 16 * 64 * 8;
constexpr size_t W_S5B = W_S5A64 + 16 * 64 * 8;
constexpr size_t W_S5BB = W_S5B + 16 * 64 * 16 * 8;
constexpr size_t W_S5CM = W_S5BB + 16 * 4 * 32 * 16 * 2;
constexpr size_t W_2K = W_S5CM + 16 * 16 * 128 * 2;
constexpr size_t W_2V = W_2K + 64 * 128 * 2;
static_assert(W_2V + 64 * 128 * 2 <= 8 * MiB, "weights overflow");
constexpr size_t W_RTH = W_2V + 64 * 128 * 2;
constexpr size_t W_RTL = W_RTH + 32 * 1024 * 2;
static_assert(W_RTL + 32 * 1024 * 2 <= 8 * MiB, "weights overflow 2");
constexpr size_t W_GU = 8 * MiB;
constexpr size_t W_DN = 24 * MiB;
constexpr size_t SM_CNT = WS_SMALL;
constexpr size_t SM_LIST = WS_SMALL + 4096;
constexpr size_t SM_TOKW = SM_LIST + 24 * (size_t)T * 4;
constexpr size_t SM_LSUM = SM_TOKW + (size_t)T * 8;
constexpr size_t SM_SLOC = SM_LSUM + 16 * 32 * 256 * 8;
constexpr size_t SM_HK = SM_SLOC + 16 * 32 * 1024 * 8;
constexpr size_t SM_HV = SM_HK + 2048 * 128 * 2;
constexpr size_t SM_KC = SM_HV + 2048 * 128 * 2;
constexpr size_t SM_VC = SM_KC + 16 * 128 * 64 * 2;
constexpr size_t SM_SCAR = SM_VC + 16 * 128 * 64 * 2;
constexpr size_t SM_LCAR = SM_SCAR + 16 * 32 * 1024 * 8;
constexpr size_t SM_SSKV = SM_LCAR + 16 * 32 * 256 * 4;
constexpr size_t SM_END = SM_SSKV + (size_t)T * 2 * 4;
static_assert(SM_END <= WS_W, "small region overflow");

constexpr int LDS_BYTES = 65536;
constexpr int LDS_HALF = LDS_BYTES + 512;
constexpr int LDS_ALLOC = 2 * LDS_HALF + 64;

struct Params {
  const float* in[45];
  float* out;
  unsigned char* ws;
  int lo, hi;
};

DEVI float bf2f(bf16_t v) { return __uint_as_float(((unsigned)v) << 16); }
DEVI bf16_t f2bf(float f) { unsigned u = __float_as_uint(f); return (bf16_t)((u + 0x7fffu + ((u >> 16) & 1u)) >> 16); }
DEVI float wsum(float v) {
#pragma unroll
  for (int o = 32; o >= 1; o >>= 1) v += __shfl_xor(v, o);
  return v;
}
DEVI float sigmoidf_(float x) { return __builtin_amdgcn_rcpf(1.f + __expf(-x)); }
DEVI float gelu_tanh(float x) { const float u2 = 1.5957691216057308f * (x + 0.044715f * x * x * x); return x * __builtin_amdgcn_rcpf(1.f + __expf(-u2)); }
DEVI f32x16 mfma32(bf16x8 a, bf16x8 b, f32x16 c) { return __builtin_amdgcn_mfma_f32_32x32x16_bf16(a, b, c, 0, 0, 0); }
DEVI f32x4 mfma16(bf16x8 a, bf16x8 b, f32x4 c) { return __builtin_amdgcn_mfma_f32_16x16x32_bf16(a, b, c, 0, 0, 0); }
DEVI int vblock() { const int bx = (int)blockIdx.x, GB = (int)gridDim.x; return (GB % 8 == 0) ? (bx % 8) * (GB / 8) * 2 + (bx / 8) * 2 + hb_() : VBID; }
DEVI int crow(int r, int h) { return (r & 3) + 8 * (r >> 2) + 4 * h; }
typedef __bf16 bf16x2_t __attribute__((ext_vector_type(2)));
typedef float f32x2_t __attribute__((ext_vector_type(2)));
DEVI unsigned pk2bf(float lo, float hi) { f32x2_t v = {lo, hi}; bf16x2_t b = __builtin_convertvector(v, bf16x2_t); return __builtin_bit_cast(unsigned, b); }

template <class AF, class BF>
DEVI void gemm128(unsigned char* lds, int K, AF aload, BF bptr, f32x4 (&acc)[4][4]) {
  const int tid = HTID, wid = tid >> 6, lane = tid & 63, wr = wid >> 1, wc = wid & 1, fr = lane & 15, fq = lane >> 4;
#pragma unroll
  for (int m = 0; m < 4; ++m)
#pragma unroll
    for (int n = 0; n < 4; ++n) acc[m][n] = (f32x4){0.f, 0.f, 0.f, 0.f};
  const int lr = tid >> 3, ch = tid & 7;
  const int wofs = lr * 128 + ((ch ^ ((lr >> 1) & 7)) * 16);
  const int sw = (fr >> 1) & 7;
  const int aro = (wr * 64 + fr) * 128, bro = (wc * 64 + fr) * 128;
  const int nk = K >> 6;
  u32x4 ra[4], rb[4];
#pragma unroll
  for (int i = 0; i < 4; ++i) { ra[i] = aload(lr + 32 * i, ch * 8); rb[i] = *(const u32x4*)bptr(lr + 32 * i, ch * 8); }
  hsync();
#pragma unroll
  for (int i = 0; i < 4; ++i) { *(u32x4*)(lds + wofs + i * 4096) = ra[i]; *(u32x4*)(lds + 16384 + wofs + i * 4096) = rb[i]; }
  hsync();
  for (int kt = 0; kt < nk; ++kt) {
    const bool more = (kt + 1 < nk);
    if (more) {
      const int k = (kt + 1) * 64 + ch * 8;
#pragma unroll
      for (int i = 0; i < 4; ++i) { ra[i] = aload(lr + 32 * i, k); rb[i] = *(const u32x4*)bptr(lr + 32 * i, k); }
    }
    const unsigned char* bufA = lds + (kt & 1) * 32768;
    const unsigned char* bufB = bufA + 16384;
#pragma unroll
    for (int kk = 0; kk < 2; ++kk) {
      bf16x8 At[4], Bt[4];
      const int co = ((kk * 4 + fq) ^ sw) * 16;
#pragma unroll
      for (int m = 0; m < 4; ++m) At[m] = *(const bf16x8*)(bufA + aro + m * 2048 + co);
#pragma unroll
      for (int n = 0; n < 4; ++n) Bt[n] = *(const bf16x8*)(bufB + bro + n * 2048 + co);
#pragma unroll
      for (int m = 0; m < 4; ++m)
#pragma unroll
        for (int n = 0; n < 4; ++n) acc[m][n] = mfma16(Bt[n], At[m], acc[m][n]);
    }
    if (more) {
      unsigned char* nb = lds + ((kt + 1) & 1) * 32768;
#pragma unroll
      for (int i = 0; i < 4; ++i) { *(u32x4*)(nb + wofs + i * 4096) = ra[i]; *(u32x4*)(nb + 16384 + wofs + i * 4096) = rb[i]; }
    }
    hsync();
  }
}
template <class AF, class BF>
DEVI void gemm128g(unsigned char* lds, int K, AF aptr, BF bptr, f32x4 (&acc)[4][4]) {
  const int tid = HTID, wid = tid >> 6, lane = tid & 63, wr = wid >> 1, wc = wid & 1, fr = lane & 15, fq = lane >> 4;
#pragma unroll
  for (int m = 0; m < 4; ++m)
#pragma unroll
    for (int n = 0; n < 4; ++n) acc[m][n] = (f32x4){0.f, 0.f, 0.f, 0.f};
  const int lr = tid >> 3;
  const int chs = ((tid & 7) ^ ((lr >> 1) & 7)) * 8;
  const int sw = (fr >> 1) & 7;
  const int aro = (wr * 64 + fr) * 128, bro = (wc * 64 + fr) * 128;
  const int nk = K >> 6;
  LAS unsigned char* l3 = (LAS unsigned char*)lds;
#define G128_STAGE(buf, kbase)                                                                                                   \
  _Pragma("unroll") for (int i = 0; i < 4; ++i) {                                                                                 \
    __builtin_amdgcn_global_load_lds((const __attribute__((address_space(1))) unsigned*)aptr(lr + 32 * i, (kbase) + chs),          \
                                     (LAS unsigned*)(l3 + (buf) * 32768 + tid * 16 + i * 4096), 16, 0, 0);                           \
    __builtin_amdgcn_global_load_lds((const __attribute__((address_space(1))) unsigned*)bptr(lr + 32 * i, (kbase) + chs),          \
                                     (LAS unsigned*)(l3 + (buf) * 32768 + 16384 + tid * 16 + i * 4096), 16, 0, 0);                   \
  }
  hsync();
  G128_STAGE(0, 0)
  asm volatile("s_waitcnt vmcnt(0)" ::: "memory");
  hsync();
  for (int kt = 0; kt < nk; ++kt) {
    if (kt + 1 < nk) { G128_STAGE((kt + 1) & 1, (kt + 1) * 64) }
    const unsigned char* bufA = lds + (kt & 1) * 32768;
    const unsigned char* bufB = bufA + 16384;
#pragma unroll
    for (int kk = 0; kk < 2; ++kk) {
      bf16x8 At[4], Bt[4];
      const int co = ((kk * 4 + fq) ^ sw) * 16;
#pragma unroll
      for (int m = 0; m < 4; ++m) At[m] = *(const bf16x8*)(bufA + aro + m * 2048 + co);
#pragma unroll
      for (int n = 0; n < 4; ++n) Bt[n] = *(const bf16x8*)(bufB + bro + n * 2048 + co);
#pragma unroll
      for (int m = 0; m < 4; ++m)
#pragma unroll
        for (int n = 0; n < 4; ++n) acc[m][n] = mfma16(Bt[n], At[m], acc[m][n]);
    }
    asm volatile("s_waitcnt vmcnt(0)" ::: "memory");
    hsync();
  }
#undef G128_STAGE
}
DEVI void gemm128p(unsigned char* lds, int K, const bf16_t* Ab, size_t lda, const bf16_t* Bb, size_t ldb, f32x4 (&acc)[4][4], int& par, bool staged, bool has_next, const bf16_t* Abn, const bf16_t* Bbn) {
  const int tid = HTID, wid = tid >> 6, lane = tid & 63, wr = wid >> 1, wc = wid & 1, fr = lane & 15, fq = lane >> 4;
#pragma unroll
  for (int m = 0; m < 4; ++m)
#pragma unroll
    for (int n = 0; n < 4; ++n) acc[m][n] = (f32x4){0.f, 0.f, 0.f, 0.f};
  const int lr = tid >> 3;
  const int chs = ((tid & 7) ^ ((lr >> 1) & 7)) * 8;
  const int sw = (fr >> 1) & 7;
  const int aro = (wr * 64 + fr) * 128, bro = (wc * 64 + fr) * 128;
  const int nk = K >> 6;
  LAS unsigned char* l3 = (LAS unsigned char*)lds;
#define GP_STAGE(buf, kbase, APTR, BPTR)                                                                                             \
  _Pragma("unroll") for (int i = 0; i < 4; ++i) {                                                                                 \
    __builtin_amdgcn_global_load_lds((const __attribute__((address_space(1))) unsigned*)((APTR) + (size_t)(lr + 32 * i) * lda + (kbase) + chs),            \
                                     (LAS unsigned*)(l3 + (buf) * 32768 + tid * 16 + i * 4096), 16, 0, 0);                           \
    __builtin_amdgcn_global_load_lds((const __attribute__((address_space(1))) unsigned*)((BPTR) + (size_t)(lr + 32 * i) * ldb + (kbase) + chs),            \
                                     (LAS unsigned*)(l3 + (buf) * 32768 + 16384 + tid * 16 + i * 4096), 16, 0, 0);                   \
  }
  if (!staged) {
    hsync();
    GP_STAGE(par, 0, Ab, Bb)
    asm volatile("s_waitcnt vmcnt(0)" ::: "memory");
    hsync();
  }
  for (int kt = 0; kt < nk; ++kt) {
    const int cur = (par + kt) & 1;
    { const bool inner = kt + 1 < nk; if (inner || has_next) { const bf16_t* ap_ = inner ? Ab : Abn; const bf16_t* bp_ = inner ? Bb : Bbn; const int kb_ = inner ? (kt + 1) * 64 : 0; GP_STAGE(cur ^ 1, kb_, ap_, bp_) } }
    const unsigned char* bufA = lds + cur * 32768;
    const unsigned char* bufB = bufA + 16384;
#pragma unroll
    for (int kk = 0; kk < 2; ++kk) {
      bf16x8 At[4], Bt[4];
      const int co = ((kk * 4 + fq) ^ sw) * 16;
#pragma unroll
      for (int m = 0; m < 4; ++m) At[m] = *(const bf16x8*)(bufA + aro + m * 2048 + co);
#pragma unroll
      for (int n = 0; n < 4; ++n) Bt[n] = *(const bf16x8*)(bufB + bro + n * 2048 + co);
#pragma unroll
      for (int m = 0; m < 4; ++m)
#pragma unroll
        for (int n = 0; n < 4; ++n) acc[m][n] = mfma16(Bt[n], At[m], acc[m][n]);
    }
    asm volatile("s_waitcnt vmcnt(0)" ::: "memory");
    hsync();
  }
  par = (par + nk) & 1;
#undef GP_STAGE
}
template <class AF, class BF>
DEVI void gemm128h(unsigned char* lds, int K, AF aptr, BF bptr, f32x4 (&acc)[2][4]) {
  const int tid = HTID, wid = tid >> 6, lane = tid & 63, fr = lane & 15, fq = lane >> 4;
#pragma unroll
  for (int m = 0; m < 2; ++m)
#pragma unroll
    for (int n = 0; n < 4; ++n) acc[m][n] = (f32x4){0.f, 0.f, 0.f, 0.f};
  const int lr = tid >> 3;
  const int chs = ((tid & 7) ^ ((lr >> 1) & 7)) * 8;
  const int sw = (fr >> 1) & 7;
  const int aro = (wid * 32 + fr) * 128, bro = fr * 128;
  const int nk = K >> 6;
  LAS unsigned char* l3 = (LAS unsigned char*)lds;
#define GH_STAGE(buf, kbase)                                                                                                     \
  { _Pragma("unroll") for (int i = 0; i < 4; ++i)                                                                                 \
      __builtin_amdgcn_global_load_lds((const __attribute__((address_space(1))) unsigned*)aptr(lr + 32 * i, (kbase) + chs),        \
                                       (LAS unsigned*)(l3 + (buf) * 32768 + tid * 16 + i * 4096), 16, 0, 0);                         \
    _Pragma("unroll") for (int i = 0; i < 2; ++i)                                                                                 \
      __builtin_amdgcn_global_load_lds((const __attribute__((address_space(1))) unsigned*)bptr(lr + 32 * i, (kbase) + chs),        \
                                       (LAS unsigned*)(l3 + (buf) * 32768 + 16384 + tid * 16 + i * 4096), 16, 0, 0); }
  hsync();
  GH_STAGE(0, 0)
  asm volatile("s_waitcnt vmcnt(0)" ::: "memory");
  hsync();
  for (int kt = 0; kt < nk; ++kt) {
    if (kt + 1 < nk) { GH_STAGE((kt + 1) & 1, (kt + 1) * 64) }
    const unsigned char* bufA = lds + (kt & 1) * 32768;
    const unsigned char* bufB = bufA + 16384;
#pragma unroll
    for (int kk = 0; kk < 2; ++kk) {
      bf16x8 At[2], Bt[4];
      const int co = ((kk * 4 + fq) ^ sw) * 16;
#pragma unroll
      for (int m = 0; m < 2; ++m) At[m] = *(const bf16x8*)(bufA + aro + m * 2048 + co);
#pragma unroll
      for (int n = 0; n < 4; ++n) Bt[n] = *(const bf16x8*)(bufB + bro + n * 2048 + co);
#pragma unroll
      for (int m = 0; m < 2; ++m)
#pragma unroll
        for (int n = 0; n < 4; ++n) acc[m][n] = mfma16(Bt[n], At[m], acc[m][n]);
    }
    asm volatile("s_waitcnt vmcnt(0)" ::: "memory");
    hsync();
  }
#undef GH_STAGE
}
#define GEMM_EPI_LOOP(body)                                                                 \
  {                                                                                         \
    const int _tid = HTID, _wid = _tid >> 6, _lane = _tid & 63, _wr = _wid >> 1, _wc = _wid & 1, _fr = _lane & 15, _fq = _lane >> 4; \
    _Pragma("unroll") for (int m = 0; m < 4; ++m) _Pragma("unroll") for (int n = 0; n < 4; ++n) _Pragma("unroll") for (int j = 0; j < 4; ++j) { \
      const int er = _wr * 64 + m * 16 + _fr, ec = _wc * 64 + n * 16 + _fq * 4 + j; const float ev = acc[m][n][j]; body }                      \
  }
#define GEMM_EPI4(body)                                                                     \
  {                                                                                         \
    const int _tid = HTID, _wid = _tid >> 6, _lane = _tid & 63, _wr = _wid >> 1, _wc = _wid & 1, _fr = _lane & 15, _fq = _lane >> 4; \
    _Pragma("unroll") for (int m = 0; m < 4; ++m) _Pragma("unroll") for (int n = 0; n < 4; ++n) {                                             \
      const int er = _wr * 64 + m * 16 + _fr, ec0 = _wc * 64 + n * 16 + _fq * 4; const f32x4 ev4 = acc[m][n]; body }                          \
  }
DEVI void st_bf16x4(bf16_t* p, f32x4 v) { uint2 o; o.x = pk2bf(v[0], v[1]); o.y = pk2bf(v[2], v[3]); *(uint2*)p = o; }

namespace pg8 {
#define PG8_LAS __attribute__((address_space(3)))
typedef unsigned short bf16_t;
typedef short bf16x8 __attribute__((ext_vector_type(8)));
typedef float f32x4 __attribute__((ext_vector_type(4)));
typedef unsigned u32x4 __attribute__((ext_vector_type(4)));
constexpr int BM = 256, BK = 64, HALF = 128, HTB = HALF * BK * 2  , STAGE_BYTES = 8 * HTB, NXCD = 8, WGM = 8;

__host__ __device__ __forceinline__ int lds_byte(int r, int c) { const int st = (r >> 4) * 2 + (c >> 5), rr = r & 15, cc = c & 31, ob = rr * 64 + cc * 2; return st * 1024 + (ob ^ (((ob >> 9) & 1) << 5)); }
__host__ __device__ __forceinline__ void stage_rc(int b, int& R, int& C) { const int st = b / 1024, sb = b % 1024, swz = sb ^ (((sb >> 9) & 1) << 5); R = (st >> 1) * 16 + swz / 64; C = (st & 1) * 32 + (swz % 64) / 2; }
__host__ __device__ __forceinline__ int perm32(int rho) { const int n = rho >> 4, i = rho & 15; return 8 * (i >> 2) + 4 * n + (i & 3); }

struct Unit { int pm, pn; };
struct Gemm { const bf16_t* A; const bf16_t* Bt; int M, N, K; };

struct StaticOrder {
    int nM, nN, nwg, G, c;
    __host__ __device__ void init(int M, int N, int G_, int c_) { nM = M / BM; nN = N / BM; nwg = nM * nN; G = G_; c = c_; }
    __host__ __device__ bool next(int i, Unit& u) const {
        const long L = (long)i * G + c; if (L >= nwg) return false;
        int wgid = (int)L; { const int q = nwg / NXCD, r = nwg % NXCD, xcd = wgid % NXCD, off = wgid / NXCD; wgid = (xcd < r ? xcd * (q + 1) : r * (q + 1) + (xcd - r) * q) + off; }
        const int nig = WGM * nN, gid = wgid / nig, fm = gid * WGM, gsz = (nM - fm) < WGM ? (nM - fm) : WGM;
        u.pm = fm + ((wgid % nig) % gsz); u.pn = (wgid % nig) / gsz; return true;
    }
    __device__ __forceinline__ void a_ready(const Unit&) const {}
    __device__ __forceinline__ void done(const Unit&) const {}
};

__device__ __forceinline__ unsigned cvt_pk_bf16(float lo, float hi) { unsigned r; asm volatile("v_cvt_pk_bf16_f32 %0, %1, %2" : "=v"(r) : "v"(lo), "v"(hi)); return r; }
typedef float f32x2 __attribute__((ext_vector_type(2)));
__device__ __forceinline__ f32x2 gelu_pk(f32x2 v) {
    const f32x2 av = __builtin_elementwise_abs(v), d = av * 0.2316418882f + 1.0f;
    f32x2 t; t.x = __builtin_amdgcn_rcpf(d.x); t.y = __builtin_amdgcn_rcpf(d.y);
    f32x2 q = t * 0.5307027145f + (-0.7265760135f); q = q * t + 0.7107068705f; q = q * t + (-0.142248368f); q = q * t + 0.127414796f; q = q * t;
    const f32x2 s = (v * v) * (-0.72134752044f);
    f32x2 e; e.x = __builtin_amdgcn_exp2f(s.x); e.y = __builtin_amdgcn_exp2f(s.y);
    const f32x2 m = v * (q * e), r = v - m;
    f32x2 o; o.x = v.x < 0.f ? m.x : r.x; o.y = v.y < 0.f ? m.y : r.y; return o;
}

template <int ACT  > struct EpiBf16 {
    static constexpr bool PERM = true, AFTER_DRAIN = false; static_assert(ACT == 0 || ACT == 1, "EpiBf16: ACT is 0 (none) or 1 (gelu_pk)");
    bf16_t* O; int ldc; const float* bias; int split_cols; size_t split_stride; float scale0;
    __device__ __forceinline__ void operator()(const f32x4 (&acc)[2][2][4][2], const Unit& u, int wr, int wc, int fr, int fq) const {
        const int row0 = u.pm * BM + wr * 64 + fr; int colt = u.pn * BM; bf16_t* base = O;
        float sc = 1.f; if (split_cols) { const int t = colt / split_cols; base += (size_t)t * split_stride; colt -= t * split_cols; if (t == 0) sc = scale0; }
        const int col0 = colt + wc * 32 + 8 * fq, bcol0 = u.pn * BM + wc * 32 + 8 * fq;
        f32x4 bv[2][2];
#pragma unroll
        for (int bj = 0; bj < 2; ++bj)
#pragma unroll
            for (int n = 0; n < 2; ++n) bv[bj][n] = bias ? *(const f32x4*)(bias + bcol0 + bj * HALF + 4 * n) : (f32x4){0.f, 0.f, 0.f, 0.f};
#pragma unroll
        for (int ai = 0; ai < 2; ++ai)
#pragma unroll
            for (int m = 0; m < 4; ++m) { bf16_t* rowp = base + (size_t)(row0 + ai * HALF + m * 16) * ldc + col0;
#pragma unroll
                for (int bj = 0; bj < 2; ++bj) { f32x4 v0 = acc[ai][bj][m][0] + bv[bj][0], v1 = acc[ai][bj][m][1] + bv[bj][1];
                    if (ACT == 1) { f32x2 a = gelu_pk((f32x2){v0[0], v0[1]}), b = gelu_pk((f32x2){v0[2], v0[3]}), c = gelu_pk((f32x2){v1[0], v1[1]}), d = gelu_pk((f32x2){v1[2], v1[3]});
                        v0 = (f32x4){a.x, a.y, b.x, b.y}; v1 = (f32x4){c.x, c.y, d.x, d.y}; }
                    v0 = v0 * sc; v1 = v1 * sc; u32x4 w; w.x = cvt_pk_bf16(v0[0], v0[1]); w.y = cvt_pk_bf16(v0[2], v0[3]); w.z = cvt_pk_bf16(v1[0], v1[1]); w.w = cvt_pk_bf16(v1[2], v1[3]);
                    *(u32x4*)(rowp + bj * HALF) = w; } }
    }
};

template <class Epi, class Sched, bool ALIGN_EPI = false, bool SP2 = false>
__device__ __forceinline__ void gemm_phase(PG8_LAS unsigned char* lds, const Gemm g, const Sched& S, const Epi& E) {
    const int tid = threadIdx.x, wid = __builtin_amdgcn_readfirstlane(tid >> 6), lane = tid & 63, wr = wid >> 2, wc = wid & 3, fr = lane & 15, fq = lane >> 4;
    const int K = g.K, nt = K / BK;
    unsigned voffA[2], voffB[2];
#pragma unroll
    for (int i = 0; i < 2; ++i) { int R, C; stage_rc(tid * 16 + i * 8192, R, C); const int Rb = Epi::PERM ? ((R & ~31) + perm32(R & 31)) : R;
        voffA[i] = (unsigned)(R * K + C) * 2u; voffB[i] = (unsigned)(Rb * K + C) * 2u; }
    const size_t kstep = (size_t)(BK * 2);
    const size_t hstep = (size_t)HALF * K * 2;
    const size_t tstep = 2 * hstep;
    const unsigned ldsw = (unsigned)wid * 1024u;
    const int aoff = lds_byte(wr * 64 + fr, fq * 8), boff = lds_byte(wc * 32 + fr, fq * 8);
#define PG8_SA(b, h) (((b) * 2 + (h)) * HTB)
#define PG8_SB(b, h) ((4 + (b) * 2 + (h)) * HTB)
#define PG8_STAGE(bufoff, gbase, voff) do { _Pragma("unroll") for (int _i = 0; _i < 2; ++_i) \
        __builtin_amdgcn_global_load_lds((const unsigned*)((const char*)(gbase) + (voff)[_i]), (PG8_LAS unsigned*)(lds + (bufoff) + ldsw + _i * 8192), 16, 0, 0); } while (0)
#define PG8_LDA(dst, b, h) do { _Pragma("unroll") for (int m = 0; m < 4; ++m) _Pragma("unroll") for (int k = 0; k < 2; ++k) dst[m][k] = *(const PG8_LAS bf16x8*)(lds + PG8_SA(b, h) + aoff + m * 2048 + k * 1024); } while (0)
#define PG8_LDB(dst, b, h) do { _Pragma("unroll") for (int n = 0; n < 2; ++n) _Pragma("unroll") for (int k = 0; k < 2; ++k) dst[n][k] = *(const PG8_LAS bf16x8*)(lds + PG8_SB(b, h) + boff + n * 2048 + k * 1024); } while (0)
#define PG8_MMA(ai, bj, At, Bt) do { __builtin_amdgcn_s_setprio(1); _Pragma("unroll") for (int m = 0; m < 4; ++m) _Pragma("unroll") for (int n = 0; n < 2; ++n) _Pragma("unroll") for (int k = 0; k < 2; ++k) \
        acc[ai][bj][m][n] = __builtin_amdgcn_mfma_f32_16x16x32_bf16(Bt[n][k], At[m][k], acc[ai][bj][m][n], 0, 0, 0); __builtin_amdgcn_s_setprio(0); } while (0)
#define PG8_WAIT_V(n) asm volatile("s_waitcnt vmcnt(" #n ")" ::: "memory")
#define PG8_WAIT_L(n) asm volatile("s_waitcnt lgkmcnt(" #n ")" ::: "memory")
#define PG8_BAR __builtin_amdgcn_s_barrier()
#define PG8_SCHED __builtin_amdgcn_sched_barrier(0)
    Unit cur, nxt; int ui = 0;
    if (!S.next(0, cur)) return;
    f32x4 acc[2][2][4][2];
#pragma unroll
    for (int a = 0; a < 2; ++a)
#pragma unroll
        for (int b = 0; b < 2; ++b)
#pragma unroll
            for (int m = 0; m < 4; ++m)
#pragma unroll
                for (int n = 0; n < 2; ++n) acc[a][b][m][n] = (f32x4){0.f, 0.f, 0.f, 0.f};
    bf16x8 At[4][2], B0[2][2], B1[2][2];
    const char* cA = (const char*)g.A + (size_t)cur.pm * tstep; const char* cB = (const char*)g.Bt + (size_t)cur.pn * tstep;
    S.a_ready(cur);
    if constexpr (SP2) {
        PG8_STAGE(PG8_SB(0, 0), cB, voffB); PG8_STAGE(PG8_SB(0, 1), cB + hstep, voffB); PG8_STAGE(PG8_SA(0, 0), cA, voffA); PG8_STAGE(PG8_SA(0, 1), cA + hstep, voffA);
        if (wr == 1) PG8_BAR;
        PG8_WAIT_V(2); PG8_BAR;
        PG8_STAGE(PG8_SB(1, 0), cB + kstep, voffB); PG8_STAGE(PG8_SA(1, 0), cA + kstep, voffA); PG8_STAGE(PG8_SB(1, 1), cB + hstep + kstep, voffB);
        PG8_WAIT_V(6); PG8_BAR;
    } else {
        PG8_STAGE(PG8_SB(0, 0), cB, voffB); PG8_STAGE(PG8_SA(0, 0), cA, voffA); PG8_STAGE(PG8_SB(0, 1), cB + hstep, voffB); PG8_STAGE(PG8_SA(0, 1), cA + hstep, voffA);
        if (wr == 1) PG8_BAR;
        PG8_WAIT_V(4); PG8_BAR;
        PG8_STAGE(PG8_SB(1, 0), cB + kstep, voffB); PG8_STAGE(PG8_SA(1, 0), cA + kstep, voffA); PG8_STAGE(PG8_SB(1, 1), cB + hstep + kstep, voffB);
        PG8_WAIT_V(6); PG8_BAR;
    }
    for (;;) {
        const bool has_next = S.next(ui + 1, nxt);
        const char* nA = has_next ? (const char*)g.A + (size_t)nxt.pm * tstep : cA; const char* nB = has_next ? (const char*)g.Bt + (size_t)nxt.pn * tstep : cB;
        for (int t = 0; t < nt; t += 2) {
            const bool last = (t == nt - 2);
            const char* a1 = cA + (size_t)(t + 1) * kstep;
            const char* a2 = last ? nA : cA + (size_t)(t + 2) * kstep; const char* b2 = last ? nB : cB + (size_t)(t + 2) * kstep;
            const char* a3 = a2 + kstep; const char* b3 = b2 + kstep;
            if (last && has_next) S.a_ready(nxt);
            if constexpr (SP2) {
            PG8_LDB(B0, 0, 0); PG8_LDB(B1, 0, 1); PG8_SCHED; PG8_LDA(At, 0, 0); PG8_STAGE(PG8_SA(1, 1), a1 + hstep, voffA);
            PG8_WAIT_V(8); PG8_WAIT_L(0); PG8_BAR; PG8_MMA(0, 0, At, B0); PG8_MMA(0, 1, At, B1); PG8_BAR; PG8_SCHED;
            PG8_LDA(At, 0, 1); PG8_STAGE(PG8_SB(0, 0), b2, voffB); PG8_STAGE(PG8_SB(0, 1), b2 + hstep, voffB); PG8_STAGE(PG8_SA(0, 0), a2, voffA);
            PG8_WAIT_V(8); PG8_WAIT_L(0); PG8_BAR; PG8_MMA(1, 0, At, B0); PG8_MMA(1, 1, At, B1); PG8_BAR; PG8_SCHED;
            PG8_LDB(B0, 1, 0); PG8_LDB(B1, 1, 1); PG8_SCHED; PG8_LDA(At, 1, 0); PG8_STAGE(PG8_SA(0, 1), a2 + hstep, voffA);
            PG8_WAIT_V(8); PG8_WAIT_L(0); PG8_BAR; PG8_MMA(0, 0, At, B0); PG8_MMA(0, 1, At, B1); PG8_BAR; PG8_SCHED;
            PG8_LDA(At, 1, 1); PG8_STAGE(PG8_SB(1, 0), b3, voffB); PG8_STAGE(PG8_SB(1, 1), b3 + hstep, voffB); PG8_STAGE(PG8_SA(1, 0), a3, voffA);
            PG8_WAIT_V(8); PG8_WAIT_L(0); PG8_BAR; PG8_MMA(1, 0, At, B0); PG8_MMA(1, 1, At, B1); PG8_BAR; PG8_SCHED;
            } else {
            PG8_LDB(B0, 0, 0); PG8_SCHED; PG8_LDA(At, 0, 0); PG8_STAGE(PG8_SA(1, 1), a1 + hstep, voffA);
            PG8_WAIT_L(8); PG8_BAR; PG8_WAIT_L(0); PG8_MMA(0, 0, At, B0); PG8_BAR; PG8_SCHED;
            PG8_LDB(B1, 0, 1); PG8_STAGE(PG8_SB(0, 0), b2, voffB);
            PG8_BAR; PG8_WAIT_L(0); PG8_MMA(0, 1, At, B1); PG8_BAR;
            PG8_LDA(At, 0, 1); PG8_STAGE(PG8_SA(0, 0), a2, voffA);
            PG8_BAR; PG8_WAIT_L(0); PG8_MMA(1, 0, At, B0); PG8_BAR; PG8_SCHED;
            PG8_STAGE(PG8_SB(0, 1), b2 + hstep, voffB);
            PG8_WAIT_V(6); PG8_BAR; PG8_MMA(1, 1, At, B1); PG8_BAR;
            PG8_LDB(B0, 1, 0); PG8_SCHED; PG8_LDA(At, 1, 0); PG8_STAGE(PG8_SA(0, 1), a2 + hstep, voffA);
            PG8_WAIT_L(8); PG8_BAR; PG8_WAIT_L(0); PG8_MMA(0, 0, At, B0); PG8_BAR; PG8_SCHED;
            PG8_LDB(B1, 1, 1); PG8_STAGE(PG8_SB(1, 0), b3, voffB);
            PG8_BAR; PG8_WAIT_L(0); PG8_MMA(0, 1, At, B1); PG8_BAR;
            PG8_LDA(At, 1, 1); PG8_STAGE(PG8_SA(1, 0), a3, voffA);
            PG8_BAR; PG8_WAIT_L(0); PG8_MMA(1, 0, At, B0); PG8_BAR; PG8_SCHED;
            PG8_STAGE(PG8_SB(1, 1), b3 + hstep, voffB);
            PG8_WAIT_V(6); PG8_BAR; PG8_MMA(1, 1, At, B1); PG8_BAR;
            }
        }
        if constexpr (ALIGN_EPI) { if (wr == 0) PG8_BAR; }
        if constexpr (!Epi::AFTER_DRAIN) { E(acc, cur, wr, wc, fr, fq); S.done(cur); }
        if (!has_next) break;
#pragma unroll
        for (int a = 0; a < 2; ++a)
#pragma unroll
            for (int b = 0; b < 2; ++b)
#pragma unroll
                for (int m = 0; m < 4; ++m)
#pragma unroll
                    for (int n = 0; n < 2; ++n) acc[a][b][m][n] = (f32x4){0.f, 0.f, 0.f, 0.f};
        cur = nxt; cA = nA; cB = nB; ++ui;
        if constexpr (ALIGN_EPI) { if (wr == 1) PG8_BAR; }
    }
    PG8_WAIT_V(0);
    if constexpr (!ALIGN_EPI) { if (wr == 0) PG8_BAR; }
    PG8_BAR;
    if constexpr (Epi::AFTER_DRAIN) { E.fused(acc, cur, wr, wc, fr, fq, lds, wid, lane); S.done(cur); }
#undef PG8_SA
#undef PG8_SB
#undef PG8_STAGE
#undef PG8_LDA
#undef PG8_LDB
#undef PG8_MMA
#undef PG8_WAIT_V
#undef PG8_WAIT_L
#undef PG8_BAR
#undef PG8_SCHED
}
}

struct EpiG1 {
  static constexpr bool PERM = false, AFTER_DRAIN = false;
  bf16_t* PROJ; bf16_t* QN; bf16_t* KS; bf16_t* KW; float* SSKV; const float2* RN; const float* g_q; const float* g_k;
  __device__ __forceinline__ void operator()(const pg8::f32x4 (&acc)[2][2][4][2], const pg8::Unit& u, int wr, int wc, int fr, int fq) const {
    const bool t1 = (u.pn == 1), t5 = (u.pn == 5);
#pragma unroll
    for (int ai = 0; ai < 2; ++ai)
#pragma unroll
      for (int m = 0; m < 4; ++m) {
        const size_t t = (size_t)u.pm * 256 + ai * 128 + wr * 64 + m * 16 + fr;
        if (!(t1 || t5) || (t1 && wc < 2)) {
#pragma unroll
          for (int bj = 0; bj < 2; ++bj)
#pragma unroll
            for (int n = 0; n < 2; ++n) st_bf16x4(PROJ + t * DINP + u.pn * 256 + bj * 128 + wc * 32 + n * 16 + fq * 4, acc[ai][bj][m][n]);
        }
        if (t1 || t5) {
          float ss = 0.f;
#pragma unroll
          for (int bj = 0; bj < 2; ++bj)
#pragma unroll
            for (int n = 0; n < 2; ++n) { const pg8::f32x4 v = acc[ai][bj][m][n]; ss += v[0] * v[0] + v[1] * v[1] + v[2] * v[2] + v[3] * v[3]; }
          ss += __shfl_xor(ss, 16); ss += __shfl_xor(ss, 32);
          if (t1 && wc < 2) { if (fq == 0) SSKV[t * 2 + wc] = ss; }
          else {
            const float rs = rsqrtf(ss * (1.f / 64) + EPS);
            const float* gg = t5 ? g_q : (g_k + (wc == 2 ? 64 : 128));
            const float sc = t5 ? (0.125f * LOG2E) : 1.f;
            bf16_t* dst = t5 ? (QN + t * 256 + wc * 64) : ((wc == 2 ? KS : KW) + t * 64);
#pragma unroll
            for (int bj = 0; bj < 2; ++bj)
#pragma unroll
              for (int n = 0; n < 2; ++n) {
                const int e0 = 32 * bj + 16 * n + 4 * fq;
                const float4 g4 = *(const float4*)(gg + e0);
                pg8::f32x4 v = acc[ai][bj][m][n];
                v[0] *= rs * g4.x; v[1] *= rs * g4.y; v[2] *= rs * g4.z; v[3] *= rs * g4.w;
                if (bj == 0 && n == 0) {
#pragma unroll
                  for (int j = 0; j < 4; ++j) {
                    const float x = v[j], partner = __shfl_xor(x, 32);
                    const int d = fq * 4 + j; const float2 cs2 = RN[t * 8 + (d & 7)];
                    v[j] = (d < 8) ? (x * cs2.x - partner * cs2.y) : (partner * cs2.y + x * cs2.x);
                  }
                }
                st_bf16x4(dst + e0, v * sc);
              }
          }
        }
      }
  }
};

struct EpiRes {
  static constexpr bool PERM = false, AFTER_DRAIN = false;
  const float* xin; float* out;
  __device__ __forceinline__ void operator()(const pg8::f32x4 (&acc)[2][2][4][2], const pg8::Unit& u, int wr, int wc, int fr, int fq) const {
#pragma unroll
    for (int ai = 0; ai < 2; ++ai)
#pragma unroll
      for (int m = 0; m < 4; ++m) {
        const size_t row = (size_t)u.pm * 256 + ai * 128 + wr * 64 + m * 16 + fr;
#pragma unroll
        for (int bj = 0; bj < 2; ++bj)
#pragma unroll
          for (int n = 0; n < 2; ++n) { const size_t o = row * 1024 + u.pn * 256 + bj * 128 + wc * 32 + n * 16 + fq * 4; *(pg8::f32x4*)(out + o) = *(const pg8::f32x4*)(xin + o) + acc[ai][bj][m][n]; }
      }
  }
};

template <class RM>
DEVI void transpose_tiles(const float* src, int K, int N, bf16_t* dst, int ldk, RM rowmap, unsigned char* lds, int& cursor, const float* kscale = nullptr) {
  float* tl = (float*)lds;
  const int tk = K / 64, tn = (N + 63) / 64, nt = tk * tn;
  const int tid = HTID;
  const int G_ = VGRID;
  for (int it = (VBID - cursor % G_ + G_) % G_; it < nt; it += G_) {
    const int kt = it / tn, ntile = it % tn, k0 = kt * 64, n0 = ntile * 64;
    hsync();
#pragma unroll
    for (int q = 0; q < 4; ++q) {
      const int r = (tid >> 4) + 16 * q, c4 = (tid & 15) * 4;
      const float* sp = src + (size_t)(k0 + r) * N + n0 + c4;
      float4 v;
      if (n0 + c4 + 3 < N) v = *(const float4*)sp;
      else { v.x = (n0 + c4 < N) ? sp[0] : 0.f; v.y = (n0 + c4 + 1 < N) ? sp[1] : 0.f; v.z = (n0 + c4 + 2 < N) ? sp[2] : 0.f; v.w = 0.f; }
      if (kscale) { const float ks = kscale[k0 + r]; v.x *= ks; v.y *= ks; v.z *= ks; v.w *= ks; }
      tl[r * 65 + c4] = v.x; tl[r * 65 + c4 + 1] = v.y; tl[r * 65 + c4 + 2] = v.z; tl[r * 65 + c4 + 3] = v.w;
    }
    hsync();
    const int n = tid >> 2, kc = (tid & 3) * 16;
    if (n0 + n < N) {
      unsigned w[8];
#pragma unroll
      for (int i = 0; i < 8; ++i) w[i] = pk2bf(tl[(kc + 2 * i) * 65 + n], tl[(kc + 2 * i + 1) * 65 + n]);
      uint4* o = (uint4*)(dst + (size_t)rowmap(n0 + n) * ldk + k0 + kc);
      o[0] = make_uint4(w[0], w[1], w[2], w[3]); o[1] = make_uint4(w[4], w[5], w[6], w[7]);
    }
  }
  cursor += nt;
}
DEVI void rmsnorm_rows(const float* x, const float* g, bf16_t* xn) {
  const int lane = HTID & 63, gw = VBID * 4 + (HTID >> 6), NGW = VGRID * 4;
  float4 gg[4];
#pragma unroll
  for (int j = 0; j < 4; ++j) gg[j] = ((const float4*)g)[lane + 64 * j];
  for (int t0 = gw * 4; t0 < T; t0 += NGW * 4) {
    float4 v[4][4];
#pragma unroll
    for (int q = 0; q < 4; ++q)
#pragma unroll
      for (int j = 0; j < 4; ++j) v[q][j] = ((const float4*)(x + (size_t)(t0 + q) * D))[lane + 64 * j];
#pragma unroll
    for (int q = 0; q < 4; ++q) {
      float s = 0.f;
#pragma unroll
      for (int j = 0; j < 4; ++j) s += v[q][j].x * v[q][j].x + v[q][j].y * v[q][j].y + v[q][j].z * v[q][j].z + v[q][j].w * v[q][j].w;
      const float rs = rsqrtf(wsum(s) * (1.f / D) + EPS);
#pragma unroll
      for (int j = 0; j < 4; ++j) {
        uint2 o; o.x = pk2bf(v[q][j].x * rs * gg[j].x, v[q][j].y * rs * gg[j].y); o.y = pk2bf(v[q][j].z * rs * gg[j].z, v[q][j].w * rs * gg[j].w);
        ((uint2*)(xn + (size_t)(t0 + q) * D))[lane + 64 * j] = o;
      }
    }
  }
}
DEVI void phase_prep(const Params& p, unsigned char* lds) {
  const size_t gtid = (size_t)VBID * NTHREADS + HTID, gn = (size_t)VGRID * NTHREADS;
  unsigned char* ws = p.ws;
  if (gtid < 64) ((int*)(ws + SM_CNT))[gtid] = 0;
  auto ident = [](int n) { return n; };
  int cursor = 0;
  for (int l = 0; l < NL; ++l) {
    unsigned char* wl = ws + WS_W + l * WS_WL;
    transpose_tiles(p.in[3] + (size_t)l * D * DIN, D, DIN, (bf16_t*)(wl + W_IN), D, [](int n) { return colmap(n); }, lds, cursor);
    for (size_t i = gtid; i < (size_t)20 * D; i += gn) ((bf16_t*)(wl + W_IN))[(size_t)236 * D + i] = 0;
    transpose_tiles(p.in[36] + (size_t)l * D * D, D, D, (bf16_t*)(wl + W_OUT), D, ident, lds, cursor);
    transpose_tiles(p.in[6] + (size_t)l * 192 * 384, 192, 384, (bf16_t*)(wl + W_UQ), 192, ident, lds, cursor, p.in[4] + l * 192);
    transpose_tiles(p.in[7] + (size_t)l * 128 * 512, 128, 512, (bf16_t*)(wl + W_UKV), 128, ident, lds, cursor, p.in[5] + l * 128);
    transpose_tiles(p.in[25] + (size_t)l * 256 * 256, 256, 256, (bf16_t*)(wl + W_GLU), 256, ident, lds, cursor);
    transpose_tiles(p.in[30] + (size_t)l * 2048 * 128, 2048, 128, (bf16_t*)(wl + W_1K), 2048, ident, lds, cursor);
    transpose_tiles(p.in[33] + (size_t)l * 2048 * 128, 2048, 128, (bf16_t*)(wl + W_1V), 2048, ident, lds, cursor);
    transpose_tiles(p.in[31] + (size_t)l * 128 * 64, 128, 64, (bf16_t*)(wl + W_2K), 128, ident, lds, cursor);
    transpose_tiles(p.in[34] + (size_t)l * 128 * 64, 128, 64, (bf16_t*)(wl + W_2V), 128, ident, lds, cursor);
    for (int h = 0; h < 4; ++h) {
      transpose_tiles(p.in[12] + ((size_t)l * 4 + h) * 64 * 64, 64, 64, (bf16_t*)(wl + W_LRU) + h * 128 * 64, 64, ident, lds, cursor);
      transpose_tiles(p.in[14] + ((size_t)l * 4 + h) * 64 * 64, 64, 64, (bf16_t*)(wl + W_LRU) + h * 128 * 64 + 64 * 64, 64, ident, lds, cursor);
    }
    for (int e = 0; e < 16; ++e) {
      bf16_t* dg = (bf16_t*)(wl + W_GU) + (size_t)e * 512 * 1024;
      transpose_tiles(p.in[42] + ((size_t)l * 16 + e) * 1024 * 256, 1024, 256, dg, 1024, [](int hh) { return (hh >> 6) * 128 + ((hh >> 5) & 1) * 64 + ((hh >> 4) & 1) * 16 + (hh & 15); }, lds, cursor);
      transpose_tiles(p.in[43] + ((size_t)l * 16 + e) * 1024 * 256, 1024, 256, dg, 1024, [](int hh) { return (hh >> 6) * 128 + ((hh >> 5) & 1) * 64 + (((hh >> 4) & 1) + 2) * 16 + (hh & 15); }, lds, cursor);
      transpose_tiles(p.in[44] + ((size_t)l * 16 + e) * 256 * 1024, 256, 1024, (bf16_t*)(wl + W_DN) + (size_t)e * 1024 * 256, 256, ident, lds, cursor);
    }
    {
      const int lane = HTID & 63, gw = VBID * 4 + (HTID >> 6), NGW = VGRID * 4;
      for (int o = gw; o < 256; o += NGW) {
        const int kv = o >> 7, j = o & 127;
        const float* pe = (kv ? p.in[32] : p.in[29]) + (size_t)l * 2048;
        const float* w1 = (kv ? p.in[33] : p.in[30]) + (size_t)l * 2048 * 128;
        float a = 0.f;
#pragma unroll 8
        for (int k = lane; k < 2048; k += 64) a += pe[k] * w1[(size_t)k * 128 + j];
        a = wsum(a);
        if (lane == 0) ((float*)(wl + (kv ? W_B1V : W_B1K)))[j] = a;
      }
    }
    for (size_t i = gtid; i < 16 * 64; i += gn) {
      const int g = (int)(i >> 6), sidx = (int)(i & 63);
      const float are = p.in[17][(size_t)l * 1024 + i], aim = p.in[18][(size_t)l * 1024 + i];
      const float dt = expf(p.in[19][l * 16 + g]);
      const float mag = expf(dt * are);
      float sn, cs; sincosf(dt * aim, &sn, &cs);
      const float abr = mag * cs, abi = mag * sn;
      const float den = are * are + aim * aim, nre = abr - 1.f;
      const float gre = (nre * are + abi * aim) / den, gim = (abi * are - nre * aim) / den;
      ((float2*)(wl + W_S5A))[i] = make_float2(abr, abi);
      float pr = abr, pi = abi;
#pragma unroll
      for (int q = 0; q < 6; ++q) { const float nr = pr * pr - pi * pi, ni = 2.f * pr * pi; pr = nr; pi = ni; }
      ((float2*)(wl + W_S5A64))[i] = make_float2(pr, pi);
      bf16_t* bb = (bf16_t*)(wl + W_S5BB);
      for (int ch = 0; ch < 16; ++ch) {
        const float br = p.in[20][((size_t)l * 1024 + i) * 16 + ch], bi = p.in[21][((size_t)l * 1024 + i) * 16 + ch];
        const float vr = gre * br - gim * bi, vi = gre * bi + gim * br;
        const int sb = sidx >> 5, r = sidx & 31;
        bb[((g * 4 + sb * 2 + 0) * 32 + r) * 16 + ch] = f2bf(vr);
        bb[((g * 4 + sb * 2 + 1) * 32 + r) * 16 + ch] = f2bf(vi);
      }
    }
    for (size_t i = gtid; i < 32 * 1024; i += gn) {
      const int n = (int)(i >> 10), k = (int)(i & 1023);
      float w = 0.f;
      if (n < 20) w = p.in[37][l * D + k] * ((n < 4) ? p.in[38][((size_t)l * D + k) * 4 + n] : p.in[40][((size_t)l * D + k) * 16 + (n - 4)]);
      const bf16_t hi = f2bf(w);
      ((bf16_t*)(wl + W_RTH))[i] = hi; ((bf16_t*)(wl + W_RTL))[i] = f2bf(w - bf2f(hi));
    }
    for (size_t i = gtid; i < 16 * 16 * 64; i += gn) {
      const int g = (int)(i >> 10), ch = (int)((i >> 6) & 15), pp = (int)(i & 63);
      const float cr = p.in[22][(size_t)l * 16384 + i], ci = p.in[23][(size_t)l * 16384 + i];
      bf16_t* cm = (bf16_t*)(wl + W_S5CM) + ((size_t)(g * 16 + ch) * 128 + 2 * pp);
      cm[0] = f2bf(cr); cm[1] = f2bf(-ci);
    }
  }
  {
    const int* positions = (const int*)p.in[1];
    float2* RM = (float2*)(ws + WS_ROPE);
    float2* RN = RM + (size_t)T * 16;
    for (size_t i = gtid; i < (size_t)T * 24; i += gn) {
      const int t = (int)(i / 24), j = (int)(i % 24);
      const int rot = (j < 16) ? 32 : 16, fi = (j < 16) ? j : (j - 16);
      const float inv = powf(500000.f, -(2.f * (float)fi) / (float)rot);
      float sn, cs; sincosf((float)positions[t] * inv, &sn, &cs);
      if (j < 16) RM[(size_t)t * 16 + fi] = make_float2(cs, sn); else RN[(size_t)t * 8 + fi] = make_float2(cs, sn);
    }
  }
  rmsnorm_rows(p.in[0], p.in[2], (bf16_t*)(ws + WS_A));
}

DEVI void phase_g1(const Params& p, int l, unsigned char* lds_full) {
  const bf16_t* XN = (const bf16_t*)(p.ws + WS_A);
  const bf16_t* W = (const bf16_t*)(p.ws + WS_W + l * WS_WL + W_IN);
  bf16_t* QN = (bf16_t*)(p.ws + WS_G);
  pg8::Gemm g{XN, W, T, DINP, D}; pg8::StaticOrder S; S.init(T, DINP, (int)gridDim.x, (int)blockIdx.x);
  EpiG1 E{(bf16_t*)(p.ws + WS_B), QN, QN + (size_t)T * 256, QN + (size_t)T * 320, (float*)(p.ws + SM_SSKV), (const float2*)(p.ws + WS_ROPE) + (size_t)T * 16, p.in[27] + l * 64, p.in[28] + l * 192};
  pg8::gemm_phase<EpiG1, pg8::StaticOrder, true, true>((LAS unsigned char*)lds_full, g, S, E);
}

DEVI void phase_g2(const Params& p, int l, unsigned char* lds) {
  unsigned char* wl = p.ws + WS_W + l * WS_WL;
  const bf16_t* PROJ = (const bf16_t*)(p.ws + WS_B);
  bf16_t* QR = (bf16_t*)(p.ws + WS_D);
  bf16_t* KVR = QR + (size_t)T * 384;
  bf16_t* GATES = (bf16_t*)(p.ws + WS_E);
  bf16_t* MK = (bf16_t*)(p.ws + WS_F) + (size_t)T * 4 * 96;
  const float2* RM = (const float2*)(p.ws + WS_ROPE);
  constexpr int N_CMP = 64, N_QR = 256 * 3, N_KVR = 256 * 4, N_GT = 256 * 4;
  const int tid = HTID, wid = tid >> 6, lane = tid & 63, wr = wid >> 1, wc = wid & 1, fr = lane & 15, fq = lane >> 4;
  for (int it = vblock(); it < N_CMP + N_QR + N_KVR + N_GT; it += VGRID) {
    f32x4 acc[4][4];
    if (it < N_CMP) {
      const int kv = it & 1, half = (it >> 1) & 1, mt = it >> 2;
      const bf16_t* W = (const bf16_t*)(wl + (kv ? W_1V : W_1K)) + (size_t)half * 64 * 2048;
      const float* bias = (const float*)(wl + (kv ? W_B1V : W_B1K)) + half * 64;
      bf16_t* H = (bf16_t*)(p.ws + (kv ? SM_HV : SM_HK)) + half * 64;
      f32x4 acc2[2][4];
      gemm128h(lds, 2048,
              [&](int r, int k) { const int m = mt * 128 + r, b = m >> 7; int c = m & 127; if (c > 126) c = 126;
                                  return PROJ + (size_t)(b * S + 16 * c + (k >> 6)) * DINP + C_KC + kv * 64 + (k & 63); },
              [&](int r, int k) { return W + (size_t)r * 2048 + k; }, acc2);
#pragma unroll
      for (int m = 0; m < 2; ++m)
#pragma unroll
        for (int n = 0; n < 4; ++n) {
          const float4 b4 = *(const float4*)(bias + n * 16 + fq * 4);
          f32x4 o; o[0] = gelu_tanh(acc2[m][n][0] + b4.x); o[1] = gelu_tanh(acc2[m][n][1] + b4.y); o[2] = gelu_tanh(acc2[m][n][2] + b4.z); o[3] = gelu_tanh(acc2[m][n][3] + b4.w);
          st_bf16x4(H + (size_t)(mt * 128 + wid * 32 + m * 16 + fr) * 128 + n * 16 + fq * 4, o);
        }
    } else if (it < N_CMP + N_QR) {
      const int i2 = it - N_CMP, mt = i2 / 3, nt = i2 % 3;
      const bf16_t* W = (const bf16_t*)(wl + W_UQ);
      gemm128g(lds, 192, [&](int r, int k) { return PROJ + (size_t)(mt * 128 + r) * DINP + C_CQ + k; }, [&](int r, int k) { return W + (size_t)(nt * 128 + r) * 192 + k; }, acc);
      GEMM_EPI4({ st_bf16x4(QR + (size_t)(mt * 128 + er) * 384 + nt * 128 + ec0, ev4); })
    } else if (it < N_CMP + N_QR + N_KVR) {
      const int i2 = it - N_CMP - N_QR, mt = i2 >> 2, hd = i2 & 3;
      const bf16_t* W = (const bf16_t*)(wl + W_UKV);
      gemm128g(lds, 128, [&](int r, int k) { return PROJ + (size_t)(mt * 128 + r) * DINP + wgcol(C_T1, k >> 6, k & 63); }, [&](int r, int k) { return W + (size_t)(hd * 128 + r) * 128 + k; }, acc);
      const float* g_k = p.in[9] + l * 96;
#pragma unroll
      for (int m = 0; m < 4; ++m) {
        const size_t t = (size_t)mt * 128 + wr * 64 + m * 16 + fr;
        const int b = (int)(t >> 11), sq = (int)(t & (S - 1));
        const float2 ssp = *(const float2*)((const float*)(p.ws + SM_SSKV) + t * 2);
        const float ss = ssp.x + ssp.y;
        const float rskv = rsqrtf(ss * (1.f / 128) + EPS);
        if (wc == 1) {
#pragma unroll
          for (int n = 0; n < 4; ++n) st_bf16x4(KVR + t * 512 + hd * 128 + 64 + n * 16 + fq * 4, acc[m][n] * rskv);
        } else {
          const uint2 plo = *(const uint2*)(PROJ + t * DINP + C_KPE + 4 * fq), phi = *(const uint2*)(PROJ + t * DINP + C_KPE + 16 + 4 * fq);
          float pl[4] = {__uint_as_float(plo.x << 16), __uint_as_float(plo.x & 0xffff0000u), __uint_as_float(plo.y << 16), __uint_as_float(plo.y & 0xffff0000u)};
          float ph[4] = {__uint_as_float(phi.x << 16), __uint_as_float(phi.x & 0xffff0000u), __uint_as_float(phi.y << 16), __uint_as_float(phi.y & 0xffff0000u)};
          float sk = 0.f;
#pragma unroll
          for (int j = 0; j < 4; ++j) sk += pl[j] * pl[j] + ph[j] * ph[j];
          f32x4 kn[4];
#pragma unroll
          for (int n = 0; n < 4; ++n) { kn[n] = acc[m][n] * rskv; sk += kn[n][0] * kn[n][0] + kn[n][1] * kn[n][1] + kn[n][2] * kn[n][2] + kn[n][3] * kn[n][3]; }
          sk += __shfl_xor(sk, 16); sk += __shfl_xor(sk, 32);
          const float rsk = rsqrtf(sk * (1.f / 96) + EPS);
          bf16_t* dst = MK + ((size_t)(b * 4 + hd) * S + sq) * 96;
          f32x4 olo, ohi;
#pragma unroll
          for (int j = 0; j < 4; ++j) {
            const int d = 4 * fq + j; const float2 cs2 = RM[t * 16 + d];
            const float x1 = pl[j] * rsk * g_k[d], x2 = ph[j] * rsk * g_k[16 + d];
            olo[j] = x1 * cs2.x - x2 * cs2.y; ohi[j] = x1 * cs2.y + x2 * cs2.x;
          }
          st_bf16x4(dst + 4 * fq, olo); st_bf16x4(dst + 16 + 4 * fq, ohi);
#pragma unroll
          for (int n = 0; n < 4; ++n) { const float4 g4 = *(const float4*)(g_k + 32 + n * 16 + fq * 4); f32x4 o = kn[n] * rsk; o[0] *= g4.x; o[1] *= g4.y; o[2] *= g4.z; o[3] *= g4.w; st_bf16x4(dst + 32 + n * 16 + fq * 4, o); }
        }
      }
    } else {
      const int i2 = it - N_CMP - N_QR - N_KVR, mt = i2 >> 2, h = i2 & 3;
      const bf16_t* W = (const bf16_t*)(wl + W_LRU) + h * 128 * 64;
      const int c0 = h * 64 + (tid & 7) * 8;
      const float* cw = p.in[10] + l * 4 * 256 + c0; const float* cbp = p.in[11] + l * 256 + c0;
      gemm128(lds, 64,
              [&](int r, int k) {
                const size_t t = (size_t)mt * 128 + r; const int sq = (int)(t & (S - 1));
                float u[8];
#pragma unroll
                for (int e = 0; e < 8; ++e) u[e] = cbp[e];
#pragma unroll
                for (int j = 0; j < 4; ++j) {
                  if (sq - 3 + j >= 0) {
                    const u32x4 w = *(const u32x4*)(PROJ + (t - 3 + j) * DINP + C_LX + h * 64 + k);
#pragma unroll
                    for (int e = 0; e < 4; ++e) { u[2 * e] += __uint_as_float(w[e] << 16) * cw[j * 256 + 2 * e]; u[2 * e + 1] += __uint_as_float(w[e] & 0xffff0000u) * cw[j * 256 + 2 * e + 1]; }
                  }
                }
                u32x4 o; o[0] = pk2bf(u[0], u[1]); o[1] = pk2bf(u[2], u[3]); o[2] = pk2bf(u[4], u[5]); o[3] = pk2bf(u[6], u[7]);
                return o; },
              [&](int r, int k) { return W + (size_t)r * 64 + k; }, acc);
      GEMM_EPI4({ st_bf16x4(GATES + (size_t)(mt * 128 + er) * 512 + h * 128 + ec0, ev4); })
    }
  }
}

DEVI void lru_ab(float u, float rpre, float ipre, float sp, bool first, float& a, float& b) {
  const float r = sigmoidf_(rpre), gi = sigmoidf_(ipre);
  const float la = -8.f * r * sp;
  a = __expf(la);
  const float x = 2.f * la;
  const float om = (x > -0.1f) ? (-x * (1.f + 0.5f * x * (1.f + (1.f / 3.f) * x * (1.f + 0.25f * x * (1.f + 0.2f * x))))) : (1.f - a * a);
  const float mult = first ? 1.f : sqrtf(fmaxf(om, 0.f));
  b = mult * gi * u;
}
DEVI float lru_conv(const bf16_t* PROJ, int t, int s, int c, const float* cw, float cb) {
  float u = cb;
#pragma unroll
  for (int j = 0; j < 4; ++j) { const int ss2 = s - 3 + j; if (ss2 >= 0) u += bf2f(PROJ[(size_t)(t - 3 + j) * DINP + C_LX + c]) * cw[j * 256 + c]; }
  return u;
}

template <bool FULL>
DEVI void s5_chunk(const Params& p, int l, int b, int chunk, unsigned char* lds) {
  unsigned char* wl = p.ws + WS_W + l * WS_WL;
  const bf16_t* PROJ = (const bf16_t*)(p.ws + WS_B);
  const float2* Abar = (const float2*)(wl + W_S5A);
  const bf16_t* BB = (const bf16_t*)(wl + W_S5BB);
  const bf16_t* CM = (const bf16_t*)(wl + W_S5CM);
  float2* SLOC = (float2*)(p.ws + SM_SLOC);
  bf16_t* YCP = (bf16_t*)(p.ws + WS_F);
  const float* dd = p.in[24] + l * 256;
  const int tid = HTID, wv = tid >> 6, lane = tid & 63, r = lane & 31, h = lane >> 5, fr = lane & 15, fq = lane >> 4;
  unsigned* Hs = (unsigned*)(lds + wv * 8704);
  const int t0 = b * S + chunk * 64;
#pragma unroll 1
  for (int gi = 0; gi < 4; ++gi) {
    const int g = wv * 4 + gi;
    bf16x8 bbf[4];
#pragma unroll
    for (int nb = 0; nb < 4; ++nb) bbf[nb] = *(const bf16x8*)(BB + ((g * 4 + nb) * 32 + r) * 16 + 8 * h);
    float2 Ac[2]; float hr[2], hi[2];
#pragma unroll
    for (int sb = 0; sb < 2; ++sb) {
      Ac[sb] = Abar[g * 64 + sb * 32 + r];
      hr[sb] = 0.f; hi[sb] = 0.f;
      if (FULL) { const float2 cin = ((const float2*)(p.ws + SM_SCAR))[((size_t)(b * 32 + chunk) * 16 + g) * 64 + sb * 32 + r]; hr[sb] = cin.x; hi[sb] = cin.y; }
    }
    bf16x8 cm[4];
    float4 dcol4 = make_float4(0.f, 0.f, 0.f, 0.f);
    if (FULL) {
#pragma unroll
      for (int kk = 0; kk < 4; ++kk) cm[kk] = *(const bf16x8*)(CM + (size_t)(g * 16 + fr) * 128 + kk * 32 + 8 * fq);
      dcol4 = *(const float4*)(dd + g * 16 + 4 * fq);
    }
#pragma unroll 1
    for (int tb = 0; tb < 2; ++tb) {
      const bf16x8 ua = *(const bf16x8*)(PROJ + (size_t)(t0 + tb * 32 + r) * DINP + C_S5 + g * 16 + 8 * h);
      f32x16 acc[4];
#pragma unroll
      for (int nb = 0; nb < 4; ++nb) {
        f32x16 z;
#pragma unroll
        for (int i = 0; i < 16; ++i) z[i] = 0.f;
        acc[nb] = mfma32(ua, bbf[nb], z);
      }
#pragma unroll
      for (int sb = 0; sb < 2; ++sb) {
        float sr = hr[sb], si = hi[sb];
        const float ax = Ac[sb].x, ay = Ac[sb].y;
#pragma unroll
        for (int q = 0; q < 4; ++q)
#pragma unroll
          for (int owner = 0; owner < 2; ++owner) {
#pragma unroll
            for (int i = 0; i < 4; ++i) {
              const int reg = 4 * q + i;
              const float br = acc[2 * sb][reg], bi = acc[2 * sb + 1][reg];
              const float nr = ax * sr - ay * si + br, ni = ax * si + ay * sr + bi; sr = nr; si = ni;
              if (FULL) { acc[2 * sb][reg] = (h == owner) ? sr : br; acc[2 * sb + 1][reg] = (h == owner) ? si : bi; }
            }
            const float orr = __shfl_xor(sr, 32), oi = __shfl_xor(si, 32);
            if (h != owner) { sr = orr; si = oi; }
          }
        hr[sb] = sr; hi[sb] = si;
      }
      if (FULL) {
#pragma unroll
        for (int sb = 0; sb < 2; ++sb)
#pragma unroll
          for (int reg = 0; reg < 16; ++reg)
            Hs[crow(reg, h) * 68 + sb * 32 + r] = pk2bf(acc[2 * sb][reg], acc[2 * sb + 1][reg]);
#pragma unroll
        for (int tb16 = 0; tb16 < 2; ++tb16) {
          f32x4 y = (f32x4){0.f, 0.f, 0.f, 0.f};
#pragma unroll
          for (int kk = 0; kk < 4; ++kk) { const bf16x8 a = *(const bf16x8*)((const bf16_t*)Hs + (tb16 * 16 + fr) * 136 + kk * 32 + 8 * fq); y = mfma16(cm[kk], a, y); }
          const size_t t = (size_t)t0 + tb * 32 + tb16 * 16 + fr; const int col = g * 16 + 4 * fq;
          const uint2 uw = *(const uint2*)(PROJ + t * DINP + C_S5 + col);
          f32x4 o;
          o[0] = gelu_tanh(y[0] + dcol4.x * __uint_as_float(uw.x << 16)); o[1] = gelu_tanh(y[1] + dcol4.y * __uint_as_float(uw.x & 0xffff0000u));
          o[2] = gelu_tanh(y[2] + dcol4.z * __uint_as_float(uw.y << 16)); o[3] = gelu_tanh(y[3] + dcol4.w * __uint_as_float(uw.y & 0xffff0000u));
          st_bf16x4(YCP + t * 256 + col, o);
        }
      }
    }
    if (!FULL) {
#pragma unroll
      for (int sb = 0; sb < 2; ++sb) if (h == 0) SLOC[((size_t)(b * 32 + chunk) * 16 + g) * 64 + sb * 32 + r] = make_float2(hr[sb], hi[sb]);
    }
  }
}

template <bool FULL>
DEVI void lru_chunk(const Params& p, int l, int b, int chunk, float* tile) {
  const bf16_t* PROJ = (const bf16_t*)(p.ws + WS_B);
  const bf16_t* GATES = (const bf16_t*)(p.ws + WS_E);
  float2* LSUM = (float2*)(p.ws + SM_LSUM);
  const int c = HTID, h = c >> 6, j = c & 63;
  const float* cw = p.in[10] + l * 4 * 256;
  const float w0 = cw[c], w1 = cw[256 + c], w2 = cw[512 + c], w3 = cw[768 + c], cb = p.in[11][l * 256 + c];
  const float ba = p.in[13][l * 256 + c], bi = p.in[15][l * 256 + c];
  const float sp = log1pf(expf(-p.in[16][l * 256 + c]));
  const int s0 = chunk * 64; const size_t t0 = (size_t)b * S + s0;
  float xm3 = 0.f, xm2 = 0.f, xm1 = 0.f;
  if (s0 > 0) { xm3 = bf2f(PROJ[(t0 - 3) * DINP + C_LX + c]); xm2 = bf2f(PROJ[(t0 - 2) * DINP + C_LX + c]); xm1 = bf2f(PROJ[(t0 - 1) * DINP + C_LX + c]); }
  float hh = 0.f, ap = 1.f;
  if (FULL) hh = ((const float*)(p.ws + SM_LCAR))[(size_t)(b * 32 + chunk) * 256 + c];
#pragma unroll 1
  for (int k0 = 0; k0 < 64; k0 += 8) {
    float xv[8], rp[8], ip[8], gt[8];
#pragma unroll
    for (int i = 0; i < 8; ++i) {
      const size_t t = t0 + k0 + i;
      xv[i] = bf2f(PROJ[t * DINP + C_LX + c]);
      rp[i] = bf2f(GATES[t * 512 + h * 128 + j]); ip[i] = bf2f(GATES[t * 512 + h * 128 + 64 + j]);
      gt[i] = FULL ? bf2f(PROJ[t * DINP + C_LG + c]) : 0.f;
    }
#pragma unroll
    for (int i = 0; i < 8; ++i) {
      const float u = cb + xm3 * w0 + xm2 * w1 + xm1 * w2 + xv[i] * w3;
      xm3 = xm2; xm2 = xm1; xm1 = xv[i];
      float a, bb; lru_ab(u, rp[i] + ba, ip[i] + bi, sp, (s0 + k0 + i) == 0, a, bb);
      hh = a * hh + bb; ap *= a;
      if (FULL) tile[(k0 + i) * 256 + c] = hh * gelu_tanh(gt[i]);
    }
  }
  if (!FULL) LSUM[(size_t)(b * 32 + chunk) * 256 + c] = make_float2(ap, hh);
}

DEVI void phase_r2(const Params& p, int l, unsigned char* lds) {
  unsigned char* wl = p.ws + WS_W + l * WS_WL;
  const bf16_t* PROJ = (const bf16_t*)(p.ws + WS_B);
  const bf16_t* QR = (const bf16_t*)(p.ws + WS_D);
  const bf16_t* KVR = QR + (size_t)T * 384;
  const bf16_t* GATES = (const bf16_t*)(p.ws + WS_E);
  bf16_t* MQ = (bf16_t*)(p.ws + WS_F);
  bf16_t* MK = MQ + (size_t)T * 4 * 96;
  const float2* RM = (const float2*)(p.ws + WS_ROPE);
  const float2* RN = RM + (size_t)T * 16;
  const int tid = HTID, lane = tid & 63, wv = tid >> 6;
  for (int it = VBID; it < NB * 32; it += VGRID) lru_chunk<false>(p, l, it >> 5, it & 31, nullptr);
  hsync();
  for (int it = VBID; it < NB * 32; it += VGRID) s5_chunk<false>(p, l, it >> 5, it & 31, lds);
  {
    const bf16_t* HK = (const bf16_t*)(p.ws + SM_HK); const bf16_t* HV = (const bf16_t*)(p.ws + SM_HV);
    bf16_t* KC = (bf16_t*)(p.ws + SM_KC); bf16_t* VC = (bf16_t*)(p.ws + SM_VC);
    const bf16_t* W2K = (const bf16_t*)(wl + W_2K); const bf16_t* W2V = (const bf16_t*)(wl + W_2V);
    const float* g0 = p.in[28] + l * 192;
    for (int it = VBID; it < 32; it += VGRID) {
      const int kv = it & 1, mt = it >> 1;
      const bf16_t* H = kv ? HV : HK; const bf16_t* W2 = kv ? W2V : W2K;
      f32x4 acc[4][4];
      hsync();
      gemm128g(lds, 128, [&](int r, int k) { return H + (size_t)(mt * 128 + r) * 128 + k; }, [&](int r, int k) { return W2 + (size_t)(r & 63) * 128 + k; }, acc);
      const int wid = tid >> 6, wr = wid >> 1, wc = wid & 1, fr = lane & 15, fq = lane >> 4;
      if (wc == 0) {
#pragma unroll
        for (int m = 0; m < 4; ++m) {
          const int row = mt * 128 + wr * 64 + m * 16 + fr, b = row >> 7, c = row & 127;
          f32x4 v[4];
#pragma unroll
          for (int n = 0; n < 4; ++n) v[n] = acc[m][n];
          if (kv == 0) {
            float ss = 0.f;
#pragma unroll
            for (int n = 0; n < 4; ++n) ss += v[n][0] * v[n][0] + v[n][1] * v[n][1] + v[n][2] * v[n][2] + v[n][3] * v[n][3];
            ss += __shfl_xor(ss, 16); ss += __shfl_xor(ss, 32);
            const float rs = rsqrtf(ss * (1.f / 64) + EPS);
#pragma unroll
            for (int n = 0; n < 4; ++n) { const float4 gg = *(const float4*)(g0 + n * 16 + fq * 4); v[n][0] *= rs * gg.x; v[n][1] *= rs * gg.y; v[n][2] *= rs * gg.z; v[n][3] *= rs * gg.w; }
            const int cc = (c < 127) ? c : 126;
            const float2* cs = RN + (size_t)(b * S + 16 * cc + 31) * 8;
#pragma unroll
            for (int j = 0; j < 4; ++j) {
              const float x = v[0][j], partner = __shfl_xor(x, 32);
              const int d = fq * 4 + j; const float2 cs2 = cs[d & 7];
              v[0][j] = (d < 8) ? (x * cs2.x - partner * cs2.y) : (partner * cs2.y + x * cs2.x);
            }
          }
          bf16_t* dst = (kv ? VC : KC) + (size_t)row * 64;
#pragma unroll
          for (int n = 0; n < 4; ++n) { f32x4 o = v[n]; if (c >= 127) o = (f32x4){0.f, 0.f, 0.f, 0.f}; st_bf16x4(dst + n * 16 + fq * 4, o); }
        }
      }
    }
  }
}

typedef short v4i16_t __attribute__((ext_vector_type(4)));
DEVI float fexp2(float x) { return __builtin_amdgcn_exp2f(x); }
constexpr int VST = 96;
constexpr int ATT_VBYTES = 64 * VST * 2;
template <int DK> constexpr int att_kbytes() { return 64 * (DK + 8) * 2; }
template <int DK> constexpr int att_buf() { return att_kbytes<DK>() + ATT_VBYTES; }
template <int DK> struct TileRegs { u32x4 k[DK / 32]; u32x4 v[2]; };
template <int DK>
DEVI void tile_load(TileRegs<DK>& tr, const bf16_t* kbase, size_t kstride, const bf16_t* vbase, size_t vstride, int key0, bool withv = true) {
  constexpr int CH = DK / 8;
#pragma unroll
  for (int i = 0; i < DK / 32; ++i) { const int c = HTID + 256 * i, r = c / CH, cc = c % CH; tr.k[i] = *(const u32x4*)(kbase + (size_t)(key0 + r) * kstride + cc * 8); }
  if (withv) {
#pragma unroll
    for (int i = 0; i < 2; ++i) { const int c = HTID + 256 * i, r = c >> 3, cc = c & 7; tr.v[i] = *(const u32x4*)(vbase + (size_t)(key0 + r) * vstride + cc * 8); }
  }
}
template <int DK>
DEVI void tile_store(const TileRegs<DK>& tr, unsigned char* buf, bool withv = true) {
  constexpr int CH = DK / 8;
  bf16_t* sK = (bf16_t*)buf; bf16_t* sV = (bf16_t*)(buf + att_kbytes<DK>());
#pragma unroll
  for (int i = 0; i < DK / 32; ++i) { const int c = HTID + 256 * i, r = c / CH, cc = c % CH; *(u32x4*)(sK + r * (DK + 8) + cc * 8) = tr.k[i]; }
  if (withv) {
#pragma unroll
    for (int i = 0; i < 2; ++i) { const int c = HTID + 256 * i, r = c >> 3, cc = c & 7; *(u32x4*)(sV + r * VST + cc * 8) = tr.v[i]; }
  }
}
template <int DK>
DEVI void qk_tile(const bf16_t* sK, const bf16x8* qf, f32x16& s0, f32x16& s1, int r, int h) {
#pragma unroll
  for (int i = 0; i < 16; ++i) { s0[i] = 0.f; s1[i] = 0.f; }
#pragma unroll
  for (int kk = 0; kk < DK / 16; ++kk) {
    const bf16x8 a0 = *(const bf16x8*)(sK + r * (DK + 8) + kk * 16 + h * 8);
    const bf16x8 a1 = *(const bf16x8*)(sK + (32 + r) * (DK + 8) + kk * 16 + h * 8);
    s0 = mfma32(a0, qf[kk], s0);
    s1 = mfma32(a1, qf[kk], s1);
  }
}
struct FState { f32x16 o0, o1; float m, l; };
DEVI void fstate_init(FState& f) {
#pragma unroll
  for (int i = 0; i < 16; ++i) { f.o0[i] = 0.f; f.o1[i] = 0.f; }
  f.m = -INFINITY; f.l = 0.f;
}
DEVI v4i16_t vtr(const bf16_t* p) { return __builtin_amdgcn_ds_read_tr16_b64_v4i16((LAS v4i16_t*)p); }
DEVI void softmax_pv(FState& f, f32x16& s0, f32x16& s1, const bf16_t* sV, int lane) {
  const int h = lane >> 5;
  float mx = -INFINITY;
#pragma unroll
  for (int i = 0; i < 16; ++i) mx = fmaxf(mx, fmaxf(s0[i], s1[i]));
  mx = fmaxf(mx, __shfl_xor(mx, 32));
  const float mnew = fmaxf(f.m, mx);
  const float muse = (mnew == -INFINITY) ? 0.f : mnew;
  float ps = 0.f;
#pragma unroll
  for (int i = 0; i < 16; ++i) { s0[i] = fexp2(s0[i] - muse); s1[i] = fexp2(s1[i] - muse); ps += s0[i] + s1[i]; }
  ps += __shfl_xor(ps, 32);
  if (__any(mnew != f.m)) {
    const float alpha = fexp2(f.m - muse);
    f.l = f.l * alpha + ps; f.m = mnew;
#pragma unroll
    for (int i = 0; i < 16; ++i) { f.o0[i] *= alpha; f.o1[i] *= alpha; }
  } else {
    f.l += ps;
  }
  const int g = lane >> 4, li = lane & 15, q = li >> 2, pp = li & 3;
  const bf16_t* vb = sV + (4 * h + q) * VST + (g & 1) * 16 + 4 * pp;
#pragma unroll
  for (int kb = 0; kb < 2; ++kb)
#pragma unroll
    for (int s = 0; s < 2; ++s) {
      unsigned pw[4];
#pragma unroll
      for (int j = 0; j < 4; ++j) pw[j] = kb ? pk2bf(s1[8 * s + 2 * j], s1[8 * s + 2 * j + 1]) : pk2bf(s0[8 * s + 2 * j], s0[8 * s + 2 * j + 1]);
      const bf16x8 pb = __builtin_bit_cast(bf16x8, (u32x4){pw[0], pw[1], pw[2], pw[3]});
#pragma unroll
      for (int db = 0; db < 2; ++db) {
        const v4i16_t lo = vtr(vb + (kb * 32 + 16 * s) * VST + db * 32);
        const v4i16_t hi = vtr(vb + (kb * 32 + 16 * s + 8) * VST + db * 32);
        const bf16x8 a = {lo[0], lo[1], lo[2], lo[3], hi[0], hi[1], hi[2], hi[3]};
        if (db == 0) f.o0 = mfma32(a, pb, f.o0); else f.o1 = mfma32(a, pb, f.o1);
      }
    }
}
DEVI void store_o(bf16_t* orow, const f32x16& o0, const f32x16& o1, float sc, int h) {
#pragma unroll
  for (int g = 0; g < 4; ++g) {
    uint2 v0, v1;
    v0.x = pk2bf(o0[4 * g] * sc, o0[4 * g + 1] * sc); v0.y = pk2bf(o0[4 * g + 2] * sc, o0[4 * g + 3] * sc);
    v1.x = pk2bf(o1[4 * g] * sc, o1[4 * g + 1] * sc); v1.y = pk2bf(o1[4 * g + 2] * sc, o1[4 * g + 3] * sc);
    *(uint2*)(orow + 8 * g + 4 * h) = v0;
    *(uint2*)(orow + 32 + 8 * g + 4 * h) = v1;
  }
}

DEVI void mla_item(const Params& p, int l, int b, int hd, int qt, unsigned char* lds) {
  const bf16_t* MQ = (const bf16_t*)(p.ws + WS_F);
  const bf16_t* MK = MQ + (size_t)T * 4 * 96;
  const bf16_t* KVR = (const bf16_t*)(p.ws + WS_D) + (size_t)T * 384;
  bf16_t* YA = (bf16_t*)(p.ws + WS_C);
  const int tid = HTID, wv = tid >> 6, lane = tid & 63, r = lane & 31, h = lane >> 5;
  const int q0 = qt * 128 + wv * 32, tq = q0 + r;
  bf16x8 qf[6];
  {
    const bf16_t* qrow = (const bf16_t*)(p.ws + WS_D) + ((size_t)b * S + tq) * 384 + hd * 96;
    const float* g_q = p.in[8] + l * 96;
    float qv[6][8]; float ss = 0.f;
#pragma unroll
    for (int kk = 0; kk < 6; ++kk) {
      const u32x4 w = *(const u32x4*)(qrow + kk * 16 + h * 8);
#pragma unroll
      for (int e = 0; e < 4; ++e) { qv[kk][2 * e] = __uint_as_float(w[e] << 16); qv[kk][2 * e + 1] = __uint_as_float(w[e] & 0xffff0000u); ss += qv[kk][2 * e] * qv[kk][2 * e] + qv[kk][2 * e + 1] * qv[kk][2 * e + 1]; }
    }
    ss += __shfl_xor(ss, 32);
    const float rs = rsqrtf(ss * (1.f / 96) + EPS) * (0.10206207261596575f * LOG2E);
#pragma unroll
    for (int kk = 0; kk < 6; ++kk)
#pragma unroll
      for (int j = 0; j < 8; ++j) qv[kk][j] *= rs * g_q[kk * 16 + h * 8 + j];
    const float2* cs = (const float2*)(p.ws + WS_ROPE) + ((size_t)b * S + tq) * 16 + 8 * h;
#pragma unroll
    for (int j = 0; j < 8; ++j) { const float2 c2 = cs[j]; const float x1 = qv[0][j], x2 = qv[1][j]; qv[0][j] = x1 * c2.x - x2 * c2.y; qv[1][j] = x1 * c2.y + x2 * c2.x; }
#pragma unroll
    for (int kk = 0; kk < 6; ++kk) { const u32x4 w = {pk2bf(qv[kk][0], qv[kk][1]), pk2bf(qv[kk][2], qv[kk][3]), pk2bf(qv[kk][4], qv[kk][5]), pk2bf(qv[kk][6], qv[kk][7])}; qf[kk] = __builtin_bit_cast(bf16x8, w); }
  }
  FState f; fstate_init(f);
  const bf16_t* kbase = MK + (size_t)(b * 4 + hd) * S * 96;
  const bf16_t* vbase = KVR + (size_t)b * S * 512 + hd * 128 + 64;
  const int ntiles = 2 * qt + 2;
  TileRegs<96> tr;
  TileRegs<96> tr2;
  tile_load<96>(tr, kbase, 96, vbase, 512, 0);
  tile_load<96>(tr2, kbase, 96, vbase, 512, 64);
  hsync();
  tile_store<96>(tr, lds);
  hsync();
  auto compute = [&](int kt, unsigned char* cur) {
    if (kt * 64 <= q0 + 31) {
      f32x16 s0, s1;
      qk_tile<96>((const bf16_t*)cur, qf, s0, s1, r, h);
      if (kt * 64 + 63 > q0) {
        int rel = tq - kt * 64 - 4 * h; asm volatile("" : "+v"(rel));
#pragma unroll
        for (int i = 0; i < 16; ++i) { const int kk2 = (i & 3) + 8 * (i >> 2); if (kk2 > rel) s0[i] = -INFINITY; if (kk2 + 32 > rel) s1[i] = -INFINITY; }
      }
      softmax_pv(f, s0, s1, (const bf16_t*)(cur + att_kbytes<96>()), lane);
    }
  };
#pragma unroll 1
  for (int kt = 0; kt < ntiles; kt += 2) {
    if (kt + 2 < ntiles) tile_load<96>(tr, kbase, 96, vbase, 512, (kt + 2) * 64);
    compute(kt, lds);
    tile_store<96>(tr2, lds + att_buf<96>());
    hsync();
    if (kt + 3 < ntiles) tile_load<96>(tr2, kbase, 96, vbase, 512, (kt + 3) * 64);
    compute(kt + 1, lds + att_buf<96>());
    if (kt + 2 < ntiles) tile_store<96>(tr, lds);
    hsync();
  }
  store_o(YA + (size_t)(b * S + tq) * 256 + hd * 64, f.o0, f.o1, 1.f / f.l, h);
}

template <class KF, class BODY>
DEVI void nsa_stream(unsigned char* lds, const bf16_t* kbase, size_t kstride, const bf16_t* vbase, size_t vstride, bool withv, int nt, KF key0f, BODY body) {
  if (nt <= 0) return;
  TileRegs<64> trA, trB;
  tile_load<64>(trA, kbase, kstride, vbase, vstride, key0f(0), withv);
  if (nt > 1) tile_load<64>(trB, kbase, kstride, vbase, vstride, key0f(1), withv);
  hsync();
  tile_store<64>(trA, lds, withv);
  hsync();
  unsigned char* buf0 = lds; unsigned char* buf1 = lds + att_buf<64>();
#pragma unroll 1
  for (int i = 0; i < nt; i += 2) {
    if (i + 2 < nt) tile_load<64>(trA, kbase, kstride, vbase, vstride, key0f(i + 2), withv);
    body(i, buf0);
    if (i + 1 < nt) tile_store<64>(trB, buf1, withv);
    hsync();
    if (i + 1 >= nt) break;
    if (i + 3 < nt) tile_load<64>(trB, kbase, kstride, vbase, vstride, key0f(i + 3), withv);
    body(i + 1, buf1);
    if (i + 2 < nt) tile_store<64>(trA, buf0, withv);
    hsync();
  }
}
DEVI void nsa_item(const Params& p, int l, int b, int qt, unsigned char* lds) {
  const bf16_t* PROJ = (const bf16_t*)(p.ws + WS_B);
  const bf16_t* KC = (const bf16_t*)(p.ws + SM_KC) + (size_t)b * 128 * 64;
  const bf16_t* VC = (const bf16_t*)(p.ws + SM_VC) + (size_t)b * 128 * 64;
  const int tid = HTID, wv = tid >> 6, lane = tid & 63, r = lane & 31, h = lane >> 5;
  float* psum = (float*)(lds + 2 * att_buf<64>());
  unsigned* selm = (unsigned*)(lds + 2 * att_buf<64>() + 16384);
  const int t0 = qt * 32, cur = t0 >> 6;
  const int ql = wv * 8 + (r >> 2), hd = r & 3, tq = t0 + ql;
  const size_t tg = (size_t)b * S + tq;
  bf16x8 qf[4];
#pragma unroll
  for (int kk = 0; kk < 4; ++kk) qf[kk] = *(const bf16x8*)((const bf16_t*)(p.ws + WS_G) + tg * 256 + hd * 64 + kk * 16 + h * 8);
  unsigned* ofs = (unsigned*)psum + wv * 1024 + lane;
  const float g0 = sigmoidf_(bf2f(PROJ[tg * DINP + C_NG + hd * 3 + 0]));
  const float g1 = sigmoidf_(bf2f(PROJ[tg * DINP + C_NG + hd * 3 + 1]));
  const float g2 = sigmoidf_(bf2f(PROJ[tg * DINP + C_NG + hd * 3 + 2]));
  FState f; fstate_init(f);
  const int ncmp = (t0 + 31 < 31) ? 0 : (((t0 >> 4) >> 6) + 1);
  nsa_stream(lds, KC, 64, VC, 64, true, ncmp, [&](int i) { return i * 64; }, [&](int kt, unsigned char* buf) {
    f32x16 s0, s1;
    qk_tile<64>((const bf16_t*)buf, qf, s0, s1, r, h);
    int rel = ((tq - 31) >> 4) - kt * 64 - 4 * h; asm volatile("" : "+v"(rel));
#pragma unroll
    for (int i = 0; i < 16; ++i) { const int kk2 = (i & 3) + 8 * (i >> 2); if (kk2 > rel) s0[i] = -INFINITY; if (kk2 + 32 > rel) s1[i] = -INFINITY; }
    softmax_pv(f, s0, s1, (const bf16_t*)(buf + att_kbytes<64>()), lane);
  });
  {
    const float muse = (f.m == -INFINITY) ? 0.f : f.m;
    const float il = (f.l > 0.f) ? 1.f / f.l : 0.f;
    if (ncmp < 2) {
#pragma unroll 1
      for (int i = tid; i < 32 * 128; i += NTHREADS) psum[i] = 0.f;
      hsync();
    }
    nsa_stream(lds, KC, 64, VC, 64, false, ncmp, [&](int i) { return i * 64; }, [&](int kt, unsigned char* buf) {
      f32x16 s0, s1;
      qk_tile<64>((const bf16_t*)buf, qf, s0, s1, r, h);
      int rel = ((tq - 31) >> 4) - kt * 64 - 4 * h; asm volatile("" : "+v"(rel));
      int cb0 = kt * 64 + 4 * h; asm volatile("" : "+v"(cb0));
#pragma unroll
      for (int i = 0; i < 16; ++i) {
        const int kk2 = (i & 3) + 8 * (i >> 2); const int c = cb0 + kk2;
        float p0 = (kk2 > rel) ? 0.f : fexp2(s0[i] - muse) * il;
        float p1 = (kk2 + 32 > rel) ? 0.f : fexp2(s1[i] - muse) * il;
        p0 += __shfl_xor(p0, 1); p0 += __shfl_xor(p0, 2);
        p1 += __shfl_xor(p1, 1); p1 += __shfl_xor(p1, 2);
        if (hd == 0) { psum[ql * 128 + c] = p0; psum[ql * 128 + c + 32] = p1; }
      }
    });
  }
  hsync();
#pragma unroll 1
  for (int itq = 0; itq < 4; ++itq) {
    const int q2 = wv * 8 + itq * 2 + (lane >> 5), j = lane & 31;
    const float* ps = psum + q2 * 128;
    float imp = 2.f * (ps[4 * j] + ps[4 * j + 1] + ps[4 * j + 2]) + ps[4 * j + 3];
    if (j > 0) imp += ps[4 * j - 1];
    const bool cand = (j >= 1) && (j <= cur - 2);
    int rank = 0;
    for (int jj = 0; jj < 32; ++jj) {
      const float v = __shfl(imp, (lane & 32) | jj);
      const bool cj = (jj >= 1) && (jj <= cur - 2);
      if (cj && (v > imp || (v == imp && jj < j))) ++rank;
    }
    const bool sel = cand && rank < 2;
    const unsigned long long bal = __ballot(sel);
    unsigned mk = (unsigned)(bal >> (32 * (lane >> 5)));
    mk |= 1u | (1u << cur); if (cur >= 1) mk |= (1u << (cur - 1));
    if (j == 0) selm[q2] = mk;
  }
  hsync();
  unsigned blk_or = 0, wave_or = 0;
  for (int i = 0; i < 32; ++i) blk_or |= selm[i];
  for (int i = 0; i < 8; ++i) wave_or |= selm[wv * 8 + i];
  const unsigned mymask = selm[ql];
  {
    const float sc = (f.l > 0.f) ? g0 / f.l : 0.f;
#pragma unroll
    for (int i = 0; i < 8; ++i) { ofs[i * 64] = pk2bf(f.o0[2 * i] * sc, f.o0[2 * i + 1] * sc); ofs[(8 + i) * 64] = pk2bf(f.o1[2 * i] * sc, f.o1[2 * i + 1] * sc); }
  }
  fstate_init(f);
  {
    unsigned* tl = selm + 32;
    if (tid < 32 && ((blk_or >> tid) & 1u)) tl[__popc(blk_or & ((1u << tid) - 1u))] = tid;
    hsync();
    const int nsel = __popc(blk_or);
    nsa_stream(lds, (const bf16_t*)(p.ws + WS_G) + (size_t)T * 256 + (size_t)b * S * 64, 64, PROJ + (size_t)b * S * DINP + C_VS, DINP, true, nsel,
      [&](int i) { return (int)tl[i] * 64; },
      [&](int i, unsigned char* buf) {
        const int jj = (int)tl[i];
        if ((wave_or >> jj) & 1u) {
          f32x16 s0, s1;
          qk_tile<64>((const bf16_t*)buf, qf, s0, s1, r, h);
          const bool on = (mymask >> jj) & 1u;
          int rel = on ? (tq - jj * 64 - 4 * h) : -1; asm volatile("" : "+v"(rel));
#pragma unroll
          for (int i2 = 0; i2 < 16; ++i2) { const int kk2 = (i2 & 3) + 8 * (i2 >> 2); if (kk2 > rel) s0[i2] = -INFINITY; if (kk2 + 32 > rel) s1[i2] = -INFINITY; }
          softmax_pv(f, s0, s1, (const bf16_t*)(buf + att_kbytes<64>()), lane);
        }
      });
    const float sc = (f.l > 0.f) ? g1 / f.l : 0.f;
#pragma unroll
    for (int i = 0; i < 8; ++i) {
      const unsigned w0 = ofs[i * 64], w1 = ofs[(8 + i) * 64];
      ofs[i * 64] = pk2bf(__uint_as_float(w0 << 16) + f.o0[2 * i] * sc, __uint_as_float(w0 & 0xffff0000u) + f.o0[2 * i + 1] * sc);
      ofs[(8 + i) * 64] = pk2bf(__uint_as_float(w1 << 16) + f.o1[2 * i] * sc, __uint_as_float(w1 & 0xffff0000u) + f.o1[2 * i + 1] * sc);
    }
  }
  fstate_init(f);
  {
    int jlo = (t0 - 511) >> 6; if (jlo < 0) jlo = 0;
    nsa_stream(lds, (const bf16_t*)(p.ws + WS_G) + (size_t)T * 320 + (size_t)b * S * 64, 64, PROJ + (size_t)b * S * DINP + C_VW, DINP, true, cur - jlo + 1,
      [&](int i) { return (jlo + i) * 64; },
      [&](int i, unsigned char* buf) {
        const int j = jlo + i;
        f32x16 s0, s1;
        qk_tile<64>((const bf16_t*)buf, qf, s0, s1, r, h);
        if (j == cur || j * 64 < t0 + 31 - 511 + 64) {
          int rel = tq - j * 64 - 4 * h; asm volatile("" : "+v"(rel));
#pragma unroll
          for (int i2 = 0; i2 < 16; ++i2) {
            const int kk2 = (i2 & 3) + 8 * (i2 >> 2);
            if (kk2 > rel || kk2 < rel - 511) s0[i2] = -INFINITY;
            if (kk2 + 32 > rel || kk2 + 32 < rel - 511) s1[i2] = -INFINITY;
          }
        }
        softmax_pv(f, s0, s1, (const bf16_t*)(buf + att_kbytes<64>()), lane);
      });
    const float sc = (f.l > 0.f) ? g2 / f.l : 0.f;
#pragma unroll
    for (int i = 0; i < 8; ++i) {
      const unsigned w0 = ofs[i * 64], w1 = ofs[(8 + i) * 64];
      f.o0[2 * i] = __uint_as_float(w0 << 16) + f.o0[2 * i] * sc; f.o0[2 * i + 1] = __uint_as_float(w0 & 0xffff0000u) + f.o0[2 * i + 1] * sc;
      f.o1[2 * i] = __uint_as_float(w1 << 16) + f.o1[2 * i] * sc; f.o1[2 * i + 1] = __uint_as_float(w1 & 0xffff0000u) + f.o1[2 * i + 1] * sc;
    }
  }
  f32x16& of0 = f.o0; f32x16& of1 = f.o1;
  {
    float ss = 0.f;
#pragma unroll
    for (int i = 0; i < 16; ++i) ss += of0[i] * of0[i] + of1[i] * of1[i];
    ss += __shfl_xor(ss, 1); ss += __shfl_xor(ss, 2); ss += __shfl_xor(ss, 32);
    const float rs = rsqrtf(ss * (1.f / 256) + EPS);
    const float* on = p.in[35] + l * 1024 + 768 + hd * 64;
#pragma unroll
    for (int g4 = 0; g4 < 4; ++g4) {
      const float4 a = *(const float4*)(on + 8 * g4 + 4 * h), b4 = *(const float4*)(on + 32 + 8 * g4 + 4 * h);
      of0[4 * g4] *= a.x; of0[4 * g4 + 1] *= a.y; of0[4 * g4 + 2] *= a.z; of0[4 * g4 + 3] *= a.w;
      of1[4 * g4] *= b4.x; of1[4 * g4 + 1] *= b4.y; of1[4 * g4 + 2] *= b4.z; of1[4 * g4 + 3] *= b4.w;
    }
    store_o((bf16_t*)(p.ws + WS_A) + tg * 1024 + 768 + hd * 64, of0, of1, rs, h);
  }
}

DEVI void carry_item(const Params& p, int l, int it) {
  const int tid = HTID;
  if (it < 64) {
    const int idx = it * 256 + tid, b = idx >> 10, gs = idx & 1023;
    const float2 a64 = ((const float2*)(p.ws + WS_W + l * WS_WL + W_S5A64))[gs];
    const float2* SLOC = (const float2*)(p.ws + SM_SLOC) + (size_t)b * 32 * 1024 + gs;
    float2* SCAR = (float2*)(p.ws + SM_SCAR) + (size_t)b * 32 * 1024 + gs;
    float hr = 0.f, hi = 0.f;
#pragma unroll 1
    for (int c0 = 0; c0 < 32; c0 += 8) {
      float2 sl[8];
#pragma unroll
      for (int i = 0; i < 8; ++i) sl[i] = SLOC[(size_t)(c0 + i) * 1024];
#pragma unroll
      for (int i = 0; i < 8; ++i) { SCAR[(size_t)(c0 + i) * 1024] = make_float2(hr, hi); const float nr = a64.x * hr - a64.y * hi + sl[i].x, ni = a64.x * hi + a64.y * hr + sl[i].y; hr = nr; hi = ni; }
    }
  } else {
    const int idx = (it - 64) * 256 + tid, b = idx >> 8, c = idx & 255;
    const float2* LSUM = (const float2*)(p.ws + SM_LSUM) + (size_t)b * 32 * 256 + c;
    float* LCAR = (float*)(p.ws + SM_LCAR) + (size_t)b * 32 * 256 + c;
    float hh = 0.f;
#pragma unroll 1
    for (int c0 = 0; c0 < 32; c0 += 8) {
      float2 sv[8];
#pragma unroll
      for (int i = 0; i < 8; ++i) sv[i] = LSUM[(size_t)(c0 + i) * 256];
#pragma unroll
      for (int i = 0; i < 8; ++i) { LCAR[(size_t)(c0 + i) * 256] = hh; hh = sv[i].x * hh + sv[i].y; }
    }
  }
}
DEVI void phase_a1(const Params& p, int l, unsigned char* lds) {
  for (int it = VBID; it < 80; it += VGRID) carry_item(p, l, it);
  const int G_ = VGRID;
  const int vb_ = vblock();
  for (int rr = 0;; ++rr) { const int j = rr * G_ + ((rr & 1) ? (G_ - 1 - vb_) : vb_); if (rr * G_ >= 1024) break; if (j < 1024) { const int b = j >> 6, qt = 63 - (j & 63); nsa_item(p, l, b, qt, lds); } }
  hsync();
  for (int rr = 0;; ++rr) { const int j = rr * G_ + ((rr & 1) ? (G_ - 1 - vb_) : vb_); if (rr * G_ >= 1024) break; if (j < 1024) { const int bh = j >> 4, qt = 15 - (j & 15); mla_item(p, l, bh >> 2, bh & 3, qt, lds); } }
}

DEVI void phase_r3(const Params& p, int l, unsigned char* lds) {
  bf16_t* Y = (bf16_t*)(p.ws + WS_A);
  const int tid = HTID, lane = tid & 63, wv = tid >> 6;
  {
    const float* onorm = p.in[35] + l * 1024 + 256;
    float* tile = (float*)lds;
    for (int it = VBID; it < NB * 32; it += VGRID) {
      const int b = it >> 5, chunk = it & 31;
      hsync();
      lru_chunk<true>(p, l, b, chunk, tile);
      hsync();
      for (int k = wv; k < 64; k += 4) {
        const float4 v = *(const float4*)(tile + k * 256 + lane * 4);
        const float rs = rsqrtf(wsum(v.x * v.x + v.y * v.y + v.z * v.z + v.w * v.w) * (1.f / 256) + EPS);
        const size_t t = (size_t)b * S + chunk * 64 + k;
        const float4 gg = *(const float4*)(onorm + lane * 4);
        st_bf16x4(Y + t * 1024 + 256 + lane * 4, (f32x4){v.x * rs * gg.x, v.y * rs * gg.y, v.z * rs * gg.z, v.w * rs * gg.w});
      }
    }
  }
  hsync();
  for (int it = VBID; it < NB * 32; it += VGRID) s5_chunk<true>(p, l, it >> 5, it & 31, lds);
}

DEVI void phase_g3(const Params& p, int l, unsigned char* lds) {
  const bf16_t* YCP = (const bf16_t*)(p.ws + WS_F);
  bf16_t* YC = (bf16_t*)(p.ws + WS_F) + (size_t)T * 256;
  const bf16_t* W = (const bf16_t*)(p.ws + WS_W + l * WS_WL + W_GLU);
  const float* bg = p.in[26] + l * 256;
  for (int it = vblock(); it < 256 * 2; it += VGRID) {
    const int mt = it >> 1, nt = it & 1;
    f32x4 acc[4][4];
    gemm128g(lds, 256, [&](int r, int k) { return YCP + (size_t)(mt * 128 + r) * 256 + k; }, [&](int r, int k) { return W + (size_t)(nt * 128 + r) * 256 + k; }, acc);
    GEMM_EPI4({ const size_t o = (size_t)(mt * 128 + er) * 256 + nt * 128 + ec0; const ushort4 yp = *(const ushort4*)(YCP + o); f32x4 r4; r4[0] = bf2f(yp.x) * sigmoidf_(ev4[0] + bg[nt * 128 + ec0]); r4[1] = bf2f(yp.y) * sigmoidf_(ev4[1] + bg[nt * 128 + ec0 + 1]); r4[2] = bf2f(yp.z) * sigmoidf_(ev4[2] + bg[nt * 128 + ec0 + 2]); r4[3] = bf2f(yp.w) * sigmoidf_(ev4[3] + bg[nt * 128 + ec0 + 3]); st_bf16x4(YC + o, r4); })
  }
}

DEVI void phase_r4(const Params& p, int l) {
  const bf16_t* YA = (const bf16_t*)(p.ws + WS_C);
  const bf16_t* YC = (const bf16_t*)(p.ws + WS_F) + (size_t)T * 256;
  bf16_t* Y = (bf16_t*)(p.ws + WS_A);
  const float* onorm = p.in[35] + l * 1024;
  const int lane = HTID & 63, gw = VBID * 4 + (HTID >> 6), NGW = VGRID * 4;
  for (int t = gw; t < T; t += NGW) {
#pragma unroll
    for (int grp = 0; grp < 2; ++grp) {
      const bf16_t* src = (grp == 0 ? YA : YC) + (size_t)t * 256;
      const int gcol = (grp == 0 ? 0 : 512);
      const ushort4 u = ((const ushort4*)src)[lane];
      const float v0 = bf2f(u.x), v1 = bf2f(u.y), v2 = bf2f(u.z), v3 = bf2f(u.w);
      const float rs = rsqrtf(wsum(v0 * v0 + v1 * v1 + v2 * v2 + v3 * v3) * (1.f / 256) + EPS);
      const float4 g = ((const float4*)(onorm + gcol))[lane];
      uint2 o; o.x = pk2bf(v0 * rs * g.x, v1 * rs * g.y); o.y = pk2bf(v2 * rs * g.z, v3 * rs * g.w);
      ((uint2*)(Y + (size_t)t * 1024 + gcol))[lane] = o;
    }
  }
}

DEVI void phase_g4(const Params& p, int l, unsigned char* lds_full) {
  const bf16_t* Y = (const bf16_t*)(p.ws + WS_A);
  const bf16_t* W = (const bf16_t*)(p.ws + WS_W + l * WS_WL + W_OUT);
  const float* xin = (l == 0) ? p.in[0] : p.out;
  pg8::Gemm g{Y, W, T, D, D}; pg8::StaticOrder S; S.init(T, D, (int)gridDim.x, (int)blockIdx.x);
  EpiRes E{xin, p.out};
  pg8::gemm_phase<EpiRes, pg8::StaticOrder, true, true>((LAS unsigned char*)lds_full, g, S, E);
}

DEVI void phase_r5(const Params& p, int l, unsigned char* lds) {
  const float* x1 = p.out;
  bf16_t* XN = (bf16_t*)(p.ws + WS_A);
  const float* g = p.in[37] + l * D;
  const bf16_t* WH = (const bf16_t*)(p.ws + WS_W + l * WS_WL + W_RTH);
  const bf16_t* WL = (const bf16_t*)(p.ws + WS_W + l * WS_WL + W_RTL);
  const float* brg = p.in[39] + l * 4; const float* bre = p.in[41] + l * 16;
  int* CNT = (int*)(p.ws + SM_CNT) + l * 32;
  int* LIST = (int*)(p.ws + SM_LIST);
  float2* TOKW = (float2*)(p.ws + SM_TOKW);
  const int tid = HTID, lane = tid & 63, wv = tid >> 6, c = lane & 15, q = lane >> 4;
  float* red = (float*)lds;
  int* hist = (int*)(lds + 16384);
  int* tokl = (int*)(lds + 16384 + 256);
  if (tid < 64) hist[tid] = 0;
  int ntok = 0;
  hsync();
  for (int it = VBID; it < T / 16; it += VGRID) {
    const size_t tb = (size_t)it * 16;
    f32x4 a0 = (f32x4){0.f, 0.f, 0.f, 0.f}, a1 = (f32x4){0.f, 0.f, 0.f, 0.f};
    float ss = 0.f;
    const float* xrow = x1 + (tb + c) * D + wv * 256 + 8 * q;
    const bf16_t* wh0 = WH + (size_t)c * 1024 + wv * 256 + 8 * q;
    const bf16_t* wl0 = WL + (size_t)c * 1024 + wv * 256 + 8 * q;
    float4 xk[8][2];
#pragma unroll
    for (int ks = 0; ks < 8; ++ks) { xk[ks][0] = *(const float4*)(xrow + ks * 32); xk[ks][1] = *(const float4*)(xrow + ks * 32 + 4); }
#pragma unroll
    for (int ks = 0; ks < 8; ++ks) {
      const bf16x8 wh_a = *(const bf16x8*)(wh0 + ks * 32), wl_a = *(const bf16x8*)(wl0 + ks * 32);
      const bf16x8 wh_b = *(const bf16x8*)(wh0 + 16 * 1024 + ks * 32), wl_b = *(const bf16x8*)(wl0 + 16 * 1024 + ks * 32);
      const float xv[8] = {xk[ks][0].x, xk[ks][0].y, xk[ks][0].z, xk[ks][0].w, xk[ks][1].x, xk[ks][1].y, xk[ks][1].z, xk[ks][1].w};
      u32x4 hw, lw;
#pragma unroll
      for (int j = 0; j < 4; ++j) {
        const float x0 = xv[2 * j], x1v = xv[2 * j + 1];
        ss += x0 * x0 + x1v * x1v;
        const unsigned hp = pk2bf(x0, x1v);
        hw[j] = hp; lw[j] = pk2bf(x0 - __uint_as_float(hp << 16), x1v - __uint_as_float(hp & 0xffff0000u));
      }
      const bf16x8 xh = __builtin_bit_cast(bf16x8, hw), xl = __builtin_bit_cast(bf16x8, lw);
      a0 = mfma16(wh_a, xh, a0); a0 = mfma16(wh_a, xl, a0); a0 = mfma16(wl_a, xh, a0);
      a1 = mfma16(wh_b, xh, a1); a1 = mfma16(wh_b, xl, a1); a1 = mfma16(wl_b, xh, a1);
    }
    ss += __shfl_xor(ss, 16); ss += __shfl_xor(ss, 32);
    hsync();
#pragma unroll
    for (int j = 0; j < 4; ++j) { red[(wv * 9 + j) * 64 + lane] = a0[j]; red[(wv * 9 + 4 + j) * 64 + lane] = a1[j]; }
    red[(wv * 9 + 8) * 64 + lane] = ss;
    hsync();
    const float s2 = red[8 * 64 + lane] + red[(9 + 8) * 64 + lane] + red[(18 + 8) * 64 + lane] + red[(27 + 8) * 64 + lane];
    const float rs = rsqrtf(s2 * (1.f / D) + EPS);
    {
      bf16_t* xo = XN + (tb + c) * D + wv * 256 + 8 * q;
      const float* gp = g + wv * 256 + 8 * q;
#pragma unroll
      for (int ks = 0; ks < 8; ++ks) {
        const float4 g0 = *(const float4*)(gp + ks * 32), g1 = *(const float4*)(gp + ks * 32 + 4);
        u32x4 o;
        o[0] = pk2bf(xk[ks][0].x * rs * g0.x, xk[ks][0].y * rs * g0.y); o[1] = pk2bf(xk[ks][0].z * rs * g0.z, xk[ks][0].w * rs * g0.w);
        o[2] = pk2bf(xk[ks][1].x * rs * g1.x, xk[ks][1].y * rs * g1.y); o[3] = pk2bf(xk[ks][1].z * rs * g1.z, xk[ks][1].w * rs * g1.w);
        *(u32x4*)(xo + ks * 32) = o;
      }
    }
    if (wv == 0) {
      float c0[4], c1[4];
#pragma unroll
      for (int j = 0; j < 4; ++j) {
        c0[j] = red[j * 64 + lane] + red[(9 + j) * 64 + lane] + red[(18 + j) * 64 + lane] + red[(27 + j) * 64 + lane];
        c1[j] = red[(4 + j) * 64 + lane] + red[(13 + j) * 64 + lane] + red[(22 + j) * 64 + lane] + red[(31 + j) * 64 + lane];
      }
      float lg[20];
#pragma unroll
      for (int qq = 0; qq < 4; ++qq)
#pragma unroll
        for (int j = 0; j < 4; ++j) lg[4 * qq + j] = __shfl(c0[j], c + 16 * qq);
#pragma unroll
      for (int j = 0; j < 4; ++j) lg[16 + j] = __shfl(c1[j], c);
      const int t = (int)tb + c;
      float gl[4];
#pragma unroll
      for (int k2 = 0; k2 < 4; ++k2) gl[k2] = lg[k2] * rs + brg[k2];
      int gi = 0; float gbest = gl[0];
#pragma unroll
      for (int k2 = 1; k2 < 4; ++k2) if (gl[k2] > gbest) { gbest = gl[k2]; gi = k2; }
      float den = 0.f;
#pragma unroll
      for (int k2 = 0; k2 < 4; ++k2) den += expf(gl[k2] - gbest);
      const float pg = 1.f / den;
      float le[4];
#pragma unroll
      for (int k2 = 0; k2 < 4; ++k2) { float sel = 0.f;
#pragma unroll
        for (int gg2 = 0; gg2 < 4; ++gg2) sel = (gi == gg2) ? (lg[4 + gg2 * 4 + k2] * rs + bre[gg2 * 4 + k2]) : sel;
        le[k2] = sel; }
      int i0 = 0; float l0 = le[0];
#pragma unroll
      for (int k2 = 1; k2 < 4; ++k2) if (le[k2] > l0) { l0 = le[k2]; i0 = k2; }
      int i1 = -1; float l1 = -INFINITY;
#pragma unroll
      for (int k2 = 0; k2 < 4; ++k2) if (k2 != i0 && le[k2] > l1) { l1 = le[k2]; i1 = k2; }
      const float e1 = expf(l1 - l0);
      const float w0 = pg / (1.f + e1), w1 = pg * e1 / (1.f + e1);
      const int elo = (i0 < i1) ? i0 : i1, ehi = (i0 < i1) ? i1 : i0;
      const float wlo = (i0 < i1) ? w0 : w1, whi = (i0 < i1) ? w1 : w0;
      const int pidx = (elo == 0) ? (ehi - 1) : ((elo == 1) ? (ehi + 1) : 5);
      const int cls = gi * 6 + pidx;
      if (q == 0) {
        const int rank = atomicAdd(&hist[cls], 1);
        tokl[2 * (ntok + c)] = t; tokl[2 * (ntok + c) + 1] = (cls << 16) | rank;
        TOKW[t] = make_float2(wlo, whi);
      }
    }
    ntok += 16;
  }
  hsync();
  if (tid < 24) { const int n = hist[tid]; hist[32 + tid] = n ? atomicAdd(&CNT[tid], n) : 0; }
  hsync();
  for (int i = tid; i < ntok; i += NTHREADS) { const int t = tokl[2 * i], cr = tokl[2 * i + 1], cls = cr >> 16; LIST[(size_t)cls * T + hist[32 + cls] + (cr & 0xffff)] = t; }
}

struct MoeItem { int cls, mtile, nt, cnt; };
DEVI void moe_prefix(const int* CNT, unsigned char* lds) {
  int* pre = (int*)(lds + LDS_BYTES + 64);
  hsync();
  if (HTID < 24) pre[32 + HTID] = CNT[HTID];
  hsync();
  if (HTID == 0) { int a = 0; for (int c = 0; c < 24; ++c) { pre[c] = a; a += (pre[32 + c] + 127) >> 7; } pre[24] = a; }
  hsync();
}
DEVI bool moe_item(unsigned char* lds, int it, MoeItem& m) {
  const int* pre = (const int*)(lds + LDS_BYTES + 64);
  const int mt = it >> 3; m.nt = it & 7;
  if (mt >= pre[24]) return false;
  int c = 0;
#pragma unroll
  for (int q = 1; q < 24; ++q) c += (mt >= pre[q]) ? 1 : 0;
  m.cls = c; m.mtile = mt - pre[c]; m.cnt = pre[32 + c];
  return true;
}
DEVI void cls_experts(int cls, int& e0, int& e1) {
  const int g = cls / 6, pi = cls % 6;
  const int lo = (pi < 3) ? 0 : ((pi < 5) ? 1 : 2);
  const int hi = (pi < 3) ? (pi + 1) : ((pi < 5) ? (pi - 1) : 3);
  e0 = g * 4 + lo; e1 = g * 4 + hi;
}
DEVI void phase_g5(const Params& p, int l, unsigned char* lds) {
  const bf16_t* XN = (const bf16_t*)(p.ws + WS_A);
  bf16_t* HID = (bf16_t*)(p.ws + WS_B);
  const bf16_t* WGU = (const bf16_t*)(p.ws + WS_W + l * WS_WL + W_GU);
  const int* CNT = (const int*)(p.ws + SM_CNT) + l * 32;
  const int* LIST = (const int*)(p.ws + SM_LIST);
  const float2* TOKW = (const float2*)(p.ws + SM_TOKW);
  moe_prefix(CNT, lds);
  const int G_ = VGRID, total_ = ((const int*)(lds + LDS_BYTES + 64))[24] * 8, full_ = (total_ / G_) * G_, rem_ = total_ - full_;
  for (int it = vblock(); it < full_ + 2 * rem_; it += G_) {
    const bool halfmode = it >= full_; const int half = (it - full_) & 1;
    MoeItem mi; if (!moe_item(lds, halfmode ? full_ + ((it - full_) >> 1) : it, mi)) break;
    int e0, e1; cls_experts(mi.cls, e0, e1);
    const int ex = (mi.nt < 4) ? e0 : e1, ntl = mi.nt & 3;
    const bf16_t* W = WGU + ((size_t)ex * 512 + ntl * 128) * 1024;
    const int* list = LIST + (size_t)mi.cls * T + mi.mtile * 128;
    const int nvalid = mi.cnt - mi.mtile * 128;
    if (halfmode) {
      f32x4 acc2[2][4];
      int tokA[4];
#pragma unroll
      for (int i = 0; i < 4; ++i) { const int r = (HTID >> 3) + 32 * i; tokA[i] = list[(r < nvalid) ? r : 0]; }
      const int tid = HTID, wid = tid >> 6, lane = tid & 63, fr = lane & 15, fq = lane >> 4;
      int tokE2[2]; float twE2[2];
#pragma unroll
      for (int m = 0; m < 2; ++m) { const int er = wid * 32 + m * 16 + fr; tokE2[m] = list[(er < nvalid) ? er : 0]; }
#pragma unroll
      for (int m = 0; m < 2; ++m) { const float2 tw = TOKW[tokE2[m]]; twE2[m] = (mi.nt < 4) ? tw.x : tw.y; }
      const bf16_t* Wh = W + (size_t)half * 64 * 1024;
      gemm128h(lds, D, [&](int r, int k) { const int i = r >> 5; const int tok = (i == 0) ? tokA[0] : (i == 1) ? tokA[1] : (i == 2) ? tokA[2] : tokA[3]; return XN + (size_t)tok * D + k; },
               [&](int r, int k) { return Wh + (size_t)r * D + k; }, acc2);
#pragma unroll
      for (int m = 0; m < 2; ++m) {
        const int er = wid * 32 + m * 16 + fr;
        if (er < nvalid) {
#pragma unroll
          for (int n = 0; n < 2; ++n) {
            f32x4 hv;
#pragma unroll
            for (int j = 0; j < 4; ++j) { const float gt = acc2[m][n][j], up = acc2[m][n + 2][j]; hv[j] = gt * sigmoidf_(gt) * up * twE2[m]; }
            st_bf16x4(HID + (size_t)tokE2[m] * 512 + (mi.nt < 4 ? 0 : 256) + ntl * 64 + half * 32 + n * 16 + fq * 4, hv);
          }
        }
      }
      continue;
    }
    f32x4 acc[4][4];
    int tokA[4], tokE[4]; float twE[4];
#pragma unroll
    for (int i = 0; i < 4; ++i) { const int r = (HTID >> 3) + 32 * i; tokA[i] = list[(r < nvalid) ? r : 0]; }
    {
      const int tid_ = HTID, er0 = ((tid_ >> 6) >> 1) * 64 + (tid_ & 15);
#pragma unroll
      for (int m = 0; m < 4; ++m) { const int er = er0 + m * 16; tokE[m] = list[(er < nvalid) ? er : 0]; }
#pragma unroll
      for (int m = 0; m < 4; ++m) { const float2 tw = TOKW[tokE[m]]; twE[m] = (mi.nt < 4) ? tw.x : tw.y; }
    }
    gemm128g(lds, D, [&](int r, int k) { const int i = r >> 5; const int tok = (i == 0) ? tokA[0] : (i == 1) ? tokA[1] : (i == 2) ? tokA[2] : tokA[3]; return XN + (size_t)tok * D + k; }, [&](int r, int k) { return W + (size_t)r * D + k; }, acc);
    {
      const int tid = HTID, wid = tid >> 6, lane = tid & 63, wr = wid >> 1, wc = wid & 1, fr = lane & 15, fq = lane >> 4;
#pragma unroll
      for (int m = 0; m < 4; ++m) {
        const int er = wr * 64 + m * 16 + fr;
        if (er < nvalid) {
          const int tok = tokE[m];
          const float w = twE[m];
#pragma unroll
          for (int n = 0; n < 2; ++n) {
            f32x4 hv;
#pragma unroll
            for (int j = 0; j < 4; ++j) { const float gt = acc[m][n][j], up = acc[m][n + 2][j]; hv[j] = gt * sigmoidf_(gt) * up * w; }
            const int hh = (mi.nt < 4 ? 0 : 256) + ntl * 64 + wc * 32 + n * 16 + fq * 4;
            st_bf16x4(HID + (size_t)tok * 512 + hh, hv);
          }
        }
      }
    }
  }
}
DEVI void phase_g6(const Params& p, int l, unsigned char* lds) {
  const bf16_t* HID = (const bf16_t*)(p.ws + WS_B);
  const bf16_t* WDN = (const bf16_t*)(p.ws + WS_W + l * WS_WL + W_DN);
  const int* CNT = (const int*)(p.ws + SM_CNT) + l * 32;
  const int* LIST = (const int*)(p.ws + SM_LIST);
  float* out = p.out;
  moe_prefix(CNT, lds);
  const int G_ = VGRID, total_ = ((const int*)(lds + LDS_BYTES + 64))[24] * 8, full_ = (total_ / G_) * G_, rem_ = total_ - full_;
  for (int it = vblock(); it < full_ + 2 * rem_; it += G_) {
    const bool halfmode = it >= full_; const int half = (it - full_) & 1;
    MoeItem mi; if (!moe_item(lds, halfmode ? full_ + ((it - full_) >> 1) : it, mi)) break;
    int e0, e1; cls_experts(mi.cls, e0, e1);
    const int* list = LIST + (size_t)mi.cls * T + mi.mtile * 128;
    const int nvalid = mi.cnt - mi.mtile * 128;
    const bf16_t* W0 = WDN + ((size_t)e0 * 1024 + mi.nt * 128) * 256;
    const bf16_t* W1 = WDN + ((size_t)e1 * 1024 + mi.nt * 128) * 256;
    if (halfmode) {
      f32x4 acc2[2][4];
      int tokA[4];
#pragma unroll
      for (int i = 0; i < 4; ++i) { const int r = (HTID >> 3) + 32 * i; tokA[i] = list[(r < nvalid) ? r : 0]; }
      const int tid = HTID, wid = tid >> 6, lane = tid & 63, fr = lane & 15, fq = lane >> 4;
      int trow2[2];
#pragma unroll
      for (int m = 0; m < 2; ++m) { const int er = wid * 32 + m * 16 + fr; trow2[m] = list[(er < nvalid) ? er : 0]; }
      const bf16_t* W0h = W0 + (size_t)half * 64 * 256; const bf16_t* W1h = W1 + (size_t)half * 64 * 256;
      gemm128h(lds, 512, [&](int r, int k) { const int i = r >> 5; const int tok = (i == 0) ? tokA[0] : (i == 1) ? tokA[1] : (i == 2) ? tokA[2] : tokA[3]; return HID + (size_t)tok * 512 + k; },
               [&](int r, int k) { return ((k < 256) ? W0h : W1h) + (size_t)r * 256 + (k & 255); }, acc2);
#pragma unroll
      for (int m = 0; m < 2; ++m) {
        const int er = wid * 32 + m * 16 + fr;
        if (er < nvalid) {
#pragma unroll
          for (int n = 0; n < 4; ++n) { float* o = out + (size_t)trow2[m] * D + mi.nt * 128 + half * 64 + n * 16 + fq * 4; const f32x4 xi = *(const f32x4*)o; *(f32x4*)o = xi + acc2[m][n]; }
        }
      }
      continue;
    }
    f32x4 acc[4][4];
    int trow[4], tokA[4];
    {
      const int tid = HTID, wid = tid >> 6, lane = tid & 63, wr = wid >> 1, fr = lane & 15;
#pragma unroll
      for (int i = 0; i < 4; ++i) { const int r = (tid >> 3) + 32 * i; tokA[i] = list[(r < nvalid) ? r : 0]; }
#pragma unroll
      for (int m = 0; m < 4; ++m) { const int er = wr * 64 + m * 16 + fr; trow[m] = list[(er < nvalid) ? er : 0]; }
    }
    gemm128g(lds, 512, [&](int r, int k) { const int i = r >> 5; const int tok = (i == 0) ? tokA[0] : (i == 1) ? tokA[1] : (i == 2) ? tokA[2] : tokA[3]; return HID + (size_t)tok * 512 + k; },
            [&](int r, int k) { return ((k < 256) ? W0 : W1) + (size_t)r * 256 + (k & 255); }, acc);
    GEMM_EPI4({ if (er < nvalid) { const size_t o = (size_t)trow[m] * D + mi.nt * 128 + ec0; const f32x4 xi = *(const f32x4*)(out + o); *(f32x4*)(out + o) = xi + ev4; } })
  }
}


#define XB_TMO      128
#define XB_XCNT(j)  (256  + 64 * (j))
#define XB_XSUB(j)  (1280 + 64 * (j))
#define XB_XGEN(j)  (2304 + 64 * (j))
#define XB_TOP      3328
#define XB_TOPGEN   3392
#define XCD_BAR_WORDS 3456
#define XB_SPIN_CAP (1u << 18)
DEVI unsigned xb_ld(unsigned* p)              { return __hip_atomic_load(p, __ATOMIC_RELAXED, __HIP_MEMORY_SCOPE_AGENT); }
DEVI unsigned xb_add(unsigned* p, unsigned v) { return __hip_atomic_fetch_add(p, v, __ATOMIC_RELAXED, __HIP_MEMORY_SCOPE_AGENT); }
DEVI unsigned xb_xcc_id() { return (unsigned)__builtin_amdgcn_s_getreg((3 << 11) | 20) & 0xFu; }
#define XB_SPIN(cond, bar) do { unsigned _sp = 0; while (cond) { __builtin_amdgcn_s_sleep(1); \
    if ((++_sp & 255u) == 0u) { if (xb_ld(&(bar)[XB_TMO])) break; if (_sp > XB_SPIN_CAP) { atomicAdd(&(bar)[XB_TMO], 1u); break; } } } } while (0)
struct XcdBarrier { unsigned* bar; unsigned x; volatile LAS unsigned* st; };
DEVI XcdBarrier xcd_barrier_post(unsigned* bar, volatile LAS unsigned* st) {
    XcdBarrier b; b.bar = bar; b.x = xb_xcc_id(); b.st = st;
    if (threadIdx.x == 0) (void)xb_add(&bar[XB_XCNT(b.x)], 1u);
    return b;
}
DEVI void xcd_barrier_complete(unsigned* bar, unsigned x, unsigned& nloc, unsigned& nx) {
    const unsigned G = gridDim.x * gridDim.y * gridDim.z;
    unsigned sum, cnt, mine, sp = 0u;
    for (;;) {
        sum = 0u; cnt = 0u; mine = 0u;
#pragma unroll
        for (unsigned j = 0; j < 16; ++j) { const unsigned c = xb_ld(&bar[XB_XCNT(j)]); sum += c; cnt += (c > 0u) ? 1u : 0u; mine = (j == x) ? c : mine; }
        if (sum == G) break;
        __builtin_amdgcn_s_sleep(1);
        if ((++sp & 255u) == 0u) { if (xb_ld(&bar[XB_TMO])) break; if (sp > XB_SPIN_CAP) { atomicAdd(&bar[XB_TMO], 1u); break; } }
    }
    nloc = mine > 0u ? mine : 1u; nx = cnt > 0u ? cnt : 1u;
}
DEVI void xcd_barrier(const XcdBarrier& b) {
    asm volatile("s_waitcnt vmcnt(0)" ::: "memory");
    __syncthreads();
    if (threadIdx.x == 0) {
        unsigned* bar = b.bar;
        __builtin_amdgcn_s_waitcnt(0);
        unsigned nloc = b.st[0], nx = b.st[1];
        if (nloc == 0u) { xcd_barrier_complete(bar, b.x, nloc, nx); b.st[0] = nloc; b.st[1] = nx; }
        const unsigned old = xb_add(&bar[XB_XSUB(b.x)], 1u);
        const unsigned gen = old / nloc;
        if (old + 1u == (gen + 1u) * nloc) {
            __builtin_amdgcn_fence(__ATOMIC_RELEASE, "agent");
            asm volatile("s_waitcnt vmcnt(0)" ::: "memory");
            const unsigned og = xb_add(&bar[XB_TOP], 1u);
            const unsigned tg = og / nx;
            if (og + 1u == (tg + 1u) * nx) xb_add(&bar[XB_TOPGEN], 1u);
            else XB_SPIN(xb_ld(&bar[XB_TOPGEN]) == tg, bar);
            __builtin_amdgcn_fence(__ATOMIC_ACQUIRE, "agent");
            xb_add(&bar[XB_XGEN(b.x)], 1u);
            asm volatile("s_waitcnt vmcnt(0)" ::: "memory");
        } else {
            XB_SPIN(xb_ld(&bar[XB_XGEN(b.x)]) == gen, bar);
            __builtin_amdgcn_fence(__ATOMIC_ACQUIRE, "agent");
            asm volatile("s_waitcnt vmcnt(0)" ::: "memory");
        }
    }
    __syncthreads();
}

#define PH(k, call) { const int _k = (k); if (p.lo <= _k && _k < p.hi) { call; if (_k + 1 < p.hi) { if (_k == 0) grid.sync(); else xcd_barrier(xbar); } } }
__global__ void __launch_bounds__(KTHREADS, 2) hybrid_fwd(Params p) {
  extern __shared__ __attribute__((aligned(16))) unsigned char lds_full[];
  unsigned char* lds = lds_full + hb_() * LDS_HALF;
  cg::grid_group grid = cg::this_grid();
  volatile LAS unsigned* xst = (volatile LAS unsigned*)(LAS unsigned char*)(lds_full + 2 * LDS_HALF);
  if (threadIdx.x < 4) { xst[threadIdx.x] = 0u; g_hs[threadIdx.x] = 0u; }
  __syncthreads();
  XcdBarrier xbar = xcd_barrier_post((unsigned*)(p.ws + WS_CTL), xst);
  PH(0, phase_prep(p, lds))
#define LAYER(l) { \
    PH(1 + 13 * l + 0, phase_g1(p, l, lds_full)) \
    PH(1 + 13 * l + 2, phase_g2(p, l, lds)) \
    PH(1 + 13 * l + 3, phase_r2(p, l, lds)) \
    PH(1 + 13 * l + 4, phase_a1(p, l, lds)) \
    PH(1 + 13 * l + 5, phase_r3(p, l, lds)) \
    PH(1 + 13 * l + 6, phase_g3(p, l, lds)) \
    PH(1 + 13 * l + 7, phase_r4(p, l)) \
    PH(1 + 13 * l + 8, phase_g4(p, l, lds_full)) \
    PH(1 + 13 * l + 9, phase_r5(p, l, lds)) \
    PH(1 + 13 * l + 10, phase_g5(p, l, lds)) \
    PH(1 + 13 * l + 11, phase_g6(p, l, lds)) }
  LAYER(0)
  PH(13, rmsnorm_rows(p.out, p.in[2] + D, (bf16_t*)(p.ws + WS_A)))
  LAYER(1)
}

extern "C" void kernel_launch(void* const* d_in, const int* in_sizes, int n_in, void* d_out, int out_size, void* d_ws, size_t ws_size, hipStream_t stream) {
  static int grid_blocks = 0;
  if (!grid_blocks) {
    if (n_in != 45 || ws_size < WS_END) { fprintf(stderr, "kernel_launch: unexpected n_in %d or ws_size %zu (< %zu)\n", n_in, ws_size, (size_t)WS_END); grid_blocks = -1; return; }
    int dev = 0, cus = 0, per_cu = 0;
    hipGetDevice(&dev);
    hipDeviceGetAttribute(&cus, hipDeviceAttributeMultiprocessorCount, dev);
    hipFuncSetAttribute((const void*)hybrid_fwd, hipFuncAttributeMaxDynamicSharedMemorySize, LDS_ALLOC);
    hipOccupancyMaxActiveBlocksPerMultiprocessor(&per_cu, (const void*)hybrid_fwd, KTHREADS, LDS_ALLOC);
    if (per_cu < 1) per_cu = 1;
    if (per_cu > 1) per_cu = 1;
    grid_blocks = cus * per_cu;
    fprintf(stderr, "kernel_launch: cus %d per_cu %d grid %d\n", cus, per_cu, grid_blocks);
  }
  if (grid_blocks < 0) return;
  (void)hipMemsetAsync((unsigned char*)d_ws + WS_CTL, 0, XCD_BAR_WORDS * 4, stream);
  Params p{};
  for (int i = 0; i < 45; ++i) p.in[i] = (const float*)d_in[i];
  p.out = (float*)d_out; p.ws = (unsigned char*)d_ws;
#if N_LAUNCH_MODE == 1
  p.lo = 0; p.hi = NPH;
  { void* args[] = {&p}; hipError_t e = hipLaunchCooperativeKernel((void*)hybrid_fwd, dim3(grid_blocks), dim3(KTHREADS), args, LDS_ALLOC, stream);
    if (e != hipSuccess) fprintf(stderr, "cooperative launch failed: %s\n", hipGetErrorString(e)); }
#else
  for (int ph = 0; ph < NPH; ++ph) {
    p.lo = ph; p.hi = ph + 1;
    void* args[] = {&p}; hipError_t e = hipLaunchCooperativeKernel((void*)hybrid_fwd, dim3(grid_blocks), dim3(KTHREADS), args, LDS_ALLOC, stream);
    if (e != hipSuccess) { fprintf(stderr, "launch %d failed: %s\n", ph, hipGetErrorString(e)); break; }
  }
#endif
}
```

```cpp
#include <hip/hip_runtime.h>
#include <hip/hip_cooperative_groups.h>
#include <cstdio>
#include <cstdint>
namespace cg = cooperative_groups;

#ifndef N_LAUNCH_MODE
#define N_LAUNCH_MODE 1
#endif

#define DEVI __device__ __forceinline__

constexpr int KTHREADS = 512;
__shared__ unsigned g_hs[4];
#define HTID ((int)(threadIdx.x & 255))
__device__ __forceinline__ int hb_() { return __builtin_amdgcn_readfirstlane((int)(threadIdx.x >> 8)); }
#define VBID ((int)blockIdx.x * 2 + hb_())
#define VGRID ((int)gridDim.x * 2)
__device__ __forceinline__ void hsync() {
  asm volatile("s_waitcnt lgkmcnt(0)" ::: "memory");
  if ((threadIdx.x & 63) == 0) {
    unsigned* c = &g_hs[hb_()];
    const unsigned old = __hip_atomic_fetch_add(c, 1u, __ATOMIC_RELAXED, __HIP_MEMORY_SCOPE_WORKGROUP);
    const unsigned target = (old & ~3u) + 4u;
    if (old + 1u != target) {
      while ((int)(__hip_atomic_load(c, __ATOMIC_RELAXED, __HIP_MEMORY_SCOPE_WORKGROUP) - target) < 0) {}
    }
  }
  asm volatile("" ::: "memory");
}
typedef unsigned short bf16_t;
typedef short bf16x8 __attribute__((ext_vector_type(8)));
typedef float f32x4 __attribute__((ext_vector_type(4)));
typedef float f32x16 __attribute__((ext_vector_type(16)));
typedef unsigned u32x4 __attribute__((ext_vector_type(4)));
#define LAS __attribute__((address_space(3)))

constexpr int NB = 16, S = 2048, T = NB * S, D = 1024, DIN = 1772, DINP = 1792, NL = 2;
constexpr int C_CQ = 0, C_KPE = 192, C_NG = 224, C_T1 = 256, C_LX = 512, C_LG = 768, C_S5 = 1024, C_T5 = 1280, C_KC = 1536, C_VC = 1600, C_VS = 1664, C_VW = 1728;
__host__ __device__ constexpr int wgcol(int tile0, int wc, int e) { return tile0 + 128 * (e >> 5) + 32 * wc + (e & 31); }
__host__ __device__ constexpr int colmap(int n) {
  if (n < 192) return n;
  if (n < 320) { const int k = n - 192; return wgcol(C_T1, k >> 6, k & 63); }
  if (n < 352) return C_KPE + (n - 320);
  if (n < 608) return C_LX + (n - 352);
  if (n < 864) return C_LG + (n - 608);
  if (n < 1120) return C_S5 + (n - 864);
  if (n < 1376) { const int q = n - 1120; return wgcol(C_T5, q >> 6, q & 63); }
  if (n < 1760) { const int j = n - 1376, part = j >> 6, d = j & 63;
    return part == 0 ? C_KC + d : part == 1 ? C_VC + d : part == 2 ? wgcol(C_T1, 2, d) : part == 3 ? C_VS + d : part == 4 ? wgcol(C_T1, 3, d) : C_VW + d; }
  return C_NG + (n - 1760);
}
constexpr float EPS = 1e-6f;
constexpr float LOG2E = 1.4426950408889634f;
constexpr int NTHREADS = 256;
constexpr int NPH = 1 + 13 * NL - 1;

constexpr size_t MiB = 1u << 20;
constexpr size_t WS_CTL = 0;
constexpr size_t WS_SMALL = 1 * MiB;
constexpr size_t WS_W = 16 * MiB;
constexpr size_t WS_WL = 32 * MiB;
constexpr size_t WS_A = 80 * MiB;
constexpr size_t WS_B = 144 * MiB;
constexpr size_t WS_C = 256 * MiB;
constexpr size_t WS_D = 292 * MiB;
constexpr size_t WS_E = 348 * MiB;
constexpr size_t WS_F = 380 * MiB;
constexpr size_t WS_G = 428 * MiB;
constexpr size_t WS_ROPE = 452 * MiB;
constexpr size_t WS_END = 460 * MiB;
constexpr size_t W_IN = 0;
constexpr size_t W_OUT = 4 * MiB;
constexpr size_t W_UQ = 6 * MiB;
constexpr size_t W_UKV = W_UQ + 384 * 192 * 2;
constexpr size_t W_LRU = W_UKV + 512 * 128 * 2;
constexpr size_t W_GLU = W_LRU + 4 * 128 * 64 * 2;
constexpr size_t W_1K = 6 * MiB + 512 * 1024;
constexpr size_t W_1V = W_1K + 128 * 2048 * 2;
constexpr size_t W_B1K = W_1V + 128 * 2048 * 2;
constexpr size_t W_B1V = W_B1K + 512;
constexpr size_t W_S5A = W_B1V + 512;
constexpr size_t W_S5A64 = W_S5A + 16 * 64 * 8;
constexpr size_t W_S5B = W_S5A64 + 16 * 64 * 8;
constexpr size_t W_S5BB = W_S5B + 16 * 64 * 16 * 8;
constexpr size_t W_S5CM = W_S5BB + 16 * 4 * 32 * 16 * 2;
constexpr size_t W_2K = W_S5CM + 16 * 16 * 128 * 2;
constexpr size_t W_2V = W_2K + 64 * 128 * 2;
static_assert(W_2V + 64 * 128 * 2 <= 8 * MiB, "weights overflow");
constexpr size_t W_RTH = W_2V + 64 * 128 * 2;
constexpr size_t W_RTL = W_RTH + 32 * 1024 * 2;
static_assert(W_RTL + 32 * 1024 * 2 <= 8 * MiB, "weights overflow 2");
constexpr size_t W_GU = 8 * MiB;
constexpr size_t W_DN = 24 * MiB;
constexpr size_t SM_CNT = WS_SMALL;
constexpr size_t SM_LIST = WS_SMALL + 4096;
constexpr size_t SM_TOKW = SM_LIST + 24 * (size_t)T * 4;
constexpr size_t SM_LSUM = SM_TOKW + (size_t)T * 8;
constexpr size_t SM_SLOC = SM_LSUM + 16 * 32 * 256 * 8;
constexpr size_t SM_HK = SM_SLOC + 16 * 32 * 1024 * 8;
constexpr size_t SM_HV = SM_HK + 2048 * 128 * 2;
constexpr size_t SM_KC = SM_HV + 2048 * 128 * 2;
constexpr size_t SM_VC = SM_KC + 16 * 128 * 64 * 2;
constexpr size_t SM_SCAR = SM_VC + 16 * 128 * 64 * 2;
constexpr size_t SM_LCAR = SM_SCAR + 16 * 32 * 1024 * 8;
constexpr size_t SM_SSKV = SM_LCAR + 16 * 32 * 256 * 4;
constexpr size_t SM_END = SM_SSKV + (size_t)T * 2 * 4;
static_assert(SM_END <= WS_W, "small region overflow");

constexpr int LDS_BYTES = 65536;
constexpr int LDS_HALF = LDS_BYTES + 512;
constexpr int LDS_ALLOC = 2 * LDS_HALF + 64;

struct Params {
  const float* in[45];
  float* out;
  unsigned char* ws;
  int lo, hi;
};

DEVI float bf2f(bf16_t v) { return __uint_as_float(((unsigned)v) << 16); }
DEVI bf16_t f2bf(float f) { unsigned u = __float_as_uint(f); return (bf16_t)((u + 0x7fffu + ((u >> 16) & 1u)) >> 16); }
DEVI float wsum(float v) {
#pragma unroll
  for (int o = 32; o >= 1; o >>= 1) v += __shfl_xor(v, o);
  return v;
}
DEVI float sigmoidf_(float x) { return __builtin_amdgcn_rcpf(1.f + __expf(-x)); }
DEVI float gelu_tanh(float x) { const float u2 = 1.5957691216057308f * (x + 0.044715f * x * x * x); return x * __builtin_amdgcn_rcpf(1.f + __expf(-u2)); }
DEVI f32x16 mfma32(bf16x8 a, bf16x8 b, f32x16 c) { return __builtin_amdgcn_mfma_f32_32x32x16_bf16(a, b, c, 0, 0, 0); }
DEVI f32x4 mfma16(bf16x8 a, bf16x8 b, f32x4 c) { return __builtin_amdgcn_mfma_f32_16x16x32_bf16(a, b, c, 0, 0, 0); }
DEVI int vblock() { const int bx = (int)blockIdx.x, GB = (int)gridDim.x; return (GB % 8 == 0) ? (bx % 8) * (GB / 8) * 2 + (bx / 8) * 2 + hb_() : VBID; }
DEVI int crow(int r, int h) { return (r & 3) + 8 * (r >> 2) + 4 * h; }
typedef __bf16 bf16x2_t __attribute__((ext_vector_type(2)));
typedef float f32x2_t __attribute__((ext_vector_type(2)));
DEVI unsigned pk2bf(float lo, float hi) { f32x2_t v = {lo, hi}; bf16x2_t b = __builtin_convertvector(v, bf16x2_t); return __builtin_bit_cast(unsigned, b); }

template <class AF, class BF>
DEVI void gemm128(unsigned char* lds, int K, AF aload, BF bptr, f32x4 (&acc)[4][4]) {
  const int tid = HTID, wid = tid >> 6, lane = tid & 63, wr = wid >> 1, wc = wid & 1, fr = lane & 15, fq = lane >> 4;
#pragma unroll
  for (int m = 0; m < 4; ++m)
#pragma unroll
    for (int n = 0; n < 4; ++n) acc[m][n] = (f32x4){0.f, 0.f, 0.f, 0.f};
  const int lr = tid >> 3, ch = tid & 7;
  const int wofs = lr * 128 + ((ch ^ ((lr >> 1) & 7)) * 16);
  const int sw = (fr >> 1) & 7;
  const int aro = (wr * 64 + fr) * 128, bro = (wc * 64 + fr) * 128;
  const int nk = K >> 6;
  u32x4 ra[4], rb[4];
#pragma unroll
  for (int i = 0; i < 4; ++i) { ra[i] = aload(lr + 32 * i, ch * 8); rb[i] = *(const u32x4*)bptr(lr + 32 * i, ch * 8); }
  hsync();
#pragma unroll
  for (int i = 0; i < 4; ++i) { *(u32x4*)(lds + wofs + i * 4096) = ra[i]; *(u32x4*)(lds + 16384 + wofs + i * 4096) = rb[i]; }
  hsync();
  for (int kt = 0; kt < nk; ++kt) {
    const bool more = (kt + 1 < nk);
    if (more) {
      const int k = (kt + 1) * 64 + ch * 8;
#pragma unroll
      for (int i = 0; i < 4; ++i) { ra[i] = aload(lr + 32 * i, k); rb[i] = *(const u32x4*)bptr(lr + 32 * i, k); }
    }
    const unsigned char* bufA = lds + (kt & 1) * 32768;
    const unsigned char* bufB = bufA + 16384;
#pragma unroll
    for (int kk = 0; kk < 2; ++kk) {
      bf16x8 At[4], Bt[4];
      const int co = ((kk * 4 + fq) ^ sw) * 16;
#pragma unroll
      for (int m = 0; m < 4; ++m) At[m] = *(const bf16x8*)(bufA + aro + m * 2048 + co);
#pragma unroll
      for (int n = 0; n < 4; ++n) Bt[n] = *(const bf16x8*)(bufB + bro + n * 2048 + co);
#pragma unroll
      for (int m = 0; m < 4; ++m)
#pragma unroll
        for (int n = 0; n < 4; ++n) acc[m][n] = mfma16(Bt[n], At[m], acc[m][n]);
    }
    if (more) {
      unsigned char* nb = lds + ((kt + 1) & 1) * 32768;
#pragma unroll
      for (int i = 0; i < 4; ++i) { *(u32x4*)(nb + wofs + i * 4096) = ra[i]; *(u32x4*)(nb + 16384 + wofs + i * 4096) = rb[i]; }
    }
    hsync();
  }
}
template <class AF, class BF>
DEVI void gemm128g(unsigned char* lds, int K, AF aptr, BF bptr, f32x4 (&acc)[4][4]) {
  const int tid = HTID, wid = tid >> 6, lane = tid & 63, wr = wid >> 1, wc = wid & 1, fr = lane & 15, fq = lane >> 4;
#pragma unroll
  for (int m = 0; m < 4; ++m)
#pragma unroll
    for (int n = 0; n < 4; ++n) acc[m][n] = (f32x4){0.f, 0.f, 0.f, 0.f};
  const int lr = tid >> 3;
  const int chs = ((tid & 7) ^ ((lr >> 1) & 7)) * 8;
  const int sw = (fr >> 1) & 7;
  const int aro = (wr * 64 + fr) * 128, bro = (wc * 64 + fr) * 128;
  const int nk = K >> 6;
  LAS unsigned char* l3 = (LAS unsigned char*)lds;
#define G128_STAGE(buf, kbase)                                                                                                   \
  _Pragma("unroll") for (int i = 0; i < 4; ++i) {                                                                                 \
    __builtin_amdgcn_global_load_lds((const __attribute__((address_space(1))) unsigned*)aptr(lr + 32 * i, (kbase) + chs),          \
                                     (LAS unsigned*)(l3 + (buf) * 32768 + tid * 16 + i * 4096), 16, 0, 0);                           \
    __builtin_amdgcn_global_load_lds((const __attribute__((address_space(1))) unsigned*)bptr(lr + 32 * i, (kbase) + chs),          \
                                     (LAS unsigned*)(l3 + (buf) * 32768 + 16384 + tid * 16 + i * 4096), 16, 0, 0);                   \
  }
  hsync();
  G128_STAGE(0, 0)
  asm volatile("s_waitcnt vmcnt(0)" ::: "memory");
  hsync();
  for (int kt = 0; kt < nk; ++kt) {
    if (kt + 1 < nk) { G128_STAGE((kt + 1) & 1, (kt + 1) * 64) }
    const unsigned char* bufA = lds + (kt & 1) * 32768;
    const unsigned char* bufB = bufA + 16384;
#pragma unroll
    for (int kk = 0; kk < 2; ++kk) {
      bf16x8 At[4], Bt[4];
      const int co = ((kk * 4 + fq) ^ sw) * 16;
#pragma unroll
      for (int m = 0; m < 4; ++m) At[m] = *(const bf16x8*)(bufA + aro + m * 2048 + co);
#pragma unroll
      for (int n = 0; n < 4; ++n) Bt[n] = *(const bf16x8*)(bufB + bro + n * 2048 + co);
#pragma unroll
      for (int m = 0; m < 4; ++m)
#pragma unroll
        for (int n = 0; n < 4; ++n) acc[m][n] = mfma16(Bt[n], At[m], acc[m][n]);
    }
    asm volatile("s_waitcnt vmcnt(0)" ::: "memory");
    hsync();
  }
#undef G128_STAGE
}
DEVI void gemm128p(unsigned char* lds, int K, const bf16_t* Ab, size_t lda, const bf16_t* Bb, size_t ldb, f32x4 (&acc)[4][4], int& par, bool staged, bool has_next, const bf16_t* Abn, const bf16_t* Bbn) {
  const int tid = HTID, wid = tid >> 6, lane = tid & 63, wr = wid >> 1, wc = wid & 1, fr = lane & 15, fq = lane >> 4;
#pragma unroll
  for (int m = 0; m < 4; ++m)
#pragma unroll
    for (int n = 0; n < 4; ++n) acc[m][n] = (f32x4){0.f, 0.f, 0.f, 0.f};
  const int lr = tid >> 3;
  const int chs = ((tid & 7) ^ ((lr >> 1) & 7)) * 8;
  const int sw = (fr >> 1) & 7;
  const int aro = (wr * 64 + fr) * 128, bro = (wc * 64 + fr) * 128;
  const int nk = K >> 6;
  LAS unsigned char* l3 = (LAS unsigned char*)lds;
#define GP_STAGE(buf, kbase, APTR, BPTR)                                                                                             \
  _Pragma("unroll") for (int i = 0; i < 4; ++i) {                                                                                 \
    __builtin_amdgcn_global_load_lds((const __attribute__((address_space(1))) unsigned*)((APTR) + (size_t)(lr + 32 * i) * lda + (kbase) + chs),            \
                                     (LAS unsigned*)(l3 + (buf) * 32768 + tid * 16 + i * 4096), 16, 0, 0);                           \
    __builtin_amdgcn_global_load_lds((const __attribute__((address_space(1))) unsigned*)((BPTR) + (size_t)(lr + 32 * i) * ldb + (kbase) + chs),            \
                                     (LAS unsigned*)(l3 + (buf) * 32768 + 16384 + tid * 16 + i * 4096), 16, 0, 0);                   \
  }
  if (!staged) {
    hsync();
    GP_STAGE(par, 0, Ab, Bb)
    asm volatile("s_waitcnt vmcnt(0)" ::: "memory");
    hsync();
  }
  for (int kt = 0; kt < nk; ++kt) {
    const int cur = (par + kt) & 1;
    { const bool inner = kt + 1 < nk; if (inner || has_next) { const bf16_t* ap_ = inner ? Ab : Abn; const bf16_t* bp_ = inner ? Bb : Bbn; const int kb_ = inner ? (kt + 1) * 64 : 0; GP_STAGE(cur ^ 1, kb_, ap_, bp_) } }
    const unsigned char* bufA = lds + cur * 32768;
    const unsigned char* bufB = bufA + 16384;
#pragma unroll
    for (int kk = 0; kk < 2; ++kk) {
      bf16x8 At[4], Bt[4];
      const int co = ((kk * 4 + fq) ^ sw) * 16;
#pragma unroll
      for (int m = 0; m < 4; ++m) At[m] = *(const bf16x8*)(bufA + aro + m * 2048 + co);
#pragma unroll
      for (int n = 0; n < 4; ++n) Bt[n] = *(const bf16x8*)(bufB + bro + n * 2048 + co);
#pragma unroll
      for (int m = 0; m < 4; ++m)
#pragma unroll
        for (int n = 0; n < 4; ++n) acc[m][n] = mfma16(Bt[n], At[m], acc[m][n]);
    }
    asm volatile("s_waitcnt vmcnt(0)" ::: "memory");
    hsync();
  }
  par = (par + nk) & 1;
#undef GP_STAGE
}
template <class AF, class BF>
DEVI void gemm128h(unsigned char* lds, int K, AF aptr, BF bptr, f32x4 (&acc)[2][4]) {
  const int tid = HTID, wid = tid >> 6, lane = tid & 63, fr = lane & 15, fq = lane >> 4;
#pragma unroll
  for (int m = 0; m < 2; ++m)
#pragma unroll
    for (int n = 0; n < 4; ++n) acc[m][n] = (f32x4){0.f, 0.f, 0.f, 0.f};
  const int lr = tid >> 3;
  const int chs = ((tid & 7) ^ ((lr >> 1) & 7)) * 8;
  const int sw = (fr >> 1) & 7;
  const int aro = (wid * 32 + fr) * 128, bro = fr * 128;
  const int nk = K >> 6;
  LAS unsigned char* l3 = (LAS unsigned char*)lds;
#define GH_STAGE(buf, kbase)                                                                                                     \
  { _Pragma("unroll") for (int i = 0; i < 4; ++i)                                                                                 \
      __builtin_amdgcn_global_load_lds((const __attribute__((address_space(1))) unsigned*)aptr(lr + 32 * i, (kbase) + chs),        \
                                       (LAS unsigned*)(l3 + (buf) * 32768 + tid * 16 + i * 4096), 16, 0, 0);                         \
    _Pragma("unroll") for (int i = 0; i < 2; ++i)                                                                                 \
      __builtin_amdgcn_global_load_lds((const __attribute__((address_space(1))) unsigned*)bptr(lr + 32 * i, (kbase) + chs),        \
                                       (LAS unsigned*)(l3 + (buf) * 32768 + 16384 + tid * 16 + i * 4096), 16, 0, 0); }
  hsync();
  GH_STAGE(0, 0)
  asm volatile("s_waitcnt vmcnt(0)" ::: "memory");
  hsync();
  for (int kt = 0; kt < nk; ++kt) {
    if (kt + 1 < nk) { GH_STAGE((kt + 1) & 1, (kt + 1) * 64) }
    const unsigned char* bufA = lds + (kt & 1) * 32768;
    const unsigned char* bufB = bufA + 16384;
#pragma unroll
    for (int kk = 0; kk < 2; ++kk) {
      bf16x8 At[2], Bt[4];
      const int co = ((kk * 4 + fq) ^ sw) * 16;
#pragma unroll
      for (int m = 0; m < 2; ++m) At[m] = *(const bf16x8*)(bufA + aro + m * 2048 + co);
#pragma unroll
      for (int n = 0; n < 4; ++n) Bt[n] = *(const bf16x8*)(bufB + bro + n * 2048 + co);
#pragma unroll
      for (int m = 0; m < 2; ++m)
#pragma unroll
        for (int n = 0; n < 4; ++n) acc[m][n] = mfma16(Bt[n], At[m], acc[m][n]);
    }
    asm volatile("s_waitcnt vmcnt(0)" ::: "memory");
    hsync();
  }
#undef GH_STAGE
}
#define GEMM_EPI_LOOP(body)                                                                 \
  {                                                                                         \
    const int _tid = HTID, _wid = _tid >> 6, _lane = _tid & 63, _wr = _wid >> 1, _wc = _wid & 1, _fr = _lane & 15, _fq = _lane >> 4; \
    _Pragma("unroll") for (int m = 0; m < 4; ++m) _Pragma("unroll") for (int n = 0; n < 4; ++n) _Pragma("unroll") for (int j = 0; j < 4; ++j) { \
      const int er = _wr * 64 + m * 16 + _fr, ec = _wc * 64 + n * 16 + _fq * 4 + j; const float ev = acc[m][n][j]; body }                      \
  }
#define GEMM_EPI4(body)                                                                     \
  {                                                                                         \
    const int _tid = HTID, _wid = _tid >> 6, _lane = _tid & 63, _wr = _wid >> 1, _wc = _wid & 1, _fr = _lane & 15, _fq = _lane >> 4; \
    _Pragma("unroll") for (int m = 0; m < 4; ++m) _Pragma("unroll") for (int n = 0; n < 4; ++n) {                                             \
      const int er = _wr * 64 + m * 16 + _fr, ec0 = _wc * 64 + n * 16 + _fq * 4; const f32x4 ev4 = acc[m][n]; body }                          \
  }
DEVI void st_bf16x4(bf16_t* p, f32x4 v) { uint2 o; o.x = pk2bf(v[0], v[1]); o.y = pk2bf(v[2], v[3]); *(uint2*)p = o; }

namespace pg8 {
#define PG8_LAS __attribute__((address_space(3)))
typedef unsigned short bf16_t;
typedef short bf16x8 __attribute__((ext_vector_type(8)));
typedef float f32x4 __attribute__((ext_vector_type(4)));
typedef unsigned u32x4 __attribute__((ext_vector_type(4)));
constexpr int BM = 256, BK = 64, HALF = 128, HTB = HALF * BK * 2  , STAGE_BYTES = 8 * HTB, NXCD = 8, WGM = 8;

__host__ __device__ __forceinline__ int lds_byte(int r, int c) { const int st = (r >> 4) * 2 + (c >> 5), rr = r & 15, cc = c & 31, ob = rr * 64 + cc * 2; return st * 1024 + (ob ^ (((ob >> 9) & 1) << 5)); }
__host__ __device__ __forceinline__ void stage_rc(int b, int& R, int& C) { const int st = b / 1024, sb = b % 1024, swz = sb ^ (((sb >> 9) & 1) << 5); R = (st >> 1) * 16 + swz / 64; C = (st & 1) * 32 + (swz % 64) / 2; }
__host__ __device__ __forceinline__ int perm32(int rho) { const int n = rho >> 4, i = rho & 15; return 8 * (i >> 2) + 4 * n + (i & 3); }

struct Unit { int pm, pn; };
struct Gemm { const bf16_t* A; const bf16_t* Bt; int M, N, K; };

struct StaticOrder {
    int nM, nN, nwg, G, c;
    __host__ __device__ void init(int M, int N, int G_, int c_) { nM = M / BM; nN = N / BM; nwg = nM * nN; G = G_; c = c_; }
    __host__ __device__ bool next(int i, Unit& u) const {
        const long L = (long)i * G + c; if (L >= nwg) return false;
        int wgid = (int)L; { const int q = nwg / NXCD, r = nwg % NXCD, xcd = wgid % NXCD, off = wgid / NXCD; wgid = (xcd < r ? xcd * (q + 1) : r * (q + 1) + (xcd - r) * q) + off; }
        const int nig = WGM * nN, gid = wgid / nig, fm = gid * WGM, gsz = (nM - fm) < WGM ? (nM - fm) : WGM;
        u.pm = fm + ((wgid % nig) % gsz); u.pn = (wgid % nig) / gsz; return true;
    }
    __device__ __forceinline__ void a_ready(const Unit&) const {}
    __device__ __forceinline__ void done(const Unit&) const {}
};

__device__ __forceinline__ unsigned cvt_pk_bf16(float lo, float hi) { unsigned r; asm volatile("v_cvt_pk_bf16_f32 %0, %1, %2" : "=v"(r) : "v"(lo), "v"(hi)); return r; }
typedef float f32x2 __attribute__((ext_vector_type(2)));
__device__ __forceinline__ f32x2 gelu_pk(f32x2 v) {
    const f32x2 av = __builtin_elementwise_abs(v), d = av * 0.2316418882f + 1.0f;
    f32x2 t; t.x = __builtin_amdgcn_rcpf(d.x); t.y = __builtin_amdgcn_rcpf(d.y);
    f32x2 q = t * 0.5307027145f + (-0.7265760135f); q = q * t + 0.7107068705f; q = q * t + (-0.142248368f); q = q * t + 0.127414796f; q = q * t;
    const f32x2 s = (v * v) * (-0.72134752044f);
    f32x2 e; e.x = __builtin_amdgcn_exp2f(s.x); e.y = __builtin_amdgcn_exp2f(s.y);
    const f32x2 m = v * (q * e), r = v - m;
    f32x2 o; o.x = v.x < 0.f ? m.x : r.x; o.y = v.y < 0.f ? m.y : r.y; return o;
}

template <int ACT  > struct EpiBf16 {
    static constexpr bool PERM = true, AFTER_DRAIN = false; static_assert(ACT == 0 || ACT == 1, "EpiBf16: ACT is 0 (none) or 1 (gelu_pk)");
    bf16_t* O; int ldc; const float* bias; int split_cols; size_t split_stride; float scale0;
    __device__ __forceinline__ void operator()(const f32x4 (&acc)[2][2][4][2], const Unit& u, int wr, int wc, int fr, int fq) const {
        const int row0 = u.pm * BM + wr * 64 + fr; int colt = u.pn * BM; bf16_t* base = O;
        float sc = 1.f; if (split_cols) { const int t = colt / split_cols; base += (size_t)t * split_stride; colt -= t * split_cols; if (t == 0) sc = scale0; }
        const int col0 = colt + wc * 32 + 8 * fq, bcol0 = u.pn * BM + wc * 32 + 8 * fq;
        f32x4 bv[2][2];
#pragma unroll
        for (int bj = 0; bj < 2; ++bj)
#pragma unroll
            for (int n = 0; n < 2; ++n) bv[bj][n] = bias ? *(const f32x4*)(bias + bcol0 + bj * HALF + 4 * n) : (f32x4){0.f, 0.f, 0.f, 0.f};
#pragma unroll
        for (int ai = 0; ai < 2; ++ai)
#pragma unroll
            for (int m = 0; m < 4; ++m) { bf16_t* rowp = base + (size_t)(row0 + ai * HALF + m * 16) * ldc + col0;
#pragma unroll
                for (int bj = 0; bj < 2; ++bj) { f32x4 v0 = acc[ai][bj][m][0] + bv[bj][0], v1 = acc[ai][bj][m][1] + bv[bj][1];
                    if (ACT == 1) { f32x2 a = gelu_pk((f32x2){v0[0], v0[1]}), b = gelu_pk((f32x2){v0[2], v0[3]}), c = gelu_pk((f32x2){v1[0], v1[1]}), d = gelu_pk((f32x2){v1[2], v1[3]});
                        v0 = (f32x4){a.x, a.y, b.x, b.y}; v1 = (f32x4){c.x, c.y, d.x, d.y}; }
                    v0 = v0 * sc; v1 = v1 * sc; u32x4 w; w.x = cvt_pk_bf16(v0[0], v0[1]); w.y = cvt_pk_bf16(v0[2], v0[3]); w.z = cvt_pk_bf16(v1[0], v1[1]); w.w = cvt_pk_bf16(v1[2], v1[3]);
                    *(u32x4*)(rowp + bj * HALF) = w; } }
    }
};

template <class Epi, class Sched, bool ALIGN_EPI = false, bool SP2 = false>
__device__ __forceinline__ void gemm_phase(PG8_LAS unsigned char* lds, const Gemm g, const Sched& S, const Epi& E) {
    const int tid = threadIdx.x, wid = __builtin_amdgcn_readfirstlane(tid >> 6), lane = tid & 63, wr = wid >> 2, wc = wid & 3, fr = lane & 15, fq = lane >> 4;
    const int K = g.K, nt = K / BK;
    unsigned voffA[2], voffB[2];
#pragma unroll
    for (int i = 0; i < 2; ++i) { int R, C; stage_rc(tid * 16 + i * 8192, R, C); const int Rb = Epi::PERM ? ((R & ~31) + perm32(R & 31)) : R;
        voffA[i] = (unsigned)(R * K + C) * 2u; voffB[i] = (unsigned)(Rb * K + C) * 2u; }
    const size_t kstep = (size_t)(BK * 2);
    const size_t hstep = (size_t)HALF * K * 2;
    const size_t tstep = 2 * hstep;
    const unsigned ldsw = (unsigned)wid * 1024u;
    const int aoff = lds_byte(wr * 64 + fr, fq * 8), boff = lds_byte(wc * 32 + fr, fq * 8);
#define PG8_SA(b, h) (((b) * 2 + (h)) * HTB)
#define PG8_SB(b, h) ((4 + (b) * 2 + (h)) * HTB)
#define PG8_STAGE(bufoff, gbase, voff) do { _Pragma("unroll") for (int _i = 0; _i < 2; ++_i) \
        __builtin_amdgcn_global_load_lds((const unsigned*)((const char*)(gbase) + (voff)[_i]), (PG8_LAS unsigned*)(lds + (bufoff) + ldsw + _i * 8192), 16, 0, 0); } while (0)
#define PG8_LDA(dst, b, h) do { _Pragma("unroll") for (int m = 0; m < 4; ++m) _Pragma("unroll") for (int k = 0; k < 2; ++k) dst[m][k] = *(const PG8_LAS bf16x8*)(lds + PG8_SA(b, h) + aoff + m * 2048 + k * 1024); } while (0)
#define PG8_LDB(dst, b, h) do { _Pragma("unroll") for (int n = 0; n < 2; ++n) _Pragma("unroll") for (int k = 0; k < 2; ++k) dst[n][k] = *(const PG8_LAS bf16x8*)(lds + PG8_SB(b, h) + boff + n * 2048 + k * 1024); } while (0)
#define PG8_MMA(ai, bj, At, Bt) do { __builtin_amdgcn_s_setprio(1); _Pragma("unroll") for (int m = 0; m < 4; ++m) _Pragma("unroll") for (int n = 0; n < 2; ++n) _Pragma("unroll") for (int k = 0; k < 2; ++k) \
        acc[ai][bj][m][n] = __builtin_amdgcn_mfma_f32_16x16x32_bf16(Bt[n][k], At[m][k], acc[ai][bj][m][n], 0, 0, 0); __builtin_amdgcn_s_setprio(0); } while (0)
#define PG8_WAIT_V(n) asm volatile("s_waitcnt vmcnt(" #n ")" ::: "memory")
#define PG8_WAIT_L(n) asm volatile("s_waitcnt lgkmcnt(" #n ")" ::: "memory")
#define PG8_BAR __builtin_amdgcn_s_barrier()
#define PG8_SCHED __builtin_amdgcn_sched_barrier(0)
    Unit cur, nxt; int ui = 0;
    if (!S.next(0, cur)) return;
    f32x4 acc[2][2][4][2];
#pragma unroll
    for (int a = 0; a < 2; ++a)
#pragma unroll
        for (int b = 0; b < 2; ++b)
#pragma unroll
            for (int m = 0; m < 4; ++m)
#pragma unroll
                for (int n = 0; n < 2; ++n) acc[a][b][m][n] = (f32x4){0.f, 0.f, 0.f, 0.f};
    bf16x8 At[4][2], B0[2][2], B1[2][2];
    const char* cA = (const char*)g.A + (size_t)cur.pm * tstep; const char* cB = (const char*)g.Bt + (size_t)cur.pn * tstep;
    S.a_ready(cur);
    if constexpr (SP2) {
        PG8_STAGE(PG8_SB(0, 0), cB, voffB); PG8_STAGE(PG8_SB(0, 1), cB + hstep, voffB); PG8_STAGE(PG8_SA(0, 0), cA, voffA); PG8_STAGE(PG8_SA(0, 1), cA + hstep, voffA);
        if (wr == 1) PG8_BAR;
        PG8_WAIT_V(2); PG8_BAR;
        PG8_STAGE(PG8_SB(1, 0), cB + kstep, voffB); PG8_STAGE(PG8_SA(1, 0), cA + kstep, voffA); PG8_STAGE(PG8_SB(1, 1), cB + hstep + kstep, voffB);
        PG8_WAIT_V(6); PG8_BAR;
    } else {
        PG8_STAGE(PG8_SB(0, 0), cB, voffB); PG8_STAGE(PG8_SA(0, 0), cA, voffA); PG8_STAGE(PG8_SB(0, 1), cB + hstep, voffB); PG8_STAGE(PG8_SA(0, 1), cA + hstep, voffA);
        if (wr == 1) PG8_BAR;
        PG8_WAIT_V(4); PG8_BAR;
        PG8_STAGE(PG8_SB(1, 0), cB + kstep, voffB); PG8_STAGE(PG8_SA(1, 0), cA + kstep, voffA); PG8_STAGE(PG8_SB(1, 1), cB + hstep + kstep, voffB);
        PG8_WAIT_V(6); PG8_BAR;
    }
    for (;;) {
        const bool has_next = S.next(ui + 1, nxt);
        const char* nA = has_next ? (const char*)g.A + (size_t)nxt.pm * tstep : cA; const char* nB = has_next ? (const char*)g.Bt + (size_t)nxt.pn * tstep : cB;
        for (int t = 0; t < nt; t += 2) {
            const bool last = (t == nt - 2);
            const char* a1 = cA + (size_t)(t + 1) * kstep;
            const char* a2 = last ? nA : cA + (size_t)(t + 2) * kstep; const char* b2 = last ? nB : cB + (size_t)(t + 2) * kstep;
            const char* a3 = a2 + kstep; const char* b3 = b2 + kstep;
            if (last && has_next) S.a_ready(nxt);
            if constexpr (SP2) {
            PG8_LDB(B0, 0, 0); PG8_LDB(B1, 0, 1); PG8_SCHED; PG8_LDA(At, 0, 0); PG8_STAGE(PG8_SA(1, 1), a1 + hstep, voffA);
            PG8_WAIT_V(8); PG8_WAIT_L(0); PG8_BAR; PG8_MMA(0, 0, At, B0); PG8_MMA(0, 1, At, B1); PG8_BAR; PG8_SCHED;
            PG8_LDA(At, 0, 1); PG8_STAGE(PG8_SB(0, 0), b2, voffB); PG8_STAGE(PG8_SB(0, 1), b2 + hstep, voffB); PG8_STAGE(PG8_SA(0, 0), a2, voffA);
            PG8_WAIT_V(8); PG8_WAIT_L(0); PG8_BAR; PG8_MMA(1, 0, At, B0); PG8_MMA(1, 1, At, B1); PG8_BAR; PG8_SCHED;
            PG8_LDB(B0, 1, 0); PG8_LDB(B1, 1, 1); PG8_SCHED; PG8_LDA(At, 1, 0); PG8_STAGE(PG8_SA(0, 1), a2 + hstep, voffA);
            PG8_WAIT_V(8); PG8_WAIT_L(0); PG8_BAR; PG8_MMA(0, 0, At, B0); PG8_MMA(0, 1, At, B1); PG8_BAR; PG8_SCHED;
            PG8_LDA(At, 1, 1); PG8_STAGE(PG8_SB(1, 0), b3, voffB); PG8_STAGE(PG8_SB(1, 1), b3 + hstep, voffB); PG8_STAGE(PG8_SA(1, 0), a3, voffA);
            PG8_WAIT_V(8); PG8_WAIT_L(0); PG8_BAR; PG8_MMA(1, 0, At, B0); PG8_MMA(1, 1, At, B1); PG8_BAR; PG8_SCHED;
            } else {
            PG8_LDB(B0, 0, 0); PG8_SCHED; PG8_LDA(At, 0, 0); PG8_STAGE(PG8_SA(1, 1), a1 + hstep, voffA);
            PG8_WAIT_L(8); PG8_BAR; PG8_WAIT_L(0); PG8_MMA(0, 0, At, B0); PG8_BAR; PG8_SCHED;
            PG8_LDB(B1, 0, 1); PG8_STAGE(PG8_SB(0, 0), b2, voffB);
            PG8_BAR; PG8_WAIT_L(0); PG8_MMA(0, 1, At, B1); PG8_BAR;
            PG8_LDA(At, 0, 1); PG8_STAGE(PG8_SA(0, 0), a2, voffA);
            PG8_BAR; PG8_WAIT_L(0); PG8_MMA(1, 0, At, B0); PG8_BAR; PG8_SCHED;
            PG8_STAGE(PG8_SB(0, 1), b2 + hstep, voffB);
            PG8_WAIT_V(6); PG8_BAR; PG8_MMA(1, 1, At, B1); PG8_BAR;
            PG8_LDB(B0, 1, 0); PG8_SCHED; PG8_LDA(At, 1, 0); PG8_STAGE(PG8_SA(0, 1), a2 + hstep, voffA);
            PG8_WAIT_L(8); PG8_BAR; PG8_WAIT_L(0); PG8_MMA(0, 0, At, B0); PG8_BAR; PG8_SCHED;
            PG8_LDB(B1, 1, 1); PG8_STAGE(PG8_SB(1, 0), b3, voffB);
            PG8_BAR; PG8_WAIT_L(0); PG8_MMA(0, 1, At, B1); PG8_BAR;
            PG8_LDA(At, 1, 1); PG8_STAGE(PG8_SA(1, 0), a3, voffA);
            PG8_BAR; PG8_WAIT_L(0); PG8_MMA(1, 0, At, B0); PG8_BAR; PG8_SCHED;
            PG8_STAGE(PG8_SB(1, 1), b3 + hstep, voffB);
            PG8_WAIT_V(6); PG8_BAR; PG8_MMA(1, 1, At, B1); PG8_BAR;
            }
        }
        if constexpr (ALIGN_EPI) { if (wr == 0) PG8_BAR; }
        if constexpr (!Epi::AFTER_DRAIN) { E(acc, cur, wr, wc, fr, fq); S.done(cur); }
        if (!has_next) break;
#pragma unroll
        for (int a = 0; a < 2; ++a)
#pragma unroll
            for (int b = 0; b < 2; ++b)
#pragma unroll
                for (int m = 0; m < 4; ++m)
#pragma unroll
                    for (int n = 0; n < 2; ++n) acc[a][b][m][n] = (f32x4){0.f, 0.f, 0.f, 0.f};
        cur = nxt; cA = nA; cB = nB; ++ui;
        if constexpr (ALIGN_EPI) { if (wr == 1) PG8_BAR; }
    }
    PG8_WAIT_V(0);
    if constexpr (!ALIGN_EPI) { if (wr == 0) PG8_BAR; }
    PG8_BAR;
    if constexpr (Epi::AFTER_DRAIN) { E.fused(acc, cur, wr, wc, fr, fq, lds, wid, lane); S.done(cur); }
#undef PG8_SA
#undef PG8_SB
#undef PG8_STAGE
#undef PG8_LDA
#undef PG8_LDB
#undef PG8_MMA
#undef PG8_WAIT_V
#undef PG8_WAIT_L
#undef PG8_BAR
#undef PG8_SCHED
}
}

struct EpiG1 {
  static constexpr bool PERM = false, AFTER_DRAIN = false;
  bf16_t* PROJ; bf16_t* QN; bf16_t* KS; bf16_t* KW; float* SSKV; const float2* RN; const float* g_q; const float* g_k;
  __device__ __forceinline__ void operator()(const pg8::f32x4 (&acc)[2][2][4][2], const pg8::Unit& u, int wr, int wc, int fr, int fq) const {
    const bool t1 = (u.pn == 1), t5 = (u.pn == 5);
#pragma unroll
    for (int ai = 0; ai < 2; ++ai)
#pragma unroll
      for (int m = 0; m < 4; ++m) {
        const size_t t = (size_t)u.pm * 256 + ai * 128 + wr * 64 + m * 16 + fr;
        if (!(t1 || t5) || (t1 && wc < 2)) {
#pragma unroll
          for (int bj = 0; bj < 2; ++bj)
#pragma unroll
            for (int n = 0; n < 2; ++n) st_bf16x4(PROJ + t * DINP + u.pn * 256 + bj * 128 + wc * 32 + n * 16 + fq * 4, acc[ai][bj][m][n]);
        }
        if (t1 || t5) {
          float ss = 0.f;
#pragma unroll
          for (int bj = 0; bj < 2; ++bj)
#pragma unroll
            for (int n = 0; n < 2; ++n) { const pg8::f32x4 v = acc[ai][bj][m][n]; ss += v[0] * v[0] + v[1] * v[1] + v[2] * v[2] + v[3] * v[3]; }
          ss += __shfl_xor(ss, 16); ss += __shfl_xor(ss, 32);
          if (t1 && wc < 2) { if (fq == 0) SSKV[t * 2 + wc] = ss; }
          else {
            const float rs = rsqrtf(ss * (1.f / 64) + EPS);
            const float* gg = t5 ? g_q : (g_k + (wc == 2 ? 64 : 128));
            const float sc = t5 ? (0.125f * LOG2E) : 1.f;
            bf16_t* dst = t5 ? (QN + t * 256 + wc * 64) : ((wc == 2 ? KS : KW) + t * 64);
#pragma unroll
            for (int bj = 0; bj < 2; ++bj)
#pragma unroll
              for (int n = 0; n < 2; ++n) {
                const int e0 = 32 * bj + 16 * n + 4 * fq;
                const float4 g4 = *(const float4*)(gg + e0);
                pg8::f32x4 v = acc[ai][bj][m][n];
                v[0] *= rs * g4.x; v[1] *= rs * g4.y; v[2] *= rs * g4.z; v[3] *= rs * g4.w;
                if (bj == 0 && n == 0) {
#pragma unroll
                  for (int j = 0; j < 4; ++j) {
                    const float x = v[j], partner = __shfl_xor(x, 32);
                    const int d = fq * 4 + j; const float2 cs2 = RN[t * 8 + (d & 7)];
                    v[j] = (d < 8) ? (x * cs2.x - partner * cs2.y) : (partner * cs2.y + x * cs2.x);
                  }
                }
                st_bf16x4(dst + e0, v * sc);
              }
          }
        }
      }
  }
};

struct EpiRes {
  static constexpr bool PERM = false, AFTER_DRAIN = false;
  const float* xin; float* out;
  __device__ __forceinline__ void operator()(const pg8::f32x4 (&acc)[2][2][4][2], const pg8::Unit& u, int wr, int wc, int fr, int fq) const {
#pragma unroll
    for (int ai = 0; ai < 2; ++ai)
#pragma unroll
      for (int m = 0; m < 4; ++m) {
        const size_t row = (size_t)u.pm * 256 + ai * 128 + wr * 64 + m * 16 + fr;
#pragma unroll
        for (int bj = 0; bj < 2; ++bj)
#pragma unroll
          for (int n = 0; n < 2; ++n) { const size_t o = row * 1024 + u.pn * 256 + bj * 128 + wc * 32 + n * 16 + fq * 4; *(pg8::f32x4*)(out + o) = *(const pg8::f32x4*)(xin + o) + acc[ai][bj][m][n]; }
      }
  }
};

template <class RM>
DEVI void transpose_tiles(const float* src, int K, int N, bf16_t* dst, int ldk, RM rowmap, unsigned char* lds, int& cursor, const float* kscale = nullptr) {
  float* tl = (float*)lds;
  const int tk = K / 64, tn = (N + 63) / 64, nt = tk * tn;
  const int tid = HTID;
  const int G_ = VGRID;
  for (int it = (VBID - cursor % G_ + G_) % G_; it < nt; it += G_) {
    const int kt = it / tn, ntile = it % tn, k0 = kt * 64, n0 = ntile * 64;
    hsync();
#pragma unroll
    for (int q = 0; q < 4; ++q) {
      const int r = (tid >> 4) + 16 * q, c4 = (tid & 15) * 4;
      const float* sp = src + (size_t)(k0 + r) * N + n0 + c4;
      float4 v;
      if (n0 + c4 + 3 < N) v = *(const float4*)sp;
      else { v.x = (n0 + c4 < N) ? sp[0] : 0.f; v.y = (n0 + c4 + 1 < N) ? sp[1] : 0.f; v.z = (n0 + c4 + 2 < N) ? sp[2] : 0.f; v.w = 0.f; }
      if (kscale) { const float ks = kscale[k0 + r]; v.x *= ks; v.y *= ks; v.z *= ks; v.w *= ks; }
      tl[r * 65 + c4] = v.x; tl[r * 65 + c4 + 1] = v.y; tl[r * 65 + c4 + 2] = v.z; tl[r * 65 + c4 + 3] = v.w;
    }
    hsync();
    const int n = tid >> 2, kc = (tid & 3) * 16;
    if (n0 + n < N) {
      unsigned w[8];
#pragma unroll
      for (int i = 0; i < 8; ++i) w[i] = pk2bf(tl[(kc + 2 * i) * 65 + n], tl[(kc + 2 * i + 1) * 65 + n]);
      uint4* o = (uint4*)(dst + (size_t)rowmap(n0 + n) * ldk + k0 + kc);
      o[0] = make_uint4(w[0], w[1], w[2], w[3]); o[1] = make_uint4(w[4], w[5], w[6], w[7]);
    }
  }
  cursor += nt;
}
DEVI void rmsnorm_rows(const float* x, const float* g, bf16_t* xn) {
  const int lane = HTID & 63, gw = VBID * 4 + (HTID >> 6), NGW = VGRID * 4;
  float4 gg[4];
#pragma unroll
  for (int j = 0; j < 4; ++j) gg[j] = ((const float4*)g)[lane + 64 * j];
  for (int t0 = gw * 4; t0 < T; t0 += NGW * 4) {
    float4 v[4][4];
#pragma unroll
    for (int q = 0; q < 4; ++q)
#pragma unroll
      for (int j = 0; j < 4; ++j) v[q][j] = ((const float4*)(x + (size_t)(t0 + q) * D))[lane + 64 * j];
#pragma unroll
    for (int q = 0; q < 4; ++q) {
      float s = 0.f;
#pragma unroll
      for (int j = 0; j < 4; ++j) s += v[q][j].x * v[q][j].x + v[q][j].y * v[q][j].y + v[q][j].z * v[q][j].z + v[q][j].w * v[q][j].w;
      const float rs = rsqrtf(wsum(s) * (1.f / D) + EPS);
#pragma unroll
      for (int j = 0; j < 4; ++j) {
        uint2 o; o.x = pk2bf(v[q][j].x * rs * gg[j].x, v[q][j].y * rs * gg[j].y); o.y = pk2bf(v[q][j].z * rs * gg[j].z, v[q][j].w * rs * gg[j].w);
        ((uint2*)(xn + (size_t)(t0 + q) * D))[lane + 64 * j] = o;
      }
    }
  }
}
DEVI void phase_prep(const Params& p, unsigned char* lds) {
  const size_t gtid = (size_t)VBID * NTHREADS + HTID, gn = (size_t)VGRID * NTHREADS;
  unsigned char* ws = p.ws;
  if (gtid < 64) ((int*)(ws + SM_CNT))[gtid] = 0;
  auto ident = [](int n) { return n; };
  int cursor = 0;
  for (int l = 0; l < NL; ++l) {
    unsigned char* wl = ws + WS_W + l * WS_WL;
    transpose_tiles(p.in[3] + (size_t)l * D * DIN, D, DIN, (bf16_t*)(wl + W_IN), D, [](int n) { return colmap(n); }, lds, cursor);
    for (size_t i = gtid; i < (size_t)20 * D; i += gn) ((bf16_t*)(wl + W_IN))[(size_t)236 * D + i] = 0;
    transpose_tiles(p.in[36] + (size_t)l * D * D, D, D, (bf16_t*)(wl + W_OUT), D, ident, lds, cursor);
    transpose_tiles(p.in[6] + (size_t)l * 192 * 384, 192, 384, (bf16_t*)(wl + W_UQ), 192, ident, lds, cursor, p.in[4] + l * 192);
    transpose_tiles(p.in[7] + (size_t)l * 128 * 512, 128, 512, (bf16_t*)(wl + W_UKV), 128, ident, lds, cursor, p.in[5] + l * 128);
    transpose_tiles(p.in[25] + (size_t)l * 256 * 256, 256, 256, (bf16_t*)(wl + W_GLU), 256, ident, lds, cursor);
    transpose_tiles(p.in[30] + (size_t)l * 2048 * 128, 2048, 128, (bf16_t*)(wl + W_1K), 2048, ident, lds, cursor);
    transpose_tiles(p.in[33] + (size_t)l * 2048 * 128, 2048, 128, (bf16_t*)(wl + W_1V), 2048, ident, lds, cursor);
    transpose_tiles(p.in[31] + (size_t)l * 128 * 64, 128, 64, (bf16_t*)(wl + W_2K), 128, ident, lds, cursor);
    transpose_tiles(p.in[34] + (size_t)l * 128 * 64, 128, 64, (bf16_t*)(wl + W_2V), 128, ident, lds, cursor);
    for (int h = 0; h < 4; ++h) {
      transpose_tiles(p.in[12] + ((size_t)l * 4 + h) * 64 * 64, 64, 64, (bf16_t*)(wl + W_LRU) + h * 128 * 64, 64, ident, lds, cursor);
      transpose_tiles(p.in[14] + ((size_t)l * 4 + h) * 64 * 64, 64, 64, (bf16_t*)(wl + W_LRU) + h * 128 * 64 + 64 * 64, 64, ident, lds, cursor);
    }
    for (int e = 0; e < 16; ++e) {
      bf16_t* dg = (bf16_t*)(wl + W_GU) + (size_t)e * 512 * 1024;
      transpose_tiles(p.in[42] + ((size_t)l * 16 + e) * 1024 * 256, 1024, 256, dg, 1024, [](int hh) { return (hh >> 6) * 128 + ((hh >> 5) & 1) * 64 + ((hh >> 4) & 1) * 16 + (hh & 15); }, lds, cursor);
      transpose_tiles(p.in[43] + ((size_t)l * 16 + e) * 1024 * 256, 1024, 256, dg, 1024, [](int hh) { return (hh >> 6) * 128 + ((hh >> 5) & 1) * 64 + (((hh >> 4) & 1) + 2) * 16 + (hh & 15); }, lds, cursor);
      transpose_tiles(p.in[44] + ((size_t)l * 16 + e) * 256 * 1024, 256, 1024, (bf16_t*)(wl + W_DN) + (size_t)e * 1024 * 256, 256, ident, lds, cursor);
    }
    {
      const int lane = HTID & 63, gw = VBID * 4 + (HTID >> 6), NGW = VGRID * 4;
      for (int o = gw; o < 256; o += NGW) {
        const int kv = o >> 7, j = o & 127;
        const float* pe = (kv ? p.in[32] : p.in[29]) + (size_t)l * 2048;
        const float* w1 = (kv ? p.in[33] : p.in[30]) + (size_t)l * 2048 * 128;
        float a = 0.f;
#pragma unroll 8
        for (int k = lane; k < 2048; k += 64) a += pe[k] * w1[(size_t)k * 128 + j];
        a = wsum(a);
        if (lane == 0) ((float*)(wl + (kv ? W_B1V : W_B1K)))[j] = a;
      }
    }
    for (size_t i = gtid; i < 16 * 64; i += gn) {
      const int g = (int)(i >> 6), sidx = (int)(i & 63);
      const float are = p.in[17][(size_t)l * 1024 + i], aim = p.in[18][(size_t)l * 1024 + i];
      const float dt = expf(p.in[19][l * 16 + g]);
      const float mag = expf(dt * are);
      float sn, cs; sincosf(dt * aim, &sn, &cs);
      const float abr = mag * cs, abi = mag * sn;
      const float den = are * are + aim * aim, nre = abr - 1.f;
      const float gre = (nre * are + abi * aim) / den, gim = (abi * are - nre * aim) / den;
      ((float2*)(wl + W_S5A))[i] = make_float2(abr, abi);
      float pr = abr, pi = abi;
#pragma unroll
      for (int q = 0; q < 6; ++q) { const float nr = pr * pr - pi * pi, ni = 2.f * pr * pi; pr = nr; pi = ni; }
      ((float2*)(wl + W_S5A64))[i] = make_float2(pr, pi);
      bf16_t* bb = (bf16_t*)(wl + W_S5BB);
      for (int ch = 0; ch < 16; ++ch) {
        const float br = p.in[20][((size_t)l * 1024 + i) * 16 + ch], bi = p.in[21][((size_t)l * 1024 + i) * 16 + ch];
        const float vr = gre * br - gim * bi, vi = gre * bi + gim * br;
        const int sb = sidx >> 5, r = sidx & 31;
        bb[((g * 4 + sb * 2 + 0) * 32 + r) * 16 + ch] = f2bf(vr);
        bb[((g * 4 + sb * 2 + 1) * 32 + r) * 16 + ch] = f2bf(vi);
      }
    }
    for (size_t i = gtid; i < 32 * 1024; i += gn) {
      const int n = (int)(i >> 10), k = (int)(i & 1023);
      float w = 0.f;
      if (n < 20) w = p.in[37][l * D + k] * ((n < 4) ? p.in[38][((size_t)l * D + k) * 4 + n] : p.in[40][((size_t)l * D + k) * 16 + (n - 4)]);
      const bf16_t hi = f2bf(w);
      ((bf16_t*)(wl + W_RTH))[i] = hi; ((bf16_t*)(wl + W_RTL))[i] = f2bf(w - bf2f(hi));
    }
    for (size_t i = gtid; i < 16 * 16 * 64; i += gn) {
      const int g = (int)(i >> 10), ch = (int)((i >> 6) & 15), pp = (int)(i & 63);
      const float cr = p.in[22][(size_t)l * 16384 + i], ci = p.in[23][(size_t)l * 16384 + i];
      bf16_t* cm = (bf16_t*)(wl + W_S5CM) + ((size_t)(g * 16 + ch) * 128 + 2 * pp);
      cm[0] = f2bf(cr); cm[1] = f2bf(-ci);
    }
  }
  {
    const int* positions = (const int*)p.in[1];
    float2* RM = (float2*)(ws + WS_ROPE);
    float2* RN = RM + (size_t)T * 16;
    for (size_t i = gtid; i < (size_t)T * 24; i += gn) {
      const int t = (int)(i / 24), j = (int)(i % 24);
      const int rot = (j < 16) ? 32 : 16, fi = (j < 16) ? j : (j - 16);
      const float inv = powf(500000.f, -(2.f * (float)fi) / (float)rot);
      float sn, cs; sincosf((float)positions[t] * inv, &sn, &cs);
      if (j < 16) RM[(size_t)t * 16 + fi] = make_float2(cs, sn); else RN[(size_t)t * 8 + fi] = make_float2(cs, sn);
    }
  }
  rmsnorm_rows(p.in[0], p.in[2], (bf16_t*)(ws + WS_A));
}

DEVI void phase_g1(const Params& p, int l, unsigned char* lds_full) {
  const bf16_t* XN = (const bf16_t*)(p.ws + WS_A);
  const bf16_t* W = (const bf16_t*)(p.ws + WS_W + l * WS_WL + W_IN);
  bf16_t* QN = (bf16_t*)(p.ws + WS_G);
  pg8::Gemm g{XN, W, T, DINP, D}; pg8::StaticOrder S; S.init(T, DINP, (int)gridDim.x, (int)blockIdx.x);
  EpiG1 E{(bf16_t*)(p.ws + WS_B), QN, QN + (size_t)T * 256, QN + (size_t)T * 320, (float*)(p.ws + SM_SSKV), (const float2*)(p.ws + WS_ROPE) + (size_t)T * 16, p.in[27] + l * 64, p.in[28] + l * 192};
  pg8::gemm_phase<EpiG1, pg8::StaticOrder, true, true>((LAS unsigned char*)lds_full, g, S, E);
}

DEVI void phase_g2(const Params& p, int l, unsigned char* lds) {
  unsigned char* wl = p.ws + WS_W + l * WS_WL;
  const bf16_t* PROJ = (const bf16_t*)(p.ws + WS_B);
  bf16_t* QR = (bf16_t*)(p.ws + WS_D);
  bf16_t* KVR = QR + (size_t)T * 384;
  bf16_t* GATES = (bf16_t*)(p.ws + WS_E);
  bf16_t* MK = (bf16_t*)(p.ws + WS_F) + (size_t)T * 4 * 96;
  const float2* RM = (const float2*)(p.ws + WS_ROPE);
  constexpr int N_CMP = 64, N_QR = 256 * 3, N_KVR = 256 * 4, N_GT = 256 * 4;
  const int tid = HTID, wid = tid >> 6, lane = tid & 63, wr = wid >> 1, wc = wid & 1, fr = lane & 15, fq = lane >> 4;
  for (int it = vblock(); it < N_CMP + N_QR + N_KVR + N_GT; it += VGRID) {
    f32x4 acc[4][4];
    if (it < N_CMP) {
      const int kv = it & 1, half = (it >> 1) & 1, mt = it >> 2;
      const bf16_t* W = (const bf16_t*)(wl + (kv ? W_1V : W_1K)) + (size_t)half * 64 * 2048;
      const float* bias = (const float*)(wl + (kv ? W_B1V : W_B1K)) + half * 64;
      bf16_t* H = (bf16_t*)(p.ws + (kv ? SM_HV : SM_HK)) + half * 64;
      f32x4 acc2[2][4];
      gemm128h(lds, 2048,
              [&](int r, int k) { const int m = mt * 128 + r, b = m >> 7; int c = m & 127; if (c > 126) c = 126;
                                  return PROJ + (size_t)(b * S + 16 * c + (k >> 6)) * DINP + C_KC + kv * 64 + (k & 63); },
              [&](int r, int k) { return W + (size_t)r * 2048 + k; }, acc2);
#pragma unroll
      for (int m = 0; m < 2; ++m)
#pragma unroll
        for (int n = 0; n < 4; ++n) {
          const float4 b4 = *(const float4*)(bias + n * 16 + fq * 4);
          f32x4 o; o[0] = gelu_tanh(acc2[m][n][0] + b4.x); o[1] = gelu_tanh(acc2[m][n][1] + b4.y); o[2] = gelu_tanh(acc2[m][n][2] + b4.z); o[3] = gelu_tanh(acc2[m][n][3] + b4.w);
          st_bf16x4(H + (size_t)(mt * 128 + wid * 32 + m * 16 + fr) * 128 + n * 16 + fq * 4, o);
        }
    } else if (it < N_CMP + N_QR) {
      const int i2 = it - N_CMP, mt = i2 / 3, nt = i2 % 3;
      const bf16_t* W = (const bf16_t*)(wl + W_UQ);
      gemm128g(lds, 192, [&](int r, int k) { return PROJ + (size_t)(mt * 128 + r) * DINP + C_CQ + k; }, [&](int r, int k) { return W + (size_t)(nt * 128 + r) * 192 + k; }, acc);
      GEMM_EPI4({ st_bf16x4(QR + (size_t)(mt * 128 + er) * 384 + nt * 128 + ec0, ev4); })
    } else if (it < N_CMP + N_QR + N_KVR) {
      const int i2 = it - N_CMP - N_QR, mt = i2 >> 2, hd = i2 & 3;
      const bf16_t* W = (const bf16_t*)(wl + W_UKV);
      gemm128g(lds, 128, [&](int r, int k) { return PROJ + (size_t)(mt * 128 + r) * DINP + wgcol(C_T1, k >> 6, k & 63); }, [&](int r, int k) { return W + (size_t)(hd * 128 + r) * 128 + k; }, acc);
      const float* g_k = p.in[9] + l * 96;
#pragma unroll
      for (int m = 0; m < 4; ++m) {
        const size_t t = (size_t)mt * 128 + wr * 64 + m * 16 + fr;
        const int b = (int)(t >> 11), sq = (int)(t & (S - 1));
        const float2 ssp = *(const float2*)((const float*)(p.ws + SM_SSKV) + t * 2);
        const float ss = ssp.x + ssp.y;
        const float rskv = rsqrtf(ss * (1.f / 128) + EPS);
        if (wc == 1) {
#pragma unroll
          for (int n = 0; n < 4; ++n) st_bf16x4(KVR + t * 512 + hd * 128 + 64 + n * 16 + fq * 4, acc[m][n] * rskv);
        } else {
          const uint2 plo = *(const uint2*)(PROJ + t * DINP + C_KPE + 4 * fq), phi = *(const uint2*)(PROJ + t * DINP + C_KPE + 16 + 4 * fq);
          float pl[4] = {__uint_as_float(plo.x << 16), __uint_as_float(plo.x & 0xffff0000u), __uint_as_float(plo.y << 16), __uint_as_float(plo.y & 0xffff0000u)};
          float ph[4] = {__uint_as_float(phi.x << 16), __uint_as_float(phi.x & 0xffff0000u), __uint_as_float(phi.y << 16), __uint_as_float(phi.y & 0xffff0000u)};
          float sk = 0.f;
#pragma unroll
          for (int j = 0; j < 4; ++j) sk += pl[j] * pl[j] + ph[j] * ph[j];
          f32x4 kn[4];
#pragma unroll
          for (int n = 0; n < 4; ++n) { kn[n] = acc[m][n] * rskv; sk += kn[n][0] * kn[n][0] + kn[n][1] * kn[n][1] + kn[n][2] * kn[n][2] + kn[n][3] * kn[n][3]; }
          sk += __shfl_xor(sk, 16); sk += __shfl_xor(sk, 32);
          const float rsk = rsqrtf(sk * (1.f / 96) + EPS);
          bf16_t* dst = MK + ((size_t)(b * 4 + hd) * S + sq) * 96;
          f32x4 olo, ohi;
#pragma unroll
          for (int j = 0; j < 4; ++j) {
            const int d = 4 * fq + j; const float2 cs2 = RM[t * 16 + d];
            const float x1 = pl[j] * rsk * g_k[d], x2 = ph[j] * rsk * g_k[16 + d];
            olo[j] = x1 * cs2.x - x2 * cs2.y; ohi[j] = x1 * cs2.y + x2 * cs2.x;
          }
          st_bf16x4(dst + 4 * fq, olo); st_bf16x4(dst + 16 + 4 * fq, ohi);
#pragma unroll
          for (int n = 0; n < 4; ++n) { const float4 g4 = *(const float4*)(g_k + 32 + n * 16 + fq * 4); f32x4 o = kn[n] * rsk; o[0] *= g4.x; o[1] *= g4.y; o[2] *= g4.z; o[3] *= g4.w; st_bf16x4(dst + 32 + n * 16 + fq * 4, o); }
        }
      }
    } else {
      const int i2 = it - N_CMP - N_QR - N_KVR, mt = i2 >> 2, h = i2 & 3;
      const bf16_t* W = (const bf16_t*)(wl + W_LRU) + h * 128 * 64;
      const int c0 = h * 64 + (tid & 7) * 8;
      const float* cw = p.in[10] + l * 4 * 256 + c0; const float* cbp = p.in[11] + l * 256 + c0;
      gemm128(lds, 64,
              [&](int r, int k) {
                const size_t t = (size_t)mt * 128 + r; const int sq = (int)(t & (S - 1));
                float u[8];
#pragma unroll
                for (int e = 0; e < 8; ++e) u[e] = cbp[e];
#pragma unroll
                for (int j = 0; j < 4; ++j) {
                  if (sq - 3 + j >= 0) {
                    const u32x4 w = *(const u32x4*)(PROJ + (t - 3 + j) * DINP + C_LX + h * 64 + k);
#pragma unroll
                    for (int e = 0; e < 4; ++e) { u[2 * e] += __uint_as_float(w[e] << 16) * cw[j * 256 + 2 * e]; u[2 * e + 1] += __uint_as_float(w[e] & 0xffff0000u) * cw[j * 256 + 2 * e + 1]; }
                  }
                }
                u32x4 o; o[0] = pk2bf(u[0], u[1]); o[1] = pk2bf(u[2], u[3]); o[2] = pk2bf(u[4], u[5]); o[3] = pk2bf(u[6], u[7]);
                return o; },
              [&](int r, int k) { return W + (size_t)r * 64 + k; }, acc);
      GEMM_EPI4({ st_bf16x4(GATES + (size_t)(mt * 128 + er) * 512 + h * 128 + ec0, ev4); })
    }
  }
}

DEVI void lru_ab(float u, float rpre, float ipre, float sp, bool first, float& a, float& b) {
  const float r = sigmoidf_(rpre), gi = sigmoidf_(ipre);
  const float la = -8.f * r * sp;
  a = __expf(la);
  const float x = 2.f * la;
  const float om = (x > -0.1f) ? (-x * (1.f + 0.5f * x * (1.f + (1.f / 3.f) * x * (1.f + 0.25f * x * (1.f + 0.2f * x))))) : (1.f - a * a);
  const float mult = first ? 1.f : sqrtf(fmaxf(om, 0.f));
  b = mult * gi * u;
}
DEVI float lru_conv(const bf16_t* PROJ, int t, int s, int c, const float* cw, float cb) {
  float u = cb;
#pragma unroll
  for (int j = 0; j < 4; ++j) { const int ss2 = s - 3 + j; if (ss2 >= 0) u += bf2f(PROJ[(size_t)(t - 3 + j) * DINP + C_LX + c]) * cw[j * 256 + c]; }
  return u;
}

template <bool FULL>
DEVI void s5_chunk(const Params& p, int l, int b, int chunk, unsigned char* lds) {
  unsigned char* wl = p.ws + WS_W + l * WS_WL;
  const bf16_t* PROJ = (const bf16_t*)(p.ws + WS_B);
  const float2* Abar = (const float2*)(wl + W_S5A);
  const bf16_t* BB = (const bf16_t*)(wl + W_S5BB);
  const bf16_t* CM = (const bf16_t*)(wl + W_S5CM);
  float2* SLOC = (float2*)(p.ws + SM_SLOC);
  bf16_t* YCP = (bf16_t*)(p.ws + WS_F);
  const float* dd = p.in[24] + l * 256;
  const int tid = HTID, wv = tid >> 6, lane = tid & 63, r = lane & 31, h = lane >> 5, fr = lane & 15, fq = lane >> 4;
  unsigned* Hs = (unsigned*)(lds + wv * 8704);
  const int t0 = b * S + chunk * 64;
#pragma unroll 1
  for (int gi = 0; gi < 4; ++gi) {
    const int g = wv * 4 + gi;
    bf16x8 bbf[4];
#pragma unroll
    for (int nb = 0; nb < 4; ++nb) bbf[nb] = *(const bf16x8*)(BB + ((g * 4 + nb) * 32 + r) * 16 + 8 * h);
    float2 Ac[2]; float hr[2], hi[2];
#pragma unroll
    for (int sb = 0; sb < 2; ++sb) {
      Ac[sb] = Abar[g * 64 + sb * 32 + r];
      hr[sb] = 0.f; hi[sb] = 0.f;
      if (FULL) { const float2 cin = ((const float2*)(p.ws + SM_SCAR))[((size_t)(b * 32 + chunk) * 16 + g) * 64 + sb * 32 + r]; hr[sb] = cin.x; hi[sb] = cin.y; }
    }
    bf16x8 cm[4];
    float4 dcol4 = make_float4(0.f, 0.f, 0.f, 0.f);
    if (FULL) {
#pragma unroll
      for (int kk = 0; kk < 4; ++kk) cm[kk] = *(const bf16x8*)(CM + (size_t)(g * 16 + fr) * 128 + kk * 32 + 8 * fq);
      dcol4 = *(const float4*)(dd + g * 16 + 4 * fq);
    }
#pragma unroll 1
    for (int tb = 0; tb < 2; ++tb) {
      const bf16x8 ua = *(const bf16x8*)(PROJ + (size_t)(t0 + tb * 32 + r) * DINP + C_S5 + g * 16 + 8 * h);
      f32x16 acc[4];
#pragma unroll
      for (int nb = 0; nb < 4; ++nb) {
        f32x16 z;
#pragma unroll
        for (int i = 0; i < 16; ++i) z[i] = 0.f;
        acc[nb] = mfma32(ua, bbf[nb], z);
      }
#pragma unroll
      for (int sb = 0; sb < 2; ++sb) {
        float sr = hr[sb], si = hi[sb];
        const float ax = Ac[sb].x, ay = Ac[sb].y;
#pragma unroll
        for (int q = 0; q < 4; ++q)
#pragma unroll
          for (int owner = 0; owner < 2; ++owner) {
#pragma unroll
            for (int i = 0; i < 4; ++i) {
              const int reg = 4 * q + i;
              const float br = acc[2 * sb][reg], bi = acc[2 * sb + 1][reg];
              const float nr = ax * sr - ay * si + br, ni = ax * si + ay * sr + bi; sr = nr; si = ni;
              if (FULL) { acc[2 * sb][reg] = (h == owner) ? sr : br; acc[2 * sb + 1][reg] = (h == owner) ? si : bi; }
            }
            const float orr = __shfl_xor(sr, 32), oi = __shfl_xor(si, 32);
            if (h != owner) { sr = orr; si = oi; }
          }
        hr[sb] = sr; hi[sb] = si;
      }
      if (FULL) {
#pragma unroll
        for (int sb = 0; sb < 2; ++sb)
#pragma unroll
          for (int reg = 0; reg < 16; ++reg)
            Hs[crow(reg, h) * 68 + sb * 32 + r] = pk2bf(acc[2 * sb][reg], acc[2 * sb + 1][reg]);
#pragma unroll
        for (int tb16 = 0; tb16 < 2; ++tb16) {
          f32x4 y = (f32x4){0.f, 0.f, 0.f, 0.f};
#pragma unroll
          for (int kk = 0; kk < 4; ++kk) { const bf16x8 a = *(const bf16x8*)((const bf16_t*)Hs + (tb16 * 16 + fr) * 136 + kk * 32 + 8 * fq); y = mfma16(cm[kk], a, y); }
          const size_t t = (size_t)t0 + tb * 32 + tb16 * 16 + fr; const int col = g * 16 + 4 * fq;
          const uint2 uw = *(const uint2*)(PROJ + t * DINP + C_S5 + col);
          f32x4 o;
          o[0] = gelu_tanh(y[0] + dcol4.x * __uint_as_float(uw.x << 16)); o[1] = gelu_tanh(y[1] + dcol4.y * __uint_as_float(uw.x & 0xffff0000u));
          o[2] = gelu_tanh(y[2] + dcol4.z * __uint_as_float(uw.y << 16)); o[3] = gelu_tanh(y[3] + dcol4.w * __uint_as_float(uw.y & 0xffff0000u));
          st_bf16x4(YCP + t * 256 + col, o);
        }
      }
    }
    if (!FULL) {
#pragma unroll
      for (int sb = 0; sb < 2; ++sb) if (h == 0) SLOC[((size_t)(b * 32 + chunk) * 16 + g) * 64 + sb * 32 + r] = make_float2(hr[sb], hi[sb]);
    }
  }
}

template <bool FULL>
DEVI void lru_chunk(const Params& p, int l, int b, int chunk, float* tile) {
  const bf16_t* PROJ = (const bf16_t*)(p.ws + WS_B);
  const bf16_t* GATES = (const bf16_t*)(p.ws + WS_E);
  float2* LSUM = (float2*)(p.ws + SM_LSUM);
  const int c = HTID, h = c >> 6, j = c & 63;
  const float* cw = p.in[10] + l * 4 * 256;
  const float w0 = cw[c], w1 = cw[256 + c], w2 = cw[512 + c], w3 = cw[768 + c], cb = p.in[11][l * 256 + c];
  const float ba = p.in[13][l * 256 + c], bi = p.in[15][l * 256 + c];
  const float sp = log1pf(expf(-p.in[16][l * 256 + c]));
  const int s0 = chunk * 64; const size_t t0 = (size_t)b * S + s0;
  float xm3 = 0.f, xm2 = 0.f, xm1 = 0.f;
  if (s0 > 0) { xm3 = bf2f(PROJ[(t0 - 3) * DINP + C_LX + c]); xm2 = bf2f(PROJ[(t0 - 2) * DINP + C_LX + c]); xm1 = bf2f(PROJ[(t0 - 1) * DINP + C_LX + c]); }
  float hh = 0.f, ap = 1.f;
  if (FULL) hh = ((const float*)(p.ws + SM_LCAR))[(size_t)(b * 32 + chunk) * 256 + c];
#pragma unroll 1
  for (int k0 = 0; k0 < 64; k0 += 8) {
    float xv[8], rp[8], ip[8], gt[8];
#pragma unroll
    for (int i = 0; i < 8; ++i) {
      const size_t t = t0 + k0 + i;
      xv[i] = bf2f(PROJ[t * DINP + C_LX + c]);
      rp[i] = bf2f(GATES[t * 512 + h * 128 + j]); ip[i] = bf2f(GATES[t * 512 + h * 128 + 64 + j]);
      gt[i] = FULL ? bf2f(PROJ[t * DINP + C_LG + c]) : 0.f;
    }
#pragma unroll
    for (int i = 0; i < 8; ++i) {
      const float u = cb + xm3 * w0 + xm2 * w1 + xm1 * w2 + xv[i] * w3;
      xm3 = xm2; xm2 = xm1; xm1 = xv[i];
      float a, bb; lru_ab(u, rp[i] + ba, ip[i] + bi, sp, (s0 + k0 + i) == 0, a, bb);
      hh = a * hh + bb; ap *= a;
      if (FULL) tile[(k0 + i) * 256 + c] = hh * gelu_tanh(gt[i]);
    }
  }
  if (!FULL) LSUM[(size_t)(b * 32 + chunk) * 256 + c] = make_float2(ap, hh);
}

DEVI void phase_r2(const Params& p, int l, unsigned char* lds) {
  unsigned char* wl = p.ws + WS_W + l * WS_WL;
  const bf16_t* PROJ = (const bf16_t*)(p.ws + WS_B);
  const bf16_t* QR = (const bf16_t*)(p.ws + WS_D);
  const bf16_t* KVR = QR + (size_t)T * 384;
  const bf16_t* GATES = (const bf16_t*)(p.ws + WS_E);
  bf16_t* MQ = (bf16_t*)(p.ws + WS_F);
  bf16_t* MK = MQ + (size_t)T * 4 * 96;
  const float2* RM = (const float2*)(p.ws + WS_ROPE);
  const float2* RN = RM + (size_t)T * 16;
  const int tid = HTID, lane = tid & 63, wv = tid >> 6;
  for (int it = VBID; it < NB * 32; it += VGRID) lru_chunk<false>(p, l, it >> 5, it & 31, nullptr);
  hsync();
  for (int it = VBID; it < NB * 32; it += VGRID) s5_chunk<false>(p, l, it >> 5, it & 31, lds);
  {
    const bf16_t* HK = (const bf16_t*)(p.ws + SM_HK); const bf16_t* HV = (const bf16_t*)(p.ws + SM_HV);
    bf16_t* KC = (bf16_t*)(p.ws + SM_KC); bf16_t* VC = (bf16_t*)(p.ws + SM_VC);
    const bf16_t* W2K = (const bf16_t*)(wl + W_2K); const bf16_t* W2V = (const bf16_t*)(wl + W_2V);
    const float* g0 = p.in[28] + l * 192;
    for (int it = VBID; it < 32; it += VGRID) {
      const int kv = it & 1, mt = it >> 1;
      const bf16_t* H = kv ? HV : HK; const bf16_t* W2 = kv ? W2V : W2K;
      f32x4 acc[4][4];
      hsync();
      gemm128g(lds, 128, [&](int r, int k) { return H + (size_t)(mt * 128 + r) * 128 + k; }, [&](int r, int k) { return W2 + (size_t)(r & 63) * 128 + k; }, acc);
      const int wid = tid >> 6, wr = wid >> 1, wc = wid & 1, fr = lane & 15, fq = lane >> 4;
      if (wc == 0) {
#pragma unroll
        for (int m = 0; m < 4; ++m) {
          const int row = mt * 128 + wr * 64 + m * 16 + fr, b = row >> 7, c = row & 127;
          f32x4 v[4];
#pragma unroll
          for (int n = 0; n < 4; ++n) v[n] = acc[m][n];
          if (kv == 0) {
            float ss = 0.f;
#pragma unroll
            for (int n = 0; n < 4; ++n) ss += v[n][0] * v[n][0] + v[n][1] * v[n][1] + v[n][2] * v[n][2] + v[n][3] * v[n][3];
            ss += __shfl_xor(ss, 16); ss += __shfl_xor(ss, 32);
            const float rs = rsqrtf(ss * (1.f / 64) + EPS);
#pragma unroll
            for (int n = 0; n < 4; ++n) { const float4 gg = *(const float4*)(g0 + n * 16 + fq * 4); v[n][0] *= rs * gg.x; v[n][1] *= rs * gg.y; v[n][2] *= rs * gg.z; v[n][3] *= rs * gg.w; }
            const int cc = (c < 127) ? c : 126;
            const float2* cs = RN + (size_t)(b * S + 16 * cc + 31) * 8;
#pragma unroll
            for (int j = 0; j < 4; ++j) {
              const float x = v[0][j], partner = __shfl_xor(x, 32);
              const int d = fq * 4 + j; const float2 cs2 = cs[d & 7];
              v[0][j] = (d < 8) ? (x * cs2.x - partner * cs2.y) : (partner * cs2.y + x * cs2.x);
            }
          }
          bf16_t* dst = (kv ? VC : KC) + (size_t)row * 64;
#pragma unroll
          for (int n = 0; n < 4; ++n) { f32x4 o = v[n]; if (c >= 127) o = (f32x4){0.f, 0.f, 0.f, 0.f}; st_bf16x4(dst + n * 16 + fq * 4, o); }
        }
      }
    }
  }
}

typedef short v4i16_t __attribute__((ext_vector_type(4)));
DEVI float fexp2(float x) { return __builtin_amdgcn_exp2f(x); }
constexpr int VST = 96;
constexpr int ATT_VBYTES = 64 * VST * 2;
template <int DK> constexpr int att_kbytes() { return 64 * (DK + 8) * 2; }
template <int DK> constexpr int att_buf() { return att_kbytes<DK>() + ATT_VBYTES; }
template <int DK> struct TileRegs { u32x4 k[(64 * DK / 8 + 511) / 512]; u32x4 v; };
template <int DK>
DEVI void tile_load(TileRegs<DK>& tr, const bf16_t* kbase, size_t kstride, const bf16_t* vbase, size_t vstride, int key0, bool withv = true) {
  constexpr int CH = DK / 8, NCH = 64 * CH;
#pragma unroll
  for (int i = 0; i < (NCH + 511) / 512; ++i) { const int c = (int)threadIdx.x + 512 * i; if (c < NCH) { const int r = c / CH, cc = c % CH; tr.k[i] = *(const u32x4*)(kbase + (size_t)(key0 + r) * kstride + cc * 8); } }
  if (withv) { const int c = (int)threadIdx.x, r = c >> 3, cc = c & 7; tr.v = *(const u32x4*)(vbase + (size_t)(key0 + r) * vstride + cc * 8); }
}
template <int DK>
DEVI void tile_store(const TileRegs<DK>& tr, unsigned char* buf, bool withv = true) {
  constexpr int CH = DK / 8, NCH = 64 * CH;
  bf16_t* sK = (bf16_t*)buf; bf16_t* sV = (bf16_t*)(buf + att_kbytes<DK>());
#pragma unroll
  for (int i = 0; i < (NCH + 511) / 512; ++i) { const int c = (int)threadIdx.x + 512 * i; if (c < NCH) { const int r = c / CH, cc = c % CH; *(u32x4*)(sK + r * (DK + 8) + cc * 8) = tr.k[i]; } }
  if (withv) { const int c = (int)threadIdx.x, r = c >> 3, cc = c & 7; *(u32x4*)(sV + r * VST + cc * 8) = tr.v; }
}
template <int DK>
DEVI void qk_tile(const bf16_t* sK, const bf16x8* qf, f32x16& s0, f32x16& s1, int r, int h) {
#pragma unroll
  for (int i = 0; i < 16; ++i) { s0[i] = 0.f; s1[i] = 0.f; }
#pragma unroll
  for (int kk = 0; kk < DK / 16; ++kk) {
    const bf16x8 a0 = *(const bf16x8*)(sK + r * (DK + 8) + kk * 16 + h * 8);
    const bf16x8 a1 = *(const bf16x8*)(sK + (32 + r) * (DK + 8) + kk * 16 + h * 8);
    s0 = mfma32(a0, qf[kk], s0);
    s1 = mfma32(a1, qf[kk], s1);
  }
}
struct FState { f32x16 o0, o1; float m, l; };
DEVI void fstate_init(FState& f) {
#pragma unroll
  for (int i = 0; i < 16; ++i) { f.o0[i] = 0.f; f.o1[i] = 0.f; }
  f.m = -INFINITY; f.l = 0.f;
}
DEVI v4i16_t vtr(const bf16_t* p) { return __builtin_amdgcn_ds_read_tr16_b64_v4i16((LAS v4i16_t*)p); }
DEVI void softmax_pv(FState& f, f32x16& s0, f32x16& s1, const bf16_t* sV, int lane) {
  const int h = lane >> 5;
  float mx = -INFINITY;
#pragma unroll
  for (int i = 0; i < 16; ++i) mx = fmaxf(mx, fmaxf(s0[i], s1[i]));
  mx = fmaxf(mx, __shfl_xor(mx, 32));
  const float mnew = fmaxf(f.m, mx);
  const float muse = (mnew == -INFINITY) ? 0.f : mnew;
  float ps = 0.f;
#pragma unroll
  for (int i = 0; i < 16; ++i) { s0[i] = fexp2(s0[i] - muse); s1[i] = fexp2(s1[i] - muse); ps += s0[i] + s1[i]; }
  ps += __shfl_xor(ps, 32);
  if (__any(mnew != f.m)) {
    const float alpha = fexp2(f.m - muse);
    f.l = f.l * alpha + ps; f.m = mnew;
#pragma unroll
    for (int i = 0; i < 16; ++i) { f.o0[i] *= alpha; f.o1[i] *= alpha; }
  } else {
    f.l += ps;
  }
  const int g = lane >> 4, li = lane & 15, q = li >> 2, pp = li & 3;
  const bf16_t* vb = sV + (4 * h + q) * VST + (g & 1) * 16 + 4 * pp;
#pragma unroll
  for (int kb = 0; kb < 2; ++kb)
#pragma unroll
    for (int s = 0; s < 2; ++s) {
      unsigned pw[4];
#pragma unroll
      for (int j = 0; j < 4; ++j) pw[j] = kb ? pk2bf(s1[8 * s + 2 * j], s1[8 * s + 2 * j + 1]) : pk2bf(s0[8 * s + 2 * j], s0[8 * s + 2 * j + 1]);
      const bf16x8 pb = __builtin_bit_cast(bf16x8, (u32x4){pw[0], pw[1], pw[2], pw[3]});
#pragma unroll
      for (int db = 0; db < 2; ++db) {
        const v4i16_t lo = vtr(vb + (kb * 32 + 16 * s) * VST + db * 32);
        const v4i16_t hi = vtr(vb + (kb * 32 + 16 * s + 8) * VST + db * 32);
        const bf16x8 a = {lo[0], lo[1], lo[2], lo[3], hi[0], hi[1], hi[2], hi[3]};
        if (db == 0) f.o0 = mfma32(a, pb, f.o0); else f.o1 = mfma32(a, pb, f.o1);
      }
    }
}
DEVI void store_o(bf16_t* orow, const f32x16& o0, const f32x16& o1, float sc, int h) {
#pragma unroll
  for (int g = 0; g < 4; ++g) {
    uint2 v0, v1;
    v0.x = pk2bf(o0[4 * g] * sc, o0[4 * g + 1] * sc); v0.y = pk2bf(o0[4 * g + 2] * sc, o0[4 * g + 3] * sc);
    v1.x = pk2bf(o1[4 * g] * sc, o1[4 * g + 1] * sc); v1.y = pk2bf(o1[4 * g + 2] * sc, o1[4 * g + 3] * sc);
    *(uint2*)(orow + 8 * g + 4 * h) = v0;
    *(uint2*)(orow + 32 + 8 * g + 4 * h) = v1;
  }
}

DEVI void mla_item(const Params& p, int l, int b, int hd, int qt, unsigned char* lds) {
  const bf16_t* MQ = (const bf16_t*)(p.ws + WS_F);
  const bf16_t* MK = MQ + (size_t)T * 4 * 96;
  const bf16_t* KVR = (const bf16_t*)(p.ws + WS_D) + (size_t)T * 384;
  bf16_t* YA = (bf16_t*)(p.ws + WS_C);
  const int tid = (int)threadIdx.x, wv = tid >> 6, lane = tid & 63, r = lane & 31, h = lane >> 5;
  const int q0 = qt * 256 + wv * 32, tq = q0 + r;
  bf16x8 qf[6];
  {
    const bf16_t* qrow = (const bf16_t*)(p.ws + WS_D) + ((size_t)b * S + tq) * 384 + hd * 96;
    const float* g_q = p.in[8] + l * 96;
    float qv[6][8]; float ss = 0.f;
#pragma unroll
    for (int kk = 0; kk < 6; ++kk) {
      const u32x4 w = *(const u32x4*)(qrow + kk * 16 + h * 8);
#pragma unroll
      for (int e = 0; e < 4; ++e) { qv[kk][2 * e] = __uint_as_float(w[e] << 16); qv[kk][2 * e + 1] = __uint_as_float(w[e] & 0xffff0000u); ss += qv[kk][2 * e] * qv[kk][2 * e] + qv[kk][2 * e + 1] * qv[kk][2 * e + 1]; }
    }
    ss += __shfl_xor(ss, 32);
    const float rs = rsqrtf(ss * (1.f / 96) + EPS) * (0.10206207261596575f * LOG2E);
#pragma unroll
    for (int kk = 0; kk < 6; ++kk)
#pragma unroll
      for (int j = 0; j < 8; ++j) qv[kk][j] *= rs * g_q[kk * 16 + h * 8 + j];
    const float2* cs = (const float2*)(p.ws + WS_ROPE) + ((size_t)b * S + tq) * 16 + 8 * h;
#pragma unroll
    for (int j = 0; j < 8; ++j) { const float2 c2 = cs[j]; const float x1 = qv[0][j], x2 = qv[1][j]; qv[0][j] = x1 * c2.x - x2 * c2.y; qv[1][j] = x1 * c2.y + x2 * c2.x; }
#pragma unroll
    for (int kk = 0; kk < 6; ++kk) { const u32x4 w = {pk2bf(qv[kk][0], qv[kk][1]), pk2bf(qv[kk][2], qv[kk][3]), pk2bf(qv[kk][4], qv[kk][5]), pk2bf(qv[kk][6], qv[kk][7])}; qf[kk] = __builtin_bit_cast(bf16x8, w); }
  }
  FState f; fstate_init(f);
  const bf16_t* kbase = MK + (size_t)(b * 4 + hd) * S * 96;
  const bf16_t* vbase = KVR + (size_t)b * S * 512 + hd * 128 + 64;
  const int ntiles = 4 * qt + 4;
  TileRegs<96> tr;
  TileRegs<96> tr2;
  tile_load<96>(tr, kbase, 96, vbase, 512, 0);
  tile_load<96>(tr2, kbase, 96, vbase, 512, 64);
  __syncthreads();
  tile_store<96>(tr, lds);
  __syncthreads();
  auto compute = [&](int kt, unsigned char* cur) {
    if (kt * 64 <= q0 + 31) {
      f32x16 s0, s1;
      qk_tile<96>((const bf16_t*)cur, qf, s0, s1, r, h);
      if (kt * 64 + 63 > q0) {
        int rel = tq - kt * 64 - 4 * h; asm volatile("" : "+v"(rel));
#pragma unroll
        for (int i = 0; i < 16; ++i) { const int kk2 = (i & 3) + 8 * (i >> 2); if (kk2 > rel) s0[i] = -INFINITY; if (kk2 + 32 > rel) s1[i] = -INFINITY; }
      }
      softmax_pv(f, s0, s1, (const bf16_t*)(cur + att_kbytes<96>()), lane);
    }
  };
#pragma unroll 1
  for (int kt = 0; kt < ntiles; kt += 2) {
    if (kt + 2 < ntiles) tile_load<96>(tr, kbase, 96, vbase, 512, (kt + 2) * 64);
    compute(kt, lds);
    tile_store<96>(tr2, lds + att_buf<96>());
    __syncthreads();
    if (kt + 3 < ntiles) tile_load<96>(tr2, kbase, 96, vbase, 512, (kt + 3) * 64);
    compute(kt + 1, lds + att_buf<96>());
    if (kt + 2 < ntiles) tile_store<96>(tr, lds);
    __syncthreads();
  }
  store_o(YA + (size_t)(b * S + tq) * 256 + hd * 64, f.o0, f.o1, 1.f / f.l, h);
}

template <class KF, class BODY>
DEVI void nsa_stream(unsigned char* lds, const bf16_t* kbase, size_t kstride, const bf16_t* vbase, size_t vstride, bool withv, int nt, KF key0f, BODY body) {
  if (nt <= 0) return;
  TileRegs<64> trA, trB;
  tile_load<64>(trA, kbase, kstride, vbase, vstride, key0f(0), withv);
  if (nt > 1) tile_load<64>(trB, kbase, kstride, vbase, vstride, key0f(1), withv);
  __syncthreads();
  tile_store<64>(trA, lds, withv);
  __syncthreads();
  unsigned char* buf0 = lds; unsigned char* buf1 = lds + att_buf<64>();
#pragma unroll 1
  for (int i = 0; i < nt; i += 2) {
    if (i + 2 < nt) tile_load<64>(trA, kbase, kstride, vbase, vstride, key0f(i + 2), withv);
    body(i, buf0);
    if (i + 1 < nt) tile_store<64>(trB, buf1, withv);
    __syncthreads();
    if (i + 1 >= nt) break;
    if (i + 3 < nt) tile_load<64>(trB, kbase, kstride, vbase, vstride, key0f(i + 3), withv);
    body(i + 1, buf1);
    if (i + 2 < nt) tile_store<64>(trA, buf0, withv);
    __syncthreads();
  }
}
DEVI void nsa_item(const Params& p, int l, int b, int qt, unsigned char* lds) {
  const bf16_t* PROJ = (const bf16_t*)(p.ws + WS_B);
  const bf16_t* KC = (const bf16_t*)(p.ws + SM_KC) + (size_t)b * 128 * 64;
  const bf16_t* VC = (const bf16_t*)(p.ws + SM_VC) + (size_t)b * 128 * 64;
  const int tid = (int)threadIdx.x, wv = tid >> 6, lane = tid & 63, r = lane & 31, h = lane >> 5;
  float* psum = (float*)(lds + 2 * att_buf<64>());
  unsigned* selm = (unsigned*)(lds + 2 * att_buf<64>() + 32768);
  const int t0 = qt * 64, cur = t0 >> 6;
  const int ql = wv * 8 + (r >> 2), hd = r & 3, tq = t0 + ql;
  const size_t tg = (size_t)b * S + tq;
  bf16x8 qf[4];
#pragma unroll
  for (int kk = 0; kk < 4; ++kk) qf[kk] = *(const bf16x8*)((const bf16_t*)(p.ws + WS_G) + tg * 256 + hd * 64 + kk * 16 + h * 8);
  unsigned* ofs = (unsigned*)psum + wv * 1024 + lane;
  const float g0 = sigmoidf_(bf2f(PROJ[tg * DINP + C_NG + hd * 3 + 0]));
  const float g1 = sigmoidf_(bf2f(PROJ[tg * DINP + C_NG + hd * 3 + 1]));
  const float g2 = sigmoidf_(bf2f(PROJ[tg * DINP + C_NG + hd * 3 + 2]));
  FState f; fstate_init(f);
  const int ncmp = (((t0 + 32) >> 4) >> 6) + 1;
  nsa_stream(lds, KC, 64, VC, 64, true, ncmp, [&](int i) { return i * 64; }, [&](int kt, unsigned char* buf) {
    f32x16 s0, s1;
    qk_tile<64>((const bf16_t*)buf, qf, s0, s1, r, h);
    int rel = ((tq - 31) >> 4) - kt * 64 - 4 * h; asm volatile("" : "+v"(rel));
#pragma unroll
    for (int i = 0; i < 16; ++i) { const int kk2 = (i & 3) + 8 * (i >> 2); if (kk2 > rel) s0[i] = -INFINITY; if (kk2 + 32 > rel) s1[i] = -INFINITY; }
    softmax_pv(f, s0, s1, (const bf16_t*)(buf + att_kbytes<64>()), lane);
  });
  {
    const float muse = (f.m == -INFINITY) ? 0.f : f.m;
    const float il = (f.l > 0.f) ? 1.f / f.l : 0.f;
    if (ncmp < 2) {
#pragma unroll 1
      for (int i = tid; i < 64 * 128; i += KTHREADS) psum[i] = 0.f;
      __syncthreads();
    }
    nsa_stream(lds, KC, 64, VC, 64, false, ncmp, [&](int i) { return i * 64; }, [&](int kt, unsigned char* buf) {
      f32x16 s0, s1;
      qk_tile<64>((const bf16_t*)buf, qf, s0, s1, r, h);
      int rel = ((tq - 31) >> 4) - kt * 64 - 4 * h; asm volatile("" : "+v"(rel));
      int cb0 = kt * 64 + 4 * h; asm volatile("" : "+v"(cb0));
#pragma unroll
      for (int i = 0; i < 16; ++i) {
        const int kk2 = (i & 3) + 8 * (i >> 2); const int c = cb0 + kk2;
        float p0 = (kk2 > rel) ? 0.f : fexp2(s0[i] - muse) * il;
        float p1 = (kk2 + 32 > rel) ? 0.f : fexp2(s1[i] - muse) * il;
        p0 += __shfl_xor(p0, 1); p0 += __shfl_xor(p0, 2);
        p1 += __shfl_xor(p1, 1); p1 += __shfl_xor(p1, 2);
        if (hd == 0) { psum[ql * 128 + c] = p0; psum[ql * 128 + c + 32] = p1; }
      }
    });
  }
  __syncthreads();
#pragma unroll 1
  for (int itq = 0; itq < 4; ++itq) {
    const int q2 = wv * 8 + itq * 2 + (lane >> 5), j = lane & 31;
    const float* ps = psum + q2 * 128;
    float imp = 2.f * (ps[4 * j] + ps[4 * j + 1] + ps[4 * j + 2]) + ps[4 * j + 3];
    if (j > 0) imp += ps[4 * j - 1];
    const bool cand = (j >= 1) && (j <= cur - 2);
    int rank = 0;
    for (int jj = 0; jj < 32; ++jj) {
      const float v = __shfl(imp, (lane & 32) | jj);
      const bool cj = (jj >= 1) && (jj <= cur - 2);
      if (cj && (v > imp || (v == imp && jj < j))) ++rank;
    }
    const bool sel = cand && rank < 2;
    const unsigned long long bal = __ballot(sel);
    unsigned mk = (unsigned)(bal >> (32 * (lane >> 5)));
    mk |= 1u | (1u << cur); if (cur >= 1) mk |= (1u << (cur - 1));
    if (j == 0) selm[q2] = mk;
  }
  __syncthreads();
  unsigned blk_or = 0, wave_or = 0;
  for (int i = 0; i < 64; ++i) blk_or |= selm[i];
  for (int i = 0; i < 8; ++i) wave_or |= selm[wv * 8 + i];
  const unsigned mymask = selm[ql];
  {
    const float sc = (f.l > 0.f) ? g0 / f.l : 0.f;
#pragma unroll
    for (int i = 0; i < 8; ++i) { ofs[i * 64] = pk2bf(f.o0[2 * i] * sc, f.o0[2 * i + 1] * sc); ofs[(8 + i) * 64] = pk2bf(f.o1[2 * i] * sc, f.o1[2 * i + 1] * sc); }
  }
  fstate_init(f);
  {
    unsigned* tl = selm + 64;
    if (tid < 32 && ((blk_or >> tid) & 1u)) tl[__popc(blk_or & ((1u << tid) - 1u))] = tid;
    __syncthreads();
    const int nsel = __popc(blk_or);
    nsa_stream(lds, (const bf16_t*)(p.ws + WS_G) + (size_t)T * 256 + (size_t)b * S * 64, 64, PROJ + (size_t)b * S * DINP + C_VS, DINP, true, nsel,
      [&](int i) { return (int)tl[i] * 64; },
      [&](int i, unsigned char* buf) {
        const int jj = (int)tl[i];
        if ((wave_or >> jj) & 1u) {
          f32x16 s0, s1;
          qk_tile<64>((const bf16_t*)buf, qf, s0, s1, r, h);
          const bool on = (mymask >> jj) & 1u;
          int rel = on ? (tq - jj * 64 - 4 * h) : -1; asm volatile("" : "+v"(rel));
#pragma unroll
          for (int i2 = 0; i2 < 16; ++i2) { const int kk2 = (i2 & 3) + 8 * (i2 >> 2); if (kk2 > rel) s0[i2] = -INFINITY; if (kk2 + 32 > rel) s1[i2] = -INFINITY; }
          softmax_pv(f, s0, s1, (const bf16_t*)(buf + att_kbytes<64>()), lane);
        }
      });
    const float sc = (f.l > 0.f) ? g1 / f.l : 0.f;
#pragma unroll
    for (int i = 0; i < 8; ++i) {
      const unsigned w0 = ofs[i * 64], w1 = ofs[(8 + i) * 64];
      ofs[i * 64] = pk2bf(__uint_as_float(w0 << 16) + f.o0[2 * i] * sc, __uint_as_float(w0 & 0xffff0000u) + f.o0[2 * i + 1] * sc);
      ofs[(8 + i) * 64] = pk2bf(__uint_as_float(w1 << 16) + f.o1[2 * i] * sc, __uint_as_float(w1 & 0xffff0000u) + f.o1[2 * i + 1] * sc);
    }
  }
  fstate_init(f);
  {
    int jlo = (t0 - 511) >> 6; if (jlo < 0) jlo = 0;
    nsa_stream(lds, (const bf16_t*)(p.ws + WS_G) + (size_t)T * 320 + (size_t)b * S * 64, 64, PROJ + (size_t)b * S * DINP + C_VW, DINP, true, cur - jlo + 1,
      [&](int i) { return (jlo + i) * 64; },
      [&](int i, unsigned char* buf) {
        const int j = jlo + i;
        f32x16 s0, s1;
        qk_tile<64>((const bf16_t*)buf, qf, s0, s1, r, h);
        if (j == cur || j * 64 < t0 + 63 - 511 + 64) {
          int rel = tq - j * 64 - 4 * h; asm volatile("" : "+v"(rel));
#pragma unroll
          for (int i2 = 0; i2 < 16; ++i2) {
            const int kk2 = (i2 & 3) + 8 * (i2 >> 2);
            if (kk2 > rel || kk2 < rel - 511) s0[i2] = -INFINITY;
            if (kk2 + 32 > rel || kk2 + 32 < rel - 511) s1[i2] = -INFINITY;
          }
        }
        softmax_pv(f, s0, s1, (const bf16_t*)(buf + att_kbytes<64>()), lane);
      });
    const float sc = (f.l > 0.f) ? g2 / f.l : 0.f;
#pragma unroll
    for (int i = 0; i < 8; ++i) {
      const unsigned w0 = ofs[i * 64], w1 = ofs[(8 + i) * 64];
      f.o0[2 * i] = __uint_as_float(w0 << 16) + f.o0[2 * i] * sc; f.o0[2 * i + 1] = __uint_as_float(w0 & 0xffff0000u) + f.o0[2 * i + 1] * sc;
      f.o1[2 * i] = __uint_as_float(w1 << 16) + f.o1[2 * i] * sc; f.o1[2 * i + 1] = __uint_as_float(w1 & 0xffff0000u) + f.o1[2 * i + 1] * sc;
    }
  }
  f32x16& of0 = f.o0; f32x16& of1 = f.o1;
  {
    float ss = 0.f;
#pragma unroll
    for (int i = 0; i < 16; ++i) ss += of0[i] * of0[i] + of1[i] * of1[i];
    ss += __shfl_xor(ss, 1); ss += __shfl_xor(ss, 2); ss += __shfl_xor(ss, 32);
    const float rs = rsqrtf(ss * (1.f / 256) + EPS);
    const float* on = p.in[35] + l * 1024 + 768 + hd * 64;
#pragma unroll
    for (int g4 = 0; g4 < 4; ++g4) {
      const float4 a = *(const float4*)(on + 8 * g4 + 4 * h), b4 = *(const float4*)(on + 32 + 8 * g4 + 4 * h);
      of0[4 * g4] *= a.x; of0[4 * g4 + 1] *= a.y; of0[4 * g4 + 2] *= a.z; of0[4 * g4 + 3] *= a.w;
      of1[4 * g4] *= b4.x; of1[4 * g4 + 1] *= b4.y; of1[4 * g4 + 2] *= b4.z; of1[4 * g4 + 3] *= b4.w;
    }
    store_o((bf16_t*)(p.ws + WS_A) + tg * 1024 + 768 + hd * 64, of0, of1, rs, h);
  }
}

DEVI void carry_item(const Params& p, int l, int it) {
  const int tid = HTID;
  if (it < 64) {
    const int idx = it * 256 + tid, b = idx >> 10, gs = idx & 1023;
    const float2 a64 = ((const float2*)(p.ws + WS_W + l * WS_WL + W_S5A64))[gs];
    const float2* SLOC = (const float2*)(p.ws + SM_SLOC) + (size_t)b * 32 * 1024 + gs;
    float2* SCAR = (float2*)(p.ws + SM_SCAR) + (size_t)b * 32 * 1024 + gs;
    float hr = 0.f, hi = 0.f;
#pragma unroll 1
    for (int c0 = 0; c0 < 32; c0 += 8) {
      float2 sl[8];
#pragma unroll
      for (int i = 0; i < 8; ++i) sl[i] = SLOC[(size_t)(c0 + i) * 1024];
#pragma unroll
      for (int i = 0; i < 8; ++i) { SCAR[(size_t)(c0 + i) * 1024] = make_float2(hr, hi); const float nr = a64.x * hr - a64.y * hi + sl[i].x, ni = a64.x * hi + a64.y * hr + sl[i].y; hr = nr; hi = ni; }
    }
  } else {
    const int idx = (it - 64) * 256 + tid, b = idx >> 8, c = idx & 255;
    const float2* LSUM = (const float2*)(p.ws + SM_LSUM) + (size_t)b * 32 * 256 + c;
    float* LCAR = (float*)(p.ws + SM_LCAR) + (size_t)b * 32 * 256 + c;
    float hh = 0.f;
#pragma unroll 1
    for (int c0 = 0; c0 < 32; c0 += 8) {
      float2 sv[8];
#pragma unroll
      for (int i = 0; i < 8; ++i) sv[i] = LSUM[(size_t)(c0 + i) * 256];
#pragma unroll
      for (int i = 0; i < 8; ++i) { LCAR[(size_t)(c0 + i) * 256] = hh; hh = sv[i].x * hh + sv[i].y; }
    }
  }
}
DEVI void phase_a1(const Params& p, int l, unsigned char* lds_full) {
  for (int it = VBID; it < 80; it += VGRID) carry_item(p, l, it);
  __syncthreads();
  const int G_ = (int)gridDim.x, bx_ = (int)blockIdx.x, vb_ = (G_ % 8 == 0) ? (bx_ % 8) * (G_ / 8) + bx_ / 8 : bx_;
  for (int rr = 0; rr * G_ < 512; ++rr) { const int j = rr * G_ + ((rr & 1) ? (G_ - 1 - vb_) : vb_); if (j < 512) { const int b = j >> 5, qt = 31 - (j & 31); nsa_item(p, l, b, qt, lds_full); } }
  __syncthreads();
  for (int rr = 0; rr * G_ < 512; ++rr) { const int j = rr * G_ + ((rr & 1) ? (G_ - 1 - vb_) : vb_); if (j < 512) { const int bh = j >> 3, qt = 7 - (j & 7); mla_item(p, l, bh >> 2, bh & 3, qt, lds_full); } }
}

DEVI void phase_r3(const Params& p, int l, unsigned char* lds) {
  bf16_t* Y = (bf16_t*)(p.ws + WS_A);
  const int tid = HTID, lane = tid & 63, wv = tid >> 6;
  {
    const float* onorm = p.in[35] + l * 1024 + 256;
    float* tile = (float*)lds;
    for (int it = VBID; it < NB * 32; it += VGRID) {
      const int b = it >> 5, chunk = it & 31;
      hsync();
      lru_chunk<true>(p, l, b, chunk, tile);
      hsync();
      for (int k = wv; k < 64; k += 4) {
        const float4 v = *(const float4*)(tile + k * 256 + lane * 4);
        const float rs = rsqrtf(wsum(v.x * v.x + v.y * v.y + v.z * v.z + v.w * v.w) * (1.f / 256) + EPS);
        const size_t t = (size_t)b * S + chunk * 64 + k;
        const float4 gg = *(const float4*)(onorm + lane * 4);
        st_bf16x4(Y + t * 1024 + 256 + lane * 4, (f32x4){v.x * rs * gg.x, v.y * rs * gg.y, v.z * rs * gg.z, v.w * rs * gg.w});
      }
    }
  }
  hsync();
  for (int it = VBID; it < NB * 32; it += VGRID) s5_chunk<true>(p, l, it >> 5, it & 31, lds);
}

DEVI void phase_g3(const Params& p, int l, unsigned char* lds) {
  const bf16_t* YCP = (const bf16_t*)(p.ws + WS_F);
  bf16_t* YC = (bf16_t*)(p.ws + WS_F) + (size_t)T * 256;
  const bf16_t* W = (const bf16_t*)(p.ws + WS_W + l * WS_WL + W_GLU);
  const float* bg = p.in[26] + l * 256;
  for (int it = vblock(); it < 256 * 2; it += VGRID) {
    const int mt = it >> 1, nt = it & 1;
    f32x4 acc[4][4];
    gemm128g(lds, 256, [&](int r, int k) { return YCP + (size_t)(mt * 128 + r) * 256 + k; }, [&](int r, int k) { return W + (size_t)(nt * 128 + r) * 256 + k; }, acc);
    GEMM_EPI4({ const size_t o = (size_t)(mt * 128 + er) * 256 + nt * 128 + ec0; const ushort4 yp = *(const ushort4*)(YCP + o); f32x4 r4; r4[0] = bf2f(yp.x) * sigmoidf_(ev4[0] + bg[nt * 128 + ec0]); r4[1] = bf2f(yp.y) * sigmoidf_(ev4[1] + bg[nt * 128 + ec0 + 1]); r4[2] = bf2f(yp.z) * sigmoidf_(ev4[2] + bg[nt * 128 + ec0 + 2]); r4[3] = bf2f(yp.w) * sigmoidf_(ev4[3] + bg[nt * 128 + ec0 + 3]); st_bf16x4(YC + o, r4); })
  }
}

DEVI void phase_r4(const Params& p, int l) {
  const bf16_t* YA = (const bf16_t*)(p.ws + WS_C);
  const bf16_t* YC = (const bf16_t*)(p.ws + WS_F) + (size_t)T * 256;
  bf16_t* Y = (bf16_t*)(p.ws + WS_A);
  const float* onorm = p.in[35] + l * 1024;
  const int lane = HTID & 63, gw = VBID * 4 + (HTID >> 6), NGW = VGRID * 4;
  for (int t = gw; t < T; t += NGW) {
#pragma unroll
    for (int grp = 0; grp < 2; ++grp) {
      const bf16_t* src = (grp == 0 ? YA : YC) + (size_t)t * 256;
      const int gcol = (grp == 0 ? 0 : 512);
      const ushort4 u = ((const ushort4*)src)[lane];
      const float v0 = bf2f(u.x), v1 = bf2f(u.y), v2 = bf2f(u.z), v3 = bf2f(u.w);
      const float rs = rsqrtf(wsum(v0 * v0 + v1 * v1 + v2 * v2 + v3 * v3) * (1.f / 256) + EPS);
      const float4 g = ((const float4*)(onorm + gcol))[lane];
      uint2 o; o.x = pk2bf(v0 * rs * g.x, v1 * rs * g.y); o.y = pk2bf(v2 * rs * g.z, v3 * rs * g.w);
      ((uint2*)(Y + (size_t)t * 1024 + gcol))[lane] = o;
    }
  }
}

DEVI void phase_g4(const Params& p, int l, unsigned char* lds_full) {
  const bf16_t* Y = (const bf16_t*)(p.ws + WS_A);
  const bf16_t* W = (const bf16_t*)(p.ws + WS_W + l * WS_WL + W_OUT);
  const float* xin = (l == 0) ? p.in[0] : p.out;
  pg8::Gemm g{Y, W, T, D, D}; pg8::StaticOrder S; S.init(T, D, (int)gridDim.x, (int)blockIdx.x);
  EpiRes E{xin, p.out};
  pg8::gemm_phase<EpiRes, pg8::StaticOrder, true, true>((LAS unsigned char*)lds_full, g, S, E);
}

DEVI void phase_r5(const Params& p, int l, unsigned char* lds) {
  const float* x1 = p.out;
  bf16_t* XN = (bf16_t*)(p.ws + WS_A);
  const float* g = p.in[37] + l * D;
  const bf16_t* WH = (const bf16_t*)(p.ws + WS_W + l * WS_WL + W_RTH);
  const bf16_t* WL = (const bf16_t*)(p.ws + WS_W + l * WS_WL + W_RTL);
  const float* brg = p.in[39] + l * 4; const float* bre = p.in[41] + l * 16;
  int* CNT = (int*)(p.ws + SM_CNT) + l * 32;
  int* LIST = (int*)(p.ws + SM_LIST);
  float2* TOKW = (float2*)(p.ws + SM_TOKW);
  const int tid = HTID, lane = tid & 63, wv = tid >> 6, c = lane & 15, q = lane >> 4;
  float* red = (float*)lds;
  int* hist = (int*)(lds + 16384);
  int* tokl = (int*)(lds + 16384 + 256);
  if (tid < 64) hist[tid] = 0;
  int ntok = 0;
  hsync();
  for (int it = VBID; it < T / 16; it += VGRID) {
    const size_t tb = (size_t)it * 16;
    f32x4 a0 = (f32x4){0.f, 0.f, 0.f, 0.f}, a1 = (f32x4){0.f, 0.f, 0.f, 0.f};
    float ss = 0.f;
    const float* xrow = x1 + (tb + c) * D + wv * 256 + 8 * q;
    const bf16_t* wh0 = WH + (size_t)c * 1024 + wv * 256 + 8 * q;
    const bf16_t* wl0 = WL + (size_t)c * 1024 + wv * 256 + 8 * q;
    float4 xk[8][2];
#pragma unroll
    for (int ks = 0; ks < 8; ++ks) { xk[ks][0] = *(const float4*)(xrow + ks * 32); xk[ks][1] = *(const float4*)(xrow + ks * 32 + 4); }
#pragma unroll
    for (int ks = 0; ks < 8; ++ks) {
      const bf16x8 wh_a = *(const bf16x8*)(wh0 + ks * 32), wl_a = *(const bf16x8*)(wl0 + ks * 32);
      const bf16x8 wh_b = *(const bf16x8*)(wh0 + 16 * 1024 + ks * 32), wl_b = *(const bf16x8*)(wl0 + 16 * 1024 + ks * 32);
      const float xv[8] = {xk[ks][0].x, xk[ks][0].y, xk[ks][0].z, xk[ks][0].w, xk[ks][1].x, xk[ks][1].y, xk[ks][1].z, xk[ks][1].w};
      u32x4 hw, lw;
#pragma unroll
      for (int j = 0; j < 4; ++j) {
        const float x0 = xv[2 * j], x1v = xv[2 * j + 1];
        ss += x0 * x0 + x1v * x1v;
        const unsigned hp = pk2bf(x0, x1v);
        hw[j] = hp; lw[j] = pk2bf(x0 - __uint_as_float(hp << 16), x1v - __uint_as_float(hp & 0xffff0000u));
      }
      const bf16x8 xh = __builtin_bit_cast(bf16x8, hw), xl = __builtin_bit_cast(bf16x8, lw);
      a0 = mfma16(wh_a, xh, a0); a0 = mfma16(wh_a, xl, a0); a0 = mfma16(wl_a, xh, a0);
      a1 = mfma16(wh_b, xh, a1); a1 = mfma16(wh_b, xl, a1); a1 = mfma16(wl_b, xh, a1);
    }
    ss += __shfl_xor(ss, 16); ss += __shfl_xor(ss, 32);
    hsync();
#pragma unroll
    for (int j = 0; j < 4; ++j) { red[(wv * 9 + j) * 64 + lane] = a0[j]; red[(wv * 9 + 4 + j) * 64 + lane] = a1[j]; }
    red[(wv * 9 + 8) * 64 + lane] = ss;
    hsync();
    const float s2 = red[8 * 64 + lane] + red[(9 + 8) * 64 + lane] + red[(18 + 8) * 64 + lane] + red[(27 + 8) * 64 + lane];
    const float rs = rsqrtf(s2 * (1.f / D) + EPS);
    {
      bf16_t* xo = XN + (tb + c) * D + wv * 256 + 8 * q;
      const float* gp = g + wv * 256 + 8 * q;
#pragma unroll
      for (int ks = 0; ks < 8; ++ks) {
        const float4 g0 = *(const float4*)(gp + ks * 32), g1 = *(const float4*)(gp + ks * 32 + 4);
        u32x4 o;
        o[0] = pk2bf(xk[ks][0].x * rs * g0.x, xk[ks][0].y * rs * g0.y); o[1] = pk2bf(xk[ks][0].z * rs * g0.z, xk[ks][0].w * rs * g0.w);
        o[2] = pk2bf(xk[ks][1].x * rs * g1.x, xk[ks][1].y * rs * g1.y); o[3] = pk2bf(xk[ks][1].z * rs * g1.z, xk[ks][1].w * rs * g1.w);
        *(u32x4*)(xo + ks * 32) = o;
      }
    }
    if (wv == 0) {
      float c0[4], c1[4];
#pragma unroll
      for (int j = 0; j < 4; ++j) {
        c0[j] = red[j * 64 + lane] + red[(9 + j) * 64 + lane] + red[(18 + j) * 64 + lane] + red[(27 + j) * 64 + lane];
        c1[j] = red[(4 + j) * 64 + lane] + red[(13 + j) * 64 + lane] + red[(22 + j) * 64 + lane] + red[(31 + j) * 64 + lane];
      }
      float lg[20];
#pragma unroll
      for (int qq = 0; qq < 4; ++qq)
#pragma unroll
        for (int j = 0; j < 4; ++j) lg[4 * qq + j] = __shfl(c0[j], c + 16 * qq);
#pragma unroll
      for (int j = 0; j < 4; ++j) lg[16 + j] = __shfl(c1[j], c);
      const int t = (int)tb + c;
      float gl[4];
#pragma unroll
      for (int k2 = 0; k2 < 4; ++k2) gl[k2] = lg[k2] * rs + brg[k2];
      int gi = 0; float gbest = gl[0];
#pragma unroll
      for (int k2 = 1; k2 < 4; ++k2) if (gl[k2] > gbest) { gbest = gl[k2]; gi = k2; }
      float den = 0.f;
#pragma unroll
      for (int k2 = 0; k2 < 4; ++k2) den += expf(gl[k2] - gbest);
      const float pg = 1.f / den;
      float le[4];
#pragma unroll
      for (int k2 = 0; k2 < 4; ++k2) { float sel = 0.f;
#pragma unroll
        for (int gg2 = 0; gg2 < 4; ++gg2) sel = (gi == gg2) ? (lg[4 + gg2 * 4 + k2] * rs + bre[gg2 * 4 + k2]) : sel;
        le[k2] = sel; }
      int i0 = 0; float l0 = le[0];
#pragma unroll
      for (int k2 = 1; k2 < 4; ++k2) if (le[k2] > l0) { l0 = le[k2]; i0 = k2; }
      int i1 = -1; float l1 = -INFINITY;
#pragma unroll
      for (int k2 = 0; k2 < 4; ++k2) if (k2 != i0 && le[k2] > l1) { l1 = le[k2]; i1 = k2; }
      const float e1 = expf(l1 - l0);
      const float w0 = pg / (1.f + e1), w1 = pg * e1 / (1.f + e1);
      const int elo = (i0 < i1) ? i0 : i1, ehi = (i0 < i1) ? i1 : i0;
      const float wlo = (i0 < i1) ? w0 : w1, whi = (i0 < i1) ? w1 : w0;
      const int pidx = (elo == 0) ? (ehi - 1) : ((elo == 1) ? (ehi + 1) : 5);
      const int cls = gi * 6 + pidx;
      if (q == 0) {
        const int rank = atomicAdd(&hist[cls], 1);
        tokl[2 * (ntok + c)] = t; tokl[2 * (ntok + c) + 1] = (cls << 16) | rank;
        TOKW[t] = make_float2(wlo, whi);
      }
    }
    ntok += 16;
  }
  hsync();
  if (tid < 24) { const int n = hist[tid]; hist[32 + tid] = n ? atomicAdd(&CNT[tid], n) : 0; }
  hsync();
  for (int i = tid; i < ntok; i += NTHREADS) { const int t = tokl[2 * i], cr = tokl[2 * i + 1], cls = cr >> 16; LIST[(size_t)cls * T + hist[32 + cls] + (cr & 0xffff)] = t; }
}

struct MoeItem { int cls, mtile, nt, cnt; };
DEVI void moe_prefix(const int* CNT, unsigned char* lds) {
  int* pre = (int*)(lds + LDS_BYTES + 64);
  hsync();
  if (HTID < 24) pre[32 + HTID] = CNT[HTID];
  hsync();
  if (HTID == 0) { int a = 0; for (int c = 0; c < 24; ++c) { pre[c] = a; a += (pre[32 + c] + 127) >> 7; } pre[24] = a; }
  hsync();
}
DEVI bool moe_item(unsigned char* lds, int it, MoeItem& m) {
  const int* pre = (const int*)(lds + LDS_BYTES + 64);
  const int mt = it >> 3; m.nt = it & 7;
  if (mt >= pre[24]) return false;
  int c = 0;
#pragma unroll
  for (int q = 1; q < 24; ++q) c += (mt >= pre[q]) ? 1 : 0;
  m.cls = c; m.mtile = mt - pre[c]; m.cnt = pre[32 + c];
  return true;
}
DEVI void cls_experts(int cls, int& e0, int& e1) {
  const int g = cls / 6, pi = cls % 6;
  const int lo = (pi < 3) ? 0 : ((pi < 5) ? 1 : 2);
  const int hi = (pi < 3) ? (pi + 1) : ((pi < 5) ? (pi - 1) : 3);
  e0 = g * 4 + lo; e1 = g * 4 + hi;
}
DEVI void phase_g5(const Params& p, int l, unsigned char* lds) {
  const bf16_t* XN = (const bf16_t*)(p.ws + WS_A);
  bf16_t* HID = (bf16_t*)(p.ws + WS_B);
  const bf16_t* WGU = (const bf16_t*)(p.ws + WS_W + l * WS_WL + W_GU);
  const int* CNT = (const int*)(p.ws + SM_CNT) + l * 32;
  const int* LIST = (const int*)(p.ws + SM_LIST);
  const float2* TOKW = (const float2*)(p.ws + SM_TOKW);
  moe_prefix(CNT, lds);
  const int G_ = VGRID, total_ = ((const int*)(lds + LDS_BYTES + 64))[24] * 8, full_ = (total_ / G_) * G_, rem_ = total_ - full_;
  for (int it = vblock(); it < full_ + 2 * rem_; it += G_) {
    const bool halfmode = it >= full_; const int half = (it - full_) & 1;
    MoeItem mi; if (!moe_item(lds, halfmode ? full_ + ((it - full_) >> 1) : it, mi)) break;
    int e0, e1; cls_experts(mi.cls, e0, e1);
    const int ex = (mi.nt < 4) ? e0 : e1, ntl = mi.nt & 3;
    const bf16_t* W = WGU + ((size_t)ex * 512 + ntl * 128) * 1024;
    const int* list = LIST + (size_t)mi.cls * T + mi.mtile * 128;
    const int nvalid = mi.cnt - mi.mtile * 128;
    if (halfmode) {
      f32x4 acc2[2][4];
      int tokA[4];
#pragma unroll
      for (int i = 0; i < 4; ++i) { const int r = (HTID >> 3) + 32 * i; tokA[i] = list[(r < nvalid) ? r : 0]; }
      const int tid = HTID, wid = tid >> 6, lane = tid & 63, fr = lane & 15, fq = lane >> 4;
      int tokE2[2]; float twE2[2];
#pragma unroll
      for (int m = 0; m < 2; ++m) { const int er = wid * 32 + m * 16 + fr; tokE2[m] = list[(er < nvalid) ? er : 0]; }
#pragma unroll
      for (int m = 0; m < 2; ++m) { const float2 tw = TOKW[tokE2[m]]; twE2[m] = (mi.nt < 4) ? tw.x : tw.y; }
      const bf16_t* Wh = W + (size_t)half * 64 * 1024;
      gemm128h(lds, D, [&](int r, int k) { const int i = r >> 5; const int tok = (i == 0) ? tokA[0] : (i == 1) ? tokA[1] : (i == 2) ? tokA[2] : tokA[3]; return XN + (size_t)tok * D + k; },
               [&](int r, int k) { return Wh + (size_t)r * D + k; }, acc2);
#pragma unroll
      for (int m = 0; m < 2; ++m) {
        const int er = wid * 32 + m * 16 + fr;
        if (er < nvalid) {
#pragma unroll
          for (int n = 0; n < 2; ++n) {
            f32x4 hv;
#pragma unroll
            for (int j = 0; j < 4; ++j) { const float gt = acc2[m][n][j], up = acc2[m][n + 2][j]; hv[j] = gt * sigmoidf_(gt) * up * twE2[m]; }
            st_bf16x4(HID + (size_t)tokE2[m] * 512 + (mi.nt < 4 ? 0 : 256) + ntl * 64 + half * 32 + n * 16 + fq * 4, hv);
          }
        }
      }
      continue;
    }
    f32x4 acc[4][4];
    int tokA[4], tokE[4]; float twE[4];
#pragma unroll
    for (int i = 0; i < 4; ++i) { const int r = (HTID >> 3) + 32 * i; tokA[i] = list[(r < nvalid) ? r : 0]; }
    {
      const int tid_ = HTID, er0 = ((tid_ >> 6) >> 1) * 64 + (tid_ & 15);
#pragma unroll
      for (int m = 0; m < 4; ++m) { const int er = er0 + m * 16; tokE[m] = list[(er < nvalid) ? er : 0]; }
#pragma unroll
      for (int m = 0; m < 4; ++m) { const float2 tw = TOKW[tokE[m]]; twE[m] = (mi.nt < 4) ? tw.x : tw.y; }
    }
    gemm128g(lds, D, [&](int r, int k) { const int i = r >> 5; const int tok = (i == 0) ? tokA[0] : (i == 1) ? tokA[1] : (i == 2) ? tokA[2] : tokA[3]; return XN + (size_t)tok * D + k; }, [&](int r, int k) { return W + (size_t)r * D + k; }, acc);
    {
      const int tid = HTID, wid = tid >> 6, lane = tid & 63, wr = wid >> 1, wc = wid & 1, fr = lane & 15, fq = lane >> 4;
#pragma unroll
      for (int m = 0; m < 4; ++m) {
        const int er = wr * 64 + m * 16 + fr;
        if (er < nvalid) {
          const int tok = tokE[m];
          const float w = twE[m];
#pragma unroll
          for (int n = 0; n < 2; ++n) {
            f32x4 hv;
#pragma unroll
            for (int j = 0; j < 4; ++j) { const float gt = acc[m][n][j], up = acc[m][n + 2][j]; hv[j] = gt * sigmoidf_(gt) * up * w; }
            const int hh = (mi.nt < 4 ? 0 : 256) + ntl * 64 + wc * 32 + n * 16 + fq * 4;
            st_bf16x4(HID + (size_t)tok * 512 + hh, hv);
          }
        }
      }
    }
  }
}
DEVI void phase_g6(const Params& p, int l, unsigned char* lds) {
  const bf16_t* HID = (const bf16_t*)(p.ws + WS_B);
  const bf16_t* WDN = (const bf16_t*)(p.ws + WS_W + l * WS_WL + W_DN);
  const int* CNT = (const int*)(p.ws + SM_CNT) + l * 32;
  const int* LIST = (const int*)(p.ws + SM_LIST);
  float* out = p.out;
  moe_prefix(CNT, lds);
  const int G_ = VGRID, total_ = ((const int*)(lds + LDS_BYTES + 64))[24] * 8, full_ = (total_ / G_) * G_, rem_ = total_ - full_;
  for (int it = vblock(); it < full_ + 2 * rem_; it += G_) {
    const bool halfmode = it >= full_; const int half = (it - full_) & 1;
    MoeItem mi; if (!moe_item(lds, halfmode ? full_ + ((it - full_) >> 1) : it, mi)) break;
    int e0, e1; cls_experts(mi.cls, e0, e1);
    const int* list = LIST + (size_t)mi.cls * T + mi.mtile * 128;
    const int nvalid = mi.cnt - mi.mtile * 128;
    const bf16_t* W0 = WDN + ((size_t)e0 * 1024 + mi.nt * 128) * 256;
    const bf16_t* W1 = WDN + ((size_t)e1 * 1024 + mi.nt * 128) * 256;
    if (halfmode) {
      f32x4 acc2[2][4];
      int tokA[4];
#pragma unroll
      for (int i = 0; i < 4; ++i) { const int r = (HTID >> 3) + 32 * i; tokA[i] = list[(r < nvalid) ? r : 0]; }
      const int tid = HTID, wid = tid >> 6, lane = tid & 63, fr = lane & 15, fq = lane >> 4;
      int trow2[2];
#pragma unroll
      for (int m = 0; m < 2; ++m) { const int er = wid * 32 + m * 16 + fr; trow2[m] = list[(er < nvalid) ? er : 0]; }
      const bf16_t* W0h = W0 + (size_t)half * 64 * 256; const bf16_t* W1h = W1 + (size_t)half * 64 * 256;
      gemm128h(lds, 512, [&](int r, int k) { const int i = r >> 5; const int tok = (i == 0) ? tokA[0] : (i == 1) ? tokA[1] : (i == 2) ? tokA[2] : tokA[3]; return HID + (size_t)tok * 512 + k; },
               [&](int r, int k) { return ((k < 256) ? W0h : W1h) + (size_t)r * 256 + (k & 255); }, acc2);
#pragma unroll
      for (int m = 0; m < 2; ++m) {
        const int er = wid * 32 + m * 16 + fr;
        if (er < nvalid) {
#pragma unroll
          for (int n = 0; n < 4; ++n) { float* o = out + (size_t)trow2[m] * D + mi.nt * 128 + half * 64 + n * 16 + fq * 4; const f32x4 xi = *(const f32x4*)o; *(f32x4*)o = xi + acc2[m][n]; }
        }
      }
      continue;
    }
    f32x4 acc[4][4];
    int trow[4], tokA[4];
    {
      const int tid = HTID, wid = tid >> 6, lane = tid & 63, wr = wid >> 1, fr = lane & 15;
#pragma unroll
      for (int i = 0; i < 4; ++i) { const int r = (tid >> 3) + 32 * i; tokA[i] = list[(r < nvalid) ? r : 0]; }
#pragma unroll
      for (int m = 0; m < 4; ++m) { const int er = wr * 64 + m * 16 + fr; trow[m] = list[(er < nvalid) ? er : 0]; }
    }
    gemm128g(lds, 512, [&](int r, int k) { const int i = r >> 5; const int tok = (i == 0) ? tokA[0] : (i == 1) ? tokA[1] : (i == 2) ? tokA[2] : tokA[3]; return HID + (size_t)tok * 512 + k; },
            [&](int r, int k) { return ((k < 256) ? W0 : W1) + (size_t)r * 256 + (k & 255); }, acc);
    GEMM_EPI4({ if (er < nvalid) { const size_t o = (size_t)trow[m] * D + mi.nt * 128 + ec0; const f32x4 xi = *(const f32x4*)(out + o); *(f32x4*)(out + o) = xi + ev4; } })
  }
}


#define XB_TMO      128
#define XB_XCNT(j)  (256  + 64 * (j))
#define XB_XSUB(j)  (1280 + 64 * (j))
#define XB_XGEN(j)  (2304 + 64 * (j))
#define XB_TOP      3328
#define XB_TOPGEN   3392
#define XCD_BAR_WORDS 3456
#define XB_SPIN_CAP (1u << 18)
DEVI unsigned xb_ld(unsigned* p)              { return __hip_atomic_load(p, __ATOMIC_RELAXED, __HIP_MEMORY_SCOPE_AGENT); }
DEVI unsigned xb_add(unsigned* p, unsigned v) { return __hip_atomic_fetch_add(p, v, __ATOMIC_RELAXED, __HIP_MEMORY_SCOPE_AGENT); }
DEVI unsigned xb_xcc_id() { return (unsigned)__builtin_amdgcn_s_getreg((3 << 11) | 20) & 0xFu; }
#define XB_SPIN(cond, bar) do { unsigned _sp = 0; while (cond) { __builtin_amdgcn_s_sleep(1); \
    if ((++_sp & 255u) == 0u) { if (xb_ld(&(bar)[XB_TMO])) break; if (_sp > XB_SPIN_CAP) { atomicAdd(&(bar)[XB_TMO], 1u); break; } } } } while (0)
struct XcdBarrier { unsigned* bar; unsigned x; volatile LAS unsigned* st; };
DEVI XcdBarrier xcd_barrier_post(unsigned* bar, volatile LAS unsigned* st) {
    XcdBarrier b; b.bar = bar; b.x = xb_xcc_id(); b.st = st;
    if (threadIdx.x == 0) (void)xb_add(&bar[XB_XCNT(b.x)], 1u);
    return b;
}
DEVI void xcd_barrier_complete(unsigned* bar, unsigned x, unsigned& nloc, unsigned& nx) {
    const unsigned G = gridDim.x * gridDim.y * gridDim.z;
    unsigned sum, cnt, mine, sp = 0u;
    for (;;) {
        sum = 0u; cnt = 0u; mine = 0u;
#pragma unroll
        for (unsigned j = 0; j < 16; ++j) { const unsigned c = xb_ld(&bar[XB_XCNT(j)]); sum += c; cnt += (c > 0u) ? 1u : 0u; mine = (j == x) ? c : mine; }
        if (sum == G) break;
        __builtin_amdgcn_s_sleep(1);
        if ((++sp & 255u) == 0u) { if (xb_ld(&bar[XB_TMO])) break; if (sp > XB_SPIN_CAP) { atomicAdd(&bar[XB_TMO], 1u); break; } }
    }
    nloc = mine > 0u ? mine : 1u; nx = cnt > 0u ? cnt : 1u;
}
DEVI void xcd_barrier(const XcdBarrier& b) {
    asm volatile("s_waitcnt vmcnt(0)" ::: "memory");
    __syncthreads();
    if (threadIdx.x == 0) {
        unsigned* bar = b.bar;
        __builtin_amdgcn_s_waitcnt(0);
        unsigned nloc = b.st[0], nx = b.st[1];
        if (nloc == 0u) { xcd_barrier_complete(bar, b.x, nloc, nx); b.st[0] = nloc; b.st[1] = nx; }
        const unsigned old = xb_add(&bar[XB_XSUB(b.x)], 1u);
        const unsigned gen = old / nloc;
        if (old + 1u == (gen + 1u) * nloc) {
            __builtin_amdgcn_fence(__ATOMIC_RELEASE, "agent");
            asm volatile("s_waitcnt vmcnt(0)" ::: "memory");
            const unsigned og = xb_add(&bar[XB_TOP], 1u);
            const unsigned tg = og / nx;
            if (og + 1u == (tg + 1u) * nx) xb_add(&bar[XB_TOPGEN], 1u);
            else XB_SPIN(xb_ld(&bar[XB_TOPGEN]) == tg, bar);
            __builtin_amdgcn_fence(__ATOMIC_ACQUIRE, "agent");
            xb_add(&bar[XB_XGEN(b.x)], 1u);
            asm volatile("s_waitcnt vmcnt(0)" ::: "memory");
        } else {
            XB_SPIN(xb_ld(&bar[XB_XGEN(b.x)]) == gen, bar);
            __builtin_amdgcn_fence(__ATOMIC_ACQUIRE, "agent");
            asm volatile("s_waitcnt vmcnt(0)" ::: "memory");
        }
    }
    __syncthreads();
}

#define PH(k, call) { const int _k = (k); if (p.lo <= _k && _k < p.hi) { call; if (_k + 1 < p.hi) { if (_k == 0) grid.sync(); else xcd_barrier(xbar); } } }
__global__ void __launch_bounds__(KTHREADS, 2) hybrid_fwd(Params p) {
  extern __shared__ __attribute__((aligned(16))) unsigned char lds_full[];
  unsigned char* lds = lds_full + hb_() * LDS_HALF;
  cg::grid_group grid = cg::this_grid();
  volatile LAS unsigned* xst = (volatile LAS unsigned*)(LAS unsigned char*)(lds_full + 2 * LDS_HALF);
  if (threadIdx.x < 4) { xst[threadIdx.x] = 0u; g_hs[threadIdx.x] = 0u; }
  __syncthreads();
  XcdBarrier xbar = xcd_barrier_post((unsigned*)(p.ws + WS_CTL), xst);
  PH(0, phase_prep(p, lds))
#define LAYER(l) { \
    PH(1 + 13 * l + 0, phase_g1(p, l, lds_full)) \
    PH(1 + 13 * l + 2, phase_g2(p, l, lds)) \
    PH(1 + 13 * l + 3, phase_r2(p, l, lds)) \
    PH(1 + 13 * l + 4, phase_a1(p, l, lds_full)) \
    PH(1 + 13 * l + 5, phase_r3(p, l, lds)) \
    PH(1 + 13 * l + 6, phase_g3(p, l, lds)) \
    PH(1 + 13 * l + 7, phase_r4(p, l)) \
    PH(1 + 13 * l + 8, phase_g4(p, l, lds_full)) \
    PH(1 + 13 * l + 9, phase_r5(p, l, lds)) \
    PH(1 + 13 * l + 10, phase_g5(p, l, lds)) \
    PH(1 + 13 * l + 11, phase_g6(p, l, lds)) }
  LAYER(0)
  PH(13, rmsnorm_rows(p.out, p.in[2] + D, (bf16_t*)(p.ws + WS_A)))
  LAYER(1)
}

extern "C" void kernel_launch(void* const* d_in, const int* in_sizes, int n_in, void* d_out, int out_size, void* d_ws, size_t ws_size, hipStream_t stream) {
  static int grid_blocks = 0;
  if (!grid_blocks) {
    if (n_in != 45 || ws_size < WS_END) { fprintf(stderr, "kernel_launch: unexpected n_in %d or ws_size %zu (< %zu)\n", n_in, ws_size, (size_t)WS_END); grid_blocks = -1; return; }
    int dev = 0, cus = 0, per_cu = 0;
    hipGetDevice(&dev);
    hipDeviceGetAttribute(&cus, hipDeviceAttributeMultiprocessorCount, dev);
    hipFuncSetAttribute((const void*)hybrid_fwd, hipFuncAttributeMaxDynamicSharedMemorySize, LDS_ALLOC);
    hipOccupancyMaxActiveBlocksPerMultiprocessor(&per_cu, (const void*)hybrid_fwd, KTHREADS, LDS_ALLOC);
    if (per_cu < 1) per_cu = 1;
    if (per_cu > 1) per_cu = 1;
    grid_blocks = cus * per_cu;
    fprintf(stderr, "kernel_launch: cus %d per_cu %d grid %d\n", cus, per_cu, grid_blocks);
  }
  if (grid_blocks < 0) return;
  (void)hipMemsetAsync((unsigned char*)d_ws + WS_CTL, 0, XCD_BAR_WORDS * 4, stream);
  Params p{};
  for (int i = 0; i < 45; ++i) p.in[i] = (const float*)d_in[i];
  p.out = (float*)d_out; p.ws = (unsigned char*)d_ws;
#if N_LAUNCH_MODE == 1
  p.lo = 0; p.hi = NPH;
  { void* args[] = {&p}; hipError_t e = hipLaunchCooperativeKernel((void*)hybrid_fwd, dim3(grid_blocks), dim3(KTHREADS), args, LDS_ALLOC, stream);
    if (e != hipSuccess) fprintf(stderr, "cooperative launch failed: %s\n", hipGetErrorString(e)); }
#else
  for (int ph = 0; ph < NPH; ++ph) {
    p.lo = ph; p.hi = ph + 1;
    void* args[] = {&p}; hipError_t e = hipLaunchCooperativeKernel((void*)hybrid_fwd, dim3(grid_blocks), dim3(KTHREADS), args, LDS_ALLOC, stream);
    if (e != hipSuccess) { fprintf(stderr, "launch %d failed: %s\n", ph, hipGetErrorString(e)); break; }
  }
#endif
}
```

```cpp
#include <hip/hip_runtime.h>
#include <hip/hip_cooperative_groups.h>
#include <cstdio>
#include <cstdint>
namespace cg = cooperative_groups;

#ifndef N_LAUNCH_MODE
#define N_LAUNCH_MODE 1
#endif

#define DEVI __device__ __forceinline__

constexpr int KTHREADS = 512;
__shared__ unsigned g_hs[4];
#define HTID ((int)(threadIdx.x & 255))
__device__ __forceinline__ int hb_() { return __builtin_amdgcn_readfirstlane((int)(threadIdx.x >> 8)); }
#define VBID ((int)blockIdx.x * 2 + hb_())
#define VGRID ((int)gridDim.x * 2)
__device__ __forceinline__ void hsync() {
  asm volatile("s_waitcnt lgkmcnt(0)" ::: "memory");
  if ((threadIdx.x & 63) == 0) {
    unsigned* c = &g_hs[hb_()];
    const unsigned old = __hip_atomic_fetch_add(c, 1u, __ATOMIC_RELAXED, __HIP_MEMORY_SCOPE_WORKGROUP);
    const unsigned target = (old & ~3u) + 4u;
    if (old + 1u != target) {
      while ((int)(__hip_atomic_load(c, __ATOMIC_RELAXED, __HIP_MEMORY_SCOPE_WORKGROUP) - target) < 0) {}
    }
  }
  asm volatile("" ::: "memory");
}
typedef unsigned short bf16_t;
typedef short bf16x8 __attribute__((ext_vector_type(8)));
typedef float f32x4 __attribute__((ext_vector_type(4)));
typedef float f32x16 __attribute__((ext_vector_type(16)));
typedef unsigned u32x4 __attribute__((ext_vector_type(4)));
#define LAS __attribute__((address_space(3)))

constexpr int NB = 16, S = 2048, T = NB * S, D = 1024, DIN = 1772, DINP = 1792, NL = 2;
constexpr int C_CQ = 0, C_KPE = 192, C_NG = 224, C_T1 = 256, C_LX = 512, C_LG = 768, C_S5 = 1024, C_T5 = 1280, C_KC = 1536, C_VC = 1600, C_VS = 1664, C_VW = 1728;
__host__ __device__ constexpr int wgcol(int tile0, int wc, int e) { return tile0 + 128 * (e >> 5) + 32 * wc + (e & 31); }
__host__ __device__ constexpr int colmap(int n) {
  if (n < 192) return n;
  if (n < 320) { const int k = n - 192; return wgcol(C_T1, k >> 6, k & 63); }
  if (n < 352) return C_KPE + (n - 320);
  if (n < 608) return C_LX + (n - 352);
  if (n < 864) return C_LG + (n - 608);
  if (n < 1120) return C_S5 + (n - 864);
  if (n < 1376) { const int q = n - 1120; return wgcol(C_T5, q >> 6, q & 63); }
  if (n < 1760) { const int j = n - 1376, part = j >> 6, d = j & 63;
    return part == 0 ? C_KC + d : part == 1 ? C_VC + d : part == 2 ? wgcol(C_T1, 2, d) : part == 3 ? C_VS + d : part == 4 ? wgcol(C_T1, 3, d) : C_VW + d; }
  return C_NG + (n - 1760);
}
constexpr float EPS = 1e-6f;
constexpr float LOG2E = 1.4426950408889634f;
constexpr int NTHREADS = 256;
constexpr int NPH = 1 + 13 * NL - 1;

constexpr size_t MiB = 1u << 20;
constexpr size_t WS_CTL = 0;
constexpr size_t WS_SMALL = 1 * MiB;
constexpr size_t WS_W = 16 * MiB;
constexpr size_t WS_WL = 32 * MiB;
constexpr size_t WS_A = 80 * MiB;
constexpr size_t WS_B = 144 * MiB;
constexpr size_t WS_C = 256 * MiB;
constexpr size_t WS_D = 292 * MiB;
constexpr size_t WS_E = 348 * MiB;
constexpr size_t WS_F = 380 * MiB;
constexpr size_t WS_G = 428 * MiB;
constexpr size_t WS_ROPE = 452 * MiB;
constexpr size_t WS_END = 460 * MiB;
constexpr size_t W_IN = 0;
constexpr size_t W_OUT = 4 * MiB;
constexpr size_t W_UQ = 6 * MiB;
constexpr size_t W_UKV = W_UQ + 384 * 192 * 2;
constexpr size_t W_LRU = W_UKV + 512 * 128 * 2;
constexpr size_t W_GLU = W_LRU + 4 * 128 * 64 * 2;
constexpr size_t W_1K = 6 * MiB + 512 * 1024;
constexpr size_t W_1V = W_1K + 128 * 2048 * 2;
constexpr size_t W_B1K = W_1V + 128 * 2048 * 2;
constexpr size_t W_B1V = W_B1K + 512;
constexpr size_t W_S5A = W_B1V + 512;
constexpr size_t W_S5A64 = W_S5A + 16 * 64 * 8;
constexpr size_t W_S5B = W_S5A64 + 16 * 64 * 8;
constexpr size_t W_S5BB = W_S5B + 16 * 64 * 16 * 8;
constexpr size_t W_S5CM = W_S5BB + 16 * 4 * 32 * 16 * 2;
constexpr size_t W_2K = W_S5CM + 16 * 16 * 128 * 2;
constexpr size_t W_2V = W_2K + 64 * 128 * 2;
static_assert(W_2V + 64 * 128 * 2 <= 8 * MiB, "weights overflow");
constexpr size_t W_RTH = W_2V + 64 * 128 * 2;
constexpr size_t W_RTL = W_RTH + 32 * 1024 * 2;
static_assert(W_RTL + 32 * 1024 * 2 <= 8 * MiB, "weights overflow 2");
constexpr size_t W_GU = 8 * MiB;
constexpr size_t W_DN = 24 * MiB;
constexpr size_t SM_CNT = WS_SMALL;
constexpr size_t SM_LIST = WS_SMALL + 4096;
constexpr size_t SM_TOKW = SM_LIST + 24 * (size_t)T * 4;
constexpr size_t SM_LSUM = SM_TOKW + (size_t)T * 8;
constexpr size_t SM_SLOC = SM_LSUM + 16 * 32 * 256 * 8;
constexpr size_t SM_HK = SM_SLOC + 16 * 32 * 1024 * 8;
constexpr size_t SM_HV = SM_HK + 2048 * 128 * 2;
constexpr size_t SM_KC = SM_HV + 2048 * 128 * 2;
constexpr size_t SM_VC = SM_KC + 16 * 128 * 64 * 2;
constexpr size_t SM_SCAR = SM_VC + 16 * 128 * 64 * 2;
constexpr size_t SM_LCAR = SM_SCAR + 16 * 32 * 1024 * 8;
constexpr size_t SM_SSKV = SM_LCAR + 16 * 32 * 256 * 4;
constexpr size_t SM_END = SM_SSKV + (size_t)T * 2 * 4;
static_assert(SM_END <= WS_W, "small region overflow");

constexpr int LDS_BYTES = 65536;
constexpr int LDS_HALF = LDS_BYTES + 512;
constexpr int LDS_ALLOC = 2 * LDS_HALF + 64;

struct Params {
  const float* in[45];
  float* out;
  unsigned char* ws;
  int lo, hi;
};

DEVI float bf2f(bf16_t v) { return __uint_as_float(((unsigned)v) << 16); }
DEVI bf16_t f2bf(float f) { unsigned u = __float_as_uint(f); return (bf16_t)((u + 0x7fffu + ((u >> 16) & 1u)) >> 16); }
DEVI float wsum(float v) {
#pragma unroll
  for (int o = 32; o >= 1; o >>= 1) v += __shfl_xor(v, o);
  return v;
}
DEVI float sigmoidf_(float x) { return __builtin_amdgcn_rcpf(1.f + __expf(-x)); }
DEVI float gelu_tanh(float x) { const float u2 = 1.5957691216057308f * (x + 0.044715f * x * x * x); return x * __builtin_amdgcn_rcpf(1.f + __expf(-u2)); }
DEVI f32x16 mfma32(bf16x8 a, bf16x8 b, f32x16 c) { return __builtin_amdgcn_mfma_f32_32x32x16_bf16(a, b, c, 0, 0, 0); }
DEVI f32x4 mfma16(bf16x8 a, bf16x8 b, f32x4 c) { return __builtin_amdgcn_mfma_f32_16x16x32_bf16(a, b, c, 0, 0, 0); }
DEVI int vblock() { const int bx = (int)blockIdx.x, GB = (int)gridDim.x; return (GB % 8 == 0) ? (bx % 8) * (GB / 8) * 2 + (bx / 8) * 2 + hb_() : VBID; }
DEVI int crow(int r, int h) { return (r & 3) + 8 * (r >> 2) + 4 * h; }
typedef __bf16 bf16x2_t __attribute__((ext_vector_type(2)));
typedef float f32x2_t __attribute__((ext_vector_type(2)));
DEVI unsigned pk2bf(float lo, float hi) { f32x2_t v = {lo, hi}; bf16x2_t b = __builtin_convertvector(v, bf16x2_t); return __builtin_bit_cast(unsigned, b); }

template <class AF, class BF>
DEVI void gemm128(unsigned char* lds, int K, AF aload, BF bptr, f32x4 (&acc)[4][4]) {
  const int tid = HTID, wid = tid >> 6, lane = tid & 63, wr = wid >> 1, wc = wid & 1, fr = lane & 15, fq = lane >> 4;
#pragma unroll
  for (int m = 0; m < 4; ++m)
#pragma unroll
    for (int n = 0; n < 4; ++n) acc[m][n] = (f32x4){0.f, 0.f, 0.f, 0.f};
  const int lr = tid >> 3, ch = tid & 7;
  const int wofs = lr * 128 + ((ch ^ ((lr >> 1) & 7)) * 16);
  const int sw = (fr >> 1) & 7;
  const int aro = (wr * 64 + fr) * 128, bro = (wc * 64 + fr) * 128;
  const int nk = K >> 6;
  u32x4 ra[4], rb[4];
#pragma unroll
  for (int i = 0; i < 4; ++i) { ra[i] = aload(lr + 32 * i, ch * 8); rb[i] = *(const u32x4*)bptr(lr + 32 * i, ch * 8); }
  hsync();
#pragma unroll
  for (int i = 0; i < 4; ++i) { *(u32x4*)(lds + wofs + i * 4096) = ra[i]; *(u32x4*)(lds + 16384 + wofs + i * 4096) = rb[i]; }
  hsync();
  for (int kt = 0; kt < nk; ++kt) {
    const bool more = (kt + 1 < nk);
    if (more) {
      const int k = (kt + 1) * 64 + ch * 8;
#pragma unroll
      for (int i = 0; i < 4; ++i) { ra[i] = aload(lr + 32 * i, k); rb[i] = *(const u32x4*)bptr(lr + 32 * i, k); }
    }
    const unsigned char* bufA = lds + (kt & 1) * 32768;
    const unsigned char* bufB = bufA + 16384;
#pragma unroll
    for (int kk = 0; kk < 2; ++kk) {
      bf16x8 At[4], Bt[4];
      const int co = ((kk * 4 + fq) ^ sw) * 16;
#pragma unroll
      for (int m = 0; m < 4; ++m) At[m] = *(const bf16x8*)(bufA + aro + m * 2048 + co);
#pragma unroll
      for (int n = 0; n < 4; ++n) Bt[n] = *(const bf16x8*)(bufB + bro + n * 2048 + co);
#pragma unroll
      for (int m = 0; m < 4; ++m)
#pragma unroll
        for (int n = 0; n < 4; ++n) acc[m][n] = mfma16(Bt[n], At[m], acc[m][n]);
    }
    if (more) {
      unsigned char* nb = lds + ((kt + 1) & 1) * 32768;
#pragma unroll
      for (int i = 0; i < 4; ++i) { *(u32x4*)(nb + wofs + i * 4096) = ra[i]; *(u32x4*)(nb + 16384 + wofs + i * 4096) = rb[i]; }
    }
    hsync();
  }
}
template <class AF, class BF>
DEVI void gemm128g(unsigned char* lds, int K, AF aptr, BF bptr, f32x4 (&acc)[4][4]) {
  const int tid = HTID, wid = tid >> 6, lane = tid & 63, wr = wid >> 1, wc = wid & 1, fr = lane & 15, fq = lane >> 4;
#pragma unroll
  for (int m = 0; m < 4; ++m)
#pragma unroll
    for (int n = 0; n < 4; ++n) acc[m][n] = (f32x4){0.f, 0.f, 0.f, 0.f};
  const int lr = tid >> 3;
  const int chs = ((tid & 7) ^ ((lr >> 1) & 7)) * 8;
  const int sw = (fr >> 1) & 7;
  const int aro = (wr * 64 + fr) * 128, bro = (wc * 64 + fr) * 128;
  const int nk = K >> 6;
  LAS unsigned char* l3 = (LAS unsigned char*)lds;
#define G128_STAGE(buf, kbase)                                                                                                   \
  _Pragma("unroll") for (int i = 0; i < 4; ++i) {                                                                                 \
    __builtin_amdgcn_global_load_lds((const __attribute__((address_space(1))) unsigned*)aptr(lr + 32 * i, (kbase) + chs),          \
                                     (LAS unsigned*)(l3 + (buf) * 32768 + tid * 16 + i * 4096), 16, 0, 0);                           \
    __builtin_amdgcn_global_load_lds((const __attribute__((address_space(1))) unsigned*)bptr(lr + 32 * i, (kbase) + chs),          \
                                     (LAS unsigned*)(l3 + (buf) * 32768 + 16384 + tid * 16 + i * 4096), 16, 0, 0);                   \
  }
  hsync();
  G128_STAGE(0, 0)
  asm volatile("s_waitcnt vmcnt(0)" ::: "memory");
  hsync();
  for (int kt = 0; kt < nk; ++kt) {
    if (kt + 1 < nk) { G128_STAGE((kt + 1) & 1, (kt + 1) * 64) }
    const unsigned char* bufA = lds + (kt & 1) * 32768;
    const unsigned char* bufB = bufA + 16384;
#pragma unroll
    for (int kk = 0; kk < 2; ++kk) {
      bf16x8 At[4], Bt[4];
      const int co = ((kk * 4 + fq) ^ sw) * 16;
#pragma unroll
      for (int m = 0; m < 4; ++m) At[m] = *(const bf16x8*)(bufA + aro + m * 2048 + co);
#pragma unroll
      for (int n = 0; n < 4; ++n) Bt[n] = *(const bf16x8*)(bufB + bro + n * 2048 + co);
#pragma unroll
      for (int m = 0; m < 4; ++m)
#pragma unroll
        for (int n = 0; n < 4; ++n) acc[m][n] = mfma16(Bt[n], At[m], acc[m][n]);
    }
    asm volatile("s_waitcnt vmcnt(0)" ::: "memory");
    hsync();
  }
#undef G128_STAGE
}
DEVI void gemm128p(unsigned char* lds, int K, const bf16_t* Ab, size_t lda, const bf16_t* Bb, size_t ldb, f32x4 (&acc)[4][4], int& par, bool staged, bool has_next, const bf16_t* Abn, const bf16_t* Bbn) {
  const int tid = HTID, wid = tid >> 6, lane = tid & 63, wr = wid >> 1, wc = wid & 1, fr = lane & 15, fq = lane >> 4;
#pragma unroll
  for (int m = 0; m < 4; ++m)
#pragma unroll
    for (int n = 0; n < 4; ++n) acc[m][n] = (f32x4){0.f, 0.f, 0.f, 0.f};
  const int lr = tid >> 3;
  const int chs = ((tid & 7) ^ ((lr >> 1) & 7)) * 8;
  const int sw = (fr >> 1) & 7;
  const int aro = (wr * 64 + fr) * 128, bro = (wc * 64 + fr) * 128;
  const int nk = K >> 6;
  LAS unsigned char* l3 = (LAS unsigned char*)lds;
#define GP_STAGE(buf, kbase, APTR, BPTR)                                                                                             \
  _Pragma("unroll") for (int i = 0; i < 4; ++i) {                                                                                 \
    __builtin_amdgcn_global_load_lds((const __attribute__((address_space(1))) unsigned*)((APTR) + (size_t)(lr + 32 * i) * lda + (kbase) + chs),            \
                                     (LAS unsigned*)(l3 + (buf) * 32768 + tid * 16 + i * 4096), 16, 0, 0);                           \
    __builtin_amdgcn_global_load_lds((const __attribute__((address_space(1))) unsigned*)((BPTR) + (size_t)(lr + 32 * i) * ldb + (kbase) + chs),            \
                                     (LAS unsigned*)(l3 + (buf) * 32768 + 16384 + tid * 16 + i * 4096), 16, 0, 0);                   \
  }
  if (!staged) {
    hsync();
    GP_STAGE(par, 0, Ab, Bb)
    asm volatile("s_waitcnt vmcnt(0)" ::: "memory");
    hsync();
  }
  for (int kt = 0; kt < nk; ++kt) {
    const int cur = (par + kt) & 1;
    { const bool inner = kt + 1 < nk; if (inner || has_next) { const bf16_t* ap_ = inner ? Ab : Abn; const bf16_t* bp_ = inner ? Bb : Bbn; const int kb_ = inner ? (kt + 1) * 64 : 0; GP_STAGE(cur ^ 1, kb_, ap_, bp_) } }
    const unsigned char* bufA = lds + cur * 32768;
    const unsigned char* bufB = bufA + 16384;
#pragma unroll
    for (int kk = 0; kk < 2; ++kk) {
      bf16x8 At[4], Bt[4];
      const int co = ((kk * 4 + fq) ^ sw) * 16;
#pragma unroll
      for (int m = 0; m < 4; ++m) At[m] = *(const bf16x8*)(bufA + aro + m * 2048 + co);
#pragma unroll
      for (int n = 0; n < 4; ++n) Bt[n] = *(const bf16x8*)(bufB + bro + n * 2048 + co);
#pragma unroll
      for (int m = 0; m < 4; ++m)
#pragma unroll
        for (int n = 0; n < 4; ++n) acc[m][n] = mfma16(Bt[n], At[m], acc[m][n]);
    }
    asm volatile("s_waitcnt vmcnt(0)" ::: "memory");
    hsync();
  }
  par = (par + nk) & 1;
#undef GP_STAGE
}
template <class AF, class BF>
DEVI void gemm128h(unsigned char* lds, int K, AF aptr, BF bptr, f32x4 (&acc)[2][4]) {
  const int tid = HTID, wid = tid >> 6, lane = tid & 63, fr = lane & 15, fq = lane >> 4;
#pragma unroll
  for (int m = 0; m < 2; ++m)
#pragma unroll
    for (int n = 0; n < 4; ++n) acc[m][n] = (f32x4){0.f, 0.f, 0.f, 0.f};
  const int lr = tid >> 3;
  const int chs = ((tid & 7) ^ ((lr >> 1) & 7)) * 8;
  const int sw = (fr >> 1) & 7;
  const int aro = (wid * 32 + fr) * 128, bro = fr * 128;
  const int nk = K >> 6;
  LAS unsigned char* l3 = (LAS unsigned char*)lds;
#define GH_STAGE(buf, kbase)                                                                                                     \
  { _Pragma("unroll") for (int i = 0; i < 4; ++i)                                                                                 \
      __builtin_amdgcn_global_load_lds((const __attribute__((address_space(1))) unsigned*)aptr(lr + 32 * i, (kbase) + chs),        \
                                       (LAS unsigned*)(l3 + (buf) * 32768 + tid * 16 + i * 4096), 16, 0, 0);                         \
    _Pragma("unroll") for (int i = 0; i < 2; ++i)                                                                                 \
      __builtin_amdgcn_global_load_lds((const __attribute__((address_space(1))) unsigned*)bptr(lr + 32 * i, (kbase) + chs),        \
                                       (LAS unsigned*)(l3 + (buf) * 32768 + 16384 + tid * 16 + i * 4096), 16, 0, 0); }
  hsync();
  GH_STAGE(0, 0)
  asm volatile("s_waitcnt vmcnt(0)" ::: "memory");
  hsync();
  for (int kt = 0; kt < nk; ++kt) {
    if (kt + 1 < nk) { GH_STAGE((kt + 1) & 1, (kt + 1) * 64) }
    const unsigned char* bufA = lds + (kt & 1) * 32768;
    const unsigned char* bufB = bufA + 16384;
#pragma unroll
    for (int kk = 0; kk < 2; ++kk) {
      bf16x8 At[2], Bt[4];
      const int co = ((kk * 4 + fq) ^ sw) * 16;
#pragma unroll
      for (int m = 0; m < 2; ++m) At[m] = *(const bf16x8*)(bufA + aro + m * 2048 + co);
#pragma unroll
      for (int n = 0; n < 4; ++n) Bt[n] = *(const bf16x8*)(bufB + bro + n * 2048 + co);
#pragma unroll
      for (int m = 0; m < 2; ++m)
#pragma unroll
        for (int n = 0; n < 4; ++n) acc[m][n] = mfma16(Bt[n], At[m], acc[m][n]);
    }
    asm volatile("s_waitcnt vmcnt(0)" ::: "memory");
    hsync();
  }
#undef GH_STAGE
}
#define GEMM_EPI_LOOP(body)                                                                 \
  {                                                                                         \
    const int _tid = HTID, _wid = _tid >> 6, _lane = _tid & 63, _wr = _wid >> 1, _wc = _wid & 1, _fr = _lane & 15, _fq = _lane >> 4; \
    _Pragma("unroll") for (int m = 0; m < 4; ++m) _Pragma("unroll") for (int n = 0; n < 4; ++n) _Pragma("unroll") for (int j = 0; j < 4; ++j) { \
      const int er = _wr * 64 + m * 16 + _fr, ec = _wc * 64 + n * 16 + _fq * 4 + j; const float ev = acc[m][n][j]; body }                      \
  }
#define GEMM_EPI4(body)                                                                     \
  {                                                                                         \
    const int _tid = HTID, _wid = _tid >> 6, _lane = _tid & 63, _wr = _wid >> 1, _wc = _wid & 1, _fr = _lane & 15, _fq = _lane >> 4; \
    _Pragma("unroll") for (int m = 0; m < 4; ++m) _Pragma("unroll") for (int n = 0; n < 4; ++n) {                                             \
      const int er = _wr * 64 + m * 16 + _fr, ec0 = _wc * 64 + n * 16 + _fq * 4; const f32x4 ev4 = acc[m][n]; body }                          \
  }
DEVI f32x4 ld_bf16x4(const bf16_t* p) { const uint2 u = *(const uint2*)p; return (f32x4){__uint_as_float(u.x << 16), __uint_as_float(u.x & 0xffff0000u), __uint_as_float(u.y << 16), __uint_as_float(u.y & 0xffff0000u)}; }
DEVI void st_bf16x4(bf16_t* p, f32x4 v) { uint2 o; o.x = pk2bf(v[0], v[1]); o.y = pk2bf(v[2], v[3]); *(uint2*)p = o; }

namespace pg8 {
#define PG8_LAS __attribute__((address_space(3)))
typedef unsigned short bf16_t;
typedef short bf16x8 __attribute__((ext_vector_type(8)));
typedef float f32x4 __attribute__((ext_vector_type(4)));
typedef unsigned u32x4 __attribute__((ext_vector_type(4)));
constexpr int BM = 256, BK = 64, HALF = 128, HTB = HALF * BK * 2  , STAGE_BYTES = 8 * HTB, NXCD = 8, WGM = 8;

__host__ __device__ __forceinline__ int lds_byte(int r, int c) { const int st = (r >> 4) * 2 + (c >> 5), rr = r & 15, cc = c & 31, ob = rr * 64 + cc * 2; return st * 1024 + (ob ^ (((ob >> 9) & 1) << 5)); }
__host__ __device__ __forceinline__ void stage_rc(int b, int& R, int& C) { const int st = b / 1024, sb = b % 1024, swz = sb ^ (((sb >> 9) & 1) << 5); R = (st >> 1) * 16 + swz / 64; C = (st & 1) * 32 + (swz % 64) / 2; }
__host__ __device__ __forceinline__ int perm32(int rho) { const int n = rho >> 4, i = rho & 15; return 8 * (i >> 2) + 4 * n + (i & 3); }

struct Unit { int pm, pn; };
struct Gemm { const bf16_t* A; const bf16_t* Bt; int M, N, K; };

struct StaticOrder {
    int nM, nN, nwg, G, c;
    __host__ __device__ void init(int M, int N, int G_, int c_) { nM = M / BM; nN = N / BM; nwg = nM * nN; G = G_; c = c_; }
    __host__ __device__ bool next(int i, Unit& u) const {
        const long L = (long)i * G + c; if (L >= nwg) return false;
        int wgid = (int)L; { const int q = nwg / NXCD, r = nwg % NXCD, xcd = wgid % NXCD, off = wgid / NXCD; wgid = (xcd < r ? xcd * (q + 1) : r * (q + 1) + (xcd - r) * q) + off; }
        const int nig = WGM * nN, gid = wgid / nig, fm = gid * WGM, gsz = (nM - fm) < WGM ? (nM - fm) : WGM;
        u.pm = fm + ((wgid % nig) % gsz); u.pn = (wgid % nig) / gsz; return true;
    }
    __device__ __forceinline__ void a_ready(const Unit&) const {}
    __device__ __forceinline__ void done(const Unit&) const {}
};

__device__ __forceinline__ unsigned cvt_pk_bf16(float lo, float hi) { unsigned r; asm volatile("v_cvt_pk_bf16_f32 %0, %1, %2" : "=v"(r) : "v"(lo), "v"(hi)); return r; }
typedef float f32x2 __attribute__((ext_vector_type(2)));
__device__ __forceinline__ f32x2 gelu_pk(f32x2 v) {
    const f32x2 av = __builtin_elementwise_abs(v), d = av * 0.2316418882f + 1.0f;
    f32x2 t; t.x = __builtin_amdgcn_rcpf(d.x); t.y = __builtin_amdgcn_rcpf(d.y);
    f32x2 q = t * 0.5307027145f + (-0.7265760135f); q = q * t + 0.7107068705f; q = q * t + (-0.142248368f); q = q * t + 0.127414796f; q = q * t;
    const f32x2 s = (v * v) * (-0.72134752044f);
    f32x2 e; e.x = __builtin_amdgcn_exp2f(s.x); e.y = __builtin_amdgcn_exp2f(s.y);
    const f32x2 m = v * (q * e), r = v - m;
    f32x2 o; o.x = v.x < 0.f ? m.x : r.x; o.y = v.y < 0.f ? m.y : r.y; return o;
}

template <int ACT  > struct EpiBf16 {
    static constexpr bool PERM = true, AFTER_DRAIN = false; static_assert(ACT == 0 || ACT == 1, "EpiBf16: ACT is 0 (none) or 1 (gelu_pk)");
    bf16_t* O; int ldc; const float* bias; int split_cols; size_t split_stride; float scale0;
    __device__ __forceinline__ void operator()(const f32x4 (&acc)[2][2][4][2], const Unit& u, int wr, int wc, int fr, int fq) const {
        const int row0 = u.pm * BM + wr * 64 + fr; int colt = u.pn * BM; bf16_t* base = O;
        float sc = 1.f; if (split_cols) { const int t = colt / split_cols; base += (size_t)t * split_stride; colt -= t * split_cols; if (t == 0) sc = scale0; }
        const int col0 = colt + wc * 32 + 8 * fq, bcol0 = u.pn * BM + wc * 32 + 8 * fq;
        f32x4 bv[2][2];
#pragma unroll
        for (int bj = 0; bj < 2; ++bj)
#pragma unroll
            for (int n = 0; n < 2; ++n) bv[bj][n] = bias ? *(const f32x4*)(bias + bcol0 + bj * HALF + 4 * n) : (f32x4){0.f, 0.f, 0.f, 0.f};
#pragma unroll
        for (int ai = 0; ai < 2; ++ai)
#pragma unroll
            for (int m = 0; m < 4; ++m) { bf16_t* rowp = base + (size_t)(row0 + ai * HALF + m * 16) * ldc + col0;
#pragma unroll
                for (int bj = 0; bj < 2; ++bj) { f32x4 v0 = acc[ai][bj][m][0] + bv[bj][0], v1 = acc[ai][bj][m][1] + bv[bj][1];
                    if (ACT == 1) { f32x2 a = gelu_pk((f32x2){v0[0], v0[1]}), b = gelu_pk((f32x2){v0[2], v0[3]}), c = gelu_pk((f32x2){v1[0], v1[1]}), d = gelu_pk((f32x2){v1[2], v1[3]});
                        v0 = (f32x4){a.x, a.y, b.x, b.y}; v1 = (f32x4){c.x, c.y, d.x, d.y}; }
                    v0 = v0 * sc; v1 = v1 * sc; u32x4 w; w.x = cvt_pk_bf16(v0[0], v0[1]); w.y = cvt_pk_bf16(v0[2], v0[3]); w.z = cvt_pk_bf16(v1[0], v1[1]); w.w = cvt_pk_bf16(v1[2], v1[3]);
                    *(u32x4*)(rowp + bj * HALF) = w; } }
    }
};

template <class Epi, class Sched, bool ALIGN_EPI = false, bool SP2 = false>
__device__ __forceinline__ void gemm_phase(PG8_LAS unsigned char* lds, const Gemm g, const Sched& S, const Epi& E) {
    const int tid = threadIdx.x, wid = __builtin_amdgcn_readfirstlane(tid >> 6), lane = tid & 63, wr = wid >> 2, wc = wid & 3, fr = lane & 15, fq = lane >> 4;
    const int K = g.K, nt = K / BK;
    unsigned voffA[2], voffB[2];
#pragma unroll
    for (int i = 0; i < 2; ++i) { int R, C; stage_rc(tid * 16 + i * 8192, R, C); const int Rb = Epi::PERM ? ((R & ~31) + perm32(R & 31)) : R;
        voffA[i] = (unsigned)(R * K + C) * 2u; voffB[i] = (unsigned)(Rb * K + C) * 2u; }
    const size_t kstep = (size_t)(BK * 2);
    const size_t hstep = (size_t)HALF * K * 2;
    const size_t tstep = 2 * hstep;
    const unsigned ldsw = (unsigned)wid * 1024u;
    const int aoff = lds_byte(wr * 64 + fr, fq * 8), boff = lds_byte(wc * 32 + fr, fq * 8);
#define PG8_SA(b, h) (((b) * 2 + (h)) * HTB)
#define PG8_SB(b, h) ((4 + (b) * 2 + (h)) * HTB)
#define PG8_STAGE(bufoff, gbase, voff) do { _Pragma("unroll") for (int _i = 0; _i < 2; ++_i) \
        __builtin_amdgcn_global_load_lds((const unsigned*)((const char*)(gbase) + (voff)[_i]), (PG8_LAS unsigned*)(lds + (bufoff) + ldsw + _i * 8192), 16, 0, 0); } while (0)
#define PG8_LDA(dst, b, h) do { _Pragma("unroll") for (int m = 0; m < 4; ++m) _Pragma("unroll") for (int k = 0; k < 2; ++k) dst[m][k] = *(const PG8_LAS bf16x8*)(lds + PG8_SA(b, h) + aoff + m * 2048 + k * 1024); } while (0)
#define PG8_LDB(dst, b, h) do { _Pragma("unroll") for (int n = 0; n < 2; ++n) _Pragma("unroll") for (int k = 0; k < 2; ++k) dst[n][k] = *(const PG8_LAS bf16x8*)(lds + PG8_SB(b, h) + boff + n * 2048 + k * 1024); } while (0)
#define PG8_MMA(ai, bj, At, Bt) do { __builtin_amdgcn_s_setprio(1); _Pragma("unroll") for (int m = 0; m < 4; ++m) _Pragma("unroll") for (int n = 0; n < 2; ++n) _Pragma("unroll") for (int k = 0; k < 2; ++k) \
        acc[ai][bj][m][n] = __builtin_amdgcn_mfma_f32_16x16x32_bf16(Bt[n][k], At[m][k], acc[ai][bj][m][n], 0, 0, 0); __builtin_amdgcn_s_setprio(0); } while (0)
#define PG8_WAIT_V(n) asm volatile("s_waitcnt vmcnt(" #n ")" ::: "memory")
#define PG8_WAIT_L(n) asm volatile("s_waitcnt lgkmcnt(" #n ")" ::: "memory")
#define PG8_BAR __builtin_amdgcn_s_barrier()
#define PG8_SCHED __builtin_amdgcn_sched_barrier(0)
    Unit cur, nxt; int ui = 0;
    if (!S.next(0, cur)) return;
    f32x4 acc[2][2][4][2];
#pragma unroll
    for (int a = 0; a < 2; ++a)
#pragma unroll
        for (int b = 0; b < 2; ++b)
#pragma unroll
            for (int m = 0; m < 4; ++m)
#pragma unroll
                for (int n = 0; n < 2; ++n) acc[a][b][m][n] = (f32x4){0.f, 0.f, 0.f, 0.f};
    bf16x8 At[4][2], B0[2][2], B1[2][2];
    const char* cA = (const char*)g.A + (size_t)cur.pm * tstep; const char* cB = (const char*)g.Bt + (size_t)cur.pn * tstep;
    S.a_ready(cur);
    if constexpr (SP2) {
        PG8_STAGE(PG8_SB(0, 0), cB, voffB); PG8_STAGE(PG8_SB(0, 1), cB + hstep, voffB); PG8_STAGE(PG8_SA(0, 0), cA, voffA); PG8_STAGE(PG8_SA(0, 1), cA + hstep, voffA);
        if (wr == 1) PG8_BAR;
        PG8_WAIT_V(2); PG8_BAR;
        PG8_STAGE(PG8_SB(1, 0), cB + kstep, voffB); PG8_STAGE(PG8_SA(1, 0), cA + kstep, voffA); PG8_STAGE(PG8_SB(1, 1), cB + hstep + kstep, voffB);
        PG8_WAIT_V(6); PG8_BAR;
    } else {
        PG8_STAGE(PG8_SB(0, 0), cB, voffB); PG8_STAGE(PG8_SA(0, 0), cA, voffA); PG8_STAGE(PG8_SB(0, 1), cB + hstep, voffB); PG8_STAGE(PG8_SA(0, 1), cA + hstep, voffA);
        if (wr == 1) PG8_BAR;
        PG8_WAIT_V(4); PG8_BAR;
        PG8_STAGE(PG8_SB(1, 0), cB + kstep, voffB); PG8_STAGE(PG8_SA(1, 0), cA + kstep, voffA); PG8_STAGE(PG8_SB(1, 1), cB + hstep + kstep, voffB);
        PG8_WAIT_V(6); PG8_BAR;
    }
    for (;;) {
        const bool has_next = S.next(ui + 1, nxt);
        const char* nA = has_next ? (const char*)g.A + (size_t)nxt.pm * tstep : cA; const char* nB = has_next ? (const char*)g.Bt + (size_t)nxt.pn * tstep : cB;
        for (int t = 0; t < nt; t += 2) {
            const bool last = (t == nt - 2);
            const char* a1 = cA + (size_t)(t + 1) * kstep;
            const char* a2 = last ? nA : cA + (size_t)(t + 2) * kstep; const char* b2 = last ? nB : cB + (size_t)(t + 2) * kstep;
            const char* a3 = a2 + kstep; const char* b3 = b2 + kstep;
            if (last && has_next) S.a_ready(nxt);
            if constexpr (SP2) {
            PG8_LDB(B0, 0, 0); PG8_LDB(B1, 0, 1); PG8_SCHED; PG8_LDA(At, 0, 0); PG8_STAGE(PG8_SA(1, 1), a1 + hstep, voffA);
            PG8_WAIT_V(8); PG8_WAIT_L(0); PG8_BAR; PG8_MMA(0, 0, At, B0); PG8_MMA(0, 1, At, B1); PG8_BAR; PG8_SCHED;
            PG8_LDA(At, 0, 1); PG8_STAGE(PG8_SB(0, 0), b2, voffB); PG8_STAGE(PG8_SB(0, 1), b2 + hstep, voffB); PG8_STAGE(PG8_SA(0, 0), a2, voffA);
            PG8_WAIT_V(8); PG8_WAIT_L(0); PG8_BAR; PG8_MMA(1, 0, At, B0); PG8_MMA(1, 1, At, B1); PG8_BAR; PG8_SCHED;
            PG8_LDB(B0, 1, 0); PG8_LDB(B1, 1, 1); PG8_SCHED; PG8_LDA(At, 1, 0); PG8_STAGE(PG8_SA(0, 1), a2 + hstep, voffA);
            PG8_WAIT_V(8); PG8_WAIT_L(0); PG8_BAR; PG8_MMA(0, 0, At, B0); PG8_MMA(0, 1, At, B1); PG8_BAR; PG8_SCHED;
            PG8_LDA(At, 1, 1); PG8_STAGE(PG8_SB(1, 0), b3, voffB); PG8_STAGE(PG8_SB(1, 1), b3 + hstep, voffB); PG8_STAGE(PG8_SA(1, 0), a3, voffA);
            PG8_WAIT_V(8); PG8_WAIT_L(0); PG8_BAR; PG8_MMA(1, 0, At, B0); PG8_MMA(1, 1, At, B1); PG8_BAR; PG8_SCHED;
            } else {
            PG8_LDB(B0, 0, 0); PG8_SCHED; PG8_LDA(At, 0, 0); PG8_STAGE(PG8_SA(1, 1), a1 + hstep, voffA);
            PG8_WAIT_L(8); PG8_BAR; PG8_WAIT_L(0); PG8_MMA(0, 0, At, B0); PG8_BAR; PG8_SCHED;
            PG8_LDB(B1, 0, 1); PG8_STAGE(PG8_SB(0, 0), b2, voffB);
            PG8_BAR; PG8_WAIT_L(0); PG8_MMA(0, 1, At, B1); PG8_BAR;
            PG8_LDA(At, 0, 1); PG8_STAGE(PG8_SA(0, 0), a2, voffA);
            PG8_BAR; PG8_WAIT_L(0); PG8_MMA(1, 0, At, B0); PG8_BAR; PG8_SCHED;
            PG8_STAGE(PG8_SB(0, 1), b2 + hstep, voffB);
            PG8_WAIT_V(6); PG8_BAR; PG8_MMA(1, 1, At, B1); PG8_BAR;
            PG8_LDB(B0, 1, 0); PG8_SCHED; PG8_LDA(At, 1, 0); PG8_STAGE(PG8_SA(0, 1), a2 + hstep, voffA);
            PG8_WAIT_L(8); PG8_BAR; PG8_WAIT_L(0); PG8_MMA(0, 0, At, B0); PG8_BAR; PG8_SCHED;
            PG8_LDB(B1, 1, 1); PG8_STAGE(PG8_SB(1, 0), b3, voffB);
            PG8_BAR; PG8_WAIT_L(0); PG8_MMA(0, 1, At, B1); PG8_BAR;
            PG8_LDA(At, 1, 1); PG8_STAGE(PG8_SA(1, 0), a3, voffA);
            PG8_BAR; PG8_WAIT_L(0); PG8_MMA(1, 0, At, B0); PG8_BAR; PG8_SCHED;
            PG8_STAGE(PG8_SB(1, 1), b3 + hstep, voffB);
            PG8_WAIT_V(6); PG8_BAR; PG8_MMA(1, 1, At, B1); PG8_BAR;
            }
        }
        if constexpr (ALIGN_EPI) { if (wr == 0) PG8_BAR; }
        if constexpr (!Epi::AFTER_DRAIN) { E(acc, cur, wr, wc, fr, fq); S.done(cur); }
        if (!has_next) break;
#pragma unroll
        for (int a = 0; a < 2; ++a)
#pragma unroll
            for (int b = 0; b < 2; ++b)
#pragma unroll
                for (int m = 0; m < 4; ++m)
#pragma unroll
                    for (int n = 0; n < 2; ++n) acc[a][b][m][n] = (f32x4){0.f, 0.f, 0.f, 0.f};
        cur = nxt; cA = nA; cB = nB; ++ui;
        if constexpr (ALIGN_EPI) { if (wr == 1) PG8_BAR; }
    }
    PG8_WAIT_V(0);
    if constexpr (!ALIGN_EPI) { if (wr == 0) PG8_BAR; }
    PG8_BAR;
    if constexpr (Epi::AFTER_DRAIN) { E.fused(acc, cur, wr, wc, fr, fq, lds, wid, lane); S.done(cur); }
#undef PG8_SA
#undef PG8_SB
#undef PG8_STAGE
#undef PG8_LDA
#undef PG8_LDB
#undef PG8_MMA
#undef PG8_WAIT_V
#undef PG8_WAIT_L
#undef PG8_BAR
#undef PG8_SCHED
}
}

struct EpiG1 {
  static constexpr bool PERM = false, AFTER_DRAIN = false;
  bf16_t* PROJ; bf16_t* QN; bf16_t* KS; bf16_t* KW; float* SSKV; const float2* RN; const float* g_q; const float* g_k;
  __device__ __forceinline__ void operator()(const pg8::f32x4 (&acc)[2][2][4][2], const pg8::Unit& u, int wr, int wc, int fr, int fq) const {
    const bool t1 = (u.pn == 1), t5 = (u.pn == 5);
#pragma unroll
    for (int ai = 0; ai < 2; ++ai)
#pragma unroll
      for (int m = 0; m < 4; ++m) {
        const size_t t = (size_t)u.pm * 256 + ai * 128 + wr * 64 + m * 16 + fr;
        if (!(t1 || t5) || (t1 && wc < 2)) {
#pragma unroll
          for (int bj = 0; bj < 2; ++bj)
#pragma unroll
            for (int n = 0; n < 2; ++n) st_bf16x4(PROJ + t * DINP + u.pn * 256 + bj * 128 + wc * 32 + n * 16 + fq * 4, acc[ai][bj][m][n]);
        }
        if (t1 || t5) {
          float ss = 0.f;
#pragma unroll
          for (int bj = 0; bj < 2; ++bj)
#pragma unroll
            for (int n = 0; n < 2; ++n) { const pg8::f32x4 v = acc[ai][bj][m][n]; ss += v[0] * v[0] + v[1] * v[1] + v[2] * v[2] + v[3] * v[3]; }
          ss += __shfl_xor(ss, 16); ss += __shfl_xor(ss, 32);
          if (t1 && wc < 2) { if (fq == 0) SSKV[t * 2 + wc] = ss; }
          else {
            const float rs = rsqrtf(ss * (1.f / 64) + EPS);
            const float* gg = t5 ? g_q : (g_k + (wc == 2 ? 64 : 128));
            const float sc = t5 ? (0.125f * LOG2E) : 1.f;
            bf16_t* dst = t5 ? (QN + t * 256 + wc * 64) : ((wc == 2 ? KS : KW) + t * 64);
#pragma unroll
            for (int bj = 0; bj < 2; ++bj)
#pragma unroll
              for (int n = 0; n < 2; ++n) {
                const int e0 = 32 * bj + 16 * n + 4 * fq;
                const float4 g4 = *(const float4*)(gg + e0);
                pg8::f32x4 v = acc[ai][bj][m][n];
                v[0] *= rs * g4.x; v[1] *= rs * g4.y; v[2] *= rs * g4.z; v[3] *= rs * g4.w;
                if (bj == 0 && n == 0) {
#pragma unroll
                  for (int j = 0; j < 4; ++j) {
                    const float x = v[j], partner = __shfl_xor(x, 32);
                    const int d = fq * 4 + j; const float2 cs2 = RN[t * 8 + (d & 7)];
                    v[j] = (d < 8) ? (x * cs2.x - partner * cs2.y) : (partner * cs2.y + x * cs2.x);
                  }
                }
                st_bf16x4(dst + e0, v * sc);
              }
          }
        }
      }
  }
};

template <bool IN16> struct EpiRes {
  static constexpr bool PERM = false, AFTER_DRAIN = false;
  const float* xin; const bf16_t* xin16; bf16_t* out;
  __device__ __forceinline__ void operator()(const pg8::f32x4 (&acc)[2][2][4][2], const pg8::Unit& u, int wr, int wc, int fr, int fq) const {
#pragma unroll
    for (int ai = 0; ai < 2; ++ai)
#pragma unroll
      for (int m = 0; m < 4; ++m) {
        const size_t row = (size_t)u.pm * 256 + ai * 128 + wr * 64 + m * 16 + fr;
#pragma unroll
        for (int bj = 0; bj < 2; ++bj)
#pragma unroll
          for (int n = 0; n < 2; ++n) {
            const size_t o = row * 1024 + u.pn * 256 + bj * 128 + wc * 32 + n * 16 + fq * 4;
            f32x4 xi;
            if constexpr (IN16) { const ushort4 u4 = *(const ushort4*)(xin16 + o); xi = (f32x4){bf2f(u4.x), bf2f(u4.y), bf2f(u4.z), bf2f(u4.w)}; }
            else xi = *(const f32x4*)(xin + o);
            st_bf16x4(out + o, xi + acc[ai][bj][m][n]);
          }
      }
  }
};

DEVI void rmsnorm_rows16(const bf16_t* x, const float* g, bf16_t* xn) {
  const int lane = HTID & 63, gw = VBID * 4 + (HTID >> 6), NGW = VGRID * 4;
  float4 gg[4];
#pragma unroll
  for (int j = 0; j < 2; ++j) { gg[2 * j] = ((const float4*)(g + 512 * j))[2 * lane]; gg[2 * j + 1] = ((const float4*)(g + 512 * j))[2 * lane + 1]; }
  for (int t0 = gw * 4; t0 < T; t0 += NGW * 4) {
    u32x4 v[4][2];
#pragma unroll
    for (int q = 0; q < 4; ++q)
#pragma unroll
      for (int j = 0; j < 2; ++j) v[q][j] = ((const u32x4*)(x + (size_t)(t0 + q) * D + 512 * j))[lane];
#pragma unroll
    for (int q = 0; q < 4; ++q) {
      float s = 0.f;
#pragma unroll
      for (int j = 0; j < 2; ++j)
#pragma unroll
        for (int e = 0; e < 4; ++e) { const float a = __uint_as_float(v[q][j][e] << 16), b = __uint_as_float(v[q][j][e] & 0xffff0000u); s += a * a + b * b; }
      const float rs = rsqrtf(wsum(s) * (1.f / D) + EPS);
#pragma unroll
      for (int j = 0; j < 2; ++j) {
        const float gq[8] = {gg[2 * j].x, gg[2 * j].y, gg[2 * j].z, gg[2 * j].w, gg[2 * j + 1].x, gg[2 * j + 1].y, gg[2 * j + 1].z, gg[2 * j + 1].w};
        u32x4 o;
#pragma unroll
        for (int e = 0; e < 4; ++e) o[e] = pk2bf(__uint_as_float(v[q][j][e] << 16) * rs * gq[2 * e], __uint_as_float(v[q][j][e] & 0xffff0000u) * rs * gq[2 * e + 1]);
        ((u32x4*)(xn + (size_t)(t0 + q) * D + 512 * j))[lane] = o;
      }
    }
  }
}

template <class RM>
DEVI void transpose_tiles(const float* src, int K, int N, bf16_t* dst, int ldk, RM rowmap, unsigned char* lds, int& cursor, const float* kscale = nullptr) {
  float* tl = (float*)lds;
  const int tk = K / 64, tn = (N + 63) / 64, nt = tk * tn;
  const int tid = HTID;
  const int G_ = VGRID;
  for (int it = (VBID - cursor % G_ + G_) % G_; it < nt; it += G_) {
    const int kt = it / tn, ntile = it % tn, k0 = kt * 64, n0 = ntile * 64;
    hsync();
#pragma unroll
    for (int q = 0; q < 4; ++q) {
      const int r = (tid >> 4) + 16 * q, c4 = (tid & 15) * 4;
      const float* sp = src + (size_t)(k0 + r) * N + n0 + c4;
      float4 v;
      if (n0 + c4 + 3 < N) v = *(const float4*)sp;
      else { v.x = (n0 + c4 < N) ? sp[0] : 0.f; v.y = (n0 + c4 + 1 < N) ? sp[1] : 0.f; v.z = (n0 + c4 + 2 < N) ? sp[2] : 0.f; v.w = 0.f; }
      if (kscale) { const float ks = kscale[k0 + r]; v.x *= ks; v.y *= ks; v.z *= ks; v.w *= ks; }
      tl[r * 65 + c4] = v.x; tl[r * 65 + c4 + 1] = v.y; tl[r * 65 + c4 + 2] = v.z; tl[r * 65 + c4 + 3] = v.w;
    }
    hsync();
    const int n = tid >> 2, kc = (tid & 3) * 16;
    if (n0 + n < N) {
      unsigned w[8];
#pragma unroll
      for (int i = 0; i < 8; ++i) w[i] = pk2bf(tl[(kc + 2 * i) * 65 + n], tl[(kc + 2 * i + 1) * 65 + n]);
      uint4* o = (uint4*)(dst + (size_t)rowmap(n0 + n) * ldk + k0 + kc);
      o[0] = make_uint4(w[0], w[1], w[2], w[3]); o[1] = make_uint4(w[4], w[5], w[6], w[7]);
    }
  }
  cursor += nt;
}
DEVI void rmsnorm_rows(const float* x, const float* g, bf16_t* xn) {
  const int lane = HTID & 63, gw = VBID * 4 + (HTID >> 6), NGW = VGRID * 4;
  float4 gg[4];
#pragma unroll
  for (int j = 0; j < 4; ++j) gg[j] = ((const float4*)g)[lane + 64 * j];
  for (int t0 = gw * 4; t0 < T; t0 += NGW * 4) {
    float4 v[4][4];
#pragma unroll
    for (int q = 0; q < 4; ++q)
#pragma unroll
      for (int j = 0; j < 4; ++j) v[q][j] = ((const float4*)(x + (size_t)(t0 + q) * D))[lane + 64 * j];
#pragma unroll
    for (int q = 0; q < 4; ++q) {
      float s = 0.f;
#pragma unroll
      for (int j = 0; j < 4; ++j) s += v[q][j].x * v[q][j].x + v[q][j].y * v[q][j].y + v[q][j].z * v[q][j].z + v[q][j].w * v[q][j].w;
      const float rs = rsqrtf(wsum(s) * (1.f / D) + EPS);
#pragma unroll
      for (int j = 0; j < 4; ++j) {
        uint2 o; o.x = pk2bf(v[q][j].x * rs * gg[j].x, v[q][j].y * rs * gg[j].y); o.y = pk2bf(v[q][j].z * rs * gg[j].z, v[q][j].w * rs * gg[j].w);
        ((uint2*)(xn + (size_t)(t0 + q) * D))[lane + 64 * j] = o;
      }
    }
  }
}
DEVI void phase_prep(const Params& p, unsigned char* lds) {
  const size_t gtid = (size_t)VBID * NTHREADS + HTID, gn = (size_t)VGRID * NTHREADS;
  unsigned char* ws = p.ws;
  if (gtid < 64) ((int*)(ws + SM_CNT))[gtid] = 0;
  auto ident = [](int n) { return n; };
  int cursor = 0;
  for (int l = 0; l < NL; ++l) {
    unsigned char* wl = ws + WS_W + l * WS_WL;
    transpose_tiles(p.in[3] + (size_t)l * D * DIN, D, DIN, (bf16_t*)(wl + W_IN), D, [](int n) { return colmap(n); }, lds, cursor);
    for (size_t i = gtid; i < (size_t)20 * D; i += gn) ((bf16_t*)(wl + W_IN))[(size_t)236 * D + i] = 0;
    transpose_tiles(p.in[36] + (size_t)l * D * D, D, D, (bf16_t*)(wl + W_OUT), D, ident, lds, cursor);
    transpose_tiles(p.in[6] + (size_t)l * 192 * 384, 192, 384, (bf16_t*)(wl + W_UQ), 192, ident, lds, cursor, p.in[4] + l * 192);
    transpose_tiles(p.in[7] + (size_t)l * 128 * 512, 128, 512, (bf16_t*)(wl + W_UKV), 128, ident, lds, cursor, p.in[5] + l * 128);
    transpose_tiles(p.in[25] + (size_t)l * 256 * 256, 256, 256, (bf16_t*)(wl + W_GLU), 256, ident, lds, cursor);
    transpose_tiles(p.in[30] + (size_t)l * 2048 * 128, 2048, 128, (bf16_t*)(wl + W_1K), 2048, ident, lds, cursor);
    transpose_tiles(p.in[33] + (size_t)l * 2048 * 128, 2048, 128, (bf16_t*)(wl + W_1V), 2048, ident, lds, cursor);
    transpose_tiles(p.in[31] + (size_t)l * 128 * 64, 128, 64, (bf16_t*)(wl + W_2K), 128, ident, lds, cursor);
    transpose_tiles(p.in[34] + (size_t)l * 128 * 64, 128, 64, (bf16_t*)(wl + W_2V), 128, ident, lds, cursor);
    for (int h = 0; h < 4; ++h) {
      transpose_tiles(p.in[12] + ((size_t)l * 4 + h) * 64 * 64, 64, 64, (bf16_t*)(wl + W_LRU) + h * 128 * 64, 64, ident, lds, cursor);
      transpose_tiles(p.in[14] + ((size_t)l * 4 + h) * 64 * 64, 64, 64, (bf16_t*)(wl + W_LRU) + h * 128 * 64 + 64 * 64, 64, ident, lds, cursor);
    }
    for (int e = 0; e < 16; ++e) {
      bf16_t* dg = (bf16_t*)(wl + W_GU) + (size_t)e * 512 * 1024;
      transpose_tiles(p.in[42] + ((size_t)l * 16 + e) * 1024 * 256, 1024, 256, dg, 1024, [](int hh) { return (hh >> 6) * 128 + ((hh >> 5) & 1) * 64 + ((hh >> 4) & 1) * 16 + (hh & 15); }, lds, cursor);
      transpose_tiles(p.in[43] + ((size_t)l * 16 + e) * 1024 * 256, 1024, 256, dg, 1024, [](int hh) { return (hh >> 6) * 128 + ((hh >> 5) & 1) * 64 + (((hh >> 4) & 1) + 2) * 16 + (hh & 15); }, lds, cursor);
      transpose_tiles(p.in[44] + ((size_t)l * 16 + e) * 256 * 1024, 256, 1024, (bf16_t*)(wl + W_DN) + (size_t)e * 1024 * 256, 256, ident, lds, cursor);
    }
    {
      const int lane = HTID & 63, gw = VBID * 4 + (HTID >> 6), NGW = VGRID * 4;
      for (int o = gw; o < 256; o += NGW) {
        const int kv = o >> 7, j = o & 127;
        const float* pe = (kv ? p.in[32] : p.in[29]) + (size_t)l * 2048;
        const float* w1 = (kv ? p.in[33] : p.in[30]) + (size_t)l * 2048 * 128;
        float a = 0.f;
#pragma unroll 8
        for (int k = lane; k < 2048; k += 64) a += pe[k] * w1[(size_t)k * 128 + j];
        a = wsum(a);
        if (lane == 0) ((float*)(wl + (kv ? W_B1V : W_B1K)))[j] = a;
      }
    }
    for (size_t i = gtid; i < 16 * 64; i += gn) {
      const int g = (int)(i >> 6), sidx = (int)(i & 63);
      const float are = p.in[17][(size_t)l * 1024 + i], aim = p.in[18][(size_t)l * 1024 + i];
      const float dt = expf(p.in[19][l * 16 + g]);
      const float mag = expf(dt * are);
      float sn, cs; sincosf(dt * aim, &sn, &cs);
      const float abr = mag * cs, abi = mag * sn;
      const float den = are * are + aim * aim, nre = abr - 1.f;
      const float gre = (nre * are + abi * aim) / den, gim = (abi * are - nre * aim) / den;
      ((float2*)(wl + W_S5A))[i] = make_float2(abr, abi);
      float pr = abr, pi = abi;
#pragma unroll
      for (int q = 0; q < 6; ++q) { const float nr = pr * pr - pi * pi, ni = 2.f * pr * pi; pr = nr; pi = ni; }
      ((float2*)(wl + W_S5A64))[i] = make_float2(pr, pi);
      bf16_t* bb = (bf16_t*)(wl + W_S5BB);
      for (int ch = 0; ch < 16; ++ch) {
        const float br = p.in[20][((size_t)l * 1024 + i) * 16 + ch], bi = p.in[21][((size_t)l * 1024 + i) * 16 + ch];
        const float vr = gre * br - gim * bi, vi = gre * bi + gim * br;
        const int sb = sidx >> 5, r = sidx & 31;
        bb[((g * 4 + sb * 2 + 0) * 32 + r) * 16 + ch] = f2bf(vr);
        bb[((g * 4 + sb * 2 + 1) * 32 + r) * 16 + ch] = f2bf(vi);
      }
    }
    for (size_t i = gtid; i < 32 * 1024; i += gn) {
      const int n = (int)(i >> 10), k = (int)(i & 1023);
      float w = 0.f;
      if (n < 20) w = p.in[37][l * D + k] * ((n < 4) ? p.in[38][((size_t)l * D + k) * 4 + n] : p.in[40][((size_t)l * D + k) * 16 + (n - 4)]);
      const bf16_t hi = f2bf(w);
      ((bf16_t*)(wl + W_RTH))[i] = hi; ((bf16_t*)(wl + W_RTL))[i] = f2bf(w - bf2f(hi));
    }
    for (size_t i = gtid; i < 16 * 16 * 64; i += gn) {
      const int g = (int)(i >> 10), ch = (int)((i >> 6) & 15), pp = (int)(i & 63);
      const float cr = p.in[22][(size_t)l * 16384 + i], ci = p.in[23][(size_t)l * 16384 + i];
      bf16_t* cm = (bf16_t*)(wl + W_S5CM) + ((size_t)(g * 16 + ch) * 128 + 2 * pp);
      cm[0] = f2bf(cr); cm[1] = f2bf(-ci);
    }
  }
  {
    const int* positions = (const int*)p.in[1];
    float2* RM = (float2*)(ws + WS_ROPE);
    float2* RN = RM + (size_t)T * 16;
    for (size_t i = gtid; i < (size_t)T * 24; i += gn) {
      const int t = (int)(i / 24), j = (int)(i % 24);
      const int rot = (j < 16) ? 32 : 16, fi = (j < 16) ? j : (j - 16);
      const float inv = powf(500000.f, -(2.f * (float)fi) / (float)rot);
      float sn, cs; sincosf((float)positions[t] * inv, &sn, &cs);
      if (j < 16) RM[(size_t)t * 16 + fi] = make_float2(cs, sn); else RN[(size_t)t * 8 + fi] = make_float2(cs, sn);
    }
  }
  rmsnorm_rows(p.in[0], p.in[2], (bf16_t*)(ws + WS_A));
}

DEVI void phase_g1(const Params& p, int l, unsigned char* lds_full) {
  const bf16_t* XN = (const bf16_t*)(p.ws + WS_A);
  const bf16_t* W = (const bf16_t*)(p.ws + WS_W + l * WS_WL + W_IN);
  bf16_t* QN = (bf16_t*)(p.ws + WS_G);
  pg8::Gemm g{XN, W, T, DINP, D}; pg8::StaticOrder S; S.init(T, DINP, (int)gridDim.x, (int)blockIdx.x);
  EpiG1 E{(bf16_t*)(p.ws + WS_B), QN, QN + (size_t)T * 256, QN + (size_t)T * 320, (float*)(p.ws + SM_SSKV), (const float2*)(p.ws + WS_ROPE) + (size_t)T * 16, p.in[27] + l * 64, p.in[28] + l * 192};
  pg8::gemm_phase<EpiG1, pg8::StaticOrder, true, true>((LAS unsigned char*)lds_full, g, S, E);
}

DEVI void phase_g2(const Params& p, int l, unsigned char* lds) {
  unsigned char* wl = p.ws + WS_W + l * WS_WL;
  const bf16_t* PROJ = (const bf16_t*)(p.ws + WS_B);
  bf16_t* QR = (bf16_t*)(p.ws + WS_D);
  bf16_t* KVR = QR + (size_t)T * 384;
  bf16_t* GATES = (bf16_t*)(p.ws + WS_E);
  bf16_t* MK = (bf16_t*)(p.ws + WS_F) + (size_t)T * 4 * 96;
  const float2* RM = (const float2*)(p.ws + WS_ROPE);
  constexpr int N_CMP = 64, N_QR = 256 * 3, N_KVR = 256 * 4, N_GT = 256 * 4;
  const int tid = HTID, wid = tid >> 6, lane = tid & 63, wr = wid >> 1, wc = wid & 1, fr = lane & 15, fq = lane >> 4;
  for (int it = vblock(); it < N_CMP + N_QR + N_KVR + N_GT; it += VGRID) {
    f32x4 acc[4][4];
    if (it < N_CMP) {
      const int kv = it & 1, half = (it >> 1) & 1, mt = it >> 2;
      const bf16_t* W = (const bf16_t*)(wl + (kv ? W_1V : W_1K)) + (size_t)half * 64 * 2048;
      const float* bias = (const float*)(wl + (kv ? W_B1V : W_B1K)) + half * 64;
      bf16_t* H = (bf16_t*)(p.ws + (kv ? SM_HV : SM_HK)) + half * 64;
      f32x4 acc2[2][4];
      gemm128h(lds, 2048,
              [&](int r, int k) { const int m = mt * 128 + r, b = m >> 7; int c = m & 127; if (c > 126) c = 126;
                                  return PROJ + (size_t)(b * S + 16 * c + (k >> 6)) * DINP + C_KC + kv * 64 + (k & 63); },
              [&](int r, int k) { return W + (size_t)r * 2048 + k; }, acc2);
#pragma unroll
      for (int m = 0; m < 2; ++m)
#pragma unroll
        for (int n = 0; n < 4; ++n) {
          const float4 b4 = *(const float4*)(bias + n * 16 + fq * 4);
          f32x4 o; o[0] = gelu_tanh(acc2[m][n][0] + b4.x); o[1] = gelu_tanh(acc2[m][n][1] + b4.y); o[2] = gelu_tanh(acc2[m][n][2] + b4.z); o[3] = gelu_tanh(acc2[m][n][3] + b4.w);
          st_bf16x4(H + (size_t)(mt * 128 + wid * 32 + m * 16 + fr) * 128 + n * 16 + fq * 4, o);
        }
    } else if (it < N_CMP + N_QR) {
      const int i2 = it - N_CMP, mt = i2 / 3, nt = i2 % 3;
      const bf16_t* W = (const bf16_t*)(wl + W_UQ);
      gemm128g(lds, 192, [&](int r, int k) { return PROJ + (size_t)(mt * 128 + r) * DINP + C_CQ + k; }, [&](int r, int k) { return W + (size_t)(nt * 128 + r) * 192 + k; }, acc);
      GEMM_EPI4({ st_bf16x4(QR + (size_t)(mt * 128 + er) * 384 + nt * 128 + ec0, ev4); })
    } else if (it < N_CMP + N_QR + N_KVR) {
      const int i2 = it - N_CMP - N_QR, mt = i2 >> 2, hd = i2 & 3;
      const bf16_t* W = (const bf16_t*)(wl + W_UKV);
      gemm128g(lds, 128, [&](int r, int k) { return PROJ + (size_t)(mt * 128 + r) * DINP + wgcol(C_T1, k >> 6, k & 63); }, [&](int r, int k) { return W + (size_t)(hd * 128 + r) * 128 + k; }, acc);
      const float* g_k = p.in[9] + l * 96;
#pragma unroll
      for (int m = 0; m < 4; ++m) {
        const size_t t = (size_t)mt * 128 + wr * 64 + m * 16 + fr;
        const int b = (int)(t >> 11), sq = (int)(t & (S - 1));
        const float2 ssp = *(const float2*)((const float*)(p.ws + SM_SSKV) + t * 2);
        const float ss = ssp.x + ssp.y;
        const float rskv = rsqrtf(ss * (1.f / 128) + EPS);
        if (wc == 1) {
#pragma unroll
          for (int n = 0; n < 4; ++n) st_bf16x4(KVR + t * 512 + hd * 128 + 64 + n * 16 + fq * 4, acc[m][n] * rskv);
        } else {
          const uint2 plo = *(const uint2*)(PROJ + t * DINP + C_KPE + 4 * fq), phi = *(const uint2*)(PROJ + t * DINP + C_KPE + 16 + 4 * fq);
          float pl[4] = {__uint_as_float(plo.x << 16), __uint_as_float(plo.x & 0xffff0000u), __uint_as_float(plo.y << 16), __uint_as_float(plo.y & 0xffff0000u)};
          float ph[4] = {__uint_as_float(phi.x << 16), __uint_as_float(phi.x & 0xffff0000u), __uint_as_float(phi.y << 16), __uint_as_float(phi.y & 0xffff0000u)};
          float sk = 0.f;
#pragma unroll
          for (int j = 0; j < 4; ++j) sk += pl[j] * pl[j] + ph[j] * ph[j];
          f32x4 kn[4];
#pragma unroll
          for (int n = 0; n < 4; ++n) { kn[n] = acc[m][n] * rskv; sk += kn[n][0] * kn[n][0] + kn[n][1] * kn[n][1] + kn[n][2] * kn[n][2] + kn[n][3] * kn[n][3]; }
          sk += __shfl_xor(sk, 16); sk += __shfl_xor(sk, 32);
          const float rsk = rsqrtf(sk * (1.f / 96) + EPS);
          bf16_t* dst = MK + ((size_t)(b * 4 + hd) * S + sq) * 96;
          f32x4 olo, ohi;
#pragma unroll
          for (int j = 0; j < 4; ++j) {
            const int d = 4 * fq + j; const float2 cs2 = RM[t * 16 + d];
            const float x1 = pl[j] * rsk * g_k[d], x2 = ph[j] * rsk * g_k[16 + d];
            olo[j] = x1 * cs2.x - x2 * cs2.y; ohi[j] = x1 * cs2.y + x2 * cs2.x;
          }
          st_bf16x4(dst + 4 * fq, olo); st_bf16x4(dst + 16 + 4 * fq, ohi);
#pragma unroll
          for (int n = 0; n < 4; ++n) { const float4 g4 = *(const float4*)(g_k + 32 + n * 16 + fq * 4); f32x4 o = kn[n] * rsk; o[0] *= g4.x; o[1] *= g4.y; o[2] *= g4.z; o[3] *= g4.w; st_bf16x4(dst + 32 + n * 16 + fq * 4, o); }
        }
      }
    } else {
      const int i2 = it - N_CMP - N_QR - N_KVR, mt = i2 >> 2, h = i2 & 3;
      const bf16_t* W = (const bf16_t*)(wl + W_LRU) + h * 128 * 64;
      const int c0 = h * 64 + (tid & 7) * 8;
      const float* cw = p.in[10] + l * 4 * 256 + c0; const float* cbp = p.in[11] + l * 256 + c0;
      gemm128(lds, 64,
              [&](int r, int k) {
                const size_t t = (size_t)mt * 128 + r; const int sq = (int)(t & (S - 1));
                float u[8];
#pragma unroll
                for (int e = 0; e < 8; ++e) u[e] = cbp[e];
#pragma unroll
                for (int j = 0; j < 4; ++j) {
                  if (sq - 3 + j >= 0) {
                    const u32x4 w = *(const u32x4*)(PROJ + (t - 3 + j) * DINP + C_LX + h * 64 + k);
#pragma unroll
                    for (int e = 0; e < 4; ++e) { u[2 * e] += __uint_as_float(w[e] << 16) * cw[j * 256 + 2 * e]; u[2 * e + 1] += __uint_as_float(w[e] & 0xffff0000u) * cw[j * 256 + 2 * e + 1]; }
                  }
                }
                u32x4 o; o[0] = pk2bf(u[0], u[1]); o[1] = pk2bf(u[2], u[3]); o[2] = pk2bf(u[4], u[5]); o[3] = pk2bf(u[6], u[7]);
                return o; },
              [&](int r, int k) { return W + (size_t)r * 64 + k; }, acc);
      GEMM_EPI4({ st_bf16x4(GATES + (size_t)(mt * 128 + er) * 512 + h * 128 + ec0, ev4); })
    }
  }
}

DEVI void lru_ab(float u, float rpre, float ipre, float sp, bool first, float& a, float& b) {
  const float r = sigmoidf_(rpre), gi = sigmoidf_(ipre);
  const float la = -8.f * r * sp;
  a = __expf(la);
  const float x = 2.f * la;
  const float om = (x > -0.1f) ? (-x * (1.f + 0.5f * x * (1.f + (1.f / 3.f) * x * (1.f + 0.25f * x * (1.f + 0.2f * x))))) : (1.f - a * a);
  const float mult = first ? 1.f : sqrtf(fmaxf(om, 0.f));
  b = mult * gi * u;
}
DEVI float lru_conv(const bf16_t* PROJ, int t, int s, int c, const float* cw, float cb) {
  float u = cb;
#pragma unroll
  for (int j = 0; j < 4; ++j) { const int ss2 = s - 3 + j; if (ss2 >= 0) u += bf2f(PROJ[(size_t)(t - 3 + j) * DINP + C_LX + c]) * cw[j * 256 + c]; }
  return u;
}

template <bool FULL>
DEVI void s5_chunk(const Params& p, int l, int b, int chunk, unsigned char* lds) {
  unsigned char* wl = p.ws + WS_W + l * WS_WL;
  const bf16_t* PROJ = (const bf16_t*)(p.ws + WS_B);
  const float2* Abar = (const float2*)(wl + W_S5A);
  const bf16_t* BB = (const bf16_t*)(wl + W_S5BB);
  const bf16_t* CM = (const bf16_t*)(wl + W_S5CM);
  float2* SLOC = (float2*)(p.ws + SM_SLOC);
  bf16_t* YCP = (bf16_t*)(p.ws + WS_F);
  const float* dd = p.in[24] + l * 256;
  const int tid = HTID, wv = tid >> 6, lane = tid & 63, r = lane & 31, h = lane >> 5, fr = lane & 15, fq = lane >> 4;
  unsigned* Hs = (unsigned*)(lds + wv * 8704);
  const int t0 = b * S + chunk * 64;
#pragma unroll 1
  for (int gi = 0; gi < 4; ++gi) {
    const int g = wv * 4 + gi;
    bf16x8 bbf[4];
#pragma unroll
    for (int nb = 0; nb < 4; ++nb) bbf[nb] = *(const bf16x8*)(BB + ((g * 4 + nb) * 32 + r) * 16 + 8 * h);
    float2 Ac[2]; float hr[2], hi[2];
#pragma unroll
    for (int sb = 0; sb < 2; ++sb) {
      Ac[sb] = Abar[g * 64 + sb * 32 + r];
      hr[sb] = 0.f; hi[sb] = 0.f;
      if (FULL) { const float2 cin = ((const float2*)(p.ws + SM_SCAR))[((size_t)(b * 32 + chunk) * 16 + g) * 64 + sb * 32 + r]; hr[sb] = cin.x; hi[sb] = cin.y; }
    }
    bf16x8 cm[4];
    float4 dcol4 = make_float4(0.f, 0.f, 0.f, 0.f);
    if (FULL) {
#pragma unroll
      for (int kk = 0; kk < 4; ++kk) cm[kk] = *(const bf16x8*)(CM + (size_t)(g * 16 + fr) * 128 + kk * 32 + 8 * fq);
      dcol4 = *(const float4*)(dd + g * 16 + 4 * fq);
    }
#pragma unroll 1
    for (int tb = 0; tb < 2; ++tb) {
      const bf16x8 ua = *(const bf16x8*)(PROJ + (size_t)(t0 + tb * 32 + r) * DINP + C_S5 + g * 16 + 8 * h);
      f32x16 acc[4];
#pragma unroll
      for (int nb = 0; nb < 4; ++nb) {
        f32x16 z;
#pragma unroll
        for (int i = 0; i < 16; ++i) z[i] = 0.f;
        acc[nb] = mfma32(ua, bbf[nb], z);
      }
#pragma unroll
      for (int sb = 0; sb < 2; ++sb) {
        float sr = hr[sb], si = hi[sb];
        const float ax = Ac[sb].x, ay = Ac[sb].y;
#pragma unroll
        for (int q = 0; q < 4; ++q)
#pragma unroll
          for (int owner = 0; owner < 2; ++owner) {
#pragma unroll
            for (int i = 0; i < 4; ++i) {
              const int reg = 4 * q + i;
              const float br = acc[2 * sb][reg], bi = acc[2 * sb + 1][reg];
              const float nr = ax * sr - ay * si + br, ni = ax * si + ay * sr + bi; sr = nr; si = ni;
              if (FULL) { acc[2 * sb][reg] = (h == owner) ? sr : br; acc[2 * sb + 1][reg] = (h == owner) ? si : bi; }
            }
            const float orr = __shfl_xor(sr, 32), oi = __shfl_xor(si, 32);
            if (h != owner) { sr = orr; si = oi; }
          }
        hr[sb] = sr; hi[sb] = si;
      }
      if (FULL) {
#pragma unroll
        for (int sb = 0; sb < 2; ++sb)
#pragma unroll
          for (int reg = 0; reg < 16; ++reg)
            Hs[crow(reg, h) * 68 + sb * 32 + r] = pk2bf(acc[2 * sb][reg], acc[2 * sb + 1][reg]);
#pragma unroll
        for (int tb16 = 0; tb16 < 2; ++tb16) {
          f32x4 y = (f32x4){0.f, 0.f, 0.f, 0.f};
#pragma unroll
          for (int kk = 0; kk < 4; ++kk) { const bf16x8 a = *(const bf16x8*)((const bf16_t*)Hs + (tb16 * 16 + fr) * 136 + kk * 32 + 8 * fq); y = mfma16(cm[kk], a, y); }
          const size_t t = (size_t)t0 + tb * 32 + tb16 * 16 + fr; const int col = g * 16 + 4 * fq;
          const uint2 uw = *(const uint2*)(PROJ + t * DINP + C_S5 + col);
          f32x4 o;
          o[0] = gelu_tanh(y[0] + dcol4.x * __uint_as_float(uw.x << 16)); o[1] = gelu_tanh(y[1] + dcol4.y * __uint_as_float(uw.x & 0xffff0000u));
          o[2] = gelu_tanh(y[2] + dcol4.z * __uint_as_float(uw.y << 16)); o[3] = gelu_tanh(y[3] + dcol4.w * __uint_as_float(uw.y & 0xffff0000u));
          st_bf16x4(YCP + t * 256 + col, o);
        }
      }
    }
    if (!FULL) {
#pragma unroll
      for (int sb = 0; sb < 2; ++sb) if (h == 0) SLOC[((size_t)(b * 32 + chunk) * 16 + g) * 64 + sb * 32 + r] = make_float2(hr[sb], hi[sb]);
    }
  }
}

template <bool FULL>
DEVI void lru_chunk(const Params& p, int l, int b, int chunk, float* tile) {
  const bf16_t* PROJ = (const bf16_t*)(p.ws + WS_B);
  const bf16_t* GATES = (const bf16_t*)(p.ws + WS_E);
  float2* LSUM = (float2*)(p.ws + SM_LSUM);
  const int c = HTID, h = c >> 6, j = c & 63;
  const float* cw = p.in[10] + l * 4 * 256;
  const float w0 = cw[c], w1 = cw[256 + c], w2 = cw[512 + c], w3 = cw[768 + c], cb = p.in[11][l * 256 + c];
  const float ba = p.in[13][l * 256 + c], bi = p.in[15][l * 256 + c];
  const float sp = log1pf(expf(-p.in[16][l * 256 + c]));
  const int s0 = chunk * 64; const size_t t0 = (size_t)b * S + s0;
  float xm3 = 0.f, xm2 = 0.f, xm1 = 0.f;
  if (s0 > 0) { xm3 = bf2f(PROJ[(t0 - 3) * DINP + C_LX + c]); xm2 = bf2f(PROJ[(t0 - 2) * DINP + C_LX + c]); xm1 = bf2f(PROJ[(t0 - 1) * DINP + C_LX + c]); }
  float hh = 0.f, ap = 1.f;
  if (FULL) hh = ((const float*)(p.ws + SM_LCAR))[(size_t)(b * 32 + chunk) * 256 + c];
#pragma unroll 1
  for (int k0 = 0; k0 < 64; k0 += 8) {
    float xv[8], rp[8], ip[8], gt[8];
#pragma unroll
    for (int i = 0; i < 8; ++i) {
      const size_t t = t0 + k0 + i;
      xv[i] = bf2f(PROJ[t * DINP + C_LX + c]);
      rp[i] = bf2f(GATES[t * 512 + h * 128 + j]); ip[i] = bf2f(GATES[t * 512 + h * 128 + 64 + j]);
      gt[i] = FULL ? bf2f(PROJ[t * DINP + C_LG + c]) : 0.f;
    }
#pragma unroll
    for (int i = 0; i < 8; ++i) {
      const float u = cb + xm3 * w0 + xm2 * w1 + xm1 * w2 + xv[i] * w3;
      xm3 = xm2; xm2 = xm1; xm1 = xv[i];
      float a, bb; lru_ab(u, rp[i] + ba, ip[i] + bi, sp, (s0 + k0 + i) == 0, a, bb);
      hh = a * hh + bb; ap *= a;
      if (FULL) tile[(k0 + i) * 256 + c] = hh * gelu_tanh(gt[i]);
    }
  }
  if (!FULL) LSUM[(size_t)(b * 32 + chunk) * 256 + c] = make_float2(ap, hh);
}

DEVI void phase_r2(const Params& p, int l, unsigned char* lds) {
  unsigned char* wl = p.ws + WS_W + l * WS_WL;
  const bf16_t* PROJ = (const bf16_t*)(p.ws + WS_B);
  const bf16_t* QR = (const bf16_t*)(p.ws + WS_D);
  const bf16_t* KVR = QR + (size_t)T * 384;
  const bf16_t* GATES = (const bf16_t*)(p.ws + WS_E);
  bf16_t* MQ = (bf16_t*)(p.ws + WS_F);
  bf16_t* MK = MQ + (size_t)T * 4 * 96;
  const float2* RM = (const float2*)(p.ws + WS_ROPE);
  const float2* RN = RM + (size_t)T * 16;
  const int tid = HTID, lane = tid & 63, wv = tid >> 6;
  for (int it = VBID; it < NB * 32; it += VGRID) lru_chunk<false>(p, l, it >> 5, it & 31, nullptr);
  hsync();
  for (int it = VBID; it < NB * 32; it += VGRID) s5_chunk<false>(p, l, it >> 5, it & 31, lds);
  {
    const bf16_t* HK = (const bf16_t*)(p.ws + SM_HK); const bf16_t* HV = (const bf16_t*)(p.ws + SM_HV);
    bf16_t* KC = (bf16_t*)(p.ws + SM_KC); bf16_t* VC = (bf16_t*)(p.ws + SM_VC);
    const bf16_t* W2K = (const bf16_t*)(wl + W_2K); const bf16_t* W2V = (const bf16_t*)(wl + W_2V);
    const float* g0 = p.in[28] + l * 192;
    for (int it = VBID; it < 32; it += VGRID) {
      const int kv = it & 1, mt = it >> 1;
      const bf16_t* H = kv ? HV : HK; const bf16_t* W2 = kv ? W2V : W2K;
      f32x4 acc[4][4];
      hsync();
      gemm128g(lds, 128, [&](int r, int k) { return H + (size_t)(mt * 128 + r) * 128 + k; }, [&](int r, int k) { return W2 + (size_t)(r & 63) * 128 + k; }, acc);
      const int wid = tid >> 6, wr = wid >> 1, wc = wid & 1, fr = lane & 15, fq = lane >> 4;
      if (wc == 0) {
#pragma unroll
        for (int m = 0; m < 4; ++m) {
          const int row = mt * 128 + wr * 64 + m * 16 + fr, b = row >> 7, c = row & 127;
          f32x4 v[4];
#pragma unroll
          for (int n = 0; n < 4; ++n) v[n] = acc[m][n];
          if (kv == 0) {
            float ss = 0.f;
#pragma unroll
            for (int n = 0; n < 4; ++n) ss += v[n][0] * v[n][0] + v[n][1] * v[n][1] + v[n][2] * v[n][2] + v[n][3] * v[n][3];
            ss += __shfl_xor(ss, 16); ss += __shfl_xor(ss, 32);
            const float rs = rsqrtf(ss * (1.f / 64) + EPS);
#pragma unroll
            for (int n = 0; n < 4; ++n) { const float4 gg = *(const float4*)(g0 + n * 16 + fq * 4); v[n][0] *= rs * gg.x; v[n][1] *= rs * gg.y; v[n][2] *= rs * gg.z; v[n][3] *= rs * gg.w; }
            const int cc = (c < 127) ? c : 126;
            const float2* cs = RN + (size_t)(b * S + 16 * cc + 31) * 8;
#pragma unroll
            for (int j = 0; j < 4; ++j) {
              const float x = v[0][j], partner = __shfl_xor(x, 32);
              const int d = fq * 4 + j; const float2 cs2 = cs[d & 7];
              v[0][j] = (d < 8) ? (x * cs2.x - partner * cs2.y) : (partner * cs2.y + x * cs2.x);
            }
          }
          bf16_t* dst = (kv ? VC : KC) + (size_t)row * 64;
#pragma unroll
          for (int n = 0; n < 4; ++n) { f32x4 o = v[n]; if (c >= 127) o = (f32x4){0.f, 0.f, 0.f, 0.f}; st_bf16x4(dst + n * 16 + fq * 4, o); }
        }
      }
    }
  }
}

typedef short v4i16_t __attribute__((ext_vector_type(4)));
DEVI float fexp2(float x) { return __builtin_amdgcn_exp2f(x); }
constexpr int VST = 96;
constexpr int ATT_VBYTES = 64 * VST * 2;
template <int DK> constexpr int att_kbytes() { return 64 * (DK + 8) * 2; }
template <int DK> constexpr int att_buf() { return att_kbytes<DK>() + ATT_VBYTES; }
template <int DK> struct TileRegs { u32x4 k[(64 * DK / 8 + 511) / 512]; u32x4 v; };
template <int DK>
DEVI void tile_load(TileRegs<DK>& tr, const bf16_t* kbase, size_t kstride, const bf16_t* vbase, size_t vstride, int key0, bool withv = true) {
  constexpr int CH = DK / 8, NCH = 64 * CH;
#pragma unroll
  for (int i = 0; i < (NCH + 511) / 512; ++i) { const int c = (int)threadIdx.x + 512 * i; if (c < NCH) { const int r = c / CH, cc = c % CH; tr.k[i] = *(const u32x4*)(kbase + (size_t)(key0 + r) * kstride + cc * 8); } }
  if (withv) { const int c = (int)threadIdx.x, r = c >> 3, cc = c & 7; tr.v = *(const u32x4*)(vbase + (size_t)(key0 + r) * vstride + cc * 8); }
}
template <int DK>
DEVI void tile_store(const TileRegs<DK>& tr, unsigned char* buf, bool withv = true) {
  constexpr int CH = DK / 8, NCH = 64 * CH;
  bf16_t* sK = (bf16_t*)buf; bf16_t* sV = (bf16_t*)(buf + att_kbytes<DK>());
#pragma unroll
  for (int i = 0; i < (NCH + 511) / 512; ++i) { const int c = (int)threadIdx.x + 512 * i; if (c < NCH) { const int r = c / CH, cc = c % CH; *(u32x4*)(sK + r * (DK + 8) + cc * 8) = tr.k[i]; } }
  if (withv) { const int c = (int)threadIdx.x, r = c >> 3, cc = c & 7; *(u32x4*)(sV + r * VST + cc * 8) = tr.v; }
}
template <int DK>
DEVI void qk_tile(const bf16_t* sK, const bf16x8* qf, f32x16& s0, f32x16& s1, int r, int h) {
#pragma unroll
  for (int i = 0; i < 16; ++i) { s0[i] = 0.f; s1[i] = 0.f; }
#pragma unroll
  for (int kk = 0; kk < DK / 16; ++kk) {
    const bf16x8 a0 = *(const bf16x8*)(sK + r * (DK + 8) + kk * 16 + h * 8);
    const bf16x8 a1 = *(const bf16x8*)(sK + (32 + r) * (DK + 8) + kk * 16 + h * 8);
    s0 = mfma32(a0, qf[kk], s0);
    s1 = mfma32(a1, qf[kk], s1);
  }
}
struct FState { f32x16 o0, o1; float m, l; };
DEVI void fstate_init(FState& f) {
#pragma unroll
  for (int i = 0; i < 16; ++i) { f.o0[i] = 0.f; f.o1[i] = 0.f; }
  f.m = -INFINITY; f.l = 0.f;
}
DEVI v4i16_t vtr(const bf16_t* p) { return __builtin_amdgcn_ds_read_tr16_b64_v4i16((LAS v4i16_t*)p); }
DEVI void softmax_pv(FState& f, f32x16& s0, f32x16& s1, const bf16_t* sV, int lane) {
  const int h = lane >> 5;
  float mx = -INFINITY;
#pragma unroll
  for (int i = 0; i < 16; ++i) mx = fmaxf(mx, fmaxf(s0[i], s1[i]));
  mx = fmaxf(mx, __shfl_xor(mx, 32));
  const float mnew = fmaxf(f.m, mx);
  const float muse = (mnew == -INFINITY) ? 0.f : mnew;
  float ps = 0.f;
#pragma unroll
  for (int i = 0; i < 16; ++i) { s0[i] = fexp2(s0[i] - muse); s1[i] = fexp2(s1[i] - muse); ps += s0[i] + s1[i]; }
  ps += __shfl_xor(ps, 32);
  if (__any(mnew != f.m)) {
    const float alpha = fexp2(f.m - muse);
    f.l = f.l * alpha + ps; f.m = mnew;
#pragma unroll
    for (int i = 0; i < 16; ++i) { f.o0[i] *= alpha; f.o1[i] *= alpha; }
  } else {
    f.l += ps;
  }
  const int g = lane >> 4, li = lane & 15, q = li >> 2, pp = li & 3;
  const bf16_t* vb = sV + (4 * h + q) * VST + (g & 1) * 16 + 4 * pp;
#pragma unroll
  for (int kb = 0; kb < 2; ++kb)
#pragma unroll
    for (int s = 0; s < 2; ++s) {
      unsigned pw[4];
#pragma unroll
      for (int j = 0; j < 4; ++j) pw[j] = kb ? pk2bf(s1[8 * s + 2 * j], s1[8 * s + 2 * j + 1]) : pk2bf(s0[8 * s + 2 * j], s0[8 * s + 2 * j + 1]);
      const bf16x8 pb = __builtin_bit_cast(bf16x8, (u32x4){pw[0], pw[1], pw[2], pw[3]});
#pragma unroll
      for (int db = 0; db < 2; ++db) {
        const v4i16_t lo = vtr(vb + (kb * 32 + 16 * s) * VST + db * 32);
        const v4i16_t hi = vtr(vb + (kb * 32 + 16 * s + 8) * VST + db * 32);
        const bf16x8 a = {lo[0], lo[1], lo[2], lo[3], hi[0], hi[1], hi[2], hi[3]};
        if (db == 0) f.o0 = mfma32(a, pb, f.o0); else f.o1 = mfma32(a, pb, f.o1);
      }
    }
}
DEVI void store_o(bf16_t* orow, const f32x16& o0, const f32x16& o1, float sc, int h) {
#pragma unroll
  for (int g = 0; g < 4; ++g) {
    uint2 v0, v1;
    v0.x = pk2bf(o0[4 * g] * sc, o0[4 * g + 1] * sc); v0.y = pk2bf(o0[4 * g + 2] * sc, o0[4 * g + 3] * sc);
    v1.x = pk2bf(o1[4 * g] * sc, o1[4 * g + 1] * sc); v1.y = pk2bf(o1[4 * g + 2] * sc, o1[4 * g + 3] * sc);
    *(uint2*)(orow + 8 * g + 4 * h) = v0;
    *(uint2*)(orow + 32 + 8 * g + 4 * h) = v1;
  }
}

DEVI void mla_item(const Params& p, int l, int b, int hd, int qt, unsigned char* lds) {
  const bf16_t* MQ = (const bf16_t*)(p.ws + WS_F);
  const bf16_t* MK = MQ + (size_t)T * 4 * 96;
  const bf16_t* KVR = (const bf16_t*)(p.ws + WS_D) + (size_t)T * 384;
  bf16_t* YA = (bf16_t*)(p.ws + WS_C);
  const int tid = (int)threadIdx.x, wv = tid >> 6, lane = tid & 63, r = lane & 31, h = lane >> 5;
  const int q0 = qt * 256 + wv * 32, tq = q0 + r;
  bf16x8 qf[6];
  {
    const bf16_t* qrow = (const bf16_t*)(p.ws + WS_D) + ((size_t)b * S + tq) * 384 + hd * 96;
    const float* g_q = p.in[8] + l * 96;
    float qv[6][8]; float ss = 0.f;
#pragma unroll
    for (int kk = 0; kk < 6; ++kk) {
      const u32x4 w = *(const u32x4*)(qrow + kk * 16 + h * 8);
#pragma unroll
      for (int e = 0; e < 4; ++e) { qv[kk][2 * e] = __uint_as_float(w[e] << 16); qv[kk][2 * e + 1] = __uint_as_float(w[e] & 0xffff0000u); ss += qv[kk][2 * e] * qv[kk][2 * e] + qv[kk][2 * e + 1] * qv[kk][2 * e + 1]; }
    }
    ss += __shfl_xor(ss, 32);
    const float rs = rsqrtf(ss * (1.f / 96) + EPS) * (0.10206207261596575f * LOG2E);
#pragma unroll
    for (int kk = 0; kk < 6; ++kk)
#pragma unroll
      for (int j = 0; j < 8; ++j) qv[kk][j] *= rs * g_q[kk * 16 + h * 8 + j];
    const float2* cs = (const float2*)(p.ws + WS_ROPE) + ((size_t)b * S + tq) * 16 + 8 * h;
#pragma unroll
    for (int j = 0; j < 8; ++j) { const float2 c2 = cs[j]; const float x1 = qv[0][j], x2 = qv[1][j]; qv[0][j] = x1 * c2.x - x2 * c2.y; qv[1][j] = x1 * c2.y + x2 * c2.x; }
#pragma unroll
    for (int kk = 0; kk < 6; ++kk) { const u32x4 w = {pk2bf(qv[kk][0], qv[kk][1]), pk2bf(qv[kk][2], qv[kk][3]), pk2bf(qv[kk][4], qv[kk][5]), pk2bf(qv[kk][6], qv[kk][7])}; qf[kk] = __builtin_bit_cast(bf16x8, w); }
  }
  FState f; fstate_init(f);
  const bf16_t* kbase = MK + (size_t)(b * 4 + hd) * S * 96;
  const bf16_t* vbase = KVR + (size_t)b * S * 512 + hd * 128 + 64;
  const int ntiles = 4 * qt + 4;
  TileRegs<96> tr;
  TileRegs<96> tr2;
  tile_load<96>(tr, kbase, 96, vbase, 512, 0);
  tile_load<96>(tr2, kbase, 96, vbase, 512, 64);
  __syncthreads();
  tile_store<96>(tr, lds);
  __syncthreads();
  auto compute = [&](int kt, unsigned char* cur) {
    if (kt * 64 <= q0 + 31) {
      f32x16 s0, s1;
      qk_tile<96>((const bf16_t*)cur, qf, s0, s1, r, h);
      if (kt * 64 + 63 > q0) {
        int rel = tq - kt * 64 - 4 * h; asm volatile("" : "+v"(rel));
#pragma unroll
        for (int i = 0; i < 16; ++i) { const int kk2 = (i & 3) + 8 * (i >> 2); if (kk2 > rel) s0[i] = -INFINITY; if (kk2 + 32 > rel) s1[i] = -INFINITY; }
      }
      softmax_pv(f, s0, s1, (const bf16_t*)(cur + att_kbytes<96>()), lane);
    }
  };
#pragma unroll 1
  for (int kt = 0; kt < ntiles; kt += 2) {
    if (kt + 2 < ntiles) tile_load<96>(tr, kbase, 96, vbase, 512, (kt + 2) * 64);
    compute(kt, lds);
    tile_store<96>(tr2, lds + att_buf<96>());
    __syncthreads();
    if (kt + 3 < ntiles) tile_load<96>(tr2, kbase, 96, vbase, 512, (kt + 3) * 64);
    compute(kt + 1, lds + att_buf<96>());
    if (kt + 2 < ntiles) tile_store<96>(tr, lds);
    __syncthreads();
  }
  store_o(YA + (size_t)(b * S + tq) * 256 + hd * 64, f.o0, f.o1, 1.f / f.l, h);
}

template <class KF, class BODY>
DEVI void nsa_stream(unsigned char* lds, const bf16_t* kbase, size_t kstride, const bf16_t* vbase, size_t vstride, bool withv, int nt, KF key0f, BODY body) {
  if (nt <= 0) return;
  TileRegs<64> trA, trB;
  tile_load<64>(trA, kbase, kstride, vbase, vstride, key0f(0), withv);
  if (nt > 1) tile_load<64>(trB, kbase, kstride, vbase, vstride, key0f(1), withv);
  __syncthreads();
  tile_store<64>(trA, lds, withv);
  __syncthreads();
  unsigned char* buf0 = lds; unsigned char* buf1 = lds + att_buf<64>();
#pragma unroll 1
  for (int i = 0; i < nt; i += 2) {
    if (i + 2 < nt) tile_load<64>(trA, kbase, kstride, vbase, vstride, key0f(i + 2), withv);
    body(i, buf0);
    if (i + 1 < nt) tile_store<64>(trB, buf1, withv);
    __syncthreads();
    if (i + 1 >= nt) break;
    if (i + 3 < nt) tile_load<64>(trB, kbase, kstride, vbase, vstride, key0f(i + 3), withv);
    body(i + 1, buf1);
    if (i + 2 < nt) tile_store<64>(trA, buf0, withv);
    __syncthreads();
  }
}
DEVI void nsa_item(const Params& p, int l, int b, int qt, unsigned char* lds) {
  const bf16_t* PROJ = (const bf16_t*)(p.ws + WS_B);
  const bf16_t* KC = (const bf16_t*)(p.ws + SM_KC) + (size_t)b * 128 * 64;
  const bf16_t* VC = (const bf16_t*)(p.ws + SM_VC) + (size_t)b * 128 * 64;
  const int tid = (int)threadIdx.x, wv = tid >> 6, lane = tid & 63, r = lane & 31, h = lane >> 5;
  float* psum = (float*)(lds + 2 * att_buf<64>());
  unsigned* selm = (unsigned*)(lds + 2 * att_buf<64>() + 32768);
  const int t0 = qt * 64, cur = t0 >> 6;
  const int ql = wv * 8 + (r >> 2), hd = r & 3, tq = t0 + ql;
  const size_t tg = (size_t)b * S + tq;
  bf16x8 qf[4];
#pragma unroll
  for (int kk = 0; kk < 4; ++kk) qf[kk] = *(const bf16x8*)((const bf16_t*)(p.ws + WS_G) + tg * 256 + hd * 64 + kk * 16 + h * 8);
  unsigned* ofs = (unsigned*)psum + wv * 1024 + lane;
  const float g0 = sigmoidf_(bf2f(PROJ[tg * DINP + C_NG + hd * 3 + 0]));
  const float g1 = sigmoidf_(bf2f(PROJ[tg * DINP + C_NG + hd * 3 + 1]));
  const float g2 = sigmoidf_(bf2f(PROJ[tg * DINP + C_NG + hd * 3 + 2]));
  FState f; fstate_init(f);
  const int ncmp = (((t0 + 32) >> 4) >> 6) + 1;
  nsa_stream(lds, KC, 64, VC, 64, true, ncmp, [&](int i) { return i * 64; }, [&](int kt, unsigned char* buf) {
    f32x16 s0, s1;
    qk_tile<64>((const bf16_t*)buf, qf, s0, s1, r, h);
    int rel = ((tq - 31) >> 4) - kt * 64 - 4 * h; asm volatile("" : "+v"(rel));
#pragma unroll
    for (int i = 0; i < 16; ++i) { const int kk2 = (i & 3) + 8 * (i >> 2); if (kk2 > rel) s0[i] = -INFINITY; if (kk2 + 32 > rel) s1[i] = -INFINITY; }
    softmax_pv(f, s0, s1, (const bf16_t*)(buf + att_kbytes<64>()), lane);
  });
  {
    const float muse = (f.m == -INFINITY) ? 0.f : f.m;
    const float il = (f.l > 0.f) ? 1.f / f.l : 0.f;
    if (ncmp < 2) {
#pragma unroll 1
      for (int i = tid; i < 64 * 128; i += KTHREADS) psum[i] = 0.f;
      __syncthreads();
    }
    nsa_stream(lds, KC, 64, VC, 64, false, ncmp, [&](int i) { return i * 64; }, [&](int kt, unsigned char* buf) {
      f32x16 s0, s1;
      qk_tile<64>((const bf16_t*)buf, qf, s0, s1, r, h);
      int rel = ((tq - 31) >> 4) - kt * 64 - 4 * h; asm volatile("" : "+v"(rel));
      int cb0 = kt * 64 + 4 * h; asm volatile("" : "+v"(cb0));
#pragma unroll
      for (int i = 0; i < 16; ++i) {
        const int kk2 = (i & 3) + 8 * (i >> 2); const int c = cb0 + kk2;
        float p0 = (kk2 > rel) ? 0.f : fexp2(s0[i] - muse) * il;
        float p1 = (kk2 + 32 > rel) ? 0.f : fexp2(s1[i] - muse) * il;
        p0 += __shfl_xor(p0, 1); p0 += __shfl_xor(p0, 2);
        p1 += __shfl_xor(p1, 1); p1 += __shfl_xor(p1, 2);
        if (hd == 0) { psum[ql * 128 + c] = p0; psum[ql * 128 + c + 32] = p1; }
      }
    });
  }
  __syncthreads();
#pragma unroll 1
  for (int itq = 0; itq < 4; ++itq) {
    const int q2 = wv * 8 + itq * 2 + (lane >> 5), j = lane & 31;
    const float* ps = psum + q2 * 128;
    float imp = 2.f * (ps[4 * j] + ps[4 * j + 1] + ps[4 * j + 2]) + ps[4 * j + 3];
    if (j > 0) imp += ps[4 * j - 1];
    const bool cand = (j >= 1) && (j <= cur - 2);
    int rank = 0;
    for (int jj = 0; jj < 32; ++jj) {
      const float v = __shfl(imp, (lane & 32) | jj);
      const bool cj = (jj >= 1) && (jj <= cur - 2);
      if (cj && (v > imp || (v == imp && jj < j))) ++rank;
    }
    const bool sel = cand && rank < 2;
    const unsigned long long bal = __ballot(sel);
    unsigned mk = (unsigned)(bal >> (32 * (lane >> 5)));
    mk |= 1u | (1u << cur); if (cur >= 1) mk |= (1u << (cur - 1));
    if (j == 0) selm[q2] = mk;
  }
  __syncthreads();
  unsigned blk_or = 0, wave_or = 0;
  for (int i = 0; i < 64; ++i) blk_or |= selm[i];
  for (int i = 0; i < 8; ++i) wave_or |= selm[wv * 8 + i];
  const unsigned mymask = selm[ql];
  {
    const float sc = (f.l > 0.f) ? g0 / f.l : 0.f;
#pragma unroll
    for (int i = 0; i < 8; ++i) { ofs[i * 64] = pk2bf(f.o0[2 * i] * sc, f.o0[2 * i + 1] * sc); ofs[(8 + i) * 64] = pk2bf(f.o1[2 * i] * sc, f.o1[2 * i + 1] * sc); }
  }
  fstate_init(f);
  {
    unsigned* tl = selm + 64;
    if (tid < 32 && ((blk_or >> tid) & 1u)) tl[__popc(blk_or & ((1u << tid) - 1u))] = tid;
    __syncthreads();
    const int nsel = __popc(blk_or);
    nsa_stream(lds, (const bf16_t*)(p.ws + WS_G) + (size_t)T * 256 + (size_t)b * S * 64, 64, PROJ + (size_t)b * S * DINP + C_VS, DINP, true, nsel,
      [&](int i) { return (int)tl[i] * 64; },
      [&](int i, unsigned char* buf) {
        const int jj = (int)tl[i];
        if ((wave_or >> jj) & 1u) {
          f32x16 s0, s1;
          qk_tile<64>((const bf16_t*)buf, qf, s0, s1, r, h);
          const bool on = (mymask >> jj) & 1u;
          int rel = on ? (tq - jj * 64 - 4 * h) : -1; asm volatile("" : "+v"(rel));
#pragma unroll
          for (int i2 = 0; i2 < 16; ++i2) { const int kk2 = (i2 & 3) + 8 * (i2 >> 2); if (kk2 > rel) s0[i2] = -INFINITY; if (kk2 + 32 > rel) s1[i2] = -INFINITY; }
          softmax_pv(f, s0, s1, (const bf16_t*)(buf + att_kbytes<64>()), lane);
        }
      });
    const float sc = (f.l > 0.f) ? g1 / f.l : 0.f;
#pragma unroll
    for (int i = 0; i < 8; ++i) {
      const unsigned w0 = ofs[i * 64], w1 = ofs[(8 + i) * 64];
      ofs[i * 64] = pk2bf(__uint_as_float(w0 << 16) + f.o0[2 * i] * sc, __uint_as_float(w0 & 0xffff0000u) + f.o0[2 * i + 1] * sc);
      ofs[(8 + i) * 64] = pk2bf(__uint_as_float(w1 << 16) + f.o1[2 * i] * sc, __uint_as_float(w1 & 0xffff0000u) + f.o1[2 * i + 1] * sc);
    }
  }
  fstate_init(f);
  {
    int jlo = (t0 - 511) >> 6; if (jlo < 0) jlo = 0;
    nsa_stream(lds, (const bf16_t*)(p.ws + WS_G) + (size_t)T * 320 + (size_t)b * S * 64, 64, PROJ + (size_t)b * S * DINP + C_VW, DINP, true, cur - jlo + 1,
      [&](int i) { return (jlo + i) * 64; },
      [&](int i, unsigned char* buf) {
        const int j = jlo + i;
        f32x16 s0, s1;
        qk_tile<64>((const bf16_t*)buf, qf, s0, s1, r, h);
        if (j == cur || j * 64 < t0 + 63 - 511 + 64) {
          int rel = tq - j * 64 - 4 * h; asm volatile("" : "+v"(rel));
#pragma unroll
          for (int i2 = 0; i2 < 16; ++i2) {
            const int kk2 = (i2 & 3) + 8 * (i2 >> 2);
            if (kk2 > rel || kk2 < rel - 511) s0[i2] = -INFINITY;
            if (kk2 + 32 > rel || kk2 + 32 < rel - 511) s1[i2] = -INFINITY;
          }
        }
        softmax_pv(f, s0, s1, (const bf16_t*)(buf + att_kbytes<64>()), lane);
      });
    const float sc = (f.l > 0.f) ? g2 / f.l : 0.f;
#pragma unroll
    for (int i = 0; i < 8; ++i) {
      const unsigned w0 = ofs[i * 64], w1 = ofs[(8 + i) * 64];
      f.o0[2 * i] = __uint_as_float(w0 << 16) + f.o0[2 * i] * sc; f.o0[2 * i + 1] = __uint_as_float(w0 & 0xffff0000u) + f.o0[2 * i + 1] * sc;
      f.o1[2 * i] = __uint_as_float(w1 << 16) + f.o1[2 * i] * sc; f.o1[2 * i + 1] = __uint_as_float(w1 & 0xffff0000u) + f.o1[2 * i + 1] * sc;
    }
  }
  f32x16& of0 = f.o0; f32x16& of1 = f.o1;
  {
    float ss = 0.f;
#pragma unroll
    for (int i = 0; i < 16; ++i) ss += of0[i] * of0[i] + of1[i] * of1[i];
    ss += __shfl_xor(ss, 1); ss += __shfl_xor(ss, 2); ss += __shfl_xor(ss, 32);
    const float rs = rsqrtf(ss * (1.f / 256) + EPS);
    const float* on = p.in[35] + l * 1024 + 768 + hd * 64;
#pragma unroll
    for (int g4 = 0; g4 < 4; ++g4) {
      const float4 a = *(const float4*)(on + 8 * g4 + 4 * h), b4 = *(const float4*)(on + 32 + 8 * g4 + 4 * h);
      of0[4 * g4] *= a.x; of0[4 * g4 + 1] *= a.y; of0[4 * g4 + 2] *= a.z; of0[4 * g4 + 3] *= a.w;
      of1[4 * g4] *= b4.x; of1[4 * g4 + 1] *= b4.y; of1[4 * g4 + 2] *= b4.z; of1[4 * g4 + 3] *= b4.w;
    }
    store_o((bf16_t*)(p.ws + WS_A) + tg * 1024 + 768 + hd * 64, of0, of1, rs, h);
  }
}

DEVI void carry_item(const Params& p, int l, int it) {
  const int tid = HTID;
  if (it < 64) {
    const int idx = it * 256 + tid, b = idx >> 10, gs = idx & 1023;
    const float2 a64 = ((const float2*)(p.ws + WS_W + l * WS_WL + W_S5A64))[gs];
    const float2* SLOC = (const float2*)(p.ws + SM_SLOC) + (size_t)b * 32 * 1024 + gs;
    float2* SCAR = (float2*)(p.ws + SM_SCAR) + (size_t)b * 32 * 1024 + gs;
    float hr = 0.f, hi = 0.f;
#pragma unroll 1
    for (int c0 = 0; c0 < 32; c0 += 8) {
      float2 sl[8];
#pragma unroll
      for (int i = 0; i < 8; ++i) sl[i] = SLOC[(size_t)(c0 + i) * 1024];
#pragma unroll
      for (int i = 0; i < 8; ++i) { SCAR[(size_t)(c0 + i) * 1024] = make_float2(hr, hi); const float nr = a64.x * hr - a64.y * hi + sl[i].x, ni = a64.x * hi + a64.y * hr + sl[i].y; hr = nr; hi = ni; }
    }
  } else {
    const int idx = (it - 64) * 256 + tid, b = idx >> 8, c = idx & 255;
    const float2* LSUM = (const float2*)(p.ws + SM_LSUM) + (size_t)b * 32 * 256 + c;
    float* LCAR = (float*)(p.ws + SM_LCAR) + (size_t)b * 32 * 256 + c;
    float hh = 0.f;
#pragma unroll 1
    for (int c0 = 0; c0 < 32; c0 += 8) {
      float2 sv[8];
#pragma unroll
      for (int i = 0; i < 8; ++i) sv[i] = LSUM[(size_t)(c0 + i) * 256];
#pragma unroll
      for (int i = 0; i < 8; ++i) { LCAR[(size_t)(c0 + i) * 256] = hh; hh = sv[i].x * hh + sv[i].y; }
    }
  }
}
DEVI void phase_a1(const Params& p, int l, unsigned char* lds_full) {
  for (int it = VBID; it < 80; it += VGRID) carry_item(p, l, it);
  __syncthreads();
  const int G_ = (int)gridDim.x, bx_ = (int)blockIdx.x, vb_ = (G_ % 8 == 0) ? (bx_ % 8) * (G_ / 8) + bx_ / 8 : bx_;
  for (int rr = 0; rr * G_ < 512; ++rr) { const int j = rr * G_ + ((rr & 1) ? (G_ - 1 - vb_) : vb_); if (j < 512) { const int b = j >> 5, qt = 31 - (j & 31); nsa_item(p, l, b, qt, lds_full); } }
  __syncthreads();
  for (int rr = 0; rr * G_ < 512; ++rr) { const int j = rr * G_ + ((rr & 1) ? (G_ - 1 - vb_) : vb_); if (j < 512) { const int bh = j >> 3, qt = 7 - (j & 7); mla_item(p, l, bh >> 2, bh & 3, qt, lds_full); } }
}

DEVI void phase_r3(const Params& p, int l, unsigned char* lds) {
  bf16_t* Y = (bf16_t*)(p.ws + WS_A);
  const int tid = HTID, lane = tid & 63, wv = tid >> 6;
  {
    const float* onorm = p.in[35] + l * 1024 + 256;
    float* tile = (float*)lds;
    for (int it = VBID; it < NB * 32; it += VGRID) {
      const int b = it >> 5, chunk = it & 31;
      hsync();
      lru_chunk<true>(p, l, b, chunk, tile);
      hsync();
      for (int k = wv; k < 64; k += 4) {
        const float4 v = *(const float4*)(tile + k * 256 + lane * 4);
        const float rs = rsqrtf(wsum(v.x * v.x + v.y * v.y + v.z * v.z + v.w * v.w) * (1.f / 256) + EPS);
        const size_t t = (size_t)b * S + chunk * 64 + k;
        const float4 gg = *(const float4*)(onorm + lane * 4);
        st_bf16x4(Y + t * 1024 + 256 + lane * 4, (f32x4){v.x * rs * gg.x, v.y * rs * gg.y, v.z * rs * gg.z, v.w * rs * gg.w});
      }
    }
  }
  hsync();
  for (int it = VBID; it < NB * 32; it += VGRID) s5_chunk<true>(p, l, it >> 5, it & 31, lds);
}

DEVI void phase_g3(const Params& p, int l, unsigned char* lds) {
  const bf16_t* YCP = (const bf16_t*)(p.ws + WS_F);
  bf16_t* YC = (bf16_t*)(p.ws + WS_F) + (size_t)T * 256;
  const bf16_t* W = (const bf16_t*)(p.ws + WS_W + l * WS_WL + W_GLU);
  const float* bg = p.in[26] + l * 256;
  for (int it = vblock(); it < 256 * 2; it += VGRID) {
    const int mt = it >> 1, nt = it & 1;
    f32x4 acc[4][4];
    gemm128g(lds, 256, [&](int r, int k) { return YCP + (size_t)(mt * 128 + r) * 256 + k; }, [&](int r, int k) { return W + (size_t)(nt * 128 + r) * 256 + k; }, acc);
    GEMM_EPI4({ const size_t o = (size_t)(mt * 128 + er) * 256 + nt * 128 + ec0; const ushort4 yp = *(const ushort4*)(YCP + o); f32x4 r4; r4[0] = bf2f(yp.x) * sigmoidf_(ev4[0] + bg[nt * 128 + ec0]); r4[1] = bf2f(yp.y) * sigmoidf_(ev4[1] + bg[nt * 128 + ec0 + 1]); r4[2] = bf2f(yp.z) * sigmoidf_(ev4[2] + bg[nt * 128 + ec0 + 2]); r4[3] = bf2f(yp.w) * sigmoidf_(ev4[3] + bg[nt * 128 + ec0 + 3]); st_bf16x4(YC + o, r4); })
  }
}

DEVI void phase_r4(const Params& p, int l) {
  const bf16_t* YA = (const bf16_t*)(p.ws + WS_C);
  const bf16_t* YC = (const bf16_t*)(p.ws + WS_F) + (size_t)T * 256;
  bf16_t* Y = (bf16_t*)(p.ws + WS_A);
  const float* onorm = p.in[35] + l * 1024;
  const int lane = HTID & 63, gw = VBID * 4 + (HTID >> 6), NGW = VGRID * 4;
  for (int t = gw; t < T; t += NGW) {
#pragma unroll
    for (int grp = 0; grp < 2; ++grp) {
      const bf16_t* src = (grp == 0 ? YA : YC) + (size_t)t * 256;
      const int gcol = (grp == 0 ? 0 : 512);
      const ushort4 u = ((const ushort4*)src)[lane];
      const float v0 = bf2f(u.x), v1 = bf2f(u.y), v2 = bf2f(u.z), v3 = bf2f(u.w);
      const float rs = rsqrtf(wsum(v0 * v0 + v1 * v1 + v2 * v2 + v3 * v3) * (1.f / 256) + EPS);
      const float4 g = ((const float4*)(onorm + gcol))[lane];
      uint2 o; o.x = pk2bf(v0 * rs * g.x, v1 * rs * g.y); o.y = pk2bf(v2 * rs * g.z, v3 * rs * g.w);
      ((uint2*)(Y + (size_t)t * 1024 + gcol))[lane] = o;
    }
  }
}

DEVI void phase_g4(const Params& p, int l, unsigned char* lds_full) {
  const bf16_t* Y = (const bf16_t*)(p.ws + WS_A);
  const bf16_t* W = (const bf16_t*)(p.ws + WS_W + l * WS_WL + W_OUT);
  pg8::Gemm g{Y, W, T, D, D}; pg8::StaticOrder S; S.init(T, D, (int)gridDim.x, (int)blockIdx.x);
  bf16_t* X1 = (bf16_t*)(p.ws + WS_D);
  if (l == 0) { EpiRes<false> E{p.in[0], nullptr, X1}; pg8::gemm_phase<EpiRes<false>, pg8::StaticOrder, true, true>((LAS unsigned char*)lds_full, g, S, E); }
  else { EpiRes<true> E{nullptr, (const bf16_t*)p.out, X1}; pg8::gemm_phase<EpiRes<true>, pg8::StaticOrder, true, true>((LAS unsigned char*)lds_full, g, S, E); }
}

DEVI void phase_r5(const Params& p, int l, unsigned char* lds) {
  const bf16_t* x1 = (const bf16_t*)(p.ws + WS_D);
  bf16_t* XN = (bf16_t*)(p.ws + WS_A);
  const float* g = p.in[37] + l * D;
  const bf16_t* WH = (const bf16_t*)(p.ws + WS_W + l * WS_WL + W_RTH);
  const bf16_t* WL = (const bf16_t*)(p.ws + WS_W + l * WS_WL + W_RTL);
  const float* brg = p.in[39] + l * 4; const float* bre = p.in[41] + l * 16;
  int* CNT = (int*)(p.ws + SM_CNT) + l * 32;
  int* LIST = (int*)(p.ws + SM_LIST);
  float2* TOKW = (float2*)(p.ws + SM_TOKW);
  const int tid = HTID, lane = tid & 63, wv = tid >> 6, c = lane & 15, q = lane >> 4;
  float* red = (float*)lds;
  int* hist = (int*)(lds + 16384);
  int* tokl = (int*)(lds + 16384 + 256);
  if (tid < 64) hist[tid] = 0;
  int ntok = 0;
  hsync();
  for (int it = VBID; it < T / 16; it += VGRID) {
    const size_t tb = (size_t)it * 16;
    f32x4 a0 = (f32x4){0.f, 0.f, 0.f, 0.f}, a1 = (f32x4){0.f, 0.f, 0.f, 0.f};
    float ss = 0.f;
    const bf16_t* xrow = x1 + (tb + c) * D + wv * 256 + 8 * q;
    const bf16_t* wh0 = WH + (size_t)c * 1024 + wv * 256 + 8 * q;
    const bf16_t* wl0 = WL + (size_t)c * 1024 + wv * 256 + 8 * q;
    u32x4 xk[8];
#pragma unroll
    for (int ks = 0; ks < 8; ++ks) xk[ks] = *(const u32x4*)(xrow + ks * 32);
#pragma unroll
    for (int ks = 0; ks < 8; ++ks) {
      const bf16x8 wh_a = *(const bf16x8*)(wh0 + ks * 32), wl_a = *(const bf16x8*)(wl0 + ks * 32);
      const bf16x8 wh_b = *(const bf16x8*)(wh0 + 16 * 1024 + ks * 32), wl_b = *(const bf16x8*)(wl0 + 16 * 1024 + ks * 32);
#pragma unroll
      for (int j = 0; j < 4; ++j) {
        const float x0 = __uint_as_float(xk[ks][j] << 16), x1v = __uint_as_float(xk[ks][j] & 0xffff0000u);
        ss += x0 * x0 + x1v * x1v;
      }
      const bf16x8 xh = __builtin_bit_cast(bf16x8, xk[ks]);
      a0 = mfma16(wh_a, xh, a0); a0 = mfma16(wl_a, xh, a0);
      a1 = mfma16(wh_b, xh, a1); a1 = mfma16(wl_b, xh, a1);
    }
    ss += __shfl_xor(ss, 16); ss += __shfl_xor(ss, 32);
    hsync();
#pragma unroll
    for (int j = 0; j < 4; ++j) { red[(wv * 9 + j) * 64 + lane] = a0[j]; red[(wv * 9 + 4 + j) * 64 + lane] = a1[j]; }
    red[(wv * 9 + 8) * 64 + lane] = ss;
    hsync();
    const float s2 = red[8 * 64 + lane] + red[(9 + 8) * 64 + lane] + red[(18 + 8) * 64 + lane] + red[(27 + 8) * 64 + lane];
    const float rs = rsqrtf(s2 * (1.f / D) + EPS);
    {
      bf16_t* xo = XN + (tb + c) * D + wv * 256 + 8 * q;
      const float* gp = g + wv * 256 + 8 * q;
#pragma unroll
      for (int ks = 0; ks < 8; ++ks) {
        const float4 g0 = *(const float4*)(gp + ks * 32), g1 = *(const float4*)(gp + ks * 32 + 4);
        u32x4 o;
        const float gq[8] = {g0.x, g0.y, g0.z, g0.w, g1.x, g1.y, g1.z, g1.w};
#pragma unroll
        for (int j = 0; j < 4; ++j) o[j] = pk2bf(__uint_as_float(xk[ks][j] << 16) * rs * gq[2 * j], __uint_as_float(xk[ks][j] & 0xffff0000u) * rs * gq[2 * j + 1]);
        *(u32x4*)(xo + ks * 32) = o;
      }
    }
    if (wv == 0) {
      float c0[4], c1[4];
#pragma unroll
      for (int j = 0; j < 4; ++j) {
        c0[j] = red[j * 64 + lane] + red[(9 + j) * 64 + lane] + red[(18 + j) * 64 + lane] + red[(27 + j) * 64 + lane];
        c1[j] = red[(4 + j) * 64 + lane] + red[(13 + j) * 64 + lane] + red[(22 + j) * 64 + lane] + red[(31 + j) * 64 + lane];
      }
      float lg[20];
#pragma unroll
      for (int qq = 0; qq < 4; ++qq)
#pragma unroll
        for (int j = 0; j < 4; ++j) lg[4 * qq + j] = __shfl(c0[j], c + 16 * qq);
#pragma unroll
      for (int j = 0; j < 4; ++j) lg[16 + j] = __shfl(c1[j], c);
      const int t = (int)tb + c;
      float gl[4];
#pragma unroll
      for (int k2 = 0; k2 < 4; ++k2) gl[k2] = lg[k2] * rs + brg[k2];
      int gi = 0; float gbest = gl[0];
#pragma unroll
      for (int k2 = 1; k2 < 4; ++k2) if (gl[k2] > gbest) { gbest = gl[k2]; gi = k2; }
      float den = 0.f;
#pragma unroll
      for (int k2 = 0; k2 < 4; ++k2) den += expf(gl[k2] - gbest);
      const float pg = 1.f / den;
      float le[4];
#pragma unroll
      for (int k2 = 0; k2 < 4; ++k2) { float sel = 0.f;
#pragma unroll
        for (int gg2 = 0; gg2 < 4; ++gg2) sel = (gi == gg2) ? (lg[4 + gg2 * 4 + k2] * rs + bre[gg2 * 4 + k2]) : sel;
        le[k2] = sel; }
      int i0 = 0; float l0 = le[0];
#pragma unroll
      for (int k2 = 1; k2 < 4; ++k2) if (le[k2] > l0) { l0 = le[k2]; i0 = k2; }
      int i1 = -1; float l1 = -INFINITY;
#pragma unroll
      for (int k2 = 0; k2 < 4; ++k2) if (k2 != i0 && le[k2] > l1) { l1 = le[k2]; i1 = k2; }
      const float e1 = expf(l1 - l0);
      const float w0 = pg / (1.f + e1), w1 = pg * e1 / (1.f + e1);
      const int elo = (i0 < i1) ? i0 : i1, ehi = (i0 < i1) ? i1 : i0;
      const float wlo = (i0 < i1) ? w0 : w1, whi = (i0 < i1) ? w1 : w0;
      const int pidx = (elo == 0) ? (ehi - 1) : ((elo == 1) ? (ehi + 1) : 5);
      const int cls = gi * 6 + pidx;
      if (q == 0) {
        const int rank = atomicAdd(&hist[cls], 1);
        tokl[2 * (ntok + c)] = t; tokl[2 * (ntok + c) + 1] = (cls << 16) | rank;
        TOKW[t] = make_float2(wlo, whi);
      }
    }
    ntok += 16;
  }
  hsync();
  if (tid < 24) { const int n = hist[tid]; hist[32 + tid] = n ? atomicAdd(&CNT[tid], n) : 0; }
  hsync();
  for (int i = tid; i < ntok; i += NTHREADS) { const int t = tokl[2 * i], cr = tokl[2 * i + 1], cls = cr >> 16; LIST[(size_t)cls * T + hist[32 + cls] + (cr & 0xffff)] = t; }
}

struct MoeItem { int cls, mtile, nt, cnt; };
DEVI void moe_prefix(const int* CNT, unsigned char* lds) {
  int* pre = (int*)(lds + LDS_BYTES + 64);
  hsync();
  if (HTID < 24) pre[32 + HTID] = CNT[HTID];
  hsync();
  if (HTID == 0) { int a = 0; for (int c = 0; c < 24; ++c) { pre[c] = a; a += (pre[32 + c] + 127) >> 7; } pre[24] = a; }
  hsync();
}
DEVI bool moe_item(unsigned char* lds, int it, MoeItem& m) {
  const int* pre = (const int*)(lds + LDS_BYTES + 64);
  const int mt = it >> 3; m.nt = it & 7;
  if (mt >= pre[24]) return false;
  int c = 0;
#pragma unroll
  for (int q = 1; q < 24; ++q) c += (mt >= pre[q]) ? 1 : 0;
  m.cls = c; m.mtile = mt - pre[c]; m.cnt = pre[32 + c];
  return true;
}
DEVI void cls_experts(int cls, int& e0, int& e1) {
  const int g = cls / 6, pi = cls % 6;
  const int lo = (pi < 3) ? 0 : ((pi < 5) ? 1 : 2);
  const int hi = (pi < 3) ? (pi + 1) : ((pi < 5) ? (pi - 1) : 3);
  e0 = g * 4 + lo; e1 = g * 4 + hi;
}
DEVI void phase_g5(const Params& p, int l, unsigned char* lds) {
  const bf16_t* XN = (const bf16_t*)(p.ws + WS_A);
  bf16_t* HID = (bf16_t*)(p.ws + WS_B);
  const bf16_t* WGU = (const bf16_t*)(p.ws + WS_W + l * WS_WL + W_GU);
  const int* CNT = (const int*)(p.ws + SM_CNT) + l * 32;
  const int* LIST = (const int*)(p.ws + SM_LIST);
  const float2* TOKW = (const float2*)(p.ws + SM_TOKW);
  moe_prefix(CNT, lds);
  const int G_ = VGRID, total_ = ((const int*)(lds + LDS_BYTES + 64))[24] * 8, full_ = (total_ / G_) * G_, rem_ = total_ - full_;
  for (int it = vblock(); it < full_ + 2 * rem_; it += G_) {
    const bool halfmode = it >= full_; const int half = (it - full_) & 1;
    MoeItem mi; if (!moe_item(lds, halfmode ? full_ + ((it - full_) >> 1) : it, mi)) break;
    int e0, e1; cls_experts(mi.cls, e0, e1);
    const int ex = (mi.nt < 4) ? e0 : e1, ntl = mi.nt & 3;
    const bf16_t* W = WGU + ((size_t)ex * 512 + ntl * 128) * 1024;
    const int* list = LIST + (size_t)mi.cls * T + mi.mtile * 128;
    const int nvalid = mi.cnt - mi.mtile * 128;
    if (halfmode) {
      f32x4 acc2[2][4];
      int tokA[4];
#pragma unroll
      for (int i = 0; i < 4; ++i) { const int r = (HTID >> 3) + 32 * i; tokA[i] = list[(r < nvalid) ? r : 0]; }
      const int tid = HTID, wid = tid >> 6, lane = tid & 63, fr = lane & 15, fq = lane >> 4;
      int tokE2[2]; float twE2[2];
#pragma unroll
      for (int m = 0; m < 2; ++m) { const int er = wid * 32 + m * 16 + fr; tokE2[m] = list[(er < nvalid) ? er : 0]; }
#pragma unroll
      for (int m = 0; m < 2; ++m) { const float2 tw = TOKW[tokE2[m]]; twE2[m] = (mi.nt < 4) ? tw.x : tw.y; }
      const bf16_t* Wh = W + (size_t)half * 64 * 1024;
      gemm128h(lds, D, [&](int r, int k) { const int i = r >> 5; const int tok = (i == 0) ? tokA[0] : (i == 1) ? tokA[1] : (i == 2) ? tokA[2] : tokA[3]; return XN + (size_t)tok * D + k; },
               [&](int r, int k) { return Wh + (size_t)r * D + k; }, acc2);
#pragma unroll
      for (int m = 0; m < 2; ++m) {
        const int er = wid * 32 + m * 16 + fr;
        if (er < nvalid) {
#pragma unroll
          for (int n = 0; n < 2; ++n) {
            f32x4 hv;
#pragma unroll
            for (int j = 0; j < 4; ++j) { const float gt = acc2[m][n][j], up = acc2[m][n + 2][j]; hv[j] = gt * sigmoidf_(gt) * up * twE2[m]; }
            st_bf16x4(HID + (size_t)tokE2[m] * 512 + (mi.nt < 4 ? 0 : 256) + ntl * 64 + half * 32 + n * 16 + fq * 4, hv);
          }
        }
      }
      continue;
    }
    f32x4 acc[4][4];
    int tokA[4], tokE[4]; float twE[4];
#pragma unroll
    for (int i = 0; i < 4; ++i) { const int r = (HTID >> 3) + 32 * i; tokA[i] = list[(r < nvalid) ? r : 0]; }
    {
      const int tid_ = HTID, er0 = ((tid_ >> 6) >> 1) * 64 + (tid_ & 15);
#pragma unroll
      for (int m = 0; m < 4; ++m) { const int er = er0 + m * 16; tokE[m] = list[(er < nvalid) ? er : 0]; }
#pragma unroll
      for (int m = 0; m < 4; ++m) { const float2 tw = TOKW[tokE[m]]; twE[m] = (mi.nt < 4) ? tw.x : tw.y; }
    }
    gemm128g(lds, D, [&](int r, int k) { const int i = r >> 5; const int tok = (i == 0) ? tokA[0] : (i == 1) ? tokA[1] : (i == 2) ? tokA[2] : tokA[3]; return XN + (size_t)tok * D + k; }, [&](int r, int k) { return W + (size_t)r * D + k; }, acc);
    {
      const int tid = HTID, wid = tid >> 6, lane = tid & 63, wr = wid >> 1, wc = wid & 1, fr = lane & 15, fq = lane >> 4;
#pragma unroll
      for (int m = 0; m < 4; ++m) {
        const int er = wr * 64 + m * 16 + fr;
        if (er < nvalid) {
          const int tok = tokE[m];
          const float w = twE[m];
#pragma unroll
          for (int n = 0; n < 2; ++n) {
            f32x4 hv;
#pragma unroll
            for (int j = 0; j < 4; ++j) { const float gt = acc[m][n][j], up = acc[m][n + 2][j]; hv[j] = gt * sigmoidf_(gt) * up * w; }
            const int hh = (mi.nt < 4 ? 0 : 256) + ntl * 64 + wc * 32 + n * 16 + fq * 4;
            st_bf16x4(HID + (size_t)tok * 512 + hh, hv);
          }
        }
      }
    }
  }
}
DEVI void phase_g6(const Params& p, int l, unsigned char* lds) {
  const bf16_t* HID = (const bf16_t*)(p.ws + WS_B);
  const bf16_t* WDN = (const bf16_t*)(p.ws + WS_W + l * WS_WL + W_DN);
  const int* CNT = (const int*)(p.ws + SM_CNT) + l * 32;
  const int* LIST = (const int*)(p.ws + SM_LIST);
  float* out = p.out;
  bf16_t* out16 = (bf16_t*)p.out;
  const bf16_t* X1 = (const bf16_t*)(p.ws + WS_D);
  moe_prefix(CNT, lds);
  const int G_ = VGRID, total_ = ((const int*)(lds + LDS_BYTES + 64))[24] * 8, full_ = (total_ / G_) * G_, rem_ = total_ - full_;
  for (int it = vblock(); it < full_ + 2 * rem_; it += G_) {
    const bool halfmode = it >= full_; const int half = (it - full_) & 1;
    MoeItem mi; if (!moe_item(lds, halfmode ? full_ + ((it - full_) >> 1) : it, mi)) break;
    int e0, e1; cls_experts(mi.cls, e0, e1);
    const int* list = LIST + (size_t)mi.cls * T + mi.mtile * 128;
    const int nvalid = mi.cnt - mi.mtile * 128;
    const bf16_t* W0 = WDN + ((size_t)e0 * 1024 + mi.nt * 128) * 256;
    const bf16_t* W1 = WDN + ((size_t)e1 * 1024 + mi.nt * 128) * 256;
    if (halfmode) {
      f32x4 acc2[2][4];
      int tokA[4];
#pragma unroll
      for (int i = 0; i < 4; ++i) { const int r = (HTID >> 3) + 32 * i; tokA[i] = list[(r < nvalid) ? r : 0]; }
      const int tid = HTID, wid = tid >> 6, lane = tid & 63, fr = lane & 15, fq = lane >> 4;
      int trow2[2];
#pragma unroll
      for (int m = 0; m < 2; ++m) { const int er = wid * 32 + m * 16 + fr; trow2[m] = list[(er < nvalid) ? er : 0]; }
      const bf16_t* W0h = W0 + (size_t)half * 64 * 256; const bf16_t* W1h = W1 + (size_t)half * 64 * 256;
      gemm128h(lds, 512, [&](int r, int k) { const int i = r >> 5; const int tok = (i == 0) ? tokA[0] : (i == 1) ? tokA[1] : (i == 2) ? tokA[2] : tokA[3]; return HID + (size_t)tok * 512 + k; },
               [&](int r, int k) { return ((k < 256) ? W0h : W1h) + (size_t)r * 256 + (k & 255); }, acc2);
#pragma unroll
      for (int m = 0; m < 2; ++m) {
        const int er = wid * 32 + m * 16 + fr;
        if (er < nvalid) {
#pragma unroll
          for (int n = 0; n < 4; ++n) {
            const size_t o = (size_t)trow2[m] * D + mi.nt * 128 + half * 64 + n * 16 + fq * 4;
            const ushort4 u4 = *(const ushort4*)(X1 + o); const f32x4 r4 = (f32x4){bf2f(u4.x), bf2f(u4.y), bf2f(u4.z), bf2f(u4.w)} + acc2[m][n];
            if (l == 0) st_bf16x4(out16 + o, r4); else *(f32x4*)(out + o) = r4;
          }
        }
      }
      continue;
    }
    f32x4 acc[4][4];
    int trow[4], tokA[4];
    {
      const int tid = HTID, wid = tid >> 6, lane = tid & 63, wr = wid >> 1, fr = lane & 15;
#pragma unroll
      for (int i = 0; i < 4; ++i) { const int r = (tid >> 3) + 32 * i; tokA[i] = list[(r < nvalid) ? r : 0]; }
#pragma unroll
      for (int m = 0; m < 4; ++m) { const int er = wr * 64 + m * 16 + fr; trow[m] = list[(er < nvalid) ? er : 0]; }
    }
    gemm128g(lds, 512, [&](int r, int k) { const int i = r >> 5; const int tok = (i == 0) ? tokA[0] : (i == 1) ? tokA[1] : (i == 2) ? tokA[2] : tokA[3]; return HID + (size_t)tok * 512 + k; },
            [&](int r, int k) { return ((k < 256) ? W0 : W1) + (size_t)r * 256 + (k & 255); }, acc);
    GEMM_EPI4({ if (er < nvalid) { const size_t o = (size_t)trow[m] * D + mi.nt * 128 + ec0; const f32x4 r4 = ld_bf16x4(X1 + o) + ev4;
      if (l == 0) st_bf16x4(out16 + o, r4); else *(f32x4*)(out + o) = r4; } })
  }
}


#define XB_TMO      128
#define XB_XCNT(j)  (256  + 64 * (j))
#define XB_XSUB(j)  (1280 + 64 * (j))
#define XB_XGEN(j)  (2304 + 64 * (j))
#define XB_TOP      3328
#define XB_TOPGEN   3392
#define XCD_BAR_WORDS 3456
#define XB_SPIN_CAP (1u << 18)
DEVI unsigned xb_ld(unsigned* p)              { return __hip_atomic_load(p, __ATOMIC_RELAXED, __HIP_MEMORY_SCOPE_AGENT); }
DEVI unsigned xb_add(unsigned* p, unsigned v) { return __hip_atomic_fetch_add(p, v, __ATOMIC_RELAXED, __HIP_MEMORY_SCOPE_AGENT); }
DEVI unsigned xb_xcc_id() { return (unsigned)__builtin_amdgcn_s_getreg((3 << 11) | 20) & 0xFu; }
#define XB_SPIN(cond, bar) do { unsigned _sp = 0; while (cond) { __builtin_amdgcn_s_sleep(1); \
    if ((++_sp & 255u) == 0u) { if (xb_ld(&(bar)[XB_TMO])) break; if (_sp > XB_SPIN_CAP) { atomicAdd(&(bar)[XB_TMO], 1u); break; } } } } while (0)
struct XcdBarrier { unsigned* bar; unsigned x; volatile LAS unsigned* st; };
DEVI XcdBarrier xcd_barrier_post(unsigned* bar, volatile LAS unsigned* st) {
    XcdBarrier b; b.bar = bar; b.x = xb_xcc_id(); b.st = st;
    if (threadIdx.x == 0) (void)xb_add(&bar[XB_XCNT(b.x)], 1u);
    return b;
}
DEVI void xcd_barrier_complete(unsigned* bar, unsigned x, unsigned& nloc, unsigned& nx) {
    const unsigned G = gridDim.x * gridDim.y * gridDim.z;
    unsigned sum, cnt, mine, sp = 0u;
    for (;;) {
        sum = 0u; cnt = 0u; mine = 0u;
#pragma unroll
        for (unsigned j = 0; j < 16; ++j) { const unsigned c = xb_ld(&bar[XB_XCNT(j)]); sum += c; cnt += (c > 0u) ? 1u : 0u; mine = (j == x) ? c : mine; }
        if (sum == G) break;
        __builtin_amdgcn_s_sleep(1);
        if ((++sp & 255u) == 0u) { if (xb_ld(&bar[XB_TMO])) break; if (sp > XB_SPIN_CAP) { atomicAdd(&bar[XB_TMO], 1u); break; } }
    }
    nloc = mine > 0u ? mine : 1u; nx = cnt > 0u ? cnt : 1u;
}
DEVI void xcd_barrier(const XcdBarrier& b) {
    asm volatile("s_waitcnt vmcnt(0)" ::: "memory");
    __syncthreads();
    if (threadIdx.x == 0) {
        unsigned* bar = b.bar;
        __builtin_amdgcn_s_waitcnt(0);
        unsigned nloc = b.st[0], nx = b.st[1];
        if (nloc == 0u) { xcd_barrier_complete(bar, b.x, nloc, nx); b.st[0] = nloc; b.st[1] = nx; }
        const unsigned old = xb_add(&bar[XB_XSUB(b.x)], 1u);
        const unsigned gen = old / nloc;
        if (old + 1u == (gen + 1u) * nloc) {
            __builtin_amdgcn_fence(__ATOMIC_RELEASE, "agent");
            asm volatile("s_waitcnt vmcnt(0)" ::: "memory");
            const unsigned og = xb_add(&bar[XB_TOP], 1u);
            const unsigned tg = og / nx;
            if (og + 1u == (tg + 1u) * nx) xb_add(&bar[XB_TOPGEN], 1u);
            else XB_SPIN(xb_ld(&bar[XB_TOPGEN]) == tg, bar);
            __builtin_amdgcn_fence(__ATOMIC_ACQUIRE, "agent");
            xb_add(&bar[XB_XGEN(b.x)], 1u);
            asm volatile("s_waitcnt vmcnt(0)" ::: "memory");
        } else {
            XB_SPIN(xb_ld(&bar[XB_XGEN(b.x)]) == gen, bar);
            __builtin_amdgcn_fence(__ATOMIC_ACQUIRE, "agent");
            asm volatile("s_waitcnt vmcnt(0)" ::: "memory");
        }
    }
    __syncthreads();
}

#define PH(k, call) { const int _k = (k); if (p.lo <= _k && _k < p.hi) { call; if (_k + 1 < p.hi) { if (_k == 0) grid.sync(); else xcd_barrier(xbar); } } }
__global__ void __launch_bounds__(KTHREADS, 2) hybrid_fwd(Params p) {
  extern __shared__ __attribute__((aligned(16))) unsigned char lds_full[];
  unsigned char* lds = lds_full + hb_() * LDS_HALF;
  cg::grid_group grid = cg::this_grid();
  volatile LAS unsigned* xst = (volatile LAS unsigned*)(LAS unsigned char*)(lds_full + 2 * LDS_HALF);
  if (threadIdx.x < 4) { xst[threadIdx.x] = 0u; g_hs[threadIdx.x] = 0u; }
  __syncthreads();
  XcdBarrier xbar = xcd_barrier_post((unsigned*)(p.ws + WS_CTL), xst);
  PH(0, phase_prep(p, lds))
#define LAYER(l) { \
    PH(1 + 13 * l + 0, phase_g1(p, l, lds_full)) \
    PH(1 + 13 * l + 2, phase_g2(p, l, lds)) \
    PH(1 + 13 * l + 3, phase_r2(p, l, lds)) \
    PH(1 + 13 * l + 4, phase_a1(p, l, lds_full)) \
    PH(1 + 13 * l + 5, phase_r3(p, l, lds)) \
    PH(1 + 13 * l + 6, phase_g3(p, l, lds)) \
    PH(1 + 13 * l + 7, phase_r4(p, l)) \
    PH(1 + 13 * l + 8, phase_g4(p, l, lds_full)) \
    PH(1 + 13 * l + 9, phase_r5(p, l, lds)) \
    PH(1 + 13 * l + 10, phase_g5(p, l, lds)) \
    PH(1 + 13 * l + 11, phase_g6(p, l, lds)) }
  LAYER(0)
  PH(13, rmsnorm_rows16((const bf16_t*)p.out, p.in[2] + D, (bf16_t*)(p.ws + WS_A)))
  LAYER(1)
}

extern "C" void kernel_launch(void* const* d_in, const int* in_sizes, int n_in, void* d_out, int out_size, void* d_ws, size_t ws_size, hipStream_t stream) {
  static int grid_blocks = 0;
  if (!grid_blocks) {
    if (n_in != 45 || ws_size < WS_END) { fprintf(stderr, "kernel_launch: unexpected n_in %d or ws_size %zu (< %zu)\n", n_in, ws_size, (size_t)WS_END); grid_blocks = -1; return; }
    int dev = 0, cus = 0, per_cu = 0;
    hipGetDevice(&dev);
    hipDeviceGetAttribute(&cus, hipDeviceAttributeMultiprocessorCount, dev);
    hipFuncSetAttribute((const void*)hybrid_fwd, hipFuncAttributeMaxDynamicSharedMemorySize, LDS_ALLOC);
    hipOccupancyMaxActiveBlocksPerMultiprocessor(&per_cu, (const void*)hybrid_fwd, KTHREADS, LDS_ALLOC);
    if (per_cu < 1) per_cu = 1;
    if (per_cu > 1) per_cu = 1;
    grid_blocks = cus * per_cu;
    fprintf(stderr, "kernel_launch: cus %d per_cu %d grid %d\n", cus, per_cu, grid_blocks);
  }
  if (grid_blocks < 0) return;
  (void)hipMemsetAsync((unsigned char*)d_ws + WS_CTL, 0, XCD_BAR_WORDS * 4, stream);
  Params p{};
  for (int i = 0; i < 45; ++i) p.in[i] = (const float*)d_in[i];
  p.out = (float*)d_out; p.ws = (unsigned char*)d_ws;
#if N_LAUNCH_MODE == 1
  p.lo = 0; p.hi = NPH;
  { void* args[] = {&p}; hipError_t e = hipLaunchCooperativeKernel((void*)hybrid_fwd, dim3(grid_blocks), dim3(KTHREADS), args, LDS_ALLOC, stream);
    if (e != hipSuccess) fprintf(stderr, "cooperative launch failed: %s\n", hipGetErrorString(e)); }
#else
  for (int ph = 0; ph < NPH; ++ph) {
    p.lo = ph; p.hi = ph + 1;
    void* args[] = {&p}; hipError_t e = hipLaunchCooperativeKernel((void*)hybrid_fwd, dim3(grid_blocks), dim3(KTHREADS), args, LDS_ALLOC, stream);
    if (e != hipSuccess) { fprintf(stderr, "launch %d failed: %s\n", ph, hipGetErrorString(e)); break; }
  }
#endif
}
```

```cpp
#include <hip/hip_runtime.h>
#include <hip/hip_cooperative_groups.h>
#include <cstdio>
#include <cstdint>
namespace cg = cooperative_groups;

#ifndef N_LAUNCH_MODE
#define N_LAUNCH_MODE 1
#endif

#define DEVI __device__ __forceinline__

constexpr int KTHREADS = 512;
__shared__ unsigned g_hs[4];
#define HTID ((int)(threadIdx.x & 255))
__device__ __forceinline__ int hb_() { return __builtin_amdgcn_readfirstlane((int)(threadIdx.x >> 8)); }
#define VBID ((int)blockIdx.x * 2 + hb_())
#define VGRID ((int)gridDim.x * 2)
__device__ __forceinline__ void hsync() {
  asm volatile("s_waitcnt lgkmcnt(0)" ::: "memory");
  if ((threadIdx.x & 63) == 0) {
    unsigned* c = &g_hs[hb_()];
    const unsigned old = __hip_atomic_fetch_add(c, 1u, __ATOMIC_RELAXED, __HIP_MEMORY_SCOPE_WORKGROUP);
    const unsigned target = (old & ~3u) + 4u;
    if (old + 1u != target) {
      while ((int)(__hip_atomic_load(c, __ATOMIC_RELAXED, __HIP_MEMORY_SCOPE_WORKGROUP) - target) < 0) {}
    }
  }
  asm volatile("" ::: "memory");
}
typedef unsigned short bf16_t;
typedef short bf16x8 __attribute__((ext_vector_type(8)));
typedef float f32x4 __attribute__((ext_vector_type(4)));
typedef float f32x16 __attribute__((ext_vector_type(16)));
typedef unsigned u32x4 __attribute__((ext_vector_type(4)));
#define LAS __attribute__((address_space(3)))

constexpr int NB = 16, S = 2048, T = NB * S, D = 1024, DIN = 1772, DINP = 1792, NL = 2;
constexpr int C_CQ = 0, C_KPE = 192, C_NG = 224, C_T1 = 256, C_LX = 512, C_LG = 768, C_S5 = 1024, C_T5 = 1280, C_KC = 1536, C_VC = 1600, C_VS = 1664, C_VW = 1728;
__host__ __device__ constexpr int wgcol(int tile0, int wc, int e) { return tile0 + 128 * (e >> 5) + 32 * wc + (e & 31); }
__host__ __device__ constexpr int colmap(int n) {
  if (n < 192) return n;
  if (n < 320) { const int k = n - 192; return wgcol(C_T1, k >> 6, k & 63); }
  if (n < 352) return C_KPE + (n - 320);
  if (n < 608) return C_LX + (n - 352);
  if (n < 864) return C_LG + (n - 608);
  if (n < 1120) return C_S5 + (n - 864);
  if (n < 1376) { const int q = n - 1120; return wgcol(C_T5, q >> 6, q & 63); }
  if (n < 1760) { const int j = n - 1376, part = j >> 6, d = j & 63;
    return part == 0 ? C_KC + d : part == 1 ? C_VC + d : part == 2 ? wgcol(C_T1, 2, d) : part == 3 ? C_VS + d : part == 4 ? wgcol(C_T1, 3, d) : C_VW + d; }
  return C_NG + (n - 1760);
}
constexpr float EPS = 1e-6f;
constexpr float LOG2E = 1.4426950408889634f;
constexpr int NTHREADS = 256;
constexpr int NPH = 1 + 13 * NL - 1;

constexpr size_t MiB = 1u << 20;
constexpr size_t WS_CTL = 0;
constexpr size_t WS_SMALL = 1 * MiB;
constexpr size_t WS_W = 16 * MiB;
constexpr size_t WS_WL = 32 * MiB;
constexpr size_t WS_A = 80 * MiB;
constexpr size_t WS_B = 144 * MiB;
constexpr size_t WS_C = 256 * MiB;
constexpr size_t WS_D = 292 * MiB;
constexpr size_t WS_E = 348 * MiB;
constexpr size_t WS_F = 380 * MiB;
constexpr size_t WS_G = 428 * MiB;
constexpr size_t WS_ROPE = 452 * MiB;
constexpr size_t WS_END = 460 * MiB;
constexpr size_t W_IN = 0;
constexpr size_t W_OUT = 4 * MiB;
constexpr size_t W_UQ = 6 * MiB;
constexpr size_t W_UKV = W_UQ + 384 * 192 * 2;
constexpr size_t W_LRU = W_UKV + 512 * 128 * 2;
constexpr size_t W_GLU = W_LRU + 4 * 128 * 64 * 2;
constexpr size_t W_1K = 6 * MiB + 512 * 1024;
constexpr size_t W_1V = W_1K + 128 * 2048 * 2;
constexpr size_t W_B1K = W_1V + 128 * 2048 * 2;
constexpr size_t W_B1V = W_B1K + 512;
constexpr size_t W_S5A = W_B1V + 512;
constexpr size_t W_S5A64 = W_S5A + 16 * 64 * 8;
constexpr size_t W_S5B = W_S5A64 + 16 * 64 * 8;
constexpr size_t W_S5BB = W_S5B + 16 * 64 * 16 * 8;
constexpr size_t W_S5CM = W_S5BB + 16 * 4 * 32 * 16 * 2;
constexpr size_t W_2K = W_S5CM + 16 * 16 * 128 * 2;
constexpr size_t W_2V = W_2K + 64 * 128 * 2;
static_assert(W_2V + 64 * 128 * 2 <= 8 * MiB, "weights overflow");
constexpr size_t W_RTH = W_2V + 64 * 128 * 2;
constexpr size_t W_RTL = W_RTH + 32 * 1024 * 2;
static_assert(W_RTL + 32 * 1024 * 2 <= 8 * MiB, "weights overflow 2");
constexpr size_t W_GU = 8 * MiB;
constexpr size_t W_DN = 24 * MiB;
constexpr size_t SM_CNT = WS_SMALL;
constexpr size_t SM_LIST = WS_SMALL + 4096;
constexpr size_t SM_TOKW = SM_LIST + 24 * (size_t)T * 4;
constexpr size_t SM_LSUM = SM_TOKW + (size_t)T * 16;
constexpr size_t SM_SLOC = SM_LSUM + 16 * 32 * 256 * 8;
constexpr size_t SM_HK = SM_SLOC + 16 * 32 * 1024 * 8;
constexpr size_t SM_HV = SM_HK + 2048 * 128 * 2;
constexpr size_t SM_KC = SM_HV + 2048 * 128 * 2;
constexpr size_t SM_VC = SM_KC + 16 * 128 * 64 * 2;
constexpr size_t SM_SCAR = SM_VC + 16 * 128 * 64 * 2;
constexpr size_t SM_LCAR = SM_SCAR + 16 * 32 * 1024 * 8;
constexpr size_t SM_SSKV = SM_LCAR + 16 * 32 * 256 * 4;
constexpr size_t SM_END = SM_SSKV + (size_t)T * 2 * 4;
static_assert(SM_END <= WS_W, "small region overflow");

constexpr int LDS_BYTES = 65536;
constexpr int LDS_HALF = LDS_BYTES + 512;
constexpr int LDS_ALLOC = 2 * LDS_HALF + 64;

struct Params {
  const float* in[45];
  float* out;
  unsigned char* ws;
  int lo, hi;
};

DEVI float bf2f(bf16_t v) { return __uint_as_float(((unsigned)v) << 16); }
DEVI bf16_t f2bf(float f) { unsigned u = __float_as_uint(f); return (bf16_t)((u + 0x7fffu + ((u >> 16) & 1u)) >> 16); }
DEVI float wsum(float v) {
#pragma unroll
  for (int o = 32; o >= 1; o >>= 1) v += __shfl_xor(v, o);
  return v;
}
DEVI float sigmoidf_(float x) { return __builtin_amdgcn_rcpf(1.f + __expf(-x)); }
DEVI float gelu_tanh(float x) { const float u2 = 1.5957691216057308f * (x + 0.044715f * x * x * x); return x * __builtin_amdgcn_rcpf(1.f + __expf(-u2)); }
DEVI f32x16 mfma32(bf16x8 a, bf16x8 b, f32x16 c) { return __builtin_amdgcn_mfma_f32_32x32x16_bf16(a, b, c, 0, 0, 0); }
DEVI f32x4 mfma16(bf16x8 a, bf16x8 b, f32x4 c) { return __builtin_amdgcn_mfma_f32_16x16x32_bf16(a, b, c, 0, 0, 0); }
DEVI int vblock() { const int bx = (int)blockIdx.x, GB = (int)gridDim.x; return (GB % 8 == 0) ? (bx % 8) * (GB / 8) * 2 + (bx / 8) * 2 + hb_() : VBID; }
DEVI int crow(int r, int h) { return (r & 3) + 8 * (r >> 2) + 4 * h; }
typedef __bf16 bf16x2_t __attribute__((ext_vector_type(2)));
typedef float f32x2_t __attribute__((ext_vector_type(2)));
DEVI unsigned pk2bf(float lo, float hi) { f32x2_t v = {lo, hi}; bf16x2_t b = __builtin_convertvector(v, bf16x2_t); return __builtin_bit_cast(unsigned, b); }

template <class AF, class BF>
DEVI void gemm128(unsigned char* lds, int K, AF aload, BF bptr, f32x4 (&acc)[4][4]) {
  const int tid = HTID, wid = tid >> 6, lane = tid & 63, wr = wid >> 1, wc = wid & 1, fr = lane & 15, fq = lane >> 4;
#pragma unroll
  for (int m = 0; m < 4; ++m)
#pragma unroll
    for (int n = 0; n < 4; ++n) acc[m][n] = (f32x4){0.f, 0.f, 0.f, 0.f};
  const int lr = tid >> 3, ch = tid & 7;
  const int wofs = lr * 128 + ((ch ^ ((lr >> 1) & 7)) * 16);
  const int sw = (fr >> 1) & 7;
  const int aro = (wr * 64 + fr) * 128, bro = (wc * 64 + fr) * 128;
  const int nk = K >> 6;
  u32x4 ra[4], rb[4];
#pragma unroll
  for (int i = 0; i < 4; ++i) { ra[i] = aload(lr + 32 * i, ch * 8); rb[i] = *(const u32x4*)bptr(lr + 32 * i, ch * 8); }
  hsync();
#pragma unroll
  for (int i = 0; i < 4; ++i) { *(u32x4*)(lds + wofs + i * 4096) = ra[i]; *(u32x4*)(lds + 16384 + wofs + i * 4096) = rb[i]; }
  hsync();
  for (int kt = 0; kt < nk; ++kt) {
    const bool more = (kt + 1 < nk);
    if (more) {
      const int k = (kt + 1) * 64 + ch * 8;
#pragma unroll
      for (int i = 0; i < 4; ++i) { ra[i] = aload(lr + 32 * i, k); rb[i] = *(const u32x4*)bptr(lr + 32 * i, k); }
    }
    const unsigned char* bufA = lds + (kt & 1) * 32768;
    const unsigned char* bufB = bufA + 16384;
#pragma unroll
    for (int kk = 0; kk < 2; ++kk) {
      bf16x8 At[4], Bt[4];
      const int co = ((kk * 4 + fq) ^ sw) * 16;
#pragma unroll
      for (int m = 0; m < 4; ++m) At[m] = *(const bf16x8*)(bufA + aro + m * 2048 + co);
#pragma unroll
      for (int n = 0; n < 4; ++n) Bt[n] = *(const bf16x8*)(bufB + bro + n * 2048 + co);
#pragma unroll
      for (int m = 0; m < 4; ++m)
#pragma unroll
        for (int n = 0; n < 4; ++n) acc[m][n] = mfma16(Bt[n], At[m], acc[m][n]);
    }
    if (more) {
      unsigned char* nb = lds + ((kt + 1) & 1) * 32768;
#pragma unroll
      for (int i = 0; i < 4; ++i) { *(u32x4*)(nb + wofs + i * 4096) = ra[i]; *(u32x4*)(nb + 16384 + wofs + i * 4096) = rb[i]; }
    }
    hsync();
  }
}
template <class AF, class BF>
DEVI void gemm128g(unsigned char* lds, int K, AF aptr, BF bptr, f32x4 (&acc)[4][4]) {
  const int tid = HTID, wid = tid >> 6, lane = tid & 63, wr = wid >> 1, wc = wid & 1, fr = lane & 15, fq = lane >> 4;
#pragma unroll
  for (int m = 0; m < 4; ++m)
#pragma unroll
    for (int n = 0; n < 4; ++n) acc[m][n] = (f32x4){0.f, 0.f, 0.f, 0.f};
  const int lr = tid >> 3;
  const int chs = ((tid & 7) ^ ((lr >> 1) & 7)) * 8;
  const int sw = (fr >> 1) & 7;
  const int aro = (wr * 64 + fr) * 128, bro = (wc * 64 + fr) * 128;
  const int nk = K >> 6;
  LAS unsigned char* l3 = (LAS unsigned char*)lds;
#define G128_STAGE(buf, kbase)                                                                                                   \
  _Pragma("unroll") for (int i = 0; i < 4; ++i) {                                                                                 \
    __builtin_amdgcn_global_load_lds((const __attribute__((address_space(1))) unsigned*)aptr(lr + 32 * i, (kbase) + chs),          \
                                     (LAS unsigned*)(l3 + (buf) * 32768 + tid * 16 + i * 4096), 16, 0, 0);                           \
    __builtin_amdgcn_global_load_lds((const __attribute__((address_space(1))) unsigned*)bptr(lr + 32 * i, (kbase) + chs),          \
                                     (LAS unsigned*)(l3 + (buf) * 32768 + 16384 + tid * 16 + i * 4096), 16, 0, 0);                   \
  }
  hsync();
  G128_STAGE(0, 0)
  asm volatile("s_waitcnt vmcnt(0)" ::: "memory");
  hsync();
  for (int kt = 0; kt < nk; ++kt) {
    if (kt + 1 < nk) { G128_STAGE((kt + 1) & 1, (kt + 1) * 64) }
    const unsigned char* bufA = lds + (kt & 1) * 32768;
    const unsigned char* bufB = bufA + 16384;
#pragma unroll
    for (int kk = 0; kk < 2; ++kk) {
      bf16x8 At[4], Bt[4];
      const int co = ((kk * 4 + fq) ^ sw) * 16;
#pragma unroll
      for (int m = 0; m < 4; ++m) At[m] = *(const bf16x8*)(bufA + aro + m * 2048 + co);
#pragma unroll
      for (int n = 0; n < 4; ++n) Bt[n] = *(const bf16x8*)(bufB + bro + n * 2048 + co);
#pragma unroll
      for (int m = 0; m < 4; ++m)
#pragma unroll
        for (int n = 0; n < 4; ++n) acc[m][n] = mfma16(Bt[n], At[m], acc[m][n]);
    }
    asm volatile("s_waitcnt vmcnt(0)" ::: "memory");
    hsync();
  }
#undef G128_STAGE
}
DEVI void gemm128p(unsigned char* lds, int K, const bf16_t* Ab, size_t lda, const bf16_t* Bb, size_t ldb, f32x4 (&acc)[4][4], int& par, bool staged, bool has_next, const bf16_t* Abn, const bf16_t* Bbn) {
  const int tid = HTID, wid = tid >> 6, lane = tid & 63, wr = wid >> 1, wc = wid & 1, fr = lane & 15, fq = lane >> 4;
#pragma unroll
  for (int m = 0; m < 4; ++m)
#pragma unroll
    for (int n = 0; n < 4; ++n) acc[m][n] = (f32x4){0.f, 0.f, 0.f, 0.f};
  const int lr = tid >> 3;
  const int chs = ((tid & 7) ^ ((lr >> 1) & 7)) * 8;
  const int sw = (fr >> 1) & 7;
  const int aro = (wr * 64 + fr) * 128, bro = (wc * 64 + fr) * 128;
  const int nk = K >> 6;
  LAS unsigned char* l3 = (LAS unsigned char*)lds;
#define GP_STAGE(buf, kbase, APTR, BPTR)                                                                                             \
  _Pragma("unroll") for (int i = 0; i < 4; ++i) {                                                                                 \
    __builtin_amdgcn_global_load_lds((const __attribute__((address_space(1))) unsigned*)((APTR) + (size_t)(lr + 32 * i) * lda + (kbase) + chs),            \
                                     (LAS unsigned*)(l3 + (buf) * 32768 + tid * 16 + i * 4096), 16, 0, 0);                           \
    __builtin_amdgcn_global_load_lds((const __attribute__((address_space(1))) unsigned*)((BPTR) + (size_t)(lr + 32 * i) * ldb + (kbase) + chs),            \
                                     (LAS unsigned*)(l3 + (buf) * 32768 + 16384 + tid * 16 + i * 4096), 16, 0, 0);                   \
  }
  if (!staged) {
    hsync();
    GP_STAGE(par, 0, Ab, Bb)
    asm volatile("s_waitcnt vmcnt(0)" ::: "memory");
    hsync();
  }
  for (int kt = 0; kt < nk; ++kt) {
    const int cur = (par + kt) & 1;
    { const bool inner = kt + 1 < nk; if (inner || has_next) { const bf16_t* ap_ = inner ? Ab : Abn; const bf16_t* bp_ = inner ? Bb : Bbn; const int kb_ = inner ? (kt + 1) * 64 : 0; GP_STAGE(cur ^ 1, kb_, ap_, bp_) } }
    const unsigned char* bufA = lds + cur * 32768;
    const unsigned char* bufB = bufA + 16384;
#pragma unroll
    for (int kk = 0; kk < 2; ++kk) {
      bf16x8 At[4], Bt[4];
      const int co = ((kk * 4 + fq) ^ sw) * 16;
#pragma unroll
      for (int m = 0; m < 4; ++m) At[m] = *(const bf16x8*)(bufA + aro + m * 2048 + co);
#pragma unroll
      for (int n = 0; n < 4; ++n) Bt[n] = *(const bf16x8*)(bufB + bro + n * 2048 + co);
#pragma unroll
      for (int m = 0; m < 4; ++m)
#pragma unroll
        for (int n = 0; n < 4; ++n) acc[m][n] = mfma16(Bt[n], At[m], acc[m][n]);
    }
    asm volatile("s_waitcnt vmcnt(0)" ::: "memory");
    hsync();
  }
  par = (par + nk) & 1;
#undef GP_STAGE
}
template <class AF, class BF>
DEVI void gemm128h(unsigned char* lds, int K, AF aptr, BF bptr, f32x4 (&acc)[2][4]) {
  const int tid = HTID, wid = tid >> 6, lane = tid & 63, fr = lane & 15, fq = lane >> 4;
#pragma unroll
  for (int m = 0; m < 2; ++m)
#pragma unroll
    for (int n = 0; n < 4; ++n) acc[m][n] = (f32x4){0.f, 0.f, 0.f, 0.f};
  const int lr = tid >> 3;
  const int chs = ((tid & 7) ^ ((lr >> 1) & 7)) * 8;
  const int sw = (fr >> 1) & 7;
  const int aro = (wid * 32 + fr) * 128, bro = fr * 128;
  const int nk = K >> 6;
  LAS unsigned char* l3 = (LAS unsigned char*)lds;
#define GH_STAGE(buf, kbase)                                                                                                     \
  { _Pragma("unroll") for (int i = 0; i < 4; ++i)                                                                                 \
      __builtin_amdgcn_global_load_lds((const __attribute__((address_space(1))) unsigned*)aptr(lr + 32 * i, (kbase) + chs),        \
                                       (LAS unsigned*)(l3 + (buf) * 32768 + tid * 16 + i * 4096), 16, 0, 0);                         \
    _Pragma("unroll") for (int i = 0; i < 2; ++i)                                                                                 \
      __builtin_amdgcn_global_load_lds((const __attribute__((address_space(1))) unsigned*)bptr(lr + 32 * i, (kbase) + chs),        \
                                       (LAS unsigned*)(l3 + (buf) * 32768 + 16384 + tid * 16 + i * 4096), 16, 0, 0); }
  hsync();
  GH_STAGE(0, 0)
  asm volatile("s_waitcnt vmcnt(0)" ::: "memory");
  hsync();
  for (int kt = 0; kt < nk; ++kt) {
    if (kt + 1 < nk) { GH_STAGE((kt + 1) & 1, (kt + 1) * 64) }
    const unsigned char* bufA = lds + (kt & 1) * 32768;
    const unsigned char* bufB = bufA + 16384;
#pragma unroll
    for (int kk = 0; kk < 2; ++kk) {
      bf16x8 At[2], Bt[4];
      const int co = ((kk * 4 + fq) ^ sw) * 16;
#pragma unroll
      for (int m = 0; m < 2; ++m) At[m] = *(const bf16x8*)(bufA + aro + m * 2048 + co);
#pragma unroll
      for (int n = 0; n < 4; ++n) Bt[n] = *(const bf16x8*)(bufB + bro + n * 2048 + co);
#pragma unroll
      for (int m = 0; m < 2; ++m)
#pragma unroll
        for (int n = 0; n < 4; ++n) acc[m][n] = mfma16(Bt[n], At[m], acc[m][n]);
    }
    asm volatile("s_waitcnt vmcnt(0)" ::: "memory");
    hsync();
  }
#undef GH_STAGE
}
#define GEMM_EPI_LOOP(body)                                                                 \
  {                                                                                         \
    const int _tid = HTID, _wid = _tid >> 6, _lane = _tid & 63, _wr = _wid >> 1, _wc = _wid & 1, _fr = _lane & 15, _fq = _lane >> 4; \
    _Pragma("unroll") for (int m = 0; m < 4; ++m) _Pragma("unroll") for (int n = 0; n < 4; ++n) _Pragma("unroll") for (int j = 0; j < 4; ++j) { \
      const int er = _wr * 64 + m * 16 + _fr, ec = _wc * 64 + n * 16 + _fq * 4 + j; const float ev = acc[m][n][j]; body }                      \
  }
#define GEMM_EPI4(body)                                                                     \
  {                                                                                         \
    const int _tid = HTID, _wid = _tid >> 6, _lane = _tid & 63, _wr = _wid >> 1, _wc = _wid & 1, _fr = _lane & 15, _fq = _lane >> 4; \
    _Pragma("unroll") for (int m = 0; m < 4; ++m) _Pragma("unroll") for (int n = 0; n < 4; ++n) {                                             \
      const int er = _wr * 64 + m * 16 + _fr, ec0 = _wc * 64 + n * 16 + _fq * 4; const f32x4 ev4 = acc[m][n]; body }                          \
  }
DEVI f32x4 ld_bf16x4(const bf16_t* p) { const uint2 u = *(const uint2*)p; return (f32x4){__uint_as_float(u.x << 16), __uint_as_float(u.x & 0xffff0000u), __uint_as_float(u.y << 16), __uint_as_float(u.y & 0xffff0000u)}; }
DEVI void st_bf16x4(bf16_t* p, f32x4 v) { uint2 o; o.x = pk2bf(v[0], v[1]); o.y = pk2bf(v[2], v[3]); *(uint2*)p = o; }

namespace pg8 {
#define PG8_LAS __attribute__((address_space(3)))
typedef unsigned short bf16_t;
typedef short bf16x8 __attribute__((ext_vector_type(8)));
typedef float f32x4 __attribute__((ext_vector_type(4)));
typedef unsigned u32x4 __attribute__((ext_vector_type(4)));
constexpr int BM = 256, BK = 64, HALF = 128, HTB = HALF * BK * 2  , STAGE_BYTES = 8 * HTB, NXCD = 8, WGM = 8;

__host__ __device__ __forceinline__ int lds_byte(int r, int c) { const int st = (r >> 4) * 2 + (c >> 5), rr = r & 15, cc = c & 31, ob = rr * 64 + cc * 2; return st * 1024 + (ob ^ (((ob >> 9) & 1) << 5)); }
__host__ __device__ __forceinline__ void stage_rc(int b, int& R, int& C) { const int st = b / 1024, sb = b % 1024, swz = sb ^ (((sb >> 9) & 1) << 5); R = (st >> 1) * 16 + swz / 64; C = (st & 1) * 32 + (swz % 64) / 2; }
__host__ __device__ __forceinline__ int perm32(int rho) { const int n = rho >> 4, i = rho & 15; return 8 * (i >> 2) + 4 * n + (i & 3); }

struct Unit { int pm, pn; };
struct Gemm { const bf16_t* A; const bf16_t* Bt; int M, N, K; };

struct StaticOrder {
    int nM, nN, nwg, G, c;
    __host__ __device__ void init(int M, int N, int G_, int c_) { nM = M / BM; nN = N / BM; nwg = nM * nN; G = G_; c = c_; }
    __host__ __device__ bool next(int i, Unit& u) const {
        const long L = (long)i * G + c; if (L >= nwg) return false;
        int wgid = (int)L; { const int q = nwg / NXCD, r = nwg % NXCD, xcd = wgid % NXCD, off = wgid / NXCD; wgid = (xcd < r ? xcd * (q + 1) : r * (q + 1) + (xcd - r) * q) + off; }
        const int nig = WGM * nN, gid = wgid / nig, fm = gid * WGM, gsz = (nM - fm) < WGM ? (nM - fm) : WGM;
        u.pm = fm + ((wgid % nig) % gsz); u.pn = (wgid % nig) / gsz; return true;
    }
    __device__ __forceinline__ void a_ready(const Unit&) const {}
    __device__ __forceinline__ void done(const Unit&) const {}
};

__device__ __forceinline__ unsigned cvt_pk_bf16(float lo, float hi) { unsigned r; asm volatile("v_cvt_pk_bf16_f32 %0, %1, %2" : "=v"(r) : "v"(lo), "v"(hi)); return r; }
typedef float f32x2 __attribute__((ext_vector_type(2)));
__device__ __forceinline__ f32x2 gelu_pk(f32x2 v) {
    const f32x2 av = __builtin_elementwise_abs(v), d = av * 0.2316418882f + 1.0f;
    f32x2 t; t.x = __builtin_amdgcn_rcpf(d.x); t.y = __builtin_amdgcn_rcpf(d.y);
    f32x2 q = t * 0.5307027145f + (-0.7265760135f); q = q * t + 0.7107068705f; q = q * t + (-0.142248368f); q = q * t + 0.127414796f; q = q * t;
    const f32x2 s = (v * v) * (-0.72134752044f);
    f32x2 e; e.x = __builtin_amdgcn_exp2f(s.x); e.y = __builtin_amdgcn_exp2f(s.y);
    const f32x2 m = v * (q * e), r = v - m;
    f32x2 o; o.x = v.x < 0.f ? m.x : r.x; o.y = v.y < 0.f ? m.y : r.y; return o;
}

template <int ACT  > struct EpiBf16 {
    static constexpr bool PERM = true, AFTER_DRAIN = false; static_assert(ACT == 0 || ACT == 1, "EpiBf16: ACT is 0 (none) or 1 (gelu_pk)");
    bf16_t* O; int ldc; const float* bias; int split_cols; size_t split_stride; float scale0;
    __device__ __forceinline__ void operator()(const f32x4 (&acc)[2][2][4][2], const Unit& u, int wr, int wc, int fr, int fq) const {
        const int row0 = u.pm * BM + wr * 64 + fr; int colt = u.pn * BM; bf16_t* base = O;
        float sc = 1.f; if (split_cols) { const int t = colt / split_cols; base += (size_t)t * split_stride; colt -= t * split_cols; if (t == 0) sc = scale0; }
        const int col0 = colt + wc * 32 + 8 * fq, bcol0 = u.pn * BM + wc * 32 + 8 * fq;
        f32x4 bv[2][2];
#pragma unroll
        for (int bj = 0; bj < 2; ++bj)
#pragma unroll
            for (int n = 0; n < 2; ++n) bv[bj][n] = bias ? *(const f32x4*)(bias + bcol0 + bj * HALF + 4 * n) : (f32x4){0.f, 0.f, 0.f, 0.f};
#pragma unroll
        for (int ai = 0; ai < 2; ++ai)
#pragma unroll
            for (int m = 0; m < 4; ++m) { bf16_t* rowp = base + (size_t)(row0 + ai * HALF + m * 16) * ldc + col0;
#pragma unroll
                for (int bj = 0; bj < 2; ++bj) { f32x4 v0 = acc[ai][bj][m][0] + bv[bj][0], v1 = acc[ai][bj][m][1] + bv[bj][1];
                    if (ACT == 1) { f32x2 a = gelu_pk((f32x2){v0[0], v0[1]}), b = gelu_pk((f32x2){v0[2], v0[3]}), c = gelu_pk((f32x2){v1[0], v1[1]}), d = gelu_pk((f32x2){v1[2], v1[3]});
                        v0 = (f32x4){a.x, a.y, b.x, b.y}; v1 = (f32x4){c.x, c.y, d.x, d.y}; }
                    v0 = v0 * sc; v1 = v1 * sc; u32x4 w; w.x = cvt_pk_bf16(v0[0], v0[1]); w.y = cvt_pk_bf16(v0[2], v0[3]); w.z = cvt_pk_bf16(v1[0], v1[1]); w.w = cvt_pk_bf16(v1[2], v1[3]);
                    *(u32x4*)(rowp + bj * HALF) = w; } }
    }
};

template <class Epi, class Sched, bool ALIGN_EPI = false, bool SP2 = false>
__device__ __forceinline__ void gemm_phase(PG8_LAS unsigned char* lds, const Gemm g, const Sched& S, const Epi& E) {
    const int tid = threadIdx.x, wid = __builtin_amdgcn_readfirstlane(tid >> 6), lane = tid & 63, wr = wid >> 2, wc = wid & 3, fr = lane & 15, fq = lane >> 4;
    const int K = g.K, nt = K / BK;
    unsigned voffA[2], voffB[2];
#pragma unroll
    for (int i = 0; i < 2; ++i) { int R, C; stage_rc(tid * 16 + i * 8192, R, C); const int Rb = Epi::PERM ? ((R & ~31) + perm32(R & 31)) : R;
        voffA[i] = (unsigned)(R * K + C) * 2u; voffB[i] = (unsigned)(Rb * K + C) * 2u; }
    const size_t kstep = (size_t)(BK * 2);
    const size_t hstep = (size_t)HALF * K * 2;
    const size_t tstep = 2 * hstep;
    const unsigned ldsw = (unsigned)wid * 1024u;
    const int aoff = lds_byte(wr * 64 + fr, fq * 8), boff = lds_byte(wc * 32 + fr, fq * 8);
#define PG8_SA(b, h) (((b) * 2 + (h)) * HTB)
#define PG8_SB(b, h) ((4 + (b) * 2 + (h)) * HTB)
#define PG8_STAGE(bufoff, gbase, voff) do { _Pragma("unroll") for (int _i = 0; _i < 2; ++_i) \
        __builtin_amdgcn_global_load_lds((const unsigned*)((const char*)(gbase) + (voff)[_i]), (PG8_LAS unsigned*)(lds + (bufoff) + ldsw + _i * 8192), 16, 0, 0); } while (0)
#define PG8_LDA(dst, b, h) do { _Pragma("unroll") for (int m = 0; m < 4; ++m) _Pragma("unroll") for (int k = 0; k < 2; ++k) dst[m][k] = *(const PG8_LAS bf16x8*)(lds + PG8_SA(b, h) + aoff + m * 2048 + k * 1024); } while (0)
#define PG8_LDB(dst, b, h) do { _Pragma("unroll") for (int n = 0; n < 2; ++n) _Pragma("unroll") for (int k = 0; k < 2; ++k) dst[n][k] = *(const PG8_LAS bf16x8*)(lds + PG8_SB(b, h) + boff + n * 2048 + k * 1024); } while (0)
#define PG8_MMA(ai, bj, At, Bt) do { __builtin_amdgcn_s_setprio(1); _Pragma("unroll") for (int m = 0; m < 4; ++m) _Pragma("unroll") for (int n = 0; n < 2; ++n) _Pragma("unroll") for (int k = 0; k < 2; ++k) \
        acc[ai][bj][m][n] = __builtin_amdgcn_mfma_f32_16x16x32_bf16(Bt[n][k], At[m][k], acc[ai][bj][m][n], 0, 0, 0); __builtin_amdgcn_s_setprio(0); } while (0)
#define PG8_WAIT_V(n) asm volatile("s_waitcnt vmcnt(" #n ")" ::: "memory")
#define PG8_WAIT_L(n) asm volatile("s_waitcnt lgkmcnt(" #n ")" ::: "memory")
#define PG8_BAR __builtin_amdgcn_s_barrier()
#define PG8_SCHED __builtin_amdgcn_sched_barrier(0)
    Unit cur, nxt; int ui = 0;
    if (!S.next(0, cur)) return;
    f32x4 acc[2][2][4][2];
#pragma unroll
    for (int a = 0; a < 2; ++a)
#pragma unroll
        for (int b = 0; b < 2; ++b)
#pragma unroll
            for (int m = 0; m < 4; ++m)
#pragma unroll
                for (int n = 0; n < 2; ++n) acc[a][b][m][n] = (f32x4){0.f, 0.f, 0.f, 0.f};
    bf16x8 At[4][2], B0[2][2], B1[2][2];
    const char* cA = (const char*)g.A + (size_t)cur.pm * tstep; const char* cB = (const char*)g.Bt + (size_t)cur.pn * tstep;
    S.a_ready(cur);
    if constexpr (SP2) {
        PG8_STAGE(PG8_SB(0, 0), cB, voffB); PG8_STAGE(PG8_SB(0, 1), cB + hstep, voffB); PG8_STAGE(PG8_SA(0, 0), cA, voffA); PG8_STAGE(PG8_SA(0, 1), cA + hstep, voffA);
        if (wr == 1) PG8_BAR;
        PG8_WAIT_V(2); PG8_BAR;
        PG8_STAGE(PG8_SB(1, 0), cB + kstep, voffB); PG8_STAGE(PG8_SA(1, 0), cA + kstep, voffA); PG8_STAGE(PG8_SB(1, 1), cB + hstep + kstep, voffB);
        PG8_WAIT_V(6); PG8_BAR;
    } else {
        PG8_STAGE(PG8_SB(0, 0), cB, voffB); PG8_STAGE(PG8_SA(0, 0), cA, voffA); PG8_STAGE(PG8_SB(0, 1), cB + hstep, voffB); PG8_STAGE(PG8_SA(0, 1), cA + hstep, voffA);
        if (wr == 1) PG8_BAR;
        PG8_WAIT_V(4); PG8_BAR;
        PG8_STAGE(PG8_SB(1, 0), cB + kstep, voffB); PG8_STAGE(PG8_SA(1, 0), cA + kstep, voffA); PG8_STAGE(PG8_SB(1, 1), cB + hstep + kstep, voffB);
        PG8_WAIT_V(6); PG8_BAR;
    }
    for (;;) {
        const bool has_next = S.next(ui + 1, nxt);
        const char* nA = has_next ? (const char*)g.A + (size_t)nxt.pm * tstep : cA; const char* nB = has_next ? (const char*)g.Bt + (size_t)nxt.pn * tstep : cB;
        for (int t = 0; t < nt; t += 2) {
            const bool last = (t == nt - 2);
            const char* a1 = cA + (size_t)(t + 1) * kstep;
            const char* a2 = last ? nA : cA + (size_t)(t + 2) * kstep; const char* b2 = last ? nB : cB + (size_t)(t + 2) * kstep;
            const char* a3 = a2 + kstep; const char* b3 = b2 + kstep;
            if (last && has_next) S.a_ready(nxt);
            if constexpr (SP2) {
            PG8_LDB(B0, 0, 0); PG8_LDB(B1, 0, 1); PG8_SCHED; PG8_LDA(At, 0, 0); PG8_STAGE(PG8_SA(1, 1), a1 + hstep, voffA);
            PG8_WAIT_V(8); PG8_WAIT_L(0); PG8_BAR; PG8_MMA(0, 0, At, B0); PG8_MMA(0, 1, At, B1); PG8_BAR; PG8_SCHED;
            PG8_LDA(At, 0, 1); PG8_STAGE(PG8_SB(0, 0), b2, voffB); PG8_STAGE(PG8_SB(0, 1), b2 + hstep, voffB); PG8_STAGE(PG8_SA(0, 0), a2, voffA);
            PG8_WAIT_V(8); PG8_WAIT_L(0); PG8_BAR; PG8_MMA(1, 0, At, B0); PG8_MMA(1, 1, At, B1); PG8_BAR; PG8_SCHED;
            PG8_LDB(B0, 1, 0); PG8_LDB(B1, 1, 1); PG8_SCHED; PG8_LDA(At, 1, 0); PG8_STAGE(PG8_SA(0, 1), a2 + hstep, voffA);
            PG8_WAIT_V(8); PG8_WAIT_L(0); PG8_BAR; PG8_MMA(0, 0, At, B0); PG8_MMA(0, 1, At, B1); PG8_BAR; PG8_SCHED;
            PG8_LDA(At, 1, 1); PG8_STAGE(PG8_SB(1, 0), b3, voffB); PG8_STAGE(PG8_SB(1, 1), b3 + hstep, voffB); PG8_STAGE(PG8_SA(1, 0), a3, voffA);
            PG8_WAIT_V(8); PG8_WAIT_L(0); PG8_BAR; PG8_MMA(1, 0, At, B0); PG8_MMA(1, 1, At, B1); PG8_BAR; PG8_SCHED;
            } else {
            PG8_LDB(B0, 0, 0); PG8_SCHED; PG8_LDA(At, 0, 0); PG8_STAGE(PG8_SA(1, 1), a1 + hstep, voffA);
            PG8_WAIT_L(8); PG8_BAR; PG8_WAIT_L(0); PG8_MMA(0, 0, At, B0); PG8_BAR; PG8_SCHED;
            PG8_LDB(B1, 0, 1); PG8_STAGE(PG8_SB(0, 0), b2, voffB);
            PG8_BAR; PG8_WAIT_L(0); PG8_MMA(0, 1, At, B1); PG8_BAR;
            PG8_LDA(At, 0, 1); PG8_STAGE(PG8_SA(0, 0), a2, voffA);
            PG8_BAR; PG8_WAIT_L(0); PG8_MMA(1, 0, At, B0); PG8_BAR; PG8_SCHED;
            PG8_STAGE(PG8_SB(0, 1), b2 + hstep, voffB);
            PG8_WAIT_V(6); PG8_BAR; PG8_MMA(1, 1, At, B1); PG8_BAR;
            PG8_LDB(B0, 1, 0); PG8_SCHED; PG8_LDA(At, 1, 0); PG8_STAGE(PG8_SA(0, 1), a2 + hstep, voffA);
            PG8_WAIT_L(8); PG8_BAR; PG8_WAIT_L(0); PG8_MMA(0, 0, At, B0); PG8_BAR; PG8_SCHED;
            PG8_LDB(B1, 1, 1); PG8_STAGE(PG8_SB(1, 0), b3, voffB);
            PG8_BAR; PG8_WAIT_L(0); PG8_MMA(0, 1, At, B1); PG8_BAR;
            PG8_LDA(At, 1, 1); PG8_STAGE(PG8_SA(1, 0), a3, voffA);
            PG8_BAR; PG8_WAIT_L(0); PG8_MMA(1, 0, At, B0); PG8_BAR; PG8_SCHED;
            PG8_STAGE(PG8_SB(1, 1), b3 + hstep, voffB);
            PG8_WAIT_V(6); PG8_BAR; PG8_MMA(1, 1, At, B1); PG8_BAR;
            }
        }
        if constexpr (ALIGN_EPI) { if (wr == 0) PG8_BAR; }
        if constexpr (!Epi::AFTER_DRAIN) { E(acc, cur, wr, wc, fr, fq); S.done(cur); }
        if (!has_next) break;
#pragma unroll
        for (int a = 0; a < 2; ++a)
#pragma unroll
            for (int b = 0; b < 2; ++b)
#pragma unroll
                for (int m = 0; m < 4; ++m)
#pragma unroll
                    for (int n = 0; n < 2; ++n) acc[a][b][m][n] = (f32x4){0.f, 0.f, 0.f, 0.f};
        cur = nxt; cA = nA; cB = nB; ++ui;
        if constexpr (ALIGN_EPI) { if (wr == 1) PG8_BAR; }
    }
    PG8_WAIT_V(0);
    if constexpr (!ALIGN_EPI) { if (wr == 0) PG8_BAR; }
    PG8_BAR;
    if constexpr (Epi::AFTER_DRAIN) { E.fused(acc, cur, wr, wc, fr, fq, lds, wid, lane); S.done(cur); }
#undef PG8_SA
#undef PG8_SB
#undef PG8_STAGE
#undef PG8_LDA
#undef PG8_LDB
#undef PG8_MMA
#undef PG8_WAIT_V
#undef PG8_WAIT_L
#undef PG8_BAR
#undef PG8_SCHED
}
}

struct EpiG1 {
  static constexpr bool PERM = false, AFTER_DRAIN = false;
  bf16_t* PROJ; bf16_t* QN; bf16_t* KS; bf16_t* KW; float* SSKV; const float2* RN; const float* g_q; const float* g_k;
  __device__ __forceinline__ void operator()(const pg8::f32x4 (&acc)[2][2][4][2], const pg8::Unit& u, int wr, int wc, int fr, int fq) const {
    const bool t1 = (u.pn == 1), t5 = (u.pn == 5);
#pragma unroll
    for (int ai = 0; ai < 2; ++ai)
#pragma unroll
      for (int m = 0; m < 4; ++m) {
        const size_t t = (size_t)u.pm * 256 + ai * 128 + wr * 64 + m * 16 + fr;
        if (!(t1 || t5) || (t1 && wc < 2)) {
#pragma unroll
          for (int bj = 0; bj < 2; ++bj)
#pragma unroll
            for (int n = 0; n < 2; ++n) st_bf16x4(PROJ + t * DINP + u.pn * 256 + bj * 128 + wc * 32 + n * 16 + fq * 4, acc[ai][bj][m][n]);
        }
        if (t1 || t5) {
          float ss = 0.f;
#pragma unroll
          for (int bj = 0; bj < 2; ++bj)
#pragma unroll
            for (int n = 0; n < 2; ++n) { const pg8::f32x4 v = acc[ai][bj][m][n]; ss += v[0] * v[0] + v[1] * v[1] + v[2] * v[2] + v[3] * v[3]; }
          ss += __shfl_xor(ss, 16); ss += __shfl_xor(ss, 32);
          if (t1 && wc < 2) { if (fq == 0) SSKV[t * 2 + wc] = ss; }
          else {
            const float rs = rsqrtf(ss * (1.f / 64) + EPS);
            const float* gg = t5 ? g_q : (g_k + (wc == 2 ? 64 : 128));
            const float sc = t5 ? (0.125f * LOG2E) : 1.f;
            bf16_t* dst = t5 ? (QN + t * 256 + wc * 64) : ((wc == 2 ? KS : KW) + t * 64);
#pragma unroll
            for (int bj = 0; bj < 2; ++bj)
#pragma unroll
              for (int n = 0; n < 2; ++n) {
                const int e0 = 32 * bj + 16 * n + 4 * fq;
                const float4 g4 = *(const float4*)(gg + e0);
                pg8::f32x4 v = acc[ai][bj][m][n];
                v[0] *= rs * g4.x; v[1] *= rs * g4.y; v[2] *= rs * g4.z; v[3] *= rs * g4.w;
                if (bj == 0 && n == 0) {
#pragma unroll
                  for (int j = 0; j < 4; ++j) {
                    const float x = v[j], partner = __shfl_xor(x, 32);
                    const int d = fq * 4 + j; const float2 cs2 = RN[t * 8 + (d & 7)];
                    v[j] = (d < 8) ? (x * cs2.x - partner * cs2.y) : (partner * cs2.y + x * cs2.x);
                  }
                }
                st_bf16x4(dst + e0, v * sc);
              }
          }
        }
      }
  }
};

template <bool IN16> struct EpiRes {
  static constexpr bool PERM = false, AFTER_DRAIN = false;
  const float* xin; const bf16_t* xin16; bf16_t* out;
  __device__ __forceinline__ void operator()(const pg8::f32x4 (&acc)[2][2][4][2], const pg8::Unit& u, int wr, int wc, int fr, int fq) const {
#pragma unroll
    for (int ai = 0; ai < 2; ++ai)
#pragma unroll
      for (int m = 0; m < 4; ++m) {
        const size_t row = (size_t)u.pm * 256 + ai * 128 + wr * 64 + m * 16 + fr;
#pragma unroll
        for (int bj = 0; bj < 2; ++bj)
#pragma unroll
          for (int n = 0; n < 2; ++n) {
            const size_t o = row * 1024 + u.pn * 256 + bj * 128 + wc * 32 + n * 16 + fq * 4;
            f32x4 xi;
            if constexpr (IN16) { const ushort4 u4 = *(const ushort4*)(xin16 + o); xi = (f32x4){bf2f(u4.x), bf2f(u4.y), bf2f(u4.z), bf2f(u4.w)}; }
            else xi = *(const f32x4*)(xin + o);
            st_bf16x4(out + o, xi + acc[ai][bj][m][n]);
          }
      }
  }
};

DEVI void rmsnorm_rows16(const bf16_t* x, const float* g, bf16_t* xn) {
  const int lane = HTID & 63, gw = VBID * 4 + (HTID >> 6), NGW = VGRID * 4;
  float4 gg[4];
#pragma unroll
  for (int j = 0; j < 2; ++j) { gg[2 * j] = ((const float4*)(g + 512 * j))[2 * lane]; gg[2 * j + 1] = ((const float4*)(g + 512 * j))[2 * lane + 1]; }
  for (int t0 = gw * 4; t0 < T; t0 += NGW * 4) {
    u32x4 v[4][2];
#pragma unroll
    for (int q = 0; q < 4; ++q)
#pragma unroll
      for (int j = 0; j < 2; ++j) v[q][j] = ((const u32x4*)(x + (size_t)(t0 + q) * D + 512 * j))[lane];
#pragma unroll
    for (int q = 0; q < 4; ++q) {
      float s = 0.f;
#pragma unroll
      for (int j = 0; j < 2; ++j)
#pragma unroll
        for (int e = 0; e < 4; ++e) { const float a = __uint_as_float(v[q][j][e] << 16), b = __uint_as_float(v[q][j][e] & 0xffff0000u); s += a * a + b * b; }
      const float rs = rsqrtf(wsum(s) * (1.f / D) + EPS);
#pragma unroll
      for (int j = 0; j < 2; ++j) {
        const float gq[8] = {gg[2 * j].x, gg[2 * j].y, gg[2 * j].z, gg[2 * j].w, gg[2 * j + 1].x, gg[2 * j + 1].y, gg[2 * j + 1].z, gg[2 * j + 1].w};
        u32x4 o;
#pragma unroll
        for (int e = 0; e < 4; ++e) o[e] = pk2bf(__uint_as_float(v[q][j][e] << 16) * rs * gq[2 * e], __uint_as_float(v[q][j][e] & 0xffff0000u) * rs * gq[2 * e + 1]);
        ((u32x4*)(xn + (size_t)(t0 + q) * D + 512 * j))[lane] = o;
      }
    }
  }
}

template <class RM>
DEVI void transpose_tiles(const float* src, int K, int N, bf16_t* dst, int ldk, RM rowmap, unsigned char* lds, int& cursor, const float* kscale = nullptr) {
  float* tl = (float*)lds;
  const int tk = K / 64, tn = (N + 63) / 64, nt = tk * tn;
  const int tid = HTID;
  const int G_ = VGRID;
  for (int it = (VBID - cursor % G_ + G_) % G_; it < nt; it += G_) {
    const int kt = it / tn, ntile = it % tn, k0 = kt * 64, n0 = ntile * 64;
    hsync();
#pragma unroll
    for (int q = 0; q < 4; ++q) {
      const int r = (tid >> 4) + 16 * q, c4 = (tid & 15) * 4;
      const float* sp = src + (size_t)(k0 + r) * N + n0 + c4;
      float4 v;
      if (n0 + c4 + 3 < N) v = *(const float4*)sp;
      else { v.x = (n0 + c4 < N) ? sp[0] : 0.f; v.y = (n0 + c4 + 1 < N) ? sp[1] : 0.f; v.z = (n0 + c4 + 2 < N) ? sp[2] : 0.f; v.w = 0.f; }
      if (kscale) { const float ks = kscale[k0 + r]; v.x *= ks; v.y *= ks; v.z *= ks; v.w *= ks; }
      tl[r * 65 + c4] = v.x; tl[r * 65 + c4 + 1] = v.y; tl[r * 65 + c4 + 2] = v.z; tl[r * 65 + c4 + 3] = v.w;
    }
    hsync();
    const int n = tid >> 2, kc = (tid & 3) * 16;
    if (n0 + n < N) {
      unsigned w[8];
#pragma unroll
      for (int i = 0; i < 8; ++i) w[i] = pk2bf(tl[(kc + 2 * i) * 65 + n], tl[(kc + 2 * i + 1) * 65 + n]);
      uint4* o = (uint4*)(dst + (size_t)rowmap(n0 + n) * ldk + k0 + kc);
      o[0] = make_uint4(w[0], w[1], w[2], w[3]); o[1] = make_uint4(w[4], w[5], w[6], w[7]);
    }
  }
  cursor += nt;
}
DEVI void rmsnorm_rows(const float* x, const float* g, bf16_t* xn) {
  const int lane = HTID & 63, gw = VBID * 4 + (HTID >> 6), NGW = VGRID * 4;
  float4 gg[4];
#pragma unroll
  for (int j = 0; j < 4; ++j) gg[j] = ((const float4*)g)[lane + 64 * j];
  for (int t0 = gw * 4; t0 < T; t0 += NGW * 4) {
    float4 v[4][4];
#pragma unroll
    for (int q = 0; q < 4; ++q)
#pragma unroll
      for (int j = 0; j < 4; ++j) v[q][j] = ((const float4*)(x + (size_t)(t0 + q) * D))[lane + 64 * j];
#pragma unroll
    for (int q = 0; q < 4; ++q) {
      float s = 0.f;
#pragma unroll
      for (int j = 0; j < 4; ++j) s += v[q][j].x * v[q][j].x + v[q][j].y * v[q][j].y + v[q][j].z * v[q][j].z + v[q][j].w * v[q][j].w;
      const float rs = rsqrtf(wsum(s) * (1.f / D) + EPS);
#pragma unroll
      for (int j = 0; j < 4; ++j) {
        uint2 o; o.x = pk2bf(v[q][j].x * rs * gg[j].x, v[q][j].y * rs * gg[j].y); o.y = pk2bf(v[q][j].z * rs * gg[j].z, v[q][j].w * rs * gg[j].w);
        ((uint2*)(xn + (size_t)(t0 + q) * D))[lane + 64 * j] = o;
      }
    }
  }
}
DEVI void phase_prep(const Params& p, unsigned char* lds) {
  const size_t gtid = (size_t)VBID * NTHREADS + HTID, gn = (size_t)VGRID * NTHREADS;
  unsigned char* ws = p.ws;
  if (gtid < 64) ((int*)(ws + SM_CNT))[gtid] = 0;
  auto ident = [](int n) { return n; };
  int cursor = 0;
  for (int l = 0; l < NL; ++l) {
    unsigned char* wl = ws + WS_W + l * WS_WL;
    transpose_tiles(p.in[3] + (size_t)l * D * DIN, D, DIN, (bf16_t*)(wl + W_IN), D, [](int n) { return colmap(n); }, lds, cursor);
    for (size_t i = gtid; i < (size_t)20 * D; i += gn) ((bf16_t*)(wl + W_IN))[(size_t)236 * D + i] = 0;
    transpose_tiles(p.in[36] + (size_t)l * D * D, D, D, (bf16_t*)(wl + W_OUT), D, ident, lds, cursor);
    transpose_tiles(p.in[6] + (size_t)l * 192 * 384, 192, 384, (bf16_t*)(wl + W_UQ), 192, ident, lds, cursor, p.in[4] + l * 192);
    transpose_tiles(p.in[7] + (size_t)l * 128 * 512, 128, 512, (bf16_t*)(wl + W_UKV), 128, ident, lds, cursor, p.in[5] + l * 128);
    transpose_tiles(p.in[25] + (size_t)l * 256 * 256, 256, 256, (bf16_t*)(wl + W_GLU), 256, ident, lds, cursor);
    transpose_tiles(p.in[30] + (size_t)l * 2048 * 128, 2048, 128, (bf16_t*)(wl + W_1K), 2048, ident, lds, cursor);
    transpose_tiles(p.in[33] + (size_t)l * 2048 * 128, 2048, 128, (bf16_t*)(wl + W_1V), 2048, ident, lds, cursor);
    transpose_tiles(p.in[31] + (size_t)l * 128 * 64, 128, 64, (bf16_t*)(wl + W_2K), 128, ident, lds, cursor);
    transpose_tiles(p.in[34] + (size_t)l * 128 * 64, 128, 64, (bf16_t*)(wl + W_2V), 128, ident, lds, cursor);
    for (int h = 0; h < 4; ++h) {
      transpose_tiles(p.in[12] + ((size_t)l * 4 + h) * 64 * 64, 64, 64, (bf16_t*)(wl + W_LRU) + h * 128 * 64, 64, ident, lds, cursor);
      transpose_tiles(p.in[14] + ((size_t)l * 4 + h) * 64 * 64, 64, 64, (bf16_t*)(wl + W_LRU) + h * 128 * 64 + 64 * 64, 64, ident, lds, cursor);
    }
    for (int e = 0; e < 16; ++e) {
      bf16_t* dg = (bf16_t*)(wl + W_GU) + (size_t)e * 512 * 1024;
      transpose_tiles(p.in[42] + ((size_t)l * 16 + e) * 1024 * 256, 1024, 256, dg, 1024, [](int hh) { return (hh >> 6) * 128 + ((hh >> 5) & 1) * 64 + ((hh >> 4) & 1) * 16 + (hh & 15); }, lds, cursor, p.in[37] + l * D);
      transpose_tiles(p.in[43] + ((size_t)l * 16 + e) * 1024 * 256, 1024, 256, dg, 1024, [](int hh) { return (hh >> 6) * 128 + ((hh >> 5) & 1) * 64 + (((hh >> 4) & 1) + 2) * 16 + (hh & 15); }, lds, cursor, p.in[37] + l * D);
      transpose_tiles(p.in[44] + ((size_t)l * 16 + e) * 256 * 1024, 256, 1024, (bf16_t*)(wl + W_DN) + (size_t)e * 1024 * 256, 256, ident, lds, cursor);
    }
    {
      const int lane = HTID & 63, gw = VBID * 4 + (HTID >> 6), NGW = VGRID * 4;
      for (int o = gw; o < 256; o += NGW) {
        const int kv = o >> 7, j = o & 127;
        const float* pe = (kv ? p.in[32] : p.in[29]) + (size_t)l * 2048;
        const float* w1 = (kv ? p.in[33] : p.in[30]) + (size_t)l * 2048 * 128;
        float a = 0.f;
#pragma unroll 8
        for (int k = lane; k < 2048; k += 64) a += pe[k] * w1[(size_t)k * 128 + j];
        a = wsum(a);
        if (lane == 0) ((float*)(wl + (kv ? W_B1V : W_B1K)))[j] = a;
      }
    }
    for (size_t i = gtid; i < 16 * 64; i += gn) {
      const int g = (int)(i >> 6), sidx = (int)(i & 63);
      const float are = p.in[17][(size_t)l * 1024 + i], aim = p.in[18][(size_t)l * 1024 + i];
      const float dt = expf(p.in[19][l * 16 + g]);
      const float mag = expf(dt * are);
      float sn, cs; sincosf(dt * aim, &sn, &cs);
      const float abr = mag * cs, abi = mag * sn;
      const float den = are * are + aim * aim, nre = abr - 1.f;
      const float gre = (nre * are + abi * aim) / den, gim = (abi * are - nre * aim) / den;
      ((float2*)(wl + W_S5A))[i] = make_float2(abr, abi);
      float pr = abr, pi = abi;
#pragma unroll
      for (int q = 0; q < 6; ++q) { const float nr = pr * pr - pi * pi, ni = 2.f * pr * pi; pr = nr; pi = ni; }
      ((float2*)(wl + W_S5A64))[i] = make_float2(pr, pi);
      bf16_t* bb = (bf16_t*)(wl + W_S5BB);
      for (int ch = 0; ch < 16; ++ch) {
        const float br = p.in[20][((size_t)l * 1024 + i) * 16 + ch], bi = p.in[21][((size_t)l * 1024 + i) * 16 + ch];
        const float vr = gre * br - gim * bi, vi = gre * bi + gim * br;
        const int sb = sidx >> 5, r = sidx & 31;
        bb[((g * 4 + sb * 2 + 0) * 32 + r) * 16 + ch] = f2bf(vr);
        bb[((g * 4 + sb * 2 + 1) * 32 + r) * 16 + ch] = f2bf(vi);
      }
    }
    for (size_t i = gtid; i < 32 * 1024; i += gn) {
      const int n = (int)(i >> 10), k = (int)(i & 1023);
      float w = 0.f;
      if (n < 20) w = p.in[37][l * D + k] * ((n < 4) ? p.in[38][((size_t)l * D + k) * 4 + n] : p.in[40][((size_t)l * D + k) * 16 + (n - 4)]);
      const bf16_t hi = f2bf(w);
      ((bf16_t*)(wl + W_RTH))[i] = hi; ((bf16_t*)(wl + W_RTL))[i] = f2bf(w - bf2f(hi));
    }
    for (size_t i = gtid; i < 16 * 16 * 64; i += gn) {
      const int g = (int)(i >> 10), ch = (int)((i >> 6) & 15), pp = (int)(i & 63);
      const float cr = p.in[22][(size_t)l * 16384 + i], ci = p.in[23][(size_t)l * 16384 + i];
      bf16_t* cm = (bf16_t*)(wl + W_S5CM) + ((size_t)(g * 16 + ch) * 128 + 2 * pp);
      cm[0] = f2bf(cr); cm[1] = f2bf(-ci);
    }
  }
  {
    const int* positions = (const int*)p.in[1];
    float2* RM = (float2*)(ws + WS_ROPE);
    float2* RN = RM + (size_t)T * 16;
    for (size_t i = gtid; i < (size_t)T * 24; i += gn) {
      const int t = (int)(i / 24), j = (int)(i % 24);
      const int rot = (j < 16) ? 32 : 16, fi = (j < 16) ? j : (j - 16);
      const float inv = powf(500000.f, -(2.f * (float)fi) / (float)rot);
      float sn, cs; sincosf((float)positions[t] * inv, &sn, &cs);
      if (j < 16) RM[(size_t)t * 16 + fi] = make_float2(cs, sn); else RN[(size_t)t * 8 + fi] = make_float2(cs, sn);
    }
  }
  rmsnorm_rows(p.in[0], p.in[2], (bf16_t*)(ws + WS_A));
}

DEVI void phase_g1(const Params& p, int l, unsigned char* lds_full) {
  const bf16_t* XN = (const bf16_t*)(p.ws + WS_A);
  const bf16_t* W = (const bf16_t*)(p.ws + WS_W + l * WS_WL + W_IN);
  bf16_t* QN = (bf16_t*)(p.ws + WS_G);
  pg8::Gemm g{XN, W, T, DINP, D}; pg8::StaticOrder S; S.init(T, DINP, (int)gridDim.x, (int)blockIdx.x);
  EpiG1 E{(bf16_t*)(p.ws + WS_B), QN, QN + (size_t)T * 256, QN + (size_t)T * 320, (float*)(p.ws + SM_SSKV), (const float2*)(p.ws + WS_ROPE) + (size_t)T * 16, p.in[27] + l * 64, p.in[28] + l * 192};
  pg8::gemm_phase<EpiG1, pg8::StaticOrder, true, true>((LAS unsigned char*)lds_full, g, S, E);
}

DEVI void phase_g2(const Params& p, int l, unsigned char* lds) {
  unsigned char* wl = p.ws + WS_W + l * WS_WL;
  const bf16_t* PROJ = (const bf16_t*)(p.ws + WS_B);
  bf16_t* QR = (bf16_t*)(p.ws + WS_D);
  bf16_t* KVR = QR + (size_t)T * 384;
  bf16_t* GATES = (bf16_t*)(p.ws + WS_E);
  bf16_t* MK = (bf16_t*)(p.ws + WS_F) + (size_t)T * 4 * 96;
  const float2* RM = (const float2*)(p.ws + WS_ROPE);
  constexpr int N_CMP = 64, N_QR = 256 * 3, N_KVR = 256 * 4, N_GT = 256 * 4;
  const int tid = HTID, wid = tid >> 6, lane = tid & 63, wr = wid >> 1, wc = wid & 1, fr = lane & 15, fq = lane >> 4;
  for (int it = vblock(); it < N_CMP + N_QR + N_KVR + N_GT; it += VGRID) {
    f32x4 acc[4][4];
    if (it < N_CMP) {
      const int kv = it & 1, half = (it >> 1) & 1, mt = it >> 2;
      const bf16_t* W = (const bf16_t*)(wl + (kv ? W_1V : W_1K)) + (size_t)half * 64 * 2048;
      const float* bias = (const float*)(wl + (kv ? W_B1V : W_B1K)) + half * 64;
      bf16_t* H = (bf16_t*)(p.ws + (kv ? SM_HV : SM_HK)) + half * 64;
      f32x4 acc2[2][4];
      gemm128h(lds, 2048,
              [&](int r, int k) { const int m = mt * 128 + r, b = m >> 7; int c = m & 127; if (c > 126) c = 126;
                                  return PROJ + (size_t)(b * S + 16 * c + (k >> 6)) * DINP + C_KC + kv * 64 + (k & 63); },
              [&](int r, int k) { return W + (size_t)r * 2048 + k; }, acc2);
#pragma unroll
      for (int m = 0; m < 2; ++m)
#pragma unroll
        for (int n = 0; n < 4; ++n) {
          const float4 b4 = *(const float4*)(bias + n * 16 + fq * 4);
          f32x4 o; o[0] = gelu_tanh(acc2[m][n][0] + b4.x); o[1] = gelu_tanh(acc2[m][n][1] + b4.y); o[2] = gelu_tanh(acc2[m][n][2] + b4.z); o[3] = gelu_tanh(acc2[m][n][3] + b4.w);
          st_bf16x4(H + (size_t)(mt * 128 + wid * 32 + m * 16 + fr) * 128 + n * 16 + fq * 4, o);
        }
    } else if (it < N_CMP + N_QR) {
      const int i2 = it - N_CMP, mt = i2 / 3, nt = i2 % 3;
      const bf16_t* W = (const bf16_t*)(wl + W_UQ);
      gemm128g(lds, 192, [&](int r, int k) { return PROJ + (size_t)(mt * 128 + r) * DINP + C_CQ + k; }, [&](int r, int k) { return W + (size_t)(nt * 128 + r) * 192 + k; }, acc);
      GEMM_EPI4({ st_bf16x4(QR + (size_t)(mt * 128 + er) * 384 + nt * 128 + ec0, ev4); })
    } else if (it < N_CMP + N_QR + N_KVR) {
      const int i2 = it - N_CMP - N_QR, mt = i2 >> 2, hd = i2 & 3;
      const bf16_t* W = (const bf16_t*)(wl + W_UKV);
      gemm128g(lds, 128, [&](int r, int k) { return PROJ + (size_t)(mt * 128 + r) * DINP + wgcol(C_T1, k >> 6, k & 63); }, [&](int r, int k) { return W + (size_t)(hd * 128 + r) * 128 + k; }, acc);
      const float* g_k = p.in[9] + l * 96;
#pragma unroll
      for (int m = 0; m < 4; ++m) {
        const size_t t = (size_t)mt * 128 + wr * 64 + m * 16 + fr;
        const int b = (int)(t >> 11), sq = (int)(t & (S - 1));
        const float2 ssp = *(const float2*)((const float*)(p.ws + SM_SSKV) + t * 2);
        const float ss = ssp.x + ssp.y;
        const float rskv = rsqrtf(ss * (1.f / 128) + EPS);
        if (wc == 1) {
#pragma unroll
          for (int n = 0; n < 4; ++n) st_bf16x4(KVR + t * 512 + hd * 128 + 64 + n * 16 + fq * 4, acc[m][n] * rskv);
        } else {
          const uint2 plo = *(const uint2*)(PROJ + t * DINP + C_KPE + 4 * fq), phi = *(const uint2*)(PROJ + t * DINP + C_KPE + 16 + 4 * fq);
          float pl[4] = {__uint_as_float(plo.x << 16), __uint_as_float(plo.x & 0xffff0000u), __uint_as_float(plo.y << 16), __uint_as_float(plo.y & 0xffff0000u)};
          float ph[4] = {__uint_as_float(phi.x << 16), __uint_as_float(phi.x & 0xffff0000u), __uint_as_float(phi.y << 16), __uint_as_float(phi.y & 0xffff0000u)};
          float sk = 0.f;
#pragma unroll
          for (int j = 0; j < 4; ++j) sk += pl[j] * pl[j] + ph[j] * ph[j];
          f32x4 kn[4];
#pragma unroll
          for (int n = 0; n < 4; ++n) { kn[n] = acc[m][n] * rskv; sk += kn[n][0] * kn[n][0] + kn[n][1] * kn[n][1] + kn[n][2] * kn[n][2] + kn[n][3] * kn[n][3]; }
          sk += __shfl_xor(sk, 16); sk += __shfl_xor(sk, 32);
          const float rsk = rsqrtf(sk * (1.f / 96) + EPS);
          bf16_t* dst = MK + ((size_t)(b * 4 + hd) * S + sq) * 96;
          f32x4 olo, ohi;
#pragma unroll
          for (int j = 0; j < 4; ++j) {
            const int d = 4 * fq + j; const float2 cs2 = RM[t * 16 + d];
            const float x1 = pl[j] * rsk * g_k[d], x2 = ph[j] * rsk * g_k[16 + d];
            olo[j] = x1 * cs2.x - x2 * cs2.y; ohi[j] = x1 * cs2.y + x2 * cs2.x;
          }
          st_bf16x4(dst + 4 * fq, olo); st_bf16x4(dst + 16 + 4 * fq, ohi);
#pragma unroll
          for (int n = 0; n < 4; ++n) { const float4 g4 = *(const float4*)(g_k + 32 + n * 16 + fq * 4); f32x4 o = kn[n] * rsk; o[0] *= g4.x; o[1] *= g4.y; o[2] *= g4.z; o[3] *= g4.w; st_bf16x4(dst + 32 + n * 16 + fq * 4, o); }
        }
      }
    } else {
      const int i2 = it - N_CMP - N_QR - N_KVR, mt = i2 >> 2, h = i2 & 3;
      const bf16_t* W = (const bf16_t*)(wl + W_LRU) + h * 128 * 64;
      const int c0 = h * 64 + (tid & 7) * 8;
      const float* cw = p.in[10] + l * 4 * 256 + c0; const float* cbp = p.in[11] + l * 256 + c0;
      gemm128(lds, 64,
              [&](int r, int k) {
                const size_t t = (size_t)mt * 128 + r; const int sq = (int)(t & (S - 1));
                float u[8];
#pragma unroll
                for (int e = 0; e < 8; ++e) u[e] = cbp[e];
#pragma unroll
                for (int j = 0; j < 4; ++j) {
                  if (sq - 3 + j >= 0) {
                    const u32x4 w = *(const u32x4*)(PROJ + (t - 3 + j) * DINP + C_LX + h * 64 + k);
#pragma unroll
                    for (int e = 0; e < 4; ++e) { u[2 * e] += __uint_as_float(w[e] << 16) * cw[j * 256 + 2 * e]; u[2 * e + 1] += __uint_as_float(w[e] & 0xffff0000u) * cw[j * 256 + 2 * e + 1]; }
                  }
                }
                u32x4 o; o[0] = pk2bf(u[0], u[1]); o[1] = pk2bf(u[2], u[3]); o[2] = pk2bf(u[4], u[5]); o[3] = pk2bf(u[6], u[7]);
                return o; },
              [&](int r, int k) { return W + (size_t)r * 64 + k; }, acc);
      GEMM_EPI4({ st_bf16x4(GATES + (size_t)(mt * 128 + er) * 512 + h * 128 + ec0, ev4); })
    }
  }
}

DEVI void lru_ab(float u, float rpre, float ipre, float sp, bool first, float& a, float& b) {
  const float r = sigmoidf_(rpre), gi = sigmoidf_(ipre);
  const float la = -8.f * r * sp;
  a = __expf(la);
  const float x = 2.f * la;
  const float om = (x > -0.1f) ? (-x * (1.f + 0.5f * x * (1.f + (1.f / 3.f) * x * (1.f + 0.25f * x * (1.f + 0.2f * x))))) : (1.f - a * a);
  const float mult = first ? 1.f : sqrtf(fmaxf(om, 0.f));
  b = mult * gi * u;
}
DEVI float lru_conv(const bf16_t* PROJ, int t, int s, int c, const float* cw, float cb) {
  float u = cb;
#pragma unroll
  for (int j = 0; j < 4; ++j) { const int ss2 = s - 3 + j; if (ss2 >= 0) u += bf2f(PROJ[(size_t)(t - 3 + j) * DINP + C_LX + c]) * cw[j * 256 + c]; }
  return u;
}

template <bool FULL>
DEVI void s5_chunk(const Params& p, int l, int b, int chunk, unsigned char* lds) {
  unsigned char* wl = p.ws + WS_W + l * WS_WL;
  const bf16_t* PROJ = (const bf16_t*)(p.ws + WS_B);
  const float2* Abar = (const float2*)(wl + W_S5A);
  const bf16_t* BB = (const bf16_t*)(wl + W_S5BB);
  const bf16_t* CM = (const bf16_t*)(wl + W_S5CM);
  float2* SLOC = (float2*)(p.ws + SM_SLOC);
  bf16_t* YCP = (bf16_t*)(p.ws + WS_F);
  const float* dd = p.in[24] + l * 256;
  const int tid = HTID, wv = tid >> 6, lane = tid & 63, r = lane & 31, h = lane >> 5, fr = lane & 15, fq = lane >> 4;
  unsigned* Hs = (unsigned*)(lds + wv * 8704);
  const int t0 = b * S + chunk * 64;
#pragma unroll 1
  for (int gi = 0; gi < 4; ++gi) {
    const int g = wv * 4 + gi;
    bf16x8 bbf[4];
#pragma unroll
    for (int nb = 0; nb < 4; ++nb) bbf[nb] = *(const bf16x8*)(BB + ((g * 4 + nb) * 32 + r) * 16 + 8 * h);
    float2 Ac[2]; float hr[2], hi[2];
#pragma unroll
    for (int sb = 0; sb < 2; ++sb) {
      Ac[sb] = Abar[g * 64 + sb * 32 + r];
      hr[sb] = 0.f; hi[sb] = 0.f;
      if (FULL) { const float2 cin = ((const float2*)(p.ws + SM_SCAR))[((size_t)(b * 32 + chunk) * 16 + g) * 64 + sb * 32 + r]; hr[sb] = cin.x; hi[sb] = cin.y; }
    }
    bf16x8 cm[4];
    float4 dcol4 = make_float4(0.f, 0.f, 0.f, 0.f);
    if (FULL) {
#pragma unroll
      for (int kk = 0; kk < 4; ++kk) cm[kk] = *(const bf16x8*)(CM + (size_t)(g * 16 + fr) * 128 + kk * 32 + 8 * fq);
      dcol4 = *(const float4*)(dd + g * 16 + 4 * fq);
    }
#pragma unroll 1
    for (int tb = 0; tb < 2; ++tb) {
      const bf16x8 ua = *(const bf16x8*)(PROJ + (size_t)(t0 + tb * 32 + r) * DINP + C_S5 + g * 16 + 8 * h);
      f32x16 acc[4];
#pragma unroll
      for (int nb = 0; nb < 4; ++nb) {
        f32x16 z;
#pragma unroll
        for (int i = 0; i < 16; ++i) z[i] = 0.f;
        acc[nb] = mfma32(ua, bbf[nb], z);
      }
#pragma unroll
      for (int sb = 0; sb < 2; ++sb) {
        float sr = hr[sb], si = hi[sb];
        const float ax = Ac[sb].x, ay = Ac[sb].y;
#pragma unroll
        for (int q = 0; q < 4; ++q)
#pragma unroll
          for (int owner = 0; owner < 2; ++owner) {
#pragma unroll
            for (int i = 0; i < 4; ++i) {
              const int reg = 4 * q + i;
              const float br = acc[2 * sb][reg], bi = acc[2 * sb + 1][reg];
              const float nr = ax * sr - ay * si + br, ni = ax * si + ay * sr + bi; sr = nr; si = ni;
              if (FULL) { acc[2 * sb][reg] = (h == owner) ? sr : br; acc[2 * sb + 1][reg] = (h == owner) ? si : bi; }
            }
            const float orr = __shfl_xor(sr, 32), oi = __shfl_xor(si, 32);
            if (h != owner) { sr = orr; si = oi; }
          }
        hr[sb] = sr; hi[sb] = si;
      }
      if (FULL) {
#pragma unroll
        for (int sb = 0; sb < 2; ++sb)
#pragma unroll
          for (int reg = 0; reg < 16; ++reg)
            Hs[crow(reg, h) * 68 + sb * 32 + r] = pk2bf(acc[2 * sb][reg], acc[2 * sb + 1][reg]);
#pragma unroll
        for (int tb16 = 0; tb16 < 2; ++tb16) {
          f32x4 y = (f32x4){0.f, 0.f, 0.f, 0.f};
#pragma unroll
          for (int kk = 0; kk < 4; ++kk) { const bf16x8 a = *(const bf16x8*)((const bf16_t*)Hs + (tb16 * 16 + fr) * 136 + kk * 32 + 8 * fq); y = mfma16(cm[kk], a, y); }
          const size_t t = (size_t)t0 + tb * 32 + tb16 * 16 + fr; const int col = g * 16 + 4 * fq;
          const uint2 uw = *(const uint2*)(PROJ + t * DINP + C_S5 + col);
          f32x4 o;
          o[0] = gelu_tanh(y[0] + dcol4.x * __uint_as_float(uw.x << 16)); o[1] = gelu_tanh(y[1] + dcol4.y * __uint_as_float(uw.x & 0xffff0000u));
          o[2] = gelu_tanh(y[2] + dcol4.z * __uint_as_float(uw.y << 16)); o[3] = gelu_tanh(y[3] + dcol4.w * __uint_as_float(uw.y & 0xffff0000u));
          st_bf16x4(YCP + t * 256 + col, o);
        }
      }
    }
    if (!FULL) {
#pragma unroll
      for (int sb = 0; sb < 2; ++sb) if (h == 0) SLOC[((size_t)(b * 32 + chunk) * 16 + g) * 64 + sb * 32 + r] = make_float2(hr[sb], hi[sb]);
    }
  }
}

template <bool FULL>
DEVI void lru_chunk(const Params& p, int l, int b, int chunk, float* tile) {
  const bf16_t* PROJ = (const bf16_t*)(p.ws + WS_B);
  const bf16_t* GATES = (const bf16_t*)(p.ws + WS_E);
  float2* LSUM = (float2*)(p.ws + SM_LSUM);
  const int c = HTID, h = c >> 6, j = c & 63;
  const float* cw = p.in[10] + l * 4 * 256;
  const float w0 = cw[c], w1 = cw[256 + c], w2 = cw[512 + c], w3 = cw[768 + c], cb = p.in[11][l * 256 + c];
  const float ba = p.in[13][l * 256 + c], bi = p.in[15][l * 256 + c];
  const float sp = log1pf(expf(-p.in[16][l * 256 + c]));
  const int s0 = chunk * 64; const size_t t0 = (size_t)b * S + s0;
  float xm3 = 0.f, xm2 = 0.f, xm1 = 0.f;
  if (s0 > 0) { xm3 = bf2f(PROJ[(t0 - 3) * DINP + C_LX + c]); xm2 = bf2f(PROJ[(t0 - 2) * DINP + C_LX + c]); xm1 = bf2f(PROJ[(t0 - 1) * DINP + C_LX + c]); }
  float hh = 0.f, ap = 1.f;
  if (FULL) hh = ((const float*)(p.ws + SM_LCAR))[(size_t)(b * 32 + chunk) * 256 + c];
#pragma unroll 1
  for (int k0 = 0; k0 < 64; k0 += 8) {
    float xv[8], rp[8], ip[8], gt[8];
#pragma unroll
    for (int i = 0; i < 8; ++i) {
      const size_t t = t0 + k0 + i;
      xv[i] = bf2f(PROJ[t * DINP + C_LX + c]);
      rp[i] = bf2f(GATES[t * 512 + h * 128 + j]); ip[i] = bf2f(GATES[t * 512 + h * 128 + 64 + j]);
      gt[i] = FULL ? bf2f(PROJ[t * DINP + C_LG + c]) : 0.f;
    }
#pragma unroll
    for (int i = 0; i < 8; ++i) {
      const float u = cb + xm3 * w0 + xm2 * w1 + xm1 * w2 + xv[i] * w3;
      xm3 = xm2; xm2 = xm1; xm1 = xv[i];
      float a, bb; lru_ab(u, rp[i] + ba, ip[i] + bi, sp, (s0 + k0 + i) == 0, a, bb);
      hh = a * hh + bb; ap *= a;
      if (FULL) tile[(k0 + i) * 256 + c] = hh * gelu_tanh(gt[i]);
    }
  }
  if (!FULL) LSUM[(size_t)(b * 32 + chunk) * 256 + c] = make_float2(ap, hh);
}

DEVI void phase_r2(const Params& p, int l, unsigned char* lds) {
  unsigned char* wl = p.ws + WS_W + l * WS_WL;
  const bf16_t* PROJ = (const bf16_t*)(p.ws + WS_B);
  const bf16_t* QR = (const bf16_t*)(p.ws + WS_D);
  const bf16_t* KVR = QR + (size_t)T * 384;
  const bf16_t* GATES = (const bf16_t*)(p.ws + WS_E);
  bf16_t* MQ = (bf16_t*)(p.ws + WS_F);
  bf16_t* MK = MQ + (size_t)T * 4 * 96;
  const float2* RM = (const float2*)(p.ws + WS_ROPE);
  const float2* RN = RM + (size_t)T * 16;
  const int tid = HTID, lane = tid & 63, wv = tid >> 6;
  for (int it = VBID; it < NB * 32; it += VGRID) lru_chunk<false>(p, l, it >> 5, it & 31, nullptr);
  hsync();
  for (int it = VBID; it < NB * 32; it += VGRID) s5_chunk<false>(p, l, it >> 5, it & 31, lds);
  {
    const bf16_t* HK = (const bf16_t*)(p.ws + SM_HK); const bf16_t* HV = (const bf16_t*)(p.ws + SM_HV);
    bf16_t* KC = (bf16_t*)(p.ws + SM_KC); bf16_t* VC = (bf16_t*)(p.ws + SM_VC);
    const bf16_t* W2K = (const bf16_t*)(wl + W_2K); const bf16_t* W2V = (const bf16_t*)(wl + W_2V);
    const float* g0 = p.in[28] + l * 192;
    for (int it = VBID; it < 32; it += VGRID) {
      const int kv = it & 1, mt = it >> 1;
      const bf16_t* H = kv ? HV : HK; const bf16_t* W2 = kv ? W2V : W2K;
      f32x4 acc[4][4];
      hsync();
      gemm128g(lds, 128, [&](int r, int k) { return H + (size_t)(mt * 128 + r) * 128 + k; }, [&](int r, int k) { return W2 + (size_t)(r & 63) * 128 + k; }, acc);
      const int wid = tid >> 6, wr = wid >> 1, wc = wid & 1, fr = lane & 15, fq = lane >> 4;
      if (wc == 0) {
#pragma unroll
        for (int m = 0; m < 4; ++m) {
          const int row = mt * 128 + wr * 64 + m * 16 + fr, b = row >> 7, c = row & 127;
          f32x4 v[4];
#pragma unroll
          for (int n = 0; n < 4; ++n) v[n] = acc[m][n];
          if (kv == 0) {
            float ss = 0.f;
#pragma unroll
            for (int n = 0; n < 4; ++n) ss += v[n][0] * v[n][0] + v[n][1] * v[n][1] + v[n][2] * v[n][2] + v[n][3] * v[n][3];
            ss += __shfl_xor(ss, 16); ss += __shfl_xor(ss, 32);
            const float rs = rsqrtf(ss * (1.f / 64) + EPS);
#pragma unroll
            for (int n = 0; n < 4; ++n) { const float4 gg = *(const float4*)(g0 + n * 16 + fq * 4); v[n][0] *= rs * gg.x; v[n][1] *= rs * gg.y; v[n][2] *= rs * gg.z; v[n][3] *= rs * gg.w; }
            const int cc = (c < 127) ? c : 126;
            const float2* cs = RN + (size_t)(b * S + 16 * cc + 31) * 8;
#pragma unroll
            for (int j = 0; j < 4; ++j) {
              const float x = v[0][j], partner = __shfl_xor(x, 32);
              const int d = fq * 4 + j; const float2 cs2 = cs[d & 7];
              v[0][j] = (d < 8) ? (x * cs2.x - partner * cs2.y) : (partner * cs2.y + x * cs2.x);
            }
          }
          bf16_t* dst = (kv ? VC : KC) + (size_t)row * 64;
#pragma unroll
          for (int n = 0; n < 4; ++n) { f32x4 o = v[n]; if (c >= 127) o = (f32x4){0.f, 0.f, 0.f, 0.f}; st_bf16x4(dst + n * 16 + fq * 4, o); }
        }
      }
    }
  }
}

typedef short v4i16_t __attribute__((ext_vector_type(4)));
DEVI float fexp2(float x) { return __builtin_amdgcn_exp2f(x); }
constexpr int VST = 96;
constexpr int ATT_VBYTES = 64 * VST * 2;
template <int DK> constexpr int att_kbytes() { return 64 * (DK + 8) * 2; }
template <int DK> constexpr int att_buf() { return att_kbytes<DK>() + ATT_VBYTES; }
template <int DK> struct TileRegs { u32x4 k[(64 * DK / 8 + 511) / 512]; u32x4 v; };
template <int DK>
DEVI void tile_load(TileRegs<DK>& tr, const bf16_t* kbase, size_t kstride, const bf16_t* vbase, size_t vstride, int key0, bool withv = true) {
  constexpr int CH = DK / 8, NCH = 64 * CH;
#pragma unroll
  for (int i = 0; i < (NCH + 511) / 512; ++i) { const int c = (int)threadIdx.x + 512 * i; if (c < NCH) { const int r = c / CH, cc = c % CH; tr.k[i] = *(const u32x4*)(kbase + (size_t)(key0 + r) * kstride + cc * 8); } }
  if (withv) { const int c = (int)threadIdx.x, r = c >> 3, cc = c & 7; tr.v = *(const u32x4*)(vbase + (size_t)(key0 + r) * vstride + cc * 8); }
}
template <int DK>
DEVI void tile_store(const TileRegs<DK>& tr, unsigned char* buf, bool withv = true) {
  constexpr int CH = DK / 8, NCH = 64 * CH;
  bf16_t* sK = (bf16_t*)buf; bf16_t* sV = (bf16_t*)(buf + att_kbytes<DK>());
#pragma unroll
  for (int i = 0; i < (NCH + 511) / 512; ++i) { const int c = (int)threadIdx.x + 512 * i; if (c < NCH) { const int r = c / CH, cc = c % CH; *(u32x4*)(sK + r * (DK + 8) + cc * 8) = tr.k[i]; } }
  if (withv) { const int c = (int)threadIdx.x, r = c >> 3, cc = c & 7; *(u32x4*)(sV + r * VST + cc * 8) = tr.v; }
}
template <int DK>
DEVI void qk_tile(const bf16_t* sK, const bf16x8* qf, f32x16& s0, f32x16& s1, int r, int h) {
#pragma unroll
  for (int i = 0; i < 16; ++i) { s0[i] = 0.f; s1[i] = 0.f; }
#pragma unroll
  for (int kk = 0; kk < DK / 16; ++kk) {
    const bf16x8 a0 = *(const bf16x8*)(sK + r * (DK + 8) + kk * 16 + h * 8);
    const bf16x8 a1 = *(const bf16x8*)(sK + (32 + r) * (DK + 8) + kk * 16 + h * 8);
    s0 = mfma32(a0, qf[kk], s0);
    s1 = mfma32(a1, qf[kk], s1);
  }
}
struct FState { f32x16 o0, o1; float m, l; };
DEVI void fstate_init(FState& f) {
#pragma unroll
  for (int i = 0; i < 16; ++i) { f.o0[i] = 0.f; f.o1[i] = 0.f; }
  f.m = -INFINITY; f.l = 0.f;
}
DEVI v4i16_t vtr(const bf16_t* p) { return __builtin_amdgcn_ds_read_tr16_b64_v4i16((LAS v4i16_t*)p); }
DEVI void softmax_pv(FState& f, f32x16& s0, f32x16& s1, const bf16_t* sV, int lane) {
  const int h = lane >> 5;
  float mx = -INFINITY;
#pragma unroll
  for (int i = 0; i < 16; ++i) mx = fmaxf(mx, fmaxf(s0[i], s1[i]));
  mx = fmaxf(mx, __shfl_xor(mx, 32));
  const float mnew = fmaxf(f.m, mx);
  const float muse = (mnew == -INFINITY) ? 0.f : mnew;
  float ps = 0.f;
#pragma unroll
  for (int i = 0; i < 16; ++i) { s0[i] = fexp2(s0[i] - muse); s1[i] = fexp2(s1[i] - muse); ps += s0[i] + s1[i]; }
  ps += __shfl_xor(ps, 32);
  if (__any(mnew != f.m)) {
    const float alpha = fexp2(f.m - muse);
    f.l = f.l * alpha + ps; f.m = mnew;
#pragma unroll
    for (int i = 0; i < 16; ++i) { f.o0[i] *= alpha; f.o1[i] *= alpha; }
  } else {
    f.l += ps;
  }
  const int g = lane >> 4, li = lane & 15, q = li >> 2, pp = li & 3;
  const bf16_t* vb = sV + (4 * h + q) * VST + (g & 1) * 16 + 4 * pp;
#pragma unroll
  for (int kb = 0; kb < 2; ++kb)
#pragma unroll
    for (int s = 0; s < 2; ++s) {
      unsigned pw[4];
#pragma unroll
      for (int j = 0; j < 4; ++j) pw[j] = kb ? pk2bf(s1[8 * s + 2 * j], s1[8 * s + 2 * j + 1]) : pk2bf(s0[8 * s + 2 * j], s0[8 * s + 2 * j + 1]);
      const bf16x8 pb = __builtin_bit_cast(bf16x8, (u32x4){pw[0], pw[1], pw[2], pw[3]});
#pragma unroll
      for (int db = 0; db < 2; ++db) {
        const v4i16_t lo = vtr(vb + (kb * 32 + 16 * s) * VST + db * 32);
        const v4i16_t hi = vtr(vb + (kb * 32 + 16 * s + 8) * VST + db * 32);
        const bf16x8 a = {lo[0], lo[1], lo[2], lo[3], hi[0], hi[1], hi[2], hi[3]};
        if (db == 0) f.o0 = mfma32(a, pb, f.o0); else f.o1 = mfma32(a, pb, f.o1);
      }
    }
}
DEVI void store_o(bf16_t* orow, const f32x16& o0, const f32x16& o1, float sc, int h) {
#pragma unroll
  for (int g = 0; g < 4; ++g) {
    uint2 v0, v1;
    v0.x = pk2bf(o0[4 * g] * sc, o0[4 * g + 1] * sc); v0.y = pk2bf(o0[4 * g + 2] * sc, o0[4 * g + 3] * sc);
    v1.x = pk2bf(o1[4 * g] * sc, o1[4 * g + 1] * sc); v1.y = pk2bf(o1[4 * g + 2] * sc, o1[4 * g + 3] * sc);
    *(uint2*)(orow + 8 * g + 4 * h) = v0;
    *(uint2*)(orow + 32 + 8 * g + 4 * h) = v1;
  }
}

DEVI void mla_item(const Params& p, int l, int b, int hd, int qt, unsigned char* lds) {
  const bf16_t* MQ = (const bf16_t*)(p.ws + WS_F);
  const bf16_t* MK = MQ + (size_t)T * 4 * 96;
  const bf16_t* KVR = (const bf16_t*)(p.ws + WS_D) + (size_t)T * 384;
  bf16_t* YA = (bf16_t*)(p.ws + WS_C);
  const int tid = (int)threadIdx.x, wv = tid >> 6, lane = tid & 63, r = lane & 31, h = lane >> 5;
  const int q0 = qt * 256 + wv * 32, tq = q0 + r;
  bf16x8 qf[6];
  {
    const bf16_t* qrow = (const bf16_t*)(p.ws + WS_D) + ((size_t)b * S + tq) * 384 + hd * 96;
    const float* g_q = p.in[8] + l * 96;
    float qv[6][8]; float ss = 0.f;
#pragma unroll
    for (int kk = 0; kk < 6; ++kk) {
      const u32x4 w = *(const u32x4*)(qrow + kk * 16 + h * 8);
#pragma unroll
      for (int e = 0; e < 4; ++e) { qv[kk][2 * e] = __uint_as_float(w[e] << 16); qv[kk][2 * e + 1] = __uint_as_float(w[e] & 0xffff0000u); ss += qv[kk][2 * e] * qv[kk][2 * e] + qv[kk][2 * e + 1] * qv[kk][2 * e + 1]; }
    }
    ss += __shfl_xor(ss, 32);
    const float rs = rsqrtf(ss * (1.f / 96) + EPS) * (0.10206207261596575f * LOG2E);
#pragma unroll
    for (int kk = 0; kk < 6; ++kk)
#pragma unroll
      for (int j = 0; j < 8; ++j) qv[kk][j] *= rs * g_q[kk * 16 + h * 8 + j];
    const float2* cs = (const float2*)(p.ws + WS_ROPE) + ((size_t)b * S + tq) * 16 + 8 * h;
#pragma unroll
    for (int j = 0; j < 8; ++j) { const float2 c2 = cs[j]; const float x1 = qv[0][j], x2 = qv[1][j]; qv[0][j] = x1 * c2.x - x2 * c2.y; qv[1][j] = x1 * c2.y + x2 * c2.x; }
#pragma unroll
    for (int kk = 0; kk < 6; ++kk) { const u32x4 w = {pk2bf(qv[kk][0], qv[kk][1]), pk2bf(qv[kk][2], qv[kk][3]), pk2bf(qv[kk][4], qv[kk][5]), pk2bf(qv[kk][6], qv[kk][7])}; qf[kk] = __builtin_bit_cast(bf16x8, w); }
  }
  FState f; fstate_init(f);
  const bf16_t* kbase = MK + (size_t)(b * 4 + hd) * S * 96;
  const bf16_t* vbase = KVR + (size_t)b * S * 512 + hd * 128 + 64;
  const int ntiles = 4 * qt + 4;
  TileRegs<96> tr;
  TileRegs<96> tr2;
  tile_load<96>(tr, kbase, 96, vbase, 512, 0);
  tile_load<96>(tr2, kbase, 96, vbase, 512, 64);
  __syncthreads();
  tile_store<96>(tr, lds);
  __syncthreads();
  auto compute = [&](int kt, unsigned char* cur) {
    if (kt * 64 <= q0 + 31) {
      f32x16 s0, s1;
      qk_tile<96>((const bf16_t*)cur, qf, s0, s1, r, h);
      if (kt * 64 + 63 > q0) {
        int rel = tq - kt * 64 - 4 * h; asm volatile("" : "+v"(rel));
#pragma unroll
        for (int i = 0; i < 16; ++i) { const int kk2 = (i & 3) + 8 * (i >> 2); if (kk2 > rel) s0[i] = -INFINITY; if (kk2 + 32 > rel) s1[i] = -INFINITY; }
      }
      softmax_pv(f, s0, s1, (const bf16_t*)(cur + att_kbytes<96>()), lane);
    }
  };
#pragma unroll 1
  for (int kt = 0; kt < ntiles; kt += 2) {
    if (kt + 2 < ntiles) tile_load<96>(tr, kbase, 96, vbase, 512, (kt + 2) * 64);
    compute(kt, lds);
    tile_store<96>(tr2, lds + att_buf<96>());
    __syncthreads();
    if (kt + 3 < ntiles) tile_load<96>(tr2, kbase, 96, vbase, 512, (kt + 3) * 64);
    compute(kt + 1, lds + att_buf<96>());
    if (kt + 2 < ntiles) tile_store<96>(tr, lds);
    __syncthreads();
  }
  store_o(YA + (size_t)(b * S + tq) * 256 + hd * 64, f.o0, f.o1, 1.f / f.l, h);
}

template <class KF, class BODY>
DEVI void nsa_stream(unsigned char* lds, const bf16_t* kbase, size_t kstride, const bf16_t* vbase, size_t vstride, bool withv, int nt, KF key0f, BODY body) {
  if (nt <= 0) return;
  TileRegs<64> trA, trB;
  tile_load<64>(trA, kbase, kstride, vbase, vstride, key0f(0), withv);
  if (nt > 1) tile_load<64>(trB, kbase, kstride, vbase, vstride, key0f(1), withv);
  __syncthreads();
  tile_store<64>(trA, lds, withv);
  __syncthreads();
  unsigned char* buf0 = lds; unsigned char* buf1 = lds + att_buf<64>();
#pragma unroll 1
  for (int i = 0; i < nt; i += 2) {
    if (i + 2 < nt) tile_load<64>(trA, kbase, kstride, vbase, vstride, key0f(i + 2), withv);
    body(i, buf0);
    if (i + 1 < nt) tile_store<64>(trB, buf1, withv);
    __syncthreads();
    if (i + 1 >= nt) break;
    if (i + 3 < nt) tile_load<64>(trB, kbase, kstride, vbase, vstride, key0f(i + 3), withv);
    body(i + 1, buf1);
    if (i + 2 < nt) tile_store<64>(trA, buf0, withv);
    __syncthreads();
  }
}
DEVI void nsa_item(const Params& p, int l, int b, int qt, unsigned char* lds) {
  const bf16_t* PROJ = (const bf16_t*)(p.ws + WS_B);
  const bf16_t* KC = (const bf16_t*)(p.ws + SM_KC) + (size_t)b * 128 * 64;
  const bf16_t* VC = (const bf16_t*)(p.ws + SM_VC) + (size_t)b * 128 * 64;
  const int tid = (int)threadIdx.x, wv = tid >> 6, lane = tid & 63, r = lane & 31, h = lane >> 5;
  float* psum = (float*)(lds + 2 * att_buf<64>());
  unsigned* selm = (unsigned*)(lds + 2 * att_buf<64>() + 32768);
  const int t0 = qt * 64, cur = t0 >> 6;
  const int ql = wv * 8 + (r >> 2), hd = r & 3, tq = t0 + ql;
  const size_t tg = (size_t)b * S + tq;
  bf16x8 qf[4];
#pragma unroll
  for (int kk = 0; kk < 4; ++kk) qf[kk] = *(const bf16x8*)((const bf16_t*)(p.ws + WS_G) + tg * 256 + hd * 64 + kk * 16 + h * 8);
  unsigned* ofs = (unsigned*)psum + wv * 1024 + lane;
  const float g0 = sigmoidf_(bf2f(PROJ[tg * DINP + C_NG + hd * 3 + 0]));
  const float g1 = sigmoidf_(bf2f(PROJ[tg * DINP + C_NG + hd * 3 + 1]));
  const float g2 = sigmoidf_(bf2f(PROJ[tg * DINP + C_NG + hd * 3 + 2]));
  FState f; fstate_init(f);
  const int ncmp = (((t0 + 32) >> 4) >> 6) + 1;
  nsa_stream(lds, KC, 64, VC, 64, true, ncmp, [&](int i) { return i * 64; }, [&](int kt, unsigned char* buf) {
    f32x16 s0, s1;
    qk_tile<64>((const bf16_t*)buf, qf, s0, s1, r, h);
    int rel = ((tq - 31) >> 4) - kt * 64 - 4 * h; asm volatile("" : "+v"(rel));
#pragma unroll
    for (int i = 0; i < 16; ++i) { const int kk2 = (i & 3) + 8 * (i >> 2); if (kk2 > rel) s0[i] = -INFINITY; if (kk2 + 32 > rel) s1[i] = -INFINITY; }
    softmax_pv(f, s0, s1, (const bf16_t*)(buf + att_kbytes<64>()), lane);
  });
  {
    const float muse = (f.m == -INFINITY) ? 0.f : f.m;
    const float il = (f.l > 0.f) ? 1.f / f.l : 0.f;
    if (ncmp < 2) {
#pragma unroll 1
      for (int i = tid; i < 64 * 128; i += KTHREADS) psum[i] = 0.f;
      __syncthreads();
    }
    nsa_stream(lds, KC, 64, VC, 64, false, ncmp, [&](int i) { return i * 64; }, [&](int kt, unsigned char* buf) {
      f32x16 s0, s1;
      qk_tile<64>((const bf16_t*)buf, qf, s0, s1, r, h);
      int rel = ((tq - 31) >> 4) - kt * 64 - 4 * h; asm volatile("" : "+v"(rel));
      int cb0 = kt * 64 + 4 * h; asm volatile("" : "+v"(cb0));
#pragma unroll
      for (int i = 0; i < 16; ++i) {
        const int kk2 = (i & 3) + 8 * (i >> 2); const int c = cb0 + kk2;
        float p0 = (kk2 > rel) ? 0.f : fexp2(s0[i] - muse) * il;
        float p1 = (kk2 + 32 > rel) ? 0.f : fexp2(s1[i] - muse) * il;
        p0 += __shfl_xor(p0, 1); p0 += __shfl_xor(p0, 2);
        p1 += __shfl_xor(p1, 1); p1 += __shfl_xor(p1, 2);
        if (hd == 0) { psum[ql * 128 + c] = p0; psum[ql * 128 + c + 32] = p1; }
      }
    });
  }
  __syncthreads();
#pragma unroll 1
  for (int itq = 0; itq < 4; ++itq) {
    const int q2 = wv * 8 + itq * 2 + (lane >> 5), j = lane & 31;
    const float* ps = psum + q2 * 128;
    float imp = 2.f * (ps[4 * j] + ps[4 * j + 1] + ps[4 * j + 2]) + ps[4 * j + 3];
    if (j > 0) imp += ps[4 * j - 1];
    const bool cand = (j >= 1) && (j <= cur - 2);
    int rank = 0;
    for (int jj = 0; jj < 32; ++jj) {
      const float v = __shfl(imp, (lane & 32) | jj);
      const bool cj = (jj >= 1) && (jj <= cur - 2);
      if (cj && (v > imp || (v == imp && jj < j))) ++rank;
    }
    const bool sel = cand && rank < 2;
    const unsigned long long bal = __ballot(sel);
    unsigned mk = (unsigned)(bal >> (32 * (lane >> 5)));
    mk |= 1u | (1u << cur); if (cur >= 1) mk |= (1u << (cur - 1));
    if (j == 0) selm[q2] = mk;
  }
  __syncthreads();
  unsigned blk_or = 0, wave_or = 0;
  for (int i = 0; i < 64; ++i) blk_or |= selm[i];
  for (int i = 0; i < 8; ++i) wave_or |= selm[wv * 8 + i];
  const unsigned mymask = selm[ql];
  {
    const float sc = (f.l > 0.f) ? g0 / f.l : 0.f;
#pragma unroll
    for (int i = 0; i < 8; ++i) { ofs[i * 64] = pk2bf(f.o0[2 * i] * sc, f.o0[2 * i + 1] * sc); ofs[(8 + i) * 64] = pk2bf(f.o1[2 * i] * sc, f.o1[2 * i + 1] * sc); }
  }
  fstate_init(f);
  {
    unsigned* tl = selm + 64;
    if (tid < 32 && ((blk_or >> tid) & 1u)) tl[__popc(blk_or & ((1u << tid) - 1u))] = tid;
    __syncthreads();
    const int nsel = __popc(blk_or);
    nsa_stream(lds, (const bf16_t*)(p.ws + WS_G) + (size_t)T * 256 + (size_t)b * S * 64, 64, PROJ + (size_t)b * S * DINP + C_VS, DINP, true, nsel,
      [&](int i) { return (int)tl[i] * 64; },
      [&](int i, unsigned char* buf) {
        const int jj = (int)tl[i];
        if ((wave_or >> jj) & 1u) {
          f32x16 s0, s1;
          qk_tile<64>((const bf16_t*)buf, qf, s0, s1, r, h);
          const bool on = (mymask >> jj) & 1u;
          int rel = on ? (tq - jj * 64 - 4 * h) : -1; asm volatile("" : "+v"(rel));
#pragma unroll
          for (int i2 = 0; i2 < 16; ++i2) { const int kk2 = (i2 & 3) + 8 * (i2 >> 2); if (kk2 > rel) s0[i2] = -INFINITY; if (kk2 + 32 > rel) s1[i2] = -INFINITY; }
          softmax_pv(f, s0, s1, (const bf16_t*)(buf + att_kbytes<64>()), lane);
        }
      });
    const float sc = (f.l > 0.f) ? g1 / f.l : 0.f;
#pragma unroll
    for (int i = 0; i < 8; ++i) {
      const unsigned w0 = ofs[i * 64], w1 = ofs[(8 + i) * 64];
      ofs[i * 64] = pk2bf(__uint_as_float(w0 << 16) + f.o0[2 * i] * sc, __uint_as_float(w0 & 0xffff0000u) + f.o0[2 * i + 1] * sc);
      ofs[(8 + i) * 64] = pk2bf(__uint_as_float(w1 << 16) + f.o1[2 * i] * sc, __uint_as_float(w1 & 0xffff0000u) + f.o1[2 * i + 1] * sc);
    }
  }
  fstate_init(f);
  {
    int jlo = (t0 - 511) >> 6; if (jlo < 0) jlo = 0;
    nsa_stream(lds, (const bf16_t*)(p.ws + WS_G) + (size_t)T * 320 + (size_t)b * S * 64, 64, PROJ + (size_t)b * S * DINP + C_VW, DINP, true, cur - jlo + 1,
      [&](int i) { return (jlo + i) * 64; },
      [&](int i, unsigned char* buf) {
        const int j = jlo + i;
        f32x16 s0, s1;
        qk_tile<64>((const bf16_t*)buf, qf, s0, s1, r, h);
        if (j == cur || j * 64 < t0 + 63 - 511 + 64) {
          int rel = tq - j * 64 - 4 * h; asm volatile("" : "+v"(rel));
#pragma unroll
          for (int i2 = 0; i2 < 16; ++i2) {
            const int kk2 = (i2 & 3) + 8 * (i2 >> 2);
            if (kk2 > rel || kk2 < rel - 511) s0[i2] = -INFINITY;
            if (kk2 + 32 > rel || kk2 + 32 < rel - 511) s1[i2] = -INFINITY;
          }
        }
        softmax_pv(f, s0, s1, (const bf16_t*)(buf + att_kbytes<64>()), lane);
      });
    const float sc = (f.l > 0.f) ? g2 / f.l : 0.f;
#pragma unroll
    for (int i = 0; i < 8; ++i) {
      const unsigned w0 = ofs[i * 64], w1 = ofs[(8 + i) * 64];
      f.o0[2 * i] = __uint_as_float(w0 << 16) + f.o0[2 * i] * sc; f.o0[2 * i + 1] = __uint_as_float(w0 & 0xffff0000u) + f.o0[2 * i + 1] * sc;
      f.o1[2 * i] = __uint_as_float(w1 << 16) + f.o1[2 * i] * sc; f.o1[2 * i + 1] = __uint_as_float(w1 & 0xffff0000u) + f.o1[2 * i + 1] * sc;
    }
  }
  f32x16& of0 = f.o0; f32x16& of1 = f.o1;
  {
    float ss = 0.f;
#pragma unroll
    for (int i = 0; i < 16; ++i) ss += of0[i] * of0[i] + of1[i] * of1[i];
    ss += __shfl_xor(ss, 1); ss += __shfl_xor(ss, 2); ss += __shfl_xor(ss, 32);
    const float rs = rsqrtf(ss * (1.f / 256) + EPS);
    const float* on = p.in[35] + l * 1024 + 768 + hd * 64;
#pragma unroll
    for (int g4 = 0; g4 < 4; ++g4) {
      const float4 a = *(const float4*)(on + 8 * g4 + 4 * h), b4 = *(const float4*)(on + 32 + 8 * g4 + 4 * h);
      of0[4 * g4] *= a.x; of0[4 * g4 + 1] *= a.y; of0[4 * g4 + 2] *= a.z; of0[4 * g4 + 3] *= a.w;
      of1[4 * g4] *= b4.x; of1[4 * g4 + 1] *= b4.y; of1[4 * g4 + 2] *= b4.z; of1[4 * g4 + 3] *= b4.w;
    }
    store_o((bf16_t*)(p.ws + WS_A) + tg * 1024 + 768 + hd * 64, of0, of1, rs, h);
  }
}

DEVI void carry_item(const Params& p, int l, int it) {
  const int tid = HTID;
  if (it < 64) {
    const int idx = it * 256 + tid, b = idx >> 10, gs = idx & 1023;
    const float2 a64 = ((const float2*)(p.ws + WS_W + l * WS_WL + W_S5A64))[gs];
    const float2* SLOC = (const float2*)(p.ws + SM_SLOC) + (size_t)b * 32 * 1024 + gs;
    float2* SCAR = (float2*)(p.ws + SM_SCAR) + (size_t)b * 32 * 1024 + gs;
    float hr = 0.f, hi = 0.f;
#pragma unroll 1
    for (int c0 = 0; c0 < 32; c0 += 8) {
      float2 sl[8];
#pragma unroll
      for (int i = 0; i < 8; ++i) sl[i] = SLOC[(size_t)(c0 + i) * 1024];
#pragma unroll
      for (int i = 0; i < 8; ++i) { SCAR[(size_t)(c0 + i) * 1024] = make_float2(hr, hi); const float nr = a64.x * hr - a64.y * hi + sl[i].x, ni = a64.x * hi + a64.y * hr + sl[i].y; hr = nr; hi = ni; }
    }
  } else {
    const int idx = (it - 64) * 256 + tid, b = idx >> 8, c = idx & 255;
    const float2* LSUM = (const float2*)(p.ws + SM_LSUM) + (size_t)b * 32 * 256 + c;
    float* LCAR = (float*)(p.ws + SM_LCAR) + (size_t)b * 32 * 256 + c;
    float hh = 0.f;
#pragma unroll 1
    for (int c0 = 0; c0 < 32; c0 += 8) {
      float2 sv[8];
#pragma unroll
      for (int i = 0; i < 8; ++i) sv[i] = LSUM[(size_t)(c0 + i) * 256];
#pragma unroll
      for (int i = 0; i < 8; ++i) { LCAR[(size_t)(c0 + i) * 256] = hh; hh = sv[i].x * hh + sv[i].y; }
    }
  }
}
DEVI void phase_a1(const Params& p, int l, unsigned char* lds_full) {
  for (int it = VBID; it < 80; it += VGRID) carry_item(p, l, it);
  __syncthreads();
  const int G_ = (int)gridDim.x, bx_ = (int)blockIdx.x, vb_ = (G_ % 8 == 0) ? (bx_ % 8) * (G_ / 8) + bx_ / 8 : bx_;
  for (int rr = 0; rr * G_ < 512; ++rr) { const int j = rr * G_ + ((rr & 1) ? (G_ - 1 - vb_) : vb_); if (j < 512) { const int b = j >> 5, qt = 31 - (j & 31); nsa_item(p, l, b, qt, lds_full); } }
  __syncthreads();
  for (int rr = 0; rr * G_ < 512; ++rr) { const int j = rr * G_ + ((rr & 1) ? (G_ - 1 - vb_) : vb_); if (j < 512) { const int bh = j >> 3, qt = 7 - (j & 7); mla_item(p, l, bh >> 2, bh & 3, qt, lds_full); } }
}

DEVI void phase_r3(const Params& p, int l, unsigned char* lds) {
  bf16_t* Y = (bf16_t*)(p.ws + WS_A);
  const int tid = HTID, lane = tid & 63, wv = tid >> 6;
  {
    const float* onorm = p.in[35] + l * 1024 + 256;
    float* tile = (float*)lds;
    for (int it = VBID; it < NB * 32; it += VGRID) {
      const int b = it >> 5, chunk = it & 31;
      hsync();
      lru_chunk<true>(p, l, b, chunk, tile);
      hsync();
      for (int k = wv; k < 64; k += 4) {
        const float4 v = *(const float4*)(tile + k * 256 + lane * 4);
        const float rs = rsqrtf(wsum(v.x * v.x + v.y * v.y + v.z * v.z + v.w * v.w) * (1.f / 256) + EPS);
        const size_t t = (size_t)b * S + chunk * 64 + k;
        const float4 gg = *(const float4*)(onorm + lane * 4);
        st_bf16x4(Y + t * 1024 + 256 + lane * 4, (f32x4){v.x * rs * gg.x, v.y * rs * gg.y, v.z * rs * gg.z, v.w * rs * gg.w});
      }
    }
  }
  hsync();
  for (int it = VBID; it < NB * 32; it += VGRID) s5_chunk<true>(p, l, it >> 5, it & 31, lds);
}

DEVI void phase_g3(const Params& p, int l, unsigned char* lds) {
  const bf16_t* YCP = (const bf16_t*)(p.ws + WS_F);
  bf16_t* YC = (bf16_t*)(p.ws + WS_F) + (size_t)T * 256;
  const bf16_t* W = (const bf16_t*)(p.ws + WS_W + l * WS_WL + W_GLU);
  const float* bg = p.in[26] + l * 256;
  for (int it = vblock(); it < 256 * 2; it += VGRID) {
    const int mt = it >> 1, nt = it & 1;
    f32x4 acc[4][4];
    gemm128g(lds, 256, [&](int r, int k) { return YCP + (size_t)(mt * 128 + r) * 256 + k; }, [&](int r, int k) { return W + (size_t)(nt * 128 + r) * 256 + k; }, acc);
    GEMM_EPI4({ const size_t o = (size_t)(mt * 128 + er) * 256 + nt * 128 + ec0; const ushort4 yp = *(const ushort4*)(YCP + o); f32x4 r4; r4[0] = bf2f(yp.x) * sigmoidf_(ev4[0] + bg[nt * 128 + ec0]); r4[1] = bf2f(yp.y) * sigmoidf_(ev4[1] + bg[nt * 128 + ec0 + 1]); r4[2] = bf2f(yp.z) * sigmoidf_(ev4[2] + bg[nt * 128 + ec0 + 2]); r4[3] = bf2f(yp.w) * sigmoidf_(ev4[3] + bg[nt * 128 + ec0 + 3]); st_bf16x4(YC + o, r4); })
  }
}

DEVI void phase_r4(const Params& p, int l) {
  const bf16_t* YA = (const bf16_t*)(p.ws + WS_C);
  const bf16_t* YC = (const bf16_t*)(p.ws + WS_F) + (size_t)T * 256;
  bf16_t* Y = (bf16_t*)(p.ws + WS_A);
  const float* onorm = p.in[35] + l * 1024;
  const int lane = HTID & 63, gw = VBID * 4 + (HTID >> 6), NGW = VGRID * 4;
  for (int t = gw; t < T; t += NGW) {
#pragma unroll
    for (int grp = 0; grp < 2; ++grp) {
      const bf16_t* src = (grp == 0 ? YA : YC) + (size_t)t * 256;
      const int gcol = (grp == 0 ? 0 : 512);
      const ushort4 u = ((const ushort4*)src)[lane];
      const float v0 = bf2f(u.x), v1 = bf2f(u.y), v2 = bf2f(u.z), v3 = bf2f(u.w);
      const float rs = rsqrtf(wsum(v0 * v0 + v1 * v1 + v2 * v2 + v3 * v3) * (1.f / 256) + EPS);
      const float4 g = ((const float4*)(onorm + gcol))[lane];
      uint2 o; o.x = pk2bf(v0 * rs * g.x, v1 * rs * g.y); o.y = pk2bf(v2 * rs * g.z, v3 * rs * g.w);
      ((uint2*)(Y + (size_t)t * 1024 + gcol))[lane] = o;
    }
  }
}

DEVI void phase_g4(const Params& p, int l, unsigned char* lds_full) {
  const bf16_t* Y = (const bf16_t*)(p.ws + WS_A);
  const bf16_t* W = (const bf16_t*)(p.ws + WS_W + l * WS_WL + W_OUT);
  pg8::Gemm g{Y, W, T, D, D}; pg8::StaticOrder S; S.init(T, D, (int)gridDim.x, (int)blockIdx.x);
  bf16_t* X1 = (bf16_t*)(p.ws + WS_D);
  if (l == 0) { EpiRes<false> E{p.in[0], nullptr, X1}; pg8::gemm_phase<EpiRes<false>, pg8::StaticOrder, true, true>((LAS unsigned char*)lds_full, g, S, E); }
  else { EpiRes<true> E{nullptr, (const bf16_t*)p.out, X1}; pg8::gemm_phase<EpiRes<true>, pg8::StaticOrder, true, true>((LAS unsigned char*)lds_full, g, S, E); }
}

DEVI void phase_r5(const Params& p, int l, unsigned char* lds) {
  const bf16_t* x1 = (const bf16_t*)(p.ws + WS_D);
  const bf16_t* WH = (const bf16_t*)(p.ws + WS_W + l * WS_WL + W_RTH);
  const bf16_t* WL = (const bf16_t*)(p.ws + WS_W + l * WS_WL + W_RTL);
  const float* brg = p.in[39] + l * 4; const float* bre = p.in[41] + l * 16;
  int* CNT = (int*)(p.ws + SM_CNT) + l * 32;
  int* LIST = (int*)(p.ws + SM_LIST);
  float4* TOKW = (float4*)(p.ws + SM_TOKW);
  const int tid = HTID, lane = tid & 63, wv = tid >> 6, c = lane & 15, q = lane >> 4;
  float* red = (float*)lds;
  int* hist = (int*)(lds + 16384);
  int* tokl = (int*)(lds + 16384 + 256);
  if (tid < 64) hist[tid] = 0;
  int ntok = 0;
  hsync();
  for (int it = VBID; it < T / 16; it += VGRID) {
    const size_t tb = (size_t)it * 16;
    f32x4 a0 = (f32x4){0.f, 0.f, 0.f, 0.f}, a1 = (f32x4){0.f, 0.f, 0.f, 0.f};
    float ss = 0.f;
    const bf16_t* xrow = x1 + (tb + c) * D + wv * 256 + 8 * q;
    const bf16_t* wh0 = WH + (size_t)c * 1024 + wv * 256 + 8 * q;
    const bf16_t* wl0 = WL + (size_t)c * 1024 + wv * 256 + 8 * q;
    u32x4 xk[8];
#pragma unroll
    for (int ks = 0; ks < 8; ++ks) xk[ks] = *(const u32x4*)(xrow + ks * 32);
#pragma unroll
    for (int ks = 0; ks < 8; ++ks) {
      const bf16x8 wh_a = *(const bf16x8*)(wh0 + ks * 32), wl_a = *(const bf16x8*)(wl0 + ks * 32);
      const bf16x8 wh_b = *(const bf16x8*)(wh0 + 16 * 1024 + ks * 32), wl_b = *(const bf16x8*)(wl0 + 16 * 1024 + ks * 32);
#pragma unroll
      for (int j = 0; j < 4; ++j) {
        const float x0 = __uint_as_float(xk[ks][j] << 16), x1v = __uint_as_float(xk[ks][j] & 0xffff0000u);
        ss += x0 * x0 + x1v * x1v;
      }
      const bf16x8 xh = __builtin_bit_cast(bf16x8, xk[ks]);
      a0 = mfma16(wh_a, xh, a0); a0 = mfma16(wl_a, xh, a0);
      a1 = mfma16(wh_b, xh, a1); a1 = mfma16(wl_b, xh, a1);
    }
    ss += __shfl_xor(ss, 16); ss += __shfl_xor(ss, 32);
    hsync();
#pragma unroll
    for (int j = 0; j < 4; ++j) { red[(wv * 9 + j) * 64 + lane] = a0[j]; red[(wv * 9 + 4 + j) * 64 + lane] = a1[j]; }
    red[(wv * 9 + 8) * 64 + lane] = ss;
    hsync();
    const float s2 = red[8 * 64 + lane] + red[(9 + 8) * 64 + lane] + red[(18 + 8) * 64 + lane] + red[(27 + 8) * 64 + lane];
    const float rs = rsqrtf(s2 * (1.f / D) + EPS);
    if (wv == 0) {
      float c0[4], c1[4];
#pragma unroll
      for (int j = 0; j < 4; ++j) {
        c0[j] = red[j * 64 + lane] + red[(9 + j) * 64 + lane] + red[(18 + j) * 64 + lane] + red[(27 + j) * 64 + lane];
        c1[j] = red[(4 + j) * 64 + lane] + red[(13 + j) * 64 + lane] + red[(22 + j) * 64 + lane] + red[(31 + j) * 64 + lane];
      }
      float lg[20];
#pragma unroll
      for (int qq = 0; qq < 4; ++qq)
#pragma unroll
        for (int j = 0; j < 4; ++j) lg[4 * qq + j] = __shfl(c0[j], c + 16 * qq);
#pragma unroll
      for (int j = 0; j < 4; ++j) lg[16 + j] = __shfl(c1[j], c);
      const int t = (int)tb + c;
      float gl[4];
#pragma unroll
      for (int k2 = 0; k2 < 4; ++k2) gl[k2] = lg[k2] * rs + brg[k2];
      int gi = 0; float gbest = gl[0];
#pragma unroll
      for (int k2 = 1; k2 < 4; ++k2) if (gl[k2] > gbest) { gbest = gl[k2]; gi = k2; }
      float den = 0.f;
#pragma unroll
      for (int k2 = 0; k2 < 4; ++k2) den += expf(gl[k2] - gbest);
      const float pg = 1.f / den;
      float le[4];
#pragma unroll
      for (int k2 = 0; k2 < 4; ++k2) { float sel = 0.f;
#pragma unroll
        for (int gg2 = 0; gg2 < 4; ++gg2) sel = (gi == gg2) ? (lg[4 + gg2 * 4 + k2] * rs + bre[gg2 * 4 + k2]) : sel;
        le[k2] = sel; }
      int i0 = 0; float l0 = le[0];
#pragma unroll
      for (int k2 = 1; k2 < 4; ++k2) if (le[k2] > l0) { l0 = le[k2]; i0 = k2; }
      int i1 = -1; float l1 = -INFINITY;
#pragma unroll
      for (int k2 = 0; k2 < 4; ++k2) if (k2 != i0 && le[k2] > l1) { l1 = le[k2]; i1 = k2; }
      const float e1 = expf(l1 - l0);
      const float w0 = pg / (1.f + e1), w1 = pg * e1 / (1.f + e1);
      const int elo = (i0 < i1) ? i0 : i1, ehi = (i0 < i1) ? i1 : i0;
      const float wlo = (i0 < i1) ? w0 : w1, whi = (i0 < i1) ? w1 : w0;
      const int pidx = (elo == 0) ? (ehi - 1) : ((elo == 1) ? (ehi + 1) : 5);
      const int cls = gi * 6 + pidx;
      if (q == 0) {
        const int rank = atomicAdd(&hist[cls], 1);
        tokl[2 * (ntok + c)] = t; tokl[2 * (ntok + c) + 1] = (cls << 16) | rank;
        TOKW[t] = make_float4(wlo, whi, rs, 0.f);
      }
    }
    ntok += 16;
  }
  hsync();
  if (tid < 24) { const int n = hist[tid]; hist[32 + tid] = n ? atomicAdd(&CNT[tid], n) : 0; }
  hsync();
  for (int i = tid; i < ntok; i += NTHREADS) { const int t = tokl[2 * i], cr = tokl[2 * i + 1], cls = cr >> 16; LIST[(size_t)cls * T + hist[32 + cls] + (cr & 0xffff)] = t; }
}

struct MoeItem { int cls, mtile, nt, cnt; };
DEVI void moe_prefix(const int* CNT, unsigned char* lds) {
  int* pre = (int*)(lds + LDS_BYTES + 64);
  hsync();
  if (HTID < 24) pre[32 + HTID] = CNT[HTID];
  hsync();
  if (HTID == 0) { int a = 0; for (int c = 0; c < 24; ++c) { pre[c] = a; a += (pre[32 + c] + 127) >> 7; } pre[24] = a; }
  hsync();
}
DEVI bool moe_item(unsigned char* lds, int it, MoeItem& m) {
  const int* pre = (const int*)(lds + LDS_BYTES + 64);
  const int mt = it >> 3; m.nt = it & 7;
  if (mt >= pre[24]) return false;
  int c = 0;
#pragma unroll
  for (int q = 1; q < 24; ++q) c += (mt >= pre[q]) ? 1 : 0;
  m.cls = c; m.mtile = mt - pre[c]; m.cnt = pre[32 + c];
  return true;
}
DEVI void cls_experts(int cls, int& e0, int& e1) {
  const int g = cls / 6, pi = cls % 6;
  const int lo = (pi < 3) ? 0 : ((pi < 5) ? 1 : 2);
  const int hi = (pi < 3) ? (pi + 1) : ((pi < 5) ? (pi - 1) : 3);
  e0 = g * 4 + lo; e1 = g * 4 + hi;
}
DEVI void phase_g5(const Params& p, int l, unsigned char* lds) {
  const bf16_t* XN = (const bf16_t*)(p.ws + WS_D);
  bf16_t* HID = (bf16_t*)(p.ws + WS_B);
  const bf16_t* WGU = (const bf16_t*)(p.ws + WS_W + l * WS_WL + W_GU);
  const int* CNT = (const int*)(p.ws + SM_CNT) + l * 32;
  const int* LIST = (const int*)(p.ws + SM_LIST);
  const float4* TOKW = (const float4*)(p.ws + SM_TOKW);
  moe_prefix(CNT, lds);
  const int G_ = VGRID, total_ = ((const int*)(lds + LDS_BYTES + 64))[24] * 8, full_ = (total_ / G_) * G_, rem_ = total_ - full_;
  for (int it = vblock(); it < full_ + 2 * rem_; it += G_) {
    const bool halfmode = it >= full_; const int half = (it - full_) & 1;
    MoeItem mi; if (!moe_item(lds, halfmode ? full_ + ((it - full_) >> 1) : it, mi)) break;
    int e0, e1; cls_experts(mi.cls, e0, e1);
    const int ex = (mi.nt < 4) ? e0 : e1, ntl = mi.nt & 3;
    const bf16_t* W = WGU + ((size_t)ex * 512 + ntl * 128) * 1024;
    const int* list = LIST + (size_t)mi.cls * T + mi.mtile * 128;
    const int nvalid = mi.cnt - mi.mtile * 128;
    if (halfmode) {
      f32x4 acc2[2][4];
      int tokA[4];
#pragma unroll
      for (int i = 0; i < 4; ++i) { const int r = (HTID >> 3) + 32 * i; tokA[i] = list[(r < nvalid) ? r : 0]; }
      const int tid = HTID, wid = tid >> 6, lane = tid & 63, fr = lane & 15, fq = lane >> 4;
      int tokE2[2]; float twE2[2], rsE2[2];
#pragma unroll
      for (int m = 0; m < 2; ++m) { const int er = wid * 32 + m * 16 + fr; tokE2[m] = list[(er < nvalid) ? er : 0]; }
#pragma unroll
      for (int m = 0; m < 2; ++m) { const float4 tw = TOKW[tokE2[m]]; twE2[m] = (mi.nt < 4) ? tw.x : tw.y; rsE2[m] = tw.z; }
      const bf16_t* Wh = W + (size_t)half * 64 * 1024;
      gemm128h(lds, D, [&](int r, int k) { const int i = r >> 5; const int tok = (i == 0) ? tokA[0] : (i == 1) ? tokA[1] : (i == 2) ? tokA[2] : tokA[3]; return XN + (size_t)tok * D + k; },
               [&](int r, int k) { return Wh + (size_t)r * D + k; }, acc2);
#pragma unroll
      for (int m = 0; m < 2; ++m) {
        const int er = wid * 32 + m * 16 + fr;
        if (er < nvalid) {
#pragma unroll
          for (int n = 0; n < 2; ++n) {
            f32x4 hv;
#pragma unroll
            for (int j = 0; j < 4; ++j) { const float gt = acc2[m][n][j] * rsE2[m], up = acc2[m][n + 2][j] * rsE2[m]; hv[j] = gt * sigmoidf_(gt) * up * twE2[m]; }
            st_bf16x4(HID + (size_t)tokE2[m] * 512 + (mi.nt < 4 ? 0 : 256) + ntl * 64 + half * 32 + n * 16 + fq * 4, hv);
          }
        }
      }
      continue;
    }
    f32x4 acc[4][4];
    int tokA[4], tokE[4]; float twE[4], rsE[4];
#pragma unroll
    for (int i = 0; i < 4; ++i) { const int r = (HTID >> 3) + 32 * i; tokA[i] = list[(r < nvalid) ? r : 0]; }
    {
      const int tid_ = HTID, er0 = ((tid_ >> 6) >> 1) * 64 + (tid_ & 15);
#pragma unroll
      for (int m = 0; m < 4; ++m) { const int er = er0 + m * 16; tokE[m] = list[(er < nvalid) ? er : 0]; }
#pragma unroll
      for (int m = 0; m < 4; ++m) { const float4 tw = TOKW[tokE[m]]; twE[m] = (mi.nt < 4) ? tw.x : tw.y; rsE[m] = tw.z; }
    }
    gemm128g(lds, D, [&](int r, int k) { const int i = r >> 5; const int tok = (i == 0) ? tokA[0] : (i == 1) ? tokA[1] : (i == 2) ? tokA[2] : tokA[3]; return XN + (size_t)tok * D + k; }, [&](int r, int k) { return W + (size_t)r * D + k; }, acc);
    {
      const int tid = HTID, wid = tid >> 6, lane = tid & 63, wr = wid >> 1, wc = wid & 1, fr = lane & 15, fq = lane >> 4;
#pragma unroll
      for (int m = 0; m < 4; ++m) {
        const int er = wr * 64 + m * 16 + fr;
        if (er < nvalid) {
          const int tok = tokE[m];
          const float w = twE[m], rsm = rsE[m];
#pragma unroll
          for (int n = 0; n < 2; ++n) {
            f32x4 hv;
#pragma unroll
            for (int j = 0; j < 4; ++j) { const float gt = acc[m][n][j] * rsm, up = acc[m][n + 2][j] * rsm; hv[j] = gt * sigmoidf_(gt) * up * w; }
            const int hh = (mi.nt < 4 ? 0 : 256) + ntl * 64 + wc * 32 + n * 16 + fq * 4;
            st_bf16x4(HID + (size_t)tok * 512 + hh, hv);
          }
        }
      }
    }
  }
}
DEVI void phase_g6(const Params& p, int l, unsigned char* lds) {
  const bf16_t* HID = (const bf16_t*)(p.ws + WS_B);
  const bf16_t* WDN = (const bf16_t*)(p.ws + WS_W + l * WS_WL + W_DN);
  const int* CNT = (const int*)(p.ws + SM_CNT) + l * 32;
  const int* LIST = (const int*)(p.ws + SM_LIST);
  float* out = p.out;
  bf16_t* out16 = (bf16_t*)p.out;
  const bf16_t* X1 = (const bf16_t*)(p.ws + WS_D);
  moe_prefix(CNT, lds);
  const int G_ = VGRID, total_ = ((const int*)(lds + LDS_BYTES + 64))[24] * 8, full_ = (total_ / G_) * G_, rem_ = total_ - full_;
  for (int it = vblock(); it < full_ + 2 * rem_; it += G_) {
    const bool halfmode = it >= full_; const int half = (it - full_) & 1;
    MoeItem mi; if (!moe_item(lds, halfmode ? full_ + ((it - full_) >> 1) : it, mi)) break;
    int e0, e1; cls_experts(mi.cls, e0, e1);
    const int* list = LIST + (size_t)mi.cls * T + mi.mtile * 128;
    const int nvalid = mi.cnt - mi.mtile * 128;
    const bf16_t* W0 = WDN + ((size_t)e0 * 1024 + mi.nt * 128) * 256;
    const bf16_t* W1 = WDN + ((size_t)e1 * 1024 + mi.nt * 128) * 256;
    if (halfmode) {
      f32x4 acc2[2][4];
      int tokA[4];
#pragma unroll
      for (int i = 0; i < 4; ++i) { const int r = (HTID >> 3) + 32 * i; tokA[i] = list[(r < nvalid) ? r : 0]; }
      const int tid = HTID, wid = tid >> 6, lane = tid & 63, fr = lane & 15, fq = lane >> 4;
      int trow2[2];
#pragma unroll
      for (int m = 0; m < 2; ++m) { const int er = wid * 32 + m * 16 + fr; trow2[m] = list[(er < nvalid) ? er : 0]; }
      const bf16_t* W0h = W0 + (size_t)half * 64 * 256; const bf16_t* W1h = W1 + (size_t)half * 64 * 256;
      gemm128h(lds, 512, [&](int r, int k) { const int i = r >> 5; const int tok = (i == 0) ? tokA[0] : (i == 1) ? tokA[1] : (i == 2) ? tokA[2] : tokA[3]; return HID + (size_t)tok * 512 + k; },
               [&](int r, int k) { return ((k < 256) ? W0h : W1h) + (size_t)r * 256 + (k & 255); }, acc2);
#pragma unroll
      for (int m = 0; m < 2; ++m) {
        const int er = wid * 32 + m * 16 + fr;
        if (er < nvalid) {
#pragma unroll
          for (int n = 0; n < 4; ++n) {
            const size_t o = (size_t)trow2[m] * D + mi.nt * 128 + half * 64 + n * 16 + fq * 4;
            const ushort4 u4 = *(const ushort4*)(X1 + o); const f32x4 r4 = (f32x4){bf2f(u4.x), bf2f(u4.y), bf2f(u4.z), bf2f(u4.w)} + acc2[m][n];
            if (l == 0) st_bf16x4(out16 + o, r4); else *(f32x4*)(out + o) = r4;
          }
        }
      }
      continue;
    }
    f32x4 acc[4][4];
    int trow[4], tokA[4];
    {
      const int tid = HTID, wid = tid >> 6, lane = tid & 63, wr = wid >> 1, fr = lane & 15;
#pragma unroll
      for (int i = 0; i < 4; ++i) { const int r = (tid >> 3) + 32 * i; tokA[i] = list[(r < nvalid) ? r : 0]; }
#pragma unroll
      for (int m = 0; m < 4; ++m) { const int er = wr * 64 + m * 16 + fr; trow[m] = list[(er < nvalid) ? er : 0]; }
    }
    gemm128g(lds, 512, [&](int r, int k) { const int i = r >> 5; const int tok = (i == 0) ? tokA[0] : (i == 1) ? tokA[1] : (i == 2) ? tokA[2] : tokA[3]; return HID + (size_t)tok * 512 + k; },
            [&](int r, int k) { return ((k < 256) ? W0 : W1) + (size_t)r * 256 + (k & 255); }, acc);
    GEMM_EPI4({ if (er < nvalid) { const size_t o = (size_t)trow[m] * D + mi.nt * 128 + ec0; const f32x4 r4 = ld_bf16x4(X1 + o) + ev4;
      if (l == 0) st_bf16x4(out16 + o, r4); else *(f32x4*)(out + o) = r4; } })
  }
}


#define XB_TMO      128
#define XB_XCNT(j)  (256  + 64 * (j))
#define XB_XSUB(j)  (1280 + 64 * (j))
#define XB_XGEN(j)  (2304 + 64 * (j))
#define XB_TOP      3328
#define XB_TOPGEN   3392
#define XCD_BAR_WORDS 3456
#define XB_SPIN_CAP (1u << 18)
DEVI unsigned xb_ld(unsigned* p)              { return __hip_atomic_load(p, __ATOMIC_RELAXED, __HIP_MEMORY_SCOPE_AGENT); }
DEVI unsigned xb_add(unsigned* p, unsigned v) { return __hip_atomic_fetch_add(p, v, __ATOMIC_RELAXED, __HIP_MEMORY_SCOPE_AGENT); }
DEVI unsigned xb_xcc_id() { return (unsigned)__builtin_amdgcn_s_getreg((3 << 11) | 20) & 0xFu; }
#define XB_SPIN(cond, bar) do { unsigned _sp = 0; while (cond) { __builtin_amdgcn_s_sleep(1); \
    if ((++_sp & 255u) == 0u) { if (xb_ld(&(bar)[XB_TMO])) break; if (_sp > XB_SPIN_CAP) { atomicAdd(&(bar)[XB_TMO], 1u); break; } } } } while (0)
struct XcdBarrier { unsigned* bar; unsigned x; volatile LAS unsigned* st; };
DEVI XcdBarrier xcd_barrier_post(unsigned* bar, volatile LAS unsigned* st) {
    XcdBarrier b; b.bar = bar; b.x = xb_xcc_id(); b.st = st;
    if (threadIdx.x == 0) (void)xb_add(&bar[XB_XCNT(b.x)], 1u);
    return b;
}
DEVI void xcd_barrier_complete(unsigned* bar, unsigned x, unsigned& nloc, unsigned& nx) {
    const unsigned G = gridDim.x * gridDim.y * gridDim.z;
    unsigned sum, cnt, mine, sp = 0u;
    for (;;) {
        sum = 0u; cnt = 0u; mine = 0u;
#pragma unroll
        for (unsigned j = 0; j < 16; ++j) { const unsigned c = xb_ld(&bar[XB_XCNT(j)]); sum += c; cnt += (c > 0u) ? 1u : 0u; mine = (j == x) ? c : mine; }
        if (sum == G) break;
        __builtin_amdgcn_s_sleep(1);
        if ((++sp & 255u) == 0u) { if (xb_ld(&bar[XB_TMO])) break; if (sp > XB_SPIN_CAP) { atomicAdd(&bar[XB_TMO], 1u); break; } }
    }
    nloc = mine > 0u ? mine : 1u; nx = cnt > 0u ? cnt : 1u;
}
DEVI void xcd_barrier(const XcdBarrier& b) {
    asm volatile("s_waitcnt vmcnt(0)" ::: "memory");
    __syncthreads();
    if (threadIdx.x == 0) {
        unsigned* bar = b.bar;
        __builtin_amdgcn_s_waitcnt(0);
        unsigned nloc = b.st[0], nx = b.st[1];
        if (nloc == 0u) { xcd_barrier_complete(bar, b.x, nloc, nx); b.st[0] = nloc; b.st[1] = nx; }
        const unsigned old = xb_add(&bar[XB_XSUB(b.x)], 1u);
        const unsigned gen = old / nloc;
        if (old + 1u == (gen + 1u) * nloc) {
            __builtin_amdgcn_fence(__ATOMIC_RELEASE, "agent");
            asm volatile("s_waitcnt vmcnt(0)" ::: "memory");
            const unsigned og = xb_add(&bar[XB_TOP], 1u);
            const unsigned tg = og / nx;
            if (og + 1u == (tg + 1u) * nx) xb_add(&bar[XB_TOPGEN], 1u);
            else XB_SPIN(xb_ld(&bar[XB_TOPGEN]) == tg, bar);
            __builtin_amdgcn_fence(__ATOMIC_ACQUIRE, "agent");
            xb_add(&bar[XB_XGEN(b.x)], 1u);
            asm volatile("s_waitcnt vmcnt(0)" ::: "memory");
        } else {
            XB_SPIN(xb_ld(&bar[XB_XGEN(b.x)]) == gen, bar);
            __builtin_amdgcn_fence(__ATOMIC_ACQUIRE, "agent");
            asm volatile("s_waitcnt vmcnt(0)" ::: "memory");
        }
    }
    __syncthreads();
}

#define PH(k, call) { const int _k = (k); if (p.lo <= _k && _k < p.hi) { call; if (_k + 1 < p.hi) { if (_k == 0) grid.sync(); else xcd_barrier(xbar); } } }
__global__ void __launch_bounds__(KTHREADS, 2) hybrid_fwd(Params p) {
  extern __shared__ __attribute__((aligned(16))) unsigned char lds_full[];
  unsigned char* lds = lds_full + hb_() * LDS_HALF;
  cg::grid_group grid = cg::this_grid();
  volatile LAS unsigned* xst = (volatile LAS unsigned*)(LAS unsigned char*)(lds_full + 2 * LDS_HALF);
  if (threadIdx.x < 4) { xst[threadIdx.x] = 0u; g_hs[threadIdx.x] = 0u; }
  __syncthreads();
  XcdBarrier xbar = xcd_barrier_post((unsigned*)(p.ws + WS_CTL), xst);
  PH(0, phase_prep(p, lds))
#define LAYER(l) { \
    PH(1 + 13 * l + 0, phase_g1(p, l, lds_full)) \
    PH(1 + 13 * l + 2, phase_g2(p, l, lds)) \
    PH(1 + 13 * l + 3, phase_r2(p, l, lds)) \
    PH(1 + 13 * l + 4, phase_a1(p, l, lds_full)) \
    PH(1 + 13 * l + 5, phase_r3(p, l, lds)) \
    PH(1 + 13 * l + 6, phase_g3(p, l, lds)) \
    PH(1 + 13 * l + 7, phase_r4(p, l)) \
    PH(1 + 13 * l + 8, phase_g4(p, l, lds_full)) \
    PH(1 + 13 * l + 9, phase_r5(p, l, lds)) \
    PH(1 + 13 * l + 10, phase_g5(p, l, lds)) \
    PH(1 + 13 * l + 11, phase_g6(p, l, lds)) }
  LAYER(0)
  PH(13, rmsnorm_rows16((const bf16_t*)p.out, p.in[2] + D, (bf16_t*)(p.ws + WS_A)))
  LAYER(1)
}

extern "C" void kernel_launch(void* const* d_in, const int* in_sizes, int n_in, void* d_out, int out_size, void* d_ws, size_t ws_size, hipStream_t stream) {
  static int grid_blocks = 0;
  if (!grid_blocks) {
    if (n_in != 45 || ws_size < WS_END) { fprintf(stderr, "kernel_launch: unexpected n_in %d or ws_size %zu (< %zu)\n", n_in, ws_size, (size_t)WS_END); grid_blocks = -1; return; }
    int dev = 0, cus = 0, per_cu = 0;
    hipGetDevice(&dev);
    hipDeviceGetAttribute(&cus, hipDeviceAttributeMultiprocessorCount, dev);
    hipFuncSetAttribute((const void*)hybrid_fwd, hipFuncAttributeMaxDynamicSharedMemorySize, LDS_ALLOC);
    hipOccupancyMaxActiveBlocksPerMultiprocessor(&per_cu, (const void*)hybrid_fwd, KTHREADS, LDS_ALLOC);
    if (per_cu < 1) per_cu = 1;
    if (per_cu > 1) per_cu = 1;
    grid_blocks = cus * per_cu;
    fprintf(stderr, "kernel_launch: cus %d per_cu %d grid %d\n", cus, per_cu, grid_blocks);
  }
  if (grid_blocks < 0) return;
  (void)hipMemsetAsync((unsigned char*)d_ws + WS_CTL, 0, XCD_BAR_WORDS * 4, stream);
  Params p{};
  for (int i = 0; i < 45; ++i) p.in[i] = (const float*)d_in[i];
  p.out = (float*)d_out; p.ws = (unsigned char*)d_ws;
#if N_LAUNCH_MODE == 1
  p.lo = 0; p.hi = NPH;
  { void* args[] = {&p}; hipError_t e = hipLaunchCooperativeKernel((void*)hybrid_fwd, dim3(grid_blocks), dim3(KTHREADS), args, LDS_ALLOC, stream);
    if (e != hipSuccess) fprintf(stderr, "cooperative launch failed: %s\n", hipGetErrorString(e)); }
#else
  for (int ph = 0; ph < NPH; ++ph) {
    p.lo = ph; p.hi = ph + 1;
    void* args[] = {&p}; hipError_t e = hipLaunchCooperativeKernel((void*)hybrid_fwd, dim3(grid_blocks), dim3(KTHREADS), args, LDS_ALLOC, stream);
    if (e != hipSuccess) { fprintf(stderr, "launch %d failed: %s\n", ph, hipGetErrorString(e)); break; }
  }
#endif
}
```

```cpp
#include <hip/hip_runtime.h>
#include <hip/hip_cooperative_groups.h>
#include <cstdio>
#include <cstdint>
namespace cg = cooperative_groups;

#ifndef N_LAUNCH_MODE
#define N_LAUNCH_MODE 1
#endif

#define DEVI __device__ __forceinline__

constexpr int KTHREADS = 512;
__shared__ unsigned g_hs[4];
#define HTID ((int)(threadIdx.x & 255))
__device__ __forceinline__ int hb_() { return __builtin_amdgcn_readfirstlane((int)(threadIdx.x >> 8)); }
#define VBID ((int)blockIdx.x * 2 + hb_())
#define VGRID ((int)gridDim.x * 2)
__device__ __forceinline__ void hsync() {
  asm volatile("s_waitcnt lgkmcnt(0)" ::: "memory");
  if ((threadIdx.x & 63) == 0) {
    unsigned* c = &g_hs[hb_()];
    const unsigned old = __hip_atomic_fetch_add(c, 1u, __ATOMIC_RELAXED, __HIP_MEMORY_SCOPE_WORKGROUP);
    const unsigned target = (old & ~3u) + 4u;
    if (old + 1u != target) {
      while ((int)(__hip_atomic_load(c, __ATOMIC_RELAXED, __HIP_MEMORY_SCOPE_WORKGROUP) - target) < 0) {}
    }
  }
  asm volatile("" ::: "memory");
}
typedef unsigned short bf16_t;
typedef short bf16x8 __attribute__((ext_vector_type(8)));
typedef float f32x4 __attribute__((ext_vector_type(4)));
typedef float f32x16 __attribute__((ext_vector_type(16)));
typedef unsigned u32x4 __attribute__((ext_vector_type(4)));
#define LAS __attribute__((address_space(3)))

constexpr int NB = 16, S = 2048, T = NB * S, D = 1024, DIN = 1772, DINP = 1792, NL = 2;
constexpr int C_CQ = 0, C_KPE = 192, C_NG = 224, C_T1 = 256, C_LX = 512, C_LG = 768, C_S5 = 1024, C_T5 = 1280, C_KC = 1536, C_VC = 1600, C_VS = 1664, C_VW = 1728;
__host__ __device__ constexpr int wgcol(int tile0, int wc, int e) { return tile0 + 128 * (e >> 5) + 32 * wc + (e & 31); }
__host__ __device__ constexpr int colmap(int n) {
  if (n < 192) return n;
  if (n < 320) { const int k = n - 192; return wgcol(C_T1, k >> 6, k & 63); }
  if (n < 352) return C_KPE + (n - 320);
  if (n < 608) return C_LX + (n - 352);
  if (n < 864) return C_LG + (n - 608);
  if (n < 1120) return C_S5 + (n - 864);
  if (n < 1376) { const int q = n - 1120; return wgcol(C_T5, q >> 6, q & 63); }
  if (n < 1760) { const int j = n - 1376, part = j >> 6, d = j & 63;
    return part == 0 ? C_KC + d : part == 1 ? C_VC + d : part == 2 ? wgcol(C_T1, 2, d) : part == 3 ? C_VS + d : part == 4 ? wgcol(C_T1, 3, d) : C_VW + d; }
  return C_NG + (n - 1760);
}
constexpr float EPS = 1e-6f;
constexpr float LOG2E = 1.4426950408889634f;
constexpr int NTHREADS = 256;
constexpr int NPH = 1 + 13 * NL - 1;

constexpr size_t MiB = 1u << 20;
constexpr size_t WS_CTL = 0;
constexpr size_t WS_SMALL = 1 * MiB;
constexpr size_t WS_W = 16 * MiB;
constexpr size_t WS_WL = 32 * MiB;
constexpr size_t WS_A = 80 * MiB;
constexpr size_t WS_B = 144 * MiB;
constexpr size_t WS_C = 256 * MiB;
constexpr size_t WS_D = 292 * MiB;
constexpr size_t WS_E = 348 * MiB;
constexpr size_t WS_F = 380 * MiB;
constexpr size_t WS_G = 428 * MiB;
constexpr size_t WS_ROPE = 452 * MiB;
constexpr size_t WS_PART = WS_ROPE + 6 * MiB;
constexpr size_t WS_END = 460 * MiB;
constexpr size_t W_IN = 0;
constexpr size_t W_OUT = 4 * MiB;
constexpr size_t W_UQ = 6 * MiB;
constexpr size_t W_UKV = W_UQ + 384 * 192 * 2;
constexpr size_t W_LRU = W_UKV + 512 * 128 * 2;
constexpr size_t W_GLU = W_LRU + 4 * 128 * 64 * 2;
constexpr size_t W_1K = 6 * MiB + 512 * 1024;
constexpr size_t W_1V = W_1K + 128 * 2048 * 2;
constexpr size_t W_B1K = W_1V + 128 * 2048 * 2;
constexpr size_t W_B1V = W_B1K + 512;
constexpr size_t W_S5A = W_B1V + 512;
constexpr size_t W_S5A64 = W_S5A + 16 * 64 * 8;
constexpr size_t W_S5B = W_S5A64 + 16 * 64 * 8;
constexpr size_t W_S5BB = W_S5B + 16 * 64 * 16 * 8;
constexpr size_t W_S5CM = W_S5BB + 16 * 4 * 32 * 16 * 2;
constexpr size_t W_2K = W_S5CM + 16 * 16 * 128 * 2;
constexpr size_t W_2V = W_2K + 64 * 128 * 2;
static_assert(W_2V + 64 * 128 * 2 <= 8 * MiB, "weights overflow");
constexpr size_t W_RTH = W_2V + 64 * 128 * 2;
constexpr size_t W_RTL = W_RTH + 32 * 1024 * 2;
static_assert(W_RTL + 32 * 1024 * 2 <= 8 * MiB, "weights overflow 2");
constexpr size_t W_GU = 8 * MiB;
constexpr size_t W_DN = 24 * MiB;
constexpr size_t SM_CNT = WS_SMALL;
constexpr size_t SM_LIST = WS_SMALL + 4096;
constexpr size_t SM_TOKW = SM_LIST + 24 * (size_t)T * 4;
constexpr size_t SM_LSUM = SM_TOKW + (size_t)T * 16;
constexpr size_t SM_SLOC = SM_LSUM + 16 * 32 * 256 * 8;
constexpr size_t SM_HK = SM_SLOC + 16 * 32 * 1024 * 8;
constexpr size_t SM_HV = SM_HK + 2048 * 128 * 2;
constexpr size_t SM_KC = SM_HV + 2048 * 128 * 2;
constexpr size_t SM_VC = SM_KC + 16 * 128 * 64 * 2;
constexpr size_t SM_SCAR = SM_VC + 16 * 128 * 64 * 2;
constexpr size_t SM_LCAR = SM_SCAR + 16 * 32 * 1024 * 8;
constexpr size_t SM_SSKV = SM_LCAR + 16 * 32 * 256 * 4;
constexpr size_t SM_END = SM_SSKV + (size_t)T * 2 * 4;
static_assert(SM_END <= WS_W, "small region overflow");

constexpr int LDS_BYTES = 65536;
constexpr int LDS_HALF = LDS_BYTES + 512;
constexpr int LDS_ALLOC = 2 * LDS_HALF + 64;

struct Params {
  const float* in[45];
  float* out;
  unsigned char* ws;
  int lo, hi;
};

DEVI float bf2f(bf16_t v) { return __uint_as_float(((unsigned)v) << 16); }
DEVI bf16_t f2bf(float f) { unsigned u = __float_as_uint(f); return (bf16_t)((u + 0x7fffu + ((u >> 16) & 1u)) >> 16); }
DEVI float wsum(float v) {
#pragma unroll
  for (int o = 32; o >= 1; o >>= 1) v += __shfl_xor(v, o);
  return v;
}
DEVI float sigmoidf_(float x) { return __builtin_amdgcn_rcpf(1.f + __expf(-x)); }
DEVI float gelu_tanh(float x) { const float u2 = 1.5957691216057308f * (x + 0.044715f * x * x * x); return x * __builtin_amdgcn_rcpf(1.f + __expf(-u2)); }
DEVI f32x16 mfma32(bf16x8 a, bf16x8 b, f32x16 c) { return __builtin_amdgcn_mfma_f32_32x32x16_bf16(a, b, c, 0, 0, 0); }
DEVI f32x4 mfma16(bf16x8 a, bf16x8 b, f32x4 c) { return __builtin_amdgcn_mfma_f32_16x16x32_bf16(a, b, c, 0, 0, 0); }
DEVI int vblock() { const int bx = (int)blockIdx.x, GB = (int)gridDim.x; return (GB % 8 == 0) ? (bx % 8) * (GB / 8) * 2 + (bx / 8) * 2 + hb_() : VBID; }
DEVI int crow(int r, int h) { return (r & 3) + 8 * (r >> 2) + 4 * h; }
typedef __bf16 bf16x2_t __attribute__((ext_vector_type(2)));
typedef float f32x2_t __attribute__((ext_vector_type(2)));
DEVI unsigned pk2bf(float lo, float hi) { f32x2_t v = {lo, hi}; bf16x2_t b = __builtin_convertvector(v, bf16x2_t); return __builtin_bit_cast(unsigned, b); }

template <class AF, class BF>
DEVI void gemm128(unsigned char* lds, int K, AF aload, BF bptr, f32x4 (&acc)[4][4]) {
  const int tid = HTID, wid = tid >> 6, lane = tid & 63, wr = wid >> 1, wc = wid & 1, fr = lane & 15, fq = lane >> 4;
#pragma unroll
  for (int m = 0; m < 4; ++m)
#pragma unroll
    for (int n = 0; n < 4; ++n) acc[m][n] = (f32x4){0.f, 0.f, 0.f, 0.f};
  const int lr = tid >> 3, ch = tid & 7;
  const int wofs = lr * 128 + ((ch ^ ((lr >> 1) & 7)) * 16);
  const int sw = (fr >> 1) & 7;
  const int aro = (wr * 64 + fr) * 128, bro = (wc * 64 + fr) * 128;
  const int nk = K >> 6;
  u32x4 ra[4], rb[4];
#pragma unroll
  for (int i = 0; i < 4; ++i) { ra[i] = aload(lr + 32 * i, ch * 8); rb[i] = *(const u32x4*)bptr(lr + 32 * i, ch * 8); }
  hsync();
#pragma unroll
  for (int i = 0; i < 4; ++i) { *(u32x4*)(lds + wofs + i * 4096) = ra[i]; *(u32x4*)(lds + 16384 + wofs + i * 4096) = rb[i]; }
  hsync();
  for (int kt = 0; kt < nk; ++kt) {
    const bool more = (kt + 1 < nk);
    if (more) {
      const int k = (kt + 1) * 64 + ch * 8;
#pragma unroll
      for (int i = 0; i < 4; ++i) { ra[i] = aload(lr + 32 * i, k); rb[i] = *(const u32x4*)bptr(lr + 32 * i, k); }
    }
    const unsigned char* bufA = lds + (kt & 1) * 32768;
    const unsigned char* bufB = bufA + 16384;
#pragma unroll
    for (int kk = 0; kk < 2; ++kk) {
      bf16x8 At[4], Bt[4];
      const int co = ((kk * 4 + fq) ^ sw) * 16;
#pragma unroll
      for (int m = 0; m < 4; ++m) At[m] = *(const bf16x8*)(bufA + aro + m * 2048 + co);
#pragma unroll
      for (int n = 0; n < 4; ++n) Bt[n] = *(const bf16x8*)(bufB + bro + n * 2048 + co);
#pragma unroll
      for (int m = 0; m < 4; ++m)
#pragma unroll
        for (int n = 0; n < 4; ++n) acc[m][n] = mfma16(Bt[n], At[m], acc[m][n]);
    }
    if (more) {
      unsigned char* nb = lds + ((kt + 1) & 1) * 32768;
#pragma unroll
      for (int i = 0; i < 4; ++i) { *(u32x4*)(nb + wofs + i * 4096) = ra[i]; *(u32x4*)(nb + 16384 + wofs + i * 4096) = rb[i]; }
    }
    hsync();
  }
}
template <class AF, class BF>
DEVI void gemm128g(unsigned char* lds, int K, AF aptr, BF bptr, f32x4 (&acc)[4][4]) {
  const int tid = HTID, wid = tid >> 6, lane = tid & 63, wr = wid >> 1, wc = wid & 1, fr = lane & 15, fq = lane >> 4;
#pragma unroll
  for (int m = 0; m < 4; ++m)
#pragma unroll
    for (int n = 0; n < 4; ++n) acc[m][n] = (f32x4){0.f, 0.f, 0.f, 0.f};
  const int lr = tid >> 3;
  const int chs = ((tid & 7) ^ ((lr >> 1) & 7)) * 8;
  const int sw = (fr >> 1) & 7;
  const int aro = (wr * 64 + fr) * 128, bro = (wc * 64 + fr) * 128;
  const int nk = K >> 6;
  LAS unsigned char* l3 = (LAS unsigned char*)lds;
#define G128_STAGE(buf, kbase)                                                                                                   \
  _Pragma("unroll") for (int i = 0; i < 4; ++i) {                                                                                 \
    __builtin_amdgcn_global_load_lds((const __attribute__((address_space(1))) unsigned*)aptr(lr + 32 * i, (kbase) + chs),          \
                                     (LAS unsigned*)(l3 + (buf) * 32768 + tid * 16 + i * 4096), 16, 0, 0);                           \
    __builtin_amdgcn_global_load_lds((const __attribute__((address_space(1))) unsigned*)bptr(lr + 32 * i, (kbase) + chs),          \
                                     (LAS unsigned*)(l3 + (buf) * 32768 + 16384 + tid * 16 + i * 4096), 16, 0, 0);                   \
  }
  hsync();
  G128_STAGE(0, 0)
  asm volatile("s_waitcnt vmcnt(0)" ::: "memory");
  hsync();
  for (int kt = 0; kt < nk; ++kt) {
    if (kt + 1 < nk) { G128_STAGE((kt + 1) & 1, (kt + 1) * 64) }
    const unsigned char* bufA = lds + (kt & 1) * 32768;
    const unsigned char* bufB = bufA + 16384;
#pragma unroll
    for (int kk = 0; kk < 2; ++kk) {
      bf16x8 At[4], Bt[4];
      const int co = ((kk * 4 + fq) ^ sw) * 16;
#pragma unroll
      for (int m = 0; m < 4; ++m) At[m] = *(const bf16x8*)(bufA + aro + m * 2048 + co);
#pragma unroll
      for (int n = 0; n < 4; ++n) Bt[n] = *(const bf16x8*)(bufB + bro + n * 2048 + co);
#pragma unroll
      for (int m = 0; m < 4; ++m)
#pragma unroll
        for (int n = 0; n < 4; ++n) acc[m][n] = mfma16(Bt[n], At[m], acc[m][n]);
    }
    asm volatile("s_waitcnt vmcnt(0)" ::: "memory");
    hsync();
  }
#undef G128_STAGE
}
DEVI void gemm128p(unsigned char* lds, int K, const bf16_t* Ab, size_t lda, const bf16_t* Bb, size_t ldb, f32x4 (&acc)[4][4], int& par, bool staged, bool has_next, const bf16_t* Abn, const bf16_t* Bbn) {
  const int tid = HTID, wid = tid >> 6, lane = tid & 63, wr = wid >> 1, wc = wid & 1, fr = lane & 15, fq = lane >> 4;
#pragma unroll
  for (int m = 0; m < 4; ++m)
#pragma unroll
    for (int n = 0; n < 4; ++n) acc[m][n] = (f32x4){0.f, 0.f, 0.f, 0.f};
  const int lr = tid >> 3;
  const int chs = ((tid & 7) ^ ((lr >> 1) & 7)) * 8;
  const int sw = (fr >> 1) & 7;
  const int aro = (wr * 64 + fr) * 128, bro = (wc * 64 + fr) * 128;
  const int nk = K >> 6;
  LAS unsigned char* l3 = (LAS unsigned char*)lds;
#define GP_STAGE(buf, kbase, APTR, BPTR)                                                                                             \
  _Pragma("unroll") for (int i = 0; i < 4; ++i) {                                                                                 \
    __builtin_amdgcn_global_load_lds((const __attribute__((address_space(1))) unsigned*)((APTR) + (size_t)(lr + 32 * i) * lda + (kbase) + chs),            \
                                     (LAS unsigned*)(l3 + (buf) * 32768 + tid * 16 + i * 4096), 16, 0, 0);                           \
    __builtin_amdgcn_global_load_lds((const __attribute__((address_space(1))) unsigned*)((BPTR) + (size_t)(lr + 32 * i) * ldb + (kbase) + chs),            \
                                     (LAS unsigned*)(l3 + (buf) * 32768 + 16384 + tid * 16 + i * 4096), 16, 0, 0);                   \
  }
  if (!staged) {
    hsync();
    GP_STAGE(par, 0, Ab, Bb)
    asm volatile("s_waitcnt vmcnt(0)" ::: "memory");
    hsync();
  }
  for (int kt = 0; kt < nk; ++kt) {
    const int cur = (par + kt) & 1;
    { const bool inner = kt + 1 < nk; if (inner || has_next) { const bf16_t* ap_ = inner ? Ab : Abn; const bf16_t* bp_ = inner ? Bb : Bbn; const int kb_ = inner ? (kt + 1) * 64 : 0; GP_STAGE(cur ^ 1, kb_, ap_, bp_) } }
    const unsigned char* bufA = lds + cur * 32768;
    const unsigned char* bufB = bufA + 16384;
#pragma unroll
    for (int kk = 0; kk < 2; ++kk) {
      bf16x8 At[4], Bt[4];
      const int co = ((kk * 4 + fq) ^ sw) * 16;
#pragma unroll
      for (int m = 0; m < 4; ++m) At[m] = *(const bf16x8*)(bufA + aro + m * 2048 + co);
#pragma unroll
      for (int n = 0; n < 4; ++n) Bt[n] = *(const bf16x8*)(bufB + bro + n * 2048 + co);
#pragma unroll
      for (int m = 0; m < 4; ++m)
#pragma unroll
        for (int n = 0; n < 4; ++n) acc[m][n] = mfma16(Bt[n], At[m], acc[m][n]);
    }
    asm volatile("s_waitcnt vmcnt(0)" ::: "memory");
    hsync();
  }
  par = (par + nk) & 1;
#undef GP_STAGE
}
template <class AF, class BF>
DEVI void gemm128h(unsigned char* lds, int K, AF aptr, BF bptr, f32x4 (&acc)[2][4]) {
  const int tid = HTID, wid = tid >> 6, lane = tid & 63, fr = lane & 15, fq = lane >> 4;
#pragma unroll
  for (int m = 0; m < 2; ++m)
#pragma unroll
    for (int n = 0; n < 4; ++n) acc[m][n] = (f32x4){0.f, 0.f, 0.f, 0.f};
  const int lr = tid >> 3;
  const int chs = ((tid & 7) ^ ((lr >> 1) & 7)) * 8;
  const int sw = (fr >> 1) & 7;
  const int aro = (wid * 32 + fr) * 128, bro = fr * 128;
  const int nk = K >> 6;
  LAS unsigned char* l3 = (LAS unsigned char*)lds;
#define GH_STAGE(buf, kbase)                                                                                                     \
  { _Pragma("unroll") for (int i = 0; i < 4; ++i)                                                                                 \
      __builtin_amdgcn_global_load_lds((const __attribute__((address_space(1))) unsigned*)aptr(lr + 32 * i, (kbase) + chs),        \
                                       (LAS unsigned*)(l3 + (buf) * 32768 + tid * 16 + i * 4096), 16, 0, 0);                         \
    _Pragma("unroll") for (int i = 0; i < 2; ++i)                                                                                 \
      __builtin_amdgcn_global_load_lds((const __attribute__((address_space(1))) unsigned*)bptr(lr + 32 * i, (kbase) + chs),        \
                                       (LAS unsigned*)(l3 + (buf) * 32768 + 16384 + tid * 16 + i * 4096), 16, 0, 0); }
  hsync();
  GH_STAGE(0, 0)
  asm volatile("s_waitcnt vmcnt(0)" ::: "memory");
  hsync();
  for (int kt = 0; kt < nk; ++kt) {
    if (kt + 1 < nk) { GH_STAGE((kt + 1) & 1, (kt + 1) * 64) }
    const unsigned char* bufA = lds + (kt & 1) * 32768;
    const unsigned char* bufB = bufA + 16384;
#pragma unroll
    for (int kk = 0; kk < 2; ++kk) {
      bf16x8 At[2], Bt[4];
      const int co = ((kk * 4 + fq) ^ sw) * 16;
#pragma unroll
      for (int m = 0; m < 2; ++m) At[m] = *(const bf16x8*)(bufA + aro + m * 2048 + co);
#pragma unroll
      for (int n = 0; n < 4; ++n) Bt[n] = *(const bf16x8*)(bufB + bro + n * 2048 + co);
#pragma unroll
      for (int m = 0; m < 2; ++m)
#pragma unroll
        for (int n = 0; n < 4; ++n) acc[m][n] = mfma16(Bt[n], At[m], acc[m][n]);
    }
    asm volatile("s_waitcnt vmcnt(0)" ::: "memory");
    hsync();
  }
#undef GH_STAGE
}
#define GEMM_EPI_LOOP(body)                                                                 \
  {                                                                                         \
    const int _tid = HTID, _wid = _tid >> 6, _lane = _tid & 63, _wr = _wid >> 1, _wc = _wid & 1, _fr = _lane & 15, _fq = _lane >> 4; \
    _Pragma("unroll") for (int m = 0; m < 4; ++m) _Pragma("unroll") for (int n = 0; n < 4; ++n) _Pragma("unroll") for (int j = 0; j < 4; ++j) { \
      const int er = _wr * 64 + m * 16 + _fr, ec = _wc * 64 + n * 16 + _fq * 4 + j; const float ev = acc[m][n][j]; body }                      \
  }
#define GEMM_EPI4(body)                                                                     \
  {                                                                                         \
    const int _tid = HTID, _wid = _tid >> 6, _lane = _tid & 63, _wr = _wid >> 1, _wc = _wid & 1, _fr = _lane & 15, _fq = _lane >> 4; \
    _Pragma("unroll") for (int m = 0; m < 4; ++m) _Pragma("unroll") for (int n = 0; n < 4; ++n) {                                             \
      const int er = _wr * 64 + m * 16 + _fr, ec0 = _wc * 64 + n * 16 + _fq * 4; const f32x4 ev4 = acc[m][n]; body }                          \
  }
DEVI f32x4 ld_bf16x4(const bf16_t* p) { const uint2 u = *(const uint2*)p; return (f32x4){__uint_as_float(u.x << 16), __uint_as_float(u.x & 0xffff0000u), __uint_as_float(u.y << 16), __uint_as_float(u.y & 0xffff0000u)}; }
DEVI void st_bf16x4(bf16_t* p, f32x4 v) { uint2 o; o.x = pk2bf(v[0], v[1]); o.y = pk2bf(v[2], v[3]); *(uint2*)p = o; }

namespace pg8 {
#define PG8_LAS __attribute__((address_space(3)))
typedef unsigned short bf16_t;
typedef short bf16x8 __attribute__((ext_vector_type(8)));
typedef float f32x4 __attribute__((ext_vector_type(4)));
typedef unsigned u32x4 __attribute__((ext_vector_type(4)));
constexpr int BM = 256, BK = 64, HALF = 128, HTB = HALF * BK * 2  , STAGE_BYTES = 8 * HTB, NXCD = 8, WGM = 8;

__host__ __device__ __forceinline__ int lds_byte(int r, int c) { const int st = (r >> 4) * 2 + (c >> 5), rr = r & 15, cc = c & 31, ob = rr * 64 + cc * 2; return st * 1024 + (ob ^ (((ob >> 9) & 1) << 5)); }
__host__ __device__ __forceinline__ void stage_rc(int b, int& R, int& C) { const int st = b / 1024, sb = b % 1024, swz = sb ^ (((sb >> 9) & 1) << 5); R = (st >> 1) * 16 + swz / 64; C = (st & 1) * 32 + (swz % 64) / 2; }
__host__ __device__ __forceinline__ int perm32(int rho) { const int n = rho >> 4, i = rho & 15; return 8 * (i >> 2) + 4 * n + (i & 3); }

struct Unit { int pm, pn; };
struct Gemm { const bf16_t* A; const bf16_t* Bt; int M, N, K; };

struct StaticOrder {
    int nM, nN, nwg, G, c;
    __host__ __device__ void init(int M, int N, int G_, int c_) { nM = M / BM; nN = N / BM; nwg = nM * nN; G = G_; c = c_; }
    __host__ __device__ bool next(int i, Unit& u) const {
        const long L = (long)i * G + c; if (L >= nwg) return false;
        int wgid = (int)L; { const int q = nwg / NXCD, r = nwg % NXCD, xcd = wgid % NXCD, off = wgid / NXCD; wgid = (xcd < r ? xcd * (q + 1) : r * (q + 1) + (xcd - r) * q) + off; }
        const int nig = WGM * nN, gid = wgid / nig, fm = gid * WGM, gsz = (nM - fm) < WGM ? (nM - fm) : WGM;
        u.pm = fm + ((wgid % nig) % gsz); u.pn = (wgid % nig) / gsz; return true;
    }
    __device__ __forceinline__ void a_ready(const Unit&) const {}
    __device__ __forceinline__ void done(const Unit&) const {}
};

__device__ __forceinline__ unsigned cvt_pk_bf16(float lo, float hi) { unsigned r; asm volatile("v_cvt_pk_bf16_f32 %0, %1, %2" : "=v"(r) : "v"(lo), "v"(hi)); return r; }
typedef float f32x2 __attribute__((ext_vector_type(2)));
__device__ __forceinline__ f32x2 gelu_pk(f32x2 v) {
    const f32x2 av = __builtin_elementwise_abs(v), d = av * 0.2316418882f + 1.0f;
    f32x2 t; t.x = __builtin_amdgcn_rcpf(d.x); t.y = __builtin_amdgcn_rcpf(d.y);
    f32x2 q = t * 0.5307027145f + (-0.7265760135f); q = q * t + 0.7107068705f; q = q * t + (-0.142248368f); q = q * t + 0.127414796f; q = q * t;
    const f32x2 s = (v * v) * (-0.72134752044f);
    f32x2 e; e.x = __builtin_amdgcn_exp2f(s.x); e.y = __builtin_amdgcn_exp2f(s.y);
    const f32x2 m = v * (q * e), r = v - m;
    f32x2 o; o.x = v.x < 0.f ? m.x : r.x; o.y = v.y < 0.f ? m.y : r.y; return o;
}

template <int ACT  > struct EpiBf16 {
    static constexpr bool PERM = true, AFTER_DRAIN = false; static_assert(ACT == 0 || ACT == 1, "EpiBf16: ACT is 0 (none) or 1 (gelu_pk)");
    bf16_t* O; int ldc; const float* bias; int split_cols; size_t split_stride; float scale0;
    __device__ __forceinline__ void operator()(const f32x4 (&acc)[2][2][4][2], const Unit& u, int wr, int wc, int fr, int fq) const {
        const int row0 = u.pm * BM + wr * 64 + fr; int colt = u.pn * BM; bf16_t* base = O;
        float sc = 1.f; if (split_cols) { const int t = colt / split_cols; base += (size_t)t * split_stride; colt -= t * split_cols; if (t == 0) sc = scale0; }
        const int col0 = colt + wc * 32 + 8 * fq, bcol0 = u.pn * BM + wc * 32 + 8 * fq;
        f32x4 bv[2][2];
#pragma unroll
        for (int bj = 0; bj < 2; ++bj)
#pragma unroll
            for (int n = 0; n < 2; ++n) bv[bj][n] = bias ? *(const f32x4*)(bias + bcol0 + bj * HALF + 4 * n) : (f32x4){0.f, 0.f, 0.f, 0.f};
#pragma unroll
        for (int ai = 0; ai < 2; ++ai)
#pragma unroll
            for (int m = 0; m < 4; ++m) { bf16_t* rowp = base + (size_t)(row0 + ai * HALF + m * 16) * ldc + col0;
#pragma unroll
                for (int bj = 0; bj < 2; ++bj) { f32x4 v0 = acc[ai][bj][m][0] + bv[bj][0], v1 = acc[ai][bj][m][1] + bv[bj][1];
                    if (ACT == 1) { f32x2 a = gelu_pk((f32x2){v0[0], v0[1]}), b = gelu_pk((f32x2){v0[2], v0[3]}), c = gelu_pk((f32x2){v1[0], v1[1]}), d = gelu_pk((f32x2){v1[2], v1[3]});
                        v0 = (f32x4){a.x, a.y, b.x, b.y}; v1 = (f32x4){c.x, c.y, d.x, d.y}; }
                    v0 = v0 * sc; v1 = v1 * sc; u32x4 w; w.x = cvt_pk_bf16(v0[0], v0[1]); w.y = cvt_pk_bf16(v0[2], v0[3]); w.z = cvt_pk_bf16(v1[0], v1[1]); w.w = cvt_pk_bf16(v1[2], v1[3]);
                    *(u32x4*)(rowp + bj * HALF) = w; } }
    }
};

template <class Epi, class Sched, bool ALIGN_EPI = false, bool SP2 = false>
__device__ __forceinline__ void gemm_phase(PG8_LAS unsigned char* lds, const Gemm g, const Sched& S, const Epi& E) {
    const int tid = threadIdx.x, wid = __builtin_amdgcn_readfirstlane(tid >> 6), lane = tid & 63, wr = wid >> 2, wc = wid & 3, fr = lane & 15, fq = lane >> 4;
    const int K = g.K, nt = K / BK;
    unsigned voffA[2], voffB[2];
#pragma unroll
    for (int i = 0; i < 2; ++i) { int R, C; stage_rc(tid * 16 + i * 8192, R, C); const int Rb = Epi::PERM ? ((R & ~31) + perm32(R & 31)) : R;
        voffA[i] = (unsigned)(R * K + C) * 2u; voffB[i] = (unsigned)(Rb * K + C) * 2u; }
    const size_t kstep = (size_t)(BK * 2);
    const size_t hstep = (size_t)HALF * K * 2;
    const size_t tstep = 2 * hstep;
    const unsigned ldsw = (unsigned)wid * 1024u;
    const int aoff = lds_byte(wr * 64 + fr, fq * 8), boff = lds_byte(wc * 32 + fr, fq * 8);
#define PG8_SA(b, h) (((b) * 2 + (h)) * HTB)
#define PG8_SB(b, h) ((4 + (b) * 2 + (h)) * HTB)
#define PG8_STAGE(bufoff, gbase, voff) do { _Pragma("unroll") for (int _i = 0; _i < 2; ++_i) \
        __builtin_amdgcn_global_load_lds((const unsigned*)((const char*)(gbase) + (voff)[_i]), (PG8_LAS unsigned*)(lds + (bufoff) + ldsw + _i * 8192), 16, 0, 0); } while (0)
#define PG8_LDA(dst, b, h) do { _Pragma("unroll") for (int m = 0; m < 4; ++m) _Pragma("unroll") for (int k = 0; k < 2; ++k) dst[m][k] = *(const PG8_LAS bf16x8*)(lds + PG8_SA(b, h) + aoff + m * 2048 + k * 1024); } while (0)
#define PG8_LDB(dst, b, h) do { _Pragma("unroll") for (int n = 0; n < 2; ++n) _Pragma("unroll") for (int k = 0; k < 2; ++k) dst[n][k] = *(const PG8_LAS bf16x8*)(lds + PG8_SB(b, h) + boff + n * 2048 + k * 1024); } while (0)
#define PG8_MMA(ai, bj, At, Bt) do { __builtin_amdgcn_s_setprio(1); _Pragma("unroll") for (int m = 0; m < 4; ++m) _Pragma("unroll") for (int n = 0; n < 2; ++n) _Pragma("unroll") for (int k = 0; k < 2; ++k) \
        acc[ai][bj][m][n] = __builtin_amdgcn_mfma_f32_16x16x32_bf16(Bt[n][k], At[m][k], acc[ai][bj][m][n], 0, 0, 0); __builtin_amdgcn_s_setprio(0); } while (0)
#define PG8_WAIT_V(n) asm volatile("s_waitcnt vmcnt(" #n ")" ::: "memory")
#define PG8_WAIT_L(n) asm volatile("s_waitcnt lgkmcnt(" #n ")" ::: "memory")
#define PG8_BAR __builtin_amdgcn_s_barrier()
#define PG8_SCHED __builtin_amdgcn_sched_barrier(0)
    Unit cur, nxt; int ui = 0;
    if (!S.next(0, cur)) return;
    f32x4 acc[2][2][4][2];
#pragma unroll
    for (int a = 0; a < 2; ++a)
#pragma unroll
        for (int b = 0; b < 2; ++b)
#pragma unroll
            for (int m = 0; m < 4; ++m)
#pragma unroll
                for (int n = 0; n < 2; ++n) acc[a][b][m][n] = (f32x4){0.f, 0.f, 0.f, 0.f};
    bf16x8 At[4][2], B0[2][2], B1[2][2];
    const char* cA = (const char*)g.A + (size_t)cur.pm * tstep; const char* cB = (const char*)g.Bt + (size_t)cur.pn * tstep;
    S.a_ready(cur);
    if constexpr (SP2) {
        PG8_STAGE(PG8_SB(0, 0), cB, voffB); PG8_STAGE(PG8_SB(0, 1), cB + hstep, voffB); PG8_STAGE(PG8_SA(0, 0), cA, voffA); PG8_STAGE(PG8_SA(0, 1), cA + hstep, voffA);
        if (wr == 1) PG8_BAR;
        PG8_WAIT_V(2); PG8_BAR;
        PG8_STAGE(PG8_SB(1, 0), cB + kstep, voffB); PG8_STAGE(PG8_SA(1, 0), cA + kstep, voffA); PG8_STAGE(PG8_SB(1, 1), cB + hstep + kstep, voffB);
        PG8_WAIT_V(6); PG8_BAR;
    } else {
        PG8_STAGE(PG8_SB(0, 0), cB, voffB); PG8_STAGE(PG8_SA(0, 0), cA, voffA); PG8_STAGE(PG8_SB(0, 1), cB + hstep, voffB); PG8_STAGE(PG8_SA(0, 1), cA + hstep, voffA);
        if (wr == 1) PG8_BAR;
        PG8_WAIT_V(4); PG8_BAR;
        PG8_STAGE(PG8_SB(1, 0), cB + kstep, voffB); PG8_STAGE(PG8_SA(1, 0), cA + kstep, voffA); PG8_STAGE(PG8_SB(1, 1), cB + hstep + kstep, voffB);
        PG8_WAIT_V(6); PG8_BAR;
    }
    for (;;) {
        const bool has_next = S.next(ui + 1, nxt);
        const char* nA = has_next ? (const char*)g.A + (size_t)nxt.pm * tstep : cA; const char* nB = has_next ? (const char*)g.Bt + (size_t)nxt.pn * tstep : cB;
        for (int t = 0; t < nt; t += 2) {
            const bool last = (t == nt - 2);
            const char* a1 = cA + (size_t)(t + 1) * kstep;
            const char* a2 = last ? nA : cA + (size_t)(t + 2) * kstep; const char* b2 = last ? nB : cB + (size_t)(t + 2) * kstep;
            const char* a3 = a2 + kstep; const char* b3 = b2 + kstep;
            if (last && has_next) S.a_ready(nxt);
            if constexpr (SP2) {
            PG8_LDB(B0, 0, 0); PG8_LDB(B1, 0, 1); PG8_SCHED; PG8_LDA(At, 0, 0); PG8_STAGE(PG8_SA(1, 1), a1 + hstep, voffA);
            PG8_WAIT_V(8); PG8_WAIT_L(0); PG8_BAR; PG8_MMA(0, 0, At, B0); PG8_MMA(0, 1, At, B1); PG8_BAR; PG8_SCHED;
            PG8_LDA(At, 0, 1); PG8_STAGE(PG8_SB(0, 0), b2, voffB); PG8_STAGE(PG8_SB(0, 1), b2 + hstep, voffB); PG8_STAGE(PG8_SA(0, 0), a2, voffA);
            PG8_WAIT_V(8); PG8_WAIT_L(0); PG8_BAR; PG8_MMA(1, 0, At, B0); PG8_MMA(1, 1, At, B1); PG8_BAR; PG8_SCHED;
            PG8_LDB(B0, 1, 0); PG8_LDB(B1, 1, 1); PG8_SCHED; PG8_LDA(At, 1, 0); PG8_STAGE(PG8_SA(0, 1), a2 + hstep, voffA);
            PG8_WAIT_V(8); PG8_WAIT_L(0); PG8_BAR; PG8_MMA(0, 0, At, B0); PG8_MMA(0, 1, At, B1); PG8_BAR; PG8_SCHED;
            PG8_LDA(At, 1, 1); PG8_STAGE(PG8_SB(1, 0), b3, voffB); PG8_STAGE(PG8_SB(1, 1), b3 + hstep, voffB); PG8_STAGE(PG8_SA(1, 0), a3, voffA);
            PG8_WAIT_V(8); PG8_WAIT_L(0); PG8_BAR; PG8_MMA(1, 0, At, B0); PG8_MMA(1, 1, At, B1); PG8_BAR; PG8_SCHED;
            } else {
            PG8_LDB(B0, 0, 0); PG8_SCHED; PG8_LDA(At, 0, 0); PG8_STAGE(PG8_SA(1, 1), a1 + hstep, voffA);
            PG8_WAIT_L(8); PG8_BAR; PG8_WAIT_L(0); PG8_MMA(0, 0, At, B0); PG8_BAR; PG8_SCHED;
            PG8_LDB(B1, 0, 1); PG8_STAGE(PG8_SB(0, 0), b2, voffB);
            PG8_BAR; PG8_WAIT_L(0); PG8_MMA(0, 1, At, B1); PG8_BAR;
            PG8_LDA(At, 0, 1); PG8_STAGE(PG8_SA(0, 0), a2, voffA);
            PG8_BAR; PG8_WAIT_L(0); PG8_MMA(1, 0, At, B0); PG8_BAR; PG8_SCHED;
            PG8_STAGE(PG8_SB(0, 1), b2 + hstep, voffB);
            PG8_WAIT_V(6); PG8_BAR; PG8_MMA(1, 1, At, B1); PG8_BAR;
            PG8_LDB(B0, 1, 0); PG8_SCHED; PG8_LDA(At, 1, 0); PG8_STAGE(PG8_SA(0, 1), a2 + hstep, voffA);
            PG8_WAIT_L(8); PG8_BAR; PG8_WAIT_L(0); PG8_MMA(0, 0, At, B0); PG8_BAR; PG8_SCHED;
            PG8_LDB(B1, 1, 1); PG8_STAGE(PG8_SB(1, 0), b3, voffB);
            PG8_BAR; PG8_WAIT_L(0); PG8_MMA(0, 1, At, B1); PG8_BAR;
            PG8_LDA(At, 1, 1); PG8_STAGE(PG8_SA(1, 0), a3, voffA);
            PG8_BAR; PG8_WAIT_L(0); PG8_MMA(1, 0, At, B0); PG8_BAR; PG8_SCHED;
            PG8_STAGE(PG8_SB(1, 1), b3 + hstep, voffB);
            PG8_WAIT_V(6); PG8_BAR; PG8_MMA(1, 1, At, B1); PG8_BAR;
            }
        }
        if constexpr (ALIGN_EPI) { if (wr == 0) PG8_BAR; }
        if constexpr (!Epi::AFTER_DRAIN) { E(acc, cur, wr, wc, fr, fq); S.done(cur); }
        if (!has_next) break;
#pragma unroll
        for (int a = 0; a < 2; ++a)
#pragma unroll
            for (int b = 0; b < 2; ++b)
#pragma unroll
                for (int m = 0; m < 4; ++m)
#pragma unroll
                    for (int n = 0; n < 2; ++n) acc[a][b][m][n] = (f32x4){0.f, 0.f, 0.f, 0.f};
        cur = nxt; cA = nA; cB = nB; ++ui;
        if constexpr (ALIGN_EPI) { if (wr == 1) PG8_BAR; }
    }
    PG8_WAIT_V(0);
    if constexpr (!ALIGN_EPI) { if (wr == 0) PG8_BAR; }
    PG8_BAR;
    if constexpr (Epi::AFTER_DRAIN) { E.fused(acc, cur, wr, wc, fr, fq, lds, wid, lane); S.done(cur); }
#undef PG8_SA
#undef PG8_SB
#undef PG8_STAGE
#undef PG8_LDA
#undef PG8_LDB
#undef PG8_MMA
#undef PG8_WAIT_V
#undef PG8_WAIT_L
#undef PG8_BAR
#undef PG8_SCHED
}
}

struct EpiG1 {
  static constexpr bool PERM = false, AFTER_DRAIN = false;
  bf16_t* PROJ; bf16_t* QN; bf16_t* KS; bf16_t* KW; float* SSKV; const float2* RN; const float* g_q; const float* g_k; const float* part;
  __device__ __forceinline__ void operator()(const pg8::f32x4 (&acc0)[2][2][4][2], const pg8::Unit& u, int wr, int wc, int fr, int fq) const {
    const bool t1 = (u.pn == 1), t5 = (u.pn == 5);
    float rs8[2][4];
    {
      float4 pq[2][4];
#pragma unroll
      for (int ai = 0; ai < 2; ++ai)
#pragma unroll
        for (int m = 0; m < 4; ++m) pq[ai][m] = ((const float4*)(part + ((size_t)u.pm * 256 + ai * 128 + wr * 64 + m * 16 + fr) * 16))[fq];
#pragma unroll
      for (int ai = 0; ai < 2; ++ai)
#pragma unroll
        for (int m = 0; m < 4; ++m) { float q = (pq[ai][m].x + pq[ai][m].y) + (pq[ai][m].z + pq[ai][m].w); q += __shfl_xor(q, 16); q += __shfl_xor(q, 32); rs8[ai][m] = rsqrtf(q * (1.f / D) + EPS); }
    }
#pragma unroll
    for (int ai = 0; ai < 2; ++ai)
#pragma unroll
      for (int m = 0; m < 4; ++m) {
        const size_t t = (size_t)u.pm * 256 + ai * 128 + wr * 64 + m * 16 + fr;
        const float rsr = rs8[ai][m];
        pg8::f32x4 acc[1][2][1][2];
#pragma unroll
        for (int bj = 0; bj < 2; ++bj)
#pragma unroll
          for (int n = 0; n < 2; ++n) acc[0][bj][0][n] = acc0[ai][bj][m][n] * rsr;
        if (!(t1 || t5) || (t1 && wc < 2)) {
#pragma unroll
          for (int bj = 0; bj < 2; ++bj)
#pragma unroll
            for (int n = 0; n < 2; ++n) st_bf16x4(PROJ + t * DINP + u.pn * 256 + bj * 128 + wc * 32 + n * 16 + fq * 4, acc[0][bj][0][n]);
        }
        if (t1 || t5) {
          float ss = 0.f;
#pragma unroll
          for (int bj = 0; bj < 2; ++bj)
#pragma unroll
            for (int n = 0; n < 2; ++n) { const pg8::f32x4 v = acc[0][bj][0][n]; ss += v[0] * v[0] + v[1] * v[1] + v[2] * v[2] + v[3] * v[3]; }
          ss += __shfl_xor(ss, 16); ss += __shfl_xor(ss, 32);
          if (t1 && wc < 2) { if (fq == 0) SSKV[t * 2 + wc] = ss; }
          else {
            const float rs = rsqrtf(ss * (1.f / 64) + EPS);
            const float* gg = t5 ? g_q : (g_k + (wc == 2 ? 64 : 128));
            const float sc = t5 ? (0.125f * LOG2E) : 1.f;
            bf16_t* dst = t5 ? (QN + t * 256 + wc * 64) : ((wc == 2 ? KS : KW) + t * 64);
#pragma unroll
            for (int bj = 0; bj < 2; ++bj)
#pragma unroll
              for (int n = 0; n < 2; ++n) {
                const int e0 = 32 * bj + 16 * n + 4 * fq;
                const float4 g4 = *(const float4*)(gg + e0);
                pg8::f32x4 v = acc[0][bj][0][n];
                v[0] *= rs * g4.x; v[1] *= rs * g4.y; v[2] *= rs * g4.z; v[3] *= rs * g4.w;
                if (bj == 0 && n == 0) {
#pragma unroll
                  for (int j = 0; j < 4; ++j) {
                    const float x = v[j], partner = __shfl_xor(x, 32);
                    const int d = fq * 4 + j; const float2 cs2 = RN[t * 8 + (d & 7)];
                    v[j] = (d < 8) ? (x * cs2.x - partner * cs2.y) : (partner * cs2.y + x * cs2.x);
                  }
                }
                st_bf16x4(dst + e0, v * sc);
              }
          }
        }
      }
  }
};

template <bool IN16> struct EpiRes {
  static constexpr bool PERM = false, AFTER_DRAIN = false;
  const float* xin; const bf16_t* xin16; bf16_t* out;
  __device__ __forceinline__ void operator()(const pg8::f32x4 (&acc)[2][2][4][2], const pg8::Unit& u, int wr, int wc, int fr, int fq) const {
#pragma unroll
    for (int ai = 0; ai < 2; ++ai)
#pragma unroll
      for (int m = 0; m < 4; ++m) {
        const size_t row = (size_t)u.pm * 256 + ai * 128 + wr * 64 + m * 16 + fr;
#pragma unroll
        for (int bj = 0; bj < 2; ++bj)
#pragma unroll
          for (int n = 0; n < 2; ++n) {
            const size_t o = row * 1024 + u.pn * 256 + bj * 128 + wc * 32 + n * 16 + fq * 4;
            f32x4 xi;
            if constexpr (IN16) { const ushort4 u4 = *(const ushort4*)(xin16 + o); xi = (f32x4){bf2f(u4.x), bf2f(u4.y), bf2f(u4.z), bf2f(u4.w)}; }
            else xi = *(const f32x4*)(xin + o);
            st_bf16x4(out + o, xi + acc[ai][bj][m][n]);
          }
      }
  }
};

template <class RM>
DEVI void transpose_tiles(const float* src, int K, int N, bf16_t* dst, int ldk, RM rowmap, unsigned char* lds, int& cursor, const float* kscale = nullptr) {
  float* tl = (float*)lds;
  const int tk = K / 64, tn = (N + 63) / 64, nt = tk * tn;
  const int tid = HTID;
  const int G_ = VGRID;
  for (int it = (VBID - cursor % G_ + G_) % G_; it < nt; it += G_) {
    const int kt = it / tn, ntile = it % tn, k0 = kt * 64, n0 = ntile * 64;
    hsync();
#pragma unroll
    for (int q = 0; q < 4; ++q) {
      const int r = (tid >> 4) + 16 * q, c4 = (tid & 15) * 4;
      const float* sp = src + (size_t)(k0 + r) * N + n0 + c4;
      float4 v;
      if (n0 + c4 + 3 < N) v = *(const float4*)sp;
      else { v.x = (n0 + c4 < N) ? sp[0] : 0.f; v.y = (n0 + c4 + 1 < N) ? sp[1] : 0.f; v.z = (n0 + c4 + 2 < N) ? sp[2] : 0.f; v.w = 0.f; }
      if (kscale) { const float ks = kscale[k0 + r]; v.x *= ks; v.y *= ks; v.z *= ks; v.w *= ks; }
      tl[r * 65 + c4] = v.x; tl[r * 65 + c4 + 1] = v.y; tl[r * 65 + c4 + 2] = v.z; tl[r * 65 + c4 + 3] = v.w;
    }
    hsync();
    const int n = tid >> 2, kc = (tid & 3) * 16;
    if (n0 + n < N) {
      unsigned w[8];
#pragma unroll
      for (int i = 0; i < 8; ++i) w[i] = pk2bf(tl[(kc + 2 * i) * 65 + n], tl[(kc + 2 * i + 1) * 65 + n]);
      uint4* o = (uint4*)(dst + (size_t)rowmap(n0 + n) * ldk + k0 + kc);
      o[0] = make_uint4(w[0], w[1], w[2], w[3]); o[1] = make_uint4(w[4], w[5], w[6], w[7]);
    }
  }
  cursor += nt;
}
DEVI void convert_rows(const float* x, bf16_t* xb, float* part) {
  const int lane = HTID & 63, gw = VBID * 4 + (HTID >> 6), NGW = VGRID * 4;
  for (int t0 = gw * 4; t0 < T; t0 += NGW * 4) {
    float4 v[4][4];
#pragma unroll
    for (int q = 0; q < 4; ++q)
#pragma unroll
      for (int j = 0; j < 4; ++j) v[q][j] = ((const float4*)(x + (size_t)(t0 + q) * D))[lane + 64 * j];
#pragma unroll
    for (int q = 0; q < 4; ++q) {
      float s = 0.f;
#pragma unroll
      for (int j = 0; j < 4; ++j) s += v[q][j].x * v[q][j].x + v[q][j].y * v[q][j].y + v[q][j].z * v[q][j].z + v[q][j].w * v[q][j].w;
      s = wsum(s);
      if (lane < 16) part[(size_t)(t0 + q) * 16 + lane] = (lane == 0) ? s : 0.f;
#pragma unroll
      for (int j = 0; j < 4; ++j) {
        uint2 o; o.x = pk2bf(v[q][j].x, v[q][j].y); o.y = pk2bf(v[q][j].z, v[q][j].w);
        ((uint2*)(xb + (size_t)(t0 + q) * D))[lane + 64 * j] = o;
      }
    }
  }
}
DEVI void phase_prep(const Params& p, unsigned char* lds) {
  const size_t gtid = (size_t)VBID * NTHREADS + HTID, gn = (size_t)VGRID * NTHREADS;
  unsigned char* ws = p.ws;
  if (gtid < 64) ((int*)(ws + SM_CNT))[gtid] = 0;
  auto ident = [](int n) { return n; };
  int cursor = 0;
  for (int l = 0; l < NL; ++l) {
    unsigned char* wl = ws + WS_W + l * WS_WL;
    transpose_tiles(p.in[3] + (size_t)l * D * DIN, D, DIN, (bf16_t*)(wl + W_IN), D, [](int n) { return colmap(n); }, lds, cursor, p.in[2] + l * D);
    for (size_t i = gtid; i < (size_t)20 * D; i += gn) ((bf16_t*)(wl + W_IN))[(size_t)236 * D + i] = 0;
    transpose_tiles(p.in[36] + (size_t)l * D * D, D, D, (bf16_t*)(wl + W_OUT), D, ident, lds, cursor);
    transpose_tiles(p.in[6] + (size_t)l * 192 * 384, 192, 384, (bf16_t*)(wl + W_UQ), 192, ident, lds, cursor, p.in[4] + l * 192);
    transpose_tiles(p.in[7] + (size_t)l * 128 * 512, 128, 512, (bf16_t*)(wl + W_UKV), 128, ident, lds, cursor, p.in[5] + l * 128);
    transpose_tiles(p.in[25] + (size_t)l * 256 * 256, 256, 256, (bf16_t*)(wl + W_GLU), 256, ident, lds, cursor);
    transpose_tiles(p.in[30] + (size_t)l * 2048 * 128, 2048, 128, (bf16_t*)(wl + W_1K), 2048, ident, lds, cursor);
    transpose_tiles(p.in[33] + (size_t)l * 2048 * 128, 2048, 128, (bf16_t*)(wl + W_1V), 2048, ident, lds, cursor);
    transpose_tiles(p.in[31] + (size_t)l * 128 * 64, 128, 64, (bf16_t*)(wl + W_2K), 128, ident, lds, cursor);
    transpose_tiles(p.in[34] + (size_t)l * 128 * 64, 128, 64, (bf16_t*)(wl + W_2V), 128, ident, lds, cursor);
    for (int h = 0; h < 4; ++h) {
      transpose_tiles(p.in[12] + ((size_t)l * 4 + h) * 64 * 64, 64, 64, (bf16_t*)(wl + W_LRU) + h * 128 * 64, 64, ident, lds, cursor);
      transpose_tiles(p.in[14] + ((size_t)l * 4 + h) * 64 * 64, 64, 64, (bf16_t*)(wl + W_LRU) + h * 128 * 64 + 64 * 64, 64, ident, lds, cursor);
    }
    for (int e = 0; e < 16; ++e) {
      bf16_t* dg = (bf16_t*)(wl + W_GU) + (size_t)e * 512 * 1024;
      transpose_tiles(p.in[42] + ((size_t)l * 16 + e) * 1024 * 256, 1024, 256, dg, 1024, [](int hh) { return (hh >> 6) * 128 + ((hh >> 5) & 1) * 64 + ((hh >> 4) & 1) * 16 + (hh & 15); }, lds, cursor, p.in[37] + l * D);
      transpose_tiles(p.in[43] + ((size_t)l * 16 + e) * 1024 * 256, 1024, 256, dg, 1024, [](int hh) { return (hh >> 6) * 128 + ((hh >> 5) & 1) * 64 + (((hh >> 4) & 1) + 2) * 16 + (hh & 15); }, lds, cursor, p.in[37] + l * D);
      transpose_tiles(p.in[44] + ((size_t)l * 16 + e) * 256 * 1024, 256, 1024, (bf16_t*)(wl + W_DN) + (size_t)e * 1024 * 256, 256, ident, lds, cursor);
    }
    {
      const int lane = HTID & 63, gw = VBID * 4 + (HTID >> 6), NGW = VGRID * 4;
      for (int o = gw; o < 256; o += NGW) {
        const int kv = o >> 7, j = o & 127;
        const float* pe = (kv ? p.in[32] : p.in[29]) + (size_t)l * 2048;
        const float* w1 = (kv ? p.in[33] : p.in[30]) + (size_t)l * 2048 * 128;
        float a = 0.f;
#pragma unroll 8
        for (int k = lane; k < 2048; k += 64) a += pe[k] * w1[(size_t)k * 128 + j];
        a = wsum(a);
        if (lane == 0) ((float*)(wl + (kv ? W_B1V : W_B1K)))[j] = a;
      }
    }
    for (size_t i = gtid; i < 16 * 64; i += gn) {
      const int g = (int)(i >> 6), sidx = (int)(i & 63);
      const float are = p.in[17][(size_t)l * 1024 + i], aim = p.in[18][(size_t)l * 1024 + i];
      const float dt = expf(p.in[19][l * 16 + g]);
      const float mag = expf(dt * are);
      float sn, cs; sincosf(dt * aim, &sn, &cs);
      const float abr = mag * cs, abi = mag * sn;
      const float den = are * are + aim * aim, nre = abr - 1.f;
      const float gre = (nre * are + abi * aim) / den, gim = (abi * are - nre * aim) / den;
      ((float2*)(wl + W_S5A))[i] = make_float2(abr, abi);
      float pr = abr, pi = abi;
#pragma unroll
      for (int q = 0; q < 6; ++q) { const float nr = pr * pr - pi * pi, ni = 2.f * pr * pi; pr = nr; pi = ni; }
      ((float2*)(wl + W_S5A64))[i] = make_float2(pr, pi);
      bf16_t* bb = (bf16_t*)(wl + W_S5BB);
      for (int ch = 0; ch < 16; ++ch) {
        const float br = p.in[20][((size_t)l * 1024 + i) * 16 + ch], bi = p.in[21][((size_t)l * 1024 + i) * 16 + ch];
        const float vr = gre * br - gim * bi, vi = gre * bi + gim * br;
        const int sb = sidx >> 5, r = sidx & 31;
        bb[((g * 4 + sb * 2 + 0) * 32 + r) * 16 + ch] = f2bf(vr);
        bb[((g * 4 + sb * 2 + 1) * 32 + r) * 16 + ch] = f2bf(vi);
      }
    }
    for (size_t i = gtid; i < 32 * 1024; i += gn) {
      const int n = (int)(i >> 10), k = (int)(i & 1023);
      float w = 0.f;
      if (n < 20) w = p.in[37][l * D + k] * ((n < 4) ? p.in[38][((size_t)l * D + k) * 4 + n] : p.in[40][((size_t)l * D + k) * 16 + (n - 4)]);
      const bf16_t hi = f2bf(w);
      ((bf16_t*)(wl + W_RTH))[i] = hi; ((bf16_t*)(wl + W_RTL))[i] = f2bf(w - bf2f(hi));
    }
    for (size_t i = gtid; i < 16 * 16 * 64; i += gn) {
      const int g = (int)(i >> 10), ch = (int)((i >> 6) & 15), pp = (int)(i & 63);
      const float cr = p.in[22][(size_t)l * 16384 + i], ci = p.in[23][(size_t)l * 16384 + i];
      bf16_t* cm = (bf16_t*)(wl + W_S5CM) + ((size_t)(g * 16 + ch) * 128 + 2 * pp);
      cm[0] = f2bf(cr); cm[1] = f2bf(-ci);
    }
  }
  {
    const int* positions = (const int*)p.in[1];
    float2* RM = (float2*)(ws + WS_ROPE);
    float2* RN = RM + (size_t)T * 16;
    for (size_t i = gtid; i < (size_t)T * 24; i += gn) {
      const int t = (int)(i / 24), j = (int)(i % 24);
      const int rot = (j < 16) ? 32 : 16, fi = (j < 16) ? j : (j - 16);
      const float inv = powf(500000.f, -(2.f * (float)fi) / (float)rot);
      float sn, cs; sincosf((float)positions[t] * inv, &sn, &cs);
      if (j < 16) RM[(size_t)t * 16 + fi] = make_float2(cs, sn); else RN[(size_t)t * 8 + fi] = make_float2(cs, sn);
    }
  }
  convert_rows(p.in[0], (bf16_t*)(ws + WS_A), (float*)(ws + WS_PART));
}

DEVI void phase_g1(const Params& p, int l, unsigned char* lds_full) {
  const bf16_t* XN = (l == 0) ? (const bf16_t*)(p.ws + WS_A) : (const bf16_t*)p.out;
  const bf16_t* W = (const bf16_t*)(p.ws + WS_W + l * WS_WL + W_IN);
  bf16_t* QN = (bf16_t*)(p.ws + WS_G);
  pg8::Gemm g{XN, W, T, DINP, D}; pg8::StaticOrder S; S.init(T, DINP, (int)gridDim.x, (int)blockIdx.x);
  EpiG1 E{(bf16_t*)(p.ws + WS_B), QN, QN + (size_t)T * 256, QN + (size_t)T * 320, (float*)(p.ws + SM_SSKV), (const float2*)(p.ws + WS_ROPE) + (size_t)T * 16, p.in[27] + l * 64, p.in[28] + l * 192, (const float*)(p.ws + WS_PART)};
  pg8::gemm_phase<EpiG1, pg8::StaticOrder, true, true>((LAS unsigned char*)lds_full, g, S, E);
}

DEVI void phase_g2(const Params& p, int l, unsigned char* lds) {
  unsigned char* wl = p.ws + WS_W + l * WS_WL;
  const bf16_t* PROJ = (const bf16_t*)(p.ws + WS_B);
  bf16_t* QR = (bf16_t*)(p.ws + WS_D);
  bf16_t* KVR = QR + (size_t)T * 384;
  bf16_t* GATES = (bf16_t*)(p.ws + WS_E);
  bf16_t* MK = (bf16_t*)(p.ws + WS_F) + (size_t)T * 4 * 96;
  const float2* RM = (const float2*)(p.ws + WS_ROPE);
  constexpr int N_CMP = 64, N_QR = 256 * 3, N_KVR = 256 * 4, N_GT = 256 * 4;
  const int tid = HTID, wid = tid >> 6, lane = tid & 63, wr = wid >> 1, wc = wid & 1, fr = lane & 15, fq = lane >> 4;
  for (int it = vblock(); it < N_CMP + N_QR + N_KVR + N_GT; it += VGRID) {
    f32x4 acc[4][4];
    if (it < N_CMP) {
      const int kv = it & 1, half = (it >> 1) & 1, mt = it >> 2;
      const bf16_t* W = (const bf16_t*)(wl + (kv ? W_1V : W_1K)) + (size_t)half * 64 * 2048;
      const float* bias = (const float*)(wl + (kv ? W_B1V : W_B1K)) + half * 64;
      bf16_t* H = (bf16_t*)(p.ws + (kv ? SM_HV : SM_HK)) + half * 64;
      f32x4 acc2[2][4];
      gemm128h(lds, 2048,
              [&](int r, int k) { const int m = mt * 128 + r, b = m >> 7; int c = m & 127; if (c > 126) c = 126;
                                  return PROJ + (size_t)(b * S + 16 * c + (k >> 6)) * DINP + C_KC + kv * 64 + (k & 63); },
              [&](int r, int k) { return W + (size_t)r * 2048 + k; }, acc2);
#pragma unroll
      for (int m = 0; m < 2; ++m)
#pragma unroll
        for (int n = 0; n < 4; ++n) {
          const float4 b4 = *(const float4*)(bias + n * 16 + fq * 4);
          f32x4 o; o[0] = gelu_tanh(acc2[m][n][0] + b4.x); o[1] = gelu_tanh(acc2[m][n][1] + b4.y); o[2] = gelu_tanh(acc2[m][n][2] + b4.z); o[3] = gelu_tanh(acc2[m][n][3] + b4.w);
          st_bf16x4(H + (size_t)(mt * 128 + wid * 32 + m * 16 + fr) * 128 + n * 16 + fq * 4, o);
        }
    } else if (it < N_CMP + N_QR) {
      const int i2 = it - N_CMP, mt = i2 / 3, nt = i2 % 3;
      const bf16_t* W = (const bf16_t*)(wl + W_UQ);
      gemm128g(lds, 192, [&](int r, int k) { return PROJ + (size_t)(mt * 128 + r) * DINP + C_CQ + k; }, [&](int r, int k) { return W + (size_t)(nt * 128 + r) * 192 + k; }, acc);
      GEMM_EPI4({ st_bf16x4(QR + (size_t)(mt * 128 + er) * 384 + nt * 128 + ec0, ev4); })
    } else if (it < N_CMP + N_QR + N_KVR) {
      const int i2 = it - N_CMP - N_QR, mt = i2 >> 2, hd = i2 & 3;
      const bf16_t* W = (const bf16_t*)(wl + W_UKV);
      gemm128g(lds, 128, [&](int r, int k) { return PROJ + (size_t)(mt * 128 + r) * DINP + wgcol(C_T1, k >> 6, k & 63); }, [&](int r, int k) { return W + (size_t)(hd * 128 + r) * 128 + k; }, acc);
      const float* g_k = p.in[9] + l * 96;
#pragma unroll
      for (int m = 0; m < 4; ++m) {
        const size_t t = (size_t)mt * 128 + wr * 64 + m * 16 + fr;
        const int b = (int)(t >> 11), sq = (int)(t & (S - 1));
        const float2 ssp = *(const float2*)((const float*)(p.ws + SM_SSKV) + t * 2);
        const float ss = ssp.x + ssp.y;
        const float rskv = rsqrtf(ss * (1.f / 128) + EPS);
        if (wc == 1) {
#pragma unroll
          for (int n = 0; n < 4; ++n) st_bf16x4(KVR + t * 512 + hd * 128 + 64 + n * 16 + fq * 4, acc[m][n] * rskv);
        } else {
          const uint2 plo = *(const uint2*)(PROJ + t * DINP + C_KPE + 4 * fq), phi = *(const uint2*)(PROJ + t * DINP + C_KPE + 16 + 4 * fq);
          float pl[4] = {__uint_as_float(plo.x << 16), __uint_as_float(plo.x & 0xffff0000u), __uint_as_float(plo.y << 16), __uint_as_float(plo.y & 0xffff0000u)};
          float ph[4] = {__uint_as_float(phi.x << 16), __uint_as_float(phi.x & 0xffff0000u), __uint_as_float(phi.y << 16), __uint_as_float(phi.y & 0xffff0000u)};
          float sk = 0.f;
#pragma unroll
          for (int j = 0; j < 4; ++j) sk += pl[j] * pl[j] + ph[j] * ph[j];
          f32x4 kn[4];
#pragma unroll
          for (int n = 0; n < 4; ++n) { kn[n] = acc[m][n] * rskv; sk += kn[n][0] * kn[n][0] + kn[n][1] * kn[n][1] + kn[n][2] * kn[n][2] + kn[n][3] * kn[n][3]; }
          sk += __shfl_xor(sk, 16); sk += __shfl_xor(sk, 32);
          const float rsk = rsqrtf(sk * (1.f / 96) + EPS);
          bf16_t* dst = MK + ((size_t)(b * 4 + hd) * S + sq) * 96;
          f32x4 olo, ohi;
#pragma unroll
          for (int j = 0; j < 4; ++j) {
            const int d = 4 * fq + j; const float2 cs2 = RM[t * 16 + d];
            const float x1 = pl[j] * rsk * g_k[d], x2 = ph[j] * rsk * g_k[16 + d];
            olo[j] = x1 * cs2.x - x2 * cs2.y; ohi[j] = x1 * cs2.y + x2 * cs2.x;
          }
          st_bf16x4(dst + 4 * fq, olo); st_bf16x4(dst + 16 + 4 * fq, ohi);
#pragma unroll
          for (int n = 0; n < 4; ++n) { const float4 g4 = *(const float4*)(g_k + 32 + n * 16 + fq * 4); f32x4 o = kn[n] * rsk; o[0] *= g4.x; o[1] *= g4.y; o[2] *= g4.z; o[3] *= g4.w; st_bf16x4(dst + 32 + n * 16 + fq * 4, o); }
        }
      }
    } else {
      const int i2 = it - N_CMP - N_QR - N_KVR, mt = i2 >> 2, h = i2 & 3;
      const bf16_t* W = (const bf16_t*)(wl + W_LRU) + h * 128 * 64;
      const int c0 = h * 64 + (tid & 7) * 8;
      const float* cw = p.in[10] + l * 4 * 256 + c0; const float* cbp = p.in[11] + l * 256 + c0;
      gemm128(lds, 64,
              [&](int r, int k) {
                const size_t t = (size_t)mt * 128 + r; const int sq = (int)(t & (S - 1));
                float u[8];
#pragma unroll
                for (int e = 0; e < 8; ++e) u[e] = cbp[e];
#pragma unroll
                for (int j = 0; j < 4; ++j) {
                  if (sq - 3 + j >= 0) {
                    const u32x4 w = *(const u32x4*)(PROJ + (t - 3 + j) * DINP + C_LX + h * 64 + k);
#pragma unroll
                    for (int e = 0; e < 4; ++e) { u[2 * e] += __uint_as_float(w[e] << 16) * cw[j * 256 + 2 * e]; u[2 * e + 1] += __uint_as_float(w[e] & 0xffff0000u) * cw[j * 256 + 2 * e + 1]; }
                  }
                }
                u32x4 o; o[0] = pk2bf(u[0], u[1]); o[1] = pk2bf(u[2], u[3]); o[2] = pk2bf(u[4], u[5]); o[3] = pk2bf(u[6], u[7]);
                return o; },
              [&](int r, int k) { return W + (size_t)r * 64 + k; }, acc);
      GEMM_EPI4({ st_bf16x4(GATES + (size_t)(mt * 128 + er) * 512 + h * 128 + ec0, ev4); })
    }
  }
}

DEVI void lru_ab(float u, float rpre, float ipre, float sp, bool first, float& a, float& b) {
  const float r = sigmoidf_(rpre), gi = sigmoidf_(ipre);
  const float la = -8.f * r * sp;
  a = __expf(la);
  const float x = 2.f * la;
  const float om = (x > -0.1f) ? (-x * (1.f + 0.5f * x * (1.f + (1.f / 3.f) * x * (1.f + 0.25f * x * (1.f + 0.2f * x))))) : (1.f - a * a);
  const float mult = first ? 1.f : sqrtf(fmaxf(om, 0.f));
  b = mult * gi * u;
}
DEVI float lru_conv(const bf16_t* PROJ, int t, int s, int c, const float* cw, float cb) {
  float u = cb;
#pragma unroll
  for (int j = 0; j < 4; ++j) { const int ss2 = s - 3 + j; if (ss2 >= 0) u += bf2f(PROJ[(size_t)(t - 3 + j) * DINP + C_LX + c]) * cw[j * 256 + c]; }
  return u;
}

template <bool FULL>
DEVI void s5_chunk(const Params& p, int l, int b, int chunk, unsigned char* lds) {
  unsigned char* wl = p.ws + WS_W + l * WS_WL;
  const bf16_t* PROJ = (const bf16_t*)(p.ws + WS_B);
  const float2* Abar = (const float2*)(wl + W_S5A);
  const bf16_t* BB = (const bf16_t*)(wl + W_S5BB);
  const bf16_t* CM = (const bf16_t*)(wl + W_S5CM);
  float2* SLOC = (float2*)(p.ws + SM_SLOC);
  bf16_t* YCP = (bf16_t*)(p.ws + WS_F);
  const float* dd = p.in[24] + l * 256;
  const int tid = HTID, wv = tid >> 6, lane = tid & 63, r = lane & 31, h = lane >> 5, fr = lane & 15, fq = lane >> 4;
  unsigned* Hs = (unsigned*)(lds + wv * 8704);
  const int t0 = b * S + chunk * 64;
#pragma unroll 1
  for (int gi = 0; gi < 4; ++gi) {
    const int g = wv * 4 + gi;
    bf16x8 bbf[4];
#pragma unroll
    for (int nb = 0; nb < 4; ++nb) bbf[nb] = *(const bf16x8*)(BB + ((g * 4 + nb) * 32 + r) * 16 + 8 * h);
    float2 Ac[2]; float hr[2], hi[2];
#pragma unroll
    for (int sb = 0; sb < 2; ++sb) {
      Ac[sb] = Abar[g * 64 + sb * 32 + r];
      hr[sb] = 0.f; hi[sb] = 0.f;
      if (FULL) { const float2 cin = ((const float2*)(p.ws + SM_SCAR))[((size_t)(b * 32 + chunk) * 16 + g) * 64 + sb * 32 + r]; hr[sb] = cin.x; hi[sb] = cin.y; }
    }
    bf16x8 cm[4];
    float4 dcol4 = make_float4(0.f, 0.f, 0.f, 0.f);
    if (FULL) {
#pragma unroll
      for (int kk = 0; kk < 4; ++kk) cm[kk] = *(const bf16x8*)(CM + (size_t)(g * 16 + fr) * 128 + kk * 32 + 8 * fq);
      dcol4 = *(const float4*)(dd + g * 16 + 4 * fq);
    }
#pragma unroll 1
    for (int tb = 0; tb < 2; ++tb) {
      const bf16x8 ua = *(const bf16x8*)(PROJ + (size_t)(t0 + tb * 32 + r) * DINP + C_S5 + g * 16 + 8 * h);
      f32x16 acc[4];
#pragma unroll
      for (int nb = 0; nb < 4; ++nb) {
        f32x16 z;
#pragma unroll
        for (int i = 0; i < 16; ++i) z[i] = 0.f;
        acc[nb] = mfma32(ua, bbf[nb], z);
      }
#pragma unroll
      for (int sb = 0; sb < 2; ++sb) {
        float sr = hr[sb], si = hi[sb];
        const float ax = Ac[sb].x, ay = Ac[sb].y;
#pragma unroll
        for (int q = 0; q < 4; ++q)
#pragma unroll
          for (int owner = 0; owner < 2; ++owner) {
#pragma unroll
            for (int i = 0; i < 4; ++i) {
              const int reg = 4 * q + i;
              const float br = acc[2 * sb][reg], bi = acc[2 * sb + 1][reg];
              const float nr = ax * sr - ay * si + br, ni = ax * si + ay * sr + bi; sr = nr; si = ni;
              if (FULL) { acc[2 * sb][reg] = (h == owner) ? sr : br; acc[2 * sb + 1][reg] = (h == owner) ? si : bi; }
            }
            const float orr = __shfl_xor(sr, 32), oi = __shfl_xor(si, 32);
            if (h != owner) { sr = orr; si = oi; }
          }
        hr[sb] = sr; hi[sb] = si;
      }
      if (FULL) {
#pragma unroll
        for (int sb = 0; sb < 2; ++sb)
#pragma unroll
          for (int reg = 0; reg < 16; ++reg)
            Hs[crow(reg, h) * 68 + sb * 32 + r] = pk2bf(acc[2 * sb][reg], acc[2 * sb + 1][reg]);
#pragma unroll
        for (int tb16 = 0; tb16 < 2; ++tb16) {
          f32x4 y = (f32x4){0.f, 0.f, 0.f, 0.f};
#pragma unroll
          for (int kk = 0; kk < 4; ++kk) { const bf16x8 a = *(const bf16x8*)((const bf16_t*)Hs + (tb16 * 16 + fr) * 136 + kk * 32 + 8 * fq); y = mfma16(cm[kk], a, y); }
          const size_t t = (size_t)t0 + tb * 32 + tb16 * 16 + fr; const int col = g * 16 + 4 * fq;
          const uint2 uw = *(const uint2*)(PROJ + t * DINP + C_S5 + col);
          f32x4 o;
          o[0] = gelu_tanh(y[0] + dcol4.x * __uint_as_float(uw.x << 16)); o[1] = gelu_tanh(y[1] + dcol4.y * __uint_as_float(uw.x & 0xffff0000u));
          o[2] = gelu_tanh(y[2] + dcol4.z * __uint_as_float(uw.y << 16)); o[3] = gelu_tanh(y[3] + dcol4.w * __uint_as_float(uw.y & 0xffff0000u));
          st_bf16x4(YCP + t * 256 + col, o);
        }
      }
    }
    if (!FULL) {
#pragma unroll
      for (int sb = 0; sb < 2; ++sb) if (h == 0) SLOC[((size_t)(b * 32 + chunk) * 16 + g) * 64 + sb * 32 + r] = make_float2(hr[sb], hi[sb]);
    }
  }
}

template <bool FULL>
DEVI void lru_chunk(const Params& p, int l, int b, int chunk, float* tile) {
  const bf16_t* PROJ = (const bf16_t*)(p.ws + WS_B);
  const bf16_t* GATES = (const bf16_t*)(p.ws + WS_E);
  float2* LSUM = (float2*)(p.ws + SM_LSUM);
  const int c = HTID, h = c >> 6, j = c & 63;
  const float* cw = p.in[10] + l * 4 * 256;
  const float w0 = cw[c], w1 = cw[256 + c], w2 = cw[512 + c], w3 = cw[768 + c], cb = p.in[11][l * 256 + c];
  const float ba = p.in[13][l * 256 + c], bi = p.in[15][l * 256 + c];
  const float sp = log1pf(expf(-p.in[16][l * 256 + c]));
  const int s0 = chunk * 64; const size_t t0 = (size_t)b * S + s0;
  float xm3 = 0.f, xm2 = 0.f, xm1 = 0.f;
  if (s0 > 0) { xm3 = bf2f(PROJ[(t0 - 3) * DINP + C_LX + c]); xm2 = bf2f(PROJ[(t0 - 2) * DINP + C_LX + c]); xm1 = bf2f(PROJ[(t0 - 1) * DINP + C_LX + c]); }
  float hh = 0.f, ap = 1.f;
  if (FULL) hh = ((const float*)(p.ws + SM_LCAR))[(size_t)(b * 32 + chunk) * 256 + c];
#pragma unroll 1
  for (int k0 = 0; k0 < 64; k0 += 8) {
    float xv[8], rp[8], ip[8], gt[8];
#pragma unroll
    for (int i = 0; i < 8; ++i) {
      const size_t t = t0 + k0 + i;
      xv[i] = bf2f(PROJ[t * DINP + C_LX + c]);
      rp[i] = bf2f(GATES[t * 512 + h * 128 + j]); ip[i] = bf2f(GATES[t * 512 + h * 128 + 64 + j]);
      gt[i] = FULL ? bf2f(PROJ[t * DINP + C_LG + c]) : 0.f;
    }
#pragma unroll
    for (int i = 0; i < 8; ++i) {
      const float u = cb + xm3 * w0 + xm2 * w1 + xm1 * w2 + xv[i] * w3;
      xm3 = xm2; xm2 = xm1; xm1 = xv[i];
      float a, bb; lru_ab(u, rp[i] + ba, ip[i] + bi, sp, (s0 + k0 + i) == 0, a, bb);
      hh = a * hh + bb; ap *= a;
      if (FULL) tile[(k0 + i) * 256 + c] = hh * gelu_tanh(gt[i]);
    }
  }
  if (!FULL) LSUM[(size_t)(b * 32 + chunk) * 256 + c] = make_float2(ap, hh);
}

DEVI void phase_r2(const Params& p, int l, unsigned char* lds) {
  unsigned char* wl = p.ws + WS_W + l * WS_WL;
  const bf16_t* PROJ = (const bf16_t*)(p.ws + WS_B);
  const bf16_t* QR = (const bf16_t*)(p.ws + WS_D);
  const bf16_t* KVR = QR + (size_t)T * 384;
  const bf16_t* GATES = (const bf16_t*)(p.ws + WS_E);
  bf16_t* MQ = (bf16_t*)(p.ws + WS_F);
  bf16_t* MK = MQ + (size_t)T * 4 * 96;
  const float2* RM = (const float2*)(p.ws + WS_ROPE);
  const float2* RN = RM + (size_t)T * 16;
  const int tid = HTID, lane = tid & 63, wv = tid >> 6;
  for (int it = VBID; it < NB * 32; it += VGRID) lru_chunk<false>(p, l, it >> 5, it & 31, nullptr);
  hsync();
  for (int it = VBID; it < NB * 32; it += VGRID) s5_chunk<false>(p, l, it >> 5, it & 31, lds);
  {
    const bf16_t* HK = (const bf16_t*)(p.ws + SM_HK); const bf16_t* HV = (const bf16_t*)(p.ws + SM_HV);
    bf16_t* KC = (bf16_t*)(p.ws + SM_KC); bf16_t* VC = (bf16_t*)(p.ws + SM_VC);
    const bf16_t* W2K = (const bf16_t*)(wl + W_2K); const bf16_t* W2V = (const bf16_t*)(wl + W_2V);
    const float* g0 = p.in[28] + l * 192;
    for (int it = VBID; it < 32; it += VGRID) {
      const int kv = it & 1, mt = it >> 1;
      const bf16_t* H = kv ? HV : HK; const bf16_t* W2 = kv ? W2V : W2K;
      f32x4 acc[4][4];
      hsync();
      gemm128g(lds, 128, [&](int r, int k) { return H + (size_t)(mt * 128 + r) * 128 + k; }, [&](int r, int k) { return W2 + (size_t)(r & 63) * 128 + k; }, acc);
      const int wid = tid >> 6, wr = wid >> 1, wc = wid & 1, fr = lane & 15, fq = lane >> 4;
      if (wc == 0) {
#pragma unroll
        for (int m = 0; m < 4; ++m) {
          const int row = mt * 128 + wr * 64 + m * 16 + fr, b = row >> 7, c = row & 127;
          f32x4 v[4];
#pragma unroll
          for (int n = 0; n < 4; ++n) v[n] = acc[m][n];
          if (kv == 0) {
            float ss = 0.f;
#pragma unroll
            for (int n = 0; n < 4; ++n) ss += v[n][0] * v[n][0] + v[n][1] * v[n][1] + v[n][2] * v[n][2] + v[n][3] * v[n][3];
            ss += __shfl_xor(ss, 16); ss += __shfl_xor(ss, 32);
            const float rs = rsqrtf(ss * (1.f / 64) + EPS);
#pragma unroll
            for (int n = 0; n < 4; ++n) { const float4 gg = *(const float4*)(g0 + n * 16 + fq * 4); v[n][0] *= rs * gg.x; v[n][1] *= rs * gg.y; v[n][2] *= rs * gg.z; v[n][3] *= rs * gg.w; }
            const int cc = (c < 127) ? c : 126;
            const float2* cs = RN + (size_t)(b * S + 16 * cc + 31) * 8;
#pragma unroll
            for (int j = 0; j < 4; ++j) {
              const float x = v[0][j], partner = __shfl_xor(x, 32);
              const int d = fq * 4 + j; const float2 cs2 = cs[d & 7];
              v[0][j] = (d < 8) ? (x * cs2.x - partner * cs2.y) : (partner * cs2.y + x * cs2.x);
            }
          }
          bf16_t* dst = (kv ? VC : KC) + (size_t)row * 64;
#pragma unroll
          for (int n = 0; n < 4; ++n) { f32x4 o = v[n]; if (c >= 127) o = (f32x4){0.f, 0.f, 0.f, 0.f}; st_bf16x4(dst + n * 16 + fq * 4, o); }
        }
      }
    }
  }
}

typedef short v4i16_t __attribute__((ext_vector_type(4)));
DEVI float fexp2(float x) { return __builtin_amdgcn_exp2f(x); }
constexpr int VST = 96;
constexpr int ATT_VBYTES = 64 * VST * 2;
template <int DK> constexpr int att_kbytes() { return 64 * (DK + 8) * 2; }
template <int DK> constexpr int att_buf() { return att_kbytes<DK>() + ATT_VBYTES; }
template <int DK> struct TileRegs { u32x4 k[(64 * DK / 8 + 511) / 512]; u32x4 v; };
template <int DK>
DEVI void tile_load(TileRegs<DK>& tr, const bf16_t* kbase, size_t kstride, const bf16_t* vbase, size_t vstride, int key0, bool withv = true) {
  constexpr int CH = DK / 8, NCH = 64 * CH;
#pragma unroll
  for (int i = 0; i < (NCH + 511) / 512; ++i) { const int c = (int)threadIdx.x + 512 * i; if (c < NCH) { const int r = c / CH, cc = c % CH; tr.k[i] = *(const u32x4*)(kbase + (size_t)(key0 + r) * kstride + cc * 8); } }
  if (withv) { const int c = (int)threadIdx.x, r = c >> 3, cc = c & 7; tr.v = *(const u32x4*)(vbase + (size_t)(key0 + r) * vstride + cc * 8); }
}
template <int DK>
DEVI void tile_store(const TileRegs<DK>& tr, unsigned char* buf, bool withv = true) {
  constexpr int CH = DK / 8, NCH = 64 * CH;
  bf16_t* sK = (bf16_t*)buf; bf16_t* sV = (bf16_t*)(buf + att_kbytes<DK>());
#pragma unroll
  for (int i = 0; i < (NCH + 511) / 512; ++i) { const int c = (int)threadIdx.x + 512 * i; if (c < NCH) { const int r = c / CH, cc = c % CH; *(u32x4*)(sK + r * (DK + 8) + cc * 8) = tr.k[i]; } }
  if (withv) { const int c = (int)threadIdx.x, r = c >> 3, cc = c & 7; *(u32x4*)(sV + r * VST + cc * 8) = tr.v; }
}
template <int DK>
DEVI void qk_tile(const bf16_t* sK, const bf16x8* qf, f32x16& s0, f32x16& s1, int r, int h) {
#pragma unroll
  for (int i = 0; i < 16; ++i) { s0[i] = 0.f; s1[i] = 0.f; }
#pragma unroll
  for (int kk = 0; kk < DK / 16; ++kk) {
    const bf16x8 a0 = *(const bf16x8*)(sK + r * (DK + 8) + kk * 16 + h * 8);
    const bf16x8 a1 = *(const bf16x8*)(sK + (32 + r) * (DK + 8) + kk * 16 + h * 8);
    s0 = mfma32(a0, qf[kk], s0);
    s1 = mfma32(a1, qf[kk], s1);
  }
}
struct FState { f32x16 o0, o1; float m, l; };
DEVI void fstate_init(FState& f) {
#pragma unroll
  for (int i = 0; i < 16; ++i) { f.o0[i] = 0.f; f.o1[i] = 0.f; }
  f.m = -INFINITY; f.l = 0.f;
}
DEVI v4i16_t vtr(const bf16_t* p) { return __builtin_amdgcn_ds_read_tr16_b64_v4i16((LAS v4i16_t*)p); }
DEVI void softmax_pv(FState& f, f32x16& s0, f32x16& s1, const bf16_t* sV, int lane) {
  const int h = lane >> 5;
  float mx = -INFINITY;
#pragma unroll
  for (int i = 0; i < 16; ++i) mx = fmaxf(mx, fmaxf(s0[i], s1[i]));
  mx = fmaxf(mx, __shfl_xor(mx, 32));
  const float mnew = fmaxf(f.m, mx);
  const float muse = (mnew == -INFINITY) ? 0.f : mnew;
  float ps = 0.f;
#pragma unroll
  for (int i = 0; i < 16; ++i) { s0[i] = fexp2(s0[i] - muse); s1[i] = fexp2(s1[i] - muse); ps += s0[i] + s1[i]; }
  ps += __shfl_xor(ps, 32);
  if (__any(mnew != f.m)) {
    const float alpha = fexp2(f.m - muse);
    f.l = f.l * alpha + ps; f.m = mnew;
#pragma unroll
    for (int i = 0; i < 16; ++i) { f.o0[i] *= alpha; f.o1[i] *= alpha; }
  } else {
    f.l += ps;
  }
  const int g = lane >> 4, li = lane & 15, q = li >> 2, pp = li & 3;
  const bf16_t* vb = sV + (4 * h + q) * VST + (g & 1) * 16 + 4 * pp;
#pragma unroll
  for (int kb = 0; kb < 2; ++kb)
#pragma unroll
    for (int s = 0; s < 2; ++s) {
      unsigned pw[4];
#pragma unroll
      for (int j = 0; j < 4; ++j) pw[j] = kb ? pk2bf(s1[8 * s + 2 * j], s1[8 * s + 2 * j + 1]) : pk2bf(s0[8 * s + 2 * j], s0[8 * s + 2 * j + 1]);
      const bf16x8 pb = __builtin_bit_cast(bf16x8, (u32x4){pw[0], pw[1], pw[2], pw[3]});
#pragma unroll
      for (int db = 0; db < 2; ++db) {
        const v4i16_t lo = vtr(vb + (kb * 32 + 16 * s) * VST + db * 32);
        const v4i16_t hi = vtr(vb + (kb * 32 + 16 * s + 8) * VST + db * 32);
        const bf16x8 a = {lo[0], lo[1], lo[2], lo[3], hi[0], hi[1], hi[2], hi[3]};
        if (db == 0) f.o0 = mfma32(a, pb, f.o0); else f.o1 = mfma32(a, pb, f.o1);
      }
    }
}
DEVI void store_o(bf16_t* orow, const f32x16& o0, const f32x16& o1, float sc, int h) {
#pragma unroll
  for (int g = 0; g < 4; ++g) {
    uint2 v0, v1;
    v0.x = pk2bf(o0[4 * g] * sc, o0[4 * g + 1] * sc); v0.y = pk2bf(o0[4 * g + 2] * sc, o0[4 * g + 3] * sc);
    v1.x = pk2bf(o1[4 * g] * sc, o1[4 * g + 1] * sc); v1.y = pk2bf(o1[4 * g + 2] * sc, o1[4 * g + 3] * sc);
    *(uint2*)(orow + 8 * g + 4 * h) = v0;
    *(uint2*)(orow + 32 + 8 * g + 4 * h) = v1;
  }
}

DEVI void mla_item(const Params& p, int l, int b, int hd, int qt, unsigned char* lds) {
  const bf16_t* MQ = (const bf16_t*)(p.ws + WS_F);
  const bf16_t* MK = MQ + (size_t)T * 4 * 96;
  const bf16_t* KVR = (const bf16_t*)(p.ws + WS_D) + (size_t)T * 384;
  bf16_t* YA = (bf16_t*)(p.ws + WS_C);
  const int tid = (int)threadIdx.x, wv = tid >> 6, lane = tid & 63, r = lane & 31, h = lane >> 5;
  const int q0 = qt * 256 + wv * 32, tq = q0 + r;
  bf16x8 qf[6];
  {
    const bf16_t* qrow = (const bf16_t*)(p.ws + WS_D) + ((size_t)b * S + tq) * 384 + hd * 96;
    const float* g_q = p.in[8] + l * 96;
    float qv[6][8]; float ss = 0.f;
#pragma unroll
    for (int kk = 0; kk < 6; ++kk) {
      const u32x4 w = *(const u32x4*)(qrow + kk * 16 + h * 8);
#pragma unroll
      for (int e = 0; e < 4; ++e) { qv[kk][2 * e] = __uint_as_float(w[e] << 16); qv[kk][2 * e + 1] = __uint_as_float(w[e] & 0xffff0000u); ss += qv[kk][2 * e] * qv[kk][2 * e] + qv[kk][2 * e + 1] * qv[kk][2 * e + 1]; }
    }
    ss += __shfl_xor(ss, 32);
    const float rs = rsqrtf(ss * (1.f / 96) + EPS) * (0.10206207261596575f * LOG2E);
#pragma unroll
    for (int kk = 0; kk < 6; ++kk)
#pragma unroll
      for (int j = 0; j < 8; ++j) qv[kk][j] *= rs * g_q[kk * 16 + h * 8 + j];
    const float2* cs = (const float2*)(p.ws + WS_ROPE) + ((size_t)b * S + tq) * 16 + 8 * h;
#pragma unroll
    for (int j = 0; j < 8; ++j) { const float2 c2 = cs[j]; const float x1 = qv[0][j], x2 = qv[1][j]; qv[0][j] = x1 * c2.x - x2 * c2.y; qv[1][j] = x1 * c2.y + x2 * c2.x; }
#pragma unroll
    for (int kk = 0; kk < 6; ++kk) { const u32x4 w = {pk2bf(qv[kk][0], qv[kk][1]), pk2bf(qv[kk][2], qv[kk][3]), pk2bf(qv[kk][4], qv[kk][5]), pk2bf(qv[kk][6], qv[kk][7])}; qf[kk] = __builtin_bit_cast(bf16x8, w); }
  }
  FState f; fstate_init(f);
  const bf16_t* kbase = MK + (size_t)(b * 4 + hd) * S * 96;
  const bf16_t* vbase = KVR + (size_t)b * S * 512 + hd * 128 + 64;
  const int ntiles = 4 * qt + 4;
  TileRegs<96> tr;
  TileRegs<96> tr2;
  tile_load<96>(tr, kbase, 96, vbase, 512, 0);
  tile_load<96>(tr2, kbase, 96, vbase, 512, 64);
  __syncthreads();
  tile_store<96>(tr, lds);
  __syncthreads();
  auto compute = [&](int kt, unsigned char* cur) {
    if (kt * 64 <= q0 + 31) {
      f32x16 s0, s1;
      qk_tile<96>((const bf16_t*)cur, qf, s0, s1, r, h);
      if (kt * 64 + 63 > q0) {
        int rel = tq - kt * 64 - 4 * h; asm volatile("" : "+v"(rel));
#pragma unroll
        for (int i = 0; i < 16; ++i) { const int kk2 = (i & 3) + 8 * (i >> 2); if (kk2 > rel) s0[i] = -INFINITY; if (kk2 + 32 > rel) s1[i] = -INFINITY; }
      }
      softmax_pv(f, s0, s1, (const bf16_t*)(cur + att_kbytes<96>()), lane);
    }
  };
#pragma unroll 1
  for (int kt = 0; kt < ntiles; kt += 2) {
    if (kt + 2 < ntiles) tile_load<96>(tr, kbase, 96, vbase, 512, (kt + 2) * 64);
    compute(kt, lds);
    tile_store<96>(tr2, lds + att_buf<96>());
    __syncthreads();
    if (kt + 3 < ntiles) tile_load<96>(tr2, kbase, 96, vbase, 512, (kt + 3) * 64);
    compute(kt + 1, lds + att_buf<96>());
    if (kt + 2 < ntiles) tile_store<96>(tr, lds);
    __syncthreads();
  }
  store_o(YA + (size_t)(b * S + tq) * 256 + hd * 64, f.o0, f.o1, 1.f / f.l, h);
}

template <class KF, class BODY>
DEVI void nsa_stream(unsigned char* lds, const bf16_t* kbase, size_t kstride, const bf16_t* vbase, size_t vstride, bool withv, int nt, KF key0f, BODY body) {
  if (nt <= 0) return;
  TileRegs<64> trA, trB;
  tile_load<64>(trA, kbase, kstride, vbase, vstride, key0f(0), withv);
  if (nt > 1) tile_load<64>(trB, kbase, kstride, vbase, vstride, key0f(1), withv);
  __syncthreads();
  tile_store<64>(trA, lds, withv);
  __syncthreads();
  unsigned char* buf0 = lds; unsigned char* buf1 = lds + att_buf<64>();
#pragma unroll 1
  for (int i = 0; i < nt; i += 2) {
    if (i + 2 < nt) tile_load<64>(trA, kbase, kstride, vbase, vstride, key0f(i + 2), withv);
    body(i, buf0);
    if (i + 1 < nt) tile_store<64>(trB, buf1, withv);
    __syncthreads();
    if (i + 1 >= nt) break;
    if (i + 3 < nt) tile_load<64>(trB, kbase, kstride, vbase, vstride, key0f(i + 3), withv);
    body(i + 1, buf1);
    if (i + 2 < nt) tile_store<64>(trA, buf0, withv);
    __syncthreads();
  }
}
DEVI void nsa_item(const Params& p, int l, int b, int qt, unsigned char* lds) {
  const bf16_t* PROJ = (const bf16_t*)(p.ws + WS_B);
  const bf16_t* KC = (const bf16_t*)(p.ws + SM_KC) + (size_t)b * 128 * 64;
  const bf16_t* VC = (const bf16_t*)(p.ws + SM_VC) + (size_t)b * 128 * 64;
  const int tid = (int)threadIdx.x, wv = tid >> 6, lane = tid & 63, r = lane & 31, h = lane >> 5;
  float* psum = (float*)(lds + 2 * att_buf<64>());
  unsigned* selm = (unsigned*)(lds + 2 * att_buf<64>() + 32768);
  const int t0 = qt * 64, cur = t0 >> 6;
  const int ql = wv * 8 + (r >> 2), hd = r & 3, tq = t0 + ql;
  const size_t tg = (size_t)b * S + tq;
  bf16x8 qf[4];
#pragma unroll
  for (int kk = 0; kk < 4; ++kk) qf[kk] = *(const bf16x8*)((const bf16_t*)(p.ws + WS_G) + tg * 256 + hd * 64 + kk * 16 + h * 8);
  unsigned* ofs = (unsigned*)psum + wv * 1024 + lane;
  const float g0 = sigmoidf_(bf2f(PROJ[tg * DINP + C_NG + hd * 3 + 0]));
  const float g1 = sigmoidf_(bf2f(PROJ[tg * DINP + C_NG + hd * 3 + 1]));
  const float g2 = sigmoidf_(bf2f(PROJ[tg * DINP + C_NG + hd * 3 + 2]));
  FState f; fstate_init(f);
  const int ncmp = (((t0 + 32) >> 4) >> 6) + 1;
  nsa_stream(lds, KC, 64, VC, 64, true, ncmp, [&](int i) { return i * 64; }, [&](int kt, unsigned char* buf) {
    f32x16 s0, s1;
    qk_tile<64>((const bf16_t*)buf, qf, s0, s1, r, h);
    int rel = ((tq - 31) >> 4) - kt * 64 - 4 * h; asm volatile("" : "+v"(rel));
#pragma unroll
    for (int i = 0; i < 16; ++i) { const int kk2 = (i & 3) + 8 * (i >> 2); if (kk2 > rel) s0[i] = -INFINITY; if (kk2 + 32 > rel) s1[i] = -INFINITY; }
    softmax_pv(f, s0, s1, (const bf16_t*)(buf + att_kbytes<64>()), lane);
  });
  {
    const float muse = (f.m == -INFINITY) ? 0.f : f.m;
    const float il = (f.l > 0.f) ? 1.f / f.l : 0.f;
    if (ncmp < 2) {
#pragma unroll 1
      for (int i = tid; i < 64 * 128; i += KTHREADS) psum[i] = 0.f;
      __syncthreads();
    }
    nsa_stream(lds, KC, 64, VC, 64, false, ncmp, [&](int i) { return i * 64; }, [&](int kt, unsigned char* buf) {
      f32x16 s0, s1;
      qk_tile<64>((const bf16_t*)buf, qf, s0, s1, r, h);
      int rel = ((tq - 31) >> 4) - kt * 64 - 4 * h; asm volatile("" : "+v"(rel));
      int cb0 = kt * 64 + 4 * h; asm volatile("" : "+v"(cb0));
#pragma unroll
      for (int i = 0; i < 16; ++i) {
        const int kk2 = (i & 3) + 8 * (i >> 2); const int c = cb0 + kk2;
        float p0 = (kk2 > rel) ? 0.f : fexp2(s0[i] - muse) * il;
        float p1 = (kk2 + 32 > rel) ? 0.f : fexp2(s1[i] - muse) * il;
        p0 += __shfl_xor(p0, 1); p0 += __shfl_xor(p0, 2);
        p1 += __shfl_xor(p1, 1); p1 += __shfl_xor(p1, 2);
        if (hd == 0) { psum[ql * 128 + c] = p0; psum[ql * 128 + c + 32] = p1; }
      }
    });
  }
  __syncthreads();
#pragma unroll 1
  for (int itq = 0; itq < 4; ++itq) {
    const int q2 = wv * 8 + itq * 2 + (lane >> 5), j = lane & 31;
    const float* ps = psum + q2 * 128;
    float imp = 2.f * (ps[4 * j] + ps[4 * j + 1] + ps[4 * j + 2]) + ps[4 * j + 3];
    if (j > 0) imp += ps[4 * j - 1];
    const bool cand = (j >= 1) && (j <= cur - 2);
    int rank = 0;
    for (int jj = 0; jj < 32; ++jj) {
      const float v = __shfl(imp, (lane & 32) | jj);
      const bool cj = (jj >= 1) && (jj <= cur - 2);
      if (cj && (v > imp || (v == imp && jj < j))) ++rank;
    }
    const bool sel = cand && rank < 2;
    const unsigned long long bal = __ballot(sel);
    unsigned mk = (unsigned)(bal >> (32 * (lane >> 5)));
    mk |= 1u | (1u << cur); if (cur >= 1) mk |= (1u << (cur - 1));
    if (j == 0) selm[q2] = mk;
  }
  __syncthreads();
  unsigned blk_or = 0, wave_or = 0;
  for (int i = 0; i < 64; ++i) blk_or |= selm[i];
  for (int i = 0; i < 8; ++i) wave_or |= selm[wv * 8 + i];
  const unsigned mymask = selm[ql];
  {
    const float sc = (f.l > 0.f) ? g0 / f.l : 0.f;
#pragma unroll
    for (int i = 0; i < 8; ++i) { ofs[i * 64] = pk2bf(f.o0[2 * i] * sc, f.o0[2 * i + 1] * sc); ofs[(8 + i) * 64] = pk2bf(f.o1[2 * i] * sc, f.o1[2 * i + 1] * sc); }
  }
  fstate_init(f);
  {
    unsigned* tl = selm + 64;
    if (tid < 32 && ((blk_or >> tid) & 1u)) tl[__popc(blk_or & ((1u << tid) - 1u))] = tid;
    __syncthreads();
    const int nsel = __popc(blk_or);
    nsa_stream(lds, (const bf16_t*)(p.ws + WS_G) + (size_t)T * 256 + (size_t)b * S * 64, 64, PROJ + (size_t)b * S * DINP + C_VS, DINP, true, nsel,
      [&](int i) { return (int)tl[i] * 64; },
      [&](int i, unsigned char* buf) {
        const int jj = (int)tl[i];
        if ((wave_or >> jj) & 1u) {
          f32x16 s0, s1;
          qk_tile<64>((const bf16_t*)buf, qf, s0, s1, r, h);
          const bool on = (mymask >> jj) & 1u;
          int rel = on ? (tq - jj * 64 - 4 * h) : -1; asm volatile("" : "+v"(rel));
#pragma unroll
          for (int i2 = 0; i2 < 16; ++i2) { const int kk2 = (i2 & 3) + 8 * (i2 >> 2); if (kk2 > rel) s0[i2] = -INFINITY; if (kk2 + 32 > rel) s1[i2] = -INFINITY; }
          softmax_pv(f, s0, s1, (const bf16_t*)(buf + att_kbytes<64>()), lane);
        }
      });
    const float sc = (f.l > 0.f) ? g1 / f.l : 0.f;
#pragma unroll
    for (int i = 0; i < 8; ++i) {
      const unsigned w0 = ofs[i * 64], w1 = ofs[(8 + i) * 64];
      ofs[i * 64] = pk2bf(__uint_as_float(w0 << 16) + f.o0[2 * i] * sc, __uint_as_float(w0 & 0xffff0000u) + f.o0[2 * i + 1] * sc);
      ofs[(8 + i) * 64] = pk2bf(__uint_as_float(w1 << 16) + f.o1[2 * i] * sc, __uint_as_float(w1 & 0xffff0000u) + f.o1[2 * i + 1] * sc);
    }
  }
  fstate_init(f);
  {
    int jlo = (t0 - 511) >> 6; if (jlo < 0) jlo = 0;
    nsa_stream(lds, (const bf16_t*)(p.ws + WS_G) + (size_t)T * 320 + (size_t)b * S * 64, 64, PROJ + (size_t)b * S * DINP + C_VW, DINP, true, cur - jlo + 1,
      [&](int i) { return (jlo + i) * 64; },
      [&](int i, unsigned char* buf) {
        const int j = jlo + i;
        f32x16 s0, s1;
        qk_tile<64>((const bf16_t*)buf, qf, s0, s1, r, h);
        if (j == cur || j * 64 < t0 + 63 - 511 + 64) {
          int rel = tq - j * 64 - 4 * h; asm volatile("" : "+v"(rel));
#pragma unroll
          for (int i2 = 0; i2 < 16; ++i2) {
            const int kk2 = (i2 & 3) + 8 * (i2 >> 2);
            if (kk2 > rel || kk2 < rel - 511) s0[i2] = -INFINITY;
            if (kk2 + 32 > rel || kk2 + 32 < rel - 511) s1[i2] = -INFINITY;
          }
        }
        softmax_pv(f, s0, s1, (const bf16_t*)(buf + att_kbytes<64>()), lane);
      });
    const float sc = (f.l > 0.f) ? g2 / f.l : 0.f;
#pragma unroll
    for (int i = 0; i < 8; ++i) {
      const unsigned w0 = ofs[i * 64], w1 = ofs[(8 + i) * 64];
      f.o0[2 * i] = __uint_as_float(w0 << 16) + f.o0[2 * i] * sc; f.o0[2 * i + 1] = __uint_as_float(w0 & 0xffff0000u) + f.o0[2 * i + 1] * sc;
      f.o1[2 * i] = __uint_as_float(w1 << 16) + f.o1[2 * i] * sc; f.o1[2 * i + 1] = __uint_as_float(w1 & 0xffff0000u) + f.o1[2 * i + 1] * sc;
    }
  }
  f32x16& of0 = f.o0; f32x16& of1 = f.o1;
  {
    float ss = 0.f;
#pragma unroll
    for (int i = 0; i < 16; ++i) ss += of0[i] * of0[i] + of1[i] * of1[i];
    ss += __shfl_xor(ss, 1); ss += __shfl_xor(ss, 2); ss += __shfl_xor(ss, 32);
    const float rs = rsqrtf(ss * (1.f / 256) + EPS);
    const float* on = p.in[35] + l * 1024 + 768 + hd * 64;
#pragma unroll
    for (int g4 = 0; g4 < 4; ++g4) {
      const float4 a = *(const float4*)(on + 8 * g4 + 4 * h), b4 = *(const float4*)(on + 32 + 8 * g4 + 4 * h);
      of0[4 * g4] *= a.x; of0[4 * g4 + 1] *= a.y; of0[4 * g4 + 2] *= a.z; of0[4 * g4 + 3] *= a.w;
      of1[4 * g4] *= b4.x; of1[4 * g4 + 1] *= b4.y; of1[4 * g4 + 2] *= b4.z; of1[4 * g4 + 3] *= b4.w;
    }
    store_o((bf16_t*)(p.ws + WS_A) + tg * 1024 + 768 + hd * 64, of0, of1, rs, h);
  }
}

DEVI void carry_item(const Params& p, int l, int it) {
  const int tid = HTID;
  if (it < 64) {
    const int idx = it * 256 + tid, b = idx >> 10, gs = idx & 1023;
    const float2 a64 = ((const float2*)(p.ws + WS_W + l * WS_WL + W_S5A64))[gs];
    const float2* SLOC = (const float2*)(p.ws + SM_SLOC) + (size_t)b * 32 * 1024 + gs;
    float2* SCAR = (float2*)(p.ws + SM_SCAR) + (size_t)b * 32 * 1024 + gs;
    float hr = 0.f, hi = 0.f;
#pragma unroll 1
    for (int c0 = 0; c0 < 32; c0 += 8) {
      float2 sl[8];
#pragma unroll
      for (int i = 0; i < 8; ++i) sl[i] = SLOC[(size_t)(c0 + i) * 1024];
#pragma unroll
      for (int i = 0; i < 8; ++i) { SCAR[(size_t)(c0 + i) * 1024] = make_float2(hr, hi); const float nr = a64.x * hr - a64.y * hi + sl[i].x, ni = a64.x * hi + a64.y * hr + sl[i].y; hr = nr; hi = ni; }
    }
  } else {
    const int idx = (it - 64) * 256 + tid, b = idx >> 8, c = idx & 255;
    const float2* LSUM = (const float2*)(p.ws + SM_LSUM) + (size_t)b * 32 * 256 + c;
    float* LCAR = (float*)(p.ws + SM_LCAR) + (size_t)b * 32 * 256 + c;
    float hh = 0.f;
#pragma unroll 1
    for (int c0 = 0; c0 < 32; c0 += 8) {
      float2 sv[8];
#pragma unroll
      for (int i = 0; i < 8; ++i) sv[i] = LSUM[(size_t)(c0 + i) * 256];
#pragma unroll
      for (int i = 0; i < 8; ++i) { LCAR[(size_t)(c0 + i) * 256] = hh; hh = sv[i].x * hh + sv[i].y; }
    }
  }
}
DEVI void phase_a1(const Params& p, int l, unsigned char* lds_full) {
  for (int it = VBID; it < 80; it += VGRID) carry_item(p, l, it);
  __syncthreads();
  const int G_ = (int)gridDim.x, bx_ = (int)blockIdx.x, vb_ = (G_ % 8 == 0) ? (bx_ % 8) * (G_ / 8) + bx_ / 8 : bx_;
  for (int rr = 0; rr * G_ < 512; ++rr) { const int j = rr * G_ + ((rr & 1) ? (G_ - 1 - vb_) : vb_); if (j < 512) { const int b = j >> 5, qt = 31 - (j & 31); nsa_item(p, l, b, qt, lds_full); } }
  __syncthreads();
  for (int rr = 0; rr * G_ < 512; ++rr) { const int j = rr * G_ + ((rr & 1) ? (G_ - 1 - vb_) : vb_); if (j < 512) { const int bh = j >> 3, qt = 7 - (j & 7); mla_item(p, l, bh >> 2, bh & 3, qt, lds_full); } }
}

DEVI void phase_r3(const Params& p, int l, unsigned char* lds) {
  bf16_t* Y = (bf16_t*)(p.ws + WS_A);
  const int tid = HTID, lane = tid & 63, wv = tid >> 6;
  {
    const float* onorm = p.in[35] + l * 1024 + 256;
    float* tile = (float*)lds;
    for (int it = VBID; it < NB * 32; it += VGRID) {
      const int b = it >> 5, chunk = it & 31;
      hsync();
      lru_chunk<true>(p, l, b, chunk, tile);
      hsync();
      for (int k = wv; k < 64; k += 4) {
        const float4 v = *(const float4*)(tile + k * 256 + lane * 4);
        const float rs = rsqrtf(wsum(v.x * v.x + v.y * v.y + v.z * v.z + v.w * v.w) * (1.f / 256) + EPS);
        const size_t t = (size_t)b * S + chunk * 64 + k;
        const float4 gg = *(const float4*)(onorm + lane * 4);
        st_bf16x4(Y + t * 1024 + 256 + lane * 4, (f32x4){v.x * rs * gg.x, v.y * rs * gg.y, v.z * rs * gg.z, v.w * rs * gg.w});
      }
    }
  }
  hsync();
  for (int it = VBID; it < NB * 32; it += VGRID) s5_chunk<true>(p, l, it >> 5, it & 31, lds);
}

DEVI void phase_g3(const Params& p, int l, unsigned char* lds) {
  const bf16_t* YCP = (const bf16_t*)(p.ws + WS_F);
  bf16_t* YC = (bf16_t*)(p.ws + WS_F) + (size_t)T * 256;
  const bf16_t* W = (const bf16_t*)(p.ws + WS_W + l * WS_WL + W_GLU);
  const float* bg = p.in[26] + l * 256;
  for (int it = vblock(); it < 256 * 2; it += VGRID) {
    const int mt = it >> 1, nt = it & 1;
    f32x4 acc[4][4];
    gemm128g(lds, 256, [&](int r, int k) { return YCP + (size_t)(mt * 128 + r) * 256 + k; }, [&](int r, int k) { return W + (size_t)(nt * 128 + r) * 256 + k; }, acc);
    GEMM_EPI4({ const size_t o = (size_t)(mt * 128 + er) * 256 + nt * 128 + ec0; const ushort4 yp = *(const ushort4*)(YCP + o); f32x4 r4; r4[0] = bf2f(yp.x) * sigmoidf_(ev4[0] + bg[nt * 128 + ec0]); r4[1] = bf2f(yp.y) * sigmoidf_(ev4[1] + bg[nt * 128 + ec0 + 1]); r4[2] = bf2f(yp.z) * sigmoidf_(ev4[2] + bg[nt * 128 + ec0 + 2]); r4[3] = bf2f(yp.w) * sigmoidf_(ev4[3] + bg[nt * 128 + ec0 + 3]); st_bf16x4(YC + o, r4); })
  }
}

DEVI void phase_r4(const Params& p, int l) {
  const bf16_t* YA = (const bf16_t*)(p.ws + WS_C);
  const bf16_t* YC = (const bf16_t*)(p.ws + WS_F) + (size_t)T * 256;
  bf16_t* Y = (bf16_t*)(p.ws + WS_A);
  const float* onorm = p.in[35] + l * 1024;
  const int lane = HTID & 63, gw = VBID * 4 + (HTID >> 6), NGW = VGRID * 4;
  for (int t = gw; t < T; t += NGW) {
#pragma unroll
    for (int grp = 0; grp < 2; ++grp) {
      const bf16_t* src = (grp == 0 ? YA : YC) + (size_t)t * 256;
      const int gcol = (grp == 0 ? 0 : 512);
      const ushort4 u = ((const ushort4*)src)[lane];
      const float v0 = bf2f(u.x), v1 = bf2f(u.y), v2 = bf2f(u.z), v3 = bf2f(u.w);
      const float rs = rsqrtf(wsum(v0 * v0 + v1 * v1 + v2 * v2 + v3 * v3) * (1.f / 256) + EPS);
      const float4 g = ((const float4*)(onorm + gcol))[lane];
      uint2 o; o.x = pk2bf(v0 * rs * g.x, v1 * rs * g.y); o.y = pk2bf(v2 * rs * g.z, v3 * rs * g.w);
      ((uint2*)(Y + (size_t)t * 1024 + gcol))[lane] = o;
    }
  }
}

DEVI void phase_g4(const Params& p, int l, unsigned char* lds_full) {
  const bf16_t* Y = (const bf16_t*)(p.ws + WS_A);
  const bf16_t* W = (const bf16_t*)(p.ws + WS_W + l * WS_WL + W_OUT);
  pg8::Gemm g{Y, W, T, D, D}; pg8::StaticOrder S; S.init(T, D, (int)gridDim.x, (int)blockIdx.x);
  bf16_t* X1 = (bf16_t*)(p.ws + WS_D);
  if (l == 0) { EpiRes<false> E{p.in[0], nullptr, X1}; pg8::gemm_phase<EpiRes<false>, pg8::StaticOrder, true, true>((LAS unsigned char*)lds_full, g, S, E); }
  else { EpiRes<true> E{nullptr, (const bf16_t*)p.out, X1}; pg8::gemm_phase<EpiRes<true>, pg8::StaticOrder, true, true>((LAS unsigned char*)lds_full, g, S, E); }
}

DEVI void phase_r5(const Params& p, int l, unsigned char* lds) {
  const bf16_t* x1 = (const bf16_t*)(p.ws + WS_D);
  const bf16_t* WH = (const bf16_t*)(p.ws + WS_W + l * WS_WL + W_RTH);
  const bf16_t* WL = (const bf16_t*)(p.ws + WS_W + l * WS_WL + W_RTL);
  const float* brg = p.in[39] + l * 4; const float* bre = p.in[41] + l * 16;
  int* CNT = (int*)(p.ws + SM_CNT) + l * 32;
  int* LIST = (int*)(p.ws + SM_LIST);
  float4* TOKW = (float4*)(p.ws + SM_TOKW);
  const int tid = HTID, lane = tid & 63, wv = tid >> 6, c = lane & 15, q = lane >> 4;
  float* red = (float*)lds;
  int* hist = (int*)(lds + 16384);
  int* tokl = (int*)(lds + 16384 + 256);
  if (tid < 64) hist[tid] = 0;
  int ntok = 0;
  hsync();
  for (int it = VBID; it < T / 16; it += VGRID) {
    const size_t tb = (size_t)it * 16;
    f32x4 a0 = (f32x4){0.f, 0.f, 0.f, 0.f}, a1 = (f32x4){0.f, 0.f, 0.f, 0.f};
    float ss = 0.f;
    const bf16_t* xrow = x1 + (tb + c) * D + wv * 256 + 8 * q;
    const bf16_t* wh0 = WH + (size_t)c * 1024 + wv * 256 + 8 * q;
    const bf16_t* wl0 = WL + (size_t)c * 1024 + wv * 256 + 8 * q;
    u32x4 xk[8];
#pragma unroll
    for (int ks = 0; ks < 8; ++ks) xk[ks] = *(const u32x4*)(xrow + ks * 32);
#pragma unroll
    for (int ks = 0; ks < 8; ++ks) {
      const bf16x8 wh_a = *(const bf16x8*)(wh0 + ks * 32), wl_a = *(const bf16x8*)(wl0 + ks * 32);
      const bf16x8 wh_b = *(const bf16x8*)(wh0 + 16 * 1024 + ks * 32), wl_b = *(const bf16x8*)(wl0 + 16 * 1024 + ks * 32);
#pragma unroll
      for (int j = 0; j < 4; ++j) {
        const float x0 = __uint_as_float(xk[ks][j] << 16), x1v = __uint_as_float(xk[ks][j] & 0xffff0000u);
        ss += x0 * x0 + x1v * x1v;
      }
      const bf16x8 xh = __builtin_bit_cast(bf16x8, xk[ks]);
      a0 = mfma16(wh_a, xh, a0); a0 = mfma16(wl_a, xh, a0);
      a1 = mfma16(wh_b, xh, a1); a1 = mfma16(wl_b, xh, a1);
    }
    ss += __shfl_xor(ss, 16); ss += __shfl_xor(ss, 32);
    hsync();
#pragma unroll
    for (int j = 0; j < 4; ++j) { red[(wv * 9 + j) * 64 + lane] = a0[j]; red[(wv * 9 + 4 + j) * 64 + lane] = a1[j]; }
    red[(wv * 9 + 8) * 64 + lane] = ss;
    hsync();
    const float s2 = red[8 * 64 + lane] + red[(9 + 8) * 64 + lane] + red[(18 + 8) * 64 + lane] + red[(27 + 8) * 64 + lane];
    const float rs = rsqrtf(s2 * (1.f / D) + EPS);
    if (wv == 0) {
      float c0[4], c1[4];
#pragma unroll
      for (int j = 0; j < 4; ++j) {
        c0[j] = red[j * 64 + lane] + red[(9 + j) * 64 + lane] + red[(18 + j) * 64 + lane] + red[(27 + j) * 64 + lane];
        c1[j] = red[(4 + j) * 64 + lane] + red[(13 + j) * 64 + lane] + red[(22 + j) * 64 + lane] + red[(31 + j) * 64 + lane];
      }
      float lg[20];
#pragma unroll
      for (int qq = 0; qq < 4; ++qq)
#pragma unroll
        for (int j = 0; j < 4; ++j) lg[4 * qq + j] = __shfl(c0[j], c + 16 * qq);
#pragma unroll
      for (int j = 0; j < 4; ++j) lg[16 + j] = __shfl(c1[j], c);
      const int t = (int)tb + c;
      float gl[4];
#pragma unroll
      for (int k2 = 0; k2 < 4; ++k2) gl[k2] = lg[k2] * rs + brg[k2];
      int gi = 0; float gbest = gl[0];
#pragma unroll
      for (int k2 = 1; k2 < 4; ++k2) if (gl[k2] > gbest) { gbest = gl[k2]; gi = k2; }
      float den = 0.f;
#pragma unroll
      for (int k2 = 0; k2 < 4; ++k2) den += expf(gl[k2] - gbest);
      const float pg = 1.f / den;
      float le[4];
#pragma unroll
      for (int k2 = 0; k2 < 4; ++k2) { float sel = 0.f;
#pragma unroll
        for (int gg2 = 0; gg2 < 4; ++gg2) sel = (gi == gg2) ? (lg[4 + gg2 * 4 + k2] * rs + bre[gg2 * 4 + k2]) : sel;
        le[k2] = sel; }
      int i0 = 0; float l0 = le[0];
#pragma unroll
      for (int k2 = 1; k2 < 4; ++k2) if (le[k2] > l0) { l0 = le[k2]; i0 = k2; }
      int i1 = -1; float l1 = -INFINITY;
#pragma unroll
      for (int k2 = 0; k2 < 4; ++k2) if (k2 != i0 && le[k2] > l1) { l1 = le[k2]; i1 = k2; }
      const float e1 = expf(l1 - l0);
      const float w0 = pg / (1.f + e1), w1 = pg * e1 / (1.f + e1);
      const int elo = (i0 < i1) ? i0 : i1, ehi = (i0 < i1) ? i1 : i0;
      const float wlo = (i0 < i1) ? w0 : w1, whi = (i0 < i1) ? w1 : w0;
      const int pidx = (elo == 0) ? (ehi - 1) : ((elo == 1) ? (ehi + 1) : 5);
      const int cls = gi * 6 + pidx;
      if (q == 0) {
        const int rank = atomicAdd(&hist[cls], 1);
        tokl[2 * (ntok + c)] = t; tokl[2 * (ntok + c) + 1] = (cls << 16) | rank;
        TOKW[t] = make_float4(wlo, whi, rs, 0.f);
      }
    }
    ntok += 16;
  }
  hsync();
  if (tid < 24) { const int n = hist[tid]; hist[32 + tid] = n ? atomicAdd(&CNT[tid], n) : 0; }
  hsync();
  for (int i = tid; i < ntok; i += NTHREADS) { const int t = tokl[2 * i], cr = tokl[2 * i + 1], cls = cr >> 16; LIST[(size_t)cls * T + hist[32 + cls] + (cr & 0xffff)] = t; }
}

struct MoeItem { int cls, mtile, nt, cnt; };
DEVI void moe_prefix(const int* CNT, unsigned char* lds) {
  int* pre = (int*)(lds + LDS_BYTES + 64);
  hsync();
  if (HTID < 24) pre[32 + HTID] = CNT[HTID];
  hsync();
  if (HTID == 0) { int a = 0; for (int c = 0; c < 24; ++c) { pre[c] = a; a += (pre[32 + c] + 127) >> 7; } pre[24] = a; }
  hsync();
}
DEVI bool moe_item(unsigned char* lds, int it, MoeItem& m) {
  const int* pre = (const int*)(lds + LDS_BYTES + 64);
  const int mt = it >> 3; m.nt = it & 7;
  if (mt >= pre[24]) return false;
  int c = 0;
#pragma unroll
  for (int q = 1; q < 24; ++q) c += (mt >= pre[q]) ? 1 : 0;
  m.cls = c; m.mtile = mt - pre[c]; m.cnt = pre[32 + c];
  return true;
}
DEVI void cls_experts(int cls, int& e0, int& e1) {
  const int g = cls / 6, pi = cls % 6;
  const int lo = (pi < 3) ? 0 : ((pi < 5) ? 1 : 2);
  const int hi = (pi < 3) ? (pi + 1) : ((pi < 5) ? (pi - 1) : 3);
  e0 = g * 4 + lo; e1 = g * 4 + hi;
}
DEVI void phase_g5(const Params& p, int l, unsigned char* lds) {
  const bf16_t* XN = (const bf16_t*)(p.ws + WS_D);
  bf16_t* HID = (bf16_t*)(p.ws + WS_B);
  const bf16_t* WGU = (const bf16_t*)(p.ws + WS_W + l * WS_WL + W_GU);
  const int* CNT = (const int*)(p.ws + SM_CNT) + l * 32;
  const int* LIST = (const int*)(p.ws + SM_LIST);
  const float4* TOKW = (const float4*)(p.ws + SM_TOKW);
  moe_prefix(CNT, lds);
  const int G_ = VGRID, total_ = ((const int*)(lds + LDS_BYTES + 64))[24] * 8, full_ = (total_ / G_) * G_, rem_ = total_ - full_;
  for (int it = vblock(); it < full_ + 2 * rem_; it += G_) {
    const bool halfmode = it >= full_; const int half = (it - full_) & 1;
    MoeItem mi; if (!moe_item(lds, halfmode ? full_ + ((it - full_) >> 1) : it, mi)) break;
    int e0, e1; cls_experts(mi.cls, e0, e1);
    const int ex = (mi.nt < 4) ? e0 : e1, ntl = mi.nt & 3;
    const bf16_t* W = WGU + ((size_t)ex * 512 + ntl * 128) * 1024;
    const int* list = LIST + (size_t)mi.cls * T + mi.mtile * 128;
    const int nvalid = mi.cnt - mi.mtile * 128;
    if (halfmode) {
      f32x4 acc2[2][4];
      int tokA[4];
#pragma unroll
      for (int i = 0; i < 4; ++i) { const int r = (HTID >> 3) + 32 * i; tokA[i] = list[(r < nvalid) ? r : 0]; }
      const int tid = HTID, wid = tid >> 6, lane = tid & 63, fr = lane & 15, fq = lane >> 4;
      int tokE2[2]; float twE2[2], rsE2[2];
#pragma unroll
      for (int m = 0; m < 2; ++m) { const int er = wid * 32 + m * 16 + fr; tokE2[m] = list[(er < nvalid) ? er : 0]; }
#pragma unroll
      for (int m = 0; m < 2; ++m) { const float4 tw = TOKW[tokE2[m]]; twE2[m] = (mi.nt < 4) ? tw.x : tw.y; rsE2[m] = tw.z; }
      const bf16_t* Wh = W + (size_t)half * 64 * 1024;
      gemm128h(lds, D, [&](int r, int k) { const int i = r >> 5; const int tok = (i == 0) ? tokA[0] : (i == 1) ? tokA[1] : (i == 2) ? tokA[2] : tokA[3]; return XN + (size_t)tok * D + k; },
               [&](int r, int k) { return Wh + (size_t)r * D + k; }, acc2);
#pragma unroll
      for (int m = 0; m < 2; ++m) {
        const int er = wid * 32 + m * 16 + fr;
        if (er < nvalid) {
#pragma unroll
          for (int n = 0; n < 2; ++n) {
            f32x4 hv;
#pragma unroll
            for (int j = 0; j < 4; ++j) { const float gt = acc2[m][n][j] * rsE2[m], up = acc2[m][n + 2][j] * rsE2[m]; hv[j] = gt * sigmoidf_(gt) * up * twE2[m]; }
            st_bf16x4(HID + (size_t)tokE2[m] * 512 + (mi.nt < 4 ? 0 : 256) + ntl * 64 + half * 32 + n * 16 + fq * 4, hv);
          }
        }
      }
      continue;
    }
    f32x4 acc[4][4];
    int tokA[4], tokE[4]; float twE[4], rsE[4];
#pragma unroll
    for (int i = 0; i < 4; ++i) { const int r = (HTID >> 3) + 32 * i; tokA[i] = list[(r < nvalid) ? r : 0]; }
    {
      const int tid_ = HTID, er0 = ((tid_ >> 6) >> 1) * 64 + (tid_ & 15);
#pragma unroll
      for (int m = 0; m < 4; ++m) { const int er = er0 + m * 16; tokE[m] = list[(er < nvalid) ? er : 0]; }
#pragma unroll
      for (int m = 0; m < 4; ++m) { const float4 tw = TOKW[tokE[m]]; twE[m] = (mi.nt < 4) ? tw.x : tw.y; rsE[m] = tw.z; }
    }
    gemm128g(lds, D, [&](int r, int k) { const int i = r >> 5; const int tok = (i == 0) ? tokA[0] : (i == 1) ? tokA[1] : (i == 2) ? tokA[2] : tokA[3]; return XN + (size_t)tok * D + k; }, [&](int r, int k) { return W + (size_t)r * D + k; }, acc);
    {
      const int tid = HTID, wid = tid >> 6, lane = tid & 63, wr = wid >> 1, wc = wid & 1, fr = lane & 15, fq = lane >> 4;
#pragma unroll
      for (int m = 0; m < 4; ++m) {
        const int er = wr * 64 + m * 16 + fr;
        if (er < nvalid) {
          const int tok = tokE[m];
          const float w = twE[m], rsm = rsE[m];
#pragma unroll
          for (int n = 0; n < 2; ++n) {
            f32x4 hv;
#pragma unroll
            for (int j = 0; j < 4; ++j) { const float gt = acc[m][n][j] * rsm, up = acc[m][n + 2][j] * rsm; hv[j] = gt * sigmoidf_(gt) * up * w; }
            const int hh = (mi.nt < 4 ? 0 : 256) + ntl * 64 + wc * 32 + n * 16 + fq * 4;
            st_bf16x4(HID + (size_t)tok * 512 + hh, hv);
          }
        }
      }
    }
  }
}
DEVI void phase_g6(const Params& p, int l, unsigned char* lds) {
  const bf16_t* HID = (const bf16_t*)(p.ws + WS_B);
  const bf16_t* WDN = (const bf16_t*)(p.ws + WS_W + l * WS_WL + W_DN);
  const int* CNT = (const int*)(p.ws + SM_CNT) + l * 32;
  const int* LIST = (const int*)(p.ws + SM_LIST);
  float* out = p.out;
  bf16_t* out16 = (bf16_t*)p.out;
  const bf16_t* X1 = (const bf16_t*)(p.ws + WS_D);
  float* PART = (float*)(p.ws + WS_PART);
  moe_prefix(CNT, lds);
  const int G_ = VGRID, total_ = ((const int*)(lds + LDS_BYTES + 64))[24] * 8, full_ = (total_ / G_) * G_, rem_ = total_ - full_;
  for (int it = vblock(); it < full_ + 2 * rem_; it += G_) {
    const bool halfmode = it >= full_; const int half = (it - full_) & 1;
    MoeItem mi; if (!moe_item(lds, halfmode ? full_ + ((it - full_) >> 1) : it, mi)) break;
    int e0, e1; cls_experts(mi.cls, e0, e1);
    const int* list = LIST + (size_t)mi.cls * T + mi.mtile * 128;
    const int nvalid = mi.cnt - mi.mtile * 128;
    const bf16_t* W0 = WDN + ((size_t)e0 * 1024 + mi.nt * 128) * 256;
    const bf16_t* W1 = WDN + ((size_t)e1 * 1024 + mi.nt * 128) * 256;
    if (halfmode) {
      f32x4 acc2[2][4];
      int tokA[4];
#pragma unroll
      for (int i = 0; i < 4; ++i) { const int r = (HTID >> 3) + 32 * i; tokA[i] = list[(r < nvalid) ? r : 0]; }
      const int tid = HTID, wid = tid >> 6, lane = tid & 63, fr = lane & 15, fq = lane >> 4;
      int trow2[2];
#pragma unroll
      for (int m = 0; m < 2; ++m) { const int er = wid * 32 + m * 16 + fr; trow2[m] = list[(er < nvalid) ? er : 0]; }
      const bf16_t* W0h = W0 + (size_t)half * 64 * 256; const bf16_t* W1h = W1 + (size_t)half * 64 * 256;
      gemm128h(lds, 512, [&](int r, int k) { const int i = r >> 5; const int tok = (i == 0) ? tokA[0] : (i == 1) ? tokA[1] : (i == 2) ? tokA[2] : tokA[3]; return HID + (size_t)tok * 512 + k; },
               [&](int r, int k) { return ((k < 256) ? W0h : W1h) + (size_t)r * 256 + (k & 255); }, acc2);
      float ssq[2] = {0.f, 0.f};
#pragma unroll
      for (int m = 0; m < 2; ++m) {
        const int er = wid * 32 + m * 16 + fr;
        if (er < nvalid) {
#pragma unroll
          for (int n = 0; n < 4; ++n) {
            const size_t o = (size_t)trow2[m] * D + mi.nt * 128 + half * 64 + n * 16 + fq * 4;
            const ushort4 u4 = *(const ushort4*)(X1 + o); const f32x4 r4 = (f32x4){bf2f(u4.x), bf2f(u4.y), bf2f(u4.z), bf2f(u4.w)} + acc2[m][n];
            if (l == 0) { st_bf16x4(out16 + o, r4); ssq[m] += r4[0] * r4[0] + r4[1] * r4[1] + r4[2] * r4[2] + r4[3] * r4[3]; } else *(f32x4*)(out + o) = r4;
          }
        }
      }
      if (l == 0) {
#pragma unroll
        for (int m = 0; m < 2; ++m) { float q2 = ssq[m]; q2 += __shfl_xor(q2, 16); q2 += __shfl_xor(q2, 32); const int er = wid * 32 + m * 16 + fr; if (fq == 0 && er < nvalid) PART[(size_t)trow2[m] * 16 + mi.nt * 2 + half] = q2; }
      }
      continue;
    }
    f32x4 acc[4][4];
    int trow[4], tokA[4];
    {
      const int tid = HTID, wid = tid >> 6, lane = tid & 63, wr = wid >> 1, fr = lane & 15;
#pragma unroll
      for (int i = 0; i < 4; ++i) { const int r = (tid >> 3) + 32 * i; tokA[i] = list[(r < nvalid) ? r : 0]; }
#pragma unroll
      for (int m = 0; m < 4; ++m) { const int er = wr * 64 + m * 16 + fr; trow[m] = list[(er < nvalid) ? er : 0]; }
    }
    gemm128g(lds, 512, [&](int r, int k) { const int i = r >> 5; const int tok = (i == 0) ? tokA[0] : (i == 1) ? tokA[1] : (i == 2) ? tokA[2] : tokA[3]; return HID + (size_t)tok * 512 + k; },
            [&](int r, int k) { return ((k < 256) ? W0 : W1) + (size_t)r * 256 + (k & 255); }, acc);
    float ssq[4] = {0.f, 0.f, 0.f, 0.f};
    GEMM_EPI4({ if (er < nvalid) { const size_t o = (size_t)trow[m] * D + mi.nt * 128 + ec0; const f32x4 r4 = ld_bf16x4(X1 + o) + ev4;
      if (l == 0) { st_bf16x4(out16 + o, r4); ssq[m] += r4[0] * r4[0] + r4[1] * r4[1] + r4[2] * r4[2] + r4[3] * r4[3]; } else *(f32x4*)(out + o) = r4; } })
    if (l == 0) {
      const int tid = HTID, wid = tid >> 6, lane = tid & 63, wr = wid >> 1, wc = wid & 1, fr = lane & 15, fq = lane >> 4;
#pragma unroll
      for (int m = 0; m < 4; ++m) { float q2 = ssq[m]; q2 += __shfl_xor(q2, 16); q2 += __shfl_xor(q2, 32); const int er = wr * 64 + m * 16 + fr; if (fq == 0 && er < nvalid) PART[(size_t)trow[m] * 16 + mi.nt * 2 + wc] = q2; }
    }
  }
}


#define XB_TMO      128
#define XB_XCNT(j)  (256  + 64 * (j))
#define XB_XSUB(j)  (1280 + 64 * (j))
#define XB_XGEN(j)  (2304 + 64 * (j))
#define XB_TOP      3328
#define XB_TOPGEN   3392
#define XCD_BAR_WORDS 3456
#define XB_SPIN_CAP (1u << 18)
DEVI unsigned xb_ld(unsigned* p)              { return __hip_atomic_load(p, __ATOMIC_RELAXED, __HIP_MEMORY_SCOPE_AGENT); }
DEVI unsigned xb_add(unsigned* p, unsigned v) { return __hip_atomic_fetch_add(p, v, __ATOMIC_RELAXED, __HIP_MEMORY_SCOPE_AGENT); }
DEVI unsigned xb_xcc_id() { return (unsigned)__builtin_amdgcn_s_getreg((3 << 11) | 20) & 0xFu; }
#define XB_SPIN(cond, bar) do { unsigned _sp = 0; while (cond) { __builtin_amdgcn_s_sleep(1); \
    if ((++_sp & 255u) == 0u) { if (xb_ld(&(bar)[XB_TMO])) break; if (_sp > XB_SPIN_CAP) { atomicAdd(&(bar)[XB_TMO], 1u); break; } } } } while (0)
struct XcdBarrier { unsigned* bar; unsigned x; volatile LAS unsigned* st; };
DEVI XcdBarrier xcd_barrier_post(unsigned* bar, volatile LAS unsigned* st) {
    XcdBarrier b; b.bar = bar; b.x = xb_xcc_id(); b.st = st;
    if (threadIdx.x == 0) (void)xb_add(&bar[XB_XCNT(b.x)], 1u);
    return b;
}
DEVI void xcd_barrier_complete(unsigned* bar, unsigned x, unsigned& nloc, unsigned& nx) {
    const unsigned G = gridDim.x * gridDim.y * gridDim.z;
    unsigned sum, cnt, mine, sp = 0u;
    for (;;) {
        sum = 0u; cnt = 0u; mine = 0u;
#pragma unroll
        for (unsigned j = 0; j < 16; ++j) { const unsigned c = xb_ld(&bar[XB_XCNT(j)]); sum += c; cnt += (c > 0u) ? 1u : 0u; mine = (j == x) ? c : mine; }
        if (sum == G) break;
        __builtin_amdgcn_s_sleep(1);
        if ((++sp & 255u) == 0u) { if (xb_ld(&bar[XB_TMO])) break; if (sp > XB_SPIN_CAP) { atomicAdd(&bar[XB_TMO], 1u); break; } }
    }
    nloc = mine > 0u ? mine : 1u; nx = cnt > 0u ? cnt : 1u;
}
DEVI void xcd_barrier(const XcdBarrier& b) {
    asm volatile("s_waitcnt vmcnt(0)" ::: "memory");
    __syncthreads();
    if (threadIdx.x == 0) {
        unsigned* bar = b.bar;
        __builtin_amdgcn_s_waitcnt(0);
        unsigned nloc = b.st[0], nx = b.st[1];
        if (nloc == 0u) { xcd_barrier_complete(bar, b.x, nloc, nx); b.st[0] = nloc; b.st[1] = nx; }
        const unsigned old = xb_add(&bar[XB_XSUB(b.x)], 1u);
        const unsigned gen = old / nloc;
        if (old + 1u == (gen + 1u) * nloc) {
            __builtin_amdgcn_fence(__ATOMIC_RELEASE, "agent");
            asm volatile("s_waitcnt vmcnt(0)" ::: "memory");
            const unsigned og = xb_add(&bar[XB_TOP], 1u);
            const unsigned tg = og / nx;
            if (og + 1u == (tg + 1u) * nx) xb_add(&bar[XB_TOPGEN], 1u);
            else XB_SPIN(xb_ld(&bar[XB_TOPGEN]) == tg, bar);
            __builtin_amdgcn_fence(__ATOMIC_ACQUIRE, "agent");
            xb_add(&bar[XB_XGEN(b.x)], 1u);
            asm volatile("s_waitcnt vmcnt(0)" ::: "memory");
        } else {
            XB_SPIN(xb_ld(&bar[XB_XGEN(b.x)]) == gen, bar);
            __builtin_amdgcn_fence(__ATOMIC_ACQUIRE, "agent");
            asm volatile("s_waitcnt vmcnt(0)" ::: "memory");
        }
    }
    __syncthreads();
}

#define PH(k, call) { const int _k = (k); if (p.lo <= _k && _k < p.hi) { call; if (_k + 1 < p.hi) { if (_k == 0) grid.sync(); else xcd_barrier(xbar); } } }
__global__ void __launch_bounds__(KTHREADS, 2) hybrid_fwd(Params p) {
  extern __shared__ __attribute__((aligned(16))) unsigned char lds_full[];
  unsigned char* lds = lds_full + hb_() * LDS_HALF;
  cg::grid_group grid = cg::this_grid();
  volatile LAS unsigned* xst = (volatile LAS unsigned*)(LAS unsigned char*)(lds_full + 2 * LDS_HALF);
  if (threadIdx.x < 4) { xst[threadIdx.x] = 0u; g_hs[threadIdx.x] = 0u; }
  __syncthreads();
  XcdBarrier xbar = xcd_barrier_post((unsigned*)(p.ws + WS_CTL), xst);
  PH(0, phase_prep(p, lds))
#define LAYER(l) { \
    PH(1 + 13 * l + 0, phase_g1(p, l, lds_full)) \
    PH(1 + 13 * l + 2, phase_g2(p, l, lds)) \
    PH(1 + 13 * l + 3, phase_r2(p, l, lds)) \
    PH(1 + 13 * l + 4, phase_a1(p, l, lds_full)) \
    PH(1 + 13 * l + 5, phase_r3(p, l, lds)) \
    PH(1 + 13 * l + 6, phase_g3(p, l, lds)) \
    PH(1 + 13 * l + 7, phase_r4(p, l)) \
    PH(1 + 13 * l + 8, phase_g4(p, l, lds_full)) \
    PH(1 + 13 * l + 9, phase_r5(p, l, lds)) \
    PH(1 + 13 * l + 10, phase_g5(p, l, lds)) \
    PH(1 + 13 * l + 11, phase_g6(p, l, lds)) }
  LAYER(0)
  LAYER(1)
}

extern "C" void kernel_launch(void* const* d_in, const int* in_sizes, int n_in, void* d_out, int out_size, void* d_ws, size_t ws_size, hipStream_t stream) {
  static int grid_blocks = 0;
  if (!grid_blocks) {
    if (n_in != 45 || ws_size < WS_END) { fprintf(stderr, "kernel_launch: unexpected n_in %d or ws_size %zu (< %zu)\n", n_in, ws_size, (size_t)WS_END); grid_blocks = -1; return; }
    int dev = 0, cus = 0, per_cu = 0;
    hipGetDevice(&dev);
    hipDeviceGetAttribute(&cus, hipDeviceAttributeMultiprocessorCount, dev);
    hipFuncSetAttribute((const void*)hybrid_fwd, hipFuncAttributeMaxDynamicSharedMemorySize, LDS_ALLOC);
    hipOccupancyMaxActiveBlocksPerMultiprocessor(&per_cu, (const void*)hybrid_fwd, KTHREADS, LDS_ALLOC);
    if (per_cu < 1) per_cu = 1;
    if (per_cu > 1) per_cu = 1;
    grid_blocks = cus * per_cu;
    fprintf(stderr, "kernel_launch: cus %d per_cu %d grid %d\n", cus, per_cu, grid_blocks);
  }
  if (grid_blocks < 0) return;
  (void)hipMemsetAsync((unsigned char*)d_ws + WS_CTL, 0, XCD_BAR_WORDS * 4, stream);
  Params p{};
  for (int i = 0; i < 45; ++i) p.in[i] = (const float*)d_in[i];
  p.out = (float*)d_out; p.ws = (unsigned char*)d_ws;
#if N_LAUNCH_MODE == 1
  p.lo = 0; p.hi = NPH;
  { void* args[] = {&p}; hipError_t e = hipLaunchCooperativeKernel((void*)hybrid_fwd, dim3(grid_blocks), dim3(KTHREADS), args, LDS_ALLOC, stream);
    if (e != hipSuccess) fprintf(stderr, "cooperative launch failed: %s\n", hipGetErrorString(e)); }
#else
  for (int ph = 0; ph < NPH; ++ph) {
    p.lo = ph; p.hi = ph + 1;
    void* args[] = {&p}; hipError_t e = hipLaunchCooperativeKernel((void*)hybrid_fwd, dim3(grid_blocks), dim3(KTHREADS), args, LDS_ALLOC, stream);
    if (e != hipSuccess) { fprintf(stderr, "launch %d failed: %s\n", ph, hipGetErrorString(e)); break; }
  }
#endif
}
```

```cpp
#include <hip/hip_runtime.h>
#include <hip/hip_cooperative_groups.h>
#include <cstdio>
#include <cstdint>
namespace cg = cooperative_groups;

#ifndef N_LAUNCH_MODE
#define N_LAUNCH_MODE 1
#endif

#define DEVI __device__ __forceinline__

constexpr int KTHREADS = 512;
__shared__ unsigned g_hs[4];
#define HTID ((int)(threadIdx.x & 255))
__device__ __forceinline__ int hb_() { return __builtin_amdgcn_readfirstlane((int)(threadIdx.x >> 8)); }
#define VBID ((int)blockIdx.x * 2 + hb_())
#define VGRID ((int)gridDim.x * 2)
__device__ __forceinline__ void hsync() {
  asm volatile("s_waitcnt lgkmcnt(0)" ::: "memory");
  if ((threadIdx.x & 63) == 0) {
    unsigned* c = &g_hs[hb_()];
    const unsigned old = __hip_atomic_fetch_add(c, 1u, __ATOMIC_RELAXED, __HIP_MEMORY_SCOPE_WORKGROUP);
    const unsigned target = (old & ~3u) + 4u;
    if (old + 1u != target) {
      while ((int)(__hip_atomic_load(c, __ATOMIC_RELAXED, __HIP_MEMORY_SCOPE_WORKGROUP) - target) < 0) {}
    }
  }
  asm volatile("" ::: "memory");
}
typedef unsigned short bf16_t;
typedef short bf16x8 __attribute__((ext_vector_type(8)));
typedef float f32x4 __attribute__((ext_vector_type(4)));
typedef float f32x16 __attribute__((ext_vector_type(16)));
typedef unsigned u32x4 __attribute__((ext_vector_type(4)));
#define LAS __attribute__((address_space(3)))

constexpr int NB = 16, S = 2048, T = NB * S, D = 1024, DIN = 1772, DINP = 1792, NL = 2;
constexpr int C_CQ = 0, C_KPE = 192, C_NG = 224, C_T1 = 256, C_LX = 512, C_LG = 768, C_S5 = 1024, C_T5 = 1280, C_KC = 1536, C_VC = 1600, C_VS = 1664, C_VW = 1728;
__host__ __device__ constexpr int wgcol(int tile0, int wc, int e) { return tile0 + 128 * (e >> 5) + 32 * wc + (e & 31); }
__host__ __device__ constexpr int colmap(int n) {
  if (n < 192) return n;
  if (n < 320) { const int k = n - 192; return wgcol(C_T1, k >> 6, k & 63); }
  if (n < 352) return C_KPE + (n - 320);
  if (n < 608) return C_LX + (n - 352);
  if (n < 864) return C_LG + (n - 608);
  if (n < 1120) return C_S5 + (n - 864);
  if (n < 1376) { const int q = n - 1120; return wgcol(C_T5, q >> 6, q & 63); }
  if (n < 1760) { const int j = n - 1376, part = j >> 6, d = j & 63;
    return part == 0 ? C_KC + d : part == 1 ? C_VC + d : part == 2 ? wgcol(C_T1, 2, d) : part == 3 ? C_VS + d : part == 4 ? wgcol(C_T1, 3, d) : C_VW + d; }
  return C_NG + (n - 1760);
}
constexpr float EPS = 1e-6f;
constexpr float LOG2E = 1.4426950408889634f;
constexpr int NTHREADS = 256;
constexpr int NPH = 1 + 13 * NL - 1;

constexpr size_t MiB = 1u << 20;
constexpr size_t WS_CTL = 0;
constexpr size_t WS_SMALL = 1 * MiB;
constexpr size_t WS_W = 16 * MiB;
constexpr size_t WS_WL = 32 * MiB;
constexpr size_t WS_A = 80 * MiB;
constexpr size_t WS_B = 144 * MiB;
constexpr size_t WS_C = 256 * MiB;
constexpr size_t WS_D = 292 * MiB;
constexpr size_t WS_E = 348 * MiB;
constexpr size_t WS_F = 380 * MiB;
constexpr size_t WS_G = 428 * MiB;
constexpr size_t WS_ROPE = 452 * MiB;
constexpr size_t WS_PART = WS_ROPE + 6 * MiB;
constexpr size_t WS_END = 460 * MiB;
constexpr size_t W_IN = 0;
constexpr size_t W_OUT = 4 * MiB;
constexpr size_t W_UQ = 6 * MiB;
constexpr size_t W_UKV = W_UQ + 384 * 192 * 2;
constexpr size_t W_LRU = W_UKV + 512 * 128 * 2;
constexpr size_t W_GLU = W_LRU + 4 * 128 * 64 * 2;
constexpr size_t W_1K = 6 * MiB + 512 * 1024;
constexpr size_t W_1V = W_1K + 128 * 2048 * 2;
constexpr size_t W_B1K = W_1V + 128 * 2048 * 2;
constexpr size_t W_B1V = W_B1K + 512;
constexpr size_t W_S5A = W_B1V + 512;
constexpr size_t W_S5A64 = W_S5A + 16 * 64 * 8;
constexpr size_t W_S5B = W_S5A64 + 16 * 64 * 8;
constexpr size_t W_S5BB = W_S5B + 16 * 64 * 16 * 8;
constexpr size_t W_S5CM = W_S5BB + 16 * 4 * 32 * 16 * 2;
constexpr size_t W_2K = W_S5CM + 16 * 16 * 128 * 2;
constexpr size_t W_2V = W_2K + 64 * 128 * 2;
static_assert(W_2V + 64 * 128 * 2 <= 8 * MiB, "weights overflow");
constexpr size_t W_RTH = W_2V + 64 * 128 * 2;
constexpr size_t W_RTL = W_RTH + 32 * 1024 * 2;
static_assert(W_RTL + 32 * 1024 * 2 <= 8 * MiB, "weights overflow 2");
constexpr size_t W_GU = 8 * MiB;
constexpr size_t W_DN = 24 * MiB;
constexpr size_t SM_CNT = WS_SMALL;
constexpr size_t SM_LIST = WS_SMALL + 4096;
constexpr size_t SM_TOKW = SM_LIST + 24 * (size_t)T * 4;
constexpr size_t SM_LSUM = SM_TOKW + (size_t)T * 16;
constexpr size_t SM_SLOC = SM_LSUM + 16 * 32 * 256 * 8;
constexpr size_t SM_HK = SM_SLOC + 16 * 32 * 1024 * 8;
constexpr size_t SM_HV = SM_HK + 2048 * 128 * 2;
constexpr size_t SM_KC = SM_HV + 2048 * 128 * 2;
constexpr size_t SM_VC = SM_KC + 16 * 128 * 64 * 2;
constexpr size_t SM_SCAR = SM_VC + 16 * 128 * 64 * 2;
constexpr size_t SM_LCAR = SM_SCAR + 16 * 32 * 1024 * 8;
constexpr size_t SM_SSKV = SM_LCAR + 16 * 32 * 256 * 4;
constexpr size_t SM_END = SM_SSKV + (size_t)T * 2 * 4;
static_assert(SM_END <= WS_W, "small region overflow");

constexpr int LDS_BYTES = 65536;
constexpr int LDS_HALF = LDS_BYTES + 512;
constexpr int LDS_ALLOC = 2 * LDS_HALF + 64;

struct Params {
  const float* in[45];
  float* out;
  unsigned char* ws;
  int lo, hi;
};

DEVI float bf2f(bf16_t v) { return __uint_as_float(((unsigned)v) << 16); }
DEVI bf16_t f2bf(float f) { unsigned u = __float_as_uint(f); return (bf16_t)((u + 0x7fffu + ((u >> 16) & 1u)) >> 16); }
DEVI float wsum(float v) {
#pragma unroll
  for (int o = 32; o >= 1; o >>= 1) v += __shfl_xor(v, o);
  return v;
}
DEVI float sigmoidf_(float x) { return __builtin_amdgcn_rcpf(1.f + __expf(-x)); }
DEVI float gelu_tanh(float x) { const float u2 = 1.5957691216057308f * (x + 0.044715f * x * x * x); return x * __builtin_amdgcn_rcpf(1.f + __expf(-u2)); }
DEVI f32x16 mfma32(bf16x8 a, bf16x8 b, f32x16 c) { return __builtin_amdgcn_mfma_f32_32x32x16_bf16(a, b, c, 0, 0, 0); }
DEVI f32x4 mfma16(bf16x8 a, bf16x8 b, f32x4 c) { return __builtin_amdgcn_mfma_f32_16x16x32_bf16(a, b, c, 0, 0, 0); }
DEVI int vblock() { const int bx = (int)blockIdx.x, GB = (int)gridDim.x; return (GB % 8 == 0) ? (bx % 8) * (GB / 8) * 2 + (bx / 8) * 2 + hb_() : VBID; }
constexpr size_t WS_QCTR = 16384;
#define DYNQ_FETCH(qctr) int _nxt = 0; if (HTID == 0) _nxt = VGRID + (int)__hip_atomic_fetch_add((qctr), 1u, __ATOMIC_RELAXED, __HIP_MEMORY_SCOPE_AGENT);
#define DYNQ_NEXT(it, lds_) { int* _qs = (int*)((lds_) + LDS_BYTES + 448); if (HTID == 0) _qs[_qpar] = _nxt; hsync(); it = __builtin_amdgcn_readfirstlane(_qs[_qpar]); _qpar ^= 1; }
DEVI int crow(int r, int h) { return (r & 3) + 8 * (r >> 2) + 4 * h; }
typedef __bf16 bf16x2_t __attribute__((ext_vector_type(2)));
typedef float f32x2_t __attribute__((ext_vector_type(2)));
DEVI unsigned pk2bf(float lo, float hi) { f32x2_t v = {lo, hi}; bf16x2_t b = __builtin_convertvector(v, bf16x2_t); return __builtin_bit_cast(unsigned, b); }

template <class AF, class BF>
DEVI void gemm128(unsigned char* lds, int K, AF aload, BF bptr, f32x4 (&acc)[4][4]) {
  const int tid = HTID, wid = tid >> 6, lane = tid & 63, wr = wid >> 1, wc = wid & 1, fr = lane & 15, fq = lane >> 4;
#pragma unroll
  for (int m = 0; m < 4; ++m)
#pragma unroll
    for (int n = 0; n < 4; ++n) acc[m][n] = (f32x4){0.f, 0.f, 0.f, 0.f};
  const int lr = tid >> 3, ch = tid & 7;
  const int wofs = lr * 128 + ((ch ^ ((lr >> 1) & 7)) * 16);
  const int sw = (fr >> 1) & 7;
  const int aro = (wr * 64 + fr) * 128, bro = (wc * 64 + fr) * 128;
  const int nk = K >> 6;
  u32x4 ra[4], rb[4];
#pragma unroll
  for (int i = 0; i < 4; ++i) { ra[i] = aload(lr + 32 * i, ch * 8); rb[i] = *(const u32x4*)bptr(lr + 32 * i, ch * 8); }
  hsync();
#pragma unroll
  for (int i = 0; i < 4; ++i) { *(u32x4*)(lds + wofs + i * 4096) = ra[i]; *(u32x4*)(lds + 16384 + wofs + i * 4096) = rb[i]; }
  hsync();
  for (int kt = 0; kt < nk; ++kt) {
    const bool more = (kt + 1 < nk);
    if (more) {
      const int k = (kt + 1) * 64 + ch * 8;
#pragma unroll
      for (int i = 0; i < 4; ++i) { ra[i] = aload(lr + 32 * i, k); rb[i] = *(const u32x4*)bptr(lr + 32 * i, k); }
    }
    const unsigned char* bufA = lds + (kt & 1) * 32768;
    const unsigned char* bufB = bufA + 16384;
#pragma unroll
    for (int kk = 0; kk < 2; ++kk) {
      bf16x8 At[4], Bt[4];
      const int co = ((kk * 4 + fq) ^ sw) * 16;
#pragma unroll
      for (int m = 0; m < 4; ++m) At[m] = *(const bf16x8*)(bufA + aro + m * 2048 + co);
#pragma unroll
      for (int n = 0; n < 4; ++n) Bt[n] = *(const bf16x8*)(bufB + bro + n * 2048 + co);
#pragma unroll
      for (int m = 0; m < 4; ++m)
#pragma unroll
        for (int n = 0; n < 4; ++n) acc[m][n] = mfma16(Bt[n], At[m], acc[m][n]);
    }
    if (more) {
      unsigned char* nb = lds + ((kt + 1) & 1) * 32768;
#pragma unroll
      for (int i = 0; i < 4; ++i) { *(u32x4*)(nb + wofs + i * 4096) = ra[i]; *(u32x4*)(nb + 16384 + wofs + i * 4096) = rb[i]; }
    }
    hsync();
  }
}
template <class AF, class BF>
DEVI void gemm128g(unsigned char* lds, int K, AF aptr, BF bptr, f32x4 (&acc)[4][4]) {
  const int tid = HTID, wid = tid >> 6, lane = tid & 63, wr = wid >> 1, wc = wid & 1, fr = lane & 15, fq = lane >> 4;
#pragma unroll
  for (int m = 0; m < 4; ++m)
#pragma unroll
    for (int n = 0; n < 4; ++n) acc[m][n] = (f32x4){0.f, 0.f, 0.f, 0.f};
  const int lr = tid >> 3;
  const int chs = ((tid & 7) ^ ((lr >> 1) & 7)) * 8;
  const int sw = (fr >> 1) & 7;
  const int aro = (wr * 64 + fr) * 128, bro = (wc * 64 + fr) * 128;
  const int nk = K >> 6;
  LAS unsigned char* l3 = (LAS unsigned char*)lds;
#define G128_STAGE(buf, kbase)                                                                                                   \
  _Pragma("unroll") for (int i = 0; i < 4; ++i) {                                                                                 \
    __builtin_amdgcn_global_load_lds((const __attribute__((address_space(1))) unsigned*)aptr(lr + 32 * i, (kbase) + chs),          \
                                     (LAS unsigned*)(l3 + (buf) * 32768 + tid * 16 + i * 4096), 16, 0, 0);                           \
    __builtin_amdgcn_global_load_lds((const __attribute__((address_space(1))) unsigned*)bptr(lr + 32 * i, (kbase) + chs),          \
                                     (LAS unsigned*)(l3 + (buf) * 32768 + 16384 + tid * 16 + i * 4096), 16, 0, 0);                   \
  }
  hsync();
  G128_STAGE(0, 0)
  asm volatile("s_waitcnt vmcnt(0)" ::: "memory");
  hsync();
  for (int kt = 0; kt < nk; ++kt) {
    if (kt + 1 < nk) { G128_STAGE((kt + 1) & 1, (kt + 1) * 64) }
    const unsigned char* bufA = lds + (kt & 1) * 32768;
    const unsigned char* bufB = bufA + 16384;
#pragma unroll
    for (int kk = 0; kk < 2; ++kk) {
      bf16x8 At[4], Bt[4];
      const int co = ((kk * 4 + fq) ^ sw) * 16;
#pragma unroll
      for (int m = 0; m < 4; ++m) At[m] = *(const bf16x8*)(bufA + aro + m * 2048 + co);
#pragma unroll
      for (int n = 0; n < 4; ++n) Bt[n] = *(const bf16x8*)(bufB + bro + n * 2048 + co);
#pragma unroll
      for (int m = 0; m < 4; ++m)
#pragma unroll
        for (int n = 0; n < 4; ++n) acc[m][n] = mfma16(Bt[n], At[m], acc[m][n]);
    }
    asm volatile("s_waitcnt vmcnt(0)" ::: "memory");
    hsync();
  }
#undef G128_STAGE
}
DEVI void gemm128p(unsigned char* lds, int K, const bf16_t* Ab, size_t lda, const bf16_t* Bb, size_t ldb, f32x4 (&acc)[4][4], int& par, bool staged, bool has_next, const bf16_t* Abn, const bf16_t* Bbn) {
  const int tid = HTID, wid = tid >> 6, lane = tid & 63, wr = wid >> 1, wc = wid & 1, fr = lane & 15, fq = lane >> 4;
#pragma unroll
  for (int m = 0; m < 4; ++m)
#pragma unroll
    for (int n = 0; n < 4; ++n) acc[m][n] = (f32x4){0.f, 0.f, 0.f, 0.f};
  const int lr = tid >> 3;
  const int chs = ((tid & 7) ^ ((lr >> 1) & 7)) * 8;
  const int sw = (fr >> 1) & 7;
  const int aro = (wr * 64 + fr) * 128, bro = (wc * 64 + fr) * 128;
  const int nk = K >> 6;
  LAS unsigned char* l3 = (LAS unsigned char*)lds;
#define GP_STAGE(buf, kbase, APTR, BPTR)                                                                                             \
  _Pragma("unroll") for (int i = 0; i < 4; ++i) {                                                                                 \
    __builtin_amdgcn_global_load_lds((const __attribute__((address_space(1))) unsigned*)((APTR) + (size_t)(lr + 32 * i) * lda + (kbase) + chs),            \
                                     (LAS unsigned*)(l3 + (buf) * 32768 + tid * 16 + i * 4096), 16, 0, 0);                           \
    __builtin_amdgcn_global_load_lds((const __attribute__((address_space(1))) unsigned*)((BPTR) + (size_t)(lr + 32 * i) * ldb + (kbase) + chs),            \
                                     (LAS unsigned*)(l3 + (buf) * 32768 + 16384 + tid * 16 + i * 4096), 16, 0, 0);                   \
  }
  if (!staged) {
    hsync();
    GP_STAGE(par, 0, Ab, Bb)
    asm volatile("s_waitcnt vmcnt(0)" ::: "memory");
    hsync();
  }
  for (int kt = 0; kt < nk; ++kt) {
    const int cur = (par + kt) & 1;
    { const bool inner = kt + 1 < nk; if (inner || has_next) { const bf16_t* ap_ = inner ? Ab : Abn; const bf16_t* bp_ = inner ? Bb : Bbn; const int kb_ = inner ? (kt + 1) * 64 : 0; GP_STAGE(cur ^ 1, kb_, ap_, bp_) } }
    const unsigned char* bufA = lds + cur * 32768;
    const unsigned char* bufB = bufA + 16384;
#pragma unroll
    for (int kk = 0; kk < 2; ++kk) {
      bf16x8 At[4], Bt[4];
      const int co = ((kk * 4 + fq) ^ sw) * 16;
#pragma unroll
      for (int m = 0; m < 4; ++m) At[m] = *(const bf16x8*)(bufA + aro + m * 2048 + co);
#pragma unroll
      for (int n = 0; n < 4; ++n) Bt[n] = *(const bf16x8*)(bufB + bro + n * 2048 + co);
#pragma unroll
      for (int m = 0; m < 4; ++m)
#pragma unroll
        for (int n = 0; n < 4; ++n) acc[m][n] = mfma16(Bt[n], At[m], acc[m][n]);
    }
    asm volatile("s_waitcnt vmcnt(0)" ::: "memory");
    hsync();
  }
  par = (par + nk) & 1;
#undef GP_STAGE
}
template <class AF, class BF>
DEVI void gemm128h(unsigned char* lds, int K, AF aptr, BF bptr, f32x4 (&acc)[2][4]) {
  const int tid = HTID, wid = tid >> 6, lane = tid & 63, fr = lane & 15, fq = lane >> 4;
#pragma unroll
  for (int m = 0; m < 2; ++m)
#pragma unroll
    for (int n = 0; n < 4; ++n) acc[m][n] = (f32x4){0.f, 0.f, 0.f, 0.f};
  const int lr = tid >> 3;
  const int chs = ((tid & 7) ^ ((lr >> 1) & 7)) * 8;
  const int sw = (fr >> 1) & 7;
  const int aro = (wid * 32 + fr) * 128, bro = fr * 128;
  const int nk = K >> 6;
  LAS unsigned char* l3 = (LAS unsigned char*)lds;
#define GH_STAGE(buf, kbase)                                                                                                     \
  { _Pragma("unroll") for (int i = 0; i < 4; ++i)                                                                                 \
      __builtin_amdgcn_global_load_lds((const __attribute__((address_space(1))) unsigned*)aptr(lr + 32 * i, (kbase) + chs),        \
                                       (LAS unsigned*)(l3 + (buf) * 32768 + tid * 16 + i * 4096), 16, 0, 0);                         \
    _Pragma("unroll") for (int i = 0; i < 2; ++i)                                                                                 \
      __builtin_amdgcn_global_load_lds((const __attribute__((address_space(1))) unsigned*)bptr(lr + 32 * i, (kbase) + chs),        \
                                       (LAS unsigned*)(l3 + (buf) * 32768 + 16384 + tid * 16 + i * 4096), 16, 0, 0); }
  hsync();
  GH_STAGE(0, 0)
  asm volatile("s_waitcnt vmcnt(0)" ::: "memory");
  hsync();
  for (int kt = 0; kt < nk; ++kt) {
    if (kt + 1 < nk) { GH_STAGE((kt + 1) & 1, (kt + 1) * 64) }
    const unsigned char* bufA = lds + (kt & 1) * 32768;
    const unsigned char* bufB = bufA + 16384;
#pragma unroll
    for (int kk = 0; kk < 2; ++kk) {
      bf16x8 At[2], Bt[4];
      const int co = ((kk * 4 + fq) ^ sw) * 16;
#pragma unroll
      for (int m = 0; m < 2; ++m) At[m] = *(const bf16x8*)(bufA + aro + m * 2048 + co);
#pragma unroll
      for (int n = 0; n < 4; ++n) Bt[n] = *(const bf16x8*)(bufB + bro + n * 2048 + co);
#pragma unroll
      for (int m = 0; m < 2; ++m)
#pragma unroll
        for (int n = 0; n < 4; ++n) acc[m][n] = mfma16(Bt[n], At[m], acc[m][n]);
    }
    asm volatile("s_waitcnt vmcnt(0)" ::: "memory");
    hsync();
  }
#undef GH_STAGE
}
#define GEMM_EPI_LOOP(body)                                                                 \
  {                                                                                         \
    const int _tid = HTID, _wid = _tid >> 6, _lane = _tid & 63, _wr = _wid >> 1, _wc = _wid & 1, _fr = _lane & 15, _fq = _lane >> 4; \
    _Pragma("unroll") for (int m = 0; m < 4; ++m) _Pragma("unroll") for (int n = 0; n < 4; ++n) _Pragma("unroll") for (int j = 0; j < 4; ++j) { \
      const int er = _wr * 64 + m * 16 + _fr, ec = _wc * 64 + n * 16 + _fq * 4 + j; const float ev = acc[m][n][j]; body }                      \
  }
#define GEMM_EPI4(body)                                                                     \
  {                                                                                         \
    const int _tid = HTID, _wid = _tid >> 6, _lane = _tid & 63, _wr = _wid >> 1, _wc = _wid & 1, _fr = _lane & 15, _fq = _lane >> 4; \
    _Pragma("unroll") for (int m = 0; m < 4; ++m) _Pragma("unroll") for (int n = 0; n < 4; ++n) {                                             \
      const int er = _wr * 64 + m * 16 + _fr, ec0 = _wc * 64 + n * 16 + _fq * 4; const f32x4 ev4 = acc[m][n]; body }                          \
  }
DEVI f32x4 ld_bf16x4(const bf16_t* p) { const uint2 u = *(const uint2*)p; return (f32x4){__uint_as_float(u.x << 16), __uint_as_float(u.x & 0xffff0000u), __uint_as_float(u.y << 16), __uint_as_float(u.y & 0xffff0000u)}; }
DEVI void st_bf16x4(bf16_t* p, f32x4 v) { uint2 o; o.x = pk2bf(v[0], v[1]); o.y = pk2bf(v[2], v[3]); *(uint2*)p = o; }

namespace pg8 {
#define PG8_LAS __attribute__((address_space(3)))
typedef unsigned short bf16_t;
typedef short bf16x8 __attribute__((ext_vector_type(8)));
typedef float f32x4 __attribute__((ext_vector_type(4)));
typedef unsigned u32x4 __attribute__((ext_vector_type(4)));
constexpr int BM = 256, BK = 64, HALF = 128, HTB = HALF * BK * 2  , STAGE_BYTES = 8 * HTB, NXCD = 8, WGM = 8;

__host__ __device__ __forceinline__ int lds_byte(int r, int c) { const int st = (r >> 4) * 2 + (c >> 5), rr = r & 15, cc = c & 31, ob = rr * 64 + cc * 2; return st * 1024 + (ob ^ (((ob >> 9) & 1) << 5)); }
__host__ __device__ __forceinline__ void stage_rc(int b, int& R, int& C) { const int st = b / 1024, sb = b % 1024, swz = sb ^ (((sb >> 9) & 1) << 5); R = (st >> 1) * 16 + swz / 64; C = (st & 1) * 32 + (swz % 64) / 2; }
__host__ __device__ __forceinline__ int perm32(int rho) { const int n = rho >> 4, i = rho & 15; return 8 * (i >> 2) + 4 * n + (i & 3); }

struct Unit { int pm, pn; };
struct Gemm { const bf16_t* A; const bf16_t* Bt; int M, N, K; };

struct StaticOrder {
    int nM, nN, nwg, G, c;
    __host__ __device__ void init(int M, int N, int G_, int c_) { nM = M / BM; nN = N / BM; nwg = nM * nN; G = G_; c = c_; }
    __host__ __device__ bool next(int i, Unit& u) const {
        const long L = (long)i * G + c; if (L >= nwg) return false;
        int wgid = (int)L; { const int q = nwg / NXCD, r = nwg % NXCD, xcd = wgid % NXCD, off = wgid / NXCD; wgid = (xcd < r ? xcd * (q + 1) : r * (q + 1) + (xcd - r) * q) + off; }
        const int nig = WGM * nN, gid = wgid / nig, fm = gid * WGM, gsz = (nM - fm) < WGM ? (nM - fm) : WGM;
        u.pm = fm + ((wgid % nig) % gsz); u.pn = (wgid % nig) / gsz; return true;
    }
    __device__ __forceinline__ void a_ready(const Unit&) const {}
    __device__ __forceinline__ void done(const Unit&) const {}
};

__device__ __forceinline__ unsigned cvt_pk_bf16(float lo, float hi) { unsigned r; asm volatile("v_cvt_pk_bf16_f32 %0, %1, %2" : "=v"(r) : "v"(lo), "v"(hi)); return r; }
typedef float f32x2 __attribute__((ext_vector_type(2)));
__device__ __forceinline__ f32x2 gelu_pk(f32x2 v) {
    const f32x2 av = __builtin_elementwise_abs(v), d = av * 0.2316418882f + 1.0f;
    f32x2 t; t.x = __builtin_amdgcn_rcpf(d.x); t.y = __builtin_amdgcn_rcpf(d.y);
    f32x2 q = t * 0.5307027145f + (-0.7265760135f); q = q * t + 0.7107068705f; q = q * t + (-0.142248368f); q = q * t + 0.127414796f; q = q * t;
    const f32x2 s = (v * v) * (-0.72134752044f);
    f32x2 e; e.x = __builtin_amdgcn_exp2f(s.x); e.y = __builtin_amdgcn_exp2f(s.y);
    const f32x2 m = v * (q * e), r = v - m;
    f32x2 o; o.x = v.x < 0.f ? m.x : r.x; o.y = v.y < 0.f ? m.y : r.y; return o;
}

template <int ACT  > struct EpiBf16 {
    static constexpr bool PERM = true, AFTER_DRAIN = false; static_assert(ACT == 0 || ACT == 1, "EpiBf16: ACT is 0 (none) or 1 (gelu_pk)");
    bf16_t* O; int ldc; const float* bias; int split_cols; size_t split_stride; float scale0;
    __device__ __forceinline__ void operator()(const f32x4 (&acc)[2][2][4][2], const Unit& u, int wr, int wc, int fr, int fq) const {
        const int row0 = u.pm * BM + wr * 64 + fr; int colt = u.pn * BM; bf16_t* base = O;
        float sc = 1.f; if (split_cols) { const int t = colt / split_cols; base += (size_t)t * split_stride; colt -= t * split_cols; if (t == 0) sc = scale0; }
        const int col0 = colt + wc * 32 + 8 * fq, bcol0 = u.pn * BM + wc * 32 + 8 * fq;
        f32x4 bv[2][2];
#pragma unroll
        for (int bj = 0; bj < 2; ++bj)
#pragma unroll
            for (int n = 0; n < 2; ++n) bv[bj][n] = bias ? *(const f32x4*)(bias + bcol0 + bj * HALF + 4 * n) : (f32x4){0.f, 0.f, 0.f, 0.f};
#pragma unroll
        for (int ai = 0; ai < 2; ++ai)
#pragma unroll
            for (int m = 0; m < 4; ++m) { bf16_t* rowp = base + (size_t)(row0 + ai * HALF + m * 16) * ldc + col0;
#pragma unroll
                for (int bj = 0; bj < 2; ++bj) { f32x4 v0 = acc[ai][bj][m][0] + bv[bj][0], v1 = acc[ai][bj][m][1] + bv[bj][1];
                    if (ACT == 1) { f32x2 a = gelu_pk((f32x2){v0[0], v0[1]}), b = gelu_pk((f32x2){v0[2], v0[3]}), c = gelu_pk((f32x2){v1[0], v1[1]}), d = gelu_pk((f32x2){v1[2], v1[3]});
                        v0 = (f32x4){a.x, a.y, b.x, b.y}; v1 = (f32x4){c.x, c.y, d.x, d.y}; }
                    v0 = v0 * sc; v1 = v1 * sc; u32x4 w; w.x = cvt_pk_bf16(v0[0], v0[1]); w.y = cvt_pk_bf16(v0[2], v0[3]); w.z = cvt_pk_bf16(v1[0], v1[1]); w.w = cvt_pk_bf16(v1[2], v1[3]);
                    *(u32x4*)(rowp + bj * HALF) = w; } }
    }
};

template <class Epi, class Sched, bool ALIGN_EPI = false, bool SP2 = false>
__device__ __forceinline__ void gemm_phase(PG8_LAS unsigned char* lds, const Gemm g, const Sched& S, const Epi& E) {
    const int tid = threadIdx.x, wid = __builtin_amdgcn_readfirstlane(tid >> 6), lane = tid & 63, wr = wid >> 2, wc = wid & 3, fr = lane & 15, fq = lane >> 4;
    const int K = g.K, nt = K / BK;
    unsigned voffA[2], voffB[2];
#pragma unroll
    for (int i = 0; i < 2; ++i) { int R, C; stage_rc(tid * 16 + i * 8192, R, C); const int Rb = Epi::PERM ? ((R & ~31) + perm32(R & 31)) : R;
        voffA[i] = (unsigned)(R * K + C) * 2u; voffB[i] = (unsigned)(Rb * K + C) * 2u; }
    const size_t kstep = (size_t)(BK * 2);
    const size_t hstep = (size_t)HALF * K * 2;
    const size_t tstep = 2 * hstep;
    const unsigned ldsw = (unsigned)wid * 1024u;
    const int aoff = lds_byte(wr * 64 + fr, fq * 8), boff = lds_byte(wc * 32 + fr, fq * 8);
#define PG8_SA(b, h) (((b) * 2 + (h)) * HTB)
#define PG8_SB(b, h) ((4 + (b) * 2 + (h)) * HTB)
#define PG8_STAGE(bufoff, gbase, voff) do { _Pragma("unroll") for (int _i = 0; _i < 2; ++_i) \
        __builtin_amdgcn_global_load_lds((const unsigned*)((const char*)(gbase) + (voff)[_i]), (PG8_LAS unsigned*)(lds + (bufoff) + ldsw + _i * 8192), 16, 0, 0); } while (0)
#define PG8_LDA(dst, b, h) do { _Pragma("unroll") for (int m = 0; m < 4; ++m) _Pragma("unroll") for (int k = 0; k < 2; ++k) dst[m][k] = *(const PG8_LAS bf16x8*)(lds + PG8_SA(b, h) + aoff + m * 2048 + k * 1024); } while (0)
#define PG8_LDB(dst, b, h) do { _Pragma("unroll") for (int n = 0; n < 2; ++n) _Pragma("unroll") for (int k = 0; k < 2; ++k) dst[n][k] = *(const PG8_LAS bf16x8*)(lds + PG8_SB(b, h) + boff + n * 2048 + k * 1024); } while (0)
#define PG8_MMA(ai, bj, At, Bt) do { __builtin_amdgcn_s_setprio(1); _Pragma("unroll") for (int m = 0; m < 4; ++m) _Pragma("unroll") for (int n = 0; n < 2; ++n) _Pragma("unroll") for (int k = 0; k < 2; ++k) \
        acc[ai][bj][m][n] = __builtin_amdgcn_mfma_f32_16x16x32_bf16(Bt[n][k], At[m][k], acc[ai][bj][m][n], 0, 0, 0); __builtin_amdgcn_s_setprio(0); } while (0)
#define PG8_WAIT_V(n) asm volatile("s_waitcnt vmcnt(" #n ")" ::: "memory")
#define PG8_WAIT_L(n) asm volatile("s_waitcnt lgkmcnt(" #n ")" ::: "memory")
#define PG8_BAR __builtin_amdgcn_s_barrier()
#define PG8_SCHED __builtin_amdgcn_sched_barrier(0)
    Unit cur, nxt; int ui = 0;
    if (!S.next(0, cur)) return;
    f32x4 acc[2][2][4][2];
#pragma unroll
    for (int a = 0; a < 2; ++a)
#pragma unroll
        for (int b = 0; b < 2; ++b)
#pragma unroll
            for (int m = 0; m < 4; ++m)
#pragma unroll
                for (int n = 0; n < 2; ++n) acc[a][b][m][n] = (f32x4){0.f, 0.f, 0.f, 0.f};
    bf16x8 At[4][2], B0[2][2], B1[2][2];
    const char* cA = (const char*)g.A + (size_t)cur.pm * tstep; const char* cB = (const char*)g.Bt + (size_t)cur.pn * tstep;
    S.a_ready(cur);
    if constexpr (SP2) {
        PG8_STAGE(PG8_SB(0, 0), cB, voffB); PG8_STAGE(PG8_SB(0, 1), cB + hstep, voffB); PG8_STAGE(PG8_SA(0, 0), cA, voffA); PG8_STAGE(PG8_SA(0, 1), cA + hstep, voffA);
        if (wr == 1) PG8_BAR;
        PG8_WAIT_V(2); PG8_BAR;
        PG8_STAGE(PG8_SB(1, 0), cB + kstep, voffB); PG8_STAGE(PG8_SA(1, 0), cA + kstep, voffA); PG8_STAGE(PG8_SB(1, 1), cB + hstep + kstep, voffB);
        PG8_WAIT_V(6); PG8_BAR;
    } else {
        PG8_STAGE(PG8_SB(0, 0), cB, voffB); PG8_STAGE(PG8_SA(0, 0), cA, voffA); PG8_STAGE(PG8_SB(0, 1), cB + hstep, voffB); PG8_STAGE(PG8_SA(0, 1), cA + hstep, voffA);
        if (wr == 1) PG8_BAR;
        PG8_WAIT_V(4); PG8_BAR;
        PG8_STAGE(PG8_SB(1, 0), cB + kstep, voffB); PG8_STAGE(PG8_SA(1, 0), cA + kstep, voffA); PG8_STAGE(PG8_SB(1, 1), cB + hstep + kstep, voffB);
        PG8_WAIT_V(6); PG8_BAR;
    }
    for (;;) {
        const bool has_next = S.next(ui + 1, nxt);
        const char* nA = has_next ? (const char*)g.A + (size_t)nxt.pm * tstep : cA; const char* nB = has_next ? (const char*)g.Bt + (size_t)nxt.pn * tstep : cB;
        for (int t = 0; t < nt; t += 2) {
            const bool last = (t == nt - 2);
            const char* a1 = cA + (size_t)(t + 1) * kstep;
            const char* a2 = last ? nA : cA + (size_t)(t + 2) * kstep; const char* b2 = last ? nB : cB + (size_t)(t + 2) * kstep;
            const char* a3 = a2 + kstep; const char* b3 = b2 + kstep;
            if (last && has_next) S.a_ready(nxt);
            if constexpr (SP2) {
            PG8_LDB(B0, 0, 0); PG8_LDB(B1, 0, 1); PG8_SCHED; PG8_LDA(At, 0, 0); PG8_STAGE(PG8_SA(1, 1), a1 + hstep, voffA);
            PG8_WAIT_V(8); PG8_WAIT_L(0); PG8_BAR; PG8_MMA(0, 0, At, B0); PG8_MMA(0, 1, At, B1); PG8_BAR; PG8_SCHED;
            PG8_LDA(At, 0, 1); PG8_STAGE(PG8_SB(0, 0), b2, voffB); PG8_STAGE(PG8_SB(0, 1), b2 + hstep, voffB); PG8_STAGE(PG8_SA(0, 0), a2, voffA);
            PG8_WAIT_V(8); PG8_WAIT_L(0); PG8_BAR; PG8_MMA(1, 0, At, B0); PG8_MMA(1, 1, At, B1); PG8_BAR; PG8_SCHED;
            PG8_LDB(B0, 1, 0); PG8_LDB(B1, 1, 1); PG8_SCHED; PG8_LDA(At, 1, 0); PG8_STAGE(PG8_SA(0, 1), a2 + hstep, voffA);
            PG8_WAIT_V(8); PG8_WAIT_L(0); PG8_BAR; PG8_MMA(0, 0, At, B0); PG8_MMA(0, 1, At, B1); PG8_BAR; PG8_SCHED;
            PG8_LDA(At, 1, 1); PG8_STAGE(PG8_SB(1, 0), b3, voffB); PG8_STAGE(PG8_SB(1, 1), b3 + hstep, voffB); PG8_STAGE(PG8_SA(1, 0), a3, voffA);
            PG8_WAIT_V(8); PG8_WAIT_L(0); PG8_BAR; PG8_MMA(1, 0, At, B0); PG8_MMA(1, 1, At, B1); PG8_BAR; PG8_SCHED;
            } else {
            PG8_LDB(B0, 0, 0); PG8_SCHED; PG8_LDA(At, 0, 0); PG8_STAGE(PG8_SA(1, 1), a1 + hstep, voffA);
            PG8_WAIT_L(8); PG8_BAR; PG8_WAIT_L(0); PG8_MMA(0, 0, At, B0); PG8_BAR; PG8_SCHED;
            PG8_LDB(B1, 0, 1); PG8_STAGE(PG8_SB(0, 0), b2, voffB);
            PG8_BAR; PG8_WAIT_L(0); PG8_MMA(0, 1, At, B1); PG8_BAR;
            PG8_LDA(At, 0, 1); PG8_STAGE(PG8_SA(0, 0), a2, voffA);
            PG8_BAR; PG8_WAIT_L(0); PG8_MMA(1, 0, At, B0); PG8_BAR; PG8_SCHED;
            PG8_STAGE(PG8_SB(0, 1), b2 + hstep, voffB);
            PG8_WAIT_V(6); PG8_BAR; PG8_MMA(1, 1, At, B1); PG8_BAR;
            PG8_LDB(B0, 1, 0); PG8_SCHED; PG8_LDA(At, 1, 0); PG8_STAGE(PG8_SA(0, 1), a2 + hstep, voffA);
            PG8_WAIT_L(8); PG8_BAR; PG8_WAIT_L(0); PG8_MMA(0, 0, At, B0); PG8_BAR; PG8_SCHED;
            PG8_LDB(B1, 1, 1); PG8_STAGE(PG8_SB(1, 0), b3, voffB);
            PG8_BAR; PG8_WAIT_L(0); PG8_MMA(0, 1, At, B1); PG8_BAR;
            PG8_LDA(At, 1, 1); PG8_STAGE(PG8_SA(1, 0), a3, voffA);
            PG8_BAR; PG8_WAIT_L(0); PG8_MMA(1, 0, At, B0); PG8_BAR; PG8_SCHED;
            PG8_STAGE(PG8_SB(1, 1), b3 + hstep, voffB);
            PG8_WAIT_V(6); PG8_BAR; PG8_MMA(1, 1, At, B1); PG8_BAR;
            }
        }
        if constexpr (ALIGN_EPI) { if (wr == 0) PG8_BAR; }
        if constexpr (!Epi::AFTER_DRAIN) { E(acc, cur, wr, wc, fr, fq); S.done(cur); }
        if (!has_next) break;
#pragma unroll
        for (int a = 0; a < 2; ++a)
#pragma unroll
            for (int b = 0; b < 2; ++b)
#pragma unroll
                for (int m = 0; m < 4; ++m)
#pragma unroll
                    for (int n = 0; n < 2; ++n) acc[a][b][m][n] = (f32x4){0.f, 0.f, 0.f, 0.f};
        cur = nxt; cA = nA; cB = nB; ++ui;
        if constexpr (ALIGN_EPI) { if (wr == 1) PG8_BAR; }
    }
    PG8_WAIT_V(0);
    if constexpr (!ALIGN_EPI) { if (wr == 0) PG8_BAR; }
    PG8_BAR;
    if constexpr (Epi::AFTER_DRAIN) { E.fused(acc, cur, wr, wc, fr, fq, lds, wid, lane); S.done(cur); }
#undef PG8_SA
#undef PG8_SB
#undef PG8_STAGE
#undef PG8_LDA
#undef PG8_LDB
#undef PG8_MMA
#undef PG8_WAIT_V
#undef PG8_WAIT_L
#undef PG8_BAR
#undef PG8_SCHED
}
}

struct EpiG1 {
  static constexpr bool PERM = false, AFTER_DRAIN = false;
  bf16_t* PROJ; bf16_t* QN; bf16_t* KS; bf16_t* KW; float* SSKV; const float2* RN; const float* g_q; const float* g_k; const float* part;
  __device__ __forceinline__ void operator()(const pg8::f32x4 (&acc0)[2][2][4][2], const pg8::Unit& u, int wr, int wc, int fr, int fq) const {
    const bool t1 = (u.pn == 1), t5 = (u.pn == 5);
    float rs8[2][4];
    {
      float4 pq[2][4];
#pragma unroll
      for (int ai = 0; ai < 2; ++ai)
#pragma unroll
        for (int m = 0; m < 4; ++m) pq[ai][m] = ((const float4*)(part + ((size_t)u.pm * 256 + ai * 128 + wr * 64 + m * 16 + fr) * 16))[fq];
#pragma unroll
      for (int ai = 0; ai < 2; ++ai)
#pragma unroll
        for (int m = 0; m < 4; ++m) { float q = (pq[ai][m].x + pq[ai][m].y) + (pq[ai][m].z + pq[ai][m].w); q += __shfl_xor(q, 16); q += __shfl_xor(q, 32); rs8[ai][m] = rsqrtf(q * (1.f / D) + EPS); }
    }
#pragma unroll
    for (int ai = 0; ai < 2; ++ai)
#pragma unroll
      for (int m = 0; m < 4; ++m) {
        const size_t t = (size_t)u.pm * 256 + ai * 128 + wr * 64 + m * 16 + fr;
        const float rsr = rs8[ai][m];
        pg8::f32x4 acc[1][2][1][2];
#pragma unroll
        for (int bj = 0; bj < 2; ++bj)
#pragma unroll
          for (int n = 0; n < 2; ++n) acc[0][bj][0][n] = acc0[ai][bj][m][n] * rsr;
        if (!(t1 || t5) || (t1 && wc < 2)) {
#pragma unroll
          for (int bj = 0; bj < 2; ++bj)
#pragma unroll
            for (int n = 0; n < 2; ++n) st_bf16x4(PROJ + t * DINP + u.pn * 256 + bj * 128 + wc * 32 + n * 16 + fq * 4, acc[0][bj][0][n]);
        }
        if (t1 || t5) {
          float ss = 0.f;
#pragma unroll
          for (int bj = 0; bj < 2; ++bj)
#pragma unroll
            for (int n = 0; n < 2; ++n) { const pg8::f32x4 v = acc[0][bj][0][n]; ss += v[0] * v[0] + v[1] * v[1] + v[2] * v[2] + v[3] * v[3]; }
          ss += __shfl_xor(ss, 16); ss += __shfl_xor(ss, 32);
          if (t1 && wc < 2) { if (fq == 0) SSKV[t * 2 + wc] = ss; }
          else {
            const float rs = rsqrtf(ss * (1.f / 64) + EPS);
            const float* gg = t5 ? g_q : (g_k + (wc == 2 ? 64 : 128));
            const float sc = t5 ? (0.125f * LOG2E) : 1.f;
            bf16_t* dst = t5 ? (QN + t * 256 + wc * 64) : ((wc == 2 ? KS : KW) + t * 64);
#pragma unroll
            for (int bj = 0; bj < 2; ++bj)
#pragma unroll
              for (int n = 0; n < 2; ++n) {
                const int e0 = 32 * bj + 16 * n + 4 * fq;
                const float4 g4 = *(const float4*)(gg + e0);
                pg8::f32x4 v = acc[0][bj][0][n];
                v[0] *= rs * g4.x; v[1] *= rs * g4.y; v[2] *= rs * g4.z; v[3] *= rs * g4.w;
                if (bj == 0 && n == 0) {
#pragma unroll
                  for (int j = 0; j < 4; ++j) {
                    const float x = v[j], partner = __shfl_xor(x, 32);
                    const int d = fq * 4 + j; const float2 cs2 = RN[t * 8 + (d & 7)];
                    v[j] = (d < 8) ? (x * cs2.x - partner * cs2.y) : (partner * cs2.y + x * cs2.x);
                  }
                }
                st_bf16x4(dst + e0, v * sc);
              }
          }
        }
      }
  }
};

template <bool IN16> struct EpiRes {
  static constexpr bool PERM = false, AFTER_DRAIN = false;
  const float* xin; const bf16_t* xin16; bf16_t* out;
  __device__ __forceinline__ void operator()(const pg8::f32x4 (&acc)[2][2][4][2], const pg8::Unit& u, int wr, int wc, int fr, int fq) const {
#pragma unroll
    for (int ai = 0; ai < 2; ++ai) {
      f32x4 xi[4][2][2];
#pragma unroll
      for (int m = 0; m < 4; ++m)
#pragma unroll
        for (int bj = 0; bj < 2; ++bj)
#pragma unroll
          for (int n = 0; n < 2; ++n) {
            const size_t o = ((size_t)u.pm * 256 + ai * 128 + wr * 64 + m * 16 + fr) * 1024 + u.pn * 256 + bj * 128 + wc * 32 + n * 16 + fq * 4;
            if constexpr (IN16) xi[m][bj][n] = ld_bf16x4(xin16 + o); else xi[m][bj][n] = *(const f32x4*)(xin + o);
          }
#pragma unroll
      for (int m = 0; m < 4; ++m)
#pragma unroll
        for (int bj = 0; bj < 2; ++bj)
#pragma unroll
          for (int n = 0; n < 2; ++n) {
            const size_t o = ((size_t)u.pm * 256 + ai * 128 + wr * 64 + m * 16 + fr) * 1024 + u.pn * 256 + bj * 128 + wc * 32 + n * 16 + fq * 4;
            st_bf16x4(out + o, xi[m][bj][n] + acc[ai][bj][m][n]);
          }
    }
  }
};

template <class RM>
DEVI void transpose_tiles(const float* src, int K, int N, bf16_t* dst, int ldk, RM rowmap, unsigned char* lds, int& cursor, const float* kscale = nullptr) {
  float* tl = (float*)lds;
  const int tk = K / 64, tn = (N + 63) / 64, nt = tk * tn;
  const int tid = HTID;
  const int G_ = VGRID;
  for (int it = (VBID - cursor % G_ + G_) % G_; it < nt; it += G_) {
    const int kt = it / tn, ntile = it % tn, k0 = kt * 64, n0 = ntile * 64;
    hsync();
#pragma unroll
    for (int q = 0; q < 4; ++q) {
      const int r = (tid >> 4) + 16 * q, c4 = (tid & 15) * 4;
      const float* sp = src + (size_t)(k0 + r) * N + n0 + c4;
      float4 v;
      if (n0 + c4 + 3 < N) v = *(const float4*)sp;
      else { v.x = (n0 + c4 < N) ? sp[0] : 0.f; v.y = (n0 + c4 + 1 < N) ? sp[1] : 0.f; v.z = (n0 + c4 + 2 < N) ? sp[2] : 0.f; v.w = 0.f; }
      if (kscale) { const float ks = kscale[k0 + r]; v.x *= ks; v.y *= ks; v.z *= ks; v.w *= ks; }
      tl[r * 65 + c4] = v.x; tl[r * 65 + c4 + 1] = v.y; tl[r * 65 + c4 + 2] = v.z; tl[r * 65 + c4 + 3] = v.w;
    }
    hsync();
    const int n = tid >> 2, kc = (tid & 3) * 16;
    if (n0 + n < N) {
      unsigned w[8];
#pragma unroll
      for (int i = 0; i < 8; ++i) w[i] = pk2bf(tl[(kc + 2 * i) * 65 + n], tl[(kc + 2 * i + 1) * 65 + n]);
      uint4* o = (uint4*)(dst + (size_t)rowmap(n0 + n) * ldk + k0 + kc);
      o[0] = make_uint4(w[0], w[1], w[2], w[3]); o[1] = make_uint4(w[4], w[5], w[6], w[7]);
    }
  }
  cursor += nt;
}
DEVI void convert_rows(const float* x, bf16_t* xb, float* part) {
  const int lane = HTID & 63, gw = VBID * 4 + (HTID >> 6), NGW = VGRID * 4;
  for (int t0 = gw * 4; t0 < T; t0 += NGW * 4) {
    float4 v[4][4];
#pragma unroll
    for (int q = 0; q < 4; ++q)
#pragma unroll
      for (int j = 0; j < 4; ++j) v[q][j] = ((const float4*)(x + (size_t)(t0 + q) * D))[lane + 64 * j];
#pragma unroll
    for (int q = 0; q < 4; ++q) {
      float s = 0.f;
#pragma unroll
      for (int j = 0; j < 4; ++j) s += v[q][j].x * v[q][j].x + v[q][j].y * v[q][j].y + v[q][j].z * v[q][j].z + v[q][j].w * v[q][j].w;
      s = wsum(s);
      if (lane < 16) part[(size_t)(t0 + q) * 16 + lane] = (lane == 0) ? s : 0.f;
#pragma unroll
      for (int j = 0; j < 4; ++j) {
        uint2 o; o.x = pk2bf(v[q][j].x, v[q][j].y); o.y = pk2bf(v[q][j].z, v[q][j].w);
        ((uint2*)(xb + (size_t)(t0 + q) * D))[lane + 64 * j] = o;
      }
    }
  }
}
DEVI void phase_prep(const Params& p, unsigned char* lds) {
  const size_t gtid = (size_t)VBID * NTHREADS + HTID, gn = (size_t)VGRID * NTHREADS;
  unsigned char* ws = p.ws;
  if (gtid < 64) ((int*)(ws + SM_CNT))[gtid] = 0;
  auto ident = [](int n) { return n; };
  int cursor = 0;
  for (int l = 0; l < NL; ++l) {
    unsigned char* wl = ws + WS_W + l * WS_WL;
    transpose_tiles(p.in[3] + (size_t)l * D * DIN, D, DIN, (bf16_t*)(wl + W_IN), D, [](int n) { return colmap(n); }, lds, cursor, p.in[2] + l * D);
    for (size_t i = gtid; i < (size_t)20 * D; i += gn) ((bf16_t*)(wl + W_IN))[(size_t)236 * D + i] = 0;
    transpose_tiles(p.in[36] + (size_t)l * D * D, D, D, (bf16_t*)(wl + W_OUT), D, ident, lds, cursor);
    transpose_tiles(p.in[6] + (size_t)l * 192 * 384, 192, 384, (bf16_t*)(wl + W_UQ), 192, ident, lds, cursor, p.in[4] + l * 192);
    transpose_tiles(p.in[7] + (size_t)l * 128 * 512, 128, 512, (bf16_t*)(wl + W_UKV), 128, ident, lds, cursor, p.in[5] + l * 128);
    transpose_tiles(p.in[25] + (size_t)l * 256 * 256, 256, 256, (bf16_t*)(wl + W_GLU), 256, ident, lds, cursor);
    transpose_tiles(p.in[30] + (size_t)l * 2048 * 128, 2048, 128, (bf16_t*)(wl + W_1K), 2048, ident, lds, cursor);
    transpose_tiles(p.in[33] + (size_t)l * 2048 * 128, 2048, 128, (bf16_t*)(wl + W_1V), 2048, ident, lds, cursor);
    transpose_tiles(p.in[31] + (size_t)l * 128 * 64, 128, 64, (bf16_t*)(wl + W_2K), 128, ident, lds, cursor);
    transpose_tiles(p.in[34] + (size_t)l * 128 * 64, 128, 64, (bf16_t*)(wl + W_2V), 128, ident, lds, cursor);
    for (int h = 0; h < 4; ++h) {
      transpose_tiles(p.in[12] + ((size_t)l * 4 + h) * 64 * 64, 64, 64, (bf16_t*)(wl + W_LRU) + h * 128 * 64, 64, ident, lds, cursor);
      transpose_tiles(p.in[14] + ((size_t)l * 4 + h) * 64 * 64, 64, 64, (bf16_t*)(wl + W_LRU) + h * 128 * 64 + 64 * 64, 64, ident, lds, cursor);
    }
    for (int e = 0; e < 16; ++e) {
      bf16_t* dg = (bf16_t*)(wl + W_GU) + (size_t)e * 512 * 1024;
      transpose_tiles(p.in[42] + ((size_t)l * 16 + e) * 1024 * 256, 1024, 256, dg, 1024, [](int hh) { return (hh >> 6) * 128 + ((hh >> 5) & 1) * 64 + ((hh >> 4) & 1) * 16 + (hh & 15); }, lds, cursor, p.in[37] + l * D);
      transpose_tiles(p.in[43] + ((size_t)l * 16 + e) * 1024 * 256, 1024, 256, dg, 1024, [](int hh) { return (hh >> 6) * 128 + ((hh >> 5) & 1) * 64 + (((hh >> 4) & 1) + 2) * 16 + (hh & 15); }, lds, cursor, p.in[37] + l * D);
      transpose_tiles(p.in[44] + ((size_t)l * 16 + e) * 256 * 1024, 256, 1024, (bf16_t*)(wl + W_DN) + (size_t)e * 1024 * 256, 256, ident, lds, cursor);
    }
    {
      const int lane = HTID & 63, gw = VBID * 4 + (HTID >> 6), NGW = VGRID * 4;
      for (int o = gw; o < 256; o += NGW) {
        const int kv = o >> 7, j = o & 127;
        const float* pe = (kv ? p.in[32] : p.in[29]) + (size_t)l * 2048;
        const float* w1 = (kv ? p.in[33] : p.in[30]) + (size_t)l * 2048 * 128;
        float a = 0.f;
#pragma unroll 8
        for (int k = lane; k < 2048; k += 64) a += pe[k] * w1[(size_t)k * 128 + j];
        a = wsum(a);
        if (lane == 0) ((float*)(wl + (kv ? W_B1V : W_B1K)))[j] = a;
      }
    }
    for (size_t i = gtid; i < 16 * 64; i += gn) {
      const int g = (int)(i >> 6), sidx = (int)(i & 63);
      const float are = p.in[17][(size_t)l * 1024 + i], aim = p.in[18][(size_t)l * 1024 + i];
      const float dt = expf(p.in[19][l * 16 + g]);
      const float mag = expf(dt * are);
      float sn, cs; sincosf(dt * aim, &sn, &cs);
      const float abr = mag * cs, abi = mag * sn;
      const float den = are * are + aim * aim, nre = abr - 1.f;
      const float gre = (nre * are + abi * aim) / den, gim = (abi * are - nre * aim) / den;
      ((float2*)(wl + W_S5A))[i] = make_float2(abr, abi);
      float pr = abr, pi = abi;
#pragma unroll
      for (int q = 0; q < 6; ++q) { const float nr = pr * pr - pi * pi, ni = 2.f * pr * pi; pr = nr; pi = ni; }
      ((float2*)(wl + W_S5A64))[i] = make_float2(pr, pi);
      bf16_t* bb = (bf16_t*)(wl + W_S5BB);
      for (int ch = 0; ch < 16; ++ch) {
        const float br = p.in[20][((size_t)l * 1024 + i) * 16 + ch], bi = p.in[21][((size_t)l * 1024 + i) * 16 + ch];
        const float vr = gre * br - gim * bi, vi = gre * bi + gim * br;
        const int sb = sidx >> 5, r = sidx & 31;
        bb[((g * 4 + sb * 2 + 0) * 32 + r) * 16 + ch] = f2bf(vr);
        bb[((g * 4 + sb * 2 + 1) * 32 + r) * 16 + ch] = f2bf(vi);
      }
    }
    for (size_t i = gtid; i < 32 * 1024; i += gn) {
      const int n = (int)(i >> 10), k = (int)(i & 1023);
      float w = 0.f;
      if (n < 20) w = p.in[37][l * D + k] * ((n < 4) ? p.in[38][((size_t)l * D + k) * 4 + n] : p.in[40][((size_t)l * D + k) * 16 + (n - 4)]);
      const bf16_t hi = f2bf(w);
      ((bf16_t*)(wl + W_RTH))[i] = hi; ((bf16_t*)(wl + W_RTL))[i] = f2bf(w - bf2f(hi));
    }
    for (size_t i = gtid; i < 16 * 16 * 64; i += gn) {
      const int g = (int)(i >> 10), ch = (int)((i >> 6) & 15), pp = (int)(i & 63);
      const float cr = p.in[22][(size_t)l * 16384 + i], ci = p.in[23][(size_t)l * 16384 + i];
      bf16_t* cm = (bf16_t*)(wl + W_S5CM) + ((size_t)(g * 16 + ch) * 128 + 2 * pp);
      cm[0] = f2bf(cr); cm[1] = f2bf(-ci);
    }
  }
  {
    const int* positions = (const int*)p.in[1];
    float2* RM = (float2*)(ws + WS_ROPE);
    float2* RN = RM + (size_t)T * 16;
    for (size_t i = gtid; i < (size_t)T * 24; i += gn) {
      const int t = (int)(i / 24), j = (int)(i % 24);
      const int rot = (j < 16) ? 32 : 16, fi = (j < 16) ? j : (j - 16);
      const float inv = powf(500000.f, -(2.f * (float)fi) / (float)rot);
      float sn, cs; sincosf((float)positions[t] * inv, &sn, &cs);
      if (j < 16) RM[(size_t)t * 16 + fi] = make_float2(cs, sn); else RN[(size_t)t * 8 + fi] = make_float2(cs, sn);
    }
  }
  convert_rows(p.in[0], (bf16_t*)(ws + WS_A), (float*)(ws + WS_PART));
}

DEVI void phase_g1(const Params& p, int l, unsigned char* lds_full) {
  const bf16_t* XN = (l == 0) ? (const bf16_t*)(p.ws + WS_A) : (const bf16_t*)p.out;
  const bf16_t* W = (const bf16_t*)(p.ws + WS_W + l * WS_WL + W_IN);
  bf16_t* QN = (bf16_t*)(p.ws + WS_G);
  pg8::Gemm g{XN, W, T, DINP, D}; pg8::StaticOrder S; S.init(T, DINP, (int)gridDim.x, (int)blockIdx.x);
  EpiG1 E{(bf16_t*)(p.ws + WS_B), QN, QN + (size_t)T * 256, QN + (size_t)T * 320, (float*)(p.ws + SM_SSKV), (const float2*)(p.ws + WS_ROPE) + (size_t)T * 16, p.in[27] + l * 64, p.in[28] + l * 192, (const float*)(p.ws + WS_PART)};
  pg8::gemm_phase<EpiG1, pg8::StaticOrder, true, true>((LAS unsigned char*)lds_full, g, S, E);
}

DEVI void phase_g2(const Params& p, int l, unsigned char* lds) {
  unsigned char* wl = p.ws + WS_W + l * WS_WL;
  const bf16_t* PROJ = (const bf16_t*)(p.ws + WS_B);
  bf16_t* QR = (bf16_t*)(p.ws + WS_D);
  bf16_t* KVR = QR + (size_t)T * 384;
  bf16_t* GATES = (bf16_t*)(p.ws + WS_E);
  bf16_t* MK = (bf16_t*)(p.ws + WS_F) + (size_t)T * 4 * 96;
  const float2* RM = (const float2*)(p.ws + WS_ROPE);
  constexpr int N_CMP = 64, N_QR = 256 * 3, N_KVR = 256 * 4, N_GT = 256 * 4;
  const int tid = HTID, wid = tid >> 6, lane = tid & 63, wr = wid >> 1, wc = wid & 1, fr = lane & 15, fq = lane >> 4;
  unsigned* qctr = (unsigned*)(p.ws + WS_CTL + WS_QCTR) + l * 16 + 0;
  int _qpar = 0;
  for (int it = vblock(); it < N_CMP + N_QR + N_KVR + N_GT; ) {
    DYNQ_FETCH(qctr)
    f32x4 acc[4][4];
    if (it < N_CMP) {
      const int kv = it & 1, half = (it >> 1) & 1, mt = it >> 2;
      const bf16_t* W = (const bf16_t*)(wl + (kv ? W_1V : W_1K)) + (size_t)half * 64 * 2048;
      const float* bias = (const float*)(wl + (kv ? W_B1V : W_B1K)) + half * 64;
      bf16_t* H = (bf16_t*)(p.ws + (kv ? SM_HV : SM_HK)) + half * 64;
      f32x4 acc2[2][4];
      gemm128h(lds, 2048,
              [&](int r, int k) { const int m = mt * 128 + r, b = m >> 7; int c = m & 127; if (c > 126) c = 126;
                                  return PROJ + (size_t)(b * S + 16 * c + (k >> 6)) * DINP + C_KC + kv * 64 + (k & 63); },
              [&](int r, int k) { return W + (size_t)r * 2048 + k; }, acc2);
#pragma unroll
      for (int m = 0; m < 2; ++m)
#pragma unroll
        for (int n = 0; n < 4; ++n) {
          const float4 b4 = *(const float4*)(bias + n * 16 + fq * 4);
          f32x4 o; o[0] = gelu_tanh(acc2[m][n][0] + b4.x); o[1] = gelu_tanh(acc2[m][n][1] + b4.y); o[2] = gelu_tanh(acc2[m][n][2] + b4.z); o[3] = gelu_tanh(acc2[m][n][3] + b4.w);
          st_bf16x4(H + (size_t)(mt * 128 + wid * 32 + m * 16 + fr) * 128 + n * 16 + fq * 4, o);
        }
    } else if (it < N_CMP + N_QR) {
      const int i2 = it - N_CMP, mt = i2 / 3, nt = i2 % 3;
      const bf16_t* W = (const bf16_t*)(wl + W_UQ);
      gemm128g(lds, 192, [&](int r, int k) { return PROJ + (size_t)(mt * 128 + r) * DINP + C_CQ + k; }, [&](int r, int k) { return W + (size_t)(nt * 128 + r) * 192 + k; }, acc);
      GEMM_EPI4({ st_bf16x4(QR + (size_t)(mt * 128 + er) * 384 + nt * 128 + ec0, ev4); })
    } else if (it < N_CMP + N_QR + N_KVR) {
      const int i2 = it - N_CMP - N_QR, mt = i2 >> 2, hd = i2 & 3;
      const bf16_t* W = (const bf16_t*)(wl + W_UKV);
      gemm128g(lds, 128, [&](int r, int k) { return PROJ + (size_t)(mt * 128 + r) * DINP + wgcol(C_T1, k >> 6, k & 63); }, [&](int r, int k) { return W + (size_t)(hd * 128 + r) * 128 + k; }, acc);
      const float* g_k = p.in[9] + l * 96;
#pragma unroll
      for (int m = 0; m < 4; ++m) {
        const size_t t = (size_t)mt * 128 + wr * 64 + m * 16 + fr;
        const int b = (int)(t >> 11), sq = (int)(t & (S - 1));
        const float2 ssp = *(const float2*)((const float*)(p.ws + SM_SSKV) + t * 2);
        const float ss = ssp.x + ssp.y;
        const float rskv = rsqrtf(ss * (1.f / 128) + EPS);
        if (wc == 1) {
#pragma unroll
          for (int n = 0; n < 4; ++n) st_bf16x4(KVR + t * 512 + hd * 128 + 64 + n * 16 + fq * 4, acc[m][n] * rskv);
        } else {
          const uint2 plo = *(const uint2*)(PROJ + t * DINP + C_KPE + 4 * fq), phi = *(const uint2*)(PROJ + t * DINP + C_KPE + 16 + 4 * fq);
          float pl[4] = {__uint_as_float(plo.x << 16), __uint_as_float(plo.x & 0xffff0000u), __uint_as_float(plo.y << 16), __uint_as_float(plo.y & 0xffff0000u)};
          float ph[4] = {__uint_as_float(phi.x << 16), __uint_as_float(phi.x & 0xffff0000u), __uint_as_float(phi.y << 16), __uint_as_float(phi.y & 0xffff0000u)};
          float sk = 0.f;
#pragma unroll
          for (int j = 0; j < 4; ++j) sk += pl[j] * pl[j] + ph[j] * ph[j];
          f32x4 kn[4];
#pragma unroll
          for (int n = 0; n < 4; ++n) { kn[n] = acc[m][n] * rskv; sk += kn[n][0] * kn[n][0] + kn[n][1] * kn[n][1] + kn[n][2] * kn[n][2] + kn[n][3] * kn[n][3]; }
          sk += __shfl_xor(sk, 16); sk += __shfl_xor(sk, 32);
          const float rsk = rsqrtf(sk * (1.f / 96) + EPS);
          bf16_t* dst = MK + ((size_t)(b * 4 + hd) * S + sq) * 96;
          f32x4 olo, ohi;
#pragma unroll
          for (int j = 0; j < 4; ++j) {
            const int d = 4 * fq + j; const float2 cs2 = RM[t * 16 + d];
            const float x1 = pl[j] * rsk * g_k[d], x2 = ph[j] * rsk * g_k[16 + d];
            olo[j] = x1 * cs2.x - x2 * cs2.y; ohi[j] = x1 * cs2.y + x2 * cs2.x;
          }
          st_bf16x4(dst + 4 * fq, olo); st_bf16x4(dst + 16 + 4 * fq, ohi);
#pragma unroll
          for (int n = 0; n < 4; ++n) { const float4 g4 = *(const float4*)(g_k + 32 + n * 16 + fq * 4); f32x4 o = kn[n] * rsk; o[0] *= g4.x; o[1] *= g4.y; o[2] *= g4.z; o[3] *= g4.w; st_bf16x4(dst + 32 + n * 16 + fq * 4, o); }
        }
      }
    } else {
      const int i2 = it - N_CMP - N_QR - N_KVR, mt = i2 >> 2, h = i2 & 3;
      const bf16_t* W = (const bf16_t*)(wl + W_LRU) + h * 128 * 64;
      const int c0 = h * 64 + (tid & 7) * 8;
      const float* cw = p.in[10] + l * 4 * 256 + c0; const float* cbp = p.in[11] + l * 256 + c0;
      gemm128(lds, 64,
              [&](int r, int k) {
                const size_t t = (size_t)mt * 128 + r; const int sq = (int)(t & (S - 1));
                float u[8];
#pragma unroll
                for (int e = 0; e < 8; ++e) u[e] = cbp[e];
#pragma unroll
                for (int j = 0; j < 4; ++j) {
                  if (sq - 3 + j >= 0) {
                    const u32x4 w = *(const u32x4*)(PROJ + (t - 3 + j) * DINP + C_LX + h * 64 + k);
#pragma unroll
                    for (int e = 0; e < 4; ++e) { u[2 * e] += __uint_as_float(w[e] << 16) * cw[j * 256 + 2 * e]; u[2 * e + 1] += __uint_as_float(w[e] & 0xffff0000u) * cw[j * 256 + 2 * e + 1]; }
                  }
                }
                u32x4 o; o[0] = pk2bf(u[0], u[1]); o[1] = pk2bf(u[2], u[3]); o[2] = pk2bf(u[4], u[5]); o[3] = pk2bf(u[6], u[7]);
                return o; },
              [&](int r, int k) { return W + (size_t)r * 64 + k; }, acc);
      GEMM_EPI4({ st_bf16x4(GATES + (size_t)(mt * 128 + er) * 512 + h * 128 + ec0, ev4); })
    }
    DYNQ_NEXT(it, lds)
  }
}

DEVI void lru_ab(float u, float rpre, float ipre, float sp, bool first, float& a, float& b) {
  const float r = sigmoidf_(rpre), gi = sigmoidf_(ipre);
  const float la = -8.f * r * sp;
  a = __expf(la);
  const float x = 2.f * la;
  const float om = (x > -0.1f) ? (-x * (1.f + 0.5f * x * (1.f + (1.f / 3.f) * x * (1.f + 0.25f * x * (1.f + 0.2f * x))))) : (1.f - a * a);
  const float mult = first ? 1.f : sqrtf(fmaxf(om, 0.f));
  b = mult * gi * u;
}
DEVI float lru_conv(const bf16_t* PROJ, int t, int s, int c, const float* cw, float cb) {
  float u = cb;
#pragma unroll
  for (int j = 0; j < 4; ++j) { const int ss2 = s - 3 + j; if (ss2 >= 0) u += bf2f(PROJ[(size_t)(t - 3 + j) * DINP + C_LX + c]) * cw[j * 256 + c]; }
  return u;
}

template <bool FULL>
DEVI void s5_chunk(const Params& p, int l, int b, int chunk, unsigned char* lds) {
  unsigned char* wl = p.ws + WS_W + l * WS_WL;
  const bf16_t* PROJ = (const bf16_t*)(p.ws + WS_B);
  const float2* Abar = (const float2*)(wl + W_S5A);
  const bf16_t* BB = (const bf16_t*)(wl + W_S5BB);
  const bf16_t* CM = (const bf16_t*)(wl + W_S5CM);
  float2* SLOC = (float2*)(p.ws + SM_SLOC);
  bf16_t* YCP = (bf16_t*)(p.ws + WS_F);
  const float* dd = p.in[24] + l * 256;
  const int tid = HTID, wv = tid >> 6, lane = tid & 63, r = lane & 31, h = lane >> 5, fr = lane & 15, fq = lane >> 4;
  unsigned* Hs = (unsigned*)(lds + wv * 8704);
  const int t0 = b * S + chunk * 64;
#pragma unroll 1
  for (int gi = 0; gi < 4; ++gi) {
    const int g = wv * 4 + gi;
    bf16x8 bbf[4];
#pragma unroll
    for (int nb = 0; nb < 4; ++nb) bbf[nb] = *(const bf16x8*)(BB + ((g * 4 + nb) * 32 + r) * 16 + 8 * h);
    float2 Ac[2]; float hr[2], hi[2];
#pragma unroll
    for (int sb = 0; sb < 2; ++sb) {
      Ac[sb] = Abar[g * 64 + sb * 32 + r];
      hr[sb] = 0.f; hi[sb] = 0.f;
      if (FULL) { const float2 cin = ((const float2*)(p.ws + SM_SCAR))[((size_t)(b * 32 + chunk) * 16 + g) * 64 + sb * 32 + r]; hr[sb] = cin.x; hi[sb] = cin.y; }
    }
    bf16x8 cm[4];
    float4 dcol4 = make_float4(0.f, 0.f, 0.f, 0.f);
    if (FULL) {
#pragma unroll
      for (int kk = 0; kk < 4; ++kk) cm[kk] = *(const bf16x8*)(CM + (size_t)(g * 16 + fr) * 128 + kk * 32 + 8 * fq);
      dcol4 = *(const float4*)(dd + g * 16 + 4 * fq);
    }
#pragma unroll 1
    for (int tb = 0; tb < 2; ++tb) {
      const bf16x8 ua = *(const bf16x8*)(PROJ + (size_t)(t0 + tb * 32 + r) * DINP + C_S5 + g * 16 + 8 * h);
      f32x16 acc[4];
#pragma unroll
      for (int nb = 0; nb < 4; ++nb) {
        f32x16 z;
#pragma unroll
        for (int i = 0; i < 16; ++i) z[i] = 0.f;
        acc[nb] = mfma32(ua, bbf[nb], z);
      }
#pragma unroll
      for (int sb = 0; sb < 2; ++sb) {
        float sr = hr[sb], si = hi[sb];
        const float ax = Ac[sb].x, ay = Ac[sb].y;
#pragma unroll
        for (int q = 0; q < 4; ++q)
#pragma unroll
          for (int owner = 0; owner < 2; ++owner) {
#pragma unroll
            for (int i = 0; i < 4; ++i) {
              const int reg = 4 * q + i;
              const float br = acc[2 * sb][reg], bi = acc[2 * sb + 1][reg];
              const float nr = ax * sr - ay * si + br, ni = ax * si + ay * sr + bi; sr = nr; si = ni;
              if (FULL) { acc[2 * sb][reg] = (h == owner) ? sr : br; acc[2 * sb + 1][reg] = (h == owner) ? si : bi; }
            }
            const float orr = __shfl_xor(sr, 32), oi = __shfl_xor(si, 32);
            if (h != owner) { sr = orr; si = oi; }
          }
        hr[sb] = sr; hi[sb] = si;
      }
      if (FULL) {
#pragma unroll
        for (int sb = 0; sb < 2; ++sb)
#pragma unroll
          for (int reg = 0; reg < 16; ++reg)
            Hs[crow(reg, h) * 68 + sb * 32 + r] = pk2bf(acc[2 * sb][reg], acc[2 * sb + 1][reg]);
#pragma unroll
        for (int tb16 = 0; tb16 < 2; ++tb16) {
          f32x4 y = (f32x4){0.f, 0.f, 0.f, 0.f};
#pragma unroll
          for (int kk = 0; kk < 4; ++kk) { const bf16x8 a = *(const bf16x8*)((const bf16_t*)Hs + (tb16 * 16 + fr) * 136 + kk * 32 + 8 * fq); y = mfma16(cm[kk], a, y); }
          const size_t t = (size_t)t0 + tb * 32 + tb16 * 16 + fr; const int col = g * 16 + 4 * fq;
          const uint2 uw = *(const uint2*)(PROJ + t * DINP + C_S5 + col);
          f32x4 o;
          o[0] = gelu_tanh(y[0] + dcol4.x * __uint_as_float(uw.x << 16)); o[1] = gelu_tanh(y[1] + dcol4.y * __uint_as_float(uw.x & 0xffff0000u));
          o[2] = gelu_tanh(y[2] + dcol4.z * __uint_as_float(uw.y << 16)); o[3] = gelu_tanh(y[3] + dcol4.w * __uint_as_float(uw.y & 0xffff0000u));
          st_bf16x4(YCP + t * 256 + col, o);
        }
      }
    }
    if (!FULL) {
#pragma unroll
      for (int sb = 0; sb < 2; ++sb) if (h == 0) SLOC[((size_t)(b * 32 + chunk) * 16 + g) * 64 + sb * 32 + r] = make_float2(hr[sb], hi[sb]);
    }
  }
}

template <bool FULL>
DEVI void lru_chunk(const Params& p, int l, int b, int chunk, float* tile) {
  const bf16_t* PROJ = (const bf16_t*)(p.ws + WS_B);
  const bf16_t* GATES = (const bf16_t*)(p.ws + WS_E);
  float2* LSUM = (float2*)(p.ws + SM_LSUM);
  const int c = HTID, h = c >> 6, j = c & 63;
  const float* cw = p.in[10] + l * 4 * 256;
  const float w0 = cw[c], w1 = cw[256 + c], w2 = cw[512 + c], w3 = cw[768 + c], cb = p.in[11][l * 256 + c];
  const float ba = p.in[13][l * 256 + c], bi = p.in[15][l * 256 + c];
  const float sp = log1pf(expf(-p.in[16][l * 256 + c]));
  const int s0 = chunk * 64; const size_t t0 = (size_t)b * S + s0;
  float xm3 = 0.f, xm2 = 0.f, xm1 = 0.f;
  if (s0 > 0) { xm3 = bf2f(PROJ[(t0 - 3) * DINP + C_LX + c]); xm2 = bf2f(PROJ[(t0 - 2) * DINP + C_LX + c]); xm1 = bf2f(PROJ[(t0 - 1) * DINP + C_LX + c]); }
  float hh = 0.f, ap = 1.f;
  if (FULL) hh = ((const float*)(p.ws + SM_LCAR))[(size_t)(b * 32 + chunk) * 256 + c];
#pragma unroll 1
  for (int k0 = 0; k0 < 64; k0 += 8) {
    float xv[8], rp[8], ip[8], gt[8];
#pragma unroll
    for (int i = 0; i < 8; ++i) {
      const size_t t = t0 + k0 + i;
      xv[i] = bf2f(PROJ[t * DINP + C_LX + c]);
      rp[i] = bf2f(GATES[t * 512 + h * 128 + j]); ip[i] = bf2f(GATES[t * 512 + h * 128 + 64 + j]);
      gt[i] = FULL ? bf2f(PROJ[t * DINP + C_LG + c]) : 0.f;
    }
#pragma unroll
    for (int i = 0; i < 8; ++i) {
      const float u = cb + xm3 * w0 + xm2 * w1 + xm1 * w2 + xv[i] * w3;
      xm3 = xm2; xm2 = xm1; xm1 = xv[i];
      float a, bb; lru_ab(u, rp[i] + ba, ip[i] + bi, sp, (s0 + k0 + i) == 0, a, bb);
      hh = a * hh + bb; ap *= a;
      if (FULL) tile[(k0 + i) * 256 + c] = hh * gelu_tanh(gt[i]);
    }
  }
  if (!FULL) LSUM[(size_t)(b * 32 + chunk) * 256 + c] = make_float2(ap, hh);
}

DEVI void phase_r2(const Params& p, int l, unsigned char* lds) {
  unsigned char* wl = p.ws + WS_W + l * WS_WL;
  const bf16_t* PROJ = (const bf16_t*)(p.ws + WS_B);
  const bf16_t* QR = (const bf16_t*)(p.ws + WS_D);
  const bf16_t* KVR = QR + (size_t)T * 384;
  const bf16_t* GATES = (const bf16_t*)(p.ws + WS_E);
  bf16_t* MQ = (bf16_t*)(p.ws + WS_F);
  bf16_t* MK = MQ + (size_t)T * 4 * 96;
  const float2* RM = (const float2*)(p.ws + WS_ROPE);
  const float2* RN = RM + (size_t)T * 16;
  const int tid = HTID, lane = tid & 63, wv = tid >> 6;
  for (int it = VBID; it < NB * 32; it += VGRID) lru_chunk<false>(p, l, it >> 5, it & 31, nullptr);
  hsync();
  for (int it = VBID; it < NB * 32; it += VGRID) s5_chunk<false>(p, l, it >> 5, it & 31, lds);
  {
    const bf16_t* HK = (const bf16_t*)(p.ws + SM_HK); const bf16_t* HV = (const bf16_t*)(p.ws + SM_HV);
    bf16_t* KC = (bf16_t*)(p.ws + SM_KC); bf16_t* VC = (bf16_t*)(p.ws + SM_VC);
    const bf16_t* W2K = (const bf16_t*)(wl + W_2K); const bf16_t* W2V = (const bf16_t*)(wl + W_2V);
    const float* g0 = p.in[28] + l * 192;
    for (int it = VBID; it < 32; it += VGRID) {
      const int kv = it & 1, mt = it >> 1;
      const bf16_t* H = kv ? HV : HK; const bf16_t* W2 = kv ? W2V : W2K;
      f32x4 acc[4][4];
      hsync();
      gemm128g(lds, 128, [&](int r, int k) { return H + (size_t)(mt * 128 + r) * 128 + k; }, [&](int r, int k) { return W2 + (size_t)(r & 63) * 128 + k; }, acc);
      const int wid = tid >> 6, wr = wid >> 1, wc = wid & 1, fr = lane & 15, fq = lane >> 4;
      if (wc == 0) {
#pragma unroll
        for (int m = 0; m < 4; ++m) {
          const int row = mt * 128 + wr * 64 + m * 16 + fr, b = row >> 7, c = row & 127;
          f32x4 v[4];
#pragma unroll
          for (int n = 0; n < 4; ++n) v[n] = acc[m][n];
          if (kv == 0) {
            float ss = 0.f;
#pragma unroll
            for (int n = 0; n < 4; ++n) ss += v[n][0] * v[n][0] + v[n][1] * v[n][1] + v[n][2] * v[n][2] + v[n][3] * v[n][3];
            ss += __shfl_xor(ss, 16); ss += __shfl_xor(ss, 32);
            const float rs = rsqrtf(ss * (1.f / 64) + EPS);
#pragma unroll
            for (int n = 0; n < 4; ++n) { const float4 gg = *(const float4*)(g0 + n * 16 + fq * 4); v[n][0] *= rs * gg.x; v[n][1] *= rs * gg.y; v[n][2] *= rs * gg.z; v[n][3] *= rs * gg.w; }
            const int cc = (c < 127) ? c : 126;
            const float2* cs = RN + (size_t)(b * S + 16 * cc + 31) * 8;
#pragma unroll
            for (int j = 0; j < 4; ++j) {
              const float x = v[0][j], partner = __shfl_xor(x, 32);
              const int d = fq * 4 + j; const float2 cs2 = cs[d & 7];
              v[0][j] = (d < 8) ? (x * cs2.x - partner * cs2.y) : (partner * cs2.y + x * cs2.x);
            }
          }
          bf16_t* dst = (kv ? VC : KC) + (size_t)row * 64;
#pragma unroll
          for (int n = 0; n < 4; ++n) { f32x4 o = v[n]; if (c >= 127) o = (f32x4){0.f, 0.f, 0.f, 0.f}; st_bf16x4(dst + n * 16 + fq * 4, o); }
        }
      }
    }
  }
}

typedef short v4i16_t __attribute__((ext_vector_type(4)));
DEVI float fexp2(float x) { return __builtin_amdgcn_exp2f(x); }
constexpr int VST = 96;
constexpr int ATT_VBYTES = 64 * VST * 2;
template <int DK> constexpr int att_kbytes() { return 64 * (DK + 8) * 2; }
template <int DK> constexpr int att_buf() { return att_kbytes<DK>() + ATT_VBYTES; }
template <int DK> struct TileRegs { u32x4 k[(64 * DK / 8 + 511) / 512]; u32x4 v; };
template <int DK>
DEVI void tile_load(TileRegs<DK>& tr, const bf16_t* kbase, size_t kstride, const bf16_t* vbase, size_t vstride, int key0, bool withv = true) {
  constexpr int CH = DK / 8, NCH = 64 * CH;
#pragma unroll
  for (int i = 0; i < (NCH + 511) / 512; ++i) { const int c = (int)threadIdx.x + 512 * i; if (c < NCH) { const int r = c / CH, cc = c % CH; tr.k[i] = *(const u32x4*)(kbase + (size_t)(key0 + r) * kstride + cc * 8); } }
  if (withv) { const int c = (int)threadIdx.x, r = c >> 3, cc = c & 7; tr.v = *(const u32x4*)(vbase + (size_t)(key0 + r) * vstride + cc * 8); }
}
template <int DK>
DEVI void tile_store(const TileRegs<DK>& tr, unsigned char* buf, bool withv = true) {
  constexpr int CH = DK / 8, NCH = 64 * CH;
  bf16_t* sK = (bf16_t*)buf; bf16_t* sV = (bf16_t*)(buf + att_kbytes<DK>());
#pragma unroll
  for (int i = 0; i < (NCH + 511) / 512; ++i) { const int c = (int)threadIdx.x + 512 * i; if (c < NCH) { const int r = c / CH, cc = c % CH; *(u32x4*)(sK + r * (DK + 8) + cc * 8) = tr.k[i]; } }
  if (withv) { const int c = (int)threadIdx.x, r = c >> 3, cc = c & 7; *(u32x4*)(sV + r * VST + cc * 8) = tr.v; }
}
template <int DK>
DEVI void qk_tile(const bf16_t* sK, const bf16x8* qf, f32x16& s0, f32x16& s1, int r, int h) {
#pragma unroll
  for (int i = 0; i < 16; ++i) { s0[i] = 0.f; s1[i] = 0.f; }
#pragma unroll
  for (int kk = 0; kk < DK / 16; ++kk) {
    const bf16x8 a0 = *(const bf16x8*)(sK + r * (DK + 8) + kk * 16 + h * 8);
    const bf16x8 a1 = *(const bf16x8*)(sK + (32 + r) * (DK + 8) + kk * 16 + h * 8);
    s0 = mfma32(a0, qf[kk], s0);
    s1 = mfma32(a1, qf[kk], s1);
  }
}
struct FState { f32x16 o0, o1; float m, l; };
DEVI void fstate_init(FState& f) {
#pragma unroll
  for (int i = 0; i < 16; ++i) { f.o0[i] = 0.f; f.o1[i] = 0.f; }
  f.m = -INFINITY; f.l = 0.f;
}
DEVI v4i16_t vtr(const bf16_t* p) { return __builtin_amdgcn_ds_read_tr16_b64_v4i16((LAS v4i16_t*)p); }
DEVI void softmax_pv(FState& f, f32x16& s0, f32x16& s1, const bf16_t* sV, int lane) {
  const int h = lane >> 5;
  float mx = -INFINITY;
#pragma unroll
  for (int i = 0; i < 16; ++i) mx = fmaxf(mx, fmaxf(s0[i], s1[i]));
  mx = fmaxf(mx, __shfl_xor(mx, 32));
  const float mnew = fmaxf(f.m, mx);
  const float muse = (mnew == -INFINITY) ? 0.f : mnew;
  float ps = 0.f;
#pragma unroll
  for (int i = 0; i < 16; ++i) { s0[i] = fexp2(s0[i] - muse); s1[i] = fexp2(s1[i] - muse); ps += s0[i] + s1[i]; }
  ps += __shfl_xor(ps, 32);
  if (__any(mnew != f.m)) {
    const float alpha = fexp2(f.m - muse);
    f.l = f.l * alpha + ps; f.m = mnew;
#pragma unroll
    for (int i = 0; i < 16; ++i) { f.o0[i] *= alpha; f.o1[i] *= alpha; }
  } else {
    f.l += ps;
  }
  const int g = lane >> 4, li = lane & 15, q = li >> 2, pp = li & 3;
  const bf16_t* vb = sV + (4 * h + q) * VST + (g & 1) * 16 + 4 * pp;
#pragma unroll
  for (int kb = 0; kb < 2; ++kb)
#pragma unroll
    for (int s = 0; s < 2; ++s) {
      unsigned pw[4];
#pragma unroll
      for (int j = 0; j < 4; ++j) pw[j] = kb ? pk2bf(s1[8 * s + 2 * j], s1[8 * s + 2 * j + 1]) : pk2bf(s0[8 * s + 2 * j], s0[8 * s + 2 * j + 1]);
      const bf16x8 pb = __builtin_bit_cast(bf16x8, (u32x4){pw[0], pw[1], pw[2], pw[3]});
#pragma unroll
      for (int db = 0; db < 2; ++db) {
        const v4i16_t lo = vtr(vb + (kb * 32 + 16 * s) * VST + db * 32);
        const v4i16_t hi = vtr(vb + (kb * 32 + 16 * s + 8) * VST + db * 32);
        const bf16x8 a = {lo[0], lo[1], lo[2], lo[3], hi[0], hi[1], hi[2], hi[3]};
        if (db == 0) f.o0 = mfma32(a, pb, f.o0); else f.o1 = mfma32(a, pb, f.o1);
      }
    }
}
DEVI void store_o(bf16_t* orow, const f32x16& o0, const f32x16& o1, float sc, int h) {
#pragma unroll
  for (int g = 0; g < 4; ++g) {
    uint2 v0, v1;
    v0.x = pk2bf(o0[4 * g] * sc, o0[4 * g + 1] * sc); v0.y = pk2bf(o0[4 * g + 2] * sc, o0[4 * g + 3] * sc);
    v1.x = pk2bf(o1[4 * g] * sc, o1[4 * g + 1] * sc); v1.y = pk2bf(o1[4 * g + 2] * sc, o1[4 * g + 3] * sc);
    *(uint2*)(orow + 8 * g + 4 * h) = v0;
    *(uint2*)(orow + 32 + 8 * g + 4 * h) = v1;
  }
}

DEVI void mla_item(const Params& p, int l, int b, int hd, int qt, unsigned char* lds) {
  const bf16_t* MQ = (const bf16_t*)(p.ws + WS_F);
  const bf16_t* MK = MQ + (size_t)T * 4 * 96;
  const bf16_t* KVR = (const bf16_t*)(p.ws + WS_D) + (size_t)T * 384;
  bf16_t* YA = (bf16_t*)(p.ws + WS_C);
  const int tid = (int)threadIdx.x, wv = tid >> 6, lane = tid & 63, r = lane & 31, h = lane >> 5;
  const int q0 = qt * 256 + wv * 32, tq = q0 + r;
  bf16x8 qf[6];
  {
    const bf16_t* qrow = (const bf16_t*)(p.ws + WS_D) + ((size_t)b * S + tq) * 384 + hd * 96;
    const float* g_q = p.in[8] + l * 96;
    float qv[6][8]; float ss = 0.f;
#pragma unroll
    for (int kk = 0; kk < 6; ++kk) {
      const u32x4 w = *(const u32x4*)(qrow + kk * 16 + h * 8);
#pragma unroll
      for (int e = 0; e < 4; ++e) { qv[kk][2 * e] = __uint_as_float(w[e] << 16); qv[kk][2 * e + 1] = __uint_as_float(w[e] & 0xffff0000u); ss += qv[kk][2 * e] * qv[kk][2 * e] + qv[kk][2 * e + 1] * qv[kk][2 * e + 1]; }
    }
    ss += __shfl_xor(ss, 32);
    const float rs = rsqrtf(ss * (1.f / 96) + EPS) * (0.10206207261596575f * LOG2E);
#pragma unroll
    for (int kk = 0; kk < 6; ++kk)
#pragma unroll
      for (int j = 0; j < 8; ++j) qv[kk][j] *= rs * g_q[kk * 16 + h * 8 + j];
    const float2* cs = (const float2*)(p.ws + WS_ROPE) + ((size_t)b * S + tq) * 16 + 8 * h;
#pragma unroll
    for (int j = 0; j < 8; ++j) { const float2 c2 = cs[j]; const float x1 = qv[0][j], x2 = qv[1][j]; qv[0][j] = x1 * c2.x - x2 * c2.y; qv[1][j] = x1 * c2.y + x2 * c2.x; }
#pragma unroll
    for (int kk = 0; kk < 6; ++kk) { const u32x4 w = {pk2bf(qv[kk][0], qv[kk][1]), pk2bf(qv[kk][2], qv[kk][3]), pk2bf(qv[kk][4], qv[kk][5]), pk2bf(qv[kk][6], qv[kk][7])}; qf[kk] = __builtin_bit_cast(bf16x8, w); }
  }
  FState f; fstate_init(f);
  const bf16_t* kbase = MK + (size_t)(b * 4 + hd) * S * 96;
  const bf16_t* vbase = KVR + (size_t)b * S * 512 + hd * 128 + 64;
  const int ntiles = 4 * qt + 4;
  TileRegs<96> tr;
  TileRegs<96> tr2;
  tile_load<96>(tr, kbase, 96, vbase, 512, 0);
  tile_load<96>(tr2, kbase, 96, vbase, 512, 64);
  __syncthreads();
  tile_store<96>(tr, lds);
  __syncthreads();
  auto compute = [&](int kt, unsigned char* cur) {
    if (kt * 64 <= q0 + 31) {
      f32x16 s0, s1;
      qk_tile<96>((const bf16_t*)cur, qf, s0, s1, r, h);
      if (kt * 64 + 63 > q0) {
        int rel = tq - kt * 64 - 4 * h; asm volatile("" : "+v"(rel));
#pragma unroll
        for (int i = 0; i < 16; ++i) { const int kk2 = (i & 3) + 8 * (i >> 2); if (kk2 > rel) s0[i] = -INFINITY; if (kk2 + 32 > rel) s1[i] = -INFINITY; }
      }
      softmax_pv(f, s0, s1, (const bf16_t*)(cur + att_kbytes<96>()), lane);
    }
  };
#pragma unroll 1
  for (int kt = 0; kt < ntiles; kt += 2) {
    if (kt + 2 < ntiles) tile_load<96>(tr, kbase, 96, vbase, 512, (kt + 2) * 64);
    compute(kt, lds);
    tile_store<96>(tr2, lds + att_buf<96>());
    __syncthreads();
    if (kt + 3 < ntiles) tile_load<96>(tr2, kbase, 96, vbase, 512, (kt + 3) * 64);
    compute(kt + 1, lds + att_buf<96>());
    if (kt + 2 < ntiles) tile_store<96>(tr, lds);
    __syncthreads();
  }
  store_o(YA + (size_t)(b * S + tq) * 256 + hd * 64, f.o0, f.o1, 1.f / f.l, h);
}

template <class KF, class BODY>
DEVI void nsa_stream(unsigned char* lds, const bf16_t* kbase, size_t kstride, const bf16_t* vbase, size_t vstride, bool withv, int nt, KF key0f, BODY body) {
  if (nt <= 0) return;
  TileRegs<64> trA, trB;
  tile_load<64>(trA, kbase, kstride, vbase, vstride, key0f(0), withv);
  if (nt > 1) tile_load<64>(trB, kbase, kstride, vbase, vstride, key0f(1), withv);
  __syncthreads();
  tile_store<64>(trA, lds, withv);
  __syncthreads();
  unsigned char* buf0 = lds; unsigned char* buf1 = lds + att_buf<64>();
#pragma unroll 1
  for (int i = 0; i < nt; i += 2) {
    if (i + 2 < nt) tile_load<64>(trA, kbase, kstride, vbase, vstride, key0f(i + 2), withv);
    body(i, buf0);
    if (i + 1 < nt) tile_store<64>(trB, buf1, withv);
    __syncthreads();
    if (i + 1 >= nt) break;
    if (i + 3 < nt) tile_load<64>(trB, kbase, kstride, vbase, vstride, key0f(i + 3), withv);
    body(i + 1, buf1);
    if (i + 2 < nt) tile_store<64>(trA, buf0, withv);
    __syncthreads();
  }
}
DEVI void nsa_item(const Params& p, int l, int b, int qt, unsigned char* lds) {
  const bf16_t* PROJ = (const bf16_t*)(p.ws + WS_B);
  const bf16_t* KC = (const bf16_t*)(p.ws + SM_KC) + (size_t)b * 128 * 64;
  const bf16_t* VC = (const bf16_t*)(p.ws + SM_VC) + (size_t)b * 128 * 64;
  const int tid = (int)threadIdx.x, wv = tid >> 6, lane = tid & 63, r = lane & 31, h = lane >> 5;
  float* psum = (float*)(lds + 2 * att_buf<64>());
  unsigned* selm = (unsigned*)(lds + 2 * att_buf<64>() + 32768);
  const int t0 = qt * 64, cur = t0 >> 6;
  const int ql = wv * 8 + (r >> 2), hd = r & 3, tq = t0 + ql;
  const size_t tg = (size_t)b * S + tq;
  bf16x8 qf[4];
#pragma unroll
  for (int kk = 0; kk < 4; ++kk) qf[kk] = *(const bf16x8*)((const bf16_t*)(p.ws + WS_G) + tg * 256 + hd * 64 + kk * 16 + h * 8);
  unsigned* ofs = (unsigned*)psum + wv * 1024 + lane;
  const float g0 = sigmoidf_(bf2f(PROJ[tg * DINP + C_NG + hd * 3 + 0]));
  const float g1 = sigmoidf_(bf2f(PROJ[tg * DINP + C_NG + hd * 3 + 1]));
  const float g2 = sigmoidf_(bf2f(PROJ[tg * DINP + C_NG + hd * 3 + 2]));
  FState f; fstate_init(f);
  const int ncmp = (((t0 + 32) >> 4) >> 6) + 1;
  nsa_stream(lds, KC, 64, VC, 64, true, ncmp, [&](int i) { return i * 64; }, [&](int kt, unsigned char* buf) {
    f32x16 s0, s1;
    qk_tile<64>((const bf16_t*)buf, qf, s0, s1, r, h);
    int rel = ((tq - 31) >> 4) - kt * 64 - 4 * h; asm volatile("" : "+v"(rel));
#pragma unroll
    for (int i = 0; i < 16; ++i) { const int kk2 = (i & 3) + 8 * (i >> 2); if (kk2 > rel) s0[i] = -INFINITY; if (kk2 + 32 > rel) s1[i] = -INFINITY; }
    softmax_pv(f, s0, s1, (const bf16_t*)(buf + att_kbytes<64>()), lane);
  });
  {
    const float muse = (f.m == -INFINITY) ? 0.f : f.m;
    const float il = (f.l > 0.f) ? 1.f / f.l : 0.f;
    if (ncmp < 2) {
#pragma unroll 1
      for (int i = tid; i < 64 * 128; i += KTHREADS) psum[i] = 0.f;
      __syncthreads();
    }
    nsa_stream(lds, KC, 64, VC, 64, false, ncmp, [&](int i) { return i * 64; }, [&](int kt, unsigned char* buf) {
      f32x16 s0, s1;
      qk_tile<64>((const bf16_t*)buf, qf, s0, s1, r, h);
      int rel = ((tq - 31) >> 4) - kt * 64 - 4 * h; asm volatile("" : "+v"(rel));
      int cb0 = kt * 64 + 4 * h; asm volatile("" : "+v"(cb0));
#pragma unroll
      for (int i = 0; i < 16; ++i) {
        const int kk2 = (i & 3) + 8 * (i >> 2); const int c = cb0 + kk2;
        float p0 = (kk2 > rel) ? 0.f : fexp2(s0[i] - muse) * il;
        float p1 = (kk2 + 32 > rel) ? 0.f : fexp2(s1[i] - muse) * il;
        p0 += __shfl_xor(p0, 1); p0 += __shfl_xor(p0, 2);
        p1 += __shfl_xor(p1, 1); p1 += __shfl_xor(p1, 2);
        if (hd == 0) { psum[ql * 128 + c] = p0; psum[ql * 128 + c + 32] = p1; }
      }
    });
  }
  __syncthreads();
#pragma unroll 1
  for (int itq = 0; itq < 4; ++itq) {
    const int q2 = wv * 8 + itq * 2 + (lane >> 5), j = lane & 31;
    const float* ps = psum + q2 * 128;
    float imp = 2.f * (ps[4 * j] + ps[4 * j + 1] + ps[4 * j + 2]) + ps[4 * j + 3];
    if (j > 0) imp += ps[4 * j - 1];
    const bool cand = (j >= 1) && (j <= cur - 2);
    int rank = 0;
    for (int jj = 0; jj < 32; ++jj) {
      const float v = __shfl(imp, (lane & 32) | jj);
      const bool cj = (jj >= 1) && (jj <= cur - 2);
      if (cj && (v > imp || (v == imp && jj < j))) ++rank;
    }
    const bool sel = cand && rank < 2;
    const unsigned long long bal = __ballot(sel);
    unsigned mk = (unsigned)(bal >> (32 * (lane >> 5)));
    mk |= 1u | (1u << cur); if (cur >= 1) mk |= (1u << (cur - 1));
    if (j == 0) selm[q2] = mk;
  }
  __syncthreads();
  unsigned blk_or = 0, wave_or = 0;
  for (int i = 0; i < 64; ++i) blk_or |= selm[i];
  for (int i = 0; i < 8; ++i) wave_or |= selm[wv * 8 + i];
  const unsigned mymask = selm[ql];
  {
    const float sc = (f.l > 0.f) ? g0 / f.l : 0.f;
#pragma unroll
    for (int i = 0; i < 8; ++i) { ofs[i * 64] = pk2bf(f.o0[2 * i] * sc, f.o0[2 * i + 1] * sc); ofs[(8 + i) * 64] = pk2bf(f.o1[2 * i] * sc, f.o1[2 * i + 1] * sc); }
  }
  fstate_init(f);
  {
    unsigned* tl = selm + 64;
    if (tid < 32 && ((blk_or >> tid) & 1u)) tl[__popc(blk_or & ((1u << tid) - 1u))] = tid;
    __syncthreads();
    const int nsel = __popc(blk_or);
    nsa_stream(lds, (const bf16_t*)(p.ws + WS_G) + (size_t)T * 256 + (size_t)b * S * 64, 64, PROJ + (size_t)b * S * DINP + C_VS, DINP, true, nsel,
      [&](int i) { return (int)tl[i] * 64; },
      [&](int i, unsigned char* buf) {
        const int jj = (int)tl[i];
        if ((wave_or >> jj) & 1u) {
          f32x16 s0, s1;
          qk_tile<64>((const bf16_t*)buf, qf, s0, s1, r, h);
          const bool on = (mymask >> jj) & 1u;
          int rel = on ? (tq - jj * 64 - 4 * h) : -1; asm volatile("" : "+v"(rel));
#pragma unroll
          for (int i2 = 0; i2 < 16; ++i2) { const int kk2 = (i2 & 3) + 8 * (i2 >> 2); if (kk2 > rel) s0[i2] = -INFINITY; if (kk2 + 32 > rel) s1[i2] = -INFINITY; }
          softmax_pv(f, s0, s1, (const bf16_t*)(buf + att_kbytes<64>()), lane);
        }
      });
    const float sc = (f.l > 0.f) ? g1 / f.l : 0.f;
#pragma unroll
    for (int i = 0; i < 8; ++i) {
      const unsigned w0 = ofs[i * 64], w1 = ofs[(8 + i) * 64];
      ofs[i * 64] = pk2bf(__uint_as_float(w0 << 16) + f.o0[2 * i] * sc, __uint_as_float(w0 & 0xffff0000u) + f.o0[2 * i + 1] * sc);
      ofs[(8 + i) * 64] = pk2bf(__uint_as_float(w1 << 16) + f.o1[2 * i] * sc, __uint_as_float(w1 & 0xffff0000u) + f.o1[2 * i + 1] * sc);
    }
  }
  fstate_init(f);
  {
    int jlo = (t0 - 511) >> 6; if (jlo < 0) jlo = 0;
    nsa_stream(lds, (const bf16_t*)(p.ws + WS_G) + (size_t)T * 320 + (size_t)b * S * 64, 64, PROJ + (size_t)b * S * DINP + C_VW, DINP, true, cur - jlo + 1,
      [&](int i) { return (jlo + i) * 64; },
      [&](int i, unsigned char* buf) {
        const int j = jlo + i;
        f32x16 s0, s1;
        qk_tile<64>((const bf16_t*)buf, qf, s0, s1, r, h);
        if (j == cur || j * 64 < t0 + 63 - 511 + 64) {
          int rel = tq - j * 64 - 4 * h; asm volatile("" : "+v"(rel));
#pragma unroll
          for (int i2 = 0; i2 < 16; ++i2) {
            const int kk2 = (i2 & 3) + 8 * (i2 >> 2);
            if (kk2 > rel || kk2 < rel - 511) s0[i2] = -INFINITY;
            if (kk2 + 32 > rel || kk2 + 32 < rel - 511) s1[i2] = -INFINITY;
          }
        }
        softmax_pv(f, s0, s1, (const bf16_t*)(buf + att_kbytes<64>()), lane);
      });
    const float sc = (f.l > 0.f) ? g2 / f.l : 0.f;
#pragma unroll
    for (int i = 0; i < 8; ++i) {
      const unsigned w0 = ofs[i * 64], w1 = ofs[(8 + i) * 64];
      f.o0[2 * i] = __uint_as_float(w0 << 16) + f.o0[2 * i] * sc; f.o0[2 * i + 1] = __uint_as_float(w0 & 0xffff0000u) + f.o0[2 * i + 1] * sc;
      f.o1[2 * i] = __uint_as_float(w1 << 16) + f.o1[2 * i] * sc; f.o1[2 * i + 1] = __uint_as_float(w1 & 0xffff0000u) + f.o1[2 * i + 1] * sc;
    }
  }
  f32x16& of0 = f.o0; f32x16& of1 = f.o1;
  {
    float ss = 0.f;
#pragma unroll
    for (int i = 0; i < 16; ++i) ss += of0[i] * of0[i] + of1[i] * of1[i];
    ss += __shfl_xor(ss, 1); ss += __shfl_xor(ss, 2); ss += __shfl_xor(ss, 32);
    const float rs = rsqrtf(ss * (1.f / 256) + EPS);
    const float* on = p.in[35] + l * 1024 + 768 + hd * 64;
#pragma unroll
    for (int g4 = 0; g4 < 4; ++g4) {
      const float4 a = *(const float4*)(on + 8 * g4 + 4 * h), b4 = *(const float4*)(on + 32 + 8 * g4 + 4 * h);
      of0[4 * g4] *= a.x; of0[4 * g4 + 1] *= a.y; of0[4 * g4 + 2] *= a.z; of0[4 * g4 + 3] *= a.w;
      of1[4 * g4] *= b4.x; of1[4 * g4 + 1] *= b4.y; of1[4 * g4 + 2] *= b4.z; of1[4 * g4 + 3] *= b4.w;
    }
    store_o((bf16_t*)(p.ws + WS_A) + tg * 1024 + 768 + hd * 64, of0, of1, rs, h);
  }
}

DEVI void carry_item(const Params& p, int l, int it) {
  const int tid = HTID;
  if (it < 64) {
    const int idx = it * 256 + tid, b = idx >> 10, gs = idx & 1023;
    const float2 a64 = ((const float2*)(p.ws + WS_W + l * WS_WL + W_S5A64))[gs];
    const float2* SLOC = (const float2*)(p.ws + SM_SLOC) + (size_t)b * 32 * 1024 + gs;
    float2* SCAR = (float2*)(p.ws + SM_SCAR) + (size_t)b * 32 * 1024 + gs;
    float hr = 0.f, hi = 0.f;
#pragma unroll 1
    for (int c0 = 0; c0 < 32; c0 += 8) {
      float2 sl[8];
#pragma unroll
      for (int i = 0; i < 8; ++i) sl[i] = SLOC[(size_t)(c0 + i) * 1024];
#pragma unroll
      for (int i = 0; i < 8; ++i) { SCAR[(size_t)(c0 + i) * 1024] = make_float2(hr, hi); const float nr = a64.x * hr - a64.y * hi + sl[i].x, ni = a64.x * hi + a64.y * hr + sl[i].y; hr = nr; hi = ni; }
    }
  } else {
    const int idx = (it - 64) * 256 + tid, b = idx >> 8, c = idx & 255;
    const float2* LSUM = (const float2*)(p.ws + SM_LSUM) + (size_t)b * 32 * 256 + c;
    float* LCAR = (float*)(p.ws + SM_LCAR) + (size_t)b * 32 * 256 + c;
    float hh = 0.f;
#pragma unroll 1
    for (int c0 = 0; c0 < 32; c0 += 8) {
      float2 sv[8];
#pragma unroll
      for (int i = 0; i < 8; ++i) sv[i] = LSUM[(size_t)(c0 + i) * 256];
#pragma unroll
      for (int i = 0; i < 8; ++i) { LCAR[(size_t)(c0 + i) * 256] = hh; hh = sv[i].x * hh + sv[i].y; }
    }
  }
}
DEVI void phase_a1(const Params& p, int l, unsigned char* lds_full) {
  for (int it = VBID; it < 80; it += VGRID) carry_item(p, l, it);
  __syncthreads();
  const int G_ = (int)gridDim.x, bx_ = (int)blockIdx.x, vb_ = (G_ % 8 == 0) ? (bx_ % 8) * (G_ / 8) + bx_ / 8 : bx_;
  for (int rr = 0; rr * G_ < 512; ++rr) { const int j = rr * G_ + ((rr & 1) ? (G_ - 1 - vb_) : vb_); if (j < 512) { const int b = j >> 5, qt = 31 - (j & 31); nsa_item(p, l, b, qt, lds_full); } }
  __syncthreads();
  for (int rr = 0; rr * G_ < 512; ++rr) { const int j = rr * G_ + ((rr & 1) ? (G_ - 1 - vb_) : vb_); if (j < 512) { const int bh = j >> 3, qt = 7 - (j & 7); mla_item(p, l, bh >> 2, bh & 3, qt, lds_full); } }
}

DEVI void phase_r3(const Params& p, int l, unsigned char* lds) {
  bf16_t* Y = (bf16_t*)(p.ws + WS_A);
  const int tid = HTID, lane = tid & 63, wv = tid >> 6;
  {
    const float* onorm = p.in[35] + l * 1024 + 256;
    float* tile = (float*)lds;
    for (int it = VBID; it < NB * 32; it += VGRID) {
      const int b = it >> 5, chunk = it & 31;
      hsync();
      lru_chunk<true>(p, l, b, chunk, tile);
      hsync();
      for (int k = wv; k < 64; k += 4) {
        const float4 v = *(const float4*)(tile + k * 256 + lane * 4);
        const float rs = rsqrtf(wsum(v.x * v.x + v.y * v.y + v.z * v.z + v.w * v.w) * (1.f / 256) + EPS);
        const size_t t = (size_t)b * S + chunk * 64 + k;
        const float4 gg = *(const float4*)(onorm + lane * 4);
        st_bf16x4(Y + t * 1024 + 256 + lane * 4, (f32x4){v.x * rs * gg.x, v.y * rs * gg.y, v.z * rs * gg.z, v.w * rs * gg.w});
      }
    }
  }
  hsync();
  for (int it = VBID; it < NB * 32; it += VGRID) s5_chunk<true>(p, l, it >> 5, it & 31, lds);
}

DEVI void phase_g3(const Params& p, int l, unsigned char* lds) {
  const bf16_t* YCP = (const bf16_t*)(p.ws + WS_F);
  bf16_t* YC = (bf16_t*)(p.ws + WS_F) + (size_t)T * 256;
  const bf16_t* W = (const bf16_t*)(p.ws + WS_W + l * WS_WL + W_GLU);
  const float* bg = p.in[26] + l * 256;
  for (int it = vblock(); it < 256 * 2; it += VGRID) {
    const int mt = it >> 1, nt = it & 1;
    f32x4 acc[4][4];
    gemm128g(lds, 256, [&](int r, int k) { return YCP + (size_t)(mt * 128 + r) * 256 + k; }, [&](int r, int k) { return W + (size_t)(nt * 128 + r) * 256 + k; }, acc);
    GEMM_EPI4({ const size_t o = (size_t)(mt * 128 + er) * 256 + nt * 128 + ec0; const ushort4 yp = *(const ushort4*)(YCP + o); f32x4 r4; r4[0] = bf2f(yp.x) * sigmoidf_(ev4[0] + bg[nt * 128 + ec0]); r4[1] = bf2f(yp.y) * sigmoidf_(ev4[1] + bg[nt * 128 + ec0 + 1]); r4[2] = bf2f(yp.z) * sigmoidf_(ev4[2] + bg[nt * 128 + ec0 + 2]); r4[3] = bf2f(yp.w) * sigmoidf_(ev4[3] + bg[nt * 128 + ec0 + 3]); st_bf16x4(YC + o, r4); })
  }
}

DEVI void phase_r4(const Params& p, int l) {
  const bf16_t* YA = (const bf16_t*)(p.ws + WS_C);
  const bf16_t* YC = (const bf16_t*)(p.ws + WS_F) + (size_t)T * 256;
  bf16_t* Y = (bf16_t*)(p.ws + WS_A);
  const float* onorm = p.in[35] + l * 1024;
  const int lane = HTID & 63, gw = VBID * 4 + (HTID >> 6), NGW = VGRID * 4;
  for (int t = gw; t < T; t += NGW) {
#pragma unroll
    for (int grp = 0; grp < 2; ++grp) {
      const bf16_t* src = (grp == 0 ? YA : YC) + (size_t)t * 256;
      const int gcol = (grp == 0 ? 0 : 512);
      const ushort4 u = ((const ushort4*)src)[lane];
      const float v0 = bf2f(u.x), v1 = bf2f(u.y), v2 = bf2f(u.z), v3 = bf2f(u.w);
      const float rs = rsqrtf(wsum(v0 * v0 + v1 * v1 + v2 * v2 + v3 * v3) * (1.f / 256) + EPS);
      const float4 g = ((const float4*)(onorm + gcol))[lane];
      uint2 o; o.x = pk2bf(v0 * rs * g.x, v1 * rs * g.y); o.y = pk2bf(v2 * rs * g.z, v3 * rs * g.w);
      ((uint2*)(Y + (size_t)t * 1024 + gcol))[lane] = o;
    }
  }
}

DEVI void phase_g4(const Params& p, int l, unsigned char* lds_full) {
  const bf16_t* Y = (const bf16_t*)(p.ws + WS_A);
  const bf16_t* W = (const bf16_t*)(p.ws + WS_W + l * WS_WL + W_OUT);
  pg8::Gemm g{Y, W, T, D, D}; pg8::StaticOrder S; S.init(T, D, (int)gridDim.x, (int)blockIdx.x);
  bf16_t* X1 = (bf16_t*)(p.ws + WS_D);
  if (l == 0) { EpiRes<false> E{p.in[0], nullptr, X1}; pg8::gemm_phase<EpiRes<false>, pg8::StaticOrder, true, true>((LAS unsigned char*)lds_full, g, S, E); }
  else { EpiRes<true> E{nullptr, (const bf16_t*)p.out, X1}; pg8::gemm_phase<EpiRes<true>, pg8::StaticOrder, true, true>((LAS unsigned char*)lds_full, g, S, E); }
}

DEVI void phase_r5(const Params& p, int l, unsigned char* lds) {
  const bf16_t* x1 = (const bf16_t*)(p.ws + WS_D);
  const bf16_t* WH = (const bf16_t*)(p.ws + WS_W + l * WS_WL + W_RTH);
  const bf16_t* WL = (const bf16_t*)(p.ws + WS_W + l * WS_WL + W_RTL);
  const float* brg = p.in[39] + l * 4; const float* bre = p.in[41] + l * 16;
  int* CNT = (int*)(p.ws + SM_CNT) + l * 32;
  int* LIST = (int*)(p.ws + SM_LIST);
  float4* TOKW = (float4*)(p.ws + SM_TOKW);
  const int tid = HTID, lane = tid & 63, wv = tid >> 6, c = lane & 15, q = lane >> 4;
  float* red = (float*)lds;
  int* hist = (int*)(lds + 16384);
  int* tokl = (int*)(lds + 16384 + 256);
  if (tid < 64) hist[tid] = 0;
  int ntok = 0;
  hsync();
  for (int it = VBID; it < T / 16; it += VGRID) {
    const size_t tb = (size_t)it * 16;
    f32x4 a0 = (f32x4){0.f, 0.f, 0.f, 0.f}, a1 = (f32x4){0.f, 0.f, 0.f, 0.f};
    float ss = 0.f;
    const bf16_t* xrow = x1 + (tb + c) * D + wv * 256 + 8 * q;
    const bf16_t* wh0 = WH + (size_t)c * 1024 + wv * 256 + 8 * q;
    const bf16_t* wl0 = WL + (size_t)c * 1024 + wv * 256 + 8 * q;
    u32x4 xk[8];
#pragma unroll
    for (int ks = 0; ks < 8; ++ks) xk[ks] = *(const u32x4*)(xrow + ks * 32);
#pragma unroll
    for (int ks = 0; ks < 8; ++ks) {
      const bf16x8 wh_a = *(const bf16x8*)(wh0 + ks * 32), wl_a = *(const bf16x8*)(wl0 + ks * 32);
      const bf16x8 wh_b = *(const bf16x8*)(wh0 + 16 * 1024 + ks * 32), wl_b = *(const bf16x8*)(wl0 + 16 * 1024 + ks * 32);
#pragma unroll
      for (int j = 0; j < 4; ++j) {
        const float x0 = __uint_as_float(xk[ks][j] << 16), x1v = __uint_as_float(xk[ks][j] & 0xffff0000u);
        ss += x0 * x0 + x1v * x1v;
      }
      const bf16x8 xh = __builtin_bit_cast(bf16x8, xk[ks]);
      a0 = mfma16(wh_a, xh, a0); a0 = mfma16(wl_a, xh, a0);
      a1 = mfma16(wh_b, xh, a1); a1 = mfma16(wl_b, xh, a1);
    }
    ss += __shfl_xor(ss, 16); ss += __shfl_xor(ss, 32);
    hsync();
#pragma unroll
    for (int j = 0; j < 4; ++j) { red[(wv * 9 + j) * 64 + lane] = a0[j]; red[(wv * 9 + 4 + j) * 64 + lane] = a1[j]; }
    red[(wv * 9 + 8) * 64 + lane] = ss;
    hsync();
    const float s2 = red[8 * 64 + lane] + red[(9 + 8) * 64 + lane] + red[(18 + 8) * 64 + lane] + red[(27 + 8) * 64 + lane];
    const float rs = rsqrtf(s2 * (1.f / D) + EPS);
    if (wv == 0) {
      float c0[4], c1[4];
#pragma unroll
      for (int j = 0; j < 4; ++j) {
        c0[j] = red[j * 64 + lane] + red[(9 + j) * 64 + lane] + red[(18 + j) * 64 + lane] + red[(27 + j) * 64 + lane];
        c1[j] = red[(4 + j) * 64 + lane] + red[(13 + j) * 64 + lane] + red[(22 + j) * 64 + lane] + red[(31 + j) * 64 + lane];
      }
      float lg[20];
#pragma unroll
      for (int qq = 0; qq < 4; ++qq)
#pragma unroll
        for (int j = 0; j < 4; ++j) lg[4 * qq + j] = __shfl(c0[j], c + 16 * qq);
#pragma unroll
      for (int j = 0; j < 4; ++j) lg[16 + j] = __shfl(c1[j], c);
      const int t = (int)tb + c;
      float gl[4];
#pragma unroll
      for (int k2 = 0; k2 < 4; ++k2) gl[k2] = lg[k2] * rs + brg[k2];
      int gi = 0; float gbest = gl[0];
#pragma unroll
      for (int k2 = 1; k2 < 4; ++k2) if (gl[k2] > gbest) { gbest = gl[k2]; gi = k2; }
      float den = 0.f;
#pragma unroll
      for (int k2 = 0; k2 < 4; ++k2) den += expf(gl[k2] - gbest);
      const float pg = 1.f / den;
      float le[4];
#pragma unroll
      for (int k2 = 0; k2 < 4; ++k2) { float sel = 0.f;
#pragma unroll
        for (int gg2 = 0; gg2 < 4; ++gg2) sel = (gi == gg2) ? (lg[4 + gg2 * 4 + k2] * rs + bre[gg2 * 4 + k2]) : sel;
        le[k2] = sel; }
      int i0 = 0; float l0 = le[0];
#pragma unroll
      for (int k2 = 1; k2 < 4; ++k2) if (le[k2] > l0) { l0 = le[k2]; i0 = k2; }
      int i1 = -1; float l1 = -INFINITY;
#pragma unroll
      for (int k2 = 0; k2 < 4; ++k2) if (k2 != i0 && le[k2] > l1) { l1 = le[k2]; i1 = k2; }
      const float e1 = expf(l1 - l0);
      const float w0 = pg / (1.f + e1), w1 = pg * e1 / (1.f + e1);
      const int elo = (i0 < i1) ? i0 : i1, ehi = (i0 < i1) ? i1 : i0;
      const float wlo = (i0 < i1) ? w0 : w1, whi = (i0 < i1) ? w1 : w0;
      const int pidx = (elo == 0) ? (ehi - 1) : ((elo == 1) ? (ehi + 1) : 5);
      const int cls = gi * 6 + pidx;
      if (q == 0) {
        const int rank = atomicAdd(&hist[cls], 1);
        tokl[2 * (ntok + c)] = t; tokl[2 * (ntok + c) + 1] = (cls << 16) | rank;
        TOKW[t] = make_float4(wlo, whi, rs, 0.f);
      }
    }
    ntok += 16;
  }
  hsync();
  if (tid < 24) { const int n = hist[tid]; hist[32 + tid] = n ? atomicAdd(&CNT[tid], n) : 0; }
  hsync();
  for (int i = tid; i < ntok; i += NTHREADS) { const int t = tokl[2 * i], cr = tokl[2 * i + 1], cls = cr >> 16; LIST[(size_t)cls * T + hist[32 + cls] + (cr & 0xffff)] = t; }
}

struct MoeItem { int cls, mtile, nt, cnt; };
DEVI void moe_prefix(const int* CNT, unsigned char* lds) {
  int* pre = (int*)(lds + LDS_BYTES + 64);
  hsync();
  if (HTID < 24) pre[32 + HTID] = CNT[HTID];
  hsync();
  if (HTID == 0) { int a = 0; for (int c = 0; c < 24; ++c) { pre[c] = a; a += (pre[32 + c] + 127) >> 7; } pre[24] = a; }
  hsync();
}
DEVI bool moe_item(unsigned char* lds, int it, MoeItem& m) {
  const int* pre = (const int*)(lds + LDS_BYTES + 64);
  const int mt = it >> 3; m.nt = it & 7;
  if (mt >= pre[24]) return false;
  int c = 0;
#pragma unroll
  for (int q = 1; q < 24; ++q) c += (mt >= pre[q]) ? 1 : 0;
  m.cls = c; m.mtile = mt - pre[c]; m.cnt = pre[32 + c];
  return true;
}
DEVI void cls_experts(int cls, int& e0, int& e1) {
  const int g = cls / 6, pi = cls % 6;
  const int lo = (pi < 3) ? 0 : ((pi < 5) ? 1 : 2);
  const int hi = (pi < 3) ? (pi + 1) : ((pi < 5) ? (pi - 1) : 3);
  e0 = g * 4 + lo; e1 = g * 4 + hi;
}
DEVI void phase_g5(const Params& p, int l, unsigned char* lds) {
  const bf16_t* XN = (const bf16_t*)(p.ws + WS_D);
  bf16_t* HID = (bf16_t*)(p.ws + WS_B);
  const bf16_t* WGU = (const bf16_t*)(p.ws + WS_W + l * WS_WL + W_GU);
  const int* CNT = (const int*)(p.ws + SM_CNT) + l * 32;
  const int* LIST = (const int*)(p.ws + SM_LIST);
  const float4* TOKW = (const float4*)(p.ws + SM_TOKW);
  moe_prefix(CNT, lds);
  const int G_ = VGRID, total_ = ((const int*)(lds + LDS_BYTES + 64))[24] * 8, full_ = (total_ / G_) * G_, rem_ = total_ - full_;
  for (int it = vblock(); it < full_ + 2 * rem_; it += G_) {
    const bool halfmode = it >= full_; const int half = (it - full_) & 1;
    MoeItem mi; if (!moe_item(lds, halfmode ? full_ + ((it - full_) >> 1) : it, mi)) break;
    int e0, e1; cls_experts(mi.cls, e0, e1);
    const int ex = (mi.nt < 4) ? e0 : e1, ntl = mi.nt & 3;
    const bf16_t* W = WGU + ((size_t)ex * 512 + ntl * 128) * 1024;
    const int* list = LIST + (size_t)mi.cls * T + mi.mtile * 128;
    const int nvalid = mi.cnt - mi.mtile * 128;
    if (halfmode) {
      f32x4 acc2[2][4];
      int tokA[4];
#pragma unroll
      for (int i = 0; i < 4; ++i) { const int r = (HTID >> 3) + 32 * i; tokA[i] = list[(r < nvalid) ? r : 0]; }
      const int tid = HTID, wid = tid >> 6, lane = tid & 63, fr = lane & 15, fq = lane >> 4;
      int tokE2[2]; float twE2[2], rsE2[2];
#pragma unroll
      for (int m = 0; m < 2; ++m) { const int er = wid * 32 + m * 16 + fr; tokE2[m] = list[(er < nvalid) ? er : 0]; }
#pragma unroll
      for (int m = 0; m < 2; ++m) { const float4 tw = TOKW[tokE2[m]]; twE2[m] = (mi.nt < 4) ? tw.x : tw.y; rsE2[m] = tw.z; }
      const bf16_t* Wh = W + (size_t)half * 64 * 1024;
      gemm128h(lds, D, [&](int r, int k) { const int i = r >> 5; const int tok = (i == 0) ? tokA[0] : (i == 1) ? tokA[1] : (i == 2) ? tokA[2] : tokA[3]; return XN + (size_t)tok * D + k; },
               [&](int r, int k) { return Wh + (size_t)r * D + k; }, acc2);
#pragma unroll
      for (int m = 0; m < 2; ++m) {
        const int er = wid * 32 + m * 16 + fr;
        if (er < nvalid) {
#pragma unroll
          for (int n = 0; n < 2; ++n) {
            f32x4 hv;
#pragma unroll
            for (int j = 0; j < 4; ++j) { const float gt = acc2[m][n][j] * rsE2[m], up = acc2[m][n + 2][j] * rsE2[m]; hv[j] = gt * sigmoidf_(gt) * up * twE2[m]; }
            st_bf16x4(HID + (size_t)tokE2[m] * 512 + (mi.nt < 4 ? 0 : 256) + ntl * 64 + half * 32 + n * 16 + fq * 4, hv);
          }
        }
      }
      continue;
    }
    f32x4 acc[4][4];
    int tokA[4], tokE[4]; float twE[4], rsE[4];
#pragma unroll
    for (int i = 0; i < 4; ++i) { const int r = (HTID >> 3) + 32 * i; tokA[i] = list[(r < nvalid) ? r : 0]; }
    {
      const int tid_ = HTID, er0 = ((tid_ >> 6) >> 1) * 64 + (tid_ & 15);
#pragma unroll
      for (int m = 0; m < 4; ++m) { const int er = er0 + m * 16; tokE[m] = list[(er < nvalid) ? er : 0]; }
#pragma unroll
      for (int m = 0; m < 4; ++m) { const float4 tw = TOKW[tokE[m]]; twE[m] = (mi.nt < 4) ? tw.x : tw.y; rsE[m] = tw.z; }
    }
    gemm128g(lds, D, [&](int r, int k) { const int i = r >> 5; const int tok = (i == 0) ? tokA[0] : (i == 1) ? tokA[1] : (i == 2) ? tokA[2] : tokA[3]; return XN + (size_t)tok * D + k; }, [&](int r, int k) { return W + (size_t)r * D + k; }, acc);
    {
      const int tid = HTID, wid = tid >> 6, lane = tid & 63, wr = wid >> 1, wc = wid & 1, fr = lane & 15, fq = lane >> 4;
#pragma unroll
      for (int m = 0; m < 4; ++m) {
        const int er = wr * 64 + m * 16 + fr;
        if (er < nvalid) {
          const int tok = tokE[m];
          const float w = twE[m], rsm = rsE[m];
#pragma unroll
          for (int n = 0; n < 2; ++n) {
            f32x4 hv;
#pragma unroll
            for (int j = 0; j < 4; ++j) { const float gt = acc[m][n][j] * rsm, up = acc[m][n + 2][j] * rsm; hv[j] = gt * sigmoidf_(gt) * up * w; }
            const int hh = (mi.nt < 4 ? 0 : 256) + ntl * 64 + wc * 32 + n * 16 + fq * 4;
            st_bf16x4(HID + (size_t)tok * 512 + hh, hv);
          }
        }
      }
    }
  }
}
DEVI void phase_g6(const Params& p, int l, unsigned char* lds) {
  const bf16_t* HID = (const bf16_t*)(p.ws + WS_B);
  const bf16_t* WDN = (const bf16_t*)(p.ws + WS_W + l * WS_WL + W_DN);
  const int* CNT = (const int*)(p.ws + SM_CNT) + l * 32;
  const int* LIST = (const int*)(p.ws + SM_LIST);
  float* out = p.out;
  bf16_t* out16 = (bf16_t*)p.out;
  const bf16_t* X1 = (const bf16_t*)(p.ws + WS_D);
  float* PART = (float*)(p.ws + WS_PART);
  moe_prefix(CNT, lds);
  const int G_ = VGRID, total_ = ((const int*)(lds + LDS_BYTES + 64))[24] * 8, full_ = (total_ / G_) * G_, rem_ = total_ - full_;
  for (int it = vblock(); it < full_ + 2 * rem_; it += G_) {
    const bool halfmode = it >= full_; const int half = (it - full_) & 1;
    MoeItem mi; if (!moe_item(lds, halfmode ? full_ + ((it - full_) >> 1) : it, mi)) break;
    int e0, e1; cls_experts(mi.cls, e0, e1);
    const int* list = LIST + (size_t)mi.cls * T + mi.mtile * 128;
    const int nvalid = mi.cnt - mi.mtile * 128;
    const bf16_t* W0 = WDN + ((size_t)e0 * 1024 + mi.nt * 128) * 256;
    const bf16_t* W1 = WDN + ((size_t)e1 * 1024 + mi.nt * 128) * 256;
    if (halfmode) {
      f32x4 acc2[2][4];
      int tokA[4];
#pragma unroll
      for (int i = 0; i < 4; ++i) { const int r = (HTID >> 3) + 32 * i; tokA[i] = list[(r < nvalid) ? r : 0]; }
      const int tid = HTID, wid = tid >> 6, lane = tid & 63, fr = lane & 15, fq = lane >> 4;
      int trow2[2];
#pragma unroll
      for (int m = 0; m < 2; ++m) { const int er = wid * 32 + m * 16 + fr; trow2[m] = list[(er < nvalid) ? er : 0]; }
      const bf16_t* W0h = W0 + (size_t)half * 64 * 256; const bf16_t* W1h = W1 + (size_t)half * 64 * 256;
      gemm128h(lds, 512, [&](int r, int k) { const int i = r >> 5; const int tok = (i == 0) ? tokA[0] : (i == 1) ? tokA[1] : (i == 2) ? tokA[2] : tokA[3]; return HID + (size_t)tok * 512 + k; },
               [&](int r, int k) { return ((k < 256) ? W0h : W1h) + (size_t)r * 256 + (k & 255); }, acc2);
      float ssq[2] = {0.f, 0.f};
      uint2 xres2[2][4];
#pragma unroll
      for (int m = 0; m < 2; ++m)
#pragma unroll
        for (int n = 0; n < 4; ++n) xres2[m][n] = *(const uint2*)(X1 + (size_t)trow2[m] * D + mi.nt * 128 + half * 64 + n * 16 + fq * 4);
#pragma unroll
      for (int m = 0; m < 2; ++m) {
        const int er = wid * 32 + m * 16 + fr;
        if (er < nvalid) {
#pragma unroll
          for (int n = 0; n < 4; ++n) {
            const size_t o = (size_t)trow2[m] * D + mi.nt * 128 + half * 64 + n * 16 + fq * 4;
            const uint2 xu = xres2[m][n];
            const f32x4 r4 = (f32x4){__uint_as_float(xu.x << 16), __uint_as_float(xu.x & 0xffff0000u), __uint_as_float(xu.y << 16), __uint_as_float(xu.y & 0xffff0000u)} + acc2[m][n];
            if (l == 0) { st_bf16x4(out16 + o, r4); ssq[m] += r4[0] * r4[0] + r4[1] * r4[1] + r4[2] * r4[2] + r4[3] * r4[3]; } else *(f32x4*)(out + o) = r4;
          }
        }
      }
      if (l == 0) {
#pragma unroll
        for (int m = 0; m < 2; ++m) { float q2 = ssq[m]; q2 += __shfl_xor(q2, 16); q2 += __shfl_xor(q2, 32); const int er = wid * 32 + m * 16 + fr; if (fq == 0 && er < nvalid) PART[(size_t)trow2[m] * 16 + mi.nt * 2 + half] = q2; }
      }
      continue;
    }
    f32x4 acc[4][4];
    int trow[4], tokA[4];
    {
      const int tid = HTID, wid = tid >> 6, lane = tid & 63, wr = wid >> 1, fr = lane & 15;
#pragma unroll
      for (int i = 0; i < 4; ++i) { const int r = (tid >> 3) + 32 * i; tokA[i] = list[(r < nvalid) ? r : 0]; }
#pragma unroll
      for (int m = 0; m < 4; ++m) { const int er = wr * 64 + m * 16 + fr; trow[m] = list[(er < nvalid) ? er : 0]; }
    }
    gemm128g(lds, 512, [&](int r, int k) { const int i = r >> 5; const int tok = (i == 0) ? tokA[0] : (i == 1) ? tokA[1] : (i == 2) ? tokA[2] : tokA[3]; return HID + (size_t)tok * 512 + k; },
            [&](int r, int k) { return ((k < 256) ? W0 : W1) + (size_t)r * 256 + (k & 255); }, acc);
    float ssq[4] = {0.f, 0.f, 0.f, 0.f};
    uint2 xres[4][4];
    GEMM_EPI4({ const size_t o = (size_t)trow[m] * D + mi.nt * 128 + ec0; xres[m][n] = *(const uint2*)(X1 + o); })
    GEMM_EPI4({ if (er < nvalid) { const size_t o = (size_t)trow[m] * D + mi.nt * 128 + ec0; const uint2 xu = xres[m][n];
      f32x4 r4; r4[0] = __uint_as_float(xu.x << 16) + ev4[0]; r4[1] = __uint_as_float(xu.x & 0xffff0000u) + ev4[1]; r4[2] = __uint_as_float(xu.y << 16) + ev4[2]; r4[3] = __uint_as_float(xu.y & 0xffff0000u) + ev4[3];
      if (l == 0) { st_bf16x4(out16 + o, r4); ssq[m] += r4[0] * r4[0] + r4[1] * r4[1] + r4[2] * r4[2] + r4[3] * r4[3]; } else *(f32x4*)(out + o) = r4; } })
    if (l == 0) {
      const int tid = HTID, wid = tid >> 6, lane = tid & 63, wr = wid >> 1, wc = wid & 1, fr = lane & 15, fq = lane >> 4;
#pragma unroll
      for (int m = 0; m < 4; ++m) { float q2 = ssq[m]; q2 += __shfl_xor(q2, 16); q2 += __shfl_xor(q2, 32); const int er = wr * 64 + m * 16 + fr; if (fq == 0 && er < nvalid) PART[(size_t)trow[m] * 16 + mi.nt * 2 + wc] = q2; }
    }
  }
}


#define XB_TMO      128
#define XB_XCNT(j)  (256  + 64 * (j))
#define XB_XSUB(j)  (1280 + 64 * (j))
#define XB_XGEN(j)  (2304 + 64 * (j))
#define XB_TOP      3328
#define XB_TOPGEN   3392
#define XCD_BAR_WORDS 3456
#define XB_SPIN_CAP (1u << 18)
DEVI unsigned xb_ld(unsigned* p)              { return __hip_atomic_load(p, __ATOMIC_RELAXED, __HIP_MEMORY_SCOPE_AGENT); }
DEVI unsigned xb_add(unsigned* p, unsigned v) { return __hip_atomic_fetch_add(p, v, __ATOMIC_RELAXED, __HIP_MEMORY_SCOPE_AGENT); }
DEVI unsigned xb_xcc_id() { return (unsigned)__builtin_amdgcn_s_getreg((3 << 11) | 20) & 0xFu; }
#define XB_SPIN(cond, bar) do { unsigned _sp = 0; while (cond) { __builtin_amdgcn_s_sleep(1); \
    if ((++_sp & 255u) == 0u) { if (xb_ld(&(bar)[XB_TMO])) break; if (_sp > XB_SPIN_CAP) { atomicAdd(&(bar)[XB_TMO], 1u); break; } } } } while (0)
struct XcdBarrier { unsigned* bar; unsigned x; volatile LAS unsigned* st; };
DEVI XcdBarrier xcd_barrier_post(unsigned* bar, volatile LAS unsigned* st) {
    XcdBarrier b; b.bar = bar; b.x = xb_xcc_id(); b.st = st;
    if (threadIdx.x == 0) (void)xb_add(&bar[XB_XCNT(b.x)], 1u);
    return b;
}
DEVI void xcd_barrier_complete(unsigned* bar, unsigned x, unsigned& nloc, unsigned& nx) {
    const unsigned G = gridDim.x * gridDim.y * gridDim.z;
    unsigned sum, cnt, mine, sp = 0u;
    for (;;) {
        sum = 0u; cnt = 0u; mine = 0u;
#pragma unroll
        for (unsigned j = 0; j < 16; ++j) { const unsigned c = xb_ld(&bar[XB_XCNT(j)]); sum += c; cnt += (c > 0u) ? 1u : 0u; mine = (j == x) ? c : mine; }
        if (sum == G) break;
        __builtin_amdgcn_s_sleep(1);
        if ((++sp & 255u) == 0u) { if (xb_ld(&bar[XB_TMO])) break; if (sp > XB_SPIN_CAP) { atomicAdd(&bar[XB_TMO], 1u); break; } }
    }
    nloc = mine > 0u ? mine : 1u; nx = cnt > 0u ? cnt : 1u;
}
DEVI void xcd_barrier(const XcdBarrier& b) {
    asm volatile("s_waitcnt vmcnt(0)" ::: "memory");
    __syncthreads();
    if (threadIdx.x == 0) {
        unsigned* bar = b.bar;
        __builtin_amdgcn_s_waitcnt(0);
        unsigned nloc = b.st[0], nx = b.st[1];
        if (nloc == 0u) { xcd_barrier_complete(bar, b.x, nloc, nx); b.st[0] = nloc; b.st[1] = nx; }
        const unsigned old = xb_add(&bar[XB_XSUB(b.x)], 1u);
        const unsigned gen = old / nloc;
        if (old + 1u == (gen + 1u) * nloc) {
            __builtin_amdgcn_fence(__ATOMIC_RELEASE, "agent");
            asm volatile("s_waitcnt vmcnt(0)" ::: "memory");
            const unsigned og = xb_add(&bar[XB_TOP], 1u);
            const unsigned tg = og / nx;
            if (og + 1u == (tg + 1u) * nx) xb_add(&bar[XB_TOPGEN], 1u);
            else XB_SPIN(xb_ld(&bar[XB_TOPGEN]) == tg, bar);
            __builtin_amdgcn_fence(__ATOMIC_ACQUIRE, "agent");
            xb_add(&bar[XB_XGEN(b.x)], 1u);
            asm volatile("s_waitcnt vmcnt(0)" ::: "memory");
        } else {
            XB_SPIN(xb_ld(&bar[XB_XGEN(b.x)]) == gen, bar);
            __builtin_amdgcn_fence(__ATOMIC_ACQUIRE, "agent");
            asm volatile("s_waitcnt vmcnt(0)" ::: "memory");
        }
    }
    __syncthreads();
}

#define PH(k, call) { const int _k = (k); if (p.lo <= _k && _k < p.hi) { call; if (_k + 1 < p.hi) { if (_k == 0) grid.sync(); else xcd_barrier(xbar); } } }
__global__ void __launch_bounds__(KTHREADS, 2) hybrid_fwd(Params p) {
  extern __shared__ __attribute__((aligned(16))) unsigned char lds_full[];
  unsigned char* lds = lds_full + hb_() * LDS_HALF;
  cg::grid_group grid = cg::this_grid();
  volatile LAS unsigned* xst = (volatile LAS unsigned*)(LAS unsigned char*)(lds_full + 2 * LDS_HALF);
  if (threadIdx.x < 4) { xst[threadIdx.x] = 0u; g_hs[threadIdx.x] = 0u; }
  __syncthreads();
  XcdBarrier xbar = xcd_barrier_post((unsigned*)(p.ws + WS_CTL), xst);
  PH(0, phase_prep(p, lds))
#define LAYER(l) { \
    PH(1 + 13 * l + 0, phase_g1(p, l, lds_full)) \
    PH(1 + 13 * l + 2, phase_g2(p, l, lds)) \
    PH(1 + 13 * l + 3, phase_r2(p, l, lds)) \
    PH(1 + 13 * l + 4, phase_a1(p, l, lds_full)) \
    PH(1 + 13 * l + 5, phase_r3(p, l, lds)) \
    PH(1 + 13 * l + 6, phase_g3(p, l, lds)) \
    PH(1 + 13 * l + 7, phase_r4(p, l)) \
    PH(1 + 13 * l + 8, phase_g4(p, l, lds_full)) \
    PH(1 + 13 * l + 9, phase_r5(p, l, lds)) \
    PH(1 + 13 * l + 10, phase_g5(p, l, lds)) \
    PH(1 + 13 * l + 11, phase_g6(p, l, lds)) }
  LAYER(0)
  LAYER(1)
}

extern "C" void kernel_launch(void* const* d_in, const int* in_sizes, int n_in, void* d_out, int out_size, void* d_ws, size_t ws_size, hipStream_t stream) {
  static int grid_blocks = 0;
  if (!grid_blocks) {
    if (n_in != 45 || ws_size < WS_END) { fprintf(stderr, "kernel_launch: unexpected n_in %d or ws_size %zu (< %zu)\n", n_in, ws_size, (size_t)WS_END); grid_blocks = -1; return; }
    int dev = 0, cus = 0, per_cu = 0;
    hipGetDevice(&dev);
    hipDeviceGetAttribute(&cus, hipDeviceAttributeMultiprocessorCount, dev);
    hipFuncSetAttribute((const void*)hybrid_fwd, hipFuncAttributeMaxDynamicSharedMemorySize, LDS_ALLOC);
    hipOccupancyMaxActiveBlocksPerMultiprocessor(&per_cu, (const void*)hybrid_fwd, KTHREADS, LDS_ALLOC);
    if (per_cu < 1) per_cu = 1;
    if (per_cu > 1) per_cu = 1;
    grid_blocks = cus * per_cu;
    fprintf(stderr, "kernel_launch: cus %d per_cu %d grid %d\n", cus, per_cu, grid_blocks);
  }
  if (grid_blocks < 0) return;
  static_assert(XCD_BAR_WORDS * 4 <= WS_QCTR, "control region layout");
  (void)hipMemsetAsync((unsigned char*)d_ws + WS_CTL, 0, WS_QCTR + NL * 16 * 4, stream);
  Params p{};
  for (int i = 0; i < 45; ++i) p.in[i] = (const float*)d_in[i];
  p.out = (float*)d_out; p.ws = (unsigned char*)d_ws;
#if N_LAUNCH_MODE == 1
  p.lo = 0; p.hi = NPH;
  { void* args[] = {&p}; hipError_t e = hipLaunchCooperativeKernel((void*)hybrid_fwd, dim3(grid_blocks), dim3(KTHREADS), args, LDS_ALLOC, stream);
    if (e != hipSuccess) fprintf(stderr, "cooperative launch failed: %s\n", hipGetErrorString(e)); }
#else
  for (int ph = 0; ph < NPH; ++ph) {
    p.lo = ph; p.hi = ph + 1;
    void* args[] = {&p}; hipError_t e = hipLaunchCooperativeKernel((void*)hybrid_fwd, dim3(grid_blocks), dim3(KTHREADS), args, LDS_ALLOC, stream);
    if (e != hipSuccess) { fprintf(stderr, "launch %d failed: %s\n", ph, hipGetErrorString(e)); break; }
  }
#endif
}
```

```cpp
#include <hip/hip_runtime.h>
#include <hip/hip_cooperative_groups.h>
#include <cstdio>
#include <cstdint>
namespace cg = cooperative_groups;

#ifndef N_LAUNCH_MODE
#define N_LAUNCH_MODE 1
#endif

#define DEVI __device__ __forceinline__

constexpr int KTHREADS = 512;
__shared__ unsigned g_hs[4];
#define HTID ((int)(threadIdx.x & 255))
__device__ __forceinline__ int hb_() { return __builtin_amdgcn_readfirstlane((int)(threadIdx.x >> 8)); }
#define VBID ((int)blockIdx.x * 2 + hb_())
#define VGRID ((int)gridDim.x * 2)
__device__ __forceinline__ void hsync() {
  asm volatile("s_waitcnt lgkmcnt(0)" ::: "memory");
  if ((threadIdx.x & 63) == 0) {
    unsigned* c = &g_hs[hb_()];
    const unsigned old = __hip_atomic_fetch_add(c, 1u, __ATOMIC_RELAXED, __HIP_MEMORY_SCOPE_WORKGROUP);
    const unsigned target = (old & ~3u) + 4u;
    if (old + 1u != target) {
      while ((int)(__hip_atomic_load(c, __ATOMIC_RELAXED, __HIP_MEMORY_SCOPE_WORKGROUP) - target) < 0) {}
    }
  }
  asm volatile("" ::: "memory");
}
typedef unsigned short bf16_t;
typedef short bf16x8 __attribute__((ext_vector_type(8)));
typedef float f32x4 __attribute__((ext_vector_type(4)));
typedef float f32x16 __attribute__((ext_vector_type(16)));
typedef unsigned u32x4 __attribute__((ext_vector_type(4)));
#define LAS __attribute__((address_space(3)))

constexpr int NB = 16, S = 2048, T = NB * S, D = 1024, DIN = 1772, DINP = 1792, NL = 2;
constexpr int C_CQ = 0, C_KPE = 192, C_NG = 224, C_T1 = 256, C_LX = 512, C_LG = 768, C_S5 = 1024, C_T5 = 1280, C_KC = 1536, C_VC = 1600, C_VS = 1664, C_VW = 1728;
__host__ __device__ constexpr int wgcol(int tile0, int wc, int e) { return tile0 + 128 * (e >> 5) + 32 * wc + (e & 31); }
__host__ __device__ constexpr int colmap(int n) {
  if (n < 192) return n;
  if (n < 320) { const int k = n - 192; return wgcol(C_T1, k >> 6, k & 63); }
  if (n < 352) return C_KPE + (n - 320);
  if (n < 608) return C_LX + (n - 352);
  if (n < 864) return C_LG + (n - 608);
  if (n < 1120) return C_S5 + (n - 864);
  if (n < 1376) { const int q = n - 1120; return wgcol(C_T5, q >> 6, q & 63); }
  if (n < 1760) { const int j = n - 1376, part = j >> 6, d = j & 63;
    return part == 0 ? C_KC + d : part == 1 ? C_VC + d : part == 2 ? wgcol(C_T1, 2, d) : part == 3 ? C_VS + d : part == 4 ? wgcol(C_T1, 3, d) : C_VW + d; }
  return C_NG + (n - 1760);
}
constexpr float EPS = 1e-6f;
constexpr float LOG2E = 1.4426950408889634f;
constexpr int NTHREADS = 256;
constexpr int NPH = 1 + 13 * NL - 1;

constexpr size_t MiB = 1u << 20;
constexpr size_t WS_CTL = 0;
constexpr size_t WS_SMALL = 1 * MiB;
constexpr size_t WS_W = 16 * MiB;
constexpr size_t WS_WL = 32 * MiB;
constexpr size_t WS_A = 80 * MiB;
constexpr size_t WS_B = 144 * MiB;
constexpr size_t WS_C = 256 * MiB;
constexpr size_t WS_D = 292 * MiB;
constexpr size_t WS_E = 348 * MiB;
constexpr size_t WS_F = 380 * MiB;
constexpr size_t WS_G = 428 * MiB;
constexpr size_t WS_ROPE = 452 * MiB;
constexpr size_t WS_PART = WS_ROPE + 6 * MiB;
constexpr size_t WS_END = 460 * MiB;
constexpr size_t W_IN = 0;
constexpr size_t W_OUT = 4 * MiB;
constexpr size_t W_UQ = 6 * MiB;
constexpr size_t W_UKV = W_UQ + 384 * 192 * 2;
constexpr size_t W_LRU = W_UKV + 512 * 128 * 2;
constexpr size_t W_GLU = W_LRU + 4 * 128 * 64 * 2;
constexpr size_t W_1K = 6 * MiB + 512 * 1024;
constexpr size_t W_1V = W_1K + 128 * 2048 * 2;
constexpr size_t W_B1K = W_1V + 128 * 2048 * 2;
constexpr size_t W_B1V = W_B1K + 512;
constexpr size_t W_S5A = W_B1V + 512;
constexpr size_t W_S5A64 = W_S5A + 16 * 64 * 8;
constexpr size_t W_S5B = W_S5A64 + 16 * 64 * 8;
constexpr size_t W_S5BB = W_S5B + 16 * 64 * 16 * 8;
constexpr size_t W_S5CM = W_S5BB + 16 * 4 * 32 * 16 * 2;
constexpr size_t W_2K = W_S5CM + 16 * 16 * 128 * 2;
constexpr size_t W_2V = W_2K + 64 * 128 * 2;
static_assert(W_2V + 64 * 128 * 2 <= 8 * MiB, "weights overflow");
constexpr size_t W_RTH = W_2V + 64 * 128 * 2;
constexpr size_t W_RTL = W_RTH + 32 * 1024 * 2;
static_assert(W_RTL + 32 * 1024 * 2 <= 8 * MiB, "weights overflow 2");
constexpr size_t W_GU = 8 * MiB;
constexpr size_t W_DN = 24 * MiB;
constexpr size_t SM_CNT = WS_SMALL;
constexpr size_t SM_LIST = WS_SMALL + 4096;
constexpr size_t SM_TOKW = SM_LIST + 24 * (size_t)T * 4;
constexpr size_t SM_LSUM = SM_TOKW + (size_t)T * 16;
constexpr size_t SM_SLOC = SM_LSUM + 16 * 32 * 256 * 8;
constexpr size_t SM_HK = SM_SLOC + 16 * 32 * 1024 * 8;
constexpr size_t SM_HV = SM_HK + 2048 * 128 * 2;
constexpr size_t SM_KC = SM_HV + 2048 * 128 * 2;
constexpr size_t SM_VC = SM_KC + 16 * 128 * 64 * 2;
constexpr size_t SM_SCAR = SM_VC + 16 * 128 * 64 * 2;
constexpr size_t SM_LCAR = SM_SCAR + 16 * 32 * 1024 * 8;
constexpr size_t SM_SSKV = SM_LCAR + 16 * 32 * 256 * 4;
constexpr size_t SM_END = SM_SSKV + (size_t)T * 2 * 4;
static_assert(SM_END <= WS_W, "small region overflow");

constexpr int LDS_BYTES = 65536;
constexpr int LDS_HALF = LDS_BYTES + 512;
constexpr int LDS_ALLOC = 2 * LDS_HALF + 64;

struct Params {
  const float* in[45];
  float* out;
  unsigned char* ws;
  int lo, hi;
};

DEVI float bf2f(bf16_t v) { return __uint_as_float(((unsigned)v) << 16); }
DEVI bf16_t f2bf(float f) { unsigned u = __float_as_uint(f); return (bf16_t)((u + 0x7fffu + ((u >> 16) & 1u)) >> 16); }
DEVI float wsum(float v) {
#pragma unroll
  for (int o = 32; o >= 1; o >>= 1) v += __shfl_xor(v, o);
  return v;
}
DEVI float sigmoidf_(float x) { return __builtin_amdgcn_rcpf(1.f + __expf(-x)); }
DEVI float gelu_tanh(float x) { const float u2 = 1.5957691216057308f * (x + 0.044715f * x * x * x); return x * __builtin_amdgcn_rcpf(1.f + __expf(-u2)); }
DEVI f32x16 mfma32(bf16x8 a, bf16x8 b, f32x16 c) { return __builtin_amdgcn_mfma_f32_32x32x16_bf16(a, b, c, 0, 0, 0); }
DEVI f32x4 mfma16(bf16x8 a, bf16x8 b, f32x4 c) { return __builtin_amdgcn_mfma_f32_16x16x32_bf16(a, b, c, 0, 0, 0); }
DEVI int vblock() { const int bx = (int)blockIdx.x, GB = (int)gridDim.x; return (GB % 8 == 0) ? (bx % 8) * (GB / 8) * 2 + (bx / 8) * 2 + hb_() : VBID; }
constexpr size_t WS_QCTR = 16384;
#define DYNQ_FETCH(qctr) int _nxt = 0; if (HTID == 0) _nxt = VGRID + (int)__hip_atomic_fetch_add((qctr), 1u, __ATOMIC_RELAXED, __HIP_MEMORY_SCOPE_AGENT);
#define DYNQ_NEXT(it, lds_) { int* _qs = (int*)((lds_) + LDS_BYTES + 448); if (HTID == 0) _qs[_qpar] = _nxt; hsync(); it = __builtin_amdgcn_readfirstlane(_qs[_qpar]); _qpar ^= 1; }
DEVI int crow(int r, int h) { return (r & 3) + 8 * (r >> 2) + 4 * h; }
typedef __bf16 bf16x2_t __attribute__((ext_vector_type(2)));
typedef float f32x2_t __attribute__((ext_vector_type(2)));
DEVI unsigned pk2bf(float lo, float hi) { f32x2_t v = {lo, hi}; bf16x2_t b = __builtin_convertvector(v, bf16x2_t); return __builtin_bit_cast(unsigned, b); }

template <class AF, class BF>
DEVI void gemm128(unsigned char* lds, int K, AF aload, BF bptr, f32x4 (&acc)[4][4]) {
  const int tid = HTID, wid = tid >> 6, lane = tid & 63, wr = wid >> 1, wc = wid & 1, fr = lane & 15, fq = lane >> 4;
#pragma unroll
  for (int m = 0; m < 4; ++m)
#pragma unroll
    for (int n = 0; n < 4; ++n) acc[m][n] = (f32x4){0.f, 0.f, 0.f, 0.f};
  const int lr = tid >> 3, ch = tid & 7;
  const int wofs = lr * 128 + ((ch ^ ((lr >> 1) & 7)) * 16);
  const int sw = (fr >> 1) & 7;
  const int aro = (wr * 64 + fr) * 128, bro = (wc * 64 + fr) * 128;
  const int nk = K >> 6;
  u32x4 ra[4], rb[4];
#pragma unroll
  for (int i = 0; i < 4; ++i) { ra[i] = aload(lr + 32 * i, ch * 8); rb[i] = *(const u32x4*)bptr(lr + 32 * i, ch * 8); }
  hsync();
#pragma unroll
  for (int i = 0; i < 4; ++i) { *(u32x4*)(lds + wofs + i * 4096) = ra[i]; *(u32x4*)(lds + 16384 + wofs + i * 4096) = rb[i]; }
  hsync();
  for (int kt = 0; kt < nk; ++kt) {
    const bool more = (kt + 1 < nk);
    if (more) {
      const int k = (kt + 1) * 64 + ch * 8;
#pragma unroll
      for (int i = 0; i < 4; ++i) { ra[i] = aload(lr + 32 * i, k); rb[i] = *(const u32x4*)bptr(lr + 32 * i, k); }
    }
    const unsigned char* bufA = lds + (kt & 1) * 32768;
    const unsigned char* bufB = bufA + 16384;
#pragma unroll
    for (int kk = 0; kk < 2; ++kk) {
      bf16x8 At[4], Bt[4];
      const int co = ((kk * 4 + fq) ^ sw) * 16;
#pragma unroll
      for (int m = 0; m < 4; ++m) At[m] = *(const bf16x8*)(bufA + aro + m * 2048 + co);
#pragma unroll
      for (int n = 0; n < 4; ++n) Bt[n] = *(const bf16x8*)(bufB + bro + n * 2048 + co);
#pragma unroll
      for (int m = 0; m < 4; ++m)
#pragma unroll
        for (int n = 0; n < 4; ++n) acc[m][n] = mfma16(Bt[n], At[m], acc[m][n]);
    }
    if (more) {
      unsigned char* nb = lds + ((kt + 1) & 1) * 32768;
#pragma unroll
      for (int i = 0; i < 4; ++i) { *(u32x4*)(nb + wofs + i * 4096) = ra[i]; *(u32x4*)(nb + 16384 + wofs + i * 4096) = rb[i]; }
    }
    hsync();
  }
}
template <class AF, class BF>
DEVI void gemm128g(unsigned char* lds, int K, AF aptr, BF bptr, f32x4 (&acc)[4][4]) {
  const int tid = HTID, wid = tid >> 6, lane = tid & 63, wr = wid >> 1, wc = wid & 1, fr = lane & 15, fq = lane >> 4;
#pragma unroll
  for (int m = 0; m < 4; ++m)
#pragma unroll
    for (int n = 0; n < 4; ++n) acc[m][n] = (f32x4){0.f, 0.f, 0.f, 0.f};
  const int lr = tid >> 3;
  const int chs = ((tid & 7) ^ ((lr >> 1) & 7)) * 8;
  const int sw = (fr >> 1) & 7;
  const int aro = (wr * 64 + fr) * 128, bro = (wc * 64 + fr) * 128;
  const int nk = K >> 6;
  LAS unsigned char* l3 = (LAS unsigned char*)lds;
#define G128_STAGE(buf, kbase)                                                                                                   \
  _Pragma("unroll") for (int i = 0; i < 4; ++i) {                                                                                 \
    __builtin_amdgcn_global_load_lds((const __attribute__((address_space(1))) unsigned*)aptr(lr + 32 * i, (kbase) + chs),          \
                                     (LAS unsigned*)(l3 + (buf) * 32768 + tid * 16 + i * 4096), 16, 0, 0);                           \
    __builtin_amdgcn_global_load_lds((const __attribute__((address_space(1))) unsigned*)bptr(lr + 32 * i, (kbase) + chs),          \
                                     (LAS unsigned*)(l3 + (buf) * 32768 + 16384 + tid * 16 + i * 4096), 16, 0, 0);                   \
  }
  hsync();
  G128_STAGE(0, 0)
  asm volatile("s_waitcnt vmcnt(0)" ::: "memory");
  hsync();
  for (int kt = 0; kt < nk; ++kt) {
    if (kt + 1 < nk) { G128_STAGE((kt + 1) & 1, (kt + 1) * 64) }
    const unsigned char* bufA = lds + (kt & 1) * 32768;
    const unsigned char* bufB = bufA + 16384;
#pragma unroll
    for (int kk = 0; kk < 2; ++kk) {
      bf16x8 At[4], Bt[4];
      const int co = ((kk * 4 + fq) ^ sw) * 16;
#pragma unroll
      for (int m = 0; m < 4; ++m) At[m] = *(const bf16x8*)(bufA + aro + m * 2048 + co);
#pragma unroll
      for (int n = 0; n < 4; ++n) Bt[n] = *(const bf16x8*)(bufB + bro + n * 2048 + co);
#pragma unroll
      for (int m = 0; m < 4; ++m)
#pragma unroll
        for (int n = 0; n < 4; ++n) acc[m][n] = mfma16(Bt[n], At[m], acc[m][n]);
    }
    asm volatile("s_waitcnt vmcnt(0)" ::: "memory");
    hsync();
  }
#undef G128_STAGE
}
DEVI void gemm128p(unsigned char* lds, int K, const bf16_t* Ab, size_t lda, const bf16_t* Bb, size_t ldb, f32x4 (&acc)[4][4], int& par, bool staged, bool has_next, const bf16_t* Abn, const bf16_t* Bbn) {
  const int tid = HTID, wid = tid >> 6, lane = tid & 63, wr = wid >> 1, wc = wid & 1, fr = lane & 15, fq = lane >> 4;
#pragma unroll
  for (int m = 0; m < 4; ++m)
#pragma unroll
    for (int n = 0; n < 4; ++n) acc[m][n] = (f32x4){0.f, 0.f, 0.f, 0.f};
  const int lr = tid >> 3;
  const int chs = ((tid & 7) ^ ((lr >> 1) & 7)) * 8;
  const int sw = (fr >> 1) & 7;
  const int aro = (wr * 64 + fr) * 128, bro = (wc * 64 + fr) * 128;
  const int nk = K >> 6;
  LAS unsigned char* l3 = (LAS unsigned char*)lds;
#define GP_STAGE(buf, kbase, APTR, BPTR)                                                                                             \
  _Pragma("unroll") for (int i = 0; i < 4; ++i) {                                                                                 \
    __builtin_amdgcn_global_load_lds((const __attribute__((address_space(1))) unsigned*)((APTR) + (size_t)(lr + 32 * i) * lda + (kbase) + chs),            \
                                     (LAS unsigned*)(l3 + (buf) * 32768 + tid * 16 + i * 4096), 16, 0, 0);                           \
    __builtin_amdgcn_global_load_lds((const __attribute__((address_space(1))) unsigned*)((BPTR) + (size_t)(lr + 32 * i) * ldb + (kbase) + chs),            \
                                     (LAS unsigned*)(l3 + (buf) * 32768 + 16384 + tid * 16 + i * 4096), 16, 0, 0);                   \
  }
  if (!staged) {
    hsync();
    GP_STAGE(par, 0, Ab, Bb)
    asm volatile("s_waitcnt vmcnt(0)" ::: "memory");
    hsync();
  }
  for (int kt = 0; kt < nk; ++kt) {
    const int cur = (par + kt) & 1;
    { const bool inner = kt + 1 < nk; if (inner || has_next) { const bf16_t* ap_ = inner ? Ab : Abn; const bf16_t* bp_ = inner ? Bb : Bbn; const int kb_ = inner ? (kt + 1) * 64 : 0; GP_STAGE(cur ^ 1, kb_, ap_, bp_) } }
    const unsigned char* bufA = lds + cur * 32768;
    const unsigned char* bufB = bufA + 16384;
#pragma unroll
    for (int kk = 0; kk < 2; ++kk) {
      bf16x8 At[4], Bt[4];
      const int co = ((kk * 4 + fq) ^ sw) * 16;
#pragma unroll
      for (int m = 0; m < 4; ++m) At[m] = *(const bf16x8*)(bufA + aro + m * 2048 + co);
#pragma unroll
      for (int n = 0; n < 4; ++n) Bt[n] = *(const bf16x8*)(bufB + bro + n * 2048 + co);
#pragma unroll
      for (int m = 0; m < 4; ++m)
#pragma unroll
        for (int n = 0; n < 4; ++n) acc[m][n] = mfma16(Bt[n], At[m], acc[m][n]);
    }
    asm volatile("s_waitcnt vmcnt(0)" ::: "memory");
    hsync();
  }
  par = (par + nk) & 1;
#undef GP_STAGE
}
template <class AF, class BF>
DEVI void gemm128h(unsigned char* lds, int K, AF aptr, BF bptr, f32x4 (&acc)[2][4]) {
  const int tid = HTID, wid = tid >> 6, lane = tid & 63, fr = lane & 15, fq = lane >> 4;
#pragma unroll
  for (int m = 0; m < 2; ++m)
#pragma unroll
    for (int n = 0; n < 4; ++n) acc[m][n] = (f32x4){0.f, 0.f, 0.f, 0.f};
  const int lr = tid >> 3;
  const int chs = ((tid & 7) ^ ((lr >> 1) & 7)) * 8;
  const int sw = (fr >> 1) & 7;
  const int aro = (wid * 32 + fr) * 128, bro = fr * 128;
  const int nk = K >> 6;
  LAS unsigned char* l3 = (LAS unsigned char*)lds;
#define GH_STAGE(buf, kbase)                                                                                                     \
  { _Pragma("unroll") for (int i = 0; i < 4; ++i)                                                                                 \
      __builtin_amdgcn_global_load_lds((const __attribute__((address_space(1))) unsigned*)aptr(lr + 32 * i, (kbase) + chs),        \
                                       (LAS unsigned*)(l3 + (buf) * 32768 + tid * 16 + i * 4096), 16, 0, 0);                         \
    _Pragma("unroll") for (int i = 0; i < 2; ++i)                                                                                 \
      __builtin_amdgcn_global_load_lds((const __attribute__((address_space(1))) unsigned*)bptr(lr + 32 * i, (kbase) + chs),        \
                                       (LAS unsigned*)(l3 + (buf) * 32768 + 16384 + tid * 16 + i * 4096), 16, 0, 0); }
  hsync();
  GH_STAGE(0, 0)
  asm volatile("s_waitcnt vmcnt(0)" ::: "memory");
  hsync();
  for (int kt = 0; kt < nk; ++kt) {
    if (kt + 1 < nk) { GH_STAGE((kt + 1) & 1, (kt + 1) * 64) }
    const unsigned char* bufA = lds + (kt & 1) * 32768;
    const unsigned char* bufB = bufA + 16384;
#pragma unroll
    for (int kk = 0; kk < 2; ++kk) {
      bf16x8 At[2], Bt[4];
      const int co = ((kk * 4 + fq) ^ sw) * 16;
#pragma unroll
      for (int m = 0; m < 2; ++m) At[m] = *(const bf16x8*)(bufA + aro + m * 2048 + co);
#pragma unroll
      for (int n = 0; n < 4; ++n) Bt[n] = *(const bf16x8*)(bufB + bro + n * 2048 + co);
#pragma unroll
      for (int m = 0; m < 2; ++m)
#pragma unroll
        for (int n = 0; n < 4; ++n) acc[m][n] = mfma16(Bt[n], At[m], acc[m][n]);
    }
    asm volatile("s_waitcnt vmcnt(0)" ::: "memory");
    hsync();
  }
#undef GH_STAGE
}
#define GEMM_EPI_LOOP(body)                                                                 \
  {                                                                                         \
    const int _tid = HTID, _wid = _tid >> 6, _lane = _tid & 63, _wr = _wid >> 1, _wc = _wid & 1, _fr = _lane & 15, _fq = _lane >> 4; \
    _Pragma("unroll") for (int m = 0; m < 4; ++m) _Pragma("unroll") for (int n = 0; n < 4; ++n) _Pragma("unroll") for (int j = 0; j < 4; ++j) { \
      const int er = _wr * 64 + m * 16 + _fr, ec = _wc * 64 + n * 16 + _fq * 4 + j; const float ev = acc[m][n][j]; body }                      \
  }
#define GEMM_EPI4(body)                                                                     \
  {                                                                                         \
    const int _tid = HTID, _wid = _tid >> 6, _lane = _tid & 63, _wr = _wid >> 1, _wc = _wid & 1, _fr = _lane & 15, _fq = _lane >> 4; \
    _Pragma("unroll") for (int m = 0; m < 4; ++m) _Pragma("unroll") for (int n = 0; n < 4; ++n) {                                             \
      const int er = _wr * 64 + m * 16 + _fr, ec0 = _wc * 64 + n * 16 + _fq * 4; const f32x4 ev4 = acc[m][n]; body }                          \
  }
DEVI f32x4 ld_bf16x4(const bf16_t* p) { const uint2 u = *(const uint2*)p; return (f32x4){__uint_as_float(u.x << 16), __uint_as_float(u.x & 0xffff0000u), __uint_as_float(u.y << 16), __uint_as_float(u.y & 0xffff0000u)}; }
DEVI void st_bf16x4(bf16_t* p, f32x4 v) { uint2 o; o.x = pk2bf(v[0], v[1]); o.y = pk2bf(v[2], v[3]); *(uint2*)p = o; }

namespace pg8 {
#define PG8_LAS __attribute__((address_space(3)))
typedef unsigned short bf16_t;
typedef short bf16x8 __attribute__((ext_vector_type(8)));
typedef float f32x4 __attribute__((ext_vector_type(4)));
typedef unsigned u32x4 __attribute__((ext_vector_type(4)));
constexpr int BM = 256, BK = 64, HALF = 128, HTB = HALF * BK * 2  , STAGE_BYTES = 8 * HTB, NXCD = 8, WGM = 8;

__host__ __device__ __forceinline__ int lds_byte(int r, int c) { const int st = (r >> 4) * 2 + (c >> 5), rr = r & 15, cc = c & 31, ob = rr * 64 + cc * 2; return st * 1024 + (ob ^ (((ob >> 9) & 1) << 5)); }
__host__ __device__ __forceinline__ void stage_rc(int b, int& R, int& C) { const int st = b / 1024, sb = b % 1024, swz = sb ^ (((sb >> 9) & 1) << 5); R = (st >> 1) * 16 + swz / 64; C = (st & 1) * 32 + (swz % 64) / 2; }
__host__ __device__ __forceinline__ int perm32(int rho) { const int n = rho >> 4, i = rho & 15; return 8 * (i >> 2) + 4 * n + (i & 3); }

struct Unit { int pm, pn; };
struct Gemm { const bf16_t* A; const bf16_t* Bt; int M, N, K; };

struct StaticOrder {
    int nM, nN, nwg, G, c;
    __host__ __device__ void init(int M, int N, int G_, int c_) { nM = M / BM; nN = N / BM; nwg = nM * nN; G = G_; c = c_; }
    __host__ __device__ bool next(int i, Unit& u) const {
        const long L = (long)i * G + c; if (L >= nwg) return false;
        int wgid = (int)L; { const int q = nwg / NXCD, r = nwg % NXCD, xcd = wgid % NXCD, off = wgid / NXCD; wgid = (xcd < r ? xcd * (q + 1) : r * (q + 1) + (xcd - r) * q) + off; }
        const int nig = WGM * nN, gid = wgid / nig, fm = gid * WGM, gsz = (nM - fm) < WGM ? (nM - fm) : WGM;
        u.pm = fm + ((wgid % nig) % gsz); u.pn = (wgid % nig) / gsz; return true;
    }
    __device__ __forceinline__ void a_ready(const Unit&) const {}
    __device__ __forceinline__ void done(const Unit&) const {}
};

__device__ __forceinline__ unsigned cvt_pk_bf16(float lo, float hi) { unsigned r; asm volatile("v_cvt_pk_bf16_f32 %0, %1, %2" : "=v"(r) : "v"(lo), "v"(hi)); return r; }
typedef float f32x2 __attribute__((ext_vector_type(2)));
__device__ __forceinline__ f32x2 gelu_pk(f32x2 v) {
    const f32x2 av = __builtin_elementwise_abs(v), d = av * 0.2316418882f + 1.0f;
    f32x2 t; t.x = __builtin_amdgcn_rcpf(d.x); t.y = __builtin_amdgcn_rcpf(d.y);
    f32x2 q = t * 0.5307027145f + (-0.7265760135f); q = q * t + 0.7107068705f; q = q * t + (-0.142248368f); q = q * t + 0.127414796f; q = q * t;
    const f32x2 s = (v * v) * (-0.72134752044f);
    f32x2 e; e.x = __builtin_amdgcn_exp2f(s.x); e.y = __builtin_amdgcn_exp2f(s.y);
    const f32x2 m = v * (q * e), r = v - m;
    f32x2 o; o.x = v.x < 0.f ? m.x : r.x; o.y = v.y < 0.f ? m.y : r.y; return o;
}

template <int ACT  > struct EpiBf16 {
    static constexpr bool PERM = true, AFTER_DRAIN = false; static_assert(ACT == 0 || ACT == 1, "EpiBf16: ACT is 0 (none) or 1 (gelu_pk)");
    bf16_t* O; int ldc; const float* bias; int split_cols; size_t split_stride; float scale0;
    __device__ __forceinline__ void operator()(const f32x4 (&acc)[2][2][4][2], const Unit& u, int wr, int wc, int fr, int fq) const {
        const int row0 = u.pm * BM + wr * 64 + fr; int colt = u.pn * BM; bf16_t* base = O;
        float sc = 1.f; if (split_cols) { const int t = colt / split_cols; base += (size_t)t * split_stride; colt -= t * split_cols; if (t == 0) sc = scale0; }
        const int col0 = colt + wc * 32 + 8 * fq, bcol0 = u.pn * BM + wc * 32 + 8 * fq;
        f32x4 bv[2][2];
#pragma unroll
        for (int bj = 0; bj < 2; ++bj)
#pragma unroll
            for (int n = 0; n < 2; ++n) bv[bj][n] = bias ? *(const f32x4*)(bias + bcol0 + bj * HALF + 4 * n) : (f32x4){0.f, 0.f, 0.f, 0.f};
#pragma unroll
        for (int ai = 0; ai < 2; ++ai)
#pragma unroll
            for (int m = 0; m < 4; ++m) { bf16_t* rowp = base + (size_t)(row0 + ai * HALF + m * 16) * ldc + col0;
#pragma unroll
                for (int bj = 0; bj < 2; ++bj) { f32x4 v0 = acc[ai][bj][m][0] + bv[bj][0], v1 = acc[ai][bj][m][1] + bv[bj][1];
                    if (ACT == 1) { f32x2 a = gelu_pk((f32x2){v0[0], v0[1]}), b = gelu_pk((f32x2){v0[2], v0[3]}), c = gelu_pk((f32x2){v1[0], v1[1]}), d = gelu_pk((f32x2){v1[2], v1[3]});
                        v0 = (f32x4){a.x, a.y, b.x, b.y}; v1 = (f32x4){c.x, c.y, d.x, d.y}; }
                    v0 = v0 * sc; v1 = v1 * sc; u32x4 w; w.x = cvt_pk_bf16(v0[0], v0[1]); w.y = cvt_pk_bf16(v0[2], v0[3]); w.z = cvt_pk_bf16(v1[0], v1[1]); w.w = cvt_pk_bf16(v1[2], v1[3]);
                    *(u32x4*)(rowp + bj * HALF) = w; } }
    }
};

template <class Epi, class Sched, bool ALIGN_EPI = false, bool SP2 = false>
__device__ __forceinline__ void gemm_phase(PG8_LAS unsigned char* lds, const Gemm g, const Sched& S, const Epi& E) {
    const int tid = threadIdx.x, wid = __builtin_amdgcn_readfirstlane(tid >> 6), lane = tid & 63, wr = wid >> 2, wc = wid & 3, fr = lane & 15, fq = lane >> 4;
    const int K = g.K, nt = K / BK;
    unsigned voffA[2], voffB[2];
#pragma unroll
    for (int i = 0; i < 2; ++i) { int R, C; stage_rc(tid * 16 + i * 8192, R, C); const int Rb = Epi::PERM ? ((R & ~31) + perm32(R & 31)) : R;
        voffA[i] = (unsigned)(R * K + C) * 2u; voffB[i] = (unsigned)(Rb * K + C) * 2u; }
    const size_t kstep = (size_t)(BK * 2);
    const size_t hstep = (size_t)HALF * K * 2;
    const size_t tstep = 2 * hstep;
    const unsigned ldsw = (unsigned)wid * 1024u;
    const int aoff = lds_byte(wr * 64 + fr, fq * 8), boff = lds_byte(wc * 32 + fr, fq * 8);
#define PG8_SA(b, h) (((b) * 2 + (h)) * HTB)
#define PG8_SB(b, h) ((4 + (b) * 2 + (h)) * HTB)
#define PG8_STAGE(bufoff, gbase, voff) do { _Pragma("unroll") for (int _i = 0; _i < 2; ++_i) \
        __builtin_amdgcn_global_load_lds((const unsigned*)((const char*)(gbase) + (voff)[_i]), (PG8_LAS unsigned*)(lds + (bufoff) + ldsw + _i * 8192), 16, 0, 0); } while (0)
#define PG8_LDA(dst, b, h) do { _Pragma("unroll") for (int m = 0; m < 4; ++m) _Pragma("unroll") for (int k = 0; k < 2; ++k) dst[m][k] = *(const PG8_LAS bf16x8*)(lds + PG8_SA(b, h) + aoff + m * 2048 + k * 1024); } while (0)
#define PG8_LDB(dst, b, h) do { _Pragma("unroll") for (int n = 0; n < 2; ++n) _Pragma("unroll") for (int k = 0; k < 2; ++k) dst[n][k] = *(const PG8_LAS bf16x8*)(lds + PG8_SB(b, h) + boff + n * 2048 + k * 1024); } while (0)
#define PG8_MMA(ai, bj, At, Bt) do { __builtin_amdgcn_s_setprio(1); _Pragma("unroll") for (int m = 0; m < 4; ++m) _Pragma("unroll") for (int n = 0; n < 2; ++n) _Pragma("unroll") for (int k = 0; k < 2; ++k) \
        acc[ai][bj][m][n] = __builtin_amdgcn_mfma_f32_16x16x32_bf16(Bt[n][k], At[m][k], acc[ai][bj][m][n], 0, 0, 0); __builtin_amdgcn_s_setprio(0); } while (0)
#define PG8_WAIT_V(n) asm volatile("s_waitcnt vmcnt(" #n ")" ::: "memory")
#define PG8_WAIT_L(n) asm volatile("s_waitcnt lgkmcnt(" #n ")" ::: "memory")
#define PG8_BAR __builtin_amdgcn_s_barrier()
#define PG8_SCHED __builtin_amdgcn_sched_barrier(0)
    Unit cur, nxt; int ui = 0;
    if (!S.next(0, cur)) return;
    f32x4 acc[2][2][4][2];
#pragma unroll
    for (int a = 0; a < 2; ++a)
#pragma unroll
        for (int b = 0; b < 2; ++b)
#pragma unroll
            for (int m = 0; m < 4; ++m)
#pragma unroll
                for (int n = 0; n < 2; ++n) acc[a][b][m][n] = (f32x4){0.f, 0.f, 0.f, 0.f};
    bf16x8 At[4][2], B0[2][2], B1[2][2];
    const char* cA = (const char*)g.A + (size_t)cur.pm * tstep; const char* cB = (const char*)g.Bt + (size_t)cur.pn * tstep;
    S.a_ready(cur);
    if constexpr (SP2) {
        PG8_STAGE(PG8_SB(0, 0), cB, voffB); PG8_STAGE(PG8_SB(0, 1), cB + hstep, voffB); PG8_STAGE(PG8_SA(0, 0), cA, voffA); PG8_STAGE(PG8_SA(0, 1), cA + hstep, voffA);
        if (wr == 1) PG8_BAR;
        PG8_WAIT_V(2); PG8_BAR;
        PG8_STAGE(PG8_SB(1, 0), cB + kstep, voffB); PG8_STAGE(PG8_SA(1, 0), cA + kstep, voffA); PG8_STAGE(PG8_SB(1, 1), cB + hstep + kstep, voffB);
        PG8_WAIT_V(6); PG8_BAR;
    } else {
        PG8_STAGE(PG8_SB(0, 0), cB, voffB); PG8_STAGE(PG8_SA(0, 0), cA, voffA); PG8_STAGE(PG8_SB(0, 1), cB + hstep, voffB); PG8_STAGE(PG8_SA(0, 1), cA + hstep, voffA);
        if (wr == 1) PG8_BAR;
        PG8_WAIT_V(4); PG8_BAR;
        PG8_STAGE(PG8_SB(1, 0), cB + kstep, voffB); PG8_STAGE(PG8_SA(1, 0), cA + kstep, voffA); PG8_STAGE(PG8_SB(1, 1), cB + hstep + kstep, voffB);
        PG8_WAIT_V(6); PG8_BAR;
    }
    for (;;) {
        const bool has_next = S.next(ui + 1, nxt);
        const char* nA = has_next ? (const char*)g.A + (size_t)nxt.pm * tstep : cA; const char* nB = has_next ? (const char*)g.Bt + (size_t)nxt.pn * tstep : cB;
        for (int t = 0; t < nt; t += 2) {
            const bool last = (t == nt - 2);
            const char* a1 = cA + (size_t)(t + 1) * kstep;
            const char* a2 = last ? nA : cA + (size_t)(t + 2) * kstep; const char* b2 = last ? nB : cB + (size_t)(t + 2) * kstep;
            const char* a3 = a2 + kstep; const char* b3 = b2 + kstep;
            if (last && has_next) S.a_ready(nxt);
            if constexpr (SP2) {
            PG8_LDB(B0, 0, 0); PG8_LDB(B1, 0, 1); PG8_SCHED; PG8_LDA(At, 0, 0); PG8_STAGE(PG8_SA(1, 1), a1 + hstep, voffA);
            PG8_WAIT_V(8); PG8_WAIT_L(0); PG8_BAR; PG8_MMA(0, 0, At, B0); PG8_MMA(0, 1, At, B1); PG8_BAR; PG8_SCHED;
            PG8_LDA(At, 0, 1); PG8_STAGE(PG8_SB(0, 0), b2, voffB); PG8_STAGE(PG8_SB(0, 1), b2 + hstep, voffB); PG8_STAGE(PG8_SA(0, 0), a2, voffA);
            PG8_WAIT_V(8); PG8_WAIT_L(0); PG8_BAR; PG8_MMA(1, 0, At, B0); PG8_MMA(1, 1, At, B1); PG8_BAR; PG8_SCHED;
            PG8_LDB(B0, 1, 0); PG8_LDB(B1, 1, 1); PG8_SCHED; PG8_LDA(At, 1, 0); PG8_STAGE(PG8_SA(0, 1), a2 + hstep, voffA);
            PG8_WAIT_V(8); PG8_WAIT_L(0); PG8_BAR; PG8_MMA(0, 0, At, B0); PG8_MMA(0, 1, At, B1); PG8_BAR; PG8_SCHED;
            PG8_LDA(At, 1, 1); PG8_STAGE(PG8_SB(1, 0), b3, voffB); PG8_STAGE(PG8_SB(1, 1), b3 + hstep, voffB); PG8_STAGE(PG8_SA(1, 0), a3, voffA);
            PG8_WAIT_V(8); PG8_WAIT_L(0); PG8_BAR; PG8_MMA(1, 0, At, B0); PG8_MMA(1, 1, At, B1); PG8_BAR; PG8_SCHED;
            } else {
            PG8_LDB(B0, 0, 0); PG8_SCHED; PG8_LDA(At, 0, 0); PG8_STAGE(PG8_SA(1, 1), a1 + hstep, voffA);
            PG8_WAIT_L(8); PG8_BAR; PG8_WAIT_L(0); PG8_MMA(0, 0, At, B0); PG8_BAR; PG8_SCHED;
            PG8_LDB(B1, 0, 1); PG8_STAGE(PG8_SB(0, 0), b2, voffB);
            PG8_BAR; PG8_WAIT_L(0); PG8_MMA(0, 1, At, B1); PG8_BAR;
            PG8_LDA(At, 0, 1); PG8_STAGE(PG8_SA(0, 0), a2, voffA);
            PG8_BAR; PG8_WAIT_L(0); PG8_MMA(1, 0, At, B0); PG8_BAR; PG8_SCHED;
            PG8_STAGE(PG8_SB(0, 1), b2 + hstep, voffB);
            PG8_WAIT_V(6); PG8_BAR; PG8_MMA(1, 1, At, B1); PG8_BAR;
            PG8_LDB(B0, 1, 0); PG8_SCHED; PG8_LDA(At, 1, 0); PG8_STAGE(PG8_SA(0, 1), a2 + hstep, voffA);
            PG8_WAIT_L(8); PG8_BAR; PG8_WAIT_L(0); PG8_MMA(0, 0, At, B0); PG8_BAR; PG8_SCHED;
            PG8_LDB(B1, 1, 1); PG8_STAGE(PG8_SB(1, 0), b3, voffB);
            PG8_BAR; PG8_WAIT_L(0); PG8_MMA(0, 1, At, B1); PG8_BAR;
            PG8_LDA(At, 1, 1); PG8_STAGE(PG8_SA(1, 0), a3, voffA);
            PG8_BAR; PG8_WAIT_L(0); PG8_MMA(1, 0, At, B0); PG8_BAR; PG8_SCHED;
            PG8_STAGE(PG8_SB(1, 1), b3 + hstep, voffB);
            PG8_WAIT_V(6); PG8_BAR; PG8_MMA(1, 1, At, B1); PG8_BAR;
            }
        }
        if constexpr (ALIGN_EPI) { if (wr == 0) PG8_BAR; }
        if constexpr (!Epi::AFTER_DRAIN) { E(acc, cur, wr, wc, fr, fq); S.done(cur); }
        if (!has_next) break;
#pragma unroll
        for (int a = 0; a < 2; ++a)
#pragma unroll
            for (int b = 0; b < 2; ++b)
#pragma unroll
                for (int m = 0; m < 4; ++m)
#pragma unroll
                    for (int n = 0; n < 2; ++n) acc[a][b][m][n] = (f32x4){0.f, 0.f, 0.f, 0.f};
        cur = nxt; cA = nA; cB = nB; ++ui;
        if constexpr (ALIGN_EPI) { if (wr == 1) PG8_BAR; }
    }
    PG8_WAIT_V(0);
    if constexpr (!ALIGN_EPI) { if (wr == 0) PG8_BAR; }
    PG8_BAR;
    if constexpr (Epi::AFTER_DRAIN) { E.fused(acc, cur, wr, wc, fr, fq, lds, wid, lane); S.done(cur); }
#undef PG8_SA
#undef PG8_SB
#undef PG8_STAGE
#undef PG8_LDA
#undef PG8_LDB
#undef PG8_MMA
#undef PG8_WAIT_V
#undef PG8_WAIT_L
#undef PG8_BAR
#undef PG8_SCHED
}
}

struct EpiG1 {
  static constexpr bool PERM = false, AFTER_DRAIN = false;
  bf16_t* PROJ; bf16_t* QN; bf16_t* KS; bf16_t* KW; float* SSKV; const float2* RN; const float* g_q; const float* g_k; const float* part;
  __device__ __forceinline__ void operator()(const pg8::f32x4 (&acc0)[2][2][4][2], const pg8::Unit& u, int wr, int wc, int fr, int fq) const {
    const bool t1 = (u.pn == 1), t5 = (u.pn == 5);
    float rs8[2][4];
    {
      float4 pq[2][4];
#pragma unroll
      for (int ai = 0; ai < 2; ++ai)
#pragma unroll
        for (int m = 0; m < 4; ++m) pq[ai][m] = ((const float4*)(part + ((size_t)u.pm * 256 + ai * 128 + wr * 64 + m * 16 + fr) * 16))[fq];
#pragma unroll
      for (int ai = 0; ai < 2; ++ai)
#pragma unroll
        for (int m = 0; m < 4; ++m) { float q = (pq[ai][m].x + pq[ai][m].y) + (pq[ai][m].z + pq[ai][m].w); q += __shfl_xor(q, 16); q += __shfl_xor(q, 32); rs8[ai][m] = rsqrtf(q * (1.f / D) + EPS); }
    }
#pragma unroll
    for (int ai = 0; ai < 2; ++ai)
#pragma unroll
      for (int m = 0; m < 4; ++m) {
        const size_t t = (size_t)u.pm * 256 + ai * 128 + wr * 64 + m * 16 + fr;
        const float rsr = rs8[ai][m];
        pg8::f32x4 acc[1][2][1][2];
#pragma unroll
        for (int bj = 0; bj < 2; ++bj)
#pragma unroll
          for (int n = 0; n < 2; ++n) acc[0][bj][0][n] = acc0[ai][bj][m][n] * rsr;
        if (!(t1 || t5) || (t1 && wc < 2)) {
#pragma unroll
          for (int bj = 0; bj < 2; ++bj)
#pragma unroll
            for (int n = 0; n < 2; ++n) st_bf16x4(PROJ + t * DINP + u.pn * 256 + bj * 128 + wc * 32 + n * 16 + fq * 4, acc[0][bj][0][n]);
        }
        if (t1 || t5) {
          float ss = 0.f;
#pragma unroll
          for (int bj = 0; bj < 2; ++bj)
#pragma unroll
            for (int n = 0; n < 2; ++n) { const pg8::f32x4 v = acc[0][bj][0][n]; ss += v[0] * v[0] + v[1] * v[1] + v[2] * v[2] + v[3] * v[3]; }
          ss += __shfl_xor(ss, 16); ss += __shfl_xor(ss, 32);
          if (t1 && wc < 2) { if (fq == 0) SSKV[t * 2 + wc] = ss; }
          else {
            const float rs = rsqrtf(ss * (1.f / 64) + EPS);
            const float* gg = t5 ? g_q : (g_k + (wc == 2 ? 64 : 128));
            const float sc = t5 ? (0.125f * LOG2E) : 1.f;
            bf16_t* dst = t5 ? (QN + t * 256 + wc * 64) : ((wc == 2 ? KS : KW) + t * 64);
#pragma unroll
            for (int bj = 0; bj < 2; ++bj)
#pragma unroll
              for (int n = 0; n < 2; ++n) {
                const int e0 = 32 * bj + 16 * n + 4 * fq;
                const float4 g4 = *(const float4*)(gg + e0);
                pg8::f32x4 v = acc[0][bj][0][n];
                v[0] *= rs * g4.x; v[1] *= rs * g4.y; v[2] *= rs * g4.z; v[3] *= rs * g4.w;
                if (bj == 0 && n == 0) {
#pragma unroll
                  for (int j = 0; j < 4; ++j) {
                    const float x = v[j], partner = __shfl_xor(x, 32);
                    const int d = fq * 4 + j; const float2 cs2 = RN[t * 8 + (d & 7)];
                    v[j] = (d < 8) ? (x * cs2.x - partner * cs2.y) : (partner * cs2.y + x * cs2.x);
                  }
                }
                st_bf16x4(dst + e0, v * sc);
              }
          }
        }
      }
  }
};

template <bool IN16> struct EpiRes {
  static constexpr bool PERM = false, AFTER_DRAIN = false;
  const float* xin; const bf16_t* xin16; bf16_t* out;
  __device__ __forceinline__ void operator()(const pg8::f32x4 (&acc)[2][2][4][2], const pg8::Unit& u, int wr, int wc, int fr, int fq) const {
#pragma unroll
    for (int ai = 0; ai < 2; ++ai) {
      f32x4 xi[4][2][2];
#pragma unroll
      for (int m = 0; m < 4; ++m)
#pragma unroll
        for (int bj = 0; bj < 2; ++bj)
#pragma unroll
          for (int n = 0; n < 2; ++n) {
            const size_t o = ((size_t)u.pm * 256 + ai * 128 + wr * 64 + m * 16 + fr) * 1024 + u.pn * 256 + bj * 128 + wc * 32 + n * 16 + fq * 4;
            if constexpr (IN16) xi[m][bj][n] = ld_bf16x4(xin16 + o); else xi[m][bj][n] = *(const f32x4*)(xin + o);
          }
#pragma unroll
      for (int m = 0; m < 4; ++m)
#pragma unroll
        for (int bj = 0; bj < 2; ++bj)
#pragma unroll
          for (int n = 0; n < 2; ++n) {
            const size_t o = ((size_t)u.pm * 256 + ai * 128 + wr * 64 + m * 16 + fr) * 1024 + u.pn * 256 + bj * 128 + wc * 32 + n * 16 + fq * 4;
            st_bf16x4(out + o, xi[m][bj][n] + acc[ai][bj][m][n]);
          }
    }
  }
};

template <class RM>
DEVI void transpose_tiles(const float* src, int K, int N, bf16_t* dst, int ldk, RM rowmap, unsigned char* lds, int& cursor, const float* kscale = nullptr) {
  float* tl = (float*)lds;
  const int tk = K / 64, tn = (N + 63) / 64, nt = tk * tn;
  const int tid = HTID;
  const int G_ = VGRID;
  for (int it = (VBID - cursor % G_ + G_) % G_; it < nt; it += G_) {
    const int kt = it / tn, ntile = it % tn, k0 = kt * 64, n0 = ntile * 64;
    hsync();
#pragma unroll
    for (int q = 0; q < 4; ++q) {
      const int r = (tid >> 4) + 16 * q, c4 = (tid & 15) * 4;
      const float* sp = src + (size_t)(k0 + r) * N + n0 + c4;
      float4 v;
      if (n0 + c4 + 3 < N) v = *(const float4*)sp;
      else { v.x = (n0 + c4 < N) ? sp[0] : 0.f; v.y = (n0 + c4 + 1 < N) ? sp[1] : 0.f; v.z = (n0 + c4 + 2 < N) ? sp[2] : 0.f; v.w = 0.f; }
      if (kscale) { const float ks = kscale[k0 + r]; v.x *= ks; v.y *= ks; v.z *= ks; v.w *= ks; }
      tl[r * 65 + c4] = v.x; tl[r * 65 + c4 + 1] = v.y; tl[r * 65 + c4 + 2] = v.z; tl[r * 65 + c4 + 3] = v.w;
    }
    hsync();
    const int n = tid >> 2, kc = (tid & 3) * 16;
    if (n0 + n < N) {
      unsigned w[8];
#pragma unroll
      for (int i = 0; i < 8; ++i) w[i] = pk2bf(tl[(kc + 2 * i) * 65 + n], tl[(kc + 2 * i + 1) * 65 + n]);
      uint4* o = (uint4*)(dst + (size_t)rowmap(n0 + n) * ldk + k0 + kc);
      o[0] = make_uint4(w[0], w[1], w[2], w[3]); o[1] = make_uint4(w[4], w[5], w[6], w[7]);
    }
  }
  cursor += nt;
}
DEVI void convert_rows(const float* x, bf16_t* xb, float* part) {
  const int lane = HTID & 63, gw = VBID * 4 + (HTID >> 6), NGW = VGRID * 4;
  for (int t0 = gw * 4; t0 < T; t0 += NGW * 4) {
    float4 v[4][4];
#pragma unroll
    for (int q = 0; q < 4; ++q)
#pragma unroll
      for (int j = 0; j < 4; ++j) v[q][j] = ((const float4*)(x + (size_t)(t0 + q) * D))[lane + 64 * j];
#pragma unroll
    for (int q = 0; q < 4; ++q) {
      float s = 0.f;
#pragma unroll
      for (int j = 0; j < 4; ++j) s += v[q][j].x * v[q][j].x + v[q][j].y * v[q][j].y + v[q][j].z * v[q][j].z + v[q][j].w * v[q][j].w;
      s = wsum(s);
      if (lane < 16) part[(size_t)(t0 + q) * 16 + lane] = (lane == 0) ? s : 0.f;
#pragma unroll
      for (int j = 0; j < 4; ++j) {
        uint2 o; o.x = pk2bf(v[q][j].x, v[q][j].y); o.y = pk2bf(v[q][j].z, v[q][j].w);
        ((uint2*)(xb + (size_t)(t0 + q) * D))[lane + 64 * j] = o;
      }
    }
  }
}
DEVI void phase_prep(const Params& p, unsigned char* lds) {
  const size_t gtid = (size_t)VBID * NTHREADS + HTID, gn = (size_t)VGRID * NTHREADS;
  unsigned char* ws = p.ws;
  if (gtid < 64) ((int*)(ws + SM_CNT))[gtid] = 0;
  auto ident = [](int n) { return n; };
  int cursor = 0;
  for (int l = 0; l < NL; ++l) {
    unsigned char* wl = ws + WS_W + l * WS_WL;
    transpose_tiles(p.in[3] + (size_t)l * D * DIN, D, DIN, (bf16_t*)(wl + W_IN), D, [](int n) { return colmap(n); }, lds, cursor, p.in[2] + l * D);
    for (size_t i = gtid; i < (size_t)20 * D; i += gn) ((bf16_t*)(wl + W_IN))[(size_t)236 * D + i] = 0;
    transpose_tiles(p.in[36] + (size_t)l * D * D, D, D, (bf16_t*)(wl + W_OUT), D, ident, lds, cursor);
    transpose_tiles(p.in[6] + (size_t)l * 192 * 384, 192, 384, (bf16_t*)(wl + W_UQ), 192, ident, lds, cursor, p.in[4] + l * 192);
    transpose_tiles(p.in[7] + (size_t)l * 128 * 512, 128, 512, (bf16_t*)(wl + W_UKV), 128, ident, lds, cursor, p.in[5] + l * 128);
    transpose_tiles(p.in[25] + (size_t)l * 256 * 256, 256, 256, (bf16_t*)(wl + W_GLU), 256, ident, lds, cursor);
    transpose_tiles(p.in[30] + (size_t)l * 2048 * 128, 2048, 128, (bf16_t*)(wl + W_1K), 2048, ident, lds, cursor);
    transpose_tiles(p.in[33] + (size_t)l * 2048 * 128, 2048, 128, (bf16_t*)(wl + W_1V), 2048, ident, lds, cursor);
    transpose_tiles(p.in[31] + (size_t)l * 128 * 64, 128, 64, (bf16_t*)(wl + W_2K), 128, ident, lds, cursor);
    transpose_tiles(p.in[34] + (size_t)l * 128 * 64, 128, 64, (bf16_t*)(wl + W_2V), 128, ident, lds, cursor);
    for (int h = 0; h < 4; ++h) {
      transpose_tiles(p.in[12] + ((size_t)l * 4 + h) * 64 * 64, 64, 64, (bf16_t*)(wl + W_LRU) + h * 128 * 64, 64, ident, lds, cursor);
      transpose_tiles(p.in[14] + ((size_t)l * 4 + h) * 64 * 64, 64, 64, (bf16_t*)(wl + W_LRU) + h * 128 * 64 + 64 * 64, 64, ident, lds, cursor);
    }
    for (int e = 0; e < 16; ++e) {
      bf16_t* dg = (bf16_t*)(wl + W_GU) + (size_t)e * 512 * 1024;
      transpose_tiles(p.in[42] + ((size_t)l * 16 + e) * 1024 * 256, 1024, 256, dg, 1024, [](int hh) { return (hh >> 6) * 128 + ((hh >> 5) & 1) * 64 + ((hh >> 4) & 1) * 16 + (hh & 15); }, lds, cursor, p.in[37] + l * D);
      transpose_tiles(p.in[43] + ((size_t)l * 16 + e) * 1024 * 256, 1024, 256, dg, 1024, [](int hh) { return (hh >> 6) * 128 + ((hh >> 5) & 1) * 64 + (((hh >> 4) & 1) + 2) * 16 + (hh & 15); }, lds, cursor, p.in[37] + l * D);
      transpose_tiles(p.in[44] + ((size_t)l * 16 + e) * 256 * 1024, 256, 1024, (bf16_t*)(wl + W_DN) + (size_t)e * 1024 * 256, 256, ident, lds, cursor);
    }
    {
      const int lane = HTID & 63, gw = VBID * 4 + (HTID >> 6), NGW = VGRID * 4;
      for (int o = gw; o < 256; o += NGW) {
        const int kv = o >> 7, j = o & 127;
        const float* pe = (kv ? p.in[32] : p.in[29]) + (size_t)l * 2048;
        const float* w1 = (kv ? p.in[33] : p.in[30]) + (size_t)l * 2048 * 128;
        float a = 0.f;
#pragma unroll 8
        for (int k = lane; k < 2048; k += 64) a += pe[k] * w1[(size_t)k * 128 + j];
        a = wsum(a);
        if (lane == 0) ((float*)(wl + (kv ? W_B1V : W_B1K)))[j] = a;
      }
    }
    for (size_t i = gtid; i < 16 * 64; i += gn) {
      const int g = (int)(i >> 6), sidx = (int)(i & 63);
      const float are = p.in[17][(size_t)l * 1024 + i], aim = p.in[18][(size_t)l * 1024 + i];
      const float dt = expf(p.in[19][l * 16 + g]);
      const float mag = expf(dt * are);
      float sn, cs; sincosf(dt * aim, &sn, &cs);
      const float abr = mag * cs, abi = mag * sn;
      const float den = are * are + aim * aim, nre = abr - 1.f;
      const float gre = (nre * are + abi * aim) / den, gim = (abi * are - nre * aim) / den;
      ((float2*)(wl + W_S5A))[i] = make_float2(abr, abi);
      float pr = abr, pi = abi;
#pragma unroll
      for (int q = 0; q < 6; ++q) { const float nr = pr * pr - pi * pi, ni = 2.f * pr * pi; pr = nr; pi = ni; }
      ((float2*)(wl + W_S5A64))[i] = make_float2(pr, pi);
      bf16_t* bb = (bf16_t*)(wl + W_S5BB);
      for (int ch = 0; ch < 16; ++ch) {
        const float br = p.in[20][((size_t)l * 1024 + i) * 16 + ch], bi = p.in[21][((size_t)l * 1024 + i) * 16 + ch];
        const float vr = gre * br - gim * bi, vi = gre * bi + gim * br;
        const int sb = sidx >> 5, r = sidx & 31;
        bb[((g * 4 + sb * 2 + 0) * 32 + r) * 16 + ch] = f2bf(vr);
        bb[((g * 4 + sb * 2 + 1) * 32 + r) * 16 + ch] = f2bf(vi);
      }
    }
    for (size_t i = gtid; i < 32 * 1024; i += gn) {
      const int n = (int)(i >> 10), k = (int)(i & 1023);
      float w = 0.f;
      if (n < 20) w = p.in[37][l * D + k] * ((n < 4) ? p.in[38][((size_t)l * D + k) * 4 + n] : p.in[40][((size_t)l * D + k) * 16 + (n - 4)]);
      const bf16_t hi = f2bf(w);
      ((bf16_t*)(wl + W_RTH))[i] = hi; ((bf16_t*)(wl + W_RTL))[i] = f2bf(w - bf2f(hi));
    }
    for (size_t i = gtid; i < 16 * 16 * 64; i += gn) {
      const int g = (int)(i >> 10), ch = (int)((i >> 6) & 15), pp = (int)(i & 63);
      const float cr = p.in[22][(size_t)l * 16384 + i], ci = p.in[23][(size_t)l * 16384 + i];
      bf16_t* cm = (bf16_t*)(wl + W_S5CM) + ((size_t)(g * 16 + ch) * 128 + 2 * pp);
      cm[0] = f2bf(cr); cm[1] = f2bf(-ci);
    }
  }
  {
    const int* positions = (const int*)p.in[1];
    float2* RM = (float2*)(ws + WS_ROPE);
    float2* RN = RM + (size_t)T * 16;
    for (size_t i = gtid; i < (size_t)T * 24; i += gn) {
      const int t = (int)(i / 24), j = (int)(i % 24);
      const int rot = (j < 16) ? 32 : 16, fi = (j < 16) ? j : (j - 16);
      const float inv = powf(500000.f, -(2.f * (float)fi) / (float)rot);
      float sn, cs; sincosf((float)positions[t] * inv, &sn, &cs);
      if (j < 16) RM[(size_t)t * 16 + fi] = make_float2(cs, sn); else RN[(size_t)t * 8 + fi] = make_float2(cs, sn);
    }
  }
  convert_rows(p.in[0], (bf16_t*)(ws + WS_A), (float*)(ws + WS_PART));
}

DEVI void phase_g1(const Params& p, int l, unsigned char* lds_full) {
  const bf16_t* XN = (l == 0) ? (const bf16_t*)(p.ws + WS_A) : (const bf16_t*)p.out;
  const bf16_t* W = (const bf16_t*)(p.ws + WS_W + l * WS_WL + W_IN);
  bf16_t* QN = (bf16_t*)(p.ws + WS_G);
  pg8::Gemm g{XN, W, T, DINP, D}; pg8::StaticOrder S; S.init(T, DINP, (int)gridDim.x, (int)blockIdx.x);
  EpiG1 E{(bf16_t*)(p.ws + WS_B), QN, QN + (size_t)T * 256, QN + (size_t)T * 320, (float*)(p.ws + SM_SSKV), (const float2*)(p.ws + WS_ROPE) + (size_t)T * 16, p.in[27] + l * 64, p.in[28] + l * 192, (const float*)(p.ws + WS_PART)};
  pg8::gemm_phase<EpiG1, pg8::StaticOrder, true, true>((LAS unsigned char*)lds_full, g, S, E);
}

DEVI void phase_g2(const Params& p, int l, unsigned char* lds) {
  unsigned char* wl = p.ws + WS_W + l * WS_WL;
  const bf16_t* PROJ = (const bf16_t*)(p.ws + WS_B);
  bf16_t* QR = (bf16_t*)(p.ws + WS_D);
  bf16_t* KVR = QR + (size_t)T * 384;
  bf16_t* GATES = (bf16_t*)(p.ws + WS_E);
  bf16_t* MK = (bf16_t*)(p.ws + WS_F) + (size_t)T * 4 * 96;
  const float2* RM = (const float2*)(p.ws + WS_ROPE);
  constexpr int N_CMP = 64, N_QR = 256 * 3, N_KVR = 256 * 4, N_GT = 256 * 4;
  const int tid = HTID, wid = tid >> 6, lane = tid & 63, wr = wid >> 1, wc = wid & 1, fr = lane & 15, fq = lane >> 4;
  unsigned* qctr = (unsigned*)(p.ws + WS_CTL + WS_QCTR) + l * 16 + 0;
  int _qpar = 0;
  for (int it = vblock(); it < N_CMP + N_QR + N_KVR + N_GT; ) {
    DYNQ_FETCH(qctr)
    f32x4 acc[4][4];
    if (it < N_CMP) {
      const int kv = it & 1, half = (it >> 1) & 1, mt = it >> 2;
      const bf16_t* W = (const bf16_t*)(wl + (kv ? W_1V : W_1K)) + (size_t)half * 64 * 2048;
      const float* bias = (const float*)(wl + (kv ? W_B1V : W_B1K)) + half * 64;
      bf16_t* H = (bf16_t*)(p.ws + (kv ? SM_HV : SM_HK)) + half * 64;
      f32x4 acc2[2][4];
      gemm128h(lds, 2048,
              [&](int r, int k) { const int m = mt * 128 + r, b = m >> 7; int c = m & 127; if (c > 126) c = 126;
                                  return PROJ + (size_t)(b * S + 16 * c + (k >> 6)) * DINP + C_KC + kv * 64 + (k & 63); },
              [&](int r, int k) { return W + (size_t)r * 2048 + k; }, acc2);
#pragma unroll
      for (int m = 0; m < 2; ++m)
#pragma unroll
        for (int n = 0; n < 4; ++n) {
          const float4 b4 = *(const float4*)(bias + n * 16 + fq * 4);
          f32x4 o; o[0] = gelu_tanh(acc2[m][n][0] + b4.x); o[1] = gelu_tanh(acc2[m][n][1] + b4.y); o[2] = gelu_tanh(acc2[m][n][2] + b4.z); o[3] = gelu_tanh(acc2[m][n][3] + b4.w);
          st_bf16x4(H + (size_t)(mt * 128 + wid * 32 + m * 16 + fr) * 128 + n * 16 + fq * 4, o);
        }
    } else if (it < N_CMP + N_QR) {
      const int i2 = it - N_CMP, mt = i2 / 3, nt = i2 % 3;
      const bf16_t* W = (const bf16_t*)(wl + W_UQ);
      gemm128g(lds, 192, [&](int r, int k) { return PROJ + (size_t)(mt * 128 + r) * DINP + C_CQ + k; }, [&](int r, int k) { return W + (size_t)(nt * 128 + r) * 192 + k; }, acc);
      GEMM_EPI4({ st_bf16x4(QR + (size_t)(mt * 128 + er) * 384 + nt * 128 + ec0, ev4); })
    } else if (it < N_CMP + N_QR + N_KVR) {
      const int i2 = it - N_CMP - N_QR, mt = i2 >> 2, hd = i2 & 3;
      const bf16_t* W = (const bf16_t*)(wl + W_UKV);
      gemm128g(lds, 128, [&](int r, int k) { return PROJ + (size_t)(mt * 128 + r) * DINP + wgcol(C_T1, k >> 6, k & 63); }, [&](int r, int k) { return W + (size_t)(hd * 128 + r) * 128 + k; }, acc);
      const float* g_k = p.in[9] + l * 96;
#pragma unroll
      for (int m = 0; m < 4; ++m) {
        const size_t t = (size_t)mt * 128 + wr * 64 + m * 16 + fr;
        const int b = (int)(t >> 11), sq = (int)(t & (S - 1));
        const float2 ssp = *(const float2*)((const float*)(p.ws + SM_SSKV) + t * 2);
        const float ss = ssp.x + ssp.y;
        const float rskv = rsqrtf(ss * (1.f / 128) + EPS);
        if (wc == 1) {
#pragma unroll
          for (int n = 0; n < 4; ++n) st_bf16x4(KVR + t * 512 + hd * 128 + 64 + n * 16 + fq * 4, acc[m][n] * rskv);
        } else {
          const uint2 plo = *(const uint2*)(PROJ + t * DINP + C_KPE + 4 * fq), phi = *(const uint2*)(PROJ + t * DINP + C_KPE + 16 + 4 * fq);
          float pl[4] = {__uint_as_float(plo.x << 16), __uint_as_float(plo.x & 0xffff0000u), __uint_as_float(plo.y << 16), __uint_as_float(plo.y & 0xffff0000u)};
          float ph[4] = {__uint_as_float(phi.x << 16), __uint_as_float(phi.x & 0xffff0000u), __uint_as_float(phi.y << 16), __uint_as_float(phi.y & 0xffff0000u)};
          float sk = 0.f;
#pragma unroll
          for (int j = 0; j < 4; ++j) sk += pl[j] * pl[j] + ph[j] * ph[j];
          f32x4 kn[4];
#pragma unroll
          for (int n = 0; n < 4; ++n) { kn[n] = acc[m][n] * rskv; sk += kn[n][0] * kn[n][0] + kn[n][1] * kn[n][1] + kn[n][2] * kn[n][2] + kn[n][3] * kn[n][3]; }
          sk += __shfl_xor(sk, 16); sk += __shfl_xor(sk, 32);
          const float rsk = rsqrtf(sk * (1.f / 96) + EPS);
          bf16_t* dst = MK + ((size_t)(b * 4 + hd) * S + sq) * 96;
          f32x4 olo, ohi;
#pragma unroll
          for (int j = 0; j < 4; ++j) {
            const int d = 4 * fq + j; const float2 cs2 = RM[t * 16 + d];
            const float x1 = pl[j] * rsk * g_k[d], x2 = ph[j] * rsk * g_k[16 + d];
            olo[j] = x1 * cs2.x - x2 * cs2.y; ohi[j] = x1 * cs2.y + x2 * cs2.x;
          }
          st_bf16x4(dst + 4 * fq, olo); st_bf16x4(dst + 16 + 4 * fq, ohi);
#pragma unroll
          for (int n = 0; n < 4; ++n) { const float4 g4 = *(const float4*)(g_k + 32 + n * 16 + fq * 4); f32x4 o = kn[n] * rsk; o[0] *= g4.x; o[1] *= g4.y; o[2] *= g4.z; o[3] *= g4.w; st_bf16x4(dst + 32 + n * 16 + fq * 4, o); }
        }
      }
    } else {
      const int i2 = it - N_CMP - N_QR - N_KVR, mt = i2 >> 2, h = i2 & 3;
      const bf16_t* W = (const bf16_t*)(wl + W_LRU) + h * 128 * 64;
      const int c0 = h * 64 + (tid & 7) * 8;
      const float* cw = p.in[10] + l * 4 * 256 + c0; const float* cbp = p.in[11] + l * 256 + c0;
      gemm128(lds, 64,
              [&](int r, int k) {
                const size_t t = (size_t)mt * 128 + r; const int sq = (int)(t & (S - 1));
                float u[8];
#pragma unroll
                for (int e = 0; e < 8; ++e) u[e] = cbp[e];
#pragma unroll
                for (int j = 0; j < 4; ++j) {
                  if (sq - 3 + j >= 0) {
                    const u32x4 w = *(const u32x4*)(PROJ + (t - 3 + j) * DINP + C_LX + h * 64 + k);
#pragma unroll
                    for (int e = 0; e < 4; ++e) { u[2 * e] += __uint_as_float(w[e] << 16) * cw[j * 256 + 2 * e]; u[2 * e + 1] += __uint_as_float(w[e] & 0xffff0000u) * cw[j * 256 + 2 * e + 1]; }
                  }
                }
                u32x4 o; o[0] = pk2bf(u[0], u[1]); o[1] = pk2bf(u[2], u[3]); o[2] = pk2bf(u[4], u[5]); o[3] = pk2bf(u[6], u[7]);
                return o; },
              [&](int r, int k) { return W + (size_t)r * 64 + k; }, acc);
      GEMM_EPI4({ st_bf16x4(GATES + (size_t)(mt * 128 + er) * 512 + h * 128 + ec0, ev4); })
    }
    DYNQ_NEXT(it, lds)
  }
}

DEVI void lru_ab(float u, float rpre, float ipre, float sp, bool first, float& a, float& b) {
  const float r = sigmoidf_(rpre), gi = sigmoidf_(ipre);
  const float la = -8.f * r * sp;
  a = __expf(la);
  const float x = 2.f * la;
  const float om = (x > -0.1f) ? (-x * (1.f + 0.5f * x * (1.f + (1.f / 3.f) * x * (1.f + 0.25f * x * (1.f + 0.2f * x))))) : (1.f - a * a);
  const float mult = first ? 1.f : sqrtf(fmaxf(om, 0.f));
  b = mult * gi * u;
}
DEVI float lru_conv(const bf16_t* PROJ, int t, int s, int c, const float* cw, float cb) {
  float u = cb;
#pragma unroll
  for (int j = 0; j < 4; ++j) { const int ss2 = s - 3 + j; if (ss2 >= 0) u += bf2f(PROJ[(size_t)(t - 3 + j) * DINP + C_LX + c]) * cw[j * 256 + c]; }
  return u;
}

template <bool FULL>
DEVI void s5_chunk(const Params& p, int l, int b, int chunk, unsigned char* lds) {
  unsigned char* wl = p.ws + WS_W + l * WS_WL;
  const bf16_t* PROJ = (const bf16_t*)(p.ws + WS_B);
  const float2* Abar = (const float2*)(wl + W_S5A);
  const bf16_t* BB = (const bf16_t*)(wl + W_S5BB);
  const bf16_t* CM = (const bf16_t*)(wl + W_S5CM);
  float2* SLOC = (float2*)(p.ws + SM_SLOC);
  bf16_t* YCP = (bf16_t*)(p.ws + WS_F);
  const float* dd = p.in[24] + l * 256;
  const int tid = HTID, wv = tid >> 6, lane = tid & 63, r = lane & 31, h = lane >> 5, fr = lane & 15, fq = lane >> 4;
  unsigned* Hs = (unsigned*)(lds + wv * 8704);
  const int t0 = b * S + chunk * 64;
#pragma unroll 1
  for (int gi = 0; gi < 4; ++gi) {
    const int g = wv * 4 + gi;
    bf16x8 bbf[4];
#pragma unroll
    for (int nb = 0; nb < 4; ++nb) bbf[nb] = *(const bf16x8*)(BB + ((g * 4 + nb) * 32 + r) * 16 + 8 * h);
    float2 Ac[2]; float hr[2], hi[2];
#pragma unroll
    for (int sb = 0; sb < 2; ++sb) {
      Ac[sb] = Abar[g * 64 + sb * 32 + r];
      hr[sb] = 0.f; hi[sb] = 0.f;
      if (FULL) { const float2 cin = ((const float2*)(p.ws + SM_SCAR))[((size_t)(b * 32 + chunk) * 16 + g) * 64 + sb * 32 + r]; hr[sb] = cin.x; hi[sb] = cin.y; }
    }
    bf16x8 cm[4];
    float4 dcol4 = make_float4(0.f, 0.f, 0.f, 0.f);
    if (FULL) {
#pragma unroll
      for (int kk = 0; kk < 4; ++kk) cm[kk] = *(const bf16x8*)(CM + (size_t)(g * 16 + fr) * 128 + kk * 32 + 8 * fq);
      dcol4 = *(const float4*)(dd + g * 16 + 4 * fq);
    }
#pragma unroll 1
    for (int tb = 0; tb < 2; ++tb) {
      const bf16x8 ua = *(const bf16x8*)(PROJ + (size_t)(t0 + tb * 32 + r) * DINP + C_S5 + g * 16 + 8 * h);
      f32x16 acc[4];
#pragma unroll
      for (int nb = 0; nb < 4; ++nb) {
        f32x16 z;
#pragma unroll
        for (int i = 0; i < 16; ++i) z[i] = 0.f;
        acc[nb] = mfma32(ua, bbf[nb], z);
      }
#pragma unroll
      for (int sb = 0; sb < 2; ++sb) {
        float sr = hr[sb], si = hi[sb];
        const float ax = Ac[sb].x, ay = Ac[sb].y;
#pragma unroll
        for (int q = 0; q < 4; ++q)
#pragma unroll
          for (int owner = 0; owner < 2; ++owner) {
#pragma unroll
            for (int i = 0; i < 4; ++i) {
              const int reg = 4 * q + i;
              const float br = acc[2 * sb][reg], bi = acc[2 * sb + 1][reg];
              const float nr = ax * sr - ay * si + br, ni = ax * si + ay * sr + bi; sr = nr; si = ni;
              if (FULL) { acc[2 * sb][reg] = (h == owner) ? sr : br; acc[2 * sb + 1][reg] = (h == owner) ? si : bi; }
            }
            const float orr = __shfl_xor(sr, 32), oi = __shfl_xor(si, 32);
            if (h != owner) { sr = orr; si = oi; }
          }
        hr[sb] = sr; hi[sb] = si;
      }
      if (FULL) {
#pragma unroll
        for (int sb = 0; sb < 2; ++sb)
#pragma unroll
          for (int reg = 0; reg < 16; ++reg)
            Hs[crow(reg, h) * 68 + sb * 32 + r] = pk2bf(acc[2 * sb][reg], acc[2 * sb + 1][reg]);
#pragma unroll
        for (int tb16 = 0; tb16 < 2; ++tb16) {
          f32x4 y = (f32x4){0.f, 0.f, 0.f, 0.f};
#pragma unroll
          for (int kk = 0; kk < 4; ++kk) { const bf16x8 a = *(const bf16x8*)((const bf16_t*)Hs + (tb16 * 16 + fr) * 136 + kk * 32 + 8 * fq); y = mfma16(cm[kk], a, y); }
          const size_t t = (size_t)t0 + tb * 32 + tb16 * 16 + fr; const int col = g * 16 + 4 * fq;
          const uint2 uw = *(const uint2*)(PROJ + t * DINP + C_S5 + col);
          f32x4 o;
          o[0] = gelu_tanh(y[0] + dcol4.x * __uint_as_float(uw.x << 16)); o[1] = gelu_tanh(y[1] + dcol4.y * __uint_as_float(uw.x & 0xffff0000u));
          o[2] = gelu_tanh(y[2] + dcol4.z * __uint_as_float(uw.y << 16)); o[3] = gelu_tanh(y[3] + dcol4.w * __uint_as_float(uw.y & 0xffff0000u));
          st_bf16x4(YCP + t * 256 + col, o);
        }
      }
    }
    if (!FULL) {
#pragma unroll
      for (int sb = 0; sb < 2; ++sb) if (h == 0) SLOC[((size_t)(b * 32 + chunk) * 16 + g) * 64 + sb * 32 + r] = make_float2(hr[sb], hi[sb]);
    }
  }
}

template <bool FULL>
DEVI void lru_chunk(const Params& p, int l, int b, int chunk, float* tile) {
  const bf16_t* PROJ = (const bf16_t*)(p.ws + WS_B);
  const bf16_t* GATES = (const bf16_t*)(p.ws + WS_E);
  float2* LSUM = (float2*)(p.ws + SM_LSUM);
  const int c = HTID, h = c >> 6, j = c & 63;
  const float* cw = p.in[10] + l * 4 * 256;
  const float w0 = cw[c], w1 = cw[256 + c], w2 = cw[512 + c], w3 = cw[768 + c], cb = p.in[11][l * 256 + c];
  const float ba = p.in[13][l * 256 + c], bi = p.in[15][l * 256 + c];
  const float sp = log1pf(expf(-p.in[16][l * 256 + c]));
  const int s0 = chunk * 64; const size_t t0 = (size_t)b * S + s0;
  float xm3 = 0.f, xm2 = 0.f, xm1 = 0.f;
  if (s0 > 0) { xm3 = bf2f(PROJ[(t0 - 3) * DINP + C_LX + c]); xm2 = bf2f(PROJ[(t0 - 2) * DINP + C_LX + c]); xm1 = bf2f(PROJ[(t0 - 1) * DINP + C_LX + c]); }
  float hh = 0.f, ap = 1.f;
  if (FULL) hh = ((const float*)(p.ws + SM_LCAR))[(size_t)(b * 32 + chunk) * 256 + c];
#pragma unroll 1
  for (int k0 = 0; k0 < 64; k0 += 8) {
    float xv[8], rp[8], ip[8], gt[8];
#pragma unroll
    for (int i = 0; i < 8; ++i) {
      const size_t t = t0 + k0 + i;
      xv[i] = bf2f(PROJ[t * DINP + C_LX + c]);
      rp[i] = bf2f(GATES[t * 512 + h * 128 + j]); ip[i] = bf2f(GATES[t * 512 + h * 128 + 64 + j]);
      gt[i] = FULL ? bf2f(PROJ[t * DINP + C_LG + c]) : 0.f;
    }
#pragma unroll
    for (int i = 0; i < 8; ++i) {
      const float u = cb + xm3 * w0 + xm2 * w1 + xm1 * w2 + xv[i] * w3;
      xm3 = xm2; xm2 = xm1; xm1 = xv[i];
      float a, bb; lru_ab(u, rp[i] + ba, ip[i] + bi, sp, (s0 + k0 + i) == 0, a, bb);
      hh = a * hh + bb; ap *= a;
      if (FULL) tile[(k0 + i) * 256 + c] = hh * gelu_tanh(gt[i]);
    }
  }
  if (!FULL) LSUM[(size_t)(b * 32 + chunk) * 256 + c] = make_float2(ap, hh);
}

DEVI void phase_r2(const Params& p, int l, unsigned char* lds) {
  unsigned char* wl = p.ws + WS_W + l * WS_WL;
  const bf16_t* PROJ = (const bf16_t*)(p.ws + WS_B);
  const bf16_t* QR = (const bf16_t*)(p.ws + WS_D);
  const bf16_t* KVR = QR + (size_t)T * 384;
  const bf16_t* GATES = (const bf16_t*)(p.ws + WS_E);
  bf16_t* MQ = (bf16_t*)(p.ws + WS_F);
  bf16_t* MK = MQ + (size_t)T * 4 * 96;
  const float2* RM = (const float2*)(p.ws + WS_ROPE);
  const float2* RN = RM + (size_t)T * 16;
  const int tid = HTID, lane = tid & 63, wv = tid >> 6;
  for (int it = VBID; it < NB * 32; it += VGRID) lru_chunk<false>(p, l, it >> 5, it & 31, nullptr);
  hsync();
  for (int it = VBID; it < NB * 32; it += VGRID) s5_chunk<false>(p, l, it >> 5, it & 31, lds);
  {
    const bf16_t* HK = (const bf16_t*)(p.ws + SM_HK); const bf16_t* HV = (const bf16_t*)(p.ws + SM_HV);
    bf16_t* KC = (bf16_t*)(p.ws + SM_KC); bf16_t* VC = (bf16_t*)(p.ws + SM_VC);
    const bf16_t* W2K = (const bf16_t*)(wl + W_2K); const bf16_t* W2V = (const bf16_t*)(wl + W_2V);
    const float* g0 = p.in[28] + l * 192;
    for (int it = VBID; it < 32; it += VGRID) {
      const int kv = it & 1, mt = it >> 1;
      const bf16_t* H = kv ? HV : HK; const bf16_t* W2 = kv ? W2V : W2K;
      f32x4 acc[4][4];
      hsync();
      gemm128g(lds, 128, [&](int r, int k) { return H + (size_t)(mt * 128 + r) * 128 + k; }, [&](int r, int k) { return W2 + (size_t)(r & 63) * 128 + k; }, acc);
      const int wid = tid >> 6, wr = wid >> 1, wc = wid & 1, fr = lane & 15, fq = lane >> 4;
      if (wc == 0) {
#pragma unroll
        for (int m = 0; m < 4; ++m) {
          const int row = mt * 128 + wr * 64 + m * 16 + fr, b = row >> 7, c = row & 127;
          f32x4 v[4];
#pragma unroll
          for (int n = 0; n < 4; ++n) v[n] = acc[m][n];
          if (kv == 0) {
            float ss = 0.f;
#pragma unroll
            for (int n = 0; n < 4; ++n) ss += v[n][0] * v[n][0] + v[n][1] * v[n][1] + v[n][2] * v[n][2] + v[n][3] * v[n][3];
            ss += __shfl_xor(ss, 16); ss += __shfl_xor(ss, 32);
            const float rs = rsqrtf(ss * (1.f / 64) + EPS);
#pragma unroll
            for (int n = 0; n < 4; ++n) { const float4 gg = *(const float4*)(g0 + n * 16 + fq * 4); v[n][0] *= rs * gg.x; v[n][1] *= rs * gg.y; v[n][2] *= rs * gg.z; v[n][3] *= rs * gg.w; }
            const int cc = (c < 127) ? c : 126;
            const float2* cs = RN + (size_t)(b * S + 16 * cc + 31) * 8;
#pragma unroll
            for (int j = 0; j < 4; ++j) {
              const float x = v[0][j], partner = __shfl_xor(x, 32);
              const int d = fq * 4 + j; const float2 cs2 = cs[d & 7];
              v[0][j] = (d < 8) ? (x * cs2.x - partner * cs2.y) : (partner * cs2.y + x * cs2.x);
            }
          }
          bf16_t* dst = (kv ? VC : KC) + (size_t)row * 64;
#pragma unroll
          for (int n = 0; n < 4; ++n) { f32x4 o = v[n]; if (c >= 127) o = (f32x4){0.f, 0.f, 0.f, 0.f}; st_bf16x4(dst + n * 16 + fq * 4, o); }
        }
      }
    }
  }
}

typedef short v4i16_t __attribute__((ext_vector_type(4)));
DEVI float fexp2(float x) { return __builtin_amdgcn_exp2f(x); }
constexpr int VST = 96;
constexpr int ATT_VBYTES = 64 * VST * 2;
template <int DK> constexpr int att_kbytes() { return 64 * (DK + 8) * 2; }
template <int DK> constexpr int att_buf() { return att_kbytes<DK>() + ATT_VBYTES; }
template <int DK> struct TileRegs { u32x4 k[(64 * DK / 8 + 511) / 512]; u32x4 v; };
template <int DK>
DEVI void tile_load(TileRegs<DK>& tr, const bf16_t* kbase, size_t kstride, const bf16_t* vbase, size_t vstride, int key0, bool withv = true) {
  constexpr int CH = DK / 8, NCH = 64 * CH;
#pragma unroll
  for (int i = 0; i < (NCH + 511) / 512; ++i) { const int c = (int)threadIdx.x + 512 * i; if (c < NCH) { const int r = c / CH, cc = c % CH; tr.k[i] = *(const u32x4*)(kbase + (size_t)(key0 + r) * kstride + cc * 8); } }
  if (withv) { const int c = (int)threadIdx.x, r = c >> 3, cc = c & 7; tr.v = *(const u32x4*)(vbase + (size_t)(key0 + r) * vstride + cc * 8); }
}
template <int DK>
DEVI void tile_store(const TileRegs<DK>& tr, unsigned char* buf, bool withv = true) {
  constexpr int CH = DK / 8, NCH = 64 * CH;
  bf16_t* sK = (bf16_t*)buf; bf16_t* sV = (bf16_t*)(buf + att_kbytes<DK>());
#pragma unroll
  for (int i = 0; i < (NCH + 511) / 512; ++i) { const int c = (int)threadIdx.x + 512 * i; if (c < NCH) { const int r = c / CH, cc = c % CH; *(u32x4*)(sK + r * (DK + 8) + cc * 8) = tr.k[i]; } }
  if (withv) { const int c = (int)threadIdx.x, r = c >> 3, cc = c & 7; *(u32x4*)(sV + r * VST + cc * 8) = tr.v; }
}
template <int DK>
DEVI void qk_tile(const bf16_t* sK, const bf16x8* qf, f32x16& s0, f32x16& s1, int r, int h) {
#pragma unroll
  for (int i = 0; i < 16; ++i) { s0[i] = 0.f; s1[i] = 0.f; }
#pragma unroll
  for (int kk = 0; kk < DK / 16; ++kk) {
    const bf16x8 a0 = *(const bf16x8*)(sK + r * (DK + 8) + kk * 16 + h * 8);
    const bf16x8 a1 = *(const bf16x8*)(sK + (32 + r) * (DK + 8) + kk * 16 + h * 8);
    s0 = mfma32(a0, qf[kk], s0);
    s1 = mfma32(a1, qf[kk], s1);
  }
}
struct FState { f32x16 o0, o1; float m, l; };
DEVI void fstate_init(FState& f) {
#pragma unroll
  for (int i = 0; i < 16; ++i) { f.o0[i] = 0.f; f.o1[i] = 0.f; }
  f.m = -INFINITY; f.l = 0.f;
}
DEVI v4i16_t vtr(const bf16_t* p) { return __builtin_amdgcn_ds_read_tr16_b64_v4i16((LAS v4i16_t*)p); }
DEVI void softmax_pv(FState& f, f32x16& s0, f32x16& s1, const bf16_t* sV, int lane) {
  const int h = lane >> 5;
  float mx = -INFINITY;
#pragma unroll
  for (int i = 0; i < 16; ++i) mx = fmaxf(mx, fmaxf(s0[i], s1[i]));
  mx = fmaxf(mx, __shfl_xor(mx, 32));
  const float mnew = fmaxf(f.m, mx);
  const float muse = (mnew == -INFINITY) ? 0.f : mnew;
  float ps = 0.f;
#pragma unroll
  for (int i = 0; i < 16; ++i) { s0[i] = fexp2(s0[i] - muse); s1[i] = fexp2(s1[i] - muse); ps += s0[i] + s1[i]; }
  ps += __shfl_xor(ps, 32);
  if (__any(mnew != f.m)) {
    const float alpha = fexp2(f.m - muse);
    f.l = f.l * alpha + ps; f.m = mnew;
#pragma unroll
    for (int i = 0; i < 16; ++i) { f.o0[i] *= alpha; f.o1[i] *= alpha; }
  } else {
    f.l += ps;
  }
  const int g = lane >> 4, li = lane & 15, q = li >> 2, pp = li & 3;
  const bf16_t* vb = sV + (4 * h + q) * VST + (g & 1) * 16 + 4 * pp;
#pragma unroll
  for (int kb = 0; kb < 2; ++kb)
#pragma unroll
    for (int s = 0; s < 2; ++s) {
      unsigned pw[4];
#pragma unroll
      for (int j = 0; j < 4; ++j) pw[j] = kb ? pk2bf(s1[8 * s + 2 * j], s1[8 * s + 2 * j + 1]) : pk2bf(s0[8 * s + 2 * j], s0[8 * s + 2 * j + 1]);
      const bf16x8 pb = __builtin_bit_cast(bf16x8, (u32x4){pw[0], pw[1], pw[2], pw[3]});
#pragma unroll
      for (int db = 0; db < 2; ++db) {
        const v4i16_t lo = vtr(vb + (kb * 32 + 16 * s) * VST + db * 32);
        const v4i16_t hi = vtr(vb + (kb * 32 + 16 * s + 8) * VST + db * 32);
        const bf16x8 a = {lo[0], lo[1], lo[2], lo[3], hi[0], hi[1], hi[2], hi[3]};
        if (db == 0) f.o0 = mfma32(a, pb, f.o0); else f.o1 = mfma32(a, pb, f.o1);
      }
    }
}
DEVI void store_o(bf16_t* orow, const f32x16& o0, const f32x16& o1, float sc, int h) {
#pragma unroll
  for (int g = 0; g < 4; ++g) {
    uint2 v0, v1;
    v0.x = pk2bf(o0[4 * g] * sc, o0[4 * g + 1] * sc); v0.y = pk2bf(o0[4 * g + 2] * sc, o0[4 * g + 3] * sc);
    v1.x = pk2bf(o1[4 * g] * sc, o1[4 * g + 1] * sc); v1.y = pk2bf(o1[4 * g + 2] * sc, o1[4 * g + 3] * sc);
    *(uint2*)(orow + 8 * g + 4 * h) = v0;
    *(uint2*)(orow + 32 + 8 * g + 4 * h) = v1;
  }
}

DEVI void mla_item(const Params& p, int l, int b, int hd, int qt, unsigned char* lds) {
  const bf16_t* MQ = (const bf16_t*)(p.ws + WS_F);
  const bf16_t* MK = MQ + (size_t)T * 4 * 96;
  const bf16_t* KVR = (const bf16_t*)(p.ws + WS_D) + (size_t)T * 384;
  bf16_t* YA = (bf16_t*)(p.ws + WS_C);
  const int tid = (int)threadIdx.x, wv = tid >> 6, lane = tid & 63, r = lane & 31, h = lane >> 5;
  const int q0 = qt * 256 + wv * 32, tq = q0 + r;
  bf16x8 qf[6];
  {
    const bf16_t* qrow = (const bf16_t*)(p.ws + WS_D) + ((size_t)b * S + tq) * 384 + hd * 96;
    const float* g_q = p.in[8] + l * 96;
    float qv[6][8]; float ss = 0.f;
#pragma unroll
    for (int kk = 0; kk < 6; ++kk) {
      const u32x4 w = *(const u32x4*)(qrow + kk * 16 + h * 8);
#pragma unroll
      for (int e = 0; e < 4; ++e) { qv[kk][2 * e] = __uint_as_float(w[e] << 16); qv[kk][2 * e + 1] = __uint_as_float(w[e] & 0xffff0000u); ss += qv[kk][2 * e] * qv[kk][2 * e] + qv[kk][2 * e + 1] * qv[kk][2 * e + 1]; }
    }
    ss += __shfl_xor(ss, 32);
    const float rs = rsqrtf(ss * (1.f / 96) + EPS) * (0.10206207261596575f * LOG2E);
#pragma unroll
    for (int kk = 0; kk < 6; ++kk)
#pragma unroll
      for (int j = 0; j < 8; ++j) qv[kk][j] *= rs * g_q[kk * 16 + h * 8 + j];
    const float2* cs = (const float2*)(p.ws + WS_ROPE) + ((size_t)b * S + tq) * 16 + 8 * h;
#pragma unroll
    for (int j = 0; j < 8; ++j) { const float2 c2 = cs[j]; const float x1 = qv[0][j], x2 = qv[1][j]; qv[0][j] = x1 * c2.x - x2 * c2.y; qv[1][j] = x1 * c2.y + x2 * c2.x; }
#pragma unroll
    for (int kk = 0; kk < 6; ++kk) { const u32x4 w = {pk2bf(qv[kk][0], qv[kk][1]), pk2bf(qv[kk][2], qv[kk][3]), pk2bf(qv[kk][4], qv[kk][5]), pk2bf(qv[kk][6], qv[kk][7])}; qf[kk] = __builtin_bit_cast(bf16x8, w); }
  }
  FState f; fstate_init(f);
  const bf16_t* kbase = MK + (size_t)(b * 4 + hd) * S * 96;
  const bf16_t* vbase = KVR + (size_t)b * S * 512 + hd * 128 + 64;
  const int ntiles = 4 * qt + 4;
  TileRegs<96> tr;
  TileRegs<96> tr2;
  tile_load<96>(tr, kbase, 96, vbase, 512, 0);
  tile_load<96>(tr2, kbase, 96, vbase, 512, 64);
  __syncthreads();
  tile_store<96>(tr, lds);
  __syncthreads();
  auto compute = [&](int kt, unsigned char* cur) {
    if (kt * 64 <= q0 + 31) {
      f32x16 s0, s1;
      qk_tile<96>((const bf16_t*)cur, qf, s0, s1, r, h);
      if (kt * 64 + 63 > q0) {
        int rel = tq - kt * 64 - 4 * h; asm volatile("" : "+v"(rel));
#pragma unroll
        for (int i = 0; i < 16; ++i) { const int kk2 = (i & 3) + 8 * (i >> 2); if (kk2 > rel) s0[i] = -INFINITY; if (kk2 + 32 > rel) s1[i] = -INFINITY; }
      }
      softmax_pv(f, s0, s1, (const bf16_t*)(cur + att_kbytes<96>()), lane);
    }
  };
#pragma unroll 1
  for (int kt = 0; kt < ntiles; kt += 2) {
    if (kt + 2 < ntiles) tile_load<96>(tr, kbase, 96, vbase, 512, (kt + 2) * 64);
    compute(kt, lds);
    tile_store<96>(tr2, lds + att_buf<96>());
    __syncthreads();
    if (kt + 3 < ntiles) tile_load<96>(tr2, kbase, 96, vbase, 512, (kt + 3) * 64);
    compute(kt + 1, lds + att_buf<96>());
    if (kt + 2 < ntiles) tile_store<96>(tr, lds);
    __syncthreads();
  }
  store_o(YA + (size_t)(b * S + tq) * 256 + hd * 64, f.o0, f.o1, 1.f / f.l, h);
}

template <class KF, class BODY>
DEVI void nsa_stream(unsigned char* lds, const bf16_t* kbase, size_t kstride, const bf16_t* vbase, size_t vstride, bool withv, int nt, KF key0f, BODY body) {
  if (nt <= 0) return;
  TileRegs<64> trA, trB;
  tile_load<64>(trA, kbase, kstride, vbase, vstride, key0f(0), withv);
  if (nt > 1) tile_load<64>(trB, kbase, kstride, vbase, vstride, key0f(1), withv);
  __syncthreads();
  tile_store<64>(trA, lds, withv);
  __syncthreads();
  unsigned char* buf0 = lds; unsigned char* buf1 = lds + att_buf<64>();
#pragma unroll 1
  for (int i = 0; i < nt; i += 2) {
    if (i + 2 < nt) tile_load<64>(trA, kbase, kstride, vbase, vstride, key0f(i + 2), withv);
    body(i, buf0);
    if (i + 1 < nt) tile_store<64>(trB, buf1, withv);
    __syncthreads();
    if (i + 1 >= nt) break;
    if (i + 3 < nt) tile_load<64>(trB, kbase, kstride, vbase, vstride, key0f(i + 3), withv);
    body(i + 1, buf1);
    if (i + 2 < nt) tile_store<64>(trA, buf0, withv);
    __syncthreads();
  }
}
DEVI void nsa_item(const Params& p, int l, int b, int qt, unsigned char* lds) {
  const bf16_t* PROJ = (const bf16_t*)(p.ws + WS_B);
  const bf16_t* KC = (const bf16_t*)(p.ws + SM_KC) + (size_t)b * 128 * 64;
  const bf16_t* VC = (const bf16_t*)(p.ws + SM_VC) + (size_t)b * 128 * 64;
  const int tid = (int)threadIdx.x, wv = tid >> 6, lane = tid & 63, r = lane & 31, h = lane >> 5;
  float* psum = (float*)(lds + 2 * att_buf<64>());
  unsigned* selm = (unsigned*)(lds + 2 * att_buf<64>() + 32768);
  const int t0 = qt * 64, cur = t0 >> 6;
  const int ql = wv * 8 + (r >> 2), hd = r & 3, tq = t0 + ql;
  const size_t tg = (size_t)b * S + tq;
  bf16x8 qf[4];
#pragma unroll
  for (int kk = 0; kk < 4; ++kk) qf[kk] = *(const bf16x8*)((const bf16_t*)(p.ws + WS_G) + tg * 256 + hd * 64 + kk * 16 + h * 8);
  unsigned* ofs = (unsigned*)psum + wv * 1024 + lane;
  const float g0 = sigmoidf_(bf2f(PROJ[tg * DINP + C_NG + hd * 3 + 0]));
  const float g1 = sigmoidf_(bf2f(PROJ[tg * DINP + C_NG + hd * 3 + 1]));
  const float g2 = sigmoidf_(bf2f(PROJ[tg * DINP + C_NG + hd * 3 + 2]));
  FState f; fstate_init(f);
  const int ncmp = (((t0 + 32) >> 4) >> 6) + 1;
  nsa_stream(lds, KC, 64, VC, 64, true, ncmp, [&](int i) { return i * 64; }, [&](int kt, unsigned char* buf) {
    f32x16 s0, s1;
    qk_tile<64>((const bf16_t*)buf, qf, s0, s1, r, h);
    int rel = ((tq - 31) >> 4) - kt * 64 - 4 * h; asm volatile("" : "+v"(rel));
#pragma unroll
    for (int i = 0; i < 16; ++i) { const int kk2 = (i & 3) + 8 * (i >> 2); if (kk2 > rel) s0[i] = -INFINITY; if (kk2 + 32 > rel) s1[i] = -INFINITY; }
    softmax_pv(f, s0, s1, (const bf16_t*)(buf + att_kbytes<64>()), lane);
  });
  {
    const float muse = (f.m == -INFINITY) ? 0.f : f.m;
    const float il = (f.l > 0.f) ? 1.f / f.l : 0.f;
    if (ncmp < 2) {
#pragma unroll 1
      for (int i = tid; i < 64 * 128; i += KTHREADS) psum[i] = 0.f;
      __syncthreads();
    }
    nsa_stream(lds, KC, 64, VC, 64, false, ncmp, [&](int i) { return i * 64; }, [&](int kt, unsigned char* buf) {
      f32x16 s0, s1;
      qk_tile<64>((const bf16_t*)buf, qf, s0, s1, r, h);
      int rel = ((tq - 31) >> 4) - kt * 64 - 4 * h; asm volatile("" : "+v"(rel));
      int cb0 = kt * 64 + 4 * h; asm volatile("" : "+v"(cb0));
#pragma unroll
      for (int i = 0; i < 16; ++i) {
        const int kk2 = (i & 3) + 8 * (i >> 2); const int c = cb0 + kk2;
        float p0 = (kk2 > rel) ? 0.f : fexp2(s0[i] - muse) * il;
        float p1 = (kk2 + 32 > rel) ? 0.f : fexp2(s1[i] - muse) * il;
        p0 += __shfl_xor(p0, 1); p0 += __shfl_xor(p0, 2);
        p1 += __shfl_xor(p1, 1); p1 += __shfl_xor(p1, 2);
        if (hd == 0) { psum[ql * 128 + c] = p0; psum[ql * 128 + c + 32] = p1; }
      }
    });
  }
  __syncthreads();
#pragma unroll 1
  for (int itq = 0; itq < 4; ++itq) {
    const int q2 = wv * 8 + itq * 2 + (lane >> 5), j = lane & 31;
    const float* ps = psum + q2 * 128;
    float imp = 2.f * (ps[4 * j] + ps[4 * j + 1] + ps[4 * j + 2]) + ps[4 * j + 3];
    if (j > 0) imp += ps[4 * j - 1];
    const bool cand = (j >= 1) && (j <= cur - 2);
    int rank = 0;
    for (int jj = 0; jj < 32; ++jj) {
      const float v = __shfl(imp, (lane & 32) | jj);
      const bool cj = (jj >= 1) && (jj <= cur - 2);
      if (cj && (v > imp || (v == imp && jj < j))) ++rank;
    }
    const bool sel = cand && rank < 2;
    const unsigned long long bal = __ballot(sel);
    unsigned mk = (unsigned)(bal >> (32 * (lane >> 5)));
    mk |= 1u | (1u << cur); if (cur >= 1) mk |= (1u << (cur - 1));
    if (j == 0) selm[q2] = mk;
  }
  __syncthreads();
  unsigned blk_or = 0, wave_or = 0;
  for (int i = 0; i < 64; ++i) blk_or |= selm[i];
  for (int i = 0; i < 8; ++i) wave_or |= selm[wv * 8 + i];
  const unsigned mymask = selm[ql];
  {
    const float sc = (f.l > 0.f) ? g0 / f.l : 0.f;
#pragma unroll
    for (int i = 0; i < 8; ++i) { ofs[i * 64] = pk2bf(f.o0[2 * i] * sc, f.o0[2 * i + 1] * sc); ofs[(8 + i) * 64] = pk2bf(f.o1[2 * i] * sc, f.o1[2 * i + 1] * sc); }
  }
  fstate_init(f);
  {
    unsigned* tl = selm + 64;
    if (tid < 32 && ((blk_or >> tid) & 1u)) tl[__popc(blk_or & ((1u << tid) - 1u))] = tid;
    __syncthreads();
    const int nsel = __popc(blk_or);
    nsa_stream(lds, (const bf16_t*)(p.ws + WS_G) + (size_t)T * 256 + (size_t)b * S * 64, 64, PROJ + (size_t)b * S * DINP + C_VS, DINP, true, nsel,
      [&](int i) { return (int)tl[i] * 64; },
      [&](int i, unsigned char* buf) {
        const int jj = (int)tl[i];
        if ((wave_or >> jj) & 1u) {
          f32x16 s0, s1;
          qk_tile<64>((const bf16_t*)buf, qf, s0, s1, r, h);
          const bool on = (mymask >> jj) & 1u;
          int rel = on ? (tq - jj * 64 - 4 * h) : -1; asm volatile("" : "+v"(rel));
#pragma unroll
          for (int i2 = 0; i2 < 16; ++i2) { const int kk2 = (i2 & 3) + 8 * (i2 >> 2); if (kk2 > rel) s0[i2] = -INFINITY; if (kk2 + 32 > rel) s1[i2] = -INFINITY; }
          softmax_pv(f, s0, s1, (const bf16_t*)(buf + att_kbytes<64>()), lane);
        }
      });
    const float sc = (f.l > 0.f) ? g1 / f.l : 0.f;
#pragma unroll
    for (int i = 0; i < 8; ++i) {
      const unsigned w0 = ofs[i * 64], w1 = ofs[(8 + i) * 64];
      ofs[i * 64] = pk2bf(__uint_as_float(w0 << 16) + f.o0[2 * i] * sc, __uint_as_float(w0 & 0xffff0000u) + f.o0[2 * i + 1] * sc);
      ofs[(8 + i) * 64] = pk2bf(__uint_as_float(w1 << 16) + f.o1[2 * i] * sc, __uint_as_float(w1 & 0xffff0000u) + f.o1[2 * i + 1] * sc);
    }
  }
  fstate_init(f);
  {
    int jlo = (t0 - 511) >> 6; if (jlo < 0) jlo = 0;
    nsa_stream(lds, (const bf16_t*)(p.ws + WS_G) + (size_t)T * 320 + (size_t)b * S * 64, 64, PROJ + (size_t)b * S * DINP + C_VW, DINP, true, cur - jlo + 1,
      [&](int i) { return (jlo + i) * 64; },
      [&](int i, unsigned char* buf) {
        const int j = jlo + i;
        f32x16 s0, s1;
        qk_tile<64>((const bf16_t*)buf, qf, s0, s1, r, h);
        if (j == cur || j * 64 < t0 + 63 - 511 + 64) {
          int rel = tq - j * 64 - 4 * h; asm volatile("" : "+v"(rel));
#pragma unroll
          for (int i2 = 0; i2 < 16; ++i2) {
            const int kk2 = (i2 & 3) + 8 * (i2 >> 2);
            if (kk2 > rel || kk2 < rel - 511) s0[i2] = -INFINITY;
            if (kk2 + 32 > rel || kk2 + 32 < rel - 511) s1[i2] = -INFINITY;
          }
        }
        softmax_pv(f, s0, s1, (const bf16_t*)(buf + att_kbytes<64>()), lane);
      });
    const float sc = (f.l > 0.f) ? g2 / f.l : 0.f;
#pragma unroll
    for (int i = 0; i < 8; ++i) {
      const unsigned w0 = ofs[i * 64], w1 = ofs[(8 + i) * 64];
      f.o0[2 * i] = __uint_as_float(w0 << 16) + f.o0[2 * i] * sc; f.o0[2 * i + 1] = __uint_as_float(w0 & 0xffff0000u) + f.o0[2 * i + 1] * sc;
      f.o1[2 * i] = __uint_as_float(w1 << 16) + f.o1[2 * i] * sc; f.o1[2 * i + 1] = __uint_as_float(w1 & 0xffff0000u) + f.o1[2 * i + 1] * sc;
    }
  }
  f32x16& of0 = f.o0; f32x16& of1 = f.o1;
  {
    float ss = 0.f;
#pragma unroll
    for (int i = 0; i < 16; ++i) ss += of0[i] * of0[i] + of1[i] * of1[i];
    ss += __shfl_xor(ss, 1); ss += __shfl_xor(ss, 2); ss += __shfl_xor(ss, 32);
    const float rs = rsqrtf(ss * (1.f / 256) + EPS);
    const float* on = p.in[35] + l * 1024 + 768 + hd * 64;
#pragma unroll
    for (int g4 = 0; g4 < 4; ++g4) {
      const float4 a = *(const float4*)(on + 8 * g4 + 4 * h), b4 = *(const float4*)(on + 32 + 8 * g4 + 4 * h);
      of0[4 * g4] *= a.x; of0[4 * g4 + 1] *= a.y; of0[4 * g4 + 2] *= a.z; of0[4 * g4 + 3] *= a.w;
      of1[4 * g4] *= b4.x; of1[4 * g4 + 1] *= b4.y; of1[4 * g4 + 2] *= b4.z; of1[4 * g4 + 3] *= b4.w;
    }
    store_o((bf16_t*)(p.ws + WS_A) + tg * 1024 + 768 + hd * 64, of0, of1, rs, h);
  }
}

DEVI void carry_item(const Params& p, int l, int it) {
  const int tid = HTID;
  if (it < 64) {
    const int idx = it * 256 + tid, b = idx >> 10, gs = idx & 1023;
    const float2 a64 = ((const float2*)(p.ws + WS_W + l * WS_WL + W_S5A64))[gs];
    const float2* SLOC = (const float2*)(p.ws + SM_SLOC) + (size_t)b * 32 * 1024 + gs;
    float2* SCAR = (float2*)(p.ws + SM_SCAR) + (size_t)b * 32 * 1024 + gs;
    float hr = 0.f, hi = 0.f;
#pragma unroll 1
    for (int c0 = 0; c0 < 32; c0 += 8) {
      float2 sl[8];
#pragma unroll
      for (int i = 0; i < 8; ++i) sl[i] = SLOC[(size_t)(c0 + i) * 1024];
#pragma unroll
      for (int i = 0; i < 8; ++i) { SCAR[(size_t)(c0 + i) * 1024] = make_float2(hr, hi); const float nr = a64.x * hr - a64.y * hi + sl[i].x, ni = a64.x * hi + a64.y * hr + sl[i].y; hr = nr; hi = ni; }
    }
  } else {
    const int idx = (it - 64) * 256 + tid, b = idx >> 8, c = idx & 255;
    const float2* LSUM = (const float2*)(p.ws + SM_LSUM) + (size_t)b * 32 * 256 + c;
    float* LCAR = (float*)(p.ws + SM_LCAR) + (size_t)b * 32 * 256 + c;
    float hh = 0.f;
#pragma unroll 1
    for (int c0 = 0; c0 < 32; c0 += 8) {
      float2 sv[8];
#pragma unroll
      for (int i = 0; i < 8; ++i) sv[i] = LSUM[(size_t)(c0 + i) * 256];
#pragma unroll
      for (int i = 0; i < 8; ++i) { LCAR[(size_t)(c0 + i) * 256] = hh; hh = sv[i].x * hh + sv[i].y; }
    }
  }
}
DEVI void phase_a1(const Params& p, int l, unsigned char* lds_full) {
  for (int it = VBID; it < 80; it += VGRID) carry_item(p, l, it);
  __syncthreads();
  const int G_ = (int)gridDim.x, bx_ = (int)blockIdx.x, vb_ = (G_ % 8 == 0) ? (bx_ % 8) * (G_ / 8) + bx_ / 8 : bx_;
  for (int rr = 0; rr * G_ < 512; ++rr) { const int j = rr * G_ + ((rr & 1) ? (G_ - 1 - vb_) : vb_); if (j < 512) { const int b = j >> 5, qt = 31 - (j & 31); nsa_item(p, l, b, qt, lds_full); } }
  __syncthreads();
  for (int rr = 0; rr * G_ < 512; ++rr) { const int j = rr * G_ + ((rr & 1) ? (G_ - 1 - vb_) : vb_); if (j < 512) { const int bh = j >> 3, qt = 7 - (j & 7); mla_item(p, l, bh >> 2, bh & 3, qt, lds_full); } }
}

DEVI void phase_r3(const Params& p, int l, unsigned char* lds) {
  bf16_t* Y = (bf16_t*)(p.ws + WS_A);
  const int tid = HTID, lane = tid & 63, wv = tid >> 6;
  {
    const float* onorm = p.in[35] + l * 1024 + 256;
    float* tile = (float*)lds;
    for (int it = VBID; it < NB * 32; it += VGRID) {
      const int b = it >> 5, chunk = it & 31;
      hsync();
      lru_chunk<true>(p, l, b, chunk, tile);
      hsync();
      for (int k = wv; k < 64; k += 4) {
        const float4 v = *(const float4*)(tile + k * 256 + lane * 4);
        const float rs = rsqrtf(wsum(v.x * v.x + v.y * v.y + v.z * v.z + v.w * v.w) * (1.f / 256) + EPS);
        const size_t t = (size_t)b * S + chunk * 64 + k;
        const float4 gg = *(const float4*)(onorm + lane * 4);
        st_bf16x4(Y + t * 1024 + 256 + lane * 4, (f32x4){v.x * rs * gg.x, v.y * rs * gg.y, v.z * rs * gg.z, v.w * rs * gg.w});
      }
    }
  }
  hsync();
  for (int it = VBID; it < NB * 32; it += VGRID) s5_chunk<true>(p, l, it >> 5, it & 31, lds);
}

DEVI void phase_g3(const Params& p, int l, unsigned char* lds) {
  const bf16_t* YCP = (const bf16_t*)(p.ws + WS_F);
  bf16_t* YC = (bf16_t*)(p.ws + WS_F) + (size_t)T * 256;
  const bf16_t* W = (const bf16_t*)(p.ws + WS_W + l * WS_WL + W_GLU);
  const float* bg = p.in[26] + l * 256;
  for (int it = vblock(); it < 256 * 2; it += VGRID) {
    const int mt = it >> 1, nt = it & 1;
    f32x4 acc[4][4];
    gemm128g(lds, 256, [&](int r, int k) { return YCP + (size_t)(mt * 128 + r) * 256 + k; }, [&](int r, int k) { return W + (size_t)(nt * 128 + r) * 256 + k; }, acc);
    GEMM_EPI4({ const size_t o = (size_t)(mt * 128 + er) * 256 + nt * 128 + ec0; const ushort4 yp = *(const ushort4*)(YCP + o); f32x4 r4; r4[0] = bf2f(yp.x) * sigmoidf_(ev4[0] + bg[nt * 128 + ec0]); r4[1] = bf2f(yp.y) * sigmoidf_(ev4[1] + bg[nt * 128 + ec0 + 1]); r4[2] = bf2f(yp.z) * sigmoidf_(ev4[2] + bg[nt * 128 + ec0 + 2]); r4[3] = bf2f(yp.w) * sigmoidf_(ev4[3] + bg[nt * 128 + ec0 + 3]); st_bf16x4(YC + o, r4); })
  }
}

DEVI void phase_r4(const Params& p, int l) {
  const bf16_t* YA = (const bf16_t*)(p.ws + WS_C);
  const bf16_t* YC = (const bf16_t*)(p.ws + WS_F) + (size_t)T * 256;
  bf16_t* Y = (bf16_t*)(p.ws + WS_A);
  const float* onorm = p.in[35] + l * 1024;
  const int lane = HTID & 63, gw = VBID * 4 + (HTID >> 6), NGW = VGRID * 4;
  for (int t = gw; t < T; t += NGW) {
#pragma unroll
    for (int grp = 0; grp < 2; ++grp) {
      const bf16_t* src = (grp == 0 ? YA : YC) + (size_t)t * 256;
      const int gcol = (grp == 0 ? 0 : 512);
      const ushort4 u = ((const ushort4*)src)[lane];
      const float v0 = bf2f(u.x), v1 = bf2f(u.y), v2 = bf2f(u.z), v3 = bf2f(u.w);
      const float rs = rsqrtf(wsum(v0 * v0 + v1 * v1 + v2 * v2 + v3 * v3) * (1.f / 256) + EPS);
      const float4 g = ((const float4*)(onorm + gcol))[lane];
      uint2 o; o.x = pk2bf(v0 * rs * g.x, v1 * rs * g.y); o.y = pk2bf(v2 * rs * g.z, v3 * rs * g.w);
      ((uint2*)(Y + (size_t)t * 1024 + gcol))[lane] = o;
    }
  }
}

DEVI void phase_g4(const Params& p, int l, unsigned char* lds_full) {
  const bf16_t* Y = (const bf16_t*)(p.ws + WS_A);
  const bf16_t* W = (const bf16_t*)(p.ws + WS_W + l * WS_WL + W_OUT);
  pg8::Gemm g{Y, W, T, D, D}; pg8::StaticOrder S; S.init(T, D, (int)gridDim.x, (int)blockIdx.x);
  bf16_t* X1 = (bf16_t*)(p.ws + WS_D);
  if (l == 0) { EpiRes<false> E{p.in[0], nullptr, X1}; pg8::gemm_phase<EpiRes<false>, pg8::StaticOrder, true, true>((LAS unsigned char*)lds_full, g, S, E); }
  else { EpiRes<true> E{nullptr, (const bf16_t*)p.out, X1}; pg8::gemm_phase<EpiRes<true>, pg8::StaticOrder, true, true>((LAS unsigned char*)lds_full, g, S, E); }
}

DEVI void phase_r5(const Params& p, int l, unsigned char* lds) {
  const bf16_t* x1 = (const bf16_t*)(p.ws + WS_D);
  const bf16_t* WH = (const bf16_t*)(p.ws + WS_W + l * WS_WL + W_RTH);
  const bf16_t* WL = (const bf16_t*)(p.ws + WS_W + l * WS_WL + W_RTL);
  const float* brg = p.in[39] + l * 4; const float* bre = p.in[41] + l * 16;
  int* CNT = (int*)(p.ws + SM_CNT) + l * 32;
  int* LIST = (int*)(p.ws + SM_LIST);
  float4* TOKW = (float4*)(p.ws + SM_TOKW);
  const int tid = HTID, lane = tid & 63, wv = tid >> 6, c = lane & 15, q = lane >> 4;
  int* hist = (int*)(lds + 16384);
  int* tokl = (int*)(lds + 16384 + 256);
  if (tid < 64) hist[tid] = 0;
  hsync();
  const int NW = VGRID * 4, wbase = VBID * 4;
  const int nit = (T / 16 - wbase + NW - 1) / NW;
  const bf16_t* wh0 = WH + (size_t)c * 1024 + 8 * q;
  const bf16_t* wl0 = WL + (size_t)c * 1024 + 8 * q;
#pragma unroll 1
  for (int n = 0; n < nit; ++n) {
    const int it = wbase + wv + n * NW;
    int* tl2 = tokl + 2 * ((n * 4 + wv) * 16 + c);
    if (it >= T / 16) { if (q == 0) { tl2[0] = -1; tl2[1] = 0; } continue; }
    const size_t tb = (size_t)it * 16;
    f32x4 a0 = (f32x4){0.f, 0.f, 0.f, 0.f}, a1 = (f32x4){0.f, 0.f, 0.f, 0.f};
    float ss = 0.f;
    const bf16_t* xrow = x1 + (tb + c) * D + 8 * q;
    u32x4 xk[8], xn[8];
#pragma unroll
    for (int ks = 0; ks < 8; ++ks) xk[ks] = *(const u32x4*)(xrow + ks * 32);
#pragma unroll
    for (int kc = 0; kc < 4; ++kc) {
      if (kc < 3) {
#pragma unroll
        for (int ks = 0; ks < 8; ++ks) xn[ks] = *(const u32x4*)(xrow + (kc + 1) * 256 + ks * 32);
      }
#pragma unroll
      for (int ks = 0; ks < 8; ++ks) {
        const int ko = kc * 256 + ks * 32;
        const bf16x8 wh_a = *(const bf16x8*)(wh0 + ko), wl_a = *(const bf16x8*)(wl0 + ko);
        const bf16x8 wh_b = *(const bf16x8*)(wh0 + 16 * 1024 + ko), wl_b = *(const bf16x8*)(wl0 + 16 * 1024 + ko);
#pragma unroll
        for (int j = 0; j < 4; ++j) {
          const float x0 = __uint_as_float(xk[ks][j] << 16), x1v = __uint_as_float(xk[ks][j] & 0xffff0000u);
          ss += x0 * x0 + x1v * x1v;
        }
        const bf16x8 xh = __builtin_bit_cast(bf16x8, xk[ks]);
        a0 = mfma16(wh_a, xh, a0); a0 = mfma16(wl_a, xh, a0);
        a1 = mfma16(wh_b, xh, a1); a1 = mfma16(wl_b, xh, a1);
      }
      if (kc < 3) {
#pragma unroll
        for (int ks = 0; ks < 8; ++ks) xk[ks] = xn[ks];
      }
    }
    ss += __shfl_xor(ss, 16); ss += __shfl_xor(ss, 32);
    const float rs = rsqrtf(ss * (1.f / D) + EPS);
    {
      float c0[4], c1[4];
#pragma unroll
      for (int j = 0; j < 4; ++j) { c0[j] = a0[j]; c1[j] = a1[j]; }
      float lg[20];
#pragma unroll
      for (int qq = 0; qq < 4; ++qq)
#pragma unroll
        for (int j = 0; j < 4; ++j) lg[4 * qq + j] = __shfl(c0[j], c + 16 * qq);
#pragma unroll
      for (int j = 0; j < 4; ++j) lg[16 + j] = __shfl(c1[j], c);
      const int t = (int)tb + c;
      float gl[4];
#pragma unroll
      for (int k2 = 0; k2 < 4; ++k2) gl[k2] = lg[k2] * rs + brg[k2];
      int gi = 0; float gbest = gl[0];
#pragma unroll
      for (int k2 = 1; k2 < 4; ++k2) if (gl[k2] > gbest) { gbest = gl[k2]; gi = k2; }
      float den = 0.f;
#pragma unroll
      for (int k2 = 0; k2 < 4; ++k2) den += expf(gl[k2] - gbest);
      const float pg = 1.f / den;
      float le[4];
#pragma unroll
      for (int k2 = 0; k2 < 4; ++k2) { float sel = 0.f;
#pragma unroll
        for (int gg2 = 0; gg2 < 4; ++gg2) sel = (gi == gg2) ? (lg[4 + gg2 * 4 + k2] * rs + bre[gg2 * 4 + k2]) : sel;
        le[k2] = sel; }
      int i0 = 0; float l0 = le[0];
#pragma unroll
      for (int k2 = 1; k2 < 4; ++k2) if (le[k2] > l0) { l0 = le[k2]; i0 = k2; }
      int i1 = -1; float l1 = -INFINITY;
#pragma unroll
      for (int k2 = 0; k2 < 4; ++k2) if (k2 != i0 && le[k2] > l1) { l1 = le[k2]; i1 = k2; }
      const float e1 = expf(l1 - l0);
      const float w0 = pg / (1.f + e1), w1 = pg * e1 / (1.f + e1);
      const int elo = (i0 < i1) ? i0 : i1, ehi = (i0 < i1) ? i1 : i0;
      const float wlo = (i0 < i1) ? w0 : w1, whi = (i0 < i1) ? w1 : w0;
      const int pidx = (elo == 0) ? (ehi - 1) : ((elo == 1) ? (ehi + 1) : 5);
      const int cls = gi * 6 + pidx;
      if (q == 0) {
        const int rank = atomicAdd(&hist[cls], 1);
        tl2[0] = t; tl2[1] = (cls << 16) | rank;
        TOKW[t] = make_float4(wlo, whi, rs, 0.f);
      }
    }
  }
  __syncthreads();
  if (threadIdx.x < 24) {
    int* h0 = (int*)(lds - hb_() * LDS_HALF + 16384); int* h1 = (int*)(lds - hb_() * LDS_HALF + LDS_HALF + 16384);
    const int n0 = h0[threadIdx.x], n1 = h1[threadIdx.x];
    const int base = (n0 + n1) ? atomicAdd(&CNT[threadIdx.x], n0 + n1) : 0;
    h0[32 + threadIdx.x] = base; h1[32 + threadIdx.x] = base + n0;
  }
  __syncthreads();
  for (int i = tid; i < nit * 64; i += NTHREADS) { const int t = tokl[2 * i], cr = tokl[2 * i + 1], cls = cr >> 16; if (t >= 0) LIST[(size_t)cls * T + hist[32 + cls] + (cr & 0xffff)] = t; }
}

struct MoeItem { int cls, mtile, nt, cnt; };
DEVI void moe_prefix(const int* CNT, unsigned char* lds) {
  int* pre = (int*)(lds + LDS_BYTES + 64);
  hsync();
  if (HTID < 24) pre[32 + HTID] = CNT[HTID];
  hsync();
  if (HTID == 0) { int a = 0; for (int c = 0; c < 24; ++c) { pre[c] = a; a += (pre[32 + c] + 127) >> 7; } pre[24] = a; }
  hsync();
}
DEVI bool moe_item(unsigned char* lds, int it, MoeItem& m) {
  const int* pre = (const int*)(lds + LDS_BYTES + 64);
  const int mt = it >> 3; m.nt = it & 7;
  if (mt >= pre[24]) return false;
  int c = 0;
#pragma unroll
  for (int q = 1; q < 24; ++q) c += (mt >= pre[q]) ? 1 : 0;
  m.cls = c; m.mtile = mt - pre[c]; m.cnt = pre[32 + c];
  return true;
}
DEVI void cls_experts(int cls, int& e0, int& e1) {
  const int g = cls / 6, pi = cls % 6;
  const int lo = (pi < 3) ? 0 : ((pi < 5) ? 1 : 2);
  const int hi = (pi < 3) ? (pi + 1) : ((pi < 5) ? (pi - 1) : 3);
  e0 = g * 4 + lo; e1 = g * 4 + hi;
}
DEVI void phase_g5(const Params& p, int l, unsigned char* lds) {
  const bf16_t* XN = (const bf16_t*)(p.ws + WS_D);
  bf16_t* HID = (bf16_t*)(p.ws + WS_B);
  const bf16_t* WGU = (const bf16_t*)(p.ws + WS_W + l * WS_WL + W_GU);
  const int* CNT = (const int*)(p.ws + SM_CNT) + l * 32;
  const int* LIST = (const int*)(p.ws + SM_LIST);
  const float4* TOKW = (const float4*)(p.ws + SM_TOKW);
  moe_prefix(CNT, lds);
  const int G_ = VGRID, total_ = ((const int*)(lds + LDS_BYTES + 64))[24] * 8, full_ = (total_ / G_) * G_, rem_ = total_ - full_;
  for (int it = vblock(); it < full_ + 2 * rem_; it += G_) {
    const bool halfmode = it >= full_; const int half = (it - full_) & 1;
    MoeItem mi; if (!moe_item(lds, halfmode ? full_ + ((it - full_) >> 1) : it, mi)) break;
    int e0, e1; cls_experts(mi.cls, e0, e1);
    const int ex = (mi.nt < 4) ? e0 : e1, ntl = mi.nt & 3;
    const bf16_t* W = WGU + ((size_t)ex * 512 + ntl * 128) * 1024;
    const int* list = LIST + (size_t)mi.cls * T + mi.mtile * 128;
    const int nvalid = mi.cnt - mi.mtile * 128;
    if (halfmode) {
      f32x4 acc2[2][4];
      int tokA[4];
#pragma unroll
      for (int i = 0; i < 4; ++i) { const int r = (HTID >> 3) + 32 * i; tokA[i] = list[(r < nvalid) ? r : 0]; }
      const int tid = HTID, wid = tid >> 6, lane = tid & 63, fr = lane & 15, fq = lane >> 4;
      int tokE2[2]; float twE2[2], rsE2[2];
#pragma unroll
      for (int m = 0; m < 2; ++m) { const int er = wid * 32 + m * 16 + fr; tokE2[m] = list[(er < nvalid) ? er : 0]; }
#pragma unroll
      for (int m = 0; m < 2; ++m) { const float4 tw = TOKW[tokE2[m]]; twE2[m] = (mi.nt < 4) ? tw.x : tw.y; rsE2[m] = tw.z; }
      const bf16_t* Wh = W + (size_t)half * 64 * 1024;
      gemm128h(lds, D, [&](int r, int k) { const int i = r >> 5; const int tok = (i == 0) ? tokA[0] : (i == 1) ? tokA[1] : (i == 2) ? tokA[2] : tokA[3]; return XN + (size_t)tok * D + k; },
               [&](int r, int k) { return Wh + (size_t)r * D + k; }, acc2);
#pragma unroll
      for (int m = 0; m < 2; ++m) {
        const int er = wid * 32 + m * 16 + fr;
        if (er < nvalid) {
#pragma unroll
          for (int n = 0; n < 2; ++n) {
            f32x4 hv;
#pragma unroll
            for (int j = 0; j < 4; ++j) { const float gt = acc2[m][n][j] * rsE2[m], up = acc2[m][n + 2][j] * rsE2[m]; hv[j] = gt * sigmoidf_(gt) * up * twE2[m]; }
            st_bf16x4(HID + (size_t)tokE2[m] * 512 + (mi.nt < 4 ? 0 : 256) + ntl * 64 + half * 32 + n * 16 + fq * 4, hv);
          }
        }
      }
      continue;
    }
    f32x4 acc[4][4];
    int tokA[4], tokE[4]; float twE[4], rsE[4];
#pragma unroll
    for (int i = 0; i < 4; ++i) { const int r = (HTID >> 3) + 32 * i; tokA[i] = list[(r < nvalid) ? r : 0]; }
    {
      const int tid_ = HTID, er0 = ((tid_ >> 6) >> 1) * 64 + (tid_ & 15);
#pragma unroll
      for (int m = 0; m < 4; ++m) { const int er = er0 + m * 16; tokE[m] = list[(er < nvalid) ? er : 0]; }
#pragma unroll
      for (int m = 0; m < 4; ++m) { const float4 tw = TOKW[tokE[m]]; twE[m] = (mi.nt < 4) ? tw.x : tw.y; rsE[m] = tw.z; }
    }
    gemm128g(lds, D, [&](int r, int k) { const int i = r >> 5; const int tok = (i == 0) ? tokA[0] : (i == 1) ? tokA[1] : (i == 2) ? tokA[2] : tokA[3]; return XN + (size_t)tok * D + k; }, [&](int r, int k) { return W + (size_t)r * D + k; }, acc);
    {
      const int tid = HTID, wid = tid >> 6, lane = tid & 63, wr = wid >> 1, wc = wid & 1, fr = lane & 15, fq = lane >> 4;
#pragma unroll
      for (int m = 0; m < 4; ++m) {
        const int er = wr * 64 + m * 16 + fr;
        if (er < nvalid) {
          const int tok = tokE[m];
          const float w = twE[m], rsm = rsE[m];
#pragma unroll
          for (int n = 0; n < 2; ++n) {
            f32x4 hv;
#pragma unroll
            for (int j = 0; j < 4; ++j) { const float gt = acc[m][n][j] * rsm, up = acc[m][n + 2][j] * rsm; hv[j] = gt * sigmoidf_(gt) * up * w; }
            const int hh = (mi.nt < 4 ? 0 : 256) + ntl * 64 + wc * 32 + n * 16 + fq * 4;
            st_bf16x4(HID + (size_t)tok * 512 + hh, hv);
          }
        }
      }
    }
  }
}
DEVI void phase_g6(const Params& p, int l, unsigned char* lds) {
  const bf16_t* HID = (const bf16_t*)(p.ws + WS_B);
  const bf16_t* WDN = (const bf16_t*)(p.ws + WS_W + l * WS_WL + W_DN);
  const int* CNT = (const int*)(p.ws + SM_CNT) + l * 32;
  const int* LIST = (const int*)(p.ws + SM_LIST);
  float* out = p.out;
  bf16_t* out16 = (bf16_t*)p.out;
  const bf16_t* X1 = (const bf16_t*)(p.ws + WS_D);
  float* PART = (float*)(p.ws + WS_PART);
  moe_prefix(CNT, lds);
  const int G_ = VGRID, total_ = ((const int*)(lds + LDS_BYTES + 64))[24] * 8, full_ = (total_ / G_) * G_, rem_ = total_ - full_;
  for (int it = vblock(); it < full_ + 2 * rem_; it += G_) {
    const bool halfmode = it >= full_; const int half = (it - full_) & 1;
    MoeItem mi; if (!moe_item(lds, halfmode ? full_ + ((it - full_) >> 1) : it, mi)) break;
    int e0, e1; cls_experts(mi.cls, e0, e1);
    const int* list = LIST + (size_t)mi.cls * T + mi.mtile * 128;
    const int nvalid = mi.cnt - mi.mtile * 128;
    const bf16_t* W0 = WDN + ((size_t)e0 * 1024 + mi.nt * 128) * 256;
    const bf16_t* W1 = WDN + ((size_t)e1 * 1024 + mi.nt * 128) * 256;
    if (halfmode) {
      f32x4 acc2[2][4];
      int tokA[4];
#pragma unroll
      for (int i = 0; i < 4; ++i) { const int r = (HTID >> 3) + 32 * i; tokA[i] = list[(r < nvalid) ? r : 0]; }
      const int tid = HTID, wid = tid >> 6, lane = tid & 63, fr = lane & 15, fq = lane >> 4;
      int trow2[2];
#pragma unroll
      for (int m = 0; m < 2; ++m) { const int er = wid * 32 + m * 16 + fr; trow2[m] = list[(er < nvalid) ? er : 0]; }
      const bf16_t* W0h = W0 + (size_t)half * 64 * 256; const bf16_t* W1h = W1 + (size_t)half * 64 * 256;
      gemm128h(lds, 512, [&](int r, int k) { const int i = r >> 5; const int tok = (i == 0) ? tokA[0] : (i == 1) ? tokA[1] : (i == 2) ? tokA[2] : tokA[3]; return HID + (size_t)tok * 512 + k; },
               [&](int r, int k) { return ((k < 256) ? W0h : W1h) + (size_t)r * 256 + (k & 255); }, acc2);
      float ssq[2] = {0.f, 0.f};
      uint2 xres2[2][4];
#pragma unroll
      for (int m = 0; m < 2; ++m)
#pragma unroll
        for (int n = 0; n < 4; ++n) xres2[m][n] = *(const uint2*)(X1 + (size_t)trow2[m] * D + mi.nt * 128 + half * 64 + n * 16 + fq * 4);
#pragma unroll
      for (int m = 0; m < 2; ++m) {
        const int er = wid * 32 + m * 16 + fr;
        if (er < nvalid) {
#pragma unroll
          for (int n = 0; n < 4; ++n) {
            const size_t o = (size_t)trow2[m] * D + mi.nt * 128 + half * 64 + n * 16 + fq * 4;
            const uint2 xu = xres2[m][n];
            const f32x4 r4 = (f32x4){__uint_as_float(xu.x << 16), __uint_as_float(xu.x & 0xffff0000u), __uint_as_float(xu.y << 16), __uint_as_float(xu.y & 0xffff0000u)} + acc2[m][n];
            if (l == 0) { st_bf16x4(out16 + o, r4); ssq[m] += r4[0] * r4[0] + r4[1] * r4[1] + r4[2] * r4[2] + r4[3] * r4[3]; } else *(f32x4*)(out + o) = r4;
          }
        }
      }
      if (l == 0) {
#pragma unroll
        for (int m = 0; m < 2; ++m) { float q2 = ssq[m]; q2 += __shfl_xor(q2, 16); q2 += __shfl_xor(q2, 32); const int er = wid * 32 + m * 16 + fr; if (fq == 0 && er < nvalid) PART[(size_t)trow2[m] * 16 + mi.nt * 2 + half] = q2; }
      }
      continue;
    }
    f32x4 acc[4][4];
    int trow[4], tokA[4];
    {
      const int tid = HTID, wid = tid >> 6, lane = tid & 63, wr = wid >> 1, fr = lane & 15;
#pragma unroll
      for (int i = 0; i < 4; ++i) { const int r = (tid >> 3) + 32 * i; tokA[i] = list[(r < nvalid) ? r : 0]; }
#pragma unroll
      for (int m = 0; m < 4; ++m) { const int er = wr * 64 + m * 16 + fr; trow[m] = list[(er < nvalid) ? er : 0]; }
    }
    gemm128g(lds, 512, [&](int r, int k) { const int i = r >> 5; const int tok = (i == 0) ? tokA[0] : (i == 1) ? tokA[1] : (i == 2) ? tokA[2] : tokA[3]; return HID + (size_t)tok * 512 + k; },
            [&](int r, int k) { return ((k < 256) ? W0 : W1) + (size_t)r * 256 + (k & 255); }, acc);
    float ssq[4] = {0.f, 0.f, 0.f, 0.f};
    uint2 xres[4][4];
    GEMM_EPI4({ const size_t o = (size_t)trow[m] * D + mi.nt * 128 + ec0; xres[m][n] = *(const uint2*)(X1 + o); })
    GEMM_EPI4({ if (er < nvalid) { const size_t o = (size_t)trow[m] * D + mi.nt * 128 + ec0; const uint2 xu = xres[m][n];
      f32x4 r4; r4[0] = __uint_as_float(xu.x << 16) + ev4[0]; r4[1] = __uint_as_float(xu.x & 0xffff0000u) + ev4[1]; r4[2] = __uint_as_float(xu.y << 16) + ev4[2]; r4[3] = __uint_as_float(xu.y & 0xffff0000u) + ev4[3];
      if (l == 0) { st_bf16x4(out16 + o, r4); ssq[m] += r4[0] * r4[0] + r4[1] * r4[1] + r4[2] * r4[2] + r4[3] * r4[3]; } else *(f32x4*)(out + o) = r4; } })
    if (l == 0) {
      const int tid = HTID, wid = tid >> 6, lane = tid & 63, wr = wid >> 1, wc = wid & 1, fr = lane & 15, fq = lane >> 4;
#pragma unroll
      for (int m = 0; m < 4; ++m) { float q2 = ssq[m]; q2 += __shfl_xor(q2, 16); q2 += __shfl_xor(q2, 32); const int er = wr * 64 + m * 16 + fr; if (fq == 0 && er < nvalid) PART[(size_t)trow[m] * 16 + mi.nt * 2 + wc] = q2; }
    }
  }
}


#define XB_TMO      128
#define XB_XCNT(j)  (256  + 64 * (j))
#define XB_XSUB(j)  (1280 + 64 * (j))
#define XB_XGEN(j)  (2304 + 64 * (j))
#define XB_TOP      3328
#define XB_TOPGEN   3392
#define XCD_BAR_WORDS 3456
#define XB_SPIN_CAP (1u << 18)
DEVI unsigned xb_ld(unsigned* p)              { return __hip_atomic_load(p, __ATOMIC_RELAXED, __HIP_MEMORY_SCOPE_AGENT); }
DEVI unsigned xb_add(unsigned* p, unsigned v) { return __hip_atomic_fetch_add(p, v, __ATOMIC_RELAXED, __HIP_MEMORY_SCOPE_AGENT); }
DEVI unsigned xb_xcc_id() { return (unsigned)__builtin_amdgcn_s_getreg((3 << 11) | 20) & 0xFu; }
#define XB_SPIN(cond, bar) do { unsigned _sp = 0; while (cond) { __builtin_amdgcn_s_sleep(1); \
    if ((++_sp & 255u) == 0u) { if (xb_ld(&(bar)[XB_TMO])) break; if (_sp > XB_SPIN_CAP) { atomicAdd(&(bar)[XB_TMO], 1u); break; } } } } while (0)
struct XcdBarrier { unsigned* bar; unsigned x; volatile LAS unsigned* st; };
DEVI XcdBarrier xcd_barrier_post(unsigned* bar, volatile LAS unsigned* st) {
    XcdBarrier b; b.bar = bar; b.x = xb_xcc_id(); b.st = st;
    if (threadIdx.x == 0) (void)xb_add(&bar[XB_XCNT(b.x)], 1u);
    return b;
}
DEVI void xcd_barrier_complete(unsigned* bar, unsigned x, unsigned& nloc, unsigned& nx) {
    const unsigned G = gridDim.x * gridDim.y * gridDim.z;
    unsigned sum, cnt, mine, sp = 0u;
    for (;;) {
        sum = 0u; cnt = 0u; mine = 0u;
#pragma unroll
        for (unsigned j = 0; j < 16; ++j) { const unsigned c = xb_ld(&bar[XB_XCNT(j)]); sum += c; cnt += (c > 0u) ? 1u : 0u; mine = (j == x) ? c : mine; }
        if (sum == G) break;
        __builtin_amdgcn_s_sleep(1);
        if ((++sp & 255u) == 0u) { if (xb_ld(&bar[XB_TMO])) break; if (sp > XB_SPIN_CAP) { atomicAdd(&bar[XB_TMO], 1u); break; } }
    }
    nloc = mine > 0u ? mine : 1u; nx = cnt > 0u ? cnt : 1u;
}
DEVI void xcd_barrier(const XcdBarrier& b) {
    asm volatile("s_waitcnt vmcnt(0)" ::: "memory");
    __syncthreads();
    if (threadIdx.x == 0) {
        unsigned* bar = b.bar;
        __builtin_amdgcn_s_waitcnt(0);
        unsigned nloc = b.st[0], nx = b.st[1];
        if (nloc == 0u) { xcd_barrier_complete(bar, b.x, nloc, nx); b.st[0] = nloc; b.st[1] = nx; }
        const unsigned old = xb_add(&bar[XB_XSUB(b.x)], 1u);
        const unsigned gen = old / nloc;
        if (old + 1u == (gen + 1u) * nloc) {
            __builtin_amdgcn_fence(__ATOMIC_RELEASE, "agent");
            asm volatile("s_waitcnt vmcnt(0)" ::: "memory");
            const unsigned og = xb_add(&bar[XB_TOP], 1u);
            const unsigned tg = og / nx;
            if (og + 1u == (tg + 1u) * nx) xb_add(&bar[XB_TOPGEN], 1u);
            else XB_SPIN(xb_ld(&bar[XB_TOPGEN]) == tg, bar);
            __builtin_amdgcn_fence(__ATOMIC_ACQUIRE, "agent");
            xb_add(&bar[XB_XGEN(b.x)], 1u);
            asm volatile("s_waitcnt vmcnt(0)" ::: "memory");
        } else {
            XB_SPIN(xb_ld(&bar[XB_XGEN(b.x)]) == gen, bar);
            __builtin_amdgcn_fence(__ATOMIC_ACQUIRE, "agent");
            asm volatile("s_waitcnt vmcnt(0)" ::: "memory");
        }
    }
    __syncthreads();
}

#define PH(k, call) { const int _k = (k); if (p.lo <= _k && _k < p.hi) { call; if (_k + 1 < p.hi) { if (_k == 0) grid.sync(); else xcd_barrier(xbar); } } }
__global__ void __launch_bounds__(KTHREADS, 2) hybrid_fwd(Params p) {
  extern __shared__ __attribute__((aligned(16))) unsigned char lds_full[];
  unsigned char* lds = lds_full + hb_() * LDS_HALF;
  cg::grid_group grid = cg::this_grid();
  volatile LAS unsigned* xst = (volatile LAS unsigned*)(LAS unsigned char*)(lds_full + 2 * LDS_HALF);
  if (threadIdx.x < 4) { xst[threadIdx.x] = 0u; g_hs[threadIdx.x] = 0u; }
  __syncthreads();
  XcdBarrier xbar = xcd_barrier_post((unsigned*)(p.ws + WS_CTL), xst);
  PH(0, phase_prep(p, lds))
#define LAYER(l) { \
    PH(1 + 13 * l + 0, phase_g1(p, l, lds_full)) \
    PH(1 + 13 * l + 2, phase_g2(p, l, lds)) \
    PH(1 + 13 * l + 3, phase_r2(p, l, lds)) \
    PH(1 + 13 * l + 4, phase_a1(p, l, lds_full)) \
    PH(1 + 13 * l + 5, phase_r3(p, l, lds)) \
    PH(1 + 13 * l + 6, phase_g3(p, l, lds)) \
    PH(1 + 13 * l + 7, phase_r4(p, l)) \
    PH(1 + 13 * l + 8, phase_g4(p, l, lds_full)) \
    PH(1 + 13 * l + 9, phase_r5(p, l, lds)) \
    PH(1 + 13 * l + 10, phase_g5(p, l, lds)) \
    PH(1 + 13 * l + 11, phase_g6(p, l, lds)) }
  LAYER(0)
  LAYER(1)
}

extern "C" void kernel_launch(void* const* d_in, const int* in_sizes, int n_in, void* d_out, int out_size, void* d_ws, size_t ws_size, hipStream_t stream) {
  static int grid_blocks = 0;
  if (!grid_blocks) {
    if (n_in != 45 || ws_size < WS_END) { fprintf(stderr, "kernel_launch: unexpected n_in %d or ws_size %zu (< %zu)\n", n_in, ws_size, (size_t)WS_END); grid_blocks = -1; return; }
    int dev = 0, cus = 0, per_cu = 0;
    hipGetDevice(&dev);
    hipDeviceGetAttribute(&cus, hipDeviceAttributeMultiprocessorCount, dev);
    hipFuncSetAttribute((const void*)hybrid_fwd, hipFuncAttributeMaxDynamicSharedMemorySize, LDS_ALLOC);
    hipOccupancyMaxActiveBlocksPerMultiprocessor(&per_cu, (const void*)hybrid_fwd, KTHREADS, LDS_ALLOC);
    if (per_cu < 1) per_cu = 1;
    if (per_cu > 1) per_cu = 1;
    grid_blocks = cus * per_cu;
    fprintf(stderr, "kernel_launch: cus %d per_cu %d grid %d\n", cus, per_cu, grid_blocks);
  }
  if (grid_blocks < 0) return;
  static_assert(XCD_BAR_WORDS * 4 <= WS_QCTR, "control region layout");
  (void)hipMemsetAsync((unsigned char*)d_ws + WS_CTL, 0, WS_QCTR + NL * 16 * 4, stream);
  Params p{};
  for (int i = 0; i < 45; ++i) p.in[i] = (const float*)d_in[i];
  p.out = (float*)d_out; p.ws = (unsigned char*)d_ws;
#if N_LAUNCH_MODE == 1
  p.lo = 0; p.hi = NPH;
  { void* args[] = {&p}; hipError_t e = hipLaunchCooperativeKernel((void*)hybrid_fwd, dim3(grid_blocks), dim3(KTHREADS), args, LDS_ALLOC, stream);
    if (e != hipSuccess) fprintf(stderr, "cooperative launch failed: %s\n", hipGetErrorString(e)); }
#else
  for (int ph = 0; ph < NPH; ++ph) {
    p.lo = ph; p.hi = ph + 1;
    void* args[] = {&p}; hipError_t e = hipLaunchCooperativeKernel((void*)hybrid_fwd, dim3(grid_blocks), dim3(KTHREADS), args, LDS_ALLOC, stream);
    if (e != hipSuccess) { fprintf(stderr, "launch %d failed: %s\n", ph, hipGetErrorString(e)); break; }
  }
#endif
}
```
